# Optimizing an MI355X kernel written in HIP

```python
import math
import jax, jax.numpy as jnp
from jax import lax
import numpy as np

D_MODEL = 1024
BATCH = 2
SEQ = 8192
DEPTH = 2

MEM_LEN = 256
HEAD_DIM = 64
D_MIX = D_MODEL
W_CONV = D_MIX // 4
W_RWKV = D_MIX // 4
W_GMLP = D_MIX // 4
W_NSA = D_MIX - W_CONV - W_RWKV - W_GMLP
N_CONV_GROUPS = W_CONV // HEAD_DIM
N_RWKV_HEADS = W_RWKV // HEAD_DIM
N_GMLP_HEADS = W_GMLP // HEAD_DIM
N_NSA_HEADS = W_NSA // HEAD_DIM
CONV_WIDTH = 31
LORA_W = 64
LORA_A = 64
LORA_V = 32
LORA_G = 128
RWKV_COLS = 3 * W_RWKV + LORA_W + LORA_A + LORA_G
RWKV_SIZES = (W_RWKV, W_RWKV, W_RWKV, LORA_W, LORA_A, LORA_G)
GMLP_CHUNK = 128
CMP_LEN = 32
CMP_STRIDE = 16
CMP_HIDDEN = 256
SEL_LEN = 64
SEL_TOPN = 16
WINDOW = 512
Q_BLOCK = 128
ROPE_THETA = 10000.0
N_MEM_HEADS = 4
MEM_HEAD_DIM = D_MODEL // N_MEM_HEADS
N_EXPERTS = 16
N_EXPERT_GROUPS = 4
TOP_K = 2
D_EXPERT = 512
ALPHA = (2 * DEPTH) ** 0.25
BETA = (8 * DEPTH) ** -0.25
LN_EPS = 1e-5
RWKV_GN_EPS = 64e-5
NEG = -1e30
IN_SIZES = (W_CONV, W_CONV, RWKV_COLS, W_GMLP, W_GMLP, W_NSA,
            HEAD_DIM, HEAD_DIM, HEAD_DIM, HEAD_DIM, HEAD_DIM, HEAD_DIM, 3 * N_NSA_HEADS)
D_IN = sum(IN_SIZES)

kernel_name = 'hybrid_conv_rwkv7_gmlp_nsa_moe_deepnorm'


def _split_points(sizes):
    pts, acc = [], 0
    for s in sizes[:-1]:
        acc += s
        pts.append(acc)
    return pts


def layer_norm(x, g, b, eps=LN_EPS):
    xf = x.astype(jnp.float32)
    mu = xf.mean(-1, keepdims=True)
    var = jnp.square(xf - mu).mean(-1, keepdims=True)
    return ((xf - mu) * lax.rsqrt(var + eps)).astype(x.dtype) * g + b


def group_norm(x, n_groups, g, b, eps):
    shp = x.shape
    xf = x.astype(jnp.float32).reshape(shp[:-1] + (n_groups, shp[-1] // n_groups))
    mu = xf.mean(-1, keepdims=True)
    var = jnp.square(xf - mu).mean(-1, keepdims=True)
    y = ((xf - mu) * lax.rsqrt(var + eps)).reshape(shp).astype(x.dtype)
    return y * g + b


def token_shift(y, mu):
    y_prev = jnp.pad(y, ((0, 0), (1, 0), (0, 0)))[:, :-1]
    return y + mu * (y_prev - y)


def rope_tables(n_pos, dim):
    inv = ROPE_THETA ** (-jnp.arange(0, dim, 2, dtype=jnp.float32) / dim)
    ang = jnp.arange(n_pos, dtype=jnp.float32)[:, None] * inv[None, :]
    return jnp.cos(ang), jnp.sin(ang)


def apply_rope(x, cos, sin):
    x1, x2 = jnp.split(x, 2, axis=-1)
    return jnp.concatenate([x1 * cos - x2 * sin, x2 * cos + x1 * sin], axis=-1).astype(x.dtype)


def masked_softmax(s, valid):
    s = jnp.where(valid, s, NEG)
    m = jnp.max(s, axis=-1, keepdims=True)
    p = jnp.exp(s - m) * valid
    return p / jnp.maximum(p.sum(-1, keepdims=True), 1e-20)


def conv_mixer(val, gate, w_dw, b_dw, gn_g, gn_b):
    h = val * jax.nn.sigmoid(gate)
    h = lax.conv_general_dilated(h, w_dw[:, None, :], window_strides=(1,),
                                 padding=[(CONV_WIDTH - 1, 0)],
                                 dimension_numbers=('NWC', 'WIO', 'NWC'),
                                 feature_group_count=W_CONV) + b_dw
    h = group_norm(h, N_CONV_GROUPS, gn_g, gn_b, LN_EPS)
    return jax.nn.silu(h)


def wkv7_scan(r, decay, k, v, a_vec, b_vec):
    B_, S_, H_, D_ = r.shape
    xs = tuple(jnp.moveaxis(t.astype(jnp.float32), 1, 0) for t in (r, decay, k, v, a_vec, b_vec))

    def step(state, inp):
        r_t, w_t, k_t, v_t, a_t, b_t = inp
        sa = jnp.einsum('bhvk,bhk->bhv', state, a_t)
        state = (state * w_t[:, :, None, :] + sa[..., None] * b_t[:, :, None, :]
                 + v_t[..., None] * k_t[:, :, None, :])
        return state, jnp.einsum('bhvk,bhk->bhv', state, r_t)

    s0 = jnp.zeros((B_, H_, D_, D_), jnp.float32)
    _, out = lax.scan(step, s0, xs)
    return jnp.moveaxis(out, 0, 1).astype(r.dtype)


def rwkv7_mixer(cols, mu, w0, w_up, a0, a_up, g_up, k_k, k_a, r_k, gn_g, gn_b, v_first, v_mix):
    B_, S_, _ = cols.shape
    y = token_shift(cols, mu)
    r, k, v, wd, ad, gd = jnp.split(y, _split_points(RWKV_SIZES), axis=-1)
    w = -jax.nn.softplus(-(w0 + jnp.tanh(wd) @ w_up)) - 0.5
    a = jax.nn.sigmoid(a0 + ad @ a_up)
    g = jax.nn.sigmoid(gd) @ g_up
    if v_first is None:
        v_first = v
    else:
        v = v + (v_first - v) * v_mix
    hs = lambda t: t.reshape(B_, S_, N_RWKV_HEADS, HEAD_DIM)
    hp = lambda p: p.reshape(N_RWKV_HEADS, HEAD_DIM)
    r, k, v, w, a = hs(r), hs(k), hs(v), hs(w), hs(a)
    kk = (k * hp(k_k)).astype(jnp.float32)
    kk = (kk / jnp.maximum(jnp.sqrt(jnp.sum(kk * kk, -1, keepdims=True)), 1e-12)).astype(k.dtype)
    k = k * (1 + (a - 1) * hp(k_a))
    decay = jnp.exp(-jnp.exp(w.astype(jnp.float32)))
    o = wkv7_scan(r, decay, k, v, -kk, kk * a)
    o = group_norm(o.reshape(B_, S_, W_RWKV), N_RWKV_HEADS, gn_g, gn_b, RWKV_GN_EPS)
    bonus = (jnp.sum(r * k * hp(r_k), -1, keepdims=True) * v).reshape(B_, S_, W_RWKV)
    return (o + bonus) * g, v_first


def gmlp_mixer(u, v, ln_g, ln_b, w_s, b_s):
    u = jax.nn.gelu(u)
    v = layer_norm(jax.nn.gelu(v), ln_g, ln_b)
    B_, S_, C = v.shape
    v = v.reshape(B_, S_ // GMLP_CHUNK, GMLP_CHUNK, N_GMLP_HEADS, C // N_GMLP_HEADS)
    mask = jnp.tril(jnp.ones((GMLP_CHUNK, GMLP_CHUNK), dtype=bool))
    w = jnp.where(mask[None], w_s, 0.0)
    mixed = jnp.einsum('hts,bcshd->bcthd', w, v) + b_s.T[None, None, :, :, None]
    return u * mixed.reshape(B_, S_, C)


def compress_blocks(kv, pe, w1, w2):
    B_, S_, D_ = kv.shape
    r = CMP_LEN // CMP_STRIDE
    n_cmp = S_ // CMP_STRIDE - (r - 1)
    c = kv.reshape(B_, S_ // CMP_STRIDE, CMP_STRIDE, D_)
    blocks = jnp.concatenate([c[:, j:j + n_cmp] for j in range(r)], axis=2) + pe
    h = jax.nn.gelu(blocks.reshape(B_, n_cmp, CMP_LEN * D_) @ w1)
    return h @ w2


def nsa_mixer(q, kc, vc, ks, vs, kw, vw, gate_logits, pe_k, w1_k, w2_k, pe_v, w1_v, w2_v, cos, sin):
    B_, S_, _ = kc.shape
    q = q.reshape(B_, S_, N_NSA_HEADS, HEAD_DIM)
    q_rot = apply_rope(q, cos[:, None, :], sin[:, None, :])
    ks = apply_rope(ks, cos, sin)
    kw = apply_rope(kw, cos, sin)
    k_cmp = compress_blocks(kc, pe_k, w1_k, w2_k)
    v_cmp = compress_blocks(vc, pe_v, w1_v, w2_v)
    n_cmp = k_cmp.shape[1]
    n_sel = S_ // SEL_LEN
    n_top = min(SEL_TOPN, n_sel)
    cmp_start = jnp.arange(n_cmp) * CMP_STRIDE
    cmp_end = cmp_start + CMP_LEN - 1
    sel_start = jnp.arange(n_sel) * SEL_LEN
    overlap = jnp.clip(jnp.minimum(cmp_start[:, None] + CMP_LEN, sel_start[None, :] + SEL_LEN)
                       - jnp.maximum(cmp_start[:, None], sel_start[None, :]), 0, None).astype(jnp.float32) / CMP_LEN
    ks_blk = ks.reshape(B_, n_sel, SEL_LEN, HEAD_DIM)
    vs_blk = vs.reshape(B_, n_sel, SEL_LEN, HEAD_DIM)
    kw_pad = jnp.pad(kw, ((0, 0), (WINDOW, 0), (0, 0)))
    vw_pad = jnp.pad(vw, ((0, 0), (WINDOW, 0), (0, 0)))
    gates = jax.nn.sigmoid(gate_logits.reshape(B_, S_, N_NSA_HEADS, 3))
    scale = HEAD_DIM ** -0.5
    b_idx = jnp.arange(B_)[:, None, None]

    def block(i):
        t0 = i * Q_BLOCK
        pos = t0 + jnp.arange(Q_BLOCK)
        qn = lax.dynamic_slice_in_dim(q, t0, Q_BLOCK, axis=1)
        qr = lax.dynamic_slice_in_dim(q_rot, t0, Q_BLOCK, axis=1)
        gb = lax.dynamic_slice_in_dim(gates, t0, Q_BLOCK, axis=1)
        s_c = jnp.einsum('bthd,bnd->bhtn', qn, k_cmp).astype(jnp.float32) * scale
        p_c = masked_softmax(s_c, cmp_end[None, :] <= pos[:, None])
        o_c = jnp.einsum('bhtn,bnd->bthd', p_c.astype(v_cmp.dtype), v_cmp)
        imp = jnp.einsum('bhtn,nj->btj', p_c, overlap)
        forced = (sel_start[None, :] == (pos[:, None] // SEL_LEN) * SEL_LEN) | (sel_start[None, :] == 0)
        allowed = sel_start[None, :] <= pos[:, None]
        imp = jnp.where(forced, jnp.inf, jnp.where(allowed, imp, -jnp.inf))
        _, idx = lax.top_k(imp, n_top)
        kg = ks_blk[b_idx, idx]
        vg = vs_blk[b_idx, idx]
        key_pos = idx[..., None] * SEL_LEN + jnp.arange(SEL_LEN)
        valid_s = (key_pos <= pos[None, :, None, None]).reshape(B_, 1, Q_BLOCK, n_top * SEL_LEN)
        s_s = jnp.einsum('bthd,btnld->bhtnl', qr, kg).astype(jnp.float32).reshape(
            B_, N_NSA_HEADS, Q_BLOCK, n_top * SEL_LEN) * scale
        p_s = masked_softmax(s_s, valid_s).reshape(B_, N_NSA_HEADS, Q_BLOCK, n_top, SEL_LEN)
        o_s = jnp.einsum('bhtnl,btnld->bthd', p_s.astype(vg.dtype), vg)
        kwb = lax.dynamic_slice_in_dim(kw_pad, t0, WINDOW + Q_BLOCK, axis=1)
        vwb = lax.dynamic_slice_in_dim(vw_pad, t0, WINDOW + Q_BLOCK, axis=1)
        kpos = t0 - WINDOW + jnp.arange(WINDOW + Q_BLOCK)
        valid_w = ((kpos[None, :] <= pos[:, None]) & (kpos[None, :] > pos[:, None] - WINDOW)
                   & (kpos[None, :] >= 0))
        s_w = jnp.einsum('bthd,bsd->bhts', qr, kwb).astype(jnp.float32) * scale
        p_w = masked_softmax(s_w, valid_w)
        o_w = jnp.einsum('bhts,bsd->bthd', p_w.astype(vwb.dtype), vwb)
        return gb[..., 0:1] * o_c + gb[..., 1:2] * o_s + gb[..., 2:3] * o_w

    out = lax.map(block, jnp.arange(S_ // Q_BLOCK))
    return jnp.moveaxis(out, 0, 1).reshape(B_, S_, W_NSA)


def mem_cross_attention(x, mem, wq, wk, wv, wo):
    B_, S_, _ = x.shape
    M_ = mem.shape[1]
    q = (x @ wq).reshape(B_, S_, N_MEM_HEADS, MEM_HEAD_DIM)
    k = (mem @ wk).reshape(B_, M_, N_MEM_HEADS, MEM_HEAD_DIM)
    v = (mem @ wv).reshape(B_, M_, N_MEM_HEADS, MEM_HEAD_DIM)
    s = jnp.einsum('bshd,bmhd->bhsm', q, k).astype(jnp.float32) * (MEM_HEAD_DIM ** -0.5)
    p = jax.nn.softmax(s, axis=-1).astype(v.dtype)
    o = jnp.einsum('bhsm,bmhd->bshd', p, v).reshape(B_, S_, D_MODEL)
    return o @ wo


def moe_ffn(x, router_w, router_bias, w_gate, w_up, w_down):
    B_, S_, D_ = x.shape
    t = x.reshape(-1, D_)
    probs = jax.nn.softmax((t @ router_w).astype(jnp.float32), axis=-1)
    sel = probs + router_bias
    grp = sel.reshape(-1, N_EXPERT_GROUPS, N_EXPERTS // N_EXPERT_GROUPS)
    grp_score = lax.top_k(grp, TOP_K)[0].sum(-1)
    g_idx = jnp.argmax(grp_score, axis=-1)
    in_group = (jnp.arange(N_EXPERTS) // (N_EXPERTS // N_EXPERT_GROUPS))[None, :] == g_idx[:, None]
    _, e_idx = lax.top_k(jnp.where(in_group, sel, -jnp.inf), TOP_K)
    w_sel = jnp.take_along_axis(probs, e_idx, axis=-1)
    w_sel = w_sel / w_sel.sum(-1, keepdims=True)
    gates = jnp.sum(jax.nn.one_hot(e_idx, N_EXPERTS, dtype=jnp.float32) * w_sel[..., None], axis=1)
    y = jnp.zeros(t.shape, jnp.float32)
    for e in range(N_EXPERTS):
        he = jax.nn.silu(t @ w_gate[e]) * (t @ w_up[e])
        y = y + gates[:, e:e + 1] * (he @ w_down[e])
    return y.astype(x.dtype).reshape(B_, S_, D_)


def setup_inputs(seed: int = 0) -> dict:
    key = jax.random.key(seed)
    ks = iter(jax.random.split(key, 80))
    nrm = lambda shape, scale: scale * jax.random.normal(next(ks), shape, jnp.float32)
    L = DEPTH
    LV = DEPTH - 1
    D = D_MODEL
    return {
        'x': nrm((BATCH, SEQ, D), 1.0),
        'mem': nrm((BATCH, MEM_LEN, D), 1.0),
        'ln_in_g': 1.0 + nrm((D,), 0.05),
        'ln_in_b': nrm((D,), 0.02),
        'w_in': nrm((L, D, D_IN), D ** -0.5),
        'w_out': nrm((L, D_MIX, D), BETA * D_MIX ** -0.5),
        'conv_w': nrm((L, CONV_WIDTH, W_CONV), CONV_WIDTH ** -0.5),
        'conv_b': nrm((L, W_CONV), 0.02),
        'conv_gn_g': 1.0 + nrm((L, W_CONV), 0.05),
        'conv_gn_b': nrm((L, W_CONV), 0.02),
        'rwkv_mu': jax.random.uniform(next(ks), (L, RWKV_COLS), jnp.float32),
        'rwkv_w0': nrm((L, W_RWKV), 0.5),
        'rwkv_w_up': nrm((L, LORA_W, W_RWKV), 0.3 * LORA_W ** -0.5),
        'rwkv_a0': nrm((L, W_RWKV), 0.5),
        'rwkv_a_up': nrm((L, LORA_A, W_RWKV), 0.3 * LORA_A ** -0.5),
        'rwkv_g_up': nrm((L, LORA_G, W_RWKV), LORA_G ** -0.5),
        'rwkv_k_k': 0.85 + nrm((L, W_RWKV), 0.05),
        'rwkv_k_a': 1.0 + nrm((L, W_RWKV), 0.05),
        'rwkv_r_k': nrm((L, W_RWKV), 0.1),
        'rwkv_gn_g': 1.0 + nrm((L, W_RWKV), 0.05),
        'rwkv_gn_b': nrm((L, W_RWKV), 0.02),
        'rwkv_v_down': nrm((LV, D, LORA_V), D ** -0.5),
        'rwkv_v_mu': jax.random.uniform(next(ks), (LV, LORA_V), jnp.float32),
        'rwkv_v0': nrm((LV, W_RWKV), 0.5),
        'rwkv_v_up': nrm((LV, LORA_V, W_RWKV), LORA_V ** -0.5),
        'gmlp_ln_g': 1.0 + nrm((L, W_GMLP), 0.05),
        'gmlp_ln_b': nrm((L, W_GMLP), 0.02),
        'gmlp_w_s': nrm((L, N_GMLP_HEADS, GMLP_CHUNK, GMLP_CHUNK), 0.5 * GMLP_CHUNK ** -0.5),
        'gmlp_b_s': 1.0 + nrm((L, N_GMLP_HEADS, GMLP_CHUNK), 0.1),
        'nsa_pe_k': nrm((L, CMP_LEN, HEAD_DIM), 0.1),
        'nsa_w1_k': nrm((L, CMP_LEN * HEAD_DIM, CMP_HIDDEN), (CMP_LEN * HEAD_DIM) ** -0.5),
        'nsa_w2_k': nrm((L, CMP_HIDDEN, HEAD_DIM), CMP_HIDDEN ** -0.5),
        'nsa_pe_v': nrm((L, CMP_LEN, HEAD_DIM), 0.1),
        'nsa_w1_v': nrm((L, CMP_LEN * HEAD_DIM, CMP_HIDDEN), (CMP_LEN * HEAD_DIM) ** -0.5),
        'nsa_w2_v': nrm((L, CMP_HIDDEN, HEAD_DIM), CMP_HIDDEN ** -0.5),
        'ln1_g': 1.0 + nrm((L, D), 0.05),
        'ln1_b': nrm((L, D), 0.02),
        'xa_wq': nrm((L, D, D), D ** -0.5),
        'xa_wk': nrm((L, D, D), D ** -0.5),
        'xa_wv': nrm((L, D, D), BETA * D ** -0.5),
        'xa_wo': nrm((L, D, D), BETA * D ** -0.5),
        'ln2_g': 1.0 + nrm((L, D), 0.05),
        'ln2_b': nrm((L, D), 0.02),
        'router_w': nrm((D, N_EXPERTS), D ** -0.5),
        'router_bias': nrm((N_EXPERTS,), 0.01),
        'moe_w_gate': nrm((L, N_EXPERTS, D, D_EXPERT), D ** -0.5),
        'moe_w_up': nrm((L, N_EXPERTS, D, D_EXPERT), D ** -0.5),
        'moe_w_down': nrm((L, N_EXPERTS, D_EXPERT, D), BETA * D_EXPERT ** -0.5),
        'ln3_g': 1.0 + nrm((L, D), 0.05),
        'ln3_b': nrm((L, D), 0.02),
    }


def reference(x, mem, ln_in_g, ln_in_b, w_in, w_out, conv_w, conv_b, conv_gn_g, conv_gn_b,
              rwkv_mu, rwkv_w0, rwkv_w_up, rwkv_a0, rwkv_a_up, rwkv_g_up, rwkv_k_k, rwkv_k_a,
              rwkv_r_k, rwkv_gn_g, rwkv_gn_b, rwkv_v_down, rwkv_v_mu, rwkv_v0, rwkv_v_up,
              gmlp_ln_g, gmlp_ln_b, gmlp_w_s, gmlp_b_s,
              nsa_pe_k, nsa_w1_k, nsa_w2_k, nsa_pe_v, nsa_w1_v, nsa_w2_v,
              ln1_g, ln1_b, xa_wq, xa_wk, xa_wv, xa_wo, ln2_g, ln2_b,
              router_w, router_bias, moe_w_gate, moe_w_up, moe_w_down, ln3_g, ln3_b):
    S_ = x.shape[1]
    cos, sin = rope_tables(S_, HEAD_DIM)
    in_points = _split_points(IN_SIZES)
    x = layer_norm(x, ln_in_g, ln_in_b)
    v_first = None
    for l in range(DEPTH):
        cols = x @ w_in[l]
        (a_val, a_gate, b_cols, c_u, c_v, d_q, d_kc, d_vc, d_ks, d_vs, d_kw, d_vw,
         d_gate) = jnp.split(cols, in_points, axis=-1)
        out_a = conv_mixer(a_val, a_gate, conv_w[l], conv_b[l], conv_gn_g[l], conv_gn_b[l])
        v_mix = None
        if l > 0:
            vd = token_shift(x @ rwkv_v_down[l - 1], rwkv_v_mu[l - 1])
            v_mix = jax.nn.sigmoid(rwkv_v0[l - 1] + vd @ rwkv_v_up[l - 1])
        out_b, v_first = rwkv7_mixer(b_cols, rwkv_mu[l], rwkv_w0[l], rwkv_w_up[l], rwkv_a0[l],
                                     rwkv_a_up[l], rwkv_g_up[l], rwkv_k_k[l], rwkv_k_a[l],
                                     rwkv_r_k[l], rwkv_gn_g[l], rwkv_gn_b[l], v_first, v_mix)
        out_c = gmlp_mixer(c_u, c_v, gmlp_ln_g[l], gmlp_ln_b[l], gmlp_w_s[l], gmlp_b_s[l])
        out_d = nsa_mixer(d_q, d_kc, d_vc, d_ks, d_vs, d_kw, d_vw, d_gate,
                          nsa_pe_k[l], nsa_w1_k[l], nsa_w2_k[l], nsa_pe_v[l], nsa_w1_v[l], nsa_w2_v[l],
                          cos, sin)
        mix = jnp.concatenate([out_a, out_b, out_c, out_d], axis=-1) @ w_out[l]
        x = layer_norm(ALPHA * x + mix, ln1_g[l], ln1_b[l])
        x = layer_norm(ALPHA * x + mem_cross_attention(x, mem, xa_wq[l], xa_wk[l], xa_wv[l], xa_wo[l]),
                       ln2_g[l], ln2_b[l])
        x = layer_norm(ALPHA * x + moe_ffn(x, router_w, router_bias, moe_w_gate[l], moe_w_up[l], moe_w_down[l]),
                       ln3_g[l], ln3_b[l])
    return x
```

```cpp
#include <hip/hip_runtime.h>
#include <stdint.h>
#include <string.h>
#include <math.h>

#define DEVI __device__ __forceinline__

constexpr int NB = 2, SEQ = 8192, DM = 1024, NTOK = NB * SEQ, DIN = 2700, MEML = 256;
constexpr int OFF_CV = 0, OFF_CG = 256, OFF_RW = 512, OFF_GU = 1536, OFF_GV = 1792, OFF_Q = 2048, OFF_KC = 2304,
              OFF_VC = 2368, OFF_KS = 2432, OFF_VS = 2496, OFF_KW = 2560, OFF_VW = 2624, OFF_GT = 2688;
constexpr int NCMP = 511;
constexpr float ALPHA = 1.4142135623730951f;

DEVI float wave_sum(float v) {
#pragma unroll
    for (int o = 32; o > 0; o >>= 1) v += __shfl_xor(v, o, 64);
    return v;
}
DEVI float wave_max(float v) {
#pragma unroll
    for (int o = 32; o > 0; o >>= 1) v = fmaxf(v, __shfl_xor(v, o, 64));
    return v;
}
DEVI float sigm(float x) { return 1.f / (1.f + expf(-x)); }
DEVI float gelu_t(float x) { return 0.5f * x * (1.f + tanhf(0.7978845608028654f * (x + 0.044715f * x * x * x))); }
DEVI float softplus_(float x) { return fmaxf(x, 0.f) + log1pf(expf(-fabsf(x))); }

DEVI float block_sum256(float v, float* red) {
    v = wave_sum(v);
    __syncthreads();
    if ((threadIdx.x & 63) == 0) red[threadIdx.x >> 6] = v;
    __syncthreads();
    return red[0] + red[1] + red[2] + red[3];
}

__global__ __launch_bounds__(256) void ln_kernel(const float* xres, float alpha, const float* add, const float* __restrict__ g,
                                                 const float* __restrict__ bt, float* out) {
    __shared__ float red[4];
    const size_t row = blockIdx.x;
    const int tid = threadIdx.x;
    float v[4];
#pragma unroll
    for (int i = 0; i < 4; ++i) {
        const size_t idx = row * DM + tid + i * 256;
        v[i] = alpha * xres[idx] + (add ? add[idx] : 0.f);
    }
    const float mean = block_sum256(v[0] + v[1] + v[2] + v[3], red) * (1.f / DM);
    float q = 0.f;
#pragma unroll
    for (int i = 0; i < 4; ++i) { v[i] -= mean; q += v[i] * v[i]; }
    const float var = block_sum256(q, red) * (1.f / DM);
    const float rstd = rsqrtf(var + 1e-5f);
#pragma unroll
    for (int i = 0; i < 4; ++i) {
        const int c = tid + i * 256;
        out[row * DM + c] = v[i] * rstd * g[c] + bt[c];
    }
}

struct GemmArgs {
    const float* A; const float* B; float* C; const int* rowidx; const int* zoff;
    long lda, sbk, sbn, ldc, sAz0, sAz1, sBz0, sBz1, sCz0, sCz1;
    int M, N, K, Z1, epi, pad;
};
__global__ __launch_bounds__(256) void gemm_f32(GemmArgs g) {
    __shared__ float As[16][68];
    __shared__ float Bs[16][68];
    const int z = blockIdx.z, z0 = z / g.Z1, z1 = z % g.Z1;
    int mbeg = 0, mend = g.M;
    if (g.zoff) { mbeg = g.zoff[z]; mend = g.zoff[z + 1]; }
    const int m0 = mbeg + blockIdx.y * 64;
    if (m0 >= mend) return;
    const int n0 = blockIdx.x * 64;
    const float* A = g.A + z0 * g.sAz0 + z1 * g.sAz1;
    const float* B = g.B + z0 * g.sBz0 + z1 * g.sBz1;
    float* C = g.C + z0 * g.sCz0 + z1 * g.sCz1;
    const int tid = threadIdx.x, tx = tid & 15, ty = tid >> 4;
    float acc[4][4];
#pragma unroll
    for (int i = 0; i < 4; ++i)
#pragma unroll
        for (int j = 0; j < 4; ++j) acc[i][j] = 0.f;
    long arow[4];
#pragma unroll
    for (int i = 0; i < 4; ++i) {
        const int r = (tid + i * 256) >> 4;
        const int row = m0 + r;
        if (row < mend) arow[i] = (long)(g.rowidx ? g.rowidx[row] : row) * g.lda; else arow[i] = -1;
    }
    for (int k0 = 0; k0 < g.K; k0 += 16) {
#pragma unroll
        for (int i = 0; i < 4; ++i) {
            const int e = tid + i * 256, r = e >> 4, kk = e & 15;
            float v = 0.f;
            if (arow[i] >= 0 && k0 + kk < g.K) v = A[arow[i] + k0 + kk];
            As[kk][r] = v;
        }
#pragma unroll
        for (int i = 0; i < 4; ++i) {
            const int e = tid + i * 256, kk = e >> 6, n = e & 63;
            float v = 0.f;
            if (n0 + n < g.N && k0 + kk < g.K) v = B[(long)(k0 + kk) * g.sbk + (long)(n0 + n) * g.sbn];
            Bs[kk][n] = v;
        }
        __syncthreads();
#pragma unroll
        for (int kk = 0; kk < 16; ++kk) {
            float a[4], b[4];
#pragma unroll
            for (int i = 0; i < 4; ++i) a[i] = As[kk][ty * 4 + i];
#pragma unroll
            for (int j = 0; j < 4; ++j) b[j] = Bs[kk][tx * 4 + j];
#pragma unroll
            for (int i = 0; i < 4; ++i)
#pragma unroll
                for (int j = 0; j < 4; ++j) acc[i][j] = fmaf(a[i], b[j], acc[i][j]);
        }
        __syncthreads();
    }
#pragma unroll
    for (int i = 0; i < 4; ++i) {
        const int row = m0 + ty * 4 + i;
        if (row >= mend) continue;
#pragma unroll
        for (int j = 0; j < 4; ++j) {
            const int col = n0 + tx * 4 + j;
            if (col >= g.N) continue;
            float* p = C + (long)row * g.ldc + col;
            float v = acc[i][j];
            if (g.epi == 1) { v = v * sigm(v) * (*p); }
            *p = v;
        }
    }
}

__global__ __launch_bounds__(256) void glu_kernel(const float* __restrict__ cols, float* __restrict__ h) {
    const size_t t = blockIdx.x; const int c = threadIdx.x;
    h[t * 256 + c] = cols[t * DIN + OFF_CV + c] * sigm(cols[t * DIN + OFF_CG + c]);
}
__global__ __launch_bounds__(256) void conv_kernel(const float* __restrict__ h, const float* __restrict__ w, const float* __restrict__ bias,
                                                   const float* __restrict__ gg, const float* __restrict__ gb, float* __restrict__ mix) {
    const int t = blockIdx.x, c = threadIdx.x;
    float acc = bias[c];
    for (int j = 0; j < 31; ++j) {
        const int tt = t - 30 + j;
        if (tt >= 0) acc = fmaf(h[(size_t)tt * 256 + c], w[j * 256 + c], acc);
    }
    const float mean = wave_sum(acc) * (1.f / 64.f);
    const float d = acc - mean;
    const float var = wave_sum(d * d) * (1.f / 64.f);
    const float y = d * rsqrtf(var + 1e-5f) * gg[c] + gb[c];
    mix[(size_t)t * DM + 0 + c] = y * sigm(y);
}

__global__ __launch_bounds__(256) void gmlp_pre(const float* __restrict__ cols, const float* __restrict__ lg, const float* __restrict__ lb,
                                                float* __restrict__ ub, float* __restrict__ vb) {
    __shared__ float red[4];
    const size_t t = blockIdx.x; const int c = threadIdx.x;
    ub[t * 256 + c] = gelu_t(cols[t * DIN + OFF_GU + c]);
    const float v = gelu_t(cols[t * DIN + OFF_GV + c]);
    const float mean = block_sum256(v, red) * (1.f / 256.f);
    const float d = v - mean;
    const float var = block_sum256(d * d, red) * (1.f / 256.f);
    vb[t * 256 + c] = d * rsqrtf(var + 1e-5f) * lg[c] + lb[c];
}
__global__ __launch_bounds__(256) void gmlp_mix(const float* __restrict__ ub, const float* __restrict__ vb, const float* __restrict__ ws,
                                                const float* __restrict__ bs, float* __restrict__ mix) {
    const int t = blockIdx.x, c = threadIdx.x, h = c >> 6, tt = t & 127, base = t - tt;
    float acc = bs[h * 128 + tt];
    const float* wr = ws + ((size_t)h * 128 + tt) * 128;
    for (int s = 0; s <= tt; ++s) acc = fmaf(wr[s], vb[(size_t)(base + s) * 256 + c], acc);
    mix[(size_t)t * DM + 512 + c] = ub[(size_t)t * 256 + c] * acc;
}

struct RwkvP {
    const float* cols; const float* mu; const float* w0; const float* w_up; const float* a0; const float* a_up; const float* g_up;
    const float* k_k; const float* k_a; const float* r_k; const float* vd; const float* v_mu; const float* v0; const float* v_up;
    float* vfirst; float* R; float* W; float* K; float* V; float* A; float* Bv; float* G; float* BON;
    int layer, pad;
};
__global__ __launch_bounds__(256) void rwkv_prep(RwkvP p) {
    __shared__ float y[1024];
    __shared__ float vds[32];
    const int t = blockIdx.x, c = threadIdx.x;
#pragma unroll
    for (int q = 0; q < 4; ++q) {
        const int j = c + q * 256;
        const float cur = p.cols[(size_t)t * DIN + OFF_RW + j];
        const float prv = t > 0 ? p.cols[(size_t)(t - 1) * DIN + OFF_RW + j] : 0.f;
        y[j] = cur + p.mu[j] * (prv - cur);
    }
    if (p.layer > 0 && c < 32) {
        const float cur = p.vd[(size_t)t * 32 + c];
        const float prv = t > 0 ? p.vd[(size_t)(t - 1) * 32 + c] : 0.f;
        vds[c] = cur + p.v_mu[c] * (prv - cur);
    }
    __syncthreads();
    float tw = 0.f, sg = 0.f;
    if (c < 64) tw = tanhf(y[768 + c]);
    if (c >= 128) sg = sigm(y[896 + (c - 128)]);
    __syncthreads();
    if (c < 64) y[768 + c] = tw;
    if (c >= 128) y[896 + (c - 128)] = sg;
    __syncthreads();
    const float r = y[c], k = y[256 + c];
    float v = y[512 + c];
    float wl = p.w0[c], al = p.a0[c], gl = 0.f;
    for (int j = 0; j < 64; ++j) { wl = fmaf(y[768 + j], p.w_up[j * 256 + c], wl); al = fmaf(y[832 + j], p.a_up[j * 256 + c], al); }
    for (int j = 0; j < 128; ++j) gl = fmaf(y[896 + j], p.g_up[j * 256 + c], gl);
    const float wlog = -softplus_(-wl) - 0.5f;
    const float decay = expf(-expf(wlog));
    const float a = sigm(al);
    if (p.layer == 0) {
        p.vfirst[(size_t)t * 256 + c] = v;
    } else {
        float vm = p.v0[c];
        for (int j = 0; j < 32; ++j) vm = fmaf(vds[j], p.v_up[j * 256 + c], vm);
        vm = sigm(vm);
        v = v + (p.vfirst[(size_t)t * 256 + c] - v) * vm;
    }
    float kk = k * p.k_k[c];
    const float nrm = sqrtf(wave_sum(kk * kk));
    kk = kk / fmaxf(nrm, 1e-12f);
    const float k2 = k * (1.f + (a - 1.f) * p.k_a[c]);
    const float bd = wave_sum(r * k2 * p.r_k[c]);
    const size_t o = (size_t)t * 256 + c;
    p.R[o] = r; p.W[o] = decay; p.K[o] = k2; p.V[o] = v; p.A[o] = -kk; p.Bv[o] = kk * a; p.G[o] = gl; p.BON[o] = bd * v;
}
__global__ __launch_bounds__(64) void rwkv_scan(float* R, const float* __restrict__ W, const float* __restrict__ K, const float* __restrict__ V,
                                                const float* __restrict__ A, const float* __restrict__ Bv) {
    __shared__ float sr[16][64], sw[16][64], sk[16][64], sa[16][64], sb[16][64], sv[16][64];
    const int h = blockIdx.x, tid = threadIdx.x;
    float st[64];
#pragma unroll
    for (int i = 0; i < 64; ++i) st[i] = 0.f;
    for (int t0 = 0; t0 < SEQ; t0 += 16) {
        __syncthreads();
#pragma unroll
        for (int s = 0; s < 16; ++s) {
            const size_t idx = (size_t)(t0 + s) * 256 + h * 64 + tid;
            sr[s][tid] = R[idx]; sw[s][tid] = W[idx]; sk[s][tid] = K[idx]; sa[s][tid] = A[idx]; sb[s][tid] = Bv[idx]; sv[s][tid] = V[idx];
        }
        __syncthreads();
#pragma unroll 1
        for (int s = 0; s < 16; ++s) {
            const float vt = sv[s][tid];
            float sa_ = 0.f;
#pragma unroll
            for (int k = 0; k < 64; ++k) sa_ = fmaf(st[k], sa[s][k], sa_);
#pragma unroll
            for (int k = 0; k < 64; ++k) st[k] = fmaf(st[k], sw[s][k], fmaf(sa_, sb[s][k], vt * sk[s][k]));
            float o = 0.f;
#pragma unroll
            for (int k = 0; k < 64; ++k) o = fmaf(st[k], sr[s][k], o);
            R[(size_t)(t0 + s) * 256 + h * 64 + tid] = o;
        }
    }
}
__global__ __launch_bounds__(256) void rwkv_post(const float* __restrict__ O, const float* __restrict__ BON, const float* __restrict__ G,
                                                 const float* __restrict__ gg, const float* __restrict__ gb, float* __restrict__ mix) {
    const size_t t = blockIdx.x; const int c = threadIdx.x;
    const float o = O[t * 256 + c];
    const float mean = wave_sum(o) * (1.f / 64.f);
    const float d = o - mean;
    const float var = wave_sum(d * d) * (1.f / 64.f);
    const float y = d * rsqrtf(var + 64e-5f) * gg[c] + gb[c];
    mix[t * DM + 256 + c] = (y + BON[t * 256 + c]) * G[t * 256 + c];
}

__global__ __launch_bounds__(256) void nsa_prep(const float* __restrict__ cols, float* __restrict__ qrot, float* __restrict__ ksr,
                                                float* __restrict__ kwr, float* __restrict__ gates) {
    const int t = blockIdx.x, c = threadIdx.x;
    const int d = c & 63, j = d & 31;
    const float inv = powf(10000.f, -(float)j / 32.f);
    const float ang = (float)t * inv;
    float sn, cs; sincosf(ang, &sn, &cs);
    {
        const float* q = cols + (size_t)t * DIN + OFF_Q + (c & ~63);
        const float x1 = q[j], x2 = q[j + 32];
        qrot[(size_t)t * 256 + c] = d < 32 ? x1 * cs - x2 * sn : x2 * cs + x1 * sn;
    }
    if (c < 128) {
        const float* kp = cols + (size_t)t * DIN + (c < 64 ? OFF_KS : OFF_KW);
        const float x1 = kp[j], x2 = kp[j + 32];
        const float v = d < 32 ? x1 * cs - x2 * sn : x2 * cs + x1 * sn;
        if (c < 64) ksr[(size_t)t * 64 + d] = v; else kwr[(size_t)t * 64 + d] = v;
    }
    if (c < 12) gates[(size_t)t * 12 + c] = sigm(cols[(size_t)t * DIN + OFF_GT + c]);
}
__global__ __launch_bounds__(256) void cmp_gather(const float* __restrict__ cols, const float* __restrict__ pek, const float* __restrict__ pev,
                                                  float* __restrict__ bk, float* __restrict__ bv) {
    const int n = blockIdx.x, tid = threadIdx.x;
    for (int i = tid; i < 2048; i += 256) {
        const int l = i >> 6, d = i & 63;
        const size_t row = (size_t)(16 * n + l) * DIN;
        bk[(size_t)n * 2048 + i] = cols[row + OFF_KC + d] + pek[i];
        bv[(size_t)n * 2048 + i] = cols[row + OFF_VC + d] + pev[i];
    }
}
__global__ void gelu_inplace(float* p, int n) {
    const int i = blockIdx.x * blockDim.x + threadIdx.x;
    if (i < n) p[i] = gelu_t(p[i]);
}

DEVI void wave_softmax(float* s, int n, int lane) {
    float m = -INFINITY;
    for (int i = lane; i < n; i += 64) m = fmaxf(m, s[i]);
    m = wave_max(m);
    if (m == -INFINITY) { for (int i = lane; i < n; i += 64) s[i] = 0.f; return; }
    float sum = 0.f;
    for (int i = lane; i < n; i += 64) { const float p = expf(s[i] - m); s[i] = p; sum += p; }
    sum = wave_sum(sum);
    const float inv = 1.f / fmaxf(sum, 1e-20f);
    for (int i = lane; i < n; i += 64) s[i] *= inv;
}
DEVI void dot4(const float* q  , const float* __restrict__ krow, float* out4) {
    float a0 = 0.f, a1 = 0.f, a2 = 0.f, a3 = 0.f;
#pragma unroll
    for (int d = 0; d < 64; d += 4) {
        const float4 kv = *(const float4*)(krow + d);
        a0 += q[d] * kv.x + q[d + 1] * kv.y + q[d + 2] * kv.z + q[d + 3] * kv.w;
        a1 += q[64 + d] * kv.x + q[64 + d + 1] * kv.y + q[64 + d + 2] * kv.z + q[64 + d + 3] * kv.w;
        a2 += q[128 + d] * kv.x + q[128 + d + 1] * kv.y + q[128 + d + 2] * kv.z + q[128 + d + 3] * kv.w;
        a3 += q[192 + d] * kv.x + q[192 + d + 1] * kv.y + q[192 + d + 2] * kv.z + q[192 + d + 3] * kv.w;
    }
    out4[0] = a0; out4[1] = a1; out4[2] = a2; out4[3] = a3;
}
__global__ __launch_bounds__(256) void nsa_attn(const float* __restrict__ cols, const float* __restrict__ qrot, const float* __restrict__ ksr,
                                                const float* __restrict__ kwr, const float* __restrict__ gates, const float* __restrict__ kcmp,
                                                const float* __restrict__ vcmp, float* __restrict__ mix) {
    __shared__ float q[256], qr[256];
    __shared__ float sc[4][1024];
    __shared__ float imp[128];
    __shared__ int sel[16];
    const int pos = blockIdx.x, tid = threadIdx.x, h = tid >> 6, lane = tid & 63;
    q[tid] = cols[(size_t)pos * DIN + OFF_Q + tid];
    qr[tid] = qrot[(size_t)pos * 256 + tid];
    __syncthreads();
    int ncv = pos >= 31 ? (pos - 31) / 16 + 1 : 0;
    if (ncv > NCMP) ncv = NCMP;
    for (int n = tid; n < 512; n += 256) {
        if (n < ncv) {
            float d4[4]; dot4(q, kcmp + (size_t)n * 64, d4);
            sc[0][n] = d4[0] * 0.125f; sc[1][n] = d4[1] * 0.125f; sc[2][n] = d4[2] * 0.125f; sc[3][n] = d4[3] * 0.125f;
        } else { sc[0][n] = 0.f; sc[1][n] = 0.f; sc[2][n] = 0.f; sc[3][n] = 0.f; }
    }
    __syncthreads();
    wave_softmax(sc[h], ncv, lane);
    __syncthreads();
    float oc = 0.f;
    for (int n = 0; n < ncv; ++n) oc = fmaf(sc[h][n], vcmp[(size_t)n * 64 + lane], oc);
    if (tid < 128) {
        const int j = tid;
        auto ps = [&](int n) -> float { return (n >= 0 && n < 512) ? (sc[0][n] + sc[1][n] + sc[2][n] + sc[3][n]) : 0.f; };
        const float v = 0.5f * ps(4 * j - 1) + ps(4 * j) + ps(4 * j + 1) + ps(4 * j + 2) + 0.5f * ps(4 * j + 3);
        const int cur = pos >> 6;
        float key;
        if (j == cur || j == 0) key = INFINITY; else if (j <= cur) key = v; else key = -1.f;
        imp[j] = key;
    }
    __syncthreads();
    if (h == 0) {
        float v0 = imp[lane], v1 = imp[lane + 64];
        for (int r = 0; r < 16; ++r) {
            float bv; int bi;
            if (v1 > v0) { bv = v1; bi = lane + 64; } else { bv = v0; bi = lane; }
#pragma unroll
            for (int o = 32; o > 0; o >>= 1) {
                const float ov = __shfl_xor(bv, o, 64); const int oi = __shfl_xor(bi, o, 64);
                if (ov > bv || (ov == bv && oi < bi)) { bv = ov; bi = oi; }
            }
            if (lane == 0) sel[r] = bi;
            if (bi == lane) v0 = -2.f;
            if (bi == lane + 64) v1 = -2.f;
        }
    }
    __syncthreads();
    for (int i = tid; i < 1024; i += 256) {
        const int kp = sel[i >> 6] * 64 + (i & 63);
        if (kp <= pos) {
            float d4[4]; dot4(qr, ksr + (size_t)kp * 64, d4);
            sc[0][i] = d4[0] * 0.125f; sc[1][i] = d4[1] * 0.125f; sc[2][i] = d4[2] * 0.125f; sc[3][i] = d4[3] * 0.125f;
        } else { sc[0][i] = -INFINITY; sc[1][i] = -INFINITY; sc[2][i] = -INFINITY; sc[3][i] = -INFINITY; }
    }
    __syncthreads();
    wave_softmax(sc[h], 1024, lane);
    __syncthreads();
    float os = 0.f;
    for (int i = 0; i < 1024; ++i) {
        const float p = sc[h][i];
        if (p != 0.f) { const int kp = sel[i >> 6] * 64 + (i & 63); os = fmaf(p, cols[(size_t)kp * DIN + OFF_VS + lane], os); }
    }
    __syncthreads();
    for (int i = tid; i < 512; i += 256) {
        const int kp = pos - 511 + i;
        if (kp >= 0) {
            float d4[4]; dot4(qr, kwr + (size_t)kp * 64, d4);
            sc[0][i] = d4[0] * 0.125f; sc[1][i] = d4[1] * 0.125f; sc[2][i] = d4[2] * 0.125f; sc[3][i] = d4[3] * 0.125f;
        } else { sc[0][i] = -INFINITY; sc[1][i] = -INFINITY; sc[2][i] = -INFINITY; sc[3][i] = -INFINITY; }
    }
    __syncthreads();
    wave_softmax(sc[h], 512, lane);
    __syncthreads();
    float ow = 0.f;
    for (int i = 0; i < 512; ++i) {
        const int kp = pos - 511 + i;
        if (kp >= 0) ow = fmaf(sc[h][i], cols[(size_t)kp * DIN + OFF_VW + lane], ow);
    }
    const float* gt = gates + (size_t)pos * 12 + h * 3;
    mix[(size_t)pos * DM + 768 + tid] = gt[0] * oc + gt[1] * os + gt[2] * ow;
}

__global__ __launch_bounds__(256) void softmax256(float* s, float scale) {
    __shared__ float red[4];
    const size_t row = blockIdx.x; const int tid = threadIdx.x;
    const float v = s[row * 256 + tid] * scale;
    float m = wave_max(v);
    __syncthreads();
    if ((tid & 63) == 0) red[tid >> 6] = m;
    __syncthreads();
    m = fmaxf(fmaxf(red[0], red[1]), fmaxf(red[2], red[3]));
    const float p = expf(v - m);
    const float sum = block_sum256(p, red);
    s[row * 256 + tid] = p / sum;
}

__global__ __launch_bounds__(256) void router_kernel(const float* __restrict__ x, const float* __restrict__ rw, const float* __restrict__ rb,
                                                     int* __restrict__ te, float* __restrict__ tw) {
    __shared__ float part[4][16];
    const size_t t = blockIdx.x; const int tid = threadIdx.x;
    float acc[16];
#pragma unroll
    for (int e = 0; e < 16; ++e) acc[e] = 0.f;
    for (int i = tid; i < DM; i += 256) {
        const float xv = x[t * DM + i];
#pragma unroll
        for (int e = 0; e < 16; ++e) acc[e] = fmaf(xv, rw[i * 16 + e], acc[e]);
    }
#pragma unroll
    for (int e = 0; e < 16; ++e) acc[e] = wave_sum(acc[e]);
    if ((tid & 63) == 0) {
#pragma unroll
        for (int e = 0; e < 16; ++e) part[tid >> 6][e] = acc[e];
    }
    __syncthreads();
    if (tid == 0) {
        float lg[16], pr[16], sl[16];
        float m = -INFINITY;
        for (int e = 0; e < 16; ++e) { lg[e] = part[0][e] + part[1][e] + part[2][e] + part[3][e]; m = fmaxf(m, lg[e]); }
        float sum = 0.f;
        for (int e = 0; e < 16; ++e) { pr[e] = expf(lg[e] - m); sum += pr[e]; }
        for (int e = 0; e < 16; ++e) { pr[e] /= sum; sl[e] = pr[e] + rb[e]; }
        int bg = 0; float bgs = -INFINITY;
        for (int gI = 0; gI < 4; ++gI) {
            float m1 = -INFINITY, m2 = -INFINITY;
            for (int j = 0; j < 4; ++j) { const float v = sl[gI * 4 + j]; if (v > m1) { m2 = m1; m1 = v; } else if (v > m2) m2 = v; }
            const float sc = m1 + m2;
            if (sc > bgs) { bgs = sc; bg = gI; }
        }
        int e0 = -1, e1 = -1; float s0 = -INFINITY, s1 = -INFINITY;
        for (int j = 0; j < 4; ++j) {
            const int e = bg * 4 + j; const float v = sl[e];
            if (v > s0) { s1 = s0; e1 = e0; s0 = v; e0 = e; } else if (v > s1) { s1 = v; e1 = e; }
        }
        const float wsum = pr[e0] + pr[e1];
        te[t * 2] = e0; te[t * 2 + 1] = e1;
        tw[t * 2] = pr[e0] / wsum; tw[t * 2 + 1] = pr[e1] / wsum;
    }
}
__global__ __launch_bounds__(1024) void moe_lists(const int* __restrict__ te, int* __restrict__ off, int* __restrict__ list, int* __restrict__ slotpos) {
    __shared__ int cnt[16];
    __shared__ int offs[17];
    const int e = threadIdx.x >> 6, lane = threadIdx.x & 63;
    int c = 0;
    for (int base = 0; base < NTOK; base += 64) {
        const int tok = base + lane;
        const bool m = (te[tok * 2] == e) || (te[tok * 2 + 1] == e);
        c += __popcll(__ballot(m));
    }
    if (lane == 0) cnt[e] = c;
    __syncthreads();
    if (threadIdx.x == 0) {
        int s = 0;
        for (int i = 0; i < 16; ++i) { offs[i] = s; off[i] = s; s += cnt[i]; }
        offs[16] = s; off[16] = s;
    }
    __syncthreads();
    int pos = offs[e];
    for (int base = 0; base < NTOK; base += 64) {
        const int tok = base + lane;
        const int a = te[tok * 2], b = te[tok * 2 + 1];
        const bool m = (a == e) || (b == e);
        const unsigned long long mask = __ballot(m);
        if (m) {
            const int p = pos + __popcll(mask & ((1ull << lane) - 1ull));
            list[p] = tok;
            slotpos[tok * 2 + (a == e ? 0 : 1)] = p;
        }
        pos += __popcll(mask);
    }
}
__global__ __launch_bounds__(256) void moe_combine_ln(const float* x, const float* __restrict__ Dp, const int* __restrict__ te,
                                                      const float* __restrict__ tw, const int* __restrict__ slotpos,
                                                      const float* __restrict__ g, const float* __restrict__ bt, float* out) {
    __shared__ float red[4];
    const size_t t = blockIdx.x; const int tid = threadIdx.x;
    int ea = te[t * 2], eb = te[t * 2 + 1];
    float wa = tw[t * 2], wb = tw[t * 2 + 1];
    size_t pa = slotpos[t * 2], pb = slotpos[t * 2 + 1];
    if (eb < ea) { const float tf = wa; wa = wb; wb = tf; const size_t tp = pa; pa = pb; pb = tp; }
    float v[4];
#pragma unroll
    for (int i = 0; i < 4; ++i) {
        const int c = tid + i * 256;
        float y = wa * Dp[pa * DM + c];
        y = y + wb * Dp[pb * DM + c];
        v[i] = ALPHA * x[t * DM + c] + y;
    }
    const float mean = block_sum256(v[0] + v[1] + v[2] + v[3], red) * (1.f / DM);
    float q = 0.f;
#pragma unroll
    for (int i = 0; i < 4; ++i) { v[i] -= mean; q += v[i] * v[i]; }
    const float var = block_sum256(q, red) * (1.f / DM);
    const float rstd = rsqrtf(var + 1e-5f);
#pragma unroll
    for (int i = 0; i < 4; ++i) {
        const int c = tid + i * 256;
        out[t * DM + c] = v[i] * rstd * g[c] + bt[c];
    }
}

static void gemm(hipStream_t st, const float* A, long lda, const float* B, long sbk, long sbn, float* C, long ldc, int M, int N, int K,
                 int Z0 = 1, int Z1 = 1, long sAz0 = 0, long sAz1 = 0, long sBz0 = 0, long sBz1 = 0, long sCz0 = 0, long sCz1 = 0,
                 const int* rowidx = nullptr, const int* zoff = nullptr, int epi = 0, int maxM = -1) {
    GemmArgs g; memset(&g, 0, sizeof(g));
    g.A = A; g.B = B; g.C = C; g.rowidx = rowidx; g.zoff = zoff;
    g.lda = lda; g.sbk = sbk; g.sbn = sbn; g.ldc = ldc;
    g.sAz0 = sAz0; g.sAz1 = sAz1; g.sBz0 = sBz0; g.sBz1 = sBz1; g.sCz0 = sCz0; g.sCz1 = sCz1;
    g.M = M; g.N = N; g.K = K; g.Z1 = Z1; g.epi = epi;
    const int mm = maxM > 0 ? maxM : M;
    dim3 grid((N + 63) / 64, (mm + 63) / 64, Z0 * Z1);
    hipLaunchKernelGGL(gemm_f32, grid, dim3(256), 0, st, g);
}

extern "C" void kernel_launch(void* const* d_in, const int* in_sizes, int n_in, void* d_out, int out_size, void* d_ws, size_t ws_size,
                              hipStream_t stream) {
    auto F = [&](int i) { return (const float*)d_in[i]; };
    const float *x_in = F(0), *mem = F(1), *ln_in_g = F(2), *ln_in_b = F(3), *w_in = F(4), *w_out = F(5), *conv_w = F(6), *conv_b = F(7),
                *conv_gn_g = F(8), *conv_gn_b = F(9), *rwkv_mu = F(10), *rwkv_w0 = F(11), *rwkv_w_up = F(12), *rwkv_a0 = F(13),
                *rwkv_a_up = F(14), *rwkv_g_up = F(15), *rwkv_k_k = F(16), *rwkv_k_a = F(17), *rwkv_r_k = F(18), *rwkv_gn_g = F(19),
                *rwkv_gn_b = F(20), *rwkv_v_down = F(21), *rwkv_v_mu = F(22), *rwkv_v0 = F(23), *rwkv_v_up = F(24), *gmlp_ln_g = F(25),
                *gmlp_ln_b = F(26), *gmlp_w_s = F(27), *gmlp_b_s = F(28), *nsa_pe_k = F(29), *nsa_w1_k = F(30), *nsa_w2_k = F(31),
                *nsa_pe_v = F(32), *nsa_w1_v = F(33), *nsa_w2_v = F(34), *ln1_g = F(35), *ln1_b = F(36), *xa_wq = F(37), *xa_wk = F(38),
                *xa_wv = F(39), *xa_wo = F(40), *ln2_g = F(41), *ln2_b = F(42), *router_w = F(43), *router_bias = F(44),
                *moe_w_gate = F(45), *moe_w_up = F(46), *moe_w_down = F(47), *ln3_g = F(48), *ln3_b = F(49);
    float* X = (float*)d_out;
    float* ws = (float*)d_ws;
    size_t o = 0;
    auto take = [&](size_t n) { float* p = ws + o; o += (n + 63) & ~(size_t)63; return p; };
    float* VFIRST = take((size_t)NTOK * 256);
    float* MIX = take((size_t)NTOK * DM);
    float* KMEM = take((size_t)NB * MEML * DM);
    float* VMEM = take((size_t)NB * MEML * DM);
    int* TE = (int*)take((size_t)NTOK * 2);
    float* TW = take((size_t)NTOK * 2);
    int* SLOT = (int*)take((size_t)NTOK * 2);
    int* LIST = (int*)take((size_t)NTOK * 2);
    int* EOFF = (int*)take(64);
    float* R0 = take((size_t)51 * 1024 * 1024);
    if (o * sizeof(float) > ws_size) return;
    float* COLS = R0;
    float* T0 = R0 + (size_t)SEQ * DIN;
    const size_t TB = (size_t)SEQ * 256;
    float *HCONV = T0, *UB = T0, *VB = T0 + TB;
    float *rR = T0, *rW = T0 + TB, *rK = T0 + 2 * TB, *rV = T0 + 3 * TB, *rA = T0 + 4 * TB, *rB = T0 + 5 * TB, *rG = T0 + 6 * TB,
          *rBON = T0 + 7 * TB, *rVD = T0 + 8 * TB;
    float *QROT = T0, *KSR = T0 + TB, *KWR = KSR + (size_t)SEQ * 64, *GATES = KWR + (size_t)SEQ * 64, *BLK = GATES + (size_t)SEQ * 12 + 16,
          *BLV = BLK + (size_t)NCMP * 2048, *HIDK = BLV + (size_t)NCMP * 2048, *HIDV = HIDK + (size_t)NCMP * 256,
          *KCMP = HIDV + (size_t)NCMP * 256, *VCMP = KCMP + (size_t)NCMP * 64;
    float* Y = R0;
    float* SC = R0 + (size_t)NTOK * DM;
    float* Qb = Y;
    float* H = R0;
    float* Dp = R0 + (size_t)2 * NTOK * 512;

    hipLaunchKernelGGL(ln_kernel, dim3(NTOK), dim3(256), 0, stream, x_in, 1.0f, (const float*)nullptr, ln_in_g, ln_in_b, X);
    for (int l = 0; l < 2; ++l) {
        gemm(stream, mem, DM, xa_wk + (size_t)l * DM * DM, DM, 1, KMEM, DM, NB * MEML, DM, DM);
        gemm(stream, mem, DM, xa_wv + (size_t)l * DM * DM, DM, 1, VMEM, DM, NB * MEML, DM, DM);
        for (int b = 0; b < NB; ++b) {
            const float* Xb = X + (size_t)b * SEQ * DM;
            float* MIXb = MIX + (size_t)b * SEQ * DM;
            float* VFb = VFIRST + (size_t)b * SEQ * 256;
            gemm(stream, Xb, DM, w_in + (size_t)l * DM * DIN, DIN, 1, COLS, DIN, SEQ, DIN, DM);
            hipLaunchKernelGGL(glu_kernel, dim3(SEQ), dim3(256), 0, stream, COLS, HCONV);
            hipLaunchKernelGGL(conv_kernel, dim3(SEQ), dim3(256), 0, stream, HCONV, conv_w + (size_t)l * 31 * 256, conv_b + l * 256,
                               conv_gn_g + l * 256, conv_gn_b + l * 256, MIXb);
            hipLaunchKernelGGL(gmlp_pre, dim3(SEQ), dim3(256), 0, stream, COLS, gmlp_ln_g + l * 256, gmlp_ln_b + l * 256, UB, VB);
            hipLaunchKernelGGL(gmlp_mix, dim3(SEQ), dim3(256), 0, stream, UB, VB, gmlp_w_s + (size_t)l * 4 * 128 * 128, gmlp_b_s + l * 4 * 128, MIXb);
            if (l > 0) gemm(stream, Xb, DM, rwkv_v_down, 32, 1, rVD, 32, SEQ, 32, DM);
            RwkvP rp; memset(&rp, 0, sizeof(rp));
            rp.cols = COLS; rp.mu = rwkv_mu + l * 1024; rp.w0 = rwkv_w0 + l * 256; rp.w_up = rwkv_w_up + (size_t)l * 64 * 256;
            rp.a0 = rwkv_a0 + l * 256; rp.a_up = rwkv_a_up + (size_t)l * 64 * 256; rp.g_up = rwkv_g_up + (size_t)l * 128 * 256;
            rp.k_k = rwkv_k_k + l * 256; rp.k_a = rwkv_k_a + l * 256; rp.r_k = rwkv_r_k + l * 256;
            rp.vd = rVD; rp.v_mu = rwkv_v_mu; rp.v0 = rwkv_v0; rp.v_up = rwkv_v_up;
            rp.vfirst = VFb; rp.R = rR; rp.W = rW; rp.K = rK; rp.V = rV; rp.A = rA; rp.Bv = rB; rp.G = rG; rp.BON = rBON; rp.layer = l;
            hipLaunchKernelGGL(rwkv_prep, dim3(SEQ), dim3(256), 0, stream, rp);
            hipLaunchKernelGGL(rwkv_scan, dim3(4), dim3(64), 0, stream, rR, rW, rK, rV, rA, rB);
            hipLaunchKernelGGL(rwkv_post, dim3(SEQ), dim3(256), 0, stream, rR, rBON, rG, rwkv_gn_g + l * 256, rwkv_gn_b + l * 256, MIXb);
            hipLaunchKernelGGL(nsa_prep, dim3(SEQ), dim3(256), 0, stream, COLS, QROT, KSR, KWR, GATES);
            hipLaunchKernelGGL(cmp_gather, dim3(NCMP), dim3(256), 0, stream, COLS, nsa_pe_k + (size_t)l * 2048, nsa_pe_v + (size_t)l * 2048, BLK, BLV);
            gemm(stream, BLK, 2048, nsa_w1_k + (size_t)l * 2048 * 256, 256, 1, HIDK, 256, NCMP, 256, 2048);
            gemm(stream, BLV, 2048, nsa_w1_v + (size_t)l * 2048 * 256, 256, 1, HIDV, 256, NCMP, 256, 2048);
            hipLaunchKernelGGL(gelu_inplace, dim3((2 * NCMP * 256 + 255) / 256), dim3(256), 0, stream, HIDK, 2 * NCMP * 256);
            gemm(stream, HIDK, 256, nsa_w2_k + (size_t)l * 256 * 64, 64, 1, KCMP, 64, NCMP, 64, 256);
            gemm(stream, HIDV, 256, nsa_w2_v + (size_t)l * 256 * 64, 64, 1, VCMP, 64, NCMP, 64, 256);
            hipLaunchKernelGGL(nsa_attn, dim3(SEQ), dim3(256), 0, stream, COLS, QROT, KSR, KWR, GATES, KCMP, VCMP, MIXb);
        }
        gemm(stream, MIX, DM, w_out + (size_t)l * DM * DM, DM, 1, Y, DM, NTOK, DM, DM);
        hipLaunchKernelGGL(ln_kernel, dim3(NTOK), dim3(256), 0, stream, X, ALPHA, Y, ln1_g + l * DM, ln1_b + l * DM, X);
        gemm(stream, X, DM, xa_wq + (size_t)l * DM * DM, DM, 1, Qb, DM, NTOK, DM, DM);
        gemm(stream, Qb, DM, KMEM, 1, DM, SC, 256, SEQ, 256, 256, NB, 4, (long)SEQ * DM, 256, (long)MEML * DM, 256, (long)4 * SEQ * 256, (long)SEQ * 256);
        hipLaunchKernelGGL(softmax256, dim3(NB * 4 * SEQ), dim3(256), 0, stream, SC, 0.0625f);
        gemm(stream, SC, 256, VMEM, DM, 1, MIX, DM, SEQ, 256, 256, NB, 4, (long)4 * SEQ * 256, (long)SEQ * 256, (long)MEML * DM, 256, (long)SEQ * DM, 256);
        gemm(stream, MIX, DM, xa_wo + (size_t)l * DM * DM, DM, 1, Y, DM, NTOK, DM, DM);
        hipLaunchKernelGGL(ln_kernel, dim3(NTOK), dim3(256), 0, stream, X, ALPHA, Y, ln2_g + l * DM, ln2_b + l * DM, X);
        hipLaunchKernelGGL(router_kernel, dim3(NTOK), dim3(256), 0, stream, X, router_w, router_bias, TE, TW);
        hipLaunchKernelGGL(moe_lists, dim3(1), dim3(1024), 0, stream, TE, EOFF, LIST, SLOT);
        const float* wg = moe_w_gate + (size_t)l * 16 * DM * 512;
        const float* wu = moe_w_up + (size_t)l * 16 * DM * 512;
        const float* wd = moe_w_down + (size_t)l * 16 * 512 * DM;
        gemm(stream, X, DM, wu, 512, 1, H, 512, 0, 512, DM, 16, 1, 0, 0, (long)DM * 512, 0, 0, 0, LIST, EOFF, 0, 2 * NTOK);
        gemm(stream, X, DM, wg, 512, 1, H, 512, 0, 512, DM, 16, 1, 0, 0, (long)DM * 512, 0, 0, 0, LIST, EOFF, 1, 2 * NTOK);
        gemm(stream, H, 512, wd, DM, 1, Dp, DM, 0, DM, 512, 16, 1, 0, 0, (long)512 * DM, 0, 0, 0, nullptr, EOFF, 0, 2 * NTOK);
        hipLaunchKernelGGL(moe_combine_ln, dim3(NTOK), dim3(256), 0, stream, X, Dp, TE, TW, SLOT, ln3_g + l * DM, ln3_b + l * DM, X);
    }
}
```

```cpp
#include <hip/hip_runtime.h>
#include <hip/hip_cooperative_groups.h>
#include <stdio.h>
namespace cg = cooperative_groups;
#include <stdint.h>
#include <string.h>
#include <math.h>

#define DEVI __device__ __forceinline__
DEVI int tidx() { int t = threadIdx.x; asm volatile("" : "+v"(t)); return t; }

constexpr int NB = 2, SEQ = 8192, DM = 1024, NTOK = NB * SEQ, DIN = 2700, MEML = 256;
constexpr int OFF_CV = 0, OFF_CG = 256, OFF_RW = 512, OFF_GU = 1536, OFF_GV = 1792, OFF_Q = 2048, OFF_KC = 2304,
              OFF_VC = 2368, OFF_KS = 2432, OFF_VS = 2496, OFF_KW = 2560, OFF_VW = 2624, OFF_GT = 2688;
constexpr int NCMP = 511;
constexpr float ALPHA = 1.4142135623730951f;

DEVI float wave_sum(float v) {
#pragma unroll
    for (int o = 32; o > 0; o >>= 1) v += __shfl_xor(v, o, 64);
    return v;
}
DEVI float wave_max(float v) {
#pragma unroll
    for (int o = 32; o > 0; o >>= 1) v = fmaxf(v, __shfl_xor(v, o, 64));
    return v;
}
DEVI float sigm(float x) { return 1.f / (1.f + expf(-x)); }
DEVI float gelu_t(float x) { return 0.5f * x * (1.f + tanhf(0.7978845608028654f * (x + 0.044715f * x * x * x))); }
DEVI float softplus_(float x) { return fmaxf(x, 0.f) + log1pf(expf(-fabsf(x))); }

DEVI float block_sum256(float v, float* red) {
    v = wave_sum(v);
    __syncthreads();
    if ((tidx() & 63) == 0) red[tidx() >> 6] = v;
    __syncthreads();
    return red[0] + red[1] + red[2] + red[3];
}

__device__ __forceinline__ void ln_kernel(const float* xres, float alpha, const float* add, const float* __restrict__ g,
                                                 const float* __restrict__ bt, float* out, int bid) {
    __syncthreads();
    __shared__ float red[4];
    const size_t row = bid;
    const int tid = tidx();
    float v[4];
#pragma unroll
    for (int i = 0; i < 4; ++i) {
        const size_t idx = row * DM + tid + i * 256;
        v[i] = alpha * xres[idx] + (add ? add[idx] : 0.f);
    }
    const float mean = block_sum256(v[0] + v[1] + v[2] + v[3], red) * (1.f / DM);
    float q = 0.f;
#pragma unroll
    for (int i = 0; i < 4; ++i) { v[i] -= mean; q += v[i] * v[i]; }
    const float var = block_sum256(q, red) * (1.f / DM);
    const float rstd = rsqrtf(var + 1e-5f);
#pragma unroll
    for (int i = 0; i < 4; ++i) {
        const int c = tid + i * 256;
        out[row * DM + c] = v[i] * rstd * g[c] + bt[c];
    }
}

struct GemmArgs {
    const float* A; const float* B; float* C; const int* rowidx; const int* zoff;
    long lda, sbk, sbn, ldc, sAz0, sAz1, sBz0, sBz1, sCz0, sCz1;
    int M, N, K, Z1, epi, pad;
};
__device__ __forceinline__ void gemm_f32(const GemmArgs& g, int bx, int by, int z) {
    __shared__ float As[16][68];
    __shared__ float Bs[16][68];
    const int z0 = z / g.Z1, z1 = z % g.Z1;
    int mbeg = 0, mend = g.M;
    if (g.zoff) { mbeg = g.zoff[z]; mend = g.zoff[z + 1]; }
    const int m0 = mbeg + by * 64;
    if (m0 >= mend) return;
    const int n0 = bx * 64;
    const float* A = g.A + z0 * g.sAz0 + z1 * g.sAz1;
    const float* B = g.B + z0 * g.sBz0 + z1 * g.sBz1;
    float* C = g.C + z0 * g.sCz0 + z1 * g.sCz1;
    const int tid = tidx(), tx = tid & 15, ty = tid >> 4;
    float acc[4][4];
#pragma unroll
    for (int i = 0; i < 4; ++i)
#pragma unroll
        for (int j = 0; j < 4; ++j) acc[i][j] = 0.f;
    long arow[4];
#pragma unroll
    for (int i = 0; i < 4; ++i) {
        const int r = (tid + i * 256) >> 4;
        const int row = m0 + r;
        if (row < mend) arow[i] = (long)(g.rowidx ? g.rowidx[row] : row) * g.lda; else arow[i] = -1;
    }
    for (int k0 = 0; k0 < g.K; k0 += 16) {
#pragma unroll
        for (int i = 0; i < 4; ++i) {
            const int e = tid + i * 256, r = e >> 4, kk = e & 15;
            float v = 0.f;
            if (arow[i] >= 0 && k0 + kk < g.K) v = A[arow[i] + k0 + kk];
            As[kk][r] = v;
        }
#pragma unroll
        for (int i = 0; i < 4; ++i) {
            const int e = tid + i * 256, kk = e >> 6, n = e & 63;
            float v = 0.f;
            if (n0 + n < g.N && k0 + kk < g.K) v = B[(long)(k0 + kk) * g.sbk + (long)(n0 + n) * g.sbn];
            Bs[kk][n] = v;
        }
        __syncthreads();
#pragma unroll
        for (int kk = 0; kk < 16; ++kk) {
            float a[4], b[4];
#pragma unroll
            for (int i = 0; i < 4; ++i) a[i] = As[kk][ty * 4 + i];
#pragma unroll
            for (int j = 0; j < 4; ++j) b[j] = Bs[kk][tx * 4 + j];
#pragma unroll
            for (int i = 0; i < 4; ++i)
#pragma unroll
                for (int j = 0; j < 4; ++j) acc[i][j] = fmaf(a[i], b[j], acc[i][j]);
        }
        __syncthreads();
    }
#pragma unroll
    for (int i = 0; i < 4; ++i) {
        const int row = m0 + ty * 4 + i;
        if (row >= mend) continue;
#pragma unroll
        for (int j = 0; j < 4; ++j) {
            const int col = n0 + tx * 4 + j;
            if (col >= g.N) continue;
            float* p = C + (long)row * g.ldc + col;
            float v = acc[i][j];
            if (g.epi == 1) { v = v * sigm(v) * (*p); }
            *p = v;
        }
    }
}

__device__ __forceinline__ void glu_kernel(const float* __restrict__ cols, float* __restrict__ h, int bid) {
    __syncthreads();
    const size_t t = bid; const int c = tidx();
    h[t * 256 + c] = cols[t * DIN + OFF_CV + c] * sigm(cols[t * DIN + OFF_CG + c]);
}
__device__ __forceinline__ void conv_kernel(const float* __restrict__ h, const float* __restrict__ w, const float* __restrict__ bias,
                                                   const float* __restrict__ gg, const float* __restrict__ gb, float* __restrict__ mix, int bid) {
    __syncthreads();
    const int t = bid, c = tidx();
    float acc = bias[c];
#pragma unroll 4
    for (int j = 0; j < 31; ++j) {
        const int tt = t - 30 + j;
        if (tt >= 0) acc = fmaf(h[(size_t)tt * 256 + c], w[j * 256 + c], acc);
    }
    const float mean = wave_sum(acc) * (1.f / 64.f);
    const float d = acc - mean;
    const float var = wave_sum(d * d) * (1.f / 64.f);
    const float y = d * rsqrtf(var + 1e-5f) * gg[c] + gb[c];
    mix[(size_t)t * DM + 0 + c] = y * sigm(y);
}

__device__ __forceinline__ void gmlp_pre(const float* __restrict__ cols, const float* __restrict__ lg, const float* __restrict__ lb,
                                                float* __restrict__ ub, float* __restrict__ vb, int bid) {
    __syncthreads();
    __shared__ float red[4];
    const size_t t = bid; const int c = tidx();
    ub[t * 256 + c] = gelu_t(cols[t * DIN + OFF_GU + c]);
    const float v = gelu_t(cols[t * DIN + OFF_GV + c]);
    const float mean = block_sum256(v, red) * (1.f / 256.f);
    const float d = v - mean;
    const float var = block_sum256(d * d, red) * (1.f / 256.f);
    vb[t * 256 + c] = d * rsqrtf(var + 1e-5f) * lg[c] + lb[c];
}
__device__ __forceinline__ void gmlp_mix(const float* __restrict__ ub, const float* __restrict__ vb, const float* __restrict__ ws,
                                                const float* __restrict__ bs, float* __restrict__ mix, int bid) {
    __syncthreads();
    const int t = bid, c = tidx(), h = c >> 6, tt = t & 127, base = t - tt;
    float acc = bs[h * 128 + tt];
    const float* wr = ws + ((size_t)h * 128 + tt) * 128;
#pragma unroll 4
    for (int s = 0; s <= tt; ++s) acc = fmaf(wr[s], vb[(size_t)(base + s) * 256 + c], acc);
    mix[(size_t)t * DM + 512 + c] = ub[(size_t)t * 256 + c] * acc;
}

struct RwkvP {
    const float* cols; const float* mu; const float* w0; const float* w_up; const float* a0; const float* a_up; const float* g_up;
    const float* k_k; const float* k_a; const float* r_k; const float* vd; const float* v_mu; const float* v0; const float* v_up;
    float* vfirst; float* R; float* W; float* K; float* V; float* A; float* Bv; float* G; float* BON;
    int layer, pad;
};
__device__ __forceinline__ void rwkv_prep(RwkvP p, int bid) {
    __syncthreads();
    __shared__ float y[1024];
    __shared__ float vds[32];
    const int t = bid, c = tidx();
#pragma unroll
    for (int q = 0; q < 4; ++q) {
        const int j = c + q * 256;
        const float cur = p.cols[(size_t)t * DIN + OFF_RW + j];
        const float prv = t > 0 ? p.cols[(size_t)(t - 1) * DIN + OFF_RW + j] : 0.f;
        y[j] = cur + p.mu[j] * (prv - cur);
    }
    if (p.layer > 0 && c < 32) {
        const float cur = p.vd[(size_t)t * 32 + c];
        const float prv = t > 0 ? p.vd[(size_t)(t - 1) * 32 + c] : 0.f;
        vds[c] = cur + p.v_mu[c] * (prv - cur);
    }
    __syncthreads();
    float tw = 0.f, sg = 0.f;
    if (c < 64) tw = tanhf(y[768 + c]);
    if (c >= 128) sg = sigm(y[896 + (c - 128)]);
    __syncthreads();
    if (c < 64) y[768 + c] = tw;
    if (c >= 128) y[896 + (c - 128)] = sg;
    __syncthreads();
    const float r = y[c], k = y[256 + c];
    float v = y[512 + c];
    float wl = p.w0[c], al = p.a0[c], gl = 0.f;
#pragma unroll 4
    for (int j = 0; j < 64; ++j) { wl = fmaf(y[768 + j], p.w_up[j * 256 + c], wl); al = fmaf(y[832 + j], p.a_up[j * 256 + c], al); }
#pragma unroll 4
    for (int j = 0; j < 128; ++j) gl = fmaf(y[896 + j], p.g_up[j * 256 + c], gl);
    const float wlog = -softplus_(-wl) - 0.5f;
    const float decay = expf(-expf(wlog));
    const float a = sigm(al);
    if (p.layer == 0) {
        p.vfirst[(size_t)t * 256 + c] = v;
    } else {
        float vm = p.v0[c];
#pragma unroll 4
        for (int j = 0; j < 32; ++j) vm = fmaf(vds[j], p.v_up[j * 256 + c], vm);
        vm = sigm(vm);
        v = v + (p.vfirst[(size_t)t * 256 + c] - v) * vm;
    }
    float kk = k * p.k_k[c];
    const float nrm = sqrtf(wave_sum(kk * kk));
    kk = kk / fmaxf(nrm, 1e-12f);
    const float k2 = k * (1.f + (a - 1.f) * p.k_a[c]);
    const float bd = wave_sum(r * k2 * p.r_k[c]);
    const size_t o = (size_t)t * 256 + c;
    p.R[o] = r; p.W[o] = decay; p.K[o] = k2; p.V[o] = v; p.A[o] = -kk; p.Bv[o] = kk * a; p.G[o] = gl; p.BON[o] = bd * v;
}
__device__ __forceinline__ void rwkv_scan(float* R, const float* __restrict__ W, const float* __restrict__ K, const float* __restrict__ V,
                          const float* __restrict__ A, const float* __restrict__ Bv) {
    __shared__ float sr[4][256], sw[4][256], sk[4][256], sa[4][256], sb[4][256], sv[4][256];
    const int tid = tidx(), h = tid >> 6, lane = tid & 63;
    float st[64];
#pragma unroll
    for (int i = 0; i < 64; ++i) st[i] = 0.f;
    for (int t0 = 0; t0 < SEQ; t0 += 4) {
        __syncthreads();
#pragma unroll
        for (int s = 0; s < 4; ++s) {
            const size_t idx = (size_t)(t0 + s) * 256 + tid;
            sr[s][tid] = R[idx]; sw[s][tid] = W[idx]; sk[s][tid] = K[idx]; sa[s][tid] = A[idx]; sb[s][tid] = Bv[idx]; sv[s][tid] = V[idx];
        }
        __syncthreads();
#pragma unroll 1
        for (int s = 0; s < 4; ++s) {
            const float vt = sv[s][tid];
            const float* pa = &sa[s][h * 64]; const float* pw = &sw[s][h * 64]; const float* pb = &sb[s][h * 64];
            const float* pk = &sk[s][h * 64]; const float* pr = &sr[s][h * 64];
            float sa_ = 0.f;
#pragma unroll
            for (int k = 0; k < 64; ++k) sa_ = fmaf(st[k], pa[k], sa_);
#pragma unroll
            for (int k = 0; k < 64; ++k) st[k] = fmaf(st[k], pw[k], fmaf(sa_, pb[k], vt * pk[k]));
            float o = 0.f;
#pragma unroll
            for (int k = 0; k < 64; ++k) o = fmaf(st[k], pr[k], o);
            R[(size_t)(t0 + s) * 256 + h * 64 + lane] = o;
        }
    }
    __syncthreads();
}
__device__ __forceinline__ void rwkv_post(const float* __restrict__ O, const float* __restrict__ BON, const float* __restrict__ G,
                                                 const float* __restrict__ gg, const float* __restrict__ gb, float* __restrict__ mix, int bid) {
    __syncthreads();
    const size_t t = bid; const int c = tidx();
    const float o = O[t * 256 + c];
    const float mean = wave_sum(o) * (1.f / 64.f);
    const float d = o - mean;
    const float var = wave_sum(d * d) * (1.f / 64.f);
    const float y = d * rsqrtf(var + 64e-5f) * gg[c] + gb[c];
    mix[t * DM + 256 + c] = (y + BON[t * 256 + c]) * G[t * 256 + c];
}

__device__ __forceinline__ void nsa_prep(const float* __restrict__ cols, float* __restrict__ qrot, float* __restrict__ ksr,
                                                float* __restrict__ kwr, float* __restrict__ gates, int bid) {
    __syncthreads();
    const int t = bid, c = tidx();
    const int d = c & 63, j = d & 31;
    const float inv = powf(10000.f, -(float)j / 32.f);
    const float ang = (float)t * inv;
    float sn, cs; sincosf(ang, &sn, &cs);
    {
        const float* q = cols + (size_t)t * DIN + OFF_Q + (c & ~63);
        const float x1 = q[j], x2 = q[j + 32];
        qrot[(size_t)t * 256 + c] = d < 32 ? x1 * cs - x2 * sn : x2 * cs + x1 * sn;
    }
    if (c < 128) {
        const float* kp = cols + (size_t)t * DIN + (c < 64 ? OFF_KS : OFF_KW);
        const float x1 = kp[j], x2 = kp[j + 32];
        const float v = d < 32 ? x1 * cs - x2 * sn : x2 * cs + x1 * sn;
        if (c < 64) ksr[(size_t)t * 64 + d] = v; else kwr[(size_t)t * 64 + d] = v;
    }
    if (c < 12) gates[(size_t)t * 12 + c] = sigm(cols[(size_t)t * DIN + OFF_GT + c]);
}
__device__ __forceinline__ void cmp_gather(const float* __restrict__ cols, const float* __restrict__ pek, const float* __restrict__ pev,
                                                  float* __restrict__ bk, float* __restrict__ bv, int bid) {
    __syncthreads();
    const int n = bid, tid = tidx();
    for (int i = tid; i < 2048; i += 256) {
        const int l = i >> 6, d = i & 63;
        const size_t row = (size_t)(16 * n + l) * DIN;
        bk[(size_t)n * 2048 + i] = cols[row + OFF_KC + d] + pek[i];
        bv[(size_t)n * 2048 + i] = cols[row + OFF_VC + d] + pev[i];
    }
}
__device__ __forceinline__ void gelu_inplace(float* p, int n, int bid) {
    const int i = bid * 256 + tidx();
    if (i < n) p[i] = gelu_t(p[i]);
}

DEVI void wave_softmax(float* s, int n, int lane) {
    float m = -INFINITY;
    for (int i = lane; i < n; i += 64) m = fmaxf(m, s[i]);
    m = wave_max(m);
    if (m == -INFINITY) { for (int i = lane; i < n; i += 64) s[i] = 0.f; return; }
    float sum = 0.f;
    for (int i = lane; i < n; i += 64) { const float p = expf(s[i] - m); s[i] = p; sum += p; }
    sum = wave_sum(sum);
    const float inv = 1.f / fmaxf(sum, 1e-20f);
    for (int i = lane; i < n; i += 64) s[i] *= inv;
}
DEVI void dot4(const float* q  , const float* __restrict__ krow, float* out4) {
    float a0 = 0.f, a1 = 0.f, a2 = 0.f, a3 = 0.f;
#pragma unroll
    for (int d = 0; d < 64; d += 4) {
        const float4 kv = *(const float4*)(krow + d);
        a0 += q[d] * kv.x + q[d + 1] * kv.y + q[d + 2] * kv.z + q[d + 3] * kv.w;
        a1 += q[64 + d] * kv.x + q[64 + d + 1] * kv.y + q[64 + d + 2] * kv.z + q[64 + d + 3] * kv.w;
        a2 += q[128 + d] * kv.x + q[128 + d + 1] * kv.y + q[128 + d + 2] * kv.z + q[128 + d + 3] * kv.w;
        a3 += q[192 + d] * kv.x + q[192 + d + 1] * kv.y + q[192 + d + 2] * kv.z + q[192 + d + 3] * kv.w;
    }
    out4[0] = a0; out4[1] = a1; out4[2] = a2; out4[3] = a3;
}
__device__ __forceinline__ void nsa_attn(const float* __restrict__ cols, const float* __restrict__ qrot, const float* __restrict__ ksr,
                                                const float* __restrict__ kwr, const float* __restrict__ gates, const float* __restrict__ kcmp,
                                                const float* __restrict__ vcmp, float* __restrict__ mix, int bid) {
    __syncthreads();
    __shared__ float q[256], qr[256];
    __shared__ float sc[4][1024];
    __shared__ float imp[128];
    __shared__ int sel[16];
    const int pos = bid, tid = tidx(), h = tid >> 6, lane = tid & 63;
    q[tid] = cols[(size_t)pos * DIN + OFF_Q + tid];
    qr[tid] = qrot[(size_t)pos * 256 + tid];
    __syncthreads();
    int ncv = pos >= 31 ? (pos - 31) / 16 + 1 : 0;
    if (ncv > NCMP) ncv = NCMP;
    for (int n = tid; n < 512; n += 256) {
        if (n < ncv) {
            float d4[4]; dot4(q, kcmp + (size_t)n * 64, d4);
            sc[0][n] = d4[0] * 0.125f; sc[1][n] = d4[1] * 0.125f; sc[2][n] = d4[2] * 0.125f; sc[3][n] = d4[3] * 0.125f;
        } else { sc[0][n] = 0.f; sc[1][n] = 0.f; sc[2][n] = 0.f; sc[3][n] = 0.f; }
    }
    __syncthreads();
    wave_softmax(sc[h], ncv, lane);
    __syncthreads();
    float oc = 0.f;
#pragma unroll 4
    for (int n = 0; n < ncv; ++n) oc = fmaf(sc[h][n], vcmp[(size_t)n * 64 + lane], oc);
    if (tid < 128) {
        const int j = tid;
        auto ps = [&](int n) -> float { return (n >= 0 && n < 512) ? (sc[0][n] + sc[1][n] + sc[2][n] + sc[3][n]) : 0.f; };
        const float v = 0.5f * ps(4 * j - 1) + ps(4 * j) + ps(4 * j + 1) + ps(4 * j + 2) + 0.5f * ps(4 * j + 3);
        const int cur = pos >> 6;
        float key;
        if (j == cur || j == 0) key = INFINITY; else if (j <= cur) key = v; else key = -1.f;
        imp[j] = key;
    }
    __syncthreads();
    if (h == 0) {
        float v0 = imp[lane], v1 = imp[lane + 64];
        for (int r = 0; r < 16; ++r) {
            float bv; int bi;
            if (v1 > v0) { bv = v1; bi = lane + 64; } else { bv = v0; bi = lane; }
#pragma unroll
            for (int o = 32; o > 0; o >>= 1) {
                const float ov = __shfl_xor(bv, o, 64); const int oi = __shfl_xor(bi, o, 64);
                if (ov > bv || (ov == bv && oi < bi)) { bv = ov; bi = oi; }
            }
            if (lane == 0) sel[r] = bi;
            if (bi == lane) v0 = -2.f;
            if (bi == lane + 64) v1 = -2.f;
        }
    }
    __syncthreads();
    for (int i = tid; i < 1024; i += 256) {
        const int kp = sel[i >> 6] * 64 + (i & 63);
        if (kp <= pos) {
            float d4[4]; dot4(qr, ksr + (size_t)kp * 64, d4);
            sc[0][i] = d4[0] * 0.125f; sc[1][i] = d4[1] * 0.125f; sc[2][i] = d4[2] * 0.125f; sc[3][i] = d4[3] * 0.125f;
        } else { sc[0][i] = -INFINITY; sc[1][i] = -INFINITY; sc[2][i] = -INFINITY; sc[3][i] = -INFINITY; }
    }
    __syncthreads();
    wave_softmax(sc[h], 1024, lane);
    __syncthreads();
    float os = 0.f;
#pragma unroll 2
    for (int i = 0; i < 1024; ++i) {
        const float p = sc[h][i];
        if (p != 0.f) { const int kp = sel[i >> 6] * 64 + (i & 63); os = fmaf(p, cols[(size_t)kp * DIN + OFF_VS + lane], os); }
    }
    __syncthreads();
    for (int i = tid; i < 512; i += 256) {
        const int kp = pos - 511 + i;
        if (kp >= 0) {
            float d4[4]; dot4(qr, kwr + (size_t)kp * 64, d4);
            sc[0][i] = d4[0] * 0.125f; sc[1][i] = d4[1] * 0.125f; sc[2][i] = d4[2] * 0.125f; sc[3][i] = d4[3] * 0.125f;
        } else { sc[0][i] = -INFINITY; sc[1][i] = -INFINITY; sc[2][i] = -INFINITY; sc[3][i] = -INFINITY; }
    }
    __syncthreads();
    wave_softmax(sc[h], 512, lane);
    __syncthreads();
    float ow = 0.f;
#pragma unroll 4
    for (int i = 0; i < 512; ++i) {
        const int kp = pos - 511 + i;
        if (kp >= 0) ow = fmaf(sc[h][i], cols[(size_t)kp * DIN + OFF_VW + lane], ow);
    }
    const float* gt = gates + (size_t)pos * 12 + h * 3;
    mix[(size_t)pos * DM + 768 + tid] = gt[0] * oc + gt[1] * os + gt[2] * ow;
}

__device__ __forceinline__ void softmax256(float* s, float scale, int bid) {
    __syncthreads();
    __shared__ float red[4];
    const size_t row = bid; const int tid = tidx();
    const float v = s[row * 256 + tid] * scale;
    float m = wave_max(v);
    __syncthreads();
    if ((tid & 63) == 0) red[tid >> 6] = m;
    __syncthreads();
    m = fmaxf(fmaxf(red[0], red[1]), fmaxf(red[2], red[3]));
    const float p = expf(v - m);
    const float sum = block_sum256(p, red);
    s[row * 256 + tid] = p / sum;
}

__device__ __forceinline__ void router_kernel(const float* __restrict__ x, const float* __restrict__ rw, const float* __restrict__ rb,
                                                     int* __restrict__ te, float* __restrict__ tw, int bid) {
    __syncthreads();
    __shared__ float part[4][16];
    const size_t t = bid; const int tid = tidx();
    float acc[16];
#pragma unroll
    for (int e = 0; e < 16; ++e) acc[e] = 0.f;
#pragma unroll 1
    for (int i = tid; i < DM; i += 256) {
        const float xv = x[t * DM + i];
#pragma unroll
        for (int e = 0; e < 16; ++e) acc[e] = fmaf(xv, rw[i * 16 + e], acc[e]);
    }
#pragma unroll
    for (int e = 0; e < 16; ++e) acc[e] = wave_sum(acc[e]);
    if ((tid & 63) == 0) {
#pragma unroll
        for (int e = 0; e < 16; ++e) part[tid >> 6][e] = acc[e];
    }
    __syncthreads();
    if (tid == 0) {
        float lg[16], pr[16], sl[16];
        float m = -INFINITY;
        for (int e = 0; e < 16; ++e) { lg[e] = part[0][e] + part[1][e] + part[2][e] + part[3][e]; m = fmaxf(m, lg[e]); }
        float sum = 0.f;
        for (int e = 0; e < 16; ++e) { pr[e] = expf(lg[e] - m); sum += pr[e]; }
        for (int e = 0; e < 16; ++e) { pr[e] /= sum; sl[e] = pr[e] + rb[e]; }
        int bg = 0; float bgs = -INFINITY;
        for (int gI = 0; gI < 4; ++gI) {
            float m1 = -INFINITY, m2 = -INFINITY;
            for (int j = 0; j < 4; ++j) { const float v = sl[gI * 4 + j]; if (v > m1) { m2 = m1; m1 = v; } else if (v > m2) m2 = v; }
            const float sc = m1 + m2;
            if (sc > bgs) { bgs = sc; bg = gI; }
        }
        int e0 = -1, e1 = -1; float s0 = -INFINITY, s1 = -INFINITY;
        for (int j = 0; j < 4; ++j) {
            const int e = bg * 4 + j; const float v = sl[e];
            if (v > s0) { s1 = s0; e1 = e0; s0 = v; e0 = e; } else if (v > s1) { s1 = v; e1 = e; }
        }
        const float wsum = pr[e0] + pr[e1];
        te[t * 2] = e0; te[t * 2 + 1] = e1;
        tw[t * 2] = pr[e0] / wsum; tw[t * 2 + 1] = pr[e1] / wsum;
    }
}
__device__ __forceinline__ void moe_lists(const int* __restrict__ te, int* __restrict__ off, int* __restrict__ list, int* __restrict__ slotpos) {
    __shared__ int cnt[16];
    __shared__ int offs[17];
    const int w = tidx() >> 6, lane = tidx() & 63;
    __syncthreads();
    for (int ee = 0; ee < 4; ++ee) {
        const int e = w * 4 + ee;
        int c = 0;
        for (int base = 0; base < NTOK; base += 64) {
            const int tok = base + lane;
            const bool m = (te[tok * 2] == e) || (te[tok * 2 + 1] == e);
            c += __popcll(__ballot(m));
        }
        if (lane == 0) cnt[e] = c;
    }
    __syncthreads();
    if (tidx() == 0) {
        int s = 0;
        for (int i = 0; i < 16; ++i) { offs[i] = s; off[i] = s; s += cnt[i]; }
        offs[16] = s; off[16] = s;
    }
    __syncthreads();
    for (int ee = 0; ee < 4; ++ee) {
        const int e = w * 4 + ee;
        int pos = offs[e];
        for (int base = 0; base < NTOK; base += 64) {
            const int tok = base + lane;
            const int a = te[tok * 2], b = te[tok * 2 + 1];
            const bool m = (a == e) || (b == e);
            const unsigned long long mask = __ballot(m);
            if (m) {
                const int p = pos + __popcll(mask & ((1ull << lane) - 1ull));
                list[p] = tok;
                slotpos[tok * 2 + (a == e ? 0 : 1)] = p;
            }
            pos += __popcll(mask);
        }
    }
}
__device__ __forceinline__ void moe_combine_ln(const float* x, const float* __restrict__ Dp, const int* __restrict__ te,
                                                      const float* __restrict__ tw, const int* __restrict__ slotpos,
                                                      const float* __restrict__ g, const float* __restrict__ bt, float* out, int bid) {
    __syncthreads();
    __shared__ float red[4];
    const size_t t = bid; const int tid = tidx();
    int ea = te[t * 2], eb = te[t * 2 + 1];
    float wa = tw[t * 2], wb = tw[t * 2 + 1];
    size_t pa = slotpos[t * 2], pb = slotpos[t * 2 + 1];
    if (eb < ea) { const float tf = wa; wa = wb; wb = tf; const size_t tp = pa; pa = pb; pb = tp; }
    float v[4];
#pragma unroll
    for (int i = 0; i < 4; ++i) {
        const int c = tid + i * 256;
        float y = wa * Dp[pa * DM + c];
        y = y + wb * Dp[pb * DM + c];
        v[i] = ALPHA * x[t * DM + c] + y;
    }
    const float mean = block_sum256(v[0] + v[1] + v[2] + v[3], red) * (1.f / DM);
    float q = 0.f;
#pragma unroll
    for (int i = 0; i < 4; ++i) { v[i] -= mean; q += v[i] * v[i]; }
    const float var = block_sum256(q, red) * (1.f / DM);
    const float rstd = rsqrtf(var + 1e-5f);
#pragma unroll
    for (int i = 0; i < 4; ++i) {
        const int c = tid + i * 256;
        out[t * DM + c] = v[i] * rstd * g[c] + bt[c];
    }
}

struct MP {
    const float* in[50];
    float *X, *VFIRST, *MIX, *KMEM, *VMEM, *TW, *R0;
    int *TE, *SLOT, *LIST, *EOFF;
};

__device__ __forceinline__ GemmArgs mk(const float* A, long lda, const float* B, long sbk, long sbn, float* C, long ldc, int M, int N, int K,
                       int Z1 = 1, long sAz0 = 0, long sAz1 = 0, long sBz0 = 0, long sBz1 = 0, long sCz0 = 0, long sCz1 = 0,
                       const int* rowidx = nullptr, const int* zoff = nullptr, int epi = 0) {
    GemmArgs g;
    g.A = A; g.B = B; g.C = C; g.rowidx = rowidx; g.zoff = zoff;
    g.lda = lda; g.sbk = sbk; g.sbn = sbn; g.ldc = ldc;
    g.sAz0 = sAz0; g.sAz1 = sAz1; g.sBz0 = sBz0; g.sBz1 = sBz1; g.sCz0 = sCz0; g.sCz1 = sCz1;
    g.M = M; g.N = N; g.K = K; g.Z1 = Z1; g.epi = epi; g.pad = 0;
    return g;
}
DEVI int gemm_tiles(const GemmArgs& g, int maxM, int Z) { return ((g.N + 63) / 64) * ((maxM + 63) / 64) * Z; }
DEVI void gemm_tile(const GemmArgs& g, int maxM, int t) {
    const int nbx = (g.N + 63) / 64, nby = (maxM + 63) / 64;
    const int bx = t % nbx, r = t / nbx;
    gemm_f32(g, bx, r % nby, r / nby);
}
DEVI void gemm_phase(const GemmArgs& g, int maxM, int Z) {
    const int total = gemm_tiles(g, maxM, Z);
    for (int t = blockIdx.x; t < total; t += gridDim.x) gemm_tile(g, maxM, t);
}

__global__ __launch_bounds__(256) void mega(MP p) {
    cg::grid_group grid = cg::this_grid();
    const int G = gridDim.x, B0 = blockIdx.x;
    const float *x_in = p.in[0], *mem = p.in[1];
    float* X = p.X;
    float* R0 = p.R0;
    float* COLS = R0;
    float* T0 = R0 + (size_t)SEQ * DIN;
    const size_t TB = (size_t)SEQ * 256;
    float *rR = T0, *rW = T0 + TB, *rK = T0 + 2 * TB, *rV = T0 + 3 * TB, *rA = T0 + 4 * TB, *rB = T0 + 5 * TB, *rG = T0 + 6 * TB,
          *rBON = T0 + 7 * TB, *rVD = T0 + 8 * TB;
    float *QROT = T0 + 9 * TB, *KSR = QROT + TB, *KWR = KSR + (size_t)SEQ * 64, *GATES = KWR + (size_t)SEQ * 64, *BLK = GATES + (size_t)SEQ * 12 + 16,
          *BLV = BLK + (size_t)NCMP * 2048, *HIDK = BLV + (size_t)NCMP * 2048, *HIDV = HIDK + (size_t)NCMP * 256,
          *KCMP = HIDV + (size_t)NCMP * 256, *VCMP = KCMP + (size_t)NCMP * 64;
    float *HCONV = VCMP + (size_t)NCMP * 64, *UB = HCONV + TB, *VB = UB + TB;
    float* Y = R0;
    float* SC = R0 + (size_t)NTOK * DM;
    float* Qb = Y;
    float* H = R0;
    float* Dp = R0 + (size_t)2 * NTOK * 512;

    for (int t = B0; t < NTOK; t += G) ln_kernel(x_in, 1.0f, nullptr, p.in[2], p.in[3], X, t);
    grid.sync();
    for (int l = 0; l < 2; ++l) {
        for (int b = 0; b < NB; ++b) {
            const float* Xb = X + (size_t)b * SEQ * DM;
            float* MIXb = p.MIX + (size_t)b * SEQ * DM;
            float* VFb = p.VFIRST + (size_t)b * SEQ * 256;
            {
                const GemmArgs g1 = mk(Xb, DM, p.in[4] + (size_t)l * DM * DIN, DIN, 1, COLS, DIN, SEQ, DIN, DM);
                const GemmArgs g2 = mk(Xb, DM, p.in[21], 32, 1, rVD, 32, SEQ, 32, DM);
                const GemmArgs g3 = mk(mem, DM, p.in[38] + (size_t)l * DM * DM, DM, 1, p.KMEM, DM, NB * MEML, DM, DM);
                const GemmArgs g4 = mk(mem, DM, p.in[39] + (size_t)l * DM * DM, DM, 1, p.VMEM, DM, NB * MEML, DM, DM);
                const int n1 = gemm_tiles(g1, SEQ, 1), n2 = l > 0 ? gemm_tiles(g2, SEQ, 1) : 0, n3 = b == 0 ? gemm_tiles(g3, NB * MEML, 1) : 0;
                for (int t = B0; t < n1 + n2 + 2 * n3; t += G) {
                    if (t < n1) gemm_tile(g1, SEQ, t);
                    else if (t < n1 + n2) gemm_tile(g2, SEQ, t - n1);
                    else if (t < n1 + n2 + n3) gemm_tile(g3, NB * MEML, t - n1 - n2);
                    else gemm_tile(g4, NB * MEML, t - n1 - n2 - n3);
                }
            }
            grid.sync();
            {
                RwkvP rp;
                rp.cols = COLS; rp.mu = p.in[10] + l * 1024; rp.w0 = p.in[11] + l * 256; rp.w_up = p.in[12] + (size_t)l * 64 * 256;
                rp.a0 = p.in[13] + l * 256; rp.a_up = p.in[14] + (size_t)l * 64 * 256; rp.g_up = p.in[15] + (size_t)l * 128 * 256;
                rp.k_k = p.in[16] + l * 256; rp.k_a = p.in[17] + l * 256; rp.r_k = p.in[18] + l * 256;
                rp.vd = rVD; rp.v_mu = p.in[22]; rp.v0 = p.in[23]; rp.v_up = p.in[24];
                rp.vfirst = VFb; rp.R = rR; rp.W = rW; rp.K = rK; rp.V = rV; rp.A = rA; rp.Bv = rB; rp.G = rG; rp.BON = rBON; rp.layer = l; rp.pad = 0;
                for (int t = B0; t < 4 * SEQ + NCMP; t += G) {
                    if (t < SEQ) glu_kernel(COLS, HCONV, t);
                    else if (t < 2 * SEQ) gmlp_pre(COLS, p.in[25] + l * 256, p.in[26] + l * 256, UB, VB, t - SEQ);
                    else if (t < 3 * SEQ) rwkv_prep(rp, t - 2 * SEQ);
                    else if (t < 4 * SEQ) nsa_prep(COLS, QROT, KSR, KWR, GATES, t - 3 * SEQ);
                    else cmp_gather(COLS, p.in[29] + (size_t)l * 2048, p.in[32] + (size_t)l * 2048, BLK, BLV, t - 4 * SEQ);
                }
            }
            grid.sync();
            {
                const GemmArgs gk = mk(BLK, 2048, p.in[30] + (size_t)l * 2048 * 256, 256, 1, HIDK, 256, NCMP, 256, 2048);
                const GemmArgs gv = mk(BLV, 2048, p.in[33] + (size_t)l * 2048 * 256, 256, 1, HIDV, 256, NCMP, 256, 2048);
                const int ng = gemm_tiles(gk, NCMP, 1);
                for (int t = B0; t < 2 * ng + 2 * SEQ; t += G) {
                    if (t < ng) gemm_tile(gk, NCMP, t);
                    else if (t < 2 * ng) gemm_tile(gv, NCMP, t - ng);
                    else if (t < 2 * ng + SEQ) conv_kernel(HCONV, p.in[6] + (size_t)l * 31 * 256, p.in[7] + l * 256, p.in[8] + l * 256, p.in[9] + l * 256, MIXb, t - 2 * ng);
                    else gmlp_mix(UB, VB, p.in[27] + (size_t)l * 4 * 128 * 128, p.in[28] + l * 4 * 128, MIXb, t - 2 * ng - SEQ);
                }
            }
            grid.sync();
            for (int t = B0; t < (2 * NCMP * 256 + 255) / 256; t += G) gelu_inplace(HIDK, 2 * NCMP * 256, t);
            grid.sync();
            {
                const GemmArgs gk = mk(HIDK, 256, p.in[31] + (size_t)l * 256 * 64, 64, 1, KCMP, 64, NCMP, 64, 256);
                const GemmArgs gv = mk(HIDV, 256, p.in[34] + (size_t)l * 256 * 64, 64, 1, VCMP, 64, NCMP, 64, 256);
                const int ng = gemm_tiles(gk, NCMP, 1);
                for (int t = B0; t < 2 * ng; t += G) { if (t < ng) gemm_tile(gk, NCMP, t); else gemm_tile(gv, NCMP, t - ng); }
            }
            grid.sync();
            if (B0 == G - 1) {
                rwkv_scan(rR, rW, rK, rV, rA, rB);
            } else {
                for (int t = B0; t < SEQ; t += G - 1) nsa_attn(COLS, QROT, KSR, KWR, GATES, KCMP, VCMP, MIXb, t);
            }
            grid.sync();
            for (int t = B0; t < SEQ; t += G) rwkv_post(rR, rBON, rG, p.in[19] + l * 256, p.in[20] + l * 256, MIXb, t);
            grid.sync();
        }
        { const GemmArgs g = mk(p.MIX, DM, p.in[5] + (size_t)l * DM * DM, DM, 1, Y, DM, NTOK, DM, DM); gemm_phase(g, NTOK, 1); }
        grid.sync();
        for (int t = B0; t < NTOK; t += G) ln_kernel(X, ALPHA, Y, p.in[35] + l * DM, p.in[36] + l * DM, X, t);
        grid.sync();
        { const GemmArgs g = mk(X, DM, p.in[37] + (size_t)l * DM * DM, DM, 1, Qb, DM, NTOK, DM, DM); gemm_phase(g, NTOK, 1); }
        grid.sync();
        { const GemmArgs g = mk(Qb, DM, p.KMEM, 1, DM, SC, 256, SEQ, 256, 256, 4, (long)SEQ * DM, 256, (long)MEML * DM, 256, (long)4 * SEQ * 256, (long)SEQ * 256);
          gemm_phase(g, SEQ, NB * 4); }
        grid.sync();
        for (int t = B0; t < NB * 4 * SEQ; t += G) softmax256(SC, 0.0625f, t);
        grid.sync();
        { const GemmArgs g = mk(SC, 256, p.VMEM, DM, 1, p.MIX, DM, SEQ, 256, 256, 4, (long)4 * SEQ * 256, (long)SEQ * 256, (long)MEML * DM, 256, (long)SEQ * DM, 256);
          gemm_phase(g, SEQ, NB * 4); }
        grid.sync();
        { const GemmArgs g = mk(p.MIX, DM, p.in[40] + (size_t)l * DM * DM, DM, 1, Y, DM, NTOK, DM, DM); gemm_phase(g, NTOK, 1); }
        grid.sync();
        for (int t = B0; t < NTOK; t += G) ln_kernel(X, ALPHA, Y, p.in[41] + l * DM, p.in[42] + l * DM, X, t);
        grid.sync();
        for (int t = B0; t < NTOK; t += G) router_kernel(X, p.in[43], p.in[44], p.TE, p.TW, t);
        grid.sync();
        if (B0 == 0) moe_lists(p.TE, p.EOFF, p.LIST, p.SLOT);
        grid.sync();
        const float* wg = p.in[45] + (size_t)l * 16 * DM * 512;
        const float* wu = p.in[46] + (size_t)l * 16 * DM * 512;
        const float* wd = p.in[47] + (size_t)l * 16 * 512 * DM;
        { const GemmArgs g = mk(X, DM, wu, 512, 1, H, 512, 0, 512, DM, 1, 0, 0, (long)DM * 512, 0, 0, 0, p.LIST, p.EOFF, 0); gemm_phase(g, 2 * NTOK, 16); }
        grid.sync();
        { const GemmArgs g = mk(X, DM, wg, 512, 1, H, 512, 0, 512, DM, 1, 0, 0, (long)DM * 512, 0, 0, 0, p.LIST, p.EOFF, 1); gemm_phase(g, 2 * NTOK, 16); }
        grid.sync();
        { const GemmArgs g = mk(H, 512, wd, DM, 1, Dp, DM, 0, DM, 512, 1, 0, 0, (long)512 * DM, 0, 0, 0, nullptr, p.EOFF, 0); gemm_phase(g, 2 * NTOK, 16); }
        grid.sync();
        for (int t = B0; t < NTOK; t += G) moe_combine_ln(X, Dp, p.TE, p.TW, p.SLOT, p.in[48] + l * DM, p.in[49] + l * DM, X, t);
        grid.sync();
    }
}

extern "C" void kernel_launch(void* const* d_in, const int* in_sizes, int n_in, void* d_out, int out_size, void* d_ws, size_t ws_size,
                              hipStream_t stream) {
    static int grid_blocks = 0;
    if (!grid_blocks) {
        int dev = 0, cus = 0, per_cu = 0;
        hipGetDevice(&dev);
        hipDeviceGetAttribute(&cus, hipDeviceAttributeMultiprocessorCount, dev);
        hipOccupancyMaxActiveBlocksPerMultiprocessor(&per_cu, mega, 256, 0);
        if (per_cu > 2) per_cu = 2;
        grid_blocks = cus * per_cu;
    }
    MP p; memset(&p, 0, sizeof(p));
    for (int i = 0; i < 50; ++i) p.in[i] = (const float*)d_in[i];
    float* ws = (float*)d_ws;
    size_t o = 0;
    auto take = [&](size_t n) { float* q = ws + o; o += (n + 63) & ~(size_t)63; return q; };
    p.X = (float*)d_out;
    p.VFIRST = take((size_t)NTOK * 256);
    p.MIX = take((size_t)NTOK * DM);
    p.KMEM = take((size_t)NB * MEML * DM);
    p.VMEM = take((size_t)NB * MEML * DM);
    p.TE = (int*)take((size_t)NTOK * 2);
    p.TW = take((size_t)NTOK * 2);
    p.SLOT = (int*)take((size_t)NTOK * 2);
    p.LIST = (int*)take((size_t)NTOK * 2);
    p.EOFF = (int*)take(64);
    p.R0 = take((size_t)51 * 1024 * 1024);
    if (o * sizeof(float) > ws_size) return;
    void* args[] = {&p};
    hipError_t e = hipLaunchCooperativeKernel((void*)mega, dim3(grid_blocks), dim3(256), args, 0, stream);
    if (e != hipSuccess) fprintf(stderr, "cooperative launch failed: %s (grid %d)\n", hipGetErrorString(e), grid_blocks);
}
```

```cpp
#include <hip/hip_runtime.h>
#include <hip/hip_cooperative_groups.h>
#include <stdio.h>
#include <stdint.h>
#include <string.h>
#include <math.h>
namespace cg = cooperative_groups;

#define DEVI __device__ __forceinline__
#define GAS __attribute__((address_space(1)))
#define LAS __attribute__((address_space(3)))
typedef unsigned short bf16;
typedef unsigned v4u __attribute__((ext_vector_type(4)));
typedef GAS unsigned gu32;
typedef GAS unsigned long long gu64;
#define RLX_AGENT __ATOMIC_RELAXED, __HIP_MEMORY_SCOPE_AGENT
#define LDS_WAIT() asm volatile("s_waitcnt lgkmcnt(0)" ::: "memory")
#define VM_WAIT() asm volatile("s_waitcnt vmcnt(0)" ::: "memory")
DEVI unsigned f2bf(float f) { unsigned u = __builtin_bit_cast(unsigned, f); return (u + 0x7fffu + ((u >> 16) & 1u)) >> 16; }
DEVI unsigned pk2(float lo, float hi) { return f2bf(lo) | (f2bf(hi) << 16); }
DEVI float bf2f(unsigned short h) { return __builtin_bit_cast(float, (unsigned)h << 16); }

constexpr int NB = 2, SEQ = 8192, DM = 1024, NTOK = NB * SEQ, DIN = 2700, DINP = 2816, MEML = 256;
constexpr int OFF_CV = 0, OFF_CG = 256, OFF_RW = 512, OFF_GU = 1536, OFF_GV = 1792, OFF_Q = 2048, OFF_KC = 2304,
              OFF_VC = 2368, OFF_KS = 2432, OFF_VS = 2496, OFF_KW = 2560, OFF_VW = 2624, OFF_GT = 2688;
constexpr int NCMP = 511;
constexpr float ALPHA = 1.4142135623730951f;
constexpr int NWAVES = 8;
constexpr int RING_OFF = 0, RING_BYTES = 131072;
constexpr int LDSCTL_OFF = RING_BYTES, MISC_OFF = LDSCTL_OFF + 320;
constexpr int LDS_BYTES = 147456;

DEVI int tidx() { int t = threadIdx.x; asm volatile("" : "+v"(t)); return t; }
namespace pg8 {
#define PG8_LAS __attribute__((address_space(3)))
typedef unsigned short bf16_t;
typedef short bf16x8 __attribute__((ext_vector_type(8)));
typedef float f32x4 __attribute__((ext_vector_type(4)));
typedef unsigned u32x4 __attribute__((ext_vector_type(4)));
constexpr int BM = 256, BK = 64, HALF = 128, HTB = HALF * BK * 2  , STAGE_BYTES = 8 * HTB, NXCD = 8, WGM = 8;

__host__ __device__ __forceinline__ int lds_byte(int r, int c) { const int st = (r >> 4) * 2 + (c >> 5), rr = r & 15, cc = c & 31, ob = rr * 64 + cc * 2; return st * 1024 + (ob ^ (((ob >> 9) & 1) << 5)); }
__host__ __device__ __forceinline__ void stage_rc(int b, int& R, int& C) { const int st = b / 1024, sb = b % 1024, swz = sb ^ (((sb >> 9) & 1) << 5); R = (st >> 1) * 16 + swz / 64; C = (st & 1) * 32 + (swz % 64) / 2; }
__host__ __device__ __forceinline__ int perm32(int rho) { const int n = rho >> 4, i = rho & 15; return 8 * (i >> 2) + 4 * n + (i & 3); }

struct Unit { int pm, pn; };
struct Gemm { const bf16_t* A; const bf16_t* Bt; int M, N, K; };

struct StaticOrder {
    int nM, nN, nwg, G, c;
    __host__ __device__ void init(int M, int N, int G_, int c_) { nM = M / BM; nN = N / BM; nwg = nM * nN; G = G_; c = c_; }
    __host__ __device__ bool next(int i, Unit& u) const {
        const long L = (long)i * G + c; if (L >= nwg) return false;
        int wgid = (int)L; { const int q = nwg / NXCD, r = nwg % NXCD, xcd = wgid % NXCD, off = wgid / NXCD; wgid = (xcd < r ? xcd * (q + 1) : r * (q + 1) + (xcd - r) * q) + off; }
        const int nig = WGM * nN, gid = wgid / nig, fm = gid * WGM, gsz = (nM - fm) < WGM ? (nM - fm) : WGM;
        u.pm = fm + ((wgid % nig) % gsz); u.pn = (wgid % nig) / gsz; return true;
    }
    __device__ __forceinline__ void a_ready(const Unit&) const {}
    __device__ __forceinline__ void done(const Unit&) const {}
};

__device__ __forceinline__ unsigned cvt_pk_bf16(float lo, float hi) { unsigned r; asm volatile("v_cvt_pk_bf16_f32 %0, %1, %2" : "=v"(r) : "v"(lo), "v"(hi)); return r; }
typedef float f32x2 __attribute__((ext_vector_type(2)));
__device__ __forceinline__ f32x2 gelu_pk(f32x2 v) {
    const f32x2 av = __builtin_elementwise_abs(v), d = av * 0.2316418882f + 1.0f;
    f32x2 t; t.x = __builtin_amdgcn_rcpf(d.x); t.y = __builtin_amdgcn_rcpf(d.y);
    f32x2 q = t * 0.5307027145f + (-0.7265760135f); q = q * t + 0.7107068705f; q = q * t + (-0.142248368f); q = q * t + 0.127414796f; q = q * t;
    const f32x2 s = (v * v) * (-0.72134752044f);
    f32x2 e; e.x = __builtin_amdgcn_exp2f(s.x); e.y = __builtin_amdgcn_exp2f(s.y);
    const f32x2 m = v * (q * e), r = v - m;
    f32x2 o; o.x = v.x < 0.f ? m.x : r.x; o.y = v.y < 0.f ? m.y : r.y; return o;
}

template <int ACT  > struct EpiBf16 {
    static constexpr bool PERM = true, AFTER_DRAIN = false; static_assert(ACT == 0 || ACT == 1, "EpiBf16: ACT is 0 (none) or 1 (gelu_pk)");
    bf16_t* O; int ldc; const float* bias; int split_cols; size_t split_stride; float scale0;
    __device__ __forceinline__ void operator()(const f32x4 (&acc)[2][2][4][2], const Unit& u, int wr, int wc, int fr, int fq) const {
        const int row0 = u.pm * BM + wr * 64 + fr; int colt = u.pn * BM; bf16_t* base = O;
        float sc = 1.f; if (split_cols) { const int t = colt / split_cols; base += (size_t)t * split_stride; colt -= t * split_cols; if (t == 0) sc = scale0; }
        const int col0 = colt + wc * 32 + 8 * fq, bcol0 = u.pn * BM + wc * 32 + 8 * fq;
        f32x4 bv[2][2];
#pragma unroll
        for (int bj = 0; bj < 2; ++bj)
#pragma unroll
            for (int n = 0; n < 2; ++n) bv[bj][n] = bias ? *(const f32x4*)(bias + bcol0 + bj * HALF + 4 * n) : (f32x4){0.f, 0.f, 0.f, 0.f};
#pragma unroll
        for (int ai = 0; ai < 2; ++ai)
#pragma unroll
            for (int m = 0; m < 4; ++m) { bf16_t* rowp = base + (size_t)(row0 + ai * HALF + m * 16) * ldc + col0;
#pragma unroll
                for (int bj = 0; bj < 2; ++bj) { f32x4 v0 = acc[ai][bj][m][0] + bv[bj][0], v1 = acc[ai][bj][m][1] + bv[bj][1];
                    if (ACT == 1) { f32x2 a = gelu_pk((f32x2){v0[0], v0[1]}), b = gelu_pk((f32x2){v0[2], v0[3]}), c = gelu_pk((f32x2){v1[0], v1[1]}), d = gelu_pk((f32x2){v1[2], v1[3]});
                        v0 = (f32x4){a.x, a.y, b.x, b.y}; v1 = (f32x4){c.x, c.y, d.x, d.y}; }
                    v0 = v0 * sc; v1 = v1 * sc; u32x4 w; w.x = cvt_pk_bf16(v0[0], v0[1]); w.y = cvt_pk_bf16(v0[2], v0[3]); w.z = cvt_pk_bf16(v1[0], v1[1]); w.w = cvt_pk_bf16(v1[2], v1[3]);
                    *(u32x4*)(rowp + bj * HALF) = w; } }
    }
};

struct PanelStats {
    unsigned* xbuf;
    unsigned* cnt;
    unsigned* tmo;
    int ntn; float eps;
    unsigned code;
    __device__ __forceinline__ bool run(const f32x4 (&v)[2][2][4][2], const Unit& u, int wr, int wc, int fr, int fq, PG8_LAS unsigned char* lds, int wid, int lane) const {
        typedef float f32x2v __attribute__((ext_vector_type(2)));
        PG8_LAS f32x2v* P = (PG8_LAS f32x2v*)lds;
        PG8_LAS f32x2v* S = (PG8_LAS f32x2v*)(lds + 8192);
        PG8_LAS unsigned* flag = (PG8_LAS unsigned*)(lds + 8192 + 2048);
#pragma unroll
        for (int ai = 0; ai < 2; ++ai)
#pragma unroll
            for (int m = 0; m < 4; ++m) {
                float s = 0.f;
#pragma unroll
                for (int bj = 0; bj < 2; ++bj)
#pragma unroll
                    for (int n = 0; n < 2; ++n) { const f32x4 x = v[ai][bj][m][n]; s += (x[0] + x[1]) + (x[2] + x[3]); }
                s += __shfl_xor(s, 16); s += __shfl_xor(s, 32);
                const float mw = s * (1.0f / 64.0f); float q = 0.f;
#pragma unroll
                for (int bj = 0; bj < 2; ++bj)
#pragma unroll
                    for (int n = 0; n < 2; ++n) { const f32x4 d = v[ai][bj][m][n] - mw; q += (d[0] * d[0] + d[1] * d[1]) + (d[2] * d[2] + d[3] * d[3]); }
                q += __shfl_xor(q, 16); q += __shfl_xor(q, 32);
                if (fq == 0) P[(ai * HALF + wr * 64 + m * 16 + fr) * 4 + wc] = (f32x2v){mw, q};
            }
        asm volatile("s_waitcnt lgkmcnt(0)" ::: "memory"); __builtin_amdgcn_s_barrier(); asm volatile("" ::: "memory");
#if defined(BROKEN_EXCHANGE_NO_WAIT)
#warning BROKEN CONTROL BUILD: the row-statistics exchange does not wait; results are wrong by design
        if (blockIdx.x >= 64) { const long long t0_ = clock64(); while (clock64() - t0_ < 60000) __builtin_amdgcn_s_sleep(8); }
#endif
        const int row = wid * 32 + (lane & 31);
        if (lane < 32) {
            const f32x2v a = P[row * 4 + 0], b = P[row * 4 + 1], c = P[row * 4 + 2], d = P[row * 4 + 3];
            const float mt = (a.x + b.x + c.x + d.x) * 0.25f;
            const float da = a.x - mt, db = b.x - mt, dc = c.x - mt, dd = d.x - mt;
            const float m2 = (a.y + b.y) + (c.y + d.y) + 64.0f * ((da * da + db * db) + (dc * dc + dd * dd));
            unsigned long long* slot = (unsigned long long*)xbuf + ((size_t)(u.pm * BM + row) * 4 + u.pn);
            __hip_atomic_store(slot, ((unsigned long long)__float_as_uint(m2) << 32) | __float_as_uint(mt), __ATOMIC_RELAXED, __HIP_MEMORY_SCOPE_AGENT);
        }
        asm volatile("s_waitcnt vmcnt(0)" ::: "memory");
        if (lane == 0) __hip_atomic_fetch_add(cnt + 64 * u.pm, 1u, __ATOMIC_RELAXED, __HIP_MEMORY_SCOPE_AGENT);
        if (wid == 0) {
            bool dead = false; const unsigned long long t0 = __builtin_amdgcn_s_memrealtime(); const unsigned want = 8u * (unsigned)ntn;
            for (;;) {
#if defined(BROKEN_EXCHANGE_NO_WAIT)
                break;
#endif
                if ((unsigned)__builtin_amdgcn_readfirstlane(__hip_atomic_load(cnt + 64 * u.pm, __ATOMIC_RELAXED, __HIP_MEMORY_SCOPE_AGENT)) >= want) break;
                if (__builtin_amdgcn_s_memrealtime() - t0 > 2000000ull) {
                    if (lane == 0) { unsigned expect = 0u; __hip_atomic_compare_exchange_strong(tmo + 1, &expect, code | (unsigned)(u.pm & 0xff), __ATOMIC_RELAXED, __ATOMIC_RELAXED, __HIP_MEMORY_SCOPE_AGENT);
                                     __hip_atomic_store(tmo, 1u, __ATOMIC_RELAXED, __HIP_MEMORY_SCOPE_AGENT); }
                    dead = true; break; }
                __builtin_amdgcn_s_sleep(2);
            }
            __builtin_amdgcn_fence(__ATOMIC_ACQUIRE, "agent");
            if (lane == 0) flag[0] = dead ? 1u : 0u;
        }
        asm volatile("s_waitcnt vmcnt(0) lgkmcnt(0)" ::: "memory"); __builtin_amdgcn_s_barrier(); asm volatile("" ::: "memory");
        const bool bad = flag[0] != 0u;
        if (lane < 32) {
            const unsigned long long* slot = (const unsigned long long*)xbuf + (size_t)(u.pm * BM + row) * 4; float mt[4], m2[4]; float ms = 0.f;
#pragma unroll
            for (int t = 0; t < 4; ++t) { if (t < ntn) { const unsigned long long w = __hip_atomic_load(slot + t, __ATOMIC_RELAXED, __HIP_MEMORY_SCOPE_AGENT); mt[t] = __uint_as_float((unsigned)w); m2[t] = __uint_as_float((unsigned)(w >> 32)); } else { mt[t] = 0.f; m2[t] = 0.f; } ms += mt[t]; }
            const float mean = ms / (float)ntn; float q = 0.f;
#pragma unroll
            for (int t = 0; t < 4; ++t) if (t < ntn) { const float dm = mt[t] - mean; q += m2[t] + 256.0f * dm * dm; }
            S[row] = (f32x2v){mean, 1.0f / sqrtf(q / (256.0f * (float)ntn) + eps)};
        }
        asm volatile("s_waitcnt lgkmcnt(0)" ::: "memory"); __builtin_amdgcn_s_barrier(); asm volatile("" ::: "memory");
        return bad;
    }
};
struct EpiLnRes {
    static constexpr bool PERM = false, AFTER_DRAIN = true;
    const float* base; float* out; int ldc; const float* bias; PanelStats st; unsigned poison;
    __device__ __forceinline__ void fused(f32x4 (&acc)[2][2][4][2], const Unit& u, int wr, int wc, int fr, int fq, PG8_LAS unsigned char* lds, int wid, int lane) const {
        typedef float f32x2v __attribute__((ext_vector_type(2)));
        const PG8_LAS f32x2v* S = (const PG8_LAS f32x2v*)(lds + 8192);
        const int col0 = u.pn * BM + wc * 32 + 4 * fq;
#pragma unroll
        for (int bj = 0; bj < 2; ++bj)
#pragma unroll
            for (int n = 0; n < 2; ++n) { const f32x4 bv = bias ? *(const f32x4*)(bias + col0 + bj * HALF + n * 16) : (f32x4){0.f, 0.f, 0.f, 0.f};
#pragma unroll
                for (int ai = 0; ai < 2; ++ai)
#pragma unroll
                    for (int m = 0; m < 4; ++m) acc[ai][bj][m][n] += bv; }
        f32x4 pre[4][2][2];
#pragma unroll
        for (int m = 0; m < 4; ++m) { const size_t off = (size_t)(u.pm * BM + wr * 64 + m * 16 + fr) * ldc + col0;
#pragma unroll
            for (int bj = 0; bj < 2; ++bj)
#pragma unroll
                for (int n = 0; n < 2; ++n) pre[m][bj][n] = *(const f32x4*)(base + off + bj * HALF + n * 16); }
        const bool bad = st.run(acc, u, wr, wc, fr, fq, lds, wid, lane) || poison != 0u;
        const float qnan = __builtin_nanf("");
#pragma unroll
        for (int ai = 0; ai < 2; ++ai)
#pragma unroll
            for (int m = 0; m < 4; ++m) { const int r = ai * HALF + wr * 64 + m * 16 + fr; const f32x2v sr = S[r]; const size_t off = (size_t)(u.pm * BM + r) * ldc + col0;
#pragma unroll
                for (int bj = 0; bj < 2; ++bj)
#pragma unroll
                    for (int n = 0; n < 2; ++n) { const f32x4 bs = ai == 0 ? pre[m][bj][n] : *(const f32x4*)(base + off + bj * HALF + n * 16); f32x4 o = bs + (acc[ai][bj][m][n] - sr.x) * sr.y;
                        if (bad) o = (f32x4){qnan, qnan, qnan, qnan}; *(f32x4*)(out + off + bj * HALF + n * 16) = o; }
                if (m & 1) asm volatile("" ::: "memory"); }
    }
};
struct EpiLnResLn {
    static constexpr bool PERM = false, AFTER_DRAIN = true;
    const float* base; float* out; bf16_t* xn; int ldc; const float* bias; PanelStats st1, st2; unsigned poison;
    __device__ __forceinline__ void fused(f32x4 (&acc)[2][2][4][2], const Unit& u, int wr, int wc, int fr, int fq, PG8_LAS unsigned char* lds, int wid, int lane) const {
        typedef float f32x2v __attribute__((ext_vector_type(2))); typedef unsigned u32x2v __attribute__((ext_vector_type(2)));
        const PG8_LAS f32x2v* S = (const PG8_LAS f32x2v*)(lds + 8192);
        const int col0 = u.pn * BM + wc * 32 + 4 * fq;
#pragma unroll
        for (int bj = 0; bj < 2; ++bj)
#pragma unroll
            for (int n = 0; n < 2; ++n) { const f32x4 bv = bias ? *(const f32x4*)(bias + col0 + bj * HALF + n * 16) : (f32x4){0.f, 0.f, 0.f, 0.f};
#pragma unroll
                for (int ai = 0; ai < 2; ++ai)
#pragma unroll
                    for (int m = 0; m < 4; ++m) acc[ai][bj][m][n] += bv; }
        bool bad = st1.run(acc, u, wr, wc, fr, fq, lds, wid, lane) || poison != 0u;
        const float qnan = __builtin_nanf("");
#pragma unroll
        for (int ai = 0; ai < 2; ++ai)
#pragma unroll
            for (int m = 0; m < 4; ++m) { const int r = ai * HALF + wr * 64 + m * 16 + fr; const f32x2v sr = S[r]; const size_t off = (size_t)(u.pm * BM + r) * ldc + col0;
#pragma unroll
                for (int bj = 0; bj < 2; ++bj)
#pragma unroll
                    for (int n = 0; n < 2; ++n) { const f32x4 bs = *(const f32x4*)(base + off + bj * HALF + n * 16); acc[ai][bj][m][n] = bs + (acc[ai][bj][m][n] - sr.x) * sr.y; }
                asm volatile("" : "+v"(acc[ai][0][m][0]), "+v"(acc[ai][0][m][1]), "+v"(acc[ai][1][m][0]), "+v"(acc[ai][1][m][1]));
                if (m & 1) asm volatile("" ::: "memory"); }
        const bool bad1 = bad;
        bad = st2.run(acc, u, wr, wc, fr, fq, lds, wid, lane) || bad;
#pragma unroll
        for (int ai = 0; ai < 2; ++ai)
#pragma unroll
            for (int m = 0; m < 4; ++m) { const int r = ai * HALF + wr * 64 + m * 16 + fr; const f32x2v sr = S[r]; const size_t off = (size_t)(u.pm * BM + r) * ldc + col0;
#pragma unroll
                for (int bj = 0; bj < 2; ++bj)
#pragma unroll
                    for (int n = 0; n < 2; ++n) { const f32x4 x1 = acc[ai][bj][m][n]; *(f32x4*)(out + off + bj * HALF + n * 16) = bad1 ? (f32x4){qnan, qnan, qnan, qnan} : x1;
                        const f32x4 o = (x1 - sr.x) * sr.y; u32x2v w; w.x = cvt_pk_bf16(o[0], o[1]); w.y = cvt_pk_bf16(o[2], o[3]);
                        if (bad) { w.x = 0x7fc07fc0u; w.y = 0x7fc07fc0u; } *(u32x2v*)(xn + off + bj * HALF + n * 16) = w; }
                asm volatile("" ::: "memory"); }
    }
};

template <class Epi, class Sched, bool ALIGN_EPI = false, bool SP2 = false>
__device__ __forceinline__ void gemm_phase(PG8_LAS unsigned char* lds, const Gemm g, const Sched& S, const Epi& E) {
    const int tid = tidx(), wid = __builtin_amdgcn_readfirstlane(tid >> 6), lane = tid & 63, wr = wid >> 2, wc = wid & 3, fr = lane & 15, fq = lane >> 4;
    const int K = g.K, nt = K / BK;
    unsigned voffA[2], voffB[2];
#pragma unroll
    for (int i = 0; i < 2; ++i) { int R, C; stage_rc(tid * 16 + i * 8192, R, C); const int Rb = Epi::PERM ? ((R & ~31) + perm32(R & 31)) : R;
        voffA[i] = (unsigned)(R * K + C) * 2u; voffB[i] = (unsigned)(Rb * K + C) * 2u; }
    const size_t kstep = (size_t)(BK * 2);
    const size_t hstep = (size_t)HALF * K * 2;
    const size_t tstep = 2 * hstep;
    const unsigned ldsw = (unsigned)wid * 1024u;
    const int aoff = lds_byte(wr * 64 + fr, fq * 8), boff = lds_byte(wc * 32 + fr, fq * 8);
#define PG8_SA(b, h) (((b) * 2 + (h)) * HTB)
#define PG8_SB(b, h) ((4 + (b) * 2 + (h)) * HTB)
#define PG8_STAGE(bufoff, gbase, voff) do { _Pragma("unroll") for (int _i = 0; _i < 2; ++_i) \
        __builtin_amdgcn_global_load_lds((const unsigned*)((const char*)(gbase) + (voff)[_i]), (PG8_LAS unsigned*)(lds + (bufoff) + ldsw + _i * 8192), 16, 0, 0); } while (0)
#define PG8_LDA(dst, b, h) do { _Pragma("unroll") for (int m = 0; m < 4; ++m) _Pragma("unroll") for (int k = 0; k < 2; ++k) dst[m][k] = *(const PG8_LAS bf16x8*)(lds + PG8_SA(b, h) + aoff + m * 2048 + k * 1024); } while (0)
#define PG8_LDB(dst, b, h) do { _Pragma("unroll") for (int n = 0; n < 2; ++n) _Pragma("unroll") for (int k = 0; k < 2; ++k) dst[n][k] = *(const PG8_LAS bf16x8*)(lds + PG8_SB(b, h) + boff + n * 2048 + k * 1024); } while (0)
#define PG8_MMA(ai, bj, At, Bt) do { __builtin_amdgcn_s_setprio(1); _Pragma("unroll") for (int m = 0; m < 4; ++m) _Pragma("unroll") for (int n = 0; n < 2; ++n) _Pragma("unroll") for (int k = 0; k < 2; ++k) \
        acc[ai][bj][m][n] = __builtin_amdgcn_mfma_f32_16x16x32_bf16(Bt[n][k], At[m][k], acc[ai][bj][m][n], 0, 0, 0); __builtin_amdgcn_s_setprio(0); } while (0)
#define PG8_WAIT_V(n) asm volatile("s_waitcnt vmcnt(" #n ")" ::: "memory")
#define PG8_WAIT_L(n) asm volatile("s_waitcnt lgkmcnt(" #n ")" ::: "memory")
#define PG8_BAR __builtin_amdgcn_s_barrier()
#define PG8_SCHED __builtin_amdgcn_sched_barrier(0)
    Unit cur, nxt; int ui = 0;
    if (!S.next(0, cur)) return;
    f32x4 acc[2][2][4][2];
#pragma unroll
    for (int a = 0; a < 2; ++a)
#pragma unroll
        for (int b = 0; b < 2; ++b)
#pragma unroll
            for (int m = 0; m < 4; ++m)
#pragma unroll
                for (int n = 0; n < 2; ++n) acc[a][b][m][n] = (f32x4){0.f, 0.f, 0.f, 0.f};
    bf16x8 At[4][2], B0[2][2], B1[2][2];
    const char* cA = (const char*)g.A + (size_t)cur.pm * tstep; const char* cB = (const char*)g.Bt + (size_t)cur.pn * tstep;
    S.a_ready(cur);
    if constexpr (SP2) {
        PG8_STAGE(PG8_SB(0, 0), cB, voffB); PG8_STAGE(PG8_SB(0, 1), cB + hstep, voffB); PG8_STAGE(PG8_SA(0, 0), cA, voffA); PG8_STAGE(PG8_SA(0, 1), cA + hstep, voffA);
        if (wr == 1) PG8_BAR;
        PG8_WAIT_V(2); PG8_BAR;
        PG8_STAGE(PG8_SB(1, 0), cB + kstep, voffB); PG8_STAGE(PG8_SA(1, 0), cA + kstep, voffA); PG8_STAGE(PG8_SB(1, 1), cB + hstep + kstep, voffB);
        PG8_WAIT_V(6); PG8_BAR;
    } else {
        PG8_STAGE(PG8_SB(0, 0), cB, voffB); PG8_STAGE(PG8_SA(0, 0), cA, voffA); PG8_STAGE(PG8_SB(0, 1), cB + hstep, voffB); PG8_STAGE(PG8_SA(0, 1), cA + hstep, voffA);
        if (wr == 1) PG8_BAR;
        PG8_WAIT_V(4); PG8_BAR;
        PG8_STAGE(PG8_SB(1, 0), cB + kstep, voffB); PG8_STAGE(PG8_SA(1, 0), cA + kstep, voffA); PG8_STAGE(PG8_SB(1, 1), cB + hstep + kstep, voffB);
        PG8_WAIT_V(6); PG8_BAR;
    }
    for (;;) {
        const bool has_next = S.next(ui + 1, nxt);
        const char* nA = has_next ? (const char*)g.A + (size_t)nxt.pm * tstep : cA; const char* nB = has_next ? (const char*)g.Bt + (size_t)nxt.pn * tstep : cB;
        for (int t = 0; t < nt; t += 2) {
            const bool last = (t == nt - 2);
            const char* a1 = cA + (size_t)(t + 1) * kstep;
            const char* a2 = last ? nA : cA + (size_t)(t + 2) * kstep; const char* b2 = last ? nB : cB + (size_t)(t + 2) * kstep;
            const char* a3 = a2 + kstep; const char* b3 = b2 + kstep;
            if (last && has_next) S.a_ready(nxt);
            if constexpr (SP2) {
            PG8_LDB(B0, 0, 0); PG8_LDB(B1, 0, 1); PG8_SCHED; PG8_LDA(At, 0, 0); PG8_STAGE(PG8_SA(1, 1), a1 + hstep, voffA);
            PG8_WAIT_V(8); PG8_WAIT_L(0); PG8_BAR; PG8_MMA(0, 0, At, B0); PG8_MMA(0, 1, At, B1); PG8_BAR; PG8_SCHED;
            PG8_LDA(At, 0, 1); PG8_STAGE(PG8_SB(0, 0), b2, voffB); PG8_STAGE(PG8_SB(0, 1), b2 + hstep, voffB); PG8_STAGE(PG8_SA(0, 0), a2, voffA);
            PG8_WAIT_V(8); PG8_WAIT_L(0); PG8_BAR; PG8_MMA(1, 0, At, B0); PG8_MMA(1, 1, At, B1); PG8_BAR; PG8_SCHED;
            PG8_LDB(B0, 1, 0); PG8_LDB(B1, 1, 1); PG8_SCHED; PG8_LDA(At, 1, 0); PG8_STAGE(PG8_SA(0, 1), a2 + hstep, voffA);
            PG8_WAIT_V(8); PG8_WAIT_L(0); PG8_BAR; PG8_MMA(0, 0, At, B0); PG8_MMA(0, 1, At, B1); PG8_BAR; PG8_SCHED;
            PG8_LDA(At, 1, 1); PG8_STAGE(PG8_SB(1, 0), b3, voffB); PG8_STAGE(PG8_SB(1, 1), b3 + hstep, voffB); PG8_STAGE(PG8_SA(1, 0), a3, voffA);
            PG8_WAIT_V(8); PG8_WAIT_L(0); PG8_BAR; PG8_MMA(1, 0, At, B0); PG8_MMA(1, 1, At, B1); PG8_BAR; PG8_SCHED;
            } else {
            PG8_LDB(B0, 0, 0); PG8_SCHED; PG8_LDA(At, 0, 0); PG8_STAGE(PG8_SA(1, 1), a1 + hstep, voffA);
            PG8_WAIT_L(8); PG8_BAR; PG8_WAIT_L(0); PG8_MMA(0, 0, At, B0); PG8_BAR; PG8_SCHED;
            PG8_LDB(B1, 0, 1); PG8_STAGE(PG8_SB(0, 0), b2, voffB);
            PG8_BAR; PG8_WAIT_L(0); PG8_MMA(0, 1, At, B1); PG8_BAR;
            PG8_LDA(At, 0, 1); PG8_STAGE(PG8_SA(0, 0), a2, voffA);
            PG8_BAR; PG8_WAIT_L(0); PG8_MMA(1, 0, At, B0); PG8_BAR; PG8_SCHED;
            PG8_STAGE(PG8_SB(0, 1), b2 + hstep, voffB);
            PG8_WAIT_V(6); PG8_BAR; PG8_MMA(1, 1, At, B1); PG8_BAR;
            PG8_LDB(B0, 1, 0); PG8_SCHED; PG8_LDA(At, 1, 0); PG8_STAGE(PG8_SA(0, 1), a2 + hstep, voffA);
            PG8_WAIT_L(8); PG8_BAR; PG8_WAIT_L(0); PG8_MMA(0, 0, At, B0); PG8_BAR; PG8_SCHED;
            PG8_LDB(B1, 1, 1); PG8_STAGE(PG8_SB(1, 0), b3, voffB);
            PG8_BAR; PG8_WAIT_L(0); PG8_MMA(0, 1, At, B1); PG8_BAR;
            PG8_LDA(At, 1, 1); PG8_STAGE(PG8_SA(1, 0), a3, voffA);
            PG8_BAR; PG8_WAIT_L(0); PG8_MMA(1, 0, At, B0); PG8_BAR; PG8_SCHED;
            PG8_STAGE(PG8_SB(1, 1), b3 + hstep, voffB);
            PG8_WAIT_V(6); PG8_BAR; PG8_MMA(1, 1, At, B1); PG8_BAR;
            }
        }
        if constexpr (ALIGN_EPI) { if (wr == 0) PG8_BAR; }
        if constexpr (!Epi::AFTER_DRAIN) { E(acc, cur, wr, wc, fr, fq); S.done(cur); }
        if (!has_next) break;
#pragma unroll
        for (int a = 0; a < 2; ++a)
#pragma unroll
            for (int b = 0; b < 2; ++b)
#pragma unroll
                for (int m = 0; m < 4; ++m)
#pragma unroll
                    for (int n = 0; n < 2; ++n) acc[a][b][m][n] = (f32x4){0.f, 0.f, 0.f, 0.f};
        cur = nxt; cA = nA; cB = nB; ++ui;
        if constexpr (ALIGN_EPI) { if (wr == 1) PG8_BAR; }
    }
    PG8_WAIT_V(0);
    if constexpr (!ALIGN_EPI) { if (wr == 0) PG8_BAR; }
    PG8_BAR;
    if constexpr (Epi::AFTER_DRAIN) { E.fused(acc, cur, wr, wc, fr, fq, lds, wid, lane); S.done(cur); }
#undef PG8_SA
#undef PG8_SB
#undef PG8_STAGE
#undef PG8_LDA
#undef PG8_LDB
#undef PG8_MMA
#undef PG8_WAIT_V
#undef PG8_WAIT_L
#undef PG8_BAR
#undef PG8_SCHED
}
}
namespace pg8 {
struct EpiF32 {
    static constexpr bool PERM = false, AFTER_DRAIN = false;
    float* C; int ldc; const float* bias;
    __device__ __forceinline__ void operator()(const f32x4 (&acc)[2][2][4][2], const Unit& u, int wr, int wc, int fr, int fq) const {
        const int row0 = u.pm * BM + wr * 64 + fr, col0 = u.pn * BM + wc * 32 + 4 * fq;
        f32x4 bv[2][2];
#pragma unroll
        for (int bj = 0; bj < 2; ++bj)
#pragma unroll
            for (int n = 0; n < 2; ++n) bv[bj][n] = bias ? *(const f32x4*)(bias + col0 + bj * HALF + n * 16) : (f32x4){0.f, 0.f, 0.f, 0.f};
#pragma unroll
        for (int ai = 0; ai < 2; ++ai)
#pragma unroll
            for (int m = 0; m < 4; ++m) { float* rowp = C + (size_t)(row0 + ai * HALF + m * 16) * ldc + col0;
#pragma unroll
                for (int bj = 0; bj < 2; ++bj)
#pragma unroll
                    for (int n = 0; n < 2; ++n) *(f32x4*)(rowp + bj * HALF + n * 16) = acc[ai][bj][m][n] + bv[bj][n]; }
    }
};
}
#define XB_TMO      128
#define XB_XCNT(j)  (256  + 64 * (j))
#define XB_XSUB(j)  (1280 + 64 * (j))
#define XB_XGEN(j)  (2304 + 64 * (j))
#define XB_TOP      3328
#define XB_TOPGEN   3392
#define XCD_BAR_WORDS 3456
#define XB_SPIN_CAP (1u << 18)

__device__ __forceinline__ unsigned xb_ld(unsigned* p)              { return __hip_atomic_load(p, __ATOMIC_RELAXED, __HIP_MEMORY_SCOPE_AGENT); }
__device__ __forceinline__ unsigned xb_add(unsigned* p, unsigned v) { return __hip_atomic_fetch_add(p, v, __ATOMIC_RELAXED, __HIP_MEMORY_SCOPE_AGENT); }
__device__ __forceinline__ unsigned xb_xcc_id() { return (unsigned)__builtin_amdgcn_s_getreg((3 << 11) | 20) & 0xFu; }
#define XB_SPIN(cond, bar) do { unsigned _sp = 0; while (cond) { __builtin_amdgcn_s_sleep(1); \
    if ((++_sp & 255u) == 0u) { if (xb_ld(&(bar)[XB_TMO])) break; if (_sp > XB_SPIN_CAP) { atomicAdd(&(bar)[XB_TMO], 1u); break; } } } } while (0)

struct XcdBarrier {
    unsigned* bar; unsigned x;
    volatile LAS unsigned* st;
};

__device__ __forceinline__ XcdBarrier xcd_barrier_post(unsigned* bar, volatile LAS unsigned* st) {
    XcdBarrier b; b.bar = bar; b.x = xb_xcc_id(); b.st = st;
    if (threadIdx.x == 0) (void)xb_add(&bar[XB_XCNT(b.x)], 1u);
    return b;
}
__device__ __forceinline__ void xcd_barrier_complete(unsigned* bar, unsigned x, unsigned& nloc, unsigned& nx) {
    const unsigned G = gridDim.x * gridDim.y * gridDim.z;
    unsigned sum, cnt, mine, sp = 0u;
    for (;;) {
        sum = 0u; cnt = 0u; mine = 0u;
#pragma unroll
        for (unsigned j = 0; j < 16; ++j) { const unsigned c = xb_ld(&bar[XB_XCNT(j)]); sum += c; cnt += (c > 0u) ? 1u : 0u; mine = (j == x) ? c : mine; }
        if (sum == G) break;
        __builtin_amdgcn_s_sleep(1);
        if ((++sp & 255u) == 0u) { if (xb_ld(&bar[XB_TMO])) break; if (sp > XB_SPIN_CAP) { atomicAdd(&bar[XB_TMO], 1u); break; } }
    }
    nloc = mine > 0u ? mine : 1u; nx = cnt > 0u ? cnt : 1u;
}

__device__ __forceinline__ void xcd_barrier(const XcdBarrier& b) {
    asm volatile("s_waitcnt vmcnt(0)" ::: "memory");
    __syncthreads();
    if (threadIdx.x == 0) {
        unsigned* bar = b.bar;
        __builtin_amdgcn_s_waitcnt(0);
        unsigned nloc = b.st[0], nx = b.st[1];
        if (nloc == 0u) { xcd_barrier_complete(bar, b.x, nloc, nx); b.st[0] = nloc; b.st[1] = nx; }
        const unsigned old = xb_add(&bar[XB_XSUB(b.x)], 1u);
        const unsigned gen = old / nloc;
        if (old + 1u == (gen + 1u) * nloc) {
            __builtin_amdgcn_fence(__ATOMIC_RELEASE, "agent");
            asm volatile("s_waitcnt vmcnt(0)" ::: "memory");
            const unsigned og = xb_add(&bar[XB_TOP], 1u);
            const unsigned tg = og / nx;
            if (og + 1u == (tg + 1u) * nx) xb_add(&bar[XB_TOPGEN], 1u);
            else XB_SPIN(xb_ld(&bar[XB_TOPGEN]) == tg, bar);
            __builtin_amdgcn_fence(__ATOMIC_ACQUIRE, "agent");
            xb_add(&bar[XB_XGEN(b.x)], 1u);
            asm volatile("s_waitcnt vmcnt(0)" ::: "memory");
        } else {
            XB_SPIN(xb_ld(&bar[XB_XGEN(b.x)]) == gen, bar);
            __builtin_amdgcn_fence(__ATOMIC_ACQUIRE, "agent");
            asm volatile("s_waitcnt vmcnt(0)" ::: "memory");
        }
    }
    __syncthreads();
}

DEVI float wave_sum(float v) {
#pragma unroll
    for (int o = 32; o > 0; o >>= 1) v += __shfl_xor(v, o, 64);
    return v;
}
DEVI float wave_max(float v) {
#pragma unroll
    for (int o = 32; o > 0; o >>= 1) v = fmaxf(v, __shfl_xor(v, o, 64));
    return v;
}
DEVI float sigm(float x) { return 1.f / (1.f + expf(-x)); }
DEVI float gelu_t(float x) { return 0.5f * x * (1.f + tanhf(0.7978845608028654f * (x + 0.044715f * x * x * x))); }
DEVI float softplus_(float x) { return fmaxf(x, 0.f) + log1pf(expf(-fabsf(x))); }

DEVI float block_sum256(float v, float* red, int tid) {
    v = wave_sum(v);
    __syncthreads();
    if ((tid & 63) == 0) red[tid >> 6] = v;
    __syncthreads();
    return red[0] + red[1] + red[2] + red[3];
}

DEVI void ln_kernel(const float* xres, float alpha, const float* add, const float* __restrict__ g, const float* __restrict__ bt,
                    float* out, bf16* outb, int bid, float* sm) {
    __syncthreads();
    const size_t row = bid;
    const int tid = tidx() & 255;
    float v[4];
#pragma unroll
    for (int i = 0; i < 4; ++i) {
        const size_t idx = row * DM + tid + i * 256;
        v[i] = alpha * xres[idx] + (add ? add[idx] : 0.f);
    }
    const float mean = block_sum256(v[0] + v[1] + v[2] + v[3], sm, tid) * (1.f / DM);
    float q = 0.f;
#pragma unroll
    for (int i = 0; i < 4; ++i) { v[i] -= mean; q += v[i] * v[i]; }
    const float var = block_sum256(q, sm, tid) * (1.f / DM);
    const float rstd = rsqrtf(var + 1e-5f);
#pragma unroll
    for (int i = 0; i < 4; ++i) {
        const int c = tid + i * 256;
        const float o = v[i] * rstd * g[c] + bt[c];
        out[row * DM + c] = o;
        outb[row * DM + c] = (bf16)f2bf(o);
    }
}

struct GemmArgs {
    const float* A; const float* B; float* C; const int* rowidx; const int* zoff;
    long lda, sbk, sbn, ldc, sAz0, sAz1, sBz0, sBz1, sCz0, sCz1;
    int M, N, K, Z1, epi, pad;
};
DEVI void gemm_f32(const GemmArgs& g, int bx, int by, int z, bool live, float* sm) {
    float (*As)[68] = (float (*)[68])sm;
    float (*Bs)[68] = (float (*)[68])(sm + 16 * 68);
    const int z0 = z / g.Z1, z1 = z % g.Z1;
    int mbeg = 0, mend = g.M;
    if (g.zoff) { mbeg = g.zoff[z]; mend = g.zoff[z + 1]; }
    const int m0 = mbeg + by * 64;
    if (!live) mend = 0;
    const int n0 = bx * 64;
    const float* A = g.A + z0 * g.sAz0 + z1 * g.sAz1;
    const float* B = g.B + z0 * g.sBz0 + z1 * g.sBz1;
    float* C = g.C + z0 * g.sCz0 + z1 * g.sCz1;
    const int tid = tidx() & 255, tx = tid & 15, ty = tid >> 4;
    float acc[4][4];
#pragma unroll
    for (int i = 0; i < 4; ++i)
#pragma unroll
        for (int j = 0; j < 4; ++j) acc[i][j] = 0.f;
    long arow[4];
#pragma unroll
    for (int i = 0; i < 4; ++i) {
        const int r = (tid + i * 256) >> 4;
        const int row = m0 + r;
        if (row < mend) arow[i] = (long)(g.rowidx ? g.rowidx[row] : row) * g.lda; else arow[i] = -1;
    }
    __syncthreads();
    for (int k0 = 0; k0 < g.K; k0 += 16) {
#pragma unroll
        for (int i = 0; i < 4; ++i) {
            const int e = tid + i * 256, r = e >> 4, kk = e & 15;
            float v = 0.f;
            if (arow[i] >= 0 && k0 + kk < g.K) v = A[arow[i] + k0 + kk];
            As[kk][r] = v;
        }
#pragma unroll
        for (int i = 0; i < 4; ++i) {
            const int e = tid + i * 256, kk = e >> 6, n = e & 63;
            float v = 0.f;
            if (m0 < mend && n0 + n < g.N && k0 + kk < g.K) v = B[(long)(k0 + kk) * g.sbk + (long)(n0 + n) * g.sbn];
            Bs[kk][n] = v;
        }
        __syncthreads();
#pragma unroll
        for (int kk = 0; kk < 16; ++kk) {
            float a[4], b[4];
#pragma unroll
            for (int i = 0; i < 4; ++i) a[i] = As[kk][ty * 4 + i];
#pragma unroll
            for (int j = 0; j < 4; ++j) b[j] = Bs[kk][tx * 4 + j];
#pragma unroll
            for (int i = 0; i < 4; ++i)
#pragma unroll
                for (int j = 0; j < 4; ++j) acc[i][j] = fmaf(a[i], b[j], acc[i][j]);
        }
        __syncthreads();
    }
#pragma unroll
    for (int i = 0; i < 4; ++i) {
        const int row = m0 + ty * 4 + i;
        if (row >= mend) continue;
#pragma unroll
        for (int j = 0; j < 4; ++j) {
            const int col = n0 + tx * 4 + j;
            if (col >= g.N) continue;
            float* p = C + (long)row * g.ldc + col;
            float v = acc[i][j];
            if (g.epi == 1) { v = v * sigm(v) * (*p); }
            *p = v;
        }
    }
}
DEVI GemmArgs mk(const float* A, long lda, const float* B, long sbk, long sbn, float* C, long ldc, int M, int N, int K,
                 int Z1 = 1, long sAz0 = 0, long sAz1 = 0, long sBz0 = 0, long sBz1 = 0, long sCz0 = 0, long sCz1 = 0,
                 const int* rowidx = nullptr, const int* zoff = nullptr, int epi = 0) {
    GemmArgs g;
    g.A = A; g.B = B; g.C = C; g.rowidx = rowidx; g.zoff = zoff;
    g.lda = lda; g.sbk = sbk; g.sbn = sbn; g.ldc = ldc;
    g.sAz0 = sAz0; g.sAz1 = sAz1; g.sBz0 = sBz0; g.sBz1 = sBz1; g.sCz0 = sCz0; g.sCz1 = sCz1;
    g.M = M; g.N = N; g.K = K; g.Z1 = Z1; g.epi = epi; g.pad = 0;
    return g;
}
DEVI int gemm_tiles(const GemmArgs& g, int maxM, int Z) { return ((g.N + 63) / 64) * ((maxM + 63) / 64) * Z; }
DEVI bool gemm_tile_live(const GemmArgs& g, int maxM, int t) {
    const int nbx = (g.N + 63) / 64, nby = (maxM + 63) / 64;
    const int r = t / nbx, by = r % nby, z = r / nby;
    int mbeg = 0, mend = g.M;
    if (g.zoff) { mbeg = g.zoff[z]; mend = g.zoff[z + 1]; }
    return mbeg + by * 64 < mend;
}
DEVI void gemm_tile(const GemmArgs& g, int maxM, int t, bool live, float* sm) {
    const int nbx = (g.N + 63) / 64, nby = (maxM + 63) / 64;
    const int bx = t % nbx, r = t / nbx;
    gemm_f32(g, bx, r % nby, r / nby, live, sm);
}

DEVI void glu_kernel(const float* __restrict__ cols, float* __restrict__ h, int bid) {
    const size_t t = bid; const int c = tidx() & 255;
    h[t * 256 + c] = cols[t * DINP + OFF_CV + c] * sigm(cols[t * DINP + OFF_CG + c]);
}
DEVI void conv_kernel(const float* __restrict__ h, const float* __restrict__ w, const float* __restrict__ bias,
                      const float* __restrict__ gg, const float* __restrict__ gb, bf16* __restrict__ mix, int bid) {
    const int t = bid, c = tidx() & 255;
    float acc = bias[c];
#pragma unroll 4
    for (int j = 0; j < 31; ++j) {
        const int tt = t - 30 + j;
        if (tt >= 0) acc = fmaf(h[(size_t)tt * 256 + c], w[j * 256 + c], acc);
    }
    const float mean = wave_sum(acc) * (1.f / 64.f);
    const float d = acc - mean;
    const float var = wave_sum(d * d) * (1.f / 64.f);
    const float y = d * rsqrtf(var + 1e-5f) * gg[c] + gb[c];
    mix[(size_t)t * DM + 0 + c] = (bf16)f2bf(y * sigm(y));
}

DEVI void gmlp_pre(const float* __restrict__ cols, const float* __restrict__ lg, const float* __restrict__ lb,
                   float* __restrict__ ub, float* __restrict__ vb, int bid, float* sm) {
    __syncthreads();
    const size_t t = bid; const int c = tidx() & 255;
    ub[t * 256 + c] = gelu_t(cols[t * DINP + OFF_GU + c]);
    const float v = gelu_t(cols[t * DINP + OFF_GV + c]);
    const float mean = block_sum256(v, sm, c) * (1.f / 256.f);
    const float d = v - mean;
    const float var = block_sum256(d * d, sm, c) * (1.f / 256.f);
    vb[t * 256 + c] = d * rsqrtf(var + 1e-5f) * lg[c] + lb[c];
}
DEVI void gmlp_mix(const float* __restrict__ ub, const float* __restrict__ vb, const float* __restrict__ ws,
                   const float* __restrict__ bs, bf16* __restrict__ mix, int bid) {
    const int t = bid, c = tidx() & 255, h = c >> 6, tt = t & 127, base = t - tt;
    float acc = bs[h * 128 + tt];
    const float* wr = ws + ((size_t)h * 128 + tt) * 128;
#pragma unroll 4
    for (int s = 0; s <= tt; ++s) acc = fmaf(wr[s], vb[(size_t)(base + s) * 256 + c], acc);
    mix[(size_t)t * DM + 512 + c] = (bf16)f2bf(ub[(size_t)t * 256 + c] * acc);
}

struct RwkvP {
    const float* cols; const float* mu; const float* w0; const float* w_up; const float* a0; const float* a_up; const float* g_up;
    const float* k_k; const float* k_a; const float* r_k; const float* vd; const float* v_mu; const float* v0; const float* v_up;
    float* vfirst; float* R; float* W; float* K; float* V; float* A; float* Bv; float* G; float* BON;
    int layer, pad;
};
DEVI void rwkv_prep(const RwkvP& p, int bid, float* sm) {
    __syncthreads();
    float* y = sm;
    float* vds = sm + 1024;
    const int t = bid, c = tidx() & 255;
#pragma unroll
    for (int q = 0; q < 4; ++q) {
        const int j = c + q * 256;
        const float cur = p.cols[(size_t)t * DINP + OFF_RW + j];
        const float prv = t > 0 ? p.cols[(size_t)(t - 1) * DINP + OFF_RW + j] : 0.f;
        y[j] = cur + p.mu[j] * (prv - cur);
    }
    if (p.layer > 0 && c < 32) {
        const float cur = p.vd[(size_t)t * 32 + c];
        const float prv = t > 0 ? p.vd[(size_t)(t - 1) * 32 + c] : 0.f;
        vds[c] = cur + p.v_mu[c] * (prv - cur);
    }
    __syncthreads();
    float tw = 0.f, sg = 0.f;
    if (c < 64) tw = tanhf(y[768 + c]);
    if (c >= 128) sg = sigm(y[896 + (c - 128)]);
    __syncthreads();
    if (c < 64) y[768 + c] = tw;
    if (c >= 128) y[896 + (c - 128)] = sg;
    __syncthreads();
    const float r = y[c], k = y[256 + c];
    float v = y[512 + c];
    float wl = p.w0[c], al = p.a0[c], gl = 0.f;
#pragma unroll 4
    for (int j = 0; j < 64; ++j) { wl = fmaf(y[768 + j], p.w_up[j * 256 + c], wl); al = fmaf(y[832 + j], p.a_up[j * 256 + c], al); }
#pragma unroll 4
    for (int j = 0; j < 128; ++j) gl = fmaf(y[896 + j], p.g_up[j * 256 + c], gl);
    const float wlog = -softplus_(-wl) - 0.5f;
    const float decay = expf(-expf(wlog));
    const float a = sigm(al);
    if (p.layer == 0) {
        p.vfirst[(size_t)t * 256 + c] = v;
    } else {
        float vm = p.v0[c];
#pragma unroll 4
        for (int j = 0; j < 32; ++j) vm = fmaf(vds[j], p.v_up[j * 256 + c], vm);
        vm = sigm(vm);
        v = v + (p.vfirst[(size_t)t * 256 + c] - v) * vm;
    }
    float kk = k * p.k_k[c];
    const float nrm = sqrtf(wave_sum(kk * kk));
    kk = kk / fmaxf(nrm, 1e-12f);
    const float k2 = k * (1.f + (a - 1.f) * p.k_a[c]);
    const float bd = wave_sum(r * k2 * p.r_k[c]);
    const size_t o = (size_t)t * 256 + c;
    p.R[o] = r; p.W[o] = decay; p.K[o] = k2; p.V[o] = v; p.A[o] = -kk; p.Bv[o] = kk * a; p.G[o] = gl; p.BON[o] = bd * v;
}
DEVI void rwkv_scan(float* R, const float* __restrict__ W, const float* __restrict__ K, const float* __restrict__ V,
                    const float* __restrict__ A, const float* __restrict__ Bv, float* sm0) {
    float (*sr)[256] = (float (*)[256])sm0, (*sw)[256] = sr + 4, (*sk)[256] = sr + 8, (*sa)[256] = sr + 12, (*sb)[256] = sr + 16, (*sv)[256] = sr + 20;
    const int vt = tidx(); const bool act = vt < 256;
    const int tid = vt & 255, h = tid >> 6, lane = tid & 63;
    float st[64];
#pragma unroll
    for (int i = 0; i < 64; ++i) st[i] = 0.f;
    for (int t0 = 0; t0 < SEQ; t0 += 4) {
        __syncthreads();
        if (act) {
#pragma unroll
            for (int s = 0; s < 4; ++s) {
                const size_t idx = (size_t)(t0 + s) * 256 + tid;
                sr[s][tid] = R[idx]; sw[s][tid] = W[idx]; sk[s][tid] = K[idx]; sa[s][tid] = A[idx]; sb[s][tid] = Bv[idx]; sv[s][tid] = V[idx];
            }
        }
        __syncthreads();
        if (act) {
#pragma unroll 1
            for (int s = 0; s < 4; ++s) {
                const float vt_ = sv[s][tid];
                const float* pa = &sa[s][h * 64]; const float* pw = &sw[s][h * 64]; const float* pb = &sb[s][h * 64];
                const float* pk = &sk[s][h * 64]; const float* pr = &sr[s][h * 64];
                float sa_ = 0.f;
#pragma unroll
                for (int k = 0; k < 64; ++k) sa_ = fmaf(st[k], pa[k], sa_);
#pragma unroll
                for (int k = 0; k < 64; ++k) st[k] = fmaf(st[k], pw[k], fmaf(sa_, pb[k], vt_ * pk[k]));
                float o = 0.f;
#pragma unroll
                for (int k = 0; k < 64; ++k) o = fmaf(st[k], pr[k], o);
                R[(size_t)(t0 + s) * 256 + h * 64 + lane] = o;
            }
        }
    }
    __syncthreads();
}
DEVI void rwkv_post(const float* __restrict__ O, const float* __restrict__ BON, const float* __restrict__ G,
                    const float* __restrict__ gg, const float* __restrict__ gb, bf16* __restrict__ mix, int bid) {
    const size_t t = bid; const int c = tidx() & 255;
    const float o = O[t * 256 + c];
    const float mean = wave_sum(o) * (1.f / 64.f);
    const float d = o - mean;
    const float var = wave_sum(d * d) * (1.f / 64.f);
    const float y = d * rsqrtf(var + 64e-5f) * gg[c] + gb[c];
    mix[t * DM + 256 + c] = (bf16)f2bf((y + BON[t * 256 + c]) * G[t * 256 + c]);
}

DEVI void nsa_prep(const float* __restrict__ cols, float* __restrict__ qrot, float* __restrict__ ksr,
                   float* __restrict__ kwr, float* __restrict__ gates, int bid) {
    const int t = bid, c = tidx() & 255;
    const int d = c & 63, j = d & 31;
    const float inv = powf(10000.f, -(float)j / 32.f);
    const float ang = (float)t * inv;
    float sn, cs; sincosf(ang, &sn, &cs);
    {
        const float* q = cols + (size_t)t * DINP + OFF_Q + (c & ~63);
        const float x1 = q[j], x2 = q[j + 32];
        qrot[(size_t)t * 256 + c] = d < 32 ? x1 * cs - x2 * sn : x2 * cs + x1 * sn;
    }
    if (c < 128) {
        const float* kp = cols + (size_t)t * DINP + (c < 64 ? OFF_KS : OFF_KW);
        const float x1 = kp[j], x2 = kp[j + 32];
        const float v = d < 32 ? x1 * cs - x2 * sn : x2 * cs + x1 * sn;
        if (c < 64) ksr[(size_t)t * 64 + d] = v; else kwr[(size_t)t * 64 + d] = v;
    }
    if (c < 12) gates[(size_t)t * 12 + c] = sigm(cols[(size_t)t * DINP + OFF_GT + c]);
}
DEVI void cmp_gather(const float* __restrict__ cols, const float* __restrict__ pek, const float* __restrict__ pev,
                     float* __restrict__ bk, float* __restrict__ bv, int bid) {
    const int n = bid, tid = tidx() & 255;
    for (int i = tid; i < 2048; i += 256) {
        const int l = i >> 6, d = i & 63;
        const size_t row = (size_t)(16 * n + l) * DINP;
        bk[(size_t)n * 2048 + i] = cols[row + OFF_KC + d] + pek[i];
        bv[(size_t)n * 2048 + i] = cols[row + OFF_VC + d] + pev[i];
    }
}
DEVI void gelu_inplace(float* p, int n, int bid) {
    const int i = bid * 256 + (tidx() & 255);
    if (i < n) p[i] = gelu_t(p[i]);
}

DEVI void wave_softmax(float* s, int n, int lane) {
    float m = -INFINITY;
    for (int i = lane; i < n; i += 64) m = fmaxf(m, s[i]);
    m = wave_max(m);
    if (m == -INFINITY) { for (int i = lane; i < n; i += 64) s[i] = 0.f; return; }
    float sum = 0.f;
    for (int i = lane; i < n; i += 64) { const float p = expf(s[i] - m); s[i] = p; sum += p; }
    sum = wave_sum(sum);
    const float inv = 1.f / fmaxf(sum, 1e-20f);
    for (int i = lane; i < n; i += 64) s[i] *= inv;
}
DEVI void dot4(const float* q  , const float* __restrict__ krow, float* out4) {
    float a0 = 0.f, a1 = 0.f, a2 = 0.f, a3 = 0.f;
#pragma unroll
    for (int d = 0; d < 64; d += 4) {
        const float4 kv = *(const float4*)(krow + d);
        a0 += q[d] * kv.x + q[d + 1] * kv.y + q[d + 2] * kv.z + q[d + 3] * kv.w;
        a1 += q[64 + d] * kv.x + q[64 + d + 1] * kv.y + q[64 + d + 2] * kv.z + q[64 + d + 3] * kv.w;
        a2 += q[128 + d] * kv.x + q[128 + d + 1] * kv.y + q[128 + d + 2] * kv.z + q[128 + d + 3] * kv.w;
        a3 += q[192 + d] * kv.x + q[192 + d + 1] * kv.y + q[192 + d + 2] * kv.z + q[192 + d + 3] * kv.w;
    }
    out4[0] = a0; out4[1] = a1; out4[2] = a2; out4[3] = a3;
}
DEVI void nsa_attn(const float* __restrict__ cols, const float* __restrict__ qrot, const float* __restrict__ ksr,
                   const float* __restrict__ kwr, const float* __restrict__ gates, const float* __restrict__ kcmp,
                   const float* __restrict__ vcmp, bf16* __restrict__ mix, int bid, float* sm) {
    __syncthreads();
    float* q = sm; float* qr = sm + 256;
    float (*sc)[1024] = (float (*)[1024])(sm + 512);
    float* imp = sm + 512 + 4096;
    int* sel = (int*)(sm + 512 + 4096 + 128);
    const int pos = bid, tid = tidx() & 255, h = tid >> 6, lane = tid & 63;
    q[tid] = cols[(size_t)pos * DINP + OFF_Q + tid];
    qr[tid] = qrot[(size_t)pos * 256 + tid];
    __syncthreads();
    int ncv = pos >= 31 ? (pos - 31) / 16 + 1 : 0;
    if (ncv > NCMP) ncv = NCMP;
    for (int n = tid; n < 512; n += 256) {
        if (n < ncv) {
            float d4[4]; dot4(q, kcmp + (size_t)n * 64, d4);
            sc[0][n] = d4[0] * 0.125f; sc[1][n] = d4[1] * 0.125f; sc[2][n] = d4[2] * 0.125f; sc[3][n] = d4[3] * 0.125f;
        } else { sc[0][n] = 0.f; sc[1][n] = 0.f; sc[2][n] = 0.f; sc[3][n] = 0.f; }
    }
    __syncthreads();
    wave_softmax(sc[h], ncv, lane);
    __syncthreads();
    float oc = 0.f;
#pragma unroll 4
    for (int n = 0; n < ncv; ++n) oc = fmaf(sc[h][n], vcmp[(size_t)n * 64 + lane], oc);
    if (tid < 128) {
        const int j = tid;
        auto ps = [&](int n) -> float { return (n >= 0 && n < 512) ? (sc[0][n] + sc[1][n] + sc[2][n] + sc[3][n]) : 0.f; };
        const float v = 0.5f * ps(4 * j - 1) + ps(4 * j) + ps(4 * j + 1) + ps(4 * j + 2) + 0.5f * ps(4 * j + 3);
        const int cur = pos >> 6;
        float key;
        if (j == cur || j == 0) key = INFINITY; else if (j <= cur) key = v; else key = -1.f;
        imp[j] = key;
    }
    __syncthreads();
    if (h == 0) {
        float v0 = imp[lane], v1 = imp[lane + 64];
        for (int r = 0; r < 16; ++r) {
            float bv; int bi;
            if (v1 > v0) { bv = v1; bi = lane + 64; } else { bv = v0; bi = lane; }
#pragma unroll
            for (int o = 32; o > 0; o >>= 1) {
                const float ov = __shfl_xor(bv, o, 64); const int oi = __shfl_xor(bi, o, 64);
                if (ov > bv || (ov == bv && oi < bi)) { bv = ov; bi = oi; }
            }
            if (lane == 0) sel[r] = bi;
            if (bi == lane) v0 = -2.f;
            if (bi == lane + 64) v1 = -2.f;
        }
    }
    __syncthreads();
    for (int i = tid; i < 1024; i += 256) {
        const int kp = sel[i >> 6] * 64 + (i & 63);
        if (kp <= pos) {
            float d4[4]; dot4(qr, ksr + (size_t)kp * 64, d4);
            sc[0][i] = d4[0] * 0.125f; sc[1][i] = d4[1] * 0.125f; sc[2][i] = d4[2] * 0.125f; sc[3][i] = d4[3] * 0.125f;
        } else { sc[0][i] = -INFINITY; sc[1][i] = -INFINITY; sc[2][i] = -INFINITY; sc[3][i] = -INFINITY; }
    }
    __syncthreads();
    wave_softmax(sc[h], 1024, lane);
    __syncthreads();
    float os = 0.f;
#pragma unroll 2
    for (int i = 0; i < 1024; ++i) {
        const float p = sc[h][i];
        if (p != 0.f) { const int kp = sel[i >> 6] * 64 + (i & 63); os = fmaf(p, cols[(size_t)kp * DINP + OFF_VS + lane], os); }
    }
    __syncthreads();
    for (int i = tid; i < 512; i += 256) {
        const int kp = pos - 511 + i;
        if (kp >= 0) {
            float d4[4]; dot4(qr, kwr + (size_t)kp * 64, d4);
            sc[0][i] = d4[0] * 0.125f; sc[1][i] = d4[1] * 0.125f; sc[2][i] = d4[2] * 0.125f; sc[3][i] = d4[3] * 0.125f;
        } else { sc[0][i] = -INFINITY; sc[1][i] = -INFINITY; sc[2][i] = -INFINITY; sc[3][i] = -INFINITY; }
    }
    __syncthreads();
    wave_softmax(sc[h], 512, lane);
    __syncthreads();
    float ow = 0.f;
#pragma unroll 4
    for (int i = 0; i < 512; ++i) {
        const int kp = pos - 511 + i;
        if (kp >= 0) ow = fmaf(sc[h][i], cols[(size_t)kp * DINP + OFF_VW + lane], ow);
    }
    const float* gt = gates + (size_t)pos * 12 + h * 3;
    mix[(size_t)pos * DM + 768 + tid] = (bf16)f2bf(gt[0] * oc + gt[1] * os + gt[2] * ow);
}

DEVI void softmax256(float* s, float scale, int bid, float* sm) {
    __syncthreads();
    const size_t row = bid; const int tid = tidx() & 255;
    const float v = s[row * 256 + tid] * scale;
    float m = wave_max(v);
    if ((tid & 63) == 0) sm[8 + (tid >> 6)] = m;
    __syncthreads();
    m = fmaxf(fmaxf(sm[8], sm[9]), fmaxf(sm[10], sm[11]));
    const float p = expf(v - m);
    const float sum = block_sum256(p, sm, tid);
    s[row * 256 + tid] = p / sum;
}

DEVI void router_kernel(const float* __restrict__ x, const float* __restrict__ rw, const float* __restrict__ rb,
                        int* __restrict__ te, float* __restrict__ tw, int bid, float* sm) {
    __syncthreads();
    float (*part)[16] = (float (*)[16])sm;
    const size_t t = bid; const int tid = tidx() & 255;
    float acc[16];
#pragma unroll
    for (int e = 0; e < 16; ++e) acc[e] = 0.f;
#pragma unroll 1
    for (int i = tid; i < DM; i += 256) {
        const float xv = x[t * DM + i];
#pragma unroll
        for (int e = 0; e < 16; ++e) acc[e] = fmaf(xv, rw[i * 16 + e], acc[e]);
    }
#pragma unroll
    for (int e = 0; e < 16; ++e) acc[e] = wave_sum(acc[e]);
    if ((tid & 63) == 0) {
#pragma unroll
        for (int e = 0; e < 16; ++e) part[tid >> 6][e] = acc[e];
    }
    __syncthreads();
    if (tid == 0) {
        float lg[16], pr[16], sl[16];
        float m = -INFINITY;
#pragma unroll
        for (int e = 0; e < 16; ++e) { lg[e] = part[0][e] + part[1][e] + part[2][e] + part[3][e]; m = fmaxf(m, lg[e]); }
        float sum = 0.f;
#pragma unroll
        for (int e = 0; e < 16; ++e) { pr[e] = expf(lg[e] - m); sum += pr[e]; }
#pragma unroll
        for (int e = 0; e < 16; ++e) { pr[e] /= sum; sl[e] = pr[e] + rb[e]; }
        int bg = 0; float bgs = -INFINITY;
#pragma unroll
        for (int gI = 0; gI < 4; ++gI) {
            float m1 = -INFINITY, m2 = -INFINITY;
#pragma unroll
            for (int j = 0; j < 4; ++j) { const float v = sl[gI * 4 + j]; if (v > m1) { m2 = m1; m1 = v; } else if (v > m2) m2 = v; }
            const float sc = m1 + m2;
            if (sc > bgs) { bgs = sc; bg = gI; }
        }
        int e0 = -1, e1 = -1; float s0 = -INFINITY, s1 = -INFINITY, p0 = 0.f, p1 = 0.f;
#pragma unroll
        for (int e = 0; e < 16; ++e) {
            if ((e >> 2) == bg) {
                const float v = sl[e];
                if (v > s0) { s1 = s0; e1 = e0; p1 = p0; s0 = v; e0 = e; p0 = pr[e]; } else if (v > s1) { s1 = v; e1 = e; p1 = pr[e]; }
            }
        }
        const float wsum = p0 + p1;
        te[t * 2] = e0; te[t * 2 + 1] = e1;
        tw[t * 2] = p0 / wsum; tw[t * 2 + 1] = p1 / wsum;
    }
}
DEVI void moe_lists(const int* __restrict__ te, int* __restrict__ off, int* __restrict__ list, int* __restrict__ slotpos, float* sm0) {
    int* cnt = (int*)sm0;
    int* offs = cnt + 16;
    const int w = tidx() >> 6, lane = tidx() & 63;
    __syncthreads();
    for (int ee = 0; ee < 2; ++ee) {
        const int e = w * 2 + ee;
        int c = 0;
        for (int base = 0; base < NTOK; base += 64) {
            const int tok = base + lane;
            const bool m = (te[tok * 2] == e) || (te[tok * 2 + 1] == e);
            c += __popcll(__ballot(m));
        }
        if (lane == 0) cnt[e] = c;
    }
    __syncthreads();
    if (tidx() == 0) {
        int s = 0;
        for (int i = 0; i < 16; ++i) { offs[i] = s; off[i] = s; s += cnt[i]; }
        offs[16] = s; off[16] = s;
    }
    __syncthreads();
    for (int ee = 0; ee < 2; ++ee) {
        const int e = w * 2 + ee;
        int pos = offs[e];
        for (int base = 0; base < NTOK; base += 64) {
            const int tok = base + lane;
            const int a = te[tok * 2], b = te[tok * 2 + 1];
            const bool m = (a == e) || (b == e);
            const unsigned long long mask = __ballot(m);
            if (m) {
                const int p = pos + __popcll(mask & ((1ull << lane) - 1ull));
                list[p] = tok;
                slotpos[tok * 2 + (a == e ? 0 : 1)] = p;
            }
            pos += __popcll(mask);
        }
    }
    __syncthreads();
}
DEVI void moe_combine_ln(const float* x, const float* __restrict__ Dp, const int* __restrict__ te,
                         const float* __restrict__ tw, const int* __restrict__ slotpos,
                         const float* __restrict__ g, const float* __restrict__ bt, float* out, bf16* outb, int bid, float* sm) {
    __syncthreads();
    const size_t t = bid; const int tid = tidx() & 255;
    int ea = te[t * 2], eb = te[t * 2 + 1];
    float wa = tw[t * 2], wb = tw[t * 2 + 1];
    size_t pa = slotpos[t * 2], pb = slotpos[t * 2 + 1];
    if (eb < ea) { const float tf = wa; wa = wb; wb = tf; const size_t tp = pa; pa = pb; pb = tp; }
    float v[4];
#pragma unroll
    for (int i = 0; i < 4; ++i) {
        const int c = tid + i * 256;
        float y = wa * Dp[pa * DM + c];
        y = y + wb * Dp[pb * DM + c];
        v[i] = ALPHA * x[t * DM + c] + y;
    }
    const float mean = block_sum256(v[0] + v[1] + v[2] + v[3], sm, tid) * (1.f / DM);
    float q = 0.f;
#pragma unroll
    for (int i = 0; i < 4; ++i) { v[i] -= mean; q += v[i] * v[i]; }
    const float var = block_sum256(q, sm, tid) * (1.f / DM);
    const float rstd = rsqrtf(var + 1e-5f);
#pragma unroll
    for (int i = 0; i < 4; ++i) {
        const int c = tid + i * 256;
        const float o = v[i] * rstd * g[c] + bt[c];
        out[t * DM + c] = o;
        outb[t * DM + c] = (bf16)f2bf(o);
    }
}
struct MP {
    const float* in[50];
    float *X, *VFIRST, *KMEM, *VMEM, *TW, *R0;
    bf16 *XN, *MIX, *WIN_T, *WOUT_T;
    int *TE, *SLOT, *LIST, *EOFF;
    unsigned* BAR;
};

DEVI void tr_item(const float* W, int K, int N, int Npad, bf16* WT, LAS float* scr, int item, int lane) {
    const int nblk = Npad / 32, kb = item / nblk, nb = item % nblk, k0 = 64 * kb, n0 = 32 * nb;
    const int n_ = n0 + (lane & 31);
#pragma unroll 8
    for (int i = 0; i < 32; ++i) { const int kk = 2 * i + (lane >> 5); scr[kk * 33 + (lane & 31)] = n_ < N ? W[(size_t)(k0 + kk) * N + n_] : 0.f; }
    LDS_WAIT(); asm volatile("" ::: "memory");
    const int c = lane & 7;
#pragma unroll
    for (int j = 0; j < 4; ++j) { const int n = (lane >> 3) + 8 * j; const LAS float* s = scr + (8 * c) * 33 + n;
        v4u o; o.x = pk2(s[0 * 33], s[1 * 33]); o.y = pk2(s[2 * 33], s[3 * 33]); o.z = pk2(s[4 * 33], s[5 * 33]); o.w = pk2(s[6 * 33], s[7 * 33]);
        *(GAS v4u*)(WT + (size_t)(n0 + n) * K + k0 + 8 * c) = o; }
    LDS_WAIT(); asm volatile("" ::: "memory");
}

DEVI void gemm_all(const GemmArgs& g, int maxM, int Z, int B0, int G, int vb, float* sm) {
    const int total = gemm_tiles(g, maxM, Z);
    for (int t0 = B0 * 2; t0 < total; t0 += G * 2) {
        const bool l0 = gemm_tile_live(g, maxM, t0), l1 = (t0 + 1 < total) && gemm_tile_live(g, maxM, t0 + 1);
        if (!l0 && !l1) continue;
        const int t = (vb && t0 + 1 < total) ? t0 + 1 : t0;
        gemm_tile(g, maxM, t, vb ? l1 : l0, sm);
    }
}

__global__ void __launch_bounds__(512, 2) mega(MP p) {
    extern __shared__ __attribute__((aligned(16))) unsigned char lds[];
    cg::grid_group grid = cg::this_grid();
    const int G = gridDim.x, B0 = blockIdx.x;
    {
        LAS unsigned* ctl = (LAS unsigned*)((LAS unsigned char*)lds + LDSCTL_OFF);
        for (int u = threadIdx.x; u < (LDS_BYTES - LDSCTL_OFF) / 4; u += NWAVES * 64) ctl[u] = 0u;
    }
    __syncthreads();
    volatile LAS unsigned* MISC = (volatile LAS unsigned*)((LAS unsigned char*)lds + MISC_OFF);
    XcdBarrier bar = xcd_barrier_post(p.BAR, MISC + 8);
    grid.sync();
#define GSYNC() xcd_barrier(bar)
    const int vb = tidx() >> 8;
    float* sm = (float*)(lds + vb * 32768);
    float* sm0 = (float*)lds;
    LAS unsigned char* ring = (LAS unsigned char*)lds + RING_OFF;
#define VLOOP(n, body) for (int t0_ = B0 * 2; t0_ < (n); t0_ += G * 2) { const int t = min(t0_ + vb, (n) - 1); body; }

    const float *x_in = p.in[0], *mem = p.in[1];
    float* X = p.X;
    float* R0 = p.R0;
    float* COLS = R0;
    float* T0 = R0 + (size_t)SEQ * DINP;
    const size_t TB = (size_t)SEQ * 256;
    float *rR = T0, *rW = T0 + TB, *rK = T0 + 2 * TB, *rV = T0 + 3 * TB, *rA = T0 + 4 * TB, *rB = T0 + 5 * TB, *rG = T0 + 6 * TB,
          *rBON = T0 + 7 * TB, *rVD = T0 + 8 * TB;
    float *QROT = T0 + 9 * TB, *KSR = QROT + TB, *KWR = KSR + (size_t)SEQ * 64, *GATES = KWR + (size_t)SEQ * 64, *BLK = GATES + (size_t)SEQ * 12 + 16,
          *BLV = BLK + (size_t)NCMP * 2048, *HIDK = BLV + (size_t)NCMP * 2048, *HIDV = HIDK + (size_t)NCMP * 256,
          *KCMP = HIDV + (size_t)NCMP * 256, *VCMP = KCMP + (size_t)NCMP * 64;
    float *HCONV = VCMP + (size_t)NCMP * 64, *UB = HCONV + TB, *VB = UB + TB;
    float* Y = R0;
    float* SC = R0 + (size_t)NTOK * DM;
    float* OX = R0 + (size_t)2 * NTOK * DM;
    float* Qb = Y;
    float* H = R0;
    float* Dp = R0 + (size_t)2 * NTOK * 512;

    {
        LAS float* scr = (LAS float*)(ring + (tidx() >> 6) * 16384);
        const int gw = B0 * NWAVES + (tidx() >> 6), NGW = G * NWAVES, lane = tidx() & 63;
        constexpr int I_IN = (DM / 64) * (DINP / 32), I_OUT = (DM / 64) * (DM / 32);
        for (int it = gw; it < 2 * I_IN + 2 * I_OUT; it += NGW) {
            int r = it;
            if (r < 2 * I_IN) { const int l = r / I_IN; tr_item(p.in[4] + (size_t)l * DM * DIN, DM, DIN, DINP, p.WIN_T + (size_t)l * DINP * DM, scr, r % I_IN, lane); continue; }
            r -= 2 * I_IN;
            { const int l = r / I_OUT; tr_item(p.in[5] + (size_t)l * DM * DM, DM, DM, DM, p.WOUT_T + (size_t)l * DM * DM, scr, r % I_OUT, lane); }
        }
    }
    VLOOP(NTOK, ln_kernel(x_in, 1.0f, nullptr, p.in[2], p.in[3], X, p.XN, t, sm))
    GSYNC();
    for (int l = 0; l < 2; ++l) {
        for (int b = 0; b < NB; ++b) {
            const float* Xb = X + (size_t)b * SEQ * DM;
            bf16* MIXb = p.MIX + (size_t)b * SEQ * DM;
            float* VFb = p.VFIRST + (size_t)b * SEQ * 256;
            {
                pg8::Gemm g{p.XN + (size_t)b * SEQ * DM, p.WIN_T + (size_t)l * DINP * DM, SEQ, DINP, DM};
                pg8::StaticOrder S; S.init(SEQ, DINP, G, B0);
                pg8::EpiF32 E{COLS, DINP, nullptr};
                pg8::gemm_phase<pg8::EpiF32, pg8::StaticOrder, true, true>(ring, g, S, E);
            }
            if (l > 0) { const GemmArgs g2 = mk(Xb, DM, p.in[21], 32, 1, rVD, 32, SEQ, 32, DM); gemm_all(g2, SEQ, 1, B0, G, vb, sm); }
            if (b == 0) {
                const GemmArgs g3 = mk(mem, DM, p.in[38] + (size_t)l * DM * DM, DM, 1, p.KMEM, DM, NB * MEML, DM, DM);
                const GemmArgs g4 = mk(mem, DM, p.in[39] + (size_t)l * DM * DM, DM, 1, p.VMEM, DM, NB * MEML, DM, DM);
                gemm_all(g3, NB * MEML, 1, B0, G, vb, sm);
                gemm_all(g4, NB * MEML, 1, B0, G, vb, sm);
            }
            GSYNC();
            {
                RwkvP rp;
                rp.cols = COLS; rp.mu = p.in[10] + l * 1024; rp.w0 = p.in[11] + l * 256; rp.w_up = p.in[12] + (size_t)l * 64 * 256;
                rp.a0 = p.in[13] + l * 256; rp.a_up = p.in[14] + (size_t)l * 64 * 256; rp.g_up = p.in[15] + (size_t)l * 128 * 256;
                rp.k_k = p.in[16] + l * 256; rp.k_a = p.in[17] + l * 256; rp.r_k = p.in[18] + l * 256;
                rp.vd = rVD; rp.v_mu = p.in[22]; rp.v0 = p.in[23]; rp.v_up = p.in[24];
                rp.vfirst = VFb; rp.R = rR; rp.W = rW; rp.K = rK; rp.V = rV; rp.A = rA; rp.Bv = rB; rp.G = rG; rp.BON = rBON; rp.layer = l; rp.pad = 0;
                VLOOP(SEQ, glu_kernel(COLS, HCONV, t))
                VLOOP(SEQ, gmlp_pre(COLS, p.in[25] + l * 256, p.in[26] + l * 256, UB, VB, t, sm))
                VLOOP(SEQ, rwkv_prep(rp, t, sm))
                VLOOP(SEQ, nsa_prep(COLS, QROT, KSR, KWR, GATES, t))
                VLOOP(NCMP, cmp_gather(COLS, p.in[29] + (size_t)l * 2048, p.in[32] + (size_t)l * 2048, BLK, BLV, t))
            }
            GSYNC();
            {
                const GemmArgs gk = mk(BLK, 2048, p.in[30] + (size_t)l * 2048 * 256, 256, 1, HIDK, 256, NCMP, 256, 2048);
                const GemmArgs gv = mk(BLV, 2048, p.in[33] + (size_t)l * 2048 * 256, 256, 1, HIDV, 256, NCMP, 256, 2048);
                gemm_all(gk, NCMP, 1, B0, G, vb, sm);
                gemm_all(gv, NCMP, 1, B0, G, vb, sm);
                VLOOP(SEQ, conv_kernel(HCONV, p.in[6] + (size_t)l * 31 * 256, p.in[7] + l * 256, p.in[8] + l * 256, p.in[9] + l * 256, MIXb, t))
                VLOOP(SEQ, gmlp_mix(UB, VB, p.in[27] + (size_t)l * 4 * 128 * 128, p.in[28] + l * 4 * 128, MIXb, t))
            }
            GSYNC();
            VLOOP((2 * NCMP * 256 + 255) / 256, gelu_inplace(HIDK, 2 * NCMP * 256, t))
            GSYNC();
            {
                const GemmArgs gk = mk(HIDK, 256, p.in[31] + (size_t)l * 256 * 64, 64, 1, KCMP, 64, NCMP, 64, 256);
                const GemmArgs gv = mk(HIDV, 256, p.in[34] + (size_t)l * 256 * 64, 64, 1, VCMP, 64, NCMP, 64, 256);
                gemm_all(gk, NCMP, 1, B0, G, vb, sm);
                gemm_all(gv, NCMP, 1, B0, G, vb, sm);
            }
            GSYNC();
            if (B0 == G - 1) {
                rwkv_scan(rR, rW, rK, rV, rA, rB, sm0);
            } else {
                for (int t0_ = B0 * 2; t0_ < SEQ; t0_ += (G - 1) * 2) { const int t = min(t0_ + vb, SEQ - 1); nsa_attn(COLS, QROT, KSR, KWR, GATES, KCMP, VCMP, MIXb, t, sm); }
            }
            GSYNC();
            VLOOP(SEQ, rwkv_post(rR, rBON, rG, p.in[19] + l * 256, p.in[20] + l * 256, MIXb, t))
            GSYNC();
        }
        {
            pg8::Gemm g{p.MIX, p.WOUT_T + (size_t)l * DM * DM, NTOK, DM, DM};
            pg8::StaticOrder S; S.init(NTOK, DM, G, B0);
            pg8::EpiF32 E{Y, DM, nullptr};
            pg8::gemm_phase<pg8::EpiF32, pg8::StaticOrder, true, true>(ring, g, S, E);
        }
        GSYNC();
        VLOOP(NTOK, ln_kernel(X, ALPHA, Y, p.in[35] + l * DM, p.in[36] + l * DM, X, p.XN, t, sm))
        GSYNC();
        { const GemmArgs g = mk(X, DM, p.in[37] + (size_t)l * DM * DM, DM, 1, Qb, DM, NTOK, DM, DM); gemm_all(g, NTOK, 1, B0, G, vb, sm); }
        GSYNC();
        { const GemmArgs g = mk(Qb, DM, p.KMEM, 1, DM, SC, 256, SEQ, 256, 256, 4, (long)SEQ * DM, 256, (long)MEML * DM, 256, (long)4 * SEQ * 256, (long)SEQ * 256);
          gemm_all(g, SEQ, NB * 4, B0, G, vb, sm); }
        GSYNC();
        VLOOP(NB * 4 * SEQ, softmax256(SC, 0.0625f, t, sm))
        GSYNC();
        { const GemmArgs g = mk(SC, 256, p.VMEM, DM, 1, OX, DM, SEQ, 256, 256, 4, (long)4 * SEQ * 256, (long)SEQ * 256, (long)MEML * DM, 256, (long)SEQ * DM, 256);
          gemm_all(g, SEQ, NB * 4, B0, G, vb, sm); }
        GSYNC();
        { const GemmArgs g = mk(OX, DM, p.in[40] + (size_t)l * DM * DM, DM, 1, Y, DM, NTOK, DM, DM); gemm_all(g, NTOK, 1, B0, G, vb, sm); }
        GSYNC();
        VLOOP(NTOK, ln_kernel(X, ALPHA, Y, p.in[41] + l * DM, p.in[42] + l * DM, X, p.XN, t, sm))
        GSYNC();
        VLOOP(NTOK, router_kernel(X, p.in[43], p.in[44], p.TE, p.TW, t, sm))
        GSYNC();
        if (B0 == 0) moe_lists(p.TE, p.EOFF, p.LIST, p.SLOT, sm0);
        GSYNC();
        const float* wg = p.in[45] + (size_t)l * 16 * DM * 512;
        const float* wu = p.in[46] + (size_t)l * 16 * DM * 512;
        const float* wd = p.in[47] + (size_t)l * 16 * 512 * DM;
        { const GemmArgs g = mk(X, DM, wu, 512, 1, H, 512, 0, 512, DM, 1, 0, 0, (long)DM * 512, 0, 0, 0, p.LIST, p.EOFF, 0); gemm_all(g, 2 * NTOK, 16, B0, G, vb, sm); }
        GSYNC();
        { const GemmArgs g = mk(X, DM, wg, 512, 1, H, 512, 0, 512, DM, 1, 0, 0, (long)DM * 512, 0, 0, 0, p.LIST, p.EOFF, 1); gemm_all(g, 2 * NTOK, 16, B0, G, vb, sm); }
        GSYNC();
        { const GemmArgs g = mk(H, 512, wd, DM, 1, Dp, DM, 0, DM, 512, 1, 0, 0, (long)512 * DM, 0, 0, 0, nullptr, p.EOFF, 0); gemm_all(g, 2 * NTOK, 16, B0, G, vb, sm); }
        GSYNC();
        VLOOP(NTOK, moe_combine_ln(X, Dp, p.TE, p.TW, p.SLOT, p.in[48] + l * DM, p.in[49] + l * DM, X, p.XN, t, sm))
        GSYNC();
    }
}

extern "C" void kernel_launch(void* const* d_in, const int* in_sizes, int n_in, void* d_out, int out_size, void* d_ws, size_t ws_size,
                              hipStream_t stream) {
    static int grid_blocks = 0;
    if (!grid_blocks) {
        int dev = 0, cus = 0, per_cu = 0;
        (void)hipGetDevice(&dev);
        (void)hipDeviceGetAttribute(&cus, hipDeviceAttributeMultiprocessorCount, dev);
        (void)hipFuncSetAttribute((const void*)mega, hipFuncAttributeMaxDynamicSharedMemorySize, LDS_BYTES);
        (void)hipOccupancyMaxActiveBlocksPerMultiprocessor(&per_cu, (const void*)mega, NWAVES * 64, LDS_BYTES);
        (void)hipGetLastError();
        if (per_cu < 1) { fprintf(stderr, "occupancy query says %d blocks per CU\n", per_cu); per_cu = 1; }
        grid_blocks = cus;
    }
    MP p; memset(&p, 0, sizeof(p));
    for (int i = 0; i < 50; ++i) p.in[i] = (const float*)d_in[i];
    char* ws = (char*)d_ws;
    size_t o = 0;
    auto take = [&](size_t bytes) { char* q = ws + o; o += (bytes + 255) & ~(size_t)255; return q; };
    p.BAR = (unsigned*)take(16384);
    p.X = (float*)d_out;
    p.VFIRST = (float*)take((size_t)NTOK * 256 * 4);
    p.MIX = (bf16*)take((size_t)NTOK * DM * 2);
    p.XN = (bf16*)take((size_t)NTOK * DM * 2);
    p.WIN_T = (bf16*)take((size_t)2 * DINP * DM * 2);
    p.WOUT_T = (bf16*)take((size_t)2 * DM * DM * 2);
    p.KMEM = (float*)take((size_t)NB * MEML * DM * 4);
    p.VMEM = (float*)take((size_t)NB * MEML * DM * 4);
    p.TE = (int*)take((size_t)NTOK * 2 * 4);
    p.TW = (float*)take((size_t)NTOK * 2 * 4);
    p.SLOT = (int*)take((size_t)NTOK * 2 * 4);
    p.LIST = (int*)take((size_t)NTOK * 2 * 4);
    p.EOFF = (int*)take(256);
    p.R0 = (float*)take((size_t)51 * 1024 * 1024 * 4);
    if (o > ws_size) { fprintf(stderr, "workspace too small: need %zu have %zu\n", o, ws_size); return; }
    (void)hipMemsetAsync(p.BAR, 0, 16384, stream);
    void* args[] = {&p};
    hipError_t e = hipLaunchCooperativeKernel((const void*)mega, dim3(grid_blocks), dim3(NWAVES * 64), args, LDS_BYTES, stream);
    if (e != hipSuccess) fprintf(stderr, "cooperative launch failed: %s (grid %d)\n", hipGetErrorString(e), grid_blocks);
}
```

```cpp
#include <hip/hip_runtime.h>
#include <hip/hip_cooperative_groups.h>
#include <stdio.h>
#include <stdint.h>
#include <string.h>
#include <math.h>
namespace cg = cooperative_groups;

#define DEVI __device__ __forceinline__
#define GAS __attribute__((address_space(1)))
#define LAS __attribute__((address_space(3)))
typedef unsigned short bf16;
typedef unsigned v4u __attribute__((ext_vector_type(4)));
typedef GAS unsigned gu32;
typedef GAS unsigned long long gu64;
#define RLX_AGENT __ATOMIC_RELAXED, __HIP_MEMORY_SCOPE_AGENT
#define LDS_WAIT() asm volatile("s_waitcnt lgkmcnt(0)" ::: "memory")
#define VM_WAIT() asm volatile("s_waitcnt vmcnt(0)" ::: "memory")
DEVI unsigned f2bf(float f) { unsigned u = __builtin_bit_cast(unsigned, f); return (u + 0x7fffu + ((u >> 16) & 1u)) >> 16; }
DEVI unsigned pk2(float lo, float hi) { return f2bf(lo) | (f2bf(hi) << 16); }
DEVI float bf2f(unsigned short h) { return __builtin_bit_cast(float, (unsigned)h << 16); }

constexpr int NB = 2, SEQ = 8192, DM = 1024, NTOK = NB * SEQ, DIN = 2700, DINP = 2816, MEML = 256;
constexpr int OFF_CV = 0, OFF_CG = 256, OFF_RW = 512, OFF_GU = 1536, OFF_GV = 1792, OFF_Q = 2048, OFF_KC = 2304,
              OFF_VC = 2368, OFF_KS = 2432, OFF_VS = 2496, OFF_KW = 2560, OFF_VW = 2624, OFF_GT = 2688;
constexpr int NCMP = 511;
constexpr float ALPHA = 1.4142135623730951f;
constexpr int NWAVES = 8;
constexpr int RING_OFF = 0, RING_BYTES = 131072;
constexpr int LDSCTL_OFF = RING_BYTES, MISC_OFF = LDSCTL_OFF + 320;
constexpr int LDS_BYTES = 147456;

DEVI int tidx() { int t = threadIdx.x; asm volatile("" : "+v"(t)); return t; }
namespace pg8 {
#define PG8_LAS __attribute__((address_space(3)))
typedef unsigned short bf16_t;
typedef short bf16x8 __attribute__((ext_vector_type(8)));
typedef float f32x4 __attribute__((ext_vector_type(4)));
typedef unsigned u32x4 __attribute__((ext_vector_type(4)));
constexpr int BM = 256, BK = 64, HALF = 128, HTB = HALF * BK * 2  , STAGE_BYTES = 8 * HTB, NXCD = 8, WGM = 8;

__host__ __device__ __forceinline__ int lds_byte(int r, int c) { const int st = (r >> 4) * 2 + (c >> 5), rr = r & 15, cc = c & 31, ob = rr * 64 + cc * 2; return st * 1024 + (ob ^ (((ob >> 9) & 1) << 5)); }
__host__ __device__ __forceinline__ void stage_rc(int b, int& R, int& C) { const int st = b / 1024, sb = b % 1024, swz = sb ^ (((sb >> 9) & 1) << 5); R = (st >> 1) * 16 + swz / 64; C = (st & 1) * 32 + (swz % 64) / 2; }
__host__ __device__ __forceinline__ int perm32(int rho) { const int n = rho >> 4, i = rho & 15; return 8 * (i >> 2) + 4 * n + (i & 3); }

struct Unit { int pm, pn; };
struct Gemm { const bf16_t* A; const bf16_t* Bt; int M, N, K; };

struct StaticOrder {
    int nM, nN, nwg, G, c;
    __host__ __device__ void init(int M, int N, int G_, int c_) { nM = M / BM; nN = N / BM; nwg = nM * nN; G = G_; c = c_; }
    __host__ __device__ bool next(int i, Unit& u) const {
        const long L = (long)i * G + c; if (L >= nwg) return false;
        int wgid = (int)L; { const int q = nwg / NXCD, r = nwg % NXCD, xcd = wgid % NXCD, off = wgid / NXCD; wgid = (xcd < r ? xcd * (q + 1) : r * (q + 1) + (xcd - r) * q) + off; }
        const int nig = WGM * nN, gid = wgid / nig, fm = gid * WGM, gsz = (nM - fm) < WGM ? (nM - fm) : WGM;
        u.pm = fm + ((wgid % nig) % gsz); u.pn = (wgid % nig) / gsz; return true;
    }
    __device__ __forceinline__ void a_ready(const Unit&) const {}
    __device__ __forceinline__ void done(const Unit&) const {}
};

__device__ __forceinline__ unsigned cvt_pk_bf16(float lo, float hi) { unsigned r; asm volatile("v_cvt_pk_bf16_f32 %0, %1, %2" : "=v"(r) : "v"(lo), "v"(hi)); return r; }
typedef float f32x2 __attribute__((ext_vector_type(2)));
__device__ __forceinline__ f32x2 gelu_pk(f32x2 v) {
    const f32x2 av = __builtin_elementwise_abs(v), d = av * 0.2316418882f + 1.0f;
    f32x2 t; t.x = __builtin_amdgcn_rcpf(d.x); t.y = __builtin_amdgcn_rcpf(d.y);
    f32x2 q = t * 0.5307027145f + (-0.7265760135f); q = q * t + 0.7107068705f; q = q * t + (-0.142248368f); q = q * t + 0.127414796f; q = q * t;
    const f32x2 s = (v * v) * (-0.72134752044f);
    f32x2 e; e.x = __builtin_amdgcn_exp2f(s.x); e.y = __builtin_amdgcn_exp2f(s.y);
    const f32x2 m = v * (q * e), r = v - m;
    f32x2 o; o.x = v.x < 0.f ? m.x : r.x; o.y = v.y < 0.f ? m.y : r.y; return o;
}

template <int ACT  > struct EpiBf16 {
    static constexpr bool PERM = true, AFTER_DRAIN = false; static_assert(ACT == 0 || ACT == 1, "EpiBf16: ACT is 0 (none) or 1 (gelu_pk)");
    bf16_t* O; int ldc; const float* bias; int split_cols; size_t split_stride; float scale0;
    __device__ __forceinline__ void operator()(const f32x4 (&acc)[2][2][4][2], const Unit& u, int wr, int wc, int fr, int fq) const {
        const int row0 = u.pm * BM + wr * 64 + fr; int colt = u.pn * BM; bf16_t* base = O;
        float sc = 1.f; if (split_cols) { const int t = colt / split_cols; base += (size_t)t * split_stride; colt -= t * split_cols; if (t == 0) sc = scale0; }
        const int col0 = colt + wc * 32 + 8 * fq, bcol0 = u.pn * BM + wc * 32 + 8 * fq;
        f32x4 bv[2][2];
#pragma unroll
        for (int bj = 0; bj < 2; ++bj)
#pragma unroll
            for (int n = 0; n < 2; ++n) bv[bj][n] = bias ? *(const f32x4*)(bias + bcol0 + bj * HALF + 4 * n) : (f32x4){0.f, 0.f, 0.f, 0.f};
#pragma unroll
        for (int ai = 0; ai < 2; ++ai)
#pragma unroll
            for (int m = 0; m < 4; ++m) { bf16_t* rowp = base + (size_t)(row0 + ai * HALF + m * 16) * ldc + col0;
#pragma unroll
                for (int bj = 0; bj < 2; ++bj) { f32x4 v0 = acc[ai][bj][m][0] + bv[bj][0], v1 = acc[ai][bj][m][1] + bv[bj][1];
                    if (ACT == 1) { f32x2 a = gelu_pk((f32x2){v0[0], v0[1]}), b = gelu_pk((f32x2){v0[2], v0[3]}), c = gelu_pk((f32x2){v1[0], v1[1]}), d = gelu_pk((f32x2){v1[2], v1[3]});
                        v0 = (f32x4){a.x, a.y, b.x, b.y}; v1 = (f32x4){c.x, c.y, d.x, d.y}; }
                    v0 = v0 * sc; v1 = v1 * sc; u32x4 w; w.x = cvt_pk_bf16(v0[0], v0[1]); w.y = cvt_pk_bf16(v0[2], v0[3]); w.z = cvt_pk_bf16(v1[0], v1[1]); w.w = cvt_pk_bf16(v1[2], v1[3]);
                    *(u32x4*)(rowp + bj * HALF) = w; } }
    }
};

struct PanelStats {
    unsigned* xbuf;
    unsigned* cnt;
    unsigned* tmo;
    int ntn; float eps;
    unsigned code;
    __device__ __forceinline__ bool run(const f32x4 (&v)[2][2][4][2], const Unit& u, int wr, int wc, int fr, int fq, PG8_LAS unsigned char* lds, int wid, int lane) const {
        typedef float f32x2v __attribute__((ext_vector_type(2)));
        PG8_LAS f32x2v* P = (PG8_LAS f32x2v*)lds;
        PG8_LAS f32x2v* S = (PG8_LAS f32x2v*)(lds + 8192);
        PG8_LAS unsigned* flag = (PG8_LAS unsigned*)(lds + 8192 + 2048);
#pragma unroll
        for (int ai = 0; ai < 2; ++ai)
#pragma unroll
            for (int m = 0; m < 4; ++m) {
                float s = 0.f;
#pragma unroll
                for (int bj = 0; bj < 2; ++bj)
#pragma unroll
                    for (int n = 0; n < 2; ++n) { const f32x4 x = v[ai][bj][m][n]; s += (x[0] + x[1]) + (x[2] + x[3]); }
                s += __shfl_xor(s, 16); s += __shfl_xor(s, 32);
                const float mw = s * (1.0f / 64.0f); float q = 0.f;
#pragma unroll
                for (int bj = 0; bj < 2; ++bj)
#pragma unroll
                    for (int n = 0; n < 2; ++n) { const f32x4 d = v[ai][bj][m][n] - mw; q += (d[0] * d[0] + d[1] * d[1]) + (d[2] * d[2] + d[3] * d[3]); }
                q += __shfl_xor(q, 16); q += __shfl_xor(q, 32);
                if (fq == 0) P[(ai * HALF + wr * 64 + m * 16 + fr) * 4 + wc] = (f32x2v){mw, q};
            }
        asm volatile("s_waitcnt lgkmcnt(0)" ::: "memory"); __builtin_amdgcn_s_barrier(); asm volatile("" ::: "memory");
#if defined(BROKEN_EXCHANGE_NO_WAIT)
#warning BROKEN CONTROL BUILD: the row-statistics exchange does not wait; results are wrong by design
        if (blockIdx.x >= 64) { const long long t0_ = clock64(); while (clock64() - t0_ < 60000) __builtin_amdgcn_s_sleep(8); }
#endif
        const int row = wid * 32 + (lane & 31);
        if (lane < 32) {
            const f32x2v a = P[row * 4 + 0], b = P[row * 4 + 1], c = P[row * 4 + 2], d = P[row * 4 + 3];
            const float mt = (a.x + b.x + c.x + d.x) * 0.25f;
            const float da = a.x - mt, db = b.x - mt, dc = c.x - mt, dd = d.x - mt;
            const float m2 = (a.y + b.y) + (c.y + d.y) + 64.0f * ((da * da + db * db) + (dc * dc + dd * dd));
            unsigned long long* slot = (unsigned long long*)xbuf + ((size_t)(u.pm * BM + row) * 4 + u.pn);
            __hip_atomic_store(slot, ((unsigned long long)__float_as_uint(m2) << 32) | __float_as_uint(mt), __ATOMIC_RELAXED, __HIP_MEMORY_SCOPE_AGENT);
        }
        asm volatile("s_waitcnt vmcnt(0)" ::: "memory");
        if (lane == 0) __hip_atomic_fetch_add(cnt + 64 * u.pm, 1u, __ATOMIC_RELAXED, __HIP_MEMORY_SCOPE_AGENT);
        if (wid == 0) {
            bool dead = false; const unsigned long long t0 = __builtin_amdgcn_s_memrealtime(); const unsigned want = 8u * (unsigned)ntn;
            for (;;) {
#if defined(BROKEN_EXCHANGE_NO_WAIT)
                break;
#endif
                if ((unsigned)__builtin_amdgcn_readfirstlane(__hip_atomic_load(cnt + 64 * u.pm, __ATOMIC_RELAXED, __HIP_MEMORY_SCOPE_AGENT)) >= want) break;
                if (__builtin_amdgcn_s_memrealtime() - t0 > 2000000ull) {
                    if (lane == 0) { unsigned expect = 0u; __hip_atomic_compare_exchange_strong(tmo + 1, &expect, code | (unsigned)(u.pm & 0xff), __ATOMIC_RELAXED, __ATOMIC_RELAXED, __HIP_MEMORY_SCOPE_AGENT);
                                     __hip_atomic_store(tmo, 1u, __ATOMIC_RELAXED, __HIP_MEMORY_SCOPE_AGENT); }
                    dead = true; break; }
                __builtin_amdgcn_s_sleep(2);
            }
            __builtin_amdgcn_fence(__ATOMIC_ACQUIRE, "agent");
            if (lane == 0) flag[0] = dead ? 1u : 0u;
        }
        asm volatile("s_waitcnt vmcnt(0) lgkmcnt(0)" ::: "memory"); __builtin_amdgcn_s_barrier(); asm volatile("" ::: "memory");
        const bool bad = flag[0] != 0u;
        if (lane < 32) {
            const unsigned long long* slot = (const unsigned long long*)xbuf + (size_t)(u.pm * BM + row) * 4; float mt[4], m2[4]; float ms = 0.f;
#pragma unroll
            for (int t = 0; t < 4; ++t) { if (t < ntn) { const unsigned long long w = __hip_atomic_load(slot + t, __ATOMIC_RELAXED, __HIP_MEMORY_SCOPE_AGENT); mt[t] = __uint_as_float((unsigned)w); m2[t] = __uint_as_float((unsigned)(w >> 32)); } else { mt[t] = 0.f; m2[t] = 0.f; } ms += mt[t]; }
            const float mean = ms / (float)ntn; float q = 0.f;
#pragma unroll
            for (int t = 0; t < 4; ++t) if (t < ntn) { const float dm = mt[t] - mean; q += m2[t] + 256.0f * dm * dm; }
            S[row] = (f32x2v){mean, 1.0f / sqrtf(q / (256.0f * (float)ntn) + eps)};
        }
        asm volatile("s_waitcnt lgkmcnt(0)" ::: "memory"); __builtin_amdgcn_s_barrier(); asm volatile("" ::: "memory");
        return bad;
    }
};
struct EpiLnRes {
    static constexpr bool PERM = false, AFTER_DRAIN = true;
    const float* base; float* out; int ldc; const float* bias; PanelStats st; unsigned poison;
    __device__ __forceinline__ void fused(f32x4 (&acc)[2][2][4][2], const Unit& u, int wr, int wc, int fr, int fq, PG8_LAS unsigned char* lds, int wid, int lane) const {
        typedef float f32x2v __attribute__((ext_vector_type(2)));
        const PG8_LAS f32x2v* S = (const PG8_LAS f32x2v*)(lds + 8192);
        const int col0 = u.pn * BM + wc * 32 + 4 * fq;
#pragma unroll
        for (int bj = 0; bj < 2; ++bj)
#pragma unroll
            for (int n = 0; n < 2; ++n) { const f32x4 bv = bias ? *(const f32x4*)(bias + col0 + bj * HALF + n * 16) : (f32x4){0.f, 0.f, 0.f, 0.f};
#pragma unroll
                for (int ai = 0; ai < 2; ++ai)
#pragma unroll
                    for (int m = 0; m < 4; ++m) acc[ai][bj][m][n] += bv; }
        f32x4 pre[4][2][2];
#pragma unroll
        for (int m = 0; m < 4; ++m) { const size_t off = (size_t)(u.pm * BM + wr * 64 + m * 16 + fr) * ldc + col0;
#pragma unroll
            for (int bj = 0; bj < 2; ++bj)
#pragma unroll
                for (int n = 0; n < 2; ++n) pre[m][bj][n] = *(const f32x4*)(base + off + bj * HALF + n * 16); }
        const bool bad = st.run(acc, u, wr, wc, fr, fq, lds, wid, lane) || poison != 0u;
        const float qnan = __builtin_nanf("");
#pragma unroll
        for (int ai = 0; ai < 2; ++ai)
#pragma unroll
            for (int m = 0; m < 4; ++m) { const int r = ai * HALF + wr * 64 + m * 16 + fr; const f32x2v sr = S[r]; const size_t off = (size_t)(u.pm * BM + r) * ldc + col0;
#pragma unroll
                for (int bj = 0; bj < 2; ++bj)
#pragma unroll
                    for (int n = 0; n < 2; ++n) { const f32x4 bs = ai == 0 ? pre[m][bj][n] : *(const f32x4*)(base + off + bj * HALF + n * 16); f32x4 o = bs + (acc[ai][bj][m][n] - sr.x) * sr.y;
                        if (bad) o = (f32x4){qnan, qnan, qnan, qnan}; *(f32x4*)(out + off + bj * HALF + n * 16) = o; }
                if (m & 1) asm volatile("" ::: "memory"); }
    }
};
struct EpiLnResLn {
    static constexpr bool PERM = false, AFTER_DRAIN = true;
    const float* base; float* out; bf16_t* xn; int ldc; const float* bias; PanelStats st1, st2; unsigned poison;
    __device__ __forceinline__ void fused(f32x4 (&acc)[2][2][4][2], const Unit& u, int wr, int wc, int fr, int fq, PG8_LAS unsigned char* lds, int wid, int lane) const {
        typedef float f32x2v __attribute__((ext_vector_type(2))); typedef unsigned u32x2v __attribute__((ext_vector_type(2)));
        const PG8_LAS f32x2v* S = (const PG8_LAS f32x2v*)(lds + 8192);
        const int col0 = u.pn * BM + wc * 32 + 4 * fq;
#pragma unroll
        for (int bj = 0; bj < 2; ++bj)
#pragma unroll
            for (int n = 0; n < 2; ++n) { const f32x4 bv = bias ? *(const f32x4*)(bias + col0 + bj * HALF + n * 16) : (f32x4){0.f, 0.f, 0.f, 0.f};
#pragma unroll
                for (int ai = 0; ai < 2; ++ai)
#pragma unroll
                    for (int m = 0; m < 4; ++m) acc[ai][bj][m][n] += bv; }
        bool bad = st1.run(acc, u, wr, wc, fr, fq, lds, wid, lane) || poison != 0u;
        const float qnan = __builtin_nanf("");
#pragma unroll
        for (int ai = 0; ai < 2; ++ai)
#pragma unroll
            for (int m = 0; m < 4; ++m) { const int r = ai * HALF + wr * 64 + m * 16 + fr; const f32x2v sr = S[r]; const size_t off = (size_t)(u.pm * BM + r) * ldc + col0;
#pragma unroll
                for (int bj = 0; bj < 2; ++bj)
#pragma unroll
                    for (int n = 0; n < 2; ++n) { const f32x4 bs = *(const f32x4*)(base + off + bj * HALF + n * 16); acc[ai][bj][m][n] = bs + (acc[ai][bj][m][n] - sr.x) * sr.y; }
                asm volatile("" : "+v"(acc[ai][0][m][0]), "+v"(acc[ai][0][m][1]), "+v"(acc[ai][1][m][0]), "+v"(acc[ai][1][m][1]));
                if (m & 1) asm volatile("" ::: "memory"); }
        const bool bad1 = bad;
        bad = st2.run(acc, u, wr, wc, fr, fq, lds, wid, lane) || bad;
#pragma unroll
        for (int ai = 0; ai < 2; ++ai)
#pragma unroll
            for (int m = 0; m < 4; ++m) { const int r = ai * HALF + wr * 64 + m * 16 + fr; const f32x2v sr = S[r]; const size_t off = (size_t)(u.pm * BM + r) * ldc + col0;
#pragma unroll
                for (int bj = 0; bj < 2; ++bj)
#pragma unroll
                    for (int n = 0; n < 2; ++n) { const f32x4 x1 = acc[ai][bj][m][n]; *(f32x4*)(out + off + bj * HALF + n * 16) = bad1 ? (f32x4){qnan, qnan, qnan, qnan} : x1;
                        const f32x4 o = (x1 - sr.x) * sr.y; u32x2v w; w.x = cvt_pk_bf16(o[0], o[1]); w.y = cvt_pk_bf16(o[2], o[3]);
                        if (bad) { w.x = 0x7fc07fc0u; w.y = 0x7fc07fc0u; } *(u32x2v*)(xn + off + bj * HALF + n * 16) = w; }
                asm volatile("" ::: "memory"); }
    }
};

template <class Epi, class Sched, bool ALIGN_EPI = false, bool SP2 = false>
__device__ __forceinline__ void gemm_phase(PG8_LAS unsigned char* lds, const Gemm g, const Sched& S, const Epi& E) {
    const int tid = tidx(), wid = __builtin_amdgcn_readfirstlane(tid >> 6), lane = tid & 63, wr = wid >> 2, wc = wid & 3, fr = lane & 15, fq = lane >> 4;
    const int K = g.K, nt = K / BK;
    unsigned voffA[2], voffB[2];
#pragma unroll
    for (int i = 0; i < 2; ++i) { int R, C; stage_rc(tid * 16 + i * 8192, R, C); const int Rb = Epi::PERM ? ((R & ~31) + perm32(R & 31)) : R;
        voffA[i] = (unsigned)(R * K + C) * 2u; voffB[i] = (unsigned)(Rb * K + C) * 2u; }
    const size_t kstep = (size_t)(BK * 2);
    const size_t hstep = (size_t)HALF * K * 2;
    const size_t tstep = 2 * hstep;
    const unsigned ldsw = (unsigned)wid * 1024u;
    const int aoff = lds_byte(wr * 64 + fr, fq * 8), boff = lds_byte(wc * 32 + fr, fq * 8);
#define PG8_SA(b, h) (((b) * 2 + (h)) * HTB)
#define PG8_SB(b, h) ((4 + (b) * 2 + (h)) * HTB)
#define PG8_STAGE(bufoff, gbase, voff) do { _Pragma("unroll") for (int _i = 0; _i < 2; ++_i) \
        __builtin_amdgcn_global_load_lds((const unsigned*)((const char*)(gbase) + (voff)[_i]), (PG8_LAS unsigned*)(lds + (bufoff) + ldsw + _i * 8192), 16, 0, 0); } while (0)
#define PG8_LDA(dst, b, h) do { _Pragma("unroll") for (int m = 0; m < 4; ++m) _Pragma("unroll") for (int k = 0; k < 2; ++k) dst[m][k] = *(const PG8_LAS bf16x8*)(lds + PG8_SA(b, h) + aoff + m * 2048 + k * 1024); } while (0)
#define PG8_LDB(dst, b, h) do { _Pragma("unroll") for (int n = 0; n < 2; ++n) _Pragma("unroll") for (int k = 0; k < 2; ++k) dst[n][k] = *(const PG8_LAS bf16x8*)(lds + PG8_SB(b, h) + boff + n * 2048 + k * 1024); } while (0)
#define PG8_MMA(ai, bj, At, Bt) do { __builtin_amdgcn_s_setprio(1); _Pragma("unroll") for (int m = 0; m < 4; ++m) _Pragma("unroll") for (int n = 0; n < 2; ++n) _Pragma("unroll") for (int k = 0; k < 2; ++k) \
        acc[ai][bj][m][n] = __builtin_amdgcn_mfma_f32_16x16x32_bf16(Bt[n][k], At[m][k], acc[ai][bj][m][n], 0, 0, 0); __builtin_amdgcn_s_setprio(0); } while (0)
#define PG8_WAIT_V(n) asm volatile("s_waitcnt vmcnt(" #n ")" ::: "memory")
#define PG8_WAIT_L(n) asm volatile("s_waitcnt lgkmcnt(" #n ")" ::: "memory")
#define PG8_BAR __builtin_amdgcn_s_barrier()
#define PG8_SCHED __builtin_amdgcn_sched_barrier(0)
    Unit cur, nxt; int ui = 0;
    if (!S.next(0, cur)) return;
    f32x4 acc[2][2][4][2];
#pragma unroll
    for (int a = 0; a < 2; ++a)
#pragma unroll
        for (int b = 0; b < 2; ++b)
#pragma unroll
            for (int m = 0; m < 4; ++m)
#pragma unroll
                for (int n = 0; n < 2; ++n) acc[a][b][m][n] = (f32x4){0.f, 0.f, 0.f, 0.f};
    bf16x8 At[4][2], B0[2][2], B1[2][2];
    const char* cA = (const char*)g.A + (size_t)cur.pm * tstep; const char* cB = (const char*)g.Bt + (size_t)cur.pn * tstep;
    S.a_ready(cur);
    if constexpr (SP2) {
        PG8_STAGE(PG8_SB(0, 0), cB, voffB); PG8_STAGE(PG8_SB(0, 1), cB + hstep, voffB); PG8_STAGE(PG8_SA(0, 0), cA, voffA); PG8_STAGE(PG8_SA(0, 1), cA + hstep, voffA);
        if (wr == 1) PG8_BAR;
        PG8_WAIT_V(2); PG8_BAR;
        PG8_STAGE(PG8_SB(1, 0), cB + kstep, voffB); PG8_STAGE(PG8_SA(1, 0), cA + kstep, voffA); PG8_STAGE(PG8_SB(1, 1), cB + hstep + kstep, voffB);
        PG8_WAIT_V(6); PG8_BAR;
    } else {
        PG8_STAGE(PG8_SB(0, 0), cB, voffB); PG8_STAGE(PG8_SA(0, 0), cA, voffA); PG8_STAGE(PG8_SB(0, 1), cB + hstep, voffB); PG8_STAGE(PG8_SA(0, 1), cA + hstep, voffA);
        if (wr == 1) PG8_BAR;
        PG8_WAIT_V(4); PG8_BAR;
        PG8_STAGE(PG8_SB(1, 0), cB + kstep, voffB); PG8_STAGE(PG8_SA(1, 0), cA + kstep, voffA); PG8_STAGE(PG8_SB(1, 1), cB + hstep + kstep, voffB);
        PG8_WAIT_V(6); PG8_BAR;
    }
    for (;;) {
        const bool has_next = S.next(ui + 1, nxt);
        const char* nA = has_next ? (const char*)g.A + (size_t)nxt.pm * tstep : cA; const char* nB = has_next ? (const char*)g.Bt + (size_t)nxt.pn * tstep : cB;
        for (int t = 0; t < nt; t += 2) {
            const bool last = (t == nt - 2);
            const char* a1 = cA + (size_t)(t + 1) * kstep;
            const char* a2 = last ? nA : cA + (size_t)(t + 2) * kstep; const char* b2 = last ? nB : cB + (size_t)(t + 2) * kstep;
            const char* a3 = a2 + kstep; const char* b3 = b2 + kstep;
            if (last && has_next) S.a_ready(nxt);
            if constexpr (SP2) {
            PG8_LDB(B0, 0, 0); PG8_LDB(B1, 0, 1); PG8_SCHED; PG8_LDA(At, 0, 0); PG8_STAGE(PG8_SA(1, 1), a1 + hstep, voffA);
            PG8_WAIT_V(8); PG8_WAIT_L(0); PG8_BAR; PG8_MMA(0, 0, At, B0); PG8_MMA(0, 1, At, B1); PG8_BAR; PG8_SCHED;
            PG8_LDA(At, 0, 1); PG8_STAGE(PG8_SB(0, 0), b2, voffB); PG8_STAGE(PG8_SB(0, 1), b2 + hstep, voffB); PG8_STAGE(PG8_SA(0, 0), a2, voffA);
            PG8_WAIT_V(8); PG8_WAIT_L(0); PG8_BAR; PG8_MMA(1, 0, At, B0); PG8_MMA(1, 1, At, B1); PG8_BAR; PG8_SCHED;
            PG8_LDB(B0, 1, 0); PG8_LDB(B1, 1, 1); PG8_SCHED; PG8_LDA(At, 1, 0); PG8_STAGE(PG8_SA(0, 1), a2 + hstep, voffA);
            PG8_WAIT_V(8); PG8_WAIT_L(0); PG8_BAR; PG8_MMA(0, 0, At, B0); PG8_MMA(0, 1, At, B1); PG8_BAR; PG8_SCHED;
            PG8_LDA(At, 1, 1); PG8_STAGE(PG8_SB(1, 0), b3, voffB); PG8_STAGE(PG8_SB(1, 1), b3 + hstep, voffB); PG8_STAGE(PG8_SA(1, 0), a3, voffA);
            PG8_WAIT_V(8); PG8_WAIT_L(0); PG8_BAR; PG8_MMA(1, 0, At, B0); PG8_MMA(1, 1, At, B1); PG8_BAR; PG8_SCHED;
            } else {
            PG8_LDB(B0, 0, 0); PG8_SCHED; PG8_LDA(At, 0, 0); PG8_STAGE(PG8_SA(1, 1), a1 + hstep, voffA);
            PG8_WAIT_L(8); PG8_BAR; PG8_WAIT_L(0); PG8_MMA(0, 0, At, B0); PG8_BAR; PG8_SCHED;
            PG8_LDB(B1, 0, 1); PG8_STAGE(PG8_SB(0, 0), b2, voffB);
            PG8_BAR; PG8_WAIT_L(0); PG8_MMA(0, 1, At, B1); PG8_BAR;
            PG8_LDA(At, 0, 1); PG8_STAGE(PG8_SA(0, 0), a2, voffA);
            PG8_BAR; PG8_WAIT_L(0); PG8_MMA(1, 0, At, B0); PG8_BAR; PG8_SCHED;
            PG8_STAGE(PG8_SB(0, 1), b2 + hstep, voffB);
            PG8_WAIT_V(6); PG8_BAR; PG8_MMA(1, 1, At, B1); PG8_BAR;
            PG8_LDB(B0, 1, 0); PG8_SCHED; PG8_LDA(At, 1, 0); PG8_STAGE(PG8_SA(0, 1), a2 + hstep, voffA);
            PG8_WAIT_L(8); PG8_BAR; PG8_WAIT_L(0); PG8_MMA(0, 0, At, B0); PG8_BAR; PG8_SCHED;
            PG8_LDB(B1, 1, 1); PG8_STAGE(PG8_SB(1, 0), b3, voffB);
            PG8_BAR; PG8_WAIT_L(0); PG8_MMA(0, 1, At, B1); PG8_BAR;
            PG8_LDA(At, 1, 1); PG8_STAGE(PG8_SA(1, 0), a3, voffA);
            PG8_BAR; PG8_WAIT_L(0); PG8_MMA(1, 0, At, B0); PG8_BAR; PG8_SCHED;
            PG8_STAGE(PG8_SB(1, 1), b3 + hstep, voffB);
            PG8_WAIT_V(6); PG8_BAR; PG8_MMA(1, 1, At, B1); PG8_BAR;
            }
        }
        if constexpr (ALIGN_EPI) { if (wr == 0) PG8_BAR; }
        if constexpr (!Epi::AFTER_DRAIN) { E(acc, cur, wr, wc, fr, fq); S.done(cur); }
        if (!has_next) break;
#pragma unroll
        for (int a = 0; a < 2; ++a)
#pragma unroll
            for (int b = 0; b < 2; ++b)
#pragma unroll
                for (int m = 0; m < 4; ++m)
#pragma unroll
                    for (int n = 0; n < 2; ++n) acc[a][b][m][n] = (f32x4){0.f, 0.f, 0.f, 0.f};
        cur = nxt; cA = nA; cB = nB; ++ui;
        if constexpr (ALIGN_EPI) { if (wr == 1) PG8_BAR; }
    }
    PG8_WAIT_V(0);
    if constexpr (!ALIGN_EPI) { if (wr == 0) PG8_BAR; }
    PG8_BAR;
    if constexpr (Epi::AFTER_DRAIN) { E.fused(acc, cur, wr, wc, fr, fq, lds, wid, lane); S.done(cur); }
#undef PG8_SA
#undef PG8_SB
#undef PG8_STAGE
#undef PG8_LDA
#undef PG8_LDB
#undef PG8_MMA
#undef PG8_WAIT_V
#undef PG8_WAIT_L
#undef PG8_BAR
#undef PG8_SCHED
}
}
namespace pg8 {
struct EpiF32 {
    static constexpr bool PERM = false, AFTER_DRAIN = false;
    float* C; int ldc; const float* bias;
    __device__ __forceinline__ void operator()(const f32x4 (&acc)[2][2][4][2], const Unit& u, int wr, int wc, int fr, int fq) const {
        const int row0 = u.pm * BM + wr * 64 + fr, col0 = u.pn * BM + wc * 32 + 4 * fq;
        f32x4 bv[2][2];
#pragma unroll
        for (int bj = 0; bj < 2; ++bj)
#pragma unroll
            for (int n = 0; n < 2; ++n) bv[bj][n] = bias ? *(const f32x4*)(bias + col0 + bj * HALF + n * 16) : (f32x4){0.f, 0.f, 0.f, 0.f};
#pragma unroll
        for (int ai = 0; ai < 2; ++ai)
#pragma unroll
            for (int m = 0; m < 4; ++m) { float* rowp = C + (size_t)(row0 + ai * HALF + m * 16) * ldc + col0;
#pragma unroll
                for (int bj = 0; bj < 2; ++bj)
#pragma unroll
                    for (int n = 0; n < 2; ++n) *(f32x4*)(rowp + bj * HALF + n * 16) = acc[ai][bj][m][n] + bv[bj][n]; }
    }
};
}
#define XB_TMO      128
#define XB_XCNT(j)  (256  + 64 * (j))
#define XB_XSUB(j)  (1280 + 64 * (j))
#define XB_XGEN(j)  (2304 + 64 * (j))
#define XB_TOP      3328
#define XB_TOPGEN   3392
#define XCD_BAR_WORDS 3456
#define XB_SPIN_CAP (1u << 18)

__device__ __forceinline__ unsigned xb_ld(unsigned* p)              { return __hip_atomic_load(p, __ATOMIC_RELAXED, __HIP_MEMORY_SCOPE_AGENT); }
__device__ __forceinline__ unsigned xb_add(unsigned* p, unsigned v) { return __hip_atomic_fetch_add(p, v, __ATOMIC_RELAXED, __HIP_MEMORY_SCOPE_AGENT); }
__device__ __forceinline__ unsigned xb_xcc_id() { return (unsigned)__builtin_amdgcn_s_getreg((3 << 11) | 20) & 0xFu; }
#define XB_SPIN(cond, bar) do { unsigned _sp = 0; while (cond) { __builtin_amdgcn_s_sleep(1); \
    if ((++_sp & 255u) == 0u) { if (xb_ld(&(bar)[XB_TMO])) break; if (_sp > XB_SPIN_CAP) { atomicAdd(&(bar)[XB_TMO], 1u); break; } } } } while (0)

struct XcdBarrier {
    unsigned* bar; unsigned x;
    volatile LAS unsigned* st;
};

__device__ __forceinline__ XcdBarrier xcd_barrier_post(unsigned* bar, volatile LAS unsigned* st) {
    XcdBarrier b; b.bar = bar; b.x = xb_xcc_id(); b.st = st;
    if (threadIdx.x == 0) (void)xb_add(&bar[XB_XCNT(b.x)], 1u);
    return b;
}
__device__ __forceinline__ void xcd_barrier_complete(unsigned* bar, unsigned x, unsigned& nloc, unsigned& nx) {
    const unsigned G = gridDim.x * gridDim.y * gridDim.z;
    unsigned sum, cnt, mine, sp = 0u;
    for (;;) {
        sum = 0u; cnt = 0u; mine = 0u;
#pragma unroll
        for (unsigned j = 0; j < 16; ++j) { const unsigned c = xb_ld(&bar[XB_XCNT(j)]); sum += c; cnt += (c > 0u) ? 1u : 0u; mine = (j == x) ? c : mine; }
        if (sum == G) break;
        __builtin_amdgcn_s_sleep(1);
        if ((++sp & 255u) == 0u) { if (xb_ld(&bar[XB_TMO])) break; if (sp > XB_SPIN_CAP) { atomicAdd(&bar[XB_TMO], 1u); break; } }
    }
    nloc = mine > 0u ? mine : 1u; nx = cnt > 0u ? cnt : 1u;
}

__device__ __forceinline__ void xcd_barrier(const XcdBarrier& b) {
    asm volatile("s_waitcnt vmcnt(0)" ::: "memory");
    __syncthreads();
    if (threadIdx.x == 0) {
        unsigned* bar = b.bar;
        __builtin_amdgcn_s_waitcnt(0);
        unsigned nloc = b.st[0], nx = b.st[1];
        if (nloc == 0u) { xcd_barrier_complete(bar, b.x, nloc, nx); b.st[0] = nloc; b.st[1] = nx; }
        const unsigned old = xb_add(&bar[XB_XSUB(b.x)], 1u);
        const unsigned gen = old / nloc;
        if (old + 1u == (gen + 1u) * nloc) {
            __builtin_amdgcn_fence(__ATOMIC_RELEASE, "agent");
            asm volatile("s_waitcnt vmcnt(0)" ::: "memory");
            const unsigned og = xb_add(&bar[XB_TOP], 1u);
            const unsigned tg = og / nx;
            if (og + 1u == (tg + 1u) * nx) xb_add(&bar[XB_TOPGEN], 1u);
            else XB_SPIN(xb_ld(&bar[XB_TOPGEN]) == tg, bar);
            __builtin_amdgcn_fence(__ATOMIC_ACQUIRE, "agent");
            xb_add(&bar[XB_XGEN(b.x)], 1u);
            asm volatile("s_waitcnt vmcnt(0)" ::: "memory");
        } else {
            XB_SPIN(xb_ld(&bar[XB_XGEN(b.x)]) == gen, bar);
            __builtin_amdgcn_fence(__ATOMIC_ACQUIRE, "agent");
            asm volatile("s_waitcnt vmcnt(0)" ::: "memory");
        }
    }
    __syncthreads();
}

DEVI float wave_sum(float v) {
#pragma unroll
    for (int o = 32; o > 0; o >>= 1) v += __shfl_xor(v, o, 64);
    return v;
}
DEVI float wave_max(float v) {
#pragma unroll
    for (int o = 32; o > 0; o >>= 1) v = fmaxf(v, __shfl_xor(v, o, 64));
    return v;
}
DEVI float sigm(float x) { return 1.f / (1.f + expf(-x)); }
DEVI float gelu_t(float x) { return 0.5f * x * (1.f + tanhf(0.7978845608028654f * (x + 0.044715f * x * x * x))); }
DEVI float softplus_(float x) { return fmaxf(x, 0.f) + log1pf(expf(-fabsf(x))); }

DEVI float block_sum256(float v, float* red, int tid) {
    v = wave_sum(v);
    __syncthreads();
    if ((tid & 63) == 0) red[tid >> 6] = v;
    __syncthreads();
    return red[0] + red[1] + red[2] + red[3];
}

DEVI void ln_kernel(const float* xres, float alpha, const float* add, const float* __restrict__ g, const float* __restrict__ bt,
                    float* out, bf16* outb, int bid, float* sm) {
    __syncthreads();
    const size_t row = bid;
    const int tid = tidx() & 255;
    float v[4];
#pragma unroll
    for (int i = 0; i < 4; ++i) {
        const size_t idx = row * DM + tid + i * 256;
        v[i] = alpha * xres[idx] + (add ? add[idx] : 0.f);
    }
    const float mean = block_sum256(v[0] + v[1] + v[2] + v[3], sm, tid) * (1.f / DM);
    float q = 0.f;
#pragma unroll
    for (int i = 0; i < 4; ++i) { v[i] -= mean; q += v[i] * v[i]; }
    const float var = block_sum256(q, sm, tid) * (1.f / DM);
    const float rstd = rsqrtf(var + 1e-5f);
#pragma unroll
    for (int i = 0; i < 4; ++i) {
        const int c = tid + i * 256;
        const float o = v[i] * rstd * g[c] + bt[c];
        out[row * DM + c] = o;
        outb[row * DM + c] = (bf16)f2bf(o);
    }
}

struct GemmArgs {
    const float* A; const float* B; float* C; const int* rowidx; const int* zoff;
    long lda, sbk, sbn, ldc, sAz0, sAz1, sBz0, sBz1, sCz0, sCz1;
    int M, N, K, Z1, epi, pad;
};
DEVI void gemm_f32(const GemmArgs& g, int bx, int by, int z, bool live, float* sm) {
    float (*As)[68] = (float (*)[68])sm;
    float (*Bs)[68] = (float (*)[68])(sm + 16 * 68);
    const int z0 = z / g.Z1, z1 = z % g.Z1;
    int mbeg = 0, mend = g.M;
    if (g.zoff) { mbeg = g.zoff[z]; mend = g.zoff[z + 1]; }
    const int m0 = mbeg + by * 64;
    if (!live) mend = 0;
    const int n0 = bx * 64;
    const float* A = g.A + z0 * g.sAz0 + z1 * g.sAz1;
    const float* B = g.B + z0 * g.sBz0 + z1 * g.sBz1;
    float* C = g.C + z0 * g.sCz0 + z1 * g.sCz1;
    const int tid = tidx() & 255, tx = tid & 15, ty = tid >> 4;
    float acc[4][4];
#pragma unroll
    for (int i = 0; i < 4; ++i)
#pragma unroll
        for (int j = 0; j < 4; ++j) acc[i][j] = 0.f;
    long arow[4];
#pragma unroll
    for (int i = 0; i < 4; ++i) {
        const int r = (tid + i * 256) >> 4;
        const int row = m0 + r;
        if (row < mend) arow[i] = (long)(g.rowidx ? g.rowidx[row] : row) * g.lda; else arow[i] = -1;
    }
    __syncthreads();
    for (int k0 = 0; k0 < g.K; k0 += 16) {
#pragma unroll
        for (int i = 0; i < 4; ++i) {
            const int e = tid + i * 256, r = e >> 4, kk = e & 15;
            float v = 0.f;
            if (arow[i] >= 0 && k0 + kk < g.K) v = A[arow[i] + k0 + kk];
            As[kk][r] = v;
        }
#pragma unroll
        for (int i = 0; i < 4; ++i) {
            const int e = tid + i * 256, kk = e >> 6, n = e & 63;
            float v = 0.f;
            if (m0 < mend && n0 + n < g.N && k0 + kk < g.K) v = B[(long)(k0 + kk) * g.sbk + (long)(n0 + n) * g.sbn];
            Bs[kk][n] = v;
        }
        __syncthreads();
#pragma unroll
        for (int kk = 0; kk < 16; ++kk) {
            float a[4], b[4];
#pragma unroll
            for (int i = 0; i < 4; ++i) a[i] = As[kk][ty * 4 + i];
#pragma unroll
            for (int j = 0; j < 4; ++j) b[j] = Bs[kk][tx * 4 + j];
#pragma unroll
            for (int i = 0; i < 4; ++i)
#pragma unroll
                for (int j = 0; j < 4; ++j) acc[i][j] = fmaf(a[i], b[j], acc[i][j]);
        }
        __syncthreads();
    }
#pragma unroll
    for (int i = 0; i < 4; ++i) {
        const int row = m0 + ty * 4 + i;
        if (row >= mend) continue;
#pragma unroll
        for (int j = 0; j < 4; ++j) {
            const int col = n0 + tx * 4 + j;
            if (col >= g.N) continue;
            float* p = C + (long)row * g.ldc + col;
            float v = acc[i][j];
            if (g.epi == 1) { v = v * sigm(v) * (*p); }
            *p = v;
        }
    }
}
DEVI GemmArgs mk(const float* A, long lda, const float* B, long sbk, long sbn, float* C, long ldc, int M, int N, int K,
                 int Z1 = 1, long sAz0 = 0, long sAz1 = 0, long sBz0 = 0, long sBz1 = 0, long sCz0 = 0, long sCz1 = 0,
                 const int* rowidx = nullptr, const int* zoff = nullptr, int epi = 0) {
    GemmArgs g;
    g.A = A; g.B = B; g.C = C; g.rowidx = rowidx; g.zoff = zoff;
    g.lda = lda; g.sbk = sbk; g.sbn = sbn; g.ldc = ldc;
    g.sAz0 = sAz0; g.sAz1 = sAz1; g.sBz0 = sBz0; g.sBz1 = sBz1; g.sCz0 = sCz0; g.sCz1 = sCz1;
    g.M = M; g.N = N; g.K = K; g.Z1 = Z1; g.epi = epi; g.pad = 0;
    return g;
}
DEVI int gemm_tiles(const GemmArgs& g, int maxM, int Z) { return ((g.N + 63) / 64) * ((maxM + 63) / 64) * Z; }
DEVI bool gemm_tile_live(const GemmArgs& g, int maxM, int t) {
    const int nbx = (g.N + 63) / 64, nby = (maxM + 63) / 64;
    const int r = t / nbx, by = r % nby, z = r / nby;
    int mbeg = 0, mend = g.M;
    if (g.zoff) { mbeg = g.zoff[z]; mend = g.zoff[z + 1]; }
    return mbeg + by * 64 < mend;
}
DEVI void gemm_tile(const GemmArgs& g, int maxM, int t, bool live, float* sm) {
    const int nbx = (g.N + 63) / 64, nby = (maxM + 63) / 64;
    const int bx = t % nbx, r = t / nbx;
    gemm_f32(g, bx, r % nby, r / nby, live, sm);
}

DEVI void glu_kernel(const bf16* __restrict__ cols, float* __restrict__ h, int bid) {
    const size_t t = bid; const int c = tidx() & 255;
    h[t * 256 + c] = bf2f(cols[t * DINP + OFF_CV + c]) * sigm(bf2f(cols[t * DINP + OFF_CG + c]));
}
DEVI void conv_kernel(const float* __restrict__ h, const float* __restrict__ w, const float* __restrict__ bias,
                      const float* __restrict__ gg, const float* __restrict__ gb, bf16* __restrict__ mix, int bid) {
    const int t = bid, c = tidx() & 255;
    float acc = bias[c];
#pragma unroll 4
    for (int j = 0; j < 31; ++j) {
        const int tt = t - 30 + j;
        if (tt >= 0) acc = fmaf(h[(size_t)tt * 256 + c], w[j * 256 + c], acc);
    }
    const float mean = wave_sum(acc) * (1.f / 64.f);
    const float d = acc - mean;
    const float var = wave_sum(d * d) * (1.f / 64.f);
    const float y = d * rsqrtf(var + 1e-5f) * gg[c] + gb[c];
    mix[(size_t)t * DM + 0 + c] = (bf16)f2bf(y * sigm(y));
}

DEVI void gmlp_pre(const bf16* __restrict__ cols, const float* __restrict__ lg, const float* __restrict__ lb,
                   float* __restrict__ ub, float* __restrict__ vb, int bid, float* sm) {
    __syncthreads();
    const size_t t = bid; const int c = tidx() & 255;
    ub[t * 256 + c] = gelu_t(bf2f(cols[t * DINP + OFF_GU + c]));
    const float v = gelu_t(bf2f(cols[t * DINP + OFF_GV + c]));
    const float mean = block_sum256(v, sm, c) * (1.f / 256.f);
    const float d = v - mean;
    const float var = block_sum256(d * d, sm, c) * (1.f / 256.f);
    vb[t * 256 + c] = d * rsqrtf(var + 1e-5f) * lg[c] + lb[c];
}
DEVI void gmlp_mix(const float* __restrict__ ub, const float* __restrict__ vb, const float* __restrict__ ws,
                   const float* __restrict__ bs, bf16* __restrict__ mix, int bid) {
    const int t = bid, c = tidx() & 255, h = c >> 6, tt = t & 127, base = t - tt;
    float acc = bs[h * 128 + tt];
    const float* wr = ws + ((size_t)h * 128 + tt) * 128;
#pragma unroll 4
    for (int s = 0; s <= tt; ++s) acc = fmaf(wr[s], vb[(size_t)(base + s) * 256 + c], acc);
    mix[(size_t)t * DM + 512 + c] = (bf16)f2bf(ub[(size_t)t * 256 + c] * acc);
}

struct RwkvP {
    const bf16* cols; const float* mu; const float* w0; const float* w_up; const float* a0; const float* a_up; const float* g_up;
    const float* k_k; const float* k_a; const float* r_k; const float* vd; const float* v_mu; const float* v0; const float* v_up;
    float* vfirst; float* R; float* W; float* K; float* V; float* A; float* Bv; float* G; float* BON;
    int layer, pad;
};
DEVI void rwkv_prep(const RwkvP& p, int bid, float* sm) {
    __syncthreads();
    float* y = sm;
    float* vds = sm + 1024;
    const int t = bid, c = tidx() & 255;
#pragma unroll
    for (int q = 0; q < 4; ++q) {
        const int j = c + q * 256;
        const float cur = bf2f(p.cols[(size_t)t * DINP + OFF_RW + j]);
        const float prv = t > 0 ? bf2f(p.cols[(size_t)(t - 1) * DINP + OFF_RW + j]) : 0.f;
        y[j] = cur + p.mu[j] * (prv - cur);
    }
    if (p.layer > 0 && c < 32) {
        const float cur = p.vd[(size_t)t * 32 + c];
        const float prv = t > 0 ? p.vd[(size_t)(t - 1) * 32 + c] : 0.f;
        vds[c] = cur + p.v_mu[c] * (prv - cur);
    }
    __syncthreads();
    float tw = 0.f, sg = 0.f;
    if (c < 64) tw = tanhf(y[768 + c]);
    if (c >= 128) sg = sigm(y[896 + (c - 128)]);
    __syncthreads();
    if (c < 64) y[768 + c] = tw;
    if (c >= 128) y[896 + (c - 128)] = sg;
    __syncthreads();
    const float r = y[c], k = y[256 + c];
    float v = y[512 + c];
    float wl = p.w0[c], al = p.a0[c], gl = 0.f;
#pragma unroll 4
    for (int j = 0; j < 64; ++j) { wl = fmaf(y[768 + j], p.w_up[j * 256 + c], wl); al = fmaf(y[832 + j], p.a_up[j * 256 + c], al); }
#pragma unroll 4
    for (int j = 0; j < 128; ++j) gl = fmaf(y[896 + j], p.g_up[j * 256 + c], gl);
    const float wlog = -softplus_(-wl) - 0.5f;
    const float decay = expf(-expf(wlog));
    const float a = sigm(al);
    if (p.layer == 0) {
        p.vfirst[(size_t)t * 256 + c] = v;
    } else {
        float vm = p.v0[c];
#pragma unroll 4
        for (int j = 0; j < 32; ++j) vm = fmaf(vds[j], p.v_up[j * 256 + c], vm);
        vm = sigm(vm);
        v = v + (p.vfirst[(size_t)t * 256 + c] - v) * vm;
    }
    float kk = k * p.k_k[c];
    const float nrm = sqrtf(wave_sum(kk * kk));
    kk = kk / fmaxf(nrm, 1e-12f);
    const float k2 = k * (1.f + (a - 1.f) * p.k_a[c]);
    const float bd = wave_sum(r * k2 * p.r_k[c]);
    const size_t o = (size_t)t * 256 + c;
    p.R[o] = r; p.W[o] = decay; p.K[o] = k2; p.V[o] = v; p.A[o] = -kk; p.Bv[o] = kk * a; p.G[o] = gl; p.BON[o] = bd * v;
}
DEVI void rwkv_scan(float* R, const float* __restrict__ W, const float* __restrict__ K, const float* __restrict__ V,
                    const float* __restrict__ A, const float* __restrict__ Bv, float* sm0) {
    float (*sr)[256] = (float (*)[256])sm0, (*sw)[256] = sr + 4, (*sk)[256] = sr + 8, (*sa)[256] = sr + 12, (*sb)[256] = sr + 16, (*sv)[256] = sr + 20;
    const int vt = tidx(); const bool act = vt < 256;
    const int tid = vt & 255, h = tid >> 6, lane = tid & 63;
    float st[64];
#pragma unroll
    for (int i = 0; i < 64; ++i) st[i] = 0.f;
    for (int t0 = 0; t0 < SEQ; t0 += 4) {
        __syncthreads();
        if (act) {
#pragma unroll
            for (int s = 0; s < 4; ++s) {
                const size_t idx = (size_t)(t0 + s) * 256 + tid;
                sr[s][tid] = R[idx]; sw[s][tid] = W[idx]; sk[s][tid] = K[idx]; sa[s][tid] = A[idx]; sb[s][tid] = Bv[idx]; sv[s][tid] = V[idx];
            }
        }
        __syncthreads();
        if (act) {
#pragma unroll 1
            for (int s = 0; s < 4; ++s) {
                const float vt_ = sv[s][tid];
                const float* pa = &sa[s][h * 64]; const float* pw = &sw[s][h * 64]; const float* pb = &sb[s][h * 64];
                const float* pk = &sk[s][h * 64]; const float* pr = &sr[s][h * 64];
                float sa_ = 0.f;
#pragma unroll
                for (int k = 0; k < 64; ++k) sa_ = fmaf(st[k], pa[k], sa_);
#pragma unroll
                for (int k = 0; k < 64; ++k) st[k] = fmaf(st[k], pw[k], fmaf(sa_, pb[k], vt_ * pk[k]));
                float o = 0.f;
#pragma unroll
                for (int k = 0; k < 64; ++k) o = fmaf(st[k], pr[k], o);
                R[(size_t)(t0 + s) * 256 + h * 64 + lane] = o;
            }
        }
    }
    __syncthreads();
}
DEVI void rwkv_post(const float* __restrict__ O, const float* __restrict__ BON, const float* __restrict__ G,
                    const float* __restrict__ gg, const float* __restrict__ gb, bf16* __restrict__ mix, int bid) {
    const size_t t = bid; const int c = tidx() & 255;
    const float o = O[t * 256 + c];
    const float mean = wave_sum(o) * (1.f / 64.f);
    const float d = o - mean;
    const float var = wave_sum(d * d) * (1.f / 64.f);
    const float y = d * rsqrtf(var + 64e-5f) * gg[c] + gb[c];
    mix[t * DM + 256 + c] = (bf16)f2bf((y + BON[t * 256 + c]) * G[t * 256 + c]);
}

DEVI void nsa_prep(const bf16* __restrict__ cols, float* __restrict__ qrot, float* __restrict__ ksr,
                   float* __restrict__ kwr, float* __restrict__ gates, int bid) {
    const int t = bid, c = tidx() & 255;
    const int d = c & 63, j = d & 31;
    const float inv = powf(10000.f, -(float)j / 32.f);
    const float ang = (float)t * inv;
    float sn, cs; sincosf(ang, &sn, &cs);
    {
        const bf16* q = cols + (size_t)t * DINP + OFF_Q + (c & ~63);
        const float x1 = bf2f(q[j]), x2 = bf2f(q[j + 32]);
        qrot[(size_t)t * 256 + c] = d < 32 ? x1 * cs - x2 * sn : x2 * cs + x1 * sn;
    }
    if (c < 128) {
        const bf16* kp = cols + (size_t)t * DINP + (c < 64 ? OFF_KS : OFF_KW);
        const float x1 = bf2f(kp[j]), x2 = bf2f(kp[j + 32]);
        const float v = d < 32 ? x1 * cs - x2 * sn : x2 * cs + x1 * sn;
        if (c < 64) ksr[(size_t)t * 64 + d] = v; else kwr[(size_t)t * 64 + d] = v;
    }
    if (c < 12) gates[(size_t)t * 12 + c] = sigm(bf2f(cols[(size_t)t * DINP + OFF_GT + c]));
}
DEVI void cmp_gather(const bf16* __restrict__ cols, const float* __restrict__ pek, const float* __restrict__ pev,
                     float* __restrict__ bk, float* __restrict__ bv, int bid) {
    const int n = bid, tid = tidx() & 255;
    for (int i = tid; i < 2048; i += 256) {
        const int l = i >> 6, d = i & 63;
        const size_t row = (size_t)(16 * n + l) * DINP;
        bk[(size_t)n * 2048 + i] = bf2f(cols[row + OFF_KC + d]) + pek[i];
        bv[(size_t)n * 2048 + i] = bf2f(cols[row + OFF_VC + d]) + pev[i];
    }
}
DEVI void gelu_inplace(float* p, int n, int bid) {
    const int i = bid * 256 + (tidx() & 255);
    if (i < n) p[i] = gelu_t(p[i]);
}

DEVI void wave_softmax(float* s, int n, int lane) {
    float m = -INFINITY;
    for (int i = lane; i < n; i += 64) m = fmaxf(m, s[i]);
    m = wave_max(m);
    if (m == -INFINITY) { for (int i = lane; i < n; i += 64) s[i] = 0.f; return; }
    float sum = 0.f;
    for (int i = lane; i < n; i += 64) { const float p = expf(s[i] - m); s[i] = p; sum += p; }
    sum = wave_sum(sum);
    const float inv = 1.f / fmaxf(sum, 1e-20f);
    for (int i = lane; i < n; i += 64) s[i] *= inv;
}
DEVI void dot4(const float* q  , const float* __restrict__ krow, float* out4) {
    float a0 = 0.f, a1 = 0.f, a2 = 0.f, a3 = 0.f;
#pragma unroll
    for (int d = 0; d < 64; d += 4) {
        const float4 kv = *(const float4*)(krow + d);
        a0 += q[d] * kv.x + q[d + 1] * kv.y + q[d + 2] * kv.z + q[d + 3] * kv.w;
        a1 += q[64 + d] * kv.x + q[64 + d + 1] * kv.y + q[64 + d + 2] * kv.z + q[64 + d + 3] * kv.w;
        a2 += q[128 + d] * kv.x + q[128 + d + 1] * kv.y + q[128 + d + 2] * kv.z + q[128 + d + 3] * kv.w;
        a3 += q[192 + d] * kv.x + q[192 + d + 1] * kv.y + q[192 + d + 2] * kv.z + q[192 + d + 3] * kv.w;
    }
    out4[0] = a0; out4[1] = a1; out4[2] = a2; out4[3] = a3;
}
DEVI void nsa_attn(const bf16* __restrict__ cols, const float* __restrict__ qrot, const float* __restrict__ ksr,
                   const float* __restrict__ kwr, const float* __restrict__ gates, const float* __restrict__ kcmp,
                   const float* __restrict__ vcmp, bf16* __restrict__ mix, int bid, float* sm) {
    __syncthreads();
    float* q = sm; float* qr = sm + 256;
    float (*sc)[1024] = (float (*)[1024])(sm + 512);
    float* imp = sm + 512 + 4096;
    int* sel = (int*)(sm + 512 + 4096 + 128);
    const int pos = bid, tid = tidx() & 255, h = tid >> 6, lane = tid & 63;
    q[tid] = bf2f(cols[(size_t)pos * DINP + OFF_Q + tid]);
    qr[tid] = qrot[(size_t)pos * 256 + tid];
    __syncthreads();
    int ncv = pos >= 31 ? (pos - 31) / 16 + 1 : 0;
    if (ncv > NCMP) ncv = NCMP;
    for (int n = tid; n < 512; n += 256) {
        if (n < ncv) {
            float d4[4]; dot4(q, kcmp + (size_t)n * 64, d4);
            sc[0][n] = d4[0] * 0.125f; sc[1][n] = d4[1] * 0.125f; sc[2][n] = d4[2] * 0.125f; sc[3][n] = d4[3] * 0.125f;
        } else { sc[0][n] = 0.f; sc[1][n] = 0.f; sc[2][n] = 0.f; sc[3][n] = 0.f; }
    }
    __syncthreads();
    wave_softmax(sc[h], ncv, lane);
    __syncthreads();
    float oc = 0.f;
#pragma unroll 4
    for (int n = 0; n < ncv; ++n) oc = fmaf(sc[h][n], vcmp[(size_t)n * 64 + lane], oc);
    if (tid < 128) {
        const int j = tid;
        auto ps = [&](int n) -> float { return (n >= 0 && n < 512) ? (sc[0][n] + sc[1][n] + sc[2][n] + sc[3][n]) : 0.f; };
        const float v = 0.5f * ps(4 * j - 1) + ps(4 * j) + ps(4 * j + 1) + ps(4 * j + 2) + 0.5f * ps(4 * j + 3);
        const int cur = pos >> 6;
        float key;
        if (j == cur || j == 0) key = INFINITY; else if (j <= cur) key = v; else key = -1.f;
        imp[j] = key;
    }
    __syncthreads();
    if (h == 0) {
        float v0 = imp[lane], v1 = imp[lane + 64];
        for (int r = 0; r < 16; ++r) {
            float bv; int bi;
            if (v1 > v0) { bv = v1; bi = lane + 64; } else { bv = v0; bi = lane; }
#pragma unroll
            for (int o = 32; o > 0; o >>= 1) {
                const float ov = __shfl_xor(bv, o, 64); const int oi = __shfl_xor(bi, o, 64);
                if (ov > bv || (ov == bv && oi < bi)) { bv = ov; bi = oi; }
            }
            if (lane == 0) sel[r] = bi;
            if (bi == lane) v0 = -2.f;
            if (bi == lane + 64) v1 = -2.f;
        }
    }
    __syncthreads();
    for (int i = tid; i < 1024; i += 256) {
        const int kp = sel[i >> 6] * 64 + (i & 63);
        if (kp <= pos) {
            float d4[4]; dot4(qr, ksr + (size_t)kp * 64, d4);
            sc[0][i] = d4[0] * 0.125f; sc[1][i] = d4[1] * 0.125f; sc[2][i] = d4[2] * 0.125f; sc[3][i] = d4[3] * 0.125f;
        } else { sc[0][i] = -INFINITY; sc[1][i] = -INFINITY; sc[2][i] = -INFINITY; sc[3][i] = -INFINITY; }
    }
    __syncthreads();
    wave_softmax(sc[h], 1024, lane);
    __syncthreads();
    float os = 0.f;
#pragma unroll 2
    for (int i = 0; i < 1024; ++i) {
        const float p = sc[h][i];
        if (p != 0.f) { const int kp = sel[i >> 6] * 64 + (i & 63); os = fmaf(p, bf2f(cols[(size_t)kp * DINP + OFF_VS + lane]), os); }
    }
    __syncthreads();
    for (int i = tid; i < 512; i += 256) {
        const int kp = pos - 511 + i;
        if (kp >= 0) {
            float d4[4]; dot4(qr, kwr + (size_t)kp * 64, d4);
            sc[0][i] = d4[0] * 0.125f; sc[1][i] = d4[1] * 0.125f; sc[2][i] = d4[2] * 0.125f; sc[3][i] = d4[3] * 0.125f;
        } else { sc[0][i] = -INFINITY; sc[1][i] = -INFINITY; sc[2][i] = -INFINITY; sc[3][i] = -INFINITY; }
    }
    __syncthreads();
    wave_softmax(sc[h], 512, lane);
    __syncthreads();
    float ow = 0.f;
#pragma unroll 4
    for (int i = 0; i < 512; ++i) {
        const int kp = pos - 511 + i;
        if (kp >= 0) ow = fmaf(sc[h][i], bf2f(cols[(size_t)kp * DINP + OFF_VW + lane]), ow);
    }
    const float* gt = gates + (size_t)pos * 12 + h * 3;
    mix[(size_t)pos * DM + 768 + tid] = (bf16)f2bf(gt[0] * oc + gt[1] * os + gt[2] * ow);
}

DEVI void softmax256(float* s, float scale, int bid, float* sm) {
    __syncthreads();
    const size_t row = bid; const int tid = tidx() & 255;
    const float v = s[row * 256 + tid] * scale;
    float m = wave_max(v);
    if ((tid & 63) == 0) sm[8 + (tid >> 6)] = m;
    __syncthreads();
    m = fmaxf(fmaxf(sm[8], sm[9]), fmaxf(sm[10], sm[11]));
    const float p = expf(v - m);
    const float sum = block_sum256(p, sm, tid);
    s[row * 256 + tid] = p / sum;
}

DEVI void router_kernel(const float* __restrict__ x, const float* __restrict__ rw, const float* __restrict__ rb,
                        int* __restrict__ te, float* __restrict__ tw, int bid, float* sm) {
    __syncthreads();
    float (*part)[16] = (float (*)[16])sm;
    const size_t t = bid; const int tid = tidx() & 255;
    float acc[16];
#pragma unroll
    for (int e = 0; e < 16; ++e) acc[e] = 0.f;
#pragma unroll 1
    for (int i = tid; i < DM; i += 256) {
        const float xv = x[t * DM + i];
#pragma unroll
        for (int e = 0; e < 16; ++e) acc[e] = fmaf(xv, rw[i * 16 + e], acc[e]);
    }
#pragma unroll
    for (int e = 0; e < 16; ++e) acc[e] = wave_sum(acc[e]);
    if ((tid & 63) == 0) {
#pragma unroll
        for (int e = 0; e < 16; ++e) part[tid >> 6][e] = acc[e];
    }
    __syncthreads();
    if (tid == 0) {
        float lg[16], pr[16], sl[16];
        float m = -INFINITY;
#pragma unroll
        for (int e = 0; e < 16; ++e) { lg[e] = part[0][e] + part[1][e] + part[2][e] + part[3][e]; m = fmaxf(m, lg[e]); }
        float sum = 0.f;
#pragma unroll
        for (int e = 0; e < 16; ++e) { pr[e] = expf(lg[e] - m); sum += pr[e]; }
#pragma unroll
        for (int e = 0; e < 16; ++e) { pr[e] /= sum; sl[e] = pr[e] + rb[e]; }
        int bg = 0; float bgs = -INFINITY;
#pragma unroll
        for (int gI = 0; gI < 4; ++gI) {
            float m1 = -INFINITY, m2 = -INFINITY;
#pragma unroll
            for (int j = 0; j < 4; ++j) { const float v = sl[gI * 4 + j]; if (v > m1) { m2 = m1; m1 = v; } else if (v > m2) m2 = v; }
            const float sc = m1 + m2;
            if (sc > bgs) { bgs = sc; bg = gI; }
        }
        int e0 = -1, e1 = -1; float s0 = -INFINITY, s1 = -INFINITY, p0 = 0.f, p1 = 0.f;
#pragma unroll
        for (int e = 0; e < 16; ++e) {
            if ((e >> 2) == bg) {
                const float v = sl[e];
                if (v > s0) { s1 = s0; e1 = e0; p1 = p0; s0 = v; e0 = e; p0 = pr[e]; } else if (v > s1) { s1 = v; e1 = e; p1 = pr[e]; }
            }
        }
        const float wsum = p0 + p1;
        te[t * 2] = e0; te[t * 2 + 1] = e1;
        tw[t * 2] = p0 / wsum; tw[t * 2 + 1] = p1 / wsum;
    }
}
DEVI void moe_lists(const int* __restrict__ te, int* __restrict__ off, int* __restrict__ list, int* __restrict__ slotpos, float* sm0) {
    int* cnt = (int*)sm0;
    int* offs = cnt + 16;
    const int w = tidx() >> 6, lane = tidx() & 63;
    __syncthreads();
    for (int ee = 0; ee < 2; ++ee) {
        const int e = w * 2 + ee;
        int c = 0;
        for (int base = 0; base < NTOK; base += 64) {
            const int tok = base + lane;
            const bool m = (te[tok * 2] == e) || (te[tok * 2 + 1] == e);
            c += __popcll(__ballot(m));
        }
        if (lane == 0) cnt[e] = c;
    }
    __syncthreads();
    if (tidx() == 0) {
        int s = 0;
        for (int i = 0; i < 16; ++i) { offs[i] = s; off[i] = s; s += cnt[i]; }
        offs[16] = s; off[16] = s;
    }
    __syncthreads();
    for (int ee = 0; ee < 2; ++ee) {
        const int e = w * 2 + ee;
        int pos = offs[e];
        for (int base = 0; base < NTOK; base += 64) {
            const int tok = base + lane;
            const int a = te[tok * 2], b = te[tok * 2 + 1];
            const bool m = (a == e) || (b == e);
            const unsigned long long mask = __ballot(m);
            if (m) {
                const int p = pos + __popcll(mask & ((1ull << lane) - 1ull));
                list[p] = tok;
                slotpos[tok * 2 + (a == e ? 0 : 1)] = p;
            }
            pos += __popcll(mask);
        }
    }
    __syncthreads();
}
DEVI void moe_combine_ln(const float* x, const float* __restrict__ Dp, const int* __restrict__ te,
                         const float* __restrict__ tw, const int* __restrict__ slotpos,
                         const float* __restrict__ g, const float* __restrict__ bt, float* out, bf16* outb, int bid, float* sm) {
    __syncthreads();
    const size_t t = bid; const int tid = tidx() & 255;
    int ea = te[t * 2], eb = te[t * 2 + 1];
    float wa = tw[t * 2], wb = tw[t * 2 + 1];
    size_t pa = slotpos[t * 2], pb = slotpos[t * 2 + 1];
    if (eb < ea) { const float tf = wa; wa = wb; wb = tf; const size_t tp = pa; pa = pb; pb = tp; }
    float v[4];
#pragma unroll
    for (int i = 0; i < 4; ++i) {
        const int c = tid + i * 256;
        float y = wa * Dp[pa * DM + c];
        y = y + wb * Dp[pb * DM + c];
        v[i] = ALPHA * x[t * DM + c] + y;
    }
    const float mean = block_sum256(v[0] + v[1] + v[2] + v[3], sm, tid) * (1.f / DM);
    float q = 0.f;
#pragma unroll
    for (int i = 0; i < 4; ++i) { v[i] -= mean; q += v[i] * v[i]; }
    const float var = block_sum256(q, sm, tid) * (1.f / DM);
    const float rstd = rsqrtf(var + 1e-5f);
#pragma unroll
    for (int i = 0; i < 4; ++i) {
        const int c = tid + i * 256;
        const float o = v[i] * rstd * g[c] + bt[c];
        out[t * DM + c] = o;
        outb[t * DM + c] = (bf16)f2bf(o);
    }
}
typedef short bf16x8 __attribute__((ext_vector_type(8)));
typedef short s16x4 __attribute__((ext_vector_type(4)));
typedef float f32x16 __attribute__((ext_vector_type(16)));
typedef float f32x2_t __attribute__((ext_vector_type(2)));
typedef __bf16 bf16x2_t __attribute__((ext_vector_type(2)));
DEVI unsigned cvtpk(float lo, float hi) { f32x2_t v = {lo, hi}; bf16x2_t b = __builtin_convertvector(v, bf16x2_t); return __builtin_bit_cast(unsigned, b); }
constexpr float QSCL = 0.125f * 1.4426950408889634f;

struct NsaP {
    const bf16 *QN, *QR, *KSR, *KWR, *VST, *VWT, *KCMP, *VCMPT;
    const float* GATES;
    bf16* MIX;
};
constexpr int NSA_KT = 0, NSA_VT = 16384, NSA_IA = 32768, NSA_IB = 65536, NSA_SELM = 98304, NSA_UNI = 99328;

DEVI int crow(int r, int hi) { return (r & 3) + 8 * (r >> 2) + 4 * hi; }

DEVI void nsa_ld(v4u& rk, v4u& rv, const bf16* kbase, const bf16* vbase, size_t vstride, int tid) {
    rk = *(const v4u*)((const char*)kbase + tid * 16);
    rv = *(const v4u*)((const char*)(vbase + (size_t)(tid >> 3) * vstride) + (tid & 7) * 16);
}
DEVI void nsa_st(LAS unsigned char* KTb, LAS unsigned char* VTb, const v4u& rk, const v4u& rv, int tid) {
    const int r = tid >> 3, c = tid & 7, off = r * 128 + ((c ^ (r & 7)) << 4);
    *(LAS v4u*)(KTb + off) = rk; *(LAS v4u*)(VTb + off) = rv;
}
DEVI void nsa_qk(f32x16& p0, f32x16& p1, const LAS unsigned char* KTb, const bf16x8 (&qf)[4], int q32, int hi) {
#pragma unroll
    for (int r = 0; r < 16; ++r) { p0[r] = 0.f; p1[r] = 0.f; }
#pragma unroll
    for (int ks = 0; ks < 4; ++ks) {
        const int c = ((2 * ks + hi) ^ (q32 & 7)) << 4;
        const bf16x8 a0 = *(const LAS bf16x8*)(KTb + q32 * 128 + c);
        const bf16x8 a1 = *(const LAS bf16x8*)(KTb + (32 + q32) * 128 + c);
        p0 = __builtin_amdgcn_mfma_f32_32x32x16_bf16(a0, qf[ks], p0, 0, 0, 0);
        p1 = __builtin_amdgcn_mfma_f32_32x32x16_bf16(a1, qf[ks], p1, 0, 0, 0);
    }
}
DEVI void nsa_pv(f32x16 (&o)[2], const LAS unsigned char* VTb, const bf16x8 (&pf)[4], int q32, int hi) {
#pragma unroll
    for (int db = 0; db < 2; ++db) {
        const int d = 32 * db + q32;
        const LAS unsigned char* rowp = VTb + d * 128 + 8 * hi;
#pragma unroll
        for (int s = 0; s < 4; ++s) {
            const s16x4 lo = *(const LAS s16x4*)(rowp + (((2 * s) ^ (d & 7)) << 4));
            const s16x4 h4 = *(const LAS s16x4*)(rowp + (((2 * s + 1) ^ (d & 7)) << 4));
            const bf16x8 a = {lo[0], lo[1], lo[2], lo[3], h4[0], h4[1], h4[2], h4[3]};
            o[db] = __builtin_amdgcn_mfma_f32_32x32x16_bf16(a, pf[s], o[db], 0, 0, 0);
        }
    }
}
DEVI void nsa_pack(bf16x8 (&pf)[4], const f32x16& p0, const f32x16& p1) {
#pragma unroll
    for (int s = 0; s < 2; ++s) {
        unsigned w0[4], w1[4];
#pragma unroll
        for (int j = 0; j < 4; ++j) { w0[j] = cvtpk(p0[8 * s + 2 * j], p0[8 * s + 2 * j + 1]); w1[j] = cvtpk(p1[8 * s + 2 * j], p1[8 * s + 2 * j + 1]); }
        pf[s] = __builtin_bit_cast(bf16x8, (v4u){w0[0], w0[1], w0[2], w0[3]});
        pf[2 + s] = __builtin_bit_cast(bf16x8, (v4u){w1[0], w1[1], w1[2], w1[3]});
    }
}
DEVI void nsa_softmax(f32x16& p0, f32x16& p1, float& m, float& l, f32x16 (&o)[2], bf16x8 (&pf)[4]) {
    float mx = -INFINITY;
#pragma unroll
    for (int r = 0; r < 16; ++r) mx = fmaxf(mx, fmaxf(p0[r], p1[r]));
    mx = fmaxf(mx, __shfl_xor(mx, 32, 64));
    const float mn = fmaxf(m, mx);
    const float ms = (mn == -INFINITY) ? 0.f : mn;
    const float alpha = __builtin_amdgcn_exp2f(m - ms);
    float sum = 0.f;
#pragma unroll
    for (int r = 0; r < 16; ++r) { p0[r] = __builtin_amdgcn_exp2f(p0[r] - ms); p1[r] = __builtin_amdgcn_exp2f(p1[r] - ms); sum += p0[r] + p1[r]; }
    sum += __shfl_xor(sum, 32, 64);
    l = l * alpha + sum; m = mn;
#pragma unroll
    for (int r = 0; r < 16; ++r) { o[0][r] *= alpha; o[1][r] *= alpha; }
    nsa_pack(pf, p0, p1);
}
DEVI void nsa_loadq(bf16x8 (&qf)[4], const bf16* Q, int tq, int head, int hi) {
    const bf16* qp = Q + (size_t)tq * 256 + head * 64 + 8 * hi;
#pragma unroll
    for (int ks = 0; ks < 4; ++ks) qf[ks] = *(const bf16x8*)(qp + 16 * ks);
}

DEVI void nsa_unit(const NsaP& P, int u, LAS unsigned char* lds) {
    const int tid = tidx(), w = tid >> 6, lane = tid & 63, q32 = lane & 31, hi = lane >> 5;
    const int t0 = u * 64, cur = u;
    const int tl = 8 * w + (q32 >> 2), head = q32 & 3, tq = t0 + tl;
    LAS unsigned char* KT = lds + NSA_KT; LAS unsigned char* VT = lds + NSA_VT;
    LAS float* IA = (LAS float*)(lds + NSA_IA); LAS float* IB = (LAS float*)(lds + NSA_IB);
    LAS unsigned* SELM = (LAS unsigned*)(lds + NSA_SELM); LAS unsigned* UNI = (LAS unsigned*)(lds + NSA_UNI);
    __syncthreads();
    for (int i = tid; i < 2 * 64 * 128; i += 512) IA[i] = 0.f;
    if (tid < 4) UNI[tid] = 0u;
    f32x16 acc[2];
#pragma unroll
    for (int r = 0; r < 16; ++r) { acc[0][r] = 0.f; acc[1][r] = 0.f; }
    bf16x8 qf[4], pf[4];
    f32x16 o[2], p0, p1;
    v4u rk, rv;
    const float g_c = P.GATES[(size_t)tq * 12 + head * 3 + 0], g_s = P.GATES[(size_t)tq * 12 + head * 3 + 1], g_w = P.GATES[(size_t)tq * 12 + head * 3 + 2];

    {
        nsa_loadq(qf, P.QN, tq, head, hi);
        const int nlim = tq >= 31 ? (tq - 31) >> 4 : -1;
        const int nmaxu = (t0 + 63 - 31) >> 4;
        const int nct = (nmaxu >> 6) + 1;
        float m = -INFINITY, l = 0.f;
        for (int pass = 0; pass < 2; ++pass) {
#pragma unroll
            for (int r = 0; r < 16; ++r) { o[0][r] = 0.f; o[1][r] = 0.f; }
            const float rl = (pass == 1 && l > 0.f) ? 1.f / l : 0.f;
            nsa_ld(rk, rv, P.KCMP, P.VCMPT, 512, tid);
            __syncthreads();
            nsa_st(KT, VT, rk, rv, tid);
            __syncthreads();
            for (int jt = 0; jt < nct; ++jt) {
                const int buf = jt & 1;
                if (jt + 1 < nct) nsa_ld(rk, rv, P.KCMP + (size_t)(jt + 1) * 64 * 64, P.VCMPT + (jt + 1) * 64, 512, tid);
                nsa_qk(p0, p1, KT + buf * 8192, qf, q32, hi);
                const int nb = jt * 64;
#pragma unroll
                for (int r = 0; r < 16; ++r) { const int n = nb + crow(r, hi); if (n > nlim) p0[r] = -INFINITY; if (n + 32 > nlim) p1[r] = -INFINITY; }
                if (pass == 0) {
                    float mx = -INFINITY;
#pragma unroll
                    for (int r = 0; r < 16; ++r) mx = fmaxf(mx, fmaxf(p0[r], p1[r]));
                    mx = fmaxf(mx, __shfl_xor(mx, 32, 64));
                    const float mn = fmaxf(m, mx), ms = (mn == -INFINITY) ? 0.f : mn;
                    float sum = 0.f;
#pragma unroll
                    for (int r = 0; r < 16; ++r) sum += __builtin_amdgcn_exp2f(p0[r] - ms) + __builtin_amdgcn_exp2f(p1[r] - ms);
                    sum += __shfl_xor(sum, 32, 64);
                    l = l * __builtin_amdgcn_exp2f(m - ms) + sum; m = mn;
                } else {
                    const float ms = (m == -INFINITY) ? 0.f : m;
#pragma unroll
                    for (int r = 0; r < 16; ++r) { p0[r] = __builtin_amdgcn_exp2f(p0[r] - ms) * rl; p1[r] = __builtin_amdgcn_exp2f(p1[r] - ms) * rl; }
#pragma unroll
                    for (int half = 0; half < 2; ++half) {
#pragma unroll
                        for (int g = 0; g < 4; ++g) {
                            const f32x16& pp = half ? p1 : p0;
                            float a = pp[4 * g] + pp[4 * g + 1] + pp[4 * g + 2] + 0.5f * pp[4 * g + 3];
                            float b = 0.5f * pp[4 * g + 3];
                            a += __shfl_xor(a, 1, 64); a += __shfl_xor(a, 2, 64);
                            b += __shfl_xor(b, 1, 64); b += __shfl_xor(b, 2, 64);
                            const int j = (nb + 32 * half + 8 * g + 4 * hi) >> 2;
                            if (head == 0 && j < 128) { IA[tl * 128 + j] = a; IB[tl * 128 + j] = b; }
                        }
                    }
                    nsa_pack(pf, p0, p1);
                    nsa_pv(o, VT + buf * 8192, pf, q32, hi);
                }
                if (jt + 1 < nct) nsa_st(KT + (buf ^ 1) * 8192, VT + (buf ^ 1) * 8192, rk, rv, tid);
                __syncthreads();
            }
        }
#pragma unroll
        for (int r = 0; r < 16; ++r) { acc[0][r] = g_c * o[0][r]; acc[1][r] = g_c * o[1][r]; }
    }
    for (int tt = 0; tt < 8; ++tt) {
        const int tok = 8 * w + tt, tpos = t0 + tok;
        float v[2];
#pragma unroll
        for (int e = 0; e < 2; ++e) {
            const int j = lane + 64 * e;
            const float imp = IA[tok * 128 + j] + (j > 0 ? IB[tok * 128 + j - 1] : 0.f);
            v[e] = (j == cur || j == 0) ? INFINITY : (j <= cur ? imp : -1.f);
        }
        (void)tpos;
        unsigned m0 = 0u, m1 = 0u, m2 = 0u, m3 = 0u;
        for (int r = 0; r < 16; ++r) {
            float bv; int bi;
            if (v[1] > v[0]) { bv = v[1]; bi = lane + 64; } else { bv = v[0]; bi = lane; }
#pragma unroll
            for (int of = 32; of > 0; of >>= 1) {
                const float ov = __shfl_xor(bv, of, 64); const int oi = __shfl_xor(bi, of, 64);
                if (ov > bv || (ov == bv && oi < bi)) { bv = ov; bi = oi; }
            }
            if (bi == lane) v[0] = -2.f;
            if (bi == lane + 64) v[1] = -2.f;
            const unsigned bit = 1u << (bi & 31);
            if ((bi >> 5) == 0) m0 |= bit; else if ((bi >> 5) == 1) m1 |= bit; else if ((bi >> 5) == 2) m2 |= bit; else m3 |= bit;
        }
        if (lane == 0) {
            SELM[tok * 4 + 0] = m0; SELM[tok * 4 + 1] = m1; SELM[tok * 4 + 2] = m2; SELM[tok * 4 + 3] = m3;
            __hip_atomic_fetch_or(&UNI[0], m0, __ATOMIC_RELAXED, __HIP_MEMORY_SCOPE_WORKGROUP); __hip_atomic_fetch_or(&UNI[1], m1, __ATOMIC_RELAXED, __HIP_MEMORY_SCOPE_WORKGROUP); __hip_atomic_fetch_or(&UNI[2], m2, __ATOMIC_RELAXED, __HIP_MEMORY_SCOPE_WORKGROUP); __hip_atomic_fetch_or(&UNI[3], m3, __ATOMIC_RELAXED, __HIP_MEMORY_SCOPE_WORKGROUP);
        }
    }
    __syncthreads();
    {
        nsa_loadq(qf, P.QR, tq, head, hi);
        const unsigned s0 = SELM[tl * 4 + 0], s1 = SELM[tl * 4 + 1], s2 = SELM[tl * 4 + 2], s3 = SELM[tl * 4 + 3];
        const unsigned u0 = UNI[0], u1 = UNI[1], u2 = UNI[2], u3 = UNI[3];
        float m = -INFINITY, l = 0.f;
#pragma unroll
        for (int r = 0; r < 16; ++r) { o[0][r] = 0.f; o[1][r] = 0.f; }
        int j = 0;
        auto ubit = [&](int jj) -> bool { const unsigned wv = jj < 32 ? u0 : (jj < 64 ? u1 : (jj < 96 ? u2 : u3)); return (wv >> (jj & 31)) & 1u; };
        auto nextj = [&](int jj) -> int { ++jj; while (jj <= cur && !ubit(jj)) ++jj; return jj; };
        nsa_ld(rk, rv, P.KSR, P.VST, SEQ, tid);
        __syncthreads();
        nsa_st(KT, VT, rk, rv, tid);
        __syncthreads();
        int buf = 0;
        while (j <= cur) {
            const int jn = nextj(j);
            if (jn <= cur) nsa_ld(rk, rv, P.KSR + (size_t)jn * 64 * 64, P.VST + jn * 64, SEQ, tid);
            const unsigned wv = j < 32 ? s0 : (j < 64 ? s1 : (j < 96 ? s2 : s3));
            const bool mine = (wv >> (j & 31)) & 1u;
            if (__any(mine)) {
                nsa_qk(p0, p1, KT + buf * 8192, qf, q32, hi);
                const int klim = mine ? (j == cur ? (tq & 63) : 63) : -1;
#pragma unroll
                for (int r = 0; r < 16; ++r) { const int k = crow(r, hi); if (k > klim) p0[r] = -INFINITY; if (k + 32 > klim) p1[r] = -INFINITY; }
                nsa_softmax(p0, p1, m, l, o, pf);
                nsa_pv(o, VT + buf * 8192, pf, q32, hi);
            }
            if (jn <= cur) nsa_st(KT + (buf ^ 1) * 8192, VT + (buf ^ 1) * 8192, rk, rv, tid);
            __syncthreads();
            buf ^= 1; j = jn;
        }
        const float sc = l > 0.f ? g_s / l : 0.f;
#pragma unroll
        for (int r = 0; r < 16; ++r) { acc[0][r] += sc * o[0][r]; acc[1][r] += sc * o[1][r]; }
    }
    {
        float m = -INFINITY, l = 0.f;
#pragma unroll
        for (int r = 0; r < 16; ++r) { o[0][r] = 0.f; o[1][r] = 0.f; }
        const int j0 = cur >= 8 ? cur - 8 : 0;
        nsa_ld(rk, rv, P.KWR + (size_t)j0 * 64 * 64, P.VWT + j0 * 64, SEQ, tid);
        __syncthreads();
        nsa_st(KT, VT, rk, rv, tid);
        __syncthreads();
        int buf = 0;
        for (int j = j0; j <= cur; ++j) {
            if (j + 1 <= cur) nsa_ld(rk, rv, P.KWR + (size_t)(j + 1) * 64 * 64, P.VWT + (j + 1) * 64, SEQ, tid);
            nsa_qk(p0, p1, KT + buf * 8192, qf, q32, hi);
            const int kb = j * 64;
#pragma unroll
            for (int r = 0; r < 16; ++r) {
                const int k = kb + crow(r, hi);
                if (k > tq || k <= tq - 512) p0[r] = -INFINITY;
                if (k + 32 > tq || k + 32 <= tq - 512) p1[r] = -INFINITY;
            }
            nsa_softmax(p0, p1, m, l, o, pf);
            nsa_pv(o, VT + buf * 8192, pf, q32, hi);
            if (j + 1 <= cur) nsa_st(KT + (buf ^ 1) * 8192, VT + (buf ^ 1) * 8192, rk, rv, tid);
            __syncthreads();
            buf ^= 1;
        }
        const float sc = l > 0.f ? g_w / l : 0.f;
#pragma unroll
        for (int r = 0; r < 16; ++r) { acc[0][r] += sc * o[0][r]; acc[1][r] += sc * o[1][r]; }
    }
    {
        bf16* op = P.MIX + (size_t)tq * DM + 768 + head * 64 + 4 * hi;
#pragma unroll
        for (int db = 0; db < 2; ++db)
#pragma unroll
            for (int g = 0; g < 4; ++g) {
                const unsigned lo = cvtpk(acc[db][4 * g], acc[db][4 * g + 1]), h2 = cvtpk(acc[db][4 * g + 2], acc[db][4 * g + 3]);
                *(uint2*)(op + 32 * db + 8 * g) = make_uint2(lo, h2);
            }
    }
}

DEVI void nsa_prep2(const bf16* __restrict__ cols, bf16* __restrict__ qn, bf16* __restrict__ qr, bf16* __restrict__ ksr, bf16* __restrict__ kwr,
                    bf16* __restrict__ vst, bf16* __restrict__ vwt, float* __restrict__ gates, int bid) {
    const int t = bid, c = tidx() & 255;
    const int d = c & 63, j = d & 31;
    const float inv = powf(10000.f, -(float)j / 32.f);
    const float ang = (float)t * inv;
    float sn, cs; sincosf(ang, &sn, &cs);
    {
        const bf16* q = cols + (size_t)t * DINP + OFF_Q + (c & ~63);
        const float x1 = bf2f(q[j]), x2 = bf2f(q[j + 32]);
        qn[(size_t)t * 256 + c] = (bf16)f2bf(bf2f(q[d]) * QSCL);
        qr[(size_t)t * 256 + c] = (bf16)f2bf((d < 32 ? x1 * cs - x2 * sn : x2 * cs + x1 * sn) * QSCL);
    }
    if (c < 128) {
        const bf16* kp = cols + (size_t)t * DINP + (c < 64 ? OFF_KS : OFF_KW);
        const float x1 = bf2f(kp[j]), x2 = bf2f(kp[j + 32]);
        const float v = d < 32 ? x1 * cs - x2 * sn : x2 * cs + x1 * sn;
        if (c < 64) ksr[(size_t)t * 64 + d] = (bf16)f2bf(v); else kwr[(size_t)t * 64 + d] = (bf16)f2bf(v);
    } else {
        const bf16 v = cols[(size_t)t * DINP + (c < 192 ? OFF_VS : OFF_VW) + d];
        if (c < 192) vst[(size_t)d * SEQ + t] = v; else vwt[(size_t)d * SEQ + t] = v;
    }
    if (c < 12) gates[(size_t)t * 12 + c] = sigm(bf2f(cols[(size_t)t * DINP + OFF_GT + c]));
}
DEVI void nsa_cmp_cvt(const float* __restrict__ kc, const float* __restrict__ vc, bf16* __restrict__ kcb, bf16* __restrict__ vct, int bid) {
    const int i = bid * 256 + (tidx() & 255);
    if (i < 512 * 64) {
        const int n = i >> 6, d = i & 63;
        kcb[i] = n < NCMP ? (bf16)f2bf(kc[i]) : (bf16)0;
        vct[d * 512 + n] = n < NCMP ? (bf16)f2bf(vc[i]) : (bf16)0;
    }
}
namespace pg8 {
struct XaOrder {
    int G, c;
    __device__ __forceinline__ bool next(int i, Unit& u) const {
        const int L = i * G + c; if (L >= 256) return false;
        u.pm = L >> 2; u.pn = ((L >> 2) >> 5) * 4 + (L & 3); return true;
    }
    __device__ __forceinline__ void a_ready(const Unit&) const {}
    __device__ __forceinline__ void done(const Unit&) const {}
};
struct MoeOrder {
    const int* tile_e; const int* nrt; int G, c;
    __device__ __forceinline__ bool next(int i, Unit& u) const {
        const int L = i * G + c; if (L >= 4 * (*nrt)) return false;
        u.pm = L >> 2; u.pn = tile_e[L >> 2] * 4 + (L & 3); return true;
    }
    __device__ __forceinline__ void a_ready(const Unit&) const {}
    __device__ __forceinline__ void done(const Unit&) const {}
};
#define PG8_EBAR() do { asm volatile("s_waitcnt lgkmcnt(0)" ::: "memory"); __builtin_amdgcn_s_barrier(); asm volatile("" ::: "memory"); } while (0)
struct EpiSoftmaxP {
    static constexpr bool PERM = true, AFTER_DRAIN = true;
    bf16_t* P;
    __device__ __forceinline__ void fused(f32x4 (&acc)[2][2][4][2], const Unit& u, int wr, int wc, int fr, int fq, PG8_LAS unsigned char* lds, int wid, int lane) const {
        PG8_LAS float* RM = (PG8_LAS float*)lds;
        PG8_LAS float* RS = RM + 1024;
#pragma unroll
        for (int ai = 0; ai < 2; ++ai)
#pragma unroll
            for (int m = 0; m < 4; ++m) {
                float mx = -INFINITY;
#pragma unroll
                for (int bj = 0; bj < 2; ++bj)
#pragma unroll
                    for (int n = 0; n < 2; ++n) { const f32x4 x = acc[ai][bj][m][n]; mx = fmaxf(mx, fmaxf(fmaxf(x[0], x[1]), fmaxf(x[2], x[3]))); }
                mx = fmaxf(mx, __shfl_xor(mx, 16)); mx = fmaxf(mx, __shfl_xor(mx, 32));
                if (fq == 0) RM[(ai * HALF + wr * 64 + m * 16 + fr) * 4 + wc] = mx;
            }
        PG8_EBAR();
#pragma unroll
        for (int ai = 0; ai < 2; ++ai)
#pragma unroll
            for (int m = 0; m < 4; ++m) {
                const int row = ai * HALF + wr * 64 + m * 16 + fr;
                const float gm = fmaxf(fmaxf(RM[row * 4 + 0], RM[row * 4 + 1]), fmaxf(RM[row * 4 + 2], RM[row * 4 + 3]));
                float s = 0.f;
#pragma unroll
                for (int bj = 0; bj < 2; ++bj)
#pragma unroll
                    for (int n = 0; n < 2; ++n) { f32x4 x = acc[ai][bj][m][n];
                        x[0] = __builtin_amdgcn_exp2f(x[0] - gm); x[1] = __builtin_amdgcn_exp2f(x[1] - gm); x[2] = __builtin_amdgcn_exp2f(x[2] - gm); x[3] = __builtin_amdgcn_exp2f(x[3] - gm);
                        s += (x[0] + x[1]) + (x[2] + x[3]); acc[ai][bj][m][n] = x; }
                s += __shfl_xor(s, 16); s += __shfl_xor(s, 32);
                if (fq == 0) RS[row * 4 + wc] = s;
            }
        PG8_EBAR();
        const int colb = (u.pn & 3) * BM + wc * 32 + 8 * fq;
#pragma unroll
        for (int ai = 0; ai < 2; ++ai)
#pragma unroll
            for (int m = 0; m < 4; ++m) {
                const int row = ai * HALF + wr * 64 + m * 16 + fr;
                const float inv = 1.0f / ((RS[row * 4 + 0] + RS[row * 4 + 1]) + (RS[row * 4 + 2] + RS[row * 4 + 3]));
                bf16_t* rowp = P + (size_t)(u.pm * BM + row) * 1024 + colb;
#pragma unroll
                for (int bj = 0; bj < 2; ++bj) { const f32x4 v0 = acc[ai][bj][m][0] * inv, v1 = acc[ai][bj][m][1] * inv;
                    u32x4 w; w.x = cvt_pk_bf16(v0[0], v0[1]); w.y = cvt_pk_bf16(v0[2], v0[3]); w.z = cvt_pk_bf16(v1[0], v1[1]); w.w = cvt_pk_bf16(v1[2], v1[3]);
                    *(u32x4*)(rowp + bj * HALF) = w; }
            }
        PG8_EBAR();
    }
};
struct EpiF32N4 {
    static constexpr bool PERM = false, AFTER_DRAIN = false;
    float* C; int ldc;
    __device__ __forceinline__ void operator()(const f32x4 (&acc)[2][2][4][2], const Unit& u, int wr, int wc, int fr, int fq) const {
        const int row0 = u.pm * BM + wr * 64 + fr, col0 = (u.pn & 3) * BM + wc * 32 + 4 * fq;
#pragma unroll
        for (int ai = 0; ai < 2; ++ai)
#pragma unroll
            for (int m = 0; m < 4; ++m) { float* rowp = C + (size_t)(row0 + ai * HALF + m * 16) * ldc + col0;
#pragma unroll
                for (int bj = 0; bj < 2; ++bj)
#pragma unroll
                    for (int n = 0; n < 2; ++n) *(f32x4*)(rowp + bj * HALF + n * 16) = acc[ai][bj][m][n]; }
    }
};
struct EpiBf16N4 {
    static constexpr bool PERM = true, AFTER_DRAIN = false;
    bf16_t* O; int ldc;
    __device__ __forceinline__ void operator()(const f32x4 (&acc)[2][2][4][2], const Unit& u, int wr, int wc, int fr, int fq) const {
        const int row0 = u.pm * BM + wr * 64 + fr, col0 = (u.pn & 3) * BM + wc * 32 + 8 * fq;
#pragma unroll
        for (int ai = 0; ai < 2; ++ai)
#pragma unroll
            for (int m = 0; m < 4; ++m) { bf16_t* rowp = O + (size_t)(row0 + ai * HALF + m * 16) * ldc + col0;
#pragma unroll
                for (int bj = 0; bj < 2; ++bj) { const f32x4 v0 = acc[ai][bj][m][0], v1 = acc[ai][bj][m][1];
                    u32x4 w; w.x = cvt_pk_bf16(v0[0], v0[1]); w.y = cvt_pk_bf16(v0[2], v0[3]); w.z = cvt_pk_bf16(v1[0], v1[1]); w.w = cvt_pk_bf16(v1[2], v1[3]);
                    *(u32x4*)(rowp + bj * HALF) = w; } }
    }
};
struct EpiSiluMul {
    static constexpr bool PERM = true, AFTER_DRAIN = false;
    bf16_t* H;
    __device__ __forceinline__ void operator()(const f32x4 (&acc)[2][2][4][2], const Unit& u, int wr, int wc, int fr, int fq) const {
        const int row0 = u.pm * BM + wr * 64 + fr, col0 = (u.pn & 3) * HALF + wc * 32 + 8 * fq;
#pragma unroll
        for (int ai = 0; ai < 2; ++ai)
#pragma unroll
            for (int m = 0; m < 4; ++m) {
                float h[8];
#pragma unroll
                for (int n = 0; n < 2; ++n)
#pragma unroll
                    for (int e = 0; e < 4; ++e) { const float g = acc[ai][0][m][n][e], up = acc[ai][1][m][n][e];
                        h[4 * n + e] = g * __builtin_amdgcn_rcpf(1.0f + __expf(-g)) * up; }
                u32x4 w; w.x = cvt_pk_bf16(h[0], h[1]); w.y = cvt_pk_bf16(h[2], h[3]); w.z = cvt_pk_bf16(h[4], h[5]); w.w = cvt_pk_bf16(h[6], h[7]);
                *(u32x4*)(H + (size_t)(row0 + ai * HALF + m * 16) * 512 + col0) = w;
            }
    }
};
}

DEVI void tr_blk(const float* W, size_t ldw, int N, int k0, int n0, bf16* WT, size_t ldt, int drow0, float scale, LAS float* scr, int lane) {
    const int n_ = n0 + (lane & 31);
#pragma unroll 8
    for (int i = 0; i < 32; ++i) { const int kk = 2 * i + (lane >> 5); scr[kk * 33 + (lane & 31)] = n_ < N ? W[(size_t)(k0 + kk) * ldw + n_] * scale : 0.f; }
    LDS_WAIT(); asm volatile("" ::: "memory");
    const int c = lane & 7;
#pragma unroll
    for (int j = 0; j < 4; ++j) { const int n = (lane >> 3) + 8 * j; const LAS float* s = scr + (8 * c) * 33 + n;
        v4u o; o.x = pk2(s[0 * 33], s[1 * 33]); o.y = pk2(s[2 * 33], s[3 * 33]); o.z = pk2(s[4 * 33], s[5 * 33]); o.w = pk2(s[6 * 33], s[7 * 33]);
        *(GAS v4u*)(WT + (size_t)(drow0 + n) * ldt + k0 + 8 * c) = o; }
    LDS_WAIT(); asm volatile("" ::: "memory");
}
DEVI void cvt_bf16(const float* __restrict__ src, bf16* __restrict__ dst, size_t n, float scale, int B0, int G) {
    for (size_t i = ((size_t)B0 * 512 + tidx()) * 4; i < n; i += (size_t)G * 512 * 4) {
        const float4 v = *(const float4*)(src + i);
        *(uint2*)(dst + i) = make_uint2(pk2(v.x * scale, v.y * scale), pk2(v.z * scale, v.w * scale));
    }
}

DEVI void moe_lists2(const int* __restrict__ te, int* __restrict__ off, int* __restrict__ nrt, int* __restrict__ tile_e, int* __restrict__ list,
                     int* __restrict__ slotpos, float* sm0) {
    int* cnt = (int*)sm0;
    int* offs = cnt + 16;
    const int w = tidx() >> 6, lane = tidx() & 63;
    __syncthreads();
    for (int ee = 0; ee < 2; ++ee) {
        const int e = w * 2 + ee;
        int c = 0;
        for (int base = 0; base < NTOK; base += 64) {
            const int tok = base + lane;
            const bool m = (te[tok * 2] == e) || (te[tok * 2 + 1] == e);
            c += __popcll(__ballot(m));
        }
        if (lane == 0) cnt[e] = c;
    }
    __syncthreads();
    if (tidx() == 0) {
        int s = 0;
#pragma unroll 1
        for (int i = 0; i < 16; ++i) { offs[i] = s; off[i] = s; const int pc = (cnt[i] + 255) & ~255;
#pragma unroll 1
            for (int r = s / 256; r < (s + pc) / 256; ++r) tile_e[r] = i;
            s += pc; }
        offs[16] = s; off[16] = s; *nrt = s / 256;
    }
    __syncthreads();
    for (int ee = 0; ee < 2; ++ee) {
        const int e = w * 2 + ee;
        int pos = offs[e];
        for (int base = 0; base < NTOK; base += 64) {
            const int tok = base + lane;
            const int a = te[tok * 2], b = te[tok * 2 + 1];
            const bool m = (a == e) || (b == e);
            const unsigned long long mask = __ballot(m);
            if (m) {
                const int p = pos + __popcll(mask & ((1ull << lane) - 1ull));
                list[p] = tok;
                slotpos[tok * 2 + (a == e ? 0 : 1)] = p;
            }
            pos += __popcll(mask);
        }
        for (int p = pos + lane; p < offs[e + 1]; p += 64) list[p] = -1;
    }
    __syncthreads();
}
DEVI void moe_gather(const bf16* __restrict__ xn, const int* __restrict__ list, const int* __restrict__ off, bf16* __restrict__ xg, int B0, int G) {
    const int total = off[16];
    const int gw = B0 * NWAVES + (tidx() >> 6), lane = tidx() & 63;
    for (int p = gw; p < total; p += G * NWAVES) {
        const int tok = list[p];
        v4u a = (v4u){0u, 0u, 0u, 0u}, b = a;
        if (tok >= 0) { const v4u* s = (const v4u*)(xn + (size_t)tok * DM); a = s[lane]; b = s[lane + 64]; }
        v4u* d = (v4u*)(xg + (size_t)p * DM); d[lane] = a; d[lane + 64] = b;
    }
}
DEVI void moe_combine_ln2(const float* x, const bf16* __restrict__ Dp, const int* __restrict__ te,
                          const float* __restrict__ tw, const int* __restrict__ slotpos,
                          const float* __restrict__ g, const float* __restrict__ bt, float* out, bf16* outb, int bid, float* sm) {
    __syncthreads();
    const size_t t = bid; const int tid = tidx() & 255;
    int ea = te[t * 2], eb = te[t * 2 + 1];
    float wa = tw[t * 2], wb = tw[t * 2 + 1];
    size_t pa = slotpos[t * 2], pb = slotpos[t * 2 + 1];
    if (eb < ea) { const float tf = wa; wa = wb; wb = tf; const size_t tp = pa; pa = pb; pb = tp; }
    float v[4];
#pragma unroll
    for (int i = 0; i < 4; ++i) {
        const int c = tid + i * 256;
        float y = wa * bf2f(Dp[pa * DM + c]);
        y = y + wb * bf2f(Dp[pb * DM + c]);
        v[i] = ALPHA * x[t * DM + c] + y;
    }
    const float mean = block_sum256(v[0] + v[1] + v[2] + v[3], sm, tid) * (1.f / DM);
    float q = 0.f;
#pragma unroll
    for (int i = 0; i < 4; ++i) { v[i] -= mean; q += v[i] * v[i]; }
    const float var = block_sum256(q, sm, tid) * (1.f / DM);
    const float rstd = rsqrtf(var + 1e-5f);
#pragma unroll
    for (int i = 0; i < 4; ++i) {
        const int c = tid + i * 256;
        const float o = v[i] * rstd * g[c] + bt[c];
        out[t * DM + c] = o;
        outb[t * DM + c] = (bf16)f2bf(o);
    }
}
struct MP {
    const float* in[50];
    float *X, *VFIRST, *KMEM, *VMEM, *TW, *R0;
    bf16 *XN, *MIX, *WIN_T, *WOUT_T, *COLSB;
    int *TE, *SLOT, *LIST, *EOFF;
    unsigned* BAR;
};

DEVI void tr_item(const float* W, int K, int N, int Npad, bf16* WT, LAS float* scr, int item, int lane) {
    const int nblk = Npad / 32, kb = item / nblk, nb = item % nblk, k0 = 64 * kb, n0 = 32 * nb;
    const int n_ = n0 + (lane & 31);
#pragma unroll 8
    for (int i = 0; i < 32; ++i) { const int kk = 2 * i + (lane >> 5); scr[kk * 33 + (lane & 31)] = n_ < N ? W[(size_t)(k0 + kk) * N + n_] : 0.f; }
    LDS_WAIT(); asm volatile("" ::: "memory");
    const int c = lane & 7;
#pragma unroll
    for (int j = 0; j < 4; ++j) { const int n = (lane >> 3) + 8 * j; const LAS float* s = scr + (8 * c) * 33 + n;
        v4u o; o.x = pk2(s[0 * 33], s[1 * 33]); o.y = pk2(s[2 * 33], s[3 * 33]); o.z = pk2(s[4 * 33], s[5 * 33]); o.w = pk2(s[6 * 33], s[7 * 33]);
        *(GAS v4u*)(WT + (size_t)(n0 + n) * K + k0 + 8 * c) = o; }
    LDS_WAIT(); asm volatile("" ::: "memory");
}

DEVI void gemm_all(const GemmArgs& g, int maxM, int Z, int B0, int G, unsigned char* lds) {
    const int total = gemm_tiles(g, maxM, Z);
    for (int t0 = B0 * 2; t0 < total; t0 += G * 2) {
        const int vb = tidx() >> 8; float* sm = (float*)(lds + vb * 32768);
        const bool l0 = gemm_tile_live(g, maxM, t0), l1 = (t0 + 1 < total) && gemm_tile_live(g, maxM, t0 + 1);
        if (!l0 && !l1) continue;
        const int t = (vb && t0 + 1 < total) ? t0 + 1 : t0;
        gemm_tile(g, maxM, t, vb ? l1 : l0, sm);
    }
}

__global__ void __launch_bounds__(512, 2) mega(MP p) {
    extern __shared__ __attribute__((aligned(16))) unsigned char lds[];
    cg::grid_group grid = cg::this_grid();
    const int G = gridDim.x, B0 = blockIdx.x;
    {
        LAS unsigned* ctl = (LAS unsigned*)((LAS unsigned char*)lds + LDSCTL_OFF);
        for (int u = threadIdx.x; u < (LDS_BYTES - LDSCTL_OFF) / 4; u += NWAVES * 64) ctl[u] = 0u;
    }
    __syncthreads();
    volatile LAS unsigned* MISC = (volatile LAS unsigned*)((LAS unsigned char*)lds + MISC_OFF);
    XcdBarrier bar = xcd_barrier_post(p.BAR, MISC + 8);
    grid.sync();
#define GSYNC() xcd_barrier(bar)
    float* sm0 = (float*)lds;
    LAS unsigned char* ring = (LAS unsigned char*)lds + RING_OFF;
#define VLOOP(n, body) for (int t0_ = B0 * 2; t0_ < (n); t0_ += G * 2) { const int vb = tidx() >> 8; float* sm = (float*)(lds + vb * 32768); const int t = min(t0_ + vb, (n) - 1); body; }

    const float *x_in = p.in[0], *mem = p.in[1];
    float* X = p.X;
    float* R0 = p.R0;
    float* T0 = R0;
    const size_t TB = (size_t)SEQ * 256;
    float *rR = T0, *rW = T0 + TB, *rK = T0 + 2 * TB, *rV = T0 + 3 * TB, *rA = T0 + 4 * TB, *rB = T0 + 5 * TB, *rG = T0 + 6 * TB,
          *rBON = T0 + 7 * TB, *rVD = T0 + 8 * TB;
    bf16 *QNb = (bf16*)(T0 + 9 * TB), *QRb = QNb + (size_t)SEQ * 256, *KSRb = QRb + (size_t)SEQ * 256, *KWRb = KSRb + (size_t)SEQ * 64,
         *VSTb = KWRb + (size_t)SEQ * 64, *VWTb = VSTb + (size_t)SEQ * 64, *KCMPb = VWTb + (size_t)SEQ * 64, *VCMPTb = KCMPb + 512 * 64;
    float *GATES = (float*)(VCMPTb + 512 * 64), *BLK = GATES + (size_t)SEQ * 12 + 16,
          *BLV = BLK + (size_t)NCMP * 2048, *HIDK = BLV + (size_t)NCMP * 2048, *HIDV = HIDK + (size_t)NCMP * 256,
          *KCMP = HIDV + (size_t)NCMP * 256, *VCMP = KCMP + (size_t)NCMP * 64;
    float *HCONV = VCMP + (size_t)NCMP * 64, *UB = HCONV + TB, *VB = UB + TB;
    float* Y = R0;
    bf16* PB = (bf16*)(R0 + (size_t)17 * 1000 * 1000);
    float* FQK = R0 + (size_t)26 * 1000 * 1000;
    float* FVO = FQK + (size_t)NB * DM * DM;
    bf16* WQK_T = (bf16*)(FVO + (size_t)NB * DM * DM);
    bf16* VWO_T = WQK_T + (size_t)NB * DM * DM;
    bf16* XG = (bf16*)R0;
    bf16* HB = (bf16*)(R0 + (size_t)19 * 1000 * 1000);
    bf16* WGU_T = (bf16*)(R0 + (size_t)34 * 1000 * 1000);
    bf16* WD_T = (bf16*)(R0 + (size_t)43 * 1000 * 1000);

    {
        LAS float* scr = (LAS float*)(ring + (tidx() >> 6) * 16384);
        const int gw = B0 * NWAVES + (tidx() >> 6), NGW = G * NWAVES, lane = tidx() & 63;
        constexpr int I_IN = (DM / 64) * (DINP / 32), I_OUT = (DM / 64) * (DM / 32);
        for (int it = gw; it < 2 * I_IN + 2 * I_OUT; it += NGW) {
            int r = it;
            if (r < 2 * I_IN) { const int l = r / I_IN; tr_item(p.in[4] + (size_t)l * DM * DIN, DM, DIN, DINP, p.WIN_T + (size_t)l * DINP * DM, scr, r % I_IN, lane); continue; }
            r -= 2 * I_IN;
            { const int l = r / I_OUT; tr_item(p.in[5] + (size_t)l * DM * DM, DM, DM, DM, p.WOUT_T + (size_t)l * DM * DM, scr, r % I_OUT, lane); }
        }
    }
    VLOOP(NTOK, ln_kernel(x_in, 1.0f, nullptr, p.in[2], p.in[3], X, p.XN, t, sm))
    GSYNC();
    for (int l = 0; l < 2; ++l) {
        {
            pg8::Gemm g{p.XN, p.WIN_T + (size_t)l * DINP * DM, NTOK, DINP, DM};
            pg8::StaticOrder S; S.init(NTOK, DINP, G, B0);
            pg8::EpiBf16<0> E{p.COLSB, DINP, nullptr, 0, 0, 1.f};
            pg8::gemm_phase<pg8::EpiBf16<0>, pg8::StaticOrder, true, true>(ring, g, S, E);
        }
        for (int b = 0; b < NB; ++b) {
            const bf16* COLS = p.COLSB + (size_t)b * SEQ * DINP;
            const float* Xb = X + (size_t)b * SEQ * DM;
            bf16* MIXb = p.MIX + (size_t)b * SEQ * DM;
            float* VFb = p.VFIRST + (size_t)b * SEQ * 256;
            if (l > 0) { const GemmArgs g2 = mk(Xb, DM, p.in[21], 32, 1, rVD, 32, SEQ, 32, DM); gemm_all(g2, SEQ, 1, B0, G, lds); }
            if (b == 0) {
                const GemmArgs g3 = mk(mem, DM, p.in[38] + (size_t)l * DM * DM, DM, 1, p.KMEM, DM, NB * MEML, DM, DM);
                const GemmArgs g4 = mk(mem, DM, p.in[39] + (size_t)l * DM * DM, DM, 1, p.VMEM, DM, NB * MEML, DM, DM);
                gemm_all(g3, NB * MEML, 1, B0, G, lds);
                gemm_all(g4, NB * MEML, 1, B0, G, lds);
            }
            GSYNC();
            {
                RwkvP rp;
                rp.cols = COLS; rp.mu = p.in[10] + l * 1024; rp.w0 = p.in[11] + l * 256; rp.w_up = p.in[12] + (size_t)l * 64 * 256;
                rp.a0 = p.in[13] + l * 256; rp.a_up = p.in[14] + (size_t)l * 64 * 256; rp.g_up = p.in[15] + (size_t)l * 128 * 256;
                rp.k_k = p.in[16] + l * 256; rp.k_a = p.in[17] + l * 256; rp.r_k = p.in[18] + l * 256;
                rp.vd = rVD; rp.v_mu = p.in[22]; rp.v0 = p.in[23]; rp.v_up = p.in[24];
                rp.vfirst = VFb; rp.R = rR; rp.W = rW; rp.K = rK; rp.V = rV; rp.A = rA; rp.Bv = rB; rp.G = rG; rp.BON = rBON; rp.layer = l; rp.pad = 0;
                VLOOP(SEQ, glu_kernel(COLS, HCONV, t))
                VLOOP(SEQ, gmlp_pre(COLS, p.in[25] + l * 256, p.in[26] + l * 256, UB, VB, t, sm))
                VLOOP(SEQ, rwkv_prep(rp, t, sm))
                VLOOP(SEQ, nsa_prep2(COLS, QNb, QRb, KSRb, KWRb, VSTb, VWTb, GATES, t))
                VLOOP(NCMP, cmp_gather(COLS, p.in[29] + (size_t)l * 2048, p.in[32] + (size_t)l * 2048, BLK, BLV, t))
            }
            GSYNC();
            {
                const GemmArgs gk = mk(BLK, 2048, p.in[30] + (size_t)l * 2048 * 256, 256, 1, HIDK, 256, NCMP, 256, 2048);
                const GemmArgs gv = mk(BLV, 2048, p.in[33] + (size_t)l * 2048 * 256, 256, 1, HIDV, 256, NCMP, 256, 2048);
                gemm_all(gk, NCMP, 1, B0, G, lds);
                gemm_all(gv, NCMP, 1, B0, G, lds);
                VLOOP(SEQ, conv_kernel(HCONV, p.in[6] + (size_t)l * 31 * 256, p.in[7] + l * 256, p.in[8] + l * 256, p.in[9] + l * 256, MIXb, t))
                VLOOP(SEQ, gmlp_mix(UB, VB, p.in[27] + (size_t)l * 4 * 128 * 128, p.in[28] + l * 4 * 128, MIXb, t))
            }
            GSYNC();
            VLOOP((2 * NCMP * 256 + 255) / 256, gelu_inplace(HIDK, 2 * NCMP * 256, t))
            GSYNC();
            {
                const GemmArgs gk = mk(HIDK, 256, p.in[31] + (size_t)l * 256 * 64, 64, 1, KCMP, 64, NCMP, 64, 256);
                const GemmArgs gv = mk(HIDV, 256, p.in[34] + (size_t)l * 256 * 64, 64, 1, VCMP, 64, NCMP, 64, 256);
                gemm_all(gk, NCMP, 1, B0, G, lds);
                gemm_all(gv, NCMP, 1, B0, G, lds);
            }
            GSYNC();
            VLOOP(512 * 64 / 256, nsa_cmp_cvt(KCMP, VCMP, KCMPb, VCMPTb, t))
            GSYNC();
            if (B0 == G - 1) {
                rwkv_scan(rR, rW, rK, rV, rA, rB, sm0);
            } else {
                NsaP np; np.QN = QNb; np.QR = QRb; np.KSR = KSRb; np.KWR = KWRb; np.VST = VSTb; np.VWT = VWTb; np.KCMP = KCMPb; np.VCMPT = VCMPTb; np.GATES = GATES; np.MIX = MIXb;
                for (int u = B0; u < SEQ / 64; u += G - 1) nsa_unit(np, SEQ / 64 - 1 - u, ring);
            }
            GSYNC();
            VLOOP(SEQ, rwkv_post(rR, rBON, rG, p.in[19] + l * 256, p.in[20] + l * 256, MIXb, t))
            GSYNC();
        }
        {
            pg8::Gemm g{p.MIX, p.WOUT_T + (size_t)l * DM * DM, NTOK, DM, DM};
            pg8::StaticOrder S; S.init(NTOK, DM, G, B0);
            pg8::EpiF32 E{Y, DM, nullptr};
            pg8::gemm_phase<pg8::EpiF32, pg8::StaticOrder, true, true>(ring, g, S, E);
        }
        GSYNC();
        VLOOP(NTOK, ln_kernel(X, ALPHA, Y, p.in[35] + l * DM, p.in[36] + l * DM, X, p.XN, t, sm))
        GSYNC();
        {
            const GemmArgs gq = mk(p.KMEM, DM, p.in[37] + (size_t)l * DM * DM, 1, DM, FQK, DM, 256, DM, 256, 4, (long)MEML * DM, 256, 0, 256, (long)4 * 256 * DM, (long)256 * DM);
            const GemmArgs gv = mk(p.VMEM, DM, p.in[40] + (size_t)l * DM * DM, DM, 1, FVO, DM, 256, DM, 256, 4, (long)MEML * DM, 256, 0, (long)256 * DM, (long)4 * 256 * DM, (long)256 * DM);
            gemm_all(gq, 256, NB * 4, B0, G, lds);
            gemm_all(gv, 256, NB * 4, B0, G, lds);
            __syncthreads();
            LAS float* scr = (LAS float*)(ring + (tidx() >> 6) * 16384);
            const int gw = B0 * NWAVES + (tidx() >> 6), NGW = G * NWAVES, lane = tidx() & 63;
            const float* wg = p.in[45] + (size_t)l * 16 * DM * 512;
            const float* wu = p.in[46] + (size_t)l * 16 * DM * 512;
            const float* wd = p.in[47] + (size_t)l * 16 * 512 * DM;
            constexpr int I_GU = (DM / 64) * (512 / 32), I_D = (512 / 64) * (DM / 32);
            for (int it = gw; it < 16 * (2 * I_GU + I_D); it += NGW) {
                const int e = it / (2 * I_GU + I_D); int r = it % (2 * I_GU + I_D);
                if (r < 2 * I_GU) {
                    const int isup = r / I_GU; r %= I_GU;
                    const int kb = r / 16, nb = r % 16, n0 = nb * 32;
                    tr_blk((isup ? wu : wg) + (size_t)e * DM * 512, 512, 512, kb * 64, n0, WGU_T + (size_t)e * 1024 * DM, DM, (n0 >> 7) * 256 + (n0 & 127) + isup * 128, 1.f, scr, lane);
                } else {
                    r -= 2 * I_GU;
                    const int kb = r / 32, nb = r % 32;
                    tr_blk(wd + (size_t)e * 512 * DM, DM, DM, kb * 64, nb * 32, WD_T + (size_t)e * DM * 512, 512, nb * 32, 1.f, scr, lane);
                }
            }
        }
        GSYNC();
        {
            cvt_bf16(FQK, WQK_T, (size_t)NB * DM * DM, 0.0625f * 1.4426950408889634f, B0, G);
            LAS float* scr = (LAS float*)(ring + (tidx() >> 6) * 16384);
            const int gw = B0 * NWAVES + (tidx() >> 6), NGW = G * NWAVES, lane = tidx() & 63;
            for (int it = gw; it < 8 * 4 * 32; it += NGW) {
                const int bh = it >> 7, r = it & 127, kb = r >> 5, nb = r & 31;
                tr_blk(FVO + (size_t)bh * 256 * DM, DM, DM, kb * 64, nb * 32, VWO_T + (size_t)(bh >> 2) * DM * DM + (bh & 3) * 256, DM, nb * 32, 1.f, scr, lane);
            }
        }
        GSYNC();
        {
            pg8::Gemm g{p.XN, WQK_T, NTOK, DM, DM};
            pg8::XaOrder S{G, B0};
            pg8::EpiSoftmaxP E{PB};
            pg8::gemm_phase<pg8::EpiSoftmaxP, pg8::XaOrder, false, true>(ring, g, S, E);
        }
        GSYNC();
        {
            pg8::Gemm g{PB, VWO_T, NTOK, DM, DM};
            pg8::XaOrder S{G, B0};
            pg8::EpiF32N4 E{Y, DM};
            pg8::gemm_phase<pg8::EpiF32N4, pg8::XaOrder, true, true>(ring, g, S, E);
        }
        GSYNC();
        VLOOP(NTOK, ln_kernel(X, ALPHA, Y, p.in[41] + l * DM, p.in[42] + l * DM, X, p.XN, t, sm))
        GSYNC();
        VLOOP(NTOK, router_kernel(X, p.in[43], p.in[44], p.TE, p.TW, t, sm))
        GSYNC();
        if (B0 == 0) moe_lists2(p.TE, p.EOFF, p.EOFF + 32, p.EOFF + 64, p.LIST, p.SLOT, sm0);
        GSYNC();
        moe_gather(p.XN, p.LIST, p.EOFF, XG, B0, G);
        GSYNC();
        {
            pg8::Gemm g{XG, WGU_T, 0, 0, DM};
            pg8::MoeOrder S{p.EOFF + 64, p.EOFF + 32, G, B0};
            pg8::EpiSiluMul E{HB};
            pg8::gemm_phase<pg8::EpiSiluMul, pg8::MoeOrder, true, true>(ring, g, S, E);
        }
        GSYNC();
        {
            pg8::Gemm g{HB, WD_T, 0, 0, 512};
            pg8::MoeOrder S{p.EOFF + 64, p.EOFF + 32, G, B0};
            pg8::EpiBf16N4 E{XG, DM};
            pg8::gemm_phase<pg8::EpiBf16N4, pg8::MoeOrder, true, true>(ring, g, S, E);
        }
        GSYNC();
        VLOOP(NTOK, moe_combine_ln2(X, XG, p.TE, p.TW, p.SLOT, p.in[48] + l * DM, p.in[49] + l * DM, X, p.XN, t, sm))
        GSYNC();
    }
}

extern "C" void kernel_launch(void* const* d_in, const int* in_sizes, int n_in, void* d_out, int out_size, void* d_ws, size_t ws_size,
                              hipStream_t stream) {
    static int grid_blocks = 0;
    if (!grid_blocks) {
        int dev = 0, cus = 0, per_cu = 0;
        (void)hipGetDevice(&dev);
        (void)hipDeviceGetAttribute(&cus, hipDeviceAttributeMultiprocessorCount, dev);
        (void)hipFuncSetAttribute((const void*)mega, hipFuncAttributeMaxDynamicSharedMemorySize, LDS_BYTES);
        (void)hipOccupancyMaxActiveBlocksPerMultiprocessor(&per_cu, (const void*)mega, NWAVES * 64, LDS_BYTES);
        (void)hipGetLastError();
        if (per_cu < 1) { fprintf(stderr, "occupancy query says %d blocks per CU\n", per_cu); per_cu = 1; }
        grid_blocks = cus;
    }
    MP p; memset(&p, 0, sizeof(p));
    for (int i = 0; i < 50; ++i) p.in[i] = (const float*)d_in[i];
    char* ws = (char*)d_ws;
    size_t o = 0;
    auto take = [&](size_t bytes) { char* q = ws + o; o += (bytes + 255) & ~(size_t)255; return q; };
    p.BAR = (unsigned*)take(16384);
    p.X = (float*)d_out;
    p.VFIRST = (float*)take((size_t)NTOK * 256 * 4);
    p.MIX = (bf16*)take((size_t)NTOK * DM * 2);
    p.XN = (bf16*)take((size_t)NTOK * DM * 2);
    p.WIN_T = (bf16*)take((size_t)2 * DINP * DM * 2);
    p.WOUT_T = (bf16*)take((size_t)2 * DM * DM * 2);
    p.KMEM = (float*)take((size_t)NB * MEML * DM * 4);
    p.VMEM = (float*)take((size_t)NB * MEML * DM * 4);
    p.TE = (int*)take((size_t)NTOK * 2 * 4);
    p.TW = (float*)take((size_t)NTOK * 2 * 4);
    p.SLOT = (int*)take((size_t)NTOK * 2 * 4);
    p.LIST = (int*)take((size_t)36864 * 4);
    p.EOFF = (int*)take(4096);
    p.R0 = (float*)take((size_t)57 * 1000 * 1000 * 4);
    p.COLSB = (bf16*)(p.R0 + (size_t)31 * 1000 * 1000);
    if (o > ws_size) { fprintf(stderr, "workspace too small: need %zu have %zu\n", o, ws_size); return; }
    (void)hipMemsetAsync(p.BAR, 0, 16384, stream);
    void* args[] = {&p};
    hipError_t e = hipLaunchCooperativeKernel((const void*)mega, dim3(grid_blocks), dim3(NWAVES * 64), args, LDS_BYTES, stream);
    if (e != hipSuccess) fprintf(stderr, "cooperative launch failed: %s (grid %d)\n", hipGetErrorString(e), grid_blocks);
}
```

```cpp
#include <hip/hip_runtime.h>
#include <hip/hip_cooperative_groups.h>
#include <stdio.h>
#include <stdint.h>
#include <string.h>
#include <math.h>
namespace cg = cooperative_groups;

#define DEVI __device__ __forceinline__
#define GAS __attribute__((address_space(1)))
#define LAS __attribute__((address_space(3)))
typedef unsigned short bf16;
typedef unsigned v4u __attribute__((ext_vector_type(4)));
typedef GAS unsigned gu32;
typedef GAS unsigned long long gu64;
#define RLX_AGENT __ATOMIC_RELAXED, __HIP_MEMORY_SCOPE_AGENT
#define LDS_WAIT() asm volatile("s_waitcnt lgkmcnt(0)" ::: "memory")
#define VM_WAIT() asm volatile("s_waitcnt vmcnt(0)" ::: "memory")
DEVI unsigned f2bf(float f) { unsigned u = __builtin_bit_cast(unsigned, f); return (u + 0x7fffu + ((u >> 16) & 1u)) >> 16; }
DEVI unsigned pk2(float lo, float hi) { return f2bf(lo) | (f2bf(hi) << 16); }
DEVI float bf2f(unsigned short h) { return __builtin_bit_cast(float, (unsigned)h << 16); }

constexpr int NB = 2, SEQ = 8192, DM = 1024, NTOK = NB * SEQ, DIN = 2700, DINP = 2816, MEML = 256;
constexpr int OFF_CV = 0, OFF_CG = 256, OFF_RW = 512, OFF_GU = 1536, OFF_GV = 1792, OFF_Q = 2048, OFF_KC = 2304,
              OFF_VC = 2368, OFF_KS = 2432, OFF_VS = 2496, OFF_KW = 2560, OFF_VW = 2624, OFF_GT = 2688;
constexpr int NCMP = 511;
constexpr float ALPHA = 1.4142135623730951f;
constexpr int NWAVES = 8;
constexpr int RING_OFF = 0, RING_BYTES = 131072;
constexpr int LDSCTL_OFF = RING_BYTES, MISC_OFF = LDSCTL_OFF + 320;
constexpr int LDS_BYTES = 147456;

DEVI int tidx() { int t = threadIdx.x; asm volatile("" : "+v"(t)); return t; }
namespace pg8 {
#define PG8_LAS __attribute__((address_space(3)))
typedef unsigned short bf16_t;
typedef short bf16x8 __attribute__((ext_vector_type(8)));
typedef float f32x4 __attribute__((ext_vector_type(4)));
typedef unsigned u32x4 __attribute__((ext_vector_type(4)));
constexpr int BM = 256, BK = 64, HALF = 128, HTB = HALF * BK * 2  , STAGE_BYTES = 8 * HTB, NXCD = 8, WGM = 8;

__host__ __device__ __forceinline__ int lds_byte(int r, int c) { const int st = (r >> 4) * 2 + (c >> 5), rr = r & 15, cc = c & 31, ob = rr * 64 + cc * 2; return st * 1024 + (ob ^ (((ob >> 9) & 1) << 5)); }
__host__ __device__ __forceinline__ void stage_rc(int b, int& R, int& C) { const int st = b / 1024, sb = b % 1024, swz = sb ^ (((sb >> 9) & 1) << 5); R = (st >> 1) * 16 + swz / 64; C = (st & 1) * 32 + (swz % 64) / 2; }
__host__ __device__ __forceinline__ int perm32(int rho) { const int n = rho >> 4, i = rho & 15; return 8 * (i >> 2) + 4 * n + (i & 3); }

struct Unit { int pm, pn; };
struct Gemm { const bf16_t* A; const bf16_t* Bt; int M, N, K; };

struct StaticOrder {
    int nM, nN, nwg, G, c;
    __host__ __device__ void init(int M, int N, int G_, int c_) { nM = M / BM; nN = N / BM; nwg = nM * nN; G = G_; c = c_; }
    __host__ __device__ bool next(int i, Unit& u) const {
        const long L = (long)i * G + c; if (L >= nwg) return false;
        int wgid = (int)L; { const int q = nwg / NXCD, r = nwg % NXCD, xcd = wgid % NXCD, off = wgid / NXCD; wgid = (xcd < r ? xcd * (q + 1) : r * (q + 1) + (xcd - r) * q) + off; }
        const int nig = WGM * nN, gid = wgid / nig, fm = gid * WGM, gsz = (nM - fm) < WGM ? (nM - fm) : WGM;
        u.pm = fm + ((wgid % nig) % gsz); u.pn = (wgid % nig) / gsz; return true;
    }
    __device__ __forceinline__ void a_ready(const Unit&) const {}
    __device__ __forceinline__ void done(const Unit&) const {}
};

__device__ __forceinline__ unsigned cvt_pk_bf16(float lo, float hi) { unsigned r; asm volatile("v_cvt_pk_bf16_f32 %0, %1, %2" : "=v"(r) : "v"(lo), "v"(hi)); return r; }
typedef float f32x2 __attribute__((ext_vector_type(2)));
__device__ __forceinline__ f32x2 gelu_pk(f32x2 v) {
    const f32x2 av = __builtin_elementwise_abs(v), d = av * 0.2316418882f + 1.0f;
    f32x2 t; t.x = __builtin_amdgcn_rcpf(d.x); t.y = __builtin_amdgcn_rcpf(d.y);
    f32x2 q = t * 0.5307027145f + (-0.7265760135f); q = q * t + 0.7107068705f; q = q * t + (-0.142248368f); q = q * t + 0.127414796f; q = q * t;
    const f32x2 s = (v * v) * (-0.72134752044f);
    f32x2 e; e.x = __builtin_amdgcn_exp2f(s.x); e.y = __builtin_amdgcn_exp2f(s.y);
    const f32x2 m = v * (q * e), r = v - m;
    f32x2 o; o.x = v.x < 0.f ? m.x : r.x; o.y = v.y < 0.f ? m.y : r.y; return o;
}

template <int ACT  > struct EpiBf16 {
    static constexpr bool PERM = true, AFTER_DRAIN = false; static_assert(ACT == 0 || ACT == 1, "EpiBf16: ACT is 0 (none) or 1 (gelu_pk)");
    bf16_t* O; int ldc; const float* bias; int split_cols; size_t split_stride; float scale0;
    __device__ __forceinline__ void operator()(const f32x4 (&acc)[2][2][4][2], const Unit& u, int wr, int wc, int fr, int fq) const {
        const int row0 = u.pm * BM + wr * 64 + fr; int colt = u.pn * BM; bf16_t* base = O;
        float sc = 1.f; if (split_cols) { const int t = colt / split_cols; base += (size_t)t * split_stride; colt -= t * split_cols; if (t == 0) sc = scale0; }
        const int col0 = colt + wc * 32 + 8 * fq, bcol0 = u.pn * BM + wc * 32 + 8 * fq;
        f32x4 bv[2][2];
#pragma unroll
        for (int bj = 0; bj < 2; ++bj)
#pragma unroll
            for (int n = 0; n < 2; ++n) bv[bj][n] = bias ? *(const f32x4*)(bias + bcol0 + bj * HALF + 4 * n) : (f32x4){0.f, 0.f, 0.f, 0.f};
#pragma unroll
        for (int ai = 0; ai < 2; ++ai)
#pragma unroll
            for (int m = 0; m < 4; ++m) { bf16_t* rowp = base + (size_t)(row0 + ai * HALF + m * 16) * ldc + col0;
#pragma unroll
                for (int bj = 0; bj < 2; ++bj) { f32x4 v0 = acc[ai][bj][m][0] + bv[bj][0], v1 = acc[ai][bj][m][1] + bv[bj][1];
                    if (ACT == 1) { f32x2 a = gelu_pk((f32x2){v0[0], v0[1]}), b = gelu_pk((f32x2){v0[2], v0[3]}), c = gelu_pk((f32x2){v1[0], v1[1]}), d = gelu_pk((f32x2){v1[2], v1[3]});
                        v0 = (f32x4){a.x, a.y, b.x, b.y}; v1 = (f32x4){c.x, c.y, d.x, d.y}; }
                    v0 = v0 * sc; v1 = v1 * sc; u32x4 w; w.x = cvt_pk_bf16(v0[0], v0[1]); w.y = cvt_pk_bf16(v0[2], v0[3]); w.z = cvt_pk_bf16(v1[0], v1[1]); w.w = cvt_pk_bf16(v1[2], v1[3]);
                    *(u32x4*)(rowp + bj * HALF) = w; } }
    }
};

struct PanelStats {
    unsigned* xbuf;
    unsigned* cnt;
    unsigned* tmo;
    int ntn; float eps;
    unsigned code;
    __device__ __forceinline__ bool run(const f32x4 (&v)[2][2][4][2], const Unit& u, int wr, int wc, int fr, int fq, PG8_LAS unsigned char* lds, int wid, int lane) const {
        typedef float f32x2v __attribute__((ext_vector_type(2)));
        PG8_LAS f32x2v* P = (PG8_LAS f32x2v*)lds;
        PG8_LAS f32x2v* S = (PG8_LAS f32x2v*)(lds + 8192);
        PG8_LAS unsigned* flag = (PG8_LAS unsigned*)(lds + 8192 + 2048);
#pragma unroll
        for (int ai = 0; ai < 2; ++ai)
#pragma unroll
            for (int m = 0; m < 4; ++m) {
                float s = 0.f;
#pragma unroll
                for (int bj = 0; bj < 2; ++bj)
#pragma unroll
                    for (int n = 0; n < 2; ++n) { const f32x4 x = v[ai][bj][m][n]; s += (x[0] + x[1]) + (x[2] + x[3]); }
                s += __shfl_xor(s, 16); s += __shfl_xor(s, 32);
                const float mw = s * (1.0f / 64.0f); float q = 0.f;
#pragma unroll
                for (int bj = 0; bj < 2; ++bj)
#pragma unroll
                    for (int n = 0; n < 2; ++n) { const f32x4 d = v[ai][bj][m][n] - mw; q += (d[0] * d[0] + d[1] * d[1]) + (d[2] * d[2] + d[3] * d[3]); }
                q += __shfl_xor(q, 16); q += __shfl_xor(q, 32);
                if (fq == 0) P[(ai * HALF + wr * 64 + m * 16 + fr) * 4 + wc] = (f32x2v){mw, q};
            }
        asm volatile("s_waitcnt lgkmcnt(0)" ::: "memory"); __builtin_amdgcn_s_barrier(); asm volatile("" ::: "memory");
#if defined(BROKEN_EXCHANGE_NO_WAIT)
#warning BROKEN CONTROL BUILD: the row-statistics exchange does not wait; results are wrong by design
        if (blockIdx.x >= 64) { const long long t0_ = clock64(); while (clock64() - t0_ < 60000) __builtin_amdgcn_s_sleep(8); }
#endif
        const int row = wid * 32 + (lane & 31);
        if (lane < 32) {
            const f32x2v a = P[row * 4 + 0], b = P[row * 4 + 1], c = P[row * 4 + 2], d = P[row * 4 + 3];
            const float mt = (a.x + b.x + c.x + d.x) * 0.25f;
            const float da = a.x - mt, db = b.x - mt, dc = c.x - mt, dd = d.x - mt;
            const float m2 = (a.y + b.y) + (c.y + d.y) + 64.0f * ((da * da + db * db) + (dc * dc + dd * dd));
            unsigned long long* slot = (unsigned long long*)xbuf + ((size_t)(u.pm * BM + row) * 4 + u.pn);
            __hip_atomic_store(slot, ((unsigned long long)__float_as_uint(m2) << 32) | __float_as_uint(mt), __ATOMIC_RELAXED, __HIP_MEMORY_SCOPE_AGENT);
        }
        asm volatile("s_waitcnt vmcnt(0)" ::: "memory");
        if (lane == 0) __hip_atomic_fetch_add(cnt + 64 * u.pm, 1u, __ATOMIC_RELAXED, __HIP_MEMORY_SCOPE_AGENT);
        if (wid == 0) {
            bool dead = false; const unsigned long long t0 = __builtin_amdgcn_s_memrealtime(); const unsigned want = 8u * (unsigned)ntn;
            for (;;) {
#if defined(BROKEN_EXCHANGE_NO_WAIT)
                break;
#endif
                if ((unsigned)__builtin_amdgcn_readfirstlane(__hip_atomic_load(cnt + 64 * u.pm, __ATOMIC_RELAXED, __HIP_MEMORY_SCOPE_AGENT)) >= want) break;
                if (__builtin_amdgcn_s_memrealtime() - t0 > 2000000ull) {
                    if (lane == 0) { unsigned expect = 0u; __hip_atomic_compare_exchange_strong(tmo + 1, &expect, code | (unsigned)(u.pm & 0xff), __ATOMIC_RELAXED, __ATOMIC_RELAXED, __HIP_MEMORY_SCOPE_AGENT);
                                     __hip_atomic_store(tmo, 1u, __ATOMIC_RELAXED, __HIP_MEMORY_SCOPE_AGENT); }
                    dead = true; break; }
                __builtin_amdgcn_s_sleep(2);
            }
            __builtin_amdgcn_fence(__ATOMIC_ACQUIRE, "agent");
            if (lane == 0) flag[0] = dead ? 1u : 0u;
        }
        asm volatile("s_waitcnt vmcnt(0) lgkmcnt(0)" ::: "memory"); __builtin_amdgcn_s_barrier(); asm volatile("" ::: "memory");
        const bool bad = flag[0] != 0u;
        if (lane < 32) {
            const unsigned long long* slot = (const unsigned long long*)xbuf + (size_t)(u.pm * BM + row) * 4; float mt[4], m2[4]; float ms = 0.f;
#pragma unroll
            for (int t = 0; t < 4; ++t) { if (t < ntn) { const unsigned long long w = __hip_atomic_load(slot + t, __ATOMIC_RELAXED, __HIP_MEMORY_SCOPE_AGENT); mt[t] = __uint_as_float((unsigned)w); m2[t] = __uint_as_float((unsigned)(w >> 32)); } else { mt[t] = 0.f; m2[t] = 0.f; } ms += mt[t]; }
            const float mean = ms / (float)ntn; float q = 0.f;
#pragma unroll
            for (int t = 0; t < 4; ++t) if (t < ntn) { const float dm = mt[t] - mean; q += m2[t] + 256.0f * dm * dm; }
            S[row] = (f32x2v){mean, 1.0f / sqrtf(q / (256.0f * (float)ntn) + eps)};
        }
        asm volatile("s_waitcnt lgkmcnt(0)" ::: "memory"); __builtin_amdgcn_s_barrier(); asm volatile("" ::: "memory");
        return bad;
    }
};
struct EpiLnRes {
    static constexpr bool PERM = false, AFTER_DRAIN = true;
    const float* base; float* out; int ldc; const float* bias; PanelStats st; unsigned poison;
    __device__ __forceinline__ void fused(f32x4 (&acc)[2][2][4][2], const Unit& u, int wr, int wc, int fr, int fq, PG8_LAS unsigned char* lds, int wid, int lane) const {
        typedef float f32x2v __attribute__((ext_vector_type(2)));
        const PG8_LAS f32x2v* S = (const PG8_LAS f32x2v*)(lds + 8192);
        const int col0 = u.pn * BM + wc * 32 + 4 * fq;
#pragma unroll
        for (int bj = 0; bj < 2; ++bj)
#pragma unroll
            for (int n = 0; n < 2; ++n) { const f32x4 bv = bias ? *(const f32x4*)(bias + col0 + bj * HALF + n * 16) : (f32x4){0.f, 0.f, 0.f, 0.f};
#pragma unroll
                for (int ai = 0; ai < 2; ++ai)
#pragma unroll
                    for (int m = 0; m < 4; ++m) acc[ai][bj][m][n] += bv; }
        f32x4 pre[4][2][2];
#pragma unroll
        for (int m = 0; m < 4; ++m) { const size_t off = (size_t)(u.pm * BM + wr * 64 + m * 16 + fr) * ldc + col0;
#pragma unroll
            for (int bj = 0; bj < 2; ++bj)
#pragma unroll
                for (int n = 0; n < 2; ++n) pre[m][bj][n] = *(const f32x4*)(base + off + bj * HALF + n * 16); }
        const bool bad = st.run(acc, u, wr, wc, fr, fq, lds, wid, lane) || poison != 0u;
        const float qnan = __builtin_nanf("");
#pragma unroll
        for (int ai = 0; ai < 2; ++ai)
#pragma unroll
            for (int m = 0; m < 4; ++m) { const int r = ai * HALF + wr * 64 + m * 16 + fr; const f32x2v sr = S[r]; const size_t off = (size_t)(u.pm * BM + r) * ldc + col0;
#pragma unroll
                for (int bj = 0; bj < 2; ++bj)
#pragma unroll
                    for (int n = 0; n < 2; ++n) { const f32x4 bs = ai == 0 ? pre[m][bj][n] : *(const f32x4*)(base + off + bj * HALF + n * 16); f32x4 o = bs + (acc[ai][bj][m][n] - sr.x) * sr.y;
                        if (bad) o = (f32x4){qnan, qnan, qnan, qnan}; *(f32x4*)(out + off + bj * HALF + n * 16) = o; }
                if (m & 1) asm volatile("" ::: "memory"); }
    }
};
struct EpiLnResLn {
    static constexpr bool PERM = false, AFTER_DRAIN = true;
    const float* base; float* out; bf16_t* xn; int ldc; const float* bias; PanelStats st1, st2; unsigned poison;
    __device__ __forceinline__ void fused(f32x4 (&acc)[2][2][4][2], const Unit& u, int wr, int wc, int fr, int fq, PG8_LAS unsigned char* lds, int wid, int lane) const {
        typedef float f32x2v __attribute__((ext_vector_type(2))); typedef unsigned u32x2v __attribute__((ext_vector_type(2)));
        const PG8_LAS f32x2v* S = (const PG8_LAS f32x2v*)(lds + 8192);
        const int col0 = u.pn * BM + wc * 32 + 4 * fq;
#pragma unroll
        for (int bj = 0; bj < 2; ++bj)
#pragma unroll
            for (int n = 0; n < 2; ++n) { const f32x4 bv = bias ? *(const f32x4*)(bias + col0 + bj * HALF + n * 16) : (f32x4){0.f, 0.f, 0.f, 0.f};
#pragma unroll
                for (int ai = 0; ai < 2; ++ai)
#pragma unroll
                    for (int m = 0; m < 4; ++m) acc[ai][bj][m][n] += bv; }
        bool bad = st1.run(acc, u, wr, wc, fr, fq, lds, wid, lane) || poison != 0u;
        const float qnan = __builtin_nanf("");
#pragma unroll
        for (int ai = 0; ai < 2; ++ai)
#pragma unroll
            for (int m = 0; m < 4; ++m) { const int r = ai * HALF + wr * 64 + m * 16 + fr; const f32x2v sr = S[r]; const size_t off = (size_t)(u.pm * BM + r) * ldc + col0;
#pragma unroll
                for (int bj = 0; bj < 2; ++bj)
#pragma unroll
                    for (int n = 0; n < 2; ++n) { const f32x4 bs = *(const f32x4*)(base + off + bj * HALF + n * 16); acc[ai][bj][m][n] = bs + (acc[ai][bj][m][n] - sr.x) * sr.y; }
                asm volatile("" : "+v"(acc[ai][0][m][0]), "+v"(acc[ai][0][m][1]), "+v"(acc[ai][1][m][0]), "+v"(acc[ai][1][m][1]));
                if (m & 1) asm volatile("" ::: "memory"); }
        const bool bad1 = bad;
        bad = st2.run(acc, u, wr, wc, fr, fq, lds, wid, lane) || bad;
#pragma unroll
        for (int ai = 0; ai < 2; ++ai)
#pragma unroll
            for (int m = 0; m < 4; ++m) { const int r = ai * HALF + wr * 64 + m * 16 + fr; const f32x2v sr = S[r]; const size_t off = (size_t)(u.pm * BM + r) * ldc + col0;
#pragma unroll
                for (int bj = 0; bj < 2; ++bj)
#pragma unroll
                    for (int n = 0; n < 2; ++n) { const f32x4 x1 = acc[ai][bj][m][n]; *(f32x4*)(out + off + bj * HALF + n * 16) = bad1 ? (f32x4){qnan, qnan, qnan, qnan} : x1;
                        const f32x4 o = (x1 - sr.x) * sr.y; u32x2v w; w.x = cvt_pk_bf16(o[0], o[1]); w.y = cvt_pk_bf16(o[2], o[3]);
                        if (bad) { w.x = 0x7fc07fc0u; w.y = 0x7fc07fc0u; } *(u32x2v*)(xn + off + bj * HALF + n * 16) = w; }
                asm volatile("" ::: "memory"); }
    }
};

template <class Epi, class Sched, bool ALIGN_EPI = false, bool SP2 = false>
__device__ __forceinline__ void gemm_phase(PG8_LAS unsigned char* lds, const Gemm g, const Sched& S, const Epi& E) {
    const int tid = tidx(), wid = __builtin_amdgcn_readfirstlane(tid >> 6), lane = tid & 63, wr = wid >> 2, wc = wid & 3, fr = lane & 15, fq = lane >> 4;
    const int K = g.K, nt = K / BK;
    unsigned voffA[2], voffB[2];
#pragma unroll
    for (int i = 0; i < 2; ++i) { int R, C; stage_rc(tid * 16 + i * 8192, R, C); const int Rb = Epi::PERM ? ((R & ~31) + perm32(R & 31)) : R;
        voffA[i] = (unsigned)(R * K + C) * 2u; voffB[i] = (unsigned)(Rb * K + C) * 2u; }
    const size_t kstep = (size_t)(BK * 2);
    const size_t hstep = (size_t)HALF * K * 2;
    const size_t tstep = 2 * hstep;
    const unsigned ldsw = (unsigned)wid * 1024u;
    const int aoff = lds_byte(wr * 64 + fr, fq * 8), boff = lds_byte(wc * 32 + fr, fq * 8);
#define PG8_SA(b, h) (((b) * 2 + (h)) * HTB)
#define PG8_SB(b, h) ((4 + (b) * 2 + (h)) * HTB)
#define PG8_STAGE(bufoff, gbase, voff) do { _Pragma("unroll") for (int _i = 0; _i < 2; ++_i) \
        __builtin_amdgcn_global_load_lds((const unsigned*)((const char*)(gbase) + (voff)[_i]), (PG8_LAS unsigned*)(lds + (bufoff) + ldsw + _i * 8192), 16, 0, 0); } while (0)
#define PG8_LDA(dst, b, h) do { _Pragma("unroll") for (int m = 0; m < 4; ++m) _Pragma("unroll") for (int k = 0; k < 2; ++k) dst[m][k] = *(const PG8_LAS bf16x8*)(lds + PG8_SA(b, h) + aoff + m * 2048 + k * 1024); } while (0)
#define PG8_LDB(dst, b, h) do { _Pragma("unroll") for (int n = 0; n < 2; ++n) _Pragma("unroll") for (int k = 0; k < 2; ++k) dst[n][k] = *(const PG8_LAS bf16x8*)(lds + PG8_SB(b, h) + boff + n * 2048 + k * 1024); } while (0)
#define PG8_MMA(ai, bj, At, Bt) do { __builtin_amdgcn_s_setprio(1); _Pragma("unroll") for (int m = 0; m < 4; ++m) _Pragma("unroll") for (int n = 0; n < 2; ++n) _Pragma("unroll") for (int k = 0; k < 2; ++k) \
        acc[ai][bj][m][n] = __builtin_amdgcn_mfma_f32_16x16x32_bf16(Bt[n][k], At[m][k], acc[ai][bj][m][n], 0, 0, 0); __builtin_amdgcn_s_setprio(0); } while (0)
#define PG8_WAIT_V(n) asm volatile("s_waitcnt vmcnt(" #n ")" ::: "memory")
#define PG8_WAIT_L(n) asm volatile("s_waitcnt lgkmcnt(" #n ")" ::: "memory")
#define PG8_BAR __builtin_amdgcn_s_barrier()
#define PG8_SCHED __builtin_amdgcn_sched_barrier(0)
    Unit cur, nxt; int ui = 0;
    if (!S.next(0, cur)) return;
    f32x4 acc[2][2][4][2];
#pragma unroll
    for (int a = 0; a < 2; ++a)
#pragma unroll
        for (int b = 0; b < 2; ++b)
#pragma unroll
            for (int m = 0; m < 4; ++m)
#pragma unroll
                for (int n = 0; n < 2; ++n) acc[a][b][m][n] = (f32x4){0.f, 0.f, 0.f, 0.f};
    bf16x8 At[4][2], B0[2][2], B1[2][2];
    const char* cA = (const char*)g.A + (size_t)cur.pm * tstep; const char* cB = (const char*)g.Bt + (size_t)cur.pn * tstep;
    S.a_ready(cur);
    if constexpr (SP2) {
        PG8_STAGE(PG8_SB(0, 0), cB, voffB); PG8_STAGE(PG8_SB(0, 1), cB + hstep, voffB); PG8_STAGE(PG8_SA(0, 0), cA, voffA); PG8_STAGE(PG8_SA(0, 1), cA + hstep, voffA);
        if (wr == 1) PG8_BAR;
        PG8_WAIT_V(2); PG8_BAR;
        PG8_STAGE(PG8_SB(1, 0), cB + kstep, voffB); PG8_STAGE(PG8_SA(1, 0), cA + kstep, voffA); PG8_STAGE(PG8_SB(1, 1), cB + hstep + kstep, voffB);
        PG8_WAIT_V(6); PG8_BAR;
    } else {
        PG8_STAGE(PG8_SB(0, 0), cB, voffB); PG8_STAGE(PG8_SA(0, 0), cA, voffA); PG8_STAGE(PG8_SB(0, 1), cB + hstep, voffB); PG8_STAGE(PG8_SA(0, 1), cA + hstep, voffA);
        if (wr == 1) PG8_BAR;
        PG8_WAIT_V(4); PG8_BAR;
        PG8_STAGE(PG8_SB(1, 0), cB + kstep, voffB); PG8_STAGE(PG8_SA(1, 0), cA + kstep, voffA); PG8_STAGE(PG8_SB(1, 1), cB + hstep + kstep, voffB);
        PG8_WAIT_V(6); PG8_BAR;
    }
    for (;;) {
        const bool has_next = S.next(ui + 1, nxt);
        const char* nA = has_next ? (const char*)g.A + (size_t)nxt.pm * tstep : cA; const char* nB = has_next ? (const char*)g.Bt + (size_t)nxt.pn * tstep : cB;
        for (int t = 0; t < nt; t += 2) {
            const bool last = (t == nt - 2);
            const char* a1 = cA + (size_t)(t + 1) * kstep;
            const char* a2 = last ? nA : cA + (size_t)(t + 2) * kstep; const char* b2 = last ? nB : cB + (size_t)(t + 2) * kstep;
            const char* a3 = a2 + kstep; const char* b3 = b2 + kstep;
            if (last && has_next) S.a_ready(nxt);
            if constexpr (SP2) {
            PG8_LDB(B0, 0, 0); PG8_LDB(B1, 0, 1); PG8_SCHED; PG8_LDA(At, 0, 0); PG8_STAGE(PG8_SA(1, 1), a1 + hstep, voffA);
            PG8_WAIT_V(8); PG8_WAIT_L(0); PG8_BAR; PG8_MMA(0, 0, At, B0); PG8_MMA(0, 1, At, B1); PG8_BAR; PG8_SCHED;
            PG8_LDA(At, 0, 1); PG8_STAGE(PG8_SB(0, 0), b2, voffB); PG8_STAGE(PG8_SB(0, 1), b2 + hstep, voffB); PG8_STAGE(PG8_SA(0, 0), a2, voffA);
            PG8_WAIT_V(8); PG8_WAIT_L(0); PG8_BAR; PG8_MMA(1, 0, At, B0); PG8_MMA(1, 1, At, B1); PG8_BAR; PG8_SCHED;
            PG8_LDB(B0, 1, 0); PG8_LDB(B1, 1, 1); PG8_SCHED; PG8_LDA(At, 1, 0); PG8_STAGE(PG8_SA(0, 1), a2 + hstep, voffA);
            PG8_WAIT_V(8); PG8_WAIT_L(0); PG8_BAR; PG8_MMA(0, 0, At, B0); PG8_MMA(0, 1, At, B1); PG8_BAR; PG8_SCHED;
            PG8_LDA(At, 1, 1); PG8_STAGE(PG8_SB(1, 0), b3, voffB); PG8_STAGE(PG8_SB(1, 1), b3 + hstep, voffB); PG8_STAGE(PG8_SA(1, 0), a3, voffA);
            PG8_WAIT_V(8); PG8_WAIT_L(0); PG8_BAR; PG8_MMA(1, 0, At, B0); PG8_MMA(1, 1, At, B1); PG8_BAR; PG8_SCHED;
            } else {
            PG8_LDB(B0, 0, 0); PG8_SCHED; PG8_LDA(At, 0, 0); PG8_STAGE(PG8_SA(1, 1), a1 + hstep, voffA);
            PG8_WAIT_L(8); PG8_BAR; PG8_WAIT_L(0); PG8_MMA(0, 0, At, B0); PG8_BAR; PG8_SCHED;
            PG8_LDB(B1, 0, 1); PG8_STAGE(PG8_SB(0, 0), b2, voffB);
            PG8_BAR; PG8_WAIT_L(0); PG8_MMA(0, 1, At, B1); PG8_BAR;
            PG8_LDA(At, 0, 1); PG8_STAGE(PG8_SA(0, 0), a2, voffA);
            PG8_BAR; PG8_WAIT_L(0); PG8_MMA(1, 0, At, B0); PG8_BAR; PG8_SCHED;
            PG8_STAGE(PG8_SB(0, 1), b2 + hstep, voffB);
            PG8_WAIT_V(6); PG8_BAR; PG8_MMA(1, 1, At, B1); PG8_BAR;
            PG8_LDB(B0, 1, 0); PG8_SCHED; PG8_LDA(At, 1, 0); PG8_STAGE(PG8_SA(0, 1), a2 + hstep, voffA);
            PG8_WAIT_L(8); PG8_BAR; PG8_WAIT_L(0); PG8_MMA(0, 0, At, B0); PG8_BAR; PG8_SCHED;
            PG8_LDB(B1, 1, 1); PG8_STAGE(PG8_SB(1, 0), b3, voffB);
            PG8_BAR; PG8_WAIT_L(0); PG8_MMA(0, 1, At, B1); PG8_BAR;
            PG8_LDA(At, 1, 1); PG8_STAGE(PG8_SA(1, 0), a3, voffA);
            PG8_BAR; PG8_WAIT_L(0); PG8_MMA(1, 0, At, B0); PG8_BAR; PG8_SCHED;
            PG8_STAGE(PG8_SB(1, 1), b3 + hstep, voffB);
            PG8_WAIT_V(6); PG8_BAR; PG8_MMA(1, 1, At, B1); PG8_BAR;
            }
        }
        if constexpr (ALIGN_EPI) { if (wr == 0) PG8_BAR; }
        if constexpr (!Epi::AFTER_DRAIN) { E(acc, cur, wr, wc, fr, fq); S.done(cur); }
        if (!has_next) break;
#pragma unroll
        for (int a = 0; a < 2; ++a)
#pragma unroll
            for (int b = 0; b < 2; ++b)
#pragma unroll
                for (int m = 0; m < 4; ++m)
#pragma unroll
                    for (int n = 0; n < 2; ++n) acc[a][b][m][n] = (f32x4){0.f, 0.f, 0.f, 0.f};
        cur = nxt; cA = nA; cB = nB; ++ui;
        if constexpr (ALIGN_EPI) { if (wr == 1) PG8_BAR; }
    }
    PG8_WAIT_V(0);
    if constexpr (!ALIGN_EPI) { if (wr == 0) PG8_BAR; }
    PG8_BAR;
    if constexpr (Epi::AFTER_DRAIN) { E.fused(acc, cur, wr, wc, fr, fq, lds, wid, lane); S.done(cur); }
#undef PG8_SA
#undef PG8_SB
#undef PG8_STAGE
#undef PG8_LDA
#undef PG8_LDB
#undef PG8_MMA
#undef PG8_WAIT_V
#undef PG8_WAIT_L
#undef PG8_BAR
#undef PG8_SCHED
}
}
namespace pg8 {
struct EpiF32 {
    static constexpr bool PERM = false, AFTER_DRAIN = false;
    float* C; int ldc; const float* bias;
    __device__ __forceinline__ void operator()(const f32x4 (&acc)[2][2][4][2], const Unit& u, int wr, int wc, int fr, int fq) const {
        const int row0 = u.pm * BM + wr * 64 + fr, col0 = u.pn * BM + wc * 32 + 4 * fq;
        f32x4 bv[2][2];
#pragma unroll
        for (int bj = 0; bj < 2; ++bj)
#pragma unroll
            for (int n = 0; n < 2; ++n) bv[bj][n] = bias ? *(const f32x4*)(bias + col0 + bj * HALF + n * 16) : (f32x4){0.f, 0.f, 0.f, 0.f};
#pragma unroll
        for (int ai = 0; ai < 2; ++ai)
#pragma unroll
            for (int m = 0; m < 4; ++m) { float* rowp = C + (size_t)(row0 + ai * HALF + m * 16) * ldc + col0;
#pragma unroll
                for (int bj = 0; bj < 2; ++bj)
#pragma unroll
                    for (int n = 0; n < 2; ++n) *(f32x4*)(rowp + bj * HALF + n * 16) = acc[ai][bj][m][n] + bv[bj][n]; }
    }
};
}
#define XB_TMO      128
#define XB_XCNT(j)  (256  + 64 * (j))
#define XB_XSUB(j)  (1280 + 64 * (j))
#define XB_XGEN(j)  (2304 + 64 * (j))
#define XB_TOP      3328
#define XB_TOPGEN   3392
#define XCD_BAR_WORDS 3456
#define XB_SPIN_CAP (1u << 18)

__device__ __forceinline__ unsigned xb_ld(unsigned* p)              { return __hip_atomic_load(p, __ATOMIC_RELAXED, __HIP_MEMORY_SCOPE_AGENT); }
__device__ __forceinline__ unsigned xb_add(unsigned* p, unsigned v) { return __hip_atomic_fetch_add(p, v, __ATOMIC_RELAXED, __HIP_MEMORY_SCOPE_AGENT); }
__device__ __forceinline__ unsigned xb_xcc_id() { return (unsigned)__builtin_amdgcn_s_getreg((3 << 11) | 20) & 0xFu; }
#define XB_SPIN(cond, bar) do { unsigned _sp = 0; while (cond) { __builtin_amdgcn_s_sleep(1); \
    if ((++_sp & 255u) == 0u) { if (xb_ld(&(bar)[XB_TMO])) break; if (_sp > XB_SPIN_CAP) { atomicAdd(&(bar)[XB_TMO], 1u); break; } } } } while (0)

struct XcdBarrier {
    unsigned* bar; unsigned x;
    volatile LAS unsigned* st;
};

__device__ __forceinline__ XcdBarrier xcd_barrier_post(unsigned* bar, volatile LAS unsigned* st) {
    XcdBarrier b; b.bar = bar; b.x = xb_xcc_id(); b.st = st;
    if (threadIdx.x == 0) (void)xb_add(&bar[XB_XCNT(b.x)], 1u);
    return b;
}
__device__ __forceinline__ void xcd_barrier_complete(unsigned* bar, unsigned x, unsigned& nloc, unsigned& nx) {
    const unsigned G = gridDim.x * gridDim.y * gridDim.z;
    unsigned sum, cnt, mine, sp = 0u;
    for (;;) {
        sum = 0u; cnt = 0u; mine = 0u;
#pragma unroll
        for (unsigned j = 0; j < 16; ++j) { const unsigned c = xb_ld(&bar[XB_XCNT(j)]); sum += c; cnt += (c > 0u) ? 1u : 0u; mine = (j == x) ? c : mine; }
        if (sum == G) break;
        __builtin_amdgcn_s_sleep(1);
        if ((++sp & 255u) == 0u) { if (xb_ld(&bar[XB_TMO])) break; if (sp > XB_SPIN_CAP) { atomicAdd(&bar[XB_TMO], 1u); break; } }
    }
    nloc = mine > 0u ? mine : 1u; nx = cnt > 0u ? cnt : 1u;
}

__device__ __forceinline__ void xcd_barrier(const XcdBarrier& b) {
    asm volatile("s_waitcnt vmcnt(0)" ::: "memory");
    __syncthreads();
    if (threadIdx.x == 0) {
        unsigned* bar = b.bar;
        __builtin_amdgcn_s_waitcnt(0);
        unsigned nloc = b.st[0], nx = b.st[1];
        if (nloc == 0u) { xcd_barrier_complete(bar, b.x, nloc, nx); b.st[0] = nloc; b.st[1] = nx; }
        const unsigned old = xb_add(&bar[XB_XSUB(b.x)], 1u);
        const unsigned gen = old / nloc;
        if (old + 1u == (gen + 1u) * nloc) {
            __builtin_amdgcn_fence(__ATOMIC_RELEASE, "agent");
            asm volatile("s_waitcnt vmcnt(0)" ::: "memory");
            const unsigned og = xb_add(&bar[XB_TOP], 1u);
            const unsigned tg = og / nx;
            if (og + 1u == (tg + 1u) * nx) xb_add(&bar[XB_TOPGEN], 1u);
            else XB_SPIN(xb_ld(&bar[XB_TOPGEN]) == tg, bar);
            __builtin_amdgcn_fence(__ATOMIC_ACQUIRE, "agent");
            xb_add(&bar[XB_XGEN(b.x)], 1u);
            asm volatile("s_waitcnt vmcnt(0)" ::: "memory");
        } else {
            XB_SPIN(xb_ld(&bar[XB_XGEN(b.x)]) == gen, bar);
            __builtin_amdgcn_fence(__ATOMIC_ACQUIRE, "agent");
            asm volatile("s_waitcnt vmcnt(0)" ::: "memory");
        }
    }
    __syncthreads();
}

DEVI float wave_sum(float v) {
#pragma unroll
    for (int o = 32; o > 0; o >>= 1) v += __shfl_xor(v, o, 64);
    return v;
}
DEVI float wave_max(float v) {
#pragma unroll
    for (int o = 32; o > 0; o >>= 1) v = fmaxf(v, __shfl_xor(v, o, 64));
    return v;
}
DEVI float sigm(float x) { return 1.f / (1.f + expf(-x)); }
DEVI float gelu_t(float x) { return 0.5f * x * (1.f + tanhf(0.7978845608028654f * (x + 0.044715f * x * x * x))); }
DEVI float softplus_(float x) { return fmaxf(x, 0.f) + log1pf(expf(-fabsf(x))); }

DEVI float block_sum256(float v, float* red, int tid) {
    v = wave_sum(v);
    __syncthreads();
    if ((tid & 63) == 0) red[tid >> 6] = v;
    __syncthreads();
    return red[0] + red[1] + red[2] + red[3];
}

DEVI void ln_kernel(const float* xres, float alpha, const float* add, const float* __restrict__ g, const float* __restrict__ bt,
                    float* out, bf16* outb, int bid, float* sm) {
    __syncthreads();
    const size_t row = bid;
    const int tid = tidx() & 255;
    float v[4];
#pragma unroll
    for (int i = 0; i < 4; ++i) {
        const size_t idx = row * DM + tid + i * 256;
        v[i] = alpha * xres[idx] + (add ? add[idx] : 0.f);
    }
    const float mean = block_sum256(v[0] + v[1] + v[2] + v[3], sm, tid) * (1.f / DM);
    float q = 0.f;
#pragma unroll
    for (int i = 0; i < 4; ++i) { v[i] -= mean; q += v[i] * v[i]; }
    const float var = block_sum256(q, sm, tid) * (1.f / DM);
    const float rstd = rsqrtf(var + 1e-5f);
#pragma unroll
    for (int i = 0; i < 4; ++i) {
        const int c = tid + i * 256;
        const float o = v[i] * rstd * g[c] + bt[c];
        out[row * DM + c] = o;
        outb[row * DM + c] = (bf16)f2bf(o);
    }
}

struct GemmArgs {
    const float* A; const float* B; float* C; const int* rowidx; const int* zoff;
    long lda, sbk, sbn, ldc, sAz0, sAz1, sBz0, sBz1, sCz0, sCz1;
    int M, N, K, Z1, epi, pad;
};
DEVI void gemm_f32(const GemmArgs& g, int bx, int by, int z, bool live, float* sm) {
    float (*As)[68] = (float (*)[68])sm;
    float (*Bs)[68] = (float (*)[68])(sm + 16 * 68);
    const int z0 = z / g.Z1, z1 = z % g.Z1;
    int mbeg = 0, mend = g.M;
    if (g.zoff) { mbeg = g.zoff[z]; mend = g.zoff[z + 1]; }
    const int m0 = mbeg + by * 64;
    if (!live) mend = 0;
    const int n0 = bx * 64;
    const float* A = g.A + z0 * g.sAz0 + z1 * g.sAz1;
    const float* B = g.B + z0 * g.sBz0 + z1 * g.sBz1;
    float* C = g.C + z0 * g.sCz0 + z1 * g.sCz1;
    const int tid = tidx() & 255, tx = tid & 15, ty = tid >> 4;
    float acc[4][4];
#pragma unroll
    for (int i = 0; i < 4; ++i)
#pragma unroll
        for (int j = 0; j < 4; ++j) acc[i][j] = 0.f;
    long arow[4];
#pragma unroll
    for (int i = 0; i < 4; ++i) {
        const int r = (tid + i * 256) >> 4;
        const int row = m0 + r;
        if (row < mend) arow[i] = (long)(g.rowidx ? g.rowidx[row] : row) * g.lda; else arow[i] = -1;
    }
    __syncthreads();
    for (int k0 = 0; k0 < g.K; k0 += 16) {
#pragma unroll
        for (int i = 0; i < 4; ++i) {
            const int e = tid + i * 256, r = e >> 4, kk = e & 15;
            float v = 0.f;
            if (arow[i] >= 0 && k0 + kk < g.K) v = A[arow[i] + k0 + kk];
            As[kk][r] = v;
        }
#pragma unroll
        for (int i = 0; i < 4; ++i) {
            const int e = tid + i * 256, kk = e >> 6, n = e & 63;
            float v = 0.f;
            if (m0 < mend && n0 + n < g.N && k0 + kk < g.K) v = B[(long)(k0 + kk) * g.sbk + (long)(n0 + n) * g.sbn];
            Bs[kk][n] = v;
        }
        __syncthreads();
#pragma unroll
        for (int kk = 0; kk < 16; ++kk) {
            float a[4], b[4];
#pragma unroll
            for (int i = 0; i < 4; ++i) a[i] = As[kk][ty * 4 + i];
#pragma unroll
            for (int j = 0; j < 4; ++j) b[j] = Bs[kk][tx * 4 + j];
#pragma unroll
            for (int i = 0; i < 4; ++i)
#pragma unroll
                for (int j = 0; j < 4; ++j) acc[i][j] = fmaf(a[i], b[j], acc[i][j]);
        }
        __syncthreads();
    }
#pragma unroll
    for (int i = 0; i < 4; ++i) {
        const int row = m0 + ty * 4 + i;
        if (row >= mend) continue;
#pragma unroll
        for (int j = 0; j < 4; ++j) {
            const int col = n0 + tx * 4 + j;
            if (col >= g.N) continue;
            float* p = C + (long)row * g.ldc + col;
            float v = acc[i][j];
            if (g.epi == 1) { v = v * sigm(v) * (*p); }
            *p = v;
        }
    }
}
DEVI GemmArgs mk(const float* A, long lda, const float* B, long sbk, long sbn, float* C, long ldc, int M, int N, int K,
                 int Z1 = 1, long sAz0 = 0, long sAz1 = 0, long sBz0 = 0, long sBz1 = 0, long sCz0 = 0, long sCz1 = 0,
                 const int* rowidx = nullptr, const int* zoff = nullptr, int epi = 0) {
    GemmArgs g;
    g.A = A; g.B = B; g.C = C; g.rowidx = rowidx; g.zoff = zoff;
    g.lda = lda; g.sbk = sbk; g.sbn = sbn; g.ldc = ldc;
    g.sAz0 = sAz0; g.sAz1 = sAz1; g.sBz0 = sBz0; g.sBz1 = sBz1; g.sCz0 = sCz0; g.sCz1 = sCz1;
    g.M = M; g.N = N; g.K = K; g.Z1 = Z1; g.epi = epi; g.pad = 0;
    return g;
}
DEVI int gemm_tiles(const GemmArgs& g, int maxM, int Z) { return ((g.N + 63) / 64) * ((maxM + 63) / 64) * Z; }
DEVI bool gemm_tile_live(const GemmArgs& g, int maxM, int t) {
    const int nbx = (g.N + 63) / 64, nby = (maxM + 63) / 64;
    const int r = t / nbx, by = r % nby, z = r / nby;
    int mbeg = 0, mend = g.M;
    if (g.zoff) { mbeg = g.zoff[z]; mend = g.zoff[z + 1]; }
    return mbeg + by * 64 < mend;
}
DEVI void gemm_tile(const GemmArgs& g, int maxM, int t, bool live, float* sm) {
    const int nbx = (g.N + 63) / 64, nby = (maxM + 63) / 64;
    const int bx = t % nbx, r = t / nbx;
    gemm_f32(g, bx, r % nby, r / nby, live, sm);
}

DEVI void glu_kernel(const bf16* __restrict__ cols, float* __restrict__ h, int bid) {
    const size_t t = bid; const int c = tidx() & 255;
    h[t * 256 + c] = bf2f(cols[t * DINP + OFF_CV + c]) * sigm(bf2f(cols[t * DINP + OFF_CG + c]));
}
DEVI void conv_kernel(const float* __restrict__ h, const float* __restrict__ w, const float* __restrict__ bias,
                      const float* __restrict__ gg, const float* __restrict__ gb, bf16* __restrict__ mix, int bid) {
    const int t = bid, c = tidx() & 255;
    float acc = bias[c];
#pragma unroll 4
    for (int j = 0; j < 31; ++j) {
        const int tt = t - 30 + j;
        if (tt >= 0) acc = fmaf(h[(size_t)tt * 256 + c], w[j * 256 + c], acc);
    }
    const float mean = wave_sum(acc) * (1.f / 64.f);
    const float d = acc - mean;
    const float var = wave_sum(d * d) * (1.f / 64.f);
    const float y = d * rsqrtf(var + 1e-5f) * gg[c] + gb[c];
    mix[(size_t)t * DM + 0 + c] = (bf16)f2bf(y * sigm(y));
}

DEVI void gmlp_pre(const bf16* __restrict__ cols, const float* __restrict__ lg, const float* __restrict__ lb,
                   float* __restrict__ ub, float* __restrict__ vb, int bid, float* sm) {
    __syncthreads();
    const size_t t = bid; const int c = tidx() & 255;
    ub[t * 256 + c] = gelu_t(bf2f(cols[t * DINP + OFF_GU + c]));
    const float v = gelu_t(bf2f(cols[t * DINP + OFF_GV + c]));
    const float mean = block_sum256(v, sm, c) * (1.f / 256.f);
    const float d = v - mean;
    const float var = block_sum256(d * d, sm, c) * (1.f / 256.f);
    vb[t * 256 + c] = d * rsqrtf(var + 1e-5f) * lg[c] + lb[c];
}
DEVI void gmlp_mix(const float* __restrict__ ub, const float* __restrict__ vb, const float* __restrict__ ws,
                   const float* __restrict__ bs, bf16* __restrict__ mix, int bid) {
    const int t = bid, c = tidx() & 255, h = c >> 6, tt = t & 127, base = t - tt;
    float acc = bs[h * 128 + tt];
    const float* wr = ws + ((size_t)h * 128 + tt) * 128;
#pragma unroll 4
    for (int s = 0; s <= tt; ++s) acc = fmaf(wr[s], vb[(size_t)(base + s) * 256 + c], acc);
    mix[(size_t)t * DM + 512 + c] = (bf16)f2bf(ub[(size_t)t * 256 + c] * acc);
}

struct RwkvP {
    const bf16* cols; const float* mu; const float* w0; const float* w_up; const float* a0; const float* a_up; const float* g_up;
    const float* k_k; const float* k_a; const float* r_k; const float* vd; const float* v_mu; const float* v0; const float* v_up;
    float* vfirst; bf16* R; float* LW; bf16* K; bf16* V; bf16* A; bf16* Bv; float* G; float* BON;
    int layer, pad;
};
DEVI void rwkv_prep(const RwkvP& p, int bid, float* sm) {
    __syncthreads();
    float* y = sm;
    float* vds = sm + 1024;
    const int t = bid, c = tidx() & 255;
#pragma unroll
    for (int q = 0; q < 4; ++q) {
        const int j = c + q * 256;
        const float cur = bf2f(p.cols[(size_t)t * DINP + OFF_RW + j]);
        const float prv = t > 0 ? bf2f(p.cols[(size_t)(t - 1) * DINP + OFF_RW + j]) : 0.f;
        y[j] = cur + p.mu[j] * (prv - cur);
    }
    if (p.layer > 0 && c < 32) {
        const float cur = p.vd[(size_t)t * 32 + c];
        const float prv = t > 0 ? p.vd[(size_t)(t - 1) * 32 + c] : 0.f;
        vds[c] = cur + p.v_mu[c] * (prv - cur);
    }
    __syncthreads();
    float tw = 0.f, sg = 0.f;
    if (c < 64) tw = tanhf(y[768 + c]);
    if (c >= 128) sg = sigm(y[896 + (c - 128)]);
    __syncthreads();
    if (c < 64) y[768 + c] = tw;
    if (c >= 128) y[896 + (c - 128)] = sg;
    __syncthreads();
    const float r = y[c], k = y[256 + c];
    float v = y[512 + c];
    float wl = p.w0[c], al = p.a0[c], gl = 0.f;
#pragma unroll 4
    for (int j = 0; j < 64; ++j) { wl = fmaf(y[768 + j], p.w_up[j * 256 + c], wl); al = fmaf(y[832 + j], p.a_up[j * 256 + c], al); }
#pragma unroll 4
    for (int j = 0; j < 128; ++j) gl = fmaf(y[896 + j], p.g_up[j * 256 + c], gl);
    const float wlog = -softplus_(-wl) - 0.5f;
    const float a = sigm(al);
    if (p.layer == 0) {
        p.vfirst[(size_t)t * 256 + c] = v;
    } else {
        float vm = p.v0[c];
#pragma unroll 4
        for (int j = 0; j < 32; ++j) vm = fmaf(vds[j], p.v_up[j * 256 + c], vm);
        vm = sigm(vm);
        v = v + (p.vfirst[(size_t)t * 256 + c] - v) * vm;
    }
    float kk = k * p.k_k[c];
    const float nrm = sqrtf(wave_sum(kk * kk));
    kk = kk / fmaxf(nrm, 1e-12f);
    const float k2 = k * (1.f + (a - 1.f) * p.k_a[c]);
    const float bd = wave_sum(r * k2 * p.r_k[c]);
    const size_t o = (size_t)t * 256 + c;
    p.R[o] = (bf16)f2bf(r); p.LW[o] = -expf(wlog); p.K[o] = (bf16)f2bf(k2); p.V[o] = (bf16)f2bf(v); p.A[o] = (bf16)f2bf(-kk); p.Bv[o] = (bf16)f2bf(kk * a); p.G[o] = gl; p.BON[o] = bd * v;
}
DEVI void rwkv_scan(float* R, const float* __restrict__ W, const float* __restrict__ K, const float* __restrict__ V,
                    const float* __restrict__ A, const float* __restrict__ Bv, float* sm0) {
    float (*sr)[256] = (float (*)[256])sm0, (*sw)[256] = sr + 4, (*sk)[256] = sr + 8, (*sa)[256] = sr + 12, (*sb)[256] = sr + 16, (*sv)[256] = sr + 20;
    const int vt = tidx(); const bool act = vt < 256;
    const int tid = vt & 255, h = tid >> 6, lane = tid & 63;
    float st[64];
#pragma unroll
    for (int i = 0; i < 64; ++i) st[i] = 0.f;
    for (int t0 = 0; t0 < SEQ; t0 += 4) {
        __syncthreads();
        if (act) {
#pragma unroll
            for (int s = 0; s < 4; ++s) {
                const size_t idx = (size_t)(t0 + s) * 256 + tid;
                sr[s][tid] = R[idx]; sw[s][tid] = W[idx]; sk[s][tid] = K[idx]; sa[s][tid] = A[idx]; sb[s][tid] = Bv[idx]; sv[s][tid] = V[idx];
            }
        }
        __syncthreads();
        if (act) {
#pragma unroll 1
            for (int s = 0; s < 4; ++s) {
                const float vt_ = sv[s][tid];
                const float* pa = &sa[s][h * 64]; const float* pw = &sw[s][h * 64]; const float* pb = &sb[s][h * 64];
                const float* pk = &sk[s][h * 64]; const float* pr = &sr[s][h * 64];
                float sa_ = 0.f;
#pragma unroll
                for (int k = 0; k < 64; ++k) sa_ = fmaf(st[k], pa[k], sa_);
#pragma unroll
                for (int k = 0; k < 64; ++k) st[k] = fmaf(st[k], pw[k], fmaf(sa_, pb[k], vt_ * pk[k]));
                float o = 0.f;
#pragma unroll
                for (int k = 0; k < 64; ++k) o = fmaf(st[k], pr[k], o);
                R[(size_t)(t0 + s) * 256 + h * 64 + lane] = o;
            }
        }
    }
    __syncthreads();
}
DEVI void rwkv_post(const float* __restrict__ O, const float* __restrict__ BON, const float* __restrict__ G,
                    const float* __restrict__ gg, const float* __restrict__ gb, bf16* __restrict__ mix, int bid) {
    const size_t t = bid; const int c = tidx() & 255;
    const float o = O[t * 256 + c];
    const float mean = wave_sum(o) * (1.f / 64.f);
    const float d = o - mean;
    const float var = wave_sum(d * d) * (1.f / 64.f);
    const float y = d * rsqrtf(var + 64e-5f) * gg[c] + gb[c];
    mix[t * DM + 256 + c] = (bf16)f2bf((y + BON[t * 256 + c]) * G[t * 256 + c]);
}

DEVI void nsa_prep(const bf16* __restrict__ cols, float* __restrict__ qrot, float* __restrict__ ksr,
                   float* __restrict__ kwr, float* __restrict__ gates, int bid) {
    const int t = bid, c = tidx() & 255;
    const int d = c & 63, j = d & 31;
    const float inv = powf(10000.f, -(float)j / 32.f);
    const float ang = (float)t * inv;
    float sn, cs; sincosf(ang, &sn, &cs);
    {
        const bf16* q = cols + (size_t)t * DINP + OFF_Q + (c & ~63);
        const float x1 = bf2f(q[j]), x2 = bf2f(q[j + 32]);
        qrot[(size_t)t * 256 + c] = d < 32 ? x1 * cs - x2 * sn : x2 * cs + x1 * sn;
    }
    if (c < 128) {
        const bf16* kp = cols + (size_t)t * DINP + (c < 64 ? OFF_KS : OFF_KW);
        const float x1 = bf2f(kp[j]), x2 = bf2f(kp[j + 32]);
        const float v = d < 32 ? x1 * cs - x2 * sn : x2 * cs + x1 * sn;
        if (c < 64) ksr[(size_t)t * 64 + d] = v; else kwr[(size_t)t * 64 + d] = v;
    }
    if (c < 12) gates[(size_t)t * 12 + c] = sigm(bf2f(cols[(size_t)t * DINP + OFF_GT + c]));
}
DEVI void cmp_gather(const bf16* __restrict__ cols, const float* __restrict__ pek, const float* __restrict__ pev,
                     float* __restrict__ bk, float* __restrict__ bv, int bid) {
    const int n = bid, tid = tidx() & 255;
    for (int i = tid; i < 2048; i += 256) {
        const int l = i >> 6, d = i & 63;
        const size_t row = (size_t)(16 * n + l) * DINP;
        bk[(size_t)n * 2048 + i] = bf2f(cols[row + OFF_KC + d]) + pek[i];
        bv[(size_t)n * 2048 + i] = bf2f(cols[row + OFF_VC + d]) + pev[i];
    }
}
DEVI void gelu_inplace(float* p, int n, int bid) {
    const int i = bid * 256 + (tidx() & 255);
    if (i < n) p[i] = gelu_t(p[i]);
}

DEVI void wave_softmax(float* s, int n, int lane) {
    float m = -INFINITY;
    for (int i = lane; i < n; i += 64) m = fmaxf(m, s[i]);
    m = wave_max(m);
    if (m == -INFINITY) { for (int i = lane; i < n; i += 64) s[i] = 0.f; return; }
    float sum = 0.f;
    for (int i = lane; i < n; i += 64) { const float p = expf(s[i] - m); s[i] = p; sum += p; }
    sum = wave_sum(sum);
    const float inv = 1.f / fmaxf(sum, 1e-20f);
    for (int i = lane; i < n; i += 64) s[i] *= inv;
}
DEVI void dot4(const float* q  , const float* __restrict__ krow, float* out4) {
    float a0 = 0.f, a1 = 0.f, a2 = 0.f, a3 = 0.f;
#pragma unroll
    for (int d = 0; d < 64; d += 4) {
        const float4 kv = *(const float4*)(krow + d);
        a0 += q[d] * kv.x + q[d + 1] * kv.y + q[d + 2] * kv.z + q[d + 3] * kv.w;
        a1 += q[64 + d] * kv.x + q[64 + d + 1] * kv.y + q[64 + d + 2] * kv.z + q[64 + d + 3] * kv.w;
        a2 += q[128 + d] * kv.x + q[128 + d + 1] * kv.y + q[128 + d + 2] * kv.z + q[128 + d + 3] * kv.w;
        a3 += q[192 + d] * kv.x + q[192 + d + 1] * kv.y + q[192 + d + 2] * kv.z + q[192 + d + 3] * kv.w;
    }
    out4[0] = a0; out4[1] = a1; out4[2] = a2; out4[3] = a3;
}
DEVI void nsa_attn(const bf16* __restrict__ cols, const float* __restrict__ qrot, const float* __restrict__ ksr,
                   const float* __restrict__ kwr, const float* __restrict__ gates, const float* __restrict__ kcmp,
                   const float* __restrict__ vcmp, bf16* __restrict__ mix, int bid, float* sm) {
    __syncthreads();
    float* q = sm; float* qr = sm + 256;
    float (*sc)[1024] = (float (*)[1024])(sm + 512);
    float* imp = sm + 512 + 4096;
    int* sel = (int*)(sm + 512 + 4096 + 128);
    const int pos = bid, tid = tidx() & 255, h = tid >> 6, lane = tid & 63;
    q[tid] = bf2f(cols[(size_t)pos * DINP + OFF_Q + tid]);
    qr[tid] = qrot[(size_t)pos * 256 + tid];
    __syncthreads();
    int ncv = pos >= 31 ? (pos - 31) / 16 + 1 : 0;
    if (ncv > NCMP) ncv = NCMP;
    for (int n = tid; n < 512; n += 256) {
        if (n < ncv) {
            float d4[4]; dot4(q, kcmp + (size_t)n * 64, d4);
            sc[0][n] = d4[0] * 0.125f; sc[1][n] = d4[1] * 0.125f; sc[2][n] = d4[2] * 0.125f; sc[3][n] = d4[3] * 0.125f;
        } else { sc[0][n] = 0.f; sc[1][n] = 0.f; sc[2][n] = 0.f; sc[3][n] = 0.f; }
    }
    __syncthreads();
    wave_softmax(sc[h], ncv, lane);
    __syncthreads();
    float oc = 0.f;
#pragma unroll 4
    for (int n = 0; n < ncv; ++n) oc = fmaf(sc[h][n], vcmp[(size_t)n * 64 + lane], oc);
    if (tid < 128) {
        const int j = tid;
        auto ps = [&](int n) -> float { return (n >= 0 && n < 512) ? (sc[0][n] + sc[1][n] + sc[2][n] + sc[3][n]) : 0.f; };
        const float v = 0.5f * ps(4 * j - 1) + ps(4 * j) + ps(4 * j + 1) + ps(4 * j + 2) + 0.5f * ps(4 * j + 3);
        const int cur = pos >> 6;
        float key;
        if (j == cur || j == 0) key = INFINITY; else if (j <= cur) key = v; else key = -1.f;
        imp[j] = key;
    }
    __syncthreads();
    if (h == 0) {
        float v0 = imp[lane], v1 = imp[lane + 64];
        for (int r = 0; r < 16; ++r) {
            float bv; int bi;
            if (v1 > v0) { bv = v1; bi = lane + 64; } else { bv = v0; bi = lane; }
#pragma unroll
            for (int o = 32; o > 0; o >>= 1) {
                const float ov = __shfl_xor(bv, o, 64); const int oi = __shfl_xor(bi, o, 64);
                if (ov > bv || (ov == bv && oi < bi)) { bv = ov; bi = oi; }
            }
            if (lane == 0) sel[r] = bi;
            if (bi == lane) v0 = -2.f;
            if (bi == lane + 64) v1 = -2.f;
        }
    }
    __syncthreads();
    for (int i = tid; i < 1024; i += 256) {
        const int kp = sel[i >> 6] * 64 + (i & 63);
        if (kp <= pos) {
            float d4[4]; dot4(qr, ksr + (size_t)kp * 64, d4);
            sc[0][i] = d4[0] * 0.125f; sc[1][i] = d4[1] * 0.125f; sc[2][i] = d4[2] * 0.125f; sc[3][i] = d4[3] * 0.125f;
        } else { sc[0][i] = -INFINITY; sc[1][i] = -INFINITY; sc[2][i] = -INFINITY; sc[3][i] = -INFINITY; }
    }
    __syncthreads();
    wave_softmax(sc[h], 1024, lane);
    __syncthreads();
    float os = 0.f;
#pragma unroll 2
    for (int i = 0; i < 1024; ++i) {
        const float p = sc[h][i];
        if (p != 0.f) { const int kp = sel[i >> 6] * 64 + (i & 63); os = fmaf(p, bf2f(cols[(size_t)kp * DINP + OFF_VS + lane]), os); }
    }
    __syncthreads();
    for (int i = tid; i < 512; i += 256) {
        const int kp = pos - 511 + i;
        if (kp >= 0) {
            float d4[4]; dot4(qr, kwr + (size_t)kp * 64, d4);
            sc[0][i] = d4[0] * 0.125f; sc[1][i] = d4[1] * 0.125f; sc[2][i] = d4[2] * 0.125f; sc[3][i] = d4[3] * 0.125f;
        } else { sc[0][i] = -INFINITY; sc[1][i] = -INFINITY; sc[2][i] = -INFINITY; sc[3][i] = -INFINITY; }
    }
    __syncthreads();
    wave_softmax(sc[h], 512, lane);
    __syncthreads();
    float ow = 0.f;
#pragma unroll 4
    for (int i = 0; i < 512; ++i) {
        const int kp = pos - 511 + i;
        if (kp >= 0) ow = fmaf(sc[h][i], bf2f(cols[(size_t)kp * DINP + OFF_VW + lane]), ow);
    }
    const float* gt = gates + (size_t)pos * 12 + h * 3;
    mix[(size_t)pos * DM + 768 + tid] = (bf16)f2bf(gt[0] * oc + gt[1] * os + gt[2] * ow);
}

DEVI void softmax256(float* s, float scale, int bid, float* sm) {
    __syncthreads();
    const size_t row = bid; const int tid = tidx() & 255;
    const float v = s[row * 256 + tid] * scale;
    float m = wave_max(v);
    if ((tid & 63) == 0) sm[8 + (tid >> 6)] = m;
    __syncthreads();
    m = fmaxf(fmaxf(sm[8], sm[9]), fmaxf(sm[10], sm[11]));
    const float p = expf(v - m);
    const float sum = block_sum256(p, sm, tid);
    s[row * 256 + tid] = p / sum;
}

DEVI void router_kernel(const float* __restrict__ x, const float* __restrict__ rw, const float* __restrict__ rb,
                        int* __restrict__ te, float* __restrict__ tw, int bid, float* sm) {
    __syncthreads();
    float (*part)[16] = (float (*)[16])sm;
    const size_t t = bid; const int tid = tidx() & 255;
    float acc[16];
#pragma unroll
    for (int e = 0; e < 16; ++e) acc[e] = 0.f;
#pragma unroll 1
    for (int i = tid; i < DM; i += 256) {
        const float xv = x[t * DM + i];
#pragma unroll
        for (int e = 0; e < 16; ++e) acc[e] = fmaf(xv, rw[i * 16 + e], acc[e]);
    }
#pragma unroll
    for (int e = 0; e < 16; ++e) acc[e] = wave_sum(acc[e]);
    if ((tid & 63) == 0) {
#pragma unroll
        for (int e = 0; e < 16; ++e) part[tid >> 6][e] = acc[e];
    }
    __syncthreads();
    if (tid == 0) {
        float lg[16], pr[16], sl[16];
        float m = -INFINITY;
#pragma unroll
        for (int e = 0; e < 16; ++e) { lg[e] = part[0][e] + part[1][e] + part[2][e] + part[3][e]; m = fmaxf(m, lg[e]); }
        float sum = 0.f;
#pragma unroll
        for (int e = 0; e < 16; ++e) { pr[e] = expf(lg[e] - m); sum += pr[e]; }
#pragma unroll
        for (int e = 0; e < 16; ++e) { pr[e] /= sum; sl[e] = pr[e] + rb[e]; }
        int bg = 0; float bgs = -INFINITY;
#pragma unroll
        for (int gI = 0; gI < 4; ++gI) {
            float m1 = -INFINITY, m2 = -INFINITY;
#pragma unroll
            for (int j = 0; j < 4; ++j) { const float v = sl[gI * 4 + j]; if (v > m1) { m2 = m1; m1 = v; } else if (v > m2) m2 = v; }
            const float sc = m1 + m2;
            if (sc > bgs) { bgs = sc; bg = gI; }
        }
        int e0 = -1, e1 = -1; float s0 = -INFINITY, s1 = -INFINITY, p0 = 0.f, p1 = 0.f;
#pragma unroll
        for (int e = 0; e < 16; ++e) {
            if ((e >> 2) == bg) {
                const float v = sl[e];
                if (v > s0) { s1 = s0; e1 = e0; p1 = p0; s0 = v; e0 = e; p0 = pr[e]; } else if (v > s1) { s1 = v; e1 = e; p1 = pr[e]; }
            }
        }
        const float wsum = p0 + p1;
        te[t * 2] = e0; te[t * 2 + 1] = e1;
        tw[t * 2] = p0 / wsum; tw[t * 2 + 1] = p1 / wsum;
    }
}
DEVI void moe_lists(const int* __restrict__ te, int* __restrict__ off, int* __restrict__ list, int* __restrict__ slotpos, float* sm0) {
    int* cnt = (int*)sm0;
    int* offs = cnt + 16;
    const int w = tidx() >> 6, lane = tidx() & 63;
    __syncthreads();
    for (int ee = 0; ee < 2; ++ee) {
        const int e = w * 2 + ee;
        int c = 0;
        for (int base = 0; base < NTOK; base += 64) {
            const int tok = base + lane;
            const bool m = (te[tok * 2] == e) || (te[tok * 2 + 1] == e);
            c += __popcll(__ballot(m));
        }
        if (lane == 0) cnt[e] = c;
    }
    __syncthreads();
    if (tidx() == 0) {
        int s = 0;
        for (int i = 0; i < 16; ++i) { offs[i] = s; off[i] = s; s += cnt[i]; }
        offs[16] = s; off[16] = s;
    }
    __syncthreads();
    for (int ee = 0; ee < 2; ++ee) {
        const int e = w * 2 + ee;
        int pos = offs[e];
        for (int base = 0; base < NTOK; base += 64) {
            const int tok = base + lane;
            const int a = te[tok * 2], b = te[tok * 2 + 1];
            const bool m = (a == e) || (b == e);
            const unsigned long long mask = __ballot(m);
            if (m) {
                const int p = pos + __popcll(mask & ((1ull << lane) - 1ull));
                list[p] = tok;
                slotpos[tok * 2 + (a == e ? 0 : 1)] = p;
            }
            pos += __popcll(mask);
        }
    }
    __syncthreads();
}
DEVI void moe_combine_ln(const float* x, const float* __restrict__ Dp, const int* __restrict__ te,
                         const float* __restrict__ tw, const int* __restrict__ slotpos,
                         const float* __restrict__ g, const float* __restrict__ bt, float* out, bf16* outb, int bid, float* sm) {
    __syncthreads();
    const size_t t = bid; const int tid = tidx() & 255;
    int ea = te[t * 2], eb = te[t * 2 + 1];
    float wa = tw[t * 2], wb = tw[t * 2 + 1];
    size_t pa = slotpos[t * 2], pb = slotpos[t * 2 + 1];
    if (eb < ea) { const float tf = wa; wa = wb; wb = tf; const size_t tp = pa; pa = pb; pb = tp; }
    float v[4];
#pragma unroll
    for (int i = 0; i < 4; ++i) {
        const int c = tid + i * 256;
        float y = wa * Dp[pa * DM + c];
        y = y + wb * Dp[pb * DM + c];
        v[i] = ALPHA * x[t * DM + c] + y;
    }
    const float mean = block_sum256(v[0] + v[1] + v[2] + v[3], sm, tid) * (1.f / DM);
    float q = 0.f;
#pragma unroll
    for (int i = 0; i < 4; ++i) { v[i] -= mean; q += v[i] * v[i]; }
    const float var = block_sum256(q, sm, tid) * (1.f / DM);
    const float rstd = rsqrtf(var + 1e-5f);
#pragma unroll
    for (int i = 0; i < 4; ++i) {
        const int c = tid + i * 256;
        const float o = v[i] * rstd * g[c] + bt[c];
        out[t * DM + c] = o;
        outb[t * DM + c] = (bf16)f2bf(o);
    }
}
typedef short bf16x8 __attribute__((ext_vector_type(8)));
typedef short s16x4 __attribute__((ext_vector_type(4)));
typedef float f32x16 __attribute__((ext_vector_type(16)));
typedef float f32x2_t __attribute__((ext_vector_type(2)));
typedef __bf16 bf16x2_t __attribute__((ext_vector_type(2)));
DEVI unsigned cvtpk(float lo, float hi) { f32x2_t v = {lo, hi}; bf16x2_t b = __builtin_convertvector(v, bf16x2_t); return __builtin_bit_cast(unsigned, b); }
constexpr float QSCL = 0.125f * 1.4426950408889634f;

struct NsaP {
    const bf16 *QN, *QR, *KSR, *KWR, *VST, *VWT, *KCMP, *VCMPT;
    const float* GATES;
    bf16* MIX;
};
constexpr int NSA_KT = 0, NSA_VT = 16384, NSA_IA = 32768, NSA_IB = 65536, NSA_SELM = 98304, NSA_UNI = 99328;

DEVI int crow(int r, int hi) { return (r & 3) + 8 * (r >> 2) + 4 * hi; }

DEVI void nsa_ld(v4u& rk, v4u& rv, const bf16* kbase, const bf16* vbase, size_t vstride, int tid) {
    rk = *(const v4u*)((const char*)kbase + tid * 16);
    rv = *(const v4u*)((const char*)(vbase + (size_t)(tid >> 3) * vstride) + (tid & 7) * 16);
}
DEVI void nsa_st(LAS unsigned char* KTb, LAS unsigned char* VTb, const v4u& rk, const v4u& rv, int tid) {
    const int r = tid >> 3, c = tid & 7, off = r * 128 + ((c ^ (r & 7)) << 4);
    *(LAS v4u*)(KTb + off) = rk; *(LAS v4u*)(VTb + off) = rv;
}
DEVI void nsa_qk(f32x16& p0, f32x16& p1, const LAS unsigned char* KTb, const bf16x8 (&qf)[4], int q32, int hi) {
#pragma unroll
    for (int r = 0; r < 16; ++r) { p0[r] = 0.f; p1[r] = 0.f; }
#pragma unroll
    for (int ks = 0; ks < 4; ++ks) {
        const int c = ((2 * ks + hi) ^ (q32 & 7)) << 4;
        const bf16x8 a0 = *(const LAS bf16x8*)(KTb + q32 * 128 + c);
        const bf16x8 a1 = *(const LAS bf16x8*)(KTb + (32 + q32) * 128 + c);
        p0 = __builtin_amdgcn_mfma_f32_32x32x16_bf16(a0, qf[ks], p0, 0, 0, 0);
        p1 = __builtin_amdgcn_mfma_f32_32x32x16_bf16(a1, qf[ks], p1, 0, 0, 0);
    }
}
DEVI void nsa_pv(f32x16 (&o)[2], const LAS unsigned char* VTb, const bf16x8 (&pf)[4], int q32, int hi) {
#pragma unroll
    for (int db = 0; db < 2; ++db) {
        const int d = 32 * db + q32;
        const LAS unsigned char* rowp = VTb + d * 128 + 8 * hi;
#pragma unroll
        for (int s = 0; s < 4; ++s) {
            const s16x4 lo = *(const LAS s16x4*)(rowp + (((2 * s) ^ (d & 7)) << 4));
            const s16x4 h4 = *(const LAS s16x4*)(rowp + (((2 * s + 1) ^ (d & 7)) << 4));
            const bf16x8 a = {lo[0], lo[1], lo[2], lo[3], h4[0], h4[1], h4[2], h4[3]};
            o[db] = __builtin_amdgcn_mfma_f32_32x32x16_bf16(a, pf[s], o[db], 0, 0, 0);
        }
    }
}
DEVI void nsa_pack(bf16x8 (&pf)[4], const f32x16& p0, const f32x16& p1) {
#pragma unroll
    for (int s = 0; s < 2; ++s) {
        unsigned w0[4], w1[4];
#pragma unroll
        for (int j = 0; j < 4; ++j) { w0[j] = cvtpk(p0[8 * s + 2 * j], p0[8 * s + 2 * j + 1]); w1[j] = cvtpk(p1[8 * s + 2 * j], p1[8 * s + 2 * j + 1]); }
        pf[s] = __builtin_bit_cast(bf16x8, (v4u){w0[0], w0[1], w0[2], w0[3]});
        pf[2 + s] = __builtin_bit_cast(bf16x8, (v4u){w1[0], w1[1], w1[2], w1[3]});
    }
}
DEVI void nsa_softmax(f32x16& p0, f32x16& p1, float& m, float& l, f32x16 (&o)[2], bf16x8 (&pf)[4]) {
    float mx = -INFINITY;
#pragma unroll
    for (int r = 0; r < 16; ++r) mx = fmaxf(mx, fmaxf(p0[r], p1[r]));
    mx = fmaxf(mx, __shfl_xor(mx, 32, 64));
    const float mn = fmaxf(m, mx);
    const float ms = (mn == -INFINITY) ? 0.f : mn;
    const float alpha = __builtin_amdgcn_exp2f(m - ms);
    float sum = 0.f;
#pragma unroll
    for (int r = 0; r < 16; ++r) { p0[r] = __builtin_amdgcn_exp2f(p0[r] - ms); p1[r] = __builtin_amdgcn_exp2f(p1[r] - ms); sum += p0[r] + p1[r]; }
    sum += __shfl_xor(sum, 32, 64);
    l = l * alpha + sum; m = mn;
#pragma unroll
    for (int r = 0; r < 16; ++r) { o[0][r] *= alpha; o[1][r] *= alpha; }
    nsa_pack(pf, p0, p1);
}
DEVI void nsa_loadq(bf16x8 (&qf)[4], const bf16* Q, int tq, int head, int hi) {
    const bf16* qp = Q + (size_t)tq * 256 + head * 64 + 8 * hi;
#pragma unroll
    for (int ks = 0; ks < 4; ++ks) qf[ks] = *(const bf16x8*)(qp + 16 * ks);
}

DEVI void nsa_unit(const NsaP& P, int u, LAS unsigned char* lds) {
    const int tid = tidx(), w = tid >> 6, lane = tid & 63, q32 = lane & 31, hi = lane >> 5;
    const int t0 = u * 64, cur = u;
    const int tl = 8 * w + (q32 >> 2), head = q32 & 3, tq = t0 + tl;
    LAS unsigned char* KT = lds + NSA_KT; LAS unsigned char* VT = lds + NSA_VT;
    LAS float* IA = (LAS float*)(lds + NSA_IA); LAS float* IB = (LAS float*)(lds + NSA_IB);
    LAS unsigned* SELM = (LAS unsigned*)(lds + NSA_SELM); LAS unsigned* UNI = (LAS unsigned*)(lds + NSA_UNI);
    __syncthreads();
    for (int i = tid; i < 2 * 64 * 128; i += 512) IA[i] = 0.f;
    if (tid < 4) UNI[tid] = 0u;
    f32x16 acc[2];
#pragma unroll
    for (int r = 0; r < 16; ++r) { acc[0][r] = 0.f; acc[1][r] = 0.f; }
    bf16x8 qf[4], pf[4];
    f32x16 o[2], p0, p1;
    v4u rk, rv;
    const float g_c = P.GATES[(size_t)tq * 12 + head * 3 + 0], g_s = P.GATES[(size_t)tq * 12 + head * 3 + 1], g_w = P.GATES[(size_t)tq * 12 + head * 3 + 2];

    {
        nsa_loadq(qf, P.QN, tq, head, hi);
        const int nlim = tq >= 31 ? (tq - 31) >> 4 : -1;
        const int nmaxu = (t0 + 63 - 31) >> 4;
        const int nct = (nmaxu >> 6) + 1;
        float m = -INFINITY, l = 0.f;
        for (int pass = 0; pass < 2; ++pass) {
#pragma unroll
            for (int r = 0; r < 16; ++r) { o[0][r] = 0.f; o[1][r] = 0.f; }
            const float rl = (pass == 1 && l > 0.f) ? 1.f / l : 0.f;
            nsa_ld(rk, rv, P.KCMP, P.VCMPT, 512, tid);
            __syncthreads();
            nsa_st(KT, VT, rk, rv, tid);
            __syncthreads();
            for (int jt = 0; jt < nct; ++jt) {
                const int buf = jt & 1;
                if (jt + 1 < nct) nsa_ld(rk, rv, P.KCMP + (size_t)(jt + 1) * 64 * 64, P.VCMPT + (jt + 1) * 64, 512, tid);
                nsa_qk(p0, p1, KT + buf * 8192, qf, q32, hi);
                const int nb = jt * 64;
#pragma unroll
                for (int r = 0; r < 16; ++r) { const int n = nb + crow(r, hi); if (n > nlim) p0[r] = -INFINITY; if (n + 32 > nlim) p1[r] = -INFINITY; }
                if (pass == 0) {
                    float mx = -INFINITY;
#pragma unroll
                    for (int r = 0; r < 16; ++r) mx = fmaxf(mx, fmaxf(p0[r], p1[r]));
                    mx = fmaxf(mx, __shfl_xor(mx, 32, 64));
                    const float mn = fmaxf(m, mx), ms = (mn == -INFINITY) ? 0.f : mn;
                    float sum = 0.f;
#pragma unroll
                    for (int r = 0; r < 16; ++r) sum += __builtin_amdgcn_exp2f(p0[r] - ms) + __builtin_amdgcn_exp2f(p1[r] - ms);
                    sum += __shfl_xor(sum, 32, 64);
                    l = l * __builtin_amdgcn_exp2f(m - ms) + sum; m = mn;
                } else {
                    const float ms = (m == -INFINITY) ? 0.f : m;
#pragma unroll
                    for (int r = 0; r < 16; ++r) { p0[r] = __builtin_amdgcn_exp2f(p0[r] - ms) * rl; p1[r] = __builtin_amdgcn_exp2f(p1[r] - ms) * rl; }
#pragma unroll
                    for (int half = 0; half < 2; ++half) {
#pragma unroll
                        for (int g = 0; g < 4; ++g) {
                            const f32x16& pp = half ? p1 : p0;
                            float a = pp[4 * g] + pp[4 * g + 1] + pp[4 * g + 2] + 0.5f * pp[4 * g + 3];
                            float b = 0.5f * pp[4 * g + 3];
                            a += __shfl_xor(a, 1, 64); a += __shfl_xor(a, 2, 64);
                            b += __shfl_xor(b, 1, 64); b += __shfl_xor(b, 2, 64);
                            const int j = (nb + 32 * half + 8 * g + 4 * hi) >> 2;
                            if (head == 0 && j < 128) { IA[tl * 128 + j] = a; IB[tl * 128 + j] = b; }
                        }
                    }
                    nsa_pack(pf, p0, p1);
                    nsa_pv(o, VT + buf * 8192, pf, q32, hi);
                }
                if (jt + 1 < nct) nsa_st(KT + (buf ^ 1) * 8192, VT + (buf ^ 1) * 8192, rk, rv, tid);
                __syncthreads();
            }
        }
#pragma unroll
        for (int r = 0; r < 16; ++r) { acc[0][r] = g_c * o[0][r]; acc[1][r] = g_c * o[1][r]; }
    }
    for (int tt = 0; tt < 8; ++tt) {
        const int tok = 8 * w + tt, tpos = t0 + tok;
        float v[2];
#pragma unroll
        for (int e = 0; e < 2; ++e) {
            const int j = lane + 64 * e;
            const float imp = IA[tok * 128 + j] + (j > 0 ? IB[tok * 128 + j - 1] : 0.f);
            v[e] = (j == cur || j == 0) ? INFINITY : (j <= cur ? imp : -1.f);
        }
        (void)tpos;
        unsigned m0 = 0u, m1 = 0u, m2 = 0u, m3 = 0u;
        for (int r = 0; r < 16; ++r) {
            float bv; int bi;
            if (v[1] > v[0]) { bv = v[1]; bi = lane + 64; } else { bv = v[0]; bi = lane; }
#pragma unroll
            for (int of = 32; of > 0; of >>= 1) {
                const float ov = __shfl_xor(bv, of, 64); const int oi = __shfl_xor(bi, of, 64);
                if (ov > bv || (ov == bv && oi < bi)) { bv = ov; bi = oi; }
            }
            if (bi == lane) v[0] = -2.f;
            if (bi == lane + 64) v[1] = -2.f;
            const unsigned bit = 1u << (bi & 31);
            if ((bi >> 5) == 0) m0 |= bit; else if ((bi >> 5) == 1) m1 |= bit; else if ((bi >> 5) == 2) m2 |= bit; else m3 |= bit;
        }
        if (lane == 0) {
            SELM[tok * 4 + 0] = m0; SELM[tok * 4 + 1] = m1; SELM[tok * 4 + 2] = m2; SELM[tok * 4 + 3] = m3;
            __hip_atomic_fetch_or(&UNI[0], m0, __ATOMIC_RELAXED, __HIP_MEMORY_SCOPE_WORKGROUP); __hip_atomic_fetch_or(&UNI[1], m1, __ATOMIC_RELAXED, __HIP_MEMORY_SCOPE_WORKGROUP); __hip_atomic_fetch_or(&UNI[2], m2, __ATOMIC_RELAXED, __HIP_MEMORY_SCOPE_WORKGROUP); __hip_atomic_fetch_or(&UNI[3], m3, __ATOMIC_RELAXED, __HIP_MEMORY_SCOPE_WORKGROUP);
        }
    }
    __syncthreads();
    {
        nsa_loadq(qf, P.QR, tq, head, hi);
        const unsigned s0 = SELM[tl * 4 + 0], s1 = SELM[tl * 4 + 1], s2 = SELM[tl * 4 + 2], s3 = SELM[tl * 4 + 3];
        const unsigned u0 = UNI[0], u1 = UNI[1], u2 = UNI[2], u3 = UNI[3];
        float m = -INFINITY, l = 0.f;
#pragma unroll
        for (int r = 0; r < 16; ++r) { o[0][r] = 0.f; o[1][r] = 0.f; }
        int j = 0;
        auto ubit = [&](int jj) -> bool { const unsigned wv = jj < 32 ? u0 : (jj < 64 ? u1 : (jj < 96 ? u2 : u3)); return (wv >> (jj & 31)) & 1u; };
        auto nextj = [&](int jj) -> int { ++jj; while (jj <= cur && !ubit(jj)) ++jj; return jj; };
        nsa_ld(rk, rv, P.KSR, P.VST, SEQ, tid);
        __syncthreads();
        nsa_st(KT, VT, rk, rv, tid);
        __syncthreads();
        int buf = 0;
        while (j <= cur) {
            const int jn = nextj(j);
            if (jn <= cur) nsa_ld(rk, rv, P.KSR + (size_t)jn * 64 * 64, P.VST + jn * 64, SEQ, tid);
            const unsigned wv = j < 32 ? s0 : (j < 64 ? s1 : (j < 96 ? s2 : s3));
            const bool mine = (wv >> (j & 31)) & 1u;
            if (__any(mine)) {
                nsa_qk(p0, p1, KT + buf * 8192, qf, q32, hi);
                const int klim = mine ? (j == cur ? (tq & 63) : 63) : -1;
#pragma unroll
                for (int r = 0; r < 16; ++r) { const int k = crow(r, hi); if (k > klim) p0[r] = -INFINITY; if (k + 32 > klim) p1[r] = -INFINITY; }
                nsa_softmax(p0, p1, m, l, o, pf);
                nsa_pv(o, VT + buf * 8192, pf, q32, hi);
            }
            if (jn <= cur) nsa_st(KT + (buf ^ 1) * 8192, VT + (buf ^ 1) * 8192, rk, rv, tid);
            __syncthreads();
            buf ^= 1; j = jn;
        }
        const float sc = l > 0.f ? g_s / l : 0.f;
#pragma unroll
        for (int r = 0; r < 16; ++r) { acc[0][r] += sc * o[0][r]; acc[1][r] += sc * o[1][r]; }
    }
    {
        float m = -INFINITY, l = 0.f;
#pragma unroll
        for (int r = 0; r < 16; ++r) { o[0][r] = 0.f; o[1][r] = 0.f; }
        const int j0 = cur >= 8 ? cur - 8 : 0;
        nsa_ld(rk, rv, P.KWR + (size_t)j0 * 64 * 64, P.VWT + j0 * 64, SEQ, tid);
        __syncthreads();
        nsa_st(KT, VT, rk, rv, tid);
        __syncthreads();
        int buf = 0;
        for (int j = j0; j <= cur; ++j) {
            if (j + 1 <= cur) nsa_ld(rk, rv, P.KWR + (size_t)(j + 1) * 64 * 64, P.VWT + (j + 1) * 64, SEQ, tid);
            nsa_qk(p0, p1, KT + buf * 8192, qf, q32, hi);
            const int kb = j * 64;
#pragma unroll
            for (int r = 0; r < 16; ++r) {
                const int k = kb + crow(r, hi);
                if (k > tq || k <= tq - 512) p0[r] = -INFINITY;
                if (k + 32 > tq || k + 32 <= tq - 512) p1[r] = -INFINITY;
            }
            nsa_softmax(p0, p1, m, l, o, pf);
            nsa_pv(o, VT + buf * 8192, pf, q32, hi);
            if (j + 1 <= cur) nsa_st(KT + (buf ^ 1) * 8192, VT + (buf ^ 1) * 8192, rk, rv, tid);
            __syncthreads();
            buf ^= 1;
        }
        const float sc = l > 0.f ? g_w / l : 0.f;
#pragma unroll
        for (int r = 0; r < 16; ++r) { acc[0][r] += sc * o[0][r]; acc[1][r] += sc * o[1][r]; }
    }
    {
        bf16* op = P.MIX + (size_t)tq * DM + 768 + head * 64 + 4 * hi;
#pragma unroll
        for (int db = 0; db < 2; ++db)
#pragma unroll
            for (int g = 0; g < 4; ++g) {
                const unsigned lo = cvtpk(acc[db][4 * g], acc[db][4 * g + 1]), h2 = cvtpk(acc[db][4 * g + 2], acc[db][4 * g + 3]);
                *(uint2*)(op + 32 * db + 8 * g) = make_uint2(lo, h2);
            }
    }
}

DEVI void nsa_prep2(const bf16* __restrict__ cols, bf16* __restrict__ qn, bf16* __restrict__ qr, bf16* __restrict__ ksr, bf16* __restrict__ kwr,
                    bf16* __restrict__ vst, bf16* __restrict__ vwt, float* __restrict__ gates, int bid) {
    const int t = bid, c = tidx() & 255;
    const int d = c & 63, j = d & 31;
    const float inv = powf(10000.f, -(float)j / 32.f);
    const float ang = (float)t * inv;
    float sn, cs; sincosf(ang, &sn, &cs);
    {
        const bf16* q = cols + (size_t)t * DINP + OFF_Q + (c & ~63);
        const float x1 = bf2f(q[j]), x2 = bf2f(q[j + 32]);
        qn[(size_t)t * 256 + c] = (bf16)f2bf(bf2f(q[d]) * QSCL);
        qr[(size_t)t * 256 + c] = (bf16)f2bf((d < 32 ? x1 * cs - x2 * sn : x2 * cs + x1 * sn) * QSCL);
    }
    if (c < 128) {
        const bf16* kp = cols + (size_t)t * DINP + (c < 64 ? OFF_KS : OFF_KW);
        const float x1 = bf2f(kp[j]), x2 = bf2f(kp[j + 32]);
        const float v = d < 32 ? x1 * cs - x2 * sn : x2 * cs + x1 * sn;
        if (c < 64) ksr[(size_t)t * 64 + d] = (bf16)f2bf(v); else kwr[(size_t)t * 64 + d] = (bf16)f2bf(v);
    } else {
        const bf16 v = cols[(size_t)t * DINP + (c < 192 ? OFF_VS : OFF_VW) + d];
        if (c < 192) vst[(size_t)d * SEQ + t] = v; else vwt[(size_t)d * SEQ + t] = v;
    }
    if (c < 12) gates[(size_t)t * 12 + c] = sigm(bf2f(cols[(size_t)t * DINP + OFF_GT + c]));
}
DEVI void nsa_cmp_cvt(const float* __restrict__ kc, const float* __restrict__ vc, bf16* __restrict__ kcb, bf16* __restrict__ vct, int bid) {
    const int i = bid * 256 + (tidx() & 255);
    if (i < 512 * 64) {
        const int n = i >> 6, d = i & 63;
        kcb[i] = n < NCMP ? (bf16)f2bf(kc[i]) : (bf16)0;
        vct[d * 512 + n] = n < NCMP ? (bf16)f2bf(vc[i]) : (bf16)0;
    }
}
constexpr int RW_SLOT = 8192;
typedef unsigned u32x2v __attribute__((ext_vector_type(2)));
DEVI int rw_off(int row, int chunk16) { return row * 128 + ((chunk16 ^ (row & 7)) << 4); }
DEVI void rw_ld(LAS unsigned char* slot, const bf16* g, int gt) {
#pragma unroll
    for (int e = 0; e < 2; ++e) { const int idx = gt + 256 * e, row = idx >> 3, ch = idx & 7;
        *(LAS v4u*)(slot + rw_off(row, ch)) = *(const v4u*)((const char*)g + idx * 16); }
}
DEVI void rw_ldT(LAS unsigned char* slot, const bf16* g, size_t gstride, int gt) {
#pragma unroll
    for (int e = 0; e < 2; ++e) { const int idx = gt + 256 * e, row = idx >> 3, ch = idx & 7;
        const v4u v = *(const v4u*)(g + (size_t)row * gstride + ch * 8);
        const unsigned w[4] = {v.x, v.y, v.z, v.w};
#pragma unroll
        for (int j = 0; j < 8; ++j) { const int col = ch * 8 + j; const unsigned short h = (unsigned short)(w[j >> 1] >> ((j & 1) * 16));
            *(LAS unsigned short*)(slot + rw_off(col, row >> 3) + (row & 7) * 2) = h; }
    }
}
DEVI bf16x8 rw_frag(const LAS unsigned char* slot, int blk, int s, int r32, int hi) {
    return *(const LAS bf16x8*)(slot + rw_off(32 * blk + r32, 2 * s + hi));
}
DEVI void rw_mm(f32x16& acc, const LAS unsigned char* slotA, int rb, const LAS unsigned char* slotBT, int cb, int r32, int hi) {
#pragma unroll
    for (int s = 0; s < 4; ++s) acc = __builtin_amdgcn_mfma_f32_32x32x16_bf16(rw_frag(slotA, rb, s, r32, hi), rw_frag(slotBT, cb, s, r32, hi), acc, 0, 0, 0);
}
DEVI void rw_stT(LAS unsigned char* slot, const f32x16& acc, int rb, int cb, int r32, int hi) {
    const int j = 32 * cb + r32;
#pragma unroll
    for (int g = 0; g < 4; ++g) {
        const u32x2v w = {cvtpk(acc[4 * g], acc[4 * g + 1]), cvtpk(acc[4 * g + 2], acc[4 * g + 3])};
        *(LAS u32x2v*)(slot + rw_off(j, 4 * rb + g) + 8 * hi) = w;
    }
}
DEVI void rw_st(LAS unsigned char* slot, const f32x16& acc, int rb, int cb, int r32, int hi) {
    const int j = 32 * cb + r32;
#pragma unroll
    for (int r = 0; r < 16; ++r) { const int i = 32 * rb + crow(r, hi);
        *(LAS unsigned short*)(slot + rw_off(i, j >> 3) + (j & 7) * 2) = (unsigned short)f2bf(acc[r]); }
}
DEVI void rw_ldaccT(f32x16& acc, const LAS unsigned char* slot, int rb, int cb, int r32, int hi) {
    const int j = 32 * cb + r32;
#pragma unroll
    for (int g = 0; g < 4; ++g) {
        const u32x2v w = *(const LAS u32x2v*)(slot + rw_off(j, 4 * rb + g) + 8 * hi);
        acc[4 * g] = __builtin_bit_cast(float, w.x << 16); acc[4 * g + 1] = __builtin_bit_cast(float, w.x & 0xffff0000u);
        acc[4 * g + 2] = __builtin_bit_cast(float, w.y << 16); acc[4 * g + 3] = __builtin_bit_cast(float, w.y & 0xffff0000u);
    }
}
DEVI void rw_zero(f32x16& a) {
#pragma unroll
    for (int r = 0; r < 16; ++r) a[r] = 0.f;
}
DEVI void rw_frags(v4u& f0, v4u& f1, const f32x16& a) {
    f0 = (v4u){cvtpk(a[0], a[1]), cvtpk(a[2], a[3]), cvtpk(a[4], a[5]), cvtpk(a[6], a[7])};
    f1 = (v4u){cvtpk(a[8], a[9]), cvtpk(a[10], a[11]), cvtpk(a[12], a[13]), cvtpk(a[14], a[15])};
}

struct RwP {
    const bf16 *R, *K, *V, *A, *B;
    const float *LW, *G, *BON;
    bf16 *AT, *BT, *KT, *RT;
    float* LAM;
    v4u *PF, *HF;
    float *QT, *OL;
    v4u* SF;
    const float *gn_g, *gn_b;
    bf16* MIX;
};

DEVI void rw_r1b(const RwP& P, int c, LAS unsigned char* lds) {
    LAS float* cum = (LAS float*)lds;
    const int tid = tidx();
    __syncthreads();
    if (tid < 256) {
        float s = 0.f;
#pragma unroll 8
        for (int t = 0; t < 64; ++t) { s += P.LW[(size_t)(c * 64 + t) * 256 + tid]; cum[t * 256 + tid] = s; }
    }
    __syncthreads();
    for (int e = tid; e < 64 * 256; e += 512) {
        const int t = e >> 8, ch = e & 255, h = ch >> 6, k = ch & 63;
        const size_t gi = (size_t)(c * 64 + t) * 256 + ch;
        const float cu = cum[e], lw = P.LW[gi];
        const float ein = __expf(cu), eout = __expf(-cu), eex = __expf(cu - lw);
        const size_t o = ((size_t)(c * 4 + h) * 64 + t) * 64 + k;
        P.AT[o] = (bf16)f2bf(bf2f(P.A[gi]) * eex);
        P.BT[o] = (bf16)f2bf(bf2f(P.B[gi]) * eout);
        P.KT[o] = (bf16)f2bf(bf2f(P.K[gi]) * eout);
        P.RT[o] = (bf16)f2bf(bf2f(P.R[gi]) * ein);
        if (t == 63) P.LAM[(size_t)(c * 4 + h) * 64 + k] = ein;
    }
}

DEVI void rw_r2(const RwP& P, int u0, LAS unsigned char* lds) {
    const int tid = tidx(), grp = tid >> 8, gt = tid & 255, gw = (tid >> 6) & 3, lane = tid & 63, r32 = lane & 31, hi = lane >> 5;
    const int rb = gw >> 1, cb = gw & 1;
    const int u = u0 + grp, c = u >> 2, h = u & 3;
    LAS unsigned char* sl = lds + grp * 65536;
#define SL(i) (sl + (i) * RW_SLOT)
    __syncthreads();
    rw_ld(SL(0), P.BT + (size_t)u * 4096, gt); rw_ld(SL(1), P.AT + (size_t)u * 4096, gt);
    rw_ld(SL(2), P.KT + (size_t)u * 4096, gt); rw_ld(SL(3), P.RT + (size_t)u * 4096, gt);
    __syncthreads();
    f32x16 aMab, aMak, aNbr, aNkr;
    rw_zero(aMab); rw_zero(aMak); rw_zero(aNbr); rw_zero(aNkr);
    rw_mm(aMab, SL(0), rb, SL(1), cb, r32, hi);
    rw_mm(aMak, SL(2), rb, SL(1), cb, r32, hi);
    rw_mm(aNbr, SL(0), rb, SL(3), cb, r32, hi);
    rw_mm(aNkr, SL(2), rb, SL(3), cb, r32, hi);
    {
        const int t = 32 * cb + r32;
#pragma unroll
        for (int r = 0; r < 16; ++r) { const int i = 32 * rb + crow(r, hi);
            if (!(i < t)) { aMab[r] = 0.f; aMak[r] = 0.f; }
            if (!(i <= t)) { aNbr[r] = 0.f; aNkr[r] = 0.f; } }
    }
    __syncthreads();
    rw_st(SL(4), aMab, rb, cb, r32, hi);
    rw_stT(SL(5), aMab, rb, cb, r32, hi);
    rw_st(SL(6), aMak, rb, cb, r32, hi);
    rw_stT(SL(7), aNbr, rb, cb, r32, hi);
    {
        const int t = 32 * cb + r32;
#pragma unroll
        for (int r = 0; r < 16; ++r) { const int i = 32 * rb + crow(r, hi); if (i == t) aMab[r] += 1.f; }
    }
    rw_st(SL(0), aMab, rb, cb, r32, hi);
    __syncthreads();
    int mA = 4, mT = 5, nA = 1, nT = 2;
#pragma unroll 1
    for (int j = 0; j < 5; ++j) {
        f32x16 a1; rw_zero(a1);
        rw_mm(a1, SL(mT), rb, SL(mA), cb, r32, hi);
        rw_stT(SL(nA), a1, rb, cb, r32, hi);
        rw_st(SL(nT), a1, rb, cb, r32, hi);
        __syncthreads();
        f32x16 a2; rw_ldaccT(a2, SL(0), rb, cb, r32, hi);
        rw_mm(a2, SL(nT), rb, SL(0), cb, r32, hi);
        __syncthreads();
        rw_stT(SL(0), a2, rb, cb, r32, hi);
        __syncthreads();
        const int ta = mA, tb = mT; mA = nA; mT = nT; nA = ta; nT = tb;
    }
    rw_ldT(SL(1), P.BT + (size_t)u * 4096, 64, gt); rw_ldT(SL(2), P.AT + (size_t)u * 4096, 64, gt);
    rw_ldT(SL(4), P.KT + (size_t)u * 4096, 64, gt); rw_ldT(SL(5), P.V + (size_t)(c * 64) * 256 + h * 64, 256, gt);
    __syncthreads();
    {
        f32x16 aY, aZ; rw_zero(aY); rw_zero(aZ);
        rw_mm(aY, SL(0), rb, SL(1), cb, r32, hi);
        rw_mm(aZ, SL(0), rb, SL(7), cb, r32, hi);
        __syncthreads();
        rw_stT(SL(1), aY, rb, cb, r32, hi);
        rw_stT(SL(7), aZ, rb, cb, r32, hi);
        __syncthreads();
    }
    {
        f32x16 aP; rw_zero(aP);
        rw_mm(aP, SL(2), rb, SL(1), cb, r32, hi);
        const int kp = 32 * cb + r32; const float lam = P.LAM[(size_t)u * 64 + kp];
#pragma unroll
        for (int r = 0; r < 16; ++r) { const int kk = 32 * rb + crow(r, hi); aP[r] = (aP[r] + (kk == kp ? 1.f : 0.f)) * lam; }
        v4u f0, f1; rw_frags(f0, f1, aP);
        v4u* dst = P.PF + ((((size_t)u * 2 + cb) * 2 + rb) * 2) * 64 + lane;
        dst[0] = f0; dst[64] = f1;
    }
    {
        f32x16 aH; rw_ldaccT(aH, SL(3), rb, cb, r32, hi);
        rw_mm(aH, SL(2), rb, SL(7), cb, r32, hi);
        v4u f0, f1; rw_frags(f0, f1, aH);
        v4u* dst = P.HF + ((((size_t)u * 2 + cb) * 2 + rb) * 2) * 64 + lane;
        dst[0] = f0; dst[64] = f1;
    }
    {
        f32x16 aD1; rw_ldaccT(aD1, SL(4), rb, cb, r32, hi);
        rw_mm(aD1, SL(6), rb, SL(1), cb, r32, hi);
        rw_mm(aNkr, SL(6), rb, SL(7), cb, r32, hi);
        __syncthreads();
        rw_stT(SL(0), aD1, rb, cb, r32, hi);
        rw_stT(SL(3), aNkr, rb, cb, r32, hi);
        __syncthreads();
    }
    {
        f32x16 aQ; rw_zero(aQ);
        rw_mm(aQ, SL(0), rb, SL(5), cb, r32, hi);
        float* dst = P.QT + (((size_t)u * 2 + cb) * 2 + rb) * 1024 + lane * 4;
#pragma unroll
        for (int g = 0; g < 4; ++g) {
            const float4 lam = *(const float4*)(P.LAM + (size_t)u * 64 + 32 * rb + 8 * g + 4 * hi);
            *(float4*)(dst + g * 256) = make_float4(aQ[4 * g] * lam.x, aQ[4 * g + 1] * lam.y, aQ[4 * g + 2] * lam.z, aQ[4 * g + 3] * lam.w);
        }
    }
    {
        f32x16 aO; rw_zero(aO);
        rw_mm(aO, SL(5), rb, SL(3), cb, r32, hi);
        float* dst = P.OL + (((size_t)u * 2 + cb) * 2 + rb) * 1024 + lane * 4;
#pragma unroll
        for (int g = 0; g < 4; ++g) *(float4*)(dst + g * 256) = make_float4(aO[4 * g], aO[4 * g + 1], aO[4 * g + 2], aO[4 * g + 3]);
    }
#undef SL
}

DEVI void rw_r3(const RwP& P, int h, int vb, int lane) {
    f32x16 st[2]; rw_zero(st[0]); rw_zero(st[1]);
#pragma unroll 1
    for (int c = 0; c < SEQ / 64; ++c) {
        const size_t u = (size_t)c * 4 + h;
        v4u sf[2][2];
        rw_frags(sf[0][0], sf[0][1], st[0]); rw_frags(sf[1][0], sf[1][1], st[1]);
        v4u* sdst = P.SF + ((u * 2 + vb) * 4) * 64 + lane;
        sdst[0] = sf[0][0]; sdst[64] = sf[0][1]; sdst[128] = sf[1][0]; sdst[192] = sf[1][1];
        f32x16 nw[2];
#pragma unroll
        for (int kb = 0; kb < 2; ++kb) {
            const float* q = P.QT + ((u * 2 + vb) * 2 + kb) * 1024 + lane * 4;
#pragma unroll
            for (int g = 0; g < 4; ++g) { const float4 v = *(const float4*)(q + g * 256); nw[kb][4 * g] = v.x; nw[kb][4 * g + 1] = v.y; nw[kb][4 * g + 2] = v.z; nw[kb][4 * g + 3] = v.w; }
            const v4u* pf = P.PF + (((u * 2 + kb) * 2) * 2) * 64 + lane;
#pragma unroll
            for (int ki = 0; ki < 2; ++ki)
#pragma unroll
                for (int s = 0; s < 2; ++s)
                    nw[kb] = __builtin_amdgcn_mfma_f32_32x32x16_bf16(__builtin_bit_cast(bf16x8, pf[(ki * 2 + s) * 64]), __builtin_bit_cast(bf16x8, sf[ki][s]), nw[kb], 0, 0, 0);
        }
        st[0] = nw[0]; st[1] = nw[1];
    }
}

DEVI void rw_r4(const RwP& P, int u, int tb, int lane) {
    const int c = u >> 2, h = u & 3, r32 = lane & 31, hi = lane >> 5;
    f32x16 o[2];
#pragma unroll
    for (int vb = 0; vb < 2; ++vb) {
        const float* ol = P.OL + (((size_t)u * 2 + tb) * 2 + vb) * 1024 + lane * 4;
#pragma unroll
        for (int g = 0; g < 4; ++g) { const float4 v = *(const float4*)(ol + g * 256); o[vb][4 * g] = v.x; o[vb][4 * g + 1] = v.y; o[vb][4 * g + 2] = v.z; o[vb][4 * g + 3] = v.w; }
        const v4u* sf = P.SF + (((size_t)u * 2 + vb) * 4) * 64 + lane;
        const v4u* hf = P.HF + ((((size_t)u * 2 + tb) * 2) * 2) * 64 + lane;
#pragma unroll
        for (int kb = 0; kb < 2; ++kb)
#pragma unroll
            for (int s = 0; s < 2; ++s)
                o[vb] = __builtin_amdgcn_mfma_f32_32x32x16_bf16(__builtin_bit_cast(bf16x8, sf[(kb * 2 + s) * 64]), __builtin_bit_cast(bf16x8, hf[(kb * 2 + s) * 64]), o[vb], 0, 0, 0);
    }
    float sum = 0.f;
#pragma unroll
    for (int r = 0; r < 16; ++r) sum += o[0][r] + o[1][r];
    sum += __shfl_xor(sum, 32, 64);
    const float mean = sum * (1.f / 64.f);
    float q = 0.f;
#pragma unroll
    for (int r = 0; r < 16; ++r) { const float d0 = o[0][r] - mean, d1 = o[1][r] - mean; q += d0 * d0 + d1 * d1; }
    q += __shfl_xor(q, 32, 64);
    const float rstd = rsqrtf(q * (1.f / 64.f) + 64e-5f);
    const size_t tok = (size_t)c * 64 + 32 * tb + r32;
#pragma unroll
    for (int vb = 0; vb < 2; ++vb)
#pragma unroll
        for (int g = 0; g < 4; ++g) {
            const int ch = h * 64 + 32 * vb + 8 * g + 4 * hi;
            const float4 gg = *(const float4*)(P.gn_g + ch), gb = *(const float4*)(P.gn_b + ch);
            const float4 bo = *(const float4*)(P.BON + tok * 256 + ch), gt = *(const float4*)(P.G + tok * 256 + ch);
            const float y0 = ((o[vb][4 * g] - mean) * rstd * gg.x + gb.x + bo.x) * gt.x;
            const float y1 = ((o[vb][4 * g + 1] - mean) * rstd * gg.y + gb.y + bo.y) * gt.y;
            const float y2 = ((o[vb][4 * g + 2] - mean) * rstd * gg.z + gb.z + bo.z) * gt.z;
            const float y3 = ((o[vb][4 * g + 3] - mean) * rstd * gg.w + gb.w + bo.w) * gt.w;
            *(uint2*)(P.MIX + tok * DM + 256 + ch) = make_uint2(cvtpk(y0, y1), cvtpk(y2, y3));
        }
}
namespace pg8 {
struct XaOrder {
    int G, c;
    __device__ __forceinline__ bool next(int i, Unit& u) const {
        const int L = i * G + c; if (L >= 256) return false;
        u.pm = L >> 2; u.pn = ((L >> 2) >> 5) * 4 + (L & 3); return true;
    }
    __device__ __forceinline__ void a_ready(const Unit&) const {}
    __device__ __forceinline__ void done(const Unit&) const {}
};
struct MoeOrder {
    const int* tile_e; const int* nrt; int G, c;
    __device__ __forceinline__ bool next(int i, Unit& u) const {
        const int L = i * G + c; if (L >= 4 * (*nrt)) return false;
        u.pm = L >> 2; u.pn = tile_e[L >> 2] * 4 + (L & 3); return true;
    }
    __device__ __forceinline__ void a_ready(const Unit&) const {}
    __device__ __forceinline__ void done(const Unit&) const {}
};
#define PG8_EBAR() do { asm volatile("s_waitcnt lgkmcnt(0)" ::: "memory"); __builtin_amdgcn_s_barrier(); asm volatile("" ::: "memory"); } while (0)
struct EpiSoftmaxP {
    static constexpr bool PERM = true, AFTER_DRAIN = true;
    bf16_t* P;
    __device__ __forceinline__ void fused(f32x4 (&acc)[2][2][4][2], const Unit& u, int wr, int wc, int fr, int fq, PG8_LAS unsigned char* lds, int wid, int lane) const {
        PG8_LAS float* RM = (PG8_LAS float*)lds;
        PG8_LAS float* RS = RM + 1024;
#pragma unroll
        for (int ai = 0; ai < 2; ++ai)
#pragma unroll
            for (int m = 0; m < 4; ++m) {
                float mx = -INFINITY;
#pragma unroll
                for (int bj = 0; bj < 2; ++bj)
#pragma unroll
                    for (int n = 0; n < 2; ++n) { const f32x4 x = acc[ai][bj][m][n]; mx = fmaxf(mx, fmaxf(fmaxf(x[0], x[1]), fmaxf(x[2], x[3]))); }
                mx = fmaxf(mx, __shfl_xor(mx, 16)); mx = fmaxf(mx, __shfl_xor(mx, 32));
                if (fq == 0) RM[(ai * HALF + wr * 64 + m * 16 + fr) * 4 + wc] = mx;
            }
        PG8_EBAR();
#pragma unroll
        for (int ai = 0; ai < 2; ++ai)
#pragma unroll
            for (int m = 0; m < 4; ++m) {
                const int row = ai * HALF + wr * 64 + m * 16 + fr;
                const float gm = fmaxf(fmaxf(RM[row * 4 + 0], RM[row * 4 + 1]), fmaxf(RM[row * 4 + 2], RM[row * 4 + 3]));
                float s = 0.f;
#pragma unroll
                for (int bj = 0; bj < 2; ++bj)
#pragma unroll
                    for (int n = 0; n < 2; ++n) { f32x4 x = acc[ai][bj][m][n];
                        x[0] = __builtin_amdgcn_exp2f(x[0] - gm); x[1] = __builtin_amdgcn_exp2f(x[1] - gm); x[2] = __builtin_amdgcn_exp2f(x[2] - gm); x[3] = __builtin_amdgcn_exp2f(x[3] - gm);
                        s += (x[0] + x[1]) + (x[2] + x[3]); acc[ai][bj][m][n] = x; }
                s += __shfl_xor(s, 16); s += __shfl_xor(s, 32);
                if (fq == 0) RS[row * 4 + wc] = s;
            }
        PG8_EBAR();
        const int colb = (u.pn & 3) * BM + wc * 32 + 8 * fq;
#pragma unroll
        for (int ai = 0; ai < 2; ++ai)
#pragma unroll
            for (int m = 0; m < 4; ++m) {
                const int row = ai * HALF + wr * 64 + m * 16 + fr;
                const float inv = 1.0f / ((RS[row * 4 + 0] + RS[row * 4 + 1]) + (RS[row * 4 + 2] + RS[row * 4 + 3]));
                bf16_t* rowp = P + (size_t)(u.pm * BM + row) * 1024 + colb;
#pragma unroll
                for (int bj = 0; bj < 2; ++bj) { const f32x4 v0 = acc[ai][bj][m][0] * inv, v1 = acc[ai][bj][m][1] * inv;
                    u32x4 w; w.x = cvt_pk_bf16(v0[0], v0[1]); w.y = cvt_pk_bf16(v0[2], v0[3]); w.z = cvt_pk_bf16(v1[0], v1[1]); w.w = cvt_pk_bf16(v1[2], v1[3]);
                    *(u32x4*)(rowp + bj * HALF) = w; }
            }
        PG8_EBAR();
    }
};
struct EpiF32N4 {
    static constexpr bool PERM = false, AFTER_DRAIN = false;
    float* C; int ldc;
    __device__ __forceinline__ void operator()(const f32x4 (&acc)[2][2][4][2], const Unit& u, int wr, int wc, int fr, int fq) const {
        const int row0 = u.pm * BM + wr * 64 + fr, col0 = (u.pn & 3) * BM + wc * 32 + 4 * fq;
#pragma unroll
        for (int ai = 0; ai < 2; ++ai)
#pragma unroll
            for (int m = 0; m < 4; ++m) { float* rowp = C + (size_t)(row0 + ai * HALF + m * 16) * ldc + col0;
#pragma unroll
                for (int bj = 0; bj < 2; ++bj)
#pragma unroll
                    for (int n = 0; n < 2; ++n) *(f32x4*)(rowp + bj * HALF + n * 16) = acc[ai][bj][m][n]; }
    }
};
struct EpiBf16N4 {
    static constexpr bool PERM = true, AFTER_DRAIN = false;
    bf16_t* O; int ldc;
    __device__ __forceinline__ void operator()(const f32x4 (&acc)[2][2][4][2], const Unit& u, int wr, int wc, int fr, int fq) const {
        const int row0 = u.pm * BM + wr * 64 + fr, col0 = (u.pn & 3) * BM + wc * 32 + 8 * fq;
#pragma unroll
        for (int ai = 0; ai < 2; ++ai)
#pragma unroll
            for (int m = 0; m < 4; ++m) { bf16_t* rowp = O + (size_t)(row0 + ai * HALF + m * 16) * ldc + col0;
#pragma unroll
                for (int bj = 0; bj < 2; ++bj) { const f32x4 v0 = acc[ai][bj][m][0], v1 = acc[ai][bj][m][1];
                    u32x4 w; w.x = cvt_pk_bf16(v0[0], v0[1]); w.y = cvt_pk_bf16(v0[2], v0[3]); w.z = cvt_pk_bf16(v1[0], v1[1]); w.w = cvt_pk_bf16(v1[2], v1[3]);
                    *(u32x4*)(rowp + bj * HALF) = w; } }
    }
};
struct EpiSiluMul {
    static constexpr bool PERM = true, AFTER_DRAIN = false;
    bf16_t* H;
    __device__ __forceinline__ void operator()(const f32x4 (&acc)[2][2][4][2], const Unit& u, int wr, int wc, int fr, int fq) const {
        const int row0 = u.pm * BM + wr * 64 + fr, col0 = (u.pn & 3) * HALF + wc * 32 + 8 * fq;
#pragma unroll
        for (int ai = 0; ai < 2; ++ai)
#pragma unroll
            for (int m = 0; m < 4; ++m) {
                float h[8];
#pragma unroll
                for (int n = 0; n < 2; ++n)
#pragma unroll
                    for (int e = 0; e < 4; ++e) { const float g = acc[ai][0][m][n][e], up = acc[ai][1][m][n][e];
                        h[4 * n + e] = g * __builtin_amdgcn_rcpf(1.0f + __expf(-g)) * up; }
                u32x4 w; w.x = cvt_pk_bf16(h[0], h[1]); w.y = cvt_pk_bf16(h[2], h[3]); w.z = cvt_pk_bf16(h[4], h[5]); w.w = cvt_pk_bf16(h[6], h[7]);
                *(u32x4*)(H + (size_t)(row0 + ai * HALF + m * 16) * 512 + col0) = w;
            }
    }
};
}

DEVI void tr_blk(const float* W, size_t ldw, int N, int k0, int n0, bf16* WT, size_t ldt, int drow0, float scale, LAS float* scr, int lane) {
    const int n_ = n0 + (lane & 31);
#pragma unroll 8
    for (int i = 0; i < 32; ++i) { const int kk = 2 * i + (lane >> 5); scr[kk * 33 + (lane & 31)] = n_ < N ? W[(size_t)(k0 + kk) * ldw + n_] * scale : 0.f; }
    LDS_WAIT(); asm volatile("" ::: "memory");
    const int c = lane & 7;
#pragma unroll
    for (int j = 0; j < 4; ++j) { const int n = (lane >> 3) + 8 * j; const LAS float* s = scr + (8 * c) * 33 + n;
        v4u o; o.x = pk2(s[0 * 33], s[1 * 33]); o.y = pk2(s[2 * 33], s[3 * 33]); o.z = pk2(s[4 * 33], s[5 * 33]); o.w = pk2(s[6 * 33], s[7 * 33]);
        *(GAS v4u*)(WT + (size_t)(drow0 + n) * ldt + k0 + 8 * c) = o; }
    LDS_WAIT(); asm volatile("" ::: "memory");
}
DEVI void cvt_bf16(const float* __restrict__ src, bf16* __restrict__ dst, size_t n, float scale, int B0, int G) {
    for (size_t i = ((size_t)B0 * 512 + tidx()) * 4; i < n; i += (size_t)G * 512 * 4) {
        const float4 v = *(const float4*)(src + i);
        *(uint2*)(dst + i) = make_uint2(pk2(v.x * scale, v.y * scale), pk2(v.z * scale, v.w * scale));
    }
}

DEVI void moe_lists2(const int* __restrict__ te, int* __restrict__ off, int* __restrict__ nrt, int* __restrict__ tile_e, int* __restrict__ list,
                     int* __restrict__ slotpos, float* sm0) {
    int* cnt = (int*)sm0;
    int* offs = cnt + 16;
    const int w = tidx() >> 6, lane = tidx() & 63;
    __syncthreads();
    for (int ee = 0; ee < 2; ++ee) {
        const int e = w * 2 + ee;
        int c = 0;
        for (int base = 0; base < NTOK; base += 64) {
            const int tok = base + lane;
            const bool m = (te[tok * 2] == e) || (te[tok * 2 + 1] == e);
            c += __popcll(__ballot(m));
        }
        if (lane == 0) cnt[e] = c;
    }
    __syncthreads();
    if (tidx() == 0) {
        int s = 0;
#pragma unroll 1
        for (int i = 0; i < 16; ++i) { offs[i] = s; off[i] = s; const int pc = (cnt[i] + 255) & ~255;
#pragma unroll 1
            for (int r = s / 256; r < (s + pc) / 256; ++r) tile_e[r] = i;
            s += pc; }
        offs[16] = s; off[16] = s; *nrt = s / 256;
    }
    __syncthreads();
    for (int ee = 0; ee < 2; ++ee) {
        const int e = w * 2 + ee;
        int pos = offs[e];
        for (int base = 0; base < NTOK; base += 64) {
            const int tok = base + lane;
            const int a = te[tok * 2], b = te[tok * 2 + 1];
            const bool m = (a == e) || (b == e);
            const unsigned long long mask = __ballot(m);
            if (m) {
                const int p = pos + __popcll(mask & ((1ull << lane) - 1ull));
                list[p] = tok;
                slotpos[tok * 2 + (a == e ? 0 : 1)] = p;
            }
            pos += __popcll(mask);
        }
        for (int p = pos + lane; p < offs[e + 1]; p += 64) list[p] = -1;
    }
    __syncthreads();
}
DEVI void moe_gather(const bf16* __restrict__ xn, const int* __restrict__ list, const int* __restrict__ off, bf16* __restrict__ xg, int B0, int G) {
    const int total = off[16];
    const int gw = B0 * NWAVES + (tidx() >> 6), lane = tidx() & 63;
    for (int p = gw; p < total; p += G * NWAVES) {
        const int tok = list[p];
        v4u a = (v4u){0u, 0u, 0u, 0u}, b = a;
        if (tok >= 0) { const v4u* s = (const v4u*)(xn + (size_t)tok * DM); a = s[lane]; b = s[lane + 64]; }
        v4u* d = (v4u*)(xg + (size_t)p * DM); d[lane] = a; d[lane + 64] = b;
    }
}
DEVI void moe_combine_ln2(const float* x, const bf16* __restrict__ Dp, const int* __restrict__ te,
                          const float* __restrict__ tw, const int* __restrict__ slotpos,
                          const float* __restrict__ g, const float* __restrict__ bt, float* out, bf16* outb, int bid, float* sm) {
    __syncthreads();
    const size_t t = bid; const int tid = tidx() & 255;
    int ea = te[t * 2], eb = te[t * 2 + 1];
    float wa = tw[t * 2], wb = tw[t * 2 + 1];
    size_t pa = slotpos[t * 2], pb = slotpos[t * 2 + 1];
    if (eb < ea) { const float tf = wa; wa = wb; wb = tf; const size_t tp = pa; pa = pb; pb = tp; }
    float v[4];
#pragma unroll
    for (int i = 0; i < 4; ++i) {
        const int c = tid + i * 256;
        float y = wa * bf2f(Dp[pa * DM + c]);
        y = y + wb * bf2f(Dp[pb * DM + c]);
        v[i] = ALPHA * x[t * DM + c] + y;
    }
    const float mean = block_sum256(v[0] + v[1] + v[2] + v[3], sm, tid) * (1.f / DM);
    float q = 0.f;
#pragma unroll
    for (int i = 0; i < 4; ++i) { v[i] -= mean; q += v[i] * v[i]; }
    const float var = block_sum256(q, sm, tid) * (1.f / DM);
    const float rstd = rsqrtf(var + 1e-5f);
#pragma unroll
    for (int i = 0; i < 4; ++i) {
        const int c = tid + i * 256;
        const float o = v[i] * rstd * g[c] + bt[c];
        out[t * DM + c] = o;
        outb[t * DM + c] = (bf16)f2bf(o);
    }
}
struct MP {
    const float* in[50];
    float *X, *VFIRST, *KMEM, *VMEM, *TW, *R0;
    bf16 *XN, *MIX, *WIN_T, *WOUT_T, *COLSB;
    int *TE, *SLOT, *LIST, *EOFF;
    unsigned* BAR;
};

DEVI void tr_item(const float* W, int K, int N, int Npad, bf16* WT, LAS float* scr, int item, int lane) {
    const int nblk = Npad / 32, kb = item / nblk, nb = item % nblk, k0 = 64 * kb, n0 = 32 * nb;
    const int n_ = n0 + (lane & 31);
#pragma unroll 8
    for (int i = 0; i < 32; ++i) { const int kk = 2 * i + (lane >> 5); scr[kk * 33 + (lane & 31)] = n_ < N ? W[(size_t)(k0 + kk) * N + n_] : 0.f; }
    LDS_WAIT(); asm volatile("" ::: "memory");
    const int c = lane & 7;
#pragma unroll
    for (int j = 0; j < 4; ++j) { const int n = (lane >> 3) + 8 * j; const LAS float* s = scr + (8 * c) * 33 + n;
        v4u o; o.x = pk2(s[0 * 33], s[1 * 33]); o.y = pk2(s[2 * 33], s[3 * 33]); o.z = pk2(s[4 * 33], s[5 * 33]); o.w = pk2(s[6 * 33], s[7 * 33]);
        *(GAS v4u*)(WT + (size_t)(n0 + n) * K + k0 + 8 * c) = o; }
    LDS_WAIT(); asm volatile("" ::: "memory");
}

DEVI void gemm_all(const GemmArgs& g, int maxM, int Z, int B0, int G, unsigned char* lds) {
    const int total = gemm_tiles(g, maxM, Z);
    for (int t0 = B0 * 2; t0 < total; t0 += G * 2) {
        const int vb = tidx() >> 8; float* sm = (float*)(lds + vb * 32768);
        const bool l0 = gemm_tile_live(g, maxM, t0), l1 = (t0 + 1 < total) && gemm_tile_live(g, maxM, t0 + 1);
        if (!l0 && !l1) continue;
        const int t = (vb && t0 + 1 < total) ? t0 + 1 : t0;
        gemm_tile(g, maxM, t, vb ? l1 : l0, sm);
    }
}

__global__ void __launch_bounds__(512, 2) mega(MP p) {
    extern __shared__ __attribute__((aligned(16))) unsigned char lds[];
    cg::grid_group grid = cg::this_grid();
    const int G = gridDim.x, B0 = blockIdx.x;
    {
        LAS unsigned* ctl = (LAS unsigned*)((LAS unsigned char*)lds + LDSCTL_OFF);
        for (int u = threadIdx.x; u < (LDS_BYTES - LDSCTL_OFF) / 4; u += NWAVES * 64) ctl[u] = 0u;
    }
    __syncthreads();
    volatile LAS unsigned* MISC = (volatile LAS unsigned*)((LAS unsigned char*)lds + MISC_OFF);
    XcdBarrier bar = xcd_barrier_post(p.BAR, MISC + 8);
    grid.sync();
#define GSYNC() xcd_barrier(bar)
    float* sm0 = (float*)lds;
    LAS unsigned char* ring = (LAS unsigned char*)lds + RING_OFF;
#define VLOOP(n, body) for (int t0_ = B0 * 2; t0_ < (n); t0_ += G * 2) { const int vb = tidx() >> 8; float* sm = (float*)(lds + vb * 32768); const int t = min(t0_ + vb, (n) - 1); body; }

    const float *x_in = p.in[0], *mem = p.in[1];
    float* X = p.X;
    float* R0 = p.R0;
    float* T0 = R0;
    const size_t TB = (size_t)SEQ * 256;
    float *rLW = T0, *rG = T0 + TB, *rBON = T0 + 2 * TB, *rVD = T0 + 5 * TB + TB / 2;
    bf16 *rR = (bf16*)(T0 + 3 * TB), *rK = rR + TB, *rV = rK + TB, *rA = rV + TB, *rB = rA + TB;
    bf16 *rAT = (bf16*)(T0 + 6 * TB), *rBT = rAT + TB, *rKT = rBT + TB, *rRT = rKT + TB;
    float* rLAM = T0 + 8 * TB;
    v4u* rSF = (v4u*)(rLAM + 512 * 64);
    bf16 *QNb = (bf16*)(T0 + 9 * TB), *QRb = QNb + (size_t)SEQ * 256, *KSRb = QRb + (size_t)SEQ * 256, *KWRb = KSRb + (size_t)SEQ * 64,
         *VSTb = KWRb + (size_t)SEQ * 64, *VWTb = VSTb + (size_t)SEQ * 64, *KCMPb = VWTb + (size_t)SEQ * 64, *VCMPTb = KCMPb + 512 * 64;
    float *GATES = (float*)(VCMPTb + 512 * 64), *BLK = GATES + (size_t)SEQ * 12 + 16,
          *BLV = BLK + (size_t)NCMP * 2048, *HIDK = BLV + (size_t)NCMP * 2048, *HIDV = HIDK + (size_t)NCMP * 256,
          *KCMP = HIDV + (size_t)NCMP * 256, *VCMP = KCMP + (size_t)NCMP * 64;
    float *HCONV = VCMP + (size_t)NCMP * 64, *UB = HCONV + TB, *VB = UB + TB;
    v4u *rPF = (v4u*)HCONV, *rHF = rPF + (size_t)512 * 512;
    float *rQT = (float*)(rHF + (size_t)512 * 512), *rOL = rQT + (size_t)512 * 4096;
    float* Y = R0;
    bf16* PB = (bf16*)(R0 + (size_t)17 * 1000 * 1000);
    float* FQK = R0 + (size_t)26 * 1000 * 1000;
    float* FVO = FQK + (size_t)NB * DM * DM;
    bf16* WQK_T = (bf16*)(FVO + (size_t)NB * DM * DM);
    bf16* VWO_T = WQK_T + (size_t)NB * DM * DM;
    bf16* XG = (bf16*)R0;
    bf16* HB = (bf16*)(R0 + (size_t)19 * 1000 * 1000);
    bf16* WGU_T = (bf16*)(R0 + (size_t)34 * 1000 * 1000);
    bf16* WD_T = (bf16*)(R0 + (size_t)43 * 1000 * 1000);

    {
        LAS float* scr = (LAS float*)(ring + (tidx() >> 6) * 16384);
        const int gw = B0 * NWAVES + (tidx() >> 6), NGW = G * NWAVES, lane = tidx() & 63;
        constexpr int I_IN = (DM / 64) * (DINP / 32), I_OUT = (DM / 64) * (DM / 32);
        for (int it = gw; it < 2 * I_IN + 2 * I_OUT; it += NGW) {
            int r = it;
            if (r < 2 * I_IN) { const int l = r / I_IN; tr_item(p.in[4] + (size_t)l * DM * DIN, DM, DIN, DINP, p.WIN_T + (size_t)l * DINP * DM, scr, r % I_IN, lane); continue; }
            r -= 2 * I_IN;
            { const int l = r / I_OUT; tr_item(p.in[5] + (size_t)l * DM * DM, DM, DM, DM, p.WOUT_T + (size_t)l * DM * DM, scr, r % I_OUT, lane); }
        }
    }
    VLOOP(NTOK, ln_kernel(x_in, 1.0f, nullptr, p.in[2], p.in[3], X, p.XN, t, sm))
    GSYNC();
    for (int l = 0; l < 2; ++l) {
        {
            pg8::Gemm g{p.XN, p.WIN_T + (size_t)l * DINP * DM, NTOK, DINP, DM};
            pg8::StaticOrder S; S.init(NTOK, DINP, G, B0);
            pg8::EpiBf16<0> E{p.COLSB, DINP, nullptr, 0, 0, 1.f};
            pg8::gemm_phase<pg8::EpiBf16<0>, pg8::StaticOrder, true, true>(ring, g, S, E);
        }
        for (int b = 0; b < NB; ++b) {
            const bf16* COLS = p.COLSB + (size_t)b * SEQ * DINP;
            RwP rw; rw.R = rR; rw.K = rK; rw.V = rV; rw.A = rA; rw.B = rB; rw.LW = rLW; rw.G = rG; rw.BON = rBON;
            rw.AT = rAT; rw.BT = rBT; rw.KT = rKT; rw.RT = rRT; rw.LAM = rLAM; rw.PF = rPF; rw.HF = rHF; rw.QT = rQT; rw.OL = rOL; rw.SF = rSF;
            rw.gn_g = p.in[19] + l * 256; rw.gn_b = p.in[20] + l * 256; rw.MIX = p.MIX + (size_t)b * SEQ * DM;
            const float* Xb = X + (size_t)b * SEQ * DM;
            bf16* MIXb = p.MIX + (size_t)b * SEQ * DM;
            float* VFb = p.VFIRST + (size_t)b * SEQ * 256;
            if (l > 0) { const GemmArgs g2 = mk(Xb, DM, p.in[21], 32, 1, rVD, 32, SEQ, 32, DM); gemm_all(g2, SEQ, 1, B0, G, lds); }
            if (b == 0) {
                const GemmArgs g3 = mk(mem, DM, p.in[38] + (size_t)l * DM * DM, DM, 1, p.KMEM, DM, NB * MEML, DM, DM);
                const GemmArgs g4 = mk(mem, DM, p.in[39] + (size_t)l * DM * DM, DM, 1, p.VMEM, DM, NB * MEML, DM, DM);
                gemm_all(g3, NB * MEML, 1, B0, G, lds);
                gemm_all(g4, NB * MEML, 1, B0, G, lds);
            }
            GSYNC();
            {
                RwkvP rp;
                rp.cols = COLS; rp.mu = p.in[10] + l * 1024; rp.w0 = p.in[11] + l * 256; rp.w_up = p.in[12] + (size_t)l * 64 * 256;
                rp.a0 = p.in[13] + l * 256; rp.a_up = p.in[14] + (size_t)l * 64 * 256; rp.g_up = p.in[15] + (size_t)l * 128 * 256;
                rp.k_k = p.in[16] + l * 256; rp.k_a = p.in[17] + l * 256; rp.r_k = p.in[18] + l * 256;
                rp.vd = rVD; rp.v_mu = p.in[22]; rp.v0 = p.in[23]; rp.v_up = p.in[24];
                rp.vfirst = VFb; rp.R = rR; rp.LW = rLW; rp.K = rK; rp.V = rV; rp.A = rA; rp.Bv = rB; rp.G = rG; rp.BON = rBON; rp.layer = l; rp.pad = 0;
                VLOOP(SEQ, glu_kernel(COLS, HCONV, t))
                VLOOP(SEQ, gmlp_pre(COLS, p.in[25] + l * 256, p.in[26] + l * 256, UB, VB, t, sm))
                VLOOP(SEQ, rwkv_prep(rp, t, sm))
                VLOOP(SEQ, nsa_prep2(COLS, QNb, QRb, KSRb, KWRb, VSTb, VWTb, GATES, t))
                VLOOP(NCMP, cmp_gather(COLS, p.in[29] + (size_t)l * 2048, p.in[32] + (size_t)l * 2048, BLK, BLV, t))
            }
            GSYNC();
            {
                const GemmArgs gk = mk(BLK, 2048, p.in[30] + (size_t)l * 2048 * 256, 256, 1, HIDK, 256, NCMP, 256, 2048);
                const GemmArgs gv = mk(BLV, 2048, p.in[33] + (size_t)l * 2048 * 256, 256, 1, HIDV, 256, NCMP, 256, 2048);
                for (int c = B0; c < SEQ / 64; c += G) rw_r1b(rw, c, ring);
                __syncthreads();
                gemm_all(gk, NCMP, 1, B0, G, lds);
                gemm_all(gv, NCMP, 1, B0, G, lds);
                VLOOP(SEQ, conv_kernel(HCONV, p.in[6] + (size_t)l * 31 * 256, p.in[7] + l * 256, p.in[8] + l * 256, p.in[9] + l * 256, MIXb, t))
                VLOOP(SEQ, gmlp_mix(UB, VB, p.in[27] + (size_t)l * 4 * 128 * 128, p.in[28] + l * 4 * 128, MIXb, t))
            }
            GSYNC();
            VLOOP((2 * NCMP * 256 + 255) / 256, gelu_inplace(HIDK, 2 * NCMP * 256, t))
            __syncthreads();
            for (int u0 = 2 * B0; u0 < 512; u0 += 2 * G) rw_r2(rw, u0, ring);
            GSYNC();
            {
                const GemmArgs gk = mk(HIDK, 256, p.in[31] + (size_t)l * 256 * 64, 64, 1, KCMP, 64, NCMP, 64, 256);
                const GemmArgs gv = mk(HIDV, 256, p.in[34] + (size_t)l * 256 * 64, 64, 1, VCMP, 64, NCMP, 64, 256);
                gemm_all(gk, NCMP, 1, B0, G, lds);
                gemm_all(gv, NCMP, 1, B0, G, lds);
            }
            GSYNC();
            VLOOP(512 * 64 / 256, nsa_cmp_cvt(KCMP, VCMP, KCMPb, VCMPTb, t))
            GSYNC();
            if (B0 == G - 1) {
                { const int w_ = tidx() >> 6; rw_r3(rw, w_ >> 1, w_ & 1, tidx() & 63); }
            } else {
                NsaP np; np.QN = QNb; np.QR = QRb; np.KSR = KSRb; np.KWR = KWRb; np.VST = VSTb; np.VWT = VWTb; np.KCMP = KCMPb; np.VCMPT = VCMPTb; np.GATES = GATES; np.MIX = MIXb;
                for (int u = B0; u < SEQ / 64; u += G - 1) nsa_unit(np, SEQ / 64 - 1 - u, ring);
            }
            GSYNC();
            for (int i = B0 * NWAVES + (tidx() >> 6); i < 1024; i += G * NWAVES) rw_r4(rw, i >> 1, i & 1, tidx() & 63);
            GSYNC();
        }
        {
            pg8::Gemm g{p.MIX, p.WOUT_T + (size_t)l * DM * DM, NTOK, DM, DM};
            pg8::StaticOrder S; S.init(NTOK, DM, G, B0);
            pg8::EpiF32 E{Y, DM, nullptr};
            pg8::gemm_phase<pg8::EpiF32, pg8::StaticOrder, true, true>(ring, g, S, E);
        }
        GSYNC();
        VLOOP(NTOK, ln_kernel(X, ALPHA, Y, p.in[35] + l * DM, p.in[36] + l * DM, X, p.XN, t, sm))
        GSYNC();
        {
            const GemmArgs gq = mk(p.KMEM, DM, p.in[37] + (size_t)l * DM * DM, 1, DM, FQK, DM, 256, DM, 256, 4, (long)MEML * DM, 256, 0, 256, (long)4 * 256 * DM, (long)256 * DM);
            const GemmArgs gv = mk(p.VMEM, DM, p.in[40] + (size_t)l * DM * DM, DM, 1, FVO, DM, 256, DM, 256, 4, (long)MEML * DM, 256, 0, (long)256 * DM, (long)4 * 256 * DM, (long)256 * DM);
            gemm_all(gq, 256, NB * 4, B0, G, lds);
            gemm_all(gv, 256, NB * 4, B0, G, lds);
            __syncthreads();
            LAS float* scr = (LAS float*)(ring + (tidx() >> 6) * 16384);
            const int gw = B0 * NWAVES + (tidx() >> 6), NGW = G * NWAVES, lane = tidx() & 63;
            const float* wg = p.in[45] + (size_t)l * 16 * DM * 512;
            const float* wu = p.in[46] + (size_t)l * 16 * DM * 512;
            const float* wd = p.in[47] + (size_t)l * 16 * 512 * DM;
            constexpr int I_GU = (DM / 64) * (512 / 32), I_D = (512 / 64) * (DM / 32);
            for (int it = gw; it < 16 * (2 * I_GU + I_D); it += NGW) {
                const int e = it / (2 * I_GU + I_D); int r = it % (2 * I_GU + I_D);
                if (r < 2 * I_GU) {
                    const int isup = r / I_GU; r %= I_GU;
                    const int kb = r / 16, nb = r % 16, n0 = nb * 32;
                    tr_blk((isup ? wu : wg) + (size_t)e * DM * 512, 512, 512, kb * 64, n0, WGU_T + (size_t)e * 1024 * DM, DM, (n0 >> 7) * 256 + (n0 & 127) + isup * 128, 1.f, scr, lane);
                } else {
                    r -= 2 * I_GU;
                    const int kb = r / 32, nb = r % 32;
                    tr_blk(wd + (size_t)e * 512 * DM, DM, DM, kb * 64, nb * 32, WD_T + (size_t)e * DM * 512, 512, nb * 32, 1.f, scr, lane);
                }
            }
        }
        GSYNC();
        {
            cvt_bf16(FQK, WQK_T, (size_t)NB * DM * DM, 0.0625f * 1.4426950408889634f, B0, G);
            LAS float* scr = (LAS float*)(ring + (tidx() >> 6) * 16384);
            const int gw = B0 * NWAVES + (tidx() >> 6), NGW = G * NWAVES, lane = tidx() & 63;
            for (int it = gw; it < 8 * 4 * 32; it += NGW) {
                const int bh = it >> 7, r = it & 127, kb = r >> 5, nb = r & 31;
                tr_blk(FVO + (size_t)bh * 256 * DM, DM, DM, kb * 64, nb * 32, VWO_T + (size_t)(bh >> 2) * DM * DM + (bh & 3) * 256, DM, nb * 32, 1.f, scr, lane);
            }
        }
        GSYNC();
        {
            pg8::Gemm g{p.XN, WQK_T, NTOK, DM, DM};
            pg8::XaOrder S{G, B0};
            pg8::EpiSoftmaxP E{PB};
            pg8::gemm_phase<pg8::EpiSoftmaxP, pg8::XaOrder, false, true>(ring, g, S, E);
        }
        GSYNC();
        {
            pg8::Gemm g{PB, VWO_T, NTOK, DM, DM};
            pg8::XaOrder S{G, B0};
            pg8::EpiF32N4 E{Y, DM};
            pg8::gemm_phase<pg8::EpiF32N4, pg8::XaOrder, true, true>(ring, g, S, E);
        }
        GSYNC();
        VLOOP(NTOK, ln_kernel(X, ALPHA, Y, p.in[41] + l * DM, p.in[42] + l * DM, X, p.XN, t, sm))
        GSYNC();
        VLOOP(NTOK, router_kernel(X, p.in[43], p.in[44], p.TE, p.TW, t, sm))
        GSYNC();
        if (B0 == 0) moe_lists2(p.TE, p.EOFF, p.EOFF + 32, p.EOFF + 64, p.LIST, p.SLOT, sm0);
        GSYNC();
        moe_gather(p.XN, p.LIST, p.EOFF, XG, B0, G);
        GSYNC();
        {
            pg8::Gemm g{XG, WGU_T, 0, 0, DM};
            pg8::MoeOrder S{p.EOFF + 64, p.EOFF + 32, G, B0};
            pg8::EpiSiluMul E{HB};
            pg8::gemm_phase<pg8::EpiSiluMul, pg8::MoeOrder, true, true>(ring, g, S, E);
        }
        GSYNC();
        {
            pg8::Gemm g{HB, WD_T, 0, 0, 512};
            pg8::MoeOrder S{p.EOFF + 64, p.EOFF + 32, G, B0};
            pg8::EpiBf16N4 E{XG, DM};
            pg8::gemm_phase<pg8::EpiBf16N4, pg8::MoeOrder, true, true>(ring, g, S, E);
        }
        GSYNC();
        VLOOP(NTOK, moe_combine_ln2(X, XG, p.TE, p.TW, p.SLOT, p.in[48] + l * DM, p.in[49] + l * DM, X, p.XN, t, sm))
        GSYNC();
    }
}

extern "C" void kernel_launch(void* const* d_in, const int* in_sizes, int n_in, void* d_out, int out_size, void* d_ws, size_t ws_size,
                              hipStream_t stream) {
    static int grid_blocks = 0;
    if (!grid_blocks) {
        int dev = 0, cus = 0, per_cu = 0;
        (void)hipGetDevice(&dev);
        (void)hipDeviceGetAttribute(&cus, hipDeviceAttributeMultiprocessorCount, dev);
        (void)hipFuncSetAttribute((const void*)mega, hipFuncAttributeMaxDynamicSharedMemorySize, LDS_BYTES);
        (void)hipOccupancyMaxActiveBlocksPerMultiprocessor(&per_cu, (const void*)mega, NWAVES * 64, LDS_BYTES);
        (void)hipGetLastError();
        if (per_cu < 1) { fprintf(stderr, "occupancy query says %d blocks per CU\n", per_cu); per_cu = 1; }
        grid_blocks = cus;
    }
    MP p; memset(&p, 0, sizeof(p));
    for (int i = 0; i < 50; ++i) p.in[i] = (const float*)d_in[i];
    char* ws = (char*)d_ws;
    size_t o = 0;
    auto take = [&](size_t bytes) { char* q = ws + o; o += (bytes + 255) & ~(size_t)255; return q; };
    p.BAR = (unsigned*)take(16384);
    p.X = (float*)d_out;
    p.VFIRST = (float*)take((size_t)NTOK * 256 * 4);
    p.MIX = (bf16*)take((size_t)NTOK * DM * 2);
    p.XN = (bf16*)take((size_t)NTOK * DM * 2);
    p.WIN_T = (bf16*)take((size_t)2 * DINP * DM * 2);
    p.WOUT_T = (bf16*)take((size_t)2 * DM * DM * 2);
    p.KMEM = (float*)take((size_t)NB * MEML * DM * 4);
    p.VMEM = (float*)take((size_t)NB * MEML * DM * 4);
    p.TE = (int*)take((size_t)NTOK * 2 * 4);
    p.TW = (float*)take((size_t)NTOK * 2 * 4);
    p.SLOT = (int*)take((size_t)NTOK * 2 * 4);
    p.LIST = (int*)take((size_t)36864 * 4);
    p.EOFF = (int*)take(4096);
    p.R0 = (float*)take((size_t)57 * 1000 * 1000 * 4);
    p.COLSB = (bf16*)(p.R0 + (size_t)31 * 1000 * 1000);
    if (o > ws_size) { fprintf(stderr, "workspace too small: need %zu have %zu\n", o, ws_size); return; }
    (void)hipMemsetAsync(p.BAR, 0, 16384, stream);
    void* args[] = {&p};
    hipError_t e = hipLaunchCooperativeKernel((const void*)mega, dim3(grid_blocks), dim3(NWAVES * 64), args, LDS_BYTES, stream);
    if (e != hipSuccess) fprintf(stderr, "cooperative launch failed: %s (grid %d)\n", hipGetErrorString(e), grid_blocks);
}
```

```cpp
#include <hip/hip_runtime.h>
#include <hip/hip_cooperative_groups.h>
#include <stdio.h>
#include <stdint.h>
#include <string.h>
#include <math.h>
namespace cg = cooperative_groups;

#define DEVI __device__ __forceinline__
#define GAS __attribute__((address_space(1)))
#define LAS __attribute__((address_space(3)))
typedef unsigned short bf16;
typedef unsigned v4u __attribute__((ext_vector_type(4)));
typedef GAS unsigned gu32;
typedef GAS unsigned long long gu64;
#define RLX_AGENT __ATOMIC_RELAXED, __HIP_MEMORY_SCOPE_AGENT
#define LDS_WAIT() asm volatile("s_waitcnt lgkmcnt(0)" ::: "memory")
#define VM_WAIT() asm volatile("s_waitcnt vmcnt(0)" ::: "memory")
DEVI unsigned f2bf(float f) { unsigned u = __builtin_bit_cast(unsigned, f); return (u + 0x7fffu + ((u >> 16) & 1u)) >> 16; }
DEVI unsigned pk2(float lo, float hi) { return f2bf(lo) | (f2bf(hi) << 16); }
DEVI float bf2f(unsigned short h) { return __builtin_bit_cast(float, (unsigned)h << 16); }

constexpr int NB = 2, SEQ = 8192, DM = 1024, NTOK = NB * SEQ, DIN = 2700, DINP = 2816, MEML = 256;
constexpr int OFF_CV = 0, OFF_CG = 256, OFF_RW = 512, OFF_GU = 1536, OFF_GV = 1792, OFF_Q = 2048, OFF_KC = 2304,
              OFF_VC = 2368, OFF_KS = 2432, OFF_VS = 2496, OFF_KW = 2560, OFF_VW = 2624, OFF_GT = 2688;
constexpr int NCMP = 511;
constexpr float ALPHA = 1.4142135623730951f;
constexpr int NWAVES = 8;
constexpr int RING_OFF = 0, RING_BYTES = 131072;
constexpr int LDSCTL_OFF = RING_BYTES, MISC_OFF = LDSCTL_OFF + 320;
constexpr int LDS_BYTES = 147456;

DEVI int tidx() { int t = threadIdx.x; asm volatile("" : "+v"(t)); return t; }
namespace pg8 {
#define PG8_LAS __attribute__((address_space(3)))
typedef unsigned short bf16_t;
typedef short bf16x8 __attribute__((ext_vector_type(8)));
typedef float f32x4 __attribute__((ext_vector_type(4)));
typedef unsigned u32x4 __attribute__((ext_vector_type(4)));
constexpr int BM = 256, BK = 64, HALF = 128, HTB = HALF * BK * 2  , STAGE_BYTES = 8 * HTB, NXCD = 8, WGM = 8;

__host__ __device__ __forceinline__ int lds_byte(int r, int c) { const int st = (r >> 4) * 2 + (c >> 5), rr = r & 15, cc = c & 31, ob = rr * 64 + cc * 2; return st * 1024 + (ob ^ (((ob >> 9) & 1) << 5)); }
__host__ __device__ __forceinline__ void stage_rc(int b, int& R, int& C) { const int st = b / 1024, sb = b % 1024, swz = sb ^ (((sb >> 9) & 1) << 5); R = (st >> 1) * 16 + swz / 64; C = (st & 1) * 32 + (swz % 64) / 2; }
__host__ __device__ __forceinline__ int perm32(int rho) { const int n = rho >> 4, i = rho & 15; return 8 * (i >> 2) + 4 * n + (i & 3); }

struct Unit { int pm, pn; };
struct Gemm { const bf16_t* A; const bf16_t* Bt; int M, N, K; int lda = 0, ldb = 0; };

struct StaticOrder {
    int nM, nN, nwg, G, c;
    __host__ __device__ void init(int M, int N, int G_, int c_) { nM = M / BM; nN = N / BM; nwg = nM * nN; G = G_; c = c_; }
    __host__ __device__ bool next(int i, Unit& u) const {
        const long L = (long)i * G + c; if (L >= nwg) return false;
        int wgid = (int)L; { const int q = nwg / NXCD, r = nwg % NXCD, xcd = wgid % NXCD, off = wgid / NXCD; wgid = (xcd < r ? xcd * (q + 1) : r * (q + 1) + (xcd - r) * q) + off; }
        const int nig = WGM * nN, gid = wgid / nig, fm = gid * WGM, gsz = (nM - fm) < WGM ? (nM - fm) : WGM;
        u.pm = fm + ((wgid % nig) % gsz); u.pn = (wgid % nig) / gsz; return true;
    }
    __device__ __forceinline__ void a_ready(const Unit&) const {}
    __device__ __forceinline__ void done(const Unit&) const {}
};

__device__ __forceinline__ unsigned cvt_pk_bf16(float lo, float hi) { unsigned r; asm volatile("v_cvt_pk_bf16_f32 %0, %1, %2" : "=v"(r) : "v"(lo), "v"(hi)); return r; }
typedef float f32x2 __attribute__((ext_vector_type(2)));
__device__ __forceinline__ f32x2 gelu_pk(f32x2 v) {
    const f32x2 av = __builtin_elementwise_abs(v), d = av * 0.2316418882f + 1.0f;
    f32x2 t; t.x = __builtin_amdgcn_rcpf(d.x); t.y = __builtin_amdgcn_rcpf(d.y);
    f32x2 q = t * 0.5307027145f + (-0.7265760135f); q = q * t + 0.7107068705f; q = q * t + (-0.142248368f); q = q * t + 0.127414796f; q = q * t;
    const f32x2 s = (v * v) * (-0.72134752044f);
    f32x2 e; e.x = __builtin_amdgcn_exp2f(s.x); e.y = __builtin_amdgcn_exp2f(s.y);
    const f32x2 m = v * (q * e), r = v - m;
    f32x2 o; o.x = v.x < 0.f ? m.x : r.x; o.y = v.y < 0.f ? m.y : r.y; return o;
}

template <int ACT  > struct EpiBf16 {
    static constexpr bool PERM = true, AFTER_DRAIN = false; static_assert(ACT == 0 || ACT == 1, "EpiBf16: ACT is 0 (none) or 1 (gelu_pk)");
    bf16_t* O; int ldc; const float* bias; int split_cols; size_t split_stride; float scale0;
    __device__ __forceinline__ void operator()(const f32x4 (&acc)[2][2][4][2], const Unit& u, int wr, int wc, int fr, int fq) const {
        const int row0 = u.pm * BM + wr * 64 + fr; int colt = u.pn * BM; bf16_t* base = O;
        float sc = 1.f; if (split_cols) { const int t = colt / split_cols; base += (size_t)t * split_stride; colt -= t * split_cols; if (t == 0) sc = scale0; }
        const int col0 = colt + wc * 32 + 8 * fq, bcol0 = u.pn * BM + wc * 32 + 8 * fq;
        f32x4 bv[2][2];
#pragma unroll
        for (int bj = 0; bj < 2; ++bj)
#pragma unroll
            for (int n = 0; n < 2; ++n) bv[bj][n] = bias ? *(const f32x4*)(bias + bcol0 + bj * HALF + 4 * n) : (f32x4){0.f, 0.f, 0.f, 0.f};
#pragma unroll
        for (int ai = 0; ai < 2; ++ai)
#pragma unroll
            for (int m = 0; m < 4; ++m) { bf16_t* rowp = base + (size_t)(row0 + ai * HALF + m * 16) * ldc + col0;
#pragma unroll
                for (int bj = 0; bj < 2; ++bj) { f32x4 v0 = acc[ai][bj][m][0] + bv[bj][0], v1 = acc[ai][bj][m][1] + bv[bj][1];
                    if (ACT == 1) { f32x2 a = gelu_pk((f32x2){v0[0], v0[1]}), b = gelu_pk((f32x2){v0[2], v0[3]}), c = gelu_pk((f32x2){v1[0], v1[1]}), d = gelu_pk((f32x2){v1[2], v1[3]});
                        v0 = (f32x4){a.x, a.y, b.x, b.y}; v1 = (f32x4){c.x, c.y, d.x, d.y}; }
                    v0 = v0 * sc; v1 = v1 * sc; u32x4 w; w.x = cvt_pk_bf16(v0[0], v0[1]); w.y = cvt_pk_bf16(v0[2], v0[3]); w.z = cvt_pk_bf16(v1[0], v1[1]); w.w = cvt_pk_bf16(v1[2], v1[3]);
                    *(u32x4*)(rowp + bj * HALF) = w; } }
    }
};

struct PanelStats {
    unsigned* xbuf;
    unsigned* cnt;
    unsigned* tmo;
    int ntn; float eps;
    unsigned code;
    __device__ __forceinline__ bool run(const f32x4 (&v)[2][2][4][2], const Unit& u, int wr, int wc, int fr, int fq, PG8_LAS unsigned char* lds, int wid, int lane) const {
        typedef float f32x2v __attribute__((ext_vector_type(2)));
        PG8_LAS f32x2v* P = (PG8_LAS f32x2v*)lds;
        PG8_LAS f32x2v* S = (PG8_LAS f32x2v*)(lds + 8192);
        PG8_LAS unsigned* flag = (PG8_LAS unsigned*)(lds + 8192 + 2048);
#pragma unroll
        for (int ai = 0; ai < 2; ++ai)
#pragma unroll
            for (int m = 0; m < 4; ++m) {
                float s = 0.f;
#pragma unroll
                for (int bj = 0; bj < 2; ++bj)
#pragma unroll
                    for (int n = 0; n < 2; ++n) { const f32x4 x = v[ai][bj][m][n]; s += (x[0] + x[1]) + (x[2] + x[3]); }
                s += __shfl_xor(s, 16); s += __shfl_xor(s, 32);
                const float mw = s * (1.0f / 64.0f); float q = 0.f;
#pragma unroll
                for (int bj = 0; bj < 2; ++bj)
#pragma unroll
                    for (int n = 0; n < 2; ++n) { const f32x4 d = v[ai][bj][m][n] - mw; q += (d[0] * d[0] + d[1] * d[1]) + (d[2] * d[2] + d[3] * d[3]); }
                q += __shfl_xor(q, 16); q += __shfl_xor(q, 32);
                if (fq == 0) P[(ai * HALF + wr * 64 + m * 16 + fr) * 4 + wc] = (f32x2v){mw, q};
            }
        asm volatile("s_waitcnt lgkmcnt(0)" ::: "memory"); __builtin_amdgcn_s_barrier(); asm volatile("" ::: "memory");
#if defined(BROKEN_EXCHANGE_NO_WAIT)
#warning BROKEN CONTROL BUILD: the row-statistics exchange does not wait; results are wrong by design
        if (blockIdx.x >= 64) { const long long t0_ = clock64(); while (clock64() - t0_ < 60000) __builtin_amdgcn_s_sleep(8); }
#endif
        const int row = wid * 32 + (lane & 31);
        if (lane < 32) {
            const f32x2v a = P[row * 4 + 0], b = P[row * 4 + 1], c = P[row * 4 + 2], d = P[row * 4 + 3];
            const float mt = (a.x + b.x + c.x + d.x) * 0.25f;
            const float da = a.x - mt, db = b.x - mt, dc = c.x - mt, dd = d.x - mt;
            const float m2 = (a.y + b.y) + (c.y + d.y) + 64.0f * ((da * da + db * db) + (dc * dc + dd * dd));
            unsigned long long* slot = (unsigned long long*)xbuf + ((size_t)(u.pm * BM + row) * 4 + u.pn);
            __hip_atomic_store(slot, ((unsigned long long)__float_as_uint(m2) << 32) | __float_as_uint(mt), __ATOMIC_RELAXED, __HIP_MEMORY_SCOPE_AGENT);
        }
        asm volatile("s_waitcnt vmcnt(0)" ::: "memory");
        if (lane == 0) __hip_atomic_fetch_add(cnt + 64 * u.pm, 1u, __ATOMIC_RELAXED, __HIP_MEMORY_SCOPE_AGENT);
        if (wid == 0) {
            bool dead = false; const unsigned long long t0 = __builtin_amdgcn_s_memrealtime(); const unsigned want = 8u * (unsigned)ntn;
            for (;;) {
#if defined(BROKEN_EXCHANGE_NO_WAIT)
                break;
#endif
                if ((unsigned)__builtin_amdgcn_readfirstlane(__hip_atomic_load(cnt + 64 * u.pm, __ATOMIC_RELAXED, __HIP_MEMORY_SCOPE_AGENT)) >= want) break;
                if (__builtin_amdgcn_s_memrealtime() - t0 > 2000000ull) {
                    if (lane == 0) { unsigned expect = 0u; __hip_atomic_compare_exchange_strong(tmo + 1, &expect, code | (unsigned)(u.pm & 0xff), __ATOMIC_RELAXED, __ATOMIC_RELAXED, __HIP_MEMORY_SCOPE_AGENT);
                                     __hip_atomic_store(tmo, 1u, __ATOMIC_RELAXED, __HIP_MEMORY_SCOPE_AGENT); }
                    dead = true; break; }
                __builtin_amdgcn_s_sleep(2);
            }
            __builtin_amdgcn_fence(__ATOMIC_ACQUIRE, "agent");
            if (lane == 0) flag[0] = dead ? 1u : 0u;
        }
        asm volatile("s_waitcnt vmcnt(0) lgkmcnt(0)" ::: "memory"); __builtin_amdgcn_s_barrier(); asm volatile("" ::: "memory");
        const bool bad = flag[0] != 0u;
        if (lane < 32) {
            const unsigned long long* slot = (const unsigned long long*)xbuf + (size_t)(u.pm * BM + row) * 4; float mt[4], m2[4]; float ms = 0.f;
#pragma unroll
            for (int t = 0; t < 4; ++t) { if (t < ntn) { const unsigned long long w = __hip_atomic_load(slot + t, __ATOMIC_RELAXED, __HIP_MEMORY_SCOPE_AGENT); mt[t] = __uint_as_float((unsigned)w); m2[t] = __uint_as_float((unsigned)(w >> 32)); } else { mt[t] = 0.f; m2[t] = 0.f; } ms += mt[t]; }
            const float mean = ms / (float)ntn; float q = 0.f;
#pragma unroll
            for (int t = 0; t < 4; ++t) if (t < ntn) { const float dm = mt[t] - mean; q += m2[t] + 256.0f * dm * dm; }
            S[row] = (f32x2v){mean, 1.0f / sqrtf(q / (256.0f * (float)ntn) + eps)};
        }
        asm volatile("s_waitcnt lgkmcnt(0)" ::: "memory"); __builtin_amdgcn_s_barrier(); asm volatile("" ::: "memory");
        return bad;
    }
};
struct EpiLnRes {
    static constexpr bool PERM = false, AFTER_DRAIN = true;
    const float* base; float* out; int ldc; const float* bias; PanelStats st; unsigned poison;
    __device__ __forceinline__ void fused(f32x4 (&acc)[2][2][4][2], const Unit& u, int wr, int wc, int fr, int fq, PG8_LAS unsigned char* lds, int wid, int lane) const {
        typedef float f32x2v __attribute__((ext_vector_type(2)));
        const PG8_LAS f32x2v* S = (const PG8_LAS f32x2v*)(lds + 8192);
        const int col0 = u.pn * BM + wc * 32 + 4 * fq;
#pragma unroll
        for (int bj = 0; bj < 2; ++bj)
#pragma unroll
            for (int n = 0; n < 2; ++n) { const f32x4 bv = bias ? *(const f32x4*)(bias + col0 + bj * HALF + n * 16) : (f32x4){0.f, 0.f, 0.f, 0.f};
#pragma unroll
                for (int ai = 0; ai < 2; ++ai)
#pragma unroll
                    for (int m = 0; m < 4; ++m) acc[ai][bj][m][n] += bv; }
        f32x4 pre[4][2][2];
#pragma unroll
        for (int m = 0; m < 4; ++m) { const size_t off = (size_t)(u.pm * BM + wr * 64 + m * 16 + fr) * ldc + col0;
#pragma unroll
            for (int bj = 0; bj < 2; ++bj)
#pragma unroll
                for (int n = 0; n < 2; ++n) pre[m][bj][n] = *(const f32x4*)(base + off + bj * HALF + n * 16); }
        const bool bad = st.run(acc, u, wr, wc, fr, fq, lds, wid, lane) || poison != 0u;
        const float qnan = __builtin_nanf("");
#pragma unroll
        for (int ai = 0; ai < 2; ++ai)
#pragma unroll
            for (int m = 0; m < 4; ++m) { const int r = ai * HALF + wr * 64 + m * 16 + fr; const f32x2v sr = S[r]; const size_t off = (size_t)(u.pm * BM + r) * ldc + col0;
#pragma unroll
                for (int bj = 0; bj < 2; ++bj)
#pragma unroll
                    for (int n = 0; n < 2; ++n) { const f32x4 bs = ai == 0 ? pre[m][bj][n] : *(const f32x4*)(base + off + bj * HALF + n * 16); f32x4 o = bs + (acc[ai][bj][m][n] - sr.x) * sr.y;
                        if (bad) o = (f32x4){qnan, qnan, qnan, qnan}; *(f32x4*)(out + off + bj * HALF + n * 16) = o; }
                if (m & 1) asm volatile("" ::: "memory"); }
    }
};
struct EpiLnResLn {
    static constexpr bool PERM = false, AFTER_DRAIN = true;
    const float* base; float* out; bf16_t* xn; int ldc; const float* bias; PanelStats st1, st2; unsigned poison;
    __device__ __forceinline__ void fused(f32x4 (&acc)[2][2][4][2], const Unit& u, int wr, int wc, int fr, int fq, PG8_LAS unsigned char* lds, int wid, int lane) const {
        typedef float f32x2v __attribute__((ext_vector_type(2))); typedef unsigned u32x2v __attribute__((ext_vector_type(2)));
        const PG8_LAS f32x2v* S = (const PG8_LAS f32x2v*)(lds + 8192);
        const int col0 = u.pn * BM + wc * 32 + 4 * fq;
#pragma unroll
        for (int bj = 0; bj < 2; ++bj)
#pragma unroll
            for (int n = 0; n < 2; ++n) { const f32x4 bv = bias ? *(const f32x4*)(bias + col0 + bj * HALF + n * 16) : (f32x4){0.f, 0.f, 0.f, 0.f};
#pragma unroll
                for (int ai = 0; ai < 2; ++ai)
#pragma unroll
                    for (int m = 0; m < 4; ++m) acc[ai][bj][m][n] += bv; }
        bool bad = st1.run(acc, u, wr, wc, fr, fq, lds, wid, lane) || poison != 0u;
        const float qnan = __builtin_nanf("");
#pragma unroll
        for (int ai = 0; ai < 2; ++ai)
#pragma unroll
            for (int m = 0; m < 4; ++m) { const int r = ai * HALF + wr * 64 + m * 16 + fr; const f32x2v sr = S[r]; const size_t off = (size_t)(u.pm * BM + r) * ldc + col0;
#pragma unroll
                for (int bj = 0; bj < 2; ++bj)
#pragma unroll
                    for (int n = 0; n < 2; ++n) { const f32x4 bs = *(const f32x4*)(base + off + bj * HALF + n * 16); acc[ai][bj][m][n] = bs + (acc[ai][bj][m][n] - sr.x) * sr.y; }
                asm volatile("" : "+v"(acc[ai][0][m][0]), "+v"(acc[ai][0][m][1]), "+v"(acc[ai][1][m][0]), "+v"(acc[ai][1][m][1]));
                if (m & 1) asm volatile("" ::: "memory"); }
        const bool bad1 = bad;
        bad = st2.run(acc, u, wr, wc, fr, fq, lds, wid, lane) || bad;
#pragma unroll
        for (int ai = 0; ai < 2; ++ai)
#pragma unroll
            for (int m = 0; m < 4; ++m) { const int r = ai * HALF + wr * 64 + m * 16 + fr; const f32x2v sr = S[r]; const size_t off = (size_t)(u.pm * BM + r) * ldc + col0;
#pragma unroll
                for (int bj = 0; bj < 2; ++bj)
#pragma unroll
                    for (int n = 0; n < 2; ++n) { const f32x4 x1 = acc[ai][bj][m][n]; *(f32x4*)(out + off + bj * HALF + n * 16) = bad1 ? (f32x4){qnan, qnan, qnan, qnan} : x1;
                        const f32x4 o = (x1 - sr.x) * sr.y; u32x2v w; w.x = cvt_pk_bf16(o[0], o[1]); w.y = cvt_pk_bf16(o[2], o[3]);
                        if (bad) { w.x = 0x7fc07fc0u; w.y = 0x7fc07fc0u; } *(u32x2v*)(xn + off + bj * HALF + n * 16) = w; }
                asm volatile("" ::: "memory"); }
    }
};

template <class Epi, class Sched, bool ALIGN_EPI = false, bool SP2 = false>
__device__ __forceinline__ void gemm_phase(PG8_LAS unsigned char* lds, const Gemm g, const Sched& S, const Epi& E) {
    const int tid = tidx(), wid = __builtin_amdgcn_readfirstlane(tid >> 6), lane = tid & 63, wr = wid >> 2, wc = wid & 3, fr = lane & 15, fq = lane >> 4;
    const int K = g.K, nt = K / BK;
    const int LDA = g.lda ? g.lda : K, LDB = g.ldb ? g.ldb : K;
    unsigned voffA[2], voffB[2];
#pragma unroll
    for (int i = 0; i < 2; ++i) { int R, C; stage_rc(tid * 16 + i * 8192, R, C); const int Rb = Epi::PERM ? ((R & ~31) + perm32(R & 31)) : R;
        voffA[i] = (unsigned)(R * LDA + C) * 2u; voffB[i] = (unsigned)(Rb * LDB + C) * 2u; }
    const size_t kstep = (size_t)(BK * 2);
    const size_t hstepA = (size_t)HALF * LDA * 2, hstepB = (size_t)HALF * LDB * 2;
    const size_t tstepA = 2 * hstepA, tstepB = 2 * hstepB;
    const unsigned ldsw = (unsigned)wid * 1024u;
    const int aoff = lds_byte(wr * 64 + fr, fq * 8), boff = lds_byte(wc * 32 + fr, fq * 8);
#define PG8_SA(b, h) (((b) * 2 + (h)) * HTB)
#define PG8_SB(b, h) ((4 + (b) * 2 + (h)) * HTB)
#define PG8_STAGE(bufoff, gbase, voff) do { _Pragma("unroll") for (int _i = 0; _i < 2; ++_i) \
        __builtin_amdgcn_global_load_lds((const unsigned*)((const char*)(gbase) + (voff)[_i]), (PG8_LAS unsigned*)(lds + (bufoff) + ldsw + _i * 8192), 16, 0, 0); } while (0)
#define PG8_LDA(dst, b, h) do { _Pragma("unroll") for (int m = 0; m < 4; ++m) _Pragma("unroll") for (int k = 0; k < 2; ++k) dst[m][k] = *(const PG8_LAS bf16x8*)(lds + PG8_SA(b, h) + aoff + m * 2048 + k * 1024); } while (0)
#define PG8_LDB(dst, b, h) do { _Pragma("unroll") for (int n = 0; n < 2; ++n) _Pragma("unroll") for (int k = 0; k < 2; ++k) dst[n][k] = *(const PG8_LAS bf16x8*)(lds + PG8_SB(b, h) + boff + n * 2048 + k * 1024); } while (0)
#define PG8_MMA(ai, bj, At, Bt) do { __builtin_amdgcn_s_setprio(1); _Pragma("unroll") for (int m = 0; m < 4; ++m) _Pragma("unroll") for (int n = 0; n < 2; ++n) _Pragma("unroll") for (int k = 0; k < 2; ++k) \
        acc[ai][bj][m][n] = __builtin_amdgcn_mfma_f32_16x16x32_bf16(Bt[n][k], At[m][k], acc[ai][bj][m][n], 0, 0, 0); __builtin_amdgcn_s_setprio(0); } while (0)
#define PG8_WAIT_V(n) asm volatile("s_waitcnt vmcnt(" #n ")" ::: "memory")
#define PG8_WAIT_L(n) asm volatile("s_waitcnt lgkmcnt(" #n ")" ::: "memory")
#define PG8_BAR __builtin_amdgcn_s_barrier()
#define PG8_SCHED __builtin_amdgcn_sched_barrier(0)
    Unit cur, nxt; int ui = 0;
    if (!S.next(0, cur)) return;
    f32x4 acc[2][2][4][2];
#pragma unroll
    for (int a = 0; a < 2; ++a)
#pragma unroll
        for (int b = 0; b < 2; ++b)
#pragma unroll
            for (int m = 0; m < 4; ++m)
#pragma unroll
                for (int n = 0; n < 2; ++n) acc[a][b][m][n] = (f32x4){0.f, 0.f, 0.f, 0.f};
    bf16x8 At[4][2], B0[2][2], B1[2][2];
    const char* cA = (const char*)g.A + (size_t)cur.pm * tstepA; const char* cB = (const char*)g.Bt + (size_t)cur.pn * tstepB;
    S.a_ready(cur);
    if constexpr (SP2) {
        PG8_STAGE(PG8_SB(0, 0), cB, voffB); PG8_STAGE(PG8_SB(0, 1), cB + hstepB, voffB); PG8_STAGE(PG8_SA(0, 0), cA, voffA); PG8_STAGE(PG8_SA(0, 1), cA + hstepA, voffA);
        if (wr == 1) PG8_BAR;
        PG8_WAIT_V(2); PG8_BAR;
        PG8_STAGE(PG8_SB(1, 0), cB + kstep, voffB); PG8_STAGE(PG8_SA(1, 0), cA + kstep, voffA); PG8_STAGE(PG8_SB(1, 1), cB + hstepB + kstep, voffB);
        PG8_WAIT_V(6); PG8_BAR;
    } else {
        PG8_STAGE(PG8_SB(0, 0), cB, voffB); PG8_STAGE(PG8_SA(0, 0), cA, voffA); PG8_STAGE(PG8_SB(0, 1), cB + hstepB, voffB); PG8_STAGE(PG8_SA(0, 1), cA + hstepA, voffA);
        if (wr == 1) PG8_BAR;
        PG8_WAIT_V(4); PG8_BAR;
        PG8_STAGE(PG8_SB(1, 0), cB + kstep, voffB); PG8_STAGE(PG8_SA(1, 0), cA + kstep, voffA); PG8_STAGE(PG8_SB(1, 1), cB + hstepB + kstep, voffB);
        PG8_WAIT_V(6); PG8_BAR;
    }
    for (;;) {
        const bool has_next = S.next(ui + 1, nxt);
        const char* nA = has_next ? (const char*)g.A + (size_t)nxt.pm * tstepA : cA; const char* nB = has_next ? (const char*)g.Bt + (size_t)nxt.pn * tstepB : cB;
        for (int t = 0; t < nt; t += 2) {
            const bool last = (t == nt - 2);
            const char* a1 = cA + (size_t)(t + 1) * kstep;
            const char* a2 = last ? nA : cA + (size_t)(t + 2) * kstep; const char* b2 = last ? nB : cB + (size_t)(t + 2) * kstep;
            const char* a3 = a2 + kstep; const char* b3 = b2 + kstep;
            if (last && has_next) S.a_ready(nxt);
            if constexpr (SP2) {
            PG8_LDB(B0, 0, 0); PG8_LDB(B1, 0, 1); PG8_SCHED; PG8_LDA(At, 0, 0); PG8_STAGE(PG8_SA(1, 1), a1 + hstepA, voffA);
            PG8_WAIT_V(8); PG8_WAIT_L(0); PG8_BAR; PG8_MMA(0, 0, At, B0); PG8_MMA(0, 1, At, B1); PG8_BAR; PG8_SCHED;
            PG8_LDA(At, 0, 1); PG8_STAGE(PG8_SB(0, 0), b2, voffB); PG8_STAGE(PG8_SB(0, 1), b2 + hstepB, voffB); PG8_STAGE(PG8_SA(0, 0), a2, voffA);
            PG8_WAIT_V(8); PG8_WAIT_L(0); PG8_BAR; PG8_MMA(1, 0, At, B0); PG8_MMA(1, 1, At, B1); PG8_BAR; PG8_SCHED;
            PG8_LDB(B0, 1, 0); PG8_LDB(B1, 1, 1); PG8_SCHED; PG8_LDA(At, 1, 0); PG8_STAGE(PG8_SA(0, 1), a2 + hstepA, voffA);
            PG8_WAIT_V(8); PG8_WAIT_L(0); PG8_BAR; PG8_MMA(0, 0, At, B0); PG8_MMA(0, 1, At, B1); PG8_BAR; PG8_SCHED;
            PG8_LDA(At, 1, 1); PG8_STAGE(PG8_SB(1, 0), b3, voffB); PG8_STAGE(PG8_SB(1, 1), b3 + hstepB, voffB); PG8_STAGE(PG8_SA(1, 0), a3, voffA);
            PG8_WAIT_V(8); PG8_WAIT_L(0); PG8_BAR; PG8_MMA(1, 0, At, B0); PG8_MMA(1, 1, At, B1); PG8_BAR; PG8_SCHED;
            } else {
            PG8_LDB(B0, 0, 0); PG8_SCHED; PG8_LDA(At, 0, 0); PG8_STAGE(PG8_SA(1, 1), a1 + hstepA, voffA);
            PG8_WAIT_L(8); PG8_BAR; PG8_WAIT_L(0); PG8_MMA(0, 0, At, B0); PG8_BAR; PG8_SCHED;
            PG8_LDB(B1, 0, 1); PG8_STAGE(PG8_SB(0, 0), b2, voffB);
            PG8_BAR; PG8_WAIT_L(0); PG8_MMA(0, 1, At, B1); PG8_BAR;
            PG8_LDA(At, 0, 1); PG8_STAGE(PG8_SA(0, 0), a2, voffA);
            PG8_BAR; PG8_WAIT_L(0); PG8_MMA(1, 0, At, B0); PG8_BAR; PG8_SCHED;
            PG8_STAGE(PG8_SB(0, 1), b2 + hstepB, voffB);
            PG8_WAIT_V(6); PG8_BAR; PG8_MMA(1, 1, At, B1); PG8_BAR;
            PG8_LDB(B0, 1, 0); PG8_SCHED; PG8_LDA(At, 1, 0); PG8_STAGE(PG8_SA(0, 1), a2 + hstepA, voffA);
            PG8_WAIT_L(8); PG8_BAR; PG8_WAIT_L(0); PG8_MMA(0, 0, At, B0); PG8_BAR; PG8_SCHED;
            PG8_LDB(B1, 1, 1); PG8_STAGE(PG8_SB(1, 0), b3, voffB);
            PG8_BAR; PG8_WAIT_L(0); PG8_MMA(0, 1, At, B1); PG8_BAR;
            PG8_LDA(At, 1, 1); PG8_STAGE(PG8_SA(1, 0), a3, voffA);
            PG8_BAR; PG8_WAIT_L(0); PG8_MMA(1, 0, At, B0); PG8_BAR; PG8_SCHED;
            PG8_STAGE(PG8_SB(1, 1), b3 + hstepB, voffB);
            PG8_WAIT_V(6); PG8_BAR; PG8_MMA(1, 1, At, B1); PG8_BAR;
            }
        }
        if constexpr (ALIGN_EPI) { if (wr == 0) PG8_BAR; }
        if constexpr (!Epi::AFTER_DRAIN) { E(acc, cur, wr, wc, fr, fq); S.done(cur); }
        if (!has_next) break;
#pragma unroll
        for (int a = 0; a < 2; ++a)
#pragma unroll
            for (int b = 0; b < 2; ++b)
#pragma unroll
                for (int m = 0; m < 4; ++m)
#pragma unroll
                    for (int n = 0; n < 2; ++n) acc[a][b][m][n] = (f32x4){0.f, 0.f, 0.f, 0.f};
        cur = nxt; cA = nA; cB = nB; ++ui;
        if constexpr (ALIGN_EPI) { if (wr == 1) PG8_BAR; }
    }
    PG8_WAIT_V(0);
    if constexpr (!ALIGN_EPI) { if (wr == 0) PG8_BAR; }
    PG8_BAR;
    if constexpr (Epi::AFTER_DRAIN) { E.fused(acc, cur, wr, wc, fr, fq, lds, wid, lane); S.done(cur); }
#undef PG8_SA
#undef PG8_SB
#undef PG8_STAGE
#undef PG8_LDA
#undef PG8_LDB
#undef PG8_MMA
#undef PG8_WAIT_V
#undef PG8_WAIT_L
#undef PG8_BAR
#undef PG8_SCHED
}
}
namespace pg8 {
struct EpiF32 {
    static constexpr bool PERM = false, AFTER_DRAIN = false;
    float* C; int ldc; const float* bias;
    __device__ __forceinline__ void operator()(const f32x4 (&acc)[2][2][4][2], const Unit& u, int wr, int wc, int fr, int fq) const {
        const int row0 = u.pm * BM + wr * 64 + fr, col0 = u.pn * BM + wc * 32 + 4 * fq;
        f32x4 bv[2][2];
#pragma unroll
        for (int bj = 0; bj < 2; ++bj)
#pragma unroll
            for (int n = 0; n < 2; ++n) bv[bj][n] = bias ? *(const f32x4*)(bias + col0 + bj * HALF + n * 16) : (f32x4){0.f, 0.f, 0.f, 0.f};
#pragma unroll
        for (int ai = 0; ai < 2; ++ai)
#pragma unroll
            for (int m = 0; m < 4; ++m) { float* rowp = C + (size_t)(row0 + ai * HALF + m * 16) * ldc + col0;
#pragma unroll
                for (int bj = 0; bj < 2; ++bj)
#pragma unroll
                    for (int n = 0; n < 2; ++n) *(f32x4*)(rowp + bj * HALF + n * 16) = acc[ai][bj][m][n] + bv[bj][n]; }
    }
};
}
#define XB_TMO      128
#define XB_XCNT(j)  (256  + 64 * (j))
#define XB_XSUB(j)  (1280 + 64 * (j))
#define XB_XGEN(j)  (2304 + 64 * (j))
#define XB_TOP      3328
#define XB_TOPGEN   3392
#define XCD_BAR_WORDS 3456
#define XB_SPIN_CAP (1u << 18)

__device__ __forceinline__ unsigned xb_ld(unsigned* p)              { return __hip_atomic_load(p, __ATOMIC_RELAXED, __HIP_MEMORY_SCOPE_AGENT); }
__device__ __forceinline__ unsigned xb_add(unsigned* p, unsigned v) { return __hip_atomic_fetch_add(p, v, __ATOMIC_RELAXED, __HIP_MEMORY_SCOPE_AGENT); }
__device__ __forceinline__ unsigned xb_xcc_id() { return (unsigned)__builtin_amdgcn_s_getreg((3 << 11) | 20) & 0xFu; }
#define XB_SPIN(cond, bar) do { unsigned _sp = 0; while (cond) { __builtin_amdgcn_s_sleep(1); \
    if ((++_sp & 255u) == 0u) { if (xb_ld(&(bar)[XB_TMO])) break; if (_sp > XB_SPIN_CAP) { atomicAdd(&(bar)[XB_TMO], 1u); break; } } } } while (0)

struct XcdBarrier {
    unsigned* bar; unsigned x;
    volatile LAS unsigned* st;
};

__device__ __forceinline__ XcdBarrier xcd_barrier_post(unsigned* bar, volatile LAS unsigned* st) {
    XcdBarrier b; b.bar = bar; b.x = xb_xcc_id(); b.st = st;
    if (threadIdx.x == 0) (void)xb_add(&bar[XB_XCNT(b.x)], 1u);
    return b;
}
__device__ __forceinline__ void xcd_barrier_complete(unsigned* bar, unsigned x, unsigned& nloc, unsigned& nx) {
    const unsigned G = gridDim.x * gridDim.y * gridDim.z;
    unsigned sum, cnt, mine, sp = 0u;
    for (;;) {
        sum = 0u; cnt = 0u; mine = 0u;
#pragma unroll
        for (unsigned j = 0; j < 16; ++j) { const unsigned c = xb_ld(&bar[XB_XCNT(j)]); sum += c; cnt += (c > 0u) ? 1u : 0u; mine = (j == x) ? c : mine; }
        if (sum == G) break;
        __builtin_amdgcn_s_sleep(1);
        if ((++sp & 255u) == 0u) { if (xb_ld(&bar[XB_TMO])) break; if (sp > XB_SPIN_CAP) { atomicAdd(&bar[XB_TMO], 1u); break; } }
    }
    nloc = mine > 0u ? mine : 1u; nx = cnt > 0u ? cnt : 1u;
}

__device__ __forceinline__ void xcd_barrier(const XcdBarrier& b) {
    asm volatile("s_waitcnt vmcnt(0)" ::: "memory");
    __syncthreads();
    if (threadIdx.x == 0) {
        unsigned* bar = b.bar;
        __builtin_amdgcn_s_waitcnt(0);
        unsigned nloc = b.st[0], nx = b.st[1];
        if (nloc == 0u) { xcd_barrier_complete(bar, b.x, nloc, nx); b.st[0] = nloc; b.st[1] = nx; }
        const unsigned old = xb_add(&bar[XB_XSUB(b.x)], 1u);
        const unsigned gen = old / nloc;
        if (old + 1u == (gen + 1u) * nloc) {
            __builtin_amdgcn_fence(__ATOMIC_RELEASE, "agent");
            asm volatile("s_waitcnt vmcnt(0)" ::: "memory");
            const unsigned og = xb_add(&bar[XB_TOP], 1u);
            const unsigned tg = og / nx;
            if (og + 1u == (tg + 1u) * nx) xb_add(&bar[XB_TOPGEN], 1u);
            else XB_SPIN(xb_ld(&bar[XB_TOPGEN]) == tg, bar);
            __builtin_amdgcn_fence(__ATOMIC_ACQUIRE, "agent");
            xb_add(&bar[XB_XGEN(b.x)], 1u);
            asm volatile("s_waitcnt vmcnt(0)" ::: "memory");
        } else {
            XB_SPIN(xb_ld(&bar[XB_XGEN(b.x)]) == gen, bar);
            __builtin_amdgcn_fence(__ATOMIC_ACQUIRE, "agent");
            asm volatile("s_waitcnt vmcnt(0)" ::: "memory");
        }
    }
    __syncthreads();
}

DEVI float wave_sum(float v) {
#pragma unroll
    for (int o = 32; o > 0; o >>= 1) v += __shfl_xor(v, o, 64);
    return v;
}
DEVI float wave_max(float v) {
#pragma unroll
    for (int o = 32; o > 0; o >>= 1) v = fmaxf(v, __shfl_xor(v, o, 64));
    return v;
}
DEVI float sigm(float x) { return 1.f / (1.f + expf(-x)); }
DEVI float gelu_t(float x) { return 0.5f * x * (1.f + tanhf(0.7978845608028654f * (x + 0.044715f * x * x * x))); }
DEVI float softplus_(float x) { return fmaxf(x, 0.f) + log1pf(expf(-fabsf(x))); }

DEVI float block_sum256(float v, float* red, int tid) {
    v = wave_sum(v);
    __syncthreads();
    if ((tid & 63) == 0) red[tid >> 6] = v;
    __syncthreads();
    return red[0] + red[1] + red[2] + red[3];
}

DEVI void ln_kernel(const float* xres, float alpha, const float* add, const float* __restrict__ g, const float* __restrict__ bt,
                    float* out, bf16* outb, int bid, float* sm) {
    __syncthreads();
    const size_t row = bid;
    const int tid = tidx() & 255;
    float v[4];
#pragma unroll
    for (int i = 0; i < 4; ++i) {
        const size_t idx = row * DM + tid + i * 256;
        v[i] = alpha * xres[idx] + (add ? add[idx] : 0.f);
    }
    const float mean = block_sum256(v[0] + v[1] + v[2] + v[3], sm, tid) * (1.f / DM);
    float q = 0.f;
#pragma unroll
    for (int i = 0; i < 4; ++i) { v[i] -= mean; q += v[i] * v[i]; }
    const float var = block_sum256(q, sm, tid) * (1.f / DM);
    const float rstd = rsqrtf(var + 1e-5f);
#pragma unroll
    for (int i = 0; i < 4; ++i) {
        const int c = tid + i * 256;
        const float o = v[i] * rstd * g[c] + bt[c];
        out[row * DM + c] = o;
        outb[row * DM + c] = (bf16)f2bf(o);
    }
}

struct GemmArgs {
    const float* A; const float* B; float* C; const int* rowidx; const int* zoff;
    long lda, sbk, sbn, ldc, sAz0, sAz1, sBz0, sBz1, sCz0, sCz1;
    int M, N, K, Z1, epi, pad;
};
DEVI void gemm_f32(const GemmArgs& g, int bx, int by, int z, bool live, float* sm) {
    float (*As)[68] = (float (*)[68])sm;
    float (*Bs)[68] = (float (*)[68])(sm + 16 * 68);
    const int z0 = z / g.Z1, z1 = z % g.Z1;
    int mbeg = 0, mend = g.M;
    if (g.zoff) { mbeg = g.zoff[z]; mend = g.zoff[z + 1]; }
    const int m0 = mbeg + by * 64;
    if (!live) mend = 0;
    const int n0 = bx * 64;
    const float* A = g.A + z0 * g.sAz0 + z1 * g.sAz1;
    const float* B = g.B + z0 * g.sBz0 + z1 * g.sBz1;
    float* C = g.C + z0 * g.sCz0 + z1 * g.sCz1;
    const int tid = tidx() & 255, tx = tid & 15, ty = tid >> 4;
    float acc[4][4];
#pragma unroll
    for (int i = 0; i < 4; ++i)
#pragma unroll
        for (int j = 0; j < 4; ++j) acc[i][j] = 0.f;
    long arow[4];
#pragma unroll
    for (int i = 0; i < 4; ++i) {
        const int r = (tid + i * 256) >> 4;
        const int row = m0 + r;
        if (row < mend) arow[i] = (long)(g.rowidx ? g.rowidx[row] : row) * g.lda; else arow[i] = -1;
    }
    __syncthreads();
    for (int k0 = 0; k0 < g.K; k0 += 16) {
#pragma unroll
        for (int i = 0; i < 4; ++i) {
            const int e = tid + i * 256, r = e >> 4, kk = e & 15;
            float v = 0.f;
            if (arow[i] >= 0 && k0 + kk < g.K) v = A[arow[i] + k0 + kk];
            As[kk][r] = v;
        }
#pragma unroll
        for (int i = 0; i < 4; ++i) {
            const int e = tid + i * 256, kk = e >> 6, n = e & 63;
            float v = 0.f;
            if (m0 < mend && n0 + n < g.N && k0 + kk < g.K) v = B[(long)(k0 + kk) * g.sbk + (long)(n0 + n) * g.sbn];
            Bs[kk][n] = v;
        }
        __syncthreads();
#pragma unroll
        for (int kk = 0; kk < 16; ++kk) {
            float a[4], b[4];
#pragma unroll
            for (int i = 0; i < 4; ++i) a[i] = As[kk][ty * 4 + i];
#pragma unroll
            for (int j = 0; j < 4; ++j) b[j] = Bs[kk][tx * 4 + j];
#pragma unroll
            for (int i = 0; i < 4; ++i)
#pragma unroll
                for (int j = 0; j < 4; ++j) acc[i][j] = fmaf(a[i], b[j], acc[i][j]);
        }
        __syncthreads();
    }
#pragma unroll
    for (int i = 0; i < 4; ++i) {
        const int row = m0 + ty * 4 + i;
        if (row >= mend) continue;
#pragma unroll
        for (int j = 0; j < 4; ++j) {
            const int col = n0 + tx * 4 + j;
            if (col >= g.N) continue;
            float* p = C + (long)row * g.ldc + col;
            float v = acc[i][j];
            if (g.epi == 1) { v = v * sigm(v) * (*p); }
            *p = v;
        }
    }
}
DEVI GemmArgs mk(const float* A, long lda, const float* B, long sbk, long sbn, float* C, long ldc, int M, int N, int K,
                 int Z1 = 1, long sAz0 = 0, long sAz1 = 0, long sBz0 = 0, long sBz1 = 0, long sCz0 = 0, long sCz1 = 0,
                 const int* rowidx = nullptr, const int* zoff = nullptr, int epi = 0) {
    GemmArgs g;
    g.A = A; g.B = B; g.C = C; g.rowidx = rowidx; g.zoff = zoff;
    g.lda = lda; g.sbk = sbk; g.sbn = sbn; g.ldc = ldc;
    g.sAz0 = sAz0; g.sAz1 = sAz1; g.sBz0 = sBz0; g.sBz1 = sBz1; g.sCz0 = sCz0; g.sCz1 = sCz1;
    g.M = M; g.N = N; g.K = K; g.Z1 = Z1; g.epi = epi; g.pad = 0;
    return g;
}
DEVI int gemm_tiles(const GemmArgs& g, int maxM, int Z) { return ((g.N + 63) / 64) * ((maxM + 63) / 64) * Z; }
DEVI bool gemm_tile_live(const GemmArgs& g, int maxM, int t) {
    const int nbx = (g.N + 63) / 64, nby = (maxM + 63) / 64;
    const int r = t / nbx, by = r % nby, z = r / nby;
    int mbeg = 0, mend = g.M;
    if (g.zoff) { mbeg = g.zoff[z]; mend = g.zoff[z + 1]; }
    return mbeg + by * 64 < mend;
}
DEVI void gemm_tile(const GemmArgs& g, int maxM, int t, bool live, float* sm) {
    const int nbx = (g.N + 63) / 64, nby = (maxM + 63) / 64;
    const int bx = t % nbx, r = t / nbx;
    gemm_f32(g, bx, r % nby, r / nby, live, sm);
}

DEVI void glu_kernel(const bf16* __restrict__ cols, float* __restrict__ h, int bid) {
    const size_t t = bid; const int c = tidx() & 255;
    h[t * 256 + c] = bf2f(cols[t * DINP + OFF_CV + c]) * sigm(bf2f(cols[t * DINP + OFF_CG + c]));
}
DEVI void conv_kernel(const float* __restrict__ h, const float* __restrict__ w, const float* __restrict__ bias,
                      const float* __restrict__ gg, const float* __restrict__ gb, bf16* __restrict__ mix, int bid) {
    const int t = bid, c = tidx() & 255;
    float acc = bias[c];
#pragma unroll 4
    for (int j = 0; j < 31; ++j) {
        const int tt = t - 30 + j;
        if (tt >= 0) acc = fmaf(h[(size_t)tt * 256 + c], w[j * 256 + c], acc);
    }
    const float mean = wave_sum(acc) * (1.f / 64.f);
    const float d = acc - mean;
    const float var = wave_sum(d * d) * (1.f / 64.f);
    const float y = d * rsqrtf(var + 1e-5f) * gg[c] + gb[c];
    mix[(size_t)t * DM + 0 + c] = (bf16)f2bf(y * sigm(y));
}

DEVI void gmlp_pre(const bf16* __restrict__ cols, const float* __restrict__ lg, const float* __restrict__ lb,
                   float* __restrict__ ub, float* __restrict__ vb, int bid, float* sm) {
    __syncthreads();
    const size_t t = bid; const int c = tidx() & 255;
    ub[t * 256 + c] = gelu_t(bf2f(cols[t * DINP + OFF_GU + c]));
    const float v = gelu_t(bf2f(cols[t * DINP + OFF_GV + c]));
    const float mean = block_sum256(v, sm, c) * (1.f / 256.f);
    const float d = v - mean;
    const float var = block_sum256(d * d, sm, c) * (1.f / 256.f);
    vb[t * 256 + c] = d * rsqrtf(var + 1e-5f) * lg[c] + lb[c];
}
DEVI void gmlp_mix(const float* __restrict__ ub, const float* __restrict__ vb, const float* __restrict__ ws,
                   const float* __restrict__ bs, bf16* __restrict__ mix, int bid) {
    const int t = bid, c = tidx() & 255, h = c >> 6, tt = t & 127, base = t - tt;
    float acc = bs[h * 128 + tt];
    const float* wr = ws + ((size_t)h * 128 + tt) * 128;
#pragma unroll 4
    for (int s = 0; s <= tt; ++s) acc = fmaf(wr[s], vb[(size_t)(base + s) * 256 + c], acc);
    mix[(size_t)t * DM + 512 + c] = (bf16)f2bf(ub[(size_t)t * 256 + c] * acc);
}

struct RwkvP {
    const bf16* cols; const float* mu; const float* w0; const float* w_up; const float* a0; const float* a_up; const float* g_up;
    const float* k_k; const float* k_a; const float* r_k; const float* vd; const float* v_mu; const float* v0; const float* v_up;
    float* vfirst; bf16* R; float* LW; bf16* K; bf16* V; bf16* A; bf16* Bv; float* G; float* BON;
    int layer, pad;
};
DEVI void rwkv_prep(const RwkvP& p, int bid, float* sm) {
    __syncthreads();
    float* y = sm;
    float* vds = sm + 1024;
    const int t = bid, c = tidx() & 255;
#pragma unroll
    for (int q = 0; q < 4; ++q) {
        const int j = c + q * 256;
        const float cur = bf2f(p.cols[(size_t)t * DINP + OFF_RW + j]);
        const float prv = t > 0 ? bf2f(p.cols[(size_t)(t - 1) * DINP + OFF_RW + j]) : 0.f;
        y[j] = cur + p.mu[j] * (prv - cur);
    }
    if (p.layer > 0 && c < 32) {
        const float cur = bf2f(p.cols[(size_t)t * DINP + DIN + c]);
        const float prv = t > 0 ? bf2f(p.cols[(size_t)(t - 1) * DINP + DIN + c]) : 0.f;
        vds[c] = cur + p.v_mu[c] * (prv - cur);
    }
    __syncthreads();
    float tw = 0.f, sg = 0.f;
    if (c < 64) tw = tanhf(y[768 + c]);
    if (c >= 128) sg = sigm(y[896 + (c - 128)]);
    __syncthreads();
    if (c < 64) y[768 + c] = tw;
    if (c >= 128) y[896 + (c - 128)] = sg;
    __syncthreads();
    const float r = y[c], k = y[256 + c];
    float v = y[512 + c];
    float wl = p.w0[c], al = p.a0[c], gl = 0.f;
#pragma unroll 4
    for (int j = 0; j < 64; ++j) { wl = fmaf(y[768 + j], p.w_up[j * 256 + c], wl); al = fmaf(y[832 + j], p.a_up[j * 256 + c], al); }
#pragma unroll 4
    for (int j = 0; j < 128; ++j) gl = fmaf(y[896 + j], p.g_up[j * 256 + c], gl);
    const float wlog = -softplus_(-wl) - 0.5f;
    const float a = sigm(al);
    if (p.layer == 0) {
        p.vfirst[(size_t)t * 256 + c] = v;
    } else {
        float vm = p.v0[c];
#pragma unroll 4
        for (int j = 0; j < 32; ++j) vm = fmaf(vds[j], p.v_up[j * 256 + c], vm);
        vm = sigm(vm);
        v = v + (p.vfirst[(size_t)t * 256 + c] - v) * vm;
    }
    float kk = k * p.k_k[c];
    const float nrm = sqrtf(wave_sum(kk * kk));
    kk = kk / fmaxf(nrm, 1e-12f);
    const float k2 = k * (1.f + (a - 1.f) * p.k_a[c]);
    const float bd = wave_sum(r * k2 * p.r_k[c]);
    const size_t o = (size_t)t * 256 + c;
    p.R[o] = (bf16)f2bf(r); p.LW[o] = -expf(wlog); p.K[o] = (bf16)f2bf(k2); p.V[o] = (bf16)f2bf(v); p.A[o] = (bf16)f2bf(-kk); p.Bv[o] = (bf16)f2bf(kk * a); p.G[o] = gl; p.BON[o] = bd * v;
}
DEVI void rwkv_scan(float* R, const float* __restrict__ W, const float* __restrict__ K, const float* __restrict__ V,
                    const float* __restrict__ A, const float* __restrict__ Bv, float* sm0) {
    float (*sr)[256] = (float (*)[256])sm0, (*sw)[256] = sr + 4, (*sk)[256] = sr + 8, (*sa)[256] = sr + 12, (*sb)[256] = sr + 16, (*sv)[256] = sr + 20;
    const int vt = tidx(); const bool act = vt < 256;
    const int tid = vt & 255, h = tid >> 6, lane = tid & 63;
    float st[64];
#pragma unroll
    for (int i = 0; i < 64; ++i) st[i] = 0.f;
    for (int t0 = 0; t0 < SEQ; t0 += 4) {
        __syncthreads();
        if (act) {
#pragma unroll
            for (int s = 0; s < 4; ++s) {
                const size_t idx = (size_t)(t0 + s) * 256 + tid;
                sr[s][tid] = R[idx]; sw[s][tid] = W[idx]; sk[s][tid] = K[idx]; sa[s][tid] = A[idx]; sb[s][tid] = Bv[idx]; sv[s][tid] = V[idx];
            }
        }
        __syncthreads();
        if (act) {
#pragma unroll 1
            for (int s = 0; s < 4; ++s) {
                const float vt_ = sv[s][tid];
                const float* pa = &sa[s][h * 64]; const float* pw = &sw[s][h * 64]; const float* pb = &sb[s][h * 64];
                const float* pk = &sk[s][h * 64]; const float* pr = &sr[s][h * 64];
                float sa_ = 0.f;
#pragma unroll
                for (int k = 0; k < 64; ++k) sa_ = fmaf(st[k], pa[k], sa_);
#pragma unroll
                for (int k = 0; k < 64; ++k) st[k] = fmaf(st[k], pw[k], fmaf(sa_, pb[k], vt_ * pk[k]));
                float o = 0.f;
#pragma unroll
                for (int k = 0; k < 64; ++k) o = fmaf(st[k], pr[k], o);
                R[(size_t)(t0 + s) * 256 + h * 64 + lane] = o;
            }
        }
    }
    __syncthreads();
}
DEVI void rwkv_post(const float* __restrict__ O, const float* __restrict__ BON, const float* __restrict__ G,
                    const float* __restrict__ gg, const float* __restrict__ gb, bf16* __restrict__ mix, int bid) {
    const size_t t = bid; const int c = tidx() & 255;
    const float o = O[t * 256 + c];
    const float mean = wave_sum(o) * (1.f / 64.f);
    const float d = o - mean;
    const float var = wave_sum(d * d) * (1.f / 64.f);
    const float y = d * rsqrtf(var + 64e-5f) * gg[c] + gb[c];
    mix[t * DM + 256 + c] = (bf16)f2bf((y + BON[t * 256 + c]) * G[t * 256 + c]);
}

DEVI void nsa_prep(const bf16* __restrict__ cols, float* __restrict__ qrot, float* __restrict__ ksr,
                   float* __restrict__ kwr, float* __restrict__ gates, int bid) {
    const int t = bid, c = tidx() & 255;
    const int d = c & 63, j = d & 31;
    const float inv = powf(10000.f, -(float)j / 32.f);
    const float ang = (float)t * inv;
    float sn, cs; sincosf(ang, &sn, &cs);
    {
        const bf16* q = cols + (size_t)t * DINP + OFF_Q + (c & ~63);
        const float x1 = bf2f(q[j]), x2 = bf2f(q[j + 32]);
        qrot[(size_t)t * 256 + c] = d < 32 ? x1 * cs - x2 * sn : x2 * cs + x1 * sn;
    }
    if (c < 128) {
        const bf16* kp = cols + (size_t)t * DINP + (c < 64 ? OFF_KS : OFF_KW);
        const float x1 = bf2f(kp[j]), x2 = bf2f(kp[j + 32]);
        const float v = d < 32 ? x1 * cs - x2 * sn : x2 * cs + x1 * sn;
        if (c < 64) ksr[(size_t)t * 64 + d] = v; else kwr[(size_t)t * 64 + d] = v;
    }
    if (c < 12) gates[(size_t)t * 12 + c] = sigm(bf2f(cols[(size_t)t * DINP + OFF_GT + c]));
}
DEVI void cmp_gather(const bf16* __restrict__ cols, const float* __restrict__ pek, const float* __restrict__ pev,
                     bf16* __restrict__ bk, bf16* __restrict__ bv, int bid) {
    const int n = bid, tid = tidx() & 255;
    for (int i = tid; i < 2048; i += 256) {
        const int l = i >> 6, d = i & 63;
        const size_t row = (size_t)(16 * n + l) * DINP;
        bk[(size_t)n * 2048 + i] = n < NCMP ? (bf16)f2bf(bf2f(cols[row + OFF_KC + d]) + pek[i]) : (bf16)0;
        bv[(size_t)n * 2048 + i] = n < NCMP ? (bf16)f2bf(bf2f(cols[row + OFF_VC + d]) + pev[i]) : (bf16)0;
    }
}
DEVI void gelu_inplace(float* p, int n, int bid) {
    const int i = bid * 256 + (tidx() & 255);
    if (i < n) p[i] = gelu_t(p[i]);
}

DEVI void wave_softmax(float* s, int n, int lane) {
    float m = -INFINITY;
    for (int i = lane; i < n; i += 64) m = fmaxf(m, s[i]);
    m = wave_max(m);
    if (m == -INFINITY) { for (int i = lane; i < n; i += 64) s[i] = 0.f; return; }
    float sum = 0.f;
    for (int i = lane; i < n; i += 64) { const float p = expf(s[i] - m); s[i] = p; sum += p; }
    sum = wave_sum(sum);
    const float inv = 1.f / fmaxf(sum, 1e-20f);
    for (int i = lane; i < n; i += 64) s[i] *= inv;
}
DEVI void dot4(const float* q  , const float* __restrict__ krow, float* out4) {
    float a0 = 0.f, a1 = 0.f, a2 = 0.f, a3 = 0.f;
#pragma unroll
    for (int d = 0; d < 64; d += 4) {
        const float4 kv = *(const float4*)(krow + d);
        a0 += q[d] * kv.x + q[d + 1] * kv.y + q[d + 2] * kv.z + q[d + 3] * kv.w;
        a1 += q[64 + d] * kv.x + q[64 + d + 1] * kv.y + q[64 + d + 2] * kv.z + q[64 + d + 3] * kv.w;
        a2 += q[128 + d] * kv.x + q[128 + d + 1] * kv.y + q[128 + d + 2] * kv.z + q[128 + d + 3] * kv.w;
        a3 += q[192 + d] * kv.x + q[192 + d + 1] * kv.y + q[192 + d + 2] * kv.z + q[192 + d + 3] * kv.w;
    }
    out4[0] = a0; out4[1] = a1; out4[2] = a2; out4[3] = a3;
}
DEVI void nsa_attn(const bf16* __restrict__ cols, const float* __restrict__ qrot, const float* __restrict__ ksr,
                   const float* __restrict__ kwr, const float* __restrict__ gates, const float* __restrict__ kcmp,
                   const float* __restrict__ vcmp, bf16* __restrict__ mix, int bid, float* sm) {
    __syncthreads();
    float* q = sm; float* qr = sm + 256;
    float (*sc)[1024] = (float (*)[1024])(sm + 512);
    float* imp = sm + 512 + 4096;
    int* sel = (int*)(sm + 512 + 4096 + 128);
    const int pos = bid, tid = tidx() & 255, h = tid >> 6, lane = tid & 63;
    q[tid] = bf2f(cols[(size_t)pos * DINP + OFF_Q + tid]);
    qr[tid] = qrot[(size_t)pos * 256 + tid];
    __syncthreads();
    int ncv = pos >= 31 ? (pos - 31) / 16 + 1 : 0;
    if (ncv > NCMP) ncv = NCMP;
    for (int n = tid; n < 512; n += 256) {
        if (n < ncv) {
            float d4[4]; dot4(q, kcmp + (size_t)n * 64, d4);
            sc[0][n] = d4[0] * 0.125f; sc[1][n] = d4[1] * 0.125f; sc[2][n] = d4[2] * 0.125f; sc[3][n] = d4[3] * 0.125f;
        } else { sc[0][n] = 0.f; sc[1][n] = 0.f; sc[2][n] = 0.f; sc[3][n] = 0.f; }
    }
    __syncthreads();
    wave_softmax(sc[h], ncv, lane);
    __syncthreads();
    float oc = 0.f;
#pragma unroll 4
    for (int n = 0; n < ncv; ++n) oc = fmaf(sc[h][n], vcmp[(size_t)n * 64 + lane], oc);
    if (tid < 128) {
        const int j = tid;
        auto ps = [&](int n) -> float { return (n >= 0 && n < 512) ? (sc[0][n] + sc[1][n] + sc[2][n] + sc[3][n]) : 0.f; };
        const float v = 0.5f * ps(4 * j - 1) + ps(4 * j) + ps(4 * j + 1) + ps(4 * j + 2) + 0.5f * ps(4 * j + 3);
        const int cur = pos >> 6;
        float key;
        if (j == cur || j == 0) key = INFINITY; else if (j <= cur) key = v; else key = -1.f;
        imp[j] = key;
    }
    __syncthreads();
    if (h == 0) {
        float v0 = imp[lane], v1 = imp[lane + 64];
        for (int r = 0; r < 16; ++r) {
            float bv; int bi;
            if (v1 > v0) { bv = v1; bi = lane + 64; } else { bv = v0; bi = lane; }
#pragma unroll
            for (int o = 32; o > 0; o >>= 1) {
                const float ov = __shfl_xor(bv, o, 64); const int oi = __shfl_xor(bi, o, 64);
                if (ov > bv || (ov == bv && oi < bi)) { bv = ov; bi = oi; }
            }
            if (lane == 0) sel[r] = bi;
            if (bi == lane) v0 = -2.f;
            if (bi == lane + 64) v1 = -2.f;
        }
    }
    __syncthreads();
    for (int i = tid; i < 1024; i += 256) {
        const int kp = sel[i >> 6] * 64 + (i & 63);
        if (kp <= pos) {
            float d4[4]; dot4(qr, ksr + (size_t)kp * 64, d4);
            sc[0][i] = d4[0] * 0.125f; sc[1][i] = d4[1] * 0.125f; sc[2][i] = d4[2] * 0.125f; sc[3][i] = d4[3] * 0.125f;
        } else { sc[0][i] = -INFINITY; sc[1][i] = -INFINITY; sc[2][i] = -INFINITY; sc[3][i] = -INFINITY; }
    }
    __syncthreads();
    wave_softmax(sc[h], 1024, lane);
    __syncthreads();
    float os = 0.f;
#pragma unroll 2
    for (int i = 0; i < 1024; ++i) {
        const float p = sc[h][i];
        if (p != 0.f) { const int kp = sel[i >> 6] * 64 + (i & 63); os = fmaf(p, bf2f(cols[(size_t)kp * DINP + OFF_VS + lane]), os); }
    }
    __syncthreads();
    for (int i = tid; i < 512; i += 256) {
        const int kp = pos - 511 + i;
        if (kp >= 0) {
            float d4[4]; dot4(qr, kwr + (size_t)kp * 64, d4);
            sc[0][i] = d4[0] * 0.125f; sc[1][i] = d4[1] * 0.125f; sc[2][i] = d4[2] * 0.125f; sc[3][i] = d4[3] * 0.125f;
        } else { sc[0][i] = -INFINITY; sc[1][i] = -INFINITY; sc[2][i] = -INFINITY; sc[3][i] = -INFINITY; }
    }
    __syncthreads();
    wave_softmax(sc[h], 512, lane);
    __syncthreads();
    float ow = 0.f;
#pragma unroll 4
    for (int i = 0; i < 512; ++i) {
        const int kp = pos - 511 + i;
        if (kp >= 0) ow = fmaf(sc[h][i], bf2f(cols[(size_t)kp * DINP + OFF_VW + lane]), ow);
    }
    const float* gt = gates + (size_t)pos * 12 + h * 3;
    mix[(size_t)pos * DM + 768 + tid] = (bf16)f2bf(gt[0] * oc + gt[1] * os + gt[2] * ow);
}

DEVI void softmax256(float* s, float scale, int bid, float* sm) {
    __syncthreads();
    const size_t row = bid; const int tid = tidx() & 255;
    const float v = s[row * 256 + tid] * scale;
    float m = wave_max(v);
    if ((tid & 63) == 0) sm[8 + (tid >> 6)] = m;
    __syncthreads();
    m = fmaxf(fmaxf(sm[8], sm[9]), fmaxf(sm[10], sm[11]));
    const float p = expf(v - m);
    const float sum = block_sum256(p, sm, tid);
    s[row * 256 + tid] = p / sum;
}

DEVI void router_kernel(const float* __restrict__ x, const float* __restrict__ rw, const float* __restrict__ rb,
                        int* __restrict__ te, float* __restrict__ tw, int bid, float* sm) {
    __syncthreads();
    float (*part)[16] = (float (*)[16])sm;
    const size_t t = bid; const int tid = tidx() & 255;
    float acc[16];
#pragma unroll
    for (int e = 0; e < 16; ++e) acc[e] = 0.f;
#pragma unroll 1
    for (int i = tid; i < DM; i += 256) {
        const float xv = x[t * DM + i];
#pragma unroll
        for (int e = 0; e < 16; ++e) acc[e] = fmaf(xv, rw[i * 16 + e], acc[e]);
    }
#pragma unroll
    for (int e = 0; e < 16; ++e) acc[e] = wave_sum(acc[e]);
    if ((tid & 63) == 0) {
#pragma unroll
        for (int e = 0; e < 16; ++e) part[tid >> 6][e] = acc[e];
    }
    __syncthreads();
    if (tid == 0) {
        float lg[16], pr[16], sl[16];
        float m = -INFINITY;
#pragma unroll
        for (int e = 0; e < 16; ++e) { lg[e] = part[0][e] + part[1][e] + part[2][e] + part[3][e]; m = fmaxf(m, lg[e]); }
        float sum = 0.f;
#pragma unroll
        for (int e = 0; e < 16; ++e) { pr[e] = expf(lg[e] - m); sum += pr[e]; }
#pragma unroll
        for (int e = 0; e < 16; ++e) { pr[e] /= sum; sl[e] = pr[e] + rb[e]; }
        int bg = 0; float bgs = -INFINITY;
#pragma unroll
        for (int gI = 0; gI < 4; ++gI) {
            float m1 = -INFINITY, m2 = -INFINITY;
#pragma unroll
            for (int j = 0; j < 4; ++j) { const float v = sl[gI * 4 + j]; if (v > m1) { m2 = m1; m1 = v; } else if (v > m2) m2 = v; }
            const float sc = m1 + m2;
            if (sc > bgs) { bgs = sc; bg = gI; }
        }
        int e0 = -1, e1 = -1; float s0 = -INFINITY, s1 = -INFINITY, p0 = 0.f, p1 = 0.f;
#pragma unroll
        for (int e = 0; e < 16; ++e) {
            if ((e >> 2) == bg) {
                const float v = sl[e];
                if (v > s0) { s1 = s0; e1 = e0; p1 = p0; s0 = v; e0 = e; p0 = pr[e]; } else if (v > s1) { s1 = v; e1 = e; p1 = pr[e]; }
            }
        }
        const float wsum = p0 + p1;
        te[t * 2] = e0; te[t * 2 + 1] = e1;
        tw[t * 2] = p0 / wsum; tw[t * 2 + 1] = p1 / wsum;
    }
}
DEVI void moe_lists(const int* __restrict__ te, int* __restrict__ off, int* __restrict__ list, int* __restrict__ slotpos, float* sm0) {
    int* cnt = (int*)sm0;
    int* offs = cnt + 16;
    const int w = tidx() >> 6, lane = tidx() & 63;
    __syncthreads();
    for (int ee = 0; ee < 2; ++ee) {
        const int e = w * 2 + ee;
        int c = 0;
        for (int base = 0; base < NTOK; base += 64) {
            const int tok = base + lane;
            const bool m = (te[tok * 2] == e) || (te[tok * 2 + 1] == e);
            c += __popcll(__ballot(m));
        }
        if (lane == 0) cnt[e] = c;
    }
    __syncthreads();
    if (tidx() == 0) {
        int s = 0;
        for (int i = 0; i < 16; ++i) { offs[i] = s; off[i] = s; s += cnt[i]; }
        offs[16] = s; off[16] = s;
    }
    __syncthreads();
    for (int ee = 0; ee < 2; ++ee) {
        const int e = w * 2 + ee;
        int pos = offs[e];
        for (int base = 0; base < NTOK; base += 64) {
            const int tok = base + lane;
            const int a = te[tok * 2], b = te[tok * 2 + 1];
            const bool m = (a == e) || (b == e);
            const unsigned long long mask = __ballot(m);
            if (m) {
                const int p = pos + __popcll(mask & ((1ull << lane) - 1ull));
                list[p] = tok;
                slotpos[tok * 2 + (a == e ? 0 : 1)] = p;
            }
            pos += __popcll(mask);
        }
    }
    __syncthreads();
}
DEVI void moe_combine_ln(const float* x, const float* __restrict__ Dp, const int* __restrict__ te,
                         const float* __restrict__ tw, const int* __restrict__ slotpos,
                         const float* __restrict__ g, const float* __restrict__ bt, float* out, bf16* outb, int bid, float* sm) {
    __syncthreads();
    const size_t t = bid; const int tid = tidx() & 255;
    int ea = te[t * 2], eb = te[t * 2 + 1];
    float wa = tw[t * 2], wb = tw[t * 2 + 1];
    size_t pa = slotpos[t * 2], pb = slotpos[t * 2 + 1];
    if (eb < ea) { const float tf = wa; wa = wb; wb = tf; const size_t tp = pa; pa = pb; pb = tp; }
    float v[4];
#pragma unroll
    for (int i = 0; i < 4; ++i) {
        const int c = tid + i * 256;
        float y = wa * Dp[pa * DM + c];
        y = y + wb * Dp[pb * DM + c];
        v[i] = ALPHA * x[t * DM + c] + y;
    }
    const float mean = block_sum256(v[0] + v[1] + v[2] + v[3], sm, tid) * (1.f / DM);
    float q = 0.f;
#pragma unroll
    for (int i = 0; i < 4; ++i) { v[i] -= mean; q += v[i] * v[i]; }
    const float var = block_sum256(q, sm, tid) * (1.f / DM);
    const float rstd = rsqrtf(var + 1e-5f);
#pragma unroll
    for (int i = 0; i < 4; ++i) {
        const int c = tid + i * 256;
        const float o = v[i] * rstd * g[c] + bt[c];
        out[t * DM + c] = o;
        outb[t * DM + c] = (bf16)f2bf(o);
    }
}
typedef short bf16x8 __attribute__((ext_vector_type(8)));
typedef short s16x4 __attribute__((ext_vector_type(4)));
typedef float f32x16 __attribute__((ext_vector_type(16)));
typedef float f32x2_t __attribute__((ext_vector_type(2)));
typedef __bf16 bf16x2_t __attribute__((ext_vector_type(2)));
DEVI unsigned cvtpk(float lo, float hi) { f32x2_t v = {lo, hi}; bf16x2_t b = __builtin_convertvector(v, bf16x2_t); return __builtin_bit_cast(unsigned, b); }
constexpr float QSCL = 0.125f * 1.4426950408889634f;

struct NsaP {
    const bf16 *QN, *QR, *KSR, *KWR, *VST, *VWT, *KCMP, *VCMPT;
    const float* GATES;
    bf16* MIX;
};
constexpr int NSA_KT = 0, NSA_VT = 16384, NSA_IA = 32768, NSA_IB = 65536, NSA_SELM = 98304, NSA_UNI = 99328;

DEVI int crow(int r, int hi) { return (r & 3) + 8 * (r >> 2) + 4 * hi; }

DEVI void nsa_ld(v4u& rk, v4u& rv, const bf16* kbase, const bf16* vbase, size_t vstride, int tid) {
    rk = *(const v4u*)((const char*)kbase + tid * 16);
    rv = *(const v4u*)((const char*)(vbase + (size_t)(tid >> 3) * vstride) + (tid & 7) * 16);
}
DEVI void nsa_st(LAS unsigned char* KTb, LAS unsigned char* VTb, const v4u& rk, const v4u& rv, int tid) {
    const int r = tid >> 3, c = tid & 7, off = r * 128 + ((c ^ (r & 7)) << 4);
    *(LAS v4u*)(KTb + off) = rk; *(LAS v4u*)(VTb + off) = rv;
}
DEVI void nsa_qk(f32x16& p0, f32x16& p1, const LAS unsigned char* KTb, const bf16x8 (&qf)[4], int q32, int hi) {
#pragma unroll
    for (int r = 0; r < 16; ++r) { p0[r] = 0.f; p1[r] = 0.f; }
#pragma unroll
    for (int ks = 0; ks < 4; ++ks) {
        const int c = ((2 * ks + hi) ^ (q32 & 7)) << 4;
        const bf16x8 a0 = *(const LAS bf16x8*)(KTb + q32 * 128 + c);
        const bf16x8 a1 = *(const LAS bf16x8*)(KTb + (32 + q32) * 128 + c);
        p0 = __builtin_amdgcn_mfma_f32_32x32x16_bf16(a0, qf[ks], p0, 0, 0, 0);
        p1 = __builtin_amdgcn_mfma_f32_32x32x16_bf16(a1, qf[ks], p1, 0, 0, 0);
    }
}
DEVI void nsa_pv(f32x16 (&o)[2], const LAS unsigned char* VTb, const bf16x8 (&pf)[4], int q32, int hi) {
#pragma unroll
    for (int db = 0; db < 2; ++db) {
        const int d = 32 * db + q32;
        const LAS unsigned char* rowp = VTb + d * 128 + 8 * hi;
#pragma unroll
        for (int s = 0; s < 4; ++s) {
            const s16x4 lo = *(const LAS s16x4*)(rowp + (((2 * s) ^ (d & 7)) << 4));
            const s16x4 h4 = *(const LAS s16x4*)(rowp + (((2 * s + 1) ^ (d & 7)) << 4));
            const bf16x8 a = {lo[0], lo[1], lo[2], lo[3], h4[0], h4[1], h4[2], h4[3]};
            o[db] = __builtin_amdgcn_mfma_f32_32x32x16_bf16(a, pf[s], o[db], 0, 0, 0);
        }
    }
}
DEVI void nsa_pack(bf16x8 (&pf)[4], const f32x16& p0, const f32x16& p1) {
#pragma unroll
    for (int s = 0; s < 2; ++s) {
        unsigned w0[4], w1[4];
#pragma unroll
        for (int j = 0; j < 4; ++j) { w0[j] = cvtpk(p0[8 * s + 2 * j], p0[8 * s + 2 * j + 1]); w1[j] = cvtpk(p1[8 * s + 2 * j], p1[8 * s + 2 * j + 1]); }
        pf[s] = __builtin_bit_cast(bf16x8, (v4u){w0[0], w0[1], w0[2], w0[3]});
        pf[2 + s] = __builtin_bit_cast(bf16x8, (v4u){w1[0], w1[1], w1[2], w1[3]});
    }
}
DEVI void nsa_softmax(f32x16& p0, f32x16& p1, float& m, float& l, f32x16 (&o)[2], bf16x8 (&pf)[4]) {
    float mx = -INFINITY;
#pragma unroll
    for (int r = 0; r < 16; ++r) mx = fmaxf(mx, fmaxf(p0[r], p1[r]));
    mx = fmaxf(mx, __shfl_xor(mx, 32, 64));
    const float mn = fmaxf(m, mx);
    const float ms = (mn == -INFINITY) ? 0.f : mn;
    const float alpha = __builtin_amdgcn_exp2f(m - ms);
    float sum = 0.f;
#pragma unroll
    for (int r = 0; r < 16; ++r) { p0[r] = __builtin_amdgcn_exp2f(p0[r] - ms); p1[r] = __builtin_amdgcn_exp2f(p1[r] - ms); sum += p0[r] + p1[r]; }
    sum += __shfl_xor(sum, 32, 64);
    l = l * alpha + sum; m = mn;
#pragma unroll
    for (int r = 0; r < 16; ++r) { o[0][r] *= alpha; o[1][r] *= alpha; }
    nsa_pack(pf, p0, p1);
}
DEVI void nsa_loadq(bf16x8 (&qf)[4], const bf16* Q, int tq, int head, int hi) {
    const bf16* qp = Q + (size_t)tq * 256 + head * 64 + 8 * hi;
#pragma unroll
    for (int ks = 0; ks < 4; ++ks) qf[ks] = *(const bf16x8*)(qp + 16 * ks);
}

DEVI void nsa_unit(const NsaP& P, int u, LAS unsigned char* lds) {
    const int tid = tidx(), w = tid >> 6, lane = tid & 63, q32 = lane & 31, hi = lane >> 5;
    const int t0 = u * 64, cur = u;
    const int tl = 8 * w + (q32 >> 2), head = q32 & 3, tq = t0 + tl;
    LAS unsigned char* KT = lds + NSA_KT; LAS unsigned char* VT = lds + NSA_VT;
    LAS float* IA = (LAS float*)(lds + NSA_IA); LAS float* IB = (LAS float*)(lds + NSA_IB);
    LAS unsigned* SELM = (LAS unsigned*)(lds + NSA_SELM); LAS unsigned* UNI = (LAS unsigned*)(lds + NSA_UNI);
    __syncthreads();
    for (int i = tid; i < 2 * 64 * 128; i += 512) IA[i] = 0.f;
    if (tid < 4) UNI[tid] = 0u;
    f32x16 acc[2];
#pragma unroll
    for (int r = 0; r < 16; ++r) { acc[0][r] = 0.f; acc[1][r] = 0.f; }
    bf16x8 qf[4], pf[4];
    f32x16 o[2], p0, p1;
    v4u rk, rv;
    const float g_c = P.GATES[(size_t)tq * 12 + head * 3 + 0], g_s = P.GATES[(size_t)tq * 12 + head * 3 + 1], g_w = P.GATES[(size_t)tq * 12 + head * 3 + 2];

    {
        nsa_loadq(qf, P.QN, tq, head, hi);
        const int nlim = tq >= 31 ? (tq - 31) >> 4 : -1;
        const int nmaxu = (t0 + 63 - 31) >> 4;
        const int nct = (nmaxu >> 6) + 1;
        float m = -INFINITY, l = 0.f;
        for (int pass = 0; pass < 2; ++pass) {
#pragma unroll
            for (int r = 0; r < 16; ++r) { o[0][r] = 0.f; o[1][r] = 0.f; }
            const float rl = (pass == 1 && l > 0.f) ? 1.f / l : 0.f;
            nsa_ld(rk, rv, P.KCMP, P.VCMPT, 512, tid);
            __syncthreads();
            nsa_st(KT, VT, rk, rv, tid);
            __syncthreads();
            for (int jt = 0; jt < nct; ++jt) {
                const int buf = jt & 1;
                if (jt + 1 < nct) nsa_ld(rk, rv, P.KCMP + (size_t)(jt + 1) * 64 * 64, P.VCMPT + (jt + 1) * 64, 512, tid);
                nsa_qk(p0, p1, KT + buf * 8192, qf, q32, hi);
                const int nb = jt * 64;
#pragma unroll
                for (int r = 0; r < 16; ++r) { const int n = nb + crow(r, hi); if (n > nlim) p0[r] = -INFINITY; if (n + 32 > nlim) p1[r] = -INFINITY; }
                if (pass == 0) {
                    float mx = -INFINITY;
#pragma unroll
                    for (int r = 0; r < 16; ++r) mx = fmaxf(mx, fmaxf(p0[r], p1[r]));
                    mx = fmaxf(mx, __shfl_xor(mx, 32, 64));
                    const float mn = fmaxf(m, mx), ms = (mn == -INFINITY) ? 0.f : mn;
                    float sum = 0.f;
#pragma unroll
                    for (int r = 0; r < 16; ++r) sum += __builtin_amdgcn_exp2f(p0[r] - ms) + __builtin_amdgcn_exp2f(p1[r] - ms);
                    sum += __shfl_xor(sum, 32, 64);
                    l = l * __builtin_amdgcn_exp2f(m - ms) + sum; m = mn;
                } else {
                    const float ms = (m == -INFINITY) ? 0.f : m;
#pragma unroll
                    for (int r = 0; r < 16; ++r) { p0[r] = __builtin_amdgcn_exp2f(p0[r] - ms) * rl; p1[r] = __builtin_amdgcn_exp2f(p1[r] - ms) * rl; }
#pragma unroll
                    for (int half = 0; half < 2; ++half) {
#pragma unroll
                        for (int g = 0; g < 4; ++g) {
                            const f32x16& pp = half ? p1 : p0;
                            float a = pp[4 * g] + pp[4 * g + 1] + pp[4 * g + 2] + 0.5f * pp[4 * g + 3];
                            float b = 0.5f * pp[4 * g + 3];
                            a += __shfl_xor(a, 1, 64); a += __shfl_xor(a, 2, 64);
                            b += __shfl_xor(b, 1, 64); b += __shfl_xor(b, 2, 64);
                            const int j = (nb + 32 * half + 8 * g + 4 * hi) >> 2;
                            if (head == 0 && j < 128) { IA[tl * 128 + j] = a; IB[tl * 128 + j] = b; }
                        }
                    }
                    nsa_pack(pf, p0, p1);
                    nsa_pv(o, VT + buf * 8192, pf, q32, hi);
                }
                if (jt + 1 < nct) nsa_st(KT + (buf ^ 1) * 8192, VT + (buf ^ 1) * 8192, rk, rv, tid);
                __syncthreads();
            }
        }
#pragma unroll
        for (int r = 0; r < 16; ++r) { acc[0][r] = g_c * o[0][r]; acc[1][r] = g_c * o[1][r]; }
    }
    for (int tt = 0; tt < 8; ++tt) {
        const int tok = 8 * w + tt, tpos = t0 + tok;
        float v[2];
#pragma unroll
        for (int e = 0; e < 2; ++e) {
            const int j = lane + 64 * e;
            const float imp = IA[tok * 128 + j] + (j > 0 ? IB[tok * 128 + j - 1] : 0.f);
            v[e] = (j == cur || j == 0) ? INFINITY : (j <= cur ? imp : -1.f);
        }
        (void)tpos;
        unsigned m0 = 0u, m1 = 0u, m2 = 0u, m3 = 0u;
        for (int r = 0; r < 16; ++r) {
            float bv; int bi;
            if (v[1] > v[0]) { bv = v[1]; bi = lane + 64; } else { bv = v[0]; bi = lane; }
#pragma unroll
            for (int of = 32; of > 0; of >>= 1) {
                const float ov = __shfl_xor(bv, of, 64); const int oi = __shfl_xor(bi, of, 64);
                if (ov > bv || (ov == bv && oi < bi)) { bv = ov; bi = oi; }
            }
            if (bi == lane) v[0] = -2.f;
            if (bi == lane + 64) v[1] = -2.f;
            const unsigned bit = 1u << (bi & 31);
            if ((bi >> 5) == 0) m0 |= bit; else if ((bi >> 5) == 1) m1 |= bit; else if ((bi >> 5) == 2) m2 |= bit; else m3 |= bit;
        }
        if (lane == 0) {
            SELM[tok * 4 + 0] = m0; SELM[tok * 4 + 1] = m1; SELM[tok * 4 + 2] = m2; SELM[tok * 4 + 3] = m3;
            __hip_atomic_fetch_or(&UNI[0], m0, __ATOMIC_RELAXED, __HIP_MEMORY_SCOPE_WORKGROUP); __hip_atomic_fetch_or(&UNI[1], m1, __ATOMIC_RELAXED, __HIP_MEMORY_SCOPE_WORKGROUP); __hip_atomic_fetch_or(&UNI[2], m2, __ATOMIC_RELAXED, __HIP_MEMORY_SCOPE_WORKGROUP); __hip_atomic_fetch_or(&UNI[3], m3, __ATOMIC_RELAXED, __HIP_MEMORY_SCOPE_WORKGROUP);
        }
    }
    __syncthreads();
    {
        nsa_loadq(qf, P.QR, tq, head, hi);
        const unsigned s0 = SELM[tl * 4 + 0], s1 = SELM[tl * 4 + 1], s2 = SELM[tl * 4 + 2], s3 = SELM[tl * 4 + 3];
        const unsigned u0 = UNI[0], u1 = UNI[1], u2 = UNI[2], u3 = UNI[3];
        float m = -INFINITY, l = 0.f;
#pragma unroll
        for (int r = 0; r < 16; ++r) { o[0][r] = 0.f; o[1][r] = 0.f; }
        int j = 0;
        auto ubit = [&](int jj) -> bool { const unsigned wv = jj < 32 ? u0 : (jj < 64 ? u1 : (jj < 96 ? u2 : u3)); return (wv >> (jj & 31)) & 1u; };
        auto nextj = [&](int jj) -> int { ++jj; while (jj <= cur && !ubit(jj)) ++jj; return jj; };
        nsa_ld(rk, rv, P.KSR, P.VST, SEQ, tid);
        __syncthreads();
        nsa_st(KT, VT, rk, rv, tid);
        __syncthreads();
        int buf = 0;
        while (j <= cur) {
            const int jn = nextj(j);
            if (jn <= cur) nsa_ld(rk, rv, P.KSR + (size_t)jn * 64 * 64, P.VST + jn * 64, SEQ, tid);
            const unsigned wv = j < 32 ? s0 : (j < 64 ? s1 : (j < 96 ? s2 : s3));
            const bool mine = (wv >> (j & 31)) & 1u;
            if (__any(mine)) {
                nsa_qk(p0, p1, KT + buf * 8192, qf, q32, hi);
                const int klim = mine ? (j == cur ? (tq & 63) : 63) : -1;
#pragma unroll
                for (int r = 0; r < 16; ++r) { const int k = crow(r, hi); if (k > klim) p0[r] = -INFINITY; if (k + 32 > klim) p1[r] = -INFINITY; }
                nsa_softmax(p0, p1, m, l, o, pf);
                nsa_pv(o, VT + buf * 8192, pf, q32, hi);
            }
            if (jn <= cur) nsa_st(KT + (buf ^ 1) * 8192, VT + (buf ^ 1) * 8192, rk, rv, tid);
            __syncthreads();
            buf ^= 1; j = jn;
        }
        const float sc = l > 0.f ? g_s / l : 0.f;
#pragma unroll
        for (int r = 0; r < 16; ++r) { acc[0][r] += sc * o[0][r]; acc[1][r] += sc * o[1][r]; }
    }
    {
        float m = -INFINITY, l = 0.f;
#pragma unroll
        for (int r = 0; r < 16; ++r) { o[0][r] = 0.f; o[1][r] = 0.f; }
        const int j0 = cur >= 8 ? cur - 8 : 0;
        nsa_ld(rk, rv, P.KWR + (size_t)j0 * 64 * 64, P.VWT + j0 * 64, SEQ, tid);
        __syncthreads();
        nsa_st(KT, VT, rk, rv, tid);
        __syncthreads();
        int buf = 0;
        for (int j = j0; j <= cur; ++j) {
            if (j + 1 <= cur) nsa_ld(rk, rv, P.KWR + (size_t)(j + 1) * 64 * 64, P.VWT + (j + 1) * 64, SEQ, tid);
            nsa_qk(p0, p1, KT + buf * 8192, qf, q32, hi);
            const int kb = j * 64;
#pragma unroll
            for (int r = 0; r < 16; ++r) {
                const int k = kb + crow(r, hi);
                if (k > tq || k <= tq - 512) p0[r] = -INFINITY;
                if (k + 32 > tq || k + 32 <= tq - 512) p1[r] = -INFINITY;
            }
            nsa_softmax(p0, p1, m, l, o, pf);
            nsa_pv(o, VT + buf * 8192, pf, q32, hi);
            if (j + 1 <= cur) nsa_st(KT + (buf ^ 1) * 8192, VT + (buf ^ 1) * 8192, rk, rv, tid);
            __syncthreads();
            buf ^= 1;
        }
        const float sc = l > 0.f ? g_w / l : 0.f;
#pragma unroll
        for (int r = 0; r < 16; ++r) { acc[0][r] += sc * o[0][r]; acc[1][r] += sc * o[1][r]; }
    }
    {
        bf16* op = P.MIX + (size_t)tq * DM + 768 + head * 64 + 4 * hi;
#pragma unroll
        for (int db = 0; db < 2; ++db)
#pragma unroll
            for (int g = 0; g < 4; ++g) {
                const unsigned lo = cvtpk(acc[db][4 * g], acc[db][4 * g + 1]), h2 = cvtpk(acc[db][4 * g + 2], acc[db][4 * g + 3]);
                *(uint2*)(op + 32 * db + 8 * g) = make_uint2(lo, h2);
            }
    }
}

DEVI void nsa_prep2(const bf16* __restrict__ cols, bf16* __restrict__ qn, bf16* __restrict__ qr, bf16* __restrict__ ksr, bf16* __restrict__ kwr,
                    bf16* __restrict__ vst, bf16* __restrict__ vwt, float* __restrict__ gates, int bid) {
    const int t = bid, c = tidx() & 255;
    const int d = c & 63, j = d & 31;
    const float inv = powf(10000.f, -(float)j / 32.f);
    const float ang = (float)t * inv;
    float sn, cs; sincosf(ang, &sn, &cs);
    {
        const bf16* q = cols + (size_t)t * DINP + OFF_Q + (c & ~63);
        const float x1 = bf2f(q[j]), x2 = bf2f(q[j + 32]);
        qn[(size_t)t * 256 + c] = (bf16)f2bf(bf2f(q[d]) * QSCL);
        qr[(size_t)t * 256 + c] = (bf16)f2bf((d < 32 ? x1 * cs - x2 * sn : x2 * cs + x1 * sn) * QSCL);
    }
    if (c < 128) {
        const bf16* kp = cols + (size_t)t * DINP + (c < 64 ? OFF_KS : OFF_KW);
        const float x1 = bf2f(kp[j]), x2 = bf2f(kp[j + 32]);
        const float v = d < 32 ? x1 * cs - x2 * sn : x2 * cs + x1 * sn;
        if (c < 64) ksr[(size_t)t * 64 + d] = (bf16)f2bf(v); else kwr[(size_t)t * 64 + d] = (bf16)f2bf(v);
    } else {
        const bf16 v = cols[(size_t)t * DINP + (c < 192 ? OFF_VS : OFF_VW) + d];
        if (c < 192) vst[(size_t)d * SEQ + t] = v; else vwt[(size_t)d * SEQ + t] = v;
    }
    if (c < 12) gates[(size_t)t * 12 + c] = sigm(bf2f(cols[(size_t)t * DINP + OFF_GT + c]));
}
DEVI void nsa_cmp_cvt(const float* __restrict__ kc, const float* __restrict__ vc, bf16* __restrict__ kcb, bf16* __restrict__ vct, int bid) {
    const int i = bid * 256 + (tidx() & 255);
    if (i < 512 * 64) {
        const int n = i >> 6, d = i & 63;
        kcb[i] = n < NCMP ? (bf16)f2bf(kc[i]) : (bf16)0;
        vct[d * 512 + n] = n < NCMP ? (bf16)f2bf(vc[i]) : (bf16)0;
    }
}
constexpr int RW_SLOT = 8192;
typedef unsigned u32x2v __attribute__((ext_vector_type(2)));
DEVI int rw_off(int row, int chunk16) { return row * 128 + ((chunk16 ^ (row & 7)) << 4); }
DEVI void rw_ld(LAS unsigned char* slot, const bf16* g, int gt) {
#pragma unroll
    for (int e = 0; e < 2; ++e) { const int idx = gt + 256 * e, row = idx >> 3, ch = idx & 7;
        *(LAS v4u*)(slot + rw_off(row, ch)) = *(const v4u*)((const char*)g + idx * 16); }
}
DEVI void rw_ldT(LAS unsigned char* slot, const bf16* g, size_t gstride, int gt) {
#pragma unroll
    for (int e = 0; e < 2; ++e) { const int idx = gt + 256 * e, row = idx >> 3, ch = idx & 7;
        const v4u v = *(const v4u*)(g + (size_t)row * gstride + ch * 8);
        const unsigned w[4] = {v.x, v.y, v.z, v.w};
#pragma unroll
        for (int j = 0; j < 8; ++j) { const int col = ch * 8 + j; const unsigned short h = (unsigned short)(w[j >> 1] >> ((j & 1) * 16));
            *(LAS unsigned short*)(slot + rw_off(col, row >> 3) + (row & 7) * 2) = h; }
    }
}
DEVI bf16x8 rw_frag(const LAS unsigned char* slot, int blk, int s, int r32, int hi) {
    return *(const LAS bf16x8*)(slot + rw_off(32 * blk + r32, 2 * s + hi));
}
DEVI void rw_mm(f32x16& acc, const LAS unsigned char* slotA, int rb, const LAS unsigned char* slotBT, int cb, int r32, int hi) {
#pragma unroll
    for (int s = 0; s < 4; ++s) acc = __builtin_amdgcn_mfma_f32_32x32x16_bf16(rw_frag(slotA, rb, s, r32, hi), rw_frag(slotBT, cb, s, r32, hi), acc, 0, 0, 0);
}
DEVI void rw_stT(LAS unsigned char* slot, const f32x16& acc, int rb, int cb, int r32, int hi) {
    const int j = 32 * cb + r32;
#pragma unroll
    for (int g = 0; g < 4; ++g) {
        const u32x2v w = {cvtpk(acc[4 * g], acc[4 * g + 1]), cvtpk(acc[4 * g + 2], acc[4 * g + 3])};
        *(LAS u32x2v*)(slot + rw_off(j, 4 * rb + g) + 8 * hi) = w;
    }
}
DEVI void rw_st(LAS unsigned char* slot, const f32x16& acc, int rb, int cb, int r32, int hi) {
    const int j = 32 * cb + r32;
#pragma unroll
    for (int r = 0; r < 16; ++r) { const int i = 32 * rb + crow(r, hi);
        *(LAS unsigned short*)(slot + rw_off(i, j >> 3) + (j & 7) * 2) = (unsigned short)f2bf(acc[r]); }
}
DEVI void rw_ldaccT(f32x16& acc, const LAS unsigned char* slot, int rb, int cb, int r32, int hi) {
    const int j = 32 * cb + r32;
#pragma unroll
    for (int g = 0; g < 4; ++g) {
        const u32x2v w = *(const LAS u32x2v*)(slot + rw_off(j, 4 * rb + g) + 8 * hi);
        acc[4 * g] = __builtin_bit_cast(float, w.x << 16); acc[4 * g + 1] = __builtin_bit_cast(float, w.x & 0xffff0000u);
        acc[4 * g + 2] = __builtin_bit_cast(float, w.y << 16); acc[4 * g + 3] = __builtin_bit_cast(float, w.y & 0xffff0000u);
    }
}
DEVI void rw_zero(f32x16& a) {
#pragma unroll
    for (int r = 0; r < 16; ++r) a[r] = 0.f;
}
DEVI void rw_frags(v4u& f0, v4u& f1, const f32x16& a) {
    f0 = (v4u){cvtpk(a[0], a[1]), cvtpk(a[2], a[3]), cvtpk(a[4], a[5]), cvtpk(a[6], a[7])};
    f1 = (v4u){cvtpk(a[8], a[9]), cvtpk(a[10], a[11]), cvtpk(a[12], a[13]), cvtpk(a[14], a[15])};
}

struct RwP {
    const bf16 *R, *K, *V, *A, *B;
    const float *LW, *G, *BON;
    bf16 *AT, *BT, *KT, *RT;
    float* LAM;
    v4u *PF, *HF;
    float *QT, *OL;
    v4u* SF;
    const float *gn_g, *gn_b;
    bf16* MIX;
};

DEVI void rw_r1b(const RwP& P, int c, LAS unsigned char* lds) {
    LAS float* cum = (LAS float*)lds;
    const int tid = tidx();
    __syncthreads();
    if (tid < 256) {
        float s = 0.f;
#pragma unroll 8
        for (int t = 0; t < 64; ++t) { s += P.LW[(size_t)(c * 64 + t) * 256 + tid]; cum[t * 256 + tid] = s; }
    }
    __syncthreads();
    for (int e = tid; e < 64 * 256; e += 512) {
        const int t = e >> 8, ch = e & 255, h = ch >> 6, k = ch & 63;
        const size_t gi = (size_t)(c * 64 + t) * 256 + ch;
        const float cu = cum[e], lw = P.LW[gi];
        const float ein = __expf(cu), eout = __expf(-cu), eex = __expf(cu - lw);
        const size_t o = ((size_t)(c * 4 + h) * 64 + t) * 64 + k;
        P.AT[o] = (bf16)f2bf(bf2f(P.A[gi]) * eex);
        P.BT[o] = (bf16)f2bf(bf2f(P.B[gi]) * eout);
        P.KT[o] = (bf16)f2bf(bf2f(P.K[gi]) * eout);
        P.RT[o] = (bf16)f2bf(bf2f(P.R[gi]) * ein);
        if (t == 63) P.LAM[(size_t)(c * 4 + h) * 64 + k] = ein;
    }
}

DEVI void rw_r2(const RwP& P, int u0, LAS unsigned char* lds) {
    const int tid = tidx(), grp = tid >> 8, gt = tid & 255, gw = (tid >> 6) & 3, lane = tid & 63, r32 = lane & 31, hi = lane >> 5;
    const int rb = gw >> 1, cb = gw & 1;
    const int u = u0 + grp, c = u >> 2, h = u & 3;
    LAS unsigned char* sl = lds + grp * 65536;
#define SL(i) (sl + (i) * RW_SLOT)
    __syncthreads();
    rw_ld(SL(0), P.BT + (size_t)u * 4096, gt); rw_ld(SL(1), P.AT + (size_t)u * 4096, gt);
    rw_ld(SL(2), P.KT + (size_t)u * 4096, gt); rw_ld(SL(3), P.RT + (size_t)u * 4096, gt);
    __syncthreads();
    f32x16 aMab, aMak, aNbr, aNkr;
    rw_zero(aMab); rw_zero(aMak); rw_zero(aNbr); rw_zero(aNkr);
    rw_mm(aMab, SL(0), rb, SL(1), cb, r32, hi);
    rw_mm(aMak, SL(2), rb, SL(1), cb, r32, hi);
    rw_mm(aNbr, SL(0), rb, SL(3), cb, r32, hi);
    rw_mm(aNkr, SL(2), rb, SL(3), cb, r32, hi);
    {
        const int t = 32 * cb + r32;
#pragma unroll
        for (int r = 0; r < 16; ++r) { const int i = 32 * rb + crow(r, hi);
            if (!(i < t)) { aMab[r] = 0.f; aMak[r] = 0.f; }
            if (!(i <= t)) { aNbr[r] = 0.f; aNkr[r] = 0.f; } }
    }
    __syncthreads();
    rw_st(SL(4), aMab, rb, cb, r32, hi);
    rw_stT(SL(5), aMab, rb, cb, r32, hi);
    rw_st(SL(6), aMak, rb, cb, r32, hi);
    rw_stT(SL(7), aNbr, rb, cb, r32, hi);
    {
        const int t = 32 * cb + r32;
#pragma unroll
        for (int r = 0; r < 16; ++r) { const int i = 32 * rb + crow(r, hi); if (i == t) aMab[r] += 1.f; }
    }
    rw_st(SL(0), aMab, rb, cb, r32, hi);
    __syncthreads();
    int mA = 4, mT = 5, nA = 1, nT = 2;
#pragma unroll 1
    for (int j = 0; j < 5; ++j) {
        f32x16 a1; rw_zero(a1);
        rw_mm(a1, SL(mT), rb, SL(mA), cb, r32, hi);
        rw_stT(SL(nA), a1, rb, cb, r32, hi);
        rw_st(SL(nT), a1, rb, cb, r32, hi);
        __syncthreads();
        f32x16 a2; rw_ldaccT(a2, SL(0), rb, cb, r32, hi);
        rw_mm(a2, SL(nT), rb, SL(0), cb, r32, hi);
        __syncthreads();
        rw_stT(SL(0), a2, rb, cb, r32, hi);
        __syncthreads();
        const int ta = mA, tb = mT; mA = nA; mT = nT; nA = ta; nT = tb;
    }
    rw_ldT(SL(1), P.BT + (size_t)u * 4096, 64, gt); rw_ldT(SL(2), P.AT + (size_t)u * 4096, 64, gt);
    rw_ldT(SL(4), P.KT + (size_t)u * 4096, 64, gt); rw_ldT(SL(5), P.V + (size_t)(c * 64) * 256 + h * 64, 256, gt);
    __syncthreads();
    {
        f32x16 aY, aZ; rw_zero(aY); rw_zero(aZ);
        rw_mm(aY, SL(0), rb, SL(1), cb, r32, hi);
        rw_mm(aZ, SL(0), rb, SL(7), cb, r32, hi);
        __syncthreads();
        rw_stT(SL(1), aY, rb, cb, r32, hi);
        rw_stT(SL(7), aZ, rb, cb, r32, hi);
        __syncthreads();
    }
    {
        f32x16 aP; rw_zero(aP);
        rw_mm(aP, SL(2), rb, SL(1), cb, r32, hi);
        const int kp = 32 * cb + r32; const float lam = P.LAM[(size_t)u * 64 + kp];
#pragma unroll
        for (int r = 0; r < 16; ++r) { const int kk = 32 * rb + crow(r, hi); aP[r] = (aP[r] + (kk == kp ? 1.f : 0.f)) * lam; }
        v4u f0, f1; rw_frags(f0, f1, aP);
        v4u* dst = P.PF + ((((size_t)u * 2 + cb) * 2 + rb) * 2) * 64 + lane;
        dst[0] = f0; dst[64] = f1;
    }
    {
        f32x16 aH; rw_ldaccT(aH, SL(3), rb, cb, r32, hi);
        rw_mm(aH, SL(2), rb, SL(7), cb, r32, hi);
        v4u f0, f1; rw_frags(f0, f1, aH);
        v4u* dst = P.HF + ((((size_t)u * 2 + cb) * 2 + rb) * 2) * 64 + lane;
        dst[0] = f0; dst[64] = f1;
    }
    {
        f32x16 aD1; rw_ldaccT(aD1, SL(4), rb, cb, r32, hi);
        rw_mm(aD1, SL(6), rb, SL(1), cb, r32, hi);
        rw_mm(aNkr, SL(6), rb, SL(7), cb, r32, hi);
        __syncthreads();
        rw_stT(SL(0), aD1, rb, cb, r32, hi);
        rw_stT(SL(3), aNkr, rb, cb, r32, hi);
        __syncthreads();
    }
    {
        f32x16 aQ; rw_zero(aQ);
        rw_mm(aQ, SL(0), rb, SL(5), cb, r32, hi);
        float* dst = P.QT + (((size_t)u * 2 + cb) * 2 + rb) * 1024 + lane * 4;
#pragma unroll
        for (int g = 0; g < 4; ++g) {
            const float4 lam = *(const float4*)(P.LAM + (size_t)u * 64 + 32 * rb + 8 * g + 4 * hi);
            *(float4*)(dst + g * 256) = make_float4(aQ[4 * g] * lam.x, aQ[4 * g + 1] * lam.y, aQ[4 * g + 2] * lam.z, aQ[4 * g + 3] * lam.w);
        }
    }
    {
        f32x16 aO; rw_zero(aO);
        rw_mm(aO, SL(5), rb, SL(3), cb, r32, hi);
        float* dst = P.OL + (((size_t)u * 2 + cb) * 2 + rb) * 1024 + lane * 4;
#pragma unroll
        for (int g = 0; g < 4; ++g) *(float4*)(dst + g * 256) = make_float4(aO[4 * g], aO[4 * g + 1], aO[4 * g + 2], aO[4 * g + 3]);
    }
#undef SL
}

DEVI void rw_r3(const RwP& P, int h, int vb, int lane) {
    f32x16 st[2]; rw_zero(st[0]); rw_zero(st[1]);
#pragma unroll 1
    for (int c = 0; c < SEQ / 64; ++c) {
        const size_t u = (size_t)c * 4 + h;
        v4u sf[2][2];
        rw_frags(sf[0][0], sf[0][1], st[0]); rw_frags(sf[1][0], sf[1][1], st[1]);
        v4u* sdst = P.SF + ((u * 2 + vb) * 4) * 64 + lane;
        sdst[0] = sf[0][0]; sdst[64] = sf[0][1]; sdst[128] = sf[1][0]; sdst[192] = sf[1][1];
        f32x16 nw[2];
#pragma unroll
        for (int kb = 0; kb < 2; ++kb) {
            const float* q = P.QT + ((u * 2 + vb) * 2 + kb) * 1024 + lane * 4;
#pragma unroll
            for (int g = 0; g < 4; ++g) { const float4 v = *(const float4*)(q + g * 256); nw[kb][4 * g] = v.x; nw[kb][4 * g + 1] = v.y; nw[kb][4 * g + 2] = v.z; nw[kb][4 * g + 3] = v.w; }
            const v4u* pf = P.PF + (((u * 2 + kb) * 2) * 2) * 64 + lane;
#pragma unroll
            for (int ki = 0; ki < 2; ++ki)
#pragma unroll
                for (int s = 0; s < 2; ++s)
                    nw[kb] = __builtin_amdgcn_mfma_f32_32x32x16_bf16(__builtin_bit_cast(bf16x8, pf[(ki * 2 + s) * 64]), __builtin_bit_cast(bf16x8, sf[ki][s]), nw[kb], 0, 0, 0);
        }
        st[0] = nw[0]; st[1] = nw[1];
    }
}

DEVI void rw_r4(const RwP& P, int u, int tb, int lane) {
    const int c = u >> 2, h = u & 3, r32 = lane & 31, hi = lane >> 5;
    f32x16 o[2];
#pragma unroll
    for (int vb = 0; vb < 2; ++vb) {
        const float* ol = P.OL + (((size_t)u * 2 + tb) * 2 + vb) * 1024 + lane * 4;
#pragma unroll
        for (int g = 0; g < 4; ++g) { const float4 v = *(const float4*)(ol + g * 256); o[vb][4 * g] = v.x; o[vb][4 * g + 1] = v.y; o[vb][4 * g + 2] = v.z; o[vb][4 * g + 3] = v.w; }
        const v4u* sf = P.SF + (((size_t)u * 2 + vb) * 4) * 64 + lane;
        const v4u* hf = P.HF + ((((size_t)u * 2 + tb) * 2) * 2) * 64 + lane;
#pragma unroll
        for (int kb = 0; kb < 2; ++kb)
#pragma unroll
            for (int s = 0; s < 2; ++s)
                o[vb] = __builtin_amdgcn_mfma_f32_32x32x16_bf16(__builtin_bit_cast(bf16x8, sf[(kb * 2 + s) * 64]), __builtin_bit_cast(bf16x8, hf[(kb * 2 + s) * 64]), o[vb], 0, 0, 0);
    }
    float sum = 0.f;
#pragma unroll
    for (int r = 0; r < 16; ++r) sum += o[0][r] + o[1][r];
    sum += __shfl_xor(sum, 32, 64);
    const float mean = sum * (1.f / 64.f);
    float q = 0.f;
#pragma unroll
    for (int r = 0; r < 16; ++r) { const float d0 = o[0][r] - mean, d1 = o[1][r] - mean; q += d0 * d0 + d1 * d1; }
    q += __shfl_xor(q, 32, 64);
    const float rstd = rsqrtf(q * (1.f / 64.f) + 64e-5f);
    const size_t tok = (size_t)c * 64 + 32 * tb + r32;
#pragma unroll
    for (int vb = 0; vb < 2; ++vb)
#pragma unroll
        for (int g = 0; g < 4; ++g) {
            const int ch = h * 64 + 32 * vb + 8 * g + 4 * hi;
            const float4 gg = *(const float4*)(P.gn_g + ch), gb = *(const float4*)(P.gn_b + ch);
            const float4 bo = *(const float4*)(P.BON + tok * 256 + ch), gt = *(const float4*)(P.G + tok * 256 + ch);
            const float y0 = ((o[vb][4 * g] - mean) * rstd * gg.x + gb.x + bo.x) * gt.x;
            const float y1 = ((o[vb][4 * g + 1] - mean) * rstd * gg.y + gb.y + bo.y) * gt.y;
            const float y2 = ((o[vb][4 * g + 2] - mean) * rstd * gg.z + gb.z + bo.z) * gt.z;
            const float y3 = ((o[vb][4 * g + 3] - mean) * rstd * gg.w + gb.w + bo.w) * gt.w;
            *(uint2*)(P.MIX + tok * DM + 256 + ch) = make_uint2(cvtpk(y0, y1), cvtpk(y2, y3));
        }
}
namespace pg8 {
struct XaOrder {
    int G, c;
    __device__ __forceinline__ bool next(int i, Unit& u) const {
        const int L = i * G + c; if (L >= 256) return false;
        u.pm = L >> 2; u.pn = ((L >> 2) >> 5) * 4 + (L & 3); return true;
    }
    __device__ __forceinline__ void a_ready(const Unit&) const {}
    __device__ __forceinline__ void done(const Unit&) const {}
};
struct MoeOrder {
    const int* tile_e; const int* nrt; int G, c;
    __device__ __forceinline__ bool next(int i, Unit& u) const {
        const int L = i * G + c; if (L >= 4 * (*nrt)) return false;
        u.pm = L >> 2; u.pn = tile_e[L >> 2] * 4 + (L & 3); return true;
    }
    __device__ __forceinline__ void a_ready(const Unit&) const {}
    __device__ __forceinline__ void done(const Unit&) const {}
};
#define PG8_EBAR() do { asm volatile("s_waitcnt lgkmcnt(0)" ::: "memory"); __builtin_amdgcn_s_barrier(); asm volatile("" ::: "memory"); } while (0)
struct EpiSoftmaxP {
    static constexpr bool PERM = true, AFTER_DRAIN = true;
    bf16_t* P;
    __device__ __forceinline__ void fused(f32x4 (&acc)[2][2][4][2], const Unit& u, int wr, int wc, int fr, int fq, PG8_LAS unsigned char* lds, int wid, int lane) const {
        PG8_LAS float* RM = (PG8_LAS float*)lds;
        PG8_LAS float* RS = RM + 1024;
#pragma unroll
        for (int ai = 0; ai < 2; ++ai)
#pragma unroll
            for (int m = 0; m < 4; ++m) {
                float mx = -INFINITY;
#pragma unroll
                for (int bj = 0; bj < 2; ++bj)
#pragma unroll
                    for (int n = 0; n < 2; ++n) { const f32x4 x = acc[ai][bj][m][n]; mx = fmaxf(mx, fmaxf(fmaxf(x[0], x[1]), fmaxf(x[2], x[3]))); }
                mx = fmaxf(mx, __shfl_xor(mx, 16)); mx = fmaxf(mx, __shfl_xor(mx, 32));
                if (fq == 0) RM[(ai * HALF + wr * 64 + m * 16 + fr) * 4 + wc] = mx;
            }
        PG8_EBAR();
#pragma unroll
        for (int ai = 0; ai < 2; ++ai)
#pragma unroll
            for (int m = 0; m < 4; ++m) {
                const int row = ai * HALF + wr * 64 + m * 16 + fr;
                const float gm = fmaxf(fmaxf(RM[row * 4 + 0], RM[row * 4 + 1]), fmaxf(RM[row * 4 + 2], RM[row * 4 + 3]));
                float s = 0.f;
#pragma unroll
                for (int bj = 0; bj < 2; ++bj)
#pragma unroll
                    for (int n = 0; n < 2; ++n) { f32x4 x = acc[ai][bj][m][n];
                        x[0] = __builtin_amdgcn_exp2f(x[0] - gm); x[1] = __builtin_amdgcn_exp2f(x[1] - gm); x[2] = __builtin_amdgcn_exp2f(x[2] - gm); x[3] = __builtin_amdgcn_exp2f(x[3] - gm);
                        s += (x[0] + x[1]) + (x[2] + x[3]); acc[ai][bj][m][n] = x; }
                s += __shfl_xor(s, 16); s += __shfl_xor(s, 32);
                if (fq == 0) RS[row * 4 + wc] = s;
            }
        PG8_EBAR();
        const int colb = (u.pn & 3) * BM + wc * 32 + 8 * fq;
#pragma unroll
        for (int ai = 0; ai < 2; ++ai)
#pragma unroll
            for (int m = 0; m < 4; ++m) {
                const int row = ai * HALF + wr * 64 + m * 16 + fr;
                const float inv = 1.0f / ((RS[row * 4 + 0] + RS[row * 4 + 1]) + (RS[row * 4 + 2] + RS[row * 4 + 3]));
                bf16_t* rowp = P + (size_t)(u.pm * BM + row) * 1024 + colb;
#pragma unroll
                for (int bj = 0; bj < 2; ++bj) { const f32x4 v0 = acc[ai][bj][m][0] * inv, v1 = acc[ai][bj][m][1] * inv;
                    u32x4 w; w.x = cvt_pk_bf16(v0[0], v0[1]); w.y = cvt_pk_bf16(v0[2], v0[3]); w.z = cvt_pk_bf16(v1[0], v1[1]); w.w = cvt_pk_bf16(v1[2], v1[3]);
                    *(u32x4*)(rowp + bj * HALF) = w; }
            }
        PG8_EBAR();
    }
};
struct EpiF32N4 {
    static constexpr bool PERM = false, AFTER_DRAIN = false;
    float* C; int ldc;
    __device__ __forceinline__ void operator()(const f32x4 (&acc)[2][2][4][2], const Unit& u, int wr, int wc, int fr, int fq) const {
        const int row0 = u.pm * BM + wr * 64 + fr, col0 = (u.pn & 3) * BM + wc * 32 + 4 * fq;
#pragma unroll
        for (int ai = 0; ai < 2; ++ai)
#pragma unroll
            for (int m = 0; m < 4; ++m) { float* rowp = C + (size_t)(row0 + ai * HALF + m * 16) * ldc + col0;
#pragma unroll
                for (int bj = 0; bj < 2; ++bj)
#pragma unroll
                    for (int n = 0; n < 2; ++n) *(f32x4*)(rowp + bj * HALF + n * 16) = acc[ai][bj][m][n]; }
    }
};
struct EpiBf16N4 {
    static constexpr bool PERM = true, AFTER_DRAIN = false;
    bf16_t* O; int ldc;
    __device__ __forceinline__ void operator()(const f32x4 (&acc)[2][2][4][2], const Unit& u, int wr, int wc, int fr, int fq) const {
        const int row0 = u.pm * BM + wr * 64 + fr, col0 = (u.pn & 3) * BM + wc * 32 + 8 * fq;
#pragma unroll
        for (int ai = 0; ai < 2; ++ai)
#pragma unroll
            for (int m = 0; m < 4; ++m) { bf16_t* rowp = O + (size_t)(row0 + ai * HALF + m * 16) * ldc + col0;
#pragma unroll
                for (int bj = 0; bj < 2; ++bj) { const f32x4 v0 = acc[ai][bj][m][0], v1 = acc[ai][bj][m][1];
                    u32x4 w; w.x = cvt_pk_bf16(v0[0], v0[1]); w.y = cvt_pk_bf16(v0[2], v0[3]); w.z = cvt_pk_bf16(v1[0], v1[1]); w.w = cvt_pk_bf16(v1[2], v1[3]);
                    *(u32x4*)(rowp + bj * HALF) = w; } }
    }
};
struct EpiSiluMul {
    static constexpr bool PERM = true, AFTER_DRAIN = false;
    bf16_t* H;
    __device__ __forceinline__ void operator()(const f32x4 (&acc)[2][2][4][2], const Unit& u, int wr, int wc, int fr, int fq) const {
        const int row0 = u.pm * BM + wr * 64 + fr, col0 = (u.pn & 3) * HALF + wc * 32 + 8 * fq;
#pragma unroll
        for (int ai = 0; ai < 2; ++ai)
#pragma unroll
            for (int m = 0; m < 4; ++m) {
                float h[8];
#pragma unroll
                for (int n = 0; n < 2; ++n)
#pragma unroll
                    for (int e = 0; e < 4; ++e) { const float g = acc[ai][0][m][n][e], up = acc[ai][1][m][n][e];
                        h[4 * n + e] = g * __builtin_amdgcn_rcpf(1.0f + __expf(-g)) * up; }
                u32x4 w; w.x = cvt_pk_bf16(h[0], h[1]); w.y = cvt_pk_bf16(h[2], h[3]); w.z = cvt_pk_bf16(h[4], h[5]); w.w = cvt_pk_bf16(h[6], h[7]);
                *(u32x4*)(H + (size_t)(row0 + ai * HALF + m * 16) * 512 + col0) = w;
            }
    }
};

struct OneUnit {
    int pm, pn, valid;
    __device__ __forceinline__ bool next(int i, Unit& u) const { if (i != 0 || !valid) return false; u.pm = pm; u.pn = pn; return true; }
    __device__ __forceinline__ void a_ready(const Unit&) const {}
    __device__ __forceinline__ void done(const Unit&) const {}
};
struct EpiBf16S {
    static constexpr bool PERM = true, AFTER_DRAIN = false;
    bf16_t* O; int ldc; float scale;
    __device__ __forceinline__ void operator()(const f32x4 (&acc)[2][2][4][2], const Unit& u, int wr, int wc, int fr, int fq) const {
        const int row0 = u.pm * BM + wr * 64 + fr, col0 = u.pn * BM + wc * 32 + 8 * fq;
#pragma unroll
        for (int ai = 0; ai < 2; ++ai)
#pragma unroll
            for (int m = 0; m < 4; ++m) { bf16_t* rowp = O + (size_t)(row0 + ai * HALF + m * 16) * ldc + col0;
#pragma unroll
                for (int bj = 0; bj < 2; ++bj) { const f32x4 v0 = acc[ai][bj][m][0] * scale, v1 = acc[ai][bj][m][1] * scale;
                    u32x4 w; w.x = cvt_pk_bf16(v0[0], v0[1]); w.y = cvt_pk_bf16(v0[2], v0[3]); w.z = cvt_pk_bf16(v1[0], v1[1]); w.w = cvt_pk_bf16(v1[2], v1[3]);
                    *(u32x4*)(rowp + bj * HALF) = w; } }
    }
};
struct EpiGeluF32 {
    static constexpr bool PERM = false, AFTER_DRAIN = false;
    float* C; int ldc;
    __device__ __forceinline__ void operator()(const f32x4 (&acc)[2][2][4][2], const Unit& u, int wr, int wc, int fr, int fq) const {
        const int row0 = u.pm * BM + wr * 64 + fr, col0 = u.pn * BM + wc * 32 + 4 * fq;
#pragma unroll
        for (int ai = 0; ai < 2; ++ai)
#pragma unroll
            for (int m = 0; m < 4; ++m) { float* rowp = C + (size_t)(row0 + ai * HALF + m * 16) * ldc + col0;
#pragma unroll
                for (int bj = 0; bj < 2; ++bj)
#pragma unroll
                    for (int n = 0; n < 2; ++n) { f32x4 x = acc[ai][bj][m][n];
#pragma unroll
                        for (int e = 0; e < 4; ++e) x[e] = 0.5f * x[e] * (1.f + tanhf(0.7978845608028654f * (x[e] + 0.044715f * x[e] * x[e] * x[e])));
                        *(f32x4*)(rowp + bj * HALF + n * 16) = x; } }
    }
};
}

DEVI void tr_blk(const float* W, size_t ldw, int N, int k0, int n0, bf16* WT, size_t ldt, int drow0, float scale, LAS float* scr, int lane) {
    const int n_ = n0 + (lane & 31);
#pragma unroll 8
    for (int i = 0; i < 32; ++i) { const int kk = 2 * i + (lane >> 5); scr[kk * 33 + (lane & 31)] = n_ < N ? W[(size_t)(k0 + kk) * ldw + n_] * scale : 0.f; }
    LDS_WAIT(); asm volatile("" ::: "memory");
    const int c = lane & 7;
#pragma unroll
    for (int j = 0; j < 4; ++j) { const int n = (lane >> 3) + 8 * j; const LAS float* s = scr + (8 * c) * 33 + n;
        v4u o; o.x = pk2(s[0 * 33], s[1 * 33]); o.y = pk2(s[2 * 33], s[3 * 33]); o.z = pk2(s[4 * 33], s[5 * 33]); o.w = pk2(s[6 * 33], s[7 * 33]);
        *(GAS v4u*)(WT + (size_t)(drow0 + n) * ldt + k0 + 8 * c) = o; }
    LDS_WAIT(); asm volatile("" ::: "memory");
}
DEVI void cvt_bf16(const float* __restrict__ src, bf16* __restrict__ dst, size_t n, float scale, int B0, int G) {
    for (size_t i = ((size_t)B0 * 512 + tidx()) * 4; i < n; i += (size_t)G * 512 * 4) {
        const float4 v = *(const float4*)(src + i);
        *(uint2*)(dst + i) = make_uint2(pk2(v.x * scale, v.y * scale), pk2(v.z * scale, v.w * scale));
    }
}

DEVI void moe_lists2(const int* __restrict__ te, int* __restrict__ off, int* __restrict__ nrt, int* __restrict__ tile_e, int* __restrict__ list,
                     int* __restrict__ slotpos, float* sm0) {
    int* cnt = (int*)sm0;
    int* offs = cnt + 16;
    const int w = tidx() >> 6, lane = tidx() & 63;
    __syncthreads();
    for (int ee = 0; ee < 2; ++ee) {
        const int e = w * 2 + ee;
        int c = 0;
        for (int base = 0; base < NTOK; base += 64) {
            const int tok = base + lane;
            const bool m = (te[tok * 2] == e) || (te[tok * 2 + 1] == e);
            c += __popcll(__ballot(m));
        }
        if (lane == 0) cnt[e] = c;
    }
    __syncthreads();
    if (tidx() == 0) {
        int s = 0;
#pragma unroll 1
        for (int i = 0; i < 16; ++i) { offs[i] = s; off[i] = s; const int pc = (cnt[i] + 255) & ~255;
#pragma unroll 1
            for (int r = s / 256; r < (s + pc) / 256; ++r) tile_e[r] = i;
            s += pc; }
        offs[16] = s; off[16] = s; *nrt = s / 256;
    }
    __syncthreads();
    for (int ee = 0; ee < 2; ++ee) {
        const int e = w * 2 + ee;
        int pos = offs[e];
        for (int base = 0; base < NTOK; base += 64) {
            const int tok = base + lane;
            const int a = te[tok * 2], b = te[tok * 2 + 1];
            const bool m = (a == e) || (b == e);
            const unsigned long long mask = __ballot(m);
            if (m) {
                const int p = pos + __popcll(mask & ((1ull << lane) - 1ull));
                list[p] = tok;
                slotpos[tok * 2 + (a == e ? 0 : 1)] = p;
            }
            pos += __popcll(mask);
        }
        for (int p = pos + lane; p < offs[e + 1]; p += 64) list[p] = -1;
    }
    __syncthreads();
}
DEVI void moe_gather(const bf16* __restrict__ xn, const int* __restrict__ list, const int* __restrict__ off, bf16* __restrict__ xg, int B0, int G) {
    const int total = off[16];
    const int gw = B0 * NWAVES + (tidx() >> 6), lane = tidx() & 63;
    for (int p = gw; p < total; p += G * NWAVES) {
        const int tok = list[p];
        v4u a = (v4u){0u, 0u, 0u, 0u}, b = a;
        if (tok >= 0) { const v4u* s = (const v4u*)(xn + (size_t)tok * DM); a = s[lane]; b = s[lane + 64]; }
        v4u* d = (v4u*)(xg + (size_t)p * DM); d[lane] = a; d[lane + 64] = b;
    }
}
DEVI void moe_combine_ln2(const float* x, const bf16* __restrict__ Dp, const int* __restrict__ te,
                          const float* __restrict__ tw, const int* __restrict__ slotpos,
                          const float* __restrict__ g, const float* __restrict__ bt, float* out, bf16* outb, int bid, float* sm) {
    __syncthreads();
    const size_t t = bid; const int tid = tidx() & 255;
    int ea = te[t * 2], eb = te[t * 2 + 1];
    float wa = tw[t * 2], wb = tw[t * 2 + 1];
    size_t pa = slotpos[t * 2], pb = slotpos[t * 2 + 1];
    if (eb < ea) { const float tf = wa; wa = wb; wb = tf; const size_t tp = pa; pa = pb; pb = tp; }
    float v[4];
#pragma unroll
    for (int i = 0; i < 4; ++i) {
        const int c = tid + i * 256;
        float y = wa * bf2f(Dp[pa * DM + c]);
        y = y + wb * bf2f(Dp[pb * DM + c]);
        v[i] = ALPHA * x[t * DM + c] + y;
    }
    const float mean = block_sum256(v[0] + v[1] + v[2] + v[3], sm, tid) * (1.f / DM);
    float q = 0.f;
#pragma unroll
    for (int i = 0; i < 4; ++i) { v[i] -= mean; q += v[i] * v[i]; }
    const float var = block_sum256(q, sm, tid) * (1.f / DM);
    const float rstd = rsqrtf(var + 1e-5f);
#pragma unroll
    for (int i = 0; i < 4; ++i) {
        const int c = tid + i * 256;
        const float o = v[i] * rstd * g[c] + bt[c];
        out[t * DM + c] = o;
        outb[t * DM + c] = (bf16)f2bf(o);
    }
}
#ifndef PROBE_ID
#define PROBE_ID 0
#endif
#define PROBE_N 3
#define REP(id) for (int rep_ = 0; rep_ < ((PROBE_ID == (id)) ? 1 + PROBE_N : 1); ++rep_)
struct MP {
    const float* in[50];
    float *X, *VFIRST, *TW, *R0;
    bf16 *XN, *MIX, *WIN_T, *WOUT_T, *COLSB, *WQK_T, *VWO_T, *W1_T;
    int *TE, *SLOT, *LIST, *EOFF;
    unsigned* BAR;
};

DEVI void tr_item(const float* W, int K, int N, int Npad, bf16* WT, LAS float* scr, int item, int lane) {
    const int nblk = Npad / 32, kb = item / nblk, nb = item % nblk, k0 = 64 * kb, n0 = 32 * nb;
    const int n_ = n0 + (lane & 31);
#pragma unroll 8
    for (int i = 0; i < 32; ++i) { const int kk = 2 * i + (lane >> 5); scr[kk * 33 + (lane & 31)] = n_ < N ? W[(size_t)(k0 + kk) * N + n_] : 0.f; }
    LDS_WAIT(); asm volatile("" ::: "memory");
    const int c = lane & 7;
#pragma unroll
    for (int j = 0; j < 4; ++j) { const int n = (lane >> 3) + 8 * j; const LAS float* s = scr + (8 * c) * 33 + n;
        v4u o; o.x = pk2(s[0 * 33], s[1 * 33]); o.y = pk2(s[2 * 33], s[3 * 33]); o.z = pk2(s[4 * 33], s[5 * 33]); o.w = pk2(s[6 * 33], s[7 * 33]);
        *(GAS v4u*)(WT + (size_t)(n0 + n) * K + k0 + 8 * c) = o; }
    LDS_WAIT(); asm volatile("" ::: "memory");
}

DEVI void gemm_all(const GemmArgs& g, int maxM, int Z, int B0, int G, unsigned char* lds) {
    const int total = gemm_tiles(g, maxM, Z);
    for (int t0 = B0 * 2; t0 < total; t0 += G * 2) {
        const int vb = tidx() >> 8; float* sm = (float*)(lds + vb * 32768);
        const bool l0 = gemm_tile_live(g, maxM, t0), l1 = (t0 + 1 < total) && gemm_tile_live(g, maxM, t0 + 1);
        if (!l0 && !l1) continue;
        const int t = (vb && t0 + 1 < total) ? t0 + 1 : t0;
        gemm_tile(g, maxM, t, vb ? l1 : l0, sm);
    }
}

__global__ void __launch_bounds__(512, 2) mega(MP p) {
    extern __shared__ __attribute__((aligned(16))) unsigned char lds[];
    cg::grid_group grid = cg::this_grid();
    const int G = gridDim.x, B0 = blockIdx.x;
    {
        LAS unsigned* ctl = (LAS unsigned*)((LAS unsigned char*)lds + LDSCTL_OFF);
        for (int u = threadIdx.x; u < (LDS_BYTES - LDSCTL_OFF) / 4; u += NWAVES * 64) ctl[u] = 0u;
    }
    __syncthreads();
    volatile LAS unsigned* MISC = (volatile LAS unsigned*)((LAS unsigned char*)lds + MISC_OFF);
    XcdBarrier bar = xcd_barrier_post(p.BAR, MISC + 8);
    grid.sync();
#define GSYNC() do { REP(24) xcd_barrier(bar); } while (0)
    float* sm0 = (float*)lds;
    LAS unsigned char* ring = (LAS unsigned char*)lds + RING_OFF;
#define VLOOP(n, body) for (int t0_ = B0 * 2; t0_ < (n); t0_ += G * 2) { const int vb = tidx() >> 8; float* sm = (float*)(lds + vb * 32768); const int t = min(t0_ + vb, (n) - 1); body; }

    const float *x_in = p.in[0], *mem = p.in[1];
    float* X = p.X;
    float* R0 = p.R0;
    float* T0 = R0;
    const size_t TB = (size_t)SEQ * 256;
    float *rLW = T0, *rG = T0 + TB, *rBON = T0 + 2 * TB, *rVD = T0 + 5 * TB + TB / 2;
    bf16 *rR = (bf16*)(T0 + 3 * TB), *rK = rR + TB, *rV = rK + TB, *rA = rV + TB, *rB = rA + TB;
    bf16 *rAT = (bf16*)(T0 + 6 * TB), *rBT = rAT + TB, *rKT = rBT + TB, *rRT = rKT + TB;
    float* rLAM = T0 + 8 * TB;
    v4u* rSF = (v4u*)(rLAM + 512 * 64);
    bf16 *QNb = (bf16*)(T0 + 9 * TB), *QRb = QNb + (size_t)SEQ * 256, *KSRb = QRb + (size_t)SEQ * 256, *KWRb = KSRb + (size_t)SEQ * 64,
         *VSTb = KWRb + (size_t)SEQ * 64, *VWTb = VSTb + (size_t)SEQ * 64, *KCMPb = VWTb + (size_t)SEQ * 64, *VCMPTb = KCMPb + 512 * 64;
    float* GATES = (float*)(VCMPTb + 512 * 64);
    bf16 *BLK = (bf16*)(GATES + (size_t)SEQ * 12 + 16), *BLV = BLK + (size_t)512 * 2048;
    float *HIDK = (float*)(BLV + (size_t)512 * 2048), *HIDV = HIDK + (size_t)512 * 256,
          *KCMP = HIDV + (size_t)512 * 256, *VCMP = KCMP + (size_t)NCMP * 64;
    float *HCONV = VCMP + (size_t)NCMP * 64, *UB = HCONV + TB, *VB = UB + TB;
    v4u *rPF = (v4u*)HCONV, *rHF = rPF + (size_t)512 * 512;
    float *rQT = (float*)(rHF + (size_t)512 * 512), *rOL = rQT + (size_t)512 * 4096;
    float* Y = R0;
    bf16* PB = (bf16*)(R0 + (size_t)17 * 1000 * 1000);
    bf16* XG = (bf16*)R0;
    bf16* HB = (bf16*)(R0 + (size_t)19 * 1000 * 1000);
    bf16* WGU_T = (bf16*)(R0 + (size_t)34 * 1000 * 1000);
    bf16* WD_T = (bf16*)(R0 + (size_t)43 * 1000 * 1000);

    bf16* WQB = (bf16*)R0;
    bf16* WKT = WQB + (size_t)2 * DM * DM;
    bf16* WVT = WKT + (size_t)2 * DM * DM;
    bf16* WOT = WVT + (size_t)2 * DM * DM;
    bf16* MEMB = WOT + (size_t)2 * DM * DM;
    bf16* KMEMB = MEMB + (size_t)NB * MEML * DM;
    bf16* VMEMB = KMEMB + (size_t)2 * NB * MEML * DM;
    {
        LAS float* scr = (LAS float*)(ring + (tidx() >> 6) * 16384);
        const int gw = B0 * NWAVES + (tidx() >> 6), NGW = G * NWAVES, lane = tidx() & 63;
        constexpr int I_IN = (DM / 64) * (DINP / 32), I_SQ = (DM / 64) * (DM / 32), I_W1 = (2048 / 64) * (256 / 32);
        for (int it = gw; it < 2 * I_IN + 8 * I_SQ + 4 * I_W1; it += NGW) {
            int r = it;
            if (r < 2 * I_IN) {
                const int l = r / I_IN, item = r % I_IN; const int nblk = DINP / 32, kb = item / nblk, nb = item % nblk, k0 = 64 * kb, n0 = 32 * nb;
                const float* W = p.in[4] + (size_t)l * DM * DIN; const float* VD = p.in[21];
                const int n_ = n0 + (lane & 31);
#pragma unroll 8
                for (int i = 0; i < 32; ++i) { const int kk = 2 * i + (lane >> 5);
                    float v = 0.f;
                    if (n_ < DIN) v = W[(size_t)(k0 + kk) * DIN + n_]; else if (l == 1 && n_ < DIN + 32) v = VD[(size_t)(k0 + kk) * 32 + (n_ - DIN)];
                    scr[kk * 33 + (lane & 31)] = v; }
                LDS_WAIT(); asm volatile("" ::: "memory");
                const int c = lane & 7; bf16* WT = p.WIN_T + (size_t)l * DINP * DM;
#pragma unroll
                for (int j = 0; j < 4; ++j) { const int n = (lane >> 3) + 8 * j; const LAS float* s = scr + (8 * c) * 33 + n;
                    v4u o; o.x = pk2(s[0 * 33], s[1 * 33]); o.y = pk2(s[2 * 33], s[3 * 33]); o.z = pk2(s[4 * 33], s[5 * 33]); o.w = pk2(s[6 * 33], s[7 * 33]);
                    *(GAS v4u*)(WT + (size_t)(n0 + n) * DM + k0 + 8 * c) = o; }
                LDS_WAIT(); asm volatile("" ::: "memory");
                continue;
            }
            r -= 2 * I_IN;
            if (r < 8 * I_SQ) {
                const int which = r / (2 * I_SQ), l = (r / I_SQ) & 1, item = r % I_SQ, kb = item / 32, nb = item % 32;
                const float* W = (which == 0 ? p.in[5] : which == 1 ? p.in[38] : which == 2 ? p.in[39] : p.in[40]) + (size_t)l * DM * DM;
                bf16* WT = (which == 0 ? p.WOUT_T : which == 1 ? WKT : which == 2 ? WVT : WOT) + (size_t)l * DM * DM;
                tr_blk(W, DM, DM, kb * 64, nb * 32, WT, DM, nb * 32, 1.f, scr, lane);
                continue;
            }
            r -= 8 * I_SQ;
            {
                const int which = r / I_W1, item = r % I_W1, kb = item / 8, nb = item % 8, l = which >> 1;
                const float* W = ((which & 1) ? p.in[33] : p.in[30]) + (size_t)l * 2048 * 256;
                tr_blk(W, 256, 256, kb * 64, nb * 32, p.W1_T + (size_t)which * 256 * 2048, 2048, nb * 32, 1.f, scr, lane);
            }
        }
        cvt_bf16(p.in[37], WQB, (size_t)2 * DM * DM, 1.f, B0, G);
        cvt_bf16(mem, MEMB, (size_t)NB * MEML * DM, 1.f, B0, G);
    }
    __syncthreads();
    VLOOP(NTOK, ln_kernel(x_in, 1.0f, nullptr, p.in[2], p.in[3], X, p.XN, t, sm))
    GSYNC();
    {
        const int gi = B0 >> 3, un = B0 & 7;
        pg8::Gemm g{MEMB, ((gi & 1) ? WVT : WKT) + (size_t)(gi >> 1) * DM * DM, NB * MEML, DM, DM};
        pg8::OneUnit S{un >> 2, un & 3, B0 < 32 ? 1 : 0};
        pg8::EpiBf16<0> E{((gi & 1) ? VMEMB : KMEMB) + (size_t)(gi >> 1) * NB * MEML * DM, DM, nullptr, 0, 0, 1.f};
        pg8::gemm_phase<pg8::EpiBf16<0>, pg8::OneUnit, false, true>(ring, g, S, E);
    }
    GSYNC();
    {
        const int l = (B0 >> 6) & 1, kind = (B0 >> 5) & 1, bh = (B0 >> 2) & 7, q4 = B0 & 3, b = bh >> 2, h = bh & 3;
        if (kind == 0) {
            pg8::Gemm g{KMEMB + (size_t)l * NB * MEML * DM + (size_t)b * MEML * DM + h * 256, WQB + (size_t)l * DM * DM + h * 256, 256, DM, 256, DM, DM};
            pg8::OneUnit S{0, q4, B0 < 128 ? 1 : 0};
            pg8::EpiBf16S E{p.WQK_T + (size_t)l * NB * DM * DM + (size_t)b * DM * DM + (size_t)h * 256 * DM, DM, 0.0625f * 1.4426950408889634f};
            pg8::gemm_phase<pg8::EpiBf16S, pg8::OneUnit, false, true>(ring, g, S, E);
        } else {
            pg8::Gemm g{WOT + (size_t)l * DM * DM + h * 256, VMEMB + (size_t)l * NB * MEML * DM + (size_t)b * MEML * DM + h * 256, DM, 256, 256, DM, DM};
            pg8::OneUnit S{q4, 0, B0 < 128 ? 1 : 0};
            pg8::EpiBf16S E{p.VWO_T + (size_t)l * NB * DM * DM + (size_t)b * DM * DM + h * 256, DM, 1.f};
            pg8::gemm_phase<pg8::EpiBf16S, pg8::OneUnit, false, true>(ring, g, S, E);
        }
    }
    GSYNC();
    for (int l = 0; l < 2; ++l) {
REP(1) {
        {
            pg8::Gemm g{p.XN, p.WIN_T + (size_t)l * DINP * DM, NTOK, DINP, DM};
            pg8::StaticOrder S; S.init(NTOK, DINP, G, B0);
            pg8::EpiBf16<0> E{p.COLSB, DINP, nullptr, 0, 0, 1.f};
            pg8::gemm_phase<pg8::EpiBf16<0>, pg8::StaticOrder, true, true>(ring, g, S, E);
        }
}
        for (int b = 0; b < NB; ++b) {
            const bf16* COLS = p.COLSB + (size_t)b * SEQ * DINP;
            RwP rw; rw.R = rR; rw.K = rK; rw.V = rV; rw.A = rA; rw.B = rB; rw.LW = rLW; rw.G = rG; rw.BON = rBON;
            rw.AT = rAT; rw.BT = rBT; rw.KT = rKT; rw.RT = rRT; rw.LAM = rLAM; rw.PF = rPF; rw.HF = rHF; rw.QT = rQT; rw.OL = rOL; rw.SF = rSF;
            rw.gn_g = p.in[19] + l * 256; rw.gn_b = p.in[20] + l * 256; rw.MIX = p.MIX + (size_t)b * SEQ * DM;
            const float* Xb = X + (size_t)b * SEQ * DM;
            bf16* MIXb = p.MIX + (size_t)b * SEQ * DM;
            float* VFb = p.VFIRST + (size_t)b * SEQ * 256;

            GSYNC();
            {
                RwkvP rp;
                rp.cols = COLS; rp.mu = p.in[10] + l * 1024; rp.w0 = p.in[11] + l * 256; rp.w_up = p.in[12] + (size_t)l * 64 * 256;
                rp.a0 = p.in[13] + l * 256; rp.a_up = p.in[14] + (size_t)l * 64 * 256; rp.g_up = p.in[15] + (size_t)l * 128 * 256;
                rp.k_k = p.in[16] + l * 256; rp.k_a = p.in[17] + l * 256; rp.r_k = p.in[18] + l * 256;
                rp.vd = rVD; rp.v_mu = p.in[22]; rp.v0 = p.in[23]; rp.v_up = p.in[24];
                rp.vfirst = VFb; rp.R = rR; rp.LW = rLW; rp.K = rK; rp.V = rV; rp.A = rA; rp.Bv = rB; rp.G = rG; rp.BON = rBON; rp.layer = l; rp.pad = 0;
REP(2) {
                VLOOP(SEQ, glu_kernel(COLS, HCONV, t))
                VLOOP(SEQ, gmlp_pre(COLS, p.in[25] + l * 256, p.in[26] + l * 256, UB, VB, t, sm))
}
REP(17) {
                VLOOP(SEQ, rwkv_prep(rp, t, sm))
}
REP(18) {
                VLOOP(SEQ, nsa_prep2(COLS, QNb, QRb, KSRb, KWRb, VSTb, VWTb, GATES, t))
                VLOOP(512, cmp_gather(COLS, p.in[29] + (size_t)l * 2048, p.in[32] + (size_t)l * 2048, BLK, BLV, t))
}
            }
            GSYNC();
            {
REP(3) {
                for (int c = B0; c < SEQ / 64; c += G) rw_r1b(rw, c, ring);
                __syncthreads();
}
REP(4) {
                {
                    const int isv = (B0 >> 1) & 1;
                    pg8::Gemm g{isv ? BLV : BLK, p.W1_T + (size_t)(l * 2 + isv) * 256 * 2048, 512, 256, 2048};
                    pg8::OneUnit S{B0 & 1, 0, B0 < 4 ? 1 : 0};
                    pg8::EpiGeluF32 E{isv ? HIDV : HIDK, 256};
                    pg8::gemm_phase<pg8::EpiGeluF32, pg8::OneUnit, false, true>(ring, g, S, E);
                }
}
REP(5) {
                VLOOP(SEQ, conv_kernel(HCONV, p.in[6] + (size_t)l * 31 * 256, p.in[7] + l * 256, p.in[8] + l * 256, p.in[9] + l * 256, MIXb, t))
                VLOOP(SEQ, gmlp_mix(UB, VB, p.in[27] + (size_t)l * 4 * 128 * 128, p.in[28] + l * 4 * 128, MIXb, t))
}
            }
            GSYNC();
REP(6) {
            for (int u0 = 2 * B0; u0 < 512; u0 += 2 * G) rw_r2(rw, u0, ring);
}
            __syncthreads();
            {
                const GemmArgs gk = mk(HIDK, 256, p.in[31] + (size_t)l * 256 * 64, 64, 1, KCMP, 64, NCMP, 64, 256);
                const GemmArgs gv = mk(HIDV, 256, p.in[34] + (size_t)l * 256 * 64, 64, 1, VCMP, 64, NCMP, 64, 256);
REP(7) {
                gemm_all(gk, NCMP, 1, B0, G, lds);
                gemm_all(gv, NCMP, 1, B0, G, lds);
}
            }
            GSYNC();
            VLOOP(512 * 64 / 256, nsa_cmp_cvt(KCMP, VCMP, KCMPb, VCMPTb, t))
            GSYNC();
            if (B0 == G - 1) {
REP(8) {
                { const int w_ = tidx() >> 6; rw_r3(rw, w_ >> 1, w_ & 1, tidx() & 63); }
}
            } else {
                NsaP np; np.QN = QNb; np.QR = QRb; np.KSR = KSRb; np.KWR = KWRb; np.VST = VSTb; np.VWT = VWTb; np.KCMP = KCMPb; np.VCMPT = VCMPTb; np.GATES = GATES; np.MIX = MIXb;
REP(9) {
                for (int u = B0; u < SEQ / 64; u += G - 1) nsa_unit(np, SEQ / 64 - 1 - u, ring);
}
            }
            GSYNC();
REP(10) {
            for (int i = B0 * NWAVES + (tidx() >> 6); i < 1024; i += G * NWAVES) rw_r4(rw, i >> 1, i & 1, tidx() & 63);
}
            GSYNC();
        }
        {
REP(11) {
            pg8::Gemm g{p.MIX, p.WOUT_T + (size_t)l * DM * DM, NTOK, DM, DM};
            pg8::StaticOrder S; S.init(NTOK, DM, G, B0);
            pg8::EpiF32 E{Y, DM, nullptr};
            pg8::gemm_phase<pg8::EpiF32, pg8::StaticOrder, true, true>(ring, g, S, E);
}
        }
        GSYNC();
        VLOOP(NTOK, ln_kernel(X, ALPHA, Y, p.in[35] + l * DM, p.in[36] + l * DM, X, p.XN, t, sm))
        __syncthreads();
        {
            LAS float* scr = (LAS float*)(ring + (tidx() >> 6) * 16384);
            const int gw = B0 * NWAVES + (tidx() >> 6), NGW = G * NWAVES, lane = tidx() & 63;
            const float* wg = p.in[45] + (size_t)l * 16 * DM * 512;
            const float* wu = p.in[46] + (size_t)l * 16 * DM * 512;
            const float* wd = p.in[47] + (size_t)l * 16 * 512 * DM;
            constexpr int I_GU = (DM / 64) * (512 / 32), I_D = (512 / 64) * (DM / 32);
REP(13) {
            for (int it = gw; it < 16 * (2 * I_GU + I_D); it += NGW) {
                const int e = it / (2 * I_GU + I_D); int r = it % (2 * I_GU + I_D);
                if (r < 2 * I_GU) {
                    const int isup = r / I_GU; r %= I_GU;
                    const int kb = r / 16, nb = r % 16, n0 = nb * 32;
                    tr_blk((isup ? wu : wg) + (size_t)e * DM * 512, 512, 512, kb * 64, n0, WGU_T + (size_t)e * 1024 * DM, DM, (n0 >> 7) * 256 + (n0 & 127) + isup * 128, 1.f, scr, lane);
                } else {
                    r -= 2 * I_GU;
                    const int kb = r / 32, nb = r % 32;
                    tr_blk(wd + (size_t)e * 512 * DM, DM, DM, kb * 64, nb * 32, WD_T + (size_t)e * DM * 512, 512, nb * 32, 1.f, scr, lane);
                }
            }
}
        }
        GSYNC();
        {
            bf16* WQK_T = p.WQK_T + (size_t)l * NB * DM * DM;
REP(14) {
            pg8::Gemm g{p.XN, WQK_T, NTOK, DM, DM};
            pg8::XaOrder S{G, B0};
            pg8::EpiSoftmaxP E{PB};
            pg8::gemm_phase<pg8::EpiSoftmaxP, pg8::XaOrder, false, true>(ring, g, S, E);
}
        }
        GSYNC();
        {
REP(15) {
            pg8::Gemm g{PB, p.VWO_T + (size_t)l * NB * DM * DM, NTOK, DM, DM};
            pg8::XaOrder S{G, B0};
            pg8::EpiF32N4 E{Y, DM};
            pg8::gemm_phase<pg8::EpiF32N4, pg8::XaOrder, true, true>(ring, g, S, E);
}
        }
        GSYNC();
        VLOOP(NTOK, ln_kernel(X, ALPHA, Y, p.in[41] + l * DM, p.in[42] + l * DM, X, p.XN, t, sm))
        GSYNC();
REP(19) {
        VLOOP(NTOK, router_kernel(X, p.in[43], p.in[44], p.TE, p.TW, t, sm))
}
        GSYNC();
REP(20) {
        if (B0 == 0) moe_lists2(p.TE, p.EOFF, p.EOFF + 32, p.EOFF + 64, p.LIST, p.SLOT, sm0);
}
        GSYNC();
REP(21) {
        moe_gather(p.XN, p.LIST, p.EOFF, XG, B0, G);
}
        GSYNC();
        {
REP(22) {
            pg8::Gemm g{XG, WGU_T, 0, 0, DM};
            pg8::MoeOrder S{p.EOFF + 64, p.EOFF + 32, G, B0};
            pg8::EpiSiluMul E{HB};
            pg8::gemm_phase<pg8::EpiSiluMul, pg8::MoeOrder, true, true>(ring, g, S, E);
}
        }
        GSYNC();
        {
REP(23) {
            pg8::Gemm g{HB, WD_T, 0, 0, 512};
            pg8::MoeOrder S{p.EOFF + 64, p.EOFF + 32, G, B0};
            pg8::EpiBf16N4 E{XG, DM};
            pg8::gemm_phase<pg8::EpiBf16N4, pg8::MoeOrder, true, true>(ring, g, S, E);
}
        }
        GSYNC();
        VLOOP(NTOK, moe_combine_ln2(X, XG, p.TE, p.TW, p.SLOT, p.in[48] + l * DM, p.in[49] + l * DM, X, p.XN, t, sm))
        GSYNC();
    }
}

extern "C" void kernel_launch(void* const* d_in, const int* in_sizes, int n_in, void* d_out, int out_size, void* d_ws, size_t ws_size,
                              hipStream_t stream) {
    static int grid_blocks = 0;
    if (!grid_blocks) {
        int dev = 0, cus = 0, per_cu = 0;
        (void)hipGetDevice(&dev);
        (void)hipDeviceGetAttribute(&cus, hipDeviceAttributeMultiprocessorCount, dev);
        (void)hipFuncSetAttribute((const void*)mega, hipFuncAttributeMaxDynamicSharedMemorySize, LDS_BYTES);
        (void)hipOccupancyMaxActiveBlocksPerMultiprocessor(&per_cu, (const void*)mega, NWAVES * 64, LDS_BYTES);
        (void)hipGetLastError();
        if (per_cu < 1) { fprintf(stderr, "occupancy query says %d blocks per CU\n", per_cu); per_cu = 1; }
        grid_blocks = cus;
    }
    MP p; memset(&p, 0, sizeof(p));
    for (int i = 0; i < 50; ++i) p.in[i] = (const float*)d_in[i];
    char* ws = (char*)d_ws;
    size_t o = 0;
    auto take = [&](size_t bytes) { char* q = ws + o; o += (bytes + 255) & ~(size_t)255; return q; };
    p.BAR = (unsigned*)take(16384);
    p.X = (float*)d_out;
    p.VFIRST = (float*)take((size_t)NTOK * 256 * 4);
    p.MIX = (bf16*)take((size_t)NTOK * DM * 2);
    p.XN = (bf16*)take((size_t)NTOK * DM * 2);
    p.WIN_T = (bf16*)take((size_t)2 * DINP * DM * 2);
    p.WOUT_T = (bf16*)take((size_t)2 * DM * DM * 2);
    p.WQK_T = (bf16*)take((size_t)2 * NB * DM * DM * 2);
    p.VWO_T = (bf16*)take((size_t)2 * NB * DM * DM * 2);
    p.W1_T = (bf16*)take((size_t)4 * 256 * 2048 * 2);
    p.TE = (int*)take((size_t)NTOK * 2 * 4);
    p.TW = (float*)take((size_t)NTOK * 2 * 4);
    p.SLOT = (int*)take((size_t)NTOK * 2 * 4);
    p.LIST = (int*)take((size_t)36864 * 4);
    p.EOFF = (int*)take(4096);
    p.R0 = (float*)take((size_t)54200000 * 4);
    p.COLSB = (bf16*)(p.R0 + (size_t)31 * 1000 * 1000);
    if (o > ws_size) { fprintf(stderr, "workspace too small: need %zu have %zu\n", o, ws_size); return; }
    (void)hipMemsetAsync(p.BAR, 0, 16384, stream);
    void* args[] = {&p};
    hipError_t e = hipLaunchCooperativeKernel((const void*)mega, dim3(grid_blocks), dim3(NWAVES * 64), args, LDS_BYTES, stream);
    if (e != hipSuccess) fprintf(stderr, "cooperative launch failed: %s (grid %d)\n", hipGetErrorString(e), grid_blocks);
}
```

```cpp
#include <hip/hip_runtime.h>
#include <hip/hip_cooperative_groups.h>
#include <stdio.h>
#include <stdint.h>
#include <string.h>
#include <math.h>
namespace cg = cooperative_groups;

#define DEVI __device__ __forceinline__
#define GAS __attribute__((address_space(1)))
#define LAS __attribute__((address_space(3)))
typedef unsigned short bf16;
typedef unsigned v4u __attribute__((ext_vector_type(4)));
typedef GAS unsigned gu32;
typedef GAS unsigned long long gu64;
#define RLX_AGENT __ATOMIC_RELAXED, __HIP_MEMORY_SCOPE_AGENT
#define LDS_WAIT() asm volatile("s_waitcnt lgkmcnt(0)" ::: "memory")
#define VM_WAIT() asm volatile("s_waitcnt vmcnt(0)" ::: "memory")
DEVI unsigned f2bf(float f) { unsigned u = __builtin_bit_cast(unsigned, f); return (u + 0x7fffu + ((u >> 16) & 1u)) >> 16; }
DEVI unsigned pk2(float lo, float hi) { return f2bf(lo) | (f2bf(hi) << 16); }
DEVI float bf2f(unsigned short h) { return __builtin_bit_cast(float, (unsigned)h << 16); }

constexpr int NB = 2, SEQ = 8192, DM = 1024, NTOK = NB * SEQ, DIN = 2700, DINP = 2816, MEML = 256;
constexpr int OFF_CV = 0, OFF_CG = 256, OFF_RW = 512, OFF_GU = 1536, OFF_GV = 1792, OFF_Q = 2048, OFF_KC = 2304,
              OFF_VC = 2368, OFF_KS = 2432, OFF_VS = 2496, OFF_KW = 2560, OFF_VW = 2624, OFF_GT = 2688;
constexpr int NCMP = 511;
constexpr float ALPHA = 1.4142135623730951f;
constexpr int NWAVES = 8;
constexpr int RING_OFF = 0, RING_BYTES = 131072;
constexpr int LDSCTL_OFF = RING_BYTES, MISC_OFF = LDSCTL_OFF + 320;
constexpr int LDS_BYTES = 147456;

DEVI int tidx() { int t = threadIdx.x; asm volatile("" : "+v"(t)); return t; }
namespace pg8 {
#define PG8_LAS __attribute__((address_space(3)))
typedef unsigned short bf16_t;
typedef short bf16x8 __attribute__((ext_vector_type(8)));
typedef float f32x4 __attribute__((ext_vector_type(4)));
typedef unsigned u32x4 __attribute__((ext_vector_type(4)));
constexpr int BM = 256, BK = 64, HALF = 128, HTB = HALF * BK * 2  , STAGE_BYTES = 8 * HTB, NXCD = 8, WGM = 8;

__host__ __device__ __forceinline__ int lds_byte(int r, int c) { const int st = (r >> 4) * 2 + (c >> 5), rr = r & 15, cc = c & 31, ob = rr * 64 + cc * 2; return st * 1024 + (ob ^ (((ob >> 9) & 1) << 5)); }
__host__ __device__ __forceinline__ void stage_rc(int b, int& R, int& C) { const int st = b / 1024, sb = b % 1024, swz = sb ^ (((sb >> 9) & 1) << 5); R = (st >> 1) * 16 + swz / 64; C = (st & 1) * 32 + (swz % 64) / 2; }
__host__ __device__ __forceinline__ int perm32(int rho) { const int n = rho >> 4, i = rho & 15; return 8 * (i >> 2) + 4 * n + (i & 3); }

struct Unit { int pm, pn; };
struct Gemm { const bf16_t* A; const bf16_t* Bt; int M, N, K; int lda = 0, ldb = 0; };

struct StaticOrder {
    int nM, nN, nwg, G, c;
    __host__ __device__ void init(int M, int N, int G_, int c_) { nM = M / BM; nN = N / BM; nwg = nM * nN; G = G_; c = c_; }
    __host__ __device__ bool next(int i, Unit& u) const {
        const long L = (long)i * G + c; if (L >= nwg) return false;
        int wgid = (int)L; { const int q = nwg / NXCD, r = nwg % NXCD, xcd = wgid % NXCD, off = wgid / NXCD; wgid = (xcd < r ? xcd * (q + 1) : r * (q + 1) + (xcd - r) * q) + off; }
        const int nig = WGM * nN, gid = wgid / nig, fm = gid * WGM, gsz = (nM - fm) < WGM ? (nM - fm) : WGM;
        u.pm = fm + ((wgid % nig) % gsz); u.pn = (wgid % nig) / gsz; return true;
    }
    __device__ __forceinline__ void a_ready(const Unit&) const {}
    __device__ __forceinline__ void done(const Unit&) const {}
};

__device__ __forceinline__ unsigned cvt_pk_bf16(float lo, float hi) { unsigned r; asm volatile("v_cvt_pk_bf16_f32 %0, %1, %2" : "=v"(r) : "v"(lo), "v"(hi)); return r; }
typedef float f32x2 __attribute__((ext_vector_type(2)));
__device__ __forceinline__ f32x2 gelu_pk(f32x2 v) {
    const f32x2 av = __builtin_elementwise_abs(v), d = av * 0.2316418882f + 1.0f;
    f32x2 t; t.x = __builtin_amdgcn_rcpf(d.x); t.y = __builtin_amdgcn_rcpf(d.y);
    f32x2 q = t * 0.5307027145f + (-0.7265760135f); q = q * t + 0.7107068705f; q = q * t + (-0.142248368f); q = q * t + 0.127414796f; q = q * t;
    const f32x2 s = (v * v) * (-0.72134752044f);
    f32x2 e; e.x = __builtin_amdgcn_exp2f(s.x); e.y = __builtin_amdgcn_exp2f(s.y);
    const f32x2 m = v * (q * e), r = v - m;
    f32x2 o; o.x = v.x < 0.f ? m.x : r.x; o.y = v.y < 0.f ? m.y : r.y; return o;
}

template <int ACT  > struct EpiBf16 {
    static constexpr bool PERM = true, AFTER_DRAIN = false; static_assert(ACT == 0 || ACT == 1, "EpiBf16: ACT is 0 (none) or 1 (gelu_pk)");
    bf16_t* O; int ldc; const float* bias; int split_cols; size_t split_stride; float scale0;
    __device__ __forceinline__ void operator()(const f32x4 (&acc)[2][2][4][2], const Unit& u, int wr, int wc, int fr, int fq) const {
        const int row0 = u.pm * BM + wr * 64 + fr; int colt = u.pn * BM; bf16_t* base = O;
        float sc = 1.f; if (split_cols) { const int t = colt / split_cols; base += (size_t)t * split_stride; colt -= t * split_cols; if (t == 0) sc = scale0; }
        const int col0 = colt + wc * 32 + 8 * fq, bcol0 = u.pn * BM + wc * 32 + 8 * fq;
        f32x4 bv[2][2];
#pragma unroll
        for (int bj = 0; bj < 2; ++bj)
#pragma unroll
            for (int n = 0; n < 2; ++n) bv[bj][n] = bias ? *(const f32x4*)(bias + bcol0 + bj * HALF + 4 * n) : (f32x4){0.f, 0.f, 0.f, 0.f};
#pragma unroll
        for (int ai = 0; ai < 2; ++ai)
#pragma unroll
            for (int m = 0; m < 4; ++m) { bf16_t* rowp = base + (size_t)(row0 + ai * HALF + m * 16) * ldc + col0;
#pragma unroll
                for (int bj = 0; bj < 2; ++bj) { f32x4 v0 = acc[ai][bj][m][0] + bv[bj][0], v1 = acc[ai][bj][m][1] + bv[bj][1];
                    if (ACT == 1) { f32x2 a = gelu_pk((f32x2){v0[0], v0[1]}), b = gelu_pk((f32x2){v0[2], v0[3]}), c = gelu_pk((f32x2){v1[0], v1[1]}), d = gelu_pk((f32x2){v1[2], v1[3]});
                        v0 = (f32x4){a.x, a.y, b.x, b.y}; v1 = (f32x4){c.x, c.y, d.x, d.y}; }
                    v0 = v0 * sc; v1 = v1 * sc; u32x4 w; w.x = cvt_pk_bf16(v0[0], v0[1]); w.y = cvt_pk_bf16(v0[2], v0[3]); w.z = cvt_pk_bf16(v1[0], v1[1]); w.w = cvt_pk_bf16(v1[2], v1[3]);
                    *(u32x4*)(rowp + bj * HALF) = w; } }
    }
};

struct PanelStats {
    unsigned* xbuf;
    unsigned* cnt;
    unsigned* tmo;
    int ntn; float eps;
    unsigned code;
    __device__ __forceinline__ bool run(const f32x4 (&v)[2][2][4][2], const Unit& u, int wr, int wc, int fr, int fq, PG8_LAS unsigned char* lds, int wid, int lane) const {
        typedef float f32x2v __attribute__((ext_vector_type(2)));
        PG8_LAS f32x2v* P = (PG8_LAS f32x2v*)lds;
        PG8_LAS f32x2v* S = (PG8_LAS f32x2v*)(lds + 8192);
        PG8_LAS unsigned* flag = (PG8_LAS unsigned*)(lds + 8192 + 2048);
#pragma unroll
        for (int ai = 0; ai < 2; ++ai)
#pragma unroll
            for (int m = 0; m < 4; ++m) {
                float s = 0.f;
#pragma unroll
                for (int bj = 0; bj < 2; ++bj)
#pragma unroll
                    for (int n = 0; n < 2; ++n) { const f32x4 x = v[ai][bj][m][n]; s += (x[0] + x[1]) + (x[2] + x[3]); }
                s += __shfl_xor(s, 16); s += __shfl_xor(s, 32);
                const float mw = s * (1.0f / 64.0f); float q = 0.f;
#pragma unroll
                for (int bj = 0; bj < 2; ++bj)
#pragma unroll
                    for (int n = 0; n < 2; ++n) { const f32x4 d = v[ai][bj][m][n] - mw; q += (d[0] * d[0] + d[1] * d[1]) + (d[2] * d[2] + d[3] * d[3]); }
                q += __shfl_xor(q, 16); q += __shfl_xor(q, 32);
                if (fq == 0) P[(ai * HALF + wr * 64 + m * 16 + fr) * 4 + wc] = (f32x2v){mw, q};
            }
        asm volatile("s_waitcnt lgkmcnt(0)" ::: "memory"); __builtin_amdgcn_s_barrier(); asm volatile("" ::: "memory");
#if defined(BROKEN_EXCHANGE_NO_WAIT)
#warning BROKEN CONTROL BUILD: the row-statistics exchange does not wait; results are wrong by design
        if (blockIdx.x >= 64) { const long long t0_ = clock64(); while (clock64() - t0_ < 60000) __builtin_amdgcn_s_sleep(8); }
#endif
        const int row = wid * 32 + (lane & 31);
        if (lane < 32) {
            const f32x2v a = P[row * 4 + 0], b = P[row * 4 + 1], c = P[row * 4 + 2], d = P[row * 4 + 3];
            const float mt = (a.x + b.x + c.x + d.x) * 0.25f;
            const float da = a.x - mt, db = b.x - mt, dc = c.x - mt, dd = d.x - mt;
            const float m2 = (a.y + b.y) + (c.y + d.y) + 64.0f * ((da * da + db * db) + (dc * dc + dd * dd));
            unsigned long long* slot = (unsigned long long*)xbuf + ((size_t)(u.pm * BM + row) * 4 + u.pn);
            __hip_atomic_store(slot, ((unsigned long long)__float_as_uint(m2) << 32) | __float_as_uint(mt), __ATOMIC_RELAXED, __HIP_MEMORY_SCOPE_AGENT);
        }
        asm volatile("s_waitcnt vmcnt(0)" ::: "memory");
        if (lane == 0) __hip_atomic_fetch_add(cnt + 64 * u.pm, 1u, __ATOMIC_RELAXED, __HIP_MEMORY_SCOPE_AGENT);
        if (wid == 0) {
            bool dead = false; const unsigned long long t0 = __builtin_amdgcn_s_memrealtime(); const unsigned want = 8u * (unsigned)ntn;
            for (;;) {
#if defined(BROKEN_EXCHANGE_NO_WAIT)
                break;
#endif
                if ((unsigned)__builtin_amdgcn_readfirstlane(__hip_atomic_load(cnt + 64 * u.pm, __ATOMIC_RELAXED, __HIP_MEMORY_SCOPE_AGENT)) >= want) break;
                if (__builtin_amdgcn_s_memrealtime() - t0 > 2000000ull) {
                    if (lane == 0) { unsigned expect = 0u; __hip_atomic_compare_exchange_strong(tmo + 1, &expect, code | (unsigned)(u.pm & 0xff), __ATOMIC_RELAXED, __ATOMIC_RELAXED, __HIP_MEMORY_SCOPE_AGENT);
                                     __hip_atomic_store(tmo, 1u, __ATOMIC_RELAXED, __HIP_MEMORY_SCOPE_AGENT); }
                    dead = true; break; }
                __builtin_amdgcn_s_sleep(2);
            }
            __builtin_amdgcn_fence(__ATOMIC_ACQUIRE, "agent");
            if (lane == 0) flag[0] = dead ? 1u : 0u;
        }
        asm volatile("s_waitcnt vmcnt(0) lgkmcnt(0)" ::: "memory"); __builtin_amdgcn_s_barrier(); asm volatile("" ::: "memory");
        const bool bad = flag[0] != 0u;
        if (lane < 32) {
            const unsigned long long* slot = (const unsigned long long*)xbuf + (size_t)(u.pm * BM + row) * 4; float mt[4], m2[4]; float ms = 0.f;
#pragma unroll
            for (int t = 0; t < 4; ++t) { if (t < ntn) { const unsigned long long w = __hip_atomic_load(slot + t, __ATOMIC_RELAXED, __HIP_MEMORY_SCOPE_AGENT); mt[t] = __uint_as_float((unsigned)w); m2[t] = __uint_as_float((unsigned)(w >> 32)); } else { mt[t] = 0.f; m2[t] = 0.f; } ms += mt[t]; }
            const float mean = ms / (float)ntn; float q = 0.f;
#pragma unroll
            for (int t = 0; t < 4; ++t) if (t < ntn) { const float dm = mt[t] - mean; q += m2[t] + 256.0f * dm * dm; }
            S[row] = (f32x2v){mean, 1.0f / sqrtf(q / (256.0f * (float)ntn) + eps)};
        }
        asm volatile("s_waitcnt lgkmcnt(0)" ::: "memory"); __builtin_amdgcn_s_barrier(); asm volatile("" ::: "memory");
        return bad;
    }
};
struct EpiLnRes {
    static constexpr bool PERM = false, AFTER_DRAIN = true;
    const float* base; float* out; int ldc; const float* bias; PanelStats st; unsigned poison;
    __device__ __forceinline__ void fused(f32x4 (&acc)[2][2][4][2], const Unit& u, int wr, int wc, int fr, int fq, PG8_LAS unsigned char* lds, int wid, int lane) const {
        typedef float f32x2v __attribute__((ext_vector_type(2)));
        const PG8_LAS f32x2v* S = (const PG8_LAS f32x2v*)(lds + 8192);
        const int col0 = u.pn * BM + wc * 32 + 4 * fq;
#pragma unroll
        for (int bj = 0; bj < 2; ++bj)
#pragma unroll
            for (int n = 0; n < 2; ++n) { const f32x4 bv = bias ? *(const f32x4*)(bias + col0 + bj * HALF + n * 16) : (f32x4){0.f, 0.f, 0.f, 0.f};
#pragma unroll
                for (int ai = 0; ai < 2; ++ai)
#pragma unroll
                    for (int m = 0; m < 4; ++m) acc[ai][bj][m][n] += bv; }
        f32x4 pre[4][2][2];
#pragma unroll
        for (int m = 0; m < 4; ++m) { const size_t off = (size_t)(u.pm * BM + wr * 64 + m * 16 + fr) * ldc + col0;
#pragma unroll
            for (int bj = 0; bj < 2; ++bj)
#pragma unroll
                for (int n = 0; n < 2; ++n) pre[m][bj][n] = *(const f32x4*)(base + off + bj * HALF + n * 16); }
        const bool bad = st.run(acc, u, wr, wc, fr, fq, lds, wid, lane) || poison != 0u;
        const float qnan = __builtin_nanf("");
#pragma unroll
        for (int ai = 0; ai < 2; ++ai)
#pragma unroll
            for (int m = 0; m < 4; ++m) { const int r = ai * HALF + wr * 64 + m * 16 + fr; const f32x2v sr = S[r]; const size_t off = (size_t)(u.pm * BM + r) * ldc + col0;
#pragma unroll
                for (int bj = 0; bj < 2; ++bj)
#pragma unroll
                    for (int n = 0; n < 2; ++n) { const f32x4 bs = ai == 0 ? pre[m][bj][n] : *(const f32x4*)(base + off + bj * HALF + n * 16); f32x4 o = bs + (acc[ai][bj][m][n] - sr.x) * sr.y;
                        if (bad) o = (f32x4){qnan, qnan, qnan, qnan}; *(f32x4*)(out + off + bj * HALF + n * 16) = o; }
                if (m & 1) asm volatile("" ::: "memory"); }
    }
};
struct EpiLnResLn {
    static constexpr bool PERM = false, AFTER_DRAIN = true;
    const float* base; float* out; bf16_t* xn; int ldc; const float* bias; PanelStats st1, st2; unsigned poison;
    __device__ __forceinline__ void fused(f32x4 (&acc)[2][2][4][2], const Unit& u, int wr, int wc, int fr, int fq, PG8_LAS unsigned char* lds, int wid, int lane) const {
        typedef float f32x2v __attribute__((ext_vector_type(2))); typedef unsigned u32x2v __attribute__((ext_vector_type(2)));
        const PG8_LAS f32x2v* S = (const PG8_LAS f32x2v*)(lds + 8192);
        const int col0 = u.pn * BM + wc * 32 + 4 * fq;
#pragma unroll
        for (int bj = 0; bj < 2; ++bj)
#pragma unroll
            for (int n = 0; n < 2; ++n) { const f32x4 bv = bias ? *(const f32x4*)(bias + col0 + bj * HALF + n * 16) : (f32x4){0.f, 0.f, 0.f, 0.f};
#pragma unroll
                for (int ai = 0; ai < 2; ++ai)
#pragma unroll
                    for (int m = 0; m < 4; ++m) acc[ai][bj][m][n] += bv; }
        bool bad = st1.run(acc, u, wr, wc, fr, fq, lds, wid, lane) || poison != 0u;
        const float qnan = __builtin_nanf("");
#pragma unroll
        for (int ai = 0; ai < 2; ++ai)
#pragma unroll
            for (int m = 0; m < 4; ++m) { const int r = ai * HALF + wr * 64 + m * 16 + fr; const f32x2v sr = S[r]; const size_t off = (size_t)(u.pm * BM + r) * ldc + col0;
#pragma unroll
                for (int bj = 0; bj < 2; ++bj)
#pragma unroll
                    for (int n = 0; n < 2; ++n) { const f32x4 bs = *(const f32x4*)(base + off + bj * HALF + n * 16); acc[ai][bj][m][n] = bs + (acc[ai][bj][m][n] - sr.x) * sr.y; }
                asm volatile("" : "+v"(acc[ai][0][m][0]), "+v"(acc[ai][0][m][1]), "+v"(acc[ai][1][m][0]), "+v"(acc[ai][1][m][1]));
                if (m & 1) asm volatile("" ::: "memory"); }
        const bool bad1 = bad;
        bad = st2.run(acc, u, wr, wc, fr, fq, lds, wid, lane) || bad;
#pragma unroll
        for (int ai = 0; ai < 2; ++ai)
#pragma unroll
            for (int m = 0; m < 4; ++m) { const int r = ai * HALF + wr * 64 + m * 16 + fr; const f32x2v sr = S[r]; const size_t off = (size_t)(u.pm * BM + r) * ldc + col0;
#pragma unroll
                for (int bj = 0; bj < 2; ++bj)
#pragma unroll
                    for (int n = 0; n < 2; ++n) { const f32x4 x1 = acc[ai][bj][m][n]; *(f32x4*)(out + off + bj * HALF + n * 16) = bad1 ? (f32x4){qnan, qnan, qnan, qnan} : x1;
                        const f32x4 o = (x1 - sr.x) * sr.y; u32x2v w; w.x = cvt_pk_bf16(o[0], o[1]); w.y = cvt_pk_bf16(o[2], o[3]);
                        if (bad) { w.x = 0x7fc07fc0u; w.y = 0x7fc07fc0u; } *(u32x2v*)(xn + off + bj * HALF + n * 16) = w; }
                asm volatile("" ::: "memory"); }
    }
};

template <class Epi, class Sched, bool ALIGN_EPI = false, bool SP2 = false>
__device__ __forceinline__ void gemm_phase(PG8_LAS unsigned char* lds, const Gemm g, const Sched& S, const Epi& E) {
    const int tid = tidx(), wid = __builtin_amdgcn_readfirstlane(tid >> 6), lane = tid & 63, wr = wid >> 2, wc = wid & 3, fr = lane & 15, fq = lane >> 4;
    const int K = g.K, nt = K / BK;
    const int LDA = g.lda ? g.lda : K, LDB = g.ldb ? g.ldb : K;
    unsigned voffA[2], voffB[2];
#pragma unroll
    for (int i = 0; i < 2; ++i) { int R, C; stage_rc(tid * 16 + i * 8192, R, C); const int Rb = Epi::PERM ? ((R & ~31) + perm32(R & 31)) : R;
        voffA[i] = (unsigned)(R * LDA + C) * 2u; voffB[i] = (unsigned)(Rb * LDB + C) * 2u; }
    const size_t kstep = (size_t)(BK * 2);
    const size_t hstepA = (size_t)HALF * LDA * 2, hstepB = (size_t)HALF * LDB * 2;
    const size_t tstepA = 2 * hstepA, tstepB = 2 * hstepB;
    const unsigned ldsw = (unsigned)wid * 1024u;
    const int aoff = lds_byte(wr * 64 + fr, fq * 8), boff = lds_byte(wc * 32 + fr, fq * 8);
#define PG8_SA(b, h) (((b) * 2 + (h)) * HTB)
#define PG8_SB(b, h) ((4 + (b) * 2 + (h)) * HTB)
#define PG8_STAGE(bufoff, gbase, voff) do { _Pragma("unroll") for (int _i = 0; _i < 2; ++_i) \
        __builtin_amdgcn_global_load_lds((const unsigned*)((const char*)(gbase) + (voff)[_i]), (PG8_LAS unsigned*)(lds + (bufoff) + ldsw + _i * 8192), 16, 0, 0); } while (0)
#define PG8_LDA(dst, b, h) do { _Pragma("unroll") for (int m = 0; m < 4; ++m) _Pragma("unroll") for (int k = 0; k < 2; ++k) dst[m][k] = *(const PG8_LAS bf16x8*)(lds + PG8_SA(b, h) + aoff + m * 2048 + k * 1024); } while (0)
#define PG8_LDB(dst, b, h) do { _Pragma("unroll") for (int n = 0; n < 2; ++n) _Pragma("unroll") for (int k = 0; k < 2; ++k) dst[n][k] = *(const PG8_LAS bf16x8*)(lds + PG8_SB(b, h) + boff + n * 2048 + k * 1024); } while (0)
#define PG8_MMA(ai, bj, At, Bt) do { __builtin_amdgcn_s_setprio(1); _Pragma("unroll") for (int m = 0; m < 4; ++m) _Pragma("unroll") for (int n = 0; n < 2; ++n) _Pragma("unroll") for (int k = 0; k < 2; ++k) \
        acc[ai][bj][m][n] = __builtin_amdgcn_mfma_f32_16x16x32_bf16(Bt[n][k], At[m][k], acc[ai][bj][m][n], 0, 0, 0); __builtin_amdgcn_s_setprio(0); } while (0)
#define PG8_WAIT_V(n) asm volatile("s_waitcnt vmcnt(" #n ")" ::: "memory")
#define PG8_WAIT_L(n) asm volatile("s_waitcnt lgkmcnt(" #n ")" ::: "memory")
#define PG8_BAR __builtin_amdgcn_s_barrier()
#define PG8_SCHED __builtin_amdgcn_sched_barrier(0)
    Unit cur, nxt; int ui = 0;
    if (!S.next(0, cur)) return;
    f32x4 acc[2][2][4][2];
#pragma unroll
    for (int a = 0; a < 2; ++a)
#pragma unroll
        for (int b = 0; b < 2; ++b)
#pragma unroll
            for (int m = 0; m < 4; ++m)
#pragma unroll
                for (int n = 0; n < 2; ++n) acc[a][b][m][n] = (f32x4){0.f, 0.f, 0.f, 0.f};
    bf16x8 At[4][2], B0[2][2], B1[2][2];
    const char* cA = (const char*)g.A + (size_t)cur.pm * tstepA; const char* cB = (const char*)g.Bt + (size_t)cur.pn * tstepB;
    S.a_ready(cur);
    if constexpr (SP2) {
        PG8_STAGE(PG8_SB(0, 0), cB, voffB); PG8_STAGE(PG8_SB(0, 1), cB + hstepB, voffB); PG8_STAGE(PG8_SA(0, 0), cA, voffA); PG8_STAGE(PG8_SA(0, 1), cA + hstepA, voffA);
        if (wr == 1) PG8_BAR;
        PG8_WAIT_V(2); PG8_BAR;
        PG8_STAGE(PG8_SB(1, 0), cB + kstep, voffB); PG8_STAGE(PG8_SA(1, 0), cA + kstep, voffA); PG8_STAGE(PG8_SB(1, 1), cB + hstepB + kstep, voffB);
        PG8_WAIT_V(6); PG8_BAR;
    } else {
        PG8_STAGE(PG8_SB(0, 0), cB, voffB); PG8_STAGE(PG8_SA(0, 0), cA, voffA); PG8_STAGE(PG8_SB(0, 1), cB + hstepB, voffB); PG8_STAGE(PG8_SA(0, 1), cA + hstepA, voffA);
        if (wr == 1) PG8_BAR;
        PG8_WAIT_V(4); PG8_BAR;
        PG8_STAGE(PG8_SB(1, 0), cB + kstep, voffB); PG8_STAGE(PG8_SA(1, 0), cA + kstep, voffA); PG8_STAGE(PG8_SB(1, 1), cB + hstepB + kstep, voffB);
        PG8_WAIT_V(6); PG8_BAR;
    }
    for (;;) {
        const bool has_next = S.next(ui + 1, nxt);
        const char* nA = has_next ? (const char*)g.A + (size_t)nxt.pm * tstepA : cA; const char* nB = has_next ? (const char*)g.Bt + (size_t)nxt.pn * tstepB : cB;
        for (int t = 0; t < nt; t += 2) {
            const bool last = (t == nt - 2);
            const char* a1 = cA + (size_t)(t + 1) * kstep;
            const char* a2 = last ? nA : cA + (size_t)(t + 2) * kstep; const char* b2 = last ? nB : cB + (size_t)(t + 2) * kstep;
            const char* a3 = a2 + kstep; const char* b3 = b2 + kstep;
            if (last && has_next) S.a_ready(nxt);
            if constexpr (SP2) {
            PG8_LDB(B0, 0, 0); PG8_LDB(B1, 0, 1); PG8_SCHED; PG8_LDA(At, 0, 0); PG8_STAGE(PG8_SA(1, 1), a1 + hstepA, voffA);
            PG8_WAIT_V(8); PG8_WAIT_L(0); PG8_BAR; PG8_MMA(0, 0, At, B0); PG8_MMA(0, 1, At, B1); PG8_BAR; PG8_SCHED;
            PG8_LDA(At, 0, 1); PG8_STAGE(PG8_SB(0, 0), b2, voffB); PG8_STAGE(PG8_SB(0, 1), b2 + hstepB, voffB); PG8_STAGE(PG8_SA(0, 0), a2, voffA);
            PG8_WAIT_V(8); PG8_WAIT_L(0); PG8_BAR; PG8_MMA(1, 0, At, B0); PG8_MMA(1, 1, At, B1); PG8_BAR; PG8_SCHED;
            PG8_LDB(B0, 1, 0); PG8_LDB(B1, 1, 1); PG8_SCHED; PG8_LDA(At, 1, 0); PG8_STAGE(PG8_SA(0, 1), a2 + hstepA, voffA);
            PG8_WAIT_V(8); PG8_WAIT_L(0); PG8_BAR; PG8_MMA(0, 0, At, B0); PG8_MMA(0, 1, At, B1); PG8_BAR; PG8_SCHED;
            PG8_LDA(At, 1, 1); PG8_STAGE(PG8_SB(1, 0), b3, voffB); PG8_STAGE(PG8_SB(1, 1), b3 + hstepB, voffB); PG8_STAGE(PG8_SA(1, 0), a3, voffA);
            PG8_WAIT_V(8); PG8_WAIT_L(0); PG8_BAR; PG8_MMA(1, 0, At, B0); PG8_MMA(1, 1, At, B1); PG8_BAR; PG8_SCHED;
            } else {
            PG8_LDB(B0, 0, 0); PG8_SCHED; PG8_LDA(At, 0, 0); PG8_STAGE(PG8_SA(1, 1), a1 + hstepA, voffA);
            PG8_WAIT_L(8); PG8_BAR; PG8_WAIT_L(0); PG8_MMA(0, 0, At, B0); PG8_BAR; PG8_SCHED;
            PG8_LDB(B1, 0, 1); PG8_STAGE(PG8_SB(0, 0), b2, voffB);
            PG8_BAR; PG8_WAIT_L(0); PG8_MMA(0, 1, At, B1); PG8_BAR;
            PG8_LDA(At, 0, 1); PG8_STAGE(PG8_SA(0, 0), a2, voffA);
            PG8_BAR; PG8_WAIT_L(0); PG8_MMA(1, 0, At, B0); PG8_BAR; PG8_SCHED;
            PG8_STAGE(PG8_SB(0, 1), b2 + hstepB, voffB);
            PG8_WAIT_V(6); PG8_BAR; PG8_MMA(1, 1, At, B1); PG8_BAR;
            PG8_LDB(B0, 1, 0); PG8_SCHED; PG8_LDA(At, 1, 0); PG8_STAGE(PG8_SA(0, 1), a2 + hstepA, voffA);
            PG8_WAIT_L(8); PG8_BAR; PG8_WAIT_L(0); PG8_MMA(0, 0, At, B0); PG8_BAR; PG8_SCHED;
            PG8_LDB(B1, 1, 1); PG8_STAGE(PG8_SB(1, 0), b3, voffB);
            PG8_BAR; PG8_WAIT_L(0); PG8_MMA(0, 1, At, B1); PG8_BAR;
            PG8_LDA(At, 1, 1); PG8_STAGE(PG8_SA(1, 0), a3, voffA);
            PG8_BAR; PG8_WAIT_L(0); PG8_MMA(1, 0, At, B0); PG8_BAR; PG8_SCHED;
            PG8_STAGE(PG8_SB(1, 1), b3 + hstepB, voffB);
            PG8_WAIT_V(6); PG8_BAR; PG8_MMA(1, 1, At, B1); PG8_BAR;
            }
        }
        if constexpr (ALIGN_EPI) { if (wr == 0) PG8_BAR; }
        if constexpr (!Epi::AFTER_DRAIN) { E(acc, cur, wr, wc, fr, fq); S.done(cur); }
        if (!has_next) break;
#pragma unroll
        for (int a = 0; a < 2; ++a)
#pragma unroll
            for (int b = 0; b < 2; ++b)
#pragma unroll
                for (int m = 0; m < 4; ++m)
#pragma unroll
                    for (int n = 0; n < 2; ++n) acc[a][b][m][n] = (f32x4){0.f, 0.f, 0.f, 0.f};
        cur = nxt; cA = nA; cB = nB; ++ui;
        if constexpr (ALIGN_EPI) { if (wr == 1) PG8_BAR; }
    }
    PG8_WAIT_V(0);
    if constexpr (!ALIGN_EPI) { if (wr == 0) PG8_BAR; }
    PG8_BAR;
    if constexpr (Epi::AFTER_DRAIN) { E.fused(acc, cur, wr, wc, fr, fq, lds, wid, lane); S.done(cur); }
#undef PG8_SA
#undef PG8_SB
#undef PG8_STAGE
#undef PG8_LDA
#undef PG8_LDB
#undef PG8_MMA
#undef PG8_WAIT_V
#undef PG8_WAIT_L
#undef PG8_BAR
#undef PG8_SCHED
}
}
namespace pg8 {
struct EpiF32 {
    static constexpr bool PERM = false, AFTER_DRAIN = false;
    float* C; int ldc; const float* bias;
    __device__ __forceinline__ void operator()(const f32x4 (&acc)[2][2][4][2], const Unit& u, int wr, int wc, int fr, int fq) const {
        const int row0 = u.pm * BM + wr * 64 + fr, col0 = u.pn * BM + wc * 32 + 4 * fq;
        f32x4 bv[2][2];
#pragma unroll
        for (int bj = 0; bj < 2; ++bj)
#pragma unroll
            for (int n = 0; n < 2; ++n) bv[bj][n] = bias ? *(const f32x4*)(bias + col0 + bj * HALF + n * 16) : (f32x4){0.f, 0.f, 0.f, 0.f};
#pragma unroll
        for (int ai = 0; ai < 2; ++ai)
#pragma unroll
            for (int m = 0; m < 4; ++m) { float* rowp = C + (size_t)(row0 + ai * HALF + m * 16) * ldc + col0;
#pragma unroll
                for (int bj = 0; bj < 2; ++bj)
#pragma unroll
                    for (int n = 0; n < 2; ++n) *(f32x4*)(rowp + bj * HALF + n * 16) = acc[ai][bj][m][n] + bv[bj][n]; }
    }
};
}
#define XB_TMO      128
#define XB_XCNT(j)  (256  + 64 * (j))
#define XB_XSUB(j)  (1280 + 64 * (j))
#define XB_XGEN(j)  (2304 + 64 * (j))
#define XB_TOP      3328
#define XB_TOPGEN   3392
#define XCD_BAR_WORDS 3456
#define XB_SPIN_CAP (1u << 18)

__device__ __forceinline__ unsigned xb_ld(unsigned* p)              { return __hip_atomic_load(p, __ATOMIC_RELAXED, __HIP_MEMORY_SCOPE_AGENT); }
__device__ __forceinline__ unsigned xb_add(unsigned* p, unsigned v) { return __hip_atomic_fetch_add(p, v, __ATOMIC_RELAXED, __HIP_MEMORY_SCOPE_AGENT); }
__device__ __forceinline__ unsigned xb_xcc_id() { return (unsigned)__builtin_amdgcn_s_getreg((3 << 11) | 20) & 0xFu; }
#define XB_SPIN(cond, bar) do { unsigned _sp = 0; while (cond) { __builtin_amdgcn_s_sleep(1); \
    if ((++_sp & 255u) == 0u) { if (xb_ld(&(bar)[XB_TMO])) break; if (_sp > XB_SPIN_CAP) { atomicAdd(&(bar)[XB_TMO], 1u); break; } } } } while (0)

struct XcdBarrier {
    unsigned* bar; unsigned x;
    volatile LAS unsigned* st;
};

__device__ __forceinline__ XcdBarrier xcd_barrier_post(unsigned* bar, volatile LAS unsigned* st) {
    XcdBarrier b; b.bar = bar; b.x = xb_xcc_id(); b.st = st;
    if (threadIdx.x == 0) (void)xb_add(&bar[XB_XCNT(b.x)], 1u);
    return b;
}
__device__ __forceinline__ void xcd_barrier_complete(unsigned* bar, unsigned x, unsigned& nloc, unsigned& nx) {
    const unsigned G = gridDim.x * gridDim.y * gridDim.z;
    unsigned sum, cnt, mine, sp = 0u;
    for (;;) {
        sum = 0u; cnt = 0u; mine = 0u;
#pragma unroll
        for (unsigned j = 0; j < 16; ++j) { const unsigned c = xb_ld(&bar[XB_XCNT(j)]); sum += c; cnt += (c > 0u) ? 1u : 0u; mine = (j == x) ? c : mine; }
        if (sum == G) break;
        __builtin_amdgcn_s_sleep(1);
        if ((++sp & 255u) == 0u) { if (xb_ld(&bar[XB_TMO])) break; if (sp > XB_SPIN_CAP) { atomicAdd(&bar[XB_TMO], 1u); break; } }
    }
    nloc = mine > 0u ? mine : 1u; nx = cnt > 0u ? cnt : 1u;
}

__device__ __forceinline__ void xcd_barrier(const XcdBarrier& b) {
    asm volatile("s_waitcnt vmcnt(0)" ::: "memory");
    __syncthreads();
    if (threadIdx.x == 0) {
        unsigned* bar = b.bar;
        __builtin_amdgcn_s_waitcnt(0);
        unsigned nloc = b.st[0], nx = b.st[1];
        if (nloc == 0u) { xcd_barrier_complete(bar, b.x, nloc, nx); b.st[0] = nloc; b.st[1] = nx; }
        const unsigned old = xb_add(&bar[XB_XSUB(b.x)], 1u);
        const unsigned gen = old / nloc;
        if (old + 1u == (gen + 1u) * nloc) {
            __builtin_amdgcn_fence(__ATOMIC_RELEASE, "agent");
            asm volatile("s_waitcnt vmcnt(0)" ::: "memory");
            const unsigned og = xb_add(&bar[XB_TOP], 1u);
            const unsigned tg = og / nx;
            if (og + 1u == (tg + 1u) * nx) xb_add(&bar[XB_TOPGEN], 1u);
            else XB_SPIN(xb_ld(&bar[XB_TOPGEN]) == tg, bar);
            __builtin_amdgcn_fence(__ATOMIC_ACQUIRE, "agent");
            xb_add(&bar[XB_XGEN(b.x)], 1u);
            asm volatile("s_waitcnt vmcnt(0)" ::: "memory");
        } else {
            XB_SPIN(xb_ld(&bar[XB_XGEN(b.x)]) == gen, bar);
            __builtin_amdgcn_fence(__ATOMIC_ACQUIRE, "agent");
            asm volatile("s_waitcnt vmcnt(0)" ::: "memory");
        }
    }
    __syncthreads();
}

DEVI float wave_sum(float v) {
#pragma unroll
    for (int o = 32; o > 0; o >>= 1) v += __shfl_xor(v, o, 64);
    return v;
}
DEVI float wave_max(float v) {
#pragma unroll
    for (int o = 32; o > 0; o >>= 1) v = fmaxf(v, __shfl_xor(v, o, 64));
    return v;
}
DEVI float sigm(float x) { return 1.f / (1.f + expf(-x)); }
DEVI float gelu_t(float x) { return 0.5f * x * (1.f + tanhf(0.7978845608028654f * (x + 0.044715f * x * x * x))); }
DEVI float softplus_(float x) { return fmaxf(x, 0.f) + log1pf(expf(-fabsf(x))); }

DEVI float block_sum256(float v, float* red, int tid) {
    v = wave_sum(v);
    __syncthreads();
    if ((tid & 63) == 0) red[tid >> 6] = v;
    __syncthreads();
    return red[0] + red[1] + red[2] + red[3];
}

DEVI void ln_kernel(const float* xres, float alpha, const float* add, const float* __restrict__ g, const float* __restrict__ bt,
                    float* out, bf16* outb, int bid, float* sm) {
    __syncthreads();
    const size_t row = bid;
    const int tid = tidx() & 255;
    float v[4];
#pragma unroll
    for (int i = 0; i < 4; ++i) {
        const size_t idx = row * DM + tid + i * 256;
        v[i] = alpha * xres[idx] + (add ? add[idx] : 0.f);
    }
    const float mean = block_sum256(v[0] + v[1] + v[2] + v[3], sm, tid) * (1.f / DM);
    float q = 0.f;
#pragma unroll
    for (int i = 0; i < 4; ++i) { v[i] -= mean; q += v[i] * v[i]; }
    const float var = block_sum256(q, sm, tid) * (1.f / DM);
    const float rstd = rsqrtf(var + 1e-5f);
#pragma unroll
    for (int i = 0; i < 4; ++i) {
        const int c = tid + i * 256;
        const float o = v[i] * rstd * g[c] + bt[c];
        out[row * DM + c] = o;
        outb[row * DM + c] = (bf16)f2bf(o);
    }
}

struct GemmArgs {
    const float* A; const float* B; float* C; const int* rowidx; const int* zoff;
    long lda, sbk, sbn, ldc, sAz0, sAz1, sBz0, sBz1, sCz0, sCz1;
    int M, N, K, Z1, epi, pad;
};
DEVI void gemm_f32(const GemmArgs& g, int bx, int by, int z, bool live, float* sm) {
    float (*As)[68] = (float (*)[68])sm;
    float (*Bs)[68] = (float (*)[68])(sm + 16 * 68);
    const int z0 = z / g.Z1, z1 = z % g.Z1;
    int mbeg = 0, mend = g.M;
    if (g.zoff) { mbeg = g.zoff[z]; mend = g.zoff[z + 1]; }
    const int m0 = mbeg + by * 64;
    if (!live) mend = 0;
    const int n0 = bx * 64;
    const float* A = g.A + z0 * g.sAz0 + z1 * g.sAz1;
    const float* B = g.B + z0 * g.sBz0 + z1 * g.sBz1;
    float* C = g.C + z0 * g.sCz0 + z1 * g.sCz1;
    const int tid = tidx() & 255, tx = tid & 15, ty = tid >> 4;
    float acc[4][4];
#pragma unroll
    for (int i = 0; i < 4; ++i)
#pragma unroll
        for (int j = 0; j < 4; ++j) acc[i][j] = 0.f;
    long arow[4];
#pragma unroll
    for (int i = 0; i < 4; ++i) {
        const int r = (tid + i * 256) >> 4;
        const int row = m0 + r;
        if (row < mend) arow[i] = (long)(g.rowidx ? g.rowidx[row] : row) * g.lda; else arow[i] = -1;
    }
    __syncthreads();
    for (int k0 = 0; k0 < g.K; k0 += 16) {
#pragma unroll
        for (int i = 0; i < 4; ++i) {
            const int e = tid + i * 256, r = e >> 4, kk = e & 15;
            float v = 0.f;
            if (arow[i] >= 0 && k0 + kk < g.K) v = A[arow[i] + k0 + kk];
            As[kk][r] = v;
        }
#pragma unroll
        for (int i = 0; i < 4; ++i) {
            const int e = tid + i * 256, kk = e >> 6, n = e & 63;
            float v = 0.f;
            if (m0 < mend && n0 + n < g.N && k0 + kk < g.K) v = B[(long)(k0 + kk) * g.sbk + (long)(n0 + n) * g.sbn];
            Bs[kk][n] = v;
        }
        __syncthreads();
#pragma unroll
        for (int kk = 0; kk < 16; ++kk) {
            float a[4], b[4];
#pragma unroll
            for (int i = 0; i < 4; ++i) a[i] = As[kk][ty * 4 + i];
#pragma unroll
            for (int j = 0; j < 4; ++j) b[j] = Bs[kk][tx * 4 + j];
#pragma unroll
            for (int i = 0; i < 4; ++i)
#pragma unroll
                for (int j = 0; j < 4; ++j) acc[i][j] = fmaf(a[i], b[j], acc[i][j]);
        }
        __syncthreads();
    }
#pragma unroll
    for (int i = 0; i < 4; ++i) {
        const int row = m0 + ty * 4 + i;
        if (row >= mend) continue;
#pragma unroll
        for (int j = 0; j < 4; ++j) {
            const int col = n0 + tx * 4 + j;
            if (col >= g.N) continue;
            float* p = C + (long)row * g.ldc + col;
            float v = acc[i][j];
            if (g.epi == 2) { ((bf16*)C)[(long)row * g.ldc + col] = (bf16)f2bf(v); continue; }
            if (g.epi == 3) { ((bf16*)C)[(long)(row >> 9) * 64 * 512 + (long)col * 512 + (row & 511)] = (bf16)f2bf(v); continue; }
            if (g.epi == 1) { v = v * sigm(v) * (*p); }
            *p = v;
        }
    }
}
DEVI GemmArgs mk(const float* A, long lda, const float* B, long sbk, long sbn, float* C, long ldc, int M, int N, int K,
                 int Z1 = 1, long sAz0 = 0, long sAz1 = 0, long sBz0 = 0, long sBz1 = 0, long sCz0 = 0, long sCz1 = 0,
                 const int* rowidx = nullptr, const int* zoff = nullptr, int epi = 0) {
    GemmArgs g;
    g.A = A; g.B = B; g.C = C; g.rowidx = rowidx; g.zoff = zoff;
    g.lda = lda; g.sbk = sbk; g.sbn = sbn; g.ldc = ldc;
    g.sAz0 = sAz0; g.sAz1 = sAz1; g.sBz0 = sBz0; g.sBz1 = sBz1; g.sCz0 = sCz0; g.sCz1 = sCz1;
    g.M = M; g.N = N; g.K = K; g.Z1 = Z1; g.epi = epi; g.pad = 0;
    return g;
}
DEVI int gemm_tiles(const GemmArgs& g, int maxM, int Z) { return ((g.N + 63) / 64) * ((maxM + 63) / 64) * Z; }
DEVI bool gemm_tile_live(const GemmArgs& g, int maxM, int t) {
    const int nbx = (g.N + 63) / 64, nby = (maxM + 63) / 64;
    const int r = t / nbx, by = r % nby, z = r / nby;
    int mbeg = 0, mend = g.M;
    if (g.zoff) { mbeg = g.zoff[z]; mend = g.zoff[z + 1]; }
    return mbeg + by * 64 < mend;
}
DEVI void gemm_tile(const GemmArgs& g, int maxM, int t, bool live, float* sm) {
    const int nbx = (g.N + 63) / 64, nby = (maxM + 63) / 64;
    const int bx = t % nbx, r = t / nbx;
    gemm_f32(g, bx, r % nby, r / nby, live, sm);
}

DEVI void glu_kernel(const bf16* __restrict__ cols, float* __restrict__ h, int bid) {
    const size_t t = bid; const int c = tidx() & 255;
    h[t * 256 + c] = bf2f(cols[t * DINP + OFF_CV + c]) * sigm(bf2f(cols[t * DINP + OFF_CG + c]));
}
DEVI void conv_kernel(const float* __restrict__ h, const float* __restrict__ w, const float* __restrict__ bias,
                      const float* __restrict__ gg, const float* __restrict__ gb, bf16* __restrict__ mix, int bid) {
    const int t = bid, c = tidx() & 255;
    float acc = bias[c];
#pragma unroll 4
    for (int j = 0; j < 31; ++j) {
        const int tt = t - 30 + j;
        if (tt >= 0) acc = fmaf(h[(size_t)tt * 256 + c], w[j * 256 + c], acc);
    }
    const float mean = wave_sum(acc) * (1.f / 64.f);
    const float d = acc - mean;
    const float var = wave_sum(d * d) * (1.f / 64.f);
    const float y = d * rsqrtf(var + 1e-5f) * gg[c] + gb[c];
    mix[(size_t)t * DM + 0 + c] = (bf16)f2bf(y * sigm(y));
}

DEVI void gmlp_pre(const bf16* __restrict__ cols, const float* __restrict__ lg, const float* __restrict__ lb,
                   float* __restrict__ ub, float* __restrict__ vb, int bid, float* sm) {
    __syncthreads();
    const size_t t = bid; const int c = tidx() & 255;
    ub[t * 256 + c] = gelu_t(bf2f(cols[t * DINP + OFF_GU + c]));
    const float v = gelu_t(bf2f(cols[t * DINP + OFF_GV + c]));
    const float mean = block_sum256(v, sm, c) * (1.f / 256.f);
    const float d = v - mean;
    const float var = block_sum256(d * d, sm, c) * (1.f / 256.f);
    vb[t * 256 + c] = d * rsqrtf(var + 1e-5f) * lg[c] + lb[c];
}
DEVI void gmlp_mix(const float* __restrict__ ub, const float* __restrict__ vb, const float* __restrict__ ws,
                   const float* __restrict__ bs, bf16* __restrict__ mix, int bid) {
    const int t = bid, c = tidx() & 255, h = c >> 6, tt = t & 127, base = t - tt;
    float acc = bs[h * 128 + tt];
    const float* wr = ws + ((size_t)h * 128 + tt) * 128;
#pragma unroll 4
    for (int s = 0; s <= tt; ++s) acc = fmaf(wr[s], vb[(size_t)(base + s) * 256 + c], acc);
    mix[(size_t)t * DM + 512 + c] = (bf16)f2bf(ub[(size_t)t * 256 + c] * acc);
}

struct RwkvP {
    const bf16* cols; const float* mu; const float* w0; const float* w_up; const float* a0; const float* a_up; const float* g_up;
    const float* k_k; const float* k_a; const float* r_k; const float* vd; const float* v_mu; const float* v0; const float* v_up;
    float* vfirst; bf16* R; float* LW; bf16* K; bf16* V; bf16* A; bf16* Bv; float* G; float* BON;
    int layer, pad;
};
DEVI void rwkv_prep(const RwkvP& p, int bid, float* sm) {
    __syncthreads();
    float* y = sm;
    float* vds = sm + 1024;
    const int t = bid, c = tidx() & 255;
#pragma unroll
    for (int q = 0; q < 4; ++q) {
        const int j = c + q * 256;
        const float cur = bf2f(p.cols[(size_t)t * DINP + OFF_RW + j]);
        const float prv = t > 0 ? bf2f(p.cols[(size_t)(t - 1) * DINP + OFF_RW + j]) : 0.f;
        y[j] = cur + p.mu[j] * (prv - cur);
    }
    if (p.layer > 0 && c < 32) {
        const float cur = bf2f(p.cols[(size_t)t * DINP + DIN + c]);
        const float prv = t > 0 ? bf2f(p.cols[(size_t)(t - 1) * DINP + DIN + c]) : 0.f;
        vds[c] = cur + p.v_mu[c] * (prv - cur);
    }
    __syncthreads();
    float tw = 0.f, sg = 0.f;
    if (c < 64) tw = tanhf(y[768 + c]);
    if (c >= 128) sg = sigm(y[896 + (c - 128)]);
    __syncthreads();
    if (c < 64) y[768 + c] = tw;
    if (c >= 128) y[896 + (c - 128)] = sg;
    __syncthreads();
    const float r = y[c], k = y[256 + c];
    float v = y[512 + c];
    float wl = p.w0[c], al = p.a0[c], gl = 0.f;
#pragma unroll 4
    for (int j = 0; j < 64; ++j) { wl = fmaf(y[768 + j], p.w_up[j * 256 + c], wl); al = fmaf(y[832 + j], p.a_up[j * 256 + c], al); }
#pragma unroll 4
    for (int j = 0; j < 128; ++j) gl = fmaf(y[896 + j], p.g_up[j * 256 + c], gl);
    const float wlog = -softplus_(-wl) - 0.5f;
    const float a = sigm(al);
    if (p.layer == 0) {
        p.vfirst[(size_t)t * 256 + c] = v;
    } else {
        float vm = p.v0[c];
#pragma unroll 4
        for (int j = 0; j < 32; ++j) vm = fmaf(vds[j], p.v_up[j * 256 + c], vm);
        vm = sigm(vm);
        v = v + (p.vfirst[(size_t)t * 256 + c] - v) * vm;
    }
    float kk = k * p.k_k[c];
    const float nrm = sqrtf(wave_sum(kk * kk));
    kk = kk / fmaxf(nrm, 1e-12f);
    const float k2 = k * (1.f + (a - 1.f) * p.k_a[c]);
    const float bd = wave_sum(r * k2 * p.r_k[c]);
    const size_t o = (size_t)t * 256 + c;
    p.R[o] = (bf16)f2bf(r); p.LW[o] = -expf(wlog); p.K[o] = (bf16)f2bf(k2); p.V[o] = (bf16)f2bf(v); p.A[o] = (bf16)f2bf(-kk); p.Bv[o] = (bf16)f2bf(kk * a); p.G[o] = gl; p.BON[o] = bd * v;
}
DEVI void rwkv_scan(float* R, const float* __restrict__ W, const float* __restrict__ K, const float* __restrict__ V,
                    const float* __restrict__ A, const float* __restrict__ Bv, float* sm0) {
    float (*sr)[256] = (float (*)[256])sm0, (*sw)[256] = sr + 4, (*sk)[256] = sr + 8, (*sa)[256] = sr + 12, (*sb)[256] = sr + 16, (*sv)[256] = sr + 20;
    const int vt = tidx(); const bool act = vt < 256;
    const int tid = vt & 255, h = tid >> 6, lane = tid & 63;
    float st[64];
#pragma unroll
    for (int i = 0; i < 64; ++i) st[i] = 0.f;
    for (int t0 = 0; t0 < SEQ; t0 += 4) {
        __syncthreads();
        if (act) {
#pragma unroll
            for (int s = 0; s < 4; ++s) {
                const size_t idx = (size_t)(t0 + s) * 256 + tid;
                sr[s][tid] = R[idx]; sw[s][tid] = W[idx]; sk[s][tid] = K[idx]; sa[s][tid] = A[idx]; sb[s][tid] = Bv[idx]; sv[s][tid] = V[idx];
            }
        }
        __syncthreads();
        if (act) {
#pragma unroll 1
            for (int s = 0; s < 4; ++s) {
                const float vt_ = sv[s][tid];
                const float* pa = &sa[s][h * 64]; const float* pw = &sw[s][h * 64]; const float* pb = &sb[s][h * 64];
                const float* pk = &sk[s][h * 64]; const float* pr = &sr[s][h * 64];
                float sa_ = 0.f;
#pragma unroll
                for (int k = 0; k < 64; ++k) sa_ = fmaf(st[k], pa[k], sa_);
#pragma unroll
                for (int k = 0; k < 64; ++k) st[k] = fmaf(st[k], pw[k], fmaf(sa_, pb[k], vt_ * pk[k]));
                float o = 0.f;
#pragma unroll
                for (int k = 0; k < 64; ++k) o = fmaf(st[k], pr[k], o);
                R[(size_t)(t0 + s) * 256 + h * 64 + lane] = o;
            }
        }
    }
    __syncthreads();
}
DEVI void rwkv_post(const float* __restrict__ O, const float* __restrict__ BON, const float* __restrict__ G,
                    const float* __restrict__ gg, const float* __restrict__ gb, bf16* __restrict__ mix, int bid) {
    const size_t t = bid; const int c = tidx() & 255;
    const float o = O[t * 256 + c];
    const float mean = wave_sum(o) * (1.f / 64.f);
    const float d = o - mean;
    const float var = wave_sum(d * d) * (1.f / 64.f);
    const float y = d * rsqrtf(var + 64e-5f) * gg[c] + gb[c];
    mix[t * DM + 256 + c] = (bf16)f2bf((y + BON[t * 256 + c]) * G[t * 256 + c]);
}

DEVI void nsa_prep(const bf16* __restrict__ cols, float* __restrict__ qrot, float* __restrict__ ksr,
                   float* __restrict__ kwr, float* __restrict__ gates, int bid) {
    const int t = bid, c = tidx() & 255;
    const int d = c & 63, j = d & 31;
    const float inv = powf(10000.f, -(float)j / 32.f);
    const float ang = (float)t * inv;
    float sn, cs; sincosf(ang, &sn, &cs);
    {
        const bf16* q = cols + (size_t)t * DINP + OFF_Q + (c & ~63);
        const float x1 = bf2f(q[j]), x2 = bf2f(q[j + 32]);
        qrot[(size_t)t * 256 + c] = d < 32 ? x1 * cs - x2 * sn : x2 * cs + x1 * sn;
    }
    if (c < 128) {
        const bf16* kp = cols + (size_t)t * DINP + (c < 64 ? OFF_KS : OFF_KW);
        const float x1 = bf2f(kp[j]), x2 = bf2f(kp[j + 32]);
        const float v = d < 32 ? x1 * cs - x2 * sn : x2 * cs + x1 * sn;
        if (c < 64) ksr[(size_t)t * 64 + d] = v; else kwr[(size_t)t * 64 + d] = v;
    }
    if (c < 12) gates[(size_t)t * 12 + c] = sigm(bf2f(cols[(size_t)t * DINP + OFF_GT + c]));
}
DEVI void cmp_gather(const bf16* __restrict__ cols, const float* __restrict__ pek, const float* __restrict__ pev,
                     bf16* __restrict__ bk, bf16* __restrict__ bv, int bid) {
    const int n = bid, tid = tidx() & 255;
    for (int i = tid; i < 2048; i += 256) {
        const int l = i >> 6, d = i & 63;
        const size_t row = (size_t)(16 * n + l) * DINP;
        bk[(size_t)n * 2048 + i] = n < NCMP ? (bf16)f2bf(bf2f(cols[row + OFF_KC + d]) + pek[i]) : (bf16)0;
        bv[(size_t)n * 2048 + i] = n < NCMP ? (bf16)f2bf(bf2f(cols[row + OFF_VC + d]) + pev[i]) : (bf16)0;
    }
}
DEVI void gelu_inplace(float* p, int n, int bid) {
    const int i = bid * 256 + (tidx() & 255);
    if (i < n) p[i] = gelu_t(p[i]);
}

DEVI void wave_softmax(float* s, int n, int lane) {
    float m = -INFINITY;
    for (int i = lane; i < n; i += 64) m = fmaxf(m, s[i]);
    m = wave_max(m);
    if (m == -INFINITY) { for (int i = lane; i < n; i += 64) s[i] = 0.f; return; }
    float sum = 0.f;
    for (int i = lane; i < n; i += 64) { const float p = expf(s[i] - m); s[i] = p; sum += p; }
    sum = wave_sum(sum);
    const float inv = 1.f / fmaxf(sum, 1e-20f);
    for (int i = lane; i < n; i += 64) s[i] *= inv;
}
DEVI void dot4(const float* q  , const float* __restrict__ krow, float* out4) {
    float a0 = 0.f, a1 = 0.f, a2 = 0.f, a3 = 0.f;
#pragma unroll
    for (int d = 0; d < 64; d += 4) {
        const float4 kv = *(const float4*)(krow + d);
        a0 += q[d] * kv.x + q[d + 1] * kv.y + q[d + 2] * kv.z + q[d + 3] * kv.w;
        a1 += q[64 + d] * kv.x + q[64 + d + 1] * kv.y + q[64 + d + 2] * kv.z + q[64 + d + 3] * kv.w;
        a2 += q[128 + d] * kv.x + q[128 + d + 1] * kv.y + q[128 + d + 2] * kv.z + q[128 + d + 3] * kv.w;
        a3 += q[192 + d] * kv.x + q[192 + d + 1] * kv.y + q[192 + d + 2] * kv.z + q[192 + d + 3] * kv.w;
    }
    out4[0] = a0; out4[1] = a1; out4[2] = a2; out4[3] = a3;
}
DEVI void nsa_attn(const bf16* __restrict__ cols, const float* __restrict__ qrot, const float* __restrict__ ksr,
                   const float* __restrict__ kwr, const float* __restrict__ gates, const float* __restrict__ kcmp,
                   const float* __restrict__ vcmp, bf16* __restrict__ mix, int bid, float* sm) {
    __syncthreads();
    float* q = sm; float* qr = sm + 256;
    float (*sc)[1024] = (float (*)[1024])(sm + 512);
    float* imp = sm + 512 + 4096;
    int* sel = (int*)(sm + 512 + 4096 + 128);
    const int pos = bid, tid = tidx() & 255, h = tid >> 6, lane = tid & 63;
    q[tid] = bf2f(cols[(size_t)pos * DINP + OFF_Q + tid]);
    qr[tid] = qrot[(size_t)pos * 256 + tid];
    __syncthreads();
    int ncv = pos >= 31 ? (pos - 31) / 16 + 1 : 0;
    if (ncv > NCMP) ncv = NCMP;
    for (int n = tid; n < 512; n += 256) {
        if (n < ncv) {
            float d4[4]; dot4(q, kcmp + (size_t)n * 64, d4);
            sc[0][n] = d4[0] * 0.125f; sc[1][n] = d4[1] * 0.125f; sc[2][n] = d4[2] * 0.125f; sc[3][n] = d4[3] * 0.125f;
        } else { sc[0][n] = 0.f; sc[1][n] = 0.f; sc[2][n] = 0.f; sc[3][n] = 0.f; }
    }
    __syncthreads();
    wave_softmax(sc[h], ncv, lane);
    __syncthreads();
    float oc = 0.f;
#pragma unroll 4
    for (int n = 0; n < ncv; ++n) oc = fmaf(sc[h][n], vcmp[(size_t)n * 64 + lane], oc);
    if (tid < 128) {
        const int j = tid;
        auto ps = [&](int n) -> float { return (n >= 0 && n < 512) ? (sc[0][n] + sc[1][n] + sc[2][n] + sc[3][n]) : 0.f; };
        const float v = 0.5f * ps(4 * j - 1) + ps(4 * j) + ps(4 * j + 1) + ps(4 * j + 2) + 0.5f * ps(4 * j + 3);
        const int cur = pos >> 6;
        float key;
        if (j == cur || j == 0) key = INFINITY; else if (j <= cur) key = v; else key = -1.f;
        imp[j] = key;
    }
    __syncthreads();
    if (h == 0) {
        float v0 = imp[lane], v1 = imp[lane + 64];
        for (int r = 0; r < 16; ++r) {
            float bv; int bi;
            if (v1 > v0) { bv = v1; bi = lane + 64; } else { bv = v0; bi = lane; }
#pragma unroll
            for (int o = 32; o > 0; o >>= 1) {
                const float ov = __shfl_xor(bv, o, 64); const int oi = __shfl_xor(bi, o, 64);
                if (ov > bv || (ov == bv && oi < bi)) { bv = ov; bi = oi; }
            }
            if (lane == 0) sel[r] = bi;
            if (bi == lane) v0 = -2.f;
            if (bi == lane + 64) v1 = -2.f;
        }
    }
    __syncthreads();
    for (int i = tid; i < 1024; i += 256) {
        const int kp = sel[i >> 6] * 64 + (i & 63);
        if (kp <= pos) {
            float d4[4]; dot4(qr, ksr + (size_t)kp * 64, d4);
            sc[0][i] = d4[0] * 0.125f; sc[1][i] = d4[1] * 0.125f; sc[2][i] = d4[2] * 0.125f; sc[3][i] = d4[3] * 0.125f;
        } else { sc[0][i] = -INFINITY; sc[1][i] = -INFINITY; sc[2][i] = -INFINITY; sc[3][i] = -INFINITY; }
    }
    __syncthreads();
    wave_softmax(sc[h], 1024, lane);
    __syncthreads();
    float os = 0.f;
#pragma unroll 2
    for (int i = 0; i < 1024; ++i) {
        const float p = sc[h][i];
        if (p != 0.f) { const int kp = sel[i >> 6] * 64 + (i & 63); os = fmaf(p, bf2f(cols[(size_t)kp * DINP + OFF_VS + lane]), os); }
    }
    __syncthreads();
    for (int i = tid; i < 512; i += 256) {
        const int kp = pos - 511 + i;
        if (kp >= 0) {
            float d4[4]; dot4(qr, kwr + (size_t)kp * 64, d4);
            sc[0][i] = d4[0] * 0.125f; sc[1][i] = d4[1] * 0.125f; sc[2][i] = d4[2] * 0.125f; sc[3][i] = d4[3] * 0.125f;
        } else { sc[0][i] = -INFINITY; sc[1][i] = -INFINITY; sc[2][i] = -INFINITY; sc[3][i] = -INFINITY; }
    }
    __syncthreads();
    wave_softmax(sc[h], 512, lane);
    __syncthreads();
    float ow = 0.f;
#pragma unroll 4
    for (int i = 0; i < 512; ++i) {
        const int kp = pos - 511 + i;
        if (kp >= 0) ow = fmaf(sc[h][i], bf2f(cols[(size_t)kp * DINP + OFF_VW + lane]), ow);
    }
    const float* gt = gates + (size_t)pos * 12 + h * 3;
    mix[(size_t)pos * DM + 768 + tid] = (bf16)f2bf(gt[0] * oc + gt[1] * os + gt[2] * ow);
}

DEVI void softmax256(float* s, float scale, int bid, float* sm) {
    __syncthreads();
    const size_t row = bid; const int tid = tidx() & 255;
    const float v = s[row * 256 + tid] * scale;
    float m = wave_max(v);
    if ((tid & 63) == 0) sm[8 + (tid >> 6)] = m;
    __syncthreads();
    m = fmaxf(fmaxf(sm[8], sm[9]), fmaxf(sm[10], sm[11]));
    const float p = expf(v - m);
    const float sum = block_sum256(p, sm, tid);
    s[row * 256 + tid] = p / sum;
}

DEVI void router_kernel(const float* __restrict__ x, const float* __restrict__ rw, const float* __restrict__ rb,
                        int* __restrict__ te, float* __restrict__ tw, int bid, float* sm) {
    __syncthreads();
    float (*part)[16] = (float (*)[16])sm;
    const size_t t = bid; const int tid = tidx() & 255;
    float acc[16];
#pragma unroll
    for (int e = 0; e < 16; ++e) acc[e] = 0.f;
#pragma unroll 1
    for (int i = tid; i < DM; i += 256) {
        const float xv = x[t * DM + i];
#pragma unroll
        for (int e = 0; e < 16; ++e) acc[e] = fmaf(xv, rw[i * 16 + e], acc[e]);
    }
#pragma unroll
    for (int e = 0; e < 16; ++e) acc[e] = wave_sum(acc[e]);
    if ((tid & 63) == 0) {
#pragma unroll
        for (int e = 0; e < 16; ++e) part[tid >> 6][e] = acc[e];
    }
    __syncthreads();
    if (tid == 0) {
        float lg[16], pr[16], sl[16];
        float m = -INFINITY;
#pragma unroll
        for (int e = 0; e < 16; ++e) { lg[e] = part[0][e] + part[1][e] + part[2][e] + part[3][e]; m = fmaxf(m, lg[e]); }
        float sum = 0.f;
#pragma unroll
        for (int e = 0; e < 16; ++e) { pr[e] = expf(lg[e] - m); sum += pr[e]; }
#pragma unroll
        for (int e = 0; e < 16; ++e) { pr[e] /= sum; sl[e] = pr[e] + rb[e]; }
        int bg = 0; float bgs = -INFINITY;
#pragma unroll
        for (int gI = 0; gI < 4; ++gI) {
            float m1 = -INFINITY, m2 = -INFINITY;
#pragma unroll
            for (int j = 0; j < 4; ++j) { const float v = sl[gI * 4 + j]; if (v > m1) { m2 = m1; m1 = v; } else if (v > m2) m2 = v; }
            const float sc = m1 + m2;
            if (sc > bgs) { bgs = sc; bg = gI; }
        }
        int e0 = -1, e1 = -1; float s0 = -INFINITY, s1 = -INFINITY, p0 = 0.f, p1 = 0.f;
#pragma unroll
        for (int e = 0; e < 16; ++e) {
            if ((e >> 2) == bg) {
                const float v = sl[e];
                if (v > s0) { s1 = s0; e1 = e0; p1 = p0; s0 = v; e0 = e; p0 = pr[e]; } else if (v > s1) { s1 = v; e1 = e; p1 = pr[e]; }
            }
        }
        const float wsum = p0 + p1;
        te[t * 2] = e0; te[t * 2 + 1] = e1;
        tw[t * 2] = p0 / wsum; tw[t * 2 + 1] = p1 / wsum;
    }
}
DEVI void moe_lists(const int* __restrict__ te, int* __restrict__ off, int* __restrict__ list, int* __restrict__ slotpos, float* sm0) {
    int* cnt = (int*)sm0;
    int* offs = cnt + 16;
    const int w = tidx() >> 6, lane = tidx() & 63;
    __syncthreads();
    for (int ee = 0; ee < 2; ++ee) {
        const int e = w * 2 + ee;
        int c = 0;
        for (int base = 0; base < NTOK; base += 64) {
            const int tok = base + lane;
            const bool m = (te[tok * 2] == e) || (te[tok * 2 + 1] == e);
            c += __popcll(__ballot(m));
        }
        if (lane == 0) cnt[e] = c;
    }
    __syncthreads();
    if (tidx() == 0) {
        int s = 0;
        for (int i = 0; i < 16; ++i) { offs[i] = s; off[i] = s; s += cnt[i]; }
        offs[16] = s; off[16] = s;
    }
    __syncthreads();
    for (int ee = 0; ee < 2; ++ee) {
        const int e = w * 2 + ee;
        int pos = offs[e];
        for (int base = 0; base < NTOK; base += 64) {
            const int tok = base + lane;
            const int a = te[tok * 2], b = te[tok * 2 + 1];
            const bool m = (a == e) || (b == e);
            const unsigned long long mask = __ballot(m);
            if (m) {
                const int p = pos + __popcll(mask & ((1ull << lane) - 1ull));
                list[p] = tok;
                slotpos[tok * 2 + (a == e ? 0 : 1)] = p;
            }
            pos += __popcll(mask);
        }
    }
    __syncthreads();
}
DEVI void moe_combine_ln(const float* x, const float* __restrict__ Dp, const int* __restrict__ te,
                         const float* __restrict__ tw, const int* __restrict__ slotpos,
                         const float* __restrict__ g, const float* __restrict__ bt, float* out, bf16* outb, int bid, float* sm) {
    __syncthreads();
    const size_t t = bid; const int tid = tidx() & 255;
    int ea = te[t * 2], eb = te[t * 2 + 1];
    float wa = tw[t * 2], wb = tw[t * 2 + 1];
    size_t pa = slotpos[t * 2], pb = slotpos[t * 2 + 1];
    if (eb < ea) { const float tf = wa; wa = wb; wb = tf; const size_t tp = pa; pa = pb; pb = tp; }
    float v[4];
#pragma unroll
    for (int i = 0; i < 4; ++i) {
        const int c = tid + i * 256;
        float y = wa * Dp[pa * DM + c];
        y = y + wb * Dp[pb * DM + c];
        v[i] = ALPHA * x[t * DM + c] + y;
    }
    const float mean = block_sum256(v[0] + v[1] + v[2] + v[3], sm, tid) * (1.f / DM);
    float q = 0.f;
#pragma unroll
    for (int i = 0; i < 4; ++i) { v[i] -= mean; q += v[i] * v[i]; }
    const float var = block_sum256(q, sm, tid) * (1.f / DM);
    const float rstd = rsqrtf(var + 1e-5f);
#pragma unroll
    for (int i = 0; i < 4; ++i) {
        const int c = tid + i * 256;
        const float o = v[i] * rstd * g[c] + bt[c];
        out[t * DM + c] = o;
        outb[t * DM + c] = (bf16)f2bf(o);
    }
}
typedef short bf16x8 __attribute__((ext_vector_type(8)));
typedef short s16x4 __attribute__((ext_vector_type(4)));
typedef float f32x16 __attribute__((ext_vector_type(16)));
typedef float f32x2_t __attribute__((ext_vector_type(2)));
typedef __bf16 bf16x2_t __attribute__((ext_vector_type(2)));
DEVI unsigned cvtpk(float lo, float hi) { f32x2_t v = {lo, hi}; bf16x2_t b = __builtin_convertvector(v, bf16x2_t); return __builtin_bit_cast(unsigned, b); }
constexpr float QSCL = 0.125f * 1.4426950408889634f;

struct NsaP {
    const bf16 *QN, *QR, *KSR, *KWR, *VST, *VWT, *KCMP, *VCMPT;
    const float* GATES;
    bf16* MIX;
};
constexpr int NSA_KT = 0, NSA_VT = 16384, NSA_IA = 32768, NSA_IB = 65536, NSA_SELM = 98304, NSA_UNI = 99328;

DEVI int crow(int r, int hi) { return (r & 3) + 8 * (r >> 2) + 4 * hi; }

DEVI void nsa_ld(v4u& rk, v4u& rv, const bf16* kbase, const bf16* vbase, size_t vstride, int tid) {
    rk = *(const v4u*)((const char*)kbase + tid * 16);
    rv = *(const v4u*)((const char*)(vbase + (size_t)(tid >> 3) * vstride) + (tid & 7) * 16);
}
DEVI void nsa_st(LAS unsigned char* KTb, LAS unsigned char* VTb, const v4u& rk, const v4u& rv, int tid) {
    const int r = tid >> 3, c = tid & 7, off = r * 128 + ((c ^ (r & 7)) << 4);
    *(LAS v4u*)(KTb + off) = rk; *(LAS v4u*)(VTb + off) = rv;
}
DEVI void nsa_qk(f32x16& p0, f32x16& p1, const LAS unsigned char* KTb, const bf16x8 (&qf)[4], int q32, int hi) {
#pragma unroll
    for (int r = 0; r < 16; ++r) { p0[r] = 0.f; p1[r] = 0.f; }
#pragma unroll
    for (int ks = 0; ks < 4; ++ks) {
        const int c = ((2 * ks + hi) ^ (q32 & 7)) << 4;
        const bf16x8 a0 = *(const LAS bf16x8*)(KTb + q32 * 128 + c);
        const bf16x8 a1 = *(const LAS bf16x8*)(KTb + (32 + q32) * 128 + c);
        p0 = __builtin_amdgcn_mfma_f32_32x32x16_bf16(a0, qf[ks], p0, 0, 0, 0);
        p1 = __builtin_amdgcn_mfma_f32_32x32x16_bf16(a1, qf[ks], p1, 0, 0, 0);
    }
}
DEVI void nsa_pv(f32x16 (&o)[2], const LAS unsigned char* VTb, const bf16x8 (&pf)[4], int q32, int hi) {
#pragma unroll
    for (int db = 0; db < 2; ++db) {
        const int d = 32 * db + q32;
        const LAS unsigned char* rowp = VTb + d * 128 + 8 * hi;
#pragma unroll
        for (int s = 0; s < 4; ++s) {
            const s16x4 lo = *(const LAS s16x4*)(rowp + (((2 * s) ^ (d & 7)) << 4));
            const s16x4 h4 = *(const LAS s16x4*)(rowp + (((2 * s + 1) ^ (d & 7)) << 4));
            const bf16x8 a = {lo[0], lo[1], lo[2], lo[3], h4[0], h4[1], h4[2], h4[3]};
            o[db] = __builtin_amdgcn_mfma_f32_32x32x16_bf16(a, pf[s], o[db], 0, 0, 0);
        }
    }
}
DEVI void nsa_pack(bf16x8 (&pf)[4], const f32x16& p0, const f32x16& p1) {
#pragma unroll
    for (int s = 0; s < 2; ++s) {
        unsigned w0[4], w1[4];
#pragma unroll
        for (int j = 0; j < 4; ++j) { w0[j] = cvtpk(p0[8 * s + 2 * j], p0[8 * s + 2 * j + 1]); w1[j] = cvtpk(p1[8 * s + 2 * j], p1[8 * s + 2 * j + 1]); }
        pf[s] = __builtin_bit_cast(bf16x8, (v4u){w0[0], w0[1], w0[2], w0[3]});
        pf[2 + s] = __builtin_bit_cast(bf16x8, (v4u){w1[0], w1[1], w1[2], w1[3]});
    }
}
DEVI void nsa_softmax(f32x16& p0, f32x16& p1, float& m, float& l, f32x16 (&o)[2], bf16x8 (&pf)[4]) {
    float mx = -INFINITY;
#pragma unroll
    for (int r = 0; r < 16; ++r) mx = fmaxf(mx, fmaxf(p0[r], p1[r]));
    mx = fmaxf(mx, __shfl_xor(mx, 32, 64));
    const float mn = fmaxf(m, mx);
    const float ms = (mn == -INFINITY) ? 0.f : mn;
    const float alpha = __builtin_amdgcn_exp2f(m - ms);
    float sum = 0.f;
#pragma unroll
    for (int r = 0; r < 16; ++r) { p0[r] = __builtin_amdgcn_exp2f(p0[r] - ms); p1[r] = __builtin_amdgcn_exp2f(p1[r] - ms); sum += p0[r] + p1[r]; }
    sum += __shfl_xor(sum, 32, 64);
    l = l * alpha + sum; m = mn;
#pragma unroll
    for (int r = 0; r < 16; ++r) { o[0][r] *= alpha; o[1][r] *= alpha; }
    nsa_pack(pf, p0, p1);
}
DEVI void nsa_loadq(bf16x8 (&qf)[4], const bf16* Q, int tq, int head, int hi) {
    const bf16* qp = Q + (size_t)tq * 256 + head * 64 + 8 * hi;
#pragma unroll
    for (int ks = 0; ks < 4; ++ks) qf[ks] = *(const bf16x8*)(qp + 16 * ks);
}

DEVI void nsa_unit(const NsaP& P, int u, LAS unsigned char* lds) {
    const int tid = tidx(), w = tid >> 6, lane = tid & 63, q32 = lane & 31, hi = lane >> 5;
    const int t0 = u * 64, cur = u;
    const int tl = 8 * w + (q32 >> 2), head = q32 & 3, tq = t0 + tl;
    LAS unsigned char* KT = lds + NSA_KT; LAS unsigned char* VT = lds + NSA_VT;
    LAS float* IA = (LAS float*)(lds + NSA_IA); LAS float* IB = (LAS float*)(lds + NSA_IB);
    LAS unsigned* SELM = (LAS unsigned*)(lds + NSA_SELM); LAS unsigned* UNI = (LAS unsigned*)(lds + NSA_UNI);
    __syncthreads();
    for (int i = tid; i < 2 * 64 * 128; i += 512) IA[i] = 0.f;
    if (tid < 4) UNI[tid] = 0u;
    f32x16 acc[2];
#pragma unroll
    for (int r = 0; r < 16; ++r) { acc[0][r] = 0.f; acc[1][r] = 0.f; }
    bf16x8 qf[4], pf[4];
    f32x16 o[2], p0, p1;
    v4u rk, rv;
    const float g_c = P.GATES[(size_t)tq * 12 + head * 3 + 0], g_s = P.GATES[(size_t)tq * 12 + head * 3 + 1], g_w = P.GATES[(size_t)tq * 12 + head * 3 + 2];

    {
        nsa_loadq(qf, P.QN, tq, head, hi);
        const int nlim = tq >= 31 ? (tq - 31) >> 4 : -1;
        const int nmaxu = (t0 + 63 - 31) >> 4;
        const int nct = (nmaxu >> 6) + 1;
        float m = -INFINITY, l = 0.f;
        for (int pass = 0; pass < 2; ++pass) {
#pragma unroll
            for (int r = 0; r < 16; ++r) { o[0][r] = 0.f; o[1][r] = 0.f; }
            const float rl = (pass == 1 && l > 0.f) ? 1.f / l : 0.f;
            nsa_ld(rk, rv, P.KCMP, P.VCMPT, 512, tid);
            __syncthreads();
            nsa_st(KT, VT, rk, rv, tid);
            __syncthreads();
            for (int jt = 0; jt < nct; ++jt) {
                const int buf = jt & 1;
                if (jt + 1 < nct) nsa_ld(rk, rv, P.KCMP + (size_t)(jt + 1) * 64 * 64, P.VCMPT + (jt + 1) * 64, 512, tid);
                nsa_qk(p0, p1, KT + buf * 8192, qf, q32, hi);
                const int nb = jt * 64;
#pragma unroll
                for (int r = 0; r < 16; ++r) { const int n = nb + crow(r, hi); if (n > nlim) p0[r] = -INFINITY; if (n + 32 > nlim) p1[r] = -INFINITY; }
                if (pass == 0) {
                    float mx = -INFINITY;
#pragma unroll
                    for (int r = 0; r < 16; ++r) mx = fmaxf(mx, fmaxf(p0[r], p1[r]));
                    mx = fmaxf(mx, __shfl_xor(mx, 32, 64));
                    const float mn = fmaxf(m, mx), ms = (mn == -INFINITY) ? 0.f : mn;
                    float sum = 0.f;
#pragma unroll
                    for (int r = 0; r < 16; ++r) sum += __builtin_amdgcn_exp2f(p0[r] - ms) + __builtin_amdgcn_exp2f(p1[r] - ms);
                    sum += __shfl_xor(sum, 32, 64);
                    l = l * __builtin_amdgcn_exp2f(m - ms) + sum; m = mn;
                } else {
                    const float ms = (m == -INFINITY) ? 0.f : m;
#pragma unroll
                    for (int r = 0; r < 16; ++r) { p0[r] = __builtin_amdgcn_exp2f(p0[r] - ms) * rl; p1[r] = __builtin_amdgcn_exp2f(p1[r] - ms) * rl; }
#pragma unroll
                    for (int half = 0; half < 2; ++half) {
#pragma unroll
                        for (int g = 0; g < 4; ++g) {
                            const f32x16& pp = half ? p1 : p0;
                            float a = pp[4 * g] + pp[4 * g + 1] + pp[4 * g + 2] + 0.5f * pp[4 * g + 3];
                            float b = 0.5f * pp[4 * g + 3];
                            a += __shfl_xor(a, 1, 64); a += __shfl_xor(a, 2, 64);
                            b += __shfl_xor(b, 1, 64); b += __shfl_xor(b, 2, 64);
                            const int j = (nb + 32 * half + 8 * g + 4 * hi) >> 2;
                            if (head == 0 && j < 128) { IA[tl * 128 + j] = a; IB[tl * 128 + j] = b; }
                        }
                    }
                    nsa_pack(pf, p0, p1);
                    nsa_pv(o, VT + buf * 8192, pf, q32, hi);
                }
                if (jt + 1 < nct) nsa_st(KT + (buf ^ 1) * 8192, VT + (buf ^ 1) * 8192, rk, rv, tid);
                __syncthreads();
            }
        }
#pragma unroll
        for (int r = 0; r < 16; ++r) { acc[0][r] = g_c * o[0][r]; acc[1][r] = g_c * o[1][r]; }
    }
    for (int tt = 0; tt < 8; ++tt) {
        const int tok = 8 * w + tt, tpos = t0 + tok;
        float v[2];
#pragma unroll
        for (int e = 0; e < 2; ++e) {
            const int j = lane + 64 * e;
            const float imp = IA[tok * 128 + j] + (j > 0 ? IB[tok * 128 + j - 1] : 0.f);
            v[e] = (j == cur || j == 0) ? INFINITY : (j <= cur ? imp : -1.f);
        }
        (void)tpos;
        unsigned m0 = 0u, m1 = 0u, m2 = 0u, m3 = 0u;
        for (int r = 0; r < 16; ++r) {
            float bv; int bi;
            if (v[1] > v[0]) { bv = v[1]; bi = lane + 64; } else { bv = v[0]; bi = lane; }
#pragma unroll
            for (int of = 32; of > 0; of >>= 1) {
                const float ov = __shfl_xor(bv, of, 64); const int oi = __shfl_xor(bi, of, 64);
                if (ov > bv || (ov == bv && oi < bi)) { bv = ov; bi = oi; }
            }
            if (bi == lane) v[0] = -2.f;
            if (bi == lane + 64) v[1] = -2.f;
            const unsigned bit = 1u << (bi & 31);
            if ((bi >> 5) == 0) m0 |= bit; else if ((bi >> 5) == 1) m1 |= bit; else if ((bi >> 5) == 2) m2 |= bit; else m3 |= bit;
        }
        if (lane == 0) {
            SELM[tok * 4 + 0] = m0; SELM[tok * 4 + 1] = m1; SELM[tok * 4 + 2] = m2; SELM[tok * 4 + 3] = m3;
            __hip_atomic_fetch_or(&UNI[0], m0, __ATOMIC_RELAXED, __HIP_MEMORY_SCOPE_WORKGROUP); __hip_atomic_fetch_or(&UNI[1], m1, __ATOMIC_RELAXED, __HIP_MEMORY_SCOPE_WORKGROUP); __hip_atomic_fetch_or(&UNI[2], m2, __ATOMIC_RELAXED, __HIP_MEMORY_SCOPE_WORKGROUP); __hip_atomic_fetch_or(&UNI[3], m3, __ATOMIC_RELAXED, __HIP_MEMORY_SCOPE_WORKGROUP);
        }
    }
    __syncthreads();
    {
        nsa_loadq(qf, P.QR, tq, head, hi);
        const unsigned s0 = SELM[tl * 4 + 0], s1 = SELM[tl * 4 + 1], s2 = SELM[tl * 4 + 2], s3 = SELM[tl * 4 + 3];
        const unsigned u0 = UNI[0], u1 = UNI[1], u2 = UNI[2], u3 = UNI[3];
        float m = -INFINITY, l = 0.f;
#pragma unroll
        for (int r = 0; r < 16; ++r) { o[0][r] = 0.f; o[1][r] = 0.f; }
        int j = 0;
        auto ubit = [&](int jj) -> bool { const unsigned wv = jj < 32 ? u0 : (jj < 64 ? u1 : (jj < 96 ? u2 : u3)); return (wv >> (jj & 31)) & 1u; };
        auto nextj = [&](int jj) -> int { ++jj; while (jj <= cur && !ubit(jj)) ++jj; return jj; };
        nsa_ld(rk, rv, P.KSR, P.VST, SEQ, tid);
        __syncthreads();
        nsa_st(KT, VT, rk, rv, tid);
        __syncthreads();
        int buf = 0;
        while (j <= cur) {
            const int jn = nextj(j);
            if (jn <= cur) nsa_ld(rk, rv, P.KSR + (size_t)jn * 64 * 64, P.VST + jn * 64, SEQ, tid);
            const unsigned wv = j < 32 ? s0 : (j < 64 ? s1 : (j < 96 ? s2 : s3));
            const bool mine = (wv >> (j & 31)) & 1u;
            if (__any(mine)) {
                nsa_qk(p0, p1, KT + buf * 8192, qf, q32, hi);
                const int klim = mine ? (j == cur ? (tq & 63) : 63) : -1;
#pragma unroll
                for (int r = 0; r < 16; ++r) { const int k = crow(r, hi); if (k > klim) p0[r] = -INFINITY; if (k + 32 > klim) p1[r] = -INFINITY; }
                nsa_softmax(p0, p1, m, l, o, pf);
                nsa_pv(o, VT + buf * 8192, pf, q32, hi);
            }
            if (jn <= cur) nsa_st(KT + (buf ^ 1) * 8192, VT + (buf ^ 1) * 8192, rk, rv, tid);
            __syncthreads();
            buf ^= 1; j = jn;
        }
        const float sc = l > 0.f ? g_s / l : 0.f;
#pragma unroll
        for (int r = 0; r < 16; ++r) { acc[0][r] += sc * o[0][r]; acc[1][r] += sc * o[1][r]; }
    }
    {
        float m = -INFINITY, l = 0.f;
#pragma unroll
        for (int r = 0; r < 16; ++r) { o[0][r] = 0.f; o[1][r] = 0.f; }
        const int j0 = cur >= 8 ? cur - 8 : 0;
        nsa_ld(rk, rv, P.KWR + (size_t)j0 * 64 * 64, P.VWT + j0 * 64, SEQ, tid);
        __syncthreads();
        nsa_st(KT, VT, rk, rv, tid);
        __syncthreads();
        int buf = 0;
        for (int j = j0; j <= cur; ++j) {
            if (j + 1 <= cur) nsa_ld(rk, rv, P.KWR + (size_t)(j + 1) * 64 * 64, P.VWT + (j + 1) * 64, SEQ, tid);
            nsa_qk(p0, p1, KT + buf * 8192, qf, q32, hi);
            const int kb = j * 64;
#pragma unroll
            for (int r = 0; r < 16; ++r) {
                const int k = kb + crow(r, hi);
                if (k > tq || k <= tq - 512) p0[r] = -INFINITY;
                if (k + 32 > tq || k + 32 <= tq - 512) p1[r] = -INFINITY;
            }
            nsa_softmax(p0, p1, m, l, o, pf);
            nsa_pv(o, VT + buf * 8192, pf, q32, hi);
            if (j + 1 <= cur) nsa_st(KT + (buf ^ 1) * 8192, VT + (buf ^ 1) * 8192, rk, rv, tid);
            __syncthreads();
            buf ^= 1;
        }
        const float sc = l > 0.f ? g_w / l : 0.f;
#pragma unroll
        for (int r = 0; r < 16; ++r) { acc[0][r] += sc * o[0][r]; acc[1][r] += sc * o[1][r]; }
    }
    {
        bf16* op = P.MIX + (size_t)tq * DM + 768 + head * 64 + 4 * hi;
#pragma unroll
        for (int db = 0; db < 2; ++db)
#pragma unroll
            for (int g = 0; g < 4; ++g) {
                const unsigned lo = cvtpk(acc[db][4 * g], acc[db][4 * g + 1]), h2 = cvtpk(acc[db][4 * g + 2], acc[db][4 * g + 3]);
                *(uint2*)(op + 32 * db + 8 * g) = make_uint2(lo, h2);
            }
    }
}

DEVI void nsa_prep2(const bf16* __restrict__ cols, bf16* __restrict__ qn, bf16* __restrict__ qr, bf16* __restrict__ ksr, bf16* __restrict__ kwr,
                    bf16* __restrict__ vst, bf16* __restrict__ vwt, float* __restrict__ gates, int bid) {
    const int t = bid, c = tidx() & 255;
    const int d = c & 63, j = d & 31;
    const float inv = powf(10000.f, -(float)j / 32.f);
    const float ang = (float)t * inv;
    float sn, cs; sincosf(ang, &sn, &cs);
    {
        const bf16* q = cols + (size_t)t * DINP + OFF_Q + (c & ~63);
        const float x1 = bf2f(q[j]), x2 = bf2f(q[j + 32]);
        qn[(size_t)t * 256 + c] = (bf16)f2bf(bf2f(q[d]) * QSCL);
        qr[(size_t)t * 256 + c] = (bf16)f2bf((d < 32 ? x1 * cs - x2 * sn : x2 * cs + x1 * sn) * QSCL);
    }
    if (c < 128) {
        const bf16* kp = cols + (size_t)t * DINP + (c < 64 ? OFF_KS : OFF_KW);
        const float x1 = bf2f(kp[j]), x2 = bf2f(kp[j + 32]);
        const float v = d < 32 ? x1 * cs - x2 * sn : x2 * cs + x1 * sn;
        if (c < 64) ksr[(size_t)t * 64 + d] = (bf16)f2bf(v); else kwr[(size_t)t * 64 + d] = (bf16)f2bf(v);
    } else {
        const bf16 v = cols[(size_t)t * DINP + (c < 192 ? OFF_VS : OFF_VW) + d];
        if (c < 192) vst[(size_t)d * SEQ + t] = v; else vwt[(size_t)d * SEQ + t] = v;
    }
    if (c < 12) gates[(size_t)t * 12 + c] = sigm(bf2f(cols[(size_t)t * DINP + OFF_GT + c]));
}
DEVI void nsa_cmp_cvt(const float* __restrict__ kc, const float* __restrict__ vc, bf16* __restrict__ kcb, bf16* __restrict__ vct, int bid) {
    const int i = bid * 256 + (tidx() & 255);
    if (i < 512 * 64) {
        const int n = i >> 6, d = i & 63;
        kcb[i] = n < NCMP ? (bf16)f2bf(kc[i]) : (bf16)0;
        vct[d * 512 + n] = n < NCMP ? (bf16)f2bf(vc[i]) : (bf16)0;
    }
}
DEVI float4 ld4bf(const bf16* p);
constexpr int RW_SLOT = 8192;
typedef unsigned u32x2v __attribute__((ext_vector_type(2)));
DEVI int rw_off(int row, int chunk16) { return row * 128 + ((chunk16 ^ (row & 7)) << 4); }
DEVI void rw_ld(LAS unsigned char* slot, const bf16* g, int gt) {
#pragma unroll
    for (int e = 0; e < 2; ++e) { const int idx = gt + 256 * e, row = idx >> 3, ch = idx & 7;
        *(LAS v4u*)(slot + rw_off(row, ch)) = *(const v4u*)((const char*)g + idx * 16); }
}
DEVI void rw_ldT(LAS unsigned char* slot, const bf16* g, size_t gstride, int gt) {
#pragma unroll
    for (int e = 0; e < 2; ++e) { const int idx = gt + 256 * e, row = idx >> 3, ch = idx & 7;
        const v4u v = *(const v4u*)(g + (size_t)row * gstride + ch * 8);
        const unsigned w[4] = {v.x, v.y, v.z, v.w};
#pragma unroll
        for (int j = 0; j < 8; ++j) { const int col = ch * 8 + j; const unsigned short h = (unsigned short)(w[j >> 1] >> ((j & 1) * 16));
            *(LAS unsigned short*)(slot + rw_off(col, row >> 3) + (row & 7) * 2) = h; }
    }
}
DEVI bf16x8 rw_frag(const LAS unsigned char* slot, int blk, int s, int r32, int hi) {
    return *(const LAS bf16x8*)(slot + rw_off(32 * blk + r32, 2 * s + hi));
}
DEVI void rw_mm(f32x16& acc, const LAS unsigned char* slotA, int rb, const LAS unsigned char* slotBT, int cb, int r32, int hi) {
#pragma unroll
    for (int s = 0; s < 4; ++s) acc = __builtin_amdgcn_mfma_f32_32x32x16_bf16(rw_frag(slotA, rb, s, r32, hi), rw_frag(slotBT, cb, s, r32, hi), acc, 0, 0, 0);
}
DEVI void rw_stT(LAS unsigned char* slot, const f32x16& acc, int rb, int cb, int r32, int hi) {
    const int j = 32 * cb + r32;
#pragma unroll
    for (int g = 0; g < 4; ++g) {
        const u32x2v w = {cvtpk(acc[4 * g], acc[4 * g + 1]), cvtpk(acc[4 * g + 2], acc[4 * g + 3])};
        *(LAS u32x2v*)(slot + rw_off(j, 4 * rb + g) + 8 * hi) = w;
    }
}
DEVI void rw_st(LAS unsigned char* slot, const f32x16& acc, int rb, int cb, int r32, int hi) {
    const int j = 32 * cb + r32;
#pragma unroll
    for (int r = 0; r < 16; ++r) { const int i = 32 * rb + crow(r, hi);
        *(LAS unsigned short*)(slot + rw_off(i, j >> 3) + (j & 7) * 2) = (unsigned short)f2bf(acc[r]); }
}
DEVI void rw_ldaccT(f32x16& acc, const LAS unsigned char* slot, int rb, int cb, int r32, int hi) {
    const int j = 32 * cb + r32;
#pragma unroll
    for (int g = 0; g < 4; ++g) {
        const u32x2v w = *(const LAS u32x2v*)(slot + rw_off(j, 4 * rb + g) + 8 * hi);
        acc[4 * g] = __builtin_bit_cast(float, w.x << 16); acc[4 * g + 1] = __builtin_bit_cast(float, w.x & 0xffff0000u);
        acc[4 * g + 2] = __builtin_bit_cast(float, w.y << 16); acc[4 * g + 3] = __builtin_bit_cast(float, w.y & 0xffff0000u);
    }
}
DEVI void rw_zero(f32x16& a) {
#pragma unroll
    for (int r = 0; r < 16; ++r) a[r] = 0.f;
}
DEVI void rw_frags(v4u& f0, v4u& f1, const f32x16& a) {
    f0 = (v4u){cvtpk(a[0], a[1]), cvtpk(a[2], a[3]), cvtpk(a[4], a[5]), cvtpk(a[6], a[7])};
    f1 = (v4u){cvtpk(a[8], a[9]), cvtpk(a[10], a[11]), cvtpk(a[12], a[13]), cvtpk(a[14], a[15])};
}

struct RwP {
    const bf16 *R, *K, *V, *A, *B;
    const float* LW; const bf16 *G, *BON;
    bf16 *AT, *BT, *KT, *RT;
    float* LAM;
    v4u *PF, *HF;
    float *QT, *OL;
    v4u* SF;
    const float *gn_g, *gn_b;
    bf16* MIX;
};

DEVI void rw_r1b(const RwP& P, int c, LAS unsigned char* lds) {
    LAS float* cum = (LAS float*)lds;
    const int tid = tidx();
    __syncthreads();
    if (tid < 256) {
        float s = 0.f;
#pragma unroll 8
        for (int t = 0; t < 64; ++t) { s += P.LW[(size_t)(c * 64 + t) * 256 + tid]; cum[t * 256 + tid] = s; }
    }
    __syncthreads();
    for (int e = tid; e < 64 * 256; e += 512) {
        const int t = e >> 8, ch = e & 255, h = ch >> 6, k = ch & 63;
        const size_t gi = (size_t)(c * 64 + t) * 256 + ch;
        const float cu = cum[e], lw = P.LW[gi];
        const float ein = __expf(cu), eout = __expf(-cu), eex = __expf(cu - lw);
        const size_t o = ((size_t)(c * 4 + h) * 64 + t) * 64 + k;
        P.AT[o] = (bf16)f2bf(bf2f(P.A[gi]) * eex);
        P.BT[o] = (bf16)f2bf(bf2f(P.B[gi]) * eout);
        P.KT[o] = (bf16)f2bf(bf2f(P.K[gi]) * eout);
        P.RT[o] = (bf16)f2bf(bf2f(P.R[gi]) * ein);
        if (t == 63) P.LAM[(size_t)(c * 4 + h) * 64 + k] = ein;
    }
}

DEVI void rw_r2(const RwP& P, int u0, LAS unsigned char* lds) {
    const int tid = tidx(), grp = tid >> 8, gt = tid & 255, gw = (tid >> 6) & 3, lane = tid & 63, r32 = lane & 31, hi = lane >> 5;
    const int rb = gw >> 1, cb = gw & 1;
    const int u = u0 + grp, c = u >> 2, h = u & 3;
    LAS unsigned char* sl = lds + grp * 65536;
#define SL(i) (sl + (i) * RW_SLOT)
    __syncthreads();
    rw_ld(SL(0), P.BT + (size_t)u * 4096, gt); rw_ld(SL(1), P.AT + (size_t)u * 4096, gt);
    rw_ld(SL(2), P.KT + (size_t)u * 4096, gt); rw_ld(SL(3), P.RT + (size_t)u * 4096, gt);
    __syncthreads();
    f32x16 aMab, aMak, aNbr, aNkr;
    rw_zero(aMab); rw_zero(aMak); rw_zero(aNbr); rw_zero(aNkr);
    rw_mm(aMab, SL(0), rb, SL(1), cb, r32, hi);
    rw_mm(aMak, SL(2), rb, SL(1), cb, r32, hi);
    rw_mm(aNbr, SL(0), rb, SL(3), cb, r32, hi);
    rw_mm(aNkr, SL(2), rb, SL(3), cb, r32, hi);
    {
        const int t = 32 * cb + r32;
#pragma unroll
        for (int r = 0; r < 16; ++r) { const int i = 32 * rb + crow(r, hi);
            if (!(i < t)) { aMab[r] = 0.f; aMak[r] = 0.f; }
            if (!(i <= t)) { aNbr[r] = 0.f; aNkr[r] = 0.f; } }
    }
    __syncthreads();
    rw_st(SL(4), aMab, rb, cb, r32, hi);
    rw_stT(SL(5), aMab, rb, cb, r32, hi);
    rw_st(SL(6), aMak, rb, cb, r32, hi);
    rw_stT(SL(7), aNbr, rb, cb, r32, hi);
    {
        const int t = 32 * cb + r32;
#pragma unroll
        for (int r = 0; r < 16; ++r) { const int i = 32 * rb + crow(r, hi); if (i == t) aMab[r] += 1.f; }
    }
    rw_st(SL(0), aMab, rb, cb, r32, hi);
    __syncthreads();
    int mA = 4, mT = 5, nA = 1, nT = 2;
#pragma unroll 1
    for (int j = 0; j < 5; ++j) {
        f32x16 a1; rw_zero(a1);
        rw_mm(a1, SL(mT), rb, SL(mA), cb, r32, hi);
        rw_stT(SL(nA), a1, rb, cb, r32, hi);
        rw_st(SL(nT), a1, rb, cb, r32, hi);
        __syncthreads();
        f32x16 a2; rw_ldaccT(a2, SL(0), rb, cb, r32, hi);
        rw_mm(a2, SL(nT), rb, SL(0), cb, r32, hi);
        __syncthreads();
        rw_stT(SL(0), a2, rb, cb, r32, hi);
        __syncthreads();
        const int ta = mA, tb = mT; mA = nA; mT = nT; nA = ta; nT = tb;
    }
    rw_ldT(SL(1), P.BT + (size_t)u * 4096, 64, gt); rw_ldT(SL(2), P.AT + (size_t)u * 4096, 64, gt);
    rw_ldT(SL(4), P.KT + (size_t)u * 4096, 64, gt); rw_ldT(SL(5), P.V + (size_t)(c * 64) * 256 + h * 64, 256, gt);
    __syncthreads();
    {
        f32x16 aY, aZ; rw_zero(aY); rw_zero(aZ);
        rw_mm(aY, SL(0), rb, SL(1), cb, r32, hi);
        rw_mm(aZ, SL(0), rb, SL(7), cb, r32, hi);
        __syncthreads();
        rw_stT(SL(1), aY, rb, cb, r32, hi);
        rw_stT(SL(7), aZ, rb, cb, r32, hi);
        __syncthreads();
    }
    {
        f32x16 aP; rw_zero(aP);
        rw_mm(aP, SL(2), rb, SL(1), cb, r32, hi);
        const int kp = 32 * cb + r32; const float lam = P.LAM[(size_t)u * 64 + kp];
#pragma unroll
        for (int r = 0; r < 16; ++r) { const int kk = 32 * rb + crow(r, hi); aP[r] = (aP[r] + (kk == kp ? 1.f : 0.f)) * lam; }
        v4u f0, f1; rw_frags(f0, f1, aP);
        v4u* dst = P.PF + ((((size_t)u * 2 + cb) * 2 + rb) * 2) * 64 + lane;
        dst[0] = f0; dst[64] = f1;
    }
    {
        f32x16 aH; rw_ldaccT(aH, SL(3), rb, cb, r32, hi);
        rw_mm(aH, SL(2), rb, SL(7), cb, r32, hi);
        v4u f0, f1; rw_frags(f0, f1, aH);
        v4u* dst = P.HF + ((((size_t)u * 2 + cb) * 2 + rb) * 2) * 64 + lane;
        dst[0] = f0; dst[64] = f1;
    }
    {
        f32x16 aD1; rw_ldaccT(aD1, SL(4), rb, cb, r32, hi);
        rw_mm(aD1, SL(6), rb, SL(1), cb, r32, hi);
        rw_mm(aNkr, SL(6), rb, SL(7), cb, r32, hi);
        __syncthreads();
        rw_stT(SL(0), aD1, rb, cb, r32, hi);
        rw_stT(SL(3), aNkr, rb, cb, r32, hi);
        __syncthreads();
    }
    {
        f32x16 aQ; rw_zero(aQ);
        rw_mm(aQ, SL(0), rb, SL(5), cb, r32, hi);
        float* dst = P.QT + (((size_t)u * 2 + cb) * 2 + rb) * 1024 + lane * 4;
#pragma unroll
        for (int g = 0; g < 4; ++g) {
            const float4 lam = *(const float4*)(P.LAM + (size_t)u * 64 + 32 * rb + 8 * g + 4 * hi);
            *(float4*)(dst + g * 256) = make_float4(aQ[4 * g] * lam.x, aQ[4 * g + 1] * lam.y, aQ[4 * g + 2] * lam.z, aQ[4 * g + 3] * lam.w);
        }
    }
    {
        f32x16 aO; rw_zero(aO);
        rw_mm(aO, SL(5), rb, SL(3), cb, r32, hi);
        float* dst = P.OL + (((size_t)u * 2 + cb) * 2 + rb) * 1024 + lane * 4;
#pragma unroll
        for (int g = 0; g < 4; ++g) *(float4*)(dst + g * 256) = make_float4(aO[4 * g], aO[4 * g + 1], aO[4 * g + 2], aO[4 * g + 3]);
    }
#undef SL
}

DEVI void rw_r3(const RwP& P, int b, int h, int vb, int lane) {
    f32x16 st[2]; rw_zero(st[0]); rw_zero(st[1]);
#pragma unroll 1
    for (int c = 0; c < SEQ / 64; ++c) {
        const size_t u = ((size_t)b * (SEQ / 64) + c) * 4 + h;
        v4u sf[2][2];
        rw_frags(sf[0][0], sf[0][1], st[0]); rw_frags(sf[1][0], sf[1][1], st[1]);
        v4u* sdst = P.SF + ((u * 2 + vb) * 4) * 64 + lane;
        sdst[0] = sf[0][0]; sdst[64] = sf[0][1]; sdst[128] = sf[1][0]; sdst[192] = sf[1][1];
        f32x16 nw[2];
#pragma unroll
        for (int kb = 0; kb < 2; ++kb) {
            const float* q = P.QT + ((u * 2 + vb) * 2 + kb) * 1024 + lane * 4;
#pragma unroll
            for (int g = 0; g < 4; ++g) { const float4 v = *(const float4*)(q + g * 256); nw[kb][4 * g] = v.x; nw[kb][4 * g + 1] = v.y; nw[kb][4 * g + 2] = v.z; nw[kb][4 * g + 3] = v.w; }
            const v4u* pf = P.PF + (((u * 2 + kb) * 2) * 2) * 64 + lane;
#pragma unroll
            for (int ki = 0; ki < 2; ++ki)
#pragma unroll
                for (int s = 0; s < 2; ++s)
                    nw[kb] = __builtin_amdgcn_mfma_f32_32x32x16_bf16(__builtin_bit_cast(bf16x8, pf[(ki * 2 + s) * 64]), __builtin_bit_cast(bf16x8, sf[ki][s]), nw[kb], 0, 0, 0);
        }
        st[0] = nw[0]; st[1] = nw[1];
    }
}

DEVI void rw_r4(const RwP& P, int u, int tb, int lane) {
    const int c = u >> 2, h = u & 3, r32 = lane & 31, hi = lane >> 5;
    f32x16 o[2];
#pragma unroll
    for (int vb = 0; vb < 2; ++vb) {
        const float* ol = P.OL + (((size_t)u * 2 + tb) * 2 + vb) * 1024 + lane * 4;
#pragma unroll
        for (int g = 0; g < 4; ++g) { const float4 v = *(const float4*)(ol + g * 256); o[vb][4 * g] = v.x; o[vb][4 * g + 1] = v.y; o[vb][4 * g + 2] = v.z; o[vb][4 * g + 3] = v.w; }
        const v4u* sf = P.SF + (((size_t)u * 2 + vb) * 4) * 64 + lane;
        const v4u* hf = P.HF + ((((size_t)u * 2 + tb) * 2) * 2) * 64 + lane;
#pragma unroll
        for (int kb = 0; kb < 2; ++kb)
#pragma unroll
            for (int s = 0; s < 2; ++s)
                o[vb] = __builtin_amdgcn_mfma_f32_32x32x16_bf16(__builtin_bit_cast(bf16x8, sf[(kb * 2 + s) * 64]), __builtin_bit_cast(bf16x8, hf[(kb * 2 + s) * 64]), o[vb], 0, 0, 0);
    }
    float sum = 0.f;
#pragma unroll
    for (int r = 0; r < 16; ++r) sum += o[0][r] + o[1][r];
    sum += __shfl_xor(sum, 32, 64);
    const float mean = sum * (1.f / 64.f);
    float q = 0.f;
#pragma unroll
    for (int r = 0; r < 16; ++r) { const float d0 = o[0][r] - mean, d1 = o[1][r] - mean; q += d0 * d0 + d1 * d1; }
    q += __shfl_xor(q, 32, 64);
    const float rstd = rsqrtf(q * (1.f / 64.f) + 64e-5f);
    const size_t tok = (size_t)c * 64 + 32 * tb + r32;
#pragma unroll
    for (int vb = 0; vb < 2; ++vb)
#pragma unroll
        for (int g = 0; g < 4; ++g) {
            const int ch = h * 64 + 32 * vb + 8 * g + 4 * hi;
            const float4 gg = *(const float4*)(P.gn_g + ch), gb = *(const float4*)(P.gn_b + ch);
            const float4 bo = ld4bf(P.BON + tok * 256 + ch), gt = ld4bf(P.G + tok * 256 + ch);
            const float y0 = ((o[vb][4 * g] - mean) * rstd * gg.x + gb.x + bo.x) * gt.x;
            const float y1 = ((o[vb][4 * g + 1] - mean) * rstd * gg.y + gb.y + bo.y) * gt.y;
            const float y2 = ((o[vb][4 * g + 2] - mean) * rstd * gg.z + gb.z + bo.z) * gt.z;
            const float y3 = ((o[vb][4 * g + 3] - mean) * rstd * gg.w + gb.w + bo.w) * gt.w;
            *(uint2*)(P.MIX + tok * DM + 256 + ch) = make_uint2(cvtpk(y0, y1), cvtpk(y2, y3));
        }
}
namespace pg8 {
struct XaOrder {
    int G, c;
    __device__ __forceinline__ bool next(int i, Unit& u) const {
        const int L = i * G + c; if (L >= 256) return false;
        u.pm = L >> 2; u.pn = ((L >> 2) >> 5) * 4 + (L & 3); return true;
    }
    __device__ __forceinline__ void a_ready(const Unit&) const {}
    __device__ __forceinline__ void done(const Unit&) const {}
};
struct MoeOrder {
    const int* tile_e; const int* nrt; int G, c;
    __device__ __forceinline__ bool next(int i, Unit& u) const {
        const int L = i * G + c; if (L >= 4 * (*nrt)) return false;
        u.pm = L >> 2; u.pn = tile_e[L >> 2] * 4 + (L & 3); return true;
    }
    __device__ __forceinline__ void a_ready(const Unit&) const {}
    __device__ __forceinline__ void done(const Unit&) const {}
};
#define PG8_EBAR() do { asm volatile("s_waitcnt lgkmcnt(0)" ::: "memory"); __builtin_amdgcn_s_barrier(); asm volatile("" ::: "memory"); } while (0)
struct EpiSoftmaxP {
    static constexpr bool PERM = true, AFTER_DRAIN = true;
    bf16_t* P;
    __device__ __forceinline__ void fused(f32x4 (&acc)[2][2][4][2], const Unit& u, int wr, int wc, int fr, int fq, PG8_LAS unsigned char* lds, int wid, int lane) const {
        PG8_LAS float* RM = (PG8_LAS float*)lds;
        PG8_LAS float* RS = RM + 1024;
#pragma unroll
        for (int ai = 0; ai < 2; ++ai)
#pragma unroll
            for (int m = 0; m < 4; ++m) {
                float mx = -INFINITY;
#pragma unroll
                for (int bj = 0; bj < 2; ++bj)
#pragma unroll
                    for (int n = 0; n < 2; ++n) { const f32x4 x = acc[ai][bj][m][n]; mx = fmaxf(mx, fmaxf(fmaxf(x[0], x[1]), fmaxf(x[2], x[3]))); }
                mx = fmaxf(mx, __shfl_xor(mx, 16)); mx = fmaxf(mx, __shfl_xor(mx, 32));
                if (fq == 0) RM[(ai * HALF + wr * 64 + m * 16 + fr) * 4 + wc] = mx;
            }
        PG8_EBAR();
#pragma unroll
        for (int ai = 0; ai < 2; ++ai)
#pragma unroll
            for (int m = 0; m < 4; ++m) {
                const int row = ai * HALF + wr * 64 + m * 16 + fr;
                const float gm = fmaxf(fmaxf(RM[row * 4 + 0], RM[row * 4 + 1]), fmaxf(RM[row * 4 + 2], RM[row * 4 + 3]));
                float s = 0.f;
#pragma unroll
                for (int bj = 0; bj < 2; ++bj)
#pragma unroll
                    for (int n = 0; n < 2; ++n) { f32x4 x = acc[ai][bj][m][n];
                        x[0] = __builtin_amdgcn_exp2f(x[0] - gm); x[1] = __builtin_amdgcn_exp2f(x[1] - gm); x[2] = __builtin_amdgcn_exp2f(x[2] - gm); x[3] = __builtin_amdgcn_exp2f(x[3] - gm);
                        s += (x[0] + x[1]) + (x[2] + x[3]); acc[ai][bj][m][n] = x; }
                s += __shfl_xor(s, 16); s += __shfl_xor(s, 32);
                if (fq == 0) RS[row * 4 + wc] = s;
            }
        PG8_EBAR();
        const int colb = (u.pn & 3) * BM + wc * 32 + 8 * fq;
#pragma unroll
        for (int ai = 0; ai < 2; ++ai)
#pragma unroll
            for (int m = 0; m < 4; ++m) {
                const int row = ai * HALF + wr * 64 + m * 16 + fr;
                const float inv = 1.0f / ((RS[row * 4 + 0] + RS[row * 4 + 1]) + (RS[row * 4 + 2] + RS[row * 4 + 3]));
                bf16_t* rowp = P + (size_t)(u.pm * BM + row) * 1024 + colb;
#pragma unroll
                for (int bj = 0; bj < 2; ++bj) { const f32x4 v0 = acc[ai][bj][m][0] * inv, v1 = acc[ai][bj][m][1] * inv;
                    u32x4 w; w.x = cvt_pk_bf16(v0[0], v0[1]); w.y = cvt_pk_bf16(v0[2], v0[3]); w.z = cvt_pk_bf16(v1[0], v1[1]); w.w = cvt_pk_bf16(v1[2], v1[3]);
                    *(u32x4*)(rowp + bj * HALF) = w; }
            }
        PG8_EBAR();
    }
};
struct EpiF32N4 {
    static constexpr bool PERM = false, AFTER_DRAIN = false;
    float* C; int ldc;
    __device__ __forceinline__ void operator()(const f32x4 (&acc)[2][2][4][2], const Unit& u, int wr, int wc, int fr, int fq) const {
        const int row0 = u.pm * BM + wr * 64 + fr, col0 = (u.pn & 3) * BM + wc * 32 + 4 * fq;
#pragma unroll
        for (int ai = 0; ai < 2; ++ai)
#pragma unroll
            for (int m = 0; m < 4; ++m) { float* rowp = C + (size_t)(row0 + ai * HALF + m * 16) * ldc + col0;
#pragma unroll
                for (int bj = 0; bj < 2; ++bj)
#pragma unroll
                    for (int n = 0; n < 2; ++n) *(f32x4*)(rowp + bj * HALF + n * 16) = acc[ai][bj][m][n]; }
    }
};
struct EpiBf16N4 {
    static constexpr bool PERM = true, AFTER_DRAIN = false;
    bf16_t* O; int ldc;
    __device__ __forceinline__ void operator()(const f32x4 (&acc)[2][2][4][2], const Unit& u, int wr, int wc, int fr, int fq) const {
        const int row0 = u.pm * BM + wr * 64 + fr, col0 = (u.pn & 3) * BM + wc * 32 + 8 * fq;
#pragma unroll
        for (int ai = 0; ai < 2; ++ai)
#pragma unroll
            for (int m = 0; m < 4; ++m) { bf16_t* rowp = O + (size_t)(row0 + ai * HALF + m * 16) * ldc + col0;
#pragma unroll
                for (int bj = 0; bj < 2; ++bj) { const f32x4 v0 = acc[ai][bj][m][0], v1 = acc[ai][bj][m][1];
                    u32x4 w; w.x = cvt_pk_bf16(v0[0], v0[1]); w.y = cvt_pk_bf16(v0[2], v0[3]); w.z = cvt_pk_bf16(v1[0], v1[1]); w.w = cvt_pk_bf16(v1[2], v1[3]);
                    *(u32x4*)(rowp + bj * HALF) = w; } }
    }
};
struct EpiSiluMul {
    static constexpr bool PERM = true, AFTER_DRAIN = false;
    bf16_t* H;
    __device__ __forceinline__ void operator()(const f32x4 (&acc)[2][2][4][2], const Unit& u, int wr, int wc, int fr, int fq) const {
        const int row0 = u.pm * BM + wr * 64 + fr, col0 = (u.pn & 3) * HALF + wc * 32 + 8 * fq;
#pragma unroll
        for (int ai = 0; ai < 2; ++ai)
#pragma unroll
            for (int m = 0; m < 4; ++m) {
                float h[8];
#pragma unroll
                for (int n = 0; n < 2; ++n)
#pragma unroll
                    for (int e = 0; e < 4; ++e) { const float g = acc[ai][0][m][n][e], up = acc[ai][1][m][n][e];
                        h[4 * n + e] = g * __builtin_amdgcn_rcpf(1.0f + __expf(-g)) * up; }
                u32x4 w; w.x = cvt_pk_bf16(h[0], h[1]); w.y = cvt_pk_bf16(h[2], h[3]); w.z = cvt_pk_bf16(h[4], h[5]); w.w = cvt_pk_bf16(h[6], h[7]);
                *(u32x4*)(H + (size_t)(row0 + ai * HALF + m * 16) * 512 + col0) = w;
            }
    }
};

struct OneUnit {
    int pm, pn, valid;
    __device__ __forceinline__ bool next(int i, Unit& u) const { if (i != 0 || !valid) return false; u.pm = pm; u.pn = pn; return true; }
    __device__ __forceinline__ void a_ready(const Unit&) const {}
    __device__ __forceinline__ void done(const Unit&) const {}
};
struct EpiBf16S {
    static constexpr bool PERM = true, AFTER_DRAIN = false;
    bf16_t* O; int ldc; float scale;
    __device__ __forceinline__ void operator()(const f32x4 (&acc)[2][2][4][2], const Unit& u, int wr, int wc, int fr, int fq) const {
        const int row0 = u.pm * BM + wr * 64 + fr, col0 = u.pn * BM + wc * 32 + 8 * fq;
#pragma unroll
        for (int ai = 0; ai < 2; ++ai)
#pragma unroll
            for (int m = 0; m < 4; ++m) { bf16_t* rowp = O + (size_t)(row0 + ai * HALF + m * 16) * ldc + col0;
#pragma unroll
                for (int bj = 0; bj < 2; ++bj) { const f32x4 v0 = acc[ai][bj][m][0] * scale, v1 = acc[ai][bj][m][1] * scale;
                    u32x4 w; w.x = cvt_pk_bf16(v0[0], v0[1]); w.y = cvt_pk_bf16(v0[2], v0[3]); w.z = cvt_pk_bf16(v1[0], v1[1]); w.w = cvt_pk_bf16(v1[2], v1[3]);
                    *(u32x4*)(rowp + bj * HALF) = w; } }
    }
};
struct EpiGeluF32 {
    static constexpr bool PERM = false, AFTER_DRAIN = false;
    float* C; int ldc;
    __device__ __forceinline__ void operator()(const f32x4 (&acc)[2][2][4][2], const Unit& u, int wr, int wc, int fr, int fq) const {
        const int row0 = u.pm * BM + wr * 64 + fr, col0 = u.pn * BM + wc * 32 + 4 * fq;
#pragma unroll
        for (int ai = 0; ai < 2; ++ai)
#pragma unroll
            for (int m = 0; m < 4; ++m) { float* rowp = C + (size_t)(row0 + ai * HALF + m * 16) * ldc + col0;
#pragma unroll
                for (int bj = 0; bj < 2; ++bj)
#pragma unroll
                    for (int n = 0; n < 2; ++n) { f32x4 x = acc[ai][bj][m][n];
#pragma unroll
                        for (int e = 0; e < 4; ++e) x[e] = 0.5f * x[e] * (1.f + tanhf(0.7978845608028654f * (x[e] + 0.044715f * x[e] * x[e] * x[e])));
                        *(f32x4*)(rowp + bj * HALF + n * 16) = x; } }
    }
};
}

DEVI void tr_blk(const float* W, size_t ldw, int N, int k0, int n0, bf16* WT, size_t ldt, int drow0, float scale, LAS float* scr, int lane) {
    const int n_ = n0 + (lane & 31);
#pragma unroll 8
    for (int i = 0; i < 32; ++i) { const int kk = 2 * i + (lane >> 5); scr[kk * 33 + (lane & 31)] = n_ < N ? W[(size_t)(k0 + kk) * ldw + n_] * scale : 0.f; }
    LDS_WAIT(); asm volatile("" ::: "memory");
    const int c = lane & 7;
#pragma unroll
    for (int j = 0; j < 4; ++j) { const int n = (lane >> 3) + 8 * j; const LAS float* s = scr + (8 * c) * 33 + n;
        v4u o; o.x = pk2(s[0 * 33], s[1 * 33]); o.y = pk2(s[2 * 33], s[3 * 33]); o.z = pk2(s[4 * 33], s[5 * 33]); o.w = pk2(s[6 * 33], s[7 * 33]);
        *(GAS v4u*)(WT + (size_t)(drow0 + n) * ldt + k0 + 8 * c) = o; }
    LDS_WAIT(); asm volatile("" ::: "memory");
}
DEVI void cvt_bf16(const float* __restrict__ src, bf16* __restrict__ dst, size_t n, float scale, int B0, int G) {
    for (size_t i = ((size_t)B0 * 512 + tidx()) * 4; i < n; i += (size_t)G * 512 * 4) {
        const float4 v = *(const float4*)(src + i);
        *(uint2*)(dst + i) = make_uint2(pk2(v.x * scale, v.y * scale), pk2(v.z * scale, v.w * scale));
    }
}

DEVI void moe_lists2(const int* __restrict__ te, int* __restrict__ off, int* __restrict__ nrt, int* __restrict__ tile_e, int* __restrict__ list,
                     int* __restrict__ slotpos, float* sm0) {
    int* cnt = (int*)sm0;
    int* offs = cnt + 16;
    const int w = tidx() >> 6, lane = tidx() & 63;
    __syncthreads();
    for (int ee = 0; ee < 2; ++ee) {
        const int e = w * 2 + ee;
        int c = 0;
        for (int base = 0; base < NTOK; base += 64) {
            const int tok = base + lane;
            const bool m = (te[tok * 2] == e) || (te[tok * 2 + 1] == e);
            c += __popcll(__ballot(m));
        }
        if (lane == 0) cnt[e] = c;
    }
    __syncthreads();
    if (tidx() == 0) {
        int s = 0;
#pragma unroll 1
        for (int i = 0; i < 16; ++i) { offs[i] = s; off[i] = s; const int pc = (cnt[i] + 255) & ~255;
#pragma unroll 1
            for (int r = s / 256; r < (s + pc) / 256; ++r) tile_e[r] = i;
            s += pc; }
        offs[16] = s; off[16] = s; *nrt = s / 256;
    }
    __syncthreads();
    for (int ee = 0; ee < 2; ++ee) {
        const int e = w * 2 + ee;
        int pos = offs[e];
        for (int base = 0; base < NTOK; base += 64) {
            const int tok = base + lane;
            const int a = te[tok * 2], b = te[tok * 2 + 1];
            const bool m = (a == e) || (b == e);
            const unsigned long long mask = __ballot(m);
            if (m) {
                const int p = pos + __popcll(mask & ((1ull << lane) - 1ull));
                list[p] = tok;
                slotpos[tok * 2 + (a == e ? 0 : 1)] = p;
            }
            pos += __popcll(mask);
        }
        for (int p = pos + lane; p < offs[e + 1]; p += 64) list[p] = -1;
    }
    __syncthreads();
}
DEVI void moe_gather(const bf16* __restrict__ xn, const int* __restrict__ list, const int* __restrict__ off, bf16* __restrict__ xg, int B0, int G) {
    const int total = off[16];
    const int gw = B0 * NWAVES + (tidx() >> 6), lane = tidx() & 63;
    for (int p = gw; p < total; p += G * NWAVES) {
        const int tok = list[p];
        v4u a = (v4u){0u, 0u, 0u, 0u}, b = a;
        if (tok >= 0) { const v4u* s = (const v4u*)(xn + (size_t)tok * DM); a = s[lane]; b = s[lane + 64]; }
        v4u* d = (v4u*)(xg + (size_t)p * DM); d[lane] = a; d[lane + 64] = b;
    }
}
DEVI void moe_combine_ln2(const float* x, const bf16* __restrict__ Dp, const int* __restrict__ te,
                          const float* __restrict__ tw, const int* __restrict__ slotpos,
                          const float* __restrict__ g, const float* __restrict__ bt, float* out, bf16* outb, int bid, float* sm) {
    __syncthreads();
    const size_t t = bid; const int tid = tidx() & 255;
    int ea = te[t * 2], eb = te[t * 2 + 1];
    float wa = tw[t * 2], wb = tw[t * 2 + 1];
    size_t pa = slotpos[t * 2], pb = slotpos[t * 2 + 1];
    if (eb < ea) { const float tf = wa; wa = wb; wb = tf; const size_t tp = pa; pa = pb; pb = tp; }
    float v[4];
#pragma unroll
    for (int i = 0; i < 4; ++i) {
        const int c = tid + i * 256;
        float y = wa * bf2f(Dp[pa * DM + c]);
        y = y + wb * bf2f(Dp[pb * DM + c]);
        v[i] = ALPHA * x[t * DM + c] + y;
    }
    const float mean = block_sum256(v[0] + v[1] + v[2] + v[3], sm, tid) * (1.f / DM);
    float q = 0.f;
#pragma unroll
    for (int i = 0; i < 4; ++i) { v[i] -= mean; q += v[i] * v[i]; }
    const float var = block_sum256(q, sm, tid) * (1.f / DM);
    const float rstd = rsqrtf(var + 1e-5f);
#pragma unroll
    for (int i = 0; i < 4; ++i) {
        const int c = tid + i * 256;
        const float o = v[i] * rstd * g[c] + bt[c];
        out[t * DM + c] = o;
        outb[t * DM + c] = (bf16)f2bf(o);
    }
}
struct MixP {
    const bf16* COLS;
    const float *conv_w, *conv_b, *conv_gg, *conv_gb;
    const float *gl_g, *gl_b;
    const float *mu, *w0, *a0, *k_k, *k_a, *r_k, *v_mu, *v0;
    const bf16 *WUP_T, *AUP_T, *GUP_T, *VUP_T;
    const float *pe_k, *pe_v;
    bf16 *MIX, *UB, *VB;
    bf16 *AT, *BT, *KT, *RT, *V, *G, *BON, *VFIRST;
    float* LAM;
    bf16 *QN, *QR, *KSR, *KWR, *VST, *VWT;
    float* GATES;
    bf16 *BLK, *BLV;
    int layer, pad;
};
DEVI float4 ld4bf(const bf16* p) { const uint2 w = *(const uint2*)p; return make_float4(__builtin_bit_cast(float, w.x << 16), __builtin_bit_cast(float, w.x & 0xffff0000u), __builtin_bit_cast(float, w.y << 16), __builtin_bit_cast(float, w.y & 0xffff0000u)); }
DEVI void st4bf(bf16* p, float a, float b, float c, float d) { *(uint2*)p = make_uint2(cvtpk(a, b), cvtpk(c, d)); }
DEVI float fsig(float x) { return __builtin_amdgcn_rcpf(1.f + __expf(-x)); }
DEVI float ftanh(float x) { const float e = __expf(-2.f * fabsf(x)); const float t = (1.f - e) * __builtin_amdgcn_rcpf(1.f + e); return x < 0.f ? -t : t; }
DEVI float fgelu(float x) { return 0.5f * x * (1.f + ftanh(0.7978845608028654f * (x + 0.044715f * x * x * x))); }

DEVI void prep_unit(const MixP& P, int cg, LAS unsigned char* lds) {
    const int tid = tidx(), w = tid >> 6, lane = tid & 63;
    const int b = cg >> 7, pos0 = (cg & 127) * 64;
    const size_t tok0 = (size_t)cg * 64;
    const bf16* cols = P.COLS + tok0 * DINP;
    {
        LAS float* hb = (LAS float*)lds;
        __syncthreads();
        for (int e = tid; e < 94 * 64; e += 512) {
            const int row = e >> 6, c4 = (e & 63) * 4, tt = row - 30;
            float4 h = make_float4(0.f, 0.f, 0.f, 0.f);
            if (pos0 + tt >= 0) {
                const bf16* cr = cols + (long)tt * DINP;
                const float4 v = ld4bf(cr + OFF_CV + c4), g = ld4bf(cr + OFF_CG + c4);
                h = make_float4(v.x * fsig(g.x), v.y * fsig(g.y), v.z * fsig(g.z), v.w * fsig(g.w));
            }
            { typedef float f32x4v __attribute__((ext_vector_type(4))); *(LAS f32x4v*)(hb + row * 256 + c4) = (f32x4v){h.x, h.y, h.z, h.w}; }
        }
        __syncthreads();
        const int c = tid & 255, half = tid >> 8;
        float wj[31];
#pragma unroll
        for (int j = 0; j < 31; ++j) wj[j] = P.conv_w[j * 256 + c];
        const float bias = P.conv_b[c], gg = P.conv_gg[c], gb = P.conv_gb[c];
#pragma unroll 1
        for (int q = 0; q < 4; ++q) {
            float xs[38];
            const int tb = 32 * half + 8 * q;
#pragma unroll
            for (int i = 0; i < 38; ++i) xs[i] = hb[(tb + i) * 256 + c];
#pragma unroll
            for (int t = 0; t < 8; ++t) {
                float acc = bias;
#pragma unroll
                for (int j = 0; j < 31; ++j) acc = fmaf(wj[j], xs[t + j], acc);
                const float mean = wave_sum(acc) * (1.f / 64.f);
                const float d = acc - mean;
                const float var = wave_sum(d * d) * (1.f / 64.f);
                const float y = d * rsqrtf(var + 1e-5f) * gg + gb;
                P.MIX[(tok0 + tb + t) * DM + c] = (bf16)f2bf(y * fsig(y));
            }
        }
    }
    {
        const float4 lg = *(const float4*)(P.gl_g + lane * 4), lb = *(const float4*)(P.gl_b + lane * 4);
#pragma unroll 2
        for (int i = 0; i < 8; ++i) {
            const int t = w * 8 + i; const bf16* cr = cols + (size_t)t * DINP;
            const float4 u = ld4bf(cr + OFF_GU + lane * 4);
            st4bf(P.UB + (tok0 + t) * 256 + lane * 4, fgelu(u.x), fgelu(u.y), fgelu(u.z), fgelu(u.w));
            float4 v = ld4bf(cr + OFF_GV + lane * 4);
            v = make_float4(fgelu(v.x), fgelu(v.y), fgelu(v.z), fgelu(v.w));
            const float mean = wave_sum((v.x + v.y) + (v.z + v.w)) * (1.f / 256.f);
            v.x -= mean; v.y -= mean; v.z -= mean; v.w -= mean;
            const float var = wave_sum((v.x * v.x + v.y * v.y) + (v.z * v.z + v.w * v.w)) * (1.f / 256.f);
            const float rs = rsqrtf(var + 1e-5f);
            st4bf(P.VB + (tok0 + t) * 256 + lane * 4, v.x * rs * lg.x + lb.x, v.y * rs * lg.y + lb.y, v.z * rs * lg.z + lb.z, v.w * rs * lg.w + lb.w);
        }
    }
    {
        LAS float* cst = (LAS float*)lds;
        LAS unsigned short* vt = (LAS unsigned short*)(lds + 16384);
        __syncthreads();
        for (int e = tid; e < 2048; e += 512) {
            const int t = e >> 5, j = e & 31;
            const float inv = powf(10000.f, -(float)j / 32.f);
            float sn, cs; sincosf((float)(pos0 + t) * inv, &sn, &cs);
            cst[e * 2] = cs; cst[e * 2 + 1] = sn;
        }
        __syncthreads();
#pragma unroll 1
        for (int i = 0; i < 8; ++i) {
            const int t = w * 8 + i; const bf16* cr = cols + (size_t)t * DINP; const size_t tok = tok0 + t;
            {
                const int d4 = (lane & 15) * 4;
                const float4 x = ld4bf(cr + OFF_Q + lane * 4);
                const float4 pr = make_float4(__shfl_xor(x.x, 8, 64), __shfl_xor(x.y, 8, 64), __shfl_xor(x.z, 8, 64), __shfl_xor(x.w, 8, 64));
                const LAS float* cp = cst + (t * 32 + (d4 & 31)) * 2;
                const float sg = d4 < 32 ? -1.f : 1.f;
                st4bf(P.QN + tok * 256 + lane * 4, x.x * QSCL, x.y * QSCL, x.z * QSCL, x.w * QSCL);
                st4bf(P.QR + tok * 256 + lane * 4, (x.x * cp[0] + sg * pr.x * cp[1]) * QSCL, (x.y * cp[2] + sg * pr.y * cp[3]) * QSCL,
                      (x.z * cp[4] + sg * pr.z * cp[5]) * QSCL, (x.w * cp[6] + sg * pr.w * cp[7]) * QSCL);
            }
            {
                const int seg = lane >> 4, d4 = (lane & 15) * 4;
                const float4 x = ld4bf(cr + OFF_KS + seg * 64 + d4);
                const float4 pr = make_float4(__shfl_xor(x.x, 8, 64), __shfl_xor(x.y, 8, 64), __shfl_xor(x.z, 8, 64), __shfl_xor(x.w, 8, 64));
                if ((seg & 1) == 0) {
                    const LAS float* cp = cst + (t * 32 + (d4 & 31)) * 2;
                    const float sg = d4 < 32 ? -1.f : 1.f;
                    bf16* dst = (seg == 0 ? P.KSR : P.KWR) + tok * 64 + d4;
                    st4bf(dst, x.x * cp[0] + sg * pr.x * cp[1], x.y * cp[2] + sg * pr.y * cp[3], x.z * cp[4] + sg * pr.z * cp[5], x.w * cp[6] + sg * pr.w * cp[7]);
                } else {
                    LAS unsigned short* vp = vt + (seg >> 1) * 4096 + d4 * 64 + t;
                    vp[0] = (unsigned short)f2bf(x.x); vp[64] = (unsigned short)f2bf(x.y); vp[128] = (unsigned short)f2bf(x.z); vp[192] = (unsigned short)f2bf(x.w);
                }
            }
            if (lane < 12) P.GATES[tok * 12 + lane] = fsig(bf2f(cr[OFF_GT + lane]));
        }
        __syncthreads();
        for (int e = tid; e < 1024; e += 512) {
            const int which = e >> 9, d = (e >> 3) & 63, ch = e & 7;
            const v4u v = *(const LAS v4u*)((LAS unsigned char*)vt + which * 8192 + d * 128 + ch * 16);
            *(v4u*)((which ? P.VWT : P.VST) + ((size_t)b * 64 + d) * SEQ + pos0 + ch * 8) = v;
        }
        for (int e = tid; e < 4 * 512 * 2; e += 512) {
            const int isv = e >> 11, r = e & 2047, nl = r >> 9, i4 = (r & 511) * 4, l = i4 >> 6, d = i4 & 63;
            const int n = 4 * (cg & 127) + nl;
            bf16* dst = (isv ? P.BLV : P.BLK) + ((size_t)b * 512 + n) * 2048 + i4;
            if (n < NCMP) {
                const float4 x = ld4bf(cols + (size_t)(16 * nl + l) * DINP + (isv ? OFF_VC : OFF_KC) + d);
                const float4 pe = *(const float4*)((isv ? P.pe_v : P.pe_k) + i4);
                st4bf(dst, x.x + pe.x, x.y + pe.y, x.z + pe.z, x.w + pe.w);
            } else *(uint2*)dst = make_uint2(0u, 0u);
        }
    }
    {
        LAS unsigned char* TW = lds;
        LAS unsigned char* AD = lds + 8192;
        LAS unsigned char* SG = lds + 16384;
        LAS unsigned char* VD = lds + 32768;
        LAS float* CAR = (LAS float*)(lds + 36864);
        __syncthreads();
        for (int e = tid; e < 64 * 64; e += 512) {
            const int t = e >> 6, j4 = (e & 63) * 4;
            const bf16* cr = cols + (size_t)t * DINP + OFF_RW + 768 + j4;
            const float4 c4 = ld4bf(cr);
            float4 p4 = make_float4(0.f, 0.f, 0.f, 0.f);
            if (pos0 + t > 0) p4 = ld4bf(cr - DINP);
            const float4 m4 = *(const float4*)(P.mu + 768 + j4);
            float y0 = c4.x + m4.x * (p4.x - c4.x), y1 = c4.y + m4.y * (p4.y - c4.y), y2 = c4.z + m4.z * (p4.z - c4.z), y3 = c4.w + m4.w * (p4.w - c4.w);
            if (j4 < 64) { y0 = ftanh(y0); y1 = ftanh(y1); y2 = ftanh(y2); y3 = ftanh(y3);
                *(LAS u32x2v*)(TW + rw_off(t, j4 >> 3) + (j4 & 7) * 2) = (u32x2v){cvtpk(y0, y1), cvtpk(y2, y3)}; }
            else if (j4 < 128) { const int jj = j4 - 64;
                *(LAS u32x2v*)(AD + rw_off(t, jj >> 3) + (jj & 7) * 2) = (u32x2v){cvtpk(y0, y1), cvtpk(y2, y3)}; }
            else { const int jj = j4 - 128; y0 = fsig(y0); y1 = fsig(y1); y2 = fsig(y2); y3 = fsig(y3);
                *(LAS u32x2v*)(SG + t * 256 + (((jj >> 3) ^ (t & 7)) << 4) + (jj & 7) * 2) = (u32x2v){cvtpk(y0, y1), cvtpk(y2, y3)}; }
        }
        if (P.layer > 0) {
            const int t = tid >> 3, j4 = (tid & 7) * 4;
            const bf16* cr = cols + (size_t)t * DINP + DIN + j4;
            const float4 c4 = ld4bf(cr);
            float4 p4 = make_float4(0.f, 0.f, 0.f, 0.f);
            if (pos0 + t > 0) p4 = ld4bf(cr - DINP);
            const float4 m4 = *(const float4*)(P.v_mu + j4);
            *(LAS u32x2v*)(VD + t * 64 + j4 * 2) = (u32x2v){cvtpk(c4.x + m4.x * (p4.x - c4.x), c4.y + m4.y * (p4.y - c4.y)), cvtpk(c4.z + m4.z * (p4.z - c4.z), c4.w + m4.w * (p4.w - c4.w))};
        }
        __syncthreads();
        const int h = w >> 1, tb = w & 1, r32 = lane & 31, hi = lane >> 5;
        const int t = 32 * tb + r32;
        const size_t tok = tok0 + t;
        const bool hasprev = (pos0 + t) > 0;
        const bf16* crow_ = cols + (size_t)t * DINP + OFF_RW;
        float n2 = 0.f, bd = 0.f;
#pragma unroll 1
        for (int cb = 0; cb < 2; ++cb) {
            f32x16 al; rw_zero(al);
            const bf16* arow = P.AUP_T + (size_t)(h * 64 + 32 * cb + r32) * 64 + 8 * hi;
#pragma unroll
            for (int s = 0; s < 4; ++s) al = __builtin_amdgcn_mfma_f32_32x32x16_bf16(*(const bf16x8*)(arow + 16 * s), rw_frag(AD, tb, s, r32, hi), al, 0, 0, 0);
#pragma unroll
            for (int g = 0; g < 4; ++g) {
                const int ch = h * 64 + 32 * cb + 8 * g + 4 * hi;
                const float4 rc = ld4bf(crow_ + ch), kc = ld4bf(crow_ + 256 + ch);
                float4 rp = make_float4(0.f, 0.f, 0.f, 0.f), kp = rp;
                if (hasprev) { rp = ld4bf(crow_ - DINP + ch); kp = ld4bf(crow_ - DINP + 256 + ch); }
                const float4 mr = *(const float4*)(P.mu + ch), mk = *(const float4*)(P.mu + 256 + ch);
                const float4 a0 = *(const float4*)(P.a0 + ch), kk_ = *(const float4*)(P.k_k + ch), ka = *(const float4*)(P.k_a + ch), rk = *(const float4*)(P.r_k + ch);
                const float rr[4] = {rc.x + mr.x * (rp.x - rc.x), rc.y + mr.y * (rp.y - rc.y), rc.z + mr.z * (rp.z - rc.z), rc.w + mr.w * (rp.w - rc.w)};
                const float kv[4] = {kc.x + mk.x * (kp.x - kc.x), kc.y + mk.y * (kp.y - kc.y), kc.z + mk.z * (kp.z - kc.z), kc.w + mk.w * (kp.w - kc.w)};
                const float a0v[4] = {a0.x, a0.y, a0.z, a0.w}, kkv[4] = {kk_.x, kk_.y, kk_.z, kk_.w}, kav[4] = {ka.x, ka.y, ka.z, ka.w}, rkv[4] = {rk.x, rk.y, rk.z, rk.w};
#pragma unroll
                for (int e = 0; e < 4; ++e) {
                    const float a = fsig(a0v[e] + al[4 * g + e]);
                    const float kq = kv[e] * kkv[e];
                    n2 = fmaf(kq, kq, n2);
                    bd = fmaf(rr[e] * rkv[e], kv[e] * (1.f + (a - 1.f) * kav[e]), bd);
                }
            }
        }
        n2 += __shfl_xor(n2, 32, 64); bd += __shfl_xor(bd, 32, 64);
        const float rnorm = 1.f / fmaxf(sqrtf(n2), 1e-12f);
        const size_t u = (size_t)cg * 4 + h;
#pragma unroll 1
        for (int cb = 0; cb < 2; ++cb) {
            f32x16 al, wl, gl, vm; rw_zero(al); rw_zero(wl); rw_zero(gl); rw_zero(vm);
            const int chrow = h * 64 + 32 * cb + r32;
            const bf16* arow = P.AUP_T + (size_t)chrow * 64 + 8 * hi;
            const bf16* wrow = P.WUP_T + (size_t)chrow * 64 + 8 * hi;
            const bf16* grow = P.GUP_T + (size_t)chrow * 128 + 8 * hi;
#pragma unroll
            for (int s = 0; s < 4; ++s) {
                al = __builtin_amdgcn_mfma_f32_32x32x16_bf16(*(const bf16x8*)(arow + 16 * s), rw_frag(AD, tb, s, r32, hi), al, 0, 0, 0);
                wl = __builtin_amdgcn_mfma_f32_32x32x16_bf16(*(const bf16x8*)(wrow + 16 * s), rw_frag(TW, tb, s, r32, hi), wl, 0, 0, 0);
            }
#pragma unroll
            for (int s = 0; s < 8; ++s) {
                const bf16x8 bfr = *(const LAS bf16x8*)(SG + t * 256 + (((2 * s + hi) ^ (t & 7)) << 4));
                gl = __builtin_amdgcn_mfma_f32_32x32x16_bf16(*(const bf16x8*)(grow + 16 * s), bfr, gl, 0, 0, 0);
            }
            if (P.layer > 0) {
                const bf16* vrow = P.VUP_T + (size_t)chrow * 32 + 8 * hi;
#pragma unroll
                for (int s = 0; s < 2; ++s) {
                    const bf16x8 bfr = *(const LAS bf16x8*)(VD + t * 64 + (2 * s + hi) * 16);
                    vm = __builtin_amdgcn_mfma_f32_32x32x16_bf16(*(const bf16x8*)(vrow + 16 * s), bfr, vm, 0, 0, 0);
                }
            }
            f32x16 lw, cum;
#pragma unroll
            for (int g = 0; g < 4; ++g) {
                const float4 w0 = *(const float4*)(P.w0 + h * 64 + 32 * cb + 8 * g + 4 * hi);
                const float w0v[4] = {w0.x, w0.y, w0.z, w0.w};
#pragma unroll
                for (int e = 0; e < 4; ++e) {
                    const float x = -(w0v[e] + wl[4 * g + e]);
                    const float sp = fmaxf(x, 0.f) + __logf(1.f + __expf(-fabsf(x)));
                    lw[4 * g + e] = -__expf(-sp - 0.5f);
                }
            }
#pragma unroll
            for (int r = 0; r < 16; ++r) {
                float s = lw[r];
#pragma unroll
                for (int dl = 1; dl < 32; dl <<= 1) { const float o = __shfl_up(s, dl, 32); if (r32 >= dl) s += o; }
                cum[r] = s;
            }
            if (tb == 0 && r32 == 31) {
#pragma unroll
                for (int r = 0; r < 16; ++r) CAR[h * 64 + 32 * cb + crow(r, hi)] = cum[r];
            }
            __syncthreads();
            if (tb == 1) {
#pragma unroll
                for (int r = 0; r < 16; ++r) cum[r] += CAR[h * 64 + 32 * cb + crow(r, hi)];
            }
#pragma unroll
            for (int g = 0; g < 4; ++g) {
                const int cl = 32 * cb + 8 * g + 4 * hi, ch = h * 64 + cl;
                const float4 rc = ld4bf(crow_ + ch), kc = ld4bf(crow_ + 256 + ch), vc = ld4bf(crow_ + 512 + ch);
                float4 rp = make_float4(0.f, 0.f, 0.f, 0.f), kp = rp, vp = rp;
                if (hasprev) { rp = ld4bf(crow_ - DINP + ch); kp = ld4bf(crow_ - DINP + 256 + ch); vp = ld4bf(crow_ - DINP + 512 + ch); }
                const float4 mr = *(const float4*)(P.mu + ch), mk = *(const float4*)(P.mu + 256 + ch), mv = *(const float4*)(P.mu + 512 + ch);
                const float4 a0 = *(const float4*)(P.a0 + ch), kk_ = *(const float4*)(P.k_k + ch), ka = *(const float4*)(P.k_a + ch);
                const float rr[4] = {rc.x + mr.x * (rp.x - rc.x), rc.y + mr.y * (rp.y - rc.y), rc.z + mr.z * (rp.z - rc.z), rc.w + mr.w * (rp.w - rc.w)};
                const float kv[4] = {kc.x + mk.x * (kp.x - kc.x), kc.y + mk.y * (kp.y - kc.y), kc.z + mk.z * (kp.z - kc.z), kc.w + mk.w * (kp.w - kc.w)};
                float vv[4] = {vc.x + mv.x * (vp.x - vc.x), vc.y + mv.y * (vp.y - vc.y), vc.z + mv.z * (vp.z - vc.z), vc.w + mv.w * (vp.w - vc.w)};
                const float a0v[4] = {a0.x, a0.y, a0.z, a0.w}, kkv[4] = {kk_.x, kk_.y, kk_.z, kk_.w}, kav[4] = {ka.x, ka.y, ka.z, ka.w};
                if (P.layer == 0) {
                    st4bf(P.VFIRST + tok * 256 + ch, vv[0], vv[1], vv[2], vv[3]);
                } else {
                    const float4 vf = ld4bf(P.VFIRST + tok * 256 + ch), v0 = *(const float4*)(P.v0 + ch);
                    const float vfv[4] = {vf.x, vf.y, vf.z, vf.w}, v0v[4] = {v0.x, v0.y, v0.z, v0.w};
#pragma unroll
                    for (int e = 0; e < 4; ++e) vv[e] = vv[e] + (vfv[e] - vv[e]) * fsig(v0v[e] + vm[4 * g + e]);
                }
                float at[4], bt[4], kt[4], rt[4], bo[4];
#pragma unroll
                for (int e = 0; e < 4; ++e) {
                    const float a = fsig(a0v[e] + al[4 * g + e]);
                    const float kkn = kv[e] * kkv[e] * rnorm;
                    const float k2 = kv[e] * (1.f + (a - 1.f) * kav[e]);
                    const float cu = cum[4 * g + e];
                    const float ein = __expf(cu), eout = __expf(-cu), eex = __expf(cu - lw[4 * g + e]);
                    at[e] = -kkn * eex; bt[e] = kkn * a * eout; kt[e] = k2 * eout; rt[e] = rr[e] * ein; bo[e] = bd * vv[e];
                    if (t == 63) P.LAM[u * 64 + cl + e] = ein;
                }
                const size_t bo_ = (u * 64 + t) * 64 + cl;
                st4bf(P.AT + bo_, at[0], at[1], at[2], at[3]); st4bf(P.BT + bo_, bt[0], bt[1], bt[2], bt[3]);
                st4bf(P.KT + bo_, kt[0], kt[1], kt[2], kt[3]); st4bf(P.RT + bo_, rt[0], rt[1], rt[2], rt[3]);
                st4bf(P.V + tok * 256 + ch, vv[0], vv[1], vv[2], vv[3]);
                st4bf(P.G + tok * 256 + ch, gl[4 * g], gl[4 * g + 1], gl[4 * g + 2], gl[4 * g + 3]);
                st4bf(P.BON + tok * 256 + ch, bo[0], bo[1], bo[2], bo[3]);
            }
        }
    }
}

DEVI void gmlp_unit(const bf16* __restrict__ UB, const bf16* __restrict__ VB, const bf16* __restrict__ GWS  , const float* __restrict__ bs,
                    bf16* __restrict__ MIX, int c128, LAS unsigned char* lds) {
    const int tid = tidx(), w = tid >> 6, lane = tid & 63, r32 = lane & 31, hi = lane >> 5;
    const size_t T0 = (size_t)c128 * 128;
    __syncthreads();
    for (int e = tid; e < 128 * 32; e += 512) {
        const int s = e >> 5, c8 = (e & 31) * 8;
        const v4u v = *(const v4u*)(VB + (T0 + s) * 256 + c8);
        const unsigned wv[4] = {v.x, v.y, v.z, v.w};
#pragma unroll
        for (int j = 0; j < 8; ++j) { const int ch = c8 + j;
            *(LAS unsigned short*)(lds + ch * 256 + (((s >> 3) ^ (ch & 7)) << 4) + (s & 7) * 2) = (unsigned short)(wv[j >> 1] >> ((j & 1) * 16)); }
    }
    __syncthreads();
    const int h = w & 3, th = w >> 2;
    f32x16 acc[2][2];
#pragma unroll
    for (int i = 0; i < 2; ++i)
#pragma unroll
        for (int j = 0; j < 2; ++j) rw_zero(acc[i][j]);
    const int nks = 4 * (th + 1);
#pragma unroll 1
    for (int s = 0; s < nks; ++s) {
        bf16x8 bfr[2];
#pragma unroll
        for (int cb = 0; cb < 2; ++cb) { const int ch = h * 64 + 32 * cb + r32; bfr[cb] = *(const LAS bf16x8*)(lds + ch * 256 + (((2 * s + hi) ^ (ch & 7)) << 4)); }
#pragma unroll
        for (int rb = 0; rb < 2; ++rb) {
            const bf16x8 afr = *(const bf16x8*)(GWS + ((size_t)h * 128 + 64 * th + 32 * rb + r32) * 128 + 16 * s + 8 * hi);
#pragma unroll
            for (int cb = 0; cb < 2; ++cb) acc[rb][cb] = __builtin_amdgcn_mfma_f32_32x32x16_bf16(afr, bfr[cb], acc[rb][cb], 0, 0, 0);
        }
    }
#pragma unroll
    for (int rb = 0; rb < 2; ++rb)
#pragma unroll
        for (int cb = 0; cb < 2; ++cb)
#pragma unroll
            for (int r = 0; r < 16; ++r) {
                const int tt = 64 * th + 32 * rb + crow(r, hi), ch = h * 64 + 32 * cb + r32;
                const float uu = bf2f(UB[(T0 + tt) * 256 + ch]);
                MIX[(T0 + tt) * DM + 512 + ch] = (bf16)f2bf(uu * (acc[rb][cb][r] + bs[h * 128 + tt]));
            }
}
#ifndef PROBE_MASK
#define PROBE_MASK 0ull
#endif
#define PROBE_N 3
#define REP(id) for (int rep_ = 0; rep_ < (((PROBE_MASK >> (id)) & 1ull) ? 1 + PROBE_N : 1); ++rep_)
struct MP {
    const float* in[50];
    float *X, *TW, *R0;
    bf16 *XN, *MIX, *WIN_T, *WOUT_T, *WQK_T, *VWO_T, *W1_T, *LORA_T, *GWS, *VFIRST;
    int *TE, *SLOT, *LIST, *EOFF;
    unsigned* BAR;
};

DEVI void tr_item(const float* W, int K, int N, int Npad, bf16* WT, LAS float* scr, int item, int lane) {
    const int nblk = Npad / 32, kb = item / nblk, nb = item % nblk, k0 = 64 * kb, n0 = 32 * nb;
    const int n_ = n0 + (lane & 31);
#pragma unroll 8
    for (int i = 0; i < 32; ++i) { const int kk = 2 * i + (lane >> 5); scr[kk * 33 + (lane & 31)] = n_ < N ? W[(size_t)(k0 + kk) * N + n_] : 0.f; }
    LDS_WAIT(); asm volatile("" ::: "memory");
    const int c = lane & 7;
#pragma unroll
    for (int j = 0; j < 4; ++j) { const int n = (lane >> 3) + 8 * j; const LAS float* s = scr + (8 * c) * 33 + n;
        v4u o; o.x = pk2(s[0 * 33], s[1 * 33]); o.y = pk2(s[2 * 33], s[3 * 33]); o.z = pk2(s[4 * 33], s[5 * 33]); o.w = pk2(s[6 * 33], s[7 * 33]);
        *(GAS v4u*)(WT + (size_t)(n0 + n) * K + k0 + 8 * c) = o; }
    LDS_WAIT(); asm volatile("" ::: "memory");
}

DEVI void gemm_all(const GemmArgs& g, int maxM, int Z, int B0, int G, unsigned char* lds) {
    const int total = gemm_tiles(g, maxM, Z);
    for (int t0 = B0 * 2; t0 < total; t0 += G * 2) {
        const int vb = tidx() >> 8; float* sm = (float*)(lds + vb * 32768);
        const bool l0 = gemm_tile_live(g, maxM, t0), l1 = (t0 + 1 < total) && gemm_tile_live(g, maxM, t0 + 1);
        if (!l0 && !l1) continue;
        const int t = (vb && t0 + 1 < total) ? t0 + 1 : t0;
        gemm_tile(g, maxM, t, vb ? l1 : l0, sm);
    }
}

__global__ void __launch_bounds__(512, 2) mega(MP p) {
    extern __shared__ __attribute__((aligned(16))) unsigned char lds[];
    cg::grid_group grid = cg::this_grid();
    const int G = gridDim.x, B0 = blockIdx.x;
    {
        LAS unsigned* ctl = (LAS unsigned*)((LAS unsigned char*)lds + LDSCTL_OFF);
        for (int u = threadIdx.x; u < (LDS_BYTES - LDSCTL_OFF) / 4; u += NWAVES * 64) ctl[u] = 0u;
    }
    __syncthreads();
    volatile LAS unsigned* MISC = (volatile LAS unsigned*)((LAS unsigned char*)lds + MISC_OFF);
    XcdBarrier bar = xcd_barrier_post(p.BAR, MISC + 8);
    grid.sync();
#define GSYNC() do { REP(24) xcd_barrier(bar); } while (0)
    float* sm0 = (float*)lds;
    LAS unsigned char* ring = (LAS unsigned char*)lds + RING_OFF;
#define VLOOP(n, body) for (int t0_ = B0 * 2; t0_ < (n); t0_ += G * 2) { const int vb = tidx() >> 8; float* sm = (float*)(lds + vb * 32768); const int t = min(t0_ + vb, (n) - 1); body; }

    const float *x_in = p.in[0], *mem = p.in[1];
    float* X = p.X;
    float* R0 = p.R0;
    unsigned char* RB = (unsigned char*)R0;
    constexpr size_t SZ_TB = (size_t)NTOK * 256 * 2;
    bf16 *rAT = (bf16*)RB, *rBT = rAT + SZ_TB / 2, *rKT = rBT + SZ_TB / 2, *rRT = rKT + SZ_TB / 2;
    bf16 *rV = rRT + SZ_TB / 2, *rG = rV + SZ_TB / 2, *rBON = rG + SZ_TB / 2;
    bf16 *QNb = rBON + SZ_TB / 2, *QRb = QNb + SZ_TB / 2, *UBb = QRb + SZ_TB / 2, *VBb = UBb + SZ_TB / 2;
    bf16 *KSRb = VBb + SZ_TB / 2, *KWRb = KSRb + (size_t)NTOK * 64, *VSTb = KWRb + (size_t)NTOK * 64, *VWTb = VSTb + (size_t)NTOK * 64;
    bf16 *BLK = VWTb + (size_t)NTOK * 64, *BLV = BLK + (size_t)1024 * 2048;
    float *rLAM = (float*)(BLV + (size_t)1024 * 2048), *GATES = rLAM + 1024 * 64;
    bf16* COLSB = (bf16*)(RB + 110100480);
    v4u *rPF = (v4u*)COLSB, *rHF = rPF + (size_t)1024 * 512, *rSF = rHF + (size_t)1024 * 512;
    float *rQT = (float*)(rSF + (size_t)1024 * 512), *rOL = rQT + (size_t)1024 * 4096;
    float *HIDK = rOL + (size_t)1024 * 4096, *HIDV = HIDK + (size_t)1024 * 256;
    bf16 *KCMPb = (bf16*)(HIDV + (size_t)1024 * 256), *VCMPTb = KCMPb + (size_t)NB * 512 * 64;
    float* Y = R0;
    bf16* PB = (bf16*)(R0 + (size_t)17 * 1000 * 1000);
    bf16* XG = (bf16*)R0;
    bf16* HB = (bf16*)(R0 + (size_t)19 * 1000 * 1000);
    bf16* WGU_T = (bf16*)(R0 + (size_t)34 * 1000 * 1000);
    bf16* WD_T = (bf16*)(R0 + (size_t)43 * 1000 * 1000);

    bf16* WQB = (bf16*)R0;
    bf16* WKT = WQB + (size_t)2 * DM * DM;
    bf16* WVT = WKT + (size_t)2 * DM * DM;
    bf16* WOT = WVT + (size_t)2 * DM * DM;
    bf16* MEMB = WOT + (size_t)2 * DM * DM;
    bf16* KMEMB = MEMB + (size_t)NB * MEML * DM;
    bf16* VMEMB = KMEMB + (size_t)2 * NB * MEML * DM;
    {
        LAS float* scr = (LAS float*)(ring + (tidx() >> 6) * 16384);
        const int gw = B0 * NWAVES + (tidx() >> 6), NGW = G * NWAVES, lane = tidx() & 63;
        constexpr int I_IN = (DM / 64) * (DINP / 32), I_SQ = (DM / 64) * (DM / 32), I_W1 = (2048 / 64) * (256 / 32);
        for (int it = gw; it < 2 * I_IN + 8 * I_SQ + 4 * I_W1; it += NGW) {
            int r = it;
            if (r < 2 * I_IN) {
                const int l = r / I_IN, item = r % I_IN; const int nblk = DINP / 32, kb = item / nblk, nb = item % nblk, k0 = 64 * kb, n0 = 32 * nb;
                const float* W = p.in[4] + (size_t)l * DM * DIN; const float* VD = p.in[21];
                const int n_ = n0 + (lane & 31);
#pragma unroll 8
                for (int i = 0; i < 32; ++i) { const int kk = 2 * i + (lane >> 5);
                    float v = 0.f;
                    if (n_ < DIN) v = W[(size_t)(k0 + kk) * DIN + n_]; else if (l == 1 && n_ < DIN + 32) v = VD[(size_t)(k0 + kk) * 32 + (n_ - DIN)];
                    scr[kk * 33 + (lane & 31)] = v; }
                LDS_WAIT(); asm volatile("" ::: "memory");
                const int c = lane & 7; bf16* WT = p.WIN_T + (size_t)l * DINP * DM;
#pragma unroll
                for (int j = 0; j < 4; ++j) { const int n = (lane >> 3) + 8 * j; const LAS float* s = scr + (8 * c) * 33 + n;
                    v4u o; o.x = pk2(s[0 * 33], s[1 * 33]); o.y = pk2(s[2 * 33], s[3 * 33]); o.z = pk2(s[4 * 33], s[5 * 33]); o.w = pk2(s[6 * 33], s[7 * 33]);
                    *(GAS v4u*)(WT + (size_t)(n0 + n) * DM + k0 + 8 * c) = o; }
                LDS_WAIT(); asm volatile("" ::: "memory");
                continue;
            }
            r -= 2 * I_IN;
            if (r < 8 * I_SQ) {
                const int which = r / (2 * I_SQ), l = (r / I_SQ) & 1, item = r % I_SQ, kb = item / 32, nb = item % 32;
                const float* W = (which == 0 ? p.in[5] : which == 1 ? p.in[38] : which == 2 ? p.in[39] : p.in[40]) + (size_t)l * DM * DM;
                bf16* WT = (which == 0 ? p.WOUT_T : which == 1 ? WKT : which == 2 ? WVT : WOT) + (size_t)l * DM * DM;
                tr_blk(W, DM, DM, kb * 64, nb * 32, WT, DM, nb * 32, 1.f, scr, lane);
                continue;
            }
            r -= 8 * I_SQ;
            {
                const int which = r / I_W1, item = r % I_W1, kb = item / 8, nb = item % 8, l = which >> 1;
                const float* W = ((which & 1) ? p.in[33] : p.in[30]) + (size_t)l * 2048 * 256;
                tr_blk(W, 256, 256, kb * 64, nb * 32, p.W1_T + (size_t)which * 256 * 2048, 2048, nb * 32, 1.f, scr, lane);
            }
        }
        for (int it = gw; it < 64; it += NGW) {
            if (it < 32) { const int which = it >> 3, nb = it & 7, l = which & 1;
                tr_blk(((which >> 1) ? p.in[14] : p.in[12]) + (size_t)l * 64 * 256, 256, 256, 0, nb * 32, p.LORA_T + (size_t)which * 256 * 64, 64, nb * 32, 1.f, scr, lane); }
            else { const int r2 = it - 32, l = r2 >> 4, kb = (r2 >> 3) & 1, nb = r2 & 7;
                tr_blk(p.in[15] + (size_t)l * 128 * 256, 256, 256, kb * 64, nb * 32, p.LORA_T + (size_t)4 * 256 * 64 + (size_t)l * 256 * 128, 128, nb * 32, 1.f, scr, lane); }
        }
        for (int e = B0 * 512 + tidx(); e < 256 * 32; e += G * 512) { const int n = e >> 5, k = e & 31;
            p.LORA_T[(size_t)4 * 256 * 64 + (size_t)2 * 256 * 128 + e] = (bf16)f2bf(p.in[24][k * 256 + n]); }
        for (int e = B0 * 512 + tidx(); e < 2 * 4 * 128 * 128; e += G * 512) { const int t = (e >> 7) & 127, s = e & 127;
            p.GWS[e] = s <= t ? (bf16)f2bf(p.in[27][e]) : (bf16)0; }
        cvt_bf16(p.in[37], WQB, (size_t)2 * DM * DM, 1.f, B0, G);
        cvt_bf16(mem, MEMB, (size_t)NB * MEML * DM, 1.f, B0, G);
    }
    __syncthreads();
    VLOOP(NTOK, ln_kernel(x_in, 1.0f, nullptr, p.in[2], p.in[3], X, p.XN, t, sm))
    GSYNC();
    {
        const int gi = B0 >> 3, un = B0 & 7;
        pg8::Gemm g{MEMB, ((gi & 1) ? WVT : WKT) + (size_t)(gi >> 1) * DM * DM, NB * MEML, DM, DM};
        pg8::OneUnit S{un >> 2, un & 3, B0 < 32 ? 1 : 0};
        pg8::EpiBf16<0> E{((gi & 1) ? VMEMB : KMEMB) + (size_t)(gi >> 1) * NB * MEML * DM, DM, nullptr, 0, 0, 1.f};
        pg8::gemm_phase<pg8::EpiBf16<0>, pg8::OneUnit, false, true>(ring, g, S, E);
    }
    GSYNC();
    {
        const int l = (B0 >> 6) & 1, kind = (B0 >> 5) & 1, bh = (B0 >> 2) & 7, q4 = B0 & 3, b = bh >> 2, h = bh & 3;
        if (kind == 0) {
            pg8::Gemm g{KMEMB + (size_t)l * NB * MEML * DM + (size_t)b * MEML * DM + h * 256, WQB + (size_t)l * DM * DM + h * 256, 256, DM, 256, DM, DM};
            pg8::OneUnit S{0, q4, B0 < 128 ? 1 : 0};
            pg8::EpiBf16S E{p.WQK_T + (size_t)l * NB * DM * DM + (size_t)b * DM * DM + (size_t)h * 256 * DM, DM, 0.0625f * 1.4426950408889634f};
            pg8::gemm_phase<pg8::EpiBf16S, pg8::OneUnit, false, true>(ring, g, S, E);
        } else {
            pg8::Gemm g{WOT + (size_t)l * DM * DM + h * 256, VMEMB + (size_t)l * NB * MEML * DM + (size_t)b * MEML * DM + h * 256, DM, 256, 256, DM, DM};
            pg8::OneUnit S{q4, 0, B0 < 128 ? 1 : 0};
            pg8::EpiBf16S E{p.VWO_T + (size_t)l * NB * DM * DM + (size_t)b * DM * DM + h * 256, DM, 1.f};
            pg8::gemm_phase<pg8::EpiBf16S, pg8::OneUnit, false, true>(ring, g, S, E);
        }
    }
    GSYNC();
    for (int l = 0; l < 2; ++l) {
REP(1) {
        {
            pg8::Gemm g{p.XN, p.WIN_T + (size_t)l * DINP * DM, NTOK, DINP, DM};
            pg8::StaticOrder S; S.init(NTOK, DINP, G, B0);
            pg8::EpiBf16<0> E{COLSB, DINP, nullptr, 0, 0, 1.f};
            pg8::gemm_phase<pg8::EpiBf16<0>, pg8::StaticOrder, true, true>(ring, g, S, E);
        }
}
        GSYNC();
        RwP rw; rw.R = nullptr; rw.K = nullptr; rw.V = rV; rw.A = nullptr; rw.B = nullptr; rw.LW = nullptr; rw.G = rG; rw.BON = rBON;
        rw.AT = rAT; rw.BT = rBT; rw.KT = rKT; rw.RT = rRT; rw.LAM = rLAM; rw.PF = rPF; rw.HF = rHF; rw.QT = rQT; rw.OL = rOL; rw.SF = rSF;
        rw.gn_g = p.in[19] + l * 256; rw.gn_b = p.in[20] + l * 256; rw.MIX = p.MIX;
        {
            MixP mp;
            mp.COLS = COLSB;
            mp.conv_w = p.in[6] + (size_t)l * 31 * 256; mp.conv_b = p.in[7] + l * 256; mp.conv_gg = p.in[8] + l * 256; mp.conv_gb = p.in[9] + l * 256;
            mp.gl_g = p.in[25] + l * 256; mp.gl_b = p.in[26] + l * 256;
            mp.mu = p.in[10] + l * 1024; mp.w0 = p.in[11] + l * 256; mp.a0 = p.in[13] + l * 256; mp.k_k = p.in[16] + l * 256; mp.k_a = p.in[17] + l * 256; mp.r_k = p.in[18] + l * 256;
            mp.v_mu = p.in[22]; mp.v0 = p.in[23];
            mp.WUP_T = p.LORA_T + (size_t)l * 256 * 64; mp.AUP_T = p.LORA_T + (size_t)(2 + l) * 256 * 64; mp.GUP_T = p.LORA_T + (size_t)4 * 256 * 64 + (size_t)l * 256 * 128;
            mp.VUP_T = p.LORA_T + (size_t)4 * 256 * 64 + (size_t)2 * 256 * 128;
            mp.pe_k = p.in[29] + (size_t)l * 2048; mp.pe_v = p.in[32] + (size_t)l * 2048;
            mp.MIX = p.MIX; mp.UB = UBb; mp.VB = VBb;
            mp.AT = rAT; mp.BT = rBT; mp.KT = rKT; mp.RT = rRT; mp.V = rV; mp.G = rG; mp.BON = rBON; mp.VFIRST = p.VFIRST; mp.LAM = rLAM;
            mp.QN = QNb; mp.QR = QRb; mp.KSR = KSRb; mp.KWR = KWRb; mp.VST = VSTb; mp.VWT = VWTb; mp.GATES = GATES; mp.BLK = BLK; mp.BLV = BLV;
            mp.layer = l; mp.pad = 0;
REP(2) {
            for (int cg = B0; cg < NTOK / 64; cg += G) prep_unit(mp, cg, ring);
}
        }
        GSYNC();
        {
REP(4) {
            {
                const int isv = (B0 >> 2) & 1;
                pg8::Gemm g{isv ? BLV : BLK, p.W1_T + (size_t)(l * 2 + isv) * 256 * 2048, 1024, 256, 2048};
                pg8::OneUnit S{B0 & 3, 0, B0 < 8 ? 1 : 0};
                pg8::EpiGeluF32 E{isv ? HIDV : HIDK, 256};
                pg8::gemm_phase<pg8::EpiGeluF32, pg8::OneUnit, false, true>(ring, g, S, E);
            }
}
REP(6) {
            for (int u0 = 2 * (G - 1 - B0); u0 < 1024; u0 += 2 * G) rw_r2(rw, u0, ring);
}
REP(5) {
            for (int c = G - 1 - B0; c < NTOK / 128; c += G) gmlp_unit(UBb, VBb, p.GWS + (size_t)l * 4 * 128 * 128, p.in[28] + l * 4 * 128, p.MIX, c, ring);
}
        }
        GSYNC();
        {
REP(7) {
            const GemmArgs gk = mk(HIDK, 256, p.in[31] + (size_t)l * 256 * 64, 64, 1, (float*)KCMPb, 64, 1024, 64, 256, 1, 0, 0, 0, 0, 0, 0, nullptr, nullptr, 2);
            const GemmArgs gv = mk(HIDV, 256, p.in[34] + (size_t)l * 256 * 64, 64, 1, (float*)VCMPTb, 64, 1024, 64, 256, 1, 0, 0, 0, 0, 0, 0, nullptr, nullptr, 3);
            gemm_all(gk, 1024, 1, B0, G, lds);
            gemm_all(gv, 1024, 1, B0, G, lds);
}
        }
        GSYNC();
        if (B0 >= G - 2) {
REP(8) {
            { const int w_ = tidx() >> 6; rw_r3(rw, G - 1 - B0, w_ >> 1, w_ & 1, tidx() & 63); }
}
        } else {
REP(9) {
            for (int uu = B0; uu < NTOK / 64; uu += G - 2) {
                const int b = uu & 1, tile = SEQ / 64 - 1 - (uu >> 1);
                NsaP np; np.QN = QNb + (size_t)b * SEQ * 256; np.QR = QRb + (size_t)b * SEQ * 256; np.KSR = KSRb + (size_t)b * SEQ * 64; np.KWR = KWRb + (size_t)b * SEQ * 64;
                np.VST = VSTb + (size_t)b * 64 * SEQ; np.VWT = VWTb + (size_t)b * 64 * SEQ; np.KCMP = KCMPb + (size_t)b * 512 * 64; np.VCMPT = VCMPTb + (size_t)b * 64 * 512;
                np.GATES = GATES + (size_t)b * SEQ * 12; np.MIX = p.MIX + (size_t)b * SEQ * DM;
                nsa_unit(np, tile, ring);
            }
}
        }
        GSYNC();
REP(10) {
        for (int i = B0 * NWAVES + (tidx() >> 6); i < 2048; i += G * NWAVES) rw_r4(rw, i >> 1, i & 1, tidx() & 63);
}
        GSYNC();
        {
REP(11) {
            pg8::Gemm g{p.MIX, p.WOUT_T + (size_t)l * DM * DM, NTOK, DM, DM};
            pg8::StaticOrder S; S.init(NTOK, DM, G, B0);
            pg8::EpiF32 E{Y, DM, nullptr};
            pg8::gemm_phase<pg8::EpiF32, pg8::StaticOrder, true, true>(ring, g, S, E);
}
        }
        GSYNC();
        VLOOP(NTOK, ln_kernel(X, ALPHA, Y, p.in[35] + l * DM, p.in[36] + l * DM, X, p.XN, t, sm))
        __syncthreads();
        {
            LAS float* scr = (LAS float*)(ring + (tidx() >> 6) * 16384);
            const int gw = B0 * NWAVES + (tidx() >> 6), NGW = G * NWAVES, lane = tidx() & 63;
            const float* wg = p.in[45] + (size_t)l * 16 * DM * 512;
            const float* wu = p.in[46] + (size_t)l * 16 * DM * 512;
            const float* wd = p.in[47] + (size_t)l * 16 * 512 * DM;
            constexpr int I_GU = (DM / 64) * (512 / 32), I_D = (512 / 64) * (DM / 32);
REP(13) {
            for (int it = gw; it < 16 * (2 * I_GU + I_D); it += NGW) {
                const int e = it / (2 * I_GU + I_D); int r = it % (2 * I_GU + I_D);
                if (r < 2 * I_GU) {
                    const int isup = r / I_GU; r %= I_GU;
                    const int kb = r / 16, nb = r % 16, n0 = nb * 32;
                    tr_blk((isup ? wu : wg) + (size_t)e * DM * 512, 512, 512, kb * 64, n0, WGU_T + (size_t)e * 1024 * DM, DM, (n0 >> 7) * 256 + (n0 & 127) + isup * 128, 1.f, scr, lane);
                } else {
                    r -= 2 * I_GU;
                    const int kb = r / 32, nb = r % 32;
                    tr_blk(wd + (size_t)e * 512 * DM, DM, DM, kb * 64, nb * 32, WD_T + (size_t)e * DM * 512, 512, nb * 32, 1.f, scr, lane);
                }
            }
}
        }
        GSYNC();
        {
            bf16* WQK_T = p.WQK_T + (size_t)l * NB * DM * DM;
REP(14) {
            pg8::Gemm g{p.XN, WQK_T, NTOK, DM, DM};
            pg8::XaOrder S{G, B0};
            pg8::EpiSoftmaxP E{PB};
            pg8::gemm_phase<pg8::EpiSoftmaxP, pg8::XaOrder, false, true>(ring, g, S, E);
}
        }
        GSYNC();
        {
REP(15) {
            pg8::Gemm g{PB, p.VWO_T + (size_t)l * NB * DM * DM, NTOK, DM, DM};
            pg8::XaOrder S{G, B0};
            pg8::EpiF32N4 E{Y, DM};
            pg8::gemm_phase<pg8::EpiF32N4, pg8::XaOrder, true, true>(ring, g, S, E);
}
        }
        GSYNC();
        VLOOP(NTOK, ln_kernel(X, ALPHA, Y, p.in[41] + l * DM, p.in[42] + l * DM, X, p.XN, t, sm))
        GSYNC();
REP(19) {
        VLOOP(NTOK, router_kernel(X, p.in[43], p.in[44], p.TE, p.TW, t, sm))
}
        GSYNC();
REP(20) {
        if (B0 == 0) moe_lists2(p.TE, p.EOFF, p.EOFF + 32, p.EOFF + 64, p.LIST, p.SLOT, sm0);
}
        GSYNC();
REP(21) {
        moe_gather(p.XN, p.LIST, p.EOFF, XG, B0, G);
}
        GSYNC();
        {
REP(22) {
            pg8::Gemm g{XG, WGU_T, 0, 0, DM};
            pg8::MoeOrder S{p.EOFF + 64, p.EOFF + 32, G, B0};
            pg8::EpiSiluMul E{HB};
            pg8::gemm_phase<pg8::EpiSiluMul, pg8::MoeOrder, true, true>(ring, g, S, E);
}
        }
        GSYNC();
        {
REP(23) {
            pg8::Gemm g{HB, WD_T, 0, 0, 512};
            pg8::MoeOrder S{p.EOFF + 64, p.EOFF + 32, G, B0};
            pg8::EpiBf16N4 E{XG, DM};
            pg8::gemm_phase<pg8::EpiBf16N4, pg8::MoeOrder, true, true>(ring, g, S, E);
}
        }
        GSYNC();
        VLOOP(NTOK, moe_combine_ln2(X, XG, p.TE, p.TW, p.SLOT, p.in[48] + l * DM, p.in[49] + l * DM, X, p.XN, t, sm))
        GSYNC();
    }
}

extern "C" void kernel_launch(void* const* d_in, const int* in_sizes, int n_in, void* d_out, int out_size, void* d_ws, size_t ws_size,
                              hipStream_t stream) {
    static int grid_blocks = 0;
    if (!grid_blocks) {
        int dev = 0, cus = 0, per_cu = 0;
        (void)hipGetDevice(&dev);
        (void)hipDeviceGetAttribute(&cus, hipDeviceAttributeMultiprocessorCount, dev);
        (void)hipFuncSetAttribute((const void*)mega, hipFuncAttributeMaxDynamicSharedMemorySize, LDS_BYTES);
        (void)hipOccupancyMaxActiveBlocksPerMultiprocessor(&per_cu, (const void*)mega, NWAVES * 64, LDS_BYTES);
        (void)hipGetLastError();
        if (per_cu < 1) { fprintf(stderr, "occupancy query says %d blocks per CU\n", per_cu); per_cu = 1; }
        grid_blocks = cus;
    }
    MP p; memset(&p, 0, sizeof(p));
    for (int i = 0; i < 50; ++i) p.in[i] = (const float*)d_in[i];
    char* ws = (char*)d_ws;
    size_t o = 0;
    auto take = [&](size_t bytes) { char* q = ws + o; o += (bytes + 255) & ~(size_t)255; return q; };
    p.BAR = (unsigned*)take(16384);
    p.X = (float*)d_out;
    p.VFIRST = (bf16*)take((size_t)NTOK * 256 * 2);
    p.LORA_T = (bf16*)take((size_t)(4 * 256 * 64 + 2 * 256 * 128 + 256 * 32) * 2);
    p.GWS = (bf16*)take((size_t)2 * 4 * 128 * 128 * 2);
    p.MIX = (bf16*)take((size_t)NTOK * DM * 2);
    p.XN = (bf16*)take((size_t)NTOK * DM * 2);
    p.WIN_T = (bf16*)take((size_t)2 * DINP * DM * 2);
    p.WOUT_T = (bf16*)take((size_t)2 * DM * DM * 2);
    p.WQK_T = (bf16*)take((size_t)2 * NB * DM * DM * 2);
    p.VWO_T = (bf16*)take((size_t)2 * NB * DM * DM * 2);
    p.W1_T = (bf16*)take((size_t)4 * 256 * 2048 * 2);
    p.TE = (int*)take((size_t)NTOK * 2 * 4);
    p.TW = (float*)take((size_t)NTOK * 2 * 4);
    p.SLOT = (int*)take((size_t)NTOK * 2 * 4);
    p.LIST = (int*)take((size_t)36864 * 4);
    p.EOFF = (int*)take(4096);
    p.R0 = (float*)take((size_t)54200000 * 4);
    if (o > ws_size) { fprintf(stderr, "workspace too small: need %zu have %zu\n", o, ws_size); return; }
    (void)hipMemsetAsync(p.BAR, 0, 16384, stream);
    void* args[] = {&p};
    hipError_t e = hipLaunchCooperativeKernel((const void*)mega, dim3(grid_blocks), dim3(NWAVES * 64), args, LDS_BYTES, stream);
    if (e != hipSuccess) fprintf(stderr, "cooperative launch failed: %s (grid %d)\n", hipGetErrorString(e), grid_blocks);
}
```

```cpp
#include <hip/hip_runtime.h>
#include <hip/hip_cooperative_groups.h>
#include <stdio.h>
#include <stdint.h>
#include <string.h>
#include <math.h>
namespace cg = cooperative_groups;

#define DEVI __device__ __forceinline__
#define GAS __attribute__((address_space(1)))
#define LAS __attribute__((address_space(3)))
typedef unsigned short bf16;
typedef unsigned v4u __attribute__((ext_vector_type(4)));
typedef GAS unsigned gu32;
typedef GAS unsigned long long gu64;
#define RLX_AGENT __ATOMIC_RELAXED, __HIP_MEMORY_SCOPE_AGENT
#define LDS_WAIT() asm volatile("s_waitcnt lgkmcnt(0)" ::: "memory")
#define VM_WAIT() asm volatile("s_waitcnt vmcnt(0)" ::: "memory")
DEVI unsigned f2bf(float f) { unsigned u = __builtin_bit_cast(unsigned, f); return (u + 0x7fffu + ((u >> 16) & 1u)) >> 16; }
DEVI unsigned pk2(float lo, float hi) { return f2bf(lo) | (f2bf(hi) << 16); }
DEVI float bf2f(unsigned short h) { return __builtin_bit_cast(float, (unsigned)h << 16); }

constexpr int NB = 2, SEQ = 8192, DM = 1024, NTOK = NB * SEQ, DIN = 2700, DINP = 2816, MEML = 256;
constexpr int OFF_CV = 0, OFF_CG = 256, OFF_RW = 512, OFF_GU = 1536, OFF_GV = 1792, OFF_Q = 2048, OFF_KC = 2304,
              OFF_VC = 2368, OFF_KS = 2432, OFF_VS = 2496, OFF_KW = 2560, OFF_VW = 2624, OFF_GT = 2688;
constexpr int NCMP = 511;
constexpr float ALPHA = 1.4142135623730951f;
constexpr int NWAVES = 8;
constexpr int RING_OFF = 0, RING_BYTES = 131072;
constexpr int LDSCTL_OFF = RING_BYTES, MISC_OFF = LDSCTL_OFF + 320;
constexpr int LDS_BYTES = 147456;

DEVI int tidx() { int t = threadIdx.x; asm volatile("" : "+v"(t)); return t; }
namespace pg8 {
#define PG8_LAS __attribute__((address_space(3)))
typedef unsigned short bf16_t;
typedef short bf16x8 __attribute__((ext_vector_type(8)));
typedef float f32x4 __attribute__((ext_vector_type(4)));
typedef unsigned u32x4 __attribute__((ext_vector_type(4)));
constexpr int BM = 256, BK = 64, HALF = 128, HTB = HALF * BK * 2  , STAGE_BYTES = 8 * HTB, NXCD = 8, WGM = 8;

__host__ __device__ __forceinline__ int lds_byte(int r, int c) { const int st = (r >> 4) * 2 + (c >> 5), rr = r & 15, cc = c & 31, ob = rr * 64 + cc * 2; return st * 1024 + (ob ^ (((ob >> 9) & 1) << 5)); }
__host__ __device__ __forceinline__ void stage_rc(int b, int& R, int& C) { const int st = b / 1024, sb = b % 1024, swz = sb ^ (((sb >> 9) & 1) << 5); R = (st >> 1) * 16 + swz / 64; C = (st & 1) * 32 + (swz % 64) / 2; }
__host__ __device__ __forceinline__ int perm32(int rho) { const int n = rho >> 4, i = rho & 15; return 8 * (i >> 2) + 4 * n + (i & 3); }

struct Unit { int pm, pn; };
struct Gemm { const bf16_t* A; const bf16_t* Bt; int M, N, K; int lda = 0, ldb = 0; };

struct StaticOrder {
    int nM, nN, nwg, G, c;
    __host__ __device__ void init(int M, int N, int G_, int c_) { nM = M / BM; nN = N / BM; nwg = nM * nN; G = G_; c = c_; }
    __host__ __device__ bool next(int i, Unit& u) const {
        const long L = (long)i * G + c; if (L >= nwg) return false;
        int wgid = (int)L; { const int q = nwg / NXCD, r = nwg % NXCD, xcd = wgid % NXCD, off = wgid / NXCD; wgid = (xcd < r ? xcd * (q + 1) : r * (q + 1) + (xcd - r) * q) + off; }
        const int nig = WGM * nN, gid = wgid / nig, fm = gid * WGM, gsz = (nM - fm) < WGM ? (nM - fm) : WGM;
        u.pm = fm + ((wgid % nig) % gsz); u.pn = (wgid % nig) / gsz; return true;
    }
    __device__ __forceinline__ void a_ready(const Unit&) const {}
    __device__ __forceinline__ void done(const Unit&) const {}
};

__device__ __forceinline__ unsigned cvt_pk_bf16(float lo, float hi) { unsigned r; asm volatile("v_cvt_pk_bf16_f32 %0, %1, %2" : "=v"(r) : "v"(lo), "v"(hi)); return r; }
typedef float f32x2 __attribute__((ext_vector_type(2)));
__device__ __forceinline__ f32x2 gelu_pk(f32x2 v) {
    const f32x2 av = __builtin_elementwise_abs(v), d = av * 0.2316418882f + 1.0f;
    f32x2 t; t.x = __builtin_amdgcn_rcpf(d.x); t.y = __builtin_amdgcn_rcpf(d.y);
    f32x2 q = t * 0.5307027145f + (-0.7265760135f); q = q * t + 0.7107068705f; q = q * t + (-0.142248368f); q = q * t + 0.127414796f; q = q * t;
    const f32x2 s = (v * v) * (-0.72134752044f);
    f32x2 e; e.x = __builtin_amdgcn_exp2f(s.x); e.y = __builtin_amdgcn_exp2f(s.y);
    const f32x2 m = v * (q * e), r = v - m;
    f32x2 o; o.x = v.x < 0.f ? m.x : r.x; o.y = v.y < 0.f ? m.y : r.y; return o;
}

template <int ACT  > struct EpiBf16 {
    static constexpr bool PERM = true, AFTER_DRAIN = false; static_assert(ACT == 0 || ACT == 1, "EpiBf16: ACT is 0 (none) or 1 (gelu_pk)");
    bf16_t* O; int ldc; const float* bias; int split_cols; size_t split_stride; float scale0;
    __device__ __forceinline__ void operator()(const f32x4 (&acc)[2][2][4][2], const Unit& u, int wr, int wc, int fr, int fq) const {
        const int row0 = u.pm * BM + wr * 64 + fr; int colt = u.pn * BM; bf16_t* base = O;
        float sc = 1.f; if (split_cols) { const int t = colt / split_cols; base += (size_t)t * split_stride; colt -= t * split_cols; if (t == 0) sc = scale0; }
        const int col0 = colt + wc * 32 + 8 * fq, bcol0 = u.pn * BM + wc * 32 + 8 * fq;
        f32x4 bv[2][2];
#pragma unroll
        for (int bj = 0; bj < 2; ++bj)
#pragma unroll
            for (int n = 0; n < 2; ++n) bv[bj][n] = bias ? *(const f32x4*)(bias + bcol0 + bj * HALF + 4 * n) : (f32x4){0.f, 0.f, 0.f, 0.f};
#pragma unroll
        for (int ai = 0; ai < 2; ++ai)
#pragma unroll
            for (int m = 0; m < 4; ++m) { bf16_t* rowp = base + (size_t)(row0 + ai * HALF + m * 16) * ldc + col0;
#pragma unroll
                for (int bj = 0; bj < 2; ++bj) { f32x4 v0 = acc[ai][bj][m][0] + bv[bj][0], v1 = acc[ai][bj][m][1] + bv[bj][1];
                    if (ACT == 1) { f32x2 a = gelu_pk((f32x2){v0[0], v0[1]}), b = gelu_pk((f32x2){v0[2], v0[3]}), c = gelu_pk((f32x2){v1[0], v1[1]}), d = gelu_pk((f32x2){v1[2], v1[3]});
                        v0 = (f32x4){a.x, a.y, b.x, b.y}; v1 = (f32x4){c.x, c.y, d.x, d.y}; }
                    v0 = v0 * sc; v1 = v1 * sc; u32x4 w; w.x = cvt_pk_bf16(v0[0], v0[1]); w.y = cvt_pk_bf16(v0[2], v0[3]); w.z = cvt_pk_bf16(v1[0], v1[1]); w.w = cvt_pk_bf16(v1[2], v1[3]);
                    *(u32x4*)(rowp + bj * HALF) = w; } }
    }
};

struct PanelStats {
    unsigned* xbuf;
    unsigned* cnt;
    unsigned* tmo;
    int ntn; float eps;
    unsigned code;
    __device__ __forceinline__ bool run(const f32x4 (&v)[2][2][4][2], const Unit& u, int wr, int wc, int fr, int fq, PG8_LAS unsigned char* lds, int wid, int lane) const {
        typedef float f32x2v __attribute__((ext_vector_type(2)));
        PG8_LAS f32x2v* P = (PG8_LAS f32x2v*)lds;
        PG8_LAS f32x2v* S = (PG8_LAS f32x2v*)(lds + 8192);
        PG8_LAS unsigned* flag = (PG8_LAS unsigned*)(lds + 8192 + 2048);
#pragma unroll
        for (int ai = 0; ai < 2; ++ai)
#pragma unroll
            for (int m = 0; m < 4; ++m) {
                float s = 0.f;
#pragma unroll
                for (int bj = 0; bj < 2; ++bj)
#pragma unroll
                    for (int n = 0; n < 2; ++n) { const f32x4 x = v[ai][bj][m][n]; s += (x[0] + x[1]) + (x[2] + x[3]); }
                s += __shfl_xor(s, 16); s += __shfl_xor(s, 32);
                const float mw = s * (1.0f / 64.0f); float q = 0.f;
#pragma unroll
                for (int bj = 0; bj < 2; ++bj)
#pragma unroll
                    for (int n = 0; n < 2; ++n) { const f32x4 d = v[ai][bj][m][n] - mw; q += (d[0] * d[0] + d[1] * d[1]) + (d[2] * d[2] + d[3] * d[3]); }
                q += __shfl_xor(q, 16); q += __shfl_xor(q, 32);
                if (fq == 0) P[(ai * HALF + wr * 64 + m * 16 + fr) * 4 + wc] = (f32x2v){mw, q};
            }
        asm volatile("s_waitcnt lgkmcnt(0)" ::: "memory"); __builtin_amdgcn_s_barrier(); asm volatile("" ::: "memory");
#if defined(BROKEN_EXCHANGE_NO_WAIT)
#warning BROKEN CONTROL BUILD: the row-statistics exchange does not wait; results are wrong by design
        if (blockIdx.x >= 64) { const long long t0_ = clock64(); while (clock64() - t0_ < 60000) __builtin_amdgcn_s_sleep(8); }
#endif
        const int row = wid * 32 + (lane & 31);
        if (lane < 32) {
            const f32x2v a = P[row * 4 + 0], b = P[row * 4 + 1], c = P[row * 4 + 2], d = P[row * 4 + 3];
            const float mt = (a.x + b.x + c.x + d.x) * 0.25f;
            const float da = a.x - mt, db = b.x - mt, dc = c.x - mt, dd = d.x - mt;
            const float m2 = (a.y + b.y) + (c.y + d.y) + 64.0f * ((da * da + db * db) + (dc * dc + dd * dd));
            unsigned long long* slot = (unsigned long long*)xbuf + ((size_t)(u.pm * BM + row) * 4 + u.pn);
            __hip_atomic_store(slot, ((unsigned long long)__float_as_uint(m2) << 32) | __float_as_uint(mt), __ATOMIC_RELAXED, __HIP_MEMORY_SCOPE_AGENT);
        }
        asm volatile("s_waitcnt vmcnt(0)" ::: "memory");
        if (lane == 0) __hip_atomic_fetch_add(cnt + 64 * u.pm, 1u, __ATOMIC_RELAXED, __HIP_MEMORY_SCOPE_AGENT);
        if (wid == 0) {
            bool dead = false; const unsigned long long t0 = __builtin_amdgcn_s_memrealtime(); const unsigned want = 8u * (unsigned)ntn;
            for (;;) {
#if defined(BROKEN_EXCHANGE_NO_WAIT)
                break;
#endif
                if ((unsigned)__builtin_amdgcn_readfirstlane(__hip_atomic_load(cnt + 64 * u.pm, __ATOMIC_RELAXED, __HIP_MEMORY_SCOPE_AGENT)) >= want) break;
                if (__builtin_amdgcn_s_memrealtime() - t0 > 2000000ull) {
                    if (lane == 0) { unsigned expect = 0u; __hip_atomic_compare_exchange_strong(tmo + 1, &expect, code | (unsigned)(u.pm & 0xff), __ATOMIC_RELAXED, __ATOMIC_RELAXED, __HIP_MEMORY_SCOPE_AGENT);
                                     __hip_atomic_store(tmo, 1u, __ATOMIC_RELAXED, __HIP_MEMORY_SCOPE_AGENT); }
                    dead = true; break; }
                __builtin_amdgcn_s_sleep(2);
            }
            __builtin_amdgcn_fence(__ATOMIC_ACQUIRE, "agent");
            if (lane == 0) flag[0] = dead ? 1u : 0u;
        }
        asm volatile("s_waitcnt vmcnt(0) lgkmcnt(0)" ::: "memory"); __builtin_amdgcn_s_barrier(); asm volatile("" ::: "memory");
        const bool bad = flag[0] != 0u;
        if (lane < 32) {
            const unsigned long long* slot = (const unsigned long long*)xbuf + (size_t)(u.pm * BM + row) * 4; float mt[4], m2[4]; float ms = 0.f;
#pragma unroll
            for (int t = 0; t < 4; ++t) { if (t < ntn) { const unsigned long long w = __hip_atomic_load(slot + t, __ATOMIC_RELAXED, __HIP_MEMORY_SCOPE_AGENT); mt[t] = __uint_as_float((unsigned)w); m2[t] = __uint_as_float((unsigned)(w >> 32)); } else { mt[t] = 0.f; m2[t] = 0.f; } ms += mt[t]; }
            const float mean = ms / (float)ntn; float q = 0.f;
#pragma unroll
            for (int t = 0; t < 4; ++t) if (t < ntn) { const float dm = mt[t] - mean; q += m2[t] + 256.0f * dm * dm; }
            S[row] = (f32x2v){mean, 1.0f / sqrtf(q / (256.0f * (float)ntn) + eps)};
        }
        asm volatile("s_waitcnt lgkmcnt(0)" ::: "memory"); __builtin_amdgcn_s_barrier(); asm volatile("" ::: "memory");
        return bad;
    }
};
struct EpiLnRes {
    static constexpr bool PERM = false, AFTER_DRAIN = true;
    const float* base; float* out; int ldc; const float* bias; PanelStats st; unsigned poison;
    __device__ __forceinline__ void fused(f32x4 (&acc)[2][2][4][2], const Unit& u, int wr, int wc, int fr, int fq, PG8_LAS unsigned char* lds, int wid, int lane) const {
        typedef float f32x2v __attribute__((ext_vector_type(2)));
        const PG8_LAS f32x2v* S = (const PG8_LAS f32x2v*)(lds + 8192);
        const int col0 = u.pn * BM + wc * 32 + 4 * fq;
#pragma unroll
        for (int bj = 0; bj < 2; ++bj)
#pragma unroll
            for (int n = 0; n < 2; ++n) { const f32x4 bv = bias ? *(const f32x4*)(bias + col0 + bj * HALF + n * 16) : (f32x4){0.f, 0.f, 0.f, 0.f};
#pragma unroll
                for (int ai = 0; ai < 2; ++ai)
#pragma unroll
                    for (int m = 0; m < 4; ++m) acc[ai][bj][m][n] += bv; }
        f32x4 pre[4][2][2];
#pragma unroll
        for (int m = 0; m < 4; ++m) { const size_t off = (size_t)(u.pm * BM + wr * 64 + m * 16 + fr) * ldc + col0;
#pragma unroll
            for (int bj = 0; bj < 2; ++bj)
#pragma unroll
                for (int n = 0; n < 2; ++n) pre[m][bj][n] = *(const f32x4*)(base + off + bj * HALF + n * 16); }
        const bool bad = st.run(acc, u, wr, wc, fr, fq, lds, wid, lane) || poison != 0u;
        const float qnan = __builtin_nanf("");
#pragma unroll
        for (int ai = 0; ai < 2; ++ai)
#pragma unroll
            for (int m = 0; m < 4; ++m) { const int r = ai * HALF + wr * 64 + m * 16 + fr; const f32x2v sr = S[r]; const size_t off = (size_t)(u.pm * BM + r) * ldc + col0;
#pragma unroll
                for (int bj = 0; bj < 2; ++bj)
#pragma unroll
                    for (int n = 0; n < 2; ++n) { const f32x4 bs = ai == 0 ? pre[m][bj][n] : *(const f32x4*)(base + off + bj * HALF + n * 16); f32x4 o = bs + (acc[ai][bj][m][n] - sr.x) * sr.y;
                        if (bad) o = (f32x4){qnan, qnan, qnan, qnan}; *(f32x4*)(out + off + bj * HALF + n * 16) = o; }
                if (m & 1) asm volatile("" ::: "memory"); }
    }
};
struct EpiLnResLn {
    static constexpr bool PERM = false, AFTER_DRAIN = true;
    const float* base; float* out; bf16_t* xn; int ldc; const float* bias; PanelStats st1, st2; unsigned poison;
    __device__ __forceinline__ void fused(f32x4 (&acc)[2][2][4][2], const Unit& u, int wr, int wc, int fr, int fq, PG8_LAS unsigned char* lds, int wid, int lane) const {
        typedef float f32x2v __attribute__((ext_vector_type(2))); typedef unsigned u32x2v __attribute__((ext_vector_type(2)));
        const PG8_LAS f32x2v* S = (const PG8_LAS f32x2v*)(lds + 8192);
        const int col0 = u.pn * BM + wc * 32 + 4 * fq;
#pragma unroll
        for (int bj = 0; bj < 2; ++bj)
#pragma unroll
            for (int n = 0; n < 2; ++n) { const f32x4 bv = bias ? *(const f32x4*)(bias + col0 + bj * HALF + n * 16) : (f32x4){0.f, 0.f, 0.f, 0.f};
#pragma unroll
                for (int ai = 0; ai < 2; ++ai)
#pragma unroll
                    for (int m = 0; m < 4; ++m) acc[ai][bj][m][n] += bv; }
        bool bad = st1.run(acc, u, wr, wc, fr, fq, lds, wid, lane) || poison != 0u;
        const float qnan = __builtin_nanf("");
#pragma unroll
        for (int ai = 0; ai < 2; ++ai)
#pragma unroll
            for (int m = 0; m < 4; ++m) { const int r = ai * HALF + wr * 64 + m * 16 + fr; const f32x2v sr = S[r]; const size_t off = (size_t)(u.pm * BM + r) * ldc + col0;
#pragma unroll
                for (int bj = 0; bj < 2; ++bj)
#pragma unroll
                    for (int n = 0; n < 2; ++n) { const f32x4 bs = *(const f32x4*)(base + off + bj * HALF + n * 16); acc[ai][bj][m][n] = bs + (acc[ai][bj][m][n] - sr.x) * sr.y; }
                asm volatile("" : "+v"(acc[ai][0][m][0]), "+v"(acc[ai][0][m][1]), "+v"(acc[ai][1][m][0]), "+v"(acc[ai][1][m][1]));
                if (m & 1) asm volatile("" ::: "memory"); }
        const bool bad1 = bad;
        bad = st2.run(acc, u, wr, wc, fr, fq, lds, wid, lane) || bad;
#pragma unroll
        for (int ai = 0; ai < 2; ++ai)
#pragma unroll
            for (int m = 0; m < 4; ++m) { const int r = ai * HALF + wr * 64 + m * 16 + fr; const f32x2v sr = S[r]; const size_t off = (size_t)(u.pm * BM + r) * ldc + col0;
#pragma unroll
                for (int bj = 0; bj < 2; ++bj)
#pragma unroll
                    for (int n = 0; n < 2; ++n) { const f32x4 x1 = acc[ai][bj][m][n]; *(f32x4*)(out + off + bj * HALF + n * 16) = bad1 ? (f32x4){qnan, qnan, qnan, qnan} : x1;
                        const f32x4 o = (x1 - sr.x) * sr.y; u32x2v w; w.x = cvt_pk_bf16(o[0], o[1]); w.y = cvt_pk_bf16(o[2], o[3]);
                        if (bad) { w.x = 0x7fc07fc0u; w.y = 0x7fc07fc0u; } *(u32x2v*)(xn + off + bj * HALF + n * 16) = w; }
                asm volatile("" ::: "memory"); }
    }
};

template <class Epi, class Sched, bool ALIGN_EPI = false, bool SP2 = false>
__device__ __forceinline__ void gemm_phase(PG8_LAS unsigned char* lds, const Gemm g, const Sched& S, const Epi& E) {
    const int tid = tidx(), wid = __builtin_amdgcn_readfirstlane(tid >> 6), lane = tid & 63, wr = wid >> 2, wc = wid & 3, fr = lane & 15, fq = lane >> 4;
    const int K = g.K, nt = K / BK;
    const int LDA = g.lda ? g.lda : K, LDB = g.ldb ? g.ldb : K;
    unsigned voffA[2], voffB[2];
#pragma unroll
    for (int i = 0; i < 2; ++i) { int R, C; stage_rc(tid * 16 + i * 8192, R, C); const int Rb = Epi::PERM ? ((R & ~31) + perm32(R & 31)) : R;
        voffA[i] = (unsigned)(R * LDA + C) * 2u; voffB[i] = (unsigned)(Rb * LDB + C) * 2u; }
    const size_t kstep = (size_t)(BK * 2);
    const size_t hstepA = (size_t)HALF * LDA * 2, hstepB = (size_t)HALF * LDB * 2;
    const size_t tstepA = 2 * hstepA, tstepB = 2 * hstepB;
    const unsigned ldsw = (unsigned)wid * 1024u;
    const int aoff = lds_byte(wr * 64 + fr, fq * 8), boff = lds_byte(wc * 32 + fr, fq * 8);
#define PG8_SA(b, h) (((b) * 2 + (h)) * HTB)
#define PG8_SB(b, h) ((4 + (b) * 2 + (h)) * HTB)
#define PG8_STAGE(bufoff, gbase, voff) do { _Pragma("unroll") for (int _i = 0; _i < 2; ++_i) \
        __builtin_amdgcn_global_load_lds((const unsigned*)((const char*)(gbase) + (voff)[_i]), (PG8_LAS unsigned*)(lds + (bufoff) + ldsw + _i * 8192), 16, 0, 0); } while (0)
#define PG8_LDA(dst, b, h) do { _Pragma("unroll") for (int m = 0; m < 4; ++m) _Pragma("unroll") for (int k = 0; k < 2; ++k) dst[m][k] = *(const PG8_LAS bf16x8*)(lds + PG8_SA(b, h) + aoff + m * 2048 + k * 1024); } while (0)
#define PG8_LDB(dst, b, h) do { _Pragma("unroll") for (int n = 0; n < 2; ++n) _Pragma("unroll") for (int k = 0; k < 2; ++k) dst[n][k] = *(const PG8_LAS bf16x8*)(lds + PG8_SB(b, h) + boff + n * 2048 + k * 1024); } while (0)
#define PG8_MMA(ai, bj, At, Bt) do { __builtin_amdgcn_s_setprio(1); _Pragma("unroll") for (int m = 0; m < 4; ++m) _Pragma("unroll") for (int n = 0; n < 2; ++n) _Pragma("unroll") for (int k = 0; k < 2; ++k) \
        acc[ai][bj][m][n] = __builtin_amdgcn_mfma_f32_16x16x32_bf16(Bt[n][k], At[m][k], acc[ai][bj][m][n], 0, 0, 0); __builtin_amdgcn_s_setprio(0); } while (0)
#define PG8_WAIT_V(n) asm volatile("s_waitcnt vmcnt(" #n ")" ::: "memory")
#define PG8_WAIT_L(n) asm volatile("s_waitcnt lgkmcnt(" #n ")" ::: "memory")
#define PG8_BAR __builtin_amdgcn_s_barrier()
#define PG8_SCHED __builtin_amdgcn_sched_barrier(0)
    Unit cur, nxt; int ui = 0;
    if (!S.next(0, cur)) return;
    f32x4 acc[2][2][4][2];
#pragma unroll
    for (int a = 0; a < 2; ++a)
#pragma unroll
        for (int b = 0; b < 2; ++b)
#pragma unroll
            for (int m = 0; m < 4; ++m)
#pragma unroll
                for (int n = 0; n < 2; ++n) acc[a][b][m][n] = (f32x4){0.f, 0.f, 0.f, 0.f};
    bf16x8 At[4][2], B0[2][2], B1[2][2];
    const char* cA = (const char*)g.A + (size_t)cur.pm * tstepA; const char* cB = (const char*)g.Bt + (size_t)cur.pn * tstepB;
    S.a_ready(cur);
    if constexpr (SP2) {
        PG8_STAGE(PG8_SB(0, 0), cB, voffB); PG8_STAGE(PG8_SB(0, 1), cB + hstepB, voffB); PG8_STAGE(PG8_SA(0, 0), cA, voffA); PG8_STAGE(PG8_SA(0, 1), cA + hstepA, voffA);
        if (wr == 1) PG8_BAR;
        PG8_WAIT_V(2); PG8_BAR;
        PG8_STAGE(PG8_SB(1, 0), cB + kstep, voffB); PG8_STAGE(PG8_SA(1, 0), cA + kstep, voffA); PG8_STAGE(PG8_SB(1, 1), cB + hstepB + kstep, voffB);
        PG8_WAIT_V(6); PG8_BAR;
    } else {
        PG8_STAGE(PG8_SB(0, 0), cB, voffB); PG8_STAGE(PG8_SA(0, 0), cA, voffA); PG8_STAGE(PG8_SB(0, 1), cB + hstepB, voffB); PG8_STAGE(PG8_SA(0, 1), cA + hstepA, voffA);
        if (wr == 1) PG8_BAR;
        PG8_WAIT_V(4); PG8_BAR;
        PG8_STAGE(PG8_SB(1, 0), cB + kstep, voffB); PG8_STAGE(PG8_SA(1, 0), cA + kstep, voffA); PG8_STAGE(PG8_SB(1, 1), cB + hstepB + kstep, voffB);
        PG8_WAIT_V(6); PG8_BAR;
    }
    for (;;) {
        const bool has_next = S.next(ui + 1, nxt);
        const char* nA = has_next ? (const char*)g.A + (size_t)nxt.pm * tstepA : cA; const char* nB = has_next ? (const char*)g.Bt + (size_t)nxt.pn * tstepB : cB;
        for (int t = 0; t < nt; t += 2) {
            const bool last = (t == nt - 2);
            const char* a1 = cA + (size_t)(t + 1) * kstep;
            const char* a2 = last ? nA : cA + (size_t)(t + 2) * kstep; const char* b2 = last ? nB : cB + (size_t)(t + 2) * kstep;
            const char* a3 = a2 + kstep; const char* b3 = b2 + kstep;
            if (last && has_next) S.a_ready(nxt);
            if constexpr (SP2) {
            PG8_LDB(B0, 0, 0); PG8_LDB(B1, 0, 1); PG8_SCHED; PG8_LDA(At, 0, 0); PG8_STAGE(PG8_SA(1, 1), a1 + hstepA, voffA);
            PG8_WAIT_V(8); PG8_WAIT_L(0); PG8_BAR; PG8_MMA(0, 0, At, B0); PG8_MMA(0, 1, At, B1); PG8_BAR; PG8_SCHED;
            PG8_LDA(At, 0, 1); PG8_STAGE(PG8_SB(0, 0), b2, voffB); PG8_STAGE(PG8_SB(0, 1), b2 + hstepB, voffB); PG8_STAGE(PG8_SA(0, 0), a2, voffA);
            PG8_WAIT_V(8); PG8_WAIT_L(0); PG8_BAR; PG8_MMA(1, 0, At, B0); PG8_MMA(1, 1, At, B1); PG8_BAR; PG8_SCHED;
            PG8_LDB(B0, 1, 0); PG8_LDB(B1, 1, 1); PG8_SCHED; PG8_LDA(At, 1, 0); PG8_STAGE(PG8_SA(0, 1), a2 + hstepA, voffA);
            PG8_WAIT_V(8); PG8_WAIT_L(0); PG8_BAR; PG8_MMA(0, 0, At, B0); PG8_MMA(0, 1, At, B1); PG8_BAR; PG8_SCHED;
            PG8_LDA(At, 1, 1); PG8_STAGE(PG8_SB(1, 0), b3, voffB); PG8_STAGE(PG8_SB(1, 1), b3 + hstepB, voffB); PG8_STAGE(PG8_SA(1, 0), a3, voffA);
            PG8_WAIT_V(8); PG8_WAIT_L(0); PG8_BAR; PG8_MMA(1, 0, At, B0); PG8_MMA(1, 1, At, B1); PG8_BAR; PG8_SCHED;
            } else {
            PG8_LDB(B0, 0, 0); PG8_SCHED; PG8_LDA(At, 0, 0); PG8_STAGE(PG8_SA(1, 1), a1 + hstepA, voffA);
            PG8_WAIT_L(8); PG8_BAR; PG8_WAIT_L(0); PG8_MMA(0, 0, At, B0); PG8_BAR; PG8_SCHED;
            PG8_LDB(B1, 0, 1); PG8_STAGE(PG8_SB(0, 0), b2, voffB);
            PG8_BAR; PG8_WAIT_L(0); PG8_MMA(0, 1, At, B1); PG8_BAR;
            PG8_LDA(At, 0, 1); PG8_STAGE(PG8_SA(0, 0), a2, voffA);
            PG8_BAR; PG8_WAIT_L(0); PG8_MMA(1, 0, At, B0); PG8_BAR; PG8_SCHED;
            PG8_STAGE(PG8_SB(0, 1), b2 + hstepB, voffB);
            PG8_WAIT_V(6); PG8_BAR; PG8_MMA(1, 1, At, B1); PG8_BAR;
            PG8_LDB(B0, 1, 0); PG8_SCHED; PG8_LDA(At, 1, 0); PG8_STAGE(PG8_SA(0, 1), a2 + hstepA, voffA);
            PG8_WAIT_L(8); PG8_BAR; PG8_WAIT_L(0); PG8_MMA(0, 0, At, B0); PG8_BAR; PG8_SCHED;
            PG8_LDB(B1, 1, 1); PG8_STAGE(PG8_SB(1, 0), b3, voffB);
            PG8_BAR; PG8_WAIT_L(0); PG8_MMA(0, 1, At, B1); PG8_BAR;
            PG8_LDA(At, 1, 1); PG8_STAGE(PG8_SA(1, 0), a3, voffA);
            PG8_BAR; PG8_WAIT_L(0); PG8_MMA(1, 0, At, B0); PG8_BAR; PG8_SCHED;
            PG8_STAGE(PG8_SB(1, 1), b3 + hstepB, voffB);
            PG8_WAIT_V(6); PG8_BAR; PG8_MMA(1, 1, At, B1); PG8_BAR;
            }
        }
        if constexpr (ALIGN_EPI) { if (wr == 0) PG8_BAR; }
        if constexpr (!Epi::AFTER_DRAIN) { E(acc, cur, wr, wc, fr, fq); S.done(cur); }
        if (!has_next) break;
#pragma unroll
        for (int a = 0; a < 2; ++a)
#pragma unroll
            for (int b = 0; b < 2; ++b)
#pragma unroll
                for (int m = 0; m < 4; ++m)
#pragma unroll
                    for (int n = 0; n < 2; ++n) acc[a][b][m][n] = (f32x4){0.f, 0.f, 0.f, 0.f};
        cur = nxt; cA = nA; cB = nB; ++ui;
        if constexpr (ALIGN_EPI) { if (wr == 1) PG8_BAR; }
    }
    PG8_WAIT_V(0);
    if constexpr (!ALIGN_EPI) { if (wr == 0) PG8_BAR; }
    PG8_BAR;
    if constexpr (Epi::AFTER_DRAIN) { E.fused(acc, cur, wr, wc, fr, fq, lds, wid, lane); S.done(cur); }
#undef PG8_SA
#undef PG8_SB
#undef PG8_STAGE
#undef PG8_LDA
#undef PG8_LDB
#undef PG8_MMA
#undef PG8_WAIT_V
#undef PG8_WAIT_L
#undef PG8_BAR
#undef PG8_SCHED
}
}
namespace pg8 {
struct EpiF32 {
    static constexpr bool PERM = false, AFTER_DRAIN = false;
    float* C; int ldc; const float* bias;
    __device__ __forceinline__ void operator()(const f32x4 (&acc)[2][2][4][2], const Unit& u, int wr, int wc, int fr, int fq) const {
        const int row0 = u.pm * BM + wr * 64 + fr, col0 = u.pn * BM + wc * 32 + 4 * fq;
        f32x4 bv[2][2];
#pragma unroll
        for (int bj = 0; bj < 2; ++bj)
#pragma unroll
            for (int n = 0; n < 2; ++n) bv[bj][n] = bias ? *(const f32x4*)(bias + col0 + bj * HALF + n * 16) : (f32x4){0.f, 0.f, 0.f, 0.f};
#pragma unroll
        for (int ai = 0; ai < 2; ++ai)
#pragma unroll
            for (int m = 0; m < 4; ++m) { float* rowp = C + (size_t)(row0 + ai * HALF + m * 16) * ldc + col0;
#pragma unroll
                for (int bj = 0; bj < 2; ++bj)
#pragma unroll
                    for (int n = 0; n < 2; ++n) *(f32x4*)(rowp + bj * HALF + n * 16) = acc[ai][bj][m][n] + bv[bj][n]; }
    }
};
}
#define XB_TMO      128
#define XB_XCNT(j)  (256  + 64 * (j))
#define XB_XSUB(j)  (1280 + 64 * (j))
#define XB_XGEN(j)  (2304 + 64 * (j))
#define XB_TOP      3328
#define XB_TOPGEN   3392
#define XCD_BAR_WORDS 3456
#define XB_SPIN_CAP (1u << 18)

__device__ __forceinline__ unsigned xb_ld(unsigned* p)              { return __hip_atomic_load(p, __ATOMIC_RELAXED, __HIP_MEMORY_SCOPE_AGENT); }
__device__ __forceinline__ unsigned xb_add(unsigned* p, unsigned v) { return __hip_atomic_fetch_add(p, v, __ATOMIC_RELAXED, __HIP_MEMORY_SCOPE_AGENT); }
__device__ __forceinline__ unsigned xb_xcc_id() { return (unsigned)__builtin_amdgcn_s_getreg((3 << 11) | 20) & 0xFu; }
#define XB_SPIN(cond, bar) do { unsigned _sp = 0; while (cond) { __builtin_amdgcn_s_sleep(1); \
    if ((++_sp & 255u) == 0u) { if (xb_ld(&(bar)[XB_TMO])) break; if (_sp > XB_SPIN_CAP) { atomicAdd(&(bar)[XB_TMO], 1u); break; } } } } while (0)

struct XcdBarrier {
    unsigned* bar; unsigned x;
    volatile LAS unsigned* st;
};

__device__ __forceinline__ XcdBarrier xcd_barrier_post(unsigned* bar, volatile LAS unsigned* st) {
    XcdBarrier b; b.bar = bar; b.x = xb_xcc_id(); b.st = st;
    if (threadIdx.x == 0) (void)xb_add(&bar[XB_XCNT(b.x)], 1u);
    return b;
}
__device__ __forceinline__ void xcd_barrier_complete(unsigned* bar, unsigned x, unsigned& nloc, unsigned& nx) {
    const unsigned G = gridDim.x * gridDim.y * gridDim.z;
    unsigned sum, cnt, mine, sp = 0u;
    for (;;) {
        sum = 0u; cnt = 0u; mine = 0u;
#pragma unroll
        for (unsigned j = 0; j < 16; ++j) { const unsigned c = xb_ld(&bar[XB_XCNT(j)]); sum += c; cnt += (c > 0u) ? 1u : 0u; mine = (j == x) ? c : mine; }
        if (sum == G) break;
        __builtin_amdgcn_s_sleep(1);
        if ((++sp & 255u) == 0u) { if (xb_ld(&bar[XB_TMO])) break; if (sp > XB_SPIN_CAP) { atomicAdd(&bar[XB_TMO], 1u); break; } }
    }
    nloc = mine > 0u ? mine : 1u; nx = cnt > 0u ? cnt : 1u;
}

__device__ __forceinline__ void xcd_barrier(const XcdBarrier& b) {
    asm volatile("s_waitcnt vmcnt(0)" ::: "memory");
    __syncthreads();
    if (threadIdx.x == 0) {
        unsigned* bar = b.bar;
        __builtin_amdgcn_s_waitcnt(0);
        unsigned nloc = b.st[0], nx = b.st[1];
        if (nloc == 0u) { xcd_barrier_complete(bar, b.x, nloc, nx); b.st[0] = nloc; b.st[1] = nx; }
        const unsigned old = xb_add(&bar[XB_XSUB(b.x)], 1u);
        const unsigned gen = old / nloc;
        if (old + 1u == (gen + 1u) * nloc) {
            __builtin_amdgcn_fence(__ATOMIC_RELEASE, "agent");
            asm volatile("s_waitcnt vmcnt(0)" ::: "memory");
            const unsigned og = xb_add(&bar[XB_TOP], 1u);
            const unsigned tg = og / nx;
            if (og + 1u == (tg + 1u) * nx) xb_add(&bar[XB_TOPGEN], 1u);
            else XB_SPIN(xb_ld(&bar[XB_TOPGEN]) == tg, bar);
            __builtin_amdgcn_fence(__ATOMIC_ACQUIRE, "agent");
            xb_add(&bar[XB_XGEN(b.x)], 1u);
            asm volatile("s_waitcnt vmcnt(0)" ::: "memory");
        } else {
            XB_SPIN(xb_ld(&bar[XB_XGEN(b.x)]) == gen, bar);
            __builtin_amdgcn_fence(__ATOMIC_ACQUIRE, "agent");
            asm volatile("s_waitcnt vmcnt(0)" ::: "memory");
        }
    }
    __syncthreads();
}

DEVI float wave_sum(float v) {
#pragma unroll
    for (int o = 32; o > 0; o >>= 1) v += __shfl_xor(v, o, 64);
    return v;
}
DEVI float wave_max(float v) {
#pragma unroll
    for (int o = 32; o > 0; o >>= 1) v = fmaxf(v, __shfl_xor(v, o, 64));
    return v;
}
DEVI float sigm(float x) { return 1.f / (1.f + expf(-x)); }
DEVI float gelu_t(float x) { return 0.5f * x * (1.f + tanhf(0.7978845608028654f * (x + 0.044715f * x * x * x))); }
DEVI float softplus_(float x) { return fmaxf(x, 0.f) + log1pf(expf(-fabsf(x))); }

DEVI float block_sum256(float v, float* red, int tid) {
    v = wave_sum(v);
    __syncthreads();
    if ((tid & 63) == 0) red[tid >> 6] = v;
    __syncthreads();
    return red[0] + red[1] + red[2] + red[3];
}

DEVI void ln_kernel(const float* xres, float alpha, const float* add, const float* __restrict__ g, const float* __restrict__ bt,
                    float* out, bf16* outb, int bid, float* sm) {
    __syncthreads();
    const size_t row = bid;
    const int tid = tidx() & 255;
    float v[4];
#pragma unroll
    for (int i = 0; i < 4; ++i) {
        const size_t idx = row * DM + tid + i * 256;
        v[i] = alpha * xres[idx] + (add ? add[idx] : 0.f);
    }
    const float mean = block_sum256(v[0] + v[1] + v[2] + v[3], sm, tid) * (1.f / DM);
    float q = 0.f;
#pragma unroll
    for (int i = 0; i < 4; ++i) { v[i] -= mean; q += v[i] * v[i]; }
    const float var = block_sum256(q, sm, tid) * (1.f / DM);
    const float rstd = rsqrtf(var + 1e-5f);
#pragma unroll
    for (int i = 0; i < 4; ++i) {
        const int c = tid + i * 256;
        const float o = v[i] * rstd * g[c] + bt[c];
        out[row * DM + c] = o;
        outb[row * DM + c] = (bf16)f2bf(o);
    }
}

struct GemmArgs {
    const float* A; const float* B; float* C; const int* rowidx; const int* zoff;
    long lda, sbk, sbn, ldc, sAz0, sAz1, sBz0, sBz1, sCz0, sCz1;
    int M, N, K, Z1, epi, pad;
};
DEVI void gemm_f32(const GemmArgs& g, int bx, int by, int z, bool live, float* sm) {
    float (*As)[68] = (float (*)[68])sm;
    float (*Bs)[68] = (float (*)[68])(sm + 16 * 68);
    const int z0 = z / g.Z1, z1 = z % g.Z1;
    int mbeg = 0, mend = g.M;
    if (g.zoff) { mbeg = g.zoff[z]; mend = g.zoff[z + 1]; }
    const int m0 = mbeg + by * 64;
    if (!live) mend = 0;
    const int n0 = bx * 64;
    const float* A = g.A + z0 * g.sAz0 + z1 * g.sAz1;
    const float* B = g.B + z0 * g.sBz0 + z1 * g.sBz1;
    float* C = g.C + z0 * g.sCz0 + z1 * g.sCz1;
    const int tid = tidx() & 255, tx = tid & 15, ty = tid >> 4;
    float acc[4][4];
#pragma unroll
    for (int i = 0; i < 4; ++i)
#pragma unroll
        for (int j = 0; j < 4; ++j) acc[i][j] = 0.f;
    long arow[4];
#pragma unroll
    for (int i = 0; i < 4; ++i) {
        const int r = (tid + i * 256) >> 4;
        const int row = m0 + r;
        if (row < mend) arow[i] = (long)(g.rowidx ? g.rowidx[row] : row) * g.lda; else arow[i] = -1;
    }
    __syncthreads();
    for (int k0 = 0; k0 < g.K; k0 += 16) {
#pragma unroll
        for (int i = 0; i < 4; ++i) {
            const int e = tid + i * 256, r = e >> 4, kk = e & 15;
            float v = 0.f;
            if (arow[i] >= 0 && k0 + kk < g.K) v = A[arow[i] + k0 + kk];
            As[kk][r] = v;
        }
#pragma unroll
        for (int i = 0; i < 4; ++i) {
            const int e = tid + i * 256, kk = e >> 6, n = e & 63;
            float v = 0.f;
            if (m0 < mend && n0 + n < g.N && k0 + kk < g.K) v = B[(long)(k0 + kk) * g.sbk + (long)(n0 + n) * g.sbn];
            Bs[kk][n] = v;
        }
        __syncthreads();
#pragma unroll
        for (int kk = 0; kk < 16; ++kk) {
            float a[4], b[4];
#pragma unroll
            for (int i = 0; i < 4; ++i) a[i] = As[kk][ty * 4 + i];
#pragma unroll
            for (int j = 0; j < 4; ++j) b[j] = Bs[kk][tx * 4 + j];
#pragma unroll
            for (int i = 0; i < 4; ++i)
#pragma unroll
                for (int j = 0; j < 4; ++j) acc[i][j] = fmaf(a[i], b[j], acc[i][j]);
        }
        __syncthreads();
    }
#pragma unroll
    for (int i = 0; i < 4; ++i) {
        const int row = m0 + ty * 4 + i;
        if (row >= mend) continue;
#pragma unroll
        for (int j = 0; j < 4; ++j) {
            const int col = n0 + tx * 4 + j;
            if (col >= g.N) continue;
            float* p = C + (long)row * g.ldc + col;
            float v = acc[i][j];
            if (g.epi == 2) { ((bf16*)C)[(long)row * g.ldc + col] = (bf16)f2bf(v); continue; }
            if (g.epi == 3) { ((bf16*)C)[(long)(row >> 9) * 64 * 512 + (long)col * 512 + (row & 511)] = (bf16)f2bf(v); continue; }
            if (g.epi == 1) { v = v * sigm(v) * (*p); }
            *p = v;
        }
    }
}
DEVI GemmArgs mk(const float* A, long lda, const float* B, long sbk, long sbn, float* C, long ldc, int M, int N, int K,
                 int Z1 = 1, long sAz0 = 0, long sAz1 = 0, long sBz0 = 0, long sBz1 = 0, long sCz0 = 0, long sCz1 = 0,
                 const int* rowidx = nullptr, const int* zoff = nullptr, int epi = 0) {
    GemmArgs g;
    g.A = A; g.B = B; g.C = C; g.rowidx = rowidx; g.zoff = zoff;
    g.lda = lda; g.sbk = sbk; g.sbn = sbn; g.ldc = ldc;
    g.sAz0 = sAz0; g.sAz1 = sAz1; g.sBz0 = sBz0; g.sBz1 = sBz1; g.sCz0 = sCz0; g.sCz1 = sCz1;
    g.M = M; g.N = N; g.K = K; g.Z1 = Z1; g.epi = epi; g.pad = 0;
    return g;
}
DEVI int gemm_tiles(const GemmArgs& g, int maxM, int Z) { return ((g.N + 63) / 64) * ((maxM + 63) / 64) * Z; }
DEVI bool gemm_tile_live(const GemmArgs& g, int maxM, int t) {
    const int nbx = (g.N + 63) / 64, nby = (maxM + 63) / 64;
    const int r = t / nbx, by = r % nby, z = r / nby;
    int mbeg = 0, mend = g.M;
    if (g.zoff) { mbeg = g.zoff[z]; mend = g.zoff[z + 1]; }
    return mbeg + by * 64 < mend;
}
DEVI void gemm_tile(const GemmArgs& g, int maxM, int t, bool live, float* sm) {
    const int nbx = (g.N + 63) / 64, nby = (maxM + 63) / 64;
    const int bx = t % nbx, r = t / nbx;
    gemm_f32(g, bx, r % nby, r / nby, live, sm);
}

DEVI void glu_kernel(const bf16* __restrict__ cols, float* __restrict__ h, int bid) {
    const size_t t = bid; const int c = tidx() & 255;
    h[t * 256 + c] = bf2f(cols[t * DINP + OFF_CV + c]) * sigm(bf2f(cols[t * DINP + OFF_CG + c]));
}
DEVI void conv_kernel(const float* __restrict__ h, const float* __restrict__ w, const float* __restrict__ bias,
                      const float* __restrict__ gg, const float* __restrict__ gb, bf16* __restrict__ mix, int bid) {
    const int t = bid, c = tidx() & 255;
    float acc = bias[c];
#pragma unroll 4
    for (int j = 0; j < 31; ++j) {
        const int tt = t - 30 + j;
        if (tt >= 0) acc = fmaf(h[(size_t)tt * 256 + c], w[j * 256 + c], acc);
    }
    const float mean = wave_sum(acc) * (1.f / 64.f);
    const float d = acc - mean;
    const float var = wave_sum(d * d) * (1.f / 64.f);
    const float y = d * rsqrtf(var + 1e-5f) * gg[c] + gb[c];
    mix[(size_t)t * DM + 0 + c] = (bf16)f2bf(y * sigm(y));
}

DEVI void gmlp_pre(const bf16* __restrict__ cols, const float* __restrict__ lg, const float* __restrict__ lb,
                   float* __restrict__ ub, float* __restrict__ vb, int bid, float* sm) {
    __syncthreads();
    const size_t t = bid; const int c = tidx() & 255;
    ub[t * 256 + c] = gelu_t(bf2f(cols[t * DINP + OFF_GU + c]));
    const float v = gelu_t(bf2f(cols[t * DINP + OFF_GV + c]));
    const float mean = block_sum256(v, sm, c) * (1.f / 256.f);
    const float d = v - mean;
    const float var = block_sum256(d * d, sm, c) * (1.f / 256.f);
    vb[t * 256 + c] = d * rsqrtf(var + 1e-5f) * lg[c] + lb[c];
}
DEVI void gmlp_mix(const float* __restrict__ ub, const float* __restrict__ vb, const float* __restrict__ ws,
                   const float* __restrict__ bs, bf16* __restrict__ mix, int bid) {
    const int t = bid, c = tidx() & 255, h = c >> 6, tt = t & 127, base = t - tt;
    float acc = bs[h * 128 + tt];
    const float* wr = ws + ((size_t)h * 128 + tt) * 128;
#pragma unroll 4
    for (int s = 0; s <= tt; ++s) acc = fmaf(wr[s], vb[(size_t)(base + s) * 256 + c], acc);
    mix[(size_t)t * DM + 512 + c] = (bf16)f2bf(ub[(size_t)t * 256 + c] * acc);
}

struct RwkvP {
    const bf16* cols; const float* mu; const float* w0; const float* w_up; const float* a0; const float* a_up; const float* g_up;
    const float* k_k; const float* k_a; const float* r_k; const float* vd; const float* v_mu; const float* v0; const float* v_up;
    float* vfirst; bf16* R; float* LW; bf16* K; bf16* V; bf16* A; bf16* Bv; float* G; float* BON;
    int layer, pad;
};
DEVI void rwkv_prep(const RwkvP& p, int bid, float* sm) {
    __syncthreads();
    float* y = sm;
    float* vds = sm + 1024;
    const int t = bid, c = tidx() & 255;
#pragma unroll
    for (int q = 0; q < 4; ++q) {
        const int j = c + q * 256;
        const float cur = bf2f(p.cols[(size_t)t * DINP + OFF_RW + j]);
        const float prv = t > 0 ? bf2f(p.cols[(size_t)(t - 1) * DINP + OFF_RW + j]) : 0.f;
        y[j] = cur + p.mu[j] * (prv - cur);
    }
    if (p.layer > 0 && c < 32) {
        const float cur = bf2f(p.cols[(size_t)t * DINP + DIN + c]);
        const float prv = t > 0 ? bf2f(p.cols[(size_t)(t - 1) * DINP + DIN + c]) : 0.f;
        vds[c] = cur + p.v_mu[c] * (prv - cur);
    }
    __syncthreads();
    float tw = 0.f, sg = 0.f;
    if (c < 64) tw = tanhf(y[768 + c]);
    if (c >= 128) sg = sigm(y[896 + (c - 128)]);
    __syncthreads();
    if (c < 64) y[768 + c] = tw;
    if (c >= 128) y[896 + (c - 128)] = sg;
    __syncthreads();
    const float r = y[c], k = y[256 + c];
    float v = y[512 + c];
    float wl = p.w0[c], al = p.a0[c], gl = 0.f;
#pragma unroll 4
    for (int j = 0; j < 64; ++j) { wl = fmaf(y[768 + j], p.w_up[j * 256 + c], wl); al = fmaf(y[832 + j], p.a_up[j * 256 + c], al); }
#pragma unroll 4
    for (int j = 0; j < 128; ++j) gl = fmaf(y[896 + j], p.g_up[j * 256 + c], gl);
    const float wlog = -softplus_(-wl) - 0.5f;
    const float a = sigm(al);
    if (p.layer == 0) {
        p.vfirst[(size_t)t * 256 + c] = v;
    } else {
        float vm = p.v0[c];
#pragma unroll 4
        for (int j = 0; j < 32; ++j) vm = fmaf(vds[j], p.v_up[j * 256 + c], vm);
        vm = sigm(vm);
        v = v + (p.vfirst[(size_t)t * 256 + c] - v) * vm;
    }
    float kk = k * p.k_k[c];
    const float nrm = sqrtf(wave_sum(kk * kk));
    kk = kk / fmaxf(nrm, 1e-12f);
    const float k2 = k * (1.f + (a - 1.f) * p.k_a[c]);
    const float bd = wave_sum(r * k2 * p.r_k[c]);
    const size_t o = (size_t)t * 256 + c;
    p.R[o] = (bf16)f2bf(r); p.LW[o] = -expf(wlog); p.K[o] = (bf16)f2bf(k2); p.V[o] = (bf16)f2bf(v); p.A[o] = (bf16)f2bf(-kk); p.Bv[o] = (bf16)f2bf(kk * a); p.G[o] = gl; p.BON[o] = bd * v;
}
DEVI void rwkv_scan(float* R, const float* __restrict__ W, const float* __restrict__ K, const float* __restrict__ V,
                    const float* __restrict__ A, const float* __restrict__ Bv, float* sm0) {
    float (*sr)[256] = (float (*)[256])sm0, (*sw)[256] = sr + 4, (*sk)[256] = sr + 8, (*sa)[256] = sr + 12, (*sb)[256] = sr + 16, (*sv)[256] = sr + 20;
    const int vt = tidx(); const bool act = vt < 256;
    const int tid = vt & 255, h = tid >> 6, lane = tid & 63;
    float st[64];
#pragma unroll
    for (int i = 0; i < 64; ++i) st[i] = 0.f;
    for (int t0 = 0; t0 < SEQ; t0 += 4) {
        __syncthreads();
        if (act) {
#pragma unroll
            for (int s = 0; s < 4; ++s) {
                const size_t idx = (size_t)(t0 + s) * 256 + tid;
                sr[s][tid] = R[idx]; sw[s][tid] = W[idx]; sk[s][tid] = K[idx]; sa[s][tid] = A[idx]; sb[s][tid] = Bv[idx]; sv[s][tid] = V[idx];
            }
        }
        __syncthreads();
        if (act) {
#pragma unroll 1
            for (int s = 0; s < 4; ++s) {
                const float vt_ = sv[s][tid];
                const float* pa = &sa[s][h * 64]; const float* pw = &sw[s][h * 64]; const float* pb = &sb[s][h * 64];
                const float* pk = &sk[s][h * 64]; const float* pr = &sr[s][h * 64];
                float sa_ = 0.f;
#pragma unroll
                for (int k = 0; k < 64; ++k) sa_ = fmaf(st[k], pa[k], sa_);
#pragma unroll
                for (int k = 0; k < 64; ++k) st[k] = fmaf(st[k], pw[k], fmaf(sa_, pb[k], vt_ * pk[k]));
                float o = 0.f;
#pragma unroll
                for (int k = 0; k < 64; ++k) o = fmaf(st[k], pr[k], o);
                R[(size_t)(t0 + s) * 256 + h * 64 + lane] = o;
            }
        }
    }
    __syncthreads();
}
DEVI void rwkv_post(const float* __restrict__ O, const float* __restrict__ BON, const float* __restrict__ G,
                    const float* __restrict__ gg, const float* __restrict__ gb, bf16* __restrict__ mix, int bid) {
    const size_t t = bid; const int c = tidx() & 255;
    const float o = O[t * 256 + c];
    const float mean = wave_sum(o) * (1.f / 64.f);
    const float d = o - mean;
    const float var = wave_sum(d * d) * (1.f / 64.f);
    const float y = d * rsqrtf(var + 64e-5f) * gg[c] + gb[c];
    mix[t * DM + 256 + c] = (bf16)f2bf((y + BON[t * 256 + c]) * G[t * 256 + c]);
}

DEVI void nsa_prep(const bf16* __restrict__ cols, float* __restrict__ qrot, float* __restrict__ ksr,
                   float* __restrict__ kwr, float* __restrict__ gates, int bid) {
    const int t = bid, c = tidx() & 255;
    const int d = c & 63, j = d & 31;
    const float inv = powf(10000.f, -(float)j / 32.f);
    const float ang = (float)t * inv;
    float sn, cs; sincosf(ang, &sn, &cs);
    {
        const bf16* q = cols + (size_t)t * DINP + OFF_Q + (c & ~63);
        const float x1 = bf2f(q[j]), x2 = bf2f(q[j + 32]);
        qrot[(size_t)t * 256 + c] = d < 32 ? x1 * cs - x2 * sn : x2 * cs + x1 * sn;
    }
    if (c < 128) {
        const bf16* kp = cols + (size_t)t * DINP + (c < 64 ? OFF_KS : OFF_KW);
        const float x1 = bf2f(kp[j]), x2 = bf2f(kp[j + 32]);
        const float v = d < 32 ? x1 * cs - x2 * sn : x2 * cs + x1 * sn;
        if (c < 64) ksr[(size_t)t * 64 + d] = v; else kwr[(size_t)t * 64 + d] = v;
    }
    if (c < 12) gates[(size_t)t * 12 + c] = sigm(bf2f(cols[(size_t)t * DINP + OFF_GT + c]));
}
DEVI void cmp_gather(const bf16* __restrict__ cols, const float* __restrict__ pek, const float* __restrict__ pev,
                     bf16* __restrict__ bk, bf16* __restrict__ bv, int bid) {
    const int n = bid, tid = tidx() & 255;
    for (int i = tid; i < 2048; i += 256) {
        const int l = i >> 6, d = i & 63;
        const size_t row = (size_t)(16 * n + l) * DINP;
        bk[(size_t)n * 2048 + i] = n < NCMP ? (bf16)f2bf(bf2f(cols[row + OFF_KC + d]) + pek[i]) : (bf16)0;
        bv[(size_t)n * 2048 + i] = n < NCMP ? (bf16)f2bf(bf2f(cols[row + OFF_VC + d]) + pev[i]) : (bf16)0;
    }
}
DEVI void gelu_inplace(float* p, int n, int bid) {
    const int i = bid * 256 + (tidx() & 255);
    if (i < n) p[i] = gelu_t(p[i]);
}

DEVI void wave_softmax(float* s, int n, int lane) {
    float m = -INFINITY;
    for (int i = lane; i < n; i += 64) m = fmaxf(m, s[i]);
    m = wave_max(m);
    if (m == -INFINITY) { for (int i = lane; i < n; i += 64) s[i] = 0.f; return; }
    float sum = 0.f;
    for (int i = lane; i < n; i += 64) { const float p = expf(s[i] - m); s[i] = p; sum += p; }
    sum = wave_sum(sum);
    const float inv = 1.f / fmaxf(sum, 1e-20f);
    for (int i = lane; i < n; i += 64) s[i] *= inv;
}
DEVI void dot4(const float* q  , const float* __restrict__ krow, float* out4) {
    float a0 = 0.f, a1 = 0.f, a2 = 0.f, a3 = 0.f;
#pragma unroll
    for (int d = 0; d < 64; d += 4) {
        const float4 kv = *(const float4*)(krow + d);
        a0 += q[d] * kv.x + q[d + 1] * kv.y + q[d + 2] * kv.z + q[d + 3] * kv.w;
        a1 += q[64 + d] * kv.x + q[64 + d + 1] * kv.y + q[64 + d + 2] * kv.z + q[64 + d + 3] * kv.w;
        a2 += q[128 + d] * kv.x + q[128 + d + 1] * kv.y + q[128 + d + 2] * kv.z + q[128 + d + 3] * kv.w;
        a3 += q[192 + d] * kv.x + q[192 + d + 1] * kv.y + q[192 + d + 2] * kv.z + q[192 + d + 3] * kv.w;
    }
    out4[0] = a0; out4[1] = a1; out4[2] = a2; out4[3] = a3;
}
DEVI void nsa_attn(const bf16* __restrict__ cols, const float* __restrict__ qrot, const float* __restrict__ ksr,
                   const float* __restrict__ kwr, const float* __restrict__ gates, const float* __restrict__ kcmp,
                   const float* __restrict__ vcmp, bf16* __restrict__ mix, int bid, float* sm) {
    __syncthreads();
    float* q = sm; float* qr = sm + 256;
    float (*sc)[1024] = (float (*)[1024])(sm + 512);
    float* imp = sm + 512 + 4096;
    int* sel = (int*)(sm + 512 + 4096 + 128);
    const int pos = bid, tid = tidx() & 255, h = tid >> 6, lane = tid & 63;
    q[tid] = bf2f(cols[(size_t)pos * DINP + OFF_Q + tid]);
    qr[tid] = qrot[(size_t)pos * 256 + tid];
    __syncthreads();
    int ncv = pos >= 31 ? (pos - 31) / 16 + 1 : 0;
    if (ncv > NCMP) ncv = NCMP;
    for (int n = tid; n < 512; n += 256) {
        if (n < ncv) {
            float d4[4]; dot4(q, kcmp + (size_t)n * 64, d4);
            sc[0][n] = d4[0] * 0.125f; sc[1][n] = d4[1] * 0.125f; sc[2][n] = d4[2] * 0.125f; sc[3][n] = d4[3] * 0.125f;
        } else { sc[0][n] = 0.f; sc[1][n] = 0.f; sc[2][n] = 0.f; sc[3][n] = 0.f; }
    }
    __syncthreads();
    wave_softmax(sc[h], ncv, lane);
    __syncthreads();
    float oc = 0.f;
#pragma unroll 4
    for (int n = 0; n < ncv; ++n) oc = fmaf(sc[h][n], vcmp[(size_t)n * 64 + lane], oc);
    if (tid < 128) {
        const int j = tid;
        auto ps = [&](int n) -> float { return (n >= 0 && n < 512) ? (sc[0][n] + sc[1][n] + sc[2][n] + sc[3][n]) : 0.f; };
        const float v = 0.5f * ps(4 * j - 1) + ps(4 * j) + ps(4 * j + 1) + ps(4 * j + 2) + 0.5f * ps(4 * j + 3);
        const int cur = pos >> 6;
        float key;
        if (j == cur || j == 0) key = INFINITY; else if (j <= cur) key = v; else key = -1.f;
        imp[j] = key;
    }
    __syncthreads();
    if (h == 0) {
        float v0 = imp[lane], v1 = imp[lane + 64];
        for (int r = 0; r < 16; ++r) {
            float bv; int bi;
            if (v1 > v0) { bv = v1; bi = lane + 64; } else { bv = v0; bi = lane; }
#pragma unroll
            for (int o = 32; o > 0; o >>= 1) {
                const float ov = __shfl_xor(bv, o, 64); const int oi = __shfl_xor(bi, o, 64);
                if (ov > bv || (ov == bv && oi < bi)) { bv = ov; bi = oi; }
            }
            if (lane == 0) sel[r] = bi;
            if (bi == lane) v0 = -2.f;
            if (bi == lane + 64) v1 = -2.f;
        }
    }
    __syncthreads();
    for (int i = tid; i < 1024; i += 256) {
        const int kp = sel[i >> 6] * 64 + (i & 63);
        if (kp <= pos) {
            float d4[4]; dot4(qr, ksr + (size_t)kp * 64, d4);
            sc[0][i] = d4[0] * 0.125f; sc[1][i] = d4[1] * 0.125f; sc[2][i] = d4[2] * 0.125f; sc[3][i] = d4[3] * 0.125f;
        } else { sc[0][i] = -INFINITY; sc[1][i] = -INFINITY; sc[2][i] = -INFINITY; sc[3][i] = -INFINITY; }
    }
    __syncthreads();
    wave_softmax(sc[h], 1024, lane);
    __syncthreads();
    float os = 0.f;
#pragma unroll 2
    for (int i = 0; i < 1024; ++i) {
        const float p = sc[h][i];
        if (p != 0.f) { const int kp = sel[i >> 6] * 64 + (i & 63); os = fmaf(p, bf2f(cols[(size_t)kp * DINP + OFF_VS + lane]), os); }
    }
    __syncthreads();
    for (int i = tid; i < 512; i += 256) {
        const int kp = pos - 511 + i;
        if (kp >= 0) {
            float d4[4]; dot4(qr, kwr + (size_t)kp * 64, d4);
            sc[0][i] = d4[0] * 0.125f; sc[1][i] = d4[1] * 0.125f; sc[2][i] = d4[2] * 0.125f; sc[3][i] = d4[3] * 0.125f;
        } else { sc[0][i] = -INFINITY; sc[1][i] = -INFINITY; sc[2][i] = -INFINITY; sc[3][i] = -INFINITY; }
    }
    __syncthreads();
    wave_softmax(sc[h], 512, lane);
    __syncthreads();
    float ow = 0.f;
#pragma unroll 4
    for (int i = 0; i < 512; ++i) {
        const int kp = pos - 511 + i;
        if (kp >= 0) ow = fmaf(sc[h][i], bf2f(cols[(size_t)kp * DINP + OFF_VW + lane]), ow);
    }
    const float* gt = gates + (size_t)pos * 12 + h * 3;
    mix[(size_t)pos * DM + 768 + tid] = (bf16)f2bf(gt[0] * oc + gt[1] * os + gt[2] * ow);
}

DEVI void softmax256(float* s, float scale, int bid, float* sm) {
    __syncthreads();
    const size_t row = bid; const int tid = tidx() & 255;
    const float v = s[row * 256 + tid] * scale;
    float m = wave_max(v);
    if ((tid & 63) == 0) sm[8 + (tid >> 6)] = m;
    __syncthreads();
    m = fmaxf(fmaxf(sm[8], sm[9]), fmaxf(sm[10], sm[11]));
    const float p = expf(v - m);
    const float sum = block_sum256(p, sm, tid);
    s[row * 256 + tid] = p / sum;
}

DEVI void router_kernel(const float* __restrict__ x, const float* __restrict__ rw, const float* __restrict__ rb,
                        int* __restrict__ te, float* __restrict__ tw, int bid, float* sm) {
    __syncthreads();
    float (*part)[16] = (float (*)[16])sm;
    const size_t t = bid; const int tid = tidx() & 255;
    float acc[16];
#pragma unroll
    for (int e = 0; e < 16; ++e) acc[e] = 0.f;
#pragma unroll 1
    for (int i = tid; i < DM; i += 256) {
        const float xv = x[t * DM + i];
#pragma unroll
        for (int e = 0; e < 16; ++e) acc[e] = fmaf(xv, rw[i * 16 + e], acc[e]);
    }
#pragma unroll
    for (int e = 0; e < 16; ++e) acc[e] = wave_sum(acc[e]);
    if ((tid & 63) == 0) {
#pragma unroll
        for (int e = 0; e < 16; ++e) part[tid >> 6][e] = acc[e];
    }
    __syncthreads();
    if (tid == 0) {
        float lg[16], pr[16], sl[16];
        float m = -INFINITY;
#pragma unroll
        for (int e = 0; e < 16; ++e) { lg[e] = part[0][e] + part[1][e] + part[2][e] + part[3][e]; m = fmaxf(m, lg[e]); }
        float sum = 0.f;
#pragma unroll
        for (int e = 0; e < 16; ++e) { pr[e] = expf(lg[e] - m); sum += pr[e]; }
#pragma unroll
        for (int e = 0; e < 16; ++e) { pr[e] /= sum; sl[e] = pr[e] + rb[e]; }
        int bg = 0; float bgs = -INFINITY;
#pragma unroll
        for (int gI = 0; gI < 4; ++gI) {
            float m1 = -INFINITY, m2 = -INFINITY;
#pragma unroll
            for (int j = 0; j < 4; ++j) { const float v = sl[gI * 4 + j]; if (v > m1) { m2 = m1; m1 = v; } else if (v > m2) m2 = v; }
            const float sc = m1 + m2;
            if (sc > bgs) { bgs = sc; bg = gI; }
        }
        int e0 = -1, e1 = -1; float s0 = -INFINITY, s1 = -INFINITY, p0 = 0.f, p1 = 0.f;
#pragma unroll
        for (int e = 0; e < 16; ++e) {
            if ((e >> 2) == bg) {
                const float v = sl[e];
                if (v > s0) { s1 = s0; e1 = e0; p1 = p0; s0 = v; e0 = e; p0 = pr[e]; } else if (v > s1) { s1 = v; e1 = e; p1 = pr[e]; }
            }
        }
        const float wsum = p0 + p1;
        te[t * 2] = e0; te[t * 2 + 1] = e1;
        tw[t * 2] = p0 / wsum; tw[t * 2 + 1] = p1 / wsum;
    }
}
DEVI void moe_lists(const int* __restrict__ te, int* __restrict__ off, int* __restrict__ list, int* __restrict__ slotpos, float* sm0) {
    int* cnt = (int*)sm0;
    int* offs = cnt + 16;
    const int w = tidx() >> 6, lane = tidx() & 63;
    __syncthreads();
    for (int ee = 0; ee < 2; ++ee) {
        const int e = w * 2 + ee;
        int c = 0;
        for (int base = 0; base < NTOK; base += 64) {
            const int tok = base + lane;
            const bool m = (te[tok * 2] == e) || (te[tok * 2 + 1] == e);
            c += __popcll(__ballot(m));
        }
        if (lane == 0) cnt[e] = c;
    }
    __syncthreads();
    if (tidx() == 0) {
        int s = 0;
        for (int i = 0; i < 16; ++i) { offs[i] = s; off[i] = s; s += cnt[i]; }
        offs[16] = s; off[16] = s;
    }
    __syncthreads();
    for (int ee = 0; ee < 2; ++ee) {
        const int e = w * 2 + ee;
        int pos = offs[e];
        for (int base = 0; base < NTOK; base += 64) {
            const int tok = base + lane;
            const int a = te[tok * 2], b = te[tok * 2 + 1];
            const bool m = (a == e) || (b == e);
            const unsigned long long mask = __ballot(m);
            if (m) {
                const int p = pos + __popcll(mask & ((1ull << lane) - 1ull));
                list[p] = tok;
                slotpos[tok * 2 + (a == e ? 0 : 1)] = p;
            }
            pos += __popcll(mask);
        }
    }
    __syncthreads();
}
DEVI void moe_combine_ln(const float* x, const float* __restrict__ Dp, const int* __restrict__ te,
                         const float* __restrict__ tw, const int* __restrict__ slotpos,
                         const float* __restrict__ g, const float* __restrict__ bt, float* out, bf16* outb, int bid, float* sm) {
    __syncthreads();
    const size_t t = bid; const int tid = tidx() & 255;
    int ea = te[t * 2], eb = te[t * 2 + 1];
    float wa = tw[t * 2], wb = tw[t * 2 + 1];
    size_t pa = slotpos[t * 2], pb = slotpos[t * 2 + 1];
    if (eb < ea) { const float tf = wa; wa = wb; wb = tf; const size_t tp = pa; pa = pb; pb = tp; }
    float v[4];
#pragma unroll
    for (int i = 0; i < 4; ++i) {
        const int c = tid + i * 256;
        float y = wa * Dp[pa * DM + c];
        y = y + wb * Dp[pb * DM + c];
        v[i] = ALPHA * x[t * DM + c] + y;
    }
    const float mean = block_sum256(v[0] + v[1] + v[2] + v[3], sm, tid) * (1.f / DM);
    float q = 0.f;
#pragma unroll
    for (int i = 0; i < 4; ++i) { v[i] -= mean; q += v[i] * v[i]; }
    const float var = block_sum256(q, sm, tid) * (1.f / DM);
    const float rstd = rsqrtf(var + 1e-5f);
#pragma unroll
    for (int i = 0; i < 4; ++i) {
        const int c = tid + i * 256;
        const float o = v[i] * rstd * g[c] + bt[c];
        out[t * DM + c] = o;
        outb[t * DM + c] = (bf16)f2bf(o);
    }
}
typedef short bf16x8 __attribute__((ext_vector_type(8)));
typedef short s16x4 __attribute__((ext_vector_type(4)));
typedef float f32x16 __attribute__((ext_vector_type(16)));
typedef float f32x2_t __attribute__((ext_vector_type(2)));
typedef __bf16 bf16x2_t __attribute__((ext_vector_type(2)));
DEVI unsigned cvtpk(float lo, float hi) { f32x2_t v = {lo, hi}; bf16x2_t b = __builtin_convertvector(v, bf16x2_t); return __builtin_bit_cast(unsigned, b); }
constexpr float QSCL = 0.125f * 1.4426950408889634f;

struct NsaP {
    const bf16 *QN, *QR, *KSR, *KWR, *VST, *VWT, *KCMP, *VCMPT;
    const float* GATES;
    bf16* MIX;
};
constexpr int NSA_KT = 0, NSA_VT = 16384, NSA_IA = 32768, NSA_IB = 65536, NSA_SELM = 98304, NSA_UNI = 99328;

DEVI int crow(int r, int hi) { return (r & 3) + 8 * (r >> 2) + 4 * hi; }

DEVI void nsa_ld(v4u& rk, v4u& rv, const bf16* kbase, const bf16* vbase, size_t vstride, int tid) {
    rk = *(const v4u*)((const char*)kbase + tid * 16);
    rv = *(const v4u*)((const char*)(vbase + (size_t)(tid >> 3) * vstride) + (tid & 7) * 16);
}
DEVI void nsa_st(LAS unsigned char* KTb, LAS unsigned char* VTb, const v4u& rk, const v4u& rv, int tid) {
    const int r = tid >> 3, c = tid & 7, off = r * 128 + ((c ^ (r & 7)) << 4);
    *(LAS v4u*)(KTb + off) = rk; *(LAS v4u*)(VTb + off) = rv;
}
DEVI void nsa_qk(f32x16& p0, f32x16& p1, const LAS unsigned char* KTb, const bf16x8 (&qf)[4], int q32, int hi) {
#pragma unroll
    for (int r = 0; r < 16; ++r) { p0[r] = 0.f; p1[r] = 0.f; }
#pragma unroll
    for (int ks = 0; ks < 4; ++ks) {
        const int c = ((2 * ks + hi) ^ (q32 & 7)) << 4;
        const bf16x8 a0 = *(const LAS bf16x8*)(KTb + q32 * 128 + c);
        const bf16x8 a1 = *(const LAS bf16x8*)(KTb + (32 + q32) * 128 + c);
        p0 = __builtin_amdgcn_mfma_f32_32x32x16_bf16(a0, qf[ks], p0, 0, 0, 0);
        p1 = __builtin_amdgcn_mfma_f32_32x32x16_bf16(a1, qf[ks], p1, 0, 0, 0);
    }
}
DEVI void nsa_pv(f32x16 (&o)[2], const LAS unsigned char* VTb, const bf16x8 (&pf)[4], int q32, int hi) {
#pragma unroll
    for (int db = 0; db < 2; ++db) {
        const int d = 32 * db + q32;
        const LAS unsigned char* rowp = VTb + d * 128 + 8 * hi;
#pragma unroll
        for (int s = 0; s < 4; ++s) {
            const s16x4 lo = *(const LAS s16x4*)(rowp + (((2 * s) ^ (d & 7)) << 4));
            const s16x4 h4 = *(const LAS s16x4*)(rowp + (((2 * s + 1) ^ (d & 7)) << 4));
            const bf16x8 a = {lo[0], lo[1], lo[2], lo[3], h4[0], h4[1], h4[2], h4[3]};
            o[db] = __builtin_amdgcn_mfma_f32_32x32x16_bf16(a, pf[s], o[db], 0, 0, 0);
        }
    }
}
DEVI void nsa_pack(bf16x8 (&pf)[4], const f32x16& p0, const f32x16& p1) {
#pragma unroll
    for (int s = 0; s < 2; ++s) {
        unsigned w0[4], w1[4];
#pragma unroll
        for (int j = 0; j < 4; ++j) { w0[j] = cvtpk(p0[8 * s + 2 * j], p0[8 * s + 2 * j + 1]); w1[j] = cvtpk(p1[8 * s + 2 * j], p1[8 * s + 2 * j + 1]); }
        pf[s] = __builtin_bit_cast(bf16x8, (v4u){w0[0], w0[1], w0[2], w0[3]});
        pf[2 + s] = __builtin_bit_cast(bf16x8, (v4u){w1[0], w1[1], w1[2], w1[3]});
    }
}
DEVI void nsa_softmax(f32x16& p0, f32x16& p1, float& m, float& l, f32x16 (&o)[2], bf16x8 (&pf)[4]) {
    float mx = -INFINITY;
#pragma unroll
    for (int r = 0; r < 16; ++r) mx = fmaxf(mx, fmaxf(p0[r], p1[r]));
    mx = fmaxf(mx, __shfl_xor(mx, 32, 64));
    const float mn = fmaxf(m, mx);
    const float ms = (mn == -INFINITY) ? 0.f : mn;
    const float alpha = __builtin_amdgcn_exp2f(m - ms);
    float sum = 0.f;
#pragma unroll
    for (int r = 0; r < 16; ++r) { p0[r] = __builtin_amdgcn_exp2f(p0[r] - ms); p1[r] = __builtin_amdgcn_exp2f(p1[r] - ms); sum += p0[r] + p1[r]; }
    sum += __shfl_xor(sum, 32, 64);
    l = l * alpha + sum; m = mn;
#pragma unroll
    for (int r = 0; r < 16; ++r) { o[0][r] *= alpha; o[1][r] *= alpha; }
    nsa_pack(pf, p0, p1);
}
DEVI void nsa_loadq(bf16x8 (&qf)[4], const bf16* Q, int tq, int head, int hi) {
    const bf16* qp = Q + (size_t)tq * 256 + head * 64 + 8 * hi;
#pragma unroll
    for (int ks = 0; ks < 4; ++ks) qf[ks] = *(const bf16x8*)(qp + 16 * ks);
}

DEVI void nsa_unit(const NsaP& P, int u, LAS unsigned char* lds) {
    const int tid = tidx(), w = tid >> 6, lane = tid & 63, q32 = lane & 31, hi = lane >> 5;
    const int t0 = u * 64, cur = u;
    const int tl = 8 * w + (q32 >> 2), head = q32 & 3, tq = t0 + tl;
    LAS unsigned char* KT = lds + NSA_KT; LAS unsigned char* VT = lds + NSA_VT;
    LAS float* IA = (LAS float*)(lds + NSA_IA); LAS float* IB = (LAS float*)(lds + NSA_IB);
    LAS unsigned* SELM = (LAS unsigned*)(lds + NSA_SELM); LAS unsigned* UNI = (LAS unsigned*)(lds + NSA_UNI);
    __syncthreads();
    for (int i = tid; i < 2 * 64 * 128; i += 512) IA[i] = 0.f;
    if (tid < 4) UNI[tid] = 0u;
    f32x16 acc[2];
#pragma unroll
    for (int r = 0; r < 16; ++r) { acc[0][r] = 0.f; acc[1][r] = 0.f; }
    bf16x8 qf[4], pf[4];
    f32x16 o[2], p0, p1;
    v4u rk, rv;
    const float g_c = P.GATES[(size_t)tq * 12 + head * 3 + 0], g_s = P.GATES[(size_t)tq * 12 + head * 3 + 1], g_w = P.GATES[(size_t)tq * 12 + head * 3 + 2];

    {
        nsa_loadq(qf, P.QN, tq, head, hi);
        const int nlim = tq >= 31 ? (tq - 31) >> 4 : -1;
        const int nmaxu = (t0 + 63 - 31) >> 4;
        const int nct = (nmaxu >> 6) + 1;
        float m = -INFINITY, l = 0.f;
        for (int pass = 0; pass < 2; ++pass) {
#pragma unroll
            for (int r = 0; r < 16; ++r) { o[0][r] = 0.f; o[1][r] = 0.f; }
            const float rl = (pass == 1 && l > 0.f) ? 1.f / l : 0.f;
            nsa_ld(rk, rv, P.KCMP, P.VCMPT, 512, tid);
            __syncthreads();
            nsa_st(KT, VT, rk, rv, tid);
            __syncthreads();
            for (int jt = 0; jt < nct; ++jt) {
                const int buf = jt & 1;
                if (jt + 1 < nct) nsa_ld(rk, rv, P.KCMP + (size_t)(jt + 1) * 64 * 64, P.VCMPT + (jt + 1) * 64, 512, tid);
                nsa_qk(p0, p1, KT + buf * 8192, qf, q32, hi);
                const int nb = jt * 64;
#pragma unroll
                for (int r = 0; r < 16; ++r) { const int n = nb + crow(r, hi); if (n > nlim) p0[r] = -INFINITY; if (n + 32 > nlim) p1[r] = -INFINITY; }
                if (pass == 0) {
                    float mx = -INFINITY;
#pragma unroll
                    for (int r = 0; r < 16; ++r) mx = fmaxf(mx, fmaxf(p0[r], p1[r]));
                    mx = fmaxf(mx, __shfl_xor(mx, 32, 64));
                    const float mn = fmaxf(m, mx), ms = (mn == -INFINITY) ? 0.f : mn;
                    float sum = 0.f;
#pragma unroll
                    for (int r = 0; r < 16; ++r) sum += __builtin_amdgcn_exp2f(p0[r] - ms) + __builtin_amdgcn_exp2f(p1[r] - ms);
                    sum += __shfl_xor(sum, 32, 64);
                    l = l * __builtin_amdgcn_exp2f(m - ms) + sum; m = mn;
                } else {
                    const float ms = (m == -INFINITY) ? 0.f : m;
#pragma unroll
                    for (int r = 0; r < 16; ++r) { p0[r] = __builtin_amdgcn_exp2f(p0[r] - ms) * rl; p1[r] = __builtin_amdgcn_exp2f(p1[r] - ms) * rl; }
#pragma unroll
                    for (int half = 0; half < 2; ++half) {
#pragma unroll
                        for (int g = 0; g < 4; ++g) {
                            const f32x16& pp = half ? p1 : p0;
                            float a = pp[4 * g] + pp[4 * g + 1] + pp[4 * g + 2] + 0.5f * pp[4 * g + 3];
                            float b = 0.5f * pp[4 * g + 3];
                            a += __shfl_xor(a, 1, 64); a += __shfl_xor(a, 2, 64);
                            b += __shfl_xor(b, 1, 64); b += __shfl_xor(b, 2, 64);
                            const int j = (nb + 32 * half + 8 * g + 4 * hi) >> 2;
                            if (head == 0 && j < 128) { IA[tl * 128 + j] = a; IB[tl * 128 + j] = b; }
                        }
                    }
                    nsa_pack(pf, p0, p1);
                    nsa_pv(o, VT + buf * 8192, pf, q32, hi);
                }
                if (jt + 1 < nct) nsa_st(KT + (buf ^ 1) * 8192, VT + (buf ^ 1) * 8192, rk, rv, tid);
                __syncthreads();
            }
        }
#pragma unroll
        for (int r = 0; r < 16; ++r) { acc[0][r] = g_c * o[0][r]; acc[1][r] = g_c * o[1][r]; }
    }
    for (int tt = 0; tt < 8; ++tt) {
        const int tok = 8 * w + tt, tpos = t0 + tok;
        float v[2];
#pragma unroll
        for (int e = 0; e < 2; ++e) {
            const int j = lane + 64 * e;
            const float imp = IA[tok * 128 + j] + (j > 0 ? IB[tok * 128 + j - 1] : 0.f);
            v[e] = (j == cur || j == 0) ? INFINITY : (j <= cur ? imp : -1.f);
        }
        (void)tpos;
        unsigned m0 = 0u, m1 = 0u, m2 = 0u, m3 = 0u;
        for (int r = 0; r < 16; ++r) {
            float bv; int bi;
            if (v[1] > v[0]) { bv = v[1]; bi = lane + 64; } else { bv = v[0]; bi = lane; }
#pragma unroll
            for (int of = 32; of > 0; of >>= 1) {
                const float ov = __shfl_xor(bv, of, 64); const int oi = __shfl_xor(bi, of, 64);
                if (ov > bv || (ov == bv && oi < bi)) { bv = ov; bi = oi; }
            }
            if (bi == lane) v[0] = -2.f;
            if (bi == lane + 64) v[1] = -2.f;
            const unsigned bit = 1u << (bi & 31);
            if ((bi >> 5) == 0) m0 |= bit; else if ((bi >> 5) == 1) m1 |= bit; else if ((bi >> 5) == 2) m2 |= bit; else m3 |= bit;
        }
        if (lane == 0) {
            SELM[tok * 4 + 0] = m0; SELM[tok * 4 + 1] = m1; SELM[tok * 4 + 2] = m2; SELM[tok * 4 + 3] = m3;
            __hip_atomic_fetch_or(&UNI[0], m0, __ATOMIC_RELAXED, __HIP_MEMORY_SCOPE_WORKGROUP); __hip_atomic_fetch_or(&UNI[1], m1, __ATOMIC_RELAXED, __HIP_MEMORY_SCOPE_WORKGROUP); __hip_atomic_fetch_or(&UNI[2], m2, __ATOMIC_RELAXED, __HIP_MEMORY_SCOPE_WORKGROUP); __hip_atomic_fetch_or(&UNI[3], m3, __ATOMIC_RELAXED, __HIP_MEMORY_SCOPE_WORKGROUP);
        }
    }
    __syncthreads();
    {
        nsa_loadq(qf, P.QR, tq, head, hi);
        const unsigned s0 = SELM[tl * 4 + 0], s1 = SELM[tl * 4 + 1], s2 = SELM[tl * 4 + 2], s3 = SELM[tl * 4 + 3];
        const unsigned u0 = UNI[0], u1 = UNI[1], u2 = UNI[2], u3 = UNI[3];
        float m = -INFINITY, l = 0.f;
#pragma unroll
        for (int r = 0; r < 16; ++r) { o[0][r] = 0.f; o[1][r] = 0.f; }
        int j = 0;
        auto ubit = [&](int jj) -> bool { const unsigned wv = jj < 32 ? u0 : (jj < 64 ? u1 : (jj < 96 ? u2 : u3)); return (wv >> (jj & 31)) & 1u; };
        auto nextj = [&](int jj) -> int { ++jj; while (jj <= cur && !ubit(jj)) ++jj; return jj; };
        nsa_ld(rk, rv, P.KSR, P.VST, SEQ, tid);
        __syncthreads();
        nsa_st(KT, VT, rk, rv, tid);
        __syncthreads();
        int buf = 0;
        while (j <= cur) {
            asm volatile("; NSA_SEL_BEGIN");
            const int jn = nextj(j);
            if (jn <= cur) nsa_ld(rk, rv, P.KSR + (size_t)jn * 64 * 64, P.VST + jn * 64, SEQ, tid);
            const unsigned wv = j < 32 ? s0 : (j < 64 ? s1 : (j < 96 ? s2 : s3));
            const bool mine = (wv >> (j & 31)) & 1u;
            if (__any(mine)) {
                nsa_qk(p0, p1, KT + buf * 8192, qf, q32, hi);
                const int klim = mine ? (j == cur ? (tq & 63) : 63) : -1;
#pragma unroll
                for (int r = 0; r < 16; ++r) { const int k = crow(r, hi); if (k > klim) p0[r] = -INFINITY; if (k + 32 > klim) p1[r] = -INFINITY; }
                nsa_softmax(p0, p1, m, l, o, pf);
                nsa_pv(o, VT + buf * 8192, pf, q32, hi);
            }
            if (jn <= cur) nsa_st(KT + (buf ^ 1) * 8192, VT + (buf ^ 1) * 8192, rk, rv, tid);
            __syncthreads();
            buf ^= 1; j = jn;
            asm volatile("; NSA_SEL_END");
        }
        const float sc = l > 0.f ? g_s / l : 0.f;
#pragma unroll
        for (int r = 0; r < 16; ++r) { acc[0][r] += sc * o[0][r]; acc[1][r] += sc * o[1][r]; }
    }
    {
        float m = -INFINITY, l = 0.f;
#pragma unroll
        for (int r = 0; r < 16; ++r) { o[0][r] = 0.f; o[1][r] = 0.f; }
        const int j0 = cur >= 8 ? cur - 8 : 0;
        nsa_ld(rk, rv, P.KWR + (size_t)j0 * 64 * 64, P.VWT + j0 * 64, SEQ, tid);
        __syncthreads();
        nsa_st(KT, VT, rk, rv, tid);
        __syncthreads();
        int buf = 0;
        for (int j = j0; j <= cur; ++j) {
            if (j + 1 <= cur) nsa_ld(rk, rv, P.KWR + (size_t)(j + 1) * 64 * 64, P.VWT + (j + 1) * 64, SEQ, tid);
            nsa_qk(p0, p1, KT + buf * 8192, qf, q32, hi);
            const int kb = j * 64;
#pragma unroll
            for (int r = 0; r < 16; ++r) {
                const int k = kb + crow(r, hi);
                if (k > tq || k <= tq - 512) p0[r] = -INFINITY;
                if (k + 32 > tq || k + 32 <= tq - 512) p1[r] = -INFINITY;
            }
            nsa_softmax(p0, p1, m, l, o, pf);
            nsa_pv(o, VT + buf * 8192, pf, q32, hi);
            if (j + 1 <= cur) nsa_st(KT + (buf ^ 1) * 8192, VT + (buf ^ 1) * 8192, rk, rv, tid);
            __syncthreads();
            buf ^= 1;
        }
        const float sc = l > 0.f ? g_w / l : 0.f;
#pragma unroll
        for (int r = 0; r < 16; ++r) { acc[0][r] += sc * o[0][r]; acc[1][r] += sc * o[1][r]; }
    }
    {
        bf16* op = P.MIX + (size_t)tq * DM + 768 + head * 64 + 4 * hi;
#pragma unroll
        for (int db = 0; db < 2; ++db)
#pragma unroll
            for (int g = 0; g < 4; ++g) {
                const unsigned lo = cvtpk(acc[db][4 * g], acc[db][4 * g + 1]), h2 = cvtpk(acc[db][4 * g + 2], acc[db][4 * g + 3]);
                *(uint2*)(op + 32 * db + 8 * g) = make_uint2(lo, h2);
            }
    }
}

DEVI void nsa_prep2(const bf16* __restrict__ cols, bf16* __restrict__ qn, bf16* __restrict__ qr, bf16* __restrict__ ksr, bf16* __restrict__ kwr,
                    bf16* __restrict__ vst, bf16* __restrict__ vwt, float* __restrict__ gates, int bid) {
    const int t = bid, c = tidx() & 255;
    const int d = c & 63, j = d & 31;
    const float inv = powf(10000.f, -(float)j / 32.f);
    const float ang = (float)t * inv;
    float sn, cs; sincosf(ang, &sn, &cs);
    {
        const bf16* q = cols + (size_t)t * DINP + OFF_Q + (c & ~63);
        const float x1 = bf2f(q[j]), x2 = bf2f(q[j + 32]);
        qn[(size_t)t * 256 + c] = (bf16)f2bf(bf2f(q[d]) * QSCL);
        qr[(size_t)t * 256 + c] = (bf16)f2bf((d < 32 ? x1 * cs - x2 * sn : x2 * cs + x1 * sn) * QSCL);
    }
    if (c < 128) {
        const bf16* kp = cols + (size_t)t * DINP + (c < 64 ? OFF_KS : OFF_KW);
        const float x1 = bf2f(kp[j]), x2 = bf2f(kp[j + 32]);
        const float v = d < 32 ? x1 * cs - x2 * sn : x2 * cs + x1 * sn;
        if (c < 64) ksr[(size_t)t * 64 + d] = (bf16)f2bf(v); else kwr[(size_t)t * 64 + d] = (bf16)f2bf(v);
    } else {
        const bf16 v = cols[(size_t)t * DINP + (c < 192 ? OFF_VS : OFF_VW) + d];
        if (c < 192) vst[(size_t)d * SEQ + t] = v; else vwt[(size_t)d * SEQ + t] = v;
    }
    if (c < 12) gates[(size_t)t * 12 + c] = sigm(bf2f(cols[(size_t)t * DINP + OFF_GT + c]));
}
DEVI void nsa_cmp_cvt(const float* __restrict__ kc, const float* __restrict__ vc, bf16* __restrict__ kcb, bf16* __restrict__ vct, int bid) {
    const int i = bid * 256 + (tidx() & 255);
    if (i < 512 * 64) {
        const int n = i >> 6, d = i & 63;
        kcb[i] = n < NCMP ? (bf16)f2bf(kc[i]) : (bf16)0;
        vct[d * 512 + n] = n < NCMP ? (bf16)f2bf(vc[i]) : (bf16)0;
    }
}
DEVI float4 ld4bf(const bf16* p);
constexpr int RW_SLOT = 8192;
typedef unsigned u32x2v __attribute__((ext_vector_type(2)));
DEVI int rw_off(int row, int chunk16) { return row * 128 + ((chunk16 ^ (row & 7)) << 4); }
DEVI void rw_ld(LAS unsigned char* slot, const bf16* g, int gt) {
#pragma unroll
    for (int e = 0; e < 2; ++e) { const int idx = gt + 256 * e, row = idx >> 3, ch = idx & 7;
        *(LAS v4u*)(slot + rw_off(row, ch)) = *(const v4u*)((const char*)g + idx * 16); }
}
DEVI void rw_ldT(LAS unsigned char* slot, const bf16* g, size_t gstride, int gt) {
#pragma unroll
    for (int e = 0; e < 2; ++e) { const int idx = gt + 256 * e, row = idx >> 3, ch = idx & 7;
        const v4u v = *(const v4u*)(g + (size_t)row * gstride + ch * 8);
        const unsigned w[4] = {v.x, v.y, v.z, v.w};
#pragma unroll
        for (int j = 0; j < 8; ++j) { const int col = ch * 8 + j; const unsigned short h = (unsigned short)(w[j >> 1] >> ((j & 1) * 16));
            *(LAS unsigned short*)(slot + rw_off(col, row >> 3) + (row & 7) * 2) = h; }
    }
}
DEVI bf16x8 rw_frag(const LAS unsigned char* slot, int blk, int s, int r32, int hi) {
    return *(const LAS bf16x8*)(slot + rw_off(32 * blk + r32, 2 * s + hi));
}
DEVI void rw_mm(f32x16& acc, const LAS unsigned char* slotA, int rb, const LAS unsigned char* slotBT, int cb, int r32, int hi) {
#pragma unroll
    for (int s = 0; s < 4; ++s) acc = __builtin_amdgcn_mfma_f32_32x32x16_bf16(rw_frag(slotA, rb, s, r32, hi), rw_frag(slotBT, cb, s, r32, hi), acc, 0, 0, 0);
}
DEVI void rw_stT(LAS unsigned char* slot, const f32x16& acc, int rb, int cb, int r32, int hi) {
    const int j = 32 * cb + r32;
#pragma unroll
    for (int g = 0; g < 4; ++g) {
        const u32x2v w = {cvtpk(acc[4 * g], acc[4 * g + 1]), cvtpk(acc[4 * g + 2], acc[4 * g + 3])};
        *(LAS u32x2v*)(slot + rw_off(j, 4 * rb + g) + 8 * hi) = w;
    }
}
DEVI void rw_st(LAS unsigned char* slot, const f32x16& acc, int rb, int cb, int r32, int hi) {
    const int j = 32 * cb + r32;
#pragma unroll
    for (int r = 0; r < 16; ++r) { const int i = 32 * rb + crow(r, hi);
        *(LAS unsigned short*)(slot + rw_off(i, j >> 3) + (j & 7) * 2) = (unsigned short)f2bf(acc[r]); }
}
DEVI void rw_ldaccT(f32x16& acc, const LAS unsigned char* slot, int rb, int cb, int r32, int hi) {
    const int j = 32 * cb + r32;
#pragma unroll
    for (int g = 0; g < 4; ++g) {
        const u32x2v w = *(const LAS u32x2v*)(slot + rw_off(j, 4 * rb + g) + 8 * hi);
        acc[4 * g] = __builtin_bit_cast(float, w.x << 16); acc[4 * g + 1] = __builtin_bit_cast(float, w.x & 0xffff0000u);
        acc[4 * g + 2] = __builtin_bit_cast(float, w.y << 16); acc[4 * g + 3] = __builtin_bit_cast(float, w.y & 0xffff0000u);
    }
}
DEVI void rw_zero(f32x16& a) {
#pragma unroll
    for (int r = 0; r < 16; ++r) a[r] = 0.f;
}
DEVI void rw_frags(v4u& f0, v4u& f1, const f32x16& a) {
    f0 = (v4u){cvtpk(a[0], a[1]), cvtpk(a[2], a[3]), cvtpk(a[4], a[5]), cvtpk(a[6], a[7])};
    f1 = (v4u){cvtpk(a[8], a[9]), cvtpk(a[10], a[11]), cvtpk(a[12], a[13]), cvtpk(a[14], a[15])};
}

struct RwP {
    const bf16 *R, *K, *V, *A, *B;
    const float* LW; const bf16 *G, *BON;
    bf16 *AT, *BT, *KT, *RT;
    float* LAM;
    v4u *PF, *HF;
    float *QT, *OL;
    v4u* SF;
    const float *gn_g, *gn_b;
    bf16* MIX;
};

DEVI void rw_r1b(const RwP& P, int c, LAS unsigned char* lds) {
    LAS float* cum = (LAS float*)lds;
    const int tid = tidx();
    __syncthreads();
    if (tid < 256) {
        float s = 0.f;
#pragma unroll 8
        for (int t = 0; t < 64; ++t) { s += P.LW[(size_t)(c * 64 + t) * 256 + tid]; cum[t * 256 + tid] = s; }
    }
    __syncthreads();
    for (int e = tid; e < 64 * 256; e += 512) {
        const int t = e >> 8, ch = e & 255, h = ch >> 6, k = ch & 63;
        const size_t gi = (size_t)(c * 64 + t) * 256 + ch;
        const float cu = cum[e], lw = P.LW[gi];
        const float ein = __expf(cu), eout = __expf(-cu), eex = __expf(cu - lw);
        const size_t o = ((size_t)(c * 4 + h) * 64 + t) * 64 + k;
        P.AT[o] = (bf16)f2bf(bf2f(P.A[gi]) * eex);
        P.BT[o] = (bf16)f2bf(bf2f(P.B[gi]) * eout);
        P.KT[o] = (bf16)f2bf(bf2f(P.K[gi]) * eout);
        P.RT[o] = (bf16)f2bf(bf2f(P.R[gi]) * ein);
        if (t == 63) P.LAM[(size_t)(c * 4 + h) * 64 + k] = ein;
    }
}

DEVI void rw_r2(const RwP& P, int u0, LAS unsigned char* lds) {
    const int tid = tidx(), grp = tid >> 8, gt = tid & 255, gw = (tid >> 6) & 3, lane = tid & 63, r32 = lane & 31, hi = lane >> 5;
    const int rb = gw >> 1, cb = gw & 1;
    const int u = u0 + grp, c = u >> 2, h = u & 3;
    LAS unsigned char* sl = lds + grp * 65536;
#define SL(i) (sl + (i) * RW_SLOT)
    __syncthreads();
    rw_ld(SL(0), P.BT + (size_t)u * 4096, gt); rw_ld(SL(1), P.AT + (size_t)u * 4096, gt);
    rw_ld(SL(2), P.KT + (size_t)u * 4096, gt); rw_ld(SL(3), P.RT + (size_t)u * 4096, gt);
    __syncthreads();
    f32x16 aMab, aMak, aNbr, aNkr;
    rw_zero(aMab); rw_zero(aMak); rw_zero(aNbr); rw_zero(aNkr);
    rw_mm(aMab, SL(0), rb, SL(1), cb, r32, hi);
    rw_mm(aMak, SL(2), rb, SL(1), cb, r32, hi);
    rw_mm(aNbr, SL(0), rb, SL(3), cb, r32, hi);
    rw_mm(aNkr, SL(2), rb, SL(3), cb, r32, hi);
    {
        const int t = 32 * cb + r32;
#pragma unroll
        for (int r = 0; r < 16; ++r) { const int i = 32 * rb + crow(r, hi);
            if (!(i < t)) { aMab[r] = 0.f; aMak[r] = 0.f; }
            if (!(i <= t)) { aNbr[r] = 0.f; aNkr[r] = 0.f; } }
    }
    __syncthreads();
    rw_st(SL(4), aMab, rb, cb, r32, hi);
    rw_stT(SL(5), aMab, rb, cb, r32, hi);
    rw_st(SL(6), aMak, rb, cb, r32, hi);
    rw_stT(SL(7), aNbr, rb, cb, r32, hi);
    {
        const int t = 32 * cb + r32;
#pragma unroll
        for (int r = 0; r < 16; ++r) { const int i = 32 * rb + crow(r, hi); if (i == t) aMab[r] += 1.f; }
    }
    rw_st(SL(0), aMab, rb, cb, r32, hi);
    __syncthreads();
    int mA = 4, mT = 5, nA = 1, nT = 2;
#pragma unroll 1
    for (int j = 0; j < 5; ++j) {
        f32x16 a1; rw_zero(a1);
        rw_mm(a1, SL(mT), rb, SL(mA), cb, r32, hi);
        rw_stT(SL(nA), a1, rb, cb, r32, hi);
        rw_st(SL(nT), a1, rb, cb, r32, hi);
        __syncthreads();
        f32x16 a2; rw_ldaccT(a2, SL(0), rb, cb, r32, hi);
        rw_mm(a2, SL(nT), rb, SL(0), cb, r32, hi);
        __syncthreads();
        rw_stT(SL(0), a2, rb, cb, r32, hi);
        __syncthreads();
        const int ta = mA, tb = mT; mA = nA; mT = nT; nA = ta; nT = tb;
    }
    rw_ldT(SL(1), P.BT + (size_t)u * 4096, 64, gt); rw_ldT(SL(2), P.AT + (size_t)u * 4096, 64, gt);
    rw_ldT(SL(4), P.KT + (size_t)u * 4096, 64, gt); rw_ldT(SL(5), P.V + (size_t)(c * 64) * 256 + h * 64, 256, gt);
    __syncthreads();
    {
        f32x16 aY, aZ; rw_zero(aY); rw_zero(aZ);
        rw_mm(aY, SL(0), rb, SL(1), cb, r32, hi);
        rw_mm(aZ, SL(0), rb, SL(7), cb, r32, hi);
        __syncthreads();
        rw_stT(SL(1), aY, rb, cb, r32, hi);
        rw_stT(SL(7), aZ, rb, cb, r32, hi);
        __syncthreads();
    }
    {
        f32x16 aP; rw_zero(aP);
        rw_mm(aP, SL(2), rb, SL(1), cb, r32, hi);
        const int kp = 32 * cb + r32; const float lam = P.LAM[(size_t)u * 64 + kp];
#pragma unroll
        for (int r = 0; r < 16; ++r) { const int kk = 32 * rb + crow(r, hi); aP[r] = (aP[r] + (kk == kp ? 1.f : 0.f)) * lam; }
        v4u f0, f1; rw_frags(f0, f1, aP);
        v4u* dst = P.PF + ((((size_t)u * 2 + cb) * 2 + rb) * 2) * 64 + lane;
        dst[0] = f0; dst[64] = f1;
    }
    {
        f32x16 aH; rw_ldaccT(aH, SL(3), rb, cb, r32, hi);
        rw_mm(aH, SL(2), rb, SL(7), cb, r32, hi);
        v4u f0, f1; rw_frags(f0, f1, aH);
        v4u* dst = P.HF + ((((size_t)u * 2 + cb) * 2 + rb) * 2) * 64 + lane;
        dst[0] = f0; dst[64] = f1;
    }
    {
        f32x16 aD1; rw_ldaccT(aD1, SL(4), rb, cb, r32, hi);
        rw_mm(aD1, SL(6), rb, SL(1), cb, r32, hi);
        rw_mm(aNkr, SL(6), rb, SL(7), cb, r32, hi);
        __syncthreads();
        rw_stT(SL(0), aD1, rb, cb, r32, hi);
        rw_stT(SL(3), aNkr, rb, cb, r32, hi);
        __syncthreads();
    }
    {
        f32x16 aQ; rw_zero(aQ);
        rw_mm(aQ, SL(0), rb, SL(5), cb, r32, hi);
        float* dst = P.QT + (((size_t)u * 2 + cb) * 2 + rb) * 1024 + lane * 4;
#pragma unroll
        for (int g = 0; g < 4; ++g) {
            const float4 lam = *(const float4*)(P.LAM + (size_t)u * 64 + 32 * rb + 8 * g + 4 * hi);
            *(float4*)(dst + g * 256) = make_float4(aQ[4 * g] * lam.x, aQ[4 * g + 1] * lam.y, aQ[4 * g + 2] * lam.z, aQ[4 * g + 3] * lam.w);
        }
    }
    {
        f32x16 aO; rw_zero(aO);
        rw_mm(aO, SL(5), rb, SL(3), cb, r32, hi);
        float* dst = P.OL + (((size_t)u * 2 + cb) * 2 + rb) * 1024 + lane * 4;
#pragma unroll
        for (int g = 0; g < 4; ++g) *(float4*)(dst + g * 256) = make_float4(aO[4 * g], aO[4 * g + 1], aO[4 * g + 2], aO[4 * g + 3]);
    }
#undef SL
}

DEVI void rw_r3_load(const RwP& P, size_t u, int vb, int lane, f32x16 (&q)[2], v4u (&pf)[8]) {
#pragma unroll
    for (int kb = 0; kb < 2; ++kb) {
        const float* qp = P.QT + ((u * 2 + vb) * 2 + kb) * 1024 + lane * 4;
#pragma unroll
        for (int g = 0; g < 4; ++g) { const float4 v = *(const float4*)(qp + g * 256); q[kb][4 * g] = v.x; q[kb][4 * g + 1] = v.y; q[kb][4 * g + 2] = v.z; q[kb][4 * g + 3] = v.w; }
        const v4u* pp = P.PF + (((u * 2 + kb) * 2) * 2) * 64 + lane;
#pragma unroll
        for (int i = 0; i < 4; ++i) pf[kb * 4 + i] = pp[i * 64];
    }
}
DEVI void rw_r3(const RwP& P, int b, int h, int vb, int lane) {
    f32x16 st[2]; rw_zero(st[0]); rw_zero(st[1]);
    f32x16 q[2], qn[2]; v4u pf[8], pfn[8];
    const size_t ub = (size_t)b * (SEQ / 64) * 4 + h;
    rw_r3_load(P, ub, vb, lane, q, pf);
#pragma unroll 1
    for (int c = 0; c < SEQ / 64; ++c) {
        const size_t u = ub + (size_t)c * 4;
        if (c + 1 < SEQ / 64) rw_r3_load(P, u + 4, vb, lane, qn, pfn);
        v4u sf[2][2];
        rw_frags(sf[0][0], sf[0][1], st[0]); rw_frags(sf[1][0], sf[1][1], st[1]);
        v4u* sdst = P.SF + ((u * 2 + vb) * 4) * 64 + lane;
        sdst[0] = sf[0][0]; sdst[64] = sf[0][1]; sdst[128] = sf[1][0]; sdst[192] = sf[1][1];
#pragma unroll
        for (int kb = 0; kb < 2; ++kb)
#pragma unroll
            for (int ki = 0; ki < 2; ++ki)
#pragma unroll
                for (int s = 0; s < 2; ++s)
                    q[kb] = __builtin_amdgcn_mfma_f32_32x32x16_bf16(__builtin_bit_cast(bf16x8, pf[kb * 4 + ki * 2 + s]), __builtin_bit_cast(bf16x8, sf[ki][s]), q[kb], 0, 0, 0);
        st[0] = q[0]; st[1] = q[1];
        q[0] = qn[0]; q[1] = qn[1];
#pragma unroll
        for (int i = 0; i < 8; ++i) pf[i] = pfn[i];
    }
}

DEVI void rw_r4(const RwP& P, int u, int tb, int lane) {
    const int c = u >> 2, h = u & 3, r32 = lane & 31, hi = lane >> 5;
    f32x16 o[2];
#pragma unroll
    for (int vb = 0; vb < 2; ++vb) {
        const float* ol = P.OL + (((size_t)u * 2 + tb) * 2 + vb) * 1024 + lane * 4;
#pragma unroll
        for (int g = 0; g < 4; ++g) { const float4 v = *(const float4*)(ol + g * 256); o[vb][4 * g] = v.x; o[vb][4 * g + 1] = v.y; o[vb][4 * g + 2] = v.z; o[vb][4 * g + 3] = v.w; }
        const v4u* sf = P.SF + (((size_t)u * 2 + vb) * 4) * 64 + lane;
        const v4u* hf = P.HF + ((((size_t)u * 2 + tb) * 2) * 2) * 64 + lane;
#pragma unroll
        for (int kb = 0; kb < 2; ++kb)
#pragma unroll
            for (int s = 0; s < 2; ++s)
                o[vb] = __builtin_amdgcn_mfma_f32_32x32x16_bf16(__builtin_bit_cast(bf16x8, sf[(kb * 2 + s) * 64]), __builtin_bit_cast(bf16x8, hf[(kb * 2 + s) * 64]), o[vb], 0, 0, 0);
    }
    float sum = 0.f;
#pragma unroll
    for (int r = 0; r < 16; ++r) sum += o[0][r] + o[1][r];
    sum += __shfl_xor(sum, 32, 64);
    const float mean = sum * (1.f / 64.f);
    float q = 0.f;
#pragma unroll
    for (int r = 0; r < 16; ++r) { const float d0 = o[0][r] - mean, d1 = o[1][r] - mean; q += d0 * d0 + d1 * d1; }
    q += __shfl_xor(q, 32, 64);
    const float rstd = rsqrtf(q * (1.f / 64.f) + 64e-5f);
    const size_t tok = (size_t)c * 64 + 32 * tb + r32;
#pragma unroll
    for (int vb = 0; vb < 2; ++vb)
#pragma unroll
        for (int g = 0; g < 4; ++g) {
            const int ch = h * 64 + 32 * vb + 8 * g + 4 * hi;
            const float4 gg = *(const float4*)(P.gn_g + ch), gb = *(const float4*)(P.gn_b + ch);
            const float4 bo = ld4bf(P.BON + tok * 256 + ch), gt = ld4bf(P.G + tok * 256 + ch);
            const float y0 = ((o[vb][4 * g] - mean) * rstd * gg.x + gb.x + bo.x) * gt.x;
            const float y1 = ((o[vb][4 * g + 1] - mean) * rstd * gg.y + gb.y + bo.y) * gt.y;
            const float y2 = ((o[vb][4 * g + 2] - mean) * rstd * gg.z + gb.z + bo.z) * gt.z;
            const float y3 = ((o[vb][4 * g + 3] - mean) * rstd * gg.w + gb.w + bo.w) * gt.w;
            *(uint2*)(P.MIX + tok * DM + 256 + ch) = make_uint2(cvtpk(y0, y1), cvtpk(y2, y3));
        }
}
namespace pg8 {
struct XaOrder {
    int G, c;
    __device__ __forceinline__ bool next(int i, Unit& u) const {
        const int L = i * G + c; if (L >= 256) return false;
        u.pm = L >> 2; u.pn = ((L >> 2) >> 5) * 4 + (L & 3); return true;
    }
    __device__ __forceinline__ void a_ready(const Unit&) const {}
    __device__ __forceinline__ void done(const Unit&) const {}
};
struct MoeOrder {
    const int* tile_e; const int* nrt; int G, c;
    __device__ __forceinline__ bool next(int i, Unit& u) const {
        const int L = i * G + c; if (L >= 4 * (*nrt)) return false;
        u.pm = L >> 2; u.pn = tile_e[L >> 2] * 4 + (L & 3); return true;
    }
    __device__ __forceinline__ void a_ready(const Unit&) const {}
    __device__ __forceinline__ void done(const Unit&) const {}
};
#define PG8_EBAR() do { asm volatile("s_waitcnt lgkmcnt(0)" ::: "memory"); __builtin_amdgcn_s_barrier(); asm volatile("" ::: "memory"); } while (0)
struct EpiSoftmaxP {
    static constexpr bool PERM = true, AFTER_DRAIN = true;
    bf16_t* P;
    __device__ __forceinline__ void fused(f32x4 (&acc)[2][2][4][2], const Unit& u, int wr, int wc, int fr, int fq, PG8_LAS unsigned char* lds, int wid, int lane) const {
        PG8_LAS float* RM = (PG8_LAS float*)lds;
        PG8_LAS float* RS = RM + 1024;
#pragma unroll
        for (int ai = 0; ai < 2; ++ai)
#pragma unroll
            for (int m = 0; m < 4; ++m) {
                float mx = -INFINITY;
#pragma unroll
                for (int bj = 0; bj < 2; ++bj)
#pragma unroll
                    for (int n = 0; n < 2; ++n) { const f32x4 x = acc[ai][bj][m][n]; mx = fmaxf(mx, fmaxf(fmaxf(x[0], x[1]), fmaxf(x[2], x[3]))); }
                mx = fmaxf(mx, __shfl_xor(mx, 16)); mx = fmaxf(mx, __shfl_xor(mx, 32));
                if (fq == 0) RM[(ai * HALF + wr * 64 + m * 16 + fr) * 4 + wc] = mx;
            }
        PG8_EBAR();
#pragma unroll
        for (int ai = 0; ai < 2; ++ai)
#pragma unroll
            for (int m = 0; m < 4; ++m) {
                const int row = ai * HALF + wr * 64 + m * 16 + fr;
                const float gm = fmaxf(fmaxf(RM[row * 4 + 0], RM[row * 4 + 1]), fmaxf(RM[row * 4 + 2], RM[row * 4 + 3]));
                float s = 0.f;
#pragma unroll
                for (int bj = 0; bj < 2; ++bj)
#pragma unroll
                    for (int n = 0; n < 2; ++n) { f32x4 x = acc[ai][bj][m][n];
                        x[0] = __builtin_amdgcn_exp2f(x[0] - gm); x[1] = __builtin_amdgcn_exp2f(x[1] - gm); x[2] = __builtin_amdgcn_exp2f(x[2] - gm); x[3] = __builtin_amdgcn_exp2f(x[3] - gm);
                        s += (x[0] + x[1]) + (x[2] + x[3]); acc[ai][bj][m][n] = x; }
                s += __shfl_xor(s, 16); s += __shfl_xor(s, 32);
                if (fq == 0) RS[row * 4 + wc] = s;
            }
        PG8_EBAR();
        const int colb = (u.pn & 3) * BM + wc * 32 + 8 * fq;
#pragma unroll
        for (int ai = 0; ai < 2; ++ai)
#pragma unroll
            for (int m = 0; m < 4; ++m) {
                const int row = ai * HALF + wr * 64 + m * 16 + fr;
                const float inv = 1.0f / ((RS[row * 4 + 0] + RS[row * 4 + 1]) + (RS[row * 4 + 2] + RS[row * 4 + 3]));
                bf16_t* rowp = P + (size_t)(u.pm * BM + row) * 1024 + colb;
#pragma unroll
                for (int bj = 0; bj < 2; ++bj) { const f32x4 v0 = acc[ai][bj][m][0] * inv, v1 = acc[ai][bj][m][1] * inv;
                    u32x4 w; w.x = cvt_pk_bf16(v0[0], v0[1]); w.y = cvt_pk_bf16(v0[2], v0[3]); w.z = cvt_pk_bf16(v1[0], v1[1]); w.w = cvt_pk_bf16(v1[2], v1[3]);
                    *(u32x4*)(rowp + bj * HALF) = w; }
            }
        PG8_EBAR();
    }
};
struct EpiF32N4 {
    static constexpr bool PERM = false, AFTER_DRAIN = false;
    float* C; int ldc;
    __device__ __forceinline__ void operator()(const f32x4 (&acc)[2][2][4][2], const Unit& u, int wr, int wc, int fr, int fq) const {
        const int row0 = u.pm * BM + wr * 64 + fr, col0 = (u.pn & 3) * BM + wc * 32 + 4 * fq;
#pragma unroll
        for (int ai = 0; ai < 2; ++ai)
#pragma unroll
            for (int m = 0; m < 4; ++m) { float* rowp = C + (size_t)(row0 + ai * HALF + m * 16) * ldc + col0;
#pragma unroll
                for (int bj = 0; bj < 2; ++bj)
#pragma unroll
                    for (int n = 0; n < 2; ++n) *(f32x4*)(rowp + bj * HALF + n * 16) = acc[ai][bj][m][n]; }
    }
};
struct EpiBf16N4 {
    static constexpr bool PERM = true, AFTER_DRAIN = false;
    bf16_t* O; int ldc;
    __device__ __forceinline__ void operator()(const f32x4 (&acc)[2][2][4][2], const Unit& u, int wr, int wc, int fr, int fq) const {
        const int row0 = u.pm * BM + wr * 64 + fr, col0 = (u.pn & 3) * BM + wc * 32 + 8 * fq;
#pragma unroll
        for (int ai = 0; ai < 2; ++ai)
#pragma unroll
            for (int m = 0; m < 4; ++m) { bf16_t* rowp = O + (size_t)(row0 + ai * HALF + m * 16) * ldc + col0;
#pragma unroll
                for (int bj = 0; bj < 2; ++bj) { const f32x4 v0 = acc[ai][bj][m][0], v1 = acc[ai][bj][m][1];
                    u32x4 w; w.x = cvt_pk_bf16(v0[0], v0[1]); w.y = cvt_pk_bf16(v0[2], v0[3]); w.z = cvt_pk_bf16(v1[0], v1[1]); w.w = cvt_pk_bf16(v1[2], v1[3]);
                    *(u32x4*)(rowp + bj * HALF) = w; } }
    }
};
struct EpiSiluMul {
    static constexpr bool PERM = true, AFTER_DRAIN = false;
    bf16_t* H;
    __device__ __forceinline__ void operator()(const f32x4 (&acc)[2][2][4][2], const Unit& u, int wr, int wc, int fr, int fq) const {
        const int row0 = u.pm * BM + wr * 64 + fr, col0 = (u.pn & 3) * HALF + wc * 32 + 8 * fq;
#pragma unroll
        for (int ai = 0; ai < 2; ++ai)
#pragma unroll
            for (int m = 0; m < 4; ++m) {
                float h[8];
#pragma unroll
                for (int n = 0; n < 2; ++n)
#pragma unroll
                    for (int e = 0; e < 4; ++e) { const float g = acc[ai][0][m][n][e], up = acc[ai][1][m][n][e];
                        h[4 * n + e] = g * __builtin_amdgcn_rcpf(1.0f + __expf(-g)) * up; }
                u32x4 w; w.x = cvt_pk_bf16(h[0], h[1]); w.y = cvt_pk_bf16(h[2], h[3]); w.z = cvt_pk_bf16(h[4], h[5]); w.w = cvt_pk_bf16(h[6], h[7]);
                *(u32x4*)(H + (size_t)(row0 + ai * HALF + m * 16) * 512 + col0) = w;
            }
    }
};

struct OneUnit {
    int pm, pn, valid;
    __device__ __forceinline__ bool next(int i, Unit& u) const { if (i != 0 || !valid) return false; u.pm = pm; u.pn = pn; return true; }
    __device__ __forceinline__ void a_ready(const Unit&) const {}
    __device__ __forceinline__ void done(const Unit&) const {}
};
struct EpiBf16S {
    static constexpr bool PERM = true, AFTER_DRAIN = false;
    bf16_t* O; int ldc; float scale;
    __device__ __forceinline__ void operator()(const f32x4 (&acc)[2][2][4][2], const Unit& u, int wr, int wc, int fr, int fq) const {
        const int row0 = u.pm * BM + wr * 64 + fr, col0 = u.pn * BM + wc * 32 + 8 * fq;
#pragma unroll
        for (int ai = 0; ai < 2; ++ai)
#pragma unroll
            for (int m = 0; m < 4; ++m) { bf16_t* rowp = O + (size_t)(row0 + ai * HALF + m * 16) * ldc + col0;
#pragma unroll
                for (int bj = 0; bj < 2; ++bj) { const f32x4 v0 = acc[ai][bj][m][0] * scale, v1 = acc[ai][bj][m][1] * scale;
                    u32x4 w; w.x = cvt_pk_bf16(v0[0], v0[1]); w.y = cvt_pk_bf16(v0[2], v0[3]); w.z = cvt_pk_bf16(v1[0], v1[1]); w.w = cvt_pk_bf16(v1[2], v1[3]);
                    *(u32x4*)(rowp + bj * HALF) = w; } }
    }
};
struct EpiGeluF32 {
    static constexpr bool PERM = false, AFTER_DRAIN = false;
    float* C; int ldc;
    __device__ __forceinline__ void operator()(const f32x4 (&acc)[2][2][4][2], const Unit& u, int wr, int wc, int fr, int fq) const {
        const int row0 = u.pm * BM + wr * 64 + fr, col0 = u.pn * BM + wc * 32 + 4 * fq;
#pragma unroll
        for (int ai = 0; ai < 2; ++ai)
#pragma unroll
            for (int m = 0; m < 4; ++m) { float* rowp = C + (size_t)(row0 + ai * HALF + m * 16) * ldc + col0;
#pragma unroll
                for (int bj = 0; bj < 2; ++bj)
#pragma unroll
                    for (int n = 0; n < 2; ++n) { f32x4 x = acc[ai][bj][m][n];
#pragma unroll
                        for (int e = 0; e < 4; ++e) x[e] = 0.5f * x[e] * (1.f + tanhf(0.7978845608028654f * (x[e] + 0.044715f * x[e] * x[e] * x[e])));
                        *(f32x4*)(rowp + bj * HALF + n * 16) = x; } }
    }
};
}

DEVI void tr_blk(const float* W, size_t ldw, int N, int k0, int n0, bf16* WT, size_t ldt, int drow0, float scale, LAS float* scr, int lane) {
    const int n_ = n0 + (lane & 31);
#pragma unroll 8
    for (int i = 0; i < 32; ++i) { const int kk = 2 * i + (lane >> 5); scr[kk * 33 + (lane & 31)] = n_ < N ? W[(size_t)(k0 + kk) * ldw + n_] * scale : 0.f; }
    LDS_WAIT(); asm volatile("" ::: "memory");
    const int c = lane & 7;
#pragma unroll
    for (int j = 0; j < 4; ++j) { const int n = (lane >> 3) + 8 * j; const LAS float* s = scr + (8 * c) * 33 + n;
        v4u o; o.x = pk2(s[0 * 33], s[1 * 33]); o.y = pk2(s[2 * 33], s[3 * 33]); o.z = pk2(s[4 * 33], s[5 * 33]); o.w = pk2(s[6 * 33], s[7 * 33]);
        *(GAS v4u*)(WT + (size_t)(drow0 + n) * ldt + k0 + 8 * c) = o; }
    LDS_WAIT(); asm volatile("" ::: "memory");
}
DEVI void cvt_bf16(const float* __restrict__ src, bf16* __restrict__ dst, size_t n, float scale, int B0, int G) {
    for (size_t i = ((size_t)B0 * 512 + tidx()) * 4; i < n; i += (size_t)G * 512 * 4) {
        const float4 v = *(const float4*)(src + i);
        *(uint2*)(dst + i) = make_uint2(pk2(v.x * scale, v.y * scale), pk2(v.z * scale, v.w * scale));
    }
}

DEVI void moe_lists2(const int* __restrict__ te, int* __restrict__ off, int* __restrict__ nrt, int* __restrict__ tile_e, int* __restrict__ list,
                     int* __restrict__ slotpos, float* sm0) {
    int* cnt = (int*)sm0;
    int* offs = cnt + 16;
    const int w = tidx() >> 6, lane = tidx() & 63;
    __syncthreads();
    for (int ee = 0; ee < 2; ++ee) {
        const int e = w * 2 + ee;
        int c = 0;
        for (int base = 0; base < NTOK; base += 64) {
            const int tok = base + lane;
            const bool m = (te[tok * 2] == e) || (te[tok * 2 + 1] == e);
            c += __popcll(__ballot(m));
        }
        if (lane == 0) cnt[e] = c;
    }
    __syncthreads();
    if (tidx() == 0) {
        int s = 0;
#pragma unroll 1
        for (int i = 0; i < 16; ++i) { offs[i] = s; off[i] = s; const int pc = (cnt[i] + 255) & ~255;
#pragma unroll 1
            for (int r = s / 256; r < (s + pc) / 256; ++r) tile_e[r] = i;
            s += pc; }
        offs[16] = s; off[16] = s; *nrt = s / 256;
    }
    __syncthreads();
    for (int ee = 0; ee < 2; ++ee) {
        const int e = w * 2 + ee;
        int pos = offs[e];
        for (int base = 0; base < NTOK; base += 64) {
            const int tok = base + lane;
            const int a = te[tok * 2], b = te[tok * 2 + 1];
            const bool m = (a == e) || (b == e);
            const unsigned long long mask = __ballot(m);
            if (m) {
                const int p = pos + __popcll(mask & ((1ull << lane) - 1ull));
                list[p] = tok;
                slotpos[tok * 2 + (a == e ? 0 : 1)] = p;
            }
            pos += __popcll(mask);
        }
        for (int p = pos + lane; p < offs[e + 1]; p += 64) list[p] = -1;
    }
    __syncthreads();
}
DEVI void moe_gather(const bf16* __restrict__ xn, const int* __restrict__ list, const int* __restrict__ off, bf16* __restrict__ xg, int B0, int G) {
    const int total = off[16];
    const int gw = B0 * NWAVES + (tidx() >> 6), lane = tidx() & 63;
    for (int p = gw; p < total; p += G * NWAVES) {
        const int tok = list[p];
        v4u a = (v4u){0u, 0u, 0u, 0u}, b = a;
        if (tok >= 0) { const v4u* s = (const v4u*)(xn + (size_t)tok * DM); a = s[lane]; b = s[lane + 64]; }
        v4u* d = (v4u*)(xg + (size_t)p * DM); d[lane] = a; d[lane + 64] = b;
    }
}
DEVI void moe_combine_ln2(const float* x, const bf16* __restrict__ Dp, const int* __restrict__ te,
                          const float* __restrict__ tw, const int* __restrict__ slotpos,
                          const float* __restrict__ g, const float* __restrict__ bt, float* out, bf16* outb, int bid, float* sm) {
    __syncthreads();
    const size_t t = bid; const int tid = tidx() & 255;
    int ea = te[t * 2], eb = te[t * 2 + 1];
    float wa = tw[t * 2], wb = tw[t * 2 + 1];
    size_t pa = slotpos[t * 2], pb = slotpos[t * 2 + 1];
    if (eb < ea) { const float tf = wa; wa = wb; wb = tf; const size_t tp = pa; pa = pb; pb = tp; }
    float v[4];
#pragma unroll
    for (int i = 0; i < 4; ++i) {
        const int c = tid + i * 256;
        float y = wa * bf2f(Dp[pa * DM + c]);
        y = y + wb * bf2f(Dp[pb * DM + c]);
        v[i] = ALPHA * x[t * DM + c] + y;
    }
    const float mean = block_sum256(v[0] + v[1] + v[2] + v[3], sm, tid) * (1.f / DM);
    float q = 0.f;
#pragma unroll
    for (int i = 0; i < 4; ++i) { v[i] -= mean; q += v[i] * v[i]; }
    const float var = block_sum256(q, sm, tid) * (1.f / DM);
    const float rstd = rsqrtf(var + 1e-5f);
#pragma unroll
    for (int i = 0; i < 4; ++i) {
        const int c = tid + i * 256;
        const float o = v[i] * rstd * g[c] + bt[c];
        out[t * DM + c] = o;
        outb[t * DM + c] = (bf16)f2bf(o);
    }
}
struct MixP {
    const bf16* COLS;
    const float *conv_w, *conv_b, *conv_gg, *conv_gb;
    const float *gl_g, *gl_b;
    const float *mu, *w0, *a0, *k_k, *k_a, *r_k, *v_mu, *v0;
    const bf16 *WUP_T, *AUP_T, *GUP_T, *VUP_T;
    const float *pe_k, *pe_v;
    bf16 *MIX, *UB, *VB;
    bf16 *AT, *BT, *KT, *RT, *V, *G, *BON, *VFIRST;
    float* LAM;
    bf16 *QN, *QR, *KSR, *KWR, *VST, *VWT;
    float* GATES;
    bf16 *BLK, *BLV;
    int layer, pad;
};
DEVI float4 ld4bf(const bf16* p) { const uint2 w = *(const uint2*)p; return make_float4(__builtin_bit_cast(float, w.x << 16), __builtin_bit_cast(float, w.x & 0xffff0000u), __builtin_bit_cast(float, w.y << 16), __builtin_bit_cast(float, w.y & 0xffff0000u)); }
DEVI void st4bf(bf16* p, float a, float b, float c, float d) { *(uint2*)p = make_uint2(cvtpk(a, b), cvtpk(c, d)); }
DEVI float fsig(float x) { return __builtin_amdgcn_rcpf(1.f + __expf(-x)); }
DEVI float ftanh(float x) { const float e = __expf(-2.f * fabsf(x)); const float t = (1.f - e) * __builtin_amdgcn_rcpf(1.f + e); return x < 0.f ? -t : t; }
DEVI float fgelu(float x) { return 0.5f * x * (1.f + ftanh(0.7978845608028654f * (x + 0.044715f * x * x * x))); }

DEVI void prep_unit(const MixP& P, int cg, LAS unsigned char* lds) {
    const int tid = tidx(), w = tid >> 6, lane = tid & 63;
    const int b = cg >> 7, pos0 = (cg & 127) * 64;
    const size_t tok0 = (size_t)cg * 64;
    const bf16* cols = P.COLS + tok0 * DINP;
    {
        LAS float* hb = (LAS float*)lds;
        __syncthreads();
        for (int e = tid; e < 94 * 64; e += 512) {
            const int row = e >> 6, c4 = (e & 63) * 4, tt = row - 30;
            float4 h = make_float4(0.f, 0.f, 0.f, 0.f);
            if (pos0 + tt >= 0) {
                const bf16* cr = cols + (long)tt * DINP;
                const float4 v = ld4bf(cr + OFF_CV + c4), g = ld4bf(cr + OFF_CG + c4);
                h = make_float4(v.x * fsig(g.x), v.y * fsig(g.y), v.z * fsig(g.z), v.w * fsig(g.w));
            }
            { typedef float f32x4v __attribute__((ext_vector_type(4))); *(LAS f32x4v*)(hb + row * 256 + c4) = (f32x4v){h.x, h.y, h.z, h.w}; }
        }
        __syncthreads();
        const int c = tid & 255, half = tid >> 8;
        float wj[31];
#pragma unroll
        for (int j = 0; j < 31; ++j) wj[j] = P.conv_w[j * 256 + c];
        const float bias = P.conv_b[c], gg = P.conv_gg[c], gb = P.conv_gb[c];
#pragma unroll 1
        for (int q = 0; q < 4; ++q) {
            float xs[38];
            const int tb = 32 * half + 8 * q;
#pragma unroll
            for (int i = 0; i < 38; ++i) xs[i] = hb[(tb + i) * 256 + c];
#pragma unroll
            for (int t = 0; t < 8; ++t) {
                float acc = bias;
#pragma unroll
                for (int j = 0; j < 31; ++j) acc = fmaf(wj[j], xs[t + j], acc);
                const float mean = wave_sum(acc) * (1.f / 64.f);
                const float d = acc - mean;
                const float var = wave_sum(d * d) * (1.f / 64.f);
                const float y = d * rsqrtf(var + 1e-5f) * gg + gb;
                P.MIX[(tok0 + tb + t) * DM + c] = (bf16)f2bf(y * fsig(y));
            }
        }
    }
    {
        const float4 lg = *(const float4*)(P.gl_g + lane * 4), lb = *(const float4*)(P.gl_b + lane * 4);
#pragma unroll 2
        for (int i = 0; i < 8; ++i) {
            const int t = w * 8 + i; const bf16* cr = cols + (size_t)t * DINP;
            const float4 u = ld4bf(cr + OFF_GU + lane * 4);
            st4bf(P.UB + (tok0 + t) * 256 + lane * 4, fgelu(u.x), fgelu(u.y), fgelu(u.z), fgelu(u.w));
            float4 v = ld4bf(cr + OFF_GV + lane * 4);
            v = make_float4(fgelu(v.x), fgelu(v.y), fgelu(v.z), fgelu(v.w));
            const float mean = wave_sum((v.x + v.y) + (v.z + v.w)) * (1.f / 256.f);
            v.x -= mean; v.y -= mean; v.z -= mean; v.w -= mean;
            const float var = wave_sum((v.x * v.x + v.y * v.y) + (v.z * v.z + v.w * v.w)) * (1.f / 256.f);
            const float rs = rsqrtf(var + 1e-5f);
            st4bf(P.VB + (tok0 + t) * 256 + lane * 4, v.x * rs * lg.x + lb.x, v.y * rs * lg.y + lb.y, v.z * rs * lg.z + lb.z, v.w * rs * lg.w + lb.w);
        }
    }
    {
        LAS float* cst = (LAS float*)lds;
        LAS unsigned short* vt = (LAS unsigned short*)(lds + 16384);
        __syncthreads();
        for (int e = tid; e < 2048; e += 512) {
            const int t = e >> 5, j = e & 31;
            const float inv = powf(10000.f, -(float)j / 32.f);
            float sn, cs; sincosf((float)(pos0 + t) * inv, &sn, &cs);
            cst[e * 2] = cs; cst[e * 2 + 1] = sn;
        }
        __syncthreads();
#pragma unroll 1
        for (int i = 0; i < 8; ++i) {
            const int t = w * 8 + i; const bf16* cr = cols + (size_t)t * DINP; const size_t tok = tok0 + t;
            {
                const int d4 = (lane & 15) * 4;
                const float4 x = ld4bf(cr + OFF_Q + lane * 4);
                const float4 pr = make_float4(__shfl_xor(x.x, 8, 64), __shfl_xor(x.y, 8, 64), __shfl_xor(x.z, 8, 64), __shfl_xor(x.w, 8, 64));
                const LAS float* cp = cst + (t * 32 + (d4 & 31)) * 2;
                const float sg = d4 < 32 ? -1.f : 1.f;
                st4bf(P.QN + tok * 256 + lane * 4, x.x * QSCL, x.y * QSCL, x.z * QSCL, x.w * QSCL);
                st4bf(P.QR + tok * 256 + lane * 4, (x.x * cp[0] + sg * pr.x * cp[1]) * QSCL, (x.y * cp[2] + sg * pr.y * cp[3]) * QSCL,
                      (x.z * cp[4] + sg * pr.z * cp[5]) * QSCL, (x.w * cp[6] + sg * pr.w * cp[7]) * QSCL);
            }
            {
                const int seg = lane >> 4, d4 = (lane & 15) * 4;
                const float4 x = ld4bf(cr + OFF_KS + seg * 64 + d4);
                const float4 pr = make_float4(__shfl_xor(x.x, 8, 64), __shfl_xor(x.y, 8, 64), __shfl_xor(x.z, 8, 64), __shfl_xor(x.w, 8, 64));
                if ((seg & 1) == 0) {
                    const LAS float* cp = cst + (t * 32 + (d4 & 31)) * 2;
                    const float sg = d4 < 32 ? -1.f : 1.f;
                    bf16* dst = (seg == 0 ? P.KSR : P.KWR) + tok * 64 + d4;
                    st4bf(dst, x.x * cp[0] + sg * pr.x * cp[1], x.y * cp[2] + sg * pr.y * cp[3], x.z * cp[4] + sg * pr.z * cp[5], x.w * cp[6] + sg * pr.w * cp[7]);
                } else {
                    LAS unsigned short* vp = vt + (seg >> 1) * 4096 + d4 * 64 + t;
                    vp[0] = (unsigned short)f2bf(x.x); vp[64] = (unsigned short)f2bf(x.y); vp[128] = (unsigned short)f2bf(x.z); vp[192] = (unsigned short)f2bf(x.w);
                }
            }
            if (lane < 12) P.GATES[tok * 12 + lane] = fsig(bf2f(cr[OFF_GT + lane]));
        }
        __syncthreads();
        for (int e = tid; e < 1024; e += 512) {
            const int which = e >> 9, d = (e >> 3) & 63, ch = e & 7;
            const v4u v = *(const LAS v4u*)((LAS unsigned char*)vt + which * 8192 + d * 128 + ch * 16);
            *(v4u*)((which ? P.VWT : P.VST) + ((size_t)b * 64 + d) * SEQ + pos0 + ch * 8) = v;
        }
        for (int e = tid; e < 4 * 512 * 2; e += 512) {
            const int isv = e >> 11, r = e & 2047, nl = r >> 9, i4 = (r & 511) * 4, l = i4 >> 6, d = i4 & 63;
            const int n = 4 * (cg & 127) + nl;
            bf16* dst = (isv ? P.BLV : P.BLK) + ((size_t)b * 512 + n) * 2048 + i4;
            if (n < NCMP) {
                const float4 x = ld4bf(cols + (size_t)(16 * nl + l) * DINP + (isv ? OFF_VC : OFF_KC) + d);
                const float4 pe = *(const float4*)((isv ? P.pe_v : P.pe_k) + i4);
                st4bf(dst, x.x + pe.x, x.y + pe.y, x.z + pe.z, x.w + pe.w);
            } else *(uint2*)dst = make_uint2(0u, 0u);
        }
    }
    {
        LAS unsigned char* TW = lds;
        LAS unsigned char* AD = lds + 8192;
        LAS unsigned char* SG = lds + 16384;
        LAS unsigned char* VD = lds + 32768;
        LAS float* CAR = (LAS float*)(lds + 36864);
        __syncthreads();
        for (int e = tid; e < 64 * 64; e += 512) {
            const int t = e >> 6, j4 = (e & 63) * 4;
            const bf16* cr = cols + (size_t)t * DINP + OFF_RW + 768 + j4;
            const float4 c4 = ld4bf(cr);
            float4 p4 = make_float4(0.f, 0.f, 0.f, 0.f);
            if (pos0 + t > 0) p4 = ld4bf(cr - DINP);
            const float4 m4 = *(const float4*)(P.mu + 768 + j4);
            float y0 = c4.x + m4.x * (p4.x - c4.x), y1 = c4.y + m4.y * (p4.y - c4.y), y2 = c4.z + m4.z * (p4.z - c4.z), y3 = c4.w + m4.w * (p4.w - c4.w);
            if (j4 < 64) { y0 = ftanh(y0); y1 = ftanh(y1); y2 = ftanh(y2); y3 = ftanh(y3);
                *(LAS u32x2v*)(TW + rw_off(t, j4 >> 3) + (j4 & 7) * 2) = (u32x2v){cvtpk(y0, y1), cvtpk(y2, y3)}; }
            else if (j4 < 128) { const int jj = j4 - 64;
                *(LAS u32x2v*)(AD + rw_off(t, jj >> 3) + (jj & 7) * 2) = (u32x2v){cvtpk(y0, y1), cvtpk(y2, y3)}; }
            else { const int jj = j4 - 128; y0 = fsig(y0); y1 = fsig(y1); y2 = fsig(y2); y3 = fsig(y3);
                *(LAS u32x2v*)(SG + t * 256 + (((jj >> 3) ^ (t & 7)) << 4) + (jj & 7) * 2) = (u32x2v){cvtpk(y0, y1), cvtpk(y2, y3)}; }
        }
        if (P.layer > 0) {
            const int t = tid >> 3, j4 = (tid & 7) * 4;
            const bf16* cr = cols + (size_t)t * DINP + DIN + j4;
            const float4 c4 = ld4bf(cr);
            float4 p4 = make_float4(0.f, 0.f, 0.f, 0.f);
            if (pos0 + t > 0) p4 = ld4bf(cr - DINP);
            const float4 m4 = *(const float4*)(P.v_mu + j4);
            *(LAS u32x2v*)(VD + t * 64 + j4 * 2) = (u32x2v){cvtpk(c4.x + m4.x * (p4.x - c4.x), c4.y + m4.y * (p4.y - c4.y)), cvtpk(c4.z + m4.z * (p4.z - c4.z), c4.w + m4.w * (p4.w - c4.w))};
        }
        __syncthreads();
        const int h = w >> 1, tb = w & 1, r32 = lane & 31, hi = lane >> 5;
        const int t = 32 * tb + r32;
        const size_t tok = tok0 + t;
        const bool hasprev = (pos0 + t) > 0;
        const bf16* crow_ = cols + (size_t)t * DINP + OFF_RW;
        float n2 = 0.f, bd = 0.f;
#pragma unroll 1
        for (int cb = 0; cb < 2; ++cb) {
            f32x16 al; rw_zero(al);
            const bf16* arow = P.AUP_T + (size_t)(h * 64 + 32 * cb + r32) * 64 + 8 * hi;
#pragma unroll
            for (int s = 0; s < 4; ++s) al = __builtin_amdgcn_mfma_f32_32x32x16_bf16(*(const bf16x8*)(arow + 16 * s), rw_frag(AD, tb, s, r32, hi), al, 0, 0, 0);
#pragma unroll
            for (int g = 0; g < 4; ++g) {
                const int ch = h * 64 + 32 * cb + 8 * g + 4 * hi;
                const float4 rc = ld4bf(crow_ + ch), kc = ld4bf(crow_ + 256 + ch);
                float4 rp = make_float4(0.f, 0.f, 0.f, 0.f), kp = rp;
                if (hasprev) { rp = ld4bf(crow_ - DINP + ch); kp = ld4bf(crow_ - DINP + 256 + ch); }
                const float4 mr = *(const float4*)(P.mu + ch), mk = *(const float4*)(P.mu + 256 + ch);
                const float4 a0 = *(const float4*)(P.a0 + ch), kk_ = *(const float4*)(P.k_k + ch), ka = *(const float4*)(P.k_a + ch), rk = *(const float4*)(P.r_k + ch);
                const float rr[4] = {rc.x + mr.x * (rp.x - rc.x), rc.y + mr.y * (rp.y - rc.y), rc.z + mr.z * (rp.z - rc.z), rc.w + mr.w * (rp.w - rc.w)};
                const float kv[4] = {kc.x + mk.x * (kp.x - kc.x), kc.y + mk.y * (kp.y - kc.y), kc.z + mk.z * (kp.z - kc.z), kc.w + mk.w * (kp.w - kc.w)};
                const float a0v[4] = {a0.x, a0.y, a0.z, a0.w}, kkv[4] = {kk_.x, kk_.y, kk_.z, kk_.w}, kav[4] = {ka.x, ka.y, ka.z, ka.w}, rkv[4] = {rk.x, rk.y, rk.z, rk.w};
#pragma unroll
                for (int e = 0; e < 4; ++e) {
                    const float a = fsig(a0v[e] + al[4 * g + e]);
                    const float kq = kv[e] * kkv[e];
                    n2 = fmaf(kq, kq, n2);
                    bd = fmaf(rr[e] * rkv[e], kv[e] * (1.f + (a - 1.f) * kav[e]), bd);
                }
            }
        }
        n2 += __shfl_xor(n2, 32, 64); bd += __shfl_xor(bd, 32, 64);
        const float rnorm = 1.f / fmaxf(sqrtf(n2), 1e-12f);
        const size_t u = (size_t)cg * 4 + h;
#pragma unroll 1
        for (int cb = 0; cb < 2; ++cb) {
            f32x16 al, wl, gl, vm; rw_zero(al); rw_zero(wl); rw_zero(gl); rw_zero(vm);
            const int chrow = h * 64 + 32 * cb + r32;
            const bf16* arow = P.AUP_T + (size_t)chrow * 64 + 8 * hi;
            const bf16* wrow = P.WUP_T + (size_t)chrow * 64 + 8 * hi;
            const bf16* grow = P.GUP_T + (size_t)chrow * 128 + 8 * hi;
#pragma unroll
            for (int s = 0; s < 4; ++s) {
                al = __builtin_amdgcn_mfma_f32_32x32x16_bf16(*(const bf16x8*)(arow + 16 * s), rw_frag(AD, tb, s, r32, hi), al, 0, 0, 0);
                wl = __builtin_amdgcn_mfma_f32_32x32x16_bf16(*(const bf16x8*)(wrow + 16 * s), rw_frag(TW, tb, s, r32, hi), wl, 0, 0, 0);
            }
#pragma unroll
            for (int s = 0; s < 8; ++s) {
                const bf16x8 bfr = *(const LAS bf16x8*)(SG + t * 256 + (((2 * s + hi) ^ (t & 7)) << 4));
                gl = __builtin_amdgcn_mfma_f32_32x32x16_bf16(*(const bf16x8*)(grow + 16 * s), bfr, gl, 0, 0, 0);
            }
            if (P.layer > 0) {
                const bf16* vrow = P.VUP_T + (size_t)chrow * 32 + 8 * hi;
#pragma unroll
                for (int s = 0; s < 2; ++s) {
                    const bf16x8 bfr = *(const LAS bf16x8*)(VD + t * 64 + (2 * s + hi) * 16);
                    vm = __builtin_amdgcn_mfma_f32_32x32x16_bf16(*(const bf16x8*)(vrow + 16 * s), bfr, vm, 0, 0, 0);
                }
            }
            f32x16 lw, cum;
#pragma unroll
            for (int g = 0; g < 4; ++g) {
                const float4 w0 = *(const float4*)(P.w0 + h * 64 + 32 * cb + 8 * g + 4 * hi);
                const float w0v[4] = {w0.x, w0.y, w0.z, w0.w};
#pragma unroll
                for (int e = 0; e < 4; ++e) {
                    const float x = -(w0v[e] + wl[4 * g + e]);
                    const float sp = fmaxf(x, 0.f) + __logf(1.f + __expf(-fabsf(x)));
                    lw[4 * g + e] = -__expf(-sp - 0.5f);
                }
            }
#pragma unroll
            for (int r = 0; r < 16; ++r) {
                float s = lw[r];
#pragma unroll
                for (int dl = 1; dl < 32; dl <<= 1) { const float o = __shfl_up(s, dl, 32); if (r32 >= dl) s += o; }
                cum[r] = s;
            }
            if (tb == 0 && r32 == 31) {
#pragma unroll
                for (int r = 0; r < 16; ++r) CAR[h * 64 + 32 * cb + crow(r, hi)] = cum[r];
            }
            __syncthreads();
            if (tb == 1) {
#pragma unroll
                for (int r = 0; r < 16; ++r) cum[r] += CAR[h * 64 + 32 * cb + crow(r, hi)];
            }
#pragma unroll
            for (int g = 0; g < 4; ++g) {
                const int cl = 32 * cb + 8 * g + 4 * hi, ch = h * 64 + cl;
                const float4 rc = ld4bf(crow_ + ch), kc = ld4bf(crow_ + 256 + ch), vc = ld4bf(crow_ + 512 + ch);
                float4 rp = make_float4(0.f, 0.f, 0.f, 0.f), kp = rp, vp = rp;
                if (hasprev) { rp = ld4bf(crow_ - DINP + ch); kp = ld4bf(crow_ - DINP + 256 + ch); vp = ld4bf(crow_ - DINP + 512 + ch); }
                const float4 mr = *(const float4*)(P.mu + ch), mk = *(const float4*)(P.mu + 256 + ch), mv = *(const float4*)(P.mu + 512 + ch);
                const float4 a0 = *(const float4*)(P.a0 + ch), kk_ = *(const float4*)(P.k_k + ch), ka = *(const float4*)(P.k_a + ch);
                const float rr[4] = {rc.x + mr.x * (rp.x - rc.x), rc.y + mr.y * (rp.y - rc.y), rc.z + mr.z * (rp.z - rc.z), rc.w + mr.w * (rp.w - rc.w)};
                const float kv[4] = {kc.x + mk.x * (kp.x - kc.x), kc.y + mk.y * (kp.y - kc.y), kc.z + mk.z * (kp.z - kc.z), kc.w + mk.w * (kp.w - kc.w)};
                float vv[4] = {vc.x + mv.x * (vp.x - vc.x), vc.y + mv.y * (vp.y - vc.y), vc.z + mv.z * (vp.z - vc.z), vc.w + mv.w * (vp.w - vc.w)};
                const float a0v[4] = {a0.x, a0.y, a0.z, a0.w}, kkv[4] = {kk_.x, kk_.y, kk_.z, kk_.w}, kav[4] = {ka.x, ka.y, ka.z, ka.w};
                if (P.layer == 0) {
                    st4bf(P.VFIRST + tok * 256 + ch, vv[0], vv[1], vv[2], vv[3]);
                } else {
                    const float4 vf = ld4bf(P.VFIRST + tok * 256 + ch), v0 = *(const float4*)(P.v0 + ch);
                    const float vfv[4] = {vf.x, vf.y, vf.z, vf.w}, v0v[4] = {v0.x, v0.y, v0.z, v0.w};
#pragma unroll
                    for (int e = 0; e < 4; ++e) vv[e] = vv[e] + (vfv[e] - vv[e]) * fsig(v0v[e] + vm[4 * g + e]);
                }
                float at[4], bt[4], kt[4], rt[4], bo[4];
#pragma unroll
                for (int e = 0; e < 4; ++e) {
                    const float a = fsig(a0v[e] + al[4 * g + e]);
                    const float kkn = kv[e] * kkv[e] * rnorm;
                    const float k2 = kv[e] * (1.f + (a - 1.f) * kav[e]);
                    const float cu = cum[4 * g + e];
                    const float ein = __expf(cu), eout = __expf(-cu), eex = __expf(cu - lw[4 * g + e]);
                    at[e] = -kkn * eex; bt[e] = kkn * a * eout; kt[e] = k2 * eout; rt[e] = rr[e] * ein; bo[e] = bd * vv[e];
                    if (t == 63) P.LAM[u * 64 + cl + e] = ein;
                }
                const size_t bo_ = (u * 64 + t) * 64 + cl;
                st4bf(P.AT + bo_, at[0], at[1], at[2], at[3]); st4bf(P.BT + bo_, bt[0], bt[1], bt[2], bt[3]);
                st4bf(P.KT + bo_, kt[0], kt[1], kt[2], kt[3]); st4bf(P.RT + bo_, rt[0], rt[1], rt[2], rt[3]);
                st4bf(P.V + tok * 256 + ch, vv[0], vv[1], vv[2], vv[3]);
                st4bf(P.G + tok * 256 + ch, gl[4 * g], gl[4 * g + 1], gl[4 * g + 2], gl[4 * g + 3]);
                st4bf(P.BON + tok * 256 + ch, bo[0], bo[1], bo[2], bo[3]);
            }
        }
    }
}

DEVI void gmlp_unit(const bf16* __restrict__ UB, const bf16* __restrict__ VB, const bf16* __restrict__ GWS  , const float* __restrict__ bs,
                    bf16* __restrict__ MIX, int c128, LAS unsigned char* lds) {
    const int tid = tidx(), w = tid >> 6, lane = tid & 63, r32 = lane & 31, hi = lane >> 5;
    const size_t T0 = (size_t)c128 * 128;
    __syncthreads();
    for (int e = tid; e < 128 * 32; e += 512) {
        const int s = e >> 5, c8 = (e & 31) * 8;
        const v4u v = *(const v4u*)(VB + (T0 + s) * 256 + c8);
        const unsigned wv[4] = {v.x, v.y, v.z, v.w};
#pragma unroll
        for (int j = 0; j < 8; ++j) { const int ch = c8 + j;
            *(LAS unsigned short*)(lds + ch * 256 + (((s >> 3) ^ (ch & 7)) << 4) + (s & 7) * 2) = (unsigned short)(wv[j >> 1] >> ((j & 1) * 16)); }
    }
    __syncthreads();
    const int h = w & 3, th = w >> 2;
    f32x16 acc[2][2];
#pragma unroll
    for (int i = 0; i < 2; ++i)
#pragma unroll
        for (int j = 0; j < 2; ++j) rw_zero(acc[i][j]);
    const int nks = 4 * (th + 1);
#pragma unroll 1
    for (int s = 0; s < nks; ++s) {
        bf16x8 bfr[2];
#pragma unroll
        for (int cb = 0; cb < 2; ++cb) { const int ch = h * 64 + 32 * cb + r32; bfr[cb] = *(const LAS bf16x8*)(lds + ch * 256 + (((2 * s + hi) ^ (ch & 7)) << 4)); }
#pragma unroll
        for (int rb = 0; rb < 2; ++rb) {
            const bf16x8 afr = *(const bf16x8*)(GWS + ((size_t)h * 128 + 64 * th + 32 * rb + r32) * 128 + 16 * s + 8 * hi);
#pragma unroll
            for (int cb = 0; cb < 2; ++cb) acc[rb][cb] = __builtin_amdgcn_mfma_f32_32x32x16_bf16(afr, bfr[cb], acc[rb][cb], 0, 0, 0);
        }
    }
#pragma unroll
    for (int rb = 0; rb < 2; ++rb)
#pragma unroll
        for (int cb = 0; cb < 2; ++cb)
#pragma unroll
            for (int r = 0; r < 16; ++r) {
                const int tt = 64 * th + 32 * rb + crow(r, hi), ch = h * 64 + 32 * cb + r32;
                const float uu = bf2f(UB[(T0 + tt) * 256 + ch]);
                MIX[(T0 + tt) * DM + 512 + ch] = (bf16)f2bf(uu * (acc[rb][cb][r] + bs[h * 128 + tt]));
            }
}
DEVI float wsum_all(float v) {
#pragma unroll
    for (int o = 1; o < 64; o <<= 1) v += __shfl_xor(v, o, 64);
    return v;
}
DEVI void ln_finish(float (&v)[16], const float* __restrict__ g, const float* __restrict__ bt, float* orow, bf16* obrow, int lane) {
    float s = 0.f;
#pragma unroll
    for (int i = 0; i < 16; ++i) s += v[i];
    const float mean = wsum_all(s) * (1.f / DM);
    float q = 0.f;
#pragma unroll
    for (int i = 0; i < 16; ++i) { v[i] -= mean; q += v[i] * v[i]; }
    const float rstd = rsqrtf(wsum_all(q) * (1.f / DM) + 1e-5f);
#pragma unroll
    for (int j = 0; j < 4; ++j) {
        const int c = lane * 4 + 256 * j;
        const float4 gg = *(const float4*)(g + c), bb = *(const float4*)(bt + c);
        v[4 * j] = v[4 * j] * rstd * gg.x + bb.x; v[4 * j + 1] = v[4 * j + 1] * rstd * gg.y + bb.y;
        v[4 * j + 2] = v[4 * j + 2] * rstd * gg.z + bb.z; v[4 * j + 3] = v[4 * j + 3] * rstd * gg.w + bb.w;
        *(float4*)(orow + c) = make_float4(v[4 * j], v[4 * j + 1], v[4 * j + 2], v[4 * j + 3]);
        *(uint2*)(obrow + c) = make_uint2(cvtpk(v[4 * j], v[4 * j + 1]), cvtpk(v[4 * j + 2], v[4 * j + 3]));
    }
}
DEVI void ln_rows(const float* xres, float alpha, const float* add, const float* __restrict__ g, const float* __restrict__ bt, float* out, bf16* outb, int B0, int G) {
    const int gw = B0 * NWAVES + (tidx() >> 6); int lane = tidx() & 63;
    for (int row = gw; row < NTOK; row += G * NWAVES) {
        asm volatile("" : "+v"(lane));
        float v[16];
#pragma unroll
        for (int j = 0; j < 4; ++j) {
            const size_t idx = (size_t)row * DM + lane * 4 + 256 * j;
            const float4 x = *(const float4*)(xres + idx);
            float4 a = make_float4(0.f, 0.f, 0.f, 0.f);
            if (add) a = *(const float4*)(add + idx);
            v[4 * j] = alpha * x.x + a.x; v[4 * j + 1] = alpha * x.y + a.y; v[4 * j + 2] = alpha * x.z + a.z; v[4 * j + 3] = alpha * x.w + a.w;
        }
        ln_finish(v, g, bt, out + (size_t)row * DM, outb + (size_t)row * DM, lane);
    }
}
DEVI void ln_router_rows(const float* xres, const float* add, const float* __restrict__ g, const float* __restrict__ bt, float* out, bf16* outb,
                         const float* __restrict__ rw, const float* __restrict__ rb, int* __restrict__ te, float* __restrict__ tw, int* __restrict__ trel,
                         int* __restrict__ cnt, int B0, int G) {
    const int gw = B0 * NWAVES + (tidx() >> 6); int lane = tidx() & 63;
    int mycnt = 0;
    int my_row = -1, my_e0 = 0, my_e1 = 0, my_r0 = 0, my_r1 = 0; int kk_ = 0;
    for (int row = gw; row < NTOK; row += G * NWAVES, ++kk_) {
        asm volatile("" : "+v"(lane));
        float v[16];
#pragma unroll
        for (int j = 0; j < 4; ++j) {
            const size_t idx = (size_t)row * DM + lane * 4 + 256 * j;
            const float4 x = *(const float4*)(xres + idx), a = *(const float4*)(add + idx);
            v[4 * j] = ALPHA * x.x + a.x; v[4 * j + 1] = ALPHA * x.y + a.y; v[4 * j + 2] = ALPHA * x.z + a.z; v[4 * j + 3] = ALPHA * x.w + a.w;
        }
        ln_finish(v, g, bt, out + (size_t)row * DM, outb + (size_t)row * DM, lane);
        float lg[16];
#pragma unroll
        for (int e = 0; e < 16; ++e) lg[e] = 0.f;
#pragma unroll
        for (int j = 0; j < 4; ++j)
#pragma unroll
            for (int k = 0; k < 4; ++k) {
                const float xv = v[4 * j + k];
                const float4* wr = (const float4*)(rw + (size_t)(lane * 4 + 256 * j + k) * 16);
                const float4 w0 = wr[0], w1 = wr[1], w2 = wr[2], w3 = wr[3];
                lg[0] = fmaf(xv, w0.x, lg[0]); lg[1] = fmaf(xv, w0.y, lg[1]); lg[2] = fmaf(xv, w0.z, lg[2]); lg[3] = fmaf(xv, w0.w, lg[3]);
                lg[4] = fmaf(xv, w1.x, lg[4]); lg[5] = fmaf(xv, w1.y, lg[5]); lg[6] = fmaf(xv, w1.z, lg[6]); lg[7] = fmaf(xv, w1.w, lg[7]);
                lg[8] = fmaf(xv, w2.x, lg[8]); lg[9] = fmaf(xv, w2.y, lg[9]); lg[10] = fmaf(xv, w2.z, lg[10]); lg[11] = fmaf(xv, w2.w, lg[11]);
                lg[12] = fmaf(xv, w3.x, lg[12]); lg[13] = fmaf(xv, w3.y, lg[13]); lg[14] = fmaf(xv, w3.z, lg[14]); lg[15] = fmaf(xv, w3.w, lg[15]);
            }
#pragma unroll
        for (int e = 0; e < 16; ++e) lg[e] = wsum_all(lg[e]);
        float m = lg[0];
#pragma unroll
        for (int e = 1; e < 16; ++e) m = fmaxf(m, lg[e]);
        float pr[16], sum = 0.f;
#pragma unroll
        for (int e = 0; e < 16; ++e) { pr[e] = expf(lg[e] - m); sum += pr[e]; }
        float sl[16];
#pragma unroll
        for (int e = 0; e < 16; ++e) { pr[e] /= sum; sl[e] = pr[e] + rb[e]; }
        int bg = 0; float bgs = -INFINITY;
#pragma unroll
        for (int gI = 0; gI < 4; ++gI) {
            float m1 = -INFINITY, m2 = -INFINITY;
#pragma unroll
            for (int j = 0; j < 4; ++j) { const float x = sl[gI * 4 + j]; if (x > m1) { m2 = m1; m1 = x; } else if (x > m2) m2 = x; }
            const float sc = m1 + m2;
            if (sc > bgs) { bgs = sc; bg = gI; }
        }
        int e0 = -1, e1 = -1; float s0 = -INFINITY, s1 = -INFINITY, p0 = 0.f, p1 = 0.f;
#pragma unroll
        for (int e = 0; e < 16; ++e) {
            if ((e >> 2) == bg) {
                const float x = sl[e];
                if (x > s0) { s1 = s0; e1 = e0; p1 = p0; s0 = x; e0 = e; p0 = pr[e]; } else if (x > s1) { s1 = x; e1 = e; p1 = pr[e]; }
            }
        }
        if (lane == 0) {
            const float ws = p0 + p1;
            te[row * 2] = e0; te[row * 2 + 1] = e1; tw[row * 2] = p0 / ws; tw[row * 2 + 1] = p1 / ws;
        }
        const int r0 = __shfl(mycnt, e0, 64), r1 = __shfl(mycnt, e1, 64);
        if (lane == e0 || lane == e1) ++mycnt;
        if (lane == kk_) { my_row = row; my_e0 = e0; my_e1 = e1; my_r0 = r0; my_r1 = r1; }
    }
    int base = 0;
    if (lane < 16 && mycnt > 0) base = atomicAdd(&cnt[lane], mycnt);
    const int b0 = __shfl(base, my_e0, 64), b1 = __shfl(base, my_e1, 64);
    if (my_row >= 0) { trel[my_row * 2] = b0 + my_r0; trel[my_row * 2 + 1] = b1 + my_r1; }
}
DEVI int moe_offsets(const int* __restrict__ cnt, int (&off)[17]) {
    int s = 0;
#pragma unroll
    for (int e = 0; e < 16; ++e) { off[e] = s; s += (cnt[e] + 255) & ~255; }
    off[16] = s; return s;
}
DEVI void moe_gather2(const bf16* __restrict__ xn, const int* __restrict__ te, const int* __restrict__ trel, const int* __restrict__ cnt, int* __restrict__ slot,
                      int* __restrict__ nrt, int* __restrict__ tile_e, bf16* __restrict__ xg, int B0, int G) {
    int off[17]; const int total = moe_offsets(cnt, off);
    const int gw = B0 * NWAVES + (tidx() >> 6), lane = tidx() & 63;
    if (B0 == 0 && tidx() < 16) {
        const int e = tidx();
        int o = 0, o1 = 0;
#pragma unroll
        for (int i = 0; i < 16; ++i) { if (i == e) o = off[i]; if (i == e) o1 = off[i + 1]; }
        for (int r = o >> 8; r < (o1 >> 8); ++r) tile_e[r] = e;
        if (e == 0) *nrt = total >> 8;
    }
    if (B0 < 16) {
        int o = 0, o1 = 0, c = 0;
#pragma unroll
        for (int i = 0; i < 16; ++i) { if (i == B0) { o = off[i]; o1 = off[i + 1]; c = cnt[i]; } }
        for (int r = o + c + (tidx() >> 6); r < o1; r += NWAVES) { v4u* d = (v4u*)(xg + (size_t)r * DM); d[lane] = (v4u){0u, 0u, 0u, 0u}; d[lane + 64] = (v4u){0u, 0u, 0u, 0u}; }
    }
    for (int tok = gw; tok < NTOK; tok += G * NWAVES) {
        const v4u* s = (const v4u*)(xn + (size_t)tok * DM);
        const v4u a = s[lane], b = s[lane + 64];
#pragma unroll
        for (int q = 0; q < 2; ++q) {
            const int e = te[tok * 2 + q];
            int o = 0;
#pragma unroll
            for (int i = 0; i < 16; ++i) if (i == e) o = off[i];
            const int pr = o + trel[tok * 2 + q];
            v4u* d = (v4u*)(xg + (size_t)pr * DM); d[lane] = a; d[lane + 64] = b;
            if (lane == 0) slot[tok * 2 + q] = pr;
        }
    }
}
DEVI void moe_combine_rows(const float* x, const bf16* __restrict__ Dp, const int* __restrict__ te, const float* __restrict__ tw, const int* __restrict__ slot,
                           const float* __restrict__ g, const float* __restrict__ bt, float* out, bf16* outb, int B0, int G) {
    const int gw = B0 * NWAVES + (tidx() >> 6); int lane = tidx() & 63;
    for (int row = gw; row < NTOK; row += G * NWAVES) {
        asm volatile("" : "+v"(lane));
        int ea = te[row * 2], eb = te[row * 2 + 1];
        float wa = tw[row * 2], wb = tw[row * 2 + 1];
        size_t pa = slot[row * 2], pb = slot[row * 2 + 1];
        if (eb < ea) { const float tf = wa; wa = wb; wb = tf; const size_t tp = pa; pa = pb; pb = tp; }
        float v[16];
#pragma unroll
        for (int j = 0; j < 4; ++j) {
            const int c = lane * 4 + 256 * j;
            const float4 xx = *(const float4*)(x + (size_t)row * DM + c);
            const float4 da = ld4bf(Dp + pa * DM + c), db = ld4bf(Dp + pb * DM + c);
            v[4 * j] = ALPHA * xx.x + (wa * da.x + wb * db.x); v[4 * j + 1] = ALPHA * xx.y + (wa * da.y + wb * db.y);
            v[4 * j + 2] = ALPHA * xx.z + (wa * da.z + wb * db.z); v[4 * j + 3] = ALPHA * xx.w + (wa * da.w + wb * db.w);
        }
        ln_finish(v, g, bt, out + (size_t)row * DM, outb + (size_t)row * DM, lane);
    }
}
#ifndef PROBE_MASK
#define PROBE_MASK 0ull
#endif
#define PROBE_N 3
#define REP(id) for (int rep_ = 0; rep_ < (((PROBE_MASK >> (id)) & 1ull) ? 1 + PROBE_N : 1); ++rep_)
struct MP {
    const float* in[50];
    float *X, *TW, *R0;
    bf16 *XN, *MIX, *WIN_T, *WOUT_T, *WQK_T, *VWO_T, *W1_T, *LORA_T, *GWS, *VFIRST;
    int *TE, *SLOT, *LIST, *EOFF;
    unsigned* BAR;
};

DEVI void tr_item(const float* W, int K, int N, int Npad, bf16* WT, LAS float* scr, int item, int lane) {
    const int nblk = Npad / 32, kb = item / nblk, nb = item % nblk, k0 = 64 * kb, n0 = 32 * nb;
    const int n_ = n0 + (lane & 31);
#pragma unroll 8
    for (int i = 0; i < 32; ++i) { const int kk = 2 * i + (lane >> 5); scr[kk * 33 + (lane & 31)] = n_ < N ? W[(size_t)(k0 + kk) * N + n_] : 0.f; }
    LDS_WAIT(); asm volatile("" ::: "memory");
    const int c = lane & 7;
#pragma unroll
    for (int j = 0; j < 4; ++j) { const int n = (lane >> 3) + 8 * j; const LAS float* s = scr + (8 * c) * 33 + n;
        v4u o; o.x = pk2(s[0 * 33], s[1 * 33]); o.y = pk2(s[2 * 33], s[3 * 33]); o.z = pk2(s[4 * 33], s[5 * 33]); o.w = pk2(s[6 * 33], s[7 * 33]);
        *(GAS v4u*)(WT + (size_t)(n0 + n) * K + k0 + 8 * c) = o; }
    LDS_WAIT(); asm volatile("" ::: "memory");
}

DEVI void gemm_all(const GemmArgs& g, int maxM, int Z, int B0, int G, unsigned char* lds) {
    const int total = gemm_tiles(g, maxM, Z);
    for (int t0 = B0 * 2; t0 < total; t0 += G * 2) {
        const int vb = tidx() >> 8; float* sm = (float*)(lds + vb * 32768);
        const bool l0 = gemm_tile_live(g, maxM, t0), l1 = (t0 + 1 < total) && gemm_tile_live(g, maxM, t0 + 1);
        if (!l0 && !l1) continue;
        const int t = (vb && t0 + 1 < total) ? t0 + 1 : t0;
        gemm_tile(g, maxM, t, vb ? l1 : l0, sm);
    }
}

__global__ void __launch_bounds__(512, 2) mega(MP p) {
    extern __shared__ __attribute__((aligned(16))) unsigned char lds[];
    cg::grid_group grid = cg::this_grid();
    const int G = gridDim.x, B0 = blockIdx.x;
    {
        LAS unsigned* ctl = (LAS unsigned*)((LAS unsigned char*)lds + LDSCTL_OFF);
        for (int u = threadIdx.x; u < (LDS_BYTES - LDSCTL_OFF) / 4; u += NWAVES * 64) ctl[u] = 0u;
    }
    __syncthreads();
    volatile LAS unsigned* MISC = (volatile LAS unsigned*)((LAS unsigned char*)lds + MISC_OFF);
    XcdBarrier bar = xcd_barrier_post(p.BAR, MISC + 8);
    grid.sync();
#define GSYNC() do { REP(24) xcd_barrier(bar); } while (0)
    float* sm0 = (float*)lds;
    LAS unsigned char* ring = (LAS unsigned char*)lds + RING_OFF;
#define VLOOP(n, body) for (int t0_ = B0 * 2; t0_ < (n); t0_ += G * 2) { const int vb = tidx() >> 8; float* sm = (float*)(lds + vb * 32768); const int t = min(t0_ + vb, (n) - 1); body; }

    const float *x_in = p.in[0], *mem = p.in[1];
    float* X = p.X;
    float* R0 = p.R0;
    unsigned char* RB = (unsigned char*)R0;
    constexpr size_t SZ_TB = (size_t)NTOK * 256 * 2;
    bf16 *rAT = (bf16*)RB, *rBT = rAT + SZ_TB / 2, *rKT = rBT + SZ_TB / 2, *rRT = rKT + SZ_TB / 2;
    bf16 *rV = rRT + SZ_TB / 2, *rG = rV + SZ_TB / 2, *rBON = rG + SZ_TB / 2;
    bf16 *QNb = rBON + SZ_TB / 2, *QRb = QNb + SZ_TB / 2, *UBb = QRb + SZ_TB / 2, *VBb = UBb + SZ_TB / 2;
    bf16 *KSRb = VBb + SZ_TB / 2, *KWRb = KSRb + (size_t)NTOK * 64, *VSTb = KWRb + (size_t)NTOK * 64, *VWTb = VSTb + (size_t)NTOK * 64;
    bf16 *BLK = VWTb + (size_t)NTOK * 64, *BLV = BLK + (size_t)1024 * 2048;
    float *rLAM = (float*)(BLV + (size_t)1024 * 2048), *GATES = rLAM + 1024 * 64;
    bf16* COLSB = (bf16*)(RB + 110100480);
    v4u *rPF = (v4u*)COLSB, *rHF = rPF + (size_t)1024 * 512, *rSF = rHF + (size_t)1024 * 512;
    float *rQT = (float*)(rSF + (size_t)1024 * 512), *rOL = rQT + (size_t)1024 * 4096;
    float *HIDK = rOL + (size_t)1024 * 4096, *HIDV = HIDK + (size_t)1024 * 256;
    bf16 *KCMPb = (bf16*)(HIDV + (size_t)1024 * 256), *VCMPTb = KCMPb + (size_t)NB * 512 * 64;
    float* Y = R0;
    bf16* PB = (bf16*)(R0 + (size_t)17 * 1000 * 1000);
    bf16* XG = (bf16*)R0;
    bf16* HB = (bf16*)(R0 + (size_t)19 * 1000 * 1000);
    bf16* WGU_T = (bf16*)(R0 + (size_t)34 * 1000 * 1000);
    bf16* WD_T = (bf16*)(R0 + (size_t)43 * 1000 * 1000);

    bf16* WQB = (bf16*)R0;
    bf16* WKT = WQB + (size_t)2 * DM * DM;
    bf16* WVT = WKT + (size_t)2 * DM * DM;
    bf16* WOT = WVT + (size_t)2 * DM * DM;
    bf16* MEMB = WOT + (size_t)2 * DM * DM;
    bf16* KMEMB = MEMB + (size_t)NB * MEML * DM;
    bf16* VMEMB = KMEMB + (size_t)2 * NB * MEML * DM;
    {
        LAS float* scr = (LAS float*)(ring + (tidx() >> 6) * 16384);
        const int gw = B0 * NWAVES + (tidx() >> 6), NGW = G * NWAVES, lane = tidx() & 63;
        constexpr int I_IN = (DM / 64) * (DINP / 32), I_SQ = (DM / 64) * (DM / 32), I_W1 = (2048 / 64) * (256 / 32);
        for (int it = gw; it < 2 * I_IN + 8 * I_SQ + 4 * I_W1; it += NGW) {
            int r = it;
            if (r < 2 * I_IN) {
                const int l = r / I_IN, item = r % I_IN; const int nblk = DINP / 32, kb = item / nblk, nb = item % nblk, k0 = 64 * kb, n0 = 32 * nb;
                const float* W = p.in[4] + (size_t)l * DM * DIN; const float* VD = p.in[21];
                const int n_ = n0 + (lane & 31);
#pragma unroll 8
                for (int i = 0; i < 32; ++i) { const int kk = 2 * i + (lane >> 5);
                    float v = 0.f;
                    if (n_ < DIN) v = W[(size_t)(k0 + kk) * DIN + n_]; else if (l == 1 && n_ < DIN + 32) v = VD[(size_t)(k0 + kk) * 32 + (n_ - DIN)];
                    scr[kk * 33 + (lane & 31)] = v; }
                LDS_WAIT(); asm volatile("" ::: "memory");
                const int c = lane & 7; bf16* WT = p.WIN_T + (size_t)l * DINP * DM;
#pragma unroll
                for (int j = 0; j < 4; ++j) { const int n = (lane >> 3) + 8 * j; const LAS float* s = scr + (8 * c) * 33 + n;
                    v4u o; o.x = pk2(s[0 * 33], s[1 * 33]); o.y = pk2(s[2 * 33], s[3 * 33]); o.z = pk2(s[4 * 33], s[5 * 33]); o.w = pk2(s[6 * 33], s[7 * 33]);
                    *(GAS v4u*)(WT + (size_t)(n0 + n) * DM + k0 + 8 * c) = o; }
                LDS_WAIT(); asm volatile("" ::: "memory");
                continue;
            }
            r -= 2 * I_IN;
            if (r < 8 * I_SQ) {
                const int which = r / (2 * I_SQ), l = (r / I_SQ) & 1, item = r % I_SQ, kb = item / 32, nb = item % 32;
                const float* W = (which == 0 ? p.in[5] : which == 1 ? p.in[38] : which == 2 ? p.in[39] : p.in[40]) + (size_t)l * DM * DM;
                bf16* WT = (which == 0 ? p.WOUT_T : which == 1 ? WKT : which == 2 ? WVT : WOT) + (size_t)l * DM * DM;
                tr_blk(W, DM, DM, kb * 64, nb * 32, WT, DM, nb * 32, 1.f, scr, lane);
                continue;
            }
            r -= 8 * I_SQ;
            {
                const int which = r / I_W1, item = r % I_W1, kb = item / 8, nb = item % 8, l = which >> 1;
                const float* W = ((which & 1) ? p.in[33] : p.in[30]) + (size_t)l * 2048 * 256;
                tr_blk(W, 256, 256, kb * 64, nb * 32, p.W1_T + (size_t)which * 256 * 2048, 2048, nb * 32, 1.f, scr, lane);
            }
        }
        for (int it = gw; it < 64; it += NGW) {
            if (it < 32) { const int which = it >> 3, nb = it & 7, l = which & 1;
                tr_blk(((which >> 1) ? p.in[14] : p.in[12]) + (size_t)l * 64 * 256, 256, 256, 0, nb * 32, p.LORA_T + (size_t)which * 256 * 64, 64, nb * 32, 1.f, scr, lane); }
            else { const int r2 = it - 32, l = r2 >> 4, kb = (r2 >> 3) & 1, nb = r2 & 7;
                tr_blk(p.in[15] + (size_t)l * 128 * 256, 256, 256, kb * 64, nb * 32, p.LORA_T + (size_t)4 * 256 * 64 + (size_t)l * 256 * 128, 128, nb * 32, 1.f, scr, lane); }
        }
        for (int e = B0 * 512 + tidx(); e < 256 * 32; e += G * 512) { const int n = e >> 5, k = e & 31;
            p.LORA_T[(size_t)4 * 256 * 64 + (size_t)2 * 256 * 128 + e] = (bf16)f2bf(p.in[24][k * 256 + n]); }
        for (int e = B0 * 512 + tidx(); e < 2 * 4 * 128 * 128; e += G * 512) { const int t = (e >> 7) & 127, s = e & 127;
            p.GWS[e] = s <= t ? (bf16)f2bf(p.in[27][e]) : (bf16)0; }
        cvt_bf16(p.in[37], WQB, (size_t)2 * DM * DM, 1.f, B0, G);
        cvt_bf16(mem, MEMB, (size_t)NB * MEML * DM, 1.f, B0, G);
    }
    __syncthreads();
    ln_rows(x_in, 1.0f, nullptr, p.in[2], p.in[3], X, p.XN, B0, G);
    GSYNC();
    {
        const int gi = B0 >> 3, un = B0 & 7;
        pg8::Gemm g{MEMB, ((gi & 1) ? WVT : WKT) + (size_t)(gi >> 1) * DM * DM, NB * MEML, DM, DM};
        pg8::OneUnit S{un >> 2, un & 3, B0 < 32 ? 1 : 0};
        pg8::EpiBf16<0> E{((gi & 1) ? VMEMB : KMEMB) + (size_t)(gi >> 1) * NB * MEML * DM, DM, nullptr, 0, 0, 1.f};
        pg8::gemm_phase<pg8::EpiBf16<0>, pg8::OneUnit, false, true>(ring, g, S, E);
    }
    GSYNC();
    {
        const int l = (B0 >> 6) & 1, kind = (B0 >> 5) & 1, bh = (B0 >> 2) & 7, q4 = B0 & 3, b = bh >> 2, h = bh & 3;
        if (kind == 0) {
            pg8::Gemm g{KMEMB + (size_t)l * NB * MEML * DM + (size_t)b * MEML * DM + h * 256, WQB + (size_t)l * DM * DM + h * 256, 256, DM, 256, DM, DM};
            pg8::OneUnit S{0, q4, B0 < 128 ? 1 : 0};
            pg8::EpiBf16S E{p.WQK_T + (size_t)l * NB * DM * DM + (size_t)b * DM * DM + (size_t)h * 256 * DM, DM, 0.0625f * 1.4426950408889634f};
            pg8::gemm_phase<pg8::EpiBf16S, pg8::OneUnit, false, true>(ring, g, S, E);
        } else {
            pg8::Gemm g{WOT + (size_t)l * DM * DM + h * 256, VMEMB + (size_t)l * NB * MEML * DM + (size_t)b * MEML * DM + h * 256, DM, 256, 256, DM, DM};
            pg8::OneUnit S{q4, 0, B0 < 128 ? 1 : 0};
            pg8::EpiBf16S E{p.VWO_T + (size_t)l * NB * DM * DM + (size_t)b * DM * DM + h * 256, DM, 1.f};
            pg8::gemm_phase<pg8::EpiBf16S, pg8::OneUnit, false, true>(ring, g, S, E);
        }
    }
    GSYNC();
    for (int l = 0; l < 2; ++l) {
REP(1) {
        {
            pg8::Gemm g{p.XN, p.WIN_T + (size_t)l * DINP * DM, NTOK, DINP, DM};
            pg8::StaticOrder S; S.init(NTOK, DINP, G, B0);
            pg8::EpiBf16<0> E{COLSB, DINP, nullptr, 0, 0, 1.f};
            pg8::gemm_phase<pg8::EpiBf16<0>, pg8::StaticOrder, true, true>(ring, g, S, E);
        }
}
        GSYNC();
        RwP rw; rw.R = nullptr; rw.K = nullptr; rw.V = rV; rw.A = nullptr; rw.B = nullptr; rw.LW = nullptr; rw.G = rG; rw.BON = rBON;
        rw.AT = rAT; rw.BT = rBT; rw.KT = rKT; rw.RT = rRT; rw.LAM = rLAM; rw.PF = rPF; rw.HF = rHF; rw.QT = rQT; rw.OL = rOL; rw.SF = rSF;
        rw.gn_g = p.in[19] + l * 256; rw.gn_b = p.in[20] + l * 256; rw.MIX = p.MIX;
        {
            MixP mp;
            mp.COLS = COLSB;
            mp.conv_w = p.in[6] + (size_t)l * 31 * 256; mp.conv_b = p.in[7] + l * 256; mp.conv_gg = p.in[8] + l * 256; mp.conv_gb = p.in[9] + l * 256;
            mp.gl_g = p.in[25] + l * 256; mp.gl_b = p.in[26] + l * 256;
            mp.mu = p.in[10] + l * 1024; mp.w0 = p.in[11] + l * 256; mp.a0 = p.in[13] + l * 256; mp.k_k = p.in[16] + l * 256; mp.k_a = p.in[17] + l * 256; mp.r_k = p.in[18] + l * 256;
            mp.v_mu = p.in[22]; mp.v0 = p.in[23];
            mp.WUP_T = p.LORA_T + (size_t)l * 256 * 64; mp.AUP_T = p.LORA_T + (size_t)(2 + l) * 256 * 64; mp.GUP_T = p.LORA_T + (size_t)4 * 256 * 64 + (size_t)l * 256 * 128;
            mp.VUP_T = p.LORA_T + (size_t)4 * 256 * 64 + (size_t)2 * 256 * 128;
            mp.pe_k = p.in[29] + (size_t)l * 2048; mp.pe_v = p.in[32] + (size_t)l * 2048;
            mp.MIX = p.MIX; mp.UB = UBb; mp.VB = VBb;
            mp.AT = rAT; mp.BT = rBT; mp.KT = rKT; mp.RT = rRT; mp.V = rV; mp.G = rG; mp.BON = rBON; mp.VFIRST = p.VFIRST; mp.LAM = rLAM;
            mp.QN = QNb; mp.QR = QRb; mp.KSR = KSRb; mp.KWR = KWRb; mp.VST = VSTb; mp.VWT = VWTb; mp.GATES = GATES; mp.BLK = BLK; mp.BLV = BLV;
            mp.layer = l; mp.pad = 0;
REP(2) {
            for (int cg = B0; cg < NTOK / 64; cg += G) prep_unit(mp, cg, ring);
}
        }
        GSYNC();
        {
REP(4) {
            {
                const int isv = (B0 >> 2) & 1;
                pg8::Gemm g{isv ? BLV : BLK, p.W1_T + (size_t)(l * 2 + isv) * 256 * 2048, 1024, 256, 2048};
                pg8::OneUnit S{B0 & 3, 0, B0 < 8 ? 1 : 0};
                pg8::EpiGeluF32 E{isv ? HIDV : HIDK, 256};
                pg8::gemm_phase<pg8::EpiGeluF32, pg8::OneUnit, false, true>(ring, g, S, E);
            }
}
REP(6) {
            for (int u0 = 2 * (G - 1 - B0); u0 < 1024; u0 += 2 * G) rw_r2(rw, u0, ring);
}
REP(5) {
            for (int c = G - 1 - B0; c < NTOK / 128; c += G) gmlp_unit(UBb, VBb, p.GWS + (size_t)l * 4 * 128 * 128, p.in[28] + l * 4 * 128, p.MIX, c, ring);
}
        }
        GSYNC();
        {
REP(7) {
            const GemmArgs gk = mk(HIDK, 256, p.in[31] + (size_t)l * 256 * 64, 64, 1, (float*)KCMPb, 64, 1024, 64, 256, 1, 0, 0, 0, 0, 0, 0, nullptr, nullptr, 2);
            const GemmArgs gv = mk(HIDV, 256, p.in[34] + (size_t)l * 256 * 64, 64, 1, (float*)VCMPTb, 64, 1024, 64, 256, 1, 0, 0, 0, 0, 0, 0, nullptr, nullptr, 3);
            gemm_all(gk, 1024, 1, B0, G, lds);
            gemm_all(gv, 1024, 1, B0, G, lds);
}
        }
        GSYNC();
        if (B0 >= G - 2) {
REP(8) {
            { const int w_ = tidx() >> 6; rw_r3(rw, G - 1 - B0, w_ >> 1, w_ & 1, tidx() & 63); }
}
        } else {
REP(9) {
            for (int uu = B0; uu < NTOK / 64; uu += G - 2) {
                const int b = uu & 1, tile = SEQ / 64 - 1 - (uu >> 1);
                NsaP np; np.QN = QNb + (size_t)b * SEQ * 256; np.QR = QRb + (size_t)b * SEQ * 256; np.KSR = KSRb + (size_t)b * SEQ * 64; np.KWR = KWRb + (size_t)b * SEQ * 64;
                np.VST = VSTb + (size_t)b * 64 * SEQ; np.VWT = VWTb + (size_t)b * 64 * SEQ; np.KCMP = KCMPb + (size_t)b * 512 * 64; np.VCMPT = VCMPTb + (size_t)b * 64 * 512;
                np.GATES = GATES + (size_t)b * SEQ * 12; np.MIX = p.MIX + (size_t)b * SEQ * DM;
                nsa_unit(np, tile, ring);
            }
}
        }
        GSYNC();
REP(10) {
        for (int i = B0 * NWAVES + (tidx() >> 6); i < 2048; i += G * NWAVES) rw_r4(rw, i >> 1, i & 1, tidx() & 63);
}
        GSYNC();
        {
REP(11) {
            pg8::Gemm g{p.MIX, p.WOUT_T + (size_t)l * DM * DM, NTOK, DM, DM};
            pg8::StaticOrder S; S.init(NTOK, DM, G, B0);
            pg8::EpiF32 E{Y, DM, nullptr};
            pg8::gemm_phase<pg8::EpiF32, pg8::StaticOrder, true, true>(ring, g, S, E);
}
        }
        GSYNC();
        ln_rows(X, ALPHA, Y, p.in[35] + l * DM, p.in[36] + l * DM, X, p.XN, B0, G);
        if (B0 == 0 && tidx() < 16) p.EOFF[512 + tidx()] = 0;
        __syncthreads();
        {
            LAS float* scr = (LAS float*)(ring + (tidx() >> 6) * 16384);
            const int gw = B0 * NWAVES + (tidx() >> 6), NGW = G * NWAVES, lane = tidx() & 63;
            const float* wg = p.in[45] + (size_t)l * 16 * DM * 512;
            const float* wu = p.in[46] + (size_t)l * 16 * DM * 512;
            const float* wd = p.in[47] + (size_t)l * 16 * 512 * DM;
            constexpr int I_GU = (DM / 64) * (512 / 32), I_D = (512 / 64) * (DM / 32);
REP(13) {
            for (int it = gw; it < 16 * (2 * I_GU + I_D); it += NGW) {
                const int e = it / (2 * I_GU + I_D); int r = it % (2 * I_GU + I_D);
                if (r < 2 * I_GU) {
                    const int isup = r / I_GU; r %= I_GU;
                    const int kb = r / 16, nb = r % 16, n0 = nb * 32;
                    tr_blk((isup ? wu : wg) + (size_t)e * DM * 512, 512, 512, kb * 64, n0, WGU_T + (size_t)e * 1024 * DM, DM, (n0 >> 7) * 256 + (n0 & 127) + isup * 128, 1.f, scr, lane);
                } else {
                    r -= 2 * I_GU;
                    const int kb = r / 32, nb = r % 32;
                    tr_blk(wd + (size_t)e * 512 * DM, DM, DM, kb * 64, nb * 32, WD_T + (size_t)e * DM * 512, 512, nb * 32, 1.f, scr, lane);
                }
            }
}
        }
        GSYNC();
        {
            bf16* WQK_T = p.WQK_T + (size_t)l * NB * DM * DM;
REP(14) {
            pg8::Gemm g{p.XN, WQK_T, NTOK, DM, DM};
            pg8::XaOrder S{G, B0};
            pg8::EpiSoftmaxP E{PB};
            pg8::gemm_phase<pg8::EpiSoftmaxP, pg8::XaOrder, false, true>(ring, g, S, E);
}
        }
        GSYNC();
        {
REP(15) {
            pg8::Gemm g{PB, p.VWO_T + (size_t)l * NB * DM * DM, NTOK, DM, DM};
            pg8::XaOrder S{G, B0};
            pg8::EpiF32N4 E{Y, DM};
            pg8::gemm_phase<pg8::EpiF32N4, pg8::XaOrder, true, true>(ring, g, S, E);
}
        }
        GSYNC();
        ln_router_rows(X, Y, p.in[41] + l * DM, p.in[42] + l * DM, X, p.XN, p.in[43], p.in[44], p.TE, p.TW, p.LIST, p.EOFF + 512, B0, G);
        GSYNC();
REP(21) {
        moe_gather2(p.XN, p.TE, p.LIST, p.EOFF + 512, p.SLOT, p.EOFF + 32, p.EOFF + 64, XG, B0, G);
}
        GSYNC();
        {
REP(22) {
            pg8::Gemm g{XG, WGU_T, 0, 0, DM};
            pg8::MoeOrder S{p.EOFF + 64, p.EOFF + 32, G, B0};
            pg8::EpiSiluMul E{HB};
            pg8::gemm_phase<pg8::EpiSiluMul, pg8::MoeOrder, true, true>(ring, g, S, E);
}
        }
        GSYNC();
        {
REP(23) {
            pg8::Gemm g{HB, WD_T, 0, 0, 512};
            pg8::MoeOrder S{p.EOFF + 64, p.EOFF + 32, G, B0};
            pg8::EpiBf16N4 E{XG, DM};
            pg8::gemm_phase<pg8::EpiBf16N4, pg8::MoeOrder, true, true>(ring, g, S, E);
}
        }
        GSYNC();
        moe_combine_rows(X, XG, p.TE, p.TW, p.SLOT, p.in[48] + l * DM, p.in[49] + l * DM, X, p.XN, B0, G);
        GSYNC();
    }
}

extern "C" void kernel_launch(void* const* d_in, const int* in_sizes, int n_in, void* d_out, int out_size, void* d_ws, size_t ws_size,
                              hipStream_t stream) {
    static int grid_blocks = 0;
    if (!grid_blocks) {
        int dev = 0, cus = 0, per_cu = 0;
        (void)hipGetDevice(&dev);
        (void)hipDeviceGetAttribute(&cus, hipDeviceAttributeMultiprocessorCount, dev);
        (void)hipFuncSetAttribute((const void*)mega, hipFuncAttributeMaxDynamicSharedMemorySize, LDS_BYTES);
        (void)hipOccupancyMaxActiveBlocksPerMultiprocessor(&per_cu, (const void*)mega, NWAVES * 64, LDS_BYTES);
        (void)hipGetLastError();
        if (per_cu < 1) { fprintf(stderr, "occupancy query says %d blocks per CU\n", per_cu); per_cu = 1; }
        grid_blocks = cus;
    }
    MP p; memset(&p, 0, sizeof(p));
    for (int i = 0; i < 50; ++i) p.in[i] = (const float*)d_in[i];
    char* ws = (char*)d_ws;
    size_t o = 0;
    auto take = [&](size_t bytes) { char* q = ws + o; o += (bytes + 255) & ~(size_t)255; return q; };
    p.BAR = (unsigned*)take(16384);
    p.X = (float*)d_out;
    p.VFIRST = (bf16*)take((size_t)NTOK * 256 * 2);
    p.LORA_T = (bf16*)take((size_t)(4 * 256 * 64 + 2 * 256 * 128 + 256 * 32) * 2);
    p.GWS = (bf16*)take((size_t)2 * 4 * 128 * 128 * 2);
    p.MIX = (bf16*)take((size_t)NTOK * DM * 2);
    p.XN = (bf16*)take((size_t)NTOK * DM * 2);
    p.WIN_T = (bf16*)take((size_t)2 * DINP * DM * 2);
    p.WOUT_T = (bf16*)take((size_t)2 * DM * DM * 2);
    p.WQK_T = (bf16*)take((size_t)2 * NB * DM * DM * 2);
    p.VWO_T = (bf16*)take((size_t)2 * NB * DM * DM * 2);
    p.W1_T = (bf16*)take((size_t)4 * 256 * 2048 * 2);
    p.TE = (int*)take((size_t)NTOK * 2 * 4);
    p.TW = (float*)take((size_t)NTOK * 2 * 4);
    p.SLOT = (int*)take((size_t)NTOK * 2 * 4);
    p.LIST = (int*)take((size_t)36864 * 4);
    p.EOFF = (int*)take(4096);
    p.R0 = (float*)take((size_t)54200000 * 4);
    if (o > ws_size) { fprintf(stderr, "workspace too small: need %zu have %zu\n", o, ws_size); return; }
    (void)hipMemsetAsync(p.BAR, 0, 16384, stream);
    void* args[] = {&p};
    hipError_t e = hipLaunchCooperativeKernel((const void*)mega, dim3(grid_blocks), dim3(NWAVES * 64), args, LDS_BYTES, stream);
    if (e != hipSuccess) fprintf(stderr, "cooperative launch failed: %s (grid %d)\n", hipGetErrorString(e), grid_blocks);
}
```

```cpp
#include <hip/hip_runtime.h>
#include <hip/hip_cooperative_groups.h>
#include <stdio.h>
#include <stdint.h>
#include <string.h>
#include <math.h>
namespace cg = cooperative_groups;

#define DEVI __device__ __forceinline__
#define GAS __attribute__((address_space(1)))
#define LAS __attribute__((address_space(3)))
typedef unsigned short bf16;
typedef unsigned v4u __attribute__((ext_vector_type(4)));
typedef GAS unsigned gu32;
typedef GAS unsigned long long gu64;
#define RLX_AGENT __ATOMIC_RELAXED, __HIP_MEMORY_SCOPE_AGENT
#define LDS_WAIT() asm volatile("s_waitcnt lgkmcnt(0)" ::: "memory")
#define VM_WAIT() asm volatile("s_waitcnt vmcnt(0)" ::: "memory")
DEVI unsigned f2bf(float f) { unsigned u = __builtin_bit_cast(unsigned, f); return (u + 0x7fffu + ((u >> 16) & 1u)) >> 16; }
DEVI unsigned pk2(float lo, float hi) { return f2bf(lo) | (f2bf(hi) << 16); }
DEVI float bf2f(unsigned short h) { return __builtin_bit_cast(float, (unsigned)h << 16); }

constexpr int NB = 2, SEQ = 8192, DM = 1024, NTOK = NB * SEQ, DIN = 2700, DINP = 2816, MEML = 256;
constexpr int OFF_CV = 0, OFF_CG = 256, OFF_RW = 512, OFF_GU = 1536, OFF_GV = 1792, OFF_Q = 2048, OFF_KC = 2304,
              OFF_VC = 2368, OFF_KS = 2432, OFF_VS = 2496, OFF_KW = 2560, OFF_VW = 2624, OFF_GT = 2688;
constexpr int NCMP = 511;
constexpr float ALPHA = 1.4142135623730951f;
constexpr int NWAVES = 8;
constexpr int RING_OFF = 0, RING_BYTES = 131072;
constexpr int LDSCTL_OFF = RING_BYTES, MISC_OFF = LDSCTL_OFF + 320;
constexpr int LDS_BYTES = 147456;

constexpr int TIDTBL_OFF = LDSCTL_OFF;
DEVI int tidx() {
    const unsigned slot = __builtin_amdgcn_s_getreg((5 << 11) | 4) & 63u;
    int w = *(volatile LAS int*)(unsigned long)(TIDTBL_OFF + slot * 4u);
    w = __builtin_amdgcn_readfirstlane(w);
    int t;
    asm volatile("v_mbcnt_lo_u32_b32 %0, -1, 0\n\tv_mbcnt_hi_u32_b32 %0, -1, %0" : "=v"(t));
    t |= w << 6;
    asm volatile("" : "+v"(t));
    return t;
}

#ifndef PROBE_MASK
#define PROBE_MASK 0ull
#endif
#define PROBE_N 3
#define REP(id) for (int rep_ = 0; rep_ < (((PROBE_MASK >> (id)) & 1ull) ? 1 + PROBE_N : 1); ++rep_)
namespace pg8 {
#define PG8_LAS __attribute__((address_space(3)))
typedef unsigned short bf16_t;
typedef short bf16x8 __attribute__((ext_vector_type(8)));
typedef float f32x4 __attribute__((ext_vector_type(4)));
typedef unsigned u32x4 __attribute__((ext_vector_type(4)));
constexpr int BM = 256, BK = 64, HALF = 128, HTB = HALF * BK * 2  , STAGE_BYTES = 8 * HTB, NXCD = 8, WGM = 8;

__host__ __device__ __forceinline__ int lds_byte(int r, int c) { const int st = (r >> 4) * 2 + (c >> 5), rr = r & 15, cc = c & 31, ob = rr * 64 + cc * 2; return st * 1024 + (ob ^ (((ob >> 9) & 1) << 5)); }
__host__ __device__ __forceinline__ void stage_rc(int b, int& R, int& C) { const int st = b / 1024, sb = b % 1024, swz = sb ^ (((sb >> 9) & 1) << 5); R = (st >> 1) * 16 + swz / 64; C = (st & 1) * 32 + (swz % 64) / 2; }
__host__ __device__ __forceinline__ int perm32(int rho) { const int n = rho >> 4, i = rho & 15; return 8 * (i >> 2) + 4 * n + (i & 3); }

struct Unit { int pm, pn; };
struct Gemm { const bf16_t* A; const bf16_t* Bt; int M, N, K; int lda = 0, ldb = 0; };

struct StaticOrder {
    int nM, nN, nwg, G, c;
    __host__ __device__ void init(int M, int N, int G_, int c_) { nM = M / BM; nN = N / BM; nwg = nM * nN; G = G_; c = c_; }
    __host__ __device__ bool next(int i, Unit& u) const {
        const long L = (long)i * G + c; if (L >= nwg) return false;
        int wgid = (int)L; { const int q = nwg / NXCD, r = nwg % NXCD, xcd = wgid % NXCD, off = wgid / NXCD; wgid = (xcd < r ? xcd * (q + 1) : r * (q + 1) + (xcd - r) * q) + off; }
        const int nig = WGM * nN, gid = wgid / nig, fm = gid * WGM, gsz = (nM - fm) < WGM ? (nM - fm) : WGM;
        u.pm = fm + ((wgid % nig) % gsz); u.pn = (wgid % nig) / gsz; return true;
    }
    __device__ __forceinline__ void a_ready(const Unit&) const {}
    __device__ __forceinline__ void done(const Unit&) const {}
};

__device__ __forceinline__ unsigned cvt_pk_bf16(float lo, float hi) { unsigned r; asm volatile("v_cvt_pk_bf16_f32 %0, %1, %2" : "=v"(r) : "v"(lo), "v"(hi)); return r; }
typedef float f32x2 __attribute__((ext_vector_type(2)));
__device__ __forceinline__ f32x2 gelu_pk(f32x2 v) {
    const f32x2 av = __builtin_elementwise_abs(v), d = av * 0.2316418882f + 1.0f;
    f32x2 t; t.x = __builtin_amdgcn_rcpf(d.x); t.y = __builtin_amdgcn_rcpf(d.y);
    f32x2 q = t * 0.5307027145f + (-0.7265760135f); q = q * t + 0.7107068705f; q = q * t + (-0.142248368f); q = q * t + 0.127414796f; q = q * t;
    const f32x2 s = (v * v) * (-0.72134752044f);
    f32x2 e; e.x = __builtin_amdgcn_exp2f(s.x); e.y = __builtin_amdgcn_exp2f(s.y);
    const f32x2 m = v * (q * e), r = v - m;
    f32x2 o; o.x = v.x < 0.f ? m.x : r.x; o.y = v.y < 0.f ? m.y : r.y; return o;
}

template <int ACT  > struct EpiBf16 {
    static constexpr bool PERM = true, AFTER_DRAIN = false; static_assert(ACT == 0 || ACT == 1, "EpiBf16: ACT is 0 (none) or 1 (gelu_pk)");
    bf16_t* O; int ldc; const float* bias; int split_cols; size_t split_stride; float scale0;
    __device__ __forceinline__ void operator()(const f32x4 (&acc)[2][2][4][2], const Unit& u, int wr, int wc, int fr, int fq) const {
        const int row0 = u.pm * BM + wr * 64 + fr; int colt = u.pn * BM; bf16_t* base = O;
        float sc = 1.f; if (split_cols) { const int t = colt / split_cols; base += (size_t)t * split_stride; colt -= t * split_cols; if (t == 0) sc = scale0; }
        const int col0 = colt + wc * 32 + 8 * fq, bcol0 = u.pn * BM + wc * 32 + 8 * fq;
        f32x4 bv[2][2];
#pragma unroll
        for (int bj = 0; bj < 2; ++bj)
#pragma unroll
            for (int n = 0; n < 2; ++n) bv[bj][n] = bias ? *(const f32x4*)(bias + bcol0 + bj * HALF + 4 * n) : (f32x4){0.f, 0.f, 0.f, 0.f};
#pragma unroll
        for (int ai = 0; ai < 2; ++ai)
#pragma unroll
            for (int m = 0; m < 4; ++m) { bf16_t* rowp = base + (size_t)(row0 + ai * HALF + m * 16) * ldc + col0;
#pragma unroll
                for (int bj = 0; bj < 2; ++bj) { f32x4 v0 = acc[ai][bj][m][0] + bv[bj][0], v1 = acc[ai][bj][m][1] + bv[bj][1];
                    if (ACT == 1) { f32x2 a = gelu_pk((f32x2){v0[0], v0[1]}), b = gelu_pk((f32x2){v0[2], v0[3]}), c = gelu_pk((f32x2){v1[0], v1[1]}), d = gelu_pk((f32x2){v1[2], v1[3]});
                        v0 = (f32x4){a.x, a.y, b.x, b.y}; v1 = (f32x4){c.x, c.y, d.x, d.y}; }
                    v0 = v0 * sc; v1 = v1 * sc; u32x4 w; w.x = cvt_pk_bf16(v0[0], v0[1]); w.y = cvt_pk_bf16(v0[2], v0[3]); w.z = cvt_pk_bf16(v1[0], v1[1]); w.w = cvt_pk_bf16(v1[2], v1[3]);
                    *(u32x4*)(rowp + bj * HALF) = w; } }
    }
};

struct PanelStats {
    unsigned* xbuf;
    unsigned* cnt;
    unsigned* tmo;
    int ntn; float eps;
    unsigned code;
    __device__ __forceinline__ bool run(const f32x4 (&v)[2][2][4][2], const Unit& u, int wr, int wc, int fr, int fq, PG8_LAS unsigned char* lds, int wid, int lane) const {
        typedef float f32x2v __attribute__((ext_vector_type(2)));
        PG8_LAS f32x2v* P = (PG8_LAS f32x2v*)lds;
        PG8_LAS f32x2v* S = (PG8_LAS f32x2v*)(lds + 8192);
        PG8_LAS unsigned* flag = (PG8_LAS unsigned*)(lds + 8192 + 2048);
#pragma unroll
        for (int ai = 0; ai < 2; ++ai)
#pragma unroll
            for (int m = 0; m < 4; ++m) {
                float s = 0.f;
#pragma unroll
                for (int bj = 0; bj < 2; ++bj)
#pragma unroll
                    for (int n = 0; n < 2; ++n) { const f32x4 x = v[ai][bj][m][n]; s += (x[0] + x[1]) + (x[2] + x[3]); }
                s += __shfl_xor(s, 16); s += __shfl_xor(s, 32);
                const float mw = s * (1.0f / 64.0f); float q = 0.f;
#pragma unroll
                for (int bj = 0; bj < 2; ++bj)
#pragma unroll
                    for (int n = 0; n < 2; ++n) { const f32x4 d = v[ai][bj][m][n] - mw; q += (d[0] * d[0] + d[1] * d[1]) + (d[2] * d[2] + d[3] * d[3]); }
                q += __shfl_xor(q, 16); q += __shfl_xor(q, 32);
                if (fq == 0) P[(ai * HALF + wr * 64 + m * 16 + fr) * 4 + wc] = (f32x2v){mw, q};
            }
        asm volatile("s_waitcnt lgkmcnt(0)" ::: "memory"); __builtin_amdgcn_s_barrier(); asm volatile("" ::: "memory");
#if defined(BROKEN_EXCHANGE_NO_WAIT)
#warning BROKEN CONTROL BUILD: the row-statistics exchange does not wait; results are wrong by design
        if (blockIdx.x >= 64) { const long long t0_ = clock64(); while (clock64() - t0_ < 60000) __builtin_amdgcn_s_sleep(8); }
#endif
        const int row = wid * 32 + (lane & 31);
        if (lane < 32) {
            const f32x2v a = P[row * 4 + 0], b = P[row * 4 + 1], c = P[row * 4 + 2], d = P[row * 4 + 3];
            const float mt = (a.x + b.x + c.x + d.x) * 0.25f;
            const float da = a.x - mt, db = b.x - mt, dc = c.x - mt, dd = d.x - mt;
            const float m2 = (a.y + b.y) + (c.y + d.y) + 64.0f * ((da * da + db * db) + (dc * dc + dd * dd));
            unsigned long long* slot = (unsigned long long*)xbuf + ((size_t)(u.pm * BM + row) * 4 + u.pn);
            __hip_atomic_store(slot, ((unsigned long long)__float_as_uint(m2) << 32) | __float_as_uint(mt), __ATOMIC_RELAXED, __HIP_MEMORY_SCOPE_AGENT);
        }
        asm volatile("s_waitcnt vmcnt(0)" ::: "memory");
        if (lane == 0) __hip_atomic_fetch_add(cnt + 64 * u.pm, 1u, __ATOMIC_RELAXED, __HIP_MEMORY_SCOPE_AGENT);
        if (wid == 0) {
            bool dead = false; const unsigned long long t0 = __builtin_amdgcn_s_memrealtime(); const unsigned want = 8u * (unsigned)ntn;
            for (;;) {
#if defined(BROKEN_EXCHANGE_NO_WAIT)
                break;
#endif
                if ((unsigned)__builtin_amdgcn_readfirstlane(__hip_atomic_load(cnt + 64 * u.pm, __ATOMIC_RELAXED, __HIP_MEMORY_SCOPE_AGENT)) >= want) break;
                if (__builtin_amdgcn_s_memrealtime() - t0 > 2000000ull) {
                    if (lane == 0) { unsigned expect = 0u; __hip_atomic_compare_exchange_strong(tmo + 1, &expect, code | (unsigned)(u.pm & 0xff), __ATOMIC_RELAXED, __ATOMIC_RELAXED, __HIP_MEMORY_SCOPE_AGENT);
                                     __hip_atomic_store(tmo, 1u, __ATOMIC_RELAXED, __HIP_MEMORY_SCOPE_AGENT); }
                    dead = true; break; }
                __builtin_amdgcn_s_sleep(2);
            }
            __builtin_amdgcn_fence(__ATOMIC_ACQUIRE, "agent");
            if (lane == 0) flag[0] = dead ? 1u : 0u;
        }
        asm volatile("s_waitcnt vmcnt(0) lgkmcnt(0)" ::: "memory"); __builtin_amdgcn_s_barrier(); asm volatile("" ::: "memory");
        const bool bad = flag[0] != 0u;
        if (lane < 32) {
            const unsigned long long* slot = (const unsigned long long*)xbuf + (size_t)(u.pm * BM + row) * 4; float mt[4], m2[4]; float ms = 0.f;
#pragma unroll
            for (int t = 0; t < 4; ++t) { if (t < ntn) { const unsigned long long w = __hip_atomic_load(slot + t, __ATOMIC_RELAXED, __HIP_MEMORY_SCOPE_AGENT); mt[t] = __uint_as_float((unsigned)w); m2[t] = __uint_as_float((unsigned)(w >> 32)); } else { mt[t] = 0.f; m2[t] = 0.f; } ms += mt[t]; }
            const float mean = ms / (float)ntn; float q = 0.f;
#pragma unroll
            for (int t = 0; t < 4; ++t) if (t < ntn) { const float dm = mt[t] - mean; q += m2[t] + 256.0f * dm * dm; }
            S[row] = (f32x2v){mean, 1.0f / sqrtf(q / (256.0f * (float)ntn) + eps)};
        }
        asm volatile("s_waitcnt lgkmcnt(0)" ::: "memory"); __builtin_amdgcn_s_barrier(); asm volatile("" ::: "memory");
        return bad;
    }
};
struct EpiLnRes {
    static constexpr bool PERM = false, AFTER_DRAIN = true;
    const float* base; float* out; int ldc; const float* bias; PanelStats st; unsigned poison;
    __device__ __forceinline__ void fused(f32x4 (&acc)[2][2][4][2], const Unit& u, int wr, int wc, int fr, int fq, PG8_LAS unsigned char* lds, int wid, int lane) const {
        typedef float f32x2v __attribute__((ext_vector_type(2)));
        const PG8_LAS f32x2v* S = (const PG8_LAS f32x2v*)(lds + 8192);
        const int col0 = u.pn * BM + wc * 32 + 4 * fq;
#pragma unroll
        for (int bj = 0; bj < 2; ++bj)
#pragma unroll
            for (int n = 0; n < 2; ++n) { const f32x4 bv = bias ? *(const f32x4*)(bias + col0 + bj * HALF + n * 16) : (f32x4){0.f, 0.f, 0.f, 0.f};
#pragma unroll
                for (int ai = 0; ai < 2; ++ai)
#pragma unroll
                    for (int m = 0; m < 4; ++m) acc[ai][bj][m][n] += bv; }
        f32x4 pre[4][2][2];
#pragma unroll
        for (int m = 0; m < 4; ++m) { const size_t off = (size_t)(u.pm * BM + wr * 64 + m * 16 + fr) * ldc + col0;
#pragma unroll
            for (int bj = 0; bj < 2; ++bj)
#pragma unroll
                for (int n = 0; n < 2; ++n) pre[m][bj][n] = *(const f32x4*)(base + off + bj * HALF + n * 16); }
        const bool bad = st.run(acc, u, wr, wc, fr, fq, lds, wid, lane) || poison != 0u;
        const float qnan = __builtin_nanf("");
#pragma unroll
        for (int ai = 0; ai < 2; ++ai)
#pragma unroll
            for (int m = 0; m < 4; ++m) { const int r = ai * HALF + wr * 64 + m * 16 + fr; const f32x2v sr = S[r]; const size_t off = (size_t)(u.pm * BM + r) * ldc + col0;
#pragma unroll
                for (int bj = 0; bj < 2; ++bj)
#pragma unroll
                    for (int n = 0; n < 2; ++n) { const f32x4 bs = ai == 0 ? pre[m][bj][n] : *(const f32x4*)(base + off + bj * HALF + n * 16); f32x4 o = bs + (acc[ai][bj][m][n] - sr.x) * sr.y;
                        if (bad) o = (f32x4){qnan, qnan, qnan, qnan}; *(f32x4*)(out + off + bj * HALF + n * 16) = o; }
                if (m & 1) asm volatile("" ::: "memory"); }
    }
};
struct EpiLnResLn {
    static constexpr bool PERM = false, AFTER_DRAIN = true;
    const float* base; float* out; bf16_t* xn; int ldc; const float* bias; PanelStats st1, st2; unsigned poison;
    __device__ __forceinline__ void fused(f32x4 (&acc)[2][2][4][2], const Unit& u, int wr, int wc, int fr, int fq, PG8_LAS unsigned char* lds, int wid, int lane) const {
        typedef float f32x2v __attribute__((ext_vector_type(2))); typedef unsigned u32x2v __attribute__((ext_vector_type(2)));
        const PG8_LAS f32x2v* S = (const PG8_LAS f32x2v*)(lds + 8192);
        const int col0 = u.pn * BM + wc * 32 + 4 * fq;
#pragma unroll
        for (int bj = 0; bj < 2; ++bj)
#pragma unroll
            for (int n = 0; n < 2; ++n) { const f32x4 bv = bias ? *(const f32x4*)(bias + col0 + bj * HALF + n * 16) : (f32x4){0.f, 0.f, 0.f, 0.f};
#pragma unroll
                for (int ai = 0; ai < 2; ++ai)
#pragma unroll
                    for (int m = 0; m < 4; ++m) acc[ai][bj][m][n] += bv; }
        bool bad = st1.run(acc, u, wr, wc, fr, fq, lds, wid, lane) || poison != 0u;
        const float qnan = __builtin_nanf("");
#pragma unroll
        for (int ai = 0; ai < 2; ++ai)
#pragma unroll
            for (int m = 0; m < 4; ++m) { const int r = ai * HALF + wr * 64 + m * 16 + fr; const f32x2v sr = S[r]; const size_t off = (size_t)(u.pm * BM + r) * ldc + col0;
#pragma unroll
                for (int bj = 0; bj < 2; ++bj)
#pragma unroll
                    for (int n = 0; n < 2; ++n) { const f32x4 bs = *(const f32x4*)(base + off + bj * HALF + n * 16); acc[ai][bj][m][n] = bs + (acc[ai][bj][m][n] - sr.x) * sr.y; }
                asm volatile("" : "+v"(acc[ai][0][m][0]), "+v"(acc[ai][0][m][1]), "+v"(acc[ai][1][m][0]), "+v"(acc[ai][1][m][1]));
                if (m & 1) asm volatile("" ::: "memory"); }
        const bool bad1 = bad;
        bad = st2.run(acc, u, wr, wc, fr, fq, lds, wid, lane) || bad;
#pragma unroll
        for (int ai = 0; ai < 2; ++ai)
#pragma unroll
            for (int m = 0; m < 4; ++m) { const int r = ai * HALF + wr * 64 + m * 16 + fr; const f32x2v sr = S[r]; const size_t off = (size_t)(u.pm * BM + r) * ldc + col0;
#pragma unroll
                for (int bj = 0; bj < 2; ++bj)
#pragma unroll
                    for (int n = 0; n < 2; ++n) { const f32x4 x1 = acc[ai][bj][m][n]; *(f32x4*)(out + off + bj * HALF + n * 16) = bad1 ? (f32x4){qnan, qnan, qnan, qnan} : x1;
                        const f32x4 o = (x1 - sr.x) * sr.y; u32x2v w; w.x = cvt_pk_bf16(o[0], o[1]); w.y = cvt_pk_bf16(o[2], o[3]);
                        if (bad) { w.x = 0x7fc07fc0u; w.y = 0x7fc07fc0u; } *(u32x2v*)(xn + off + bj * HALF + n * 16) = w; }
                asm volatile("" ::: "memory"); }
    }
};

template <class Epi, class Sched, bool ALIGN_EPI = false, bool SP2 = false>
__device__ __forceinline__ void gemm_phase(PG8_LAS unsigned char* lds, const Gemm g, const Sched& S, const Epi& E) {
    const int tid = tidx(), wid = __builtin_amdgcn_readfirstlane(tid >> 6), lane = tid & 63, wr = wid >> 2, wc = wid & 3, fr = lane & 15, fq = lane >> 4;
    const int K = g.K, nt = K / BK;
    const int LDA = g.lda ? g.lda : K, LDB = g.ldb ? g.ldb : K;
    unsigned voffA[2], voffB[2];
#pragma unroll
    for (int i = 0; i < 2; ++i) { int R, C; stage_rc(tid * 16 + i * 8192, R, C); const int Rb = Epi::PERM ? ((R & ~31) + perm32(R & 31)) : R;
        voffA[i] = (unsigned)(R * LDA + C) * 2u; voffB[i] = (unsigned)(Rb * LDB + C) * 2u; }
    const size_t kstep = (size_t)(BK * 2);
    const size_t hstepA = (size_t)HALF * LDA * 2, hstepB = (size_t)HALF * LDB * 2;
    const size_t tstepA = 2 * hstepA, tstepB = 2 * hstepB;
    const unsigned ldsw = (unsigned)wid * 1024u;
    const int aoff = lds_byte(wr * 64 + fr, fq * 8), boff = lds_byte(wc * 32 + fr, fq * 8);
#define PG8_SA(b, h) (((b) * 2 + (h)) * HTB)
#define PG8_SB(b, h) ((4 + (b) * 2 + (h)) * HTB)
#define PG8_STAGE(bufoff, gbase, voff) do { _Pragma("unroll") for (int _i = 0; _i < 2; ++_i) \
        __builtin_amdgcn_global_load_lds((const unsigned*)((const char*)(gbase) + (voff)[_i]), (PG8_LAS unsigned*)(lds + (bufoff) + ldsw + _i * 8192), 16, 0, 0); } while (0)
#define PG8_LDA(dst, b, h) do { _Pragma("unroll") for (int m = 0; m < 4; ++m) _Pragma("unroll") for (int k = 0; k < 2; ++k) dst[m][k] = *(const PG8_LAS bf16x8*)(lds + PG8_SA(b, h) + aoff + m * 2048 + k * 1024); } while (0)
#define PG8_LDB(dst, b, h) do { _Pragma("unroll") for (int n = 0; n < 2; ++n) _Pragma("unroll") for (int k = 0; k < 2; ++k) dst[n][k] = *(const PG8_LAS bf16x8*)(lds + PG8_SB(b, h) + boff + n * 2048 + k * 1024); } while (0)
#define PG8_MMA(ai, bj, At, Bt) do { __builtin_amdgcn_s_setprio(1); _Pragma("unroll") for (int m = 0; m < 4; ++m) _Pragma("unroll") for (int n = 0; n < 2; ++n) _Pragma("unroll") for (int k = 0; k < 2; ++k) \
        acc[ai][bj][m][n] = __builtin_amdgcn_mfma_f32_16x16x32_bf16(Bt[n][k], At[m][k], acc[ai][bj][m][n], 0, 0, 0); __builtin_amdgcn_s_setprio(0); } while (0)
#define PG8_WAIT_V(n) asm volatile("s_waitcnt vmcnt(" #n ")" ::: "memory")
#define PG8_WAIT_L(n) asm volatile("s_waitcnt lgkmcnt(" #n ")" ::: "memory")
#define PG8_BAR __builtin_amdgcn_s_barrier()
#define PG8_SCHED __builtin_amdgcn_sched_barrier(0)
    Unit cur, nxt; int ui = 0;
    if (!S.next(0, cur)) return;
    f32x4 acc[2][2][4][2];
#pragma unroll
    for (int a = 0; a < 2; ++a)
#pragma unroll
        for (int b = 0; b < 2; ++b)
#pragma unroll
            for (int m = 0; m < 4; ++m)
#pragma unroll
                for (int n = 0; n < 2; ++n) acc[a][b][m][n] = (f32x4){0.f, 0.f, 0.f, 0.f};
    bf16x8 At[4][2], B0[2][2], B1[2][2];
    const char* cA = (const char*)g.A + (size_t)cur.pm * tstepA; const char* cB = (const char*)g.Bt + (size_t)cur.pn * tstepB;
    S.a_ready(cur);
    if constexpr (SP2) {
        PG8_STAGE(PG8_SB(0, 0), cB, voffB); PG8_STAGE(PG8_SB(0, 1), cB + hstepB, voffB); PG8_STAGE(PG8_SA(0, 0), cA, voffA); PG8_STAGE(PG8_SA(0, 1), cA + hstepA, voffA);
        if (wr == 1) PG8_BAR;
        PG8_WAIT_V(2); PG8_BAR;
        PG8_STAGE(PG8_SB(1, 0), cB + kstep, voffB); PG8_STAGE(PG8_SA(1, 0), cA + kstep, voffA); PG8_STAGE(PG8_SB(1, 1), cB + hstepB + kstep, voffB);
        PG8_WAIT_V(6); PG8_BAR;
    } else {
        PG8_STAGE(PG8_SB(0, 0), cB, voffB); PG8_STAGE(PG8_SA(0, 0), cA, voffA); PG8_STAGE(PG8_SB(0, 1), cB + hstepB, voffB); PG8_STAGE(PG8_SA(0, 1), cA + hstepA, voffA);
        if (wr == 1) PG8_BAR;
        PG8_WAIT_V(4); PG8_BAR;
        PG8_STAGE(PG8_SB(1, 0), cB + kstep, voffB); PG8_STAGE(PG8_SA(1, 0), cA + kstep, voffA); PG8_STAGE(PG8_SB(1, 1), cB + hstepB + kstep, voffB);
        PG8_WAIT_V(6); PG8_BAR;
    }
    for (;;) {
        const bool has_next = S.next(ui + 1, nxt);
        const char* nA = has_next ? (const char*)g.A + (size_t)nxt.pm * tstepA : cA; const char* nB = has_next ? (const char*)g.Bt + (size_t)nxt.pn * tstepB : cB;
        for (int t = 0; t < nt; t += 2) {
            const bool last = (t == nt - 2);
            const char* a1 = cA + (size_t)(t + 1) * kstep;
            const char* a2 = last ? nA : cA + (size_t)(t + 2) * kstep; const char* b2 = last ? nB : cB + (size_t)(t + 2) * kstep;
            const char* a3 = a2 + kstep; const char* b3 = b2 + kstep;
            if (last && has_next) S.a_ready(nxt);
            if constexpr (SP2) {
            PG8_LDB(B0, 0, 0); PG8_LDB(B1, 0, 1); PG8_SCHED; PG8_LDA(At, 0, 0); PG8_STAGE(PG8_SA(1, 1), a1 + hstepA, voffA);
            PG8_WAIT_V(8); PG8_WAIT_L(0); PG8_BAR; PG8_MMA(0, 0, At, B0); PG8_MMA(0, 1, At, B1); PG8_BAR; PG8_SCHED;
            PG8_LDA(At, 0, 1); PG8_STAGE(PG8_SB(0, 0), b2, voffB); PG8_STAGE(PG8_SB(0, 1), b2 + hstepB, voffB); PG8_STAGE(PG8_SA(0, 0), a2, voffA);
            PG8_WAIT_V(8); PG8_WAIT_L(0); PG8_BAR; PG8_MMA(1, 0, At, B0); PG8_MMA(1, 1, At, B1); PG8_BAR; PG8_SCHED;
            PG8_LDB(B0, 1, 0); PG8_LDB(B1, 1, 1); PG8_SCHED; PG8_LDA(At, 1, 0); PG8_STAGE(PG8_SA(0, 1), a2 + hstepA, voffA);
            PG8_WAIT_V(8); PG8_WAIT_L(0); PG8_BAR; PG8_MMA(0, 0, At, B0); PG8_MMA(0, 1, At, B1); PG8_BAR; PG8_SCHED;
            PG8_LDA(At, 1, 1); PG8_STAGE(PG8_SB(1, 0), b3, voffB); PG8_STAGE(PG8_SB(1, 1), b3 + hstepB, voffB); PG8_STAGE(PG8_SA(1, 0), a3, voffA);
            PG8_WAIT_V(8); PG8_WAIT_L(0); PG8_BAR; PG8_MMA(1, 0, At, B0); PG8_MMA(1, 1, At, B1); PG8_BAR; PG8_SCHED;
            } else {
            PG8_LDB(B0, 0, 0); PG8_SCHED; PG8_LDA(At, 0, 0); PG8_STAGE(PG8_SA(1, 1), a1 + hstepA, voffA);
            PG8_WAIT_L(8); PG8_BAR; PG8_WAIT_L(0); PG8_MMA(0, 0, At, B0); PG8_BAR; PG8_SCHED;
            PG8_LDB(B1, 0, 1); PG8_STAGE(PG8_SB(0, 0), b2, voffB);
            PG8_BAR; PG8_WAIT_L(0); PG8_MMA(0, 1, At, B1); PG8_BAR;
            PG8_LDA(At, 0, 1); PG8_STAGE(PG8_SA(0, 0), a2, voffA);
            PG8_BAR; PG8_WAIT_L(0); PG8_MMA(1, 0, At, B0); PG8_BAR; PG8_SCHED;
            PG8_STAGE(PG8_SB(0, 1), b2 + hstepB, voffB);
            PG8_WAIT_V(6); PG8_BAR; PG8_MMA(1, 1, At, B1); PG8_BAR;
            PG8_LDB(B0, 1, 0); PG8_SCHED; PG8_LDA(At, 1, 0); PG8_STAGE(PG8_SA(0, 1), a2 + hstepA, voffA);
            PG8_WAIT_L(8); PG8_BAR; PG8_WAIT_L(0); PG8_MMA(0, 0, At, B0); PG8_BAR; PG8_SCHED;
            PG8_LDB(B1, 1, 1); PG8_STAGE(PG8_SB(1, 0), b3, voffB);
            PG8_BAR; PG8_WAIT_L(0); PG8_MMA(0, 1, At, B1); PG8_BAR;
            PG8_LDA(At, 1, 1); PG8_STAGE(PG8_SA(1, 0), a3, voffA);
            PG8_BAR; PG8_WAIT_L(0); PG8_MMA(1, 0, At, B0); PG8_BAR; PG8_SCHED;
            PG8_STAGE(PG8_SB(1, 1), b3 + hstepB, voffB);
            PG8_WAIT_V(6); PG8_BAR; PG8_MMA(1, 1, At, B1); PG8_BAR;
            }
        }
        if constexpr (ALIGN_EPI) { if (wr == 0) PG8_BAR; }
        if constexpr (!Epi::AFTER_DRAIN) { E(acc, cur, wr, wc, fr, fq); S.done(cur); }
        if (!has_next) break;
#pragma unroll
        for (int a = 0; a < 2; ++a)
#pragma unroll
            for (int b = 0; b < 2; ++b)
#pragma unroll
                for (int m = 0; m < 4; ++m)
#pragma unroll
                    for (int n = 0; n < 2; ++n) acc[a][b][m][n] = (f32x4){0.f, 0.f, 0.f, 0.f};
        cur = nxt; cA = nA; cB = nB; ++ui;
        if constexpr (ALIGN_EPI) { if (wr == 1) PG8_BAR; }
    }
    PG8_WAIT_V(0);
    if constexpr (!ALIGN_EPI) { if (wr == 0) PG8_BAR; }
    PG8_BAR;
    if constexpr (Epi::AFTER_DRAIN) { E.fused(acc, cur, wr, wc, fr, fq, lds, wid, lane); S.done(cur); }
#undef PG8_SA
#undef PG8_SB
#undef PG8_STAGE
#undef PG8_LDA
#undef PG8_LDB
#undef PG8_MMA
#undef PG8_WAIT_V
#undef PG8_WAIT_L
#undef PG8_BAR
#undef PG8_SCHED
}
}
namespace pg8 {
struct EpiF32 {
    static constexpr bool PERM = false, AFTER_DRAIN = false;
    float* C; int ldc; const float* bias;
    __device__ __forceinline__ void operator()(const f32x4 (&acc)[2][2][4][2], const Unit& u, int wr, int wc, int fr, int fq) const {
        const int row0 = u.pm * BM + wr * 64 + fr, col0 = u.pn * BM + wc * 32 + 4 * fq;
        f32x4 bv[2][2];
#pragma unroll
        for (int bj = 0; bj < 2; ++bj)
#pragma unroll
            for (int n = 0; n < 2; ++n) bv[bj][n] = bias ? *(const f32x4*)(bias + col0 + bj * HALF + n * 16) : (f32x4){0.f, 0.f, 0.f, 0.f};
#pragma unroll
        for (int ai = 0; ai < 2; ++ai)
#pragma unroll
            for (int m = 0; m < 4; ++m) { float* rowp = C + (size_t)(row0 + ai * HALF + m * 16) * ldc + col0;
#pragma unroll
                for (int bj = 0; bj < 2; ++bj)
#pragma unroll
                    for (int n = 0; n < 2; ++n) *(f32x4*)(rowp + bj * HALF + n * 16) = acc[ai][bj][m][n] + bv[bj][n]; }
    }
};
}
#define XB_TMO      128
#define XB_XCNT(j)  (256  + 64 * (j))
#define XB_XSUB(j)  (1280 + 64 * (j))
#define XB_XGEN(j)  (2304 + 64 * (j))
#define XB_TOP      3328
#define XB_TOPGEN   3392
#define XCD_BAR_WORDS 3456
#define XB_SPIN_CAP (1u << 18)

__device__ __forceinline__ unsigned xb_ld(unsigned* p)              { return __hip_atomic_load(p, __ATOMIC_RELAXED, __HIP_MEMORY_SCOPE_AGENT); }
__device__ __forceinline__ unsigned xb_add(unsigned* p, unsigned v) { return __hip_atomic_fetch_add(p, v, __ATOMIC_RELAXED, __HIP_MEMORY_SCOPE_AGENT); }
__device__ __forceinline__ unsigned xb_xcc_id() { return (unsigned)__builtin_amdgcn_s_getreg((3 << 11) | 20) & 0xFu; }
#define XB_SPIN(cond, bar) do { unsigned _sp = 0; while (cond) { __builtin_amdgcn_s_sleep(1); \
    if ((++_sp & 255u) == 0u) { if (xb_ld(&(bar)[XB_TMO])) break; if (_sp > XB_SPIN_CAP) { atomicAdd(&(bar)[XB_TMO], 1u); break; } } } } while (0)

struct XcdBarrier {
    unsigned* bar; unsigned x;
    volatile LAS unsigned* st;
};

__device__ __forceinline__ XcdBarrier xcd_barrier_post(unsigned* bar, volatile LAS unsigned* st) {
    XcdBarrier b; b.bar = bar; b.x = xb_xcc_id(); b.st = st;
    if (tidx() == 0) (void)xb_add(&bar[XB_XCNT(b.x)], 1u);
    return b;
}
__device__ __forceinline__ void xcd_barrier_complete(unsigned* bar, unsigned x, unsigned& nloc, unsigned& nx) {
    const unsigned G = gridDim.x * gridDim.y * gridDim.z;
    unsigned sum, cnt, mine, sp = 0u;
    for (;;) {
        sum = 0u; cnt = 0u; mine = 0u;
#pragma unroll
        for (unsigned j = 0; j < 16; ++j) { const unsigned c = xb_ld(&bar[XB_XCNT(j)]); sum += c; cnt += (c > 0u) ? 1u : 0u; mine = (j == x) ? c : mine; }
        if (sum == G) break;
        __builtin_amdgcn_s_sleep(1);
        if ((++sp & 255u) == 0u) { if (xb_ld(&bar[XB_TMO])) break; if (sp > XB_SPIN_CAP) { atomicAdd(&bar[XB_TMO], 1u); break; } }
    }
    nloc = mine > 0u ? mine : 1u; nx = cnt > 0u ? cnt : 1u;
}

__device__ __forceinline__ void xcd_barrier(const XcdBarrier& b) {
    asm volatile("s_waitcnt vmcnt(0)" ::: "memory");
    __syncthreads();
    if (tidx() == 0) {
        unsigned* bar = b.bar;
        __builtin_amdgcn_s_waitcnt(0);
        unsigned nloc = b.st[0], nx = b.st[1];
        if (nloc == 0u) { xcd_barrier_complete(bar, b.x, nloc, nx); b.st[0] = nloc; b.st[1] = nx; }
        const unsigned old = xb_add(&bar[XB_XSUB(b.x)], 1u);
        const unsigned gen = old / nloc;
        if (old + 1u == (gen + 1u) * nloc) {
            __builtin_amdgcn_fence(__ATOMIC_RELEASE, "agent");
            asm volatile("s_waitcnt vmcnt(0)" ::: "memory");
            const unsigned og = xb_add(&bar[XB_TOP], 1u);
            const unsigned tg = og / nx;
            if (og + 1u == (tg + 1u) * nx) xb_add(&bar[XB_TOPGEN], 1u);
            else XB_SPIN(xb_ld(&bar[XB_TOPGEN]) == tg, bar);
            __builtin_amdgcn_fence(__ATOMIC_ACQUIRE, "agent");
            xb_add(&bar[XB_XGEN(b.x)], 1u);
            asm volatile("s_waitcnt vmcnt(0)" ::: "memory");
        } else {
            XB_SPIN(xb_ld(&bar[XB_XGEN(b.x)]) == gen, bar);
            __builtin_amdgcn_fence(__ATOMIC_ACQUIRE, "agent");
            asm volatile("s_waitcnt vmcnt(0)" ::: "memory");
        }
    }
    __syncthreads();
}

DEVI float wave_sum(float v) {
#pragma unroll
    for (int o = 32; o > 0; o >>= 1) v += __shfl_xor(v, o, 64);
    return v;
}
DEVI float wave_max(float v) {
#pragma unroll
    for (int o = 32; o > 0; o >>= 1) v = fmaxf(v, __shfl_xor(v, o, 64));
    return v;
}
DEVI float sigm(float x) { return 1.f / (1.f + expf(-x)); }
DEVI float gelu_t(float x) { return 0.5f * x * (1.f + tanhf(0.7978845608028654f * (x + 0.044715f * x * x * x))); }
DEVI float softplus_(float x) { return fmaxf(x, 0.f) + log1pf(expf(-fabsf(x))); }

DEVI float block_sum256(float v, float* red, int tid) {
    v = wave_sum(v);
    __syncthreads();
    if ((tid & 63) == 0) red[tid >> 6] = v;
    __syncthreads();
    return red[0] + red[1] + red[2] + red[3];
}

DEVI void ln_kernel(const float* xres, float alpha, const float* add, const float* __restrict__ g, const float* __restrict__ bt,
                    float* out, bf16* outb, int bid, float* sm) {
    __syncthreads();
    const size_t row = bid;
    const int tid = tidx() & 255;
    float v[4];
#pragma unroll
    for (int i = 0; i < 4; ++i) {
        const size_t idx = row * DM + tid + i * 256;
        v[i] = alpha * xres[idx] + (add ? add[idx] : 0.f);
    }
    const float mean = block_sum256(v[0] + v[1] + v[2] + v[3], sm, tid) * (1.f / DM);
    float q = 0.f;
#pragma unroll
    for (int i = 0; i < 4; ++i) { v[i] -= mean; q += v[i] * v[i]; }
    const float var = block_sum256(q, sm, tid) * (1.f / DM);
    const float rstd = rsqrtf(var + 1e-5f);
#pragma unroll
    for (int i = 0; i < 4; ++i) {
        const int c = tid + i * 256;
        const float o = v[i] * rstd * g[c] + bt[c];
        out[row * DM + c] = o;
        outb[row * DM + c] = (bf16)f2bf(o);
    }
}

struct GemmArgs {
    const float* A; const float* B; float* C; const int* rowidx; const int* zoff;
    long lda, sbk, sbn, ldc, sAz0, sAz1, sBz0, sBz1, sCz0, sCz1;
    int M, N, K, Z1, epi, pad;
};
DEVI void gemm_f32(const GemmArgs& g, int bx, int by, int z, bool live, float* sm) {
    float (*As)[68] = (float (*)[68])sm;
    float (*Bs)[68] = (float (*)[68])(sm + 16 * 68);
    const int z0 = z / g.Z1, z1 = z % g.Z1;
    int mbeg = 0, mend = g.M;
    if (g.zoff) { mbeg = g.zoff[z]; mend = g.zoff[z + 1]; }
    const int m0 = mbeg + by * 64;
    if (!live) mend = 0;
    const int n0 = bx * 64;
    const float* A = g.A + z0 * g.sAz0 + z1 * g.sAz1;
    const float* B = g.B + z0 * g.sBz0 + z1 * g.sBz1;
    float* C = g.C + z0 * g.sCz0 + z1 * g.sCz1;
    const int tid = tidx() & 255, tx = tid & 15, ty = tid >> 4;
    float acc[4][4];
#pragma unroll
    for (int i = 0; i < 4; ++i)
#pragma unroll
        for (int j = 0; j < 4; ++j) acc[i][j] = 0.f;
    long arow[4];
#pragma unroll
    for (int i = 0; i < 4; ++i) {
        const int r = (tid + i * 256) >> 4;
        const int row = m0 + r;
        if (row < mend) arow[i] = (long)(g.rowidx ? g.rowidx[row] : row) * g.lda; else arow[i] = -1;
    }
    __syncthreads();
    for (int k0 = 0; k0 < g.K; k0 += 16) {
#pragma unroll
        for (int i = 0; i < 4; ++i) {
            const int e = tid + i * 256, r = e >> 4, kk = e & 15;
            float v = 0.f;
            if (arow[i] >= 0 && k0 + kk < g.K) v = A[arow[i] + k0 + kk];
            As[kk][r] = v;
        }
#pragma unroll
        for (int i = 0; i < 4; ++i) {
            const int e = tid + i * 256, kk = e >> 6, n = e & 63;
            float v = 0.f;
            if (m0 < mend && n0 + n < g.N && k0 + kk < g.K) v = B[(long)(k0 + kk) * g.sbk + (long)(n0 + n) * g.sbn];
            Bs[kk][n] = v;
        }
        __syncthreads();
#pragma unroll
        for (int kk = 0; kk < 16; ++kk) {
            float a[4], b[4];
#pragma unroll
            for (int i = 0; i < 4; ++i) a[i] = As[kk][ty * 4 + i];
#pragma unroll
            for (int j = 0; j < 4; ++j) b[j] = Bs[kk][tx * 4 + j];
#pragma unroll
            for (int i = 0; i < 4; ++i)
#pragma unroll
                for (int j = 0; j < 4; ++j) acc[i][j] = fmaf(a[i], b[j], acc[i][j]);
        }
        __syncthreads();
    }
#pragma unroll
    for (int i = 0; i < 4; ++i) {
        const int row = m0 + ty * 4 + i;
        if (row >= mend) continue;
#pragma unroll
        for (int j = 0; j < 4; ++j) {
            const int col = n0 + tx * 4 + j;
            if (col >= g.N) continue;
            float* p = C + (long)row * g.ldc + col;
            float v = acc[i][j];
            if (g.epi == 2) { ((bf16*)C)[(long)row * g.ldc + col] = (bf16)f2bf(v); continue; }
            if (g.epi == 3) { ((bf16*)C)[(long)(row >> 9) * 64 * 512 + (long)col * 512 + (row & 511)] = (bf16)f2bf(v); continue; }
            if (g.epi == 1) { v = v * sigm(v) * (*p); }
            *p = v;
        }
    }
}
DEVI GemmArgs mk(const float* A, long lda, const float* B, long sbk, long sbn, float* C, long ldc, int M, int N, int K,
                 int Z1 = 1, long sAz0 = 0, long sAz1 = 0, long sBz0 = 0, long sBz1 = 0, long sCz0 = 0, long sCz1 = 0,
                 const int* rowidx = nullptr, const int* zoff = nullptr, int epi = 0) {
    GemmArgs g;
    g.A = A; g.B = B; g.C = C; g.rowidx = rowidx; g.zoff = zoff;
    g.lda = lda; g.sbk = sbk; g.sbn = sbn; g.ldc = ldc;
    g.sAz0 = sAz0; g.sAz1 = sAz1; g.sBz0 = sBz0; g.sBz1 = sBz1; g.sCz0 = sCz0; g.sCz1 = sCz1;
    g.M = M; g.N = N; g.K = K; g.Z1 = Z1; g.epi = epi; g.pad = 0;
    return g;
}
DEVI int gemm_tiles(const GemmArgs& g, int maxM, int Z) { return ((g.N + 63) / 64) * ((maxM + 63) / 64) * Z; }
DEVI bool gemm_tile_live(const GemmArgs& g, int maxM, int t) {
    const int nbx = (g.N + 63) / 64, nby = (maxM + 63) / 64;
    const int r = t / nbx, by = r % nby, z = r / nby;
    int mbeg = 0, mend = g.M;
    if (g.zoff) { mbeg = g.zoff[z]; mend = g.zoff[z + 1]; }
    return mbeg + by * 64 < mend;
}
DEVI void gemm_tile(const GemmArgs& g, int maxM, int t, bool live, float* sm) {
    const int nbx = (g.N + 63) / 64, nby = (maxM + 63) / 64;
    const int bx = t % nbx, r = t / nbx;
    gemm_f32(g, bx, r % nby, r / nby, live, sm);
}

DEVI void glu_kernel(const bf16* __restrict__ cols, float* __restrict__ h, int bid) {
    const size_t t = bid; const int c = tidx() & 255;
    h[t * 256 + c] = bf2f(cols[t * DINP + OFF_CV + c]) * sigm(bf2f(cols[t * DINP + OFF_CG + c]));
}
DEVI void conv_kernel(const float* __restrict__ h, const float* __restrict__ w, const float* __restrict__ bias,
                      const float* __restrict__ gg, const float* __restrict__ gb, bf16* __restrict__ mix, int bid) {
    const int t = bid, c = tidx() & 255;
    float acc = bias[c];
#pragma unroll 4
    for (int j = 0; j < 31; ++j) {
        const int tt = t - 30 + j;
        if (tt >= 0) acc = fmaf(h[(size_t)tt * 256 + c], w[j * 256 + c], acc);
    }
    const float mean = wave_sum(acc) * (1.f / 64.f);
    const float d = acc - mean;
    const float var = wave_sum(d * d) * (1.f / 64.f);
    const float y = d * rsqrtf(var + 1e-5f) * gg[c] + gb[c];
    mix[(size_t)t * DM + 0 + c] = (bf16)f2bf(y * sigm(y));
}

DEVI void gmlp_pre(const bf16* __restrict__ cols, const float* __restrict__ lg, const float* __restrict__ lb,
                   float* __restrict__ ub, float* __restrict__ vb, int bid, float* sm) {
    __syncthreads();
    const size_t t = bid; const int c = tidx() & 255;
    ub[t * 256 + c] = gelu_t(bf2f(cols[t * DINP + OFF_GU + c]));
    const float v = gelu_t(bf2f(cols[t * DINP + OFF_GV + c]));
    const float mean = block_sum256(v, sm, c) * (1.f / 256.f);
    const float d = v - mean;
    const float var = block_sum256(d * d, sm, c) * (1.f / 256.f);
    vb[t * 256 + c] = d * rsqrtf(var + 1e-5f) * lg[c] + lb[c];
}
DEVI void gmlp_mix(const float* __restrict__ ub, const float* __restrict__ vb, const float* __restrict__ ws,
                   const float* __restrict__ bs, bf16* __restrict__ mix, int bid) {
    const int t = bid, c = tidx() & 255, h = c >> 6, tt = t & 127, base = t - tt;
    float acc = bs[h * 128 + tt];
    const float* wr = ws + ((size_t)h * 128 + tt) * 128;
#pragma unroll 4
    for (int s = 0; s <= tt; ++s) acc = fmaf(wr[s], vb[(size_t)(base + s) * 256 + c], acc);
    mix[(size_t)t * DM + 512 + c] = (bf16)f2bf(ub[(size_t)t * 256 + c] * acc);
}

struct RwkvP {
    const bf16* cols; const float* mu; const float* w0; const float* w_up; const float* a0; const float* a_up; const float* g_up;
    const float* k_k; const float* k_a; const float* r_k; const float* vd; const float* v_mu; const float* v0; const float* v_up;
    float* vfirst; bf16* R; float* LW; bf16* K; bf16* V; bf16* A; bf16* Bv; float* G; float* BON;
    int layer, pad;
};
DEVI void rwkv_prep(const RwkvP& p, int bid, float* sm) {
    __syncthreads();
    float* y = sm;
    float* vds = sm + 1024;
    const int t = bid, c = tidx() & 255;
#pragma unroll
    for (int q = 0; q < 4; ++q) {
        const int j = c + q * 256;
        const float cur = bf2f(p.cols[(size_t)t * DINP + OFF_RW + j]);
        const float prv = t > 0 ? bf2f(p.cols[(size_t)(t - 1) * DINP + OFF_RW + j]) : 0.f;
        y[j] = cur + p.mu[j] * (prv - cur);
    }
    if (p.layer > 0 && c < 32) {
        const float cur = bf2f(p.cols[(size_t)t * DINP + DIN + c]);
        const float prv = t > 0 ? bf2f(p.cols[(size_t)(t - 1) * DINP + DIN + c]) : 0.f;
        vds[c] = cur + p.v_mu[c] * (prv - cur);
    }
    __syncthreads();
    float tw = 0.f, sg = 0.f;
    if (c < 64) tw = tanhf(y[768 + c]);
    if (c >= 128) sg = sigm(y[896 + (c - 128)]);
    __syncthreads();
    if (c < 64) y[768 + c] = tw;
    if (c >= 128) y[896 + (c - 128)] = sg;
    __syncthreads();
    const float r = y[c], k = y[256 + c];
    float v = y[512 + c];
    float wl = p.w0[c], al = p.a0[c], gl = 0.f;
#pragma unroll 4
    for (int j = 0; j < 64; ++j) { wl = fmaf(y[768 + j], p.w_up[j * 256 + c], wl); al = fmaf(y[832 + j], p.a_up[j * 256 + c], al); }
#pragma unroll 4
    for (int j = 0; j < 128; ++j) gl = fmaf(y[896 + j], p.g_up[j * 256 + c], gl);
    const float wlog = -softplus_(-wl) - 0.5f;
    const float a = sigm(al);
    if (p.layer == 0) {
        p.vfirst[(size_t)t * 256 + c] = v;
    } else {
        float vm = p.v0[c];
#pragma unroll 4
        for (int j = 0; j < 32; ++j) vm = fmaf(vds[j], p.v_up[j * 256 + c], vm);
        vm = sigm(vm);
        v = v + (p.vfirst[(size_t)t * 256 + c] - v) * vm;
    }
    float kk = k * p.k_k[c];
    const float nrm = sqrtf(wave_sum(kk * kk));
    kk = kk / fmaxf(nrm, 1e-12f);
    const float k2 = k * (1.f + (a - 1.f) * p.k_a[c]);
    const float bd = wave_sum(r * k2 * p.r_k[c]);
    const size_t o = (size_t)t * 256 + c;
    p.R[o] = (bf16)f2bf(r); p.LW[o] = -expf(wlog); p.K[o] = (bf16)f2bf(k2); p.V[o] = (bf16)f2bf(v); p.A[o] = (bf16)f2bf(-kk); p.Bv[o] = (bf16)f2bf(kk * a); p.G[o] = gl; p.BON[o] = bd * v;
}
DEVI void rwkv_scan(float* R, const float* __restrict__ W, const float* __restrict__ K, const float* __restrict__ V,
                    const float* __restrict__ A, const float* __restrict__ Bv, float* sm0) {
    float (*sr)[256] = (float (*)[256])sm0, (*sw)[256] = sr + 4, (*sk)[256] = sr + 8, (*sa)[256] = sr + 12, (*sb)[256] = sr + 16, (*sv)[256] = sr + 20;
    const int vt = tidx(); const bool act = vt < 256;
    const int tid = vt & 255, h = tid >> 6, lane = tid & 63;
    float st[64];
#pragma unroll
    for (int i = 0; i < 64; ++i) st[i] = 0.f;
    for (int t0 = 0; t0 < SEQ; t0 += 4) {
        __syncthreads();
        if (act) {
#pragma unroll
            for (int s = 0; s < 4; ++s) {
                const size_t idx = (size_t)(t0 + s) * 256 + tid;
                sr[s][tid] = R[idx]; sw[s][tid] = W[idx]; sk[s][tid] = K[idx]; sa[s][tid] = A[idx]; sb[s][tid] = Bv[idx]; sv[s][tid] = V[idx];
            }
        }
        __syncthreads();
        if (act) {
#pragma unroll 1
            for (int s = 0; s < 4; ++s) {
                const float vt_ = sv[s][tid];
                const float* pa = &sa[s][h * 64]; const float* pw = &sw[s][h * 64]; const float* pb = &sb[s][h * 64];
                const float* pk = &sk[s][h * 64]; const float* pr = &sr[s][h * 64];
                float sa_ = 0.f;
#pragma unroll
                for (int k = 0; k < 64; ++k) sa_ = fmaf(st[k], pa[k], sa_);
#pragma unroll
                for (int k = 0; k < 64; ++k) st[k] = fmaf(st[k], pw[k], fmaf(sa_, pb[k], vt_ * pk[k]));
                float o = 0.f;
#pragma unroll
                for (int k = 0; k < 64; ++k) o = fmaf(st[k], pr[k], o);
                R[(size_t)(t0 + s) * 256 + h * 64 + lane] = o;
            }
        }
    }
    __syncthreads();
}
DEVI void rwkv_post(const float* __restrict__ O, const float* __restrict__ BON, const float* __restrict__ G,
                    const float* __restrict__ gg, const float* __restrict__ gb, bf16* __restrict__ mix, int bid) {
    const size_t t = bid; const int c = tidx() & 255;
    const float o = O[t * 256 + c];
    const float mean = wave_sum(o) * (1.f / 64.f);
    const float d = o - mean;
    const float var = wave_sum(d * d) * (1.f / 64.f);
    const float y = d * rsqrtf(var + 64e-5f) * gg[c] + gb[c];
    mix[t * DM + 256 + c] = (bf16)f2bf((y + BON[t * 256 + c]) * G[t * 256 + c]);
}

DEVI void nsa_prep(const bf16* __restrict__ cols, float* __restrict__ qrot, float* __restrict__ ksr,
                   float* __restrict__ kwr, float* __restrict__ gates, int bid) {
    const int t = bid, c = tidx() & 255;
    const int d = c & 63, j = d & 31;
    const float inv = powf(10000.f, -(float)j / 32.f);
    const float ang = (float)t * inv;
    float sn, cs; sincosf(ang, &sn, &cs);
    {
        const bf16* q = cols + (size_t)t * DINP + OFF_Q + (c & ~63);
        const float x1 = bf2f(q[j]), x2 = bf2f(q[j + 32]);
        qrot[(size_t)t * 256 + c] = d < 32 ? x1 * cs - x2 * sn : x2 * cs + x1 * sn;
    }
    if (c < 128) {
        const bf16* kp = cols + (size_t)t * DINP + (c < 64 ? OFF_KS : OFF_KW);
        const float x1 = bf2f(kp[j]), x2 = bf2f(kp[j + 32]);
        const float v = d < 32 ? x1 * cs - x2 * sn : x2 * cs + x1 * sn;
        if (c < 64) ksr[(size_t)t * 64 + d] = v; else kwr[(size_t)t * 64 + d] = v;
    }
    if (c < 12) gates[(size_t)t * 12 + c] = sigm(bf2f(cols[(size_t)t * DINP + OFF_GT + c]));
}
DEVI void cmp_gather(const bf16* __restrict__ cols, const float* __restrict__ pek, const float* __restrict__ pev,
                     bf16* __restrict__ bk, bf16* __restrict__ bv, int bid) {
    const int n = bid, tid = tidx() & 255;
    for (int i = tid; i < 2048; i += 256) {
        const int l = i >> 6, d = i & 63;
        const size_t row = (size_t)(16 * n + l) * DINP;
        bk[(size_t)n * 2048 + i] = n < NCMP ? (bf16)f2bf(bf2f(cols[row + OFF_KC + d]) + pek[i]) : (bf16)0;
        bv[(size_t)n * 2048 + i] = n < NCMP ? (bf16)f2bf(bf2f(cols[row + OFF_VC + d]) + pev[i]) : (bf16)0;
    }
}
DEVI void gelu_inplace(float* p, int n, int bid) {
    const int i = bid * 256 + (tidx() & 255);
    if (i < n) p[i] = gelu_t(p[i]);
}

DEVI void wave_softmax(float* s, int n, int lane) {
    float m = -INFINITY;
    for (int i = lane; i < n; i += 64) m = fmaxf(m, s[i]);
    m = wave_max(m);
    if (m == -INFINITY) { for (int i = lane; i < n; i += 64) s[i] = 0.f; return; }
    float sum = 0.f;
    for (int i = lane; i < n; i += 64) { const float p = expf(s[i] - m); s[i] = p; sum += p; }
    sum = wave_sum(sum);
    const float inv = 1.f / fmaxf(sum, 1e-20f);
    for (int i = lane; i < n; i += 64) s[i] *= inv;
}
DEVI void dot4(const float* q  , const float* __restrict__ krow, float* out4) {
    float a0 = 0.f, a1 = 0.f, a2 = 0.f, a3 = 0.f;
#pragma unroll
    for (int d = 0; d < 64; d += 4) {
        const float4 kv = *(const float4*)(krow + d);
        a0 += q[d] * kv.x + q[d + 1] * kv.y + q[d + 2] * kv.z + q[d + 3] * kv.w;
        a1 += q[64 + d] * kv.x + q[64 + d + 1] * kv.y + q[64 + d + 2] * kv.z + q[64 + d + 3] * kv.w;
        a2 += q[128 + d] * kv.x + q[128 + d + 1] * kv.y + q[128 + d + 2] * kv.z + q[128 + d + 3] * kv.w;
        a3 += q[192 + d] * kv.x + q[192 + d + 1] * kv.y + q[192 + d + 2] * kv.z + q[192 + d + 3] * kv.w;
    }
    out4[0] = a0; out4[1] = a1; out4[2] = a2; out4[3] = a3;
}
DEVI void nsa_attn(const bf16* __restrict__ cols, const float* __restrict__ qrot, const float* __restrict__ ksr,
                   const float* __restrict__ kwr, const float* __restrict__ gates, const float* __restrict__ kcmp,
                   const float* __restrict__ vcmp, bf16* __restrict__ mix, int bid, float* sm) {
    __syncthreads();
    float* q = sm; float* qr = sm + 256;
    float (*sc)[1024] = (float (*)[1024])(sm + 512);
    float* imp = sm + 512 + 4096;
    int* sel = (int*)(sm + 512 + 4096 + 128);
    const int pos = bid, tid = tidx() & 255, h = tid >> 6, lane = tid & 63;
    q[tid] = bf2f(cols[(size_t)pos * DINP + OFF_Q + tid]);
    qr[tid] = qrot[(size_t)pos * 256 + tid];
    __syncthreads();
    int ncv = pos >= 31 ? (pos - 31) / 16 + 1 : 0;
    if (ncv > NCMP) ncv = NCMP;
    for (int n = tid; n < 512; n += 256) {
        if (n < ncv) {
            float d4[4]; dot4(q, kcmp + (size_t)n * 64, d4);
            sc[0][n] = d4[0] * 0.125f; sc[1][n] = d4[1] * 0.125f; sc[2][n] = d4[2] * 0.125f; sc[3][n] = d4[3] * 0.125f;
        } else { sc[0][n] = 0.f; sc[1][n] = 0.f; sc[2][n] = 0.f; sc[3][n] = 0.f; }
    }
    __syncthreads();
    wave_softmax(sc[h], ncv, lane);
    __syncthreads();
    float oc = 0.f;
#pragma unroll 4
    for (int n = 0; n < ncv; ++n) oc = fmaf(sc[h][n], vcmp[(size_t)n * 64 + lane], oc);
    if (tid < 128) {
        const int j = tid;
        auto ps = [&](int n) -> float { return (n >= 0 && n < 512) ? (sc[0][n] + sc[1][n] + sc[2][n] + sc[3][n]) : 0.f; };
        const float v = 0.5f * ps(4 * j - 1) + ps(4 * j) + ps(4 * j + 1) + ps(4 * j + 2) + 0.5f * ps(4 * j + 3);
        const int cur = pos >> 6;
        float key;
        if (j == cur || j == 0) key = INFINITY; else if (j <= cur) key = v; else key = -1.f;
        imp[j] = key;
    }
    __syncthreads();
    if (h == 0) {
        float v0 = imp[lane], v1 = imp[lane + 64];
        for (int r = 0; r < 16; ++r) {
            float bv; int bi;
            if (v1 > v0) { bv = v1; bi = lane + 64; } else { bv = v0; bi = lane; }
#pragma unroll
            for (int o = 32; o > 0; o >>= 1) {
                const float ov = __shfl_xor(bv, o, 64); const int oi = __shfl_xor(bi, o, 64);
                if (ov > bv || (ov == bv && oi < bi)) { bv = ov; bi = oi; }
            }
            if (lane == 0) sel[r] = bi;
            if (bi == lane) v0 = -2.f;
            if (bi == lane + 64) v1 = -2.f;
        }
    }
    __syncthreads();
    for (int i = tid; i < 1024; i += 256) {
        const int kp = sel[i >> 6] * 64 + (i & 63);
        if (kp <= pos) {
            float d4[4]; dot4(qr, ksr + (size_t)kp * 64, d4);
            sc[0][i] = d4[0] * 0.125f; sc[1][i] = d4[1] * 0.125f; sc[2][i] = d4[2] * 0.125f; sc[3][i] = d4[3] * 0.125f;
        } else { sc[0][i] = -INFINITY; sc[1][i] = -INFINITY; sc[2][i] = -INFINITY; sc[3][i] = -INFINITY; }
    }
    __syncthreads();
    wave_softmax(sc[h], 1024, lane);
    __syncthreads();
    float os = 0.f;
#pragma unroll 2
    for (int i = 0; i < 1024; ++i) {
        const float p = sc[h][i];
        if (p != 0.f) { const int kp = sel[i >> 6] * 64 + (i & 63); os = fmaf(p, bf2f(cols[(size_t)kp * DINP + OFF_VS + lane]), os); }
    }
    __syncthreads();
    for (int i = tid; i < 512; i += 256) {
        const int kp = pos - 511 + i;
        if (kp >= 0) {
            float d4[4]; dot4(qr, kwr + (size_t)kp * 64, d4);
            sc[0][i] = d4[0] * 0.125f; sc[1][i] = d4[1] * 0.125f; sc[2][i] = d4[2] * 0.125f; sc[3][i] = d4[3] * 0.125f;
        } else { sc[0][i] = -INFINITY; sc[1][i] = -INFINITY; sc[2][i] = -INFINITY; sc[3][i] = -INFINITY; }
    }
    __syncthreads();
    wave_softmax(sc[h], 512, lane);
    __syncthreads();
    float ow = 0.f;
#pragma unroll 4
    for (int i = 0; i < 512; ++i) {
        const int kp = pos - 511 + i;
        if (kp >= 0) ow = fmaf(sc[h][i], bf2f(cols[(size_t)kp * DINP + OFF_VW + lane]), ow);
    }
    const float* gt = gates + (size_t)pos * 12 + h * 3;
    mix[(size_t)pos * DM + 768 + tid] = (bf16)f2bf(gt[0] * oc + gt[1] * os + gt[2] * ow);
}

DEVI void softmax256(float* s, float scale, int bid, float* sm) {
    __syncthreads();
    const size_t row = bid; const int tid = tidx() & 255;
    const float v = s[row * 256 + tid] * scale;
    float m = wave_max(v);
    if ((tid & 63) == 0) sm[8 + (tid >> 6)] = m;
    __syncthreads();
    m = fmaxf(fmaxf(sm[8], sm[9]), fmaxf(sm[10], sm[11]));
    const float p = expf(v - m);
    const float sum = block_sum256(p, sm, tid);
    s[row * 256 + tid] = p / sum;
}

DEVI void router_kernel(const float* __restrict__ x, const float* __restrict__ rw, const float* __restrict__ rb,
                        int* __restrict__ te, float* __restrict__ tw, int bid, float* sm) {
    __syncthreads();
    float (*part)[16] = (float (*)[16])sm;
    const size_t t = bid; const int tid = tidx() & 255;
    float acc[16];
#pragma unroll
    for (int e = 0; e < 16; ++e) acc[e] = 0.f;
#pragma unroll 1
    for (int i = tid; i < DM; i += 256) {
        const float xv = x[t * DM + i];
#pragma unroll
        for (int e = 0; e < 16; ++e) acc[e] = fmaf(xv, rw[i * 16 + e], acc[e]);
    }
#pragma unroll
    for (int e = 0; e < 16; ++e) acc[e] = wave_sum(acc[e]);
    if ((tid & 63) == 0) {
#pragma unroll
        for (int e = 0; e < 16; ++e) part[tid >> 6][e] = acc[e];
    }
    __syncthreads();
    if (tid == 0) {
        float lg[16], pr[16], sl[16];
        float m = -INFINITY;
#pragma unroll
        for (int e = 0; e < 16; ++e) { lg[e] = part[0][e] + part[1][e] + part[2][e] + part[3][e]; m = fmaxf(m, lg[e]); }
        float sum = 0.f;
#pragma unroll
        for (int e = 0; e < 16; ++e) { pr[e] = expf(lg[e] - m); sum += pr[e]; }
#pragma unroll
        for (int e = 0; e < 16; ++e) { pr[e] /= sum; sl[e] = pr[e] + rb[e]; }
        int bg = 0; float bgs = -INFINITY;
#pragma unroll
        for (int gI = 0; gI < 4; ++gI) {
            float m1 = -INFINITY, m2 = -INFINITY;
#pragma unroll
            for (int j = 0; j < 4; ++j) { const float v = sl[gI * 4 + j]; if (v > m1) { m2 = m1; m1 = v; } else if (v > m2) m2 = v; }
            const float sc = m1 + m2;
            if (sc > bgs) { bgs = sc; bg = gI; }
        }
        int e0 = -1, e1 = -1; float s0 = -INFINITY, s1 = -INFINITY, p0 = 0.f, p1 = 0.f;
#pragma unroll
        for (int e = 0; e < 16; ++e) {
            if ((e >> 2) == bg) {
                const float v = sl[e];
                if (v > s0) { s1 = s0; e1 = e0; p1 = p0; s0 = v; e0 = e; p0 = pr[e]; } else if (v > s1) { s1 = v; e1 = e; p1 = pr[e]; }
            }
        }
        const float wsum = p0 + p1;
        te[t * 2] = e0; te[t * 2 + 1] = e1;
        tw[t * 2] = p0 / wsum; tw[t * 2 + 1] = p1 / wsum;
    }
}
DEVI void moe_lists(const int* __restrict__ te, int* __restrict__ off, int* __restrict__ list, int* __restrict__ slotpos, float* sm0) {
    int* cnt = (int*)sm0;
    int* offs = cnt + 16;
    const int w = tidx() >> 6, lane = tidx() & 63;
    __syncthreads();
    for (int ee = 0; ee < 2; ++ee) {
        const int e = w * 2 + ee;
        int c = 0;
        for (int base = 0; base < NTOK; base += 64) {
            const int tok = base + lane;
            const bool m = (te[tok * 2] == e) || (te[tok * 2 + 1] == e);
            c += __popcll(__ballot(m));
        }
        if (lane == 0) cnt[e] = c;
    }
    __syncthreads();
    if (tidx() == 0) {
        int s = 0;
        for (int i = 0; i < 16; ++i) { offs[i] = s; off[i] = s; s += cnt[i]; }
        offs[16] = s; off[16] = s;
    }
    __syncthreads();
    for (int ee = 0; ee < 2; ++ee) {
        const int e = w * 2 + ee;
        int pos = offs[e];
        for (int base = 0; base < NTOK; base += 64) {
            const int tok = base + lane;
            const int a = te[tok * 2], b = te[tok * 2 + 1];
            const bool m = (a == e) || (b == e);
            const unsigned long long mask = __ballot(m);
            if (m) {
                const int p = pos + __popcll(mask & ((1ull << lane) - 1ull));
                list[p] = tok;
                slotpos[tok * 2 + (a == e ? 0 : 1)] = p;
            }
            pos += __popcll(mask);
        }
    }
    __syncthreads();
}
DEVI void moe_combine_ln(const float* x, const float* __restrict__ Dp, const int* __restrict__ te,
                         const float* __restrict__ tw, const int* __restrict__ slotpos,
                         const float* __restrict__ g, const float* __restrict__ bt, float* out, bf16* outb, int bid, float* sm) {
    __syncthreads();
    const size_t t = bid; const int tid = tidx() & 255;
    int ea = te[t * 2], eb = te[t * 2 + 1];
    float wa = tw[t * 2], wb = tw[t * 2 + 1];
    size_t pa = slotpos[t * 2], pb = slotpos[t * 2 + 1];
    if (eb < ea) { const float tf = wa; wa = wb; wb = tf; const size_t tp = pa; pa = pb; pb = tp; }
    float v[4];
#pragma unroll
    for (int i = 0; i < 4; ++i) {
        const int c = tid + i * 256;
        float y = wa * Dp[pa * DM + c];
        y = y + wb * Dp[pb * DM + c];
        v[i] = ALPHA * x[t * DM + c] + y;
    }
    const float mean = block_sum256(v[0] + v[1] + v[2] + v[3], sm, tid) * (1.f / DM);
    float q = 0.f;
#pragma unroll
    for (int i = 0; i < 4; ++i) { v[i] -= mean; q += v[i] * v[i]; }
    const float var = block_sum256(q, sm, tid) * (1.f / DM);
    const float rstd = rsqrtf(var + 1e-5f);
#pragma unroll
    for (int i = 0; i < 4; ++i) {
        const int c = tid + i * 256;
        const float o = v[i] * rstd * g[c] + bt[c];
        out[t * DM + c] = o;
        outb[t * DM + c] = (bf16)f2bf(o);
    }
}
typedef short bf16x8 __attribute__((ext_vector_type(8)));
typedef short s16x4 __attribute__((ext_vector_type(4)));
typedef float f32x16 __attribute__((ext_vector_type(16)));
typedef float f32x2_t __attribute__((ext_vector_type(2)));
typedef __bf16 bf16x2_t __attribute__((ext_vector_type(2)));
DEVI unsigned cvtpk(float lo, float hi) { f32x2_t v = {lo, hi}; bf16x2_t b = __builtin_convertvector(v, bf16x2_t); return __builtin_bit_cast(unsigned, b); }
constexpr float QSCL = 0.125f * 1.4426950408889634f;

struct NsaP {
    const bf16 *QN, *QR, *KSR, *KWR, *VST, *VWT, *KCMP, *VCMPT;
    const float* GATES;
    bf16* MIX;
};
constexpr int NSA_KT = 0, NSA_VT = 16384, NSA_IA = 32768, NSA_IB = 65536, NSA_SELM = 98304, NSA_UNI = 99328;

DEVI int crow(int r, int hi) { return (r & 3) + 8 * (r >> 2) + 4 * hi; }
DEVI float max3f(float a, float b, float c) { float r; asm("v_max3_f32 %0, %1, %2, %3" : "=v"(r) : "v"(a), "v"(b), "v"(c)); return r; }
DEVI float max2f(float a, float b) { float r; asm("v_max_f32_e32 %0, %1, %2" : "=v"(r) : "v"(a), "v"(b)); return r; }
DEVI float half_max(float x) { auto rr = __builtin_amdgcn_permlane32_swap(__float_as_uint(x), __float_as_uint(x), false, false); return max2f(__uint_as_float(rr[0]), __uint_as_float(rr[1])); }
DEVI float half_sum(float x) { auto rr = __builtin_amdgcn_permlane32_swap(__float_as_uint(x), __float_as_uint(x), false, false); return __uint_as_float(rr[0]) + __uint_as_float(rr[1]); }
DEVI float quad_sum(float x) {
    x += __int_as_float(__builtin_amdgcn_update_dpp(0, __float_as_int(x), 0xB1, 0xF, 0xF, true));
    x += __int_as_float(__builtin_amdgcn_update_dpp(0, __float_as_int(x), 0x4E, 0xF, 0xF, true));
    return x;
}
DEVI float rowmax32(const f32x16& p0, const f32x16& p1) {
    float a = max3f(p0[0], p0[1], p1[0]), b = max3f(p0[2], p0[3], p1[1]); a = max3f(a, p1[2], p1[3]);
#pragma unroll
    for (int r = 4; r < 16; r += 4) { a = max3f(a, p0[r], p0[r + 1]); b = max3f(b, p0[r + 2], p0[r + 3]); a = max3f(a, p1[r], p1[r + 1]); b = max3f(b, p1[r + 2], p1[r + 3]); }
    return half_max(max2f(a, b));
}

DEVI void nsa_ld(v4u& rk, v4u& rv, const bf16* kbase, const bf16* vbase, size_t vstride, int tid) {
    rk = *(const v4u*)((const char*)kbase + tid * 16);
    rv = *(const v4u*)((const char*)(vbase + (size_t)(tid >> 3) * vstride) + (tid & 7) * 16);
}
DEVI void nsa_st(LAS unsigned char* KTb, LAS unsigned char* VTb, const v4u& rk, const v4u& rv, int tid) {
    const int r = tid >> 3, c = tid & 7, off = r * 128 + ((c ^ (r & 7)) << 4);
    *(LAS v4u*)(KTb + off) = rk; *(LAS v4u*)(VTb + off) = rv;
}
DEVI void nsa_qk(f32x16& p0, f32x16& p1, const LAS unsigned char* KTb, const bf16x8 (&qf)[4], int q32, int hi) {
#pragma unroll
    for (int r = 0; r < 16; ++r) { p0[r] = 0.f; p1[r] = 0.f; }
#pragma unroll
    for (int ks = 0; ks < 4; ++ks) {
        const int c = ((2 * ks + hi) ^ (q32 & 7)) << 4;
        const bf16x8 a0 = *(const LAS bf16x8*)(KTb + q32 * 128 + c);
        const bf16x8 a1 = *(const LAS bf16x8*)(KTb + (32 + q32) * 128 + c);
        p0 = __builtin_amdgcn_mfma_f32_32x32x16_bf16(a0, qf[ks], p0, 0, 0, 0);
        p1 = __builtin_amdgcn_mfma_f32_32x32x16_bf16(a1, qf[ks], p1, 0, 0, 0);
    }
}
DEVI void nsa_pv(f32x16 (&o)[2], const LAS unsigned char* VTb, const bf16x8 (&pf)[4], int q32, int hi) {
#pragma unroll
    for (int db = 0; db < 2; ++db) {
        const int d = 32 * db + q32;
        const LAS unsigned char* rowp = VTb + d * 128 + 8 * hi;
#pragma unroll
        for (int s = 0; s < 4; ++s) {
            const s16x4 lo = *(const LAS s16x4*)(rowp + (((2 * s) ^ (d & 7)) << 4));
            const s16x4 h4 = *(const LAS s16x4*)(rowp + (((2 * s + 1) ^ (d & 7)) << 4));
            const bf16x8 a = {lo[0], lo[1], lo[2], lo[3], h4[0], h4[1], h4[2], h4[3]};
            o[db] = __builtin_amdgcn_mfma_f32_32x32x16_bf16(a, pf[s], o[db], 0, 0, 0);
        }
    }
}
DEVI void nsa_pack(bf16x8 (&pf)[4], const f32x16& p0, const f32x16& p1) {
#pragma unroll
    for (int s = 0; s < 2; ++s) {
        unsigned w0[4], w1[4];
#pragma unroll
        for (int j = 0; j < 4; ++j) { w0[j] = cvtpk(p0[8 * s + 2 * j], p0[8 * s + 2 * j + 1]); w1[j] = cvtpk(p1[8 * s + 2 * j], p1[8 * s + 2 * j + 1]); }
        pf[s] = __builtin_bit_cast(bf16x8, (v4u){w0[0], w0[1], w0[2], w0[3]});
        pf[2 + s] = __builtin_bit_cast(bf16x8, (v4u){w1[0], w1[1], w1[2], w1[3]});
    }
}
DEVI void nsa_softmax(f32x16& p0, f32x16& p1, float& m, float& l, f32x16 (&o)[2], bf16x8 (&pf)[4]) {
    typedef float f2 __attribute__((ext_vector_type(2)));
    const float mx = rowmax32(p0, p1);
    if (__any(mx > m + 8.f)) {
        const float mn = fmaxf(m, mx);
        const float msn = (mn == -INFINITY) ? 0.f : mn;
        const float alpha = __builtin_amdgcn_exp2f(m - msn);
        l *= alpha; m = mn;
#pragma unroll
        for (int r = 0; r < 16; ++r) { o[0][r] *= alpha; o[1][r] *= alpha; }
    }
    const float ms = (m == -INFINITY) ? 0.f : m;
    f2 sum = {0.f, 0.f};
#pragma unroll
    for (int r = 0; r < 16; r += 2) {
        f2 x0 = {p0[r], p0[r + 1]}, x1 = {p1[r], p1[r + 1]};
        x0 = x0 - ms; x1 = x1 - ms;
        x0.x = __builtin_amdgcn_exp2f(x0.x); x0.y = __builtin_amdgcn_exp2f(x0.y); x1.x = __builtin_amdgcn_exp2f(x1.x); x1.y = __builtin_amdgcn_exp2f(x1.y);
        sum = sum + x0 + x1;
        p0[r] = x0.x; p0[r + 1] = x0.y; p1[r] = x1.x; p1[r + 1] = x1.y;
    }
    l += half_sum(sum.x + sum.y);
    nsa_pack(pf, p0, p1);
}
DEVI void nsa_loadq(bf16x8 (&qf)[4], const bf16* Q, int tq, int head, int hi) {
    const bf16* qp = Q + (size_t)tq * 256 + head * 64 + 8 * hi;
#pragma unroll
    for (int ks = 0; ks < 4; ++ks) qf[ks] = *(const bf16x8*)(qp + 16 * ks);
}


#define NSA_PIPE(NT_, KP_, VP_, VSTR_, ...) do { \
    const int nt_ = (NT_); v4u rk0_, rv0_, rk1_, rv1_; \
    if (nt_ > 0) nsa_ld(rk0_, rv0_, KP_(0), VP_(0), VSTR_, tid); \
    if (nt_ > 1) nsa_ld(rk1_, rv1_, KP_(1), VP_(1), VSTR_, tid); \
    __syncthreads(); \
    if (nt_ > 0) nsa_st(KT, VT, rk0_, rv0_, tid); \
    __syncthreads(); \
    if (nt_ > 2) nsa_ld(rk0_, rv0_, KP_(2), VP_(2), VSTR_, tid); \
    for (int it0_ = 0; it0_ < nt_; it0_ += 2) { \
        { const int it_ = it0_; const int bo_ = 0; __VA_ARGS__ } \
        if (it0_ + 1 < nt_) nsa_st(KT + 8192, VT + 8192, rk1_, rv1_, tid); \
        __syncthreads(); \
        if (it0_ + 3 < nt_) nsa_ld(rk1_, rv1_, KP_(it0_ + 3), VP_(it0_ + 3), VSTR_, tid); \
        if (it0_ + 1 >= nt_) break; \
        { const int it_ = it0_ + 1; const int bo_ = 8192; __VA_ARGS__ } \
        if (it0_ + 2 < nt_) nsa_st(KT, VT, rk0_, rv0_, tid); \
        __syncthreads(); \
        if (it0_ + 4 < nt_) nsa_ld(rk0_, rv0_, KP_(it0_ + 4), VP_(it0_ + 4), VSTR_, tid); \
    } } while (0)

DEVI void nsa_unit(const NsaP& P, int u, LAS unsigned char* lds) {
    const int tid = tidx(), w = tid >> 6, lane = tid & 63, q32 = lane & 31, hi = lane >> 5;
    const int t0 = u * 64, cur = u;
    const int tl = 8 * w + (q32 >> 2), head = q32 & 3, tq = t0 + tl;
    LAS unsigned char* KT = lds + NSA_KT; LAS unsigned char* VT = lds + NSA_VT;
    LAS float* IA = (LAS float*)(lds + NSA_IA); LAS float* IB = (LAS float*)(lds + NSA_IB);
    LAS unsigned* SELM = (LAS unsigned*)(lds + NSA_SELM); LAS unsigned* UNI = (LAS unsigned*)(lds + NSA_UNI);
    __syncthreads();
    for (int i = tid; i < 2 * 64 * 128; i += 512) IA[i] = 0.f;
    if (tid < 4) UNI[tid] = 0u;
    LAS float* ACC = (LAS float*)(lds + NSA_IA) + (w * 32) * 64 + lane;
    bf16x8 qf[4], pf[4];
    f32x16 o[2], p0, p1;

    {
        nsa_loadq(qf, P.QN, tq, head, hi);
        const int nlim = tq >= 31 ? (tq - 31) >> 4 : -1;
        const int nmaxu = (t0 + 63 - 31) >> 4;
        const int nct = (nmaxu >> 6) + 1;
        float m = -INFINITY, l = 0.f;
        for (int pass = 0; pass < 2; ++pass) {
#pragma unroll
            for (int r = 0; r < 16; ++r) { o[0][r] = 0.f; o[1][r] = 0.f; }
            const float rl = (pass == 1 && l > 0.f) ? 1.f / l : 0.f;
#define KPC_(i) (P.KCMP + (size_t)(i) * 64 * 64)
#define VPC_(i) (P.VCMPT + (i) * 64)
            NSA_PIPE(nct, KPC_, VPC_, 512, {
                nsa_qk(p0, p1, KT + bo_, qf, q32, hi);
                const int nb = it_ * 64;
                if (__any(nb + 63 > nlim)) {
                    const int lim = nlim - nb - 4 * hi;
_Pragma("unroll")
                    for (int r = 0; r < 16; ++r) { const int c0 = (r & 3) + 8 * (r >> 2); if (c0 > lim) p0[r] = -INFINITY; if (c0 + 32 > lim) p1[r] = -INFINITY; }
                }
                if (pass == 0) {
                    const float mx = rowmax32(p0, p1);
                    const float mn = fmaxf(m, mx), ms = (mn == -INFINITY) ? 0.f : mn;
                    float sum = 0.f;
_Pragma("unroll")
                    for (int r = 0; r < 16; ++r) sum += __builtin_amdgcn_exp2f(p0[r] - ms) + __builtin_amdgcn_exp2f(p1[r] - ms);
                    sum = half_sum(sum);
                    l = l * __builtin_amdgcn_exp2f(m - ms) + sum; m = mn;
                } else {
                    const float ms = (m == -INFINITY) ? 0.f : m;
_Pragma("unroll")
                    for (int r = 0; r < 16; ++r) { p0[r] = __builtin_amdgcn_exp2f(p0[r] - ms) * rl; p1[r] = __builtin_amdgcn_exp2f(p1[r] - ms) * rl; }
_Pragma("unroll")
                    for (int half = 0; half < 2; ++half) {
_Pragma("unroll")
                        for (int g = 0; g < 4; ++g) {
                            const f32x16& pp = half ? p1 : p0;
                            float a = pp[4 * g] + pp[4 * g + 1] + pp[4 * g + 2] + 0.5f * pp[4 * g + 3];
                            float b = 0.5f * pp[4 * g + 3];
                            a = quad_sum(a); b = quad_sum(b);
                            const int j = (nb + 32 * half + 8 * g + 4 * hi) >> 2;
                            if (head == 0 && j < 128) { IA[tl * 128 + j] = a; IB[tl * 128 + j] = b; }
                        }
                    }
                    nsa_pack(pf, p0, p1);
                    nsa_pv(o, VT + bo_, pf, q32, hi);
                }
            });
        }
        { const float g_c = P.GATES[(size_t)tq * 12 + head * 3 + 0];
#pragma unroll
        for (int r = 0; r < 16; ++r) { o[0][r] *= g_c; o[1][r] *= g_c; } }
    }
    REP(26)
    for (int tt = 0; tt < 8; ++tt) {
        const int tok = 8 * w + tt;
        unsigned k0, k1;
        {
            const int j0 = lane, j1 = lane + 64;
            const float i0f = IA[tok * 128 + j0] + (j0 > 0 ? IB[tok * 128 + j0 - 1] : 0.f), i1f = IA[tok * 128 + j1] + IB[tok * 128 + j1 - 1];
            k0 = (j0 == cur || j0 == 0) ? 0x7f800001u : (j0 <= cur ? __float_as_uint(i0f) + 1u : 0u);
            k1 = (j1 == cur) ? 0x7f800001u : (j1 <= cur ? __float_as_uint(i1f) + 1u : 0u);
        }
        unsigned T = 0u;
#pragma unroll 1
        for (int bit = 30; bit >= 0; --bit) {
            const unsigned cand = T | (1u << bit);
            const int cnt = __popcll(__ballot(k0 >= cand)) + __popcll(__ballot(k1 >= cand));
            if (cnt >= 16) T = cand;
        }
        const unsigned long long gt0 = __ballot(k0 > T), gt1 = __ballot(k1 > T), eq0 = __ballot(k0 == T), eq1 = __ballot(k1 == T);
        const int need = 16 - (__popcll(gt0) + __popcll(gt1));
        const unsigned long long lt = (1ull << lane) - 1ull;
        const bool s0_ = (k0 > T) || ((k0 == T) && __popcll(eq0 & lt) < need);
        const bool s1_ = (k1 > T) || ((k1 == T) && (__popcll(eq0) + __popcll(eq1 & lt)) < need);
        const unsigned long long b0 = __ballot(s0_), b1 = __ballot(s1_);
        if (lane == 0) {
            const unsigned m0 = (unsigned)b0, m1 = (unsigned)(b0 >> 32), m2 = (unsigned)b1, m3 = (unsigned)(b1 >> 32);
            SELM[tok * 4 + 0] = m0; SELM[tok * 4 + 1] = m1; SELM[tok * 4 + 2] = m2; SELM[tok * 4 + 3] = m3;
            __hip_atomic_fetch_or(&UNI[0], m0, __ATOMIC_RELAXED, __HIP_MEMORY_SCOPE_WORKGROUP); __hip_atomic_fetch_or(&UNI[1], m1, __ATOMIC_RELAXED, __HIP_MEMORY_SCOPE_WORKGROUP);
            __hip_atomic_fetch_or(&UNI[2], m2, __ATOMIC_RELAXED, __HIP_MEMORY_SCOPE_WORKGROUP); __hip_atomic_fetch_or(&UNI[3], m3, __ATOMIC_RELAXED, __HIP_MEMORY_SCOPE_WORKGROUP);
        }
    }
    __syncthreads();
#pragma unroll
    for (int r = 0; r < 16; ++r) { ACC[r * 64] = o[0][r]; ACC[(16 + r) * 64] = o[1][r]; }
    {
        nsa_loadq(qf, P.QR, tq, head, hi);
        const unsigned s0 = SELM[tl * 4 + 0], s1 = SELM[tl * 4 + 1], s2 = SELM[tl * 4 + 2], s3 = SELM[tl * 4 + 3];
        const unsigned u0 = UNI[0], u1 = UNI[1], u2 = UNI[2], u3 = UNI[3];
        float m = -INFINITY, l = 0.f;
        LAS unsigned char* TL = (LAS unsigned char*)(lds + NSA_UNI + 16);
        int ntl;
        {
            const unsigned lt0 = cur >= 31 ? 0xffffffffu : ((2u << cur) - 1u), lt1 = cur < 32 ? 0u : (cur >= 63 ? 0xffffffffu : ((2u << (cur - 32)) - 1u)),
                           lt2 = cur < 64 ? 0u : (cur >= 95 ? 0xffffffffu : ((2u << (cur - 64)) - 1u)), lt3 = cur < 96 ? 0u : (cur >= 127 ? 0xffffffffu : ((2u << (cur - 96)) - 1u));
            const unsigned v0 = u0 & lt0, v1 = u1 & lt1, v2 = u2 & lt2, v3 = u3 & lt3;
            ntl = __popc(v0) + __popc(v1) + __popc(v2) + __popc(v3);
            if (tid < 128) {
                const int jj = tid, wq = jj >> 5; const unsigned bit = 1u << (jj & 31), below = bit - 1u;
                const unsigned vw = wq == 0 ? v0 : (wq == 1 ? v1 : (wq == 2 ? v2 : v3));
                if (vw & bit) {
                    const int pos = (wq > 0 ? __popc(v0) : 0) + (wq > 1 ? __popc(v1) : 0) + (wq > 2 ? __popc(v2) : 0) + __popc(vw & below);
                    TL[pos] = (unsigned char)jj;
                }
            }
        }
        __syncthreads();
#define KPS_(i) (P.KSR + (size_t)TL[i] * 64 * 64)
#define VPS_(i) (P.VST + (int)TL[i] * 64)
        REP(25) {
        m = -INFINITY; l = 0.f;
#pragma unroll
        for (int r = 0; r < 16; ++r) { o[0][r] = 0.f; o[1][r] = 0.f; }
        NSA_PIPE(ntl, KPS_, VPS_, SEQ, {
            const int j = TL[it_];
            const unsigned wv = j < 32 ? s0 : (j < 64 ? s1 : (j < 96 ? s2 : s3));
            const bool mine = (wv >> (j & 31)) & 1u;
            if (__any(mine)) {
                nsa_qk(p0, p1, KT + bo_, qf, q32, hi);
                if (j == cur || !__all(mine)) {
                    const int klim = (mine ? (j == cur ? (tq & 63) : 63) : -1) - 4 * hi;
_Pragma("unroll")
                    for (int r = 0; r < 16; ++r) { const int c0 = (r & 3) + 8 * (r >> 2); if (c0 > klim) p0[r] = -INFINITY; if (c0 + 32 > klim) p1[r] = -INFINITY; }
                }
                nsa_softmax(p0, p1, m, l, o, pf);
                nsa_pv(o, VT + bo_, pf, q32, hi);
            }
        });
        }
        const float g_s = P.GATES[(size_t)tq * 12 + head * 3 + 1];
        const float sc = l > 0.f ? g_s / l : 0.f;
#pragma unroll
        for (int r = 0; r < 16; ++r) { ACC[r * 64] += sc * o[0][r]; ACC[(16 + r) * 64] += sc * o[1][r]; }
    }
    {
        float m = -INFINITY, l = 0.f;
#pragma unroll
        for (int r = 0; r < 16; ++r) { o[0][r] = 0.f; o[1][r] = 0.f; }
        const int j0 = cur >= 8 ? cur - 8 : 0;
#define KPW_(i) (P.KWR + (size_t)(j0 + (i)) * 64 * 64)
#define VPW_(i) (P.VWT + (j0 + (i)) * 64)
        NSA_PIPE(cur - j0 + 1, KPW_, VPW_, SEQ, {
            const int j = j0 + it_;
            nsa_qk(p0, p1, KT + bo_, qf, q32, hi);
            if (j == cur || j + 8 == cur) {
                const int hiA = tq - j * 64 - 4 * hi, loA = hiA - 512;
_Pragma("unroll")
                for (int r = 0; r < 16; ++r) {
                    const int c0 = (r & 3) + 8 * (r >> 2);
                    if (c0 > hiA || c0 <= loA) p0[r] = -INFINITY;
                    if (c0 + 32 > hiA || c0 + 32 <= loA) p1[r] = -INFINITY;
                }
            }
            nsa_softmax(p0, p1, m, l, o, pf);
            nsa_pv(o, VT + bo_, pf, q32, hi);
        });
        const float g_w = P.GATES[(size_t)tq * 12 + head * 3 + 2];
        const float sc = l > 0.f ? g_w / l : 0.f;
#pragma unroll
        for (int r = 0; r < 16; ++r) { o[0][r] = ACC[r * 64] + sc * o[0][r]; o[1][r] = ACC[(16 + r) * 64] + sc * o[1][r]; }
    }
    {
        bf16* op = P.MIX + (size_t)tq * DM + 768 + head * 64 + 4 * hi;
#pragma unroll
        for (int db = 0; db < 2; ++db)
#pragma unroll
            for (int g = 0; g < 4; ++g) {
                const unsigned lo = cvtpk(o[db][4 * g], o[db][4 * g + 1]), h2 = cvtpk(o[db][4 * g + 2], o[db][4 * g + 3]);
                *(uint2*)(op + 32 * db + 8 * g) = make_uint2(lo, h2);
            }
    }
}

DEVI void nsa_prep2(const bf16* __restrict__ cols, bf16* __restrict__ qn, bf16* __restrict__ qr, bf16* __restrict__ ksr, bf16* __restrict__ kwr,
                    bf16* __restrict__ vst, bf16* __restrict__ vwt, float* __restrict__ gates, int bid) {
    const int t = bid, c = tidx() & 255;
    const int d = c & 63, j = d & 31;
    const float inv = powf(10000.f, -(float)j / 32.f);
    const float ang = (float)t * inv;
    float sn, cs; sincosf(ang, &sn, &cs);
    {
        const bf16* q = cols + (size_t)t * DINP + OFF_Q + (c & ~63);
        const float x1 = bf2f(q[j]), x2 = bf2f(q[j + 32]);
        qn[(size_t)t * 256 + c] = (bf16)f2bf(bf2f(q[d]) * QSCL);
        qr[(size_t)t * 256 + c] = (bf16)f2bf((d < 32 ? x1 * cs - x2 * sn : x2 * cs + x1 * sn) * QSCL);
    }
    if (c < 128) {
        const bf16* kp = cols + (size_t)t * DINP + (c < 64 ? OFF_KS : OFF_KW);
        const float x1 = bf2f(kp[j]), x2 = bf2f(kp[j + 32]);
        const float v = d < 32 ? x1 * cs - x2 * sn : x2 * cs + x1 * sn;
        if (c < 64) ksr[(size_t)t * 64 + d] = (bf16)f2bf(v); else kwr[(size_t)t * 64 + d] = (bf16)f2bf(v);
    } else {
        const bf16 v = cols[(size_t)t * DINP + (c < 192 ? OFF_VS : OFF_VW) + d];
        if (c < 192) vst[(size_t)d * SEQ + t] = v; else vwt[(size_t)d * SEQ + t] = v;
    }
    if (c < 12) gates[(size_t)t * 12 + c] = sigm(bf2f(cols[(size_t)t * DINP + OFF_GT + c]));
}
DEVI void nsa_cmp_cvt(const float* __restrict__ kc, const float* __restrict__ vc, bf16* __restrict__ kcb, bf16* __restrict__ vct, int bid) {
    const int i = bid * 256 + (tidx() & 255);
    if (i < 512 * 64) {
        const int n = i >> 6, d = i & 63;
        kcb[i] = n < NCMP ? (bf16)f2bf(kc[i]) : (bf16)0;
        vct[d * 512 + n] = n < NCMP ? (bf16)f2bf(vc[i]) : (bf16)0;
    }
}
DEVI float4 ld4bf(const bf16* p);
constexpr int RW_SLOT = 8192;
typedef unsigned u32x2v __attribute__((ext_vector_type(2)));
DEVI int rw_off(int row, int chunk16) { return row * 128 + ((chunk16 ^ (row & 7)) << 4); }
DEVI void rw_ld(LAS unsigned char* slot, const bf16* g, int gt) {
#pragma unroll
    for (int e = 0; e < 2; ++e) { const int idx = gt + 256 * e, row = idx >> 3, ch = idx & 7;
        *(LAS v4u*)(slot + rw_off(row, ch)) = *(const v4u*)((const char*)g + idx * 16); }
}
DEVI void rw_ldT(LAS unsigned char* slot, const bf16* g, size_t gstride, int gt) {
#pragma unroll
    for (int e = 0; e < 2; ++e) { const int idx = gt + 256 * e, row = idx >> 3, ch = idx & 7;
        const v4u v = *(const v4u*)(g + (size_t)row * gstride + ch * 8);
        const unsigned w[4] = {v.x, v.y, v.z, v.w};
#pragma unroll
        for (int j = 0; j < 8; ++j) { const int col = ch * 8 + j; const unsigned short h = (unsigned short)(w[j >> 1] >> ((j & 1) * 16));
            *(LAS unsigned short*)(slot + rw_off(col, row >> 3) + (row & 7) * 2) = h; }
    }
}
DEVI bf16x8 rw_frag(const LAS unsigned char* slot, int blk, int s, int r32, int hi) {
    return *(const LAS bf16x8*)(slot + rw_off(32 * blk + r32, 2 * s + hi));
}
DEVI void rw_mm(f32x16& acc, const LAS unsigned char* slotA, int rb, const LAS unsigned char* slotBT, int cb, int r32, int hi) {
#pragma unroll
    for (int s = 0; s < 4; ++s) acc = __builtin_amdgcn_mfma_f32_32x32x16_bf16(rw_frag(slotA, rb, s, r32, hi), rw_frag(slotBT, cb, s, r32, hi), acc, 0, 0, 0);
}
DEVI void rw_stT(LAS unsigned char* slot, const f32x16& acc, int rb, int cb, int r32, int hi) {
    const int j = 32 * cb + r32;
#pragma unroll
    for (int g = 0; g < 4; ++g) {
        const u32x2v w = {cvtpk(acc[4 * g], acc[4 * g + 1]), cvtpk(acc[4 * g + 2], acc[4 * g + 3])};
        *(LAS u32x2v*)(slot + rw_off(j, 4 * rb + g) + 8 * hi) = w;
    }
}
DEVI void rw_st(LAS unsigned char* slot, const f32x16& acc, int rb, int cb, int r32, int hi) {
    const int j = 32 * cb + r32;
#pragma unroll
    for (int r = 0; r < 16; ++r) { const int i = 32 * rb + crow(r, hi);
        *(LAS unsigned short*)(slot + rw_off(i, j >> 3) + (j & 7) * 2) = (unsigned short)f2bf(acc[r]); }
}
DEVI void rw_ldaccT(f32x16& acc, const LAS unsigned char* slot, int rb, int cb, int r32, int hi) {
    const int j = 32 * cb + r32;
#pragma unroll
    for (int g = 0; g < 4; ++g) {
        const u32x2v w = *(const LAS u32x2v*)(slot + rw_off(j, 4 * rb + g) + 8 * hi);
        acc[4 * g] = __builtin_bit_cast(float, w.x << 16); acc[4 * g + 1] = __builtin_bit_cast(float, w.x & 0xffff0000u);
        acc[4 * g + 2] = __builtin_bit_cast(float, w.y << 16); acc[4 * g + 3] = __builtin_bit_cast(float, w.y & 0xffff0000u);
    }
}
DEVI void rw_zero(f32x16& a) {
#pragma unroll
    for (int r = 0; r < 16; ++r) a[r] = 0.f;
}
DEVI void rw_frags(v4u& f0, v4u& f1, const f32x16& a) {
    f0 = (v4u){cvtpk(a[0], a[1]), cvtpk(a[2], a[3]), cvtpk(a[4], a[5]), cvtpk(a[6], a[7])};
    f1 = (v4u){cvtpk(a[8], a[9]), cvtpk(a[10], a[11]), cvtpk(a[12], a[13]), cvtpk(a[14], a[15])};
}

struct RwP {
    const bf16 *R, *K, *V, *A, *B;
    const float* LW; const bf16 *G, *BON;
    bf16 *AT, *BT, *KT, *RT;
    float* LAM;
    v4u *PF, *HF;
    float *QT, *OL;
    v4u* SF;
    const float *gn_g, *gn_b;
    bf16* MIX;
};

DEVI void rw_r1b(const RwP& P, int c, LAS unsigned char* lds) {
    LAS float* cum = (LAS float*)lds;
    const int tid = tidx();
    __syncthreads();
    if (tid < 256) {
        float s = 0.f;
#pragma unroll 8
        for (int t = 0; t < 64; ++t) { s += P.LW[(size_t)(c * 64 + t) * 256 + tid]; cum[t * 256 + tid] = s; }
    }
    __syncthreads();
    for (int e = tid; e < 64 * 256; e += 512) {
        const int t = e >> 8, ch = e & 255, h = ch >> 6, k = ch & 63;
        const size_t gi = (size_t)(c * 64 + t) * 256 + ch;
        const float cu = cum[e], lw = P.LW[gi];
        const float ein = __expf(cu), eout = __expf(-cu), eex = __expf(cu - lw);
        const size_t o = ((size_t)(c * 4 + h) * 64 + t) * 64 + k;
        P.AT[o] = (bf16)f2bf(bf2f(P.A[gi]) * eex);
        P.BT[o] = (bf16)f2bf(bf2f(P.B[gi]) * eout);
        P.KT[o] = (bf16)f2bf(bf2f(P.K[gi]) * eout);
        P.RT[o] = (bf16)f2bf(bf2f(P.R[gi]) * ein);
        if (t == 63) P.LAM[(size_t)(c * 4 + h) * 64 + k] = ein;
    }
}

DEVI void rw_r2(const RwP& P, int u0, LAS unsigned char* lds) {
    const int tid = tidx(), grp = tid >> 8, gt = tid & 255, gw = (tid >> 6) & 3, lane = tid & 63, r32 = lane & 31, hi = lane >> 5;
    const int rb = gw >> 1, cb = gw & 1;
    const int u = u0 + grp, c = u >> 2, h = u & 3;
    LAS unsigned char* sl = lds + grp * 65536;
#define SL(i) (sl + (i) * RW_SLOT)
    __syncthreads();
    rw_ld(SL(0), P.BT + (size_t)u * 4096, gt); rw_ld(SL(1), P.AT + (size_t)u * 4096, gt);
    rw_ld(SL(2), P.KT + (size_t)u * 4096, gt); rw_ld(SL(3), P.RT + (size_t)u * 4096, gt);
    __syncthreads();
    f32x16 aMab, aMak, aNbr, aNkr;
    rw_zero(aMab); rw_zero(aMak); rw_zero(aNbr); rw_zero(aNkr);
    rw_mm(aMab, SL(0), rb, SL(1), cb, r32, hi);
    rw_mm(aMak, SL(2), rb, SL(1), cb, r32, hi);
    rw_mm(aNbr, SL(0), rb, SL(3), cb, r32, hi);
    rw_mm(aNkr, SL(2), rb, SL(3), cb, r32, hi);
    {
        const int t = 32 * cb + r32;
#pragma unroll
        for (int r = 0; r < 16; ++r) { const int i = 32 * rb + crow(r, hi);
            if (!(i < t)) { aMab[r] = 0.f; aMak[r] = 0.f; }
            if (!(i <= t)) { aNbr[r] = 0.f; aNkr[r] = 0.f; } }
    }
    __syncthreads();
    rw_st(SL(4), aMab, rb, cb, r32, hi);
    rw_stT(SL(5), aMab, rb, cb, r32, hi);
    rw_st(SL(6), aMak, rb, cb, r32, hi);
    rw_stT(SL(7), aNbr, rb, cb, r32, hi);
    {
        const int t = 32 * cb + r32;
#pragma unroll
        for (int r = 0; r < 16; ++r) { const int i = 32 * rb + crow(r, hi); if (i == t) aMab[r] += 1.f; }
    }
    rw_st(SL(0), aMab, rb, cb, r32, hi);
    __syncthreads();
    int mA = 4, mT = 5, nA = 1, nT = 2;
#pragma unroll 1
    for (int j = 0; j < 5; ++j) {
        f32x16 a1; rw_zero(a1);
        rw_mm(a1, SL(mT), rb, SL(mA), cb, r32, hi);
        rw_stT(SL(nA), a1, rb, cb, r32, hi);
        rw_st(SL(nT), a1, rb, cb, r32, hi);
        __syncthreads();
        f32x16 a2; rw_ldaccT(a2, SL(0), rb, cb, r32, hi);
        rw_mm(a2, SL(nT), rb, SL(0), cb, r32, hi);
        __syncthreads();
        rw_stT(SL(0), a2, rb, cb, r32, hi);
        __syncthreads();
        const int ta = mA, tb = mT; mA = nA; mT = nT; nA = ta; nT = tb;
    }
    rw_ldT(SL(1), P.BT + (size_t)u * 4096, 64, gt); rw_ldT(SL(2), P.AT + (size_t)u * 4096, 64, gt);
    rw_ldT(SL(4), P.KT + (size_t)u * 4096, 64, gt); rw_ldT(SL(5), P.V + (size_t)(c * 64) * 256 + h * 64, 256, gt);
    __syncthreads();
    {
        f32x16 aY, aZ; rw_zero(aY); rw_zero(aZ);
        rw_mm(aY, SL(0), rb, SL(1), cb, r32, hi);
        rw_mm(aZ, SL(0), rb, SL(7), cb, r32, hi);
        __syncthreads();
        rw_stT(SL(1), aY, rb, cb, r32, hi);
        rw_stT(SL(7), aZ, rb, cb, r32, hi);
        __syncthreads();
    }
    {
        f32x16 aP; rw_zero(aP);
        rw_mm(aP, SL(2), rb, SL(1), cb, r32, hi);
        const int kp = 32 * cb + r32; const float lam = P.LAM[(size_t)u * 64 + kp];
#pragma unroll
        for (int r = 0; r < 16; ++r) { const int kk = 32 * rb + crow(r, hi); aP[r] = (aP[r] + (kk == kp ? 1.f : 0.f)) * lam; }
        v4u f0, f1; rw_frags(f0, f1, aP);
        v4u* dst = P.PF + ((((size_t)u * 2 + cb) * 2 + rb) * 2) * 64 + lane;
        dst[0] = f0; dst[64] = f1;
    }
    {
        f32x16 aH; rw_ldaccT(aH, SL(3), rb, cb, r32, hi);
        rw_mm(aH, SL(2), rb, SL(7), cb, r32, hi);
        v4u f0, f1; rw_frags(f0, f1, aH);
        v4u* dst = P.HF + ((((size_t)u * 2 + cb) * 2 + rb) * 2) * 64 + lane;
        dst[0] = f0; dst[64] = f1;
    }
    {
        f32x16 aD1; rw_ldaccT(aD1, SL(4), rb, cb, r32, hi);
        rw_mm(aD1, SL(6), rb, SL(1), cb, r32, hi);
        rw_mm(aNkr, SL(6), rb, SL(7), cb, r32, hi);
        __syncthreads();
        rw_stT(SL(0), aD1, rb, cb, r32, hi);
        rw_stT(SL(3), aNkr, rb, cb, r32, hi);
        __syncthreads();
    }
    {
        f32x16 aQ; rw_zero(aQ);
        rw_mm(aQ, SL(0), rb, SL(5), cb, r32, hi);
        float* dst = P.QT + (((size_t)u * 2 + cb) * 2 + rb) * 1024 + lane * 4;
#pragma unroll
        for (int g = 0; g < 4; ++g) {
            const float4 lam = *(const float4*)(P.LAM + (size_t)u * 64 + 32 * rb + 8 * g + 4 * hi);
            *(float4*)(dst + g * 256) = make_float4(aQ[4 * g] * lam.x, aQ[4 * g + 1] * lam.y, aQ[4 * g + 2] * lam.z, aQ[4 * g + 3] * lam.w);
        }
    }
    {
        f32x16 aO; rw_zero(aO);
        rw_mm(aO, SL(5), rb, SL(3), cb, r32, hi);
        float* dst = P.OL + (((size_t)u * 2 + cb) * 2 + rb) * 1024 + lane * 4;
#pragma unroll
        for (int g = 0; g < 4; ++g) *(float4*)(dst + g * 256) = make_float4(aO[4 * g], aO[4 * g + 1], aO[4 * g + 2], aO[4 * g + 3]);
    }
#undef SL
}

DEVI void rw_r3_load(const RwP& P, size_t u, int vb, int lane, f32x16 (&q)[2], v4u (&pf)[8]) {
#pragma unroll
    for (int kb = 0; kb < 2; ++kb) {
        const float* qp = P.QT + ((u * 2 + vb) * 2 + kb) * 1024 + lane * 4;
#pragma unroll
        for (int g = 0; g < 4; ++g) { const float4 v = *(const float4*)(qp + g * 256); q[kb][4 * g] = v.x; q[kb][4 * g + 1] = v.y; q[kb][4 * g + 2] = v.z; q[kb][4 * g + 3] = v.w; }
        const v4u* pp = P.PF + (((u * 2 + kb) * 2) * 2) * 64 + lane;
#pragma unroll
        for (int i = 0; i < 4; ++i) pf[kb * 4 + i] = pp[i * 64];
    }
}
DEVI void rw_r3(const RwP& P, int b, int h, int vb, int lane) {
    f32x16 st[2]; rw_zero(st[0]); rw_zero(st[1]);
    f32x16 q[2], qn[2]; v4u pf[8], pfn[8];
    const size_t ub = (size_t)b * (SEQ / 64) * 4 + h;
    rw_r3_load(P, ub, vb, lane, q, pf);
#pragma unroll 1
    for (int c = 0; c < SEQ / 64; ++c) {
        const size_t u = ub + (size_t)c * 4;
        if (c + 1 < SEQ / 64) rw_r3_load(P, u + 4, vb, lane, qn, pfn);
        v4u sf[2][2];
        rw_frags(sf[0][0], sf[0][1], st[0]); rw_frags(sf[1][0], sf[1][1], st[1]);
        v4u* sdst = P.SF + ((u * 2 + vb) * 4) * 64 + lane;
        sdst[0] = sf[0][0]; sdst[64] = sf[0][1]; sdst[128] = sf[1][0]; sdst[192] = sf[1][1];
#pragma unroll
        for (int kb = 0; kb < 2; ++kb)
#pragma unroll
            for (int ki = 0; ki < 2; ++ki)
#pragma unroll
                for (int s = 0; s < 2; ++s)
                    q[kb] = __builtin_amdgcn_mfma_f32_32x32x16_bf16(__builtin_bit_cast(bf16x8, pf[kb * 4 + ki * 2 + s]), __builtin_bit_cast(bf16x8, sf[ki][s]), q[kb], 0, 0, 0);
        st[0] = q[0]; st[1] = q[1];
        q[0] = qn[0]; q[1] = qn[1];
#pragma unroll
        for (int i = 0; i < 8; ++i) pf[i] = pfn[i];
    }
}

DEVI void rw_r4(const RwP& P, int u, int tb, int lane) {
    const int c = u >> 2, h = u & 3, r32 = lane & 31, hi = lane >> 5;
    f32x16 o[2];
#pragma unroll
    for (int vb = 0; vb < 2; ++vb) {
        const float* ol = P.OL + (((size_t)u * 2 + tb) * 2 + vb) * 1024 + lane * 4;
#pragma unroll
        for (int g = 0; g < 4; ++g) { const float4 v = *(const float4*)(ol + g * 256); o[vb][4 * g] = v.x; o[vb][4 * g + 1] = v.y; o[vb][4 * g + 2] = v.z; o[vb][4 * g + 3] = v.w; }
        const v4u* sf = P.SF + (((size_t)u * 2 + vb) * 4) * 64 + lane;
        const v4u* hf = P.HF + ((((size_t)u * 2 + tb) * 2) * 2) * 64 + lane;
#pragma unroll
        for (int kb = 0; kb < 2; ++kb)
#pragma unroll
            for (int s = 0; s < 2; ++s)
                o[vb] = __builtin_amdgcn_mfma_f32_32x32x16_bf16(__builtin_bit_cast(bf16x8, sf[(kb * 2 + s) * 64]), __builtin_bit_cast(bf16x8, hf[(kb * 2 + s) * 64]), o[vb], 0, 0, 0);
    }
    float sum = 0.f;
#pragma unroll
    for (int r = 0; r < 16; ++r) sum += o[0][r] + o[1][r];
    sum += __shfl_xor(sum, 32, 64);
    const float mean = sum * (1.f / 64.f);
    float q = 0.f;
#pragma unroll
    for (int r = 0; r < 16; ++r) { const float d0 = o[0][r] - mean, d1 = o[1][r] - mean; q += d0 * d0 + d1 * d1; }
    q += __shfl_xor(q, 32, 64);
    const float rstd = rsqrtf(q * (1.f / 64.f) + 64e-5f);
    const size_t tok = (size_t)c * 64 + 32 * tb + r32;
#pragma unroll
    for (int vb = 0; vb < 2; ++vb)
#pragma unroll
        for (int g = 0; g < 4; ++g) {
            const int ch = h * 64 + 32 * vb + 8 * g + 4 * hi;
            const float4 gg = *(const float4*)(P.gn_g + ch), gb = *(const float4*)(P.gn_b + ch);
            const float4 bo = ld4bf(P.BON + tok * 256 + ch), gt = ld4bf(P.G + tok * 256 + ch);
            const float y0 = ((o[vb][4 * g] - mean) * rstd * gg.x + gb.x + bo.x) * gt.x;
            const float y1 = ((o[vb][4 * g + 1] - mean) * rstd * gg.y + gb.y + bo.y) * gt.y;
            const float y2 = ((o[vb][4 * g + 2] - mean) * rstd * gg.z + gb.z + bo.z) * gt.z;
            const float y3 = ((o[vb][4 * g + 3] - mean) * rstd * gg.w + gb.w + bo.w) * gt.w;
            *(uint2*)(P.MIX + tok * DM + 256 + ch) = make_uint2(cvtpk(y0, y1), cvtpk(y2, y3));
        }
}
namespace pg8 {
struct XaOrder {
    int G, c;
    __device__ __forceinline__ bool next(int i, Unit& u) const {
        const int L = i * G + c; if (L >= 256) return false;
        u.pm = L >> 2; u.pn = ((L >> 2) >> 5) * 4 + (L & 3); return true;
    }
    __device__ __forceinline__ void a_ready(const Unit&) const {}
    __device__ __forceinline__ void done(const Unit&) const {}
};
struct MoeOrder {
    const int* tile_e; const int* nrt; int G, c;
    __device__ __forceinline__ bool next(int i, Unit& u) const {
        const int L = i * G + c; if (L >= 4 * (*nrt)) return false;
        u.pm = L >> 2; u.pn = tile_e[L >> 2] * 4 + (L & 3); return true;
    }
    __device__ __forceinline__ void a_ready(const Unit&) const {}
    __device__ __forceinline__ void done(const Unit&) const {}
};
#define PG8_EBAR() do { asm volatile("s_waitcnt lgkmcnt(0)" ::: "memory"); __builtin_amdgcn_s_barrier(); asm volatile("" ::: "memory"); } while (0)
struct EpiSoftmaxP {
    static constexpr bool PERM = true, AFTER_DRAIN = true;
    bf16_t* P;
    __device__ __forceinline__ void fused(f32x4 (&acc)[2][2][4][2], const Unit& u, int wr, int wc, int fr, int fq, PG8_LAS unsigned char* lds, int wid, int lane) const {
        PG8_LAS float* RM = (PG8_LAS float*)lds;
        PG8_LAS float* RS = RM + 1024;
#pragma unroll
        for (int ai = 0; ai < 2; ++ai)
#pragma unroll
            for (int m = 0; m < 4; ++m) {
                float mx = -INFINITY;
#pragma unroll
                for (int bj = 0; bj < 2; ++bj)
#pragma unroll
                    for (int n = 0; n < 2; ++n) { const f32x4 x = acc[ai][bj][m][n]; mx = fmaxf(mx, fmaxf(fmaxf(x[0], x[1]), fmaxf(x[2], x[3]))); }
                mx = fmaxf(mx, __shfl_xor(mx, 16)); mx = fmaxf(mx, __shfl_xor(mx, 32));
                if (fq == 0) RM[(ai * HALF + wr * 64 + m * 16 + fr) * 4 + wc] = mx;
            }
        PG8_EBAR();
#pragma unroll
        for (int ai = 0; ai < 2; ++ai)
#pragma unroll
            for (int m = 0; m < 4; ++m) {
                const int row = ai * HALF + wr * 64 + m * 16 + fr;
                const float gm = fmaxf(fmaxf(RM[row * 4 + 0], RM[row * 4 + 1]), fmaxf(RM[row * 4 + 2], RM[row * 4 + 3]));
                float s = 0.f;
#pragma unroll
                for (int bj = 0; bj < 2; ++bj)
#pragma unroll
                    for (int n = 0; n < 2; ++n) { f32x4 x = acc[ai][bj][m][n];
                        x[0] = __builtin_amdgcn_exp2f(x[0] - gm); x[1] = __builtin_amdgcn_exp2f(x[1] - gm); x[2] = __builtin_amdgcn_exp2f(x[2] - gm); x[3] = __builtin_amdgcn_exp2f(x[3] - gm);
                        s += (x[0] + x[1]) + (x[2] + x[3]); acc[ai][bj][m][n] = x; }
                s += __shfl_xor(s, 16); s += __shfl_xor(s, 32);
                if (fq == 0) RS[row * 4 + wc] = s;
            }
        PG8_EBAR();
        const int colb = (u.pn & 3) * BM + wc * 32 + 8 * fq;
#pragma unroll
        for (int ai = 0; ai < 2; ++ai)
#pragma unroll
            for (int m = 0; m < 4; ++m) {
                const int row = ai * HALF + wr * 64 + m * 16 + fr;
                const float inv = 1.0f / ((RS[row * 4 + 0] + RS[row * 4 + 1]) + (RS[row * 4 + 2] + RS[row * 4 + 3]));
                bf16_t* rowp = P + (size_t)(u.pm * BM + row) * 1024 + colb;
#pragma unroll
                for (int bj = 0; bj < 2; ++bj) { const f32x4 v0 = acc[ai][bj][m][0] * inv, v1 = acc[ai][bj][m][1] * inv;
                    u32x4 w; w.x = cvt_pk_bf16(v0[0], v0[1]); w.y = cvt_pk_bf16(v0[2], v0[3]); w.z = cvt_pk_bf16(v1[0], v1[1]); w.w = cvt_pk_bf16(v1[2], v1[3]);
                    *(u32x4*)(rowp + bj * HALF) = w; }
            }
        PG8_EBAR();
    }
};
struct EpiF32N4 {
    static constexpr bool PERM = false, AFTER_DRAIN = false;
    float* C; int ldc;
    __device__ __forceinline__ void operator()(const f32x4 (&acc)[2][2][4][2], const Unit& u, int wr, int wc, int fr, int fq) const {
        const int row0 = u.pm * BM + wr * 64 + fr, col0 = (u.pn & 3) * BM + wc * 32 + 4 * fq;
#pragma unroll
        for (int ai = 0; ai < 2; ++ai)
#pragma unroll
            for (int m = 0; m < 4; ++m) { float* rowp = C + (size_t)(row0 + ai * HALF + m * 16) * ldc + col0;
#pragma unroll
                for (int bj = 0; bj < 2; ++bj)
#pragma unroll
                    for (int n = 0; n < 2; ++n) *(f32x4*)(rowp + bj * HALF + n * 16) = acc[ai][bj][m][n]; }
    }
};
struct EpiBf16N4 {
    static constexpr bool PERM = true, AFTER_DRAIN = false;
    bf16_t* O; int ldc;
    __device__ __forceinline__ void operator()(const f32x4 (&acc)[2][2][4][2], const Unit& u, int wr, int wc, int fr, int fq) const {
        const int row0 = u.pm * BM + wr * 64 + fr, col0 = (u.pn & 3) * BM + wc * 32 + 8 * fq;
#pragma unroll
        for (int ai = 0; ai < 2; ++ai)
#pragma unroll
            for (int m = 0; m < 4; ++m) { bf16_t* rowp = O + (size_t)(row0 + ai * HALF + m * 16) * ldc + col0;
#pragma unroll
                for (int bj = 0; bj < 2; ++bj) { const f32x4 v0 = acc[ai][bj][m][0], v1 = acc[ai][bj][m][1];
                    u32x4 w; w.x = cvt_pk_bf16(v0[0], v0[1]); w.y = cvt_pk_bf16(v0[2], v0[3]); w.z = cvt_pk_bf16(v1[0], v1[1]); w.w = cvt_pk_bf16(v1[2], v1[3]);
                    *(u32x4*)(rowp + bj * HALF) = w; } }
    }
};
struct EpiSiluMul {
    static constexpr bool PERM = true, AFTER_DRAIN = false;
    bf16_t* H;
    __device__ __forceinline__ void operator()(const f32x4 (&acc)[2][2][4][2], const Unit& u, int wr, int wc, int fr, int fq) const {
        const int row0 = u.pm * BM + wr * 64 + fr, col0 = (u.pn & 3) * HALF + wc * 32 + 8 * fq;
#pragma unroll
        for (int ai = 0; ai < 2; ++ai)
#pragma unroll
            for (int m = 0; m < 4; ++m) {
                float h[8];
#pragma unroll
                for (int n = 0; n < 2; ++n)
#pragma unroll
                    for (int e = 0; e < 4; ++e) { const float g = acc[ai][0][m][n][e], up = acc[ai][1][m][n][e];
                        h[4 * n + e] = g * __builtin_amdgcn_rcpf(1.0f + __expf(-g)) * up; }
                u32x4 w; w.x = cvt_pk_bf16(h[0], h[1]); w.y = cvt_pk_bf16(h[2], h[3]); w.z = cvt_pk_bf16(h[4], h[5]); w.w = cvt_pk_bf16(h[6], h[7]);
                *(u32x4*)(H + (size_t)(row0 + ai * HALF + m * 16) * 512 + col0) = w;
            }
    }
};

struct OneUnit {
    int pm, pn, valid;
    __device__ __forceinline__ bool next(int i, Unit& u) const { if (i != 0 || !valid) return false; u.pm = pm; u.pn = pn; return true; }
    __device__ __forceinline__ void a_ready(const Unit&) const {}
    __device__ __forceinline__ void done(const Unit&) const {}
};
struct EpiBf16S {
    static constexpr bool PERM = true, AFTER_DRAIN = false;
    bf16_t* O; int ldc; float scale;
    __device__ __forceinline__ void operator()(const f32x4 (&acc)[2][2][4][2], const Unit& u, int wr, int wc, int fr, int fq) const {
        const int row0 = u.pm * BM + wr * 64 + fr, col0 = u.pn * BM + wc * 32 + 8 * fq;
#pragma unroll
        for (int ai = 0; ai < 2; ++ai)
#pragma unroll
            for (int m = 0; m < 4; ++m) { bf16_t* rowp = O + (size_t)(row0 + ai * HALF + m * 16) * ldc + col0;
#pragma unroll
                for (int bj = 0; bj < 2; ++bj) { const f32x4 v0 = acc[ai][bj][m][0] * scale, v1 = acc[ai][bj][m][1] * scale;
                    u32x4 w; w.x = cvt_pk_bf16(v0[0], v0[1]); w.y = cvt_pk_bf16(v0[2], v0[3]); w.z = cvt_pk_bf16(v1[0], v1[1]); w.w = cvt_pk_bf16(v1[2], v1[3]);
                    *(u32x4*)(rowp + bj * HALF) = w; } }
    }
};
struct EpiGeluF32 {
    static constexpr bool PERM = false, AFTER_DRAIN = false;
    float* C; int ldc;
    __device__ __forceinline__ void operator()(const f32x4 (&acc)[2][2][4][2], const Unit& u, int wr, int wc, int fr, int fq) const {
        const int row0 = u.pm * BM + wr * 64 + fr, col0 = u.pn * BM + wc * 32 + 4 * fq;
#pragma unroll
        for (int ai = 0; ai < 2; ++ai)
#pragma unroll
            for (int m = 0; m < 4; ++m) { float* rowp = C + (size_t)(row0 + ai * HALF + m * 16) * ldc + col0;
#pragma unroll
                for (int bj = 0; bj < 2; ++bj)
#pragma unroll
                    for (int n = 0; n < 2; ++n) { f32x4 x = acc[ai][bj][m][n];
#pragma unroll
                        for (int e = 0; e < 4; ++e) x[e] = 0.5f * x[e] * (1.f + tanhf(0.7978845608028654f * (x[e] + 0.044715f * x[e] * x[e] * x[e])));
                        *(f32x4*)(rowp + bj * HALF + n * 16) = x; } }
    }
};
}

DEVI void tr_blk(const float* W, size_t ldw, int N, int k0, int n0, bf16* WT, size_t ldt, int drow0, float scale, LAS float* scr, int lane) {
    const int n_ = n0 + (lane & 31);
#pragma unroll 8
    for (int i = 0; i < 32; ++i) { const int kk = 2 * i + (lane >> 5); scr[kk * 33 + (lane & 31)] = n_ < N ? W[(size_t)(k0 + kk) * ldw + n_] * scale : 0.f; }
    LDS_WAIT(); asm volatile("" ::: "memory");
    const int c = lane & 7;
#pragma unroll
    for (int j = 0; j < 4; ++j) { const int n = (lane >> 3) + 8 * j; const LAS float* s = scr + (8 * c) * 33 + n;
        v4u o; o.x = pk2(s[0 * 33], s[1 * 33]); o.y = pk2(s[2 * 33], s[3 * 33]); o.z = pk2(s[4 * 33], s[5 * 33]); o.w = pk2(s[6 * 33], s[7 * 33]);
        *(GAS v4u*)(WT + (size_t)(drow0 + n) * ldt + k0 + 8 * c) = o; }
    LDS_WAIT(); asm volatile("" ::: "memory");
}
DEVI void cvt_bf16(const float* __restrict__ src, bf16* __restrict__ dst, size_t n, float scale, int B0, int G) {
    for (size_t i = ((size_t)B0 * 512 + tidx()) * 4; i < n; i += (size_t)G * 512 * 4) {
        const float4 v = *(const float4*)(src + i);
        *(uint2*)(dst + i) = make_uint2(pk2(v.x * scale, v.y * scale), pk2(v.z * scale, v.w * scale));
    }
}

DEVI void moe_lists2(const int* __restrict__ te, int* __restrict__ off, int* __restrict__ nrt, int* __restrict__ tile_e, int* __restrict__ list,
                     int* __restrict__ slotpos, float* sm0) {
    int* cnt = (int*)sm0;
    int* offs = cnt + 16;
    const int w = tidx() >> 6, lane = tidx() & 63;
    __syncthreads();
    for (int ee = 0; ee < 2; ++ee) {
        const int e = w * 2 + ee;
        int c = 0;
        for (int base = 0; base < NTOK; base += 64) {
            const int tok = base + lane;
            const bool m = (te[tok * 2] == e) || (te[tok * 2 + 1] == e);
            c += __popcll(__ballot(m));
        }
        if (lane == 0) cnt[e] = c;
    }
    __syncthreads();
    if (tidx() == 0) {
        int s = 0;
#pragma unroll 1
        for (int i = 0; i < 16; ++i) { offs[i] = s; off[i] = s; const int pc = (cnt[i] + 255) & ~255;
#pragma unroll 1
            for (int r = s / 256; r < (s + pc) / 256; ++r) tile_e[r] = i;
            s += pc; }
        offs[16] = s; off[16] = s; *nrt = s / 256;
    }
    __syncthreads();
    for (int ee = 0; ee < 2; ++ee) {
        const int e = w * 2 + ee;
        int pos = offs[e];
        for (int base = 0; base < NTOK; base += 64) {
            const int tok = base + lane;
            const int a = te[tok * 2], b = te[tok * 2 + 1];
            const bool m = (a == e) || (b == e);
            const unsigned long long mask = __ballot(m);
            if (m) {
                const int p = pos + __popcll(mask & ((1ull << lane) - 1ull));
                list[p] = tok;
                slotpos[tok * 2 + (a == e ? 0 : 1)] = p;
            }
            pos += __popcll(mask);
        }
        for (int p = pos + lane; p < offs[e + 1]; p += 64) list[p] = -1;
    }
    __syncthreads();
}
DEVI void moe_gather(const bf16* __restrict__ xn, const int* __restrict__ list, const int* __restrict__ off, bf16* __restrict__ xg, int B0, int G) {
    const int total = off[16];
    const int gw = B0 * NWAVES + (tidx() >> 6), lane = tidx() & 63;
    for (int p = gw; p < total; p += G * NWAVES) {
        const int tok = list[p];
        v4u a = (v4u){0u, 0u, 0u, 0u}, b = a;
        if (tok >= 0) { const v4u* s = (const v4u*)(xn + (size_t)tok * DM); a = s[lane]; b = s[lane + 64]; }
        v4u* d = (v4u*)(xg + (size_t)p * DM); d[lane] = a; d[lane + 64] = b;
    }
}
DEVI void moe_combine_ln2(const float* x, const bf16* __restrict__ Dp, const int* __restrict__ te,
                          const float* __restrict__ tw, const int* __restrict__ slotpos,
                          const float* __restrict__ g, const float* __restrict__ bt, float* out, bf16* outb, int bid, float* sm) {
    __syncthreads();
    const size_t t = bid; const int tid = tidx() & 255;
    int ea = te[t * 2], eb = te[t * 2 + 1];
    float wa = tw[t * 2], wb = tw[t * 2 + 1];
    size_t pa = slotpos[t * 2], pb = slotpos[t * 2 + 1];
    if (eb < ea) { const float tf = wa; wa = wb; wb = tf; const size_t tp = pa; pa = pb; pb = tp; }
    float v[4];
#pragma unroll
    for (int i = 0; i < 4; ++i) {
        const int c = tid + i * 256;
        float y = wa * bf2f(Dp[pa * DM + c]);
        y = y + wb * bf2f(Dp[pb * DM + c]);
        v[i] = ALPHA * x[t * DM + c] + y;
    }
    const float mean = block_sum256(v[0] + v[1] + v[2] + v[3], sm, tid) * (1.f / DM);
    float q = 0.f;
#pragma unroll
    for (int i = 0; i < 4; ++i) { v[i] -= mean; q += v[i] * v[i]; }
    const float var = block_sum256(q, sm, tid) * (1.f / DM);
    const float rstd = rsqrtf(var + 1e-5f);
#pragma unroll
    for (int i = 0; i < 4; ++i) {
        const int c = tid + i * 256;
        const float o = v[i] * rstd * g[c] + bt[c];
        out[t * DM + c] = o;
        outb[t * DM + c] = (bf16)f2bf(o);
    }
}
struct MixP {
    const bf16* COLS;
    const float *conv_w, *conv_b, *conv_gg, *conv_gb;
    const float *gl_g, *gl_b;
    const float *mu, *w0, *a0, *k_k, *k_a, *r_k, *v_mu, *v0;
    const bf16 *WUP_T, *AUP_T, *GUP_T, *VUP_T;
    const float *pe_k, *pe_v;
    bf16 *MIX, *UB, *VB;
    bf16 *AT, *BT, *KT, *RT, *V, *G, *BON, *VFIRST;
    float* LAM;
    bf16 *QN, *QR, *KSR, *KWR, *VST, *VWT;
    float* GATES;
    bf16 *BLK, *BLV;
    int layer, pad;
};
DEVI float4 ld4bf(const bf16* p) { const uint2 w = *(const uint2*)p; return make_float4(__builtin_bit_cast(float, w.x << 16), __builtin_bit_cast(float, w.x & 0xffff0000u), __builtin_bit_cast(float, w.y << 16), __builtin_bit_cast(float, w.y & 0xffff0000u)); }
DEVI void st4bf(bf16* p, float a, float b, float c, float d) { *(uint2*)p = make_uint2(cvtpk(a, b), cvtpk(c, d)); }
DEVI float fsig(float x) { return __builtin_amdgcn_rcpf(1.f + __expf(-x)); }
DEVI float ftanh(float x) { const float e = __expf(-2.f * fabsf(x)); const float t = (1.f - e) * __builtin_amdgcn_rcpf(1.f + e); return x < 0.f ? -t : t; }
DEVI float fgelu(float x) { return 0.5f * x * (1.f + ftanh(0.7978845608028654f * (x + 0.044715f * x * x * x))); }

DEVI void prep_unit(const MixP& P, int cg, LAS unsigned char* lds) {
    const int tid = tidx(), w = tid >> 6, lane = tid & 63;
    const int b = cg >> 7, pos0 = (cg & 127) * 64;
    const size_t tok0 = (size_t)cg * 64;
    const bf16* cols = P.COLS + tok0 * DINP;
    {
        LAS float* hb = (LAS float*)lds;
        __syncthreads();
        for (int e = tid; e < 94 * 64; e += 512) {
            const int row = e >> 6, c4 = (e & 63) * 4, tt = row - 30;
            float4 h = make_float4(0.f, 0.f, 0.f, 0.f);
            if (pos0 + tt >= 0) {
                const bf16* cr = cols + (long)tt * DINP;
                const float4 v = ld4bf(cr + OFF_CV + c4), g = ld4bf(cr + OFF_CG + c4);
                h = make_float4(v.x * fsig(g.x), v.y * fsig(g.y), v.z * fsig(g.z), v.w * fsig(g.w));
            }
            { typedef float f32x4v __attribute__((ext_vector_type(4))); *(LAS f32x4v*)(hb + row * 256 + c4) = (f32x4v){h.x, h.y, h.z, h.w}; }
        }
        __syncthreads();
        const int c = tid & 255, half = tid >> 8;
        float wj[31];
#pragma unroll
        for (int j = 0; j < 31; ++j) wj[j] = P.conv_w[j * 256 + c];
        const float bias = P.conv_b[c], gg = P.conv_gg[c], gb = P.conv_gb[c];
#pragma unroll 1
        for (int q = 0; q < 4; ++q) {
            float xs[38];
            const int tb = 32 * half + 8 * q;
#pragma unroll
            for (int i = 0; i < 38; ++i) xs[i] = hb[(tb + i) * 256 + c];
#pragma unroll
            for (int t = 0; t < 8; ++t) {
                float acc = bias;
#pragma unroll
                for (int j = 0; j < 31; ++j) acc = fmaf(wj[j], xs[t + j], acc);
                const float mean = wave_sum(acc) * (1.f / 64.f);
                const float d = acc - mean;
                const float var = wave_sum(d * d) * (1.f / 64.f);
                const float y = d * rsqrtf(var + 1e-5f) * gg + gb;
                P.MIX[(tok0 + tb + t) * DM + c] = (bf16)f2bf(y * fsig(y));
            }
        }
    }
    {
        const float4 lg = *(const float4*)(P.gl_g + lane * 4), lb = *(const float4*)(P.gl_b + lane * 4);
#pragma unroll 2
        for (int i = 0; i < 8; ++i) {
            const int t = w * 8 + i; const bf16* cr = cols + (size_t)t * DINP;
            const float4 u = ld4bf(cr + OFF_GU + lane * 4);
            st4bf(P.UB + (tok0 + t) * 256 + lane * 4, fgelu(u.x), fgelu(u.y), fgelu(u.z), fgelu(u.w));
            float4 v = ld4bf(cr + OFF_GV + lane * 4);
            v = make_float4(fgelu(v.x), fgelu(v.y), fgelu(v.z), fgelu(v.w));
            const float mean = wave_sum((v.x + v.y) + (v.z + v.w)) * (1.f / 256.f);
            v.x -= mean; v.y -= mean; v.z -= mean; v.w -= mean;
            const float var = wave_sum((v.x * v.x + v.y * v.y) + (v.z * v.z + v.w * v.w)) * (1.f / 256.f);
            const float rs = rsqrtf(var + 1e-5f);
            st4bf(P.VB + (tok0 + t) * 256 + lane * 4, v.x * rs * lg.x + lb.x, v.y * rs * lg.y + lb.y, v.z * rs * lg.z + lb.z, v.w * rs * lg.w + lb.w);
        }
    }
    {
        LAS float* cst = (LAS float*)lds;
        LAS unsigned short* vt = (LAS unsigned short*)(lds + 16384);
        __syncthreads();
        for (int e = tid; e < 2048; e += 512) {
            const int t = e >> 5, j = e & 31;
            const float inv = powf(10000.f, -(float)j / 32.f);
            float sn, cs; sincosf((float)(pos0 + t) * inv, &sn, &cs);
            cst[e * 2] = cs; cst[e * 2 + 1] = sn;
        }
        __syncthreads();
#pragma unroll 1
        for (int i = 0; i < 8; ++i) {
            const int t = w * 8 + i; const bf16* cr = cols + (size_t)t * DINP; const size_t tok = tok0 + t;
            {
                const int d4 = (lane & 15) * 4;
                const float4 x = ld4bf(cr + OFF_Q + lane * 4);
                const float4 pr = make_float4(__shfl_xor(x.x, 8, 64), __shfl_xor(x.y, 8, 64), __shfl_xor(x.z, 8, 64), __shfl_xor(x.w, 8, 64));
                const LAS float* cp = cst + (t * 32 + (d4 & 31)) * 2;
                const float sg = d4 < 32 ? -1.f : 1.f;
                st4bf(P.QN + tok * 256 + lane * 4, x.x * QSCL, x.y * QSCL, x.z * QSCL, x.w * QSCL);
                st4bf(P.QR + tok * 256 + lane * 4, (x.x * cp[0] + sg * pr.x * cp[1]) * QSCL, (x.y * cp[2] + sg * pr.y * cp[3]) * QSCL,
                      (x.z * cp[4] + sg * pr.z * cp[5]) * QSCL, (x.w * cp[6] + sg * pr.w * cp[7]) * QSCL);
            }
            {
                const int seg = lane >> 4, d4 = (lane & 15) * 4;
                const float4 x = ld4bf(cr + OFF_KS + seg * 64 + d4);
                const float4 pr = make_float4(__shfl_xor(x.x, 8, 64), __shfl_xor(x.y, 8, 64), __shfl_xor(x.z, 8, 64), __shfl_xor(x.w, 8, 64));
                if ((seg & 1) == 0) {
                    const LAS float* cp = cst + (t * 32 + (d4 & 31)) * 2;
                    const float sg = d4 < 32 ? -1.f : 1.f;
                    bf16* dst = (seg == 0 ? P.KSR : P.KWR) + tok * 64 + d4;
                    st4bf(dst, x.x * cp[0] + sg * pr.x * cp[1], x.y * cp[2] + sg * pr.y * cp[3], x.z * cp[4] + sg * pr.z * cp[5], x.w * cp[6] + sg * pr.w * cp[7]);
                } else {
                    LAS unsigned short* vp = vt + (seg >> 1) * 4096 + d4 * 64 + t;
                    vp[0] = (unsigned short)f2bf(x.x); vp[64] = (unsigned short)f2bf(x.y); vp[128] = (unsigned short)f2bf(x.z); vp[192] = (unsigned short)f2bf(x.w);
                }
            }
            if (lane < 12) P.GATES[tok * 12 + lane] = fsig(bf2f(cr[OFF_GT + lane]));
        }
        __syncthreads();
        for (int e = tid; e < 1024; e += 512) {
            const int which = e >> 9, d = (e >> 3) & 63, ch = e & 7;
            const v4u v = *(const LAS v4u*)((LAS unsigned char*)vt + which * 8192 + d * 128 + ch * 16);
            *(v4u*)((which ? P.VWT : P.VST) + ((size_t)b * 64 + d) * SEQ + pos0 + ch * 8) = v;
        }
        for (int e = tid; e < 4 * 512 * 2; e += 512) {
            const int isv = e >> 11, r = e & 2047, nl = r >> 9, i4 = (r & 511) * 4, l = i4 >> 6, d = i4 & 63;
            const int n = 4 * (cg & 127) + nl;
            bf16* dst = (isv ? P.BLV : P.BLK) + ((size_t)b * 512 + n) * 2048 + i4;
            if (n < NCMP) {
                const float4 x = ld4bf(cols + (size_t)(16 * nl + l) * DINP + (isv ? OFF_VC : OFF_KC) + d);
                const float4 pe = *(const float4*)((isv ? P.pe_v : P.pe_k) + i4);
                st4bf(dst, x.x + pe.x, x.y + pe.y, x.z + pe.z, x.w + pe.w);
            } else *(uint2*)dst = make_uint2(0u, 0u);
        }
    }
    {
        LAS unsigned char* TW = lds;
        LAS unsigned char* AD = lds + 8192;
        LAS unsigned char* SG = lds + 16384;
        LAS unsigned char* VD = lds + 32768;
        LAS float* CAR = (LAS float*)(lds + 36864);
        __syncthreads();
        for (int e = tid; e < 64 * 64; e += 512) {
            const int t = e >> 6, j4 = (e & 63) * 4;
            const bf16* cr = cols + (size_t)t * DINP + OFF_RW + 768 + j4;
            const float4 c4 = ld4bf(cr);
            float4 p4 = make_float4(0.f, 0.f, 0.f, 0.f);
            if (pos0 + t > 0) p4 = ld4bf(cr - DINP);
            const float4 m4 = *(const float4*)(P.mu + 768 + j4);
            float y0 = c4.x + m4.x * (p4.x - c4.x), y1 = c4.y + m4.y * (p4.y - c4.y), y2 = c4.z + m4.z * (p4.z - c4.z), y3 = c4.w + m4.w * (p4.w - c4.w);
            if (j4 < 64) { y0 = ftanh(y0); y1 = ftanh(y1); y2 = ftanh(y2); y3 = ftanh(y3);
                *(LAS u32x2v*)(TW + rw_off(t, j4 >> 3) + (j4 & 7) * 2) = (u32x2v){cvtpk(y0, y1), cvtpk(y2, y3)}; }
            else if (j4 < 128) { const int jj = j4 - 64;
                *(LAS u32x2v*)(AD + rw_off(t, jj >> 3) + (jj & 7) * 2) = (u32x2v){cvtpk(y0, y1), cvtpk(y2, y3)}; }
            else { const int jj = j4 - 128; y0 = fsig(y0); y1 = fsig(y1); y2 = fsig(y2); y3 = fsig(y3);
                *(LAS u32x2v*)(SG + t * 256 + (((jj >> 3) ^ (t & 7)) << 4) + (jj & 7) * 2) = (u32x2v){cvtpk(y0, y1), cvtpk(y2, y3)}; }
        }
        if (P.layer > 0) {
            const int t = tid >> 3, j4 = (tid & 7) * 4;
            const bf16* cr = cols + (size_t)t * DINP + DIN + j4;
            const float4 c4 = ld4bf(cr);
            float4 p4 = make_float4(0.f, 0.f, 0.f, 0.f);
            if (pos0 + t > 0) p4 = ld4bf(cr - DINP);
            const float4 m4 = *(const float4*)(P.v_mu + j4);
            *(LAS u32x2v*)(VD + t * 64 + j4 * 2) = (u32x2v){cvtpk(c4.x + m4.x * (p4.x - c4.x), c4.y + m4.y * (p4.y - c4.y)), cvtpk(c4.z + m4.z * (p4.z - c4.z), c4.w + m4.w * (p4.w - c4.w))};
        }
        __syncthreads();
        const int h = w >> 1, tb = w & 1, r32 = lane & 31, hi = lane >> 5;
        const int t = 32 * tb + r32;
        const size_t tok = tok0 + t;
        const bool hasprev = (pos0 + t) > 0;
        const bf16* crow_ = cols + (size_t)t * DINP + OFF_RW;
        float n2 = 0.f, bd = 0.f;
#pragma unroll 1
        for (int cb = 0; cb < 2; ++cb) {
            f32x16 al; rw_zero(al);
            const bf16* arow = P.AUP_T + (size_t)(h * 64 + 32 * cb + r32) * 64 + 8 * hi;
#pragma unroll
            for (int s = 0; s < 4; ++s) al = __builtin_amdgcn_mfma_f32_32x32x16_bf16(*(const bf16x8*)(arow + 16 * s), rw_frag(AD, tb, s, r32, hi), al, 0, 0, 0);
#pragma unroll
            for (int g = 0; g < 4; ++g) {
                const int ch = h * 64 + 32 * cb + 8 * g + 4 * hi;
                const float4 rc = ld4bf(crow_ + ch), kc = ld4bf(crow_ + 256 + ch);
                float4 rp = make_float4(0.f, 0.f, 0.f, 0.f), kp = rp;
                if (hasprev) { rp = ld4bf(crow_ - DINP + ch); kp = ld4bf(crow_ - DINP + 256 + ch); }
                const float4 mr = *(const float4*)(P.mu + ch), mk = *(const float4*)(P.mu + 256 + ch);
                const float4 a0 = *(const float4*)(P.a0 + ch), kk_ = *(const float4*)(P.k_k + ch), ka = *(const float4*)(P.k_a + ch), rk = *(const float4*)(P.r_k + ch);
                const float rr[4] = {rc.x + mr.x * (rp.x - rc.x), rc.y + mr.y * (rp.y - rc.y), rc.z + mr.z * (rp.z - rc.z), rc.w + mr.w * (rp.w - rc.w)};
                const float kv[4] = {kc.x + mk.x * (kp.x - kc.x), kc.y + mk.y * (kp.y - kc.y), kc.z + mk.z * (kp.z - kc.z), kc.w + mk.w * (kp.w - kc.w)};
                const float a0v[4] = {a0.x, a0.y, a0.z, a0.w}, kkv[4] = {kk_.x, kk_.y, kk_.z, kk_.w}, kav[4] = {ka.x, ka.y, ka.z, ka.w}, rkv[4] = {rk.x, rk.y, rk.z, rk.w};
#pragma unroll
                for (int e = 0; e < 4; ++e) {
                    const float a = fsig(a0v[e] + al[4 * g + e]);
                    const float kq = kv[e] * kkv[e];
                    n2 = fmaf(kq, kq, n2);
                    bd = fmaf(rr[e] * rkv[e], kv[e] * (1.f + (a - 1.f) * kav[e]), bd);
                }
            }
        }
        n2 += __shfl_xor(n2, 32, 64); bd += __shfl_xor(bd, 32, 64);
        const float rnorm = 1.f / fmaxf(sqrtf(n2), 1e-12f);
        const size_t u = (size_t)cg * 4 + h;
#pragma unroll 1
        for (int cb = 0; cb < 2; ++cb) {
            f32x16 al, wl, gl, vm; rw_zero(al); rw_zero(wl); rw_zero(gl); rw_zero(vm);
            const int chrow = h * 64 + 32 * cb + r32;
            const bf16* arow = P.AUP_T + (size_t)chrow * 64 + 8 * hi;
            const bf16* wrow = P.WUP_T + (size_t)chrow * 64 + 8 * hi;
            const bf16* grow = P.GUP_T + (size_t)chrow * 128 + 8 * hi;
#pragma unroll
            for (int s = 0; s < 4; ++s) {
                al = __builtin_amdgcn_mfma_f32_32x32x16_bf16(*(const bf16x8*)(arow + 16 * s), rw_frag(AD, tb, s, r32, hi), al, 0, 0, 0);
                wl = __builtin_amdgcn_mfma_f32_32x32x16_bf16(*(const bf16x8*)(wrow + 16 * s), rw_frag(TW, tb, s, r32, hi), wl, 0, 0, 0);
            }
#pragma unroll
            for (int s = 0; s < 8; ++s) {
                const bf16x8 bfr = *(const LAS bf16x8*)(SG + t * 256 + (((2 * s + hi) ^ (t & 7)) << 4));
                gl = __builtin_amdgcn_mfma_f32_32x32x16_bf16(*(const bf16x8*)(grow + 16 * s), bfr, gl, 0, 0, 0);
            }
            if (P.layer > 0) {
                const bf16* vrow = P.VUP_T + (size_t)chrow * 32 + 8 * hi;
#pragma unroll
                for (int s = 0; s < 2; ++s) {
                    const bf16x8 bfr = *(const LAS bf16x8*)(VD + t * 64 + (2 * s + hi) * 16);
                    vm = __builtin_amdgcn_mfma_f32_32x32x16_bf16(*(const bf16x8*)(vrow + 16 * s), bfr, vm, 0, 0, 0);
                }
            }
            f32x16 lw, cum;
#pragma unroll
            for (int g = 0; g < 4; ++g) {
                const float4 w0 = *(const float4*)(P.w0 + h * 64 + 32 * cb + 8 * g + 4 * hi);
                const float w0v[4] = {w0.x, w0.y, w0.z, w0.w};
#pragma unroll
                for (int e = 0; e < 4; ++e) {
                    const float x = -(w0v[e] + wl[4 * g + e]);
                    const float sp = fmaxf(x, 0.f) + __logf(1.f + __expf(-fabsf(x)));
                    lw[4 * g + e] = -__expf(-sp - 0.5f);
                }
            }
#pragma unroll
            for (int r = 0; r < 16; ++r) {
                float s = lw[r];
#pragma unroll
                for (int dl = 1; dl < 32; dl <<= 1) { const float o = __shfl_up(s, dl, 32); if (r32 >= dl) s += o; }
                cum[r] = s;
            }
            if (tb == 0 && r32 == 31) {
#pragma unroll
                for (int r = 0; r < 16; ++r) CAR[h * 64 + 32 * cb + crow(r, hi)] = cum[r];
            }
            __syncthreads();
            if (tb == 1) {
#pragma unroll
                for (int r = 0; r < 16; ++r) cum[r] += CAR[h * 64 + 32 * cb + crow(r, hi)];
            }
#pragma unroll
            for (int g = 0; g < 4; ++g) {
                const int cl = 32 * cb + 8 * g + 4 * hi, ch = h * 64 + cl;
                const float4 rc = ld4bf(crow_ + ch), kc = ld4bf(crow_ + 256 + ch), vc = ld4bf(crow_ + 512 + ch);
                float4 rp = make_float4(0.f, 0.f, 0.f, 0.f), kp = rp, vp = rp;
                if (hasprev) { rp = ld4bf(crow_ - DINP + ch); kp = ld4bf(crow_ - DINP + 256 + ch); vp = ld4bf(crow_ - DINP + 512 + ch); }
                const float4 mr = *(const float4*)(P.mu + ch), mk = *(const float4*)(P.mu + 256 + ch), mv = *(const float4*)(P.mu + 512 + ch);
                const float4 a0 = *(const float4*)(P.a0 + ch), kk_ = *(const float4*)(P.k_k + ch), ka = *(const float4*)(P.k_a + ch);
                const float rr[4] = {rc.x + mr.x * (rp.x - rc.x), rc.y + mr.y * (rp.y - rc.y), rc.z + mr.z * (rp.z - rc.z), rc.w + mr.w * (rp.w - rc.w)};
                const float kv[4] = {kc.x + mk.x * (kp.x - kc.x), kc.y + mk.y * (kp.y - kc.y), kc.z + mk.z * (kp.z - kc.z), kc.w + mk.w * (kp.w - kc.w)};
                float vv[4] = {vc.x + mv.x * (vp.x - vc.x), vc.y + mv.y * (vp.y - vc.y), vc.z + mv.z * (vp.z - vc.z), vc.w + mv.w * (vp.w - vc.w)};
                const float a0v[4] = {a0.x, a0.y, a0.z, a0.w}, kkv[4] = {kk_.x, kk_.y, kk_.z, kk_.w}, kav[4] = {ka.x, ka.y, ka.z, ka.w};
                if (P.layer == 0) {
                    st4bf(P.VFIRST + tok * 256 + ch, vv[0], vv[1], vv[2], vv[3]);
                } else {
                    const float4 vf = ld4bf(P.VFIRST + tok * 256 + ch), v0 = *(const float4*)(P.v0 + ch);
                    const float vfv[4] = {vf.x, vf.y, vf.z, vf.w}, v0v[4] = {v0.x, v0.y, v0.z, v0.w};
#pragma unroll
                    for (int e = 0; e < 4; ++e) vv[e] = vv[e] + (vfv[e] - vv[e]) * fsig(v0v[e] + vm[4 * g + e]);
                }
                float at[4], bt[4], kt[4], rt[4], bo[4];
#pragma unroll
                for (int e = 0; e < 4; ++e) {
                    const float a = fsig(a0v[e] + al[4 * g + e]);
                    const float kkn = kv[e] * kkv[e] * rnorm;
                    const float k2 = kv[e] * (1.f + (a - 1.f) * kav[e]);
                    const float cu = cum[4 * g + e];
                    const float ein = __expf(cu), eout = __expf(-cu), eex = __expf(cu - lw[4 * g + e]);
                    at[e] = -kkn * eex; bt[e] = kkn * a * eout; kt[e] = k2 * eout; rt[e] = rr[e] * ein; bo[e] = bd * vv[e];
                    if (t == 63) P.LAM[u * 64 + cl + e] = ein;
                }
                const size_t bo_ = (u * 64 + t) * 64 + cl;
                st4bf(P.AT + bo_, at[0], at[1], at[2], at[3]); st4bf(P.BT + bo_, bt[0], bt[1], bt[2], bt[3]);
                st4bf(P.KT + bo_, kt[0], kt[1], kt[2], kt[3]); st4bf(P.RT + bo_, rt[0], rt[1], rt[2], rt[3]);
                st4bf(P.V + tok * 256 + ch, vv[0], vv[1], vv[2], vv[3]);
                st4bf(P.G + tok * 256 + ch, gl[4 * g], gl[4 * g + 1], gl[4 * g + 2], gl[4 * g + 3]);
                st4bf(P.BON + tok * 256 + ch, bo[0], bo[1], bo[2], bo[3]);
            }
        }
    }
}

DEVI void gmlp_unit(const bf16* __restrict__ UB, const bf16* __restrict__ VB, const bf16* __restrict__ GWS  , const float* __restrict__ bs,
                    bf16* __restrict__ MIX, int c128, LAS unsigned char* lds) {
    const int tid = tidx(), w = tid >> 6, lane = tid & 63, r32 = lane & 31, hi = lane >> 5;
    const size_t T0 = (size_t)c128 * 128;
    __syncthreads();
    for (int e = tid; e < 128 * 32; e += 512) {
        const int s = e >> 5, c8 = (e & 31) * 8;
        const v4u v = *(const v4u*)(VB + (T0 + s) * 256 + c8);
        const unsigned wv[4] = {v.x, v.y, v.z, v.w};
#pragma unroll
        for (int j = 0; j < 8; ++j) { const int ch = c8 + j;
            *(LAS unsigned short*)(lds + ch * 256 + (((s >> 3) ^ (ch & 7)) << 4) + (s & 7) * 2) = (unsigned short)(wv[j >> 1] >> ((j & 1) * 16)); }
    }
    __syncthreads();
    const int h = w & 3, th = w >> 2;
    f32x16 acc[2][2];
#pragma unroll
    for (int i = 0; i < 2; ++i)
#pragma unroll
        for (int j = 0; j < 2; ++j) rw_zero(acc[i][j]);
    const int nks = 4 * (th + 1);
#pragma unroll 1
    for (int s = 0; s < nks; ++s) {
        bf16x8 bfr[2];
#pragma unroll
        for (int cb = 0; cb < 2; ++cb) { const int ch = h * 64 + 32 * cb + r32; bfr[cb] = *(const LAS bf16x8*)(lds + ch * 256 + (((2 * s + hi) ^ (ch & 7)) << 4)); }
#pragma unroll
        for (int rb = 0; rb < 2; ++rb) {
            const bf16x8 afr = *(const bf16x8*)(GWS + ((size_t)h * 128 + 64 * th + 32 * rb + r32) * 128 + 16 * s + 8 * hi);
#pragma unroll
            for (int cb = 0; cb < 2; ++cb) acc[rb][cb] = __builtin_amdgcn_mfma_f32_32x32x16_bf16(afr, bfr[cb], acc[rb][cb], 0, 0, 0);
        }
    }
#pragma unroll
    for (int rb = 0; rb < 2; ++rb)
#pragma unroll
        for (int cb = 0; cb < 2; ++cb)
#pragma unroll
            for (int r = 0; r < 16; ++r) {
                const int tt = 64 * th + 32 * rb + crow(r, hi), ch = h * 64 + 32 * cb + r32;
                const float uu = bf2f(UB[(T0 + tt) * 256 + ch]);
                MIX[(T0 + tt) * DM + 512 + ch] = (bf16)f2bf(uu * (acc[rb][cb][r] + bs[h * 128 + tt]));
            }
}
DEVI float wsum_all(float v) {
#pragma unroll
    for (int o = 1; o < 64; o <<= 1) v += __shfl_xor(v, o, 64);
    return v;
}
DEVI void ln_finish(float (&v)[16], const float* __restrict__ g, const float* __restrict__ bt, float* orow, bf16* obrow, int lane) {
    float s = 0.f;
#pragma unroll
    for (int i = 0; i < 16; ++i) s += v[i];
    const float mean = wsum_all(s) * (1.f / DM);
    float q = 0.f;
#pragma unroll
    for (int i = 0; i < 16; ++i) { v[i] -= mean; q += v[i] * v[i]; }
    const float rstd = rsqrtf(wsum_all(q) * (1.f / DM) + 1e-5f);
#pragma unroll
    for (int j = 0; j < 4; ++j) {
        const int c = lane * 4 + 256 * j;
        const float4 gg = *(const float4*)(g + c), bb = *(const float4*)(bt + c);
        v[4 * j] = v[4 * j] * rstd * gg.x + bb.x; v[4 * j + 1] = v[4 * j + 1] * rstd * gg.y + bb.y;
        v[4 * j + 2] = v[4 * j + 2] * rstd * gg.z + bb.z; v[4 * j + 3] = v[4 * j + 3] * rstd * gg.w + bb.w;
        *(float4*)(orow + c) = make_float4(v[4 * j], v[4 * j + 1], v[4 * j + 2], v[4 * j + 3]);
        *(uint2*)(obrow + c) = make_uint2(cvtpk(v[4 * j], v[4 * j + 1]), cvtpk(v[4 * j + 2], v[4 * j + 3]));
    }
}
DEVI void ln_rows(const float* xres, float alpha, const float* add, const float* __restrict__ g, const float* __restrict__ bt, float* out, bf16* outb, int B0, int G) {
    const int gw = B0 * NWAVES + (tidx() >> 6); int lane = tidx() & 63;
    for (int row = gw; row < NTOK; row += G * NWAVES) {
        asm volatile("" : "+v"(lane));
        float v[16];
#pragma unroll
        for (int j = 0; j < 4; ++j) {
            const size_t idx = (size_t)row * DM + lane * 4 + 256 * j;
            const float4 x = *(const float4*)(xres + idx);
            float4 a = make_float4(0.f, 0.f, 0.f, 0.f);
            if (add) a = *(const float4*)(add + idx);
            v[4 * j] = alpha * x.x + a.x; v[4 * j + 1] = alpha * x.y + a.y; v[4 * j + 2] = alpha * x.z + a.z; v[4 * j + 3] = alpha * x.w + a.w;
        }
        ln_finish(v, g, bt, out + (size_t)row * DM, outb + (size_t)row * DM, lane);
    }
}
DEVI void ln_router_rows(const float* xres, const float* add, const float* __restrict__ g, const float* __restrict__ bt, float* out, bf16* outb,
                         const float* __restrict__ rw, const float* __restrict__ rb, int* __restrict__ te, float* __restrict__ tw, int* __restrict__ trel,
                         int* __restrict__ cnt, int B0, int G) {
    const int gw = B0 * NWAVES + (tidx() >> 6); int lane = tidx() & 63;
    int mycnt = 0;
    int my_row = -1, my_e0 = 0, my_e1 = 0, my_r0 = 0, my_r1 = 0; int kk_ = 0;
    for (int row = gw; row < NTOK; row += G * NWAVES, ++kk_) {
        asm volatile("" : "+v"(lane));
        float v[16];
#pragma unroll
        for (int j = 0; j < 4; ++j) {
            const size_t idx = (size_t)row * DM + lane * 4 + 256 * j;
            const float4 x = *(const float4*)(xres + idx), a = *(const float4*)(add + idx);
            v[4 * j] = ALPHA * x.x + a.x; v[4 * j + 1] = ALPHA * x.y + a.y; v[4 * j + 2] = ALPHA * x.z + a.z; v[4 * j + 3] = ALPHA * x.w + a.w;
        }
        ln_finish(v, g, bt, out + (size_t)row * DM, outb + (size_t)row * DM, lane);
        float lg[16];
#pragma unroll
        for (int e = 0; e < 16; ++e) lg[e] = 0.f;
#pragma unroll
        for (int j = 0; j < 4; ++j)
#pragma unroll
            for (int k = 0; k < 4; ++k) {
                const float xv = v[4 * j + k];
                const float4* wr = (const float4*)(rw + (size_t)(lane * 4 + 256 * j + k) * 16);
                const float4 w0 = wr[0], w1 = wr[1], w2 = wr[2], w3 = wr[3];
                lg[0] = fmaf(xv, w0.x, lg[0]); lg[1] = fmaf(xv, w0.y, lg[1]); lg[2] = fmaf(xv, w0.z, lg[2]); lg[3] = fmaf(xv, w0.w, lg[3]);
                lg[4] = fmaf(xv, w1.x, lg[4]); lg[5] = fmaf(xv, w1.y, lg[5]); lg[6] = fmaf(xv, w1.z, lg[6]); lg[7] = fmaf(xv, w1.w, lg[7]);
                lg[8] = fmaf(xv, w2.x, lg[8]); lg[9] = fmaf(xv, w2.y, lg[9]); lg[10] = fmaf(xv, w2.z, lg[10]); lg[11] = fmaf(xv, w2.w, lg[11]);
                lg[12] = fmaf(xv, w3.x, lg[12]); lg[13] = fmaf(xv, w3.y, lg[13]); lg[14] = fmaf(xv, w3.z, lg[14]); lg[15] = fmaf(xv, w3.w, lg[15]);
            }
#pragma unroll
        for (int e = 0; e < 16; ++e) lg[e] = wsum_all(lg[e]);
        float m = lg[0];
#pragma unroll
        for (int e = 1; e < 16; ++e) m = fmaxf(m, lg[e]);
        float pr[16], sum = 0.f;
#pragma unroll
        for (int e = 0; e < 16; ++e) { pr[e] = expf(lg[e] - m); sum += pr[e]; }
        float sl[16];
#pragma unroll
        for (int e = 0; e < 16; ++e) { pr[e] /= sum; sl[e] = pr[e] + rb[e]; }
        int bg = 0; float bgs = -INFINITY;
#pragma unroll
        for (int gI = 0; gI < 4; ++gI) {
            float m1 = -INFINITY, m2 = -INFINITY;
#pragma unroll
            for (int j = 0; j < 4; ++j) { const float x = sl[gI * 4 + j]; if (x > m1) { m2 = m1; m1 = x; } else if (x > m2) m2 = x; }
            const float sc = m1 + m2;
            if (sc > bgs) { bgs = sc; bg = gI; }
        }
        int e0 = -1, e1 = -1; float s0 = -INFINITY, s1 = -INFINITY, p0 = 0.f, p1 = 0.f;
#pragma unroll
        for (int e = 0; e < 16; ++e) {
            if ((e >> 2) == bg) {
                const float x = sl[e];
                if (x > s0) { s1 = s0; e1 = e0; p1 = p0; s0 = x; e0 = e; p0 = pr[e]; } else if (x > s1) { s1 = x; e1 = e; p1 = pr[e]; }
            }
        }
        if (lane == 0) {
            const float ws = p0 + p1;
            te[row * 2] = e0; te[row * 2 + 1] = e1; tw[row * 2] = p0 / ws; tw[row * 2 + 1] = p1 / ws;
        }
        const int r0 = __shfl(mycnt, e0, 64), r1 = __shfl(mycnt, e1, 64);
        if (lane == e0 || lane == e1) ++mycnt;
        if (lane == kk_) { my_row = row; my_e0 = e0; my_e1 = e1; my_r0 = r0; my_r1 = r1; }
    }
    int base = 0;
    if (lane < 16 && mycnt > 0) base = atomicAdd(&cnt[lane], mycnt);
    const int b0 = __shfl(base, my_e0, 64), b1 = __shfl(base, my_e1, 64);
    if (my_row >= 0) { trel[my_row * 2] = b0 + my_r0; trel[my_row * 2 + 1] = b1 + my_r1; }
}
DEVI void moe_gather2(const bf16* __restrict__ xn, const int* __restrict__ te, const int* __restrict__ trel, const int* __restrict__ cnt, int* __restrict__ slot,
                      int* __restrict__ nrt, int* __restrict__ tile_e, bf16* __restrict__ xg, int B0, int G, LAS int* ofs) {
    __syncthreads();
    if (tidx() == 0) {
        int s = 0;
#pragma unroll 1
        for (int e = 0; e < 16; ++e) { const int c = cnt[e]; ofs[e] = s; ofs[17 + e] = c; s += (c + 255) & ~255; }
        ofs[16] = s;
    }
    __syncthreads();
    const int gw = B0 * NWAVES + (tidx() >> 6), lane = tidx() & 63;
    if (B0 == 0 && tidx() < 16) {
        const int e = tidx();
        for (int r = ofs[e] >> 8; r < (ofs[e + 1] >> 8); ++r) tile_e[r] = e;
        if (e == 0) *nrt = ofs[16] >> 8;
    }
    if (B0 < 16) {
        const int o1 = ofs[B0 + 1];
        for (int r = ofs[B0] + ofs[17 + B0] + (tidx() >> 6); r < o1; r += NWAVES) { v4u* d = (v4u*)(xg + (size_t)r * DM); d[lane] = (v4u){0u, 0u, 0u, 0u}; d[lane + 64] = (v4u){0u, 0u, 0u, 0u}; }
    }
    for (int tok = gw; tok < NTOK; tok += G * NWAVES) {
        const v4u* s = (const v4u*)(xn + (size_t)tok * DM);
        const v4u a = s[lane], b = s[lane + 64];
#pragma unroll
        for (int q = 0; q < 2; ++q) {
            const int pr = ofs[te[tok * 2 + q]] + trel[tok * 2 + q];
            v4u* d = (v4u*)(xg + (size_t)pr * DM); d[lane] = a; d[lane + 64] = b;
            if (lane == 0) slot[tok * 2 + q] = pr;
        }
    }
}
DEVI void moe_combine_rows(const float* x, const bf16* __restrict__ Dp, const int* __restrict__ te, const float* __restrict__ tw, const int* __restrict__ slot,
                           const float* __restrict__ g, const float* __restrict__ bt, float* out, bf16* outb, int B0, int G) {
    const int gw = B0 * NWAVES + (tidx() >> 6); int lane = tidx() & 63;
    for (int row = gw; row < NTOK; row += G * NWAVES) {
        asm volatile("" : "+v"(lane));
        int ea = te[row * 2], eb = te[row * 2 + 1];
        float wa = tw[row * 2], wb = tw[row * 2 + 1];
        size_t pa = slot[row * 2], pb = slot[row * 2 + 1];
        if (eb < ea) { const float tf = wa; wa = wb; wb = tf; const size_t tp = pa; pa = pb; pb = tp; }
        float v[16];
#pragma unroll
        for (int j = 0; j < 4; ++j) {
            const int c = lane * 4 + 256 * j;
            const float4 xx = *(const float4*)(x + (size_t)row * DM + c);
            const float4 da = ld4bf(Dp + pa * DM + c), db = ld4bf(Dp + pb * DM + c);
            v[4 * j] = ALPHA * xx.x + (wa * da.x + wb * db.x); v[4 * j + 1] = ALPHA * xx.y + (wa * da.y + wb * db.y);
            v[4 * j + 2] = ALPHA * xx.z + (wa * da.z + wb * db.z); v[4 * j + 3] = ALPHA * xx.w + (wa * da.w + wb * db.w);
        }
        ln_finish(v, g, bt, out + (size_t)row * DM, outb + (size_t)row * DM, lane);
    }
}
struct MP {
    const float* in[50];
    float *X, *TW, *R0;
    bf16 *XN, *MIX, *WIN_T, *WOUT_T, *WQK_T, *VWO_T, *W1_T, *LORA_T, *GWS, *VFIRST;
    int *TE, *SLOT, *LIST, *EOFF;
    unsigned* BAR;
};

DEVI void tr_item(const float* W, int K, int N, int Npad, bf16* WT, LAS float* scr, int item, int lane) {
    const int nblk = Npad / 32, kb = item / nblk, nb = item % nblk, k0 = 64 * kb, n0 = 32 * nb;
    const int n_ = n0 + (lane & 31);
#pragma unroll 8
    for (int i = 0; i < 32; ++i) { const int kk = 2 * i + (lane >> 5); scr[kk * 33 + (lane & 31)] = n_ < N ? W[(size_t)(k0 + kk) * N + n_] : 0.f; }
    LDS_WAIT(); asm volatile("" ::: "memory");
    const int c = lane & 7;
#pragma unroll
    for (int j = 0; j < 4; ++j) { const int n = (lane >> 3) + 8 * j; const LAS float* s = scr + (8 * c) * 33 + n;
        v4u o; o.x = pk2(s[0 * 33], s[1 * 33]); o.y = pk2(s[2 * 33], s[3 * 33]); o.z = pk2(s[4 * 33], s[5 * 33]); o.w = pk2(s[6 * 33], s[7 * 33]);
        *(GAS v4u*)(WT + (size_t)(n0 + n) * K + k0 + 8 * c) = o; }
    LDS_WAIT(); asm volatile("" ::: "memory");
}

DEVI void gemm_all(const GemmArgs& g, int maxM, int Z, int B0, int G, unsigned char* lds) {
    const int total = gemm_tiles(g, maxM, Z);
    for (int t0 = B0 * 2; t0 < total; t0 += G * 2) {
        const int vb = tidx() >> 8; float* sm = (float*)(lds + vb * 32768);
        const bool l0 = gemm_tile_live(g, maxM, t0), l1 = (t0 + 1 < total) && gemm_tile_live(g, maxM, t0 + 1);
        if (!l0 && !l1) continue;
        const int t = (vb && t0 + 1 < total) ? t0 + 1 : t0;
        gemm_tile(g, maxM, t, vb ? l1 : l0, sm);
    }
}

typedef const __attribute__((address_space(4))) MP* kargp_t;
DEVI kargp_t kargs() { kargp_t q = (kargp_t)__builtin_amdgcn_kernarg_segment_ptr(); asm volatile("" : "+s"(q)); return q; }
__global__ void __launch_bounds__(512, 2) mega(MP p_arg) {
#define p (*kargs())
    extern __shared__ __attribute__((aligned(16))) unsigned char lds[];
    cg::grid_group grid = cg::this_grid();
    const int G = gridDim.x, B0 = blockIdx.x;
    {
        LAS unsigned* ctl = (LAS unsigned*)((LAS unsigned char*)lds + LDSCTL_OFF);
        for (int u = threadIdx.x; u < (LDS_BYTES - LDSCTL_OFF) / 4; u += NWAVES * 64) ctl[u] = 0u;
        __syncthreads();
        if ((threadIdx.x & 63) == 0) ctl[__builtin_amdgcn_s_getreg((5 << 11) | 4) & 63u] = threadIdx.x >> 6;
    }
    __syncthreads();
    volatile LAS unsigned* MISC = (volatile LAS unsigned*)((LAS unsigned char*)lds + MISC_OFF);
    XcdBarrier bar = xcd_barrier_post(p.BAR, MISC + 8);
    grid.sync();
#define GSYNC() do { REP(24) xcd_barrier(bar); } while (0)
    float* sm0 = (float*)lds;
    LAS unsigned char* ring = (LAS unsigned char*)lds + RING_OFF;
#define VLOOP(n, body) for (int t0_ = B0 * 2; t0_ < (n); t0_ += G * 2) { const int vb = tidx() >> 8; float* sm = (float*)(lds + vb * 32768); const int t = min(t0_ + vb, (n) - 1); body; }

#define x_in (p.in[0])
#define mem (p.in[1])
#define RB ((unsigned char*)p.R0)
#define SZ_TB ((size_t)NTOK * 256 * 2)
#define rAT ((bf16*)RB)
#define rBT ((bf16*)(RB + 1 * SZ_TB))
#define rKT ((bf16*)(RB + 2 * SZ_TB))
#define rRT ((bf16*)(RB + 3 * SZ_TB))
#define rV ((bf16*)(RB + 4 * SZ_TB))
#define rG ((bf16*)(RB + 5 * SZ_TB))
#define rBON ((bf16*)(RB + 6 * SZ_TB))
#define QNb ((bf16*)(RB + 7 * SZ_TB))
#define QRb ((bf16*)(RB + 8 * SZ_TB))
#define UBb ((bf16*)(RB + 9 * SZ_TB))
#define VBb ((bf16*)(RB + 10 * SZ_TB))
#define KSRb ((bf16*)(RB + 11 * SZ_TB))
#define KWRb (KSRb + (size_t)NTOK * 64)
#define VSTb (KWRb + (size_t)NTOK * 64)
#define VWTb (VSTb + (size_t)NTOK * 64)
#define BLKb (VWTb + (size_t)NTOK * 64)
#define BLVb (BLKb + (size_t)1024 * 2048)
#define rLAM ((float*)(BLVb + (size_t)1024 * 2048))
#define GATESb (rLAM + 1024 * 64)
#define COLSB ((bf16*)(RB + 110100480))
#define rPF ((v4u*)COLSB)
#define rHF (rPF + (size_t)1024 * 512)
#define rSF (rHF + (size_t)1024 * 512)
#define rQT ((float*)(rSF + (size_t)1024 * 512))
#define rOL (rQT + (size_t)1024 * 4096)
#define HIDK (rOL + (size_t)1024 * 4096)
#define HIDV (HIDK + (size_t)1024 * 256)
#define KCMPb ((bf16*)(HIDV + (size_t)1024 * 256))
#define VCMPTb (KCMPb + (size_t)NB * 512 * 64)
#define YBUF (p.R0)
#define PB ((bf16*)(p.R0 + (size_t)17 * 1000 * 1000))
#define XG ((bf16*)p.R0)
#define HB ((bf16*)(p.R0 + (size_t)19 * 1000 * 1000))
#define WGU_T ((bf16*)(p.R0 + (size_t)34 * 1000 * 1000))
#define WD_T ((bf16*)(p.R0 + (size_t)43 * 1000 * 1000))

    bf16* WQB = (bf16*)p.R0;
    bf16* WKT = WQB + (size_t)2 * DM * DM;
    bf16* WVT = WKT + (size_t)2 * DM * DM;
    bf16* WOT = WVT + (size_t)2 * DM * DM;
    bf16* MEMB = WOT + (size_t)2 * DM * DM;
    bf16* KMEMB = MEMB + (size_t)NB * MEML * DM;
    bf16* VMEMB = KMEMB + (size_t)2 * NB * MEML * DM;
    {
        LAS float* scr = (LAS float*)(ring + (tidx() >> 6) * 16384);
        const int gw = B0 * NWAVES + (tidx() >> 6), NGW = G * NWAVES, lane = tidx() & 63;
        constexpr int I_IN = (DM / 64) * (DINP / 32), I_SQ = (DM / 64) * (DM / 32), I_W1 = (2048 / 64) * (256 / 32);
        for (int it = gw; it < 2 * I_IN + 8 * I_SQ + 4 * I_W1; it += NGW) {
            int r = it;
            if (r < 2 * I_IN) {
                const int l = r / I_IN, item = r % I_IN; const int nblk = DINP / 32, kb = item / nblk, nb = item % nblk, k0 = 64 * kb, n0 = 32 * nb;
                const float* W = p.in[4] + (size_t)l * DM * DIN; const float* VD = p.in[21];
                const int n_ = n0 + (lane & 31);
#pragma unroll 8
                for (int i = 0; i < 32; ++i) { const int kk = 2 * i + (lane >> 5);
                    float v = 0.f;
                    if (n_ < DIN) v = W[(size_t)(k0 + kk) * DIN + n_]; else if (l == 1 && n_ < DIN + 32) v = VD[(size_t)(k0 + kk) * 32 + (n_ - DIN)];
                    scr[kk * 33 + (lane & 31)] = v; }
                LDS_WAIT(); asm volatile("" ::: "memory");
                const int c = lane & 7; bf16* WT = p.WIN_T + (size_t)l * DINP * DM;
#pragma unroll
                for (int j = 0; j < 4; ++j) { const int n = (lane >> 3) + 8 * j; const LAS float* s = scr + (8 * c) * 33 + n;
                    v4u o; o.x = pk2(s[0 * 33], s[1 * 33]); o.y = pk2(s[2 * 33], s[3 * 33]); o.z = pk2(s[4 * 33], s[5 * 33]); o.w = pk2(s[6 * 33], s[7 * 33]);
                    *(GAS v4u*)(WT + (size_t)(n0 + n) * DM + k0 + 8 * c) = o; }
                LDS_WAIT(); asm volatile("" ::: "memory");
                continue;
            }
            r -= 2 * I_IN;
            if (r < 8 * I_SQ) {
                const int which = r / (2 * I_SQ), l = (r / I_SQ) & 1, item = r % I_SQ, kb = item / 32, nb = item % 32;
                const float* W = (which == 0 ? p.in[5] : which == 1 ? p.in[38] : which == 2 ? p.in[39] : p.in[40]) + (size_t)l * DM * DM;
                bf16* WT = (which == 0 ? p.WOUT_T : which == 1 ? WKT : which == 2 ? WVT : WOT) + (size_t)l * DM * DM;
                tr_blk(W, DM, DM, kb * 64, nb * 32, WT, DM, nb * 32, 1.f, scr, lane);
                continue;
            }
            r -= 8 * I_SQ;
            {
                const int which = r / I_W1, item = r % I_W1, kb = item / 8, nb = item % 8, l = which >> 1;
                const float* W = ((which & 1) ? p.in[33] : p.in[30]) + (size_t)l * 2048 * 256;
                tr_blk(W, 256, 256, kb * 64, nb * 32, p.W1_T + (size_t)which * 256 * 2048, 2048, nb * 32, 1.f, scr, lane);
            }
        }
        for (int it = gw; it < 64; it += NGW) {
            if (it < 32) { const int which = it >> 3, nb = it & 7, l = which & 1;
                tr_blk(((which >> 1) ? p.in[14] : p.in[12]) + (size_t)l * 64 * 256, 256, 256, 0, nb * 32, p.LORA_T + (size_t)which * 256 * 64, 64, nb * 32, 1.f, scr, lane); }
            else { const int r2 = it - 32, l = r2 >> 4, kb = (r2 >> 3) & 1, nb = r2 & 7;
                tr_blk(p.in[15] + (size_t)l * 128 * 256, 256, 256, kb * 64, nb * 32, p.LORA_T + (size_t)4 * 256 * 64 + (size_t)l * 256 * 128, 128, nb * 32, 1.f, scr, lane); }
        }
        for (int e = B0 * 512 + tidx(); e < 256 * 32; e += G * 512) { const int n = e >> 5, k = e & 31;
            p.LORA_T[(size_t)4 * 256 * 64 + (size_t)2 * 256 * 128 + e] = (bf16)f2bf(p.in[24][k * 256 + n]); }
        for (int e = B0 * 512 + tidx(); e < 2 * 4 * 128 * 128; e += G * 512) { const int t = (e >> 7) & 127, s = e & 127;
            p.GWS[e] = s <= t ? (bf16)f2bf(p.in[27][e]) : (bf16)0; }
        cvt_bf16(p.in[37], WQB, (size_t)2 * DM * DM, 1.f, B0, G);
        cvt_bf16(mem, MEMB, (size_t)NB * MEML * DM, 1.f, B0, G);
    }
    __syncthreads();
    ln_rows(x_in, 1.0f, nullptr, p.in[2], p.in[3], p.X, p.XN, B0, G);
    GSYNC();
    {
        const int gi = B0 >> 3, un = B0 & 7;
        pg8::Gemm g{MEMB, ((gi & 1) ? WVT : WKT) + (size_t)(gi >> 1) * DM * DM, NB * MEML, DM, DM};
        pg8::OneUnit S{un >> 2, un & 3, B0 < 32 ? 1 : 0};
        pg8::EpiBf16<0> E{((gi & 1) ? VMEMB : KMEMB) + (size_t)(gi >> 1) * NB * MEML * DM, DM, nullptr, 0, 0, 1.f};
        pg8::gemm_phase<pg8::EpiBf16<0>, pg8::OneUnit, false, true>(ring, g, S, E);
    }
    GSYNC();
    {
        const int l = (B0 >> 6) & 1, kind = (B0 >> 5) & 1, bh = (B0 >> 2) & 7, q4 = B0 & 3, b = bh >> 2, h = bh & 3;
        if (kind == 0) {
            pg8::Gemm g{KMEMB + (size_t)l * NB * MEML * DM + (size_t)b * MEML * DM + h * 256, WQB + (size_t)l * DM * DM + h * 256, 256, DM, 256, DM, DM};
            pg8::OneUnit S{0, q4, B0 < 128 ? 1 : 0};
            pg8::EpiBf16S E{p.WQK_T + (size_t)l * NB * DM * DM + (size_t)b * DM * DM + (size_t)h * 256 * DM, DM, 0.0625f * 1.4426950408889634f};
            pg8::gemm_phase<pg8::EpiBf16S, pg8::OneUnit, false, true>(ring, g, S, E);
        } else {
            pg8::Gemm g{WOT + (size_t)l * DM * DM + h * 256, VMEMB + (size_t)l * NB * MEML * DM + (size_t)b * MEML * DM + h * 256, DM, 256, 256, DM, DM};
            pg8::OneUnit S{q4, 0, B0 < 128 ? 1 : 0};
            pg8::EpiBf16S E{p.VWO_T + (size_t)l * NB * DM * DM + (size_t)b * DM * DM + h * 256, DM, 1.f};
            pg8::gemm_phase<pg8::EpiBf16S, pg8::OneUnit, false, true>(ring, g, S, E);
        }
    }
    GSYNC();
    for (int l = 0; l < 2; ++l) {
REP(1) {
        {
            pg8::Gemm g{p.XN, p.WIN_T + (size_t)l * DINP * DM, NTOK, DINP, DM};
            pg8::StaticOrder S; S.init(NTOK, DINP, G, B0);
            pg8::EpiBf16<0> E{COLSB, DINP, nullptr, 0, 0, 1.f};
            pg8::gemm_phase<pg8::EpiBf16<0>, pg8::StaticOrder, true, true>(ring, g, S, E);
        }
}
        GSYNC();
#define MK_RW() RwP rw; rw.R = nullptr; rw.K = nullptr; rw.V = rV; rw.A = nullptr; rw.B = nullptr; rw.LW = nullptr; rw.G = rG; rw.BON = rBON; \
        rw.AT = rAT; rw.BT = rBT; rw.KT = rKT; rw.RT = rRT; rw.LAM = rLAM; rw.PF = rPF; rw.HF = rHF; rw.QT = rQT; rw.OL = rOL; rw.SF = rSF; \
        rw.gn_g = p.in[19] + l * 256; rw.gn_b = p.in[20] + l * 256; rw.MIX = p.MIX;
        {
            MixP mp;
            mp.COLS = COLSB;
            mp.conv_w = p.in[6] + (size_t)l * 31 * 256; mp.conv_b = p.in[7] + l * 256; mp.conv_gg = p.in[8] + l * 256; mp.conv_gb = p.in[9] + l * 256;
            mp.gl_g = p.in[25] + l * 256; mp.gl_b = p.in[26] + l * 256;
            mp.mu = p.in[10] + l * 1024; mp.w0 = p.in[11] + l * 256; mp.a0 = p.in[13] + l * 256; mp.k_k = p.in[16] + l * 256; mp.k_a = p.in[17] + l * 256; mp.r_k = p.in[18] + l * 256;
            mp.v_mu = p.in[22]; mp.v0 = p.in[23];
            mp.WUP_T = p.LORA_T + (size_t)l * 256 * 64; mp.AUP_T = p.LORA_T + (size_t)(2 + l) * 256 * 64; mp.GUP_T = p.LORA_T + (size_t)4 * 256 * 64 + (size_t)l * 256 * 128;
            mp.VUP_T = p.LORA_T + (size_t)4 * 256 * 64 + (size_t)2 * 256 * 128;
            mp.pe_k = p.in[29] + (size_t)l * 2048; mp.pe_v = p.in[32] + (size_t)l * 2048;
            mp.MIX = p.MIX; mp.UB = UBb; mp.VB = VBb;
            mp.AT = rAT; mp.BT = rBT; mp.KT = rKT; mp.RT = rRT; mp.V = rV; mp.G = rG; mp.BON = rBON; mp.VFIRST = p.VFIRST; mp.LAM = rLAM;
            mp.QN = QNb; mp.QR = QRb; mp.KSR = KSRb; mp.KWR = KWRb; mp.VST = VSTb; mp.VWT = VWTb; mp.GATES = GATESb; mp.BLK = BLKb; mp.BLV = BLVb;
            mp.layer = l; mp.pad = 0;
REP(2) {
            for (int cg = B0; cg < NTOK / 64; cg += G) prep_unit(mp, cg, ring);
}
        }
        GSYNC();
        {
REP(4) {
            {
                const int isv = (B0 >> 2) & 1;
                pg8::Gemm g{isv ? BLVb : BLKb, p.W1_T + (size_t)(l * 2 + isv) * 256 * 2048, 1024, 256, 2048};
                pg8::OneUnit S{B0 & 3, 0, B0 < 8 ? 1 : 0};
                pg8::EpiGeluF32 E{isv ? HIDV : HIDK, 256};
                pg8::gemm_phase<pg8::EpiGeluF32, pg8::OneUnit, false, true>(ring, g, S, E);
            }
}
REP(6) {
            MK_RW()
            for (int u0 = 2 * (G - 1 - B0); u0 < 1024; u0 += 2 * G) rw_r2(rw, u0, ring);
}
REP(5) {
            for (int c = G - 1 - B0; c < NTOK / 128; c += G) gmlp_unit(UBb, VBb, p.GWS + (size_t)l * 4 * 128 * 128, p.in[28] + l * 4 * 128, p.MIX, c, ring);
}
        }
        GSYNC();
        {
REP(7) {
            const GemmArgs gk = mk(HIDK, 256, p.in[31] + (size_t)l * 256 * 64, 64, 1, (float*)KCMPb, 64, 1024, 64, 256, 1, 0, 0, 0, 0, 0, 0, nullptr, nullptr, 2);
            const GemmArgs gv = mk(HIDV, 256, p.in[34] + (size_t)l * 256 * 64, 64, 1, (float*)VCMPTb, 64, 1024, 64, 256, 1, 0, 0, 0, 0, 0, 0, nullptr, nullptr, 3);
            gemm_all(gk, 1024, 1, B0, G, lds);
            gemm_all(gv, 1024, 1, B0, G, lds);
}
        }
        GSYNC();
        if (B0 >= G - 2) {
REP(8) {
            { MK_RW() const int w_ = tidx() >> 6; rw_r3(rw, G - 1 - B0, w_ >> 1, w_ & 1, tidx() & 63); }
}
        } else {
REP(9) {
            for (int uu = B0; uu < NTOK / 64; uu += G - 2) {
                const int b = uu & 1, tile = SEQ / 64 - 1 - (uu >> 1);
                NsaP np; np.QN = QNb + (size_t)b * SEQ * 256; np.QR = QRb + (size_t)b * SEQ * 256; np.KSR = KSRb + (size_t)b * SEQ * 64; np.KWR = KWRb + (size_t)b * SEQ * 64;
                np.VST = VSTb + (size_t)b * 64 * SEQ; np.VWT = VWTb + (size_t)b * 64 * SEQ; np.KCMP = KCMPb + (size_t)b * 512 * 64; np.VCMPT = VCMPTb + (size_t)b * 64 * 512;
                np.GATES = GATESb + (size_t)b * SEQ * 12; np.MIX = p.MIX + (size_t)b * SEQ * DM;
                nsa_unit(np, tile, ring);
            }
}
        }
        GSYNC();
REP(10) {
        MK_RW()
        for (int i = B0 * NWAVES + (tidx() >> 6); i < 2048; i += G * NWAVES) rw_r4(rw, i >> 1, i & 1, tidx() & 63);
}
        GSYNC();
        {
REP(11) {
            pg8::Gemm g{p.MIX, p.WOUT_T + (size_t)l * DM * DM, NTOK, DM, DM};
            pg8::StaticOrder S; S.init(NTOK, DM, G, B0);
            pg8::EpiF32 E{YBUF, DM, nullptr};
            pg8::gemm_phase<pg8::EpiF32, pg8::StaticOrder, true, true>(ring, g, S, E);
}
        }
        GSYNC();
        ln_rows(p.X, ALPHA, YBUF, p.in[35] + l * DM, p.in[36] + l * DM, p.X, p.XN, B0, G);
        if (B0 == 0 && tidx() < 16) p.EOFF[512 + tidx()] = 0;
        __syncthreads();
        {
            LAS float* scr = (LAS float*)(ring + (tidx() >> 6) * 16384);
            const int gw = B0 * NWAVES + (tidx() >> 6), NGW = G * NWAVES, lane = tidx() & 63;
            const float* wg = p.in[45] + (size_t)l * 16 * DM * 512;
            const float* wu = p.in[46] + (size_t)l * 16 * DM * 512;
            const float* wd = p.in[47] + (size_t)l * 16 * 512 * DM;
            constexpr int I_GU = (DM / 64) * (512 / 32), I_D = (512 / 64) * (DM / 32);
REP(13) {
            for (int it = gw; it < 16 * (2 * I_GU + I_D); it += NGW) {
                const int e = it / (2 * I_GU + I_D); int r = it % (2 * I_GU + I_D);
                if (r < 2 * I_GU) {
                    const int isup = r / I_GU; r %= I_GU;
                    const int kb = r / 16, nb = r % 16, n0 = nb * 32;
                    tr_blk((isup ? wu : wg) + (size_t)e * DM * 512, 512, 512, kb * 64, n0, WGU_T + (size_t)e * 1024 * DM, DM, (n0 >> 7) * 256 + (n0 & 127) + isup * 128, 1.f, scr, lane);
                } else {
                    r -= 2 * I_GU;
                    const int kb = r / 32, nb = r % 32;
                    tr_blk(wd + (size_t)e * 512 * DM, DM, DM, kb * 64, nb * 32, WD_T + (size_t)e * DM * 512, 512, nb * 32, 1.f, scr, lane);
                }
            }
}
        }
        GSYNC();
        {
            bf16* WQK_T = p.WQK_T + (size_t)l * NB * DM * DM;
REP(14) {
            pg8::Gemm g{p.XN, WQK_T, NTOK, DM, DM};
            pg8::XaOrder S{G, B0};
            pg8::EpiSoftmaxP E{PB};
            pg8::gemm_phase<pg8::EpiSoftmaxP, pg8::XaOrder, false, true>(ring, g, S, E);
}
        }
        GSYNC();
        {
REP(15) {
            pg8::Gemm g{PB, p.VWO_T + (size_t)l * NB * DM * DM, NTOK, DM, DM};
            pg8::XaOrder S{G, B0};
            pg8::EpiF32N4 E{YBUF, DM};
            pg8::gemm_phase<pg8::EpiF32N4, pg8::XaOrder, true, true>(ring, g, S, E);
}
        }
        GSYNC();
        ln_router_rows(p.X, YBUF, p.in[41] + l * DM, p.in[42] + l * DM, p.X, p.XN, p.in[43], p.in[44], p.TE, p.TW, p.LIST, p.EOFF + 512, B0, G);
        GSYNC();
REP(21) {
        moe_gather2(p.XN, p.TE, p.LIST, p.EOFF + 512, p.SLOT, p.EOFF + 32, p.EOFF + 64, XG, B0, G, (LAS int*)ring);
}
        GSYNC();
        {
REP(22) {
            pg8::Gemm g{XG, WGU_T, 0, 0, DM};
            pg8::MoeOrder S{p.EOFF + 64, p.EOFF + 32, G, B0};
            pg8::EpiSiluMul E{HB};
            pg8::gemm_phase<pg8::EpiSiluMul, pg8::MoeOrder, true, true>(ring, g, S, E);
}
        }
        GSYNC();
        {
REP(23) {
            pg8::Gemm g{HB, WD_T, 0, 0, 512};
            pg8::MoeOrder S{p.EOFF + 64, p.EOFF + 32, G, B0};
            pg8::EpiBf16N4 E{XG, DM};
            pg8::gemm_phase<pg8::EpiBf16N4, pg8::MoeOrder, true, true>(ring, g, S, E);
}
        }
        GSYNC();
        moe_combine_rows(p.X, XG, p.TE, p.TW, p.SLOT, p.in[48] + l * DM, p.in[49] + l * DM, p.X, p.XN, B0, G);
        GSYNC();
    }
}

#undef RB
#undef SZ_TB
#undef rAT
#undef rBT
#undef rKT
#undef rRT
#undef rV
#undef rG
#undef rBON
#undef QNb
#undef QRb
#undef UBb
#undef VBb
#undef KSRb
#undef KWRb
#undef VSTb
#undef VWTb
#undef BLKb
#undef BLVb
#undef rLAM
#undef GATESb
#undef COLSB
#undef rPF
#undef rHF
#undef rSF
#undef rQT
#undef rOL
#undef HIDK
#undef HIDV
#undef KCMPb
#undef VCMPTb
#undef YBUF
#undef PB
#undef XG
#undef HB
#undef WGU_T
#undef WD_T
#undef x_in
#undef mem
#undef p
extern "C" void kernel_launch(void* const* d_in, const int* in_sizes, int n_in, void* d_out, int out_size, void* d_ws, size_t ws_size,
                              hipStream_t stream) {
    static int grid_blocks = 0;
    if (!grid_blocks) {
        int dev = 0, cus = 0, per_cu = 0;
        (void)hipGetDevice(&dev);
        (void)hipDeviceGetAttribute(&cus, hipDeviceAttributeMultiprocessorCount, dev);
        (void)hipFuncSetAttribute((const void*)mega, hipFuncAttributeMaxDynamicSharedMemorySize, LDS_BYTES);
        (void)hipOccupancyMaxActiveBlocksPerMultiprocessor(&per_cu, (const void*)mega, NWAVES * 64, LDS_BYTES);
        (void)hipGetLastError();
        if (per_cu < 1) { fprintf(stderr, "occupancy query says %d blocks per CU\n", per_cu); per_cu = 1; }
        grid_blocks = cus;
    }
    MP p; memset(&p, 0, sizeof(p));
    for (int i = 0; i < 50; ++i) p.in[i] = (const float*)d_in[i];
    char* ws = (char*)d_ws;
    size_t o = 0;
    auto take = [&](size_t bytes) { char* q = ws + o; o += (bytes + 255) & ~(size_t)255; return q; };
    p.BAR = (unsigned*)take(16384);
    p.X = (float*)d_out;
    p.VFIRST = (bf16*)take((size_t)NTOK * 256 * 2);
    p.LORA_T = (bf16*)take((size_t)(4 * 256 * 64 + 2 * 256 * 128 + 256 * 32) * 2);
    p.GWS = (bf16*)take((size_t)2 * 4 * 128 * 128 * 2);
    p.MIX = (bf16*)take((size_t)NTOK * DM * 2);
    p.XN = (bf16*)take((size_t)NTOK * DM * 2);
    p.WIN_T = (bf16*)take((size_t)2 * DINP * DM * 2);
    p.WOUT_T = (bf16*)take((size_t)2 * DM * DM * 2);
    p.WQK_T = (bf16*)take((size_t)2 * NB * DM * DM * 2);
    p.VWO_T = (bf16*)take((size_t)2 * NB * DM * DM * 2);
    p.W1_T = (bf16*)take((size_t)4 * 256 * 2048 * 2);
    p.TE = (int*)take((size_t)NTOK * 2 * 4);
    p.TW = (float*)take((size_t)NTOK * 2 * 4);
    p.SLOT = (int*)take((size_t)NTOK * 2 * 4);
    p.LIST = (int*)take((size_t)36864 * 4);
    p.EOFF = (int*)take(4096);
    p.R0 = (float*)take((size_t)54200000 * 4);
    if (o > ws_size) { fprintf(stderr, "workspace too small: need %zu have %zu\n", o, ws_size); return; }
    (void)hipMemsetAsync(p.BAR, 0, 16384, stream);
    void* args[] = {&p};
    hipError_t e = hipLaunchCooperativeKernel((const void*)mega, dim3(grid_blocks), dim3(NWAVES * 64), args, LDS_BYTES, stream);
    if (e != hipSuccess) fprintf(stderr, "cooperative launch failed: %s (grid %d)\n", hipGetErrorString(e), grid_blocks);
}
```

```cpp
#include <hip/hip_runtime.h>
#include <hip/hip_cooperative_groups.h>
#include <stdio.h>
#include <stdint.h>
#include <string.h>
#include <math.h>
namespace cg = cooperative_groups;

#define DEVI __device__ __forceinline__
#define GAS __attribute__((address_space(1)))
#define LAS __attribute__((address_space(3)))
typedef unsigned short bf16;
typedef unsigned v4u __attribute__((ext_vector_type(4)));
typedef GAS unsigned gu32;
typedef GAS unsigned long long gu64;
#define RLX_AGENT __ATOMIC_RELAXED, __HIP_MEMORY_SCOPE_AGENT
#define LDS_WAIT() asm volatile("s_waitcnt lgkmcnt(0)" ::: "memory")
#define VM_WAIT() asm volatile("s_waitcnt vmcnt(0)" ::: "memory")
DEVI unsigned f2bf(float f) { unsigned u = __builtin_bit_cast(unsigned, f); return (u + 0x7fffu + ((u >> 16) & 1u)) >> 16; }
DEVI unsigned pk2(float lo, float hi) { return f2bf(lo) | (f2bf(hi) << 16); }
DEVI float bf2f(unsigned short h) { return __builtin_bit_cast(float, (unsigned)h << 16); }

constexpr int NB = 2, SEQ = 8192, DM = 1024, NTOK = NB * SEQ, DIN = 2700, DINP = 2816, MEML = 256;
constexpr int OFF_CV = 0, OFF_CG = 256, OFF_RW = 512, OFF_GU = 1536, OFF_GV = 1792, OFF_Q = 2048, OFF_KC = 2304,
              OFF_VC = 2368, OFF_KS = 2432, OFF_VS = 2496, OFF_KW = 2560, OFF_VW = 2624, OFF_GT = 2688;
constexpr int NCMP = 511;
constexpr float ALPHA = 1.4142135623730951f;
constexpr int NWAVES = 8;
constexpr int RING_OFF = 0, RING_BYTES = 131072;
constexpr int LDSCTL_OFF = RING_BYTES, MISC_OFF = LDSCTL_OFF + 320;
constexpr int LDS_BYTES = 147456;

constexpr int TIDTBL_OFF = LDSCTL_OFF;
DEVI int tidx() {
    const unsigned slot = __builtin_amdgcn_s_getreg((5 << 11) | 4) & 63u;
    int w = *(volatile LAS int*)(unsigned long)(TIDTBL_OFF + slot * 4u);
    w = __builtin_amdgcn_readfirstlane(w);
    int t;
    asm volatile("v_mbcnt_lo_u32_b32 %0, -1, 0\n\tv_mbcnt_hi_u32_b32 %0, -1, %0" : "=v"(t));
    t |= w << 6;
    asm volatile("" : "+v"(t));
    return t;
}

#ifndef PROBE_MASK
#define PROBE_MASK 0ull
#endif
#define PROBE_N 3
#define REP(id) for (int rep_ = 0; rep_ < (((PROBE_MASK >> (id)) & 1ull) ? 1 + PROBE_N : 1); ++rep_)
namespace pg8 {
#define PG8_LAS __attribute__((address_space(3)))
typedef unsigned short bf16_t;
typedef short bf16x8 __attribute__((ext_vector_type(8)));
typedef float f32x4 __attribute__((ext_vector_type(4)));
typedef unsigned u32x4 __attribute__((ext_vector_type(4)));
constexpr int BM = 256, BK = 64, HALF = 128, HTB = HALF * BK * 2  , STAGE_BYTES = 8 * HTB, NXCD = 8, WGM = 8;

__host__ __device__ __forceinline__ int lds_byte(int r, int c) { const int st = (r >> 4) * 2 + (c >> 5), rr = r & 15, cc = c & 31, ob = rr * 64 + cc * 2; return st * 1024 + (ob ^ (((ob >> 9) & 1) << 5)); }
__host__ __device__ __forceinline__ void stage_rc(int b, int& R, int& C) { const int st = b / 1024, sb = b % 1024, swz = sb ^ (((sb >> 9) & 1) << 5); R = (st >> 1) * 16 + swz / 64; C = (st & 1) * 32 + (swz % 64) / 2; }
__host__ __device__ __forceinline__ int perm32(int rho) { const int n = rho >> 4, i = rho & 15; return 8 * (i >> 2) + 4 * n + (i & 3); }

struct Unit { int pm, pn; };
struct Gemm { const bf16_t* A; const bf16_t* Bt; int M, N, K; int lda = 0, ldb = 0; };

struct StaticOrder {
    int nM, nN, nwg, G, c;
    __host__ __device__ void init(int M, int N, int G_, int c_) { nM = M / BM; nN = N / BM; nwg = nM * nN; G = G_; c = c_; }
    __host__ __device__ bool next(int i, Unit& u) const {
        const long L = (long)i * G + c; if (L >= nwg) return false;
        int wgid = (int)L; { const int q = nwg / NXCD, r = nwg % NXCD, xcd = wgid % NXCD, off = wgid / NXCD; wgid = (xcd < r ? xcd * (q + 1) : r * (q + 1) + (xcd - r) * q) + off; }
        const int nig = WGM * nN, gid = wgid / nig, fm = gid * WGM, gsz = (nM - fm) < WGM ? (nM - fm) : WGM;
        u.pm = fm + ((wgid % nig) % gsz); u.pn = (wgid % nig) / gsz; return true;
    }
    __device__ __forceinline__ void a_ready(const Unit&) const {}
    __device__ __forceinline__ void done(const Unit&) const {}
};

__device__ __forceinline__ unsigned cvt_pk_bf16(float lo, float hi) { unsigned r; asm volatile("v_cvt_pk_bf16_f32 %0, %1, %2" : "=v"(r) : "v"(lo), "v"(hi)); return r; }
typedef float f32x2 __attribute__((ext_vector_type(2)));
__device__ __forceinline__ f32x2 gelu_pk(f32x2 v) {
    const f32x2 av = __builtin_elementwise_abs(v), d = av * 0.2316418882f + 1.0f;
    f32x2 t; t.x = __builtin_amdgcn_rcpf(d.x); t.y = __builtin_amdgcn_rcpf(d.y);
    f32x2 q = t * 0.5307027145f + (-0.7265760135f); q = q * t + 0.7107068705f; q = q * t + (-0.142248368f); q = q * t + 0.127414796f; q = q * t;
    const f32x2 s = (v * v) * (-0.72134752044f);
    f32x2 e; e.x = __builtin_amdgcn_exp2f(s.x); e.y = __builtin_amdgcn_exp2f(s.y);
    const f32x2 m = v * (q * e), r = v - m;
    f32x2 o; o.x = v.x < 0.f ? m.x : r.x; o.y = v.y < 0.f ? m.y : r.y; return o;
}

template <int ACT  > struct EpiBf16 {
    static constexpr bool PERM = true, AFTER_DRAIN = false; static_assert(ACT == 0 || ACT == 1, "EpiBf16: ACT is 0 (none) or 1 (gelu_pk)");
    bf16_t* O; int ldc; const float* bias; int split_cols; size_t split_stride; float scale0;
    __device__ __forceinline__ void operator()(const f32x4 (&acc)[2][2][4][2], const Unit& u, int wr, int wc, int fr, int fq) const {
        const int row0 = u.pm * BM + wr * 64 + fr; int colt = u.pn * BM; bf16_t* base = O;
        float sc = 1.f; if (split_cols) { const int t = colt / split_cols; base += (size_t)t * split_stride; colt -= t * split_cols; if (t == 0) sc = scale0; }
        const int col0 = colt + wc * 32 + 8 * fq, bcol0 = u.pn * BM + wc * 32 + 8 * fq;
        f32x4 bv[2][2];
#pragma unroll
        for (int bj = 0; bj < 2; ++bj)
#pragma unroll
            for (int n = 0; n < 2; ++n) bv[bj][n] = bias ? *(const f32x4*)(bias + bcol0 + bj * HALF + 4 * n) : (f32x4){0.f, 0.f, 0.f, 0.f};
#pragma unroll
        for (int ai = 0; ai < 2; ++ai)
#pragma unroll
            for (int m = 0; m < 4; ++m) { bf16_t* rowp = base + (size_t)(row0 + ai * HALF + m * 16) * ldc + col0;
#pragma unroll
                for (int bj = 0; bj < 2; ++bj) { f32x4 v0 = acc[ai][bj][m][0] + bv[bj][0], v1 = acc[ai][bj][m][1] + bv[bj][1];
                    if (ACT == 1) { f32x2 a = gelu_pk((f32x2){v0[0], v0[1]}), b = gelu_pk((f32x2){v0[2], v0[3]}), c = gelu_pk((f32x2){v1[0], v1[1]}), d = gelu_pk((f32x2){v1[2], v1[3]});
                        v0 = (f32x4){a.x, a.y, b.x, b.y}; v1 = (f32x4){c.x, c.y, d.x, d.y}; }
                    v0 = v0 * sc; v1 = v1 * sc; u32x4 w; w.x = cvt_pk_bf16(v0[0], v0[1]); w.y = cvt_pk_bf16(v0[2], v0[3]); w.z = cvt_pk_bf16(v1[0], v1[1]); w.w = cvt_pk_bf16(v1[2], v1[3]);
                    *(u32x4*)(rowp + bj * HALF) = w; } }
    }
};

struct PanelStats {
    unsigned* xbuf;
    unsigned* cnt;
    unsigned* tmo;
    int ntn; float eps;
    unsigned code;
    __device__ __forceinline__ bool run(const f32x4 (&v)[2][2][4][2], const Unit& u, int wr, int wc, int fr, int fq, PG8_LAS unsigned char* lds, int wid, int lane) const {
        typedef float f32x2v __attribute__((ext_vector_type(2)));
        PG8_LAS f32x2v* P = (PG8_LAS f32x2v*)lds;
        PG8_LAS f32x2v* S = (PG8_LAS f32x2v*)(lds + 8192);
        PG8_LAS unsigned* flag = (PG8_LAS unsigned*)(lds + 8192 + 2048);
#pragma unroll
        for (int ai = 0; ai < 2; ++ai)
#pragma unroll
            for (int m = 0; m < 4; ++m) {
                float s = 0.f;
#pragma unroll
                for (int bj = 0; bj < 2; ++bj)
#pragma unroll
                    for (int n = 0; n < 2; ++n) { const f32x4 x = v[ai][bj][m][n]; s += (x[0] + x[1]) + (x[2] + x[3]); }
                s += __shfl_xor(s, 16); s += __shfl_xor(s, 32);
                const float mw = s * (1.0f / 64.0f); float q = 0.f;
#pragma unroll
                for (int bj = 0; bj < 2; ++bj)
#pragma unroll
                    for (int n = 0; n < 2; ++n) { const f32x4 d = v[ai][bj][m][n] - mw; q += (d[0] * d[0] + d[1] * d[1]) + (d[2] * d[2] + d[3] * d[3]); }
                q += __shfl_xor(q, 16); q += __shfl_xor(q, 32);
                if (fq == 0) P[(ai * HALF + wr * 64 + m * 16 + fr) * 4 + wc] = (f32x2v){mw, q};
            }
        asm volatile("s_waitcnt lgkmcnt(0)" ::: "memory"); __builtin_amdgcn_s_barrier(); asm volatile("" ::: "memory");
#if defined(BROKEN_EXCHANGE_NO_WAIT)
#warning BROKEN CONTROL BUILD: the row-statistics exchange does not wait; results are wrong by design
        if (blockIdx.x >= 64) { const long long t0_ = clock64(); while (clock64() - t0_ < 60000) __builtin_amdgcn_s_sleep(8); }
#endif
        const int row = wid * 32 + (lane & 31);
        if (lane < 32) {
            const f32x2v a = P[row * 4 + 0], b = P[row * 4 + 1], c = P[row * 4 + 2], d = P[row * 4 + 3];
            const float mt = (a.x + b.x + c.x + d.x) * 0.25f;
            const float da = a.x - mt, db = b.x - mt, dc = c.x - mt, dd = d.x - mt;
            const float m2 = (a.y + b.y) + (c.y + d.y) + 64.0f * ((da * da + db * db) + (dc * dc + dd * dd));
            unsigned long long* slot = (unsigned long long*)xbuf + ((size_t)(u.pm * BM + row) * 4 + u.pn);
            __hip_atomic_store(slot, ((unsigned long long)__float_as_uint(m2) << 32) | __float_as_uint(mt), __ATOMIC_RELAXED, __HIP_MEMORY_SCOPE_AGENT);
        }
        asm volatile("s_waitcnt vmcnt(0)" ::: "memory");
        if (lane == 0) __hip_atomic_fetch_add(cnt + 64 * u.pm, 1u, __ATOMIC_RELAXED, __HIP_MEMORY_SCOPE_AGENT);
        if (wid == 0) {
            bool dead = false; const unsigned long long t0 = __builtin_amdgcn_s_memrealtime(); const unsigned want = 8u * (unsigned)ntn;
            for (;;) {
#if defined(BROKEN_EXCHANGE_NO_WAIT)
                break;
#endif
                if ((unsigned)__builtin_amdgcn_readfirstlane(__hip_atomic_load(cnt + 64 * u.pm, __ATOMIC_RELAXED, __HIP_MEMORY_SCOPE_AGENT)) >= want) break;
                if (__builtin_amdgcn_s_memrealtime() - t0 > 2000000ull) {
                    if (lane == 0) { unsigned expect = 0u; __hip_atomic_compare_exchange_strong(tmo + 1, &expect, code | (unsigned)(u.pm & 0xff), __ATOMIC_RELAXED, __ATOMIC_RELAXED, __HIP_MEMORY_SCOPE_AGENT);
                                     __hip_atomic_store(tmo, 1u, __ATOMIC_RELAXED, __HIP_MEMORY_SCOPE_AGENT); }
                    dead = true; break; }
                __builtin_amdgcn_s_sleep(2);
            }
            __builtin_amdgcn_fence(__ATOMIC_ACQUIRE, "agent");
            if (lane == 0) flag[0] = dead ? 1u : 0u;
        }
        asm volatile("s_waitcnt vmcnt(0) lgkmcnt(0)" ::: "memory"); __builtin_amdgcn_s_barrier(); asm volatile("" ::: "memory");
        const bool bad = flag[0] != 0u;
        if (lane < 32) {
            const unsigned long long* slot = (const unsigned long long*)xbuf + (size_t)(u.pm * BM + row) * 4; float mt[4], m2[4]; float ms = 0.f;
#pragma unroll
            for (int t = 0; t < 4; ++t) { if (t < ntn) { const unsigned long long w = __hip_atomic_load(slot + t, __ATOMIC_RELAXED, __HIP_MEMORY_SCOPE_AGENT); mt[t] = __uint_as_float((unsigned)w); m2[t] = __uint_as_float((unsigned)(w >> 32)); } else { mt[t] = 0.f; m2[t] = 0.f; } ms += mt[t]; }
            const float mean = ms / (float)ntn; float q = 0.f;
#pragma unroll
            for (int t = 0; t < 4; ++t) if (t < ntn) { const float dm = mt[t] - mean; q += m2[t] + 256.0f * dm * dm; }
            S[row] = (f32x2v){mean, 1.0f / sqrtf(q / (256.0f * (float)ntn) + eps)};
        }
        asm volatile("s_waitcnt lgkmcnt(0)" ::: "memory"); __builtin_amdgcn_s_barrier(); asm volatile("" ::: "memory");
        return bad;
    }
};
struct EpiLnRes {
    static constexpr bool PERM = false, AFTER_DRAIN = true;
    const float* base; float* out; int ldc; const float* bias; PanelStats st; unsigned poison;
    __device__ __forceinline__ void fused(f32x4 (&acc)[2][2][4][2], const Unit& u, int wr, int wc, int fr, int fq, PG8_LAS unsigned char* lds, int wid, int lane) const {
        typedef float f32x2v __attribute__((ext_vector_type(2)));
        const PG8_LAS f32x2v* S = (const PG8_LAS f32x2v*)(lds + 8192);
        const int col0 = u.pn * BM + wc * 32 + 4 * fq;
#pragma unroll
        for (int bj = 0; bj < 2; ++bj)
#pragma unroll
            for (int n = 0; n < 2; ++n) { const f32x4 bv = bias ? *(const f32x4*)(bias + col0 + bj * HALF + n * 16) : (f32x4){0.f, 0.f, 0.f, 0.f};
#pragma unroll
                for (int ai = 0; ai < 2; ++ai)
#pragma unroll
                    for (int m = 0; m < 4; ++m) acc[ai][bj][m][n] += bv; }
        f32x4 pre[4][2][2];
#pragma unroll
        for (int m = 0; m < 4; ++m) { const size_t off = (size_t)(u.pm * BM + wr * 64 + m * 16 + fr) * ldc + col0;
#pragma unroll
            for (int bj = 0; bj < 2; ++bj)
#pragma unroll
                for (int n = 0; n < 2; ++n) pre[m][bj][n] = *(const f32x4*)(base + off + bj * HALF + n * 16); }
        const bool bad = st.run(acc, u, wr, wc, fr, fq, lds, wid, lane) || poison != 0u;
        const float qnan = __builtin_nanf("");
#pragma unroll
        for (int ai = 0; ai < 2; ++ai)
#pragma unroll
            for (int m = 0; m < 4; ++m) { const int r = ai * HALF + wr * 64 + m * 16 + fr; const f32x2v sr = S[r]; const size_t off = (size_t)(u.pm * BM + r) * ldc + col0;
#pragma unroll
                for (int bj = 0; bj < 2; ++bj)
#pragma unroll
                    for (int n = 0; n < 2; ++n) { const f32x4 bs = ai == 0 ? pre[m][bj][n] : *(const f32x4*)(base + off + bj * HALF + n * 16); f32x4 o = bs + (acc[ai][bj][m][n] - sr.x) * sr.y;
                        if (bad) o = (f32x4){qnan, qnan, qnan, qnan}; *(f32x4*)(out + off + bj * HALF + n * 16) = o; }
                if (m & 1) asm volatile("" ::: "memory"); }
    }
};
struct EpiLnResLn {
    static constexpr bool PERM = false, AFTER_DRAIN = true;
    const float* base; float* out; bf16_t* xn; int ldc; const float* bias; PanelStats st1, st2; unsigned poison;
    __device__ __forceinline__ void fused(f32x4 (&acc)[2][2][4][2], const Unit& u, int wr, int wc, int fr, int fq, PG8_LAS unsigned char* lds, int wid, int lane) const {
        typedef float f32x2v __attribute__((ext_vector_type(2))); typedef unsigned u32x2v __attribute__((ext_vector_type(2)));
        const PG8_LAS f32x2v* S = (const PG8_LAS f32x2v*)(lds + 8192);
        const int col0 = u.pn * BM + wc * 32 + 4 * fq;
#pragma unroll
        for (int bj = 0; bj < 2; ++bj)
#pragma unroll
            for (int n = 0; n < 2; ++n) { const f32x4 bv = bias ? *(const f32x4*)(bias + col0 + bj * HALF + n * 16) : (f32x4){0.f, 0.f, 0.f, 0.f};
#pragma unroll
                for (int ai = 0; ai < 2; ++ai)
#pragma unroll
                    for (int m = 0; m < 4; ++m) acc[ai][bj][m][n] += bv; }
        bool bad = st1.run(acc, u, wr, wc, fr, fq, lds, wid, lane) || poison != 0u;
        const float qnan = __builtin_nanf("");
#pragma unroll
        for (int ai = 0; ai < 2; ++ai)
#pragma unroll
            for (int m = 0; m < 4; ++m) { const int r = ai * HALF + wr * 64 + m * 16 + fr; const f32x2v sr = S[r]; const size_t off = (size_t)(u.pm * BM + r) * ldc + col0;
#pragma unroll
                for (int bj = 0; bj < 2; ++bj)
#pragma unroll
                    for (int n = 0; n < 2; ++n) { const f32x4 bs = *(const f32x4*)(base + off + bj * HALF + n * 16); acc[ai][bj][m][n] = bs + (acc[ai][bj][m][n] - sr.x) * sr.y; }
                asm volatile("" : "+v"(acc[ai][0][m][0]), "+v"(acc[ai][0][m][1]), "+v"(acc[ai][1][m][0]), "+v"(acc[ai][1][m][1]));
                if (m & 1) asm volatile("" ::: "memory"); }
        const bool bad1 = bad;
        bad = st2.run(acc, u, wr, wc, fr, fq, lds, wid, lane) || bad;
#pragma unroll
        for (int ai = 0; ai < 2; ++ai)
#pragma unroll
            for (int m = 0; m < 4; ++m) { const int r = ai * HALF + wr * 64 + m * 16 + fr; const f32x2v sr = S[r]; const size_t off = (size_t)(u.pm * BM + r) * ldc + col0;
#pragma unroll
                for (int bj = 0; bj < 2; ++bj)
#pragma unroll
                    for (int n = 0; n < 2; ++n) { const f32x4 x1 = acc[ai][bj][m][n]; *(f32x4*)(out + off + bj * HALF + n * 16) = bad1 ? (f32x4){qnan, qnan, qnan, qnan} : x1;
                        const f32x4 o = (x1 - sr.x) * sr.y; u32x2v w; w.x = cvt_pk_bf16(o[0], o[1]); w.y = cvt_pk_bf16(o[2], o[3]);
                        if (bad) { w.x = 0x7fc07fc0u; w.y = 0x7fc07fc0u; } *(u32x2v*)(xn + off + bj * HALF + n * 16) = w; }
                asm volatile("" ::: "memory"); }
    }
};

template <class Epi, class Sched, bool ALIGN_EPI = false, bool SP2 = false>
__device__ __forceinline__ void gemm_phase(PG8_LAS unsigned char* lds, const Gemm g, const Sched& S, const Epi& E) {
    const int tid = tidx(), wid = __builtin_amdgcn_readfirstlane(tid >> 6), lane = tid & 63, wr = wid >> 2, wc = wid & 3, fr = lane & 15, fq = lane >> 4;
    const int K = g.K, nt = K / BK;
    const int LDA = g.lda ? g.lda : K, LDB = g.ldb ? g.ldb : K;
    unsigned voffA[2], voffB[2];
#pragma unroll
    for (int i = 0; i < 2; ++i) { int R, C; stage_rc(tid * 16 + i * 8192, R, C); const int Rb = Epi::PERM ? ((R & ~31) + perm32(R & 31)) : R;
        voffA[i] = (unsigned)(R * LDA + C) * 2u; voffB[i] = (unsigned)(Rb * LDB + C) * 2u; }
    const size_t kstep = (size_t)(BK * 2);
    const size_t hstepA = (size_t)HALF * LDA * 2, hstepB = (size_t)HALF * LDB * 2;
    const size_t tstepA = 2 * hstepA, tstepB = 2 * hstepB;
    const unsigned ldsw = (unsigned)wid * 1024u;
    const int aoff = lds_byte(wr * 64 + fr, fq * 8), boff = lds_byte(wc * 32 + fr, fq * 8);
#define PG8_SA(b, h) (((b) * 2 + (h)) * HTB)
#define PG8_SB(b, h) ((4 + (b) * 2 + (h)) * HTB)
#define PG8_STAGE(bufoff, gbase, voff) do { _Pragma("unroll") for (int _i = 0; _i < 2; ++_i) \
        __builtin_amdgcn_global_load_lds((const unsigned*)((const char*)(gbase) + (voff)[_i]), (PG8_LAS unsigned*)(lds + (bufoff) + ldsw + _i * 8192), 16, 0, 0); } while (0)
#define PG8_LDA(dst, b, h) do { _Pragma("unroll") for (int m = 0; m < 4; ++m) _Pragma("unroll") for (int k = 0; k < 2; ++k) dst[m][k] = *(const PG8_LAS bf16x8*)(lds + PG8_SA(b, h) + aoff + m * 2048 + k * 1024); } while (0)
#define PG8_LDB(dst, b, h) do { _Pragma("unroll") for (int n = 0; n < 2; ++n) _Pragma("unroll") for (int k = 0; k < 2; ++k) dst[n][k] = *(const PG8_LAS bf16x8*)(lds + PG8_SB(b, h) + boff + n * 2048 + k * 1024); } while (0)
#define PG8_MMA(ai, bj, At, Bt) do { __builtin_amdgcn_s_setprio(1); _Pragma("unroll") for (int m = 0; m < 4; ++m) _Pragma("unroll") for (int n = 0; n < 2; ++n) _Pragma("unroll") for (int k = 0; k < 2; ++k) \
        acc[ai][bj][m][n] = __builtin_amdgcn_mfma_f32_16x16x32_bf16(Bt[n][k], At[m][k], acc[ai][bj][m][n], 0, 0, 0); __builtin_amdgcn_s_setprio(0); } while (0)
#define PG8_WAIT_V(n) asm volatile("s_waitcnt vmcnt(" #n ")" ::: "memory")
#define PG8_WAIT_L(n) asm volatile("s_waitcnt lgkmcnt(" #n ")" ::: "memory")
#define PG8_BAR __builtin_amdgcn_s_barrier()
#define PG8_SCHED __builtin_amdgcn_sched_barrier(0)
    Unit cur, nxt; int ui = 0;
    if (!S.next(0, cur)) return;
    f32x4 acc[2][2][4][2];
#pragma unroll
    for (int a = 0; a < 2; ++a)
#pragma unroll
        for (int b = 0; b < 2; ++b)
#pragma unroll
            for (int m = 0; m < 4; ++m)
#pragma unroll
                for (int n = 0; n < 2; ++n) acc[a][b][m][n] = (f32x4){0.f, 0.f, 0.f, 0.f};
    bf16x8 At[4][2], B0[2][2], B1[2][2];
    const char* cA = (const char*)g.A + (size_t)cur.pm * tstepA; const char* cB = (const char*)g.Bt + (size_t)cur.pn * tstepB;
    S.a_ready(cur);
    if constexpr (SP2) {
        PG8_STAGE(PG8_SB(0, 0), cB, voffB); PG8_STAGE(PG8_SB(0, 1), cB + hstepB, voffB); PG8_STAGE(PG8_SA(0, 0), cA, voffA); PG8_STAGE(PG8_SA(0, 1), cA + hstepA, voffA);
        if (wr == 1) PG8_BAR;
        PG8_WAIT_V(2); PG8_BAR;
        PG8_STAGE(PG8_SB(1, 0), cB + kstep, voffB); PG8_STAGE(PG8_SA(1, 0), cA + kstep, voffA); PG8_STAGE(PG8_SB(1, 1), cB + hstepB + kstep, voffB);
        PG8_WAIT_V(6); PG8_BAR;
    } else {
        PG8_STAGE(PG8_SB(0, 0), cB, voffB); PG8_STAGE(PG8_SA(0, 0), cA, voffA); PG8_STAGE(PG8_SB(0, 1), cB + hstepB, voffB); PG8_STAGE(PG8_SA(0, 1), cA + hstepA, voffA);
        if (wr == 1) PG8_BAR;
        PG8_WAIT_V(4); PG8_BAR;
        PG8_STAGE(PG8_SB(1, 0), cB + kstep, voffB); PG8_STAGE(PG8_SA(1, 0), cA + kstep, voffA); PG8_STAGE(PG8_SB(1, 1), cB + hstepB + kstep, voffB);
        PG8_WAIT_V(6); PG8_BAR;
    }
    for (;;) {
        const bool has_next = S.next(ui + 1, nxt);
        const char* nA = has_next ? (const char*)g.A + (size_t)nxt.pm * tstepA : cA; const char* nB = has_next ? (const char*)g.Bt + (size_t)nxt.pn * tstepB : cB;
        for (int t = 0; t < nt; t += 2) {
            const bool last = (t == nt - 2);
            const char* a1 = cA + (size_t)(t + 1) * kstep;
            const char* a2 = last ? nA : cA + (size_t)(t + 2) * kstep; const char* b2 = last ? nB : cB + (size_t)(t + 2) * kstep;
            const char* a3 = a2 + kstep; const char* b3 = b2 + kstep;
            if (last && has_next) S.a_ready(nxt);
            if constexpr (SP2) {
            PG8_LDB(B0, 0, 0); PG8_LDB(B1, 0, 1); PG8_SCHED; PG8_LDA(At, 0, 0); PG8_STAGE(PG8_SA(1, 1), a1 + hstepA, voffA);
            PG8_WAIT_V(8); PG8_WAIT_L(0); PG8_BAR; PG8_MMA(0, 0, At, B0); PG8_MMA(0, 1, At, B1); PG8_BAR; PG8_SCHED;
            PG8_LDA(At, 0, 1); PG8_STAGE(PG8_SB(0, 0), b2, voffB); PG8_STAGE(PG8_SB(0, 1), b2 + hstepB, voffB); PG8_STAGE(PG8_SA(0, 0), a2, voffA);
            PG8_WAIT_V(8); PG8_WAIT_L(0); PG8_BAR; PG8_MMA(1, 0, At, B0); PG8_MMA(1, 1, At, B1); PG8_BAR; PG8_SCHED;
            PG8_LDB(B0, 1, 0); PG8_LDB(B1, 1, 1); PG8_SCHED; PG8_LDA(At, 1, 0); PG8_STAGE(PG8_SA(0, 1), a2 + hstepA, voffA);
            PG8_WAIT_V(8); PG8_WAIT_L(0); PG8_BAR; PG8_MMA(0, 0, At, B0); PG8_MMA(0, 1, At, B1); PG8_BAR; PG8_SCHED;
            PG8_LDA(At, 1, 1); PG8_STAGE(PG8_SB(1, 0), b3, voffB); PG8_STAGE(PG8_SB(1, 1), b3 + hstepB, voffB); PG8_STAGE(PG8_SA(1, 0), a3, voffA);
            PG8_WAIT_V(8); PG8_WAIT_L(0); PG8_BAR; PG8_MMA(1, 0, At, B0); PG8_MMA(1, 1, At, B1); PG8_BAR; PG8_SCHED;
            } else {
            PG8_LDB(B0, 0, 0); PG8_SCHED; PG8_LDA(At, 0, 0); PG8_STAGE(PG8_SA(1, 1), a1 + hstepA, voffA);
            PG8_WAIT_L(8); PG8_BAR; PG8_WAIT_L(0); PG8_MMA(0, 0, At, B0); PG8_BAR; PG8_SCHED;
            PG8_LDB(B1, 0, 1); PG8_STAGE(PG8_SB(0, 0), b2, voffB);
            PG8_BAR; PG8_WAIT_L(0); PG8_MMA(0, 1, At, B1); PG8_BAR;
            PG8_LDA(At, 0, 1); PG8_STAGE(PG8_SA(0, 0), a2, voffA);
            PG8_BAR; PG8_WAIT_L(0); PG8_MMA(1, 0, At, B0); PG8_BAR; PG8_SCHED;
            PG8_STAGE(PG8_SB(0, 1), b2 + hstepB, voffB);
            PG8_WAIT_V(6); PG8_BAR; PG8_MMA(1, 1, At, B1); PG8_BAR;
            PG8_LDB(B0, 1, 0); PG8_SCHED; PG8_LDA(At, 1, 0); PG8_STAGE(PG8_SA(0, 1), a2 + hstepA, voffA);
            PG8_WAIT_L(8); PG8_BAR; PG8_WAIT_L(0); PG8_MMA(0, 0, At, B0); PG8_BAR; PG8_SCHED;
            PG8_LDB(B1, 1, 1); PG8_STAGE(PG8_SB(1, 0), b3, voffB);
            PG8_BAR; PG8_WAIT_L(0); PG8_MMA(0, 1, At, B1); PG8_BAR;
            PG8_LDA(At, 1, 1); PG8_STAGE(PG8_SA(1, 0), a3, voffA);
            PG8_BAR; PG8_WAIT_L(0); PG8_MMA(1, 0, At, B0); PG8_BAR; PG8_SCHED;
            PG8_STAGE(PG8_SB(1, 1), b3 + hstepB, voffB);
            PG8_WAIT_V(6); PG8_BAR; PG8_MMA(1, 1, At, B1); PG8_BAR;
            }
        }
        if constexpr (ALIGN_EPI) { if (wr == 0) PG8_BAR; }
        if constexpr (!Epi::AFTER_DRAIN) { E(acc, cur, wr, wc, fr, fq); S.done(cur); }
        if (!has_next) break;
#pragma unroll
        for (int a = 0; a < 2; ++a)
#pragma unroll
            for (int b = 0; b < 2; ++b)
#pragma unroll
                for (int m = 0; m < 4; ++m)
#pragma unroll
                    for (int n = 0; n < 2; ++n) acc[a][b][m][n] = (f32x4){0.f, 0.f, 0.f, 0.f};
        cur = nxt; cA = nA; cB = nB; ++ui;
        if constexpr (ALIGN_EPI) { if (wr == 1) PG8_BAR; }
    }
    PG8_WAIT_V(0);
    if constexpr (!ALIGN_EPI) { if (wr == 0) PG8_BAR; }
    PG8_BAR;
    if constexpr (Epi::AFTER_DRAIN) { E.fused(acc, cur, wr, wc, fr, fq, lds, wid, lane); S.done(cur); }
#undef PG8_SA
#undef PG8_SB
#undef PG8_STAGE
#undef PG8_LDA
#undef PG8_LDB
#undef PG8_MMA
#undef PG8_WAIT_V
#undef PG8_WAIT_L
#undef PG8_BAR
#undef PG8_SCHED
}
}
namespace pg8 {
struct EpiF32 {
    static constexpr bool PERM = false, AFTER_DRAIN = false;
    float* C; int ldc; const float* bias;
    __device__ __forceinline__ void operator()(const f32x4 (&acc)[2][2][4][2], const Unit& u, int wr, int wc, int fr, int fq) const {
        const int row0 = u.pm * BM + wr * 64 + fr, col0 = u.pn * BM + wc * 32 + 4 * fq;
        f32x4 bv[2][2];
#pragma unroll
        for (int bj = 0; bj < 2; ++bj)
#pragma unroll
            for (int n = 0; n < 2; ++n) bv[bj][n] = bias ? *(const f32x4*)(bias + col0 + bj * HALF + n * 16) : (f32x4){0.f, 0.f, 0.f, 0.f};
#pragma unroll
        for (int ai = 0; ai < 2; ++ai)
#pragma unroll
            for (int m = 0; m < 4; ++m) { float* rowp = C + (size_t)(row0 + ai * HALF + m * 16) * ldc + col0;
#pragma unroll
                for (int bj = 0; bj < 2; ++bj)
#pragma unroll
                    for (int n = 0; n < 2; ++n) *(f32x4*)(rowp + bj * HALF + n * 16) = acc[ai][bj][m][n] + bv[bj][n]; }
    }
};
}
#define XB_TMO      128
#define XB_XCNT(j)  (256  + 64 * (j))
#define XB_XSUB(j)  (1280 + 64 * (j))
#define XB_XGEN(j)  (2304 + 64 * (j))
#define XB_TOP      3328
#define XB_TOPGEN   3392
#define XCD_BAR_WORDS 3456
#define XB_SPIN_CAP (1u << 18)

__device__ __forceinline__ unsigned xb_ld(unsigned* p)              { return __hip_atomic_load(p, __ATOMIC_RELAXED, __HIP_MEMORY_SCOPE_AGENT); }
__device__ __forceinline__ unsigned xb_add(unsigned* p, unsigned v) { return __hip_atomic_fetch_add(p, v, __ATOMIC_RELAXED, __HIP_MEMORY_SCOPE_AGENT); }
__device__ __forceinline__ unsigned xb_xcc_id() { return (unsigned)__builtin_amdgcn_s_getreg((3 << 11) | 20) & 0xFu; }
#define XB_SPIN(cond, bar) do { unsigned _sp = 0; while (cond) { __builtin_amdgcn_s_sleep(1); \
    if ((++_sp & 255u) == 0u) { if (xb_ld(&(bar)[XB_TMO])) break; if (_sp > XB_SPIN_CAP) { atomicAdd(&(bar)[XB_TMO], 1u); break; } } } } while (0)

struct XcdBarrier {
    unsigned* bar; unsigned x;
    volatile LAS unsigned* st;
};

__device__ __forceinline__ XcdBarrier xcd_barrier_post(unsigned* bar, volatile LAS unsigned* st) {
    XcdBarrier b; b.bar = bar; b.x = xb_xcc_id(); b.st = st;
    if (tidx() == 0) (void)xb_add(&bar[XB_XCNT(b.x)], 1u);
    return b;
}
__device__ __forceinline__ void xcd_barrier_complete(unsigned* bar, unsigned x, unsigned& nloc, unsigned& nx) {
    const unsigned G = gridDim.x * gridDim.y * gridDim.z;
    unsigned sum, cnt, mine, sp = 0u;
    for (;;) {
        sum = 0u; cnt = 0u; mine = 0u;
#pragma unroll
        for (unsigned j = 0; j < 16; ++j) { const unsigned c = xb_ld(&bar[XB_XCNT(j)]); sum += c; cnt += (c > 0u) ? 1u : 0u; mine = (j == x) ? c : mine; }
        if (sum == G) break;
        __builtin_amdgcn_s_sleep(1);
        if ((++sp & 255u) == 0u) { if (xb_ld(&bar[XB_TMO])) break; if (sp > XB_SPIN_CAP) { atomicAdd(&bar[XB_TMO], 1u); break; } }
    }
    nloc = mine > 0u ? mine : 1u; nx = cnt > 0u ? cnt : 1u;
}

__device__ __forceinline__ void xcd_barrier(const XcdBarrier& b) {
    asm volatile("s_waitcnt vmcnt(0)" ::: "memory");
    __syncthreads();
    if (tidx() == 0) {
        unsigned* bar = b.bar;
        __builtin_amdgcn_s_waitcnt(0);
        unsigned nloc = b.st[0], nx = b.st[1];
        if (nloc == 0u) { xcd_barrier_complete(bar, b.x, nloc, nx); b.st[0] = nloc; b.st[1] = nx; }
        const unsigned old = xb_add(&bar[XB_XSUB(b.x)], 1u);
        const unsigned gen = old / nloc;
        if (old + 1u == (gen + 1u) * nloc) {
            __builtin_amdgcn_fence(__ATOMIC_RELEASE, "agent");
            asm volatile("s_waitcnt vmcnt(0)" ::: "memory");
            const unsigned og = xb_add(&bar[XB_TOP], 1u);
            const unsigned tg = og / nx;
            if (og + 1u == (tg + 1u) * nx) xb_add(&bar[XB_TOPGEN], 1u);
            else XB_SPIN(xb_ld(&bar[XB_TOPGEN]) == tg, bar);
            __builtin_amdgcn_fence(__ATOMIC_ACQUIRE, "agent");
            xb_add(&bar[XB_XGEN(b.x)], 1u);
            asm volatile("s_waitcnt vmcnt(0)" ::: "memory");
        } else {
            XB_SPIN(xb_ld(&bar[XB_XGEN(b.x)]) == gen, bar);
            __builtin_amdgcn_fence(__ATOMIC_ACQUIRE, "agent");
            asm volatile("s_waitcnt vmcnt(0)" ::: "memory");
        }
    }
    __syncthreads();
}

DEVI float wave_sum(float v) {
#pragma unroll
    for (int o = 32; o > 0; o >>= 1) v += __shfl_xor(v, o, 64);
    return v;
}
DEVI float wave_max(float v) {
#pragma unroll
    for (int o = 32; o > 0; o >>= 1) v = fmaxf(v, __shfl_xor(v, o, 64));
    return v;
}
DEVI float sigm(float x) { return 1.f / (1.f + expf(-x)); }
DEVI float gelu_t(float x) { return 0.5f * x * (1.f + tanhf(0.7978845608028654f * (x + 0.044715f * x * x * x))); }
DEVI float softplus_(float x) { return fmaxf(x, 0.f) + log1pf(expf(-fabsf(x))); }

DEVI float block_sum256(float v, float* red, int tid) {
    v = wave_sum(v);
    __syncthreads();
    if ((tid & 63) == 0) red[tid >> 6] = v;
    __syncthreads();
    return red[0] + red[1] + red[2] + red[3];
}

DEVI void ln_kernel(const float* xres, float alpha, const float* add, const float* __restrict__ g, const float* __restrict__ bt,
                    float* out, bf16* outb, int bid, float* sm) {
    __syncthreads();
    const size_t row = bid;
    const int tid = tidx() & 255;
    float v[4];
#pragma unroll
    for (int i = 0; i < 4; ++i) {
        const size_t idx = row * DM + tid + i * 256;
        v[i] = alpha * xres[idx] + (add ? add[idx] : 0.f);
    }
    const float mean = block_sum256(v[0] + v[1] + v[2] + v[3], sm, tid) * (1.f / DM);
    float q = 0.f;
#pragma unroll
    for (int i = 0; i < 4; ++i) { v[i] -= mean; q += v[i] * v[i]; }
    const float var = block_sum256(q, sm, tid) * (1.f / DM);
    const float rstd = rsqrtf(var + 1e-5f);
#pragma unroll
    for (int i = 0; i < 4; ++i) {
        const int c = tid + i * 256;
        const float o = v[i] * rstd * g[c] + bt[c];
        out[row * DM + c] = o;
        outb[row * DM + c] = (bf16)f2bf(o);
    }
}

struct GemmArgs {
    const float* A; const float* B; float* C; const int* rowidx; const int* zoff;
    long lda, sbk, sbn, ldc, sAz0, sAz1, sBz0, sBz1, sCz0, sCz1;
    int M, N, K, Z1, epi, pad;
};
DEVI void gemm_f32(const GemmArgs& g, int bx, int by, int z, bool live, float* sm) {
    float (*As)[68] = (float (*)[68])sm;
    float (*Bs)[68] = (float (*)[68])(sm + 16 * 68);
    const int z0 = z / g.Z1, z1 = z % g.Z1;
    int mbeg = 0, mend = g.M;
    if (g.zoff) { mbeg = g.zoff[z]; mend = g.zoff[z + 1]; }
    const int m0 = mbeg + by * 64;
    if (!live) mend = 0;
    const int n0 = bx * 64;
    const float* A = g.A + z0 * g.sAz0 + z1 * g.sAz1;
    const float* B = g.B + z0 * g.sBz0 + z1 * g.sBz1;
    float* C = g.C + z0 * g.sCz0 + z1 * g.sCz1;
    const int tid = tidx() & 255, tx = tid & 15, ty = tid >> 4;
    float acc[4][4];
#pragma unroll
    for (int i = 0; i < 4; ++i)
#pragma unroll
        for (int j = 0; j < 4; ++j) acc[i][j] = 0.f;
    long arow[4];
#pragma unroll
    for (int i = 0; i < 4; ++i) {
        const int r = (tid + i * 256) >> 4;
        const int row = m0 + r;
        if (row < mend) arow[i] = (long)(g.rowidx ? g.rowidx[row] : row) * g.lda; else arow[i] = -1;
    }
    __syncthreads();
    for (int k0 = 0; k0 < g.K; k0 += 16) {
#pragma unroll
        for (int i = 0; i < 4; ++i) {
            const int e = tid + i * 256, r = e >> 4, kk = e & 15;
            float v = 0.f;
            if (arow[i] >= 0 && k0 + kk < g.K) v = A[arow[i] + k0 + kk];
            As[kk][r] = v;
        }
#pragma unroll
        for (int i = 0; i < 4; ++i) {
            const int e = tid + i * 256, kk = e >> 6, n = e & 63;
            float v = 0.f;
            if (m0 < mend && n0 + n < g.N && k0 + kk < g.K) v = B[(long)(k0 + kk) * g.sbk + (long)(n0 + n) * g.sbn];
            Bs[kk][n] = v;
        }
        __syncthreads();
#pragma unroll
        for (int kk = 0; kk < 16; ++kk) {
            float a[4], b[4];
#pragma unroll
            for (int i = 0; i < 4; ++i) a[i] = As[kk][ty * 4 + i];
#pragma unroll
            for (int j = 0; j < 4; ++j) b[j] = Bs[kk][tx * 4 + j];
#pragma unroll
            for (int i = 0; i < 4; ++i)
#pragma unroll
                for (int j = 0; j < 4; ++j) acc[i][j] = fmaf(a[i], b[j], acc[i][j]);
        }
        __syncthreads();
    }
#pragma unroll
    for (int i = 0; i < 4; ++i) {
        const int row = m0 + ty * 4 + i;
        if (row >= mend) continue;
#pragma unroll
        for (int j = 0; j < 4; ++j) {
            const int col = n0 + tx * 4 + j;
            if (col >= g.N) continue;
            float* p = C + (long)row * g.ldc + col;
            float v = acc[i][j];
            if (g.epi == 2) { ((bf16*)C)[(long)row * g.ldc + col] = (bf16)f2bf(v); continue; }
            if (g.epi == 3) { ((bf16*)C)[(long)(row >> 9) * 64 * 512 + (long)col * 512 + (row & 511)] = (bf16)f2bf(v); continue; }
            if (g.epi == 1) { v = v * sigm(v) * (*p); }
            *p = v;
        }
    }
}
DEVI GemmArgs mk(const float* A, long lda, const float* B, long sbk, long sbn, float* C, long ldc, int M, int N, int K,
                 int Z1 = 1, long sAz0 = 0, long sAz1 = 0, long sBz0 = 0, long sBz1 = 0, long sCz0 = 0, long sCz1 = 0,
                 const int* rowidx = nullptr, const int* zoff = nullptr, int epi = 0) {
    GemmArgs g;
    g.A = A; g.B = B; g.C = C; g.rowidx = rowidx; g.zoff = zoff;
    g.lda = lda; g.sbk = sbk; g.sbn = sbn; g.ldc = ldc;
    g.sAz0 = sAz0; g.sAz1 = sAz1; g.sBz0 = sBz0; g.sBz1 = sBz1; g.sCz0 = sCz0; g.sCz1 = sCz1;
    g.M = M; g.N = N; g.K = K; g.Z1 = Z1; g.epi = epi; g.pad = 0;
    return g;
}
DEVI int gemm_tiles(const GemmArgs& g, int maxM, int Z) { return ((g.N + 63) / 64) * ((maxM + 63) / 64) * Z; }
DEVI bool gemm_tile_live(const GemmArgs& g, int maxM, int t) {
    const int nbx = (g.N + 63) / 64, nby = (maxM + 63) / 64;
    const int r = t / nbx, by = r % nby, z = r / nby;
    int mbeg = 0, mend = g.M;
    if (g.zoff) { mbeg = g.zoff[z]; mend = g.zoff[z + 1]; }
    return mbeg + by * 64 < mend;
}
DEVI void gemm_tile(const GemmArgs& g, int maxM, int t, bool live, float* sm) {
    const int nbx = (g.N + 63) / 64, nby = (maxM + 63) / 64;
    const int bx = t % nbx, r = t / nbx;
    gemm_f32(g, bx, r % nby, r / nby, live, sm);
}

DEVI void glu_kernel(const bf16* __restrict__ cols, float* __restrict__ h, int bid) {
    const size_t t = bid; const int c = tidx() & 255;
    h[t * 256 + c] = bf2f(cols[t * DINP + OFF_CV + c]) * sigm(bf2f(cols[t * DINP + OFF_CG + c]));
}
DEVI void conv_kernel(const float* __restrict__ h, const float* __restrict__ w, const float* __restrict__ bias,
                      const float* __restrict__ gg, const float* __restrict__ gb, bf16* __restrict__ mix, int bid) {
    const int t = bid, c = tidx() & 255;
    float acc = bias[c];
#pragma unroll 4
    for (int j = 0; j < 31; ++j) {
        const int tt = t - 30 + j;
        if (tt >= 0) acc = fmaf(h[(size_t)tt * 256 + c], w[j * 256 + c], acc);
    }
    const float mean = wave_sum(acc) * (1.f / 64.f);
    const float d = acc - mean;
    const float var = wave_sum(d * d) * (1.f / 64.f);
    const float y = d * rsqrtf(var + 1e-5f) * gg[c] + gb[c];
    mix[(size_t)t * DM + 0 + c] = (bf16)f2bf(y * sigm(y));
}

DEVI void gmlp_pre(const bf16* __restrict__ cols, const float* __restrict__ lg, const float* __restrict__ lb,
                   float* __restrict__ ub, float* __restrict__ vb, int bid, float* sm) {
    __syncthreads();
    const size_t t = bid; const int c = tidx() & 255;
    ub[t * 256 + c] = gelu_t(bf2f(cols[t * DINP + OFF_GU + c]));
    const float v = gelu_t(bf2f(cols[t * DINP + OFF_GV + c]));
    const float mean = block_sum256(v, sm, c) * (1.f / 256.f);
    const float d = v - mean;
    const float var = block_sum256(d * d, sm, c) * (1.f / 256.f);
    vb[t * 256 + c] = d * rsqrtf(var + 1e-5f) * lg[c] + lb[c];
}
DEVI void gmlp_mix(const float* __restrict__ ub, const float* __restrict__ vb, const float* __restrict__ ws,
                   const float* __restrict__ bs, bf16* __restrict__ mix, int bid) {
    const int t = bid, c = tidx() & 255, h = c >> 6, tt = t & 127, base = t - tt;
    float acc = bs[h * 128 + tt];
    const float* wr = ws + ((size_t)h * 128 + tt) * 128;
#pragma unroll 4
    for (int s = 0; s <= tt; ++s) acc = fmaf(wr[s], vb[(size_t)(base + s) * 256 + c], acc);
    mix[(size_t)t * DM + 512 + c] = (bf16)f2bf(ub[(size_t)t * 256 + c] * acc);
}

struct RwkvP {
    const bf16* cols; const float* mu; const float* w0; const float* w_up; const float* a0; const float* a_up; const float* g_up;
    const float* k_k; const float* k_a; const float* r_k; const float* vd; const float* v_mu; const float* v0; const float* v_up;
    float* vfirst; bf16* R; float* LW; bf16* K; bf16* V; bf16* A; bf16* Bv; float* G; float* BON;
    int layer, pad;
};
DEVI void rwkv_prep(const RwkvP& p, int bid, float* sm) {
    __syncthreads();
    float* y = sm;
    float* vds = sm + 1024;
    const int t = bid, c = tidx() & 255;
#pragma unroll
    for (int q = 0; q < 4; ++q) {
        const int j = c + q * 256;
        const float cur = bf2f(p.cols[(size_t)t * DINP + OFF_RW + j]);
        const float prv = t > 0 ? bf2f(p.cols[(size_t)(t - 1) * DINP + OFF_RW + j]) : 0.f;
        y[j] = cur + p.mu[j] * (prv - cur);
    }
    if (p.layer > 0 && c < 32) {
        const float cur = bf2f(p.cols[(size_t)t * DINP + DIN + c]);
        const float prv = t > 0 ? bf2f(p.cols[(size_t)(t - 1) * DINP + DIN + c]) : 0.f;
        vds[c] = cur + p.v_mu[c] * (prv - cur);
    }
    __syncthreads();
    float tw = 0.f, sg = 0.f;
    if (c < 64) tw = tanhf(y[768 + c]);
    if (c >= 128) sg = sigm(y[896 + (c - 128)]);
    __syncthreads();
    if (c < 64) y[768 + c] = tw;
    if (c >= 128) y[896 + (c - 128)] = sg;
    __syncthreads();
    const float r = y[c], k = y[256 + c];
    float v = y[512 + c];
    float wl = p.w0[c], al = p.a0[c], gl = 0.f;
#pragma unroll 4
    for (int j = 0; j < 64; ++j) { wl = fmaf(y[768 + j], p.w_up[j * 256 + c], wl); al = fmaf(y[832 + j], p.a_up[j * 256 + c], al); }
#pragma unroll 4
    for (int j = 0; j < 128; ++j) gl = fmaf(y[896 + j], p.g_up[j * 256 + c], gl);
    const float wlog = -softplus_(-wl) - 0.5f;
    const float a = sigm(al);
    if (p.layer == 0) {
        p.vfirst[(size_t)t * 256 + c] = v;
    } else {
        float vm = p.v0[c];
#pragma unroll 4
        for (int j = 0; j < 32; ++j) vm = fmaf(vds[j], p.v_up[j * 256 + c], vm);
        vm = sigm(vm);
        v = v + (p.vfirst[(size_t)t * 256 + c] - v) * vm;
    }
    float kk = k * p.k_k[c];
    const float nrm = sqrtf(wave_sum(kk * kk));
    kk = kk / fmaxf(nrm, 1e-12f);
    const float k2 = k * (1.f + (a - 1.f) * p.k_a[c]);
    const float bd = wave_sum(r * k2 * p.r_k[c]);
    const size_t o = (size_t)t * 256 + c;
    p.R[o] = (bf16)f2bf(r); p.LW[o] = -expf(wlog); p.K[o] = (bf16)f2bf(k2); p.V[o] = (bf16)f2bf(v); p.A[o] = (bf16)f2bf(-kk); p.Bv[o] = (bf16)f2bf(kk * a); p.G[o] = gl; p.BON[o] = bd * v;
}
DEVI void rwkv_scan(float* R, const float* __restrict__ W, const float* __restrict__ K, const float* __restrict__ V,
                    const float* __restrict__ A, const float* __restrict__ Bv, float* sm0) {
    float (*sr)[256] = (float (*)[256])sm0, (*sw)[256] = sr + 4, (*sk)[256] = sr + 8, (*sa)[256] = sr + 12, (*sb)[256] = sr + 16, (*sv)[256] = sr + 20;
    const int vt = tidx(); const bool act = vt < 256;
    const int tid = vt & 255, h = tid >> 6, lane = tid & 63;
    float st[64];
#pragma unroll
    for (int i = 0; i < 64; ++i) st[i] = 0.f;
    for (int t0 = 0; t0 < SEQ; t0 += 4) {
        __syncthreads();
        if (act) {
#pragma unroll
            for (int s = 0; s < 4; ++s) {
                const size_t idx = (size_t)(t0 + s) * 256 + tid;
                sr[s][tid] = R[idx]; sw[s][tid] = W[idx]; sk[s][tid] = K[idx]; sa[s][tid] = A[idx]; sb[s][tid] = Bv[idx]; sv[s][tid] = V[idx];
            }
        }
        __syncthreads();
        if (act) {
#pragma unroll 1
            for (int s = 0; s < 4; ++s) {
                const float vt_ = sv[s][tid];
                const float* pa = &sa[s][h * 64]; const float* pw = &sw[s][h * 64]; const float* pb = &sb[s][h * 64];
                const float* pk = &sk[s][h * 64]; const float* pr = &sr[s][h * 64];
                float sa_ = 0.f;
#pragma unroll
                for (int k = 0; k < 64; ++k) sa_ = fmaf(st[k], pa[k], sa_);
#pragma unroll
                for (int k = 0; k < 64; ++k) st[k] = fmaf(st[k], pw[k], fmaf(sa_, pb[k], vt_ * pk[k]));
                float o = 0.f;
#pragma unroll
                for (int k = 0; k < 64; ++k) o = fmaf(st[k], pr[k], o);
                R[(size_t)(t0 + s) * 256 + h * 64 + lane] = o;
            }
        }
    }
    __syncthreads();
}
DEVI void rwkv_post(const float* __restrict__ O, const float* __restrict__ BON, const float* __restrict__ G,
                    const float* __restrict__ gg, const float* __restrict__ gb, bf16* __restrict__ mix, int bid) {
    const size_t t = bid; const int c = tidx() & 255;
    const float o = O[t * 256 + c];
    const float mean = wave_sum(o) * (1.f / 64.f);
    const float d = o - mean;
    const float var = wave_sum(d * d) * (1.f / 64.f);
    const float y = d * rsqrtf(var + 64e-5f) * gg[c] + gb[c];
    mix[t * DM + 256 + c] = (bf16)f2bf((y + BON[t * 256 + c]) * G[t * 256 + c]);
}

DEVI void nsa_prep(const bf16* __restrict__ cols, float* __restrict__ qrot, float* __restrict__ ksr,
                   float* __restrict__ kwr, float* __restrict__ gates, int bid) {
    const int t = bid, c = tidx() & 255;
    const int d = c & 63, j = d & 31;
    const float inv = powf(10000.f, -(float)j / 32.f);
    const float ang = (float)t * inv;
    float sn, cs; sincosf(ang, &sn, &cs);
    {
        const bf16* q = cols + (size_t)t * DINP + OFF_Q + (c & ~63);
        const float x1 = bf2f(q[j]), x2 = bf2f(q[j + 32]);
        qrot[(size_t)t * 256 + c] = d < 32 ? x1 * cs - x2 * sn : x2 * cs + x1 * sn;
    }
    if (c < 128) {
        const bf16* kp = cols + (size_t)t * DINP + (c < 64 ? OFF_KS : OFF_KW);
        const float x1 = bf2f(kp[j]), x2 = bf2f(kp[j + 32]);
        const float v = d < 32 ? x1 * cs - x2 * sn : x2 * cs + x1 * sn;
        if (c < 64) ksr[(size_t)t * 64 + d] = v; else kwr[(size_t)t * 64 + d] = v;
    }
    if (c < 12) gates[(size_t)t * 12 + c] = sigm(bf2f(cols[(size_t)t * DINP + OFF_GT + c]));
}
DEVI void cmp_gather(const bf16* __restrict__ cols, const float* __restrict__ pek, const float* __restrict__ pev,
                     bf16* __restrict__ bk, bf16* __restrict__ bv, int bid) {
    const int n = bid, tid = tidx() & 255;
    for (int i = tid; i < 2048; i += 256) {
        const int l = i >> 6, d = i & 63;
        const size_t row = (size_t)(16 * n + l) * DINP;
        bk[(size_t)n * 2048 + i] = n < NCMP ? (bf16)f2bf(bf2f(cols[row + OFF_KC + d]) + pek[i]) : (bf16)0;
        bv[(size_t)n * 2048 + i] = n < NCMP ? (bf16)f2bf(bf2f(cols[row + OFF_VC + d]) + pev[i]) : (bf16)0;
    }
}
DEVI void gelu_inplace(float* p, int n, int bid) {
    const int i = bid * 256 + (tidx() & 255);
    if (i < n) p[i] = gelu_t(p[i]);
}

DEVI void wave_softmax(float* s, int n, int lane) {
    float m = -INFINITY;
    for (int i = lane; i < n; i += 64) m = fmaxf(m, s[i]);
    m = wave_max(m);
    if (m == -INFINITY) { for (int i = lane; i < n; i += 64) s[i] = 0.f; return; }
    float sum = 0.f;
    for (int i = lane; i < n; i += 64) { const float p = expf(s[i] - m); s[i] = p; sum += p; }
    sum = wave_sum(sum);
    const float inv = 1.f / fmaxf(sum, 1e-20f);
    for (int i = lane; i < n; i += 64) s[i] *= inv;
}
DEVI void dot4(const float* q  , const float* __restrict__ krow, float* out4) {
    float a0 = 0.f, a1 = 0.f, a2 = 0.f, a3 = 0.f;
#pragma unroll
    for (int d = 0; d < 64; d += 4) {
        const float4 kv = *(const float4*)(krow + d);
        a0 += q[d] * kv.x + q[d + 1] * kv.y + q[d + 2] * kv.z + q[d + 3] * kv.w;
        a1 += q[64 + d] * kv.x + q[64 + d + 1] * kv.y + q[64 + d + 2] * kv.z + q[64 + d + 3] * kv.w;
        a2 += q[128 + d] * kv.x + q[128 + d + 1] * kv.y + q[128 + d + 2] * kv.z + q[128 + d + 3] * kv.w;
        a3 += q[192 + d] * kv.x + q[192 + d + 1] * kv.y + q[192 + d + 2] * kv.z + q[192 + d + 3] * kv.w;
    }
    out4[0] = a0; out4[1] = a1; out4[2] = a2; out4[3] = a3;
}
DEVI void nsa_attn(const bf16* __restrict__ cols, const float* __restrict__ qrot, const float* __restrict__ ksr,
                   const float* __restrict__ kwr, const float* __restrict__ gates, const float* __restrict__ kcmp,
                   const float* __restrict__ vcmp, bf16* __restrict__ mix, int bid, float* sm) {
    __syncthreads();
    float* q = sm; float* qr = sm + 256;
    float (*sc)[1024] = (float (*)[1024])(sm + 512);
    float* imp = sm + 512 + 4096;
    int* sel = (int*)(sm + 512 + 4096 + 128);
    const int pos = bid, tid = tidx() & 255, h = tid >> 6, lane = tid & 63;
    q[tid] = bf2f(cols[(size_t)pos * DINP + OFF_Q + tid]);
    qr[tid] = qrot[(size_t)pos * 256 + tid];
    __syncthreads();
    int ncv = pos >= 31 ? (pos - 31) / 16 + 1 : 0;
    if (ncv > NCMP) ncv = NCMP;
    for (int n = tid; n < 512; n += 256) {
        if (n < ncv) {
            float d4[4]; dot4(q, kcmp + (size_t)n * 64, d4);
            sc[0][n] = d4[0] * 0.125f; sc[1][n] = d4[1] * 0.125f; sc[2][n] = d4[2] * 0.125f; sc[3][n] = d4[3] * 0.125f;
        } else { sc[0][n] = 0.f; sc[1][n] = 0.f; sc[2][n] = 0.f; sc[3][n] = 0.f; }
    }
    __syncthreads();
    wave_softmax(sc[h], ncv, lane);
    __syncthreads();
    float oc = 0.f;
#pragma unroll 4
    for (int n = 0; n < ncv; ++n) oc = fmaf(sc[h][n], vcmp[(size_t)n * 64 + lane], oc);
    if (tid < 128) {
        const int j = tid;
        auto ps = [&](int n) -> float { return (n >= 0 && n < 512) ? (sc[0][n] + sc[1][n] + sc[2][n] + sc[3][n]) : 0.f; };
        const float v = 0.5f * ps(4 * j - 1) + ps(4 * j) + ps(4 * j + 1) + ps(4 * j + 2) + 0.5f * ps(4 * j + 3);
        const int cur = pos >> 6;
        float key;
        if (j == cur || j == 0) key = INFINITY; else if (j <= cur) key = v; else key = -1.f;
        imp[j] = key;
    }
    __syncthreads();
    if (h == 0) {
        float v0 = imp[lane], v1 = imp[lane + 64];
        for (int r = 0; r < 16; ++r) {
            float bv; int bi;
            if (v1 > v0) { bv = v1; bi = lane + 64; } else { bv = v0; bi = lane; }
#pragma unroll
            for (int o = 32; o > 0; o >>= 1) {
                const float ov = __shfl_xor(bv, o, 64); const int oi = __shfl_xor(bi, o, 64);
                if (ov > bv || (ov == bv && oi < bi)) { bv = ov; bi = oi; }
            }
            if (lane == 0) sel[r] = bi;
            if (bi == lane) v0 = -2.f;
            if (bi == lane + 64) v1 = -2.f;
        }
    }
    __syncthreads();
    for (int i = tid; i < 1024; i += 256) {
        const int kp = sel[i >> 6] * 64 + (i & 63);
        if (kp <= pos) {
            float d4[4]; dot4(qr, ksr + (size_t)kp * 64, d4);
            sc[0][i] = d4[0] * 0.125f; sc[1][i] = d4[1] * 0.125f; sc[2][i] = d4[2] * 0.125f; sc[3][i] = d4[3] * 0.125f;
        } else { sc[0][i] = -INFINITY; sc[1][i] = -INFINITY; sc[2][i] = -INFINITY; sc[3][i] = -INFINITY; }
    }
    __syncthreads();
    wave_softmax(sc[h], 1024, lane);
    __syncthreads();
    float os = 0.f;
#pragma unroll 2
    for (int i = 0; i < 1024; ++i) {
        const float p = sc[h][i];
        if (p != 0.f) { const int kp = sel[i >> 6] * 64 + (i & 63); os = fmaf(p, bf2f(cols[(size_t)kp * DINP + OFF_VS + lane]), os); }
    }
    __syncthreads();
    for (int i = tid; i < 512; i += 256) {
        const int kp = pos - 511 + i;
        if (kp >= 0) {
            float d4[4]; dot4(qr, kwr + (size_t)kp * 64, d4);
            sc[0][i] = d4[0] * 0.125f; sc[1][i] = d4[1] * 0.125f; sc[2][i] = d4[2] * 0.125f; sc[3][i] = d4[3] * 0.125f;
        } else { sc[0][i] = -INFINITY; sc[1][i] = -INFINITY; sc[2][i] = -INFINITY; sc[3][i] = -INFINITY; }
    }
    __syncthreads();
    wave_softmax(sc[h], 512, lane);
    __syncthreads();
    float ow = 0.f;
#pragma unroll 4
    for (int i = 0; i < 512; ++i) {
        const int kp = pos - 511 + i;
        if (kp >= 0) ow = fmaf(sc[h][i], bf2f(cols[(size_t)kp * DINP + OFF_VW + lane]), ow);
    }
    const float* gt = gates + (size_t)pos * 12 + h * 3;
    mix[(size_t)pos * DM + 768 + tid] = (bf16)f2bf(gt[0] * oc + gt[1] * os + gt[2] * ow);
}

DEVI void softmax256(float* s, float scale, int bid, float* sm) {
    __syncthreads();
    const size_t row = bid; const int tid = tidx() & 255;
    const float v = s[row * 256 + tid] * scale;
    float m = wave_max(v);
    if ((tid & 63) == 0) sm[8 + (tid >> 6)] = m;
    __syncthreads();
    m = fmaxf(fmaxf(sm[8], sm[9]), fmaxf(sm[10], sm[11]));
    const float p = expf(v - m);
    const float sum = block_sum256(p, sm, tid);
    s[row * 256 + tid] = p / sum;
}

DEVI void router_kernel(const float* __restrict__ x, const float* __restrict__ rw, const float* __restrict__ rb,
                        int* __restrict__ te, float* __restrict__ tw, int bid, float* sm) {
    __syncthreads();
    float (*part)[16] = (float (*)[16])sm;
    const size_t t = bid; const int tid = tidx() & 255;
    float acc[16];
#pragma unroll
    for (int e = 0; e < 16; ++e) acc[e] = 0.f;
#pragma unroll 1
    for (int i = tid; i < DM; i += 256) {
        const float xv = x[t * DM + i];
#pragma unroll
        for (int e = 0; e < 16; ++e) acc[e] = fmaf(xv, rw[i * 16 + e], acc[e]);
    }
#pragma unroll
    for (int e = 0; e < 16; ++e) acc[e] = wave_sum(acc[e]);
    if ((tid & 63) == 0) {
#pragma unroll
        for (int e = 0; e < 16; ++e) part[tid >> 6][e] = acc[e];
    }
    __syncthreads();
    if (tid == 0) {
        float lg[16], pr[16], sl[16];
        float m = -INFINITY;
#pragma unroll
        for (int e = 0; e < 16; ++e) { lg[e] = part[0][e] + part[1][e] + part[2][e] + part[3][e]; m = fmaxf(m, lg[e]); }
        float sum = 0.f;
#pragma unroll
        for (int e = 0; e < 16; ++e) { pr[e] = expf(lg[e] - m); sum += pr[e]; }
#pragma unroll
        for (int e = 0; e < 16; ++e) { pr[e] /= sum; sl[e] = pr[e] + rb[e]; }
        int bg = 0; float bgs = -INFINITY;
#pragma unroll
        for (int gI = 0; gI < 4; ++gI) {
            float m1 = -INFINITY, m2 = -INFINITY;
#pragma unroll
            for (int j = 0; j < 4; ++j) { const float v = sl[gI * 4 + j]; if (v > m1) { m2 = m1; m1 = v; } else if (v > m2) m2 = v; }
            const float sc = m1 + m2;
            if (sc > bgs) { bgs = sc; bg = gI; }
        }
        int e0 = -1, e1 = -1; float s0 = -INFINITY, s1 = -INFINITY, p0 = 0.f, p1 = 0.f;
#pragma unroll
        for (int e = 0; e < 16; ++e) {
            if ((e >> 2) == bg) {
                const float v = sl[e];
                if (v > s0) { s1 = s0; e1 = e0; p1 = p0; s0 = v; e0 = e; p0 = pr[e]; } else if (v > s1) { s1 = v; e1 = e; p1 = pr[e]; }
            }
        }
        const float wsum = p0 + p1;
        te[t * 2] = e0; te[t * 2 + 1] = e1;
        tw[t * 2] = p0 / wsum; tw[t * 2 + 1] = p1 / wsum;
    }
}
DEVI void moe_lists(const int* __restrict__ te, int* __restrict__ off, int* __restrict__ list, int* __restrict__ slotpos, float* sm0) {
    int* cnt = (int*)sm0;
    int* offs = cnt + 16;
    const int w = tidx() >> 6, lane = tidx() & 63;
    __syncthreads();
    for (int ee = 0; ee < 2; ++ee) {
        const int e = w * 2 + ee;
        int c = 0;
        for (int base = 0; base < NTOK; base += 64) {
            const int tok = base + lane;
            const bool m = (te[tok * 2] == e) || (te[tok * 2 + 1] == e);
            c += __popcll(__ballot(m));
        }
        if (lane == 0) cnt[e] = c;
    }
    __syncthreads();
    if (tidx() == 0) {
        int s = 0;
        for (int i = 0; i < 16; ++i) { offs[i] = s; off[i] = s; s += cnt[i]; }
        offs[16] = s; off[16] = s;
    }
    __syncthreads();
    for (int ee = 0; ee < 2; ++ee) {
        const int e = w * 2 + ee;
        int pos = offs[e];
        for (int base = 0; base < NTOK; base += 64) {
            const int tok = base + lane;
            const int a = te[tok * 2], b = te[tok * 2 + 1];
            const bool m = (a == e) || (b == e);
            const unsigned long long mask = __ballot(m);
            if (m) {
                const int p = pos + __popcll(mask & ((1ull << lane) - 1ull));
                list[p] = tok;
                slotpos[tok * 2 + (a == e ? 0 : 1)] = p;
            }
            pos += __popcll(mask);
        }
    }
    __syncthreads();
}
DEVI void moe_combine_ln(const float* x, const float* __restrict__ Dp, const int* __restrict__ te,
                         const float* __restrict__ tw, const int* __restrict__ slotpos,
                         const float* __restrict__ g, const float* __restrict__ bt, float* out, bf16* outb, int bid, float* sm) {
    __syncthreads();
    const size_t t = bid; const int tid = tidx() & 255;
    int ea = te[t * 2], eb = te[t * 2 + 1];
    float wa = tw[t * 2], wb = tw[t * 2 + 1];
    size_t pa = slotpos[t * 2], pb = slotpos[t * 2 + 1];
    if (eb < ea) { const float tf = wa; wa = wb; wb = tf; const size_t tp = pa; pa = pb; pb = tp; }
    float v[4];
#pragma unroll
    for (int i = 0; i < 4; ++i) {
        const int c = tid + i * 256;
        float y = wa * Dp[pa * DM + c];
        y = y + wb * Dp[pb * DM + c];
        v[i] = ALPHA * x[t * DM + c] + y;
    }
    const float mean = block_sum256(v[0] + v[1] + v[2] + v[3], sm, tid) * (1.f / DM);
    float q = 0.f;
#pragma unroll
    for (int i = 0; i < 4; ++i) { v[i] -= mean; q += v[i] * v[i]; }
    const float var = block_sum256(q, sm, tid) * (1.f / DM);
    const float rstd = rsqrtf(var + 1e-5f);
#pragma unroll
    for (int i = 0; i < 4; ++i) {
        const int c = tid + i * 256;
        const float o = v[i] * rstd * g[c] + bt[c];
        out[t * DM + c] = o;
        outb[t * DM + c] = (bf16)f2bf(o);
    }
}
typedef short bf16x8 __attribute__((ext_vector_type(8)));
typedef short s16x4 __attribute__((ext_vector_type(4)));
typedef float f32x16 __attribute__((ext_vector_type(16)));
typedef float f32x2_t __attribute__((ext_vector_type(2)));
typedef __bf16 bf16x2_t __attribute__((ext_vector_type(2)));
DEVI unsigned cvtpk(float lo, float hi) { f32x2_t v = {lo, hi}; bf16x2_t b = __builtin_convertvector(v, bf16x2_t); return __builtin_bit_cast(unsigned, b); }
constexpr float QSCL = 0.125f * 1.4426950408889634f;

struct NsaP {
    const bf16 *QN, *QR, *KSR, *KWR, *VST, *VWT, *KCMP, *VCMPT;
    const float* GATES;
    bf16* MIX;
};
constexpr int NSA_KT = 0, NSA_VT = 16384, NSA_IA = 32768, NSA_IB = 65536, NSA_SELM = 98304, NSA_UNI = 99328;

DEVI int crow(int r, int hi) { return (r & 3) + 8 * (r >> 2) + 4 * hi; }
DEVI float max3f(float a, float b, float c) { float r; asm("v_max3_f32 %0, %1, %2, %3" : "=v"(r) : "v"(a), "v"(b), "v"(c)); return r; }
DEVI float max2f(float a, float b) { float r; asm("v_max_f32_e32 %0, %1, %2" : "=v"(r) : "v"(a), "v"(b)); return r; }
DEVI float half_max(float x) { auto rr = __builtin_amdgcn_permlane32_swap(__float_as_uint(x), __float_as_uint(x), false, false); return max2f(__uint_as_float(rr[0]), __uint_as_float(rr[1])); }
DEVI float half_sum(float x) { auto rr = __builtin_amdgcn_permlane32_swap(__float_as_uint(x), __float_as_uint(x), false, false); return __uint_as_float(rr[0]) + __uint_as_float(rr[1]); }
DEVI float quad_sum(float x) {
    x += __int_as_float(__builtin_amdgcn_update_dpp(0, __float_as_int(x), 0xB1, 0xF, 0xF, true));
    x += __int_as_float(__builtin_amdgcn_update_dpp(0, __float_as_int(x), 0x4E, 0xF, 0xF, true));
    return x;
}
DEVI float rowmax32(const f32x16& p0, const f32x16& p1) {
    float a = max3f(p0[0], p0[1], p1[0]), b = max3f(p0[2], p0[3], p1[1]); a = max3f(a, p1[2], p1[3]);
#pragma unroll
    for (int r = 4; r < 16; r += 4) { a = max3f(a, p0[r], p0[r + 1]); b = max3f(b, p0[r + 2], p0[r + 3]); a = max3f(a, p1[r], p1[r + 1]); b = max3f(b, p1[r + 2], p1[r + 3]); }
    return half_max(max2f(a, b));
}

DEVI void nsa_ld(v4u& rk, v4u& rv, const bf16* kbase, const bf16* vbase, size_t vstride, int tid) {
    rk = *(const v4u*)((const char*)kbase + tid * 16);
    rv = *(const v4u*)((const char*)(vbase + (size_t)(tid >> 3) * vstride) + (tid & 7) * 16);
}
DEVI void nsa_st(LAS unsigned char* KTb, LAS unsigned char* VTb, const v4u& rk, const v4u& rv, int tid) {
    const int r = tid >> 3, c = tid & 7, off = r * 128 + ((c ^ (r & 7)) << 4);
    *(LAS v4u*)(KTb + off) = rk; *(LAS v4u*)(VTb + off) = rv;
}
DEVI void nsa_qk(f32x16& p0, f32x16& p1, const LAS unsigned char* KTb, const bf16x8 (&qf)[4], int q32, int hi) {
#pragma unroll
    for (int r = 0; r < 16; ++r) { p0[r] = 0.f; p1[r] = 0.f; }
#pragma unroll
    for (int ks = 0; ks < 4; ++ks) {
        const int c = ((2 * ks + hi) ^ (q32 & 7)) << 4;
        const bf16x8 a0 = *(const LAS bf16x8*)(KTb + q32 * 128 + c);
        const bf16x8 a1 = *(const LAS bf16x8*)(KTb + (32 + q32) * 128 + c);
        p0 = __builtin_amdgcn_mfma_f32_32x32x16_bf16(a0, qf[ks], p0, 0, 0, 0);
        p1 = __builtin_amdgcn_mfma_f32_32x32x16_bf16(a1, qf[ks], p1, 0, 0, 0);
    }
}
DEVI void nsa_pv(f32x16 (&o)[2], const LAS unsigned char* VTb, const bf16x8 (&pf)[4], int q32, int hi) {
#pragma unroll
    for (int db = 0; db < 2; ++db) {
        const int d = 32 * db + q32;
        const LAS unsigned char* rowp = VTb + d * 128 + 8 * hi;
#pragma unroll
        for (int s = 0; s < 4; ++s) {
            const s16x4 lo = *(const LAS s16x4*)(rowp + (((2 * s) ^ (d & 7)) << 4));
            const s16x4 h4 = *(const LAS s16x4*)(rowp + (((2 * s + 1) ^ (d & 7)) << 4));
            const bf16x8 a = {lo[0], lo[1], lo[2], lo[3], h4[0], h4[1], h4[2], h4[3]};
            o[db] = __builtin_amdgcn_mfma_f32_32x32x16_bf16(a, pf[s], o[db], 0, 0, 0);
        }
    }
}
DEVI void nsa_pack(bf16x8 (&pf)[4], const f32x16& p0, const f32x16& p1) {
#pragma unroll
    for (int s = 0; s < 2; ++s) {
        unsigned w0[4], w1[4];
#pragma unroll
        for (int j = 0; j < 4; ++j) { w0[j] = cvtpk(p0[8 * s + 2 * j], p0[8 * s + 2 * j + 1]); w1[j] = cvtpk(p1[8 * s + 2 * j], p1[8 * s + 2 * j + 1]); }
        pf[s] = __builtin_bit_cast(bf16x8, (v4u){w0[0], w0[1], w0[2], w0[3]});
        pf[2 + s] = __builtin_bit_cast(bf16x8, (v4u){w1[0], w1[1], w1[2], w1[3]});
    }
}
DEVI void nsa_softmax(f32x16& p0, f32x16& p1, float& m, float& l, f32x16 (&o)[2], bf16x8 (&pf)[4]) {
    typedef float f2 __attribute__((ext_vector_type(2)));
    const float mx = rowmax32(p0, p1);
    if (__any(mx > m + 8.f)) {
        const float mn = fmaxf(m, mx);
        const float msn = (mn == -INFINITY) ? 0.f : mn;
        const float alpha = __builtin_amdgcn_exp2f(m - msn);
        l *= alpha; m = mn;
#pragma unroll
        for (int r = 0; r < 16; ++r) { o[0][r] *= alpha; o[1][r] *= alpha; }
    }
    const float ms = (m == -INFINITY) ? 0.f : m;
    f2 sum = {0.f, 0.f};
#pragma unroll
    for (int r = 0; r < 16; r += 2) {
        f2 x0 = {p0[r], p0[r + 1]}, x1 = {p1[r], p1[r + 1]};
        x0 = x0 - ms; x1 = x1 - ms;
        x0.x = __builtin_amdgcn_exp2f(x0.x); x0.y = __builtin_amdgcn_exp2f(x0.y); x1.x = __builtin_amdgcn_exp2f(x1.x); x1.y = __builtin_amdgcn_exp2f(x1.y);
        sum = sum + x0 + x1;
        p0[r] = x0.x; p0[r + 1] = x0.y; p1[r] = x1.x; p1[r + 1] = x1.y;
    }
    l += half_sum(sum.x + sum.y);
    nsa_pack(pf, p0, p1);
}
DEVI void nsa_loadq(bf16x8 (&qf)[4], const bf16* Q, int tq, int head, int hi) {
    const bf16* qp = Q + (size_t)tq * 256 + head * 64 + 8 * hi;
#pragma unroll
    for (int ks = 0; ks < 4; ++ks) qf[ks] = *(const bf16x8*)(qp + 16 * ks);
}


#define NSA_PIPE(NT_, KP_, VP_, VSTR_, ...) do { \
    const int nt_ = (NT_); v4u rk0_, rv0_, rk1_, rv1_; \
    if (nt_ > 0) nsa_ld(rk0_, rv0_, KP_(0), VP_(0), VSTR_, tid); \
    if (nt_ > 1) nsa_ld(rk1_, rv1_, KP_(1), VP_(1), VSTR_, tid); \
    __syncthreads(); \
    if (nt_ > 0) nsa_st(KT, VT, rk0_, rv0_, tid); \
    __syncthreads(); \
    if (nt_ > 2) nsa_ld(rk0_, rv0_, KP_(2), VP_(2), VSTR_, tid); \
    for (int it0_ = 0; it0_ < nt_; it0_ += 2) { \
        { const int it_ = it0_; const int bo_ = 0; __VA_ARGS__ } \
        if (it0_ + 1 < nt_) nsa_st(KT + 8192, VT + 8192, rk1_, rv1_, tid); \
        __syncthreads(); \
        if (it0_ + 3 < nt_) nsa_ld(rk1_, rv1_, KP_(it0_ + 3), VP_(it0_ + 3), VSTR_, tid); \
        if (it0_ + 1 >= nt_) break; \
        { const int it_ = it0_ + 1; const int bo_ = 8192; __VA_ARGS__ } \
        if (it0_ + 2 < nt_) nsa_st(KT, VT, rk0_, rv0_, tid); \
        __syncthreads(); \
        if (it0_ + 4 < nt_) nsa_ld(rk0_, rv0_, KP_(it0_ + 4), VP_(it0_ + 4), VSTR_, tid); \
    } } while (0)

DEVI void nsa_unit(const NsaP& P, int u, LAS unsigned char* lds) {
    const int tid = tidx(), w = tid >> 6, lane = tid & 63, q32 = lane & 31, hi = lane >> 5;
    const int t0 = u * 64, cur = u;
    const int tl = 8 * w + (q32 >> 2), head = q32 & 3, tq = t0 + tl;
    LAS unsigned char* KT = lds + NSA_KT; LAS unsigned char* VT = lds + NSA_VT;
    LAS float* IA = (LAS float*)(lds + NSA_IA); LAS float* IB = (LAS float*)(lds + NSA_IB);
    LAS unsigned* SELM = (LAS unsigned*)(lds + NSA_SELM); LAS unsigned* UNI = (LAS unsigned*)(lds + NSA_UNI);
    __syncthreads();
    for (int i = tid; i < 2 * 64 * 128; i += 512) IA[i] = 0.f;
    if (tid < 4) UNI[tid] = 0u;
    LAS float* ACC = (LAS float*)(lds + NSA_IA) + (w * 32) * 64 + lane;
    bf16x8 qf[4], pf[4];
    f32x16 o[2], p0, p1;

    {
        nsa_loadq(qf, P.QN, tq, head, hi);
        const int nlim = tq >= 31 ? (tq - 31) >> 4 : -1;
        const int nmaxu = (t0 + 63 - 31) >> 4;
        const int nct = (nmaxu >> 6) + 1;
        float m = -INFINITY, l = 0.f;
        for (int pass = 0; pass < 2; ++pass) {
#pragma unroll
            for (int r = 0; r < 16; ++r) { o[0][r] = 0.f; o[1][r] = 0.f; }
            const float rl = (pass == 1 && l > 0.f) ? 1.f / l : 0.f;
#define KPC_(i) (P.KCMP + (size_t)(i) * 64 * 64)
#define VPC_(i) (P.VCMPT + (i) * 64)
            NSA_PIPE(nct, KPC_, VPC_, 512, {
                nsa_qk(p0, p1, KT + bo_, qf, q32, hi);
                const int nb = it_ * 64;
                if (__any(nb + 63 > nlim)) {
                    const int lim = nlim - nb - 4 * hi;
_Pragma("unroll")
                    for (int r = 0; r < 16; ++r) { const int c0 = (r & 3) + 8 * (r >> 2); if (c0 > lim) p0[r] = -INFINITY; if (c0 + 32 > lim) p1[r] = -INFINITY; }
                }
                if (pass == 0) {
                    const float mx = rowmax32(p0, p1);
                    const float mn = fmaxf(m, mx), ms = (mn == -INFINITY) ? 0.f : mn;
                    float sum = 0.f;
_Pragma("unroll")
                    for (int r = 0; r < 16; ++r) sum += __builtin_amdgcn_exp2f(p0[r] - ms) + __builtin_amdgcn_exp2f(p1[r] - ms);
                    sum = half_sum(sum);
                    l = l * __builtin_amdgcn_exp2f(m - ms) + sum; m = mn;
                } else {
                    const float ms = (m == -INFINITY) ? 0.f : m;
_Pragma("unroll")
                    for (int r = 0; r < 16; ++r) { p0[r] = __builtin_amdgcn_exp2f(p0[r] - ms) * rl; p1[r] = __builtin_amdgcn_exp2f(p1[r] - ms) * rl; }
_Pragma("unroll")
                    for (int half = 0; half < 2; ++half) {
_Pragma("unroll")
                        for (int g = 0; g < 4; ++g) {
                            const f32x16& pp = half ? p1 : p0;
                            float a = pp[4 * g] + pp[4 * g + 1] + pp[4 * g + 2] + 0.5f * pp[4 * g + 3];
                            float b = 0.5f * pp[4 * g + 3];
                            a = quad_sum(a); b = quad_sum(b);
                            const int j = (nb + 32 * half + 8 * g + 4 * hi) >> 2;
                            if (head == 0 && j < 128) { IA[tl * 128 + j] = a; IB[tl * 128 + j] = b; }
                        }
                    }
                    nsa_pack(pf, p0, p1);
                    nsa_pv(o, VT + bo_, pf, q32, hi);
                }
            });
        }
        { const float g_c = P.GATES[(size_t)tq * 12 + head * 3 + 0];
#pragma unroll
        for (int r = 0; r < 16; ++r) { o[0][r] *= g_c; o[1][r] *= g_c; } }
    }
    REP(26)
    for (int tt = 0; tt < 8; ++tt) {
        const int tok = 8 * w + tt;
        unsigned k0, k1;
        {
            const int j0 = lane, j1 = lane + 64;
            const float i0f = IA[tok * 128 + j0] + (j0 > 0 ? IB[tok * 128 + j0 - 1] : 0.f), i1f = IA[tok * 128 + j1] + IB[tok * 128 + j1 - 1];
            k0 = (j0 == cur || j0 == 0) ? 0x7f800001u : (j0 <= cur ? __float_as_uint(i0f) + 1u : 0u);
            k1 = (j1 == cur) ? 0x7f800001u : (j1 <= cur ? __float_as_uint(i1f) + 1u : 0u);
        }
        unsigned T = 0u;
#pragma unroll 1
        for (int bit = 30; bit >= 0; --bit) {
            const unsigned cand = T | (1u << bit);
            const int cnt = __popcll(__ballot(k0 >= cand)) + __popcll(__ballot(k1 >= cand));
            if (cnt >= 16) T = cand;
        }
        const unsigned long long gt0 = __ballot(k0 > T), gt1 = __ballot(k1 > T), eq0 = __ballot(k0 == T), eq1 = __ballot(k1 == T);
        const int need = 16 - (__popcll(gt0) + __popcll(gt1));
        const unsigned long long lt = (1ull << lane) - 1ull;
        const bool s0_ = (k0 > T) || ((k0 == T) && __popcll(eq0 & lt) < need);
        const bool s1_ = (k1 > T) || ((k1 == T) && (__popcll(eq0) + __popcll(eq1 & lt)) < need);
        const unsigned long long b0 = __ballot(s0_), b1 = __ballot(s1_);
        if (lane == 0) {
            const unsigned m0 = (unsigned)b0, m1 = (unsigned)(b0 >> 32), m2 = (unsigned)b1, m3 = (unsigned)(b1 >> 32);
            SELM[tok * 4 + 0] = m0; SELM[tok * 4 + 1] = m1; SELM[tok * 4 + 2] = m2; SELM[tok * 4 + 3] = m3;
            __hip_atomic_fetch_or(&UNI[0], m0, __ATOMIC_RELAXED, __HIP_MEMORY_SCOPE_WORKGROUP); __hip_atomic_fetch_or(&UNI[1], m1, __ATOMIC_RELAXED, __HIP_MEMORY_SCOPE_WORKGROUP);
            __hip_atomic_fetch_or(&UNI[2], m2, __ATOMIC_RELAXED, __HIP_MEMORY_SCOPE_WORKGROUP); __hip_atomic_fetch_or(&UNI[3], m3, __ATOMIC_RELAXED, __HIP_MEMORY_SCOPE_WORKGROUP);
        }
    }
    __syncthreads();
#pragma unroll
    for (int r = 0; r < 16; ++r) { ACC[r * 64] = o[0][r]; ACC[(16 + r) * 64] = o[1][r]; }
    {
        nsa_loadq(qf, P.QR, tq, head, hi);
        const unsigned s0 = SELM[tl * 4 + 0], s1 = SELM[tl * 4 + 1], s2 = SELM[tl * 4 + 2], s3 = SELM[tl * 4 + 3];
        const unsigned u0 = UNI[0], u1 = UNI[1], u2 = UNI[2], u3 = UNI[3];
        float m = -INFINITY, l = 0.f;
        LAS unsigned char* TL = (LAS unsigned char*)(lds + NSA_UNI + 16);
        int ntl;
        {
            const unsigned lt0 = cur >= 31 ? 0xffffffffu : ((2u << cur) - 1u), lt1 = cur < 32 ? 0u : (cur >= 63 ? 0xffffffffu : ((2u << (cur - 32)) - 1u)),
                           lt2 = cur < 64 ? 0u : (cur >= 95 ? 0xffffffffu : ((2u << (cur - 64)) - 1u)), lt3 = cur < 96 ? 0u : (cur >= 127 ? 0xffffffffu : ((2u << (cur - 96)) - 1u));
            const unsigned v0 = u0 & lt0, v1 = u1 & lt1, v2 = u2 & lt2, v3 = u3 & lt3;
            ntl = __popc(v0) + __popc(v1) + __popc(v2) + __popc(v3);
            if (tid < 128) {
                const int jj = tid, wq = jj >> 5; const unsigned bit = 1u << (jj & 31), below = bit - 1u;
                const unsigned vw = wq == 0 ? v0 : (wq == 1 ? v1 : (wq == 2 ? v2 : v3));
                if (vw & bit) {
                    const int pos = (wq > 0 ? __popc(v0) : 0) + (wq > 1 ? __popc(v1) : 0) + (wq > 2 ? __popc(v2) : 0) + __popc(vw & below);
                    TL[pos] = (unsigned char)jj;
                }
            }
        }
        __syncthreads();
#define KPS_(i) (P.KSR + (size_t)TL[i] * 64 * 64)
#define VPS_(i) (P.VST + (int)TL[i] * 64)
        REP(25) {
        m = -INFINITY; l = 0.f;
#pragma unroll
        for (int r = 0; r < 16; ++r) { o[0][r] = 0.f; o[1][r] = 0.f; }
        NSA_PIPE(ntl, KPS_, VPS_, SEQ, {
            const int j = TL[it_];
            const unsigned wv = j < 32 ? s0 : (j < 64 ? s1 : (j < 96 ? s2 : s3));
            const bool mine = (wv >> (j & 31)) & 1u;
            if (__any(mine)) {
                nsa_qk(p0, p1, KT + bo_, qf, q32, hi);
                if (j == cur || !__all(mine)) {
                    const int klim = (mine ? (j == cur ? (tq & 63) : 63) : -1) - 4 * hi;
_Pragma("unroll")
                    for (int r = 0; r < 16; ++r) { const int c0 = (r & 3) + 8 * (r >> 2); if (c0 > klim) p0[r] = -INFINITY; if (c0 + 32 > klim) p1[r] = -INFINITY; }
                }
                nsa_softmax(p0, p1, m, l, o, pf);
                nsa_pv(o, VT + bo_, pf, q32, hi);
            }
        });
        }
        const float g_s = P.GATES[(size_t)tq * 12 + head * 3 + 1];
        const float sc = l > 0.f ? g_s / l : 0.f;
#pragma unroll
        for (int r = 0; r < 16; ++r) { ACC[r * 64] += sc * o[0][r]; ACC[(16 + r) * 64] += sc * o[1][r]; }
    }
    {
        float m = -INFINITY, l = 0.f;
#pragma unroll
        for (int r = 0; r < 16; ++r) { o[0][r] = 0.f; o[1][r] = 0.f; }
        const int j0 = cur >= 8 ? cur - 8 : 0;
#define KPW_(i) (P.KWR + (size_t)(j0 + (i)) * 64 * 64)
#define VPW_(i) (P.VWT + (j0 + (i)) * 64)
        NSA_PIPE(cur - j0 + 1, KPW_, VPW_, SEQ, {
            const int j = j0 + it_;
            nsa_qk(p0, p1, KT + bo_, qf, q32, hi);
            if (j == cur || j + 8 == cur) {
                const int hiA = tq - j * 64 - 4 * hi, loA = hiA - 512;
_Pragma("unroll")
                for (int r = 0; r < 16; ++r) {
                    const int c0 = (r & 3) + 8 * (r >> 2);
                    if (c0 > hiA || c0 <= loA) p0[r] = -INFINITY;
                    if (c0 + 32 > hiA || c0 + 32 <= loA) p1[r] = -INFINITY;
                }
            }
            nsa_softmax(p0, p1, m, l, o, pf);
            nsa_pv(o, VT + bo_, pf, q32, hi);
        });
        const float g_w = P.GATES[(size_t)tq * 12 + head * 3 + 2];
        const float sc = l > 0.f ? g_w / l : 0.f;
#pragma unroll
        for (int r = 0; r < 16; ++r) { o[0][r] = ACC[r * 64] + sc * o[0][r]; o[1][r] = ACC[(16 + r) * 64] + sc * o[1][r]; }
    }
    {
        bf16* op = P.MIX + (size_t)tq * DM + 768 + head * 64 + 4 * hi;
#pragma unroll
        for (int db = 0; db < 2; ++db)
#pragma unroll
            for (int g = 0; g < 4; ++g) {
                const unsigned lo = cvtpk(o[db][4 * g], o[db][4 * g + 1]), h2 = cvtpk(o[db][4 * g + 2], o[db][4 * g + 3]);
                *(uint2*)(op + 32 * db + 8 * g) = make_uint2(lo, h2);
            }
    }
}

DEVI void nsa_prep2(const bf16* __restrict__ cols, bf16* __restrict__ qn, bf16* __restrict__ qr, bf16* __restrict__ ksr, bf16* __restrict__ kwr,
                    bf16* __restrict__ vst, bf16* __restrict__ vwt, float* __restrict__ gates, int bid) {
    const int t = bid, c = tidx() & 255;
    const int d = c & 63, j = d & 31;
    const float inv = powf(10000.f, -(float)j / 32.f);
    const float ang = (float)t * inv;
    float sn, cs; sincosf(ang, &sn, &cs);
    {
        const bf16* q = cols + (size_t)t * DINP + OFF_Q + (c & ~63);
        const float x1 = bf2f(q[j]), x2 = bf2f(q[j + 32]);
        qn[(size_t)t * 256 + c] = (bf16)f2bf(bf2f(q[d]) * QSCL);
        qr[(size_t)t * 256 + c] = (bf16)f2bf((d < 32 ? x1 * cs - x2 * sn : x2 * cs + x1 * sn) * QSCL);
    }
    if (c < 128) {
        const bf16* kp = cols + (size_t)t * DINP + (c < 64 ? OFF_KS : OFF_KW);
        const float x1 = bf2f(kp[j]), x2 = bf2f(kp[j + 32]);
        const float v = d < 32 ? x1 * cs - x2 * sn : x2 * cs + x1 * sn;
        if (c < 64) ksr[(size_t)t * 64 + d] = (bf16)f2bf(v); else kwr[(size_t)t * 64 + d] = (bf16)f2bf(v);
    } else {
        const bf16 v = cols[(size_t)t * DINP + (c < 192 ? OFF_VS : OFF_VW) + d];
        if (c < 192) vst[(size_t)d * SEQ + t] = v; else vwt[(size_t)d * SEQ + t] = v;
    }
    if (c < 12) gates[(size_t)t * 12 + c] = sigm(bf2f(cols[(size_t)t * DINP + OFF_GT + c]));
}
DEVI void nsa_cmp_cvt(const float* __restrict__ kc, const float* __restrict__ vc, bf16* __restrict__ kcb, bf16* __restrict__ vct, int bid) {
    const int i = bid * 256 + (tidx() & 255);
    if (i < 512 * 64) {
        const int n = i >> 6, d = i & 63;
        kcb[i] = n < NCMP ? (bf16)f2bf(kc[i]) : (bf16)0;
        vct[d * 512 + n] = n < NCMP ? (bf16)f2bf(vc[i]) : (bf16)0;
    }
}
DEVI float4 ld4bf(const bf16* p);
constexpr int RW_SLOT = 8192;
typedef unsigned u32x2v __attribute__((ext_vector_type(2)));
DEVI int rw_off(int row, int chunk16) { return row * 128 + ((chunk16 ^ (row & 7)) << 4); }
DEVI void rw_ld(LAS unsigned char* slot, const bf16* g, int gt) {
#pragma unroll
    for (int e = 0; e < 2; ++e) { const int idx = gt + 256 * e, row = idx >> 3, ch = idx & 7;
        *(LAS v4u*)(slot + rw_off(row, ch)) = *(const v4u*)((const char*)g + idx * 16); }
}
DEVI void rw_ldT(LAS unsigned char* slot, const bf16* g, size_t gstride, int gt) {
#pragma unroll
    for (int e = 0; e < 2; ++e) { const int idx = gt + 256 * e, row = idx >> 3, ch = idx & 7;
        const v4u v = *(const v4u*)(g + (size_t)row * gstride + ch * 8);
        const unsigned w[4] = {v.x, v.y, v.z, v.w};
#pragma unroll
        for (int j = 0; j < 8; ++j) { const int col = ch * 8 + j; const unsigned short h = (unsigned short)(w[j >> 1] >> ((j & 1) * 16));
            *(LAS unsigned short*)(slot + rw_off(col, row >> 3) + (row & 7) * 2) = h; }
    }
}
DEVI bf16x8 rw_frag(const LAS unsigned char* slot, int blk, int s, int r32, int hi) {
    return *(const LAS bf16x8*)(slot + rw_off(32 * blk + r32, 2 * s + hi));
}
DEVI void rw_mm(f32x16& acc, const LAS unsigned char* slotA, int rb, const LAS unsigned char* slotBT, int cb, int r32, int hi) {
#pragma unroll
    for (int s = 0; s < 4; ++s) acc = __builtin_amdgcn_mfma_f32_32x32x16_bf16(rw_frag(slotA, rb, s, r32, hi), rw_frag(slotBT, cb, s, r32, hi), acc, 0, 0, 0);
}
DEVI void rw_stT(LAS unsigned char* slot, const f32x16& acc, int rb, int cb, int r32, int hi) {
    const int j = 32 * cb + r32;
#pragma unroll
    for (int g = 0; g < 4; ++g) {
        const u32x2v w = {cvtpk(acc[4 * g], acc[4 * g + 1]), cvtpk(acc[4 * g + 2], acc[4 * g + 3])};
        *(LAS u32x2v*)(slot + rw_off(j, 4 * rb + g) + 8 * hi) = w;
    }
}
DEVI void rw_st(LAS unsigned char* slot, const f32x16& acc, int rb, int cb, int r32, int hi) {
    const int j = 32 * cb + r32;
#pragma unroll
    for (int r = 0; r < 16; ++r) { const int i = 32 * rb + crow(r, hi);
        *(LAS unsigned short*)(slot + rw_off(i, j >> 3) + (j & 7) * 2) = (unsigned short)f2bf(acc[r]); }
}
DEVI void rw_ldaccT(f32x16& acc, const LAS unsigned char* slot, int rb, int cb, int r32, int hi) {
    const int j = 32 * cb + r32;
#pragma unroll
    for (int g = 0; g < 4; ++g) {
        const u32x2v w = *(const LAS u32x2v*)(slot + rw_off(j, 4 * rb + g) + 8 * hi);
        acc[4 * g] = __builtin_bit_cast(float, w.x << 16); acc[4 * g + 1] = __builtin_bit_cast(float, w.x & 0xffff0000u);
        acc[4 * g + 2] = __builtin_bit_cast(float, w.y << 16); acc[4 * g + 3] = __builtin_bit_cast(float, w.y & 0xffff0000u);
    }
}
DEVI void rw_zero(f32x16& a) {
#pragma unroll
    for (int r = 0; r < 16; ++r) a[r] = 0.f;
}
DEVI void rw_frags(v4u& f0, v4u& f1, const f32x16& a) {
    f0 = (v4u){cvtpk(a[0], a[1]), cvtpk(a[2], a[3]), cvtpk(a[4], a[5]), cvtpk(a[6], a[7])};
    f1 = (v4u){cvtpk(a[8], a[9]), cvtpk(a[10], a[11]), cvtpk(a[12], a[13]), cvtpk(a[14], a[15])};
}

struct RwP {
    const bf16 *R, *K, *V, *A, *B;
    const float* LW; const bf16 *G, *BON;
    bf16 *AT, *BT, *KT, *RT;
    float* LAM;
    v4u *PF, *HF;
    float *QT, *OL;
    v4u* SF;
    const float *gn_g, *gn_b;
    bf16* MIX;
};

DEVI void rw_r1b(const RwP& P, int c, LAS unsigned char* lds) {
    LAS float* cum = (LAS float*)lds;
    const int tid = tidx();
    __syncthreads();
    if (tid < 256) {
        float s = 0.f;
#pragma unroll 8
        for (int t = 0; t < 64; ++t) { s += P.LW[(size_t)(c * 64 + t) * 256 + tid]; cum[t * 256 + tid] = s; }
    }
    __syncthreads();
    for (int e = tid; e < 64 * 256; e += 512) {
        const int t = e >> 8, ch = e & 255, h = ch >> 6, k = ch & 63;
        const size_t gi = (size_t)(c * 64 + t) * 256 + ch;
        const float cu = cum[e], lw = P.LW[gi];
        const float ein = __expf(cu), eout = __expf(-cu), eex = __expf(cu - lw);
        const size_t o = ((size_t)(c * 4 + h) * 64 + t) * 64 + k;
        P.AT[o] = (bf16)f2bf(bf2f(P.A[gi]) * eex);
        P.BT[o] = (bf16)f2bf(bf2f(P.B[gi]) * eout);
        P.KT[o] = (bf16)f2bf(bf2f(P.K[gi]) * eout);
        P.RT[o] = (bf16)f2bf(bf2f(P.R[gi]) * ein);
        if (t == 63) P.LAM[(size_t)(c * 4 + h) * 64 + k] = ein;
    }
}

DEVI void rw_r2(const RwP& P, int u0, LAS unsigned char* lds) {
    const int tid = tidx(), grp = tid >> 8, gt = tid & 255, gw = (tid >> 6) & 3, lane = tid & 63, r32 = lane & 31, hi = lane >> 5;
    const int rb = gw >> 1, cb = gw & 1;
    const int u = u0 + grp, c = u >> 2, h = u & 3;
    LAS unsigned char* sl = lds + grp * 65536;
#define SL(i) (sl + (i) * RW_SLOT)
    __syncthreads();
    rw_ld(SL(0), P.BT + (size_t)u * 4096, gt); rw_ld(SL(1), P.AT + (size_t)u * 4096, gt);
    rw_ld(SL(2), P.KT + (size_t)u * 4096, gt); rw_ld(SL(3), P.RT + (size_t)u * 4096, gt);
    __syncthreads();
    f32x16 aMab, aMak, aNbr, aNkr;
    rw_zero(aMab); rw_zero(aMak); rw_zero(aNbr); rw_zero(aNkr);
    rw_mm(aMab, SL(0), rb, SL(1), cb, r32, hi);
    rw_mm(aMak, SL(2), rb, SL(1), cb, r32, hi);
    rw_mm(aNbr, SL(0), rb, SL(3), cb, r32, hi);
    rw_mm(aNkr, SL(2), rb, SL(3), cb, r32, hi);
    {
        const int t = 32 * cb + r32;
#pragma unroll
        for (int r = 0; r < 16; ++r) { const int i = 32 * rb + crow(r, hi);
            if (!(i < t)) { aMab[r] = 0.f; aMak[r] = 0.f; }
            if (!(i <= t)) { aNbr[r] = 0.f; aNkr[r] = 0.f; } }
    }
    __syncthreads();
    rw_st(SL(4), aMab, rb, cb, r32, hi);
    rw_stT(SL(5), aMab, rb, cb, r32, hi);
    rw_st(SL(6), aMak, rb, cb, r32, hi);
    rw_stT(SL(7), aNbr, rb, cb, r32, hi);
    {
        const int t = 32 * cb + r32;
#pragma unroll
        for (int r = 0; r < 16; ++r) { const int i = 32 * rb + crow(r, hi); if (i == t) aMab[r] += 1.f; }
    }
    rw_st(SL(0), aMab, rb, cb, r32, hi);
    __syncthreads();
    int mA = 4, mT = 5, nA = 1, nT = 2;
#pragma unroll 1
    for (int j = 0; j < 5; ++j) {
        f32x16 a1; rw_zero(a1);
        rw_mm(a1, SL(mT), rb, SL(mA), cb, r32, hi);
        rw_stT(SL(nA), a1, rb, cb, r32, hi);
        rw_st(SL(nT), a1, rb, cb, r32, hi);
        __syncthreads();
        f32x16 a2; rw_ldaccT(a2, SL(0), rb, cb, r32, hi);
        rw_mm(a2, SL(nT), rb, SL(0), cb, r32, hi);
        __syncthreads();
        rw_stT(SL(0), a2, rb, cb, r32, hi);
        __syncthreads();
        const int ta = mA, tb = mT; mA = nA; mT = nT; nA = ta; nT = tb;
    }
    rw_ldT(SL(1), P.BT + (size_t)u * 4096, 64, gt); rw_ldT(SL(2), P.AT + (size_t)u * 4096, 64, gt);
    rw_ldT(SL(4), P.KT + (size_t)u * 4096, 64, gt); rw_ldT(SL(5), P.V + (size_t)(c * 64) * 256 + h * 64, 256, gt);
    __syncthreads();
    {
        f32x16 aY, aZ; rw_zero(aY); rw_zero(aZ);
        rw_mm(aY, SL(0), rb, SL(1), cb, r32, hi);
        rw_mm(aZ, SL(0), rb, SL(7), cb, r32, hi);
        __syncthreads();
        rw_stT(SL(1), aY, rb, cb, r32, hi);
        rw_stT(SL(7), aZ, rb, cb, r32, hi);
        __syncthreads();
    }
    {
        f32x16 aP; rw_zero(aP);
        rw_mm(aP, SL(2), rb, SL(1), cb, r32, hi);
        const int kp = 32 * cb + r32; const float lam = P.LAM[(size_t)u * 64 + kp];
#pragma unroll
        for (int r = 0; r < 16; ++r) { const int kk = 32 * rb + crow(r, hi); aP[r] = (aP[r] + (kk == kp ? 1.f : 0.f)) * lam; }
        v4u f0, f1; rw_frags(f0, f1, aP);
        v4u* dst = P.PF + ((((size_t)u * 2 + cb) * 2 + rb) * 2) * 64 + lane;
        dst[0] = f0; dst[64] = f1;
    }
    {
        f32x16 aH; rw_ldaccT(aH, SL(3), rb, cb, r32, hi);
        rw_mm(aH, SL(2), rb, SL(7), cb, r32, hi);
        v4u f0, f1; rw_frags(f0, f1, aH);
        v4u* dst = P.HF + ((((size_t)u * 2 + cb) * 2 + rb) * 2) * 64 + lane;
        dst[0] = f0; dst[64] = f1;
    }
    {
        f32x16 aD1; rw_ldaccT(aD1, SL(4), rb, cb, r32, hi);
        rw_mm(aD1, SL(6), rb, SL(1), cb, r32, hi);
        rw_mm(aNkr, SL(6), rb, SL(7), cb, r32, hi);
        __syncthreads();
        rw_stT(SL(0), aD1, rb, cb, r32, hi);
        rw_stT(SL(3), aNkr, rb, cb, r32, hi);
        __syncthreads();
    }
    {
        f32x16 aQ; rw_zero(aQ);
        rw_mm(aQ, SL(0), rb, SL(5), cb, r32, hi);
        float* dst = P.QT + (((size_t)u * 2 + cb) * 2 + rb) * 1024 + lane * 4;
#pragma unroll
        for (int g = 0; g < 4; ++g) {
            const float4 lam = *(const float4*)(P.LAM + (size_t)u * 64 + 32 * rb + 8 * g + 4 * hi);
            *(float4*)(dst + g * 256) = make_float4(aQ[4 * g] * lam.x, aQ[4 * g + 1] * lam.y, aQ[4 * g + 2] * lam.z, aQ[4 * g + 3] * lam.w);
        }
    }
    {
        f32x16 aO; rw_zero(aO);
        rw_mm(aO, SL(5), rb, SL(3), cb, r32, hi);
        float* dst = P.OL + (((size_t)u * 2 + cb) * 2 + rb) * 1024 + lane * 4;
#pragma unroll
        for (int g = 0; g < 4; ++g) *(float4*)(dst + g * 256) = make_float4(aO[4 * g], aO[4 * g + 1], aO[4 * g + 2], aO[4 * g + 3]);
    }
#undef SL
}

DEVI void rw_r3_load(const RwP& P, size_t u, int vb, int lane, f32x16 (&q)[2], v4u (&pf)[8]) {
#pragma unroll
    for (int kb = 0; kb < 2; ++kb) {
        const float* qp = P.QT + ((u * 2 + vb) * 2 + kb) * 1024 + lane * 4;
#pragma unroll
        for (int g = 0; g < 4; ++g) { const float4 v = *(const float4*)(qp + g * 256); q[kb][4 * g] = v.x; q[kb][4 * g + 1] = v.y; q[kb][4 * g + 2] = v.z; q[kb][4 * g + 3] = v.w; }
        const v4u* pp = P.PF + (((u * 2 + kb) * 2) * 2) * 64 + lane;
#pragma unroll
        for (int i = 0; i < 4; ++i) pf[kb * 4 + i] = pp[i * 64];
    }
}
DEVI void rw_r3(const RwP& P, int b, int h, int vb, int lane) {
    f32x16 st[2]; rw_zero(st[0]); rw_zero(st[1]);
    f32x16 q[2], qn[2]; v4u pf[8], pfn[8];
    const size_t ub = (size_t)b * (SEQ / 64) * 4 + h;
    rw_r3_load(P, ub, vb, lane, q, pf);
#pragma unroll 1
    for (int c = 0; c < SEQ / 64; ++c) {
        const size_t u = ub + (size_t)c * 4;
        if (c + 1 < SEQ / 64) rw_r3_load(P, u + 4, vb, lane, qn, pfn);
        v4u sf[2][2];
        rw_frags(sf[0][0], sf[0][1], st[0]); rw_frags(sf[1][0], sf[1][1], st[1]);
        v4u* sdst = P.SF + ((u * 2 + vb) * 4) * 64 + lane;
        sdst[0] = sf[0][0]; sdst[64] = sf[0][1]; sdst[128] = sf[1][0]; sdst[192] = sf[1][1];
#pragma unroll
        for (int kb = 0; kb < 2; ++kb)
#pragma unroll
            for (int ki = 0; ki < 2; ++ki)
#pragma unroll
                for (int s = 0; s < 2; ++s)
                    q[kb] = __builtin_amdgcn_mfma_f32_32x32x16_bf16(__builtin_bit_cast(bf16x8, pf[kb * 4 + ki * 2 + s]), __builtin_bit_cast(bf16x8, sf[ki][s]), q[kb], 0, 0, 0);
        st[0] = q[0]; st[1] = q[1];
        q[0] = qn[0]; q[1] = qn[1];
#pragma unroll
        for (int i = 0; i < 8; ++i) pf[i] = pfn[i];
    }
}

DEVI void rw_r4(const RwP& P, int u, int tb, int lane) {
    const int c = u >> 2, h = u & 3, r32 = lane & 31, hi = lane >> 5;
    f32x16 o[2];
#pragma unroll
    for (int vb = 0; vb < 2; ++vb) {
        const float* ol = P.OL + (((size_t)u * 2 + tb) * 2 + vb) * 1024 + lane * 4;
#pragma unroll
        for (int g = 0; g < 4; ++g) { const float4 v = *(const float4*)(ol + g * 256); o[vb][4 * g] = v.x; o[vb][4 * g + 1] = v.y; o[vb][4 * g + 2] = v.z; o[vb][4 * g + 3] = v.w; }
        const v4u* sf = P.SF + (((size_t)u * 2 + vb) * 4) * 64 + lane;
        const v4u* hf = P.HF + ((((size_t)u * 2 + tb) * 2) * 2) * 64 + lane;
#pragma unroll
        for (int kb = 0; kb < 2; ++kb)
#pragma unroll
            for (int s = 0; s < 2; ++s)
                o[vb] = __builtin_amdgcn_mfma_f32_32x32x16_bf16(__builtin_bit_cast(bf16x8, sf[(kb * 2 + s) * 64]), __builtin_bit_cast(bf16x8, hf[(kb * 2 + s) * 64]), o[vb], 0, 0, 0);
    }
    float sum = 0.f;
#pragma unroll
    for (int r = 0; r < 16; ++r) sum += o[0][r] + o[1][r];
    sum += __shfl_xor(sum, 32, 64);
    const float mean = sum * (1.f / 64.f);
    float q = 0.f;
#pragma unroll
    for (int r = 0; r < 16; ++r) { const float d0 = o[0][r] - mean, d1 = o[1][r] - mean; q += d0 * d0 + d1 * d1; }
    q += __shfl_xor(q, 32, 64);
    const float rstd = rsqrtf(q * (1.f / 64.f) + 64e-5f);
    const size_t tok = (size_t)c * 64 + 32 * tb + r32;
#pragma unroll
    for (int vb = 0; vb < 2; ++vb)
#pragma unroll
        for (int g = 0; g < 4; ++g) {
            const int ch = h * 64 + 32 * vb + 8 * g + 4 * hi;
            const float4 gg = *(const float4*)(P.gn_g + ch), gb = *(const float4*)(P.gn_b + ch);
            const float4 bo = ld4bf(P.BON + tok * 256 + ch), gt = ld4bf(P.G + tok * 256 + ch);
            const float y0 = ((o[vb][4 * g] - mean) * rstd * gg.x + gb.x + bo.x) * gt.x;
            const float y1 = ((o[vb][4 * g + 1] - mean) * rstd * gg.y + gb.y + bo.y) * gt.y;
            const float y2 = ((o[vb][4 * g + 2] - mean) * rstd * gg.z + gb.z + bo.z) * gt.z;
            const float y3 = ((o[vb][4 * g + 3] - mean) * rstd * gg.w + gb.w + bo.w) * gt.w;
            *(uint2*)(P.MIX + tok * DM + 256 + ch) = make_uint2(cvtpk(y0, y1), cvtpk(y2, y3));
        }
}
namespace pg8 {
struct XaOrder {
    int G, c;
    __device__ __forceinline__ bool next(int i, Unit& u) const {
        const int L = i * G + c; if (L >= 256) return false;
        u.pm = L >> 2; u.pn = ((L >> 2) >> 5) * 4 + (L & 3); return true;
    }
    __device__ __forceinline__ void a_ready(const Unit&) const {}
    __device__ __forceinline__ void done(const Unit&) const {}
};
struct MoeOrder {
    const int* tile_e; const int* nrt; int G, c;
    __device__ __forceinline__ bool next(int i, Unit& u) const {
        const int L = i * G + c; if (L >= 4 * (*nrt)) return false;
        u.pm = L >> 2; u.pn = tile_e[L >> 2] * 4 + (L & 3); return true;
    }
    __device__ __forceinline__ void a_ready(const Unit&) const {}
    __device__ __forceinline__ void done(const Unit&) const {}
};
#define PG8_EBAR() do { asm volatile("s_waitcnt lgkmcnt(0)" ::: "memory"); __builtin_amdgcn_s_barrier(); asm volatile("" ::: "memory"); } while (0)
struct EpiSoftmaxP {
    static constexpr bool PERM = true, AFTER_DRAIN = true;
    bf16_t* P;
    __device__ __forceinline__ void fused(f32x4 (&acc)[2][2][4][2], const Unit& u, int wr, int wc, int fr, int fq, PG8_LAS unsigned char* lds, int wid, int lane) const {
        PG8_LAS float* RM = (PG8_LAS float*)lds;
        PG8_LAS float* RS = RM + 1024;
#pragma unroll
        for (int ai = 0; ai < 2; ++ai)
#pragma unroll
            for (int m = 0; m < 4; ++m) {
                float mx = -INFINITY;
#pragma unroll
                for (int bj = 0; bj < 2; ++bj)
#pragma unroll
                    for (int n = 0; n < 2; ++n) { const f32x4 x = acc[ai][bj][m][n]; mx = fmaxf(mx, fmaxf(fmaxf(x[0], x[1]), fmaxf(x[2], x[3]))); }
                mx = fmaxf(mx, __shfl_xor(mx, 16)); mx = fmaxf(mx, __shfl_xor(mx, 32));
                if (fq == 0) RM[(ai * HALF + wr * 64 + m * 16 + fr) * 4 + wc] = mx;
            }
        PG8_EBAR();
#pragma unroll
        for (int ai = 0; ai < 2; ++ai)
#pragma unroll
            for (int m = 0; m < 4; ++m) {
                const int row = ai * HALF + wr * 64 + m * 16 + fr;
                const float gm = fmaxf(fmaxf(RM[row * 4 + 0], RM[row * 4 + 1]), fmaxf(RM[row * 4 + 2], RM[row * 4 + 3]));
                float s = 0.f;
#pragma unroll
                for (int bj = 0; bj < 2; ++bj)
#pragma unroll
                    for (int n = 0; n < 2; ++n) { f32x4 x = acc[ai][bj][m][n];
                        x[0] = __builtin_amdgcn_exp2f(x[0] - gm); x[1] = __builtin_amdgcn_exp2f(x[1] - gm); x[2] = __builtin_amdgcn_exp2f(x[2] - gm); x[3] = __builtin_amdgcn_exp2f(x[3] - gm);
                        s += (x[0] + x[1]) + (x[2] + x[3]); acc[ai][bj][m][n] = x; }
                s += __shfl_xor(s, 16); s += __shfl_xor(s, 32);
                if (fq == 0) RS[row * 4 + wc] = s;
            }
        PG8_EBAR();
        const int colb = (u.pn & 3) * BM + wc * 32 + 8 * fq;
#pragma unroll
        for (int ai = 0; ai < 2; ++ai)
#pragma unroll
            for (int m = 0; m < 4; ++m) {
                const int row = ai * HALF + wr * 64 + m * 16 + fr;
                const float inv = 1.0f / ((RS[row * 4 + 0] + RS[row * 4 + 1]) + (RS[row * 4 + 2] + RS[row * 4 + 3]));
                bf16_t* rowp = P + (size_t)(u.pm * BM + row) * 1024 + colb;
#pragma unroll
                for (int bj = 0; bj < 2; ++bj) { const f32x4 v0 = acc[ai][bj][m][0] * inv, v1 = acc[ai][bj][m][1] * inv;
                    u32x4 w; w.x = cvt_pk_bf16(v0[0], v0[1]); w.y = cvt_pk_bf16(v0[2], v0[3]); w.z = cvt_pk_bf16(v1[0], v1[1]); w.w = cvt_pk_bf16(v1[2], v1[3]);
                    *(u32x4*)(rowp + bj * HALF) = w; }
            }
        PG8_EBAR();
    }
};
struct EpiF32N4 {
    static constexpr bool PERM = false, AFTER_DRAIN = false;
    float* C; int ldc;
    __device__ __forceinline__ void operator()(const f32x4 (&acc)[2][2][4][2], const Unit& u, int wr, int wc, int fr, int fq) const {
        const int row0 = u.pm * BM + wr * 64 + fr, col0 = (u.pn & 3) * BM + wc * 32 + 4 * fq;
#pragma unroll
        for (int ai = 0; ai < 2; ++ai)
#pragma unroll
            for (int m = 0; m < 4; ++m) { float* rowp = C + (size_t)(row0 + ai * HALF + m * 16) * ldc + col0;
#pragma unroll
                for (int bj = 0; bj < 2; ++bj)
#pragma unroll
                    for (int n = 0; n < 2; ++n) *(f32x4*)(rowp + bj * HALF + n * 16) = acc[ai][bj][m][n]; }
    }
};
struct EpiBf16N4 {
    static constexpr bool PERM = true, AFTER_DRAIN = false;
    bf16_t* O; int ldc;
    __device__ __forceinline__ void operator()(const f32x4 (&acc)[2][2][4][2], const Unit& u, int wr, int wc, int fr, int fq) const {
        const int row0 = u.pm * BM + wr * 64 + fr, col0 = (u.pn & 3) * BM + wc * 32 + 8 * fq;
#pragma unroll
        for (int ai = 0; ai < 2; ++ai)
#pragma unroll
            for (int m = 0; m < 4; ++m) { bf16_t* rowp = O + (size_t)(row0 + ai * HALF + m * 16) * ldc + col0;
#pragma unroll
                for (int bj = 0; bj < 2; ++bj) { const f32x4 v0 = acc[ai][bj][m][0], v1 = acc[ai][bj][m][1];
                    u32x4 w; w.x = cvt_pk_bf16(v0[0], v0[1]); w.y = cvt_pk_bf16(v0[2], v0[3]); w.z = cvt_pk_bf16(v1[0], v1[1]); w.w = cvt_pk_bf16(v1[2], v1[3]);
                    *(u32x4*)(rowp + bj * HALF) = w; } }
    }
};
struct EpiSiluMul {
    static constexpr bool PERM = true, AFTER_DRAIN = false;
    bf16_t* H;
    __device__ __forceinline__ void operator()(const f32x4 (&acc)[2][2][4][2], const Unit& u, int wr, int wc, int fr, int fq) const {
        const int row0 = u.pm * BM + wr * 64 + fr, col0 = (u.pn & 3) * HALF + wc * 32 + 8 * fq;
#pragma unroll
        for (int ai = 0; ai < 2; ++ai)
#pragma unroll
            for (int m = 0; m < 4; ++m) {
                float h[8];
#pragma unroll
                for (int n = 0; n < 2; ++n)
#pragma unroll
                    for (int e = 0; e < 4; ++e) { const float g = acc[ai][0][m][n][e], up = acc[ai][1][m][n][e];
                        h[4 * n + e] = g * __builtin_amdgcn_rcpf(1.0f + __expf(-g)) * up; }
                u32x4 w; w.x = cvt_pk_bf16(h[0], h[1]); w.y = cvt_pk_bf16(h[2], h[3]); w.z = cvt_pk_bf16(h[4], h[5]); w.w = cvt_pk_bf16(h[6], h[7]);
                *(u32x4*)(H + (size_t)(row0 + ai * HALF + m * 16) * 512 + col0) = w;
            }
    }
};

struct OneUnit {
    int pm, pn, valid;
    __device__ __forceinline__ bool next(int i, Unit& u) const { if (i != 0 || !valid) return false; u.pm = pm; u.pn = pn; return true; }
    __device__ __forceinline__ void a_ready(const Unit&) const {}
    __device__ __forceinline__ void done(const Unit&) const {}
};
struct EpiBf16S {
    static constexpr bool PERM = true, AFTER_DRAIN = false;
    bf16_t* O; int ldc; float scale;
    __device__ __forceinline__ void operator()(const f32x4 (&acc)[2][2][4][2], const Unit& u, int wr, int wc, int fr, int fq) const {
        const int row0 = u.pm * BM + wr * 64 + fr, col0 = u.pn * BM + wc * 32 + 8 * fq;
#pragma unroll
        for (int ai = 0; ai < 2; ++ai)
#pragma unroll
            for (int m = 0; m < 4; ++m) { bf16_t* rowp = O + (size_t)(row0 + ai * HALF + m * 16) * ldc + col0;
#pragma unroll
                for (int bj = 0; bj < 2; ++bj) { const f32x4 v0 = acc[ai][bj][m][0] * scale, v1 = acc[ai][bj][m][1] * scale;
                    u32x4 w; w.x = cvt_pk_bf16(v0[0], v0[1]); w.y = cvt_pk_bf16(v0[2], v0[3]); w.z = cvt_pk_bf16(v1[0], v1[1]); w.w = cvt_pk_bf16(v1[2], v1[3]);
                    *(u32x4*)(rowp + bj * HALF) = w; } }
    }
};
struct EpiGeluF32 {
    static constexpr bool PERM = false, AFTER_DRAIN = false;
    float* C; int ldc;
    __device__ __forceinline__ void operator()(const f32x4 (&acc)[2][2][4][2], const Unit& u, int wr, int wc, int fr, int fq) const {
        const int row0 = u.pm * BM + wr * 64 + fr, col0 = u.pn * BM + wc * 32 + 4 * fq;
#pragma unroll
        for (int ai = 0; ai < 2; ++ai)
#pragma unroll
            for (int m = 0; m < 4; ++m) { float* rowp = C + (size_t)(row0 + ai * HALF + m * 16) * ldc + col0;
#pragma unroll
                for (int bj = 0; bj < 2; ++bj)
#pragma unroll
                    for (int n = 0; n < 2; ++n) { f32x4 x = acc[ai][bj][m][n];
#pragma unroll
                        for (int e = 0; e < 4; ++e) x[e] = 0.5f * x[e] * (1.f + tanhf(0.7978845608028654f * (x[e] + 0.044715f * x[e] * x[e] * x[e])));
                        *(f32x4*)(rowp + bj * HALF + n * 16) = x; } }
    }
};
struct EpiGeluW2 {
    static constexpr bool PERM = false, AFTER_DRAIN = true;
    const bf16_t* W2T;
    bf16_t* O;
    int isv;
    __device__ __forceinline__ void fused(f32x4 (&acc)[2][2][4][2], const Unit& u, int wr, int wc, int fr, int fq, PG8_LAS unsigned char* lds, int wid, int lane) const {
        typedef unsigned u32x2e __attribute__((ext_vector_type(2)));
        typedef float f32x16e __attribute__((ext_vector_type(16)));
#pragma unroll
        for (int ai = 0; ai < 2; ++ai)
#pragma unroll
            for (int m = 0; m < 4; ++m) { const int row = ai * HALF + wr * 64 + m * 16 + fr;
#pragma unroll
                for (int bj = 0; bj < 2; ++bj)
#pragma unroll
                    for (int n = 0; n < 2; ++n) { f32x4 x = acc[ai][bj][m][n];
#pragma unroll
                        for (int e = 0; e < 4; ++e) x[e] = 0.5f * x[e] * (1.f + tanhf(0.7978845608028654f * (x[e] + 0.044715f * x[e] * x[e] * x[e])));
                        const int col = bj * HALF + wc * 32 + n * 16 + 4 * fq;
                        *(PG8_LAS u32x2e*)(lds + row * 512 + ((((col >> 3) ^ (row & 7))) << 4) + (col & 7) * 2) = (u32x2e){cvt_pk_bf16(x[0], x[1]), cvt_pk_bf16(x[2], x[3])}; } }
        PG8_EBAR();
        const int r32 = lane & 31, hi = lane >> 5, row = wid * 32 + r32;
        f32x16e o[2];
#pragma unroll
        for (int cb = 0; cb < 2; ++cb)
#pragma unroll
            for (int r = 0; r < 16; ++r) o[cb][r] = 0.f;
#pragma unroll 4
        for (int s = 0; s < 16; ++s) {
            const bf16x8 a = *(const PG8_LAS bf16x8*)(lds + row * 512 + (((2 * s + hi) ^ (row & 7)) << 4));
#pragma unroll
            for (int cb = 0; cb < 2; ++cb) {
                const bf16x8 b = *(const bf16x8*)(W2T + (size_t)(32 * cb + r32) * 256 + 16 * s + 8 * hi);
                o[cb] = __builtin_amdgcn_mfma_f32_32x32x16_bf16(a, b, o[cb], 0, 0, 0);
            }
        }
#pragma unroll
        for (int cb = 0; cb < 2; ++cb)
#pragma unroll
            for (int g = 0; g < 4; ++g) {
                const int grow = u.pm * BM + wid * 32 + 8 * g + 4 * hi, col = 32 * cb + r32;
                if (isv) { *(u32x2e*)(O + (size_t)(grow >> 9) * 64 * 512 + (size_t)col * 512 + (grow & 511)) = (u32x2e){cvt_pk_bf16(o[cb][4 * g], o[cb][4 * g + 1]), cvt_pk_bf16(o[cb][4 * g + 2], o[cb][4 * g + 3])}; }
                else {
#pragma unroll
                    for (int e = 0; e < 4; ++e) O[(size_t)(grow + e) * 64 + col] = (bf16_t)(cvt_pk_bf16(o[cb][4 * g + e], 0.f) & 0xffffu);
                }
            }
        PG8_EBAR();
    }
};
}

DEVI void tr_blk(const float* W, size_t ldw, int N, int k0, int n0, bf16* WT, size_t ldt, int drow0, float scale, LAS float* scr, int lane) {
    const int n_ = n0 + (lane & 31);
#pragma unroll 8
    for (int i = 0; i < 32; ++i) { const int kk = 2 * i + (lane >> 5); scr[kk * 33 + (lane & 31)] = n_ < N ? W[(size_t)(k0 + kk) * ldw + n_] * scale : 0.f; }
    LDS_WAIT(); asm volatile("" ::: "memory");
    const int c = lane & 7;
#pragma unroll
    for (int j = 0; j < 4; ++j) { const int n = (lane >> 3) + 8 * j; const LAS float* s = scr + (8 * c) * 33 + n;
        v4u o; o.x = pk2(s[0 * 33], s[1 * 33]); o.y = pk2(s[2 * 33], s[3 * 33]); o.z = pk2(s[4 * 33], s[5 * 33]); o.w = pk2(s[6 * 33], s[7 * 33]);
        *(GAS v4u*)(WT + (size_t)(drow0 + n) * ldt + k0 + 8 * c) = o; }
    LDS_WAIT(); asm volatile("" ::: "memory");
}
DEVI void cvt_bf16(const float* __restrict__ src, bf16* __restrict__ dst, size_t n, float scale, int B0, int G) {
    for (size_t i = ((size_t)B0 * 512 + tidx()) * 4; i < n; i += (size_t)G * 512 * 4) {
        const float4 v = *(const float4*)(src + i);
        *(uint2*)(dst + i) = make_uint2(pk2(v.x * scale, v.y * scale), pk2(v.z * scale, v.w * scale));
    }
}

DEVI void moe_lists2(const int* __restrict__ te, int* __restrict__ off, int* __restrict__ nrt, int* __restrict__ tile_e, int* __restrict__ list,
                     int* __restrict__ slotpos, float* sm0) {
    int* cnt = (int*)sm0;
    int* offs = cnt + 16;
    const int w = tidx() >> 6, lane = tidx() & 63;
    __syncthreads();
    for (int ee = 0; ee < 2; ++ee) {
        const int e = w * 2 + ee;
        int c = 0;
        for (int base = 0; base < NTOK; base += 64) {
            const int tok = base + lane;
            const bool m = (te[tok * 2] == e) || (te[tok * 2 + 1] == e);
            c += __popcll(__ballot(m));
        }
        if (lane == 0) cnt[e] = c;
    }
    __syncthreads();
    if (tidx() == 0) {
        int s = 0;
#pragma unroll 1
        for (int i = 0; i < 16; ++i) { offs[i] = s; off[i] = s; const int pc = (cnt[i] + 255) & ~255;
#pragma unroll 1
            for (int r = s / 256; r < (s + pc) / 256; ++r) tile_e[r] = i;
            s += pc; }
        offs[16] = s; off[16] = s; *nrt = s / 256;
    }
    __syncthreads();
    for (int ee = 0; ee < 2; ++ee) {
        const int e = w * 2 + ee;
        int pos = offs[e];
        for (int base = 0; base < NTOK; base += 64) {
            const int tok = base + lane;
            const int a = te[tok * 2], b = te[tok * 2 + 1];
            const bool m = (a == e) || (b == e);
            const unsigned long long mask = __ballot(m);
            if (m) {
                const int p = pos + __popcll(mask & ((1ull << lane) - 1ull));
                list[p] = tok;
                slotpos[tok * 2 + (a == e ? 0 : 1)] = p;
            }
            pos += __popcll(mask);
        }
        for (int p = pos + lane; p < offs[e + 1]; p += 64) list[p] = -1;
    }
    __syncthreads();
}
DEVI void moe_gather(const bf16* __restrict__ xn, const int* __restrict__ list, const int* __restrict__ off, bf16* __restrict__ xg, int B0, int G) {
    const int total = off[16];
    const int gw = B0 * NWAVES + (tidx() >> 6), lane = tidx() & 63;
    for (int p = gw; p < total; p += G * NWAVES) {
        const int tok = list[p];
        v4u a = (v4u){0u, 0u, 0u, 0u}, b = a;
        if (tok >= 0) { const v4u* s = (const v4u*)(xn + (size_t)tok * DM); a = s[lane]; b = s[lane + 64]; }
        v4u* d = (v4u*)(xg + (size_t)p * DM); d[lane] = a; d[lane + 64] = b;
    }
}
DEVI void moe_combine_ln2(const float* x, const bf16* __restrict__ Dp, const int* __restrict__ te,
                          const float* __restrict__ tw, const int* __restrict__ slotpos,
                          const float* __restrict__ g, const float* __restrict__ bt, float* out, bf16* outb, int bid, float* sm) {
    __syncthreads();
    const size_t t = bid; const int tid = tidx() & 255;
    int ea = te[t * 2], eb = te[t * 2 + 1];
    float wa = tw[t * 2], wb = tw[t * 2 + 1];
    size_t pa = slotpos[t * 2], pb = slotpos[t * 2 + 1];
    if (eb < ea) { const float tf = wa; wa = wb; wb = tf; const size_t tp = pa; pa = pb; pb = tp; }
    float v[4];
#pragma unroll
    for (int i = 0; i < 4; ++i) {
        const int c = tid + i * 256;
        float y = wa * bf2f(Dp[pa * DM + c]);
        y = y + wb * bf2f(Dp[pb * DM + c]);
        v[i] = ALPHA * x[t * DM + c] + y;
    }
    const float mean = block_sum256(v[0] + v[1] + v[2] + v[3], sm, tid) * (1.f / DM);
    float q = 0.f;
#pragma unroll
    for (int i = 0; i < 4; ++i) { v[i] -= mean; q += v[i] * v[i]; }
    const float var = block_sum256(q, sm, tid) * (1.f / DM);
    const float rstd = rsqrtf(var + 1e-5f);
#pragma unroll
    for (int i = 0; i < 4; ++i) {
        const int c = tid + i * 256;
        const float o = v[i] * rstd * g[c] + bt[c];
        out[t * DM + c] = o;
        outb[t * DM + c] = (bf16)f2bf(o);
    }
}
struct MixP {
    const bf16* COLS;
    const float *conv_w, *conv_b, *conv_gg, *conv_gb;
    const float *gl_g, *gl_b;
    const float *mu, *w0, *a0, *k_k, *k_a, *r_k, *v_mu, *v0;
    const bf16 *WUP_T, *AUP_T, *GUP_T, *VUP_T;
    const float *pe_k, *pe_v;
    bf16 *MIX, *UB, *VB;
    bf16 *AT, *BT, *KT, *RT, *V, *G, *BON, *VFIRST;
    float* LAM;
    bf16 *QN, *QR, *KSR, *KWR, *VST, *VWT;
    float* GATES;
    bf16 *BLK, *BLV;
    int layer, pad;
};
DEVI float4 ld4bf(const bf16* p) { const uint2 w = *(const uint2*)p; return make_float4(__builtin_bit_cast(float, w.x << 16), __builtin_bit_cast(float, w.x & 0xffff0000u), __builtin_bit_cast(float, w.y << 16), __builtin_bit_cast(float, w.y & 0xffff0000u)); }
DEVI void st4bf(bf16* p, float a, float b, float c, float d) { *(uint2*)p = make_uint2(cvtpk(a, b), cvtpk(c, d)); }
DEVI float fsig(float x) { return __builtin_amdgcn_rcpf(1.f + __expf(-x)); }
DEVI float ftanh(float x) { const float e = __expf(-2.f * fabsf(x)); const float t = (1.f - e) * __builtin_amdgcn_rcpf(1.f + e); return x < 0.f ? -t : t; }
DEVI float fgelu(float x) { return 0.5f * x * (1.f + ftanh(0.7978845608028654f * (x + 0.044715f * x * x * x))); }

DEVI void prep_unit(const MixP& P, int cg, LAS unsigned char* lds) {
    const int tid = tidx(), w = tid >> 6, lane = tid & 63;
    const int b = cg >> 7, pos0 = (cg & 127) * 64;
    const size_t tok0 = (size_t)cg * 64;
    const bf16* cols = P.COLS + tok0 * DINP;
    {
        LAS float* hb = (LAS float*)lds;
        __syncthreads();
        for (int e = tid; e < 94 * 64; e += 512) {
            const int row = e >> 6, c4 = (e & 63) * 4, tt = row - 30;
            float4 h = make_float4(0.f, 0.f, 0.f, 0.f);
            if (pos0 + tt >= 0) {
                const bf16* cr = cols + (long)tt * DINP;
                const float4 v = ld4bf(cr + OFF_CV + c4), g = ld4bf(cr + OFF_CG + c4);
                h = make_float4(v.x * fsig(g.x), v.y * fsig(g.y), v.z * fsig(g.z), v.w * fsig(g.w));
            }
            { typedef float f32x4v __attribute__((ext_vector_type(4))); *(LAS f32x4v*)(hb + row * 256 + c4) = (f32x4v){h.x, h.y, h.z, h.w}; }
        }
        __syncthreads();
        const int c = tid & 255, half = tid >> 8;
        float wj[31];
#pragma unroll
        for (int j = 0; j < 31; ++j) wj[j] = P.conv_w[j * 256 + c];
        const float bias = P.conv_b[c], gg = P.conv_gg[c], gb = P.conv_gb[c];
#pragma unroll 1
        for (int q = 0; q < 4; ++q) {
            float xs[38];
            const int tb = 32 * half + 8 * q;
#pragma unroll
            for (int i = 0; i < 38; ++i) xs[i] = hb[(tb + i) * 256 + c];
#pragma unroll
            for (int t = 0; t < 8; ++t) {
                float acc = bias;
#pragma unroll
                for (int j = 0; j < 31; ++j) acc = fmaf(wj[j], xs[t + j], acc);
                const float mean = wave_sum(acc) * (1.f / 64.f);
                const float d = acc - mean;
                const float var = wave_sum(d * d) * (1.f / 64.f);
                const float y = d * rsqrtf(var + 1e-5f) * gg + gb;
                P.MIX[(tok0 + tb + t) * DM + c] = (bf16)f2bf(y * fsig(y));
            }
        }
    }
    {
        const float4 lg = *(const float4*)(P.gl_g + lane * 4), lb = *(const float4*)(P.gl_b + lane * 4);
#pragma unroll 2
        for (int i = 0; i < 8; ++i) {
            const int t = w * 8 + i; const bf16* cr = cols + (size_t)t * DINP;
            const float4 u = ld4bf(cr + OFF_GU + lane * 4);
            st4bf(P.UB + (tok0 + t) * 256 + lane * 4, fgelu(u.x), fgelu(u.y), fgelu(u.z), fgelu(u.w));
            float4 v = ld4bf(cr + OFF_GV + lane * 4);
            v = make_float4(fgelu(v.x), fgelu(v.y), fgelu(v.z), fgelu(v.w));
            const float mean = wave_sum((v.x + v.y) + (v.z + v.w)) * (1.f / 256.f);
            v.x -= mean; v.y -= mean; v.z -= mean; v.w -= mean;
            const float var = wave_sum((v.x * v.x + v.y * v.y) + (v.z * v.z + v.w * v.w)) * (1.f / 256.f);
            const float rs = rsqrtf(var + 1e-5f);
            st4bf(P.VB + (tok0 + t) * 256 + lane * 4, v.x * rs * lg.x + lb.x, v.y * rs * lg.y + lb.y, v.z * rs * lg.z + lb.z, v.w * rs * lg.w + lb.w);
        }
    }
    {
        LAS float* cst = (LAS float*)lds;
        LAS unsigned short* vt = (LAS unsigned short*)(lds + 16384);
        __syncthreads();
        for (int e = tid; e < 2048; e += 512) {
            const int t = e >> 5, j = e & 31;
            const float inv = powf(10000.f, -(float)j / 32.f);
            float sn, cs; sincosf((float)(pos0 + t) * inv, &sn, &cs);
            cst[e * 2] = cs; cst[e * 2 + 1] = sn;
        }
        __syncthreads();
#pragma unroll 1
        for (int i = 0; i < 8; ++i) {
            const int t = w * 8 + i; const bf16* cr = cols + (size_t)t * DINP; const size_t tok = tok0 + t;
            {
                const int d4 = (lane & 15) * 4;
                const float4 x = ld4bf(cr + OFF_Q + lane * 4);
                const float4 pr = make_float4(__shfl_xor(x.x, 8, 64), __shfl_xor(x.y, 8, 64), __shfl_xor(x.z, 8, 64), __shfl_xor(x.w, 8, 64));
                const LAS float* cp = cst + (t * 32 + (d4 & 31)) * 2;
                const float sg = d4 < 32 ? -1.f : 1.f;
                st4bf(P.QN + tok * 256 + lane * 4, x.x * QSCL, x.y * QSCL, x.z * QSCL, x.w * QSCL);
                st4bf(P.QR + tok * 256 + lane * 4, (x.x * cp[0] + sg * pr.x * cp[1]) * QSCL, (x.y * cp[2] + sg * pr.y * cp[3]) * QSCL,
                      (x.z * cp[4] + sg * pr.z * cp[5]) * QSCL, (x.w * cp[6] + sg * pr.w * cp[7]) * QSCL);
            }
            {
                const int seg = lane >> 4, d4 = (lane & 15) * 4;
                const float4 x = ld4bf(cr + OFF_KS + seg * 64 + d4);
                const float4 pr = make_float4(__shfl_xor(x.x, 8, 64), __shfl_xor(x.y, 8, 64), __shfl_xor(x.z, 8, 64), __shfl_xor(x.w, 8, 64));
                if ((seg & 1) == 0) {
                    const LAS float* cp = cst + (t * 32 + (d4 & 31)) * 2;
                    const float sg = d4 < 32 ? -1.f : 1.f;
                    bf16* dst = (seg == 0 ? P.KSR : P.KWR) + tok * 64 + d4;
                    st4bf(dst, x.x * cp[0] + sg * pr.x * cp[1], x.y * cp[2] + sg * pr.y * cp[3], x.z * cp[4] + sg * pr.z * cp[5], x.w * cp[6] + sg * pr.w * cp[7]);
                } else {
                    LAS unsigned short* vp = vt + (seg >> 1) * 4096 + d4 * 64 + t;
                    vp[0] = (unsigned short)f2bf(x.x); vp[64] = (unsigned short)f2bf(x.y); vp[128] = (unsigned short)f2bf(x.z); vp[192] = (unsigned short)f2bf(x.w);
                }
            }
            if (lane < 12) P.GATES[tok * 12 + lane] = fsig(bf2f(cr[OFF_GT + lane]));
        }
        __syncthreads();
        for (int e = tid; e < 1024; e += 512) {
            const int which = e >> 9, d = (e >> 3) & 63, ch = e & 7;
            const v4u v = *(const LAS v4u*)((LAS unsigned char*)vt + which * 8192 + d * 128 + ch * 16);
            *(v4u*)((which ? P.VWT : P.VST) + ((size_t)b * 64 + d) * SEQ + pos0 + ch * 8) = v;
        }
        for (int e = tid; e < 4 * 512 * 2; e += 512) {
            const int isv = e >> 11, r = e & 2047, nl = r >> 9, i4 = (r & 511) * 4, l = i4 >> 6, d = i4 & 63;
            const int n = 4 * (cg & 127) + nl;
            bf16* dst = (isv ? P.BLV : P.BLK) + ((size_t)b * 512 + n) * 2048 + i4;
            if (n < NCMP) {
                const float4 x = ld4bf(cols + (size_t)(16 * nl + l) * DINP + (isv ? OFF_VC : OFF_KC) + d);
                const float4 pe = *(const float4*)((isv ? P.pe_v : P.pe_k) + i4);
                st4bf(dst, x.x + pe.x, x.y + pe.y, x.z + pe.z, x.w + pe.w);
            } else *(uint2*)dst = make_uint2(0u, 0u);
        }
    }
    {
        LAS unsigned char* TW = lds;
        LAS unsigned char* AD = lds + 8192;
        LAS unsigned char* SG = lds + 16384;
        LAS unsigned char* VD = lds + 32768;
        LAS float* CAR = (LAS float*)(lds + 36864);
        __syncthreads();
        for (int e = tid; e < 64 * 64; e += 512) {
            const int t = e >> 6, j4 = (e & 63) * 4;
            const bf16* cr = cols + (size_t)t * DINP + OFF_RW + 768 + j4;
            const float4 c4 = ld4bf(cr);
            float4 p4 = make_float4(0.f, 0.f, 0.f, 0.f);
            if (pos0 + t > 0) p4 = ld4bf(cr - DINP);
            const float4 m4 = *(const float4*)(P.mu + 768 + j4);
            float y0 = c4.x + m4.x * (p4.x - c4.x), y1 = c4.y + m4.y * (p4.y - c4.y), y2 = c4.z + m4.z * (p4.z - c4.z), y3 = c4.w + m4.w * (p4.w - c4.w);
            if (j4 < 64) { y0 = ftanh(y0); y1 = ftanh(y1); y2 = ftanh(y2); y3 = ftanh(y3);
                *(LAS u32x2v*)(TW + rw_off(t, j4 >> 3) + (j4 & 7) * 2) = (u32x2v){cvtpk(y0, y1), cvtpk(y2, y3)}; }
            else if (j4 < 128) { const int jj = j4 - 64;
                *(LAS u32x2v*)(AD + rw_off(t, jj >> 3) + (jj & 7) * 2) = (u32x2v){cvtpk(y0, y1), cvtpk(y2, y3)}; }
            else { const int jj = j4 - 128; y0 = fsig(y0); y1 = fsig(y1); y2 = fsig(y2); y3 = fsig(y3);
                *(LAS u32x2v*)(SG + t * 256 + (((jj >> 3) ^ (t & 7)) << 4) + (jj & 7) * 2) = (u32x2v){cvtpk(y0, y1), cvtpk(y2, y3)}; }
        }
        if (P.layer > 0) {
            const int t = tid >> 3, j4 = (tid & 7) * 4;
            const bf16* cr = cols + (size_t)t * DINP + DIN + j4;
            const float4 c4 = ld4bf(cr);
            float4 p4 = make_float4(0.f, 0.f, 0.f, 0.f);
            if (pos0 + t > 0) p4 = ld4bf(cr - DINP);
            const float4 m4 = *(const float4*)(P.v_mu + j4);
            *(LAS u32x2v*)(VD + t * 64 + j4 * 2) = (u32x2v){cvtpk(c4.x + m4.x * (p4.x - c4.x), c4.y + m4.y * (p4.y - c4.y)), cvtpk(c4.z + m4.z * (p4.z - c4.z), c4.w + m4.w * (p4.w - c4.w))};
        }
        __syncthreads();
        const int h = w >> 1, tb = w & 1, r32 = lane & 31, hi = lane >> 5;
        const int t = 32 * tb + r32;
        const size_t tok = tok0 + t;
        const bool hasprev = (pos0 + t) > 0;
        const bf16* crow_ = cols + (size_t)t * DINP + OFF_RW;
        float n2 = 0.f, bd = 0.f;
#pragma unroll 1
        for (int cb = 0; cb < 2; ++cb) {
            f32x16 al; rw_zero(al);
            const bf16* arow = P.AUP_T + (size_t)(h * 64 + 32 * cb + r32) * 64 + 8 * hi;
#pragma unroll
            for (int s = 0; s < 4; ++s) al = __builtin_amdgcn_mfma_f32_32x32x16_bf16(*(const bf16x8*)(arow + 16 * s), rw_frag(AD, tb, s, r32, hi), al, 0, 0, 0);
#pragma unroll
            for (int g = 0; g < 4; ++g) {
                const int ch = h * 64 + 32 * cb + 8 * g + 4 * hi;
                const float4 rc = ld4bf(crow_ + ch), kc = ld4bf(crow_ + 256 + ch);
                float4 rp = make_float4(0.f, 0.f, 0.f, 0.f), kp = rp;
                if (hasprev) { rp = ld4bf(crow_ - DINP + ch); kp = ld4bf(crow_ - DINP + 256 + ch); }
                const float4 mr = *(const float4*)(P.mu + ch), mk = *(const float4*)(P.mu + 256 + ch);
                const float4 a0 = *(const float4*)(P.a0 + ch), kk_ = *(const float4*)(P.k_k + ch), ka = *(const float4*)(P.k_a + ch), rk = *(const float4*)(P.r_k + ch);
                const float rr[4] = {rc.x + mr.x * (rp.x - rc.x), rc.y + mr.y * (rp.y - rc.y), rc.z + mr.z * (rp.z - rc.z), rc.w + mr.w * (rp.w - rc.w)};
                const float kv[4] = {kc.x + mk.x * (kp.x - kc.x), kc.y + mk.y * (kp.y - kc.y), kc.z + mk.z * (kp.z - kc.z), kc.w + mk.w * (kp.w - kc.w)};
                const float a0v[4] = {a0.x, a0.y, a0.z, a0.w}, kkv[4] = {kk_.x, kk_.y, kk_.z, kk_.w}, kav[4] = {ka.x, ka.y, ka.z, ka.w}, rkv[4] = {rk.x, rk.y, rk.z, rk.w};
#pragma unroll
                for (int e = 0; e < 4; ++e) {
                    const float a = fsig(a0v[e] + al[4 * g + e]);
                    const float kq = kv[e] * kkv[e];
                    n2 = fmaf(kq, kq, n2);
                    bd = fmaf(rr[e] * rkv[e], kv[e] * (1.f + (a - 1.f) * kav[e]), bd);
                }
            }
        }
        n2 += __shfl_xor(n2, 32, 64); bd += __shfl_xor(bd, 32, 64);
        const float rnorm = 1.f / fmaxf(sqrtf(n2), 1e-12f);
        const size_t u = (size_t)cg * 4 + h;
#pragma unroll 1
        for (int cb = 0; cb < 2; ++cb) {
            f32x16 al, wl, gl, vm; rw_zero(al); rw_zero(wl); rw_zero(gl); rw_zero(vm);
            const int chrow = h * 64 + 32 * cb + r32;
            const bf16* arow = P.AUP_T + (size_t)chrow * 64 + 8 * hi;
            const bf16* wrow = P.WUP_T + (size_t)chrow * 64 + 8 * hi;
            const bf16* grow = P.GUP_T + (size_t)chrow * 128 + 8 * hi;
#pragma unroll
            for (int s = 0; s < 4; ++s) {
                al = __builtin_amdgcn_mfma_f32_32x32x16_bf16(*(const bf16x8*)(arow + 16 * s), rw_frag(AD, tb, s, r32, hi), al, 0, 0, 0);
                wl = __builtin_amdgcn_mfma_f32_32x32x16_bf16(*(const bf16x8*)(wrow + 16 * s), rw_frag(TW, tb, s, r32, hi), wl, 0, 0, 0);
            }
#pragma unroll
            for (int s = 0; s < 8; ++s) {
                const bf16x8 bfr = *(const LAS bf16x8*)(SG + t * 256 + (((2 * s + hi) ^ (t & 7)) << 4));
                gl = __builtin_amdgcn_mfma_f32_32x32x16_bf16(*(const bf16x8*)(grow + 16 * s), bfr, gl, 0, 0, 0);
            }
            if (P.layer > 0) {
                const bf16* vrow = P.VUP_T + (size_t)chrow * 32 + 8 * hi;
#pragma unroll
                for (int s = 0; s < 2; ++s) {
                    const bf16x8 bfr = *(const LAS bf16x8*)(VD + t * 64 + (2 * s + hi) * 16);
                    vm = __builtin_amdgcn_mfma_f32_32x32x16_bf16(*(const bf16x8*)(vrow + 16 * s), bfr, vm, 0, 0, 0);
                }
            }
            f32x16 lw, cum;
#pragma unroll
            for (int g = 0; g < 4; ++g) {
                const float4 w0 = *(const float4*)(P.w0 + h * 64 + 32 * cb + 8 * g + 4 * hi);
                const float w0v[4] = {w0.x, w0.y, w0.z, w0.w};
#pragma unroll
                for (int e = 0; e < 4; ++e) {
                    const float x = -(w0v[e] + wl[4 * g + e]);
                    const float sp = fmaxf(x, 0.f) + __logf(1.f + __expf(-fabsf(x)));
                    lw[4 * g + e] = -__expf(-sp - 0.5f);
                }
            }
#pragma unroll
            for (int r = 0; r < 16; ++r) {
                float s = lw[r];
#pragma unroll
                for (int dl = 1; dl < 32; dl <<= 1) { const float o = __shfl_up(s, dl, 32); if (r32 >= dl) s += o; }
                cum[r] = s;
            }
            if (tb == 0 && r32 == 31) {
#pragma unroll
                for (int r = 0; r < 16; ++r) CAR[h * 64 + 32 * cb + crow(r, hi)] = cum[r];
            }
            __syncthreads();
            if (tb == 1) {
#pragma unroll
                for (int r = 0; r < 16; ++r) cum[r] += CAR[h * 64 + 32 * cb + crow(r, hi)];
            }
#pragma unroll
            for (int g = 0; g < 4; ++g) {
                const int cl = 32 * cb + 8 * g + 4 * hi, ch = h * 64 + cl;
                const float4 rc = ld4bf(crow_ + ch), kc = ld4bf(crow_ + 256 + ch), vc = ld4bf(crow_ + 512 + ch);
                float4 rp = make_float4(0.f, 0.f, 0.f, 0.f), kp = rp, vp = rp;
                if (hasprev) { rp = ld4bf(crow_ - DINP + ch); kp = ld4bf(crow_ - DINP + 256 + ch); vp = ld4bf(crow_ - DINP + 512 + ch); }
                const float4 mr = *(const float4*)(P.mu + ch), mk = *(const float4*)(P.mu + 256 + ch), mv = *(const float4*)(P.mu + 512 + ch);
                const float4 a0 = *(const float4*)(P.a0 + ch), kk_ = *(const float4*)(P.k_k + ch), ka = *(const float4*)(P.k_a + ch);
                const float rr[4] = {rc.x + mr.x * (rp.x - rc.x), rc.y + mr.y * (rp.y - rc.y), rc.z + mr.z * (rp.z - rc.z), rc.w + mr.w * (rp.w - rc.w)};
                const float kv[4] = {kc.x + mk.x * (kp.x - kc.x), kc.y + mk.y * (kp.y - kc.y), kc.z + mk.z * (kp.z - kc.z), kc.w + mk.w * (kp.w - kc.w)};
                float vv[4] = {vc.x + mv.x * (vp.x - vc.x), vc.y + mv.y * (vp.y - vc.y), vc.z + mv.z * (vp.z - vc.z), vc.w + mv.w * (vp.w - vc.w)};
                const float a0v[4] = {a0.x, a0.y, a0.z, a0.w}, kkv[4] = {kk_.x, kk_.y, kk_.z, kk_.w}, kav[4] = {ka.x, ka.y, ka.z, ka.w};
                if (P.layer == 0) {
                    st4bf(P.VFIRST + tok * 256 + ch, vv[0], vv[1], vv[2], vv[3]);
                } else {
                    const float4 vf = ld4bf(P.VFIRST + tok * 256 + ch), v0 = *(const float4*)(P.v0 + ch);
                    const float vfv[4] = {vf.x, vf.y, vf.z, vf.w}, v0v[4] = {v0.x, v0.y, v0.z, v0.w};
#pragma unroll
                    for (int e = 0; e < 4; ++e) vv[e] = vv[e] + (vfv[e] - vv[e]) * fsig(v0v[e] + vm[4 * g + e]);
                }
                float at[4], bt[4], kt[4], rt[4], bo[4];
#pragma unroll
                for (int e = 0; e < 4; ++e) {
                    const float a = fsig(a0v[e] + al[4 * g + e]);
                    const float kkn = kv[e] * kkv[e] * rnorm;
                    const float k2 = kv[e] * (1.f + (a - 1.f) * kav[e]);
                    const float cu = cum[4 * g + e];
                    const float ein = __expf(cu), eout = __expf(-cu), eex = __expf(cu - lw[4 * g + e]);
                    at[e] = -kkn * eex; bt[e] = kkn * a * eout; kt[e] = k2 * eout; rt[e] = rr[e] * ein; bo[e] = bd * vv[e];
                    if (t == 63) P.LAM[u * 64 + cl + e] = ein;
                }
                const size_t bo_ = (u * 64 + t) * 64 + cl;
                st4bf(P.AT + bo_, at[0], at[1], at[2], at[3]); st4bf(P.BT + bo_, bt[0], bt[1], bt[2], bt[3]);
                st4bf(P.KT + bo_, kt[0], kt[1], kt[2], kt[3]); st4bf(P.RT + bo_, rt[0], rt[1], rt[2], rt[3]);
                st4bf(P.V + tok * 256 + ch, vv[0], vv[1], vv[2], vv[3]);
                st4bf(P.G + tok * 256 + ch, gl[4 * g], gl[4 * g + 1], gl[4 * g + 2], gl[4 * g + 3]);
                st4bf(P.BON + tok * 256 + ch, bo[0], bo[1], bo[2], bo[3]);
            }
        }
    }
}

DEVI void gmlp_unit(const bf16* __restrict__ UB, const bf16* __restrict__ VB, const bf16* __restrict__ GWS  , const float* __restrict__ bs,
                    bf16* __restrict__ MIX, int c128, LAS unsigned char* lds) {
    const int tid = tidx(), w = tid >> 6, lane = tid & 63, r32 = lane & 31, hi = lane >> 5;
    const size_t T0 = (size_t)c128 * 128;
    __syncthreads();
    for (int e = tid; e < 128 * 32; e += 512) {
        const int s = e >> 5, c8 = (e & 31) * 8;
        const v4u v = *(const v4u*)(VB + (T0 + s) * 256 + c8);
        const unsigned wv[4] = {v.x, v.y, v.z, v.w};
#pragma unroll
        for (int j = 0; j < 8; ++j) { const int ch = c8 + j;
            *(LAS unsigned short*)(lds + ch * 256 + (((s >> 3) ^ (ch & 7)) << 4) + (s & 7) * 2) = (unsigned short)(wv[j >> 1] >> ((j & 1) * 16)); }
    }
    __syncthreads();
    const int h = w & 3, th = w >> 2;
    f32x16 acc[2][2];
#pragma unroll
    for (int i = 0; i < 2; ++i)
#pragma unroll
        for (int j = 0; j < 2; ++j) rw_zero(acc[i][j]);
    const int nks = 4 * (th + 1);
#pragma unroll 1
    for (int s = 0; s < nks; ++s) {
        bf16x8 bfr[2];
#pragma unroll
        for (int cb = 0; cb < 2; ++cb) { const int ch = h * 64 + 32 * cb + r32; bfr[cb] = *(const LAS bf16x8*)(lds + ch * 256 + (((2 * s + hi) ^ (ch & 7)) << 4)); }
#pragma unroll
        for (int rb = 0; rb < 2; ++rb) {
            const bf16x8 afr = *(const bf16x8*)(GWS + ((size_t)h * 128 + 64 * th + 32 * rb + r32) * 128 + 16 * s + 8 * hi);
#pragma unroll
            for (int cb = 0; cb < 2; ++cb) acc[rb][cb] = __builtin_amdgcn_mfma_f32_32x32x16_bf16(afr, bfr[cb], acc[rb][cb], 0, 0, 0);
        }
    }
#pragma unroll
    for (int rb = 0; rb < 2; ++rb)
#pragma unroll
        for (int cb = 0; cb < 2; ++cb)
#pragma unroll
            for (int r = 0; r < 16; ++r) {
                const int tt = 64 * th + 32 * rb + crow(r, hi), ch = h * 64 + 32 * cb + r32;
                const float uu = bf2f(UB[(T0 + tt) * 256 + ch]);
                MIX[(T0 + tt) * DM + 512 + ch] = (bf16)f2bf(uu * (acc[rb][cb][r] + bs[h * 128 + tt]));
            }
}
#define DPP_ADD(x, ctrl) ((x) + __int_as_float(__builtin_amdgcn_update_dpp(0, __float_as_int(x), (ctrl), 0xF, 0xF, true)))
DEVI float wsum_all(float v) {
    v = DPP_ADD(v, 0xB1);
    v = DPP_ADD(v, 0x4E);
    v = DPP_ADD(v, 0x141);
    v = DPP_ADD(v, 0x140);
    const float r0 = __int_as_float(__builtin_amdgcn_readlane(__float_as_int(v), 0)), r1 = __int_as_float(__builtin_amdgcn_readlane(__float_as_int(v), 16));
    const float r2 = __int_as_float(__builtin_amdgcn_readlane(__float_as_int(v), 32)), r3 = __int_as_float(__builtin_amdgcn_readlane(__float_as_int(v), 48));
    return (r0 + r1) + (r2 + r3);
}
DEVI void ln_finish(float (&v)[16], const float* __restrict__ g, const float* __restrict__ bt, float* orow, bf16* obrow, int lane) {
    float s = 0.f;
#pragma unroll
    for (int i = 0; i < 16; ++i) s += v[i];
    const float mean = wsum_all(s) * (1.f / DM);
    float q = 0.f;
#pragma unroll
    for (int i = 0; i < 16; ++i) { v[i] -= mean; q += v[i] * v[i]; }
    const float rstd = rsqrtf(wsum_all(q) * (1.f / DM) + 1e-5f);
#pragma unroll
    for (int j = 0; j < 4; ++j) {
        const int c = lane * 4 + 256 * j;
        const float4 gg = *(const float4*)(g + c), bb = *(const float4*)(bt + c);
        v[4 * j] = v[4 * j] * rstd * gg.x + bb.x; v[4 * j + 1] = v[4 * j + 1] * rstd * gg.y + bb.y;
        v[4 * j + 2] = v[4 * j + 2] * rstd * gg.z + bb.z; v[4 * j + 3] = v[4 * j + 3] * rstd * gg.w + bb.w;
        *(float4*)(orow + c) = make_float4(v[4 * j], v[4 * j + 1], v[4 * j + 2], v[4 * j + 3]);
        *(uint2*)(obrow + c) = make_uint2(cvtpk(v[4 * j], v[4 * j + 1]), cvtpk(v[4 * j + 2], v[4 * j + 3]));
    }
}
DEVI void ln_rows(const float* xres, float alpha, const float* add, const float* __restrict__ g, const float* __restrict__ bt, float* out, bf16* outb, int B0, int G) {
    const int gw = B0 * NWAVES + (tidx() >> 6); int lane = tidx() & 63;
    for (int row = gw; row < NTOK; row += G * NWAVES) {
        asm volatile("" : "+v"(lane));
        float v[16];
#pragma unroll
        for (int j = 0; j < 4; ++j) {
            const size_t idx = (size_t)row * DM + lane * 4 + 256 * j;
            const float4 x = *(const float4*)(xres + idx);
            float4 a = make_float4(0.f, 0.f, 0.f, 0.f);
            if (add) a = *(const float4*)(add + idx);
            v[4 * j] = alpha * x.x + a.x; v[4 * j + 1] = alpha * x.y + a.y; v[4 * j + 2] = alpha * x.z + a.z; v[4 * j + 3] = alpha * x.w + a.w;
        }
        ln_finish(v, g, bt, out + (size_t)row * DM, outb + (size_t)row * DM, lane);
    }
}
DEVI void ln_router_rows(const float* xres, const float* add, const float* __restrict__ g, const float* __restrict__ bt, float* out, bf16* outb,
                         const float* __restrict__ rw, const float* __restrict__ rb, int* __restrict__ te, float* __restrict__ tw, int* __restrict__ trel,
                         int* __restrict__ cnt, int B0, int G) {
    const int gw = B0 * NWAVES + (tidx() >> 6); int lane = tidx() & 63;
    int mycnt = 0;
    int my_row = -1, my_e0 = 0, my_e1 = 0, my_r0 = 0, my_r1 = 0; int kk_ = 0;
    for (int row = gw; row < NTOK; row += G * NWAVES, ++kk_) {
        asm volatile("" : "+v"(lane));
        float v[16];
#pragma unroll
        for (int j = 0; j < 4; ++j) {
            const size_t idx = (size_t)row * DM + lane * 4 + 256 * j;
            const float4 x = *(const float4*)(xres + idx), a = *(const float4*)(add + idx);
            v[4 * j] = ALPHA * x.x + a.x; v[4 * j + 1] = ALPHA * x.y + a.y; v[4 * j + 2] = ALPHA * x.z + a.z; v[4 * j + 3] = ALPHA * x.w + a.w;
        }
        ln_finish(v, g, bt, out + (size_t)row * DM, outb + (size_t)row * DM, lane);
        float lg[16];
#pragma unroll
        for (int e = 0; e < 16; ++e) lg[e] = 0.f;
#pragma unroll
        for (int j = 0; j < 4; ++j)
#pragma unroll
            for (int k = 0; k < 4; ++k) {
                const float xv = v[4 * j + k];
                const float4* wr = (const float4*)(rw + (size_t)(lane * 4 + 256 * j + k) * 16);
                const float4 w0 = wr[0], w1 = wr[1], w2 = wr[2], w3 = wr[3];
                lg[0] = fmaf(xv, w0.x, lg[0]); lg[1] = fmaf(xv, w0.y, lg[1]); lg[2] = fmaf(xv, w0.z, lg[2]); lg[3] = fmaf(xv, w0.w, lg[3]);
                lg[4] = fmaf(xv, w1.x, lg[4]); lg[5] = fmaf(xv, w1.y, lg[5]); lg[6] = fmaf(xv, w1.z, lg[6]); lg[7] = fmaf(xv, w1.w, lg[7]);
                lg[8] = fmaf(xv, w2.x, lg[8]); lg[9] = fmaf(xv, w2.y, lg[9]); lg[10] = fmaf(xv, w2.z, lg[10]); lg[11] = fmaf(xv, w2.w, lg[11]);
                lg[12] = fmaf(xv, w3.x, lg[12]); lg[13] = fmaf(xv, w3.y, lg[13]); lg[14] = fmaf(xv, w3.z, lg[14]); lg[15] = fmaf(xv, w3.w, lg[15]);
            }
#pragma unroll
        for (int e = 0; e < 16; ++e) lg[e] = wsum_all(lg[e]);
        float m = lg[0];
#pragma unroll
        for (int e = 1; e < 16; ++e) m = fmaxf(m, lg[e]);
        float pr[16], sum = 0.f;
#pragma unroll
        for (int e = 0; e < 16; ++e) { pr[e] = expf(lg[e] - m); sum += pr[e]; }
        float sl[16];
#pragma unroll
        for (int e = 0; e < 16; ++e) { pr[e] /= sum; sl[e] = pr[e] + rb[e]; }
        int bg = 0; float bgs = -INFINITY;
#pragma unroll
        for (int gI = 0; gI < 4; ++gI) {
            float m1 = -INFINITY, m2 = -INFINITY;
#pragma unroll
            for (int j = 0; j < 4; ++j) { const float x = sl[gI * 4 + j]; if (x > m1) { m2 = m1; m1 = x; } else if (x > m2) m2 = x; }
            const float sc = m1 + m2;
            if (sc > bgs) { bgs = sc; bg = gI; }
        }
        int e0 = -1, e1 = -1; float s0 = -INFINITY, s1 = -INFINITY, p0 = 0.f, p1 = 0.f;
#pragma unroll
        for (int e = 0; e < 16; ++e) {
            if ((e >> 2) == bg) {
                const float x = sl[e];
                if (x > s0) { s1 = s0; e1 = e0; p1 = p0; s0 = x; e0 = e; p0 = pr[e]; } else if (x > s1) { s1 = x; e1 = e; p1 = pr[e]; }
            }
        }
        if (lane == 0) {
            const float ws = p0 + p1;
            te[row * 2] = e0; te[row * 2 + 1] = e1; tw[row * 2] = p0 / ws; tw[row * 2 + 1] = p1 / ws;
        }
        const int r0 = __shfl(mycnt, e0, 64), r1 = __shfl(mycnt, e1, 64);
        if (lane == e0 || lane == e1) ++mycnt;
        if (lane == kk_) { my_row = row; my_e0 = e0; my_e1 = e1; my_r0 = r0; my_r1 = r1; }
    }
    int base = 0;
    if (lane < 16 && mycnt > 0) base = atomicAdd(&cnt[lane], mycnt);
    const int b0 = __shfl(base, my_e0, 64), b1 = __shfl(base, my_e1, 64);
    if (my_row >= 0) { trel[my_row * 2] = b0 + my_r0; trel[my_row * 2 + 1] = b1 + my_r1; }
}
DEVI void moe_gather2(const bf16* __restrict__ xn, const int* __restrict__ te, const int* __restrict__ trel, const int* __restrict__ cnt, int* __restrict__ slot,
                      int* __restrict__ nrt, int* __restrict__ tile_e, bf16* __restrict__ xg, int B0, int G, LAS int* ofs) {
    __syncthreads();
    if (tidx() == 0) {
        int s = 0;
#pragma unroll 1
        for (int e = 0; e < 16; ++e) { const int c = cnt[e]; ofs[e] = s; ofs[17 + e] = c; s += (c + 255) & ~255; }
        ofs[16] = s;
    }
    __syncthreads();
    const int gw = B0 * NWAVES + (tidx() >> 6), lane = tidx() & 63;
    if (B0 == 0 && tidx() < 16) {
        const int e = tidx();
        for (int r = ofs[e] >> 8; r < (ofs[e + 1] >> 8); ++r) tile_e[r] = e;
        if (e == 0) *nrt = ofs[16] >> 8;
    }
    if (B0 < 16) {
        const int o1 = ofs[B0 + 1];
        for (int r = ofs[B0] + ofs[17 + B0] + (tidx() >> 6); r < o1; r += NWAVES) { v4u* d = (v4u*)(xg + (size_t)r * DM); d[lane] = (v4u){0u, 0u, 0u, 0u}; d[lane + 64] = (v4u){0u, 0u, 0u, 0u}; }
    }
    for (int tok = gw; tok < NTOK; tok += G * NWAVES) {
        const v4u* s = (const v4u*)(xn + (size_t)tok * DM);
        const v4u a = s[lane], b = s[lane + 64];
#pragma unroll
        for (int q = 0; q < 2; ++q) {
            const int pr = ofs[te[tok * 2 + q]] + trel[tok * 2 + q];
            v4u* d = (v4u*)(xg + (size_t)pr * DM); d[lane] = a; d[lane + 64] = b;
            if (lane == 0) slot[tok * 2 + q] = pr;
        }
    }
}
DEVI void moe_combine_rows(const float* x, const bf16* __restrict__ Dp, const int* __restrict__ te, const float* __restrict__ tw, const int* __restrict__ slot,
                           const float* __restrict__ g, const float* __restrict__ bt, float* out, bf16* outb, int B0, int G) {
    const int gw = B0 * NWAVES + (tidx() >> 6); int lane = tidx() & 63;
    for (int row = gw; row < NTOK; row += G * NWAVES) {
        asm volatile("" : "+v"(lane));
        int ea = te[row * 2], eb = te[row * 2 + 1];
        float wa = tw[row * 2], wb = tw[row * 2 + 1];
        size_t pa = slot[row * 2], pb = slot[row * 2 + 1];
        if (eb < ea) { const float tf = wa; wa = wb; wb = tf; const size_t tp = pa; pa = pb; pb = tp; }
        float v[16];
#pragma unroll
        for (int j = 0; j < 4; ++j) {
            const int c = lane * 4 + 256 * j;
            const float4 xx = *(const float4*)(x + (size_t)row * DM + c);
            const float4 da = ld4bf(Dp + pa * DM + c), db = ld4bf(Dp + pb * DM + c);
            v[4 * j] = ALPHA * xx.x + (wa * da.x + wb * db.x); v[4 * j + 1] = ALPHA * xx.y + (wa * da.y + wb * db.y);
            v[4 * j + 2] = ALPHA * xx.z + (wa * da.z + wb * db.z); v[4 * j + 3] = ALPHA * xx.w + (wa * da.w + wb * db.w);
        }
        ln_finish(v, g, bt, out + (size_t)row * DM, outb + (size_t)row * DM, lane);
    }
}
struct MP {
    const float* in[50];
    float *X, *TW, *R0;
    bf16 *XN, *MIX, *WIN_T, *WOUT_T, *WQK_T, *VWO_T, *W1_T, *W2_T, *LORA_T, *GWS, *VFIRST;
    int *TE, *SLOT, *LIST, *EOFF;
    unsigned* BAR;
};

DEVI void tr_item(const float* W, int K, int N, int Npad, bf16* WT, LAS float* scr, int item, int lane) {
    const int nblk = Npad / 32, kb = item / nblk, nb = item % nblk, k0 = 64 * kb, n0 = 32 * nb;
    const int n_ = n0 + (lane & 31);
#pragma unroll 8
    for (int i = 0; i < 32; ++i) { const int kk = 2 * i + (lane >> 5); scr[kk * 33 + (lane & 31)] = n_ < N ? W[(size_t)(k0 + kk) * N + n_] : 0.f; }
    LDS_WAIT(); asm volatile("" ::: "memory");
    const int c = lane & 7;
#pragma unroll
    for (int j = 0; j < 4; ++j) { const int n = (lane >> 3) + 8 * j; const LAS float* s = scr + (8 * c) * 33 + n;
        v4u o; o.x = pk2(s[0 * 33], s[1 * 33]); o.y = pk2(s[2 * 33], s[3 * 33]); o.z = pk2(s[4 * 33], s[5 * 33]); o.w = pk2(s[6 * 33], s[7 * 33]);
        *(GAS v4u*)(WT + (size_t)(n0 + n) * K + k0 + 8 * c) = o; }
    LDS_WAIT(); asm volatile("" ::: "memory");
}

DEVI void gemm_all(const GemmArgs& g, int maxM, int Z, int B0, int G, unsigned char* lds) {
    const int total = gemm_tiles(g, maxM, Z);
    for (int t0 = B0 * 2; t0 < total; t0 += G * 2) {
        const int vb = tidx() >> 8; float* sm = (float*)(lds + vb * 32768);
        const bool l0 = gemm_tile_live(g, maxM, t0), l1 = (t0 + 1 < total) && gemm_tile_live(g, maxM, t0 + 1);
        if (!l0 && !l1) continue;
        const int t = (vb && t0 + 1 < total) ? t0 + 1 : t0;
        gemm_tile(g, maxM, t, vb ? l1 : l0, sm);
    }
}

typedef const __attribute__((address_space(4))) MP* kargp_t;
DEVI kargp_t kargs() { kargp_t q = (kargp_t)__builtin_amdgcn_kernarg_segment_ptr(); asm volatile("" : "+s"(q)); return q; }
__global__ void __launch_bounds__(512, 2) mega(MP p_arg) {
#define p (*kargs())
    extern __shared__ __attribute__((aligned(16))) unsigned char lds[];
    cg::grid_group grid = cg::this_grid();
    const int G = gridDim.x, B0 = blockIdx.x;
    {
        LAS unsigned* ctl = (LAS unsigned*)((LAS unsigned char*)lds + LDSCTL_OFF);
        for (int u = threadIdx.x; u < (LDS_BYTES - LDSCTL_OFF) / 4; u += NWAVES * 64) ctl[u] = 0u;
        __syncthreads();
        if ((threadIdx.x & 63) == 0) ctl[__builtin_amdgcn_s_getreg((5 << 11) | 4) & 63u] = threadIdx.x >> 6;
    }
    __syncthreads();
    volatile LAS unsigned* MISC = (volatile LAS unsigned*)((LAS unsigned char*)lds + MISC_OFF);
    XcdBarrier bar = xcd_barrier_post(p.BAR, MISC + 8);
    grid.sync();
#define GSYNC() do { REP(24) xcd_barrier(bar); } while (0)
    float* sm0 = (float*)lds;
    LAS unsigned char* ring = (LAS unsigned char*)lds + RING_OFF;
#define VLOOP(n, body) for (int t0_ = B0 * 2; t0_ < (n); t0_ += G * 2) { const int vb = tidx() >> 8; float* sm = (float*)(lds + vb * 32768); const int t = min(t0_ + vb, (n) - 1); body; }

#define x_in (p.in[0])
#define mem (p.in[1])
#define RB ((unsigned char*)p.R0)
#define SZ_TB ((size_t)NTOK * 256 * 2)
#define rAT ((bf16*)RB)
#define rBT ((bf16*)(RB + 1 * SZ_TB))
#define rKT ((bf16*)(RB + 2 * SZ_TB))
#define rRT ((bf16*)(RB + 3 * SZ_TB))
#define rV ((bf16*)(RB + 4 * SZ_TB))
#define rG ((bf16*)(RB + 5 * SZ_TB))
#define rBON ((bf16*)(RB + 6 * SZ_TB))
#define QNb ((bf16*)(RB + 7 * SZ_TB))
#define QRb ((bf16*)(RB + 8 * SZ_TB))
#define UBb ((bf16*)(RB + 9 * SZ_TB))
#define VBb ((bf16*)(RB + 10 * SZ_TB))
#define KSRb ((bf16*)(RB + 11 * SZ_TB))
#define KWRb (KSRb + (size_t)NTOK * 64)
#define VSTb (KWRb + (size_t)NTOK * 64)
#define VWTb (VSTb + (size_t)NTOK * 64)
#define BLKb (VWTb + (size_t)NTOK * 64)
#define BLVb (BLKb + (size_t)1024 * 2048)
#define rLAM ((float*)(BLVb + (size_t)1024 * 2048))
#define GATESb (rLAM + 1024 * 64)
#define COLSB ((bf16*)(RB + 110100480))
#define rPF ((v4u*)COLSB)
#define rHF (rPF + (size_t)1024 * 512)
#define rSF (rHF + (size_t)1024 * 512)
#define rQT ((float*)(rSF + (size_t)1024 * 512))
#define rOL (rQT + (size_t)1024 * 4096)
#define HIDK (rOL + (size_t)1024 * 4096)
#define HIDV (HIDK + (size_t)1024 * 256)
#define KCMPb ((bf16*)(HIDV + (size_t)1024 * 256))
#define VCMPTb (KCMPb + (size_t)NB * 512 * 64)
#define YBUF (p.R0)
#define PB ((bf16*)(p.R0 + (size_t)17 * 1000 * 1000))
#define XG ((bf16*)p.R0)
#define HB ((bf16*)(p.R0 + (size_t)19 * 1000 * 1000))
#define WGU_T ((bf16*)(p.R0 + (size_t)34 * 1000 * 1000))
#define WD_T ((bf16*)(p.R0 + (size_t)43 * 1000 * 1000))

    bf16* WQB = (bf16*)p.R0;
    bf16* WKT = WQB + (size_t)2 * DM * DM;
    bf16* WVT = WKT + (size_t)2 * DM * DM;
    bf16* WOT = WVT + (size_t)2 * DM * DM;
    bf16* MEMB = WOT + (size_t)2 * DM * DM;
    bf16* KMEMB = MEMB + (size_t)NB * MEML * DM;
    bf16* VMEMB = KMEMB + (size_t)2 * NB * MEML * DM;
    {
        LAS float* scr = (LAS float*)(ring + (tidx() >> 6) * 16384);
        const int gw = B0 * NWAVES + (tidx() >> 6), NGW = G * NWAVES, lane = tidx() & 63;
        constexpr int I_IN = (DM / 64) * (DINP / 32), I_SQ = (DM / 64) * (DM / 32), I_W1 = (2048 / 64) * (256 / 32);
        for (int it = gw; it < 2 * I_IN + 8 * I_SQ + 4 * I_W1; it += NGW) {
            int r = it;
            if (r < 2 * I_IN) {
                const int l = r / I_IN, item = r % I_IN; const int nblk = DINP / 32, kb = item / nblk, nb = item % nblk, k0 = 64 * kb, n0 = 32 * nb;
                const float* W = p.in[4] + (size_t)l * DM * DIN; const float* VD = p.in[21];
                const int n_ = n0 + (lane & 31);
#pragma unroll 8
                for (int i = 0; i < 32; ++i) { const int kk = 2 * i + (lane >> 5);
                    float v = 0.f;
                    if (n_ < DIN) v = W[(size_t)(k0 + kk) * DIN + n_]; else if (l == 1 && n_ < DIN + 32) v = VD[(size_t)(k0 + kk) * 32 + (n_ - DIN)];
                    scr[kk * 33 + (lane & 31)] = v; }
                LDS_WAIT(); asm volatile("" ::: "memory");
                const int c = lane & 7; bf16* WT = p.WIN_T + (size_t)l * DINP * DM;
#pragma unroll
                for (int j = 0; j < 4; ++j) { const int n = (lane >> 3) + 8 * j; const LAS float* s = scr + (8 * c) * 33 + n;
                    v4u o; o.x = pk2(s[0 * 33], s[1 * 33]); o.y = pk2(s[2 * 33], s[3 * 33]); o.z = pk2(s[4 * 33], s[5 * 33]); o.w = pk2(s[6 * 33], s[7 * 33]);
                    *(GAS v4u*)(WT + (size_t)(n0 + n) * DM + k0 + 8 * c) = o; }
                LDS_WAIT(); asm volatile("" ::: "memory");
                continue;
            }
            r -= 2 * I_IN;
            if (r < 8 * I_SQ) {
                const int which = r / (2 * I_SQ), l = (r / I_SQ) & 1, item = r % I_SQ, kb = item / 32, nb = item % 32;
                const float* W = (which == 0 ? p.in[5] : which == 1 ? p.in[38] : which == 2 ? p.in[39] : p.in[40]) + (size_t)l * DM * DM;
                bf16* WT = (which == 0 ? p.WOUT_T : which == 1 ? WKT : which == 2 ? WVT : WOT) + (size_t)l * DM * DM;
                tr_blk(W, DM, DM, kb * 64, nb * 32, WT, DM, nb * 32, 1.f, scr, lane);
                continue;
            }
            r -= 8 * I_SQ;
            {
                const int which = r / I_W1, item = r % I_W1, kb = item / 8, nb = item % 8, l = which >> 1;
                const float* W = ((which & 1) ? p.in[33] : p.in[30]) + (size_t)l * 2048 * 256;
                tr_blk(W, 256, 256, kb * 64, nb * 32, p.W1_T + (size_t)which * 256 * 2048, 2048, nb * 32, 1.f, scr, lane);
            }
        }
        for (int it = gw; it < 64; it += NGW) {
            if (it < 32) { const int which = it >> 3, nb = it & 7, l = which & 1;
                tr_blk(((which >> 1) ? p.in[14] : p.in[12]) + (size_t)l * 64 * 256, 256, 256, 0, nb * 32, p.LORA_T + (size_t)which * 256 * 64, 64, nb * 32, 1.f, scr, lane); }
            else { const int r2 = it - 32, l = r2 >> 4, kb = (r2 >> 3) & 1, nb = r2 & 7;
                tr_blk(p.in[15] + (size_t)l * 128 * 256, 256, 256, kb * 64, nb * 32, p.LORA_T + (size_t)4 * 256 * 64 + (size_t)l * 256 * 128, 128, nb * 32, 1.f, scr, lane); }
        }
        for (int e = B0 * 512 + tidx(); e < 256 * 32; e += G * 512) { const int n = e >> 5, k = e & 31;
            p.LORA_T[(size_t)4 * 256 * 64 + (size_t)2 * 256 * 128 + e] = (bf16)f2bf(p.in[24][k * 256 + n]); }
        for (int e = B0 * 512 + tidx(); e < 4 * 64 * 256; e += G * 512) { const int which = e >> 14, n = (e >> 8) & 63, k = e & 255;
            p.W2_T[e] = (bf16)f2bf(((which & 1) ? p.in[34] : p.in[31])[(size_t)(which >> 1) * 256 * 64 + k * 64 + n]); }
        for (int e = B0 * 512 + tidx(); e < 2 * 4 * 128 * 128; e += G * 512) { const int t = (e >> 7) & 127, s = e & 127;
            p.GWS[e] = s <= t ? (bf16)f2bf(p.in[27][e]) : (bf16)0; }
        cvt_bf16(p.in[37], WQB, (size_t)2 * DM * DM, 1.f, B0, G);
        cvt_bf16(mem, MEMB, (size_t)NB * MEML * DM, 1.f, B0, G);
    }
    __syncthreads();
    ln_rows(x_in, 1.0f, nullptr, p.in[2], p.in[3], p.X, p.XN, B0, G);
    GSYNC();
    {
        const int gi = B0 >> 3, un = B0 & 7;
        pg8::Gemm g{MEMB, ((gi & 1) ? WVT : WKT) + (size_t)(gi >> 1) * DM * DM, NB * MEML, DM, DM};
        pg8::OneUnit S{un >> 2, un & 3, B0 < 32 ? 1 : 0};
        pg8::EpiBf16<0> E{((gi & 1) ? VMEMB : KMEMB) + (size_t)(gi >> 1) * NB * MEML * DM, DM, nullptr, 0, 0, 1.f};
        pg8::gemm_phase<pg8::EpiBf16<0>, pg8::OneUnit, false, true>(ring, g, S, E);
    }
    GSYNC();
    {
        const int l = (B0 >> 6) & 1, kind = (B0 >> 5) & 1, bh = (B0 >> 2) & 7, q4 = B0 & 3, b = bh >> 2, h = bh & 3;
        if (kind == 0) {
            pg8::Gemm g{KMEMB + (size_t)l * NB * MEML * DM + (size_t)b * MEML * DM + h * 256, WQB + (size_t)l * DM * DM + h * 256, 256, DM, 256, DM, DM};
            pg8::OneUnit S{0, q4, B0 < 128 ? 1 : 0};
            pg8::EpiBf16S E{p.WQK_T + (size_t)l * NB * DM * DM + (size_t)b * DM * DM + (size_t)h * 256 * DM, DM, 0.0625f * 1.4426950408889634f};
            pg8::gemm_phase<pg8::EpiBf16S, pg8::OneUnit, false, true>(ring, g, S, E);
        } else {
            pg8::Gemm g{WOT + (size_t)l * DM * DM + h * 256, VMEMB + (size_t)l * NB * MEML * DM + (size_t)b * MEML * DM + h * 256, DM, 256, 256, DM, DM};
            pg8::OneUnit S{q4, 0, B0 < 128 ? 1 : 0};
            pg8::EpiBf16S E{p.VWO_T + (size_t)l * NB * DM * DM + (size_t)b * DM * DM + h * 256, DM, 1.f};
            pg8::gemm_phase<pg8::EpiBf16S, pg8::OneUnit, false, true>(ring, g, S, E);
        }
    }
    GSYNC();
    for (int l = 0; l < 2; ++l) {
REP(1) {
        {
            pg8::Gemm g{p.XN, p.WIN_T + (size_t)l * DINP * DM, NTOK, DINP, DM};
            pg8::StaticOrder S; S.init(NTOK, DINP, G, B0);
            pg8::EpiBf16<0> E{COLSB, DINP, nullptr, 0, 0, 1.f};
            pg8::gemm_phase<pg8::EpiBf16<0>, pg8::StaticOrder, true, true>(ring, g, S, E);
        }
}
        GSYNC();
#define MK_RW() RwP rw; rw.R = nullptr; rw.K = nullptr; rw.V = rV; rw.A = nullptr; rw.B = nullptr; rw.LW = nullptr; rw.G = rG; rw.BON = rBON; \
        rw.AT = rAT; rw.BT = rBT; rw.KT = rKT; rw.RT = rRT; rw.LAM = rLAM; rw.PF = rPF; rw.HF = rHF; rw.QT = rQT; rw.OL = rOL; rw.SF = rSF; \
        rw.gn_g = p.in[19] + l * 256; rw.gn_b = p.in[20] + l * 256; rw.MIX = p.MIX;
        {
            MixP mp;
            mp.COLS = COLSB;
            mp.conv_w = p.in[6] + (size_t)l * 31 * 256; mp.conv_b = p.in[7] + l * 256; mp.conv_gg = p.in[8] + l * 256; mp.conv_gb = p.in[9] + l * 256;
            mp.gl_g = p.in[25] + l * 256; mp.gl_b = p.in[26] + l * 256;
            mp.mu = p.in[10] + l * 1024; mp.w0 = p.in[11] + l * 256; mp.a0 = p.in[13] + l * 256; mp.k_k = p.in[16] + l * 256; mp.k_a = p.in[17] + l * 256; mp.r_k = p.in[18] + l * 256;
            mp.v_mu = p.in[22]; mp.v0 = p.in[23];
            mp.WUP_T = p.LORA_T + (size_t)l * 256 * 64; mp.AUP_T = p.LORA_T + (size_t)(2 + l) * 256 * 64; mp.GUP_T = p.LORA_T + (size_t)4 * 256 * 64 + (size_t)l * 256 * 128;
            mp.VUP_T = p.LORA_T + (size_t)4 * 256 * 64 + (size_t)2 * 256 * 128;
            mp.pe_k = p.in[29] + (size_t)l * 2048; mp.pe_v = p.in[32] + (size_t)l * 2048;
            mp.MIX = p.MIX; mp.UB = UBb; mp.VB = VBb;
            mp.AT = rAT; mp.BT = rBT; mp.KT = rKT; mp.RT = rRT; mp.V = rV; mp.G = rG; mp.BON = rBON; mp.VFIRST = p.VFIRST; mp.LAM = rLAM;
            mp.QN = QNb; mp.QR = QRb; mp.KSR = KSRb; mp.KWR = KWRb; mp.VST = VSTb; mp.VWT = VWTb; mp.GATES = GATESb; mp.BLK = BLKb; mp.BLV = BLVb;
            mp.layer = l; mp.pad = 0;
REP(2) {
            for (int cg = B0; cg < NTOK / 64; cg += G) prep_unit(mp, cg, ring);
}
        }
        GSYNC();
        {
REP(4) {
            {
                const int isv = (B0 >> 2) & 1;
                pg8::Gemm g{isv ? BLVb : BLKb, p.W1_T + (size_t)(l * 2 + isv) * 256 * 2048, 1024, 256, 2048};
                pg8::OneUnit S{B0 & 3, 0, B0 < 8 ? 1 : 0};
                pg8::EpiGeluW2 E{p.W2_T + (size_t)(l * 2 + isv) * 64 * 256, isv ? VCMPTb : KCMPb, isv};
                pg8::gemm_phase<pg8::EpiGeluW2, pg8::OneUnit, false, true>(ring, g, S, E);
            }
}
REP(6) {
            MK_RW()
            for (int u0 = 2 * (G - 1 - B0); u0 < 1024; u0 += 2 * G) rw_r2(rw, u0, ring);
}
REP(5) {
            for (int c = G - 1 - B0; c < NTOK / 128; c += G) gmlp_unit(UBb, VBb, p.GWS + (size_t)l * 4 * 128 * 128, p.in[28] + l * 4 * 128, p.MIX, c, ring);
}
        }
        GSYNC();
        if (B0 >= G - 2) {
REP(8) {
            { MK_RW() const int w_ = tidx() >> 6; rw_r3(rw, G - 1 - B0, w_ >> 1, w_ & 1, tidx() & 63); }
}
        } else {
REP(9) {
            for (int uu = B0; uu < NTOK / 64; uu += G - 2) {
                const int b = uu & 1, tile = SEQ / 64 - 1 - (uu >> 1);
                NsaP np; np.QN = QNb + (size_t)b * SEQ * 256; np.QR = QRb + (size_t)b * SEQ * 256; np.KSR = KSRb + (size_t)b * SEQ * 64; np.KWR = KWRb + (size_t)b * SEQ * 64;
                np.VST = VSTb + (size_t)b * 64 * SEQ; np.VWT = VWTb + (size_t)b * 64 * SEQ; np.KCMP = KCMPb + (size_t)b * 512 * 64; np.VCMPT = VCMPTb + (size_t)b * 64 * 512;
                np.GATES = GATESb + (size_t)b * SEQ * 12; np.MIX = p.MIX + (size_t)b * SEQ * DM;
                nsa_unit(np, tile, ring);
            }
}
        }
        GSYNC();
REP(10) {
        MK_RW()
        for (int i = B0 * NWAVES + (tidx() >> 6); i < 2048; i += G * NWAVES) rw_r4(rw, i >> 1, i & 1, tidx() & 63);
}
        GSYNC();
        {
REP(11) {
            pg8::Gemm g{p.MIX, p.WOUT_T + (size_t)l * DM * DM, NTOK, DM, DM};
            pg8::StaticOrder S; S.init(NTOK, DM, G, B0);
            pg8::EpiF32 E{YBUF, DM, nullptr};
            pg8::gemm_phase<pg8::EpiF32, pg8::StaticOrder, true, true>(ring, g, S, E);
}
        }
        GSYNC();
        ln_rows(p.X, ALPHA, YBUF, p.in[35] + l * DM, p.in[36] + l * DM, p.X, p.XN, B0, G);
        if (B0 == 0 && tidx() < 16) p.EOFF[512 + tidx()] = 0;
        __syncthreads();
        {
            LAS float* scr = (LAS float*)(ring + (tidx() >> 6) * 16384);
            const int gw = B0 * NWAVES + (tidx() >> 6), NGW = G * NWAVES, lane = tidx() & 63;
            const float* wg = p.in[45] + (size_t)l * 16 * DM * 512;
            const float* wu = p.in[46] + (size_t)l * 16 * DM * 512;
            const float* wd = p.in[47] + (size_t)l * 16 * 512 * DM;
            constexpr int I_GU = (DM / 64) * (512 / 32), I_D = (512 / 64) * (DM / 32);
REP(13) {
            for (int it = gw; it < 16 * (2 * I_GU + I_D); it += NGW) {
                const int e = it / (2 * I_GU + I_D); int r = it % (2 * I_GU + I_D);
                if (r < 2 * I_GU) {
                    const int isup = r / I_GU; r %= I_GU;
                    const int kb = r / 16, nb = r % 16, n0 = nb * 32;
                    tr_blk((isup ? wu : wg) + (size_t)e * DM * 512, 512, 512, kb * 64, n0, WGU_T + (size_t)e * 1024 * DM, DM, (n0 >> 7) * 256 + (n0 & 127) + isup * 128, 1.f, scr, lane);
                } else {
                    r -= 2 * I_GU;
                    const int kb = r / 32, nb = r % 32;
                    tr_blk(wd + (size_t)e * 512 * DM, DM, DM, kb * 64, nb * 32, WD_T + (size_t)e * DM * 512, 512, nb * 32, 1.f, scr, lane);
                }
            }
}
        }
        GSYNC();
        {
            bf16* WQK_T = p.WQK_T + (size_t)l * NB * DM * DM;
REP(14) {
            pg8::Gemm g{p.XN, WQK_T, NTOK, DM, DM};
            pg8::XaOrder S{G, B0};
            pg8::EpiSoftmaxP E{PB};
            pg8::gemm_phase<pg8::EpiSoftmaxP, pg8::XaOrder, false, true>(ring, g, S, E);
}
        }
        GSYNC();
        {
REP(15) {
            pg8::Gemm g{PB, p.VWO_T + (size_t)l * NB * DM * DM, NTOK, DM, DM};
            pg8::XaOrder S{G, B0};
            pg8::EpiF32N4 E{YBUF, DM};
            pg8::gemm_phase<pg8::EpiF32N4, pg8::XaOrder, true, true>(ring, g, S, E);
}
        }
        GSYNC();
        ln_router_rows(p.X, YBUF, p.in[41] + l * DM, p.in[42] + l * DM, p.X, p.XN, p.in[43], p.in[44], p.TE, p.TW, p.LIST, p.EOFF + 512, B0, G);
        GSYNC();
REP(21) {
        moe_gather2(p.XN, p.TE, p.LIST, p.EOFF + 512, p.SLOT, p.EOFF + 32, p.EOFF + 64, XG, B0, G, (LAS int*)ring);
}
        GSYNC();
        {
REP(22) {
            pg8::Gemm g{XG, WGU_T, 0, 0, DM};
            pg8::MoeOrder S{p.EOFF + 64, p.EOFF + 32, G, B0};
            pg8::EpiSiluMul E{HB};
            pg8::gemm_phase<pg8::EpiSiluMul, pg8::MoeOrder, true, true>(ring, g, S, E);
}
        }
        GSYNC();
        {
REP(23) {
            pg8::Gemm g{HB, WD_T, 0, 0, 512};
            pg8::MoeOrder S{p.EOFF + 64, p.EOFF + 32, G, B0};
            pg8::EpiBf16N4 E{XG, DM};
            pg8::gemm_phase<pg8::EpiBf16N4, pg8::MoeOrder, true, true>(ring, g, S, E);
}
        }
        GSYNC();
        moe_combine_rows(p.X, XG, p.TE, p.TW, p.SLOT, p.in[48] + l * DM, p.in[49] + l * DM, p.X, p.XN, B0, G);
        GSYNC();
    }
}

#undef RB
#undef SZ_TB
#undef rAT
#undef rBT
#undef rKT
#undef rRT
#undef rV
#undef rG
#undef rBON
#undef QNb
#undef QRb
#undef UBb
#undef VBb
#undef KSRb
#undef KWRb
#undef VSTb
#undef VWTb
#undef BLKb
#undef BLVb
#undef rLAM
#undef GATESb
#undef COLSB
#undef rPF
#undef rHF
#undef rSF
#undef rQT
#undef rOL
#undef HIDK
#undef HIDV
#undef KCMPb
#undef VCMPTb
#undef YBUF
#undef PB
#undef XG
#undef HB
#undef WGU_T
#undef WD_T
#undef x_in
#undef mem
#undef p
extern "C" void kernel_launch(void* const* d_in, const int* in_sizes, int n_in, void* d_out, int out_size, void* d_ws, size_t ws_size,
                              hipStream_t stream) {
    static int grid_blocks = 0;
    if (!grid_blocks) {
        int dev = 0, cus = 0, per_cu = 0;
        (void)hipGetDevice(&dev);
        (void)hipDeviceGetAttribute(&cus, hipDeviceAttributeMultiprocessorCount, dev);
        (void)hipFuncSetAttribute((const void*)mega, hipFuncAttributeMaxDynamicSharedMemorySize, LDS_BYTES);
        (void)hipOccupancyMaxActiveBlocksPerMultiprocessor(&per_cu, (const void*)mega, NWAVES * 64, LDS_BYTES);
        (void)hipGetLastError();
        if (per_cu < 1) { fprintf(stderr, "occupancy query says %d blocks per CU\n", per_cu); per_cu = 1; }
        grid_blocks = cus;
    }
    MP p; memset(&p, 0, sizeof(p));
    for (int i = 0; i < 50; ++i) p.in[i] = (const float*)d_in[i];
    char* ws = (char*)d_ws;
    size_t o = 0;
    auto take = [&](size_t bytes) { char* q = ws + o; o += (bytes + 255) & ~(size_t)255; return q; };
    p.BAR = (unsigned*)take(16384);
    p.X = (float*)d_out;
    p.VFIRST = (bf16*)take((size_t)NTOK * 256 * 2);
    p.LORA_T = (bf16*)take((size_t)(4 * 256 * 64 + 2 * 256 * 128 + 256 * 32) * 2);
    p.GWS = (bf16*)take((size_t)2 * 4 * 128 * 128 * 2);
    p.MIX = (bf16*)take((size_t)NTOK * DM * 2);
    p.XN = (bf16*)take((size_t)NTOK * DM * 2);
    p.WIN_T = (bf16*)take((size_t)2 * DINP * DM * 2);
    p.WOUT_T = (bf16*)take((size_t)2 * DM * DM * 2);
    p.WQK_T = (bf16*)take((size_t)2 * NB * DM * DM * 2);
    p.VWO_T = (bf16*)take((size_t)2 * NB * DM * DM * 2);
    p.W1_T = (bf16*)take((size_t)4 * 256 * 2048 * 2);
    p.W2_T = (bf16*)take((size_t)4 * 64 * 256 * 2);
    p.TE = (int*)take((size_t)NTOK * 2 * 4);
    p.TW = (float*)take((size_t)NTOK * 2 * 4);
    p.SLOT = (int*)take((size_t)NTOK * 2 * 4);
    p.LIST = (int*)take((size_t)36864 * 4);
    p.EOFF = (int*)take(4096);
    p.R0 = (float*)take((size_t)54200000 * 4);
    if (o > ws_size) { fprintf(stderr, "workspace too small: need %zu have %zu\n", o, ws_size); return; }
    (void)hipMemsetAsync(p.BAR, 0, 16384, stream);
    void* args[] = {&p};
    hipError_t e = hipLaunchCooperativeKernel((const void*)mega, dim3(grid_blocks), dim3(NWAVES * 64), args, LDS_BYTES, stream);
    if (e != hipSuccess) fprintf(stderr, "cooperative launch failed: %s (grid %d)\n", hipGetErrorString(e), grid_blocks);
}
```

```cpp
#include <hip/hip_runtime.h>
#include <hip/hip_cooperative_groups.h>
#include <stdio.h>
#include <stdint.h>
#include <string.h>
#include <math.h>
namespace cg = cooperative_groups;

#define DEVI __device__ __forceinline__
#define GAS __attribute__((address_space(1)))
#define LAS __attribute__((address_space(3)))
typedef unsigned short bf16;
typedef unsigned v4u __attribute__((ext_vector_type(4)));
typedef GAS unsigned gu32;
typedef GAS unsigned long long gu64;
#define RLX_AGENT __ATOMIC_RELAXED, __HIP_MEMORY_SCOPE_AGENT
#define LDS_WAIT() asm volatile("s_waitcnt lgkmcnt(0)" ::: "memory")
#define VM_WAIT() asm volatile("s_waitcnt vmcnt(0)" ::: "memory")
DEVI unsigned f2bf(float f) { unsigned u = __builtin_bit_cast(unsigned, f); return (u + 0x7fffu + ((u >> 16) & 1u)) >> 16; }
DEVI unsigned pk2(float lo, float hi) { return f2bf(lo) | (f2bf(hi) << 16); }
DEVI float bf2f(unsigned short h) { return __builtin_bit_cast(float, (unsigned)h << 16); }

constexpr int NB = 2, SEQ = 8192, DM = 1024, NTOK = NB * SEQ, DIN = 2700, DINP = 2816, MEML = 256;
constexpr int OFF_CV = 0, OFF_CG = 256, OFF_RW = 512, OFF_GU = 1536, OFF_GV = 1792, OFF_Q = 2048, OFF_KC = 2304,
              OFF_VC = 2368, OFF_KS = 2432, OFF_VS = 2496, OFF_KW = 2560, OFF_VW = 2624, OFF_GT = 2688;
constexpr int NCMP = 511;
constexpr float ALPHA = 1.4142135623730951f;
constexpr int NWAVES = 8;
constexpr int RING_OFF = 0, RING_BYTES = 131072;
constexpr int LDSCTL_OFF = RING_BYTES, MISC_OFF = LDSCTL_OFF + 320;
constexpr int LDS_BYTES = 147456;

constexpr int TIDTBL_OFF = LDSCTL_OFF;
DEVI int tidx() {
    const unsigned slot = __builtin_amdgcn_s_getreg((5 << 11) | 4) & 63u;
    int w = *(volatile LAS int*)(unsigned long)(TIDTBL_OFF + slot * 4u);
    w = __builtin_amdgcn_readfirstlane(w);
    int t;
    asm volatile("v_mbcnt_lo_u32_b32 %0, -1, 0\n\tv_mbcnt_hi_u32_b32 %0, -1, %0" : "=v"(t));
    t |= w << 6;
    asm volatile("" : "+v"(t));
    return t;
}

#ifndef PROBE_MASK
#define PROBE_MASK 0ull
#endif
#define PROBE_N 3
#define REP(id) for (int rep_ = 0; rep_ < (((PROBE_MASK >> (id)) & 1ull) ? 1 + PROBE_N : 1); ++rep_)
namespace pg8 {
#define PG8_LAS __attribute__((address_space(3)))
typedef unsigned short bf16_t;
typedef short bf16x8 __attribute__((ext_vector_type(8)));
typedef float f32x4 __attribute__((ext_vector_type(4)));
typedef unsigned u32x4 __attribute__((ext_vector_type(4)));
constexpr int BM = 256, BK = 64, HALF = 128, HTB = HALF * BK * 2  , STAGE_BYTES = 8 * HTB, NXCD = 8, WGM = 8;

__host__ __device__ __forceinline__ int lds_byte(int r, int c) { const int st = (r >> 4) * 2 + (c >> 5), rr = r & 15, cc = c & 31, ob = rr * 64 + cc * 2; return st * 1024 + (ob ^ (((ob >> 9) & 1) << 5)); }
__host__ __device__ __forceinline__ void stage_rc(int b, int& R, int& C) { const int st = b / 1024, sb = b % 1024, swz = sb ^ (((sb >> 9) & 1) << 5); R = (st >> 1) * 16 + swz / 64; C = (st & 1) * 32 + (swz % 64) / 2; }
__host__ __device__ __forceinline__ int perm32(int rho) { const int n = rho >> 4, i = rho & 15; return 8 * (i >> 2) + 4 * n + (i & 3); }

struct Unit { int pm, pn; };
struct Gemm { const bf16_t* A; const bf16_t* Bt; int M, N, K; int lda = 0, ldb = 0; };

struct StaticOrder {
    int nM, nN, nwg, G, c;
    __host__ __device__ void init(int M, int N, int G_, int c_) { nM = M / BM; nN = N / BM; nwg = nM * nN; G = G_; c = c_; }
    __host__ __device__ bool next(int i, Unit& u) const {
        const long L = (long)i * G + c; if (L >= nwg) return false;
        int wgid = (int)L; { const int q = nwg / NXCD, r = nwg % NXCD, xcd = wgid % NXCD, off = wgid / NXCD; wgid = (xcd < r ? xcd * (q + 1) : r * (q + 1) + (xcd - r) * q) + off; }
        const int nig = WGM * nN, gid = wgid / nig, fm = gid * WGM, gsz = (nM - fm) < WGM ? (nM - fm) : WGM;
        u.pm = fm + ((wgid % nig) % gsz); u.pn = (wgid % nig) / gsz; return true;
    }
    __device__ __forceinline__ void a_ready(const Unit&) const {}
    __device__ __forceinline__ void done(const Unit&) const {}
};

__device__ __forceinline__ unsigned cvt_pk_bf16(float lo, float hi) { unsigned r; asm volatile("v_cvt_pk_bf16_f32 %0, %1, %2" : "=v"(r) : "v"(lo), "v"(hi)); return r; }
typedef float f32x2 __attribute__((ext_vector_type(2)));
__device__ __forceinline__ f32x2 gelu_pk(f32x2 v) {
    const f32x2 av = __builtin_elementwise_abs(v), d = av * 0.2316418882f + 1.0f;
    f32x2 t; t.x = __builtin_amdgcn_rcpf(d.x); t.y = __builtin_amdgcn_rcpf(d.y);
    f32x2 q = t * 0.5307027145f + (-0.7265760135f); q = q * t + 0.7107068705f; q = q * t + (-0.142248368f); q = q * t + 0.127414796f; q = q * t;
    const f32x2 s = (v * v) * (-0.72134752044f);
    f32x2 e; e.x = __builtin_amdgcn_exp2f(s.x); e.y = __builtin_amdgcn_exp2f(s.y);
    const f32x2 m = v * (q * e), r = v - m;
    f32x2 o; o.x = v.x < 0.f ? m.x : r.x; o.y = v.y < 0.f ? m.y : r.y; return o;
}

template <int ACT  > struct EpiBf16 {
    static constexpr bool PERM = true, AFTER_DRAIN = false; static_assert(ACT == 0 || ACT == 1, "EpiBf16: ACT is 0 (none) or 1 (gelu_pk)");
    bf16_t* O; int ldc; const float* bias; int split_cols; size_t split_stride; float scale0;
    __device__ __forceinline__ void operator()(const f32x4 (&acc)[2][2][4][2], const Unit& u, int wr, int wc, int fr, int fq) const {
        const int row0 = u.pm * BM + wr * 64 + fr; int colt = u.pn * BM; bf16_t* base = O;
        float sc = 1.f; if (split_cols) { const int t = colt / split_cols; base += (size_t)t * split_stride; colt -= t * split_cols; if (t == 0) sc = scale0; }
        const int col0 = colt + wc * 32 + 8 * fq, bcol0 = u.pn * BM + wc * 32 + 8 * fq;
        f32x4 bv[2][2];
#pragma unroll
        for (int bj = 0; bj < 2; ++bj)
#pragma unroll
            for (int n = 0; n < 2; ++n) bv[bj][n] = bias ? *(const f32x4*)(bias + bcol0 + bj * HALF + 4 * n) : (f32x4){0.f, 0.f, 0.f, 0.f};
#pragma unroll
        for (int ai = 0; ai < 2; ++ai)
#pragma unroll
            for (int m = 0; m < 4; ++m) { bf16_t* rowp = base + (size_t)(row0 + ai * HALF + m * 16) * ldc + col0;
#pragma unroll
                for (int bj = 0; bj < 2; ++bj) { f32x4 v0 = acc[ai][bj][m][0] + bv[bj][0], v1 = acc[ai][bj][m][1] + bv[bj][1];
                    if (ACT == 1) { f32x2 a = gelu_pk((f32x2){v0[0], v0[1]}), b = gelu_pk((f32x2){v0[2], v0[3]}), c = gelu_pk((f32x2){v1[0], v1[1]}), d = gelu_pk((f32x2){v1[2], v1[3]});
                        v0 = (f32x4){a.x, a.y, b.x, b.y}; v1 = (f32x4){c.x, c.y, d.x, d.y}; }
                    v0 = v0 * sc; v1 = v1 * sc; u32x4 w; w.x = cvt_pk_bf16(v0[0], v0[1]); w.y = cvt_pk_bf16(v0[2], v0[3]); w.z = cvt_pk_bf16(v1[0], v1[1]); w.w = cvt_pk_bf16(v1[2], v1[3]);
                    *(u32x4*)(rowp + bj * HALF) = w; } }
    }
};

struct PanelStats {
    unsigned* xbuf;
    unsigned* cnt;
    unsigned* tmo;
    int ntn; float eps;
    unsigned code;
    __device__ __forceinline__ bool run(const f32x4 (&v)[2][2][4][2], const Unit& u, int wr, int wc, int fr, int fq, PG8_LAS unsigned char* lds, int wid, int lane) const {
        typedef float f32x2v __attribute__((ext_vector_type(2)));
        PG8_LAS f32x2v* P = (PG8_LAS f32x2v*)lds;
        PG8_LAS f32x2v* S = (PG8_LAS f32x2v*)(lds + 8192);
        PG8_LAS unsigned* flag = (PG8_LAS unsigned*)(lds + 8192 + 2048);
#pragma unroll
        for (int ai = 0; ai < 2; ++ai)
#pragma unroll
            for (int m = 0; m < 4; ++m) {
                float s = 0.f;
#pragma unroll
                for (int bj = 0; bj < 2; ++bj)
#pragma unroll
                    for (int n = 0; n < 2; ++n) { const f32x4 x = v[ai][bj][m][n]; s += (x[0] + x[1]) + (x[2] + x[3]); }
                s += __shfl_xor(s, 16); s += __shfl_xor(s, 32);
                const float mw = s * (1.0f / 64.0f); float q = 0.f;
#pragma unroll
                for (int bj = 0; bj < 2; ++bj)
#pragma unroll
                    for (int n = 0; n < 2; ++n) { const f32x4 d = v[ai][bj][m][n] - mw; q += (d[0] * d[0] + d[1] * d[1]) + (d[2] * d[2] + d[3] * d[3]); }
                q += __shfl_xor(q, 16); q += __shfl_xor(q, 32);
                if (fq == 0) P[(ai * HALF + wr * 64 + m * 16 + fr) * 4 + wc] = (f32x2v){mw, q};
            }
        asm volatile("s_waitcnt lgkmcnt(0)" ::: "memory"); __builtin_amdgcn_s_barrier(); asm volatile("" ::: "memory");
#if defined(BROKEN_EXCHANGE_NO_WAIT)
#warning BROKEN CONTROL BUILD: the row-statistics exchange does not wait; results are wrong by design
        if (blockIdx.x >= 64) { const long long t0_ = clock64(); while (clock64() - t0_ < 60000) __builtin_amdgcn_s_sleep(8); }
#endif
        const int row = wid * 32 + (lane & 31);
        if (lane < 32) {
            const f32x2v a = P[row * 4 + 0], b = P[row * 4 + 1], c = P[row * 4 + 2], d = P[row * 4 + 3];
            const float mt = (a.x + b.x + c.x + d.x) * 0.25f;
            const float da = a.x - mt, db = b.x - mt, dc = c.x - mt, dd = d.x - mt;
            const float m2 = (a.y + b.y) + (c.y + d.y) + 64.0f * ((da * da + db * db) + (dc * dc + dd * dd));
            unsigned long long* slot = (unsigned long long*)xbuf + ((size_t)(u.pm * BM + row) * 4 + u.pn);
            __hip_atomic_store(slot, ((unsigned long long)__float_as_uint(m2) << 32) | __float_as_uint(mt), __ATOMIC_RELAXED, __HIP_MEMORY_SCOPE_AGENT);
        }
        asm volatile("s_waitcnt vmcnt(0)" ::: "memory");
        if (lane == 0) __hip_atomic_fetch_add(cnt + 64 * u.pm, 1u, __ATOMIC_RELAXED, __HIP_MEMORY_SCOPE_AGENT);
        if (wid == 0) {
            bool dead = false; const unsigned long long t0 = __builtin_amdgcn_s_memrealtime(); const unsigned want = 8u * (unsigned)ntn;
            for (;;) {
#if defined(BROKEN_EXCHANGE_NO_WAIT)
                break;
#endif
                if ((unsigned)__builtin_amdgcn_readfirstlane(__hip_atomic_load(cnt + 64 * u.pm, __ATOMIC_RELAXED, __HIP_MEMORY_SCOPE_AGENT)) >= want) break;
                if (__builtin_amdgcn_s_memrealtime() - t0 > 2000000ull) {
                    if (lane == 0) { unsigned expect = 0u; __hip_atomic_compare_exchange_strong(tmo + 1, &expect, code | (unsigned)(u.pm & 0xff), __ATOMIC_RELAXED, __ATOMIC_RELAXED, __HIP_MEMORY_SCOPE_AGENT);
                                     __hip_atomic_store(tmo, 1u, __ATOMIC_RELAXED, __HIP_MEMORY_SCOPE_AGENT); }
                    dead = true; break; }
                __builtin_amdgcn_s_sleep(2);
            }
            __builtin_amdgcn_fence(__ATOMIC_ACQUIRE, "agent");
            if (lane == 0) flag[0] = dead ? 1u : 0u;
        }
        asm volatile("s_waitcnt vmcnt(0) lgkmcnt(0)" ::: "memory"); __builtin_amdgcn_s_barrier(); asm volatile("" ::: "memory");
        const bool bad = flag[0] != 0u;
        if (lane < 32) {
            const unsigned long long* slot = (const unsigned long long*)xbuf + (size_t)(u.pm * BM + row) * 4; float mt[4], m2[4]; float ms = 0.f;
#pragma unroll
            for (int t = 0; t < 4; ++t) { if (t < ntn) { const unsigned long long w = __hip_atomic_load(slot + t, __ATOMIC_RELAXED, __HIP_MEMORY_SCOPE_AGENT); mt[t] = __uint_as_float((unsigned)w); m2[t] = __uint_as_float((unsigned)(w >> 32)); } else { mt[t] = 0.f; m2[t] = 0.f; } ms += mt[t]; }
            const float mean = ms / (float)ntn; float q = 0.f;
#pragma unroll
            for (int t = 0; t < 4; ++t) if (t < ntn) { const float dm = mt[t] - mean; q += m2[t] + 256.0f * dm * dm; }
            S[row] = (f32x2v){mean, 1.0f / sqrtf(q / (256.0f * (float)ntn) + eps)};
        }
        asm volatile("s_waitcnt lgkmcnt(0)" ::: "memory"); __builtin_amdgcn_s_barrier(); asm volatile("" ::: "memory");
        return bad;
    }
};
struct EpiLnRes {
    static constexpr bool PERM = false, AFTER_DRAIN = true;
    const float* base; float* out; int ldc; const float* bias; PanelStats st; unsigned poison;
    __device__ __forceinline__ void fused(f32x4 (&acc)[2][2][4][2], const Unit& u, int wr, int wc, int fr, int fq, PG8_LAS unsigned char* lds, int wid, int lane) const {
        typedef float f32x2v __attribute__((ext_vector_type(2)));
        const PG8_LAS f32x2v* S = (const PG8_LAS f32x2v*)(lds + 8192);
        const int col0 = u.pn * BM + wc * 32 + 4 * fq;
#pragma unroll
        for (int bj = 0; bj < 2; ++bj)
#pragma unroll
            for (int n = 0; n < 2; ++n) { const f32x4 bv = bias ? *(const f32x4*)(bias + col0 + bj * HALF + n * 16) : (f32x4){0.f, 0.f, 0.f, 0.f};
#pragma unroll
                for (int ai = 0; ai < 2; ++ai)
#pragma unroll
                    for (int m = 0; m < 4; ++m) acc[ai][bj][m][n] += bv; }
        f32x4 pre[4][2][2];
#pragma unroll
        for (int m = 0; m < 4; ++m) { const size_t off = (size_t)(u.pm * BM + wr * 64 + m * 16 + fr) * ldc + col0;
#pragma unroll
            for (int bj = 0; bj < 2; ++bj)
#pragma unroll
                for (int n = 0; n < 2; ++n) pre[m][bj][n] = *(const f32x4*)(base + off + bj * HALF + n * 16); }
        const bool bad = st.run(acc, u, wr, wc, fr, fq, lds, wid, lane) || poison != 0u;
        const float qnan = __builtin_nanf("");
#pragma unroll
        for (int ai = 0; ai < 2; ++ai)
#pragma unroll
            for (int m = 0; m < 4; ++m) { const int r = ai * HALF + wr * 64 + m * 16 + fr; const f32x2v sr = S[r]; const size_t off = (size_t)(u.pm * BM + r) * ldc + col0;
#pragma unroll
                for (int bj = 0; bj < 2; ++bj)
#pragma unroll
                    for (int n = 0; n < 2; ++n) { const f32x4 bs = ai == 0 ? pre[m][bj][n] : *(const f32x4*)(base + off + bj * HALF + n * 16); f32x4 o = bs + (acc[ai][bj][m][n] - sr.x) * sr.y;
                        if (bad) o = (f32x4){qnan, qnan, qnan, qnan}; *(f32x4*)(out + off + bj * HALF + n * 16) = o; }
                if (m & 1) asm volatile("" ::: "memory"); }
    }
};
struct EpiLnResLn {
    static constexpr bool PERM = false, AFTER_DRAIN = true;
    const float* base; float* out; bf16_t* xn; int ldc; const float* bias; PanelStats st1, st2; unsigned poison;
    __device__ __forceinline__ void fused(f32x4 (&acc)[2][2][4][2], const Unit& u, int wr, int wc, int fr, int fq, PG8_LAS unsigned char* lds, int wid, int lane) const {
        typedef float f32x2v __attribute__((ext_vector_type(2))); typedef unsigned u32x2v __attribute__((ext_vector_type(2)));
        const PG8_LAS f32x2v* S = (const PG8_LAS f32x2v*)(lds + 8192);
        const int col0 = u.pn * BM + wc * 32 + 4 * fq;
#pragma unroll
        for (int bj = 0; bj < 2; ++bj)
#pragma unroll
            for (int n = 0; n < 2; ++n) { const f32x4 bv = bias ? *(const f32x4*)(bias + col0 + bj * HALF + n * 16) : (f32x4){0.f, 0.f, 0.f, 0.f};
#pragma unroll
                for (int ai = 0; ai < 2; ++ai)
#pragma unroll
                    for (int m = 0; m < 4; ++m) acc[ai][bj][m][n] += bv; }
        bool bad = st1.run(acc, u, wr, wc, fr, fq, lds, wid, lane) || poison != 0u;
        const float qnan = __builtin_nanf("");
#pragma unroll
        for (int ai = 0; ai < 2; ++ai)
#pragma unroll
            for (int m = 0; m < 4; ++m) { const int r = ai * HALF + wr * 64 + m * 16 + fr; const f32x2v sr = S[r]; const size_t off = (size_t)(u.pm * BM + r) * ldc + col0;
#pragma unroll
                for (int bj = 0; bj < 2; ++bj)
#pragma unroll
                    for (int n = 0; n < 2; ++n) { const f32x4 bs = *(const f32x4*)(base + off + bj * HALF + n * 16); acc[ai][bj][m][n] = bs + (acc[ai][bj][m][n] - sr.x) * sr.y; }
                asm volatile("" : "+v"(acc[ai][0][m][0]), "+v"(acc[ai][0][m][1]), "+v"(acc[ai][1][m][0]), "+v"(acc[ai][1][m][1]));
                if (m & 1) asm volatile("" ::: "memory"); }
        const bool bad1 = bad;
        bad = st2.run(acc, u, wr, wc, fr, fq, lds, wid, lane) || bad;
#pragma unroll
        for (int ai = 0; ai < 2; ++ai)
#pragma unroll
            for (int m = 0; m < 4; ++m) { const int r = ai * HALF + wr * 64 + m * 16 + fr; const f32x2v sr = S[r]; const size_t off = (size_t)(u.pm * BM + r) * ldc + col0;
#pragma unroll
                for (int bj = 0; bj < 2; ++bj)
#pragma unroll
                    for (int n = 0; n < 2; ++n) { const f32x4 x1 = acc[ai][bj][m][n]; *(f32x4*)(out + off + bj * HALF + n * 16) = bad1 ? (f32x4){qnan, qnan, qnan, qnan} : x1;
                        const f32x4 o = (x1 - sr.x) * sr.y; u32x2v w; w.x = cvt_pk_bf16(o[0], o[1]); w.y = cvt_pk_bf16(o[2], o[3]);
                        if (bad) { w.x = 0x7fc07fc0u; w.y = 0x7fc07fc0u; } *(u32x2v*)(xn + off + bj * HALF + n * 16) = w; }
                asm volatile("" ::: "memory"); }
    }
};

template <class Epi, class Sched, bool ALIGN_EPI = false, bool SP2 = false>
__device__ __forceinline__ void gemm_phase(PG8_LAS unsigned char* lds, const Gemm g, const Sched& S, const Epi& E) {
    const int tid = tidx(), wid = __builtin_amdgcn_readfirstlane(tid >> 6), lane = tid & 63, wr = wid >> 2, wc = wid & 3, fr = lane & 15, fq = lane >> 4;
    const int K = g.K, nt = K / BK;
    const int LDA = g.lda ? g.lda : K, LDB = g.ldb ? g.ldb : K;
    unsigned voffA[2], voffB[2];
#pragma unroll
    for (int i = 0; i < 2; ++i) { int R, C; stage_rc(tid * 16 + i * 8192, R, C); const int Rb = Epi::PERM ? ((R & ~31) + perm32(R & 31)) : R;
        voffA[i] = (unsigned)(R * LDA + C) * 2u; voffB[i] = (unsigned)(Rb * LDB + C) * 2u; }
    const size_t kstep = (size_t)(BK * 2);
    const size_t hstepA = (size_t)HALF * LDA * 2, hstepB = (size_t)HALF * LDB * 2;
    const size_t tstepA = 2 * hstepA, tstepB = 2 * hstepB;
    const unsigned ldsw = (unsigned)wid * 1024u;
    const int aoff = lds_byte(wr * 64 + fr, fq * 8), boff = lds_byte(wc * 32 + fr, fq * 8);
#define PG8_SA(b, h) (((b) * 2 + (h)) * HTB)
#define PG8_SB(b, h) ((4 + (b) * 2 + (h)) * HTB)
#define PG8_STAGE(bufoff, gbase, voff) do { _Pragma("unroll") for (int _i = 0; _i < 2; ++_i) \
        __builtin_amdgcn_global_load_lds((const unsigned*)((const char*)(gbase) + (voff)[_i]), (PG8_LAS unsigned*)(lds + (bufoff) + ldsw + _i * 8192), 16, 0, 0); } while (0)
#define PG8_LDA(dst, b, h) do { _Pragma("unroll") for (int m = 0; m < 4; ++m) _Pragma("unroll") for (int k = 0; k < 2; ++k) dst[m][k] = *(const PG8_LAS bf16x8*)(lds + PG8_SA(b, h) + aoff + m * 2048 + k * 1024); } while (0)
#define PG8_LDB(dst, b, h) do { _Pragma("unroll") for (int n = 0; n < 2; ++n) _Pragma("unroll") for (int k = 0; k < 2; ++k) dst[n][k] = *(const PG8_LAS bf16x8*)(lds + PG8_SB(b, h) + boff + n * 2048 + k * 1024); } while (0)
#define PG8_MMA(ai, bj, At, Bt) do { __builtin_amdgcn_s_setprio(1); _Pragma("unroll") for (int m = 0; m < 4; ++m) _Pragma("unroll") for (int n = 0; n < 2; ++n) _Pragma("unroll") for (int k = 0; k < 2; ++k) \
        acc[ai][bj][m][n] = __builtin_amdgcn_mfma_f32_16x16x32_bf16(Bt[n][k], At[m][k], acc[ai][bj][m][n], 0, 0, 0); __builtin_amdgcn_s_setprio(0); } while (0)
#define PG8_WAIT_V(n) asm volatile("s_waitcnt vmcnt(" #n ")" ::: "memory")
#define PG8_WAIT_L(n) asm volatile("s_waitcnt lgkmcnt(" #n ")" ::: "memory")
#define PG8_BAR __builtin_amdgcn_s_barrier()
#define PG8_SCHED __builtin_amdgcn_sched_barrier(0)
    Unit cur, nxt; int ui = 0;
    if (!S.next(0, cur)) return;
    f32x4 acc[2][2][4][2];
#pragma unroll
    for (int a = 0; a < 2; ++a)
#pragma unroll
        for (int b = 0; b < 2; ++b)
#pragma unroll
            for (int m = 0; m < 4; ++m)
#pragma unroll
                for (int n = 0; n < 2; ++n) acc[a][b][m][n] = (f32x4){0.f, 0.f, 0.f, 0.f};
    bf16x8 At[4][2], B0[2][2], B1[2][2];
    const char* cA = (const char*)g.A + (size_t)cur.pm * tstepA; const char* cB = (const char*)g.Bt + (size_t)cur.pn * tstepB;
    S.a_ready(cur);
    if constexpr (SP2) {
        PG8_STAGE(PG8_SB(0, 0), cB, voffB); PG8_STAGE(PG8_SB(0, 1), cB + hstepB, voffB); PG8_STAGE(PG8_SA(0, 0), cA, voffA); PG8_STAGE(PG8_SA(0, 1), cA + hstepA, voffA);
        if (wr == 1) PG8_BAR;
        PG8_WAIT_V(2); PG8_BAR;
        PG8_STAGE(PG8_SB(1, 0), cB + kstep, voffB); PG8_STAGE(PG8_SA(1, 0), cA + kstep, voffA); PG8_STAGE(PG8_SB(1, 1), cB + hstepB + kstep, voffB);
        PG8_WAIT_V(6); PG8_BAR;
    } else {
        PG8_STAGE(PG8_SB(0, 0), cB, voffB); PG8_STAGE(PG8_SA(0, 0), cA, voffA); PG8_STAGE(PG8_SB(0, 1), cB + hstepB, voffB); PG8_STAGE(PG8_SA(0, 1), cA + hstepA, voffA);
        if (wr == 1) PG8_BAR;
        PG8_WAIT_V(4); PG8_BAR;
        PG8_STAGE(PG8_SB(1, 0), cB + kstep, voffB); PG8_STAGE(PG8_SA(1, 0), cA + kstep, voffA); PG8_STAGE(PG8_SB(1, 1), cB + hstepB + kstep, voffB);
        PG8_WAIT_V(6); PG8_BAR;
    }
    for (;;) {
        const bool has_next = S.next(ui + 1, nxt);
        const char* nA = has_next ? (const char*)g.A + (size_t)nxt.pm * tstepA : cA; const char* nB = has_next ? (const char*)g.Bt + (size_t)nxt.pn * tstepB : cB;
        for (int t = 0; t < nt; t += 2) {
            const bool last = (t == nt - 2);
            const char* a1 = cA + (size_t)(t + 1) * kstep;
            const char* a2 = last ? nA : cA + (size_t)(t + 2) * kstep; const char* b2 = last ? nB : cB + (size_t)(t + 2) * kstep;
            const char* a3 = a2 + kstep; const char* b3 = b2 + kstep;
            if (last && has_next) S.a_ready(nxt);
            if constexpr (SP2) {
            PG8_LDB(B0, 0, 0); PG8_LDB(B1, 0, 1); PG8_SCHED; PG8_LDA(At, 0, 0); PG8_STAGE(PG8_SA(1, 1), a1 + hstepA, voffA);
            PG8_WAIT_V(8); PG8_WAIT_L(0); PG8_BAR; PG8_MMA(0, 0, At, B0); PG8_MMA(0, 1, At, B1); PG8_BAR; PG8_SCHED;
            PG8_LDA(At, 0, 1); PG8_STAGE(PG8_SB(0, 0), b2, voffB); PG8_STAGE(PG8_SB(0, 1), b2 + hstepB, voffB); PG8_STAGE(PG8_SA(0, 0), a2, voffA);
            PG8_WAIT_V(8); PG8_WAIT_L(0); PG8_BAR; PG8_MMA(1, 0, At, B0); PG8_MMA(1, 1, At, B1); PG8_BAR; PG8_SCHED;
            PG8_LDB(B0, 1, 0); PG8_LDB(B1, 1, 1); PG8_SCHED; PG8_LDA(At, 1, 0); PG8_STAGE(PG8_SA(0, 1), a2 + hstepA, voffA);
            PG8_WAIT_V(8); PG8_WAIT_L(0); PG8_BAR; PG8_MMA(0, 0, At, B0); PG8_MMA(0, 1, At, B1); PG8_BAR; PG8_SCHED;
            PG8_LDA(At, 1, 1); PG8_STAGE(PG8_SB(1, 0), b3, voffB); PG8_STAGE(PG8_SB(1, 1), b3 + hstepB, voffB); PG8_STAGE(PG8_SA(1, 0), a3, voffA);
            PG8_WAIT_V(8); PG8_WAIT_L(0); PG8_BAR; PG8_MMA(1, 0, At, B0); PG8_MMA(1, 1, At, B1); PG8_BAR; PG8_SCHED;
            } else {
            PG8_LDB(B0, 0, 0); PG8_SCHED; PG8_LDA(At, 0, 0); PG8_STAGE(PG8_SA(1, 1), a1 + hstepA, voffA);
            PG8_WAIT_L(8); PG8_BAR; PG8_WAIT_L(0); PG8_MMA(0, 0, At, B0); PG8_BAR; PG8_SCHED;
            PG8_LDB(B1, 0, 1); PG8_STAGE(PG8_SB(0, 0), b2, voffB);
            PG8_BAR; PG8_WAIT_L(0); PG8_MMA(0, 1, At, B1); PG8_BAR;
            PG8_LDA(At, 0, 1); PG8_STAGE(PG8_SA(0, 0), a2, voffA);
            PG8_BAR; PG8_WAIT_L(0); PG8_MMA(1, 0, At, B0); PG8_BAR; PG8_SCHED;
            PG8_STAGE(PG8_SB(0, 1), b2 + hstepB, voffB);
            PG8_WAIT_V(6); PG8_BAR; PG8_MMA(1, 1, At, B1); PG8_BAR;
            PG8_LDB(B0, 1, 0); PG8_SCHED; PG8_LDA(At, 1, 0); PG8_STAGE(PG8_SA(0, 1), a2 + hstepA, voffA);
            PG8_WAIT_L(8); PG8_BAR; PG8_WAIT_L(0); PG8_MMA(0, 0, At, B0); PG8_BAR; PG8_SCHED;
            PG8_LDB(B1, 1, 1); PG8_STAGE(PG8_SB(1, 0), b3, voffB);
            PG8_BAR; PG8_WAIT_L(0); PG8_MMA(0, 1, At, B1); PG8_BAR;
            PG8_LDA(At, 1, 1); PG8_STAGE(PG8_SA(1, 0), a3, voffA);
            PG8_BAR; PG8_WAIT_L(0); PG8_MMA(1, 0, At, B0); PG8_BAR; PG8_SCHED;
            PG8_STAGE(PG8_SB(1, 1), b3 + hstepB, voffB);
            PG8_WAIT_V(6); PG8_BAR; PG8_MMA(1, 1, At, B1); PG8_BAR;
            }
        }
        if constexpr (ALIGN_EPI) { if (wr == 0) PG8_BAR; }
        if constexpr (!Epi::AFTER_DRAIN) { E(acc, cur, wr, wc, fr, fq); S.done(cur); }
        if (!has_next) break;
#pragma unroll
        for (int a = 0; a < 2; ++a)
#pragma unroll
            for (int b = 0; b < 2; ++b)
#pragma unroll
                for (int m = 0; m < 4; ++m)
#pragma unroll
                    for (int n = 0; n < 2; ++n) acc[a][b][m][n] = (f32x4){0.f, 0.f, 0.f, 0.f};
        cur = nxt; cA = nA; cB = nB; ++ui;
        if constexpr (ALIGN_EPI) { if (wr == 1) PG8_BAR; }
    }
    PG8_WAIT_V(0);
    if constexpr (!ALIGN_EPI) { if (wr == 0) PG8_BAR; }
    PG8_BAR;
    if constexpr (Epi::AFTER_DRAIN) { E.fused(acc, cur, wr, wc, fr, fq, lds, wid, lane); S.done(cur); }
#undef PG8_SA
#undef PG8_SB
#undef PG8_STAGE
#undef PG8_LDA
#undef PG8_LDB
#undef PG8_MMA
#undef PG8_WAIT_V
#undef PG8_WAIT_L
#undef PG8_BAR
#undef PG8_SCHED
}
}
namespace pg8 {
struct EpiF32 {
    static constexpr bool PERM = false, AFTER_DRAIN = false;
    float* C; int ldc; const float* bias;
    __device__ __forceinline__ void operator()(const f32x4 (&acc)[2][2][4][2], const Unit& u, int wr, int wc, int fr, int fq) const {
        const int row0 = u.pm * BM + wr * 64 + fr, col0 = u.pn * BM + wc * 32 + 4 * fq;
        f32x4 bv[2][2];
#pragma unroll
        for (int bj = 0; bj < 2; ++bj)
#pragma unroll
            for (int n = 0; n < 2; ++n) bv[bj][n] = bias ? *(const f32x4*)(bias + col0 + bj * HALF + n * 16) : (f32x4){0.f, 0.f, 0.f, 0.f};
#pragma unroll
        for (int ai = 0; ai < 2; ++ai)
#pragma unroll
            for (int m = 0; m < 4; ++m) { float* rowp = C + (size_t)(row0 + ai * HALF + m * 16) * ldc + col0;
#pragma unroll
                for (int bj = 0; bj < 2; ++bj)
#pragma unroll
                    for (int n = 0; n < 2; ++n) *(f32x4*)(rowp + bj * HALF + n * 16) = acc[ai][bj][m][n] + bv[bj][n]; }
    }
};
}
#define XB_TMO      128
#define XB_XCNT(j)  (256  + 64 * (j))
#define XB_XSUB(j)  (1280 + 64 * (j))
#define XB_XGEN(j)  (2304 + 64 * (j))
#define XB_TOP      3328
#define XB_TOPGEN   3392
#define XCD_BAR_WORDS 3456
#define XB_SPIN_CAP (1u << 18)

__device__ __forceinline__ unsigned xb_ld(unsigned* p)              { return __hip_atomic_load(p, __ATOMIC_RELAXED, __HIP_MEMORY_SCOPE_AGENT); }
__device__ __forceinline__ unsigned xb_add(unsigned* p, unsigned v) { return __hip_atomic_fetch_add(p, v, __ATOMIC_RELAXED, __HIP_MEMORY_SCOPE_AGENT); }
__device__ __forceinline__ unsigned xb_xcc_id() { return (unsigned)__builtin_amdgcn_s_getreg((3 << 11) | 20) & 0xFu; }
#define XB_SPIN(cond, bar) do { unsigned _sp = 0; while (cond) { __builtin_amdgcn_s_sleep(1); \
    if ((++_sp & 255u) == 0u) { if (xb_ld(&(bar)[XB_TMO])) break; if (_sp > XB_SPIN_CAP) { atomicAdd(&(bar)[XB_TMO], 1u); break; } } } } while (0)

struct XcdBarrier {
    unsigned* bar; unsigned x;
    volatile LAS unsigned* st;
};

__device__ __forceinline__ XcdBarrier xcd_barrier_post(unsigned* bar, volatile LAS unsigned* st) {
    XcdBarrier b; b.bar = bar; b.x = xb_xcc_id(); b.st = st;
    if (tidx() == 0) (void)xb_add(&bar[XB_XCNT(b.x)], 1u);
    return b;
}
__device__ __forceinline__ void xcd_barrier_complete(unsigned* bar, unsigned x, unsigned& nloc, unsigned& nx) {
    const unsigned G = gridDim.x * gridDim.y * gridDim.z;
    unsigned sum, cnt, mine, sp = 0u;
    for (;;) {
        sum = 0u; cnt = 0u; mine = 0u;
#pragma unroll
        for (unsigned j = 0; j < 16; ++j) { const unsigned c = xb_ld(&bar[XB_XCNT(j)]); sum += c; cnt += (c > 0u) ? 1u : 0u; mine = (j == x) ? c : mine; }
        if (sum == G) break;
        __builtin_amdgcn_s_sleep(1);
        if ((++sp & 255u) == 0u) { if (xb_ld(&bar[XB_TMO])) break; if (sp > XB_SPIN_CAP) { atomicAdd(&bar[XB_TMO], 1u); break; } }
    }
    nloc = mine > 0u ? mine : 1u; nx = cnt > 0u ? cnt : 1u;
}

__device__ __forceinline__ void xcd_barrier(const XcdBarrier& b) {
    asm volatile("s_waitcnt vmcnt(0)" ::: "memory");
    __syncthreads();
    if (tidx() == 0) {
        unsigned* bar = b.bar;
        __builtin_amdgcn_s_waitcnt(0);
        unsigned nloc = b.st[0], nx = b.st[1];
        if (nloc == 0u) { xcd_barrier_complete(bar, b.x, nloc, nx); b.st[0] = nloc; b.st[1] = nx; }
        const unsigned old = xb_add(&bar[XB_XSUB(b.x)], 1u);
        const unsigned gen = old / nloc;
        if (old + 1u == (gen + 1u) * nloc) {
            __builtin_amdgcn_fence(__ATOMIC_RELEASE, "agent");
            asm volatile("s_waitcnt vmcnt(0)" ::: "memory");
            const unsigned og = xb_add(&bar[XB_TOP], 1u);
            const unsigned tg = og / nx;
            if (og + 1u == (tg + 1u) * nx) xb_add(&bar[XB_TOPGEN], 1u);
            else XB_SPIN(xb_ld(&bar[XB_TOPGEN]) == tg, bar);
            __builtin_amdgcn_fence(__ATOMIC_ACQUIRE, "agent");
            xb_add(&bar[XB_XGEN(b.x)], 1u);
            asm volatile("s_waitcnt vmcnt(0)" ::: "memory");
        } else {
            XB_SPIN(xb_ld(&bar[XB_XGEN(b.x)]) == gen, bar);
            __builtin_amdgcn_fence(__ATOMIC_ACQUIRE, "agent");
            asm volatile("s_waitcnt vmcnt(0)" ::: "memory");
        }
    }
    __syncthreads();
}

#define DPP_ADD(x, ctrl) ((x) + __int_as_float(__builtin_amdgcn_update_dpp(0, __float_as_int(x), (ctrl), 0xF, 0xF, true)))
DEVI float wsum_all(float v) {
    v = DPP_ADD(v, 0xB1);
    v = DPP_ADD(v, 0x4E);
    v = DPP_ADD(v, 0x141);
    v = DPP_ADD(v, 0x140);
    const float r0 = __int_as_float(__builtin_amdgcn_readlane(__float_as_int(v), 0)), r1 = __int_as_float(__builtin_amdgcn_readlane(__float_as_int(v), 16));
    const float r2 = __int_as_float(__builtin_amdgcn_readlane(__float_as_int(v), 32)), r3 = __int_as_float(__builtin_amdgcn_readlane(__float_as_int(v), 48));
    return (r0 + r1) + (r2 + r3);
}
DEVI float wave_sum(float v) { return wsum_all(v); }
DEVI float wave_max(float v) {
#pragma unroll
    for (int o = 32; o > 0; o >>= 1) v = fmaxf(v, __shfl_xor(v, o, 64));
    return v;
}
DEVI float sigm(float x) { return 1.f / (1.f + expf(-x)); }
DEVI float gelu_t(float x) { return 0.5f * x * (1.f + tanhf(0.7978845608028654f * (x + 0.044715f * x * x * x))); }
DEVI float softplus_(float x) { return fmaxf(x, 0.f) + log1pf(expf(-fabsf(x))); }

DEVI float block_sum256(float v, float* red, int tid) {
    v = wave_sum(v);
    __syncthreads();
    if ((tid & 63) == 0) red[tid >> 6] = v;
    __syncthreads();
    return red[0] + red[1] + red[2] + red[3];
}

DEVI void ln_kernel(const float* xres, float alpha, const float* add, const float* __restrict__ g, const float* __restrict__ bt,
                    float* out, bf16* outb, int bid, float* sm) {
    __syncthreads();
    const size_t row = bid;
    const int tid = tidx() & 255;
    float v[4];
#pragma unroll
    for (int i = 0; i < 4; ++i) {
        const size_t idx = row * DM + tid + i * 256;
        v[i] = alpha * xres[idx] + (add ? add[idx] : 0.f);
    }
    const float mean = block_sum256(v[0] + v[1] + v[2] + v[3], sm, tid) * (1.f / DM);
    float q = 0.f;
#pragma unroll
    for (int i = 0; i < 4; ++i) { v[i] -= mean; q += v[i] * v[i]; }
    const float var = block_sum256(q, sm, tid) * (1.f / DM);
    const float rstd = rsqrtf(var + 1e-5f);
#pragma unroll
    for (int i = 0; i < 4; ++i) {
        const int c = tid + i * 256;
        const float o = v[i] * rstd * g[c] + bt[c];
        out[row * DM + c] = o;
        outb[row * DM + c] = (bf16)f2bf(o);
    }
}

struct GemmArgs {
    const float* A; const float* B; float* C; const int* rowidx; const int* zoff;
    long lda, sbk, sbn, ldc, sAz0, sAz1, sBz0, sBz1, sCz0, sCz1;
    int M, N, K, Z1, epi, pad;
};
DEVI void gemm_f32(const GemmArgs& g, int bx, int by, int z, bool live, float* sm) {
    float (*As)[68] = (float (*)[68])sm;
    float (*Bs)[68] = (float (*)[68])(sm + 16 * 68);
    const int z0 = z / g.Z1, z1 = z % g.Z1;
    int mbeg = 0, mend = g.M;
    if (g.zoff) { mbeg = g.zoff[z]; mend = g.zoff[z + 1]; }
    const int m0 = mbeg + by * 64;
    if (!live) mend = 0;
    const int n0 = bx * 64;
    const float* A = g.A + z0 * g.sAz0 + z1 * g.sAz1;
    const float* B = g.B + z0 * g.sBz0 + z1 * g.sBz1;
    float* C = g.C + z0 * g.sCz0 + z1 * g.sCz1;
    const int tid = tidx() & 255, tx = tid & 15, ty = tid >> 4;
    float acc[4][4];
#pragma unroll
    for (int i = 0; i < 4; ++i)
#pragma unroll
        for (int j = 0; j < 4; ++j) acc[i][j] = 0.f;
    long arow[4];
#pragma unroll
    for (int i = 0; i < 4; ++i) {
        const int r = (tid + i * 256) >> 4;
        const int row = m0 + r;
        if (row < mend) arow[i] = (long)(g.rowidx ? g.rowidx[row] : row) * g.lda; else arow[i] = -1;
    }
    __syncthreads();
    for (int k0 = 0; k0 < g.K; k0 += 16) {
#pragma unroll
        for (int i = 0; i < 4; ++i) {
            const int e = tid + i * 256, r = e >> 4, kk = e & 15;
            float v = 0.f;
            if (arow[i] >= 0 && k0 + kk < g.K) v = A[arow[i] + k0 + kk];
            As[kk][r] = v;
        }
#pragma unroll
        for (int i = 0; i < 4; ++i) {
            const int e = tid + i * 256, kk = e >> 6, n = e & 63;
            float v = 0.f;
            if (m0 < mend && n0 + n < g.N && k0 + kk < g.K) v = B[(long)(k0 + kk) * g.sbk + (long)(n0 + n) * g.sbn];
            Bs[kk][n] = v;
        }
        __syncthreads();
#pragma unroll
        for (int kk = 0; kk < 16; ++kk) {
            float a[4], b[4];
#pragma unroll
            for (int i = 0; i < 4; ++i) a[i] = As[kk][ty * 4 + i];
#pragma unroll
            for (int j = 0; j < 4; ++j) b[j] = Bs[kk][tx * 4 + j];
#pragma unroll
            for (int i = 0; i < 4; ++i)
#pragma unroll
                for (int j = 0; j < 4; ++j) acc[i][j] = fmaf(a[i], b[j], acc[i][j]);
        }
        __syncthreads();
    }
#pragma unroll
    for (int i = 0; i < 4; ++i) {
        const int row = m0 + ty * 4 + i;
        if (row >= mend) continue;
#pragma unroll
        for (int j = 0; j < 4; ++j) {
            const int col = n0 + tx * 4 + j;
            if (col >= g.N) continue;
            float* p = C + (long)row * g.ldc + col;
            float v = acc[i][j];
            if (g.epi == 2) { ((bf16*)C)[(long)row * g.ldc + col] = (bf16)f2bf(v); continue; }
            if (g.epi == 3) { ((bf16*)C)[(long)(row >> 9) * 64 * 512 + (long)col * 512 + (row & 511)] = (bf16)f2bf(v); continue; }
            if (g.epi == 1) { v = v * sigm(v) * (*p); }
            *p = v;
        }
    }
}
DEVI GemmArgs mk(const float* A, long lda, const float* B, long sbk, long sbn, float* C, long ldc, int M, int N, int K,
                 int Z1 = 1, long sAz0 = 0, long sAz1 = 0, long sBz0 = 0, long sBz1 = 0, long sCz0 = 0, long sCz1 = 0,
                 const int* rowidx = nullptr, const int* zoff = nullptr, int epi = 0) {
    GemmArgs g;
    g.A = A; g.B = B; g.C = C; g.rowidx = rowidx; g.zoff = zoff;
    g.lda = lda; g.sbk = sbk; g.sbn = sbn; g.ldc = ldc;
    g.sAz0 = sAz0; g.sAz1 = sAz1; g.sBz0 = sBz0; g.sBz1 = sBz1; g.sCz0 = sCz0; g.sCz1 = sCz1;
    g.M = M; g.N = N; g.K = K; g.Z1 = Z1; g.epi = epi; g.pad = 0;
    return g;
}
DEVI int gemm_tiles(const GemmArgs& g, int maxM, int Z) { return ((g.N + 63) / 64) * ((maxM + 63) / 64) * Z; }
DEVI bool gemm_tile_live(const GemmArgs& g, int maxM, int t) {
    const int nbx = (g.N + 63) / 64, nby = (maxM + 63) / 64;
    const int r = t / nbx, by = r % nby, z = r / nby;
    int mbeg = 0, mend = g.M;
    if (g.zoff) { mbeg = g.zoff[z]; mend = g.zoff[z + 1]; }
    return mbeg + by * 64 < mend;
}
DEVI void gemm_tile(const GemmArgs& g, int maxM, int t, bool live, float* sm) {
    const int nbx = (g.N + 63) / 64, nby = (maxM + 63) / 64;
    const int bx = t % nbx, r = t / nbx;
    gemm_f32(g, bx, r % nby, r / nby, live, sm);
}

DEVI void glu_kernel(const bf16* __restrict__ cols, float* __restrict__ h, int bid) {
    const size_t t = bid; const int c = tidx() & 255;
    h[t * 256 + c] = bf2f(cols[t * DINP + OFF_CV + c]) * sigm(bf2f(cols[t * DINP + OFF_CG + c]));
}
DEVI void conv_kernel(const float* __restrict__ h, const float* __restrict__ w, const float* __restrict__ bias,
                      const float* __restrict__ gg, const float* __restrict__ gb, bf16* __restrict__ mix, int bid) {
    const int t = bid, c = tidx() & 255;
    float acc = bias[c];
#pragma unroll 4
    for (int j = 0; j < 31; ++j) {
        const int tt = t - 30 + j;
        if (tt >= 0) acc = fmaf(h[(size_t)tt * 256 + c], w[j * 256 + c], acc);
    }
    const float mean = wave_sum(acc) * (1.f / 64.f);
    const float d = acc - mean;
    const float var = wave_sum(d * d) * (1.f / 64.f);
    const float y = d * rsqrtf(var + 1e-5f) * gg[c] + gb[c];
    mix[(size_t)t * DM + 0 + c] = (bf16)f2bf(y * sigm(y));
}

DEVI void gmlp_pre(const bf16* __restrict__ cols, const float* __restrict__ lg, const float* __restrict__ lb,
                   float* __restrict__ ub, float* __restrict__ vb, int bid, float* sm) {
    __syncthreads();
    const size_t t = bid; const int c = tidx() & 255;
    ub[t * 256 + c] = gelu_t(bf2f(cols[t * DINP + OFF_GU + c]));
    const float v = gelu_t(bf2f(cols[t * DINP + OFF_GV + c]));
    const float mean = block_sum256(v, sm, c) * (1.f / 256.f);
    const float d = v - mean;
    const float var = block_sum256(d * d, sm, c) * (1.f / 256.f);
    vb[t * 256 + c] = d * rsqrtf(var + 1e-5f) * lg[c] + lb[c];
}
DEVI void gmlp_mix(const float* __restrict__ ub, const float* __restrict__ vb, const float* __restrict__ ws,
                   const float* __restrict__ bs, bf16* __restrict__ mix, int bid) {
    const int t = bid, c = tidx() & 255, h = c >> 6, tt = t & 127, base = t - tt;
    float acc = bs[h * 128 + tt];
    const float* wr = ws + ((size_t)h * 128 + tt) * 128;
#pragma unroll 4
    for (int s = 0; s <= tt; ++s) acc = fmaf(wr[s], vb[(size_t)(base + s) * 256 + c], acc);
    mix[(size_t)t * DM + 512 + c] = (bf16)f2bf(ub[(size_t)t * 256 + c] * acc);
}

struct RwkvP {
    const bf16* cols; const float* mu; const float* w0; const float* w_up; const float* a0; const float* a_up; const float* g_up;
    const float* k_k; const float* k_a; const float* r_k; const float* vd; const float* v_mu; const float* v0; const float* v_up;
    float* vfirst; bf16* R; float* LW; bf16* K; bf16* V; bf16* A; bf16* Bv; float* G; float* BON;
    int layer, pad;
};
DEVI void rwkv_prep(const RwkvP& p, int bid, float* sm) {
    __syncthreads();
    float* y = sm;
    float* vds = sm + 1024;
    const int t = bid, c = tidx() & 255;
#pragma unroll
    for (int q = 0; q < 4; ++q) {
        const int j = c + q * 256;
        const float cur = bf2f(p.cols[(size_t)t * DINP + OFF_RW + j]);
        const float prv = t > 0 ? bf2f(p.cols[(size_t)(t - 1) * DINP + OFF_RW + j]) : 0.f;
        y[j] = cur + p.mu[j] * (prv - cur);
    }
    if (p.layer > 0 && c < 32) {
        const float cur = bf2f(p.cols[(size_t)t * DINP + DIN + c]);
        const float prv = t > 0 ? bf2f(p.cols[(size_t)(t - 1) * DINP + DIN + c]) : 0.f;
        vds[c] = cur + p.v_mu[c] * (prv - cur);
    }
    __syncthreads();
    float tw = 0.f, sg = 0.f;
    if (c < 64) tw = tanhf(y[768 + c]);
    if (c >= 128) sg = sigm(y[896 + (c - 128)]);
    __syncthreads();
    if (c < 64) y[768 + c] = tw;
    if (c >= 128) y[896 + (c - 128)] = sg;
    __syncthreads();
    const float r = y[c], k = y[256 + c];
    float v = y[512 + c];
    float wl = p.w0[c], al = p.a0[c], gl = 0.f;
#pragma unroll 4
    for (int j = 0; j < 64; ++j) { wl = fmaf(y[768 + j], p.w_up[j * 256 + c], wl); al = fmaf(y[832 + j], p.a_up[j * 256 + c], al); }
#pragma unroll 4
    for (int j = 0; j < 128; ++j) gl = fmaf(y[896 + j], p.g_up[j * 256 + c], gl);
    const float wlog = -softplus_(-wl) - 0.5f;
    const float a = sigm(al);
    if (p.layer == 0) {
        p.vfirst[(size_t)t * 256 + c] = v;
    } else {
        float vm = p.v0[c];
#pragma unroll 4
        for (int j = 0; j < 32; ++j) vm = fmaf(vds[j], p.v_up[j * 256 + c], vm);
        vm = sigm(vm);
        v = v + (p.vfirst[(size_t)t * 256 + c] - v) * vm;
    }
    float kk = k * p.k_k[c];
    const float nrm = sqrtf(wave_sum(kk * kk));
    kk = kk / fmaxf(nrm, 1e-12f);
    const float k2 = k * (1.f + (a - 1.f) * p.k_a[c]);
    const float bd = wave_sum(r * k2 * p.r_k[c]);
    const size_t o = (size_t)t * 256 + c;
    p.R[o] = (bf16)f2bf(r); p.LW[o] = -expf(wlog); p.K[o] = (bf16)f2bf(k2); p.V[o] = (bf16)f2bf(v); p.A[o] = (bf16)f2bf(-kk); p.Bv[o] = (bf16)f2bf(kk * a); p.G[o] = gl; p.BON[o] = bd * v;
}
DEVI void rwkv_scan(float* R, const float* __restrict__ W, const float* __restrict__ K, const float* __restrict__ V,
                    const float* __restrict__ A, const float* __restrict__ Bv, float* sm0) {
    float (*sr)[256] = (float (*)[256])sm0, (*sw)[256] = sr + 4, (*sk)[256] = sr + 8, (*sa)[256] = sr + 12, (*sb)[256] = sr + 16, (*sv)[256] = sr + 20;
    const int vt = tidx(); const bool act = vt < 256;
    const int tid = vt & 255, h = tid >> 6, lane = tid & 63;
    float st[64];
#pragma unroll
    for (int i = 0; i < 64; ++i) st[i] = 0.f;
    for (int t0 = 0; t0 < SEQ; t0 += 4) {
        __syncthreads();
        if (act) {
#pragma unroll
            for (int s = 0; s < 4; ++s) {
                const size_t idx = (size_t)(t0 + s) * 256 + tid;
                sr[s][tid] = R[idx]; sw[s][tid] = W[idx]; sk[s][tid] = K[idx]; sa[s][tid] = A[idx]; sb[s][tid] = Bv[idx]; sv[s][tid] = V[idx];
            }
        }
        __syncthreads();
        if (act) {
#pragma unroll 1
            for (int s = 0; s < 4; ++s) {
                const float vt_ = sv[s][tid];
                const float* pa = &sa[s][h * 64]; const float* pw = &sw[s][h * 64]; const float* pb = &sb[s][h * 64];
                const float* pk = &sk[s][h * 64]; const float* pr = &sr[s][h * 64];
                float sa_ = 0.f;
#pragma unroll
                for (int k = 0; k < 64; ++k) sa_ = fmaf(st[k], pa[k], sa_);
#pragma unroll
                for (int k = 0; k < 64; ++k) st[k] = fmaf(st[k], pw[k], fmaf(sa_, pb[k], vt_ * pk[k]));
                float o = 0.f;
#pragma unroll
                for (int k = 0; k < 64; ++k) o = fmaf(st[k], pr[k], o);
                R[(size_t)(t0 + s) * 256 + h * 64 + lane] = o;
            }
        }
    }
    __syncthreads();
}
DEVI void rwkv_post(const float* __restrict__ O, const float* __restrict__ BON, const float* __restrict__ G,
                    const float* __restrict__ gg, const float* __restrict__ gb, bf16* __restrict__ mix, int bid) {
    const size_t t = bid; const int c = tidx() & 255;
    const float o = O[t * 256 + c];
    const float mean = wave_sum(o) * (1.f / 64.f);
    const float d = o - mean;
    const float var = wave_sum(d * d) * (1.f / 64.f);
    const float y = d * rsqrtf(var + 64e-5f) * gg[c] + gb[c];
    mix[t * DM + 256 + c] = (bf16)f2bf((y + BON[t * 256 + c]) * G[t * 256 + c]);
}

DEVI void nsa_prep(const bf16* __restrict__ cols, float* __restrict__ qrot, float* __restrict__ ksr,
                   float* __restrict__ kwr, float* __restrict__ gates, int bid) {
    const int t = bid, c = tidx() & 255;
    const int d = c & 63, j = d & 31;
    const float inv = powf(10000.f, -(float)j / 32.f);
    const float ang = (float)t * inv;
    float sn, cs; sincosf(ang, &sn, &cs);
    {
        const bf16* q = cols + (size_t)t * DINP + OFF_Q + (c & ~63);
        const float x1 = bf2f(q[j]), x2 = bf2f(q[j + 32]);
        qrot[(size_t)t * 256 + c] = d < 32 ? x1 * cs - x2 * sn : x2 * cs + x1 * sn;
    }
    if (c < 128) {
        const bf16* kp = cols + (size_t)t * DINP + (c < 64 ? OFF_KS : OFF_KW);
        const float x1 = bf2f(kp[j]), x2 = bf2f(kp[j + 32]);
        const float v = d < 32 ? x1 * cs - x2 * sn : x2 * cs + x1 * sn;
        if (c < 64) ksr[(size_t)t * 64 + d] = v; else kwr[(size_t)t * 64 + d] = v;
    }
    if (c < 12) gates[(size_t)t * 12 + c] = sigm(bf2f(cols[(size_t)t * DINP + OFF_GT + c]));
}
DEVI void cmp_gather(const bf16* __restrict__ cols, const float* __restrict__ pek, const float* __restrict__ pev,
                     bf16* __restrict__ bk, bf16* __restrict__ bv, int bid) {
    const int n = bid, tid = tidx() & 255;
    for (int i = tid; i < 2048; i += 256) {
        const int l = i >> 6, d = i & 63;
        const size_t row = (size_t)(16 * n + l) * DINP;
        bk[(size_t)n * 2048 + i] = n < NCMP ? (bf16)f2bf(bf2f(cols[row + OFF_KC + d]) + pek[i]) : (bf16)0;
        bv[(size_t)n * 2048 + i] = n < NCMP ? (bf16)f2bf(bf2f(cols[row + OFF_VC + d]) + pev[i]) : (bf16)0;
    }
}
DEVI void gelu_inplace(float* p, int n, int bid) {
    const int i = bid * 256 + (tidx() & 255);
    if (i < n) p[i] = gelu_t(p[i]);
}

DEVI void wave_softmax(float* s, int n, int lane) {
    float m = -INFINITY;
    for (int i = lane; i < n; i += 64) m = fmaxf(m, s[i]);
    m = wave_max(m);
    if (m == -INFINITY) { for (int i = lane; i < n; i += 64) s[i] = 0.f; return; }
    float sum = 0.f;
    for (int i = lane; i < n; i += 64) { const float p = expf(s[i] - m); s[i] = p; sum += p; }
    sum = wave_sum(sum);
    const float inv = 1.f / fmaxf(sum, 1e-20f);
    for (int i = lane; i < n; i += 64) s[i] *= inv;
}
DEVI void dot4(const float* q  , const float* __restrict__ krow, float* out4) {
    float a0 = 0.f, a1 = 0.f, a2 = 0.f, a3 = 0.f;
#pragma unroll
    for (int d = 0; d < 64; d += 4) {
        const float4 kv = *(const float4*)(krow + d);
        a0 += q[d] * kv.x + q[d + 1] * kv.y + q[d + 2] * kv.z + q[d + 3] * kv.w;
        a1 += q[64 + d] * kv.x + q[64 + d + 1] * kv.y + q[64 + d + 2] * kv.z + q[64 + d + 3] * kv.w;
        a2 += q[128 + d] * kv.x + q[128 + d + 1] * kv.y + q[128 + d + 2] * kv.z + q[128 + d + 3] * kv.w;
        a3 += q[192 + d] * kv.x + q[192 + d + 1] * kv.y + q[192 + d + 2] * kv.z + q[192 + d + 3] * kv.w;
    }
    out4[0] = a0; out4[1] = a1; out4[2] = a2; out4[3] = a3;
}
DEVI void nsa_attn(const bf16* __restrict__ cols, const float* __restrict__ qrot, const float* __restrict__ ksr,
                   const float* __restrict__ kwr, const float* __restrict__ gates, const float* __restrict__ kcmp,
                   const float* __restrict__ vcmp, bf16* __restrict__ mix, int bid, float* sm) {
    __syncthreads();
    float* q = sm; float* qr = sm + 256;
    float (*sc)[1024] = (float (*)[1024])(sm + 512);
    float* imp = sm + 512 + 4096;
    int* sel = (int*)(sm + 512 + 4096 + 128);
    const int pos = bid, tid = tidx() & 255, h = tid >> 6, lane = tid & 63;
    q[tid] = bf2f(cols[(size_t)pos * DINP + OFF_Q + tid]);
    qr[tid] = qrot[(size_t)pos * 256 + tid];
    __syncthreads();
    int ncv = pos >= 31 ? (pos - 31) / 16 + 1 : 0;
    if (ncv > NCMP) ncv = NCMP;
    for (int n = tid; n < 512; n += 256) {
        if (n < ncv) {
            float d4[4]; dot4(q, kcmp + (size_t)n * 64, d4);
            sc[0][n] = d4[0] * 0.125f; sc[1][n] = d4[1] * 0.125f; sc[2][n] = d4[2] * 0.125f; sc[3][n] = d4[3] * 0.125f;
        } else { sc[0][n] = 0.f; sc[1][n] = 0.f; sc[2][n] = 0.f; sc[3][n] = 0.f; }
    }
    __syncthreads();
    wave_softmax(sc[h], ncv, lane);
    __syncthreads();
    float oc = 0.f;
#pragma unroll 4
    for (int n = 0; n < ncv; ++n) oc = fmaf(sc[h][n], vcmp[(size_t)n * 64 + lane], oc);
    if (tid < 128) {
        const int j = tid;
        auto ps = [&](int n) -> float { return (n >= 0 && n < 512) ? (sc[0][n] + sc[1][n] + sc[2][n] + sc[3][n]) : 0.f; };
        const float v = 0.5f * ps(4 * j - 1) + ps(4 * j) + ps(4 * j + 1) + ps(4 * j + 2) + 0.5f * ps(4 * j + 3);
        const int cur = pos >> 6;
        float key;
        if (j == cur || j == 0) key = INFINITY; else if (j <= cur) key = v; else key = -1.f;
        imp[j] = key;
    }
    __syncthreads();
    if (h == 0) {
        float v0 = imp[lane], v1 = imp[lane + 64];
        for (int r = 0; r < 16; ++r) {
            float bv; int bi;
            if (v1 > v0) { bv = v1; bi = lane + 64; } else { bv = v0; bi = lane; }
#pragma unroll
            for (int o = 32; o > 0; o >>= 1) {
                const float ov = __shfl_xor(bv, o, 64); const int oi = __shfl_xor(bi, o, 64);
                if (ov > bv || (ov == bv && oi < bi)) { bv = ov; bi = oi; }
            }
            if (lane == 0) sel[r] = bi;
            if (bi == lane) v0 = -2.f;
            if (bi == lane + 64) v1 = -2.f;
        }
    }
    __syncthreads();
    for (int i = tid; i < 1024; i += 256) {
        const int kp = sel[i >> 6] * 64 + (i & 63);
        if (kp <= pos) {
            float d4[4]; dot4(qr, ksr + (size_t)kp * 64, d4);
            sc[0][i] = d4[0] * 0.125f; sc[1][i] = d4[1] * 0.125f; sc[2][i] = d4[2] * 0.125f; sc[3][i] = d4[3] * 0.125f;
        } else { sc[0][i] = -INFINITY; sc[1][i] = -INFINITY; sc[2][i] = -INFINITY; sc[3][i] = -INFINITY; }
    }
    __syncthreads();
    wave_softmax(sc[h], 1024, lane);
    __syncthreads();
    float os = 0.f;
#pragma unroll 2
    for (int i = 0; i < 1024; ++i) {
        const float p = sc[h][i];
        if (p != 0.f) { const int kp = sel[i >> 6] * 64 + (i & 63); os = fmaf(p, bf2f(cols[(size_t)kp * DINP + OFF_VS + lane]), os); }
    }
    __syncthreads();
    for (int i = tid; i < 512; i += 256) {
        const int kp = pos - 511 + i;
        if (kp >= 0) {
            float d4[4]; dot4(qr, kwr + (size_t)kp * 64, d4);
            sc[0][i] = d4[0] * 0.125f; sc[1][i] = d4[1] * 0.125f; sc[2][i] = d4[2] * 0.125f; sc[3][i] = d4[3] * 0.125f;
        } else { sc[0][i] = -INFINITY; sc[1][i] = -INFINITY; sc[2][i] = -INFINITY; sc[3][i] = -INFINITY; }
    }
    __syncthreads();
    wave_softmax(sc[h], 512, lane);
    __syncthreads();
    float ow = 0.f;
#pragma unroll 4
    for (int i = 0; i < 512; ++i) {
        const int kp = pos - 511 + i;
        if (kp >= 0) ow = fmaf(sc[h][i], bf2f(cols[(size_t)kp * DINP + OFF_VW + lane]), ow);
    }
    const float* gt = gates + (size_t)pos * 12 + h * 3;
    mix[(size_t)pos * DM + 768 + tid] = (bf16)f2bf(gt[0] * oc + gt[1] * os + gt[2] * ow);
}

DEVI void softmax256(float* s, float scale, int bid, float* sm) {
    __syncthreads();
    const size_t row = bid; const int tid = tidx() & 255;
    const float v = s[row * 256 + tid] * scale;
    float m = wave_max(v);
    if ((tid & 63) == 0) sm[8 + (tid >> 6)] = m;
    __syncthreads();
    m = fmaxf(fmaxf(sm[8], sm[9]), fmaxf(sm[10], sm[11]));
    const float p = expf(v - m);
    const float sum = block_sum256(p, sm, tid);
    s[row * 256 + tid] = p / sum;
}

DEVI void router_kernel(const float* __restrict__ x, const float* __restrict__ rw, const float* __restrict__ rb,
                        int* __restrict__ te, float* __restrict__ tw, int bid, float* sm) {
    __syncthreads();
    float (*part)[16] = (float (*)[16])sm;
    const size_t t = bid; const int tid = tidx() & 255;
    float acc[16];
#pragma unroll
    for (int e = 0; e < 16; ++e) acc[e] = 0.f;
#pragma unroll 1
    for (int i = tid; i < DM; i += 256) {
        const float xv = x[t * DM + i];
#pragma unroll
        for (int e = 0; e < 16; ++e) acc[e] = fmaf(xv, rw[i * 16 + e], acc[e]);
    }
#pragma unroll
    for (int e = 0; e < 16; ++e) acc[e] = wave_sum(acc[e]);
    if ((tid & 63) == 0) {
#pragma unroll
        for (int e = 0; e < 16; ++e) part[tid >> 6][e] = acc[e];
    }
    __syncthreads();
    if (tid == 0) {
        float lg[16], pr[16], sl[16];
        float m = -INFINITY;
#pragma unroll
        for (int e = 0; e < 16; ++e) { lg[e] = part[0][e] + part[1][e] + part[2][e] + part[3][e]; m = fmaxf(m, lg[e]); }
        float sum = 0.f;
#pragma unroll
        for (int e = 0; e < 16; ++e) { pr[e] = expf(lg[e] - m); sum += pr[e]; }
#pragma unroll
        for (int e = 0; e < 16; ++e) { pr[e] /= sum; sl[e] = pr[e] + rb[e]; }
        int bg = 0; float bgs = -INFINITY;
#pragma unroll
        for (int gI = 0; gI < 4; ++gI) {
            float m1 = -INFINITY, m2 = -INFINITY;
#pragma unroll
            for (int j = 0; j < 4; ++j) { const float v = sl[gI * 4 + j]; if (v > m1) { m2 = m1; m1 = v; } else if (v > m2) m2 = v; }
            const float sc = m1 + m2;
            if (sc > bgs) { bgs = sc; bg = gI; }
        }
        int e0 = -1, e1 = -1; float s0 = -INFINITY, s1 = -INFINITY, p0 = 0.f, p1 = 0.f;
#pragma unroll
        for (int e = 0; e < 16; ++e) {
            if ((e >> 2) == bg) {
                const float v = sl[e];
                if (v > s0) { s1 = s0; e1 = e0; p1 = p0; s0 = v; e0 = e; p0 = pr[e]; } else if (v > s1) { s1 = v; e1 = e; p1 = pr[e]; }
            }
        }
        const float wsum = p0 + p1;
        te[t * 2] = e0; te[t * 2 + 1] = e1;
        tw[t * 2] = p0 / wsum; tw[t * 2 + 1] = p1 / wsum;
    }
}
DEVI void moe_lists(const int* __restrict__ te, int* __restrict__ off, int* __restrict__ list, int* __restrict__ slotpos, float* sm0) {
    int* cnt = (int*)sm0;
    int* offs = cnt + 16;
    const int w = tidx() >> 6, lane = tidx() & 63;
    __syncthreads();
    for (int ee = 0; ee < 2; ++ee) {
        const int e = w * 2 + ee;
        int c = 0;
        for (int base = 0; base < NTOK; base += 64) {
            const int tok = base + lane;
            const bool m = (te[tok * 2] == e) || (te[tok * 2 + 1] == e);
            c += __popcll(__ballot(m));
        }
        if (lane == 0) cnt[e] = c;
    }
    __syncthreads();
    if (tidx() == 0) {
        int s = 0;
        for (int i = 0; i < 16; ++i) { offs[i] = s; off[i] = s; s += cnt[i]; }
        offs[16] = s; off[16] = s;
    }
    __syncthreads();
    for (int ee = 0; ee < 2; ++ee) {
        const int e = w * 2 + ee;
        int pos = offs[e];
        for (int base = 0; base < NTOK; base += 64) {
            const int tok = base + lane;
            const int a = te[tok * 2], b = te[tok * 2 + 1];
            const bool m = (a == e) || (b == e);
            const unsigned long long mask = __ballot(m);
            if (m) {
                const int p = pos + __popcll(mask & ((1ull << lane) - 1ull));
                list[p] = tok;
                slotpos[tok * 2 + (a == e ? 0 : 1)] = p;
            }
            pos += __popcll(mask);
        }
    }
    __syncthreads();
}
DEVI void moe_combine_ln(const float* x, const float* __restrict__ Dp, const int* __restrict__ te,
                         const float* __restrict__ tw, const int* __restrict__ slotpos,
                         const float* __restrict__ g, const float* __restrict__ bt, float* out, bf16* outb, int bid, float* sm) {
    __syncthreads();
    const size_t t = bid; const int tid = tidx() & 255;
    int ea = te[t * 2], eb = te[t * 2 + 1];
    float wa = tw[t * 2], wb = tw[t * 2 + 1];
    size_t pa = slotpos[t * 2], pb = slotpos[t * 2 + 1];
    if (eb < ea) { const float tf = wa; wa = wb; wb = tf; const size_t tp = pa; pa = pb; pb = tp; }
    float v[4];
#pragma unroll
    for (int i = 0; i < 4; ++i) {
        const int c = tid + i * 256;
        float y = wa * Dp[pa * DM + c];
        y = y + wb * Dp[pb * DM + c];
        v[i] = ALPHA * x[t * DM + c] + y;
    }
    const float mean = block_sum256(v[0] + v[1] + v[2] + v[3], sm, tid) * (1.f / DM);
    float q = 0.f;
#pragma unroll
    for (int i = 0; i < 4; ++i) { v[i] -= mean; q += v[i] * v[i]; }
    const float var = block_sum256(q, sm, tid) * (1.f / DM);
    const float rstd = rsqrtf(var + 1e-5f);
#pragma unroll
    for (int i = 0; i < 4; ++i) {
        const int c = tid + i * 256;
        const float o = v[i] * rstd * g[c] + bt[c];
        out[t * DM + c] = o;
        outb[t * DM + c] = (bf16)f2bf(o);
    }
}
typedef short bf16x8 __attribute__((ext_vector_type(8)));
typedef short s16x4 __attribute__((ext_vector_type(4)));
typedef float f32x16 __attribute__((ext_vector_type(16)));
typedef float f32x2_t __attribute__((ext_vector_type(2)));
typedef __bf16 bf16x2_t __attribute__((ext_vector_type(2)));
DEVI unsigned cvtpk(float lo, float hi) { f32x2_t v = {lo, hi}; bf16x2_t b = __builtin_convertvector(v, bf16x2_t); return __builtin_bit_cast(unsigned, b); }
constexpr float QSCL = 0.125f * 1.4426950408889634f;

struct NsaP {
    const bf16 *QN, *QR, *KSR, *KWR, *VST, *VWT, *KCMP, *VCMPT;
    const float* GATES;
    bf16* MIX;
};
constexpr int NSA_KT = 0, NSA_VT = 16384, NSA_IA = 32768, NSA_IB = 65536, NSA_SELM = 98304, NSA_UNI = 99328;

DEVI int crow(int r, int hi) { return (r & 3) + 8 * (r >> 2) + 4 * hi; }
DEVI float max3f(float a, float b, float c) { float r; asm("v_max3_f32 %0, %1, %2, %3" : "=v"(r) : "v"(a), "v"(b), "v"(c)); return r; }
DEVI float max2f(float a, float b) { float r; asm("v_max_f32_e32 %0, %1, %2" : "=v"(r) : "v"(a), "v"(b)); return r; }
DEVI float half_max(float x) { auto rr = __builtin_amdgcn_permlane32_swap(__float_as_uint(x), __float_as_uint(x), false, false); return max2f(__uint_as_float(rr[0]), __uint_as_float(rr[1])); }
DEVI float half_sum(float x) { auto rr = __builtin_amdgcn_permlane32_swap(__float_as_uint(x), __float_as_uint(x), false, false); return __uint_as_float(rr[0]) + __uint_as_float(rr[1]); }
DEVI float quad_sum(float x) {
    x += __int_as_float(__builtin_amdgcn_update_dpp(0, __float_as_int(x), 0xB1, 0xF, 0xF, true));
    x += __int_as_float(__builtin_amdgcn_update_dpp(0, __float_as_int(x), 0x4E, 0xF, 0xF, true));
    return x;
}
DEVI float rowmax32(const f32x16& p0, const f32x16& p1) {
    float a = max3f(p0[0], p0[1], p1[0]), b = max3f(p0[2], p0[3], p1[1]); a = max3f(a, p1[2], p1[3]);
#pragma unroll
    for (int r = 4; r < 16; r += 4) { a = max3f(a, p0[r], p0[r + 1]); b = max3f(b, p0[r + 2], p0[r + 3]); a = max3f(a, p1[r], p1[r + 1]); b = max3f(b, p1[r + 2], p1[r + 3]); }
    return half_max(max2f(a, b));
}

DEVI void nsa_ld(v4u& rk, v4u& rv, const bf16* kbase, const bf16* vbase, size_t vstride, int tid) {
    rk = *(const v4u*)((const char*)kbase + tid * 16);
    rv = *(const v4u*)((const char*)(vbase + (size_t)(tid >> 3) * vstride) + (tid & 7) * 16);
}
DEVI void nsa_st(LAS unsigned char* KTb, LAS unsigned char* VTb, const v4u& rk, const v4u& rv, int tid) {
    typedef unsigned u32x2s __attribute__((ext_vector_type(2)));
    const int r = tid >> 3, c = tid & 7, f = (r >> 1) & 7;
    *(LAS v4u*)(KTb + r * 128 + ((c ^ f) << 4)) = rk;
    const int G = c >> 1, o8 = (c & 1) * 8;
    *(LAS u32x2s*)(VTb + r * 128 + (((2 * G) ^ f) << 4) + o8) = (u32x2s){rv.x, rv.y};
    *(LAS u32x2s*)(VTb + r * 128 + (((2 * G + 1) ^ f) << 4) + o8) = (u32x2s){rv.z, rv.w};
}
DEVI void nsa_qk(f32x16& p0, f32x16& p1, const LAS unsigned char* KTb, const bf16x8 (&qf)[4], int q32, int hi) {
#pragma unroll
    for (int r = 0; r < 16; ++r) { p0[r] = 0.f; p1[r] = 0.f; }
    const int f = (q32 >> 1) & 7;
#pragma unroll
    for (int ks = 0; ks < 4; ++ks) {
        const int c = ((2 * ks + hi) ^ f) << 4;
        const bf16x8 a0 = *(const LAS bf16x8*)(KTb + q32 * 128 + c);
        const bf16x8 a1 = *(const LAS bf16x8*)(KTb + (32 + q32) * 128 + c);
        p0 = __builtin_amdgcn_mfma_f32_32x32x16_bf16(a0, qf[ks], p0, 0, 0, 0);
        p1 = __builtin_amdgcn_mfma_f32_32x32x16_bf16(a1, qf[ks], p1, 0, 0, 0);
    }
}
DEVI void nsa_pv(f32x16 (&o)[2], const LAS unsigned char* VTb, const bf16x8 (&pf)[4], int q32, int hi) {
    const int f = (q32 >> 1) & 7;
#pragma unroll
    for (int db = 0; db < 2; ++db) {
        const LAS unsigned char* rowp = VTb + (32 * db + q32) * 128;
#pragma unroll
        for (int s = 0; s < 4; ++s) {
            const bf16x8 a = *(const LAS bf16x8*)(rowp + (((2 * s + hi) ^ f) << 4));
            o[db] = __builtin_amdgcn_mfma_f32_32x32x16_bf16(a, pf[s], o[db], 0, 0, 0);
        }
    }
}
DEVI void nsa_pack(bf16x8 (&pf)[4], const f32x16& p0, const f32x16& p1) {
#pragma unroll
    for (int s = 0; s < 2; ++s) {
        unsigned w0[4], w1[4];
#pragma unroll
        for (int j = 0; j < 4; ++j) { w0[j] = cvtpk(p0[8 * s + 2 * j], p0[8 * s + 2 * j + 1]); w1[j] = cvtpk(p1[8 * s + 2 * j], p1[8 * s + 2 * j + 1]); }
        pf[s] = __builtin_bit_cast(bf16x8, (v4u){w0[0], w0[1], w0[2], w0[3]});
        pf[2 + s] = __builtin_bit_cast(bf16x8, (v4u){w1[0], w1[1], w1[2], w1[3]});
    }
}
DEVI void nsa_softmax(f32x16& p0, f32x16& p1, float& m, float& l, f32x16 (&o)[2], bf16x8 (&pf)[4]) {
    typedef float f2 __attribute__((ext_vector_type(2)));
    const float mx = rowmax32(p0, p1);
    if (__any(mx > m + 8.f)) {
        const float mn = fmaxf(m, mx);
        const float msn = (mn == -INFINITY) ? 0.f : mn;
        const float alpha = __builtin_amdgcn_exp2f(m - msn);
        l *= alpha; m = mn;
#pragma unroll
        for (int r = 0; r < 16; ++r) { o[0][r] *= alpha; o[1][r] *= alpha; }
    }
    const float ms = (m == -INFINITY) ? 0.f : m;
    f2 sum = {0.f, 0.f};
#pragma unroll
    for (int r = 0; r < 16; r += 2) {
        f2 x0 = {p0[r], p0[r + 1]}, x1 = {p1[r], p1[r + 1]};
        x0 = x0 - ms; x1 = x1 - ms;
        x0.x = __builtin_amdgcn_exp2f(x0.x); x0.y = __builtin_amdgcn_exp2f(x0.y); x1.x = __builtin_amdgcn_exp2f(x1.x); x1.y = __builtin_amdgcn_exp2f(x1.y);
        sum = sum + x0 + x1;
        p0[r] = x0.x; p0[r + 1] = x0.y; p1[r] = x1.x; p1[r + 1] = x1.y;
    }
    l += half_sum(sum.x + sum.y);
    nsa_pack(pf, p0, p1);
}
DEVI void nsa_loadq(bf16x8 (&qf)[4], const bf16* Q, int tq, int head, int hi) {
    const bf16* qp = Q + (size_t)tq * 256 + head * 64 + 8 * hi;
#pragma unroll
    for (int ks = 0; ks < 4; ++ks) qf[ks] = *(const bf16x8*)(qp + 16 * ks);
}


#define NSA_PIPE(NT_, KP_, VP_, VSTR_, ...) do { \
    const int nt_ = (NT_); v4u rk0_, rv0_, rk1_, rv1_; \
    if (nt_ > 0) nsa_ld(rk0_, rv0_, KP_(0), VP_(0), VSTR_, tid); \
    if (nt_ > 1) nsa_ld(rk1_, rv1_, KP_(1), VP_(1), VSTR_, tid); \
    __syncthreads(); \
    if (nt_ > 0) nsa_st(KT, VT, rk0_, rv0_, tid); \
    __syncthreads(); \
    if (nt_ > 2) nsa_ld(rk0_, rv0_, KP_(2), VP_(2), VSTR_, tid); \
    for (int it0_ = 0; it0_ < nt_; it0_ += 2) { \
        { const int it_ = it0_; const int bo_ = 0; __VA_ARGS__ } \
        if (it0_ + 1 < nt_) nsa_st(KT + 8192, VT + 8192, rk1_, rv1_, tid); \
        __syncthreads(); \
        if (it0_ + 3 < nt_) nsa_ld(rk1_, rv1_, KP_(it0_ + 3), VP_(it0_ + 3), VSTR_, tid); \
        if (it0_ + 1 >= nt_) break; \
        { const int it_ = it0_ + 1; const int bo_ = 8192; __VA_ARGS__ } \
        if (it0_ + 2 < nt_) nsa_st(KT, VT, rk0_, rv0_, tid); \
        __syncthreads(); \
        if (it0_ + 4 < nt_) nsa_ld(rk0_, rv0_, KP_(it0_ + 4), VP_(it0_ + 4), VSTR_, tid); \
    } } while (0)

DEVI int nsa_split(int cur) { return (cur + 10) >> 1; }
DEVI void nsa_unit(const NsaP& P, int u, LAS unsigned char* lds, int kind, unsigned* part) {
    const int tid = tidx(), w = tid >> 6, lane = tid & 63, q32 = lane & 31, hi = lane >> 5;
    const int t0 = u * 64, cur = u;
    const int tl = 8 * w + (q32 >> 2), head = q32 & 3, tq = t0 + tl;
    LAS unsigned char* KT = lds + NSA_KT; LAS unsigned char* VT = lds + NSA_VT;
    LAS float* IA = (LAS float*)(lds + NSA_IA); LAS float* IB = (LAS float*)(lds + NSA_IB);
    LAS unsigned* SELM = (LAS unsigned*)(lds + NSA_SELM); LAS unsigned* UNI = (LAS unsigned*)(lds + NSA_UNI);
    __syncthreads();
    for (int i = tid; i < 2 * 64 * 128; i += 512) IA[i] = 0.f;
    if (tid < 4) UNI[tid] = 0u;
    LAS float* ACC = (LAS float*)(lds + NSA_IA) + (w * 32) * 64 + lane;
    bf16x8 qf[4], pf[4];
    f32x16 o[2], p0, p1;

    {
        nsa_loadq(qf, P.QN, tq, head, hi);
        const int nlim = tq >= 31 ? (tq - 31) >> 4 : -1;
        const int nmaxu = (t0 + 63 - 31) >> 4;
        const int nct = (nmaxu >> 6) + 1;
        float m = -INFINITY, l = 0.f;
        for (int pass = 0; pass < 2; ++pass) {
#pragma unroll
            for (int r = 0; r < 16; ++r) { o[0][r] = 0.f; o[1][r] = 0.f; }
            const float rl = (pass == 1 && l > 0.f) ? 1.f / l : 0.f;
#define KPC_(i) (P.KCMP + (size_t)(i) * 64 * 64)
#define VPC_(i) (P.VCMPT + (i) * 64)
            NSA_PIPE(nct, KPC_, VPC_, 512, {
                nsa_qk(p0, p1, KT + bo_, qf, q32, hi);
                const int nb = it_ * 64;
                if (__any(nb + 63 > nlim)) {
                    const int lim = nlim - nb - 4 * hi;
_Pragma("unroll")
                    for (int r = 0; r < 16; ++r) { const int c0 = (r & 3) + 8 * (r >> 2); if (c0 > lim) p0[r] = -INFINITY; if (c0 + 32 > lim) p1[r] = -INFINITY; }
                }
                if (pass == 0) {
                    const float mx = rowmax32(p0, p1);
                    const float mn = fmaxf(m, mx), ms = (mn == -INFINITY) ? 0.f : mn;
                    float sum = 0.f;
_Pragma("unroll")
                    for (int r = 0; r < 16; ++r) sum += __builtin_amdgcn_exp2f(p0[r] - ms) + __builtin_amdgcn_exp2f(p1[r] - ms);
                    sum = half_sum(sum);
                    l = l * __builtin_amdgcn_exp2f(m - ms) + sum; m = mn;
                } else {
                    const float ms = (m == -INFINITY) ? 0.f : m;
_Pragma("unroll")
                    for (int r = 0; r < 16; ++r) { p0[r] = __builtin_amdgcn_exp2f(p0[r] - ms) * rl; p1[r] = __builtin_amdgcn_exp2f(p1[r] - ms) * rl; }
_Pragma("unroll")
                    for (int half = 0; half < 2; ++half) {
_Pragma("unroll")
                        for (int g = 0; g < 4; ++g) {
                            const f32x16& pp = half ? p1 : p0;
                            float a = pp[4 * g] + pp[4 * g + 1] + pp[4 * g + 2] + 0.5f * pp[4 * g + 3];
                            float b = 0.5f * pp[4 * g + 3];
                            a = quad_sum(a); b = quad_sum(b);
                            const int j = (nb + 32 * half + 8 * g + 4 * hi) >> 2;
                            if (head == 0 && j < 128) { IA[tl * 128 + j] = a; IB[tl * 128 + j] = b; }
                        }
                    }
                    nsa_pack(pf, p0, p1);
                    nsa_pv(o, VT + bo_, pf, q32, hi);
                }
            });
        }
        { const float g_c = P.GATES[(size_t)tq * 12 + head * 3 + 0];
#pragma unroll
        for (int r = 0; r < 16; ++r) { o[0][r] *= g_c; o[1][r] *= g_c; } }
    }
    REP(26)
    for (int tt = 0; tt < 8; ++tt) {
        const int tok = 8 * w + tt;
        unsigned k0, k1;
        {
            const int j0 = lane, j1 = lane + 64;
            const float i0f = IA[tok * 128 + j0] + (j0 > 0 ? IB[tok * 128 + j0 - 1] : 0.f), i1f = IA[tok * 128 + j1] + IB[tok * 128 + j1 - 1];
            k0 = (j0 == cur || j0 == 0) ? 0x7f800001u : (j0 <= cur ? __float_as_uint(i0f) + 1u : 0u);
            k1 = (j1 == cur) ? 0x7f800001u : (j1 <= cur ? __float_as_uint(i1f) + 1u : 0u);
        }
        unsigned T = 0u;
#pragma unroll 1
        for (int bit = 30; bit >= 0; --bit) {
            const unsigned cand = T | (1u << bit);
            const int cnt = __popcll(__ballot(k0 >= cand)) + __popcll(__ballot(k1 >= cand));
            if (cnt >= 16) T = cand;
        }
        const unsigned long long gt0 = __ballot(k0 > T), gt1 = __ballot(k1 > T), eq0 = __ballot(k0 == T), eq1 = __ballot(k1 == T);
        const int need = 16 - (__popcll(gt0) + __popcll(gt1));
        const unsigned long long lt = (1ull << lane) - 1ull;
        const bool s0_ = (k0 > T) || ((k0 == T) && __popcll(eq0 & lt) < need);
        const bool s1_ = (k1 > T) || ((k1 == T) && (__popcll(eq0) + __popcll(eq1 & lt)) < need);
        const unsigned long long b0 = __ballot(s0_), b1 = __ballot(s1_);
        if (lane == 0) {
            const unsigned m0 = (unsigned)b0, m1 = (unsigned)(b0 >> 32), m2 = (unsigned)b1, m3 = (unsigned)(b1 >> 32);
            SELM[tok * 4 + 0] = m0; SELM[tok * 4 + 1] = m1; SELM[tok * 4 + 2] = m2; SELM[tok * 4 + 3] = m3;
            __hip_atomic_fetch_or(&UNI[0], m0, __ATOMIC_RELAXED, __HIP_MEMORY_SCOPE_WORKGROUP); __hip_atomic_fetch_or(&UNI[1], m1, __ATOMIC_RELAXED, __HIP_MEMORY_SCOPE_WORKGROUP);
            __hip_atomic_fetch_or(&UNI[2], m2, __ATOMIC_RELAXED, __HIP_MEMORY_SCOPE_WORKGROUP); __hip_atomic_fetch_or(&UNI[3], m3, __ATOMIC_RELAXED, __HIP_MEMORY_SCOPE_WORKGROUP);
        }
    }
    __syncthreads();
#pragma unroll
    for (int r = 0; r < 16; ++r) { ACC[r * 64] = o[0][r]; ACC[(16 + r) * 64] = o[1][r]; }
    {
        nsa_loadq(qf, P.QR, tq, head, hi);
        const unsigned s0 = SELM[tl * 4 + 0], s1 = SELM[tl * 4 + 1], s2 = SELM[tl * 4 + 2], s3 = SELM[tl * 4 + 3];
        unsigned u0 = UNI[0], u1 = UNI[1], u2 = UNI[2], u3 = UNI[3];
        if (kind != 0) {
            const int js = nsa_split(cur);
            const unsigned g0 = js >= 32 ? 0u : (0xffffffffu << js), g1 = js >= 64 ? 0u : (js <= 32 ? 0xffffffffu : (0xffffffffu << (js - 32))),
                           g2 = js >= 96 ? 0u : (js <= 64 ? 0xffffffffu : (0xffffffffu << (js - 64))), g3 = js <= 96 ? 0xffffffffu : (0xffffffffu << (js - 96));
            if (kind == 1) { u0 &= g0; u1 &= g1; u2 &= g2; u3 &= g3; } else { u0 &= ~g0; u1 &= ~g1; u2 &= ~g2; u3 &= ~g3; }
        }
        float m = -INFINITY, l = 0.f;
        LAS unsigned char* TL = (LAS unsigned char*)(lds + NSA_UNI + 16);
        int ntl;
        {
            const unsigned lt0 = cur >= 31 ? 0xffffffffu : ((2u << cur) - 1u), lt1 = cur < 32 ? 0u : (cur >= 63 ? 0xffffffffu : ((2u << (cur - 32)) - 1u)),
                           lt2 = cur < 64 ? 0u : (cur >= 95 ? 0xffffffffu : ((2u << (cur - 64)) - 1u)), lt3 = cur < 96 ? 0u : (cur >= 127 ? 0xffffffffu : ((2u << (cur - 96)) - 1u));
            const unsigned v0 = u0 & lt0, v1 = u1 & lt1, v2 = u2 & lt2, v3 = u3 & lt3;
            ntl = __popc(v0) + __popc(v1) + __popc(v2) + __popc(v3);
            if (tid < 128) {
                const int jj = tid, wq = jj >> 5; const unsigned bit = 1u << (jj & 31), below = bit - 1u;
                const unsigned vw = wq == 0 ? v0 : (wq == 1 ? v1 : (wq == 2 ? v2 : v3));
                if (vw & bit) {
                    const int pos = (wq > 0 ? __popc(v0) : 0) + (wq > 1 ? __popc(v1) : 0) + (wq > 2 ? __popc(v2) : 0) + __popc(vw & below);
                    TL[pos] = (unsigned char)jj;
                }
            }
        }
        __syncthreads();
#define KPS_(i) (P.KSR + (size_t)TL[i] * 64 * 64)
#define VPS_(i) (P.VST + (int)TL[i] * 64)
        REP(25) {
        m = -INFINITY; l = 0.f;
#pragma unroll
        for (int r = 0; r < 16; ++r) { o[0][r] = 0.f; o[1][r] = 0.f; }
        NSA_PIPE(ntl, KPS_, VPS_, SEQ, {
            const int j = TL[it_];
            const unsigned wv = j < 32 ? s0 : (j < 64 ? s1 : (j < 96 ? s2 : s3));
            const bool mine = (wv >> (j & 31)) & 1u;
            if (__any(mine)) {
                nsa_qk(p0, p1, KT + bo_, qf, q32, hi);
                if (j == cur || !__all(mine)) {
                    const int klim = (mine ? (j == cur ? (tq & 63) : 63) : -1) - 4 * hi;
_Pragma("unroll")
                    for (int r = 0; r < 16; ++r) { const int c0 = (r & 3) + 8 * (r >> 2); if (c0 > klim) p0[r] = -INFINITY; if (c0 + 32 > klim) p1[r] = -INFINITY; }
                }
                nsa_softmax(p0, p1, m, l, o, pf);
                nsa_pv(o, VT + bo_, pf, q32, hi);
            }
        });
        }
        if (kind == 0) {
            const float g_s = P.GATES[(size_t)tq * 12 + head * 3 + 1];
            const float sc = l > 0.f ? g_s / l : 0.f;
#pragma unroll
            for (int r = 0; r < 16; ++r) { ACC[r * 64] += sc * o[0][r]; ACC[(16 + r) * 64] += sc * o[1][r]; }
        } else {
            unsigned* pp = part + ((size_t)(kind - 1) * 8 + w) * 18 * 64 + lane;
#pragma unroll
            for (int db = 0; db < 2; ++db)
#pragma unroll
                for (int g = 0; g < 8; ++g) pp[(db * 8 + g) * 64] = cvtpk(o[db][2 * g], o[db][2 * g + 1]);
            pp[16 * 64] = __float_as_uint(m); pp[17 * 64] = __float_as_uint(l);
        }
    }
    if (kind == 2) return;
    {
        float m = -INFINITY, l = 0.f;
#pragma unroll
        for (int r = 0; r < 16; ++r) { o[0][r] = 0.f; o[1][r] = 0.f; }
        const int j0 = cur >= 8 ? cur - 8 : 0;
#define KPW_(i) (P.KWR + (size_t)(j0 + (i)) * 64 * 64)
#define VPW_(i) (P.VWT + (j0 + (i)) * 64)
        NSA_PIPE(cur - j0 + 1, KPW_, VPW_, SEQ, {
            const int j = j0 + it_;
            nsa_qk(p0, p1, KT + bo_, qf, q32, hi);
            if (j == cur || j + 8 == cur) {
                const int hiA = tq - j * 64 - 4 * hi, loA = hiA - 512;
_Pragma("unroll")
                for (int r = 0; r < 16; ++r) {
                    const int c0 = (r & 3) + 8 * (r >> 2);
                    if (c0 > hiA || c0 <= loA) p0[r] = -INFINITY;
                    if (c0 + 32 > hiA || c0 + 32 <= loA) p1[r] = -INFINITY;
                }
            }
            nsa_softmax(p0, p1, m, l, o, pf);
            nsa_pv(o, VT + bo_, pf, q32, hi);
        });
        const float g_w = P.GATES[(size_t)tq * 12 + head * 3 + 2];
        const float sc = l > 0.f ? g_w / l : 0.f;
#pragma unroll
        for (int r = 0; r < 16; ++r) { o[0][r] = ACC[r * 64] + sc * o[0][r]; o[1][r] = ACC[(16 + r) * 64] + sc * o[1][r]; }
    }
    if (kind == 1) {
        unsigned* pp = part + ((size_t)2 * 8 + w) * 18 * 64 + lane;
#pragma unroll
        for (int db = 0; db < 2; ++db)
#pragma unroll
            for (int g = 0; g < 8; ++g) pp[(db * 8 + g) * 64] = cvtpk(o[db][2 * g], o[db][2 * g + 1]);
        return;
    }
    {
        bf16* op = P.MIX + (size_t)tq * DM + 768 + head * 64 + 4 * hi;
#pragma unroll
        for (int db = 0; db < 2; ++db)
#pragma unroll
            for (int g = 0; g < 4; ++g) {
                const unsigned lo = cvtpk(o[db][4 * g], o[db][4 * g + 1]), h2 = cvtpk(o[db][4 * g + 2], o[db][4 * g + 3]);
                *(uint2*)(op + 32 * db + 8 * g) = make_uint2(lo, h2);
            }
    }
}

DEVI void nsa_combine(const NsaP& P, int u, int w, int lane, const unsigned* part) {
    const int q32 = lane & 31, hi = lane >> 5, tl = 8 * w + (q32 >> 2), head = q32 & 3, tq = u * 64 + tl;
    const unsigned* pa = part + ((size_t)1 * 8 + w) * 18 * 64 + lane;
    const unsigned* pb = part + ((size_t)0 * 8 + w) * 18 * 64 + lane;
    const unsigned* pc = part + ((size_t)2 * 8 + w) * 18 * 64 + lane;
    const float ma = __uint_as_float(pa[16 * 64]), la = __uint_as_float(pa[17 * 64]), mb = __uint_as_float(pb[16 * 64]), lb = __uint_as_float(pb[17 * 64]);
    const float mm = fmaxf(ma, mb), ms = (mm == -INFINITY) ? 0.f : mm;
    const float wa = __builtin_amdgcn_exp2f(ma - ms), wb = __builtin_amdgcn_exp2f(mb - ms);
    const float l = la * wa + lb * wb;
    const float g_s = P.GATES[(size_t)tq * 12 + head * 3 + 1];
    const float sc = l > 0.f ? g_s / l : 0.f;
    bf16* op = P.MIX + (size_t)tq * DM + 768 + head * 64 + 4 * hi;
#pragma unroll
    for (int db = 0; db < 2; ++db)
#pragma unroll
        for (int g = 0; g < 4; ++g) {
            float v[4];
#pragma unroll
            for (int e = 0; e < 2; ++e) {
                const unsigned xa = pa[(db * 8 + 2 * g + e) * 64], xb = pb[(db * 8 + 2 * g + e) * 64], xc = pc[(db * 8 + 2 * g + e) * 64];
                v[2 * e] = __uint_as_float(xc << 16) + sc * (wa * __uint_as_float(xa << 16) + wb * __uint_as_float(xb << 16));
                v[2 * e + 1] = __uint_as_float(xc & 0xffff0000u) + sc * (wa * __uint_as_float(xa & 0xffff0000u) + wb * __uint_as_float(xb & 0xffff0000u));
            }
            *(uint2*)(op + 32 * db + 8 * g) = make_uint2(cvtpk(v[0], v[1]), cvtpk(v[2], v[3]));
        }
}

DEVI void nsa_prep2(const bf16* __restrict__ cols, bf16* __restrict__ qn, bf16* __restrict__ qr, bf16* __restrict__ ksr, bf16* __restrict__ kwr,
                    bf16* __restrict__ vst, bf16* __restrict__ vwt, float* __restrict__ gates, int bid) {
    const int t = bid, c = tidx() & 255;
    const int d = c & 63, j = d & 31;
    const float inv = powf(10000.f, -(float)j / 32.f);
    const float ang = (float)t * inv;
    float sn, cs; sincosf(ang, &sn, &cs);
    {
        const bf16* q = cols + (size_t)t * DINP + OFF_Q + (c & ~63);
        const float x1 = bf2f(q[j]), x2 = bf2f(q[j + 32]);
        qn[(size_t)t * 256 + c] = (bf16)f2bf(bf2f(q[d]) * QSCL);
        qr[(size_t)t * 256 + c] = (bf16)f2bf((d < 32 ? x1 * cs - x2 * sn : x2 * cs + x1 * sn) * QSCL);
    }
    if (c < 128) {
        const bf16* kp = cols + (size_t)t * DINP + (c < 64 ? OFF_KS : OFF_KW);
        const float x1 = bf2f(kp[j]), x2 = bf2f(kp[j + 32]);
        const float v = d < 32 ? x1 * cs - x2 * sn : x2 * cs + x1 * sn;
        if (c < 64) ksr[(size_t)t * 64 + d] = (bf16)f2bf(v); else kwr[(size_t)t * 64 + d] = (bf16)f2bf(v);
    } else {
        const bf16 v = cols[(size_t)t * DINP + (c < 192 ? OFF_VS : OFF_VW) + d];
        if (c < 192) vst[(size_t)d * SEQ + t] = v; else vwt[(size_t)d * SEQ + t] = v;
    }
    if (c < 12) gates[(size_t)t * 12 + c] = sigm(bf2f(cols[(size_t)t * DINP + OFF_GT + c]));
}
DEVI void nsa_cmp_cvt(const float* __restrict__ kc, const float* __restrict__ vc, bf16* __restrict__ kcb, bf16* __restrict__ vct, int bid) {
    const int i = bid * 256 + (tidx() & 255);
    if (i < 512 * 64) {
        const int n = i >> 6, d = i & 63;
        kcb[i] = n < NCMP ? (bf16)f2bf(kc[i]) : (bf16)0;
        vct[d * 512 + n] = n < NCMP ? (bf16)f2bf(vc[i]) : (bf16)0;
    }
}
DEVI float4 ld4bf(const bf16* p);
constexpr int RW_SLOT = 8192;
typedef unsigned u32x2v __attribute__((ext_vector_type(2)));
DEVI int rw_off(int row, int chunk16) { return row * 128 + ((chunk16 ^ (row & 7)) << 4); }
DEVI void rw_ld(LAS unsigned char* slot, const bf16* g, int gt) {
#pragma unroll
    for (int e = 0; e < 2; ++e) { const int idx = gt + 256 * e, row = idx >> 3, ch = idx & 7;
        *(LAS v4u*)(slot + rw_off(row, ch)) = *(const v4u*)((const char*)g + idx * 16); }
}
DEVI void rw_ldT(LAS unsigned char* slot, const bf16* g, size_t gstride, int gt) {
#pragma unroll
    for (int e = 0; e < 2; ++e) { const int idx = gt + 256 * e, row = idx >> 3, ch = idx & 7;
        const v4u v = *(const v4u*)(g + (size_t)row * gstride + ch * 8);
        const unsigned w[4] = {v.x, v.y, v.z, v.w};
#pragma unroll
        for (int j = 0; j < 8; ++j) { const int col = ch * 8 + j; const unsigned short h = (unsigned short)(w[j >> 1] >> ((j & 1) * 16));
            *(LAS unsigned short*)(slot + rw_off(col, row >> 3) + (row & 7) * 2) = h; }
    }
}
DEVI bf16x8 rw_frag(const LAS unsigned char* slot, int blk, int s, int r32, int hi) {
    return *(const LAS bf16x8*)(slot + rw_off(32 * blk + r32, 2 * s + hi));
}
DEVI void rw_mm(f32x16& acc, const LAS unsigned char* slotA, int rb, const LAS unsigned char* slotBT, int cb, int r32, int hi) {
#pragma unroll
    for (int s = 0; s < 4; ++s) acc = __builtin_amdgcn_mfma_f32_32x32x16_bf16(rw_frag(slotA, rb, s, r32, hi), rw_frag(slotBT, cb, s, r32, hi), acc, 0, 0, 0);
}
DEVI void rw_stT(LAS unsigned char* slot, const f32x16& acc, int rb, int cb, int r32, int hi) {
    const int j = 32 * cb + r32;
#pragma unroll
    for (int g = 0; g < 4; ++g) {
        const u32x2v w = {cvtpk(acc[4 * g], acc[4 * g + 1]), cvtpk(acc[4 * g + 2], acc[4 * g + 3])};
        *(LAS u32x2v*)(slot + rw_off(j, 4 * rb + g) + 8 * hi) = w;
    }
}
DEVI void rw_st(LAS unsigned char* slot, const f32x16& acc, int rb, int cb, int r32, int hi) {
    const int j = 32 * cb + r32;
#pragma unroll
    for (int r = 0; r < 16; ++r) { const int i = 32 * rb + crow(r, hi);
        *(LAS unsigned short*)(slot + rw_off(i, j >> 3) + (j & 7) * 2) = (unsigned short)f2bf(acc[r]); }
}
DEVI void rw_ldaccT(f32x16& acc, const LAS unsigned char* slot, int rb, int cb, int r32, int hi) {
    const int j = 32 * cb + r32;
#pragma unroll
    for (int g = 0; g < 4; ++g) {
        const u32x2v w = *(const LAS u32x2v*)(slot + rw_off(j, 4 * rb + g) + 8 * hi);
        acc[4 * g] = __builtin_bit_cast(float, w.x << 16); acc[4 * g + 1] = __builtin_bit_cast(float, w.x & 0xffff0000u);
        acc[4 * g + 2] = __builtin_bit_cast(float, w.y << 16); acc[4 * g + 3] = __builtin_bit_cast(float, w.y & 0xffff0000u);
    }
}
DEVI void rw_zero(f32x16& a) {
#pragma unroll
    for (int r = 0; r < 16; ++r) a[r] = 0.f;
}
DEVI void rw_frags(v4u& f0, v4u& f1, const f32x16& a) {
    f0 = (v4u){cvtpk(a[0], a[1]), cvtpk(a[2], a[3]), cvtpk(a[4], a[5]), cvtpk(a[6], a[7])};
    f1 = (v4u){cvtpk(a[8], a[9]), cvtpk(a[10], a[11]), cvtpk(a[12], a[13]), cvtpk(a[14], a[15])};
}

struct RwP {
    const bf16 *R, *K, *V, *A, *B;
    const float* LW; const bf16 *G, *BON;
    bf16 *AT, *BT, *KT, *RT;
    float* LAM;
    v4u *PF, *HF;
    float *QT, *OL;
    v4u* SF;
    const float *gn_g, *gn_b;
    bf16* MIX;
};

DEVI void rw_r1b(const RwP& P, int c, LAS unsigned char* lds) {
    LAS float* cum = (LAS float*)lds;
    const int tid = tidx();
    __syncthreads();
    if (tid < 256) {
        float s = 0.f;
#pragma unroll 8
        for (int t = 0; t < 64; ++t) { s += P.LW[(size_t)(c * 64 + t) * 256 + tid]; cum[t * 256 + tid] = s; }
    }
    __syncthreads();
    for (int e = tid; e < 64 * 256; e += 512) {
        const int t = e >> 8, ch = e & 255, h = ch >> 6, k = ch & 63;
        const size_t gi = (size_t)(c * 64 + t) * 256 + ch;
        const float cu = cum[e], lw = P.LW[gi];
        const float ein = __expf(cu), eout = __expf(-cu), eex = __expf(cu - lw);
        const size_t o = ((size_t)(c * 4 + h) * 64 + t) * 64 + k;
        P.AT[o] = (bf16)f2bf(bf2f(P.A[gi]) * eex);
        P.BT[o] = (bf16)f2bf(bf2f(P.B[gi]) * eout);
        P.KT[o] = (bf16)f2bf(bf2f(P.K[gi]) * eout);
        P.RT[o] = (bf16)f2bf(bf2f(P.R[gi]) * ein);
        if (t == 63) P.LAM[(size_t)(c * 4 + h) * 64 + k] = ein;
    }
}

DEVI void rw_r2(const RwP& P, int u0, LAS unsigned char* lds) {
    const int tid = tidx(), grp = tid >> 8, gt = tid & 255, gw = (tid >> 6) & 3, lane = tid & 63, r32 = lane & 31, hi = lane >> 5;
    const int rb = gw >> 1, cb = gw & 1;
    const int u = u0 + grp, c = u >> 2, h = u & 3;
    LAS unsigned char* sl = lds + grp * 65536;
#define SL(i) (sl + (i) * RW_SLOT)
    __syncthreads();
    rw_ld(SL(0), P.BT + (size_t)u * 4096, gt); rw_ld(SL(1), P.AT + (size_t)u * 4096, gt);
    rw_ld(SL(2), P.KT + (size_t)u * 4096, gt); rw_ld(SL(3), P.RT + (size_t)u * 4096, gt);
    __syncthreads();
    f32x16 aMab, aMak, aNbr, aNkr;
    rw_zero(aMab); rw_zero(aMak); rw_zero(aNbr); rw_zero(aNkr);
    rw_mm(aMab, SL(0), rb, SL(1), cb, r32, hi);
    rw_mm(aMak, SL(2), rb, SL(1), cb, r32, hi);
    rw_mm(aNbr, SL(0), rb, SL(3), cb, r32, hi);
    rw_mm(aNkr, SL(2), rb, SL(3), cb, r32, hi);
    {
        const int t = 32 * cb + r32;
#pragma unroll
        for (int r = 0; r < 16; ++r) { const int i = 32 * rb + crow(r, hi);
            if (!(i < t)) { aMab[r] = 0.f; aMak[r] = 0.f; }
            if (!(i <= t)) { aNbr[r] = 0.f; aNkr[r] = 0.f; } }
    }
    __syncthreads();
    rw_st(SL(4), aMab, rb, cb, r32, hi);
    rw_stT(SL(5), aMab, rb, cb, r32, hi);
    rw_st(SL(6), aMak, rb, cb, r32, hi);
    rw_stT(SL(7), aNbr, rb, cb, r32, hi);
    {
        const int t = 32 * cb + r32;
#pragma unroll
        for (int r = 0; r < 16; ++r) { const int i = 32 * rb + crow(r, hi); if (i == t) aMab[r] += 1.f; }
    }
    rw_st(SL(0), aMab, rb, cb, r32, hi);
    __syncthreads();
    int mA = 4, mT = 5, nA = 1, nT = 2;
#pragma unroll 1
    for (int j = 0; j < 5; ++j) {
        f32x16 a1; rw_zero(a1);
        rw_mm(a1, SL(mT), rb, SL(mA), cb, r32, hi);
        rw_stT(SL(nA), a1, rb, cb, r32, hi);
        rw_st(SL(nT), a1, rb, cb, r32, hi);
        __syncthreads();
        f32x16 a2; rw_ldaccT(a2, SL(0), rb, cb, r32, hi);
        rw_mm(a2, SL(nT), rb, SL(0), cb, r32, hi);
        __syncthreads();
        rw_stT(SL(0), a2, rb, cb, r32, hi);
        __syncthreads();
        const int ta = mA, tb = mT; mA = nA; mT = nT; nA = ta; nT = tb;
    }
    rw_ldT(SL(1), P.BT + (size_t)u * 4096, 64, gt); rw_ldT(SL(2), P.AT + (size_t)u * 4096, 64, gt);
    rw_ldT(SL(4), P.KT + (size_t)u * 4096, 64, gt); rw_ldT(SL(5), P.V + (size_t)(c * 64) * 256 + h * 64, 256, gt);
    __syncthreads();
    {
        f32x16 aY, aZ; rw_zero(aY); rw_zero(aZ);
        rw_mm(aY, SL(0), rb, SL(1), cb, r32, hi);
        rw_mm(aZ, SL(0), rb, SL(7), cb, r32, hi);
        __syncthreads();
        rw_stT(SL(1), aY, rb, cb, r32, hi);
        rw_stT(SL(7), aZ, rb, cb, r32, hi);
        __syncthreads();
    }
    {
        f32x16 aP; rw_zero(aP);
        rw_mm(aP, SL(2), rb, SL(1), cb, r32, hi);
        const int kp = 32 * cb + r32; const float lam = P.LAM[(size_t)u * 64 + kp];
#pragma unroll
        for (int r = 0; r < 16; ++r) { const int kk = 32 * rb + crow(r, hi); aP[r] = (aP[r] + (kk == kp ? 1.f : 0.f)) * lam; }
        v4u f0, f1; rw_frags(f0, f1, aP);
        v4u* dst = P.PF + ((((size_t)u * 2 + cb) * 2 + rb) * 2) * 64 + lane;
        dst[0] = f0; dst[64] = f1;
    }
    {
        f32x16 aH; rw_ldaccT(aH, SL(3), rb, cb, r32, hi);
        rw_mm(aH, SL(2), rb, SL(7), cb, r32, hi);
        v4u f0, f1; rw_frags(f0, f1, aH);
        v4u* dst = P.HF + ((((size_t)u * 2 + cb) * 2 + rb) * 2) * 64 + lane;
        dst[0] = f0; dst[64] = f1;
    }
    {
        f32x16 aD1; rw_ldaccT(aD1, SL(4), rb, cb, r32, hi);
        rw_mm(aD1, SL(6), rb, SL(1), cb, r32, hi);
        rw_mm(aNkr, SL(6), rb, SL(7), cb, r32, hi);
        __syncthreads();
        rw_stT(SL(0), aD1, rb, cb, r32, hi);
        rw_stT(SL(3), aNkr, rb, cb, r32, hi);
        __syncthreads();
    }
    {
        f32x16 aQ; rw_zero(aQ);
        rw_mm(aQ, SL(0), rb, SL(5), cb, r32, hi);
        float* dst = P.QT + (((size_t)u * 2 + cb) * 2 + rb) * 1024 + lane * 4;
#pragma unroll
        for (int g = 0; g < 4; ++g) {
            const float4 lam = *(const float4*)(P.LAM + (size_t)u * 64 + 32 * rb + 8 * g + 4 * hi);
            *(float4*)(dst + g * 256) = make_float4(aQ[4 * g] * lam.x, aQ[4 * g + 1] * lam.y, aQ[4 * g + 2] * lam.z, aQ[4 * g + 3] * lam.w);
        }
    }
    {
        f32x16 aO; rw_zero(aO);
        rw_mm(aO, SL(5), rb, SL(3), cb, r32, hi);
        float* dst = P.OL + (((size_t)u * 2 + cb) * 2 + rb) * 1024 + lane * 4;
#pragma unroll
        for (int g = 0; g < 4; ++g) *(float4*)(dst + g * 256) = make_float4(aO[4 * g], aO[4 * g + 1], aO[4 * g + 2], aO[4 * g + 3]);
    }
#undef SL
}

DEVI void rw_r3_dma(const RwP& P, size_t u, int vb, int lane, LAS unsigned char* slot) {
#pragma unroll
    for (int kb = 0; kb < 2; ++kb) {
        const float* qp = P.QT + ((u * 2 + vb) * 2 + kb) * 1024 + lane * 4;
#pragma unroll
        for (int g = 0; g < 4; ++g) __builtin_amdgcn_global_load_lds((const unsigned*)(qp + g * 256), (LAS unsigned*)(slot + (kb * 4 + g) * 1024), 16, 0, 0);
        const v4u* pp = P.PF + (((u * 2 + kb) * 2) * 2) * 64 + lane;
#pragma unroll
        for (int i = 0; i < 4; ++i) __builtin_amdgcn_global_load_lds((const unsigned*)(pp + i * 64), (LAS unsigned*)(slot + 8192 + (kb * 4 + i) * 1024), 16, 0, 0);
    }
}
DEVI void rw_r3(const RwP& P, int b, int h, int vb, int lane, LAS unsigned char* ring4  ) {
    typedef float f32x4e __attribute__((ext_vector_type(4)));
    f32x16 st[2]; rw_zero(st[0]); rw_zero(st[1]);
    const size_t ub = (size_t)b * (SEQ / 64) * 4 + h;
    const int NC = SEQ / 64;
    rw_r3_dma(P, ub, vb, lane, ring4);
    rw_r3_dma(P, ub + 4, vb, lane, ring4 + 16384);
    rw_r3_dma(P, ub + 8, vb, lane, ring4 + 32768);
#pragma unroll 1
    for (int c = 0; c < NC; ++c) {
        const size_t u = ub + (size_t)c * 4;
        LAS unsigned char* slot = ring4 + (c & 3) * 16384;
        v4u sf[2][2];
        rw_frags(sf[0][0], sf[0][1], st[0]); rw_frags(sf[1][0], sf[1][1], st[1]);
        asm volatile("s_waitcnt vmcnt(32)" ::: "memory");
        f32x16 q[2]; v4u pf[8];
#pragma unroll
        for (int kb = 0; kb < 2; ++kb) {
#pragma unroll
            for (int g = 0; g < 4; ++g) { const f32x4e v = *(const LAS f32x4e*)(slot + (kb * 4 + g) * 1024 + lane * 16); q[kb][4 * g] = v[0]; q[kb][4 * g + 1] = v[1]; q[kb][4 * g + 2] = v[2]; q[kb][4 * g + 3] = v[3]; }
#pragma unroll
            for (int i = 0; i < 4; ++i) pf[kb * 4 + i] = *(const LAS v4u*)(slot + 8192 + (kb * 4 + i) * 1024 + lane * 16);
        }
        asm volatile("s_waitcnt lgkmcnt(0)" ::: "memory");
        v4u* sdst = P.SF + ((u * 2 + vb) * 4) * 64 + lane;
        sdst[0] = sf[0][0]; sdst[64] = sf[0][1]; sdst[128] = sf[1][0]; sdst[192] = sf[1][1];
        __builtin_amdgcn_sched_barrier(0);
        rw_r3_dma(P, ub + (size_t)(c + 3 < NC ? c + 3 : NC - 1) * 4, vb, lane, ring4 + ((c + 3) & 3) * 16384);
        __builtin_amdgcn_sched_barrier(0);
#pragma unroll
        for (int kb = 0; kb < 2; ++kb)
#pragma unroll
            for (int ki = 0; ki < 2; ++ki)
#pragma unroll
                for (int s = 0; s < 2; ++s)
                    q[kb] = __builtin_amdgcn_mfma_f32_32x32x16_bf16(__builtin_bit_cast(bf16x8, pf[kb * 4 + ki * 2 + s]), __builtin_bit_cast(bf16x8, sf[ki][s]), q[kb], 0, 0, 0);
        st[0] = q[0]; st[1] = q[1];
    }
    asm volatile("s_waitcnt vmcnt(0)" ::: "memory");
}

DEVI void rw_r4(const RwP& P, int u, int tb, int lane) {
    const int c = u >> 2, h = u & 3, r32 = lane & 31, hi = lane >> 5;
    f32x16 o[2];
#pragma unroll
    for (int vb = 0; vb < 2; ++vb) {
        const float* ol = P.OL + (((size_t)u * 2 + tb) * 2 + vb) * 1024 + lane * 4;
#pragma unroll
        for (int g = 0; g < 4; ++g) { const float4 v = *(const float4*)(ol + g * 256); o[vb][4 * g] = v.x; o[vb][4 * g + 1] = v.y; o[vb][4 * g + 2] = v.z; o[vb][4 * g + 3] = v.w; }
        const v4u* sf = P.SF + (((size_t)u * 2 + vb) * 4) * 64 + lane;
        const v4u* hf = P.HF + ((((size_t)u * 2 + tb) * 2) * 2) * 64 + lane;
#pragma unroll
        for (int kb = 0; kb < 2; ++kb)
#pragma unroll
            for (int s = 0; s < 2; ++s)
                o[vb] = __builtin_amdgcn_mfma_f32_32x32x16_bf16(__builtin_bit_cast(bf16x8, sf[(kb * 2 + s) * 64]), __builtin_bit_cast(bf16x8, hf[(kb * 2 + s) * 64]), o[vb], 0, 0, 0);
    }
    float sum = 0.f;
#pragma unroll
    for (int r = 0; r < 16; ++r) sum += o[0][r] + o[1][r];
    sum += __shfl_xor(sum, 32, 64);
    const float mean = sum * (1.f / 64.f);
    float q = 0.f;
#pragma unroll
    for (int r = 0; r < 16; ++r) { const float d0 = o[0][r] - mean, d1 = o[1][r] - mean; q += d0 * d0 + d1 * d1; }
    q += __shfl_xor(q, 32, 64);
    const float rstd = rsqrtf(q * (1.f / 64.f) + 64e-5f);
    const size_t tok = (size_t)c * 64 + 32 * tb + r32;
#pragma unroll
    for (int vb = 0; vb < 2; ++vb)
#pragma unroll
        for (int g = 0; g < 4; ++g) {
            const int ch = h * 64 + 32 * vb + 8 * g + 4 * hi;
            const float4 gg = *(const float4*)(P.gn_g + ch), gb = *(const float4*)(P.gn_b + ch);
            const float4 bo = ld4bf(P.BON + tok * 256 + ch), gt = ld4bf(P.G + tok * 256 + ch);
            const float y0 = ((o[vb][4 * g] - mean) * rstd * gg.x + gb.x + bo.x) * gt.x;
            const float y1 = ((o[vb][4 * g + 1] - mean) * rstd * gg.y + gb.y + bo.y) * gt.y;
            const float y2 = ((o[vb][4 * g + 2] - mean) * rstd * gg.z + gb.z + bo.z) * gt.z;
            const float y3 = ((o[vb][4 * g + 3] - mean) * rstd * gg.w + gb.w + bo.w) * gt.w;
            *(uint2*)(P.MIX + tok * DM + 256 + ch) = make_uint2(cvtpk(y0, y1), cvtpk(y2, y3));
        }
}
namespace pg8 {
struct XaOrder {
    int G, c;
    __device__ __forceinline__ bool next(int i, Unit& u) const {
        const int L = i * G + c; if (L >= 256) return false;
        u.pm = L >> 2; u.pn = ((L >> 2) >> 5) * 4 + (L & 3); return true;
    }
    __device__ __forceinline__ void a_ready(const Unit&) const {}
    __device__ __forceinline__ void done(const Unit&) const {}
};
struct MoeOrder {
    const int* tile_e; const int* nrt; int G, c;
    __device__ __forceinline__ bool next(int i, Unit& u) const {
        const int L = i * G + c; if (L >= 4 * (*nrt)) return false;
        u.pm = L >> 2; u.pn = tile_e[L >> 2] * 4 + (L & 3); return true;
    }
    __device__ __forceinline__ void a_ready(const Unit&) const {}
    __device__ __forceinline__ void done(const Unit&) const {}
};
#define PG8_EBAR() do { asm volatile("s_waitcnt lgkmcnt(0)" ::: "memory"); __builtin_amdgcn_s_barrier(); asm volatile("" ::: "memory"); } while (0)
struct EpiSoftmaxP {
    static constexpr bool PERM = true, AFTER_DRAIN = true;
    bf16_t* P;
    __device__ __forceinline__ void fused(f32x4 (&acc)[2][2][4][2], const Unit& u, int wr, int wc, int fr, int fq, PG8_LAS unsigned char* lds, int wid, int lane) const {
        PG8_LAS float* RM = (PG8_LAS float*)lds;
        PG8_LAS float* RS = RM + 1024;
#pragma unroll
        for (int ai = 0; ai < 2; ++ai)
#pragma unroll
            for (int m = 0; m < 4; ++m) {
                float mx = -INFINITY;
#pragma unroll
                for (int bj = 0; bj < 2; ++bj)
#pragma unroll
                    for (int n = 0; n < 2; ++n) { const f32x4 x = acc[ai][bj][m][n]; mx = fmaxf(mx, fmaxf(fmaxf(x[0], x[1]), fmaxf(x[2], x[3]))); }
                mx = fmaxf(mx, __shfl_xor(mx, 16)); mx = fmaxf(mx, __shfl_xor(mx, 32));
                if (fq == 0) RM[(ai * HALF + wr * 64 + m * 16 + fr) * 4 + wc] = mx;
            }
        PG8_EBAR();
#pragma unroll
        for (int ai = 0; ai < 2; ++ai)
#pragma unroll
            for (int m = 0; m < 4; ++m) {
                const int row = ai * HALF + wr * 64 + m * 16 + fr;
                const float gm = fmaxf(fmaxf(RM[row * 4 + 0], RM[row * 4 + 1]), fmaxf(RM[row * 4 + 2], RM[row * 4 + 3]));
                float s = 0.f;
#pragma unroll
                for (int bj = 0; bj < 2; ++bj)
#pragma unroll
                    for (int n = 0; n < 2; ++n) { f32x4 x = acc[ai][bj][m][n];
                        x[0] = __builtin_amdgcn_exp2f(x[0] - gm); x[1] = __builtin_amdgcn_exp2f(x[1] - gm); x[2] = __builtin_amdgcn_exp2f(x[2] - gm); x[3] = __builtin_amdgcn_exp2f(x[3] - gm);
                        s += (x[0] + x[1]) + (x[2] + x[3]); acc[ai][bj][m][n] = x; }
                s += __shfl_xor(s, 16); s += __shfl_xor(s, 32);
                if (fq == 0) RS[row * 4 + wc] = s;
            }
        PG8_EBAR();
        const int colb = (u.pn & 3) * BM + wc * 32 + 8 * fq;
#pragma unroll
        for (int ai = 0; ai < 2; ++ai)
#pragma unroll
            for (int m = 0; m < 4; ++m) {
                const int row = ai * HALF + wr * 64 + m * 16 + fr;
                const float inv = 1.0f / ((RS[row * 4 + 0] + RS[row * 4 + 1]) + (RS[row * 4 + 2] + RS[row * 4 + 3]));
                bf16_t* rowp = P + (size_t)(u.pm * BM + row) * 1024 + colb;
#pragma unroll
                for (int bj = 0; bj < 2; ++bj) { const f32x4 v0 = acc[ai][bj][m][0] * inv, v1 = acc[ai][bj][m][1] * inv;
                    u32x4 w; w.x = cvt_pk_bf16(v0[0], v0[1]); w.y = cvt_pk_bf16(v0[2], v0[3]); w.z = cvt_pk_bf16(v1[0], v1[1]); w.w = cvt_pk_bf16(v1[2], v1[3]);
                    *(u32x4*)(rowp + bj * HALF) = w; }
            }
        PG8_EBAR();
    }
};
struct EpiF32N4 {
    static constexpr bool PERM = false, AFTER_DRAIN = false;
    float* C; int ldc;
    __device__ __forceinline__ void operator()(const f32x4 (&acc)[2][2][4][2], const Unit& u, int wr, int wc, int fr, int fq) const {
        const int row0 = u.pm * BM + wr * 64 + fr, col0 = (u.pn & 3) * BM + wc * 32 + 4 * fq;
#pragma unroll
        for (int ai = 0; ai < 2; ++ai)
#pragma unroll
            for (int m = 0; m < 4; ++m) { float* rowp = C + (size_t)(row0 + ai * HALF + m * 16) * ldc + col0;
#pragma unroll
                for (int bj = 0; bj < 2; ++bj)
#pragma unroll
                    for (int n = 0; n < 2; ++n) *(f32x4*)(rowp + bj * HALF + n * 16) = acc[ai][bj][m][n]; }
    }
};
struct EpiBf16N4 {
    static constexpr bool PERM = true, AFTER_DRAIN = false;
    bf16_t* O; int ldc;
    __device__ __forceinline__ void operator()(const f32x4 (&acc)[2][2][4][2], const Unit& u, int wr, int wc, int fr, int fq) const {
        const int row0 = u.pm * BM + wr * 64 + fr, col0 = (u.pn & 3) * BM + wc * 32 + 8 * fq;
#pragma unroll
        for (int ai = 0; ai < 2; ++ai)
#pragma unroll
            for (int m = 0; m < 4; ++m) { bf16_t* rowp = O + (size_t)(row0 + ai * HALF + m * 16) * ldc + col0;
#pragma unroll
                for (int bj = 0; bj < 2; ++bj) { const f32x4 v0 = acc[ai][bj][m][0], v1 = acc[ai][bj][m][1];
                    u32x4 w; w.x = cvt_pk_bf16(v0[0], v0[1]); w.y = cvt_pk_bf16(v0[2], v0[3]); w.z = cvt_pk_bf16(v1[0], v1[1]); w.w = cvt_pk_bf16(v1[2], v1[3]);
                    *(u32x4*)(rowp + bj * HALF) = w; } }
    }
};
struct EpiSiluMul {
    static constexpr bool PERM = true, AFTER_DRAIN = false;
    bf16_t* H;
    __device__ __forceinline__ void operator()(const f32x4 (&acc)[2][2][4][2], const Unit& u, int wr, int wc, int fr, int fq) const {
        const int row0 = u.pm * BM + wr * 64 + fr, col0 = (u.pn & 3) * HALF + wc * 32 + 8 * fq;
#pragma unroll
        for (int ai = 0; ai < 2; ++ai)
#pragma unroll
            for (int m = 0; m < 4; ++m) {
                float h[8];
#pragma unroll
                for (int n = 0; n < 2; ++n)
#pragma unroll
                    for (int e = 0; e < 4; ++e) { const float g = acc[ai][0][m][n][e], up = acc[ai][1][m][n][e];
                        h[4 * n + e] = g * __builtin_amdgcn_rcpf(1.0f + __expf(-g)) * up; }
                u32x4 w; w.x = cvt_pk_bf16(h[0], h[1]); w.y = cvt_pk_bf16(h[2], h[3]); w.z = cvt_pk_bf16(h[4], h[5]); w.w = cvt_pk_bf16(h[6], h[7]);
                *(u32x4*)(H + (size_t)(row0 + ai * HALF + m * 16) * 512 + col0) = w;
            }
    }
};

struct OneUnit {
    int pm, pn, valid;
    __device__ __forceinline__ bool next(int i, Unit& u) const { if (i != 0 || !valid) return false; u.pm = pm; u.pn = pn; return true; }
    __device__ __forceinline__ void a_ready(const Unit&) const {}
    __device__ __forceinline__ void done(const Unit&) const {}
};
struct EpiBf16S {
    static constexpr bool PERM = true, AFTER_DRAIN = false;
    bf16_t* O; int ldc; float scale;
    __device__ __forceinline__ void operator()(const f32x4 (&acc)[2][2][4][2], const Unit& u, int wr, int wc, int fr, int fq) const {
        const int row0 = u.pm * BM + wr * 64 + fr, col0 = u.pn * BM + wc * 32 + 8 * fq;
#pragma unroll
        for (int ai = 0; ai < 2; ++ai)
#pragma unroll
            for (int m = 0; m < 4; ++m) { bf16_t* rowp = O + (size_t)(row0 + ai * HALF + m * 16) * ldc + col0;
#pragma unroll
                for (int bj = 0; bj < 2; ++bj) { const f32x4 v0 = acc[ai][bj][m][0] * scale, v1 = acc[ai][bj][m][1] * scale;
                    u32x4 w; w.x = cvt_pk_bf16(v0[0], v0[1]); w.y = cvt_pk_bf16(v0[2], v0[3]); w.z = cvt_pk_bf16(v1[0], v1[1]); w.w = cvt_pk_bf16(v1[2], v1[3]);
                    *(u32x4*)(rowp + bj * HALF) = w; } }
    }
};
struct EpiGeluF32 {
    static constexpr bool PERM = false, AFTER_DRAIN = false;
    float* C; int ldc;
    __device__ __forceinline__ void operator()(const f32x4 (&acc)[2][2][4][2], const Unit& u, int wr, int wc, int fr, int fq) const {
        const int row0 = u.pm * BM + wr * 64 + fr, col0 = u.pn * BM + wc * 32 + 4 * fq;
#pragma unroll
        for (int ai = 0; ai < 2; ++ai)
#pragma unroll
            for (int m = 0; m < 4; ++m) { float* rowp = C + (size_t)(row0 + ai * HALF + m * 16) * ldc + col0;
#pragma unroll
                for (int bj = 0; bj < 2; ++bj)
#pragma unroll
                    for (int n = 0; n < 2; ++n) { f32x4 x = acc[ai][bj][m][n];
#pragma unroll
                        for (int e = 0; e < 4; ++e) x[e] = 0.5f * x[e] * (1.f + tanhf(0.7978845608028654f * (x[e] + 0.044715f * x[e] * x[e] * x[e])));
                        *(f32x4*)(rowp + bj * HALF + n * 16) = x; } }
    }
};
struct EpiGeluW2 {
    static constexpr bool PERM = false, AFTER_DRAIN = true;
    const bf16_t* W2T;
    bf16_t* O;
    int isv;
    __device__ __forceinline__ void fused(f32x4 (&acc)[2][2][4][2], const Unit& u, int wr, int wc, int fr, int fq, PG8_LAS unsigned char* lds, int wid, int lane) const {
        typedef unsigned u32x2e __attribute__((ext_vector_type(2)));
        typedef float f32x16e __attribute__((ext_vector_type(16)));
#pragma unroll
        for (int ai = 0; ai < 2; ++ai)
#pragma unroll
            for (int m = 0; m < 4; ++m) { const int row = ai * HALF + wr * 64 + m * 16 + fr;
#pragma unroll
                for (int bj = 0; bj < 2; ++bj)
#pragma unroll
                    for (int n = 0; n < 2; ++n) { f32x4 x = acc[ai][bj][m][n];
#pragma unroll
                        for (int e = 0; e < 4; ++e) x[e] = 0.5f * x[e] * (1.f + tanhf(0.7978845608028654f * (x[e] + 0.044715f * x[e] * x[e] * x[e])));
                        const int col = bj * HALF + wc * 32 + n * 16 + 4 * fq;
                        *(PG8_LAS u32x2e*)(lds + row * 512 + ((((col >> 3) ^ (row & 7))) << 4) + (col & 7) * 2) = (u32x2e){cvt_pk_bf16(x[0], x[1]), cvt_pk_bf16(x[2], x[3])}; } }
        PG8_EBAR();
        const int r32 = lane & 31, hi = lane >> 5, row = wid * 32 + r32;
        f32x16e o[2];
#pragma unroll
        for (int cb = 0; cb < 2; ++cb)
#pragma unroll
            for (int r = 0; r < 16; ++r) o[cb][r] = 0.f;
#pragma unroll 4
        for (int s = 0; s < 16; ++s) {
            const bf16x8 a = *(const PG8_LAS bf16x8*)(lds + row * 512 + (((2 * s + hi) ^ (row & 7)) << 4));
#pragma unroll
            for (int cb = 0; cb < 2; ++cb) {
                const bf16x8 b = *(const bf16x8*)(W2T + (size_t)(32 * cb + r32) * 256 + 16 * s + 8 * hi);
                o[cb] = __builtin_amdgcn_mfma_f32_32x32x16_bf16(a, b, o[cb], 0, 0, 0);
            }
        }
#pragma unroll
        for (int cb = 0; cb < 2; ++cb)
#pragma unroll
            for (int g = 0; g < 4; ++g) {
                const int grow = u.pm * BM + wid * 32 + 8 * g + 4 * hi, col = 32 * cb + r32;
                if (isv) { *(u32x2e*)(O + (size_t)(grow >> 9) * 64 * 512 + (size_t)col * 512 + (grow & 511)) = (u32x2e){cvt_pk_bf16(o[cb][4 * g], o[cb][4 * g + 1]), cvt_pk_bf16(o[cb][4 * g + 2], o[cb][4 * g + 3])}; }
                else {
#pragma unroll
                    for (int e = 0; e < 4; ++e) O[(size_t)(grow + e) * 64 + col] = (bf16_t)(cvt_pk_bf16(o[cb][4 * g + e], 0.f) & 0xffffu);
                }
            }
        PG8_EBAR();
    }
};
}

DEVI void tr_blk(const float* W, size_t ldw, int N, int k0, int n0, bf16* WT, size_t ldt, int drow0, float scale, LAS float* scr, int lane) {
    const int n_ = n0 + (lane & 31);
#pragma unroll 8
    for (int i = 0; i < 32; ++i) { const int kk = 2 * i + (lane >> 5); scr[kk * 33 + (lane & 31)] = n_ < N ? W[(size_t)(k0 + kk) * ldw + n_] * scale : 0.f; }
    LDS_WAIT(); asm volatile("" ::: "memory");
    const int c = lane & 7;
#pragma unroll
    for (int j = 0; j < 4; ++j) { const int n = (lane >> 3) + 8 * j; const LAS float* s = scr + (8 * c) * 33 + n;
        v4u o; o.x = pk2(s[0 * 33], s[1 * 33]); o.y = pk2(s[2 * 33], s[3 * 33]); o.z = pk2(s[4 * 33], s[5 * 33]); o.w = pk2(s[6 * 33], s[7 * 33]);
        *(GAS v4u*)(WT + (size_t)(drow0 + n) * ldt + k0 + 8 * c) = o; }
    LDS_WAIT(); asm volatile("" ::: "memory");
}
DEVI void cvt_bf16(const float* __restrict__ src, bf16* __restrict__ dst, size_t n, float scale, int B0, int G) {
    for (size_t i = ((size_t)B0 * 512 + tidx()) * 4; i < n; i += (size_t)G * 512 * 4) {
        const float4 v = *(const float4*)(src + i);
        *(uint2*)(dst + i) = make_uint2(pk2(v.x * scale, v.y * scale), pk2(v.z * scale, v.w * scale));
    }
}

DEVI void moe_lists2(const int* __restrict__ te, int* __restrict__ off, int* __restrict__ nrt, int* __restrict__ tile_e, int* __restrict__ list,
                     int* __restrict__ slotpos, float* sm0) {
    int* cnt = (int*)sm0;
    int* offs = cnt + 16;
    const int w = tidx() >> 6, lane = tidx() & 63;
    __syncthreads();
    for (int ee = 0; ee < 2; ++ee) {
        const int e = w * 2 + ee;
        int c = 0;
        for (int base = 0; base < NTOK; base += 64) {
            const int tok = base + lane;
            const bool m = (te[tok * 2] == e) || (te[tok * 2 + 1] == e);
            c += __popcll(__ballot(m));
        }
        if (lane == 0) cnt[e] = c;
    }
    __syncthreads();
    if (tidx() == 0) {
        int s = 0;
#pragma unroll 1
        for (int i = 0; i < 16; ++i) { offs[i] = s; off[i] = s; const int pc = (cnt[i] + 255) & ~255;
#pragma unroll 1
            for (int r = s / 256; r < (s + pc) / 256; ++r) tile_e[r] = i;
            s += pc; }
        offs[16] = s; off[16] = s; *nrt = s / 256;
    }
    __syncthreads();
    for (int ee = 0; ee < 2; ++ee) {
        const int e = w * 2 + ee;
        int pos = offs[e];
        for (int base = 0; base < NTOK; base += 64) {
            const int tok = base + lane;
            const int a = te[tok * 2], b = te[tok * 2 + 1];
            const bool m = (a == e) || (b == e);
            const unsigned long long mask = __ballot(m);
            if (m) {
                const int p = pos + __popcll(mask & ((1ull << lane) - 1ull));
                list[p] = tok;
                slotpos[tok * 2 + (a == e ? 0 : 1)] = p;
            }
            pos += __popcll(mask);
        }
        for (int p = pos + lane; p < offs[e + 1]; p += 64) list[p] = -1;
    }
    __syncthreads();
}
DEVI void moe_gather(const bf16* __restrict__ xn, const int* __restrict__ list, const int* __restrict__ off, bf16* __restrict__ xg, int B0, int G) {
    const int total = off[16];
    const int gw = B0 * NWAVES + (tidx() >> 6), lane = tidx() & 63;
    for (int p = gw; p < total; p += G * NWAVES) {
        const int tok = list[p];
        v4u a = (v4u){0u, 0u, 0u, 0u}, b = a;
        if (tok >= 0) { const v4u* s = (const v4u*)(xn + (size_t)tok * DM); a = s[lane]; b = s[lane + 64]; }
        v4u* d = (v4u*)(xg + (size_t)p * DM); d[lane] = a; d[lane + 64] = b;
    }
}
DEVI void moe_combine_ln2(const float* x, const bf16* __restrict__ Dp, const int* __restrict__ te,
                          const float* __restrict__ tw, const int* __restrict__ slotpos,
                          const float* __restrict__ g, const float* __restrict__ bt, float* out, bf16* outb, int bid, float* sm) {
    __syncthreads();
    const size_t t = bid; const int tid = tidx() & 255;
    int ea = te[t * 2], eb = te[t * 2 + 1];
    float wa = tw[t * 2], wb = tw[t * 2 + 1];
    size_t pa = slotpos[t * 2], pb = slotpos[t * 2 + 1];
    if (eb < ea) { const float tf = wa; wa = wb; wb = tf; const size_t tp = pa; pa = pb; pb = tp; }
    float v[4];
#pragma unroll
    for (int i = 0; i < 4; ++i) {
        const int c = tid + i * 256;
        float y = wa * bf2f(Dp[pa * DM + c]);
        y = y + wb * bf2f(Dp[pb * DM + c]);
        v[i] = ALPHA * x[t * DM + c] + y;
    }
    const float mean = block_sum256(v[0] + v[1] + v[2] + v[3], sm, tid) * (1.f / DM);
    float q = 0.f;
#pragma unroll
    for (int i = 0; i < 4; ++i) { v[i] -= mean; q += v[i] * v[i]; }
    const float var = block_sum256(q, sm, tid) * (1.f / DM);
    const float rstd = rsqrtf(var + 1e-5f);
#pragma unroll
    for (int i = 0; i < 4; ++i) {
        const int c = tid + i * 256;
        const float o = v[i] * rstd * g[c] + bt[c];
        out[t * DM + c] = o;
        outb[t * DM + c] = (bf16)f2bf(o);
    }
}
struct MixP {
    const bf16* COLS;
    const float *conv_w, *conv_b, *conv_gg, *conv_gb;
    const float *gl_g, *gl_b;
    const float *mu, *w0, *a0, *k_k, *k_a, *r_k, *v_mu, *v0;
    const bf16 *WUP_T, *AUP_T, *GUP_T, *VUP_T;
    const float *pe_k, *pe_v;
    bf16 *MIX, *UB, *VB;
    bf16 *AT, *BT, *KT, *RT, *V, *G, *BON, *VFIRST;
    float* LAM;
    bf16 *QN, *QR, *KSR, *KWR, *VST, *VWT;
    float* GATES;
    bf16 *BLK, *BLV;
    int layer, pad;
};
DEVI float4 ld4bf(const bf16* p) { const uint2 w = *(const uint2*)p; return make_float4(__builtin_bit_cast(float, w.x << 16), __builtin_bit_cast(float, w.x & 0xffff0000u), __builtin_bit_cast(float, w.y << 16), __builtin_bit_cast(float, w.y & 0xffff0000u)); }
DEVI void st4bf(bf16* p, float a, float b, float c, float d) { *(uint2*)p = make_uint2(cvtpk(a, b), cvtpk(c, d)); }
DEVI float fsig(float x) { return __builtin_amdgcn_rcpf(1.f + __expf(-x)); }
DEVI float ftanh(float x) { const float e = __expf(-2.f * fabsf(x)); const float t = (1.f - e) * __builtin_amdgcn_rcpf(1.f + e); return x < 0.f ? -t : t; }
DEVI float fgelu(float x) { return 0.5f * x * (1.f + ftanh(0.7978845608028654f * (x + 0.044715f * x * x * x))); }

DEVI void prep_unit(const MixP& P, int cg, LAS unsigned char* lds) {
    const int tid = tidx(), w = tid >> 6, lane = tid & 63;
    const int b = cg >> 7, pos0 = (cg & 127) * 64;
    const size_t tok0 = (size_t)cg * 64;
    const bf16* cols = P.COLS + tok0 * DINP;
    {
        LAS float* hb = (LAS float*)lds;
        __syncthreads();
        for (int e = tid; e < 94 * 64; e += 512) {
            const int row = e >> 6, c4 = (e & 63) * 4, tt = row - 30;
            float4 h = make_float4(0.f, 0.f, 0.f, 0.f);
            if (pos0 + tt >= 0) {
                const bf16* cr = cols + (long)tt * DINP;
                const float4 v = ld4bf(cr + OFF_CV + c4), g = ld4bf(cr + OFF_CG + c4);
                h = make_float4(v.x * fsig(g.x), v.y * fsig(g.y), v.z * fsig(g.z), v.w * fsig(g.w));
            }
            { typedef float f32x4v __attribute__((ext_vector_type(4))); *(LAS f32x4v*)(hb + row * 256 + c4) = (f32x4v){h.x, h.y, h.z, h.w}; }
        }
        __syncthreads();
        const int c = tid & 255, half = tid >> 8;
        float wj[31];
#pragma unroll
        for (int j = 0; j < 31; ++j) wj[j] = P.conv_w[j * 256 + c];
        const float bias = P.conv_b[c], gg = P.conv_gg[c], gb = P.conv_gb[c];
#pragma unroll 1
        for (int q = 0; q < 4; ++q) {
            float xs[38];
            const int tb = 32 * half + 8 * q;
#pragma unroll
            for (int i = 0; i < 38; ++i) xs[i] = hb[(tb + i) * 256 + c];
#pragma unroll
            for (int t = 0; t < 8; ++t) {
                float acc = bias;
#pragma unroll
                for (int j = 0; j < 31; ++j) acc = fmaf(wj[j], xs[t + j], acc);
                const float mean = wave_sum(acc) * (1.f / 64.f);
                const float d = acc - mean;
                const float var = wave_sum(d * d) * (1.f / 64.f);
                const float y = d * rsqrtf(var + 1e-5f) * gg + gb;
                P.MIX[(tok0 + tb + t) * DM + c] = (bf16)f2bf(y * fsig(y));
            }
        }
    }
    {
        const float4 lg = *(const float4*)(P.gl_g + lane * 4), lb = *(const float4*)(P.gl_b + lane * 4);
#pragma unroll 2
        for (int i = 0; i < 8; ++i) {
            const int t = w * 8 + i; const bf16* cr = cols + (size_t)t * DINP;
            const float4 u = ld4bf(cr + OFF_GU + lane * 4);
            st4bf(P.UB + (tok0 + t) * 256 + lane * 4, fgelu(u.x), fgelu(u.y), fgelu(u.z), fgelu(u.w));
            float4 v = ld4bf(cr + OFF_GV + lane * 4);
            v = make_float4(fgelu(v.x), fgelu(v.y), fgelu(v.z), fgelu(v.w));
            const float mean = wave_sum((v.x + v.y) + (v.z + v.w)) * (1.f / 256.f);
            v.x -= mean; v.y -= mean; v.z -= mean; v.w -= mean;
            const float var = wave_sum((v.x * v.x + v.y * v.y) + (v.z * v.z + v.w * v.w)) * (1.f / 256.f);
            const float rs = rsqrtf(var + 1e-5f);
            st4bf(P.VB + (tok0 + t) * 256 + lane * 4, v.x * rs * lg.x + lb.x, v.y * rs * lg.y + lb.y, v.z * rs * lg.z + lb.z, v.w * rs * lg.w + lb.w);
        }
    }
    {
        LAS float* cst = (LAS float*)lds;
        LAS unsigned short* vt = (LAS unsigned short*)(lds + 16384);
        __syncthreads();
        for (int e = tid; e < 2048; e += 512) {
            const int t = e >> 5, j = e & 31;
            const float inv = powf(10000.f, -(float)j / 32.f);
            float sn, cs; sincosf((float)(pos0 + t) * inv, &sn, &cs);
            cst[e * 2] = cs; cst[e * 2 + 1] = sn;
        }
        __syncthreads();
#pragma unroll 1
        for (int i = 0; i < 8; ++i) {
            const int t = w * 8 + i; const bf16* cr = cols + (size_t)t * DINP; const size_t tok = tok0 + t;
            {
                const int d4 = (lane & 15) * 4;
                const float4 x = ld4bf(cr + OFF_Q + lane * 4);
                const float4 pr = make_float4(__shfl_xor(x.x, 8, 64), __shfl_xor(x.y, 8, 64), __shfl_xor(x.z, 8, 64), __shfl_xor(x.w, 8, 64));
                const LAS float* cp = cst + (t * 32 + (d4 & 31)) * 2;
                const float sg = d4 < 32 ? -1.f : 1.f;
                st4bf(P.QN + tok * 256 + lane * 4, x.x * QSCL, x.y * QSCL, x.z * QSCL, x.w * QSCL);
                st4bf(P.QR + tok * 256 + lane * 4, (x.x * cp[0] + sg * pr.x * cp[1]) * QSCL, (x.y * cp[2] + sg * pr.y * cp[3]) * QSCL,
                      (x.z * cp[4] + sg * pr.z * cp[5]) * QSCL, (x.w * cp[6] + sg * pr.w * cp[7]) * QSCL);
            }
            {
                const int seg = lane >> 4, d4 = (lane & 15) * 4;
                const float4 x = ld4bf(cr + OFF_KS + seg * 64 + d4);
                const float4 pr = make_float4(__shfl_xor(x.x, 8, 64), __shfl_xor(x.y, 8, 64), __shfl_xor(x.z, 8, 64), __shfl_xor(x.w, 8, 64));
                if ((seg & 1) == 0) {
                    const LAS float* cp = cst + (t * 32 + (d4 & 31)) * 2;
                    const float sg = d4 < 32 ? -1.f : 1.f;
                    bf16* dst = (seg == 0 ? P.KSR : P.KWR) + tok * 64 + d4;
                    st4bf(dst, x.x * cp[0] + sg * pr.x * cp[1], x.y * cp[2] + sg * pr.y * cp[3], x.z * cp[4] + sg * pr.z * cp[5], x.w * cp[6] + sg * pr.w * cp[7]);
                } else {
                    LAS unsigned short* vp = vt + (seg >> 1) * 4096 + d4 * 64 + t;
                    vp[0] = (unsigned short)f2bf(x.x); vp[64] = (unsigned short)f2bf(x.y); vp[128] = (unsigned short)f2bf(x.z); vp[192] = (unsigned short)f2bf(x.w);
                }
            }
            if (lane < 12) P.GATES[tok * 12 + lane] = fsig(bf2f(cr[OFF_GT + lane]));
        }
        __syncthreads();
        for (int e = tid; e < 1024; e += 512) {
            const int which = e >> 9, d = (e >> 3) & 63, ch = e & 7;
            const v4u v = *(const LAS v4u*)((LAS unsigned char*)vt + which * 8192 + d * 128 + ch * 16);
            *(v4u*)((which ? P.VWT : P.VST) + ((size_t)b * 64 + d) * SEQ + pos0 + ch * 8) = v;
        }
        for (int e = tid; e < 4 * 512 * 2; e += 512) {
            const int isv = e >> 11, r = e & 2047, nl = r >> 9, i4 = (r & 511) * 4, l = i4 >> 6, d = i4 & 63;
            const int n = 4 * (cg & 127) + nl;
            bf16* dst = (isv ? P.BLV : P.BLK) + ((size_t)b * 512 + n) * 2048 + i4;
            if (n < NCMP) {
                const float4 x = ld4bf(cols + (size_t)(16 * nl + l) * DINP + (isv ? OFF_VC : OFF_KC) + d);
                const float4 pe = *(const float4*)((isv ? P.pe_v : P.pe_k) + i4);
                st4bf(dst, x.x + pe.x, x.y + pe.y, x.z + pe.z, x.w + pe.w);
            } else *(uint2*)dst = make_uint2(0u, 0u);
        }
    }
    {
        LAS unsigned char* TW = lds;
        LAS unsigned char* AD = lds + 8192;
        LAS unsigned char* SG = lds + 16384;
        LAS unsigned char* VD = lds + 32768;
        LAS float* CAR = (LAS float*)(lds + 36864);
        __syncthreads();
        for (int e = tid; e < 64 * 64; e += 512) {
            const int t = e >> 6, j4 = (e & 63) * 4;
            const bf16* cr = cols + (size_t)t * DINP + OFF_RW + 768 + j4;
            const float4 c4 = ld4bf(cr);
            float4 p4 = make_float4(0.f, 0.f, 0.f, 0.f);
            if (pos0 + t > 0) p4 = ld4bf(cr - DINP);
            const float4 m4 = *(const float4*)(P.mu + 768 + j4);
            float y0 = c4.x + m4.x * (p4.x - c4.x), y1 = c4.y + m4.y * (p4.y - c4.y), y2 = c4.z + m4.z * (p4.z - c4.z), y3 = c4.w + m4.w * (p4.w - c4.w);
            if (j4 < 64) { y0 = ftanh(y0); y1 = ftanh(y1); y2 = ftanh(y2); y3 = ftanh(y3);
                *(LAS u32x2v*)(TW + rw_off(t, j4 >> 3) + (j4 & 7) * 2) = (u32x2v){cvtpk(y0, y1), cvtpk(y2, y3)}; }
            else if (j4 < 128) { const int jj = j4 - 64;
                *(LAS u32x2v*)(AD + rw_off(t, jj >> 3) + (jj & 7) * 2) = (u32x2v){cvtpk(y0, y1), cvtpk(y2, y3)}; }
            else { const int jj = j4 - 128; y0 = fsig(y0); y1 = fsig(y1); y2 = fsig(y2); y3 = fsig(y3);
                *(LAS u32x2v*)(SG + t * 256 + (((jj >> 3) ^ (t & 7)) << 4) + (jj & 7) * 2) = (u32x2v){cvtpk(y0, y1), cvtpk(y2, y3)}; }
        }
        if (P.layer > 0) {
            const int t = tid >> 3, j4 = (tid & 7) * 4;
            const bf16* cr = cols + (size_t)t * DINP + DIN + j4;
            const float4 c4 = ld4bf(cr);
            float4 p4 = make_float4(0.f, 0.f, 0.f, 0.f);
            if (pos0 + t > 0) p4 = ld4bf(cr - DINP);
            const float4 m4 = *(const float4*)(P.v_mu + j4);
            *(LAS u32x2v*)(VD + t * 64 + j4 * 2) = (u32x2v){cvtpk(c4.x + m4.x * (p4.x - c4.x), c4.y + m4.y * (p4.y - c4.y)), cvtpk(c4.z + m4.z * (p4.z - c4.z), c4.w + m4.w * (p4.w - c4.w))};
        }
        __syncthreads();
        const int h = w >> 1, tb = w & 1, r32 = lane & 31, hi = lane >> 5;
        const int t = 32 * tb + r32;
        const size_t tok = tok0 + t;
        const bool hasprev = (pos0 + t) > 0;
        const bf16* crow_ = cols + (size_t)t * DINP + OFF_RW;
        float n2 = 0.f, bd = 0.f;
#pragma unroll 1
        for (int cb = 0; cb < 2; ++cb) {
            f32x16 al; rw_zero(al);
            const bf16* arow = P.AUP_T + (size_t)(h * 64 + 32 * cb + r32) * 64 + 8 * hi;
#pragma unroll
            for (int s = 0; s < 4; ++s) al = __builtin_amdgcn_mfma_f32_32x32x16_bf16(*(const bf16x8*)(arow + 16 * s), rw_frag(AD, tb, s, r32, hi), al, 0, 0, 0);
#pragma unroll
            for (int g = 0; g < 4; ++g) {
                const int ch = h * 64 + 32 * cb + 8 * g + 4 * hi;
                const float4 rc = ld4bf(crow_ + ch), kc = ld4bf(crow_ + 256 + ch);
                float4 rp = make_float4(0.f, 0.f, 0.f, 0.f), kp = rp;
                if (hasprev) { rp = ld4bf(crow_ - DINP + ch); kp = ld4bf(crow_ - DINP + 256 + ch); }
                const float4 mr = *(const float4*)(P.mu + ch), mk = *(const float4*)(P.mu + 256 + ch);
                const float4 a0 = *(const float4*)(P.a0 + ch), kk_ = *(const float4*)(P.k_k + ch), ka = *(const float4*)(P.k_a + ch), rk = *(const float4*)(P.r_k + ch);
                const float rr[4] = {rc.x + mr.x * (rp.x - rc.x), rc.y + mr.y * (rp.y - rc.y), rc.z + mr.z * (rp.z - rc.z), rc.w + mr.w * (rp.w - rc.w)};
                const float kv[4] = {kc.x + mk.x * (kp.x - kc.x), kc.y + mk.y * (kp.y - kc.y), kc.z + mk.z * (kp.z - kc.z), kc.w + mk.w * (kp.w - kc.w)};
                const float a0v[4] = {a0.x, a0.y, a0.z, a0.w}, kkv[4] = {kk_.x, kk_.y, kk_.z, kk_.w}, kav[4] = {ka.x, ka.y, ka.z, ka.w}, rkv[4] = {rk.x, rk.y, rk.z, rk.w};
#pragma unroll
                for (int e = 0; e < 4; ++e) {
                    const float a = fsig(a0v[e] + al[4 * g + e]);
                    const float kq = kv[e] * kkv[e];
                    n2 = fmaf(kq, kq, n2);
                    bd = fmaf(rr[e] * rkv[e], kv[e] * (1.f + (a - 1.f) * kav[e]), bd);
                }
            }
        }
        n2 += __shfl_xor(n2, 32, 64); bd += __shfl_xor(bd, 32, 64);
        const float rnorm = 1.f / fmaxf(sqrtf(n2), 1e-12f);
        const size_t u = (size_t)cg * 4 + h;
#pragma unroll 1
        for (int cb = 0; cb < 2; ++cb) {
            f32x16 al, wl, gl, vm; rw_zero(al); rw_zero(wl); rw_zero(gl); rw_zero(vm);
            const int chrow = h * 64 + 32 * cb + r32;
            const bf16* arow = P.AUP_T + (size_t)chrow * 64 + 8 * hi;
            const bf16* wrow = P.WUP_T + (size_t)chrow * 64 + 8 * hi;
            const bf16* grow = P.GUP_T + (size_t)chrow * 128 + 8 * hi;
#pragma unroll
            for (int s = 0; s < 4; ++s) {
                al = __builtin_amdgcn_mfma_f32_32x32x16_bf16(*(const bf16x8*)(arow + 16 * s), rw_frag(AD, tb, s, r32, hi), al, 0, 0, 0);
                wl = __builtin_amdgcn_mfma_f32_32x32x16_bf16(*(const bf16x8*)(wrow + 16 * s), rw_frag(TW, tb, s, r32, hi), wl, 0, 0, 0);
            }
#pragma unroll
            for (int s = 0; s < 8; ++s) {
                const bf16x8 bfr = *(const LAS bf16x8*)(SG + t * 256 + (((2 * s + hi) ^ (t & 7)) << 4));
                gl = __builtin_amdgcn_mfma_f32_32x32x16_bf16(*(const bf16x8*)(grow + 16 * s), bfr, gl, 0, 0, 0);
            }
            if (P.layer > 0) {
                const bf16* vrow = P.VUP_T + (size_t)chrow * 32 + 8 * hi;
#pragma unroll
                for (int s = 0; s < 2; ++s) {
                    const bf16x8 bfr = *(const LAS bf16x8*)(VD + t * 64 + (2 * s + hi) * 16);
                    vm = __builtin_amdgcn_mfma_f32_32x32x16_bf16(*(const bf16x8*)(vrow + 16 * s), bfr, vm, 0, 0, 0);
                }
            }
            f32x16 lw, cum;
#pragma unroll
            for (int g = 0; g < 4; ++g) {
                const float4 w0 = *(const float4*)(P.w0 + h * 64 + 32 * cb + 8 * g + 4 * hi);
                const float w0v[4] = {w0.x, w0.y, w0.z, w0.w};
#pragma unroll
                for (int e = 0; e < 4; ++e) {
                    const float x = -(w0v[e] + wl[4 * g + e]);
                    const float sp = fmaxf(x, 0.f) + __logf(1.f + __expf(-fabsf(x)));
                    lw[4 * g + e] = -__expf(-sp - 0.5f);
                }
            }
#pragma unroll
            for (int r = 0; r < 16; ++r) {
                float s = lw[r];
#pragma unroll
                for (int dl = 1; dl < 32; dl <<= 1) { const float o = __shfl_up(s, dl, 32); if (r32 >= dl) s += o; }
                cum[r] = s;
            }
            if (tb == 0 && r32 == 31) {
#pragma unroll
                for (int r = 0; r < 16; ++r) CAR[h * 64 + 32 * cb + crow(r, hi)] = cum[r];
            }
            __syncthreads();
            if (tb == 1) {
#pragma unroll
                for (int r = 0; r < 16; ++r) cum[r] += CAR[h * 64 + 32 * cb + crow(r, hi)];
            }
#pragma unroll
            for (int g = 0; g < 4; ++g) {
                const int cl = 32 * cb + 8 * g + 4 * hi, ch = h * 64 + cl;
                const float4 rc = ld4bf(crow_ + ch), kc = ld4bf(crow_ + 256 + ch), vc = ld4bf(crow_ + 512 + ch);
                float4 rp = make_float4(0.f, 0.f, 0.f, 0.f), kp = rp, vp = rp;
                if (hasprev) { rp = ld4bf(crow_ - DINP + ch); kp = ld4bf(crow_ - DINP + 256 + ch); vp = ld4bf(crow_ - DINP + 512 + ch); }
                const float4 mr = *(const float4*)(P.mu + ch), mk = *(const float4*)(P.mu + 256 + ch), mv = *(const float4*)(P.mu + 512 + ch);
                const float4 a0 = *(const float4*)(P.a0 + ch), kk_ = *(const float4*)(P.k_k + ch), ka = *(const float4*)(P.k_a + ch);
                const float rr[4] = {rc.x + mr.x * (rp.x - rc.x), rc.y + mr.y * (rp.y - rc.y), rc.z + mr.z * (rp.z - rc.z), rc.w + mr.w * (rp.w - rc.w)};
                const float kv[4] = {kc.x + mk.x * (kp.x - kc.x), kc.y + mk.y * (kp.y - kc.y), kc.z + mk.z * (kp.z - kc.z), kc.w + mk.w * (kp.w - kc.w)};
                float vv[4] = {vc.x + mv.x * (vp.x - vc.x), vc.y + mv.y * (vp.y - vc.y), vc.z + mv.z * (vp.z - vc.z), vc.w + mv.w * (vp.w - vc.w)};
                const float a0v[4] = {a0.x, a0.y, a0.z, a0.w}, kkv[4] = {kk_.x, kk_.y, kk_.z, kk_.w}, kav[4] = {ka.x, ka.y, ka.z, ka.w};
                if (P.layer == 0) {
                    st4bf(P.VFIRST + tok * 256 + ch, vv[0], vv[1], vv[2], vv[3]);
                } else {
                    const float4 vf = ld4bf(P.VFIRST + tok * 256 + ch), v0 = *(const float4*)(P.v0 + ch);
                    const float vfv[4] = {vf.x, vf.y, vf.z, vf.w}, v0v[4] = {v0.x, v0.y, v0.z, v0.w};
#pragma unroll
                    for (int e = 0; e < 4; ++e) vv[e] = vv[e] + (vfv[e] - vv[e]) * fsig(v0v[e] + vm[4 * g + e]);
                }
                float at[4], bt[4], kt[4], rt[4], bo[4];
#pragma unroll
                for (int e = 0; e < 4; ++e) {
                    const float a = fsig(a0v[e] + al[4 * g + e]);
                    const float kkn = kv[e] * kkv[e] * rnorm;
                    const float k2 = kv[e] * (1.f + (a - 1.f) * kav[e]);
                    const float cu = cum[4 * g + e];
                    const float ein = __expf(cu), eout = __expf(-cu), eex = __expf(cu - lw[4 * g + e]);
                    at[e] = -kkn * eex; bt[e] = kkn * a * eout; kt[e] = k2 * eout; rt[e] = rr[e] * ein; bo[e] = bd * vv[e];
                    if (t == 63) P.LAM[u * 64 + cl + e] = ein;
                }
                const size_t bo_ = (u * 64 + t) * 64 + cl;
                st4bf(P.AT + bo_, at[0], at[1], at[2], at[3]); st4bf(P.BT + bo_, bt[0], bt[1], bt[2], bt[3]);
                st4bf(P.KT + bo_, kt[0], kt[1], kt[2], kt[3]); st4bf(P.RT + bo_, rt[0], rt[1], rt[2], rt[3]);
                st4bf(P.V + tok * 256 + ch, vv[0], vv[1], vv[2], vv[3]);
                st4bf(P.G + tok * 256 + ch, gl[4 * g], gl[4 * g + 1], gl[4 * g + 2], gl[4 * g + 3]);
                st4bf(P.BON + tok * 256 + ch, bo[0], bo[1], bo[2], bo[3]);
            }
        }
    }
}

DEVI void gmlp_unit(const bf16* __restrict__ UB, const bf16* __restrict__ VB, const bf16* __restrict__ GWS  , const float* __restrict__ bs,
                    bf16* __restrict__ MIX, int c128, LAS unsigned char* lds) {
    const int tid = tidx(), w = tid >> 6, lane = tid & 63, r32 = lane & 31, hi = lane >> 5;
    const size_t T0 = (size_t)c128 * 128;
    __syncthreads();
    for (int e = tid; e < 128 * 32; e += 512) {
        const int s = e >> 5, c8 = (e & 31) * 8;
        const v4u v = *(const v4u*)(VB + (T0 + s) * 256 + c8);
        const unsigned wv[4] = {v.x, v.y, v.z, v.w};
#pragma unroll
        for (int j = 0; j < 8; ++j) { const int ch = c8 + j;
            *(LAS unsigned short*)(lds + ch * 256 + (((s >> 3) ^ (ch & 7)) << 4) + (s & 7) * 2) = (unsigned short)(wv[j >> 1] >> ((j & 1) * 16)); }
    }
    __syncthreads();
    const int h = w & 3, th = w >> 2;
    f32x16 acc[2][2];
#pragma unroll
    for (int i = 0; i < 2; ++i)
#pragma unroll
        for (int j = 0; j < 2; ++j) rw_zero(acc[i][j]);
    const int nks = 4 * (th + 1);
#pragma unroll 1
    for (int s = 0; s < nks; ++s) {
        bf16x8 bfr[2];
#pragma unroll
        for (int cb = 0; cb < 2; ++cb) { const int ch = h * 64 + 32 * cb + r32; bfr[cb] = *(const LAS bf16x8*)(lds + ch * 256 + (((2 * s + hi) ^ (ch & 7)) << 4)); }
#pragma unroll
        for (int rb = 0; rb < 2; ++rb) {
            const bf16x8 afr = *(const bf16x8*)(GWS + ((size_t)h * 128 + 64 * th + 32 * rb + r32) * 128 + 16 * s + 8 * hi);
#pragma unroll
            for (int cb = 0; cb < 2; ++cb) acc[rb][cb] = __builtin_amdgcn_mfma_f32_32x32x16_bf16(afr, bfr[cb], acc[rb][cb], 0, 0, 0);
        }
    }
#pragma unroll
    for (int rb = 0; rb < 2; ++rb)
#pragma unroll
        for (int cb = 0; cb < 2; ++cb)
#pragma unroll
            for (int r = 0; r < 16; ++r) {
                const int tt = 64 * th + 32 * rb + crow(r, hi), ch = h * 64 + 32 * cb + r32;
                const float uu = bf2f(UB[(T0 + tt) * 256 + ch]);
                MIX[(T0 + tt) * DM + 512 + ch] = (bf16)f2bf(uu * (acc[rb][cb][r] + bs[h * 128 + tt]));
            }
}
DEVI void ln_finish(float (&v)[16], const float* __restrict__ g, const float* __restrict__ bt, float* orow, bf16* obrow, int lane) {
    float s = 0.f;
#pragma unroll
    for (int i = 0; i < 16; ++i) s += v[i];
    const float mean = wsum_all(s) * (1.f / DM);
    float q = 0.f;
#pragma unroll
    for (int i = 0; i < 16; ++i) { v[i] -= mean; q += v[i] * v[i]; }
    const float rstd = rsqrtf(wsum_all(q) * (1.f / DM) + 1e-5f);
#pragma unroll
    for (int j = 0; j < 4; ++j) {
        const int c = lane * 4 + 256 * j;
        const float4 gg = *(const float4*)(g + c), bb = *(const float4*)(bt + c);
        v[4 * j] = v[4 * j] * rstd * gg.x + bb.x; v[4 * j + 1] = v[4 * j + 1] * rstd * gg.y + bb.y;
        v[4 * j + 2] = v[4 * j + 2] * rstd * gg.z + bb.z; v[4 * j + 3] = v[4 * j + 3] * rstd * gg.w + bb.w;
        if (orow) *(float4*)(orow + c) = make_float4(v[4 * j], v[4 * j + 1], v[4 * j + 2], v[4 * j + 3]);
        *(uint2*)(obrow + c) = make_uint2(cvtpk(v[4 * j], v[4 * j + 1]), cvtpk(v[4 * j + 2], v[4 * j + 3]));
    }
}
DEVI void ln_rows_in(const float* __restrict__ xin, const float* __restrict__ g, const float* __restrict__ bt, bf16* outb, int B0, int G) {
    const int gw = B0 * NWAVES + (tidx() >> 6); int lane = tidx() & 63;
    for (int row = gw; row < NTOK; row += G * NWAVES) {
        asm volatile("" : "+v"(lane));
        float v[16];
#pragma unroll
        for (int j = 0; j < 4; ++j) { const float4 x = *(const float4*)(xin + (size_t)row * DM + lane * 4 + 256 * j); v[4 * j] = x.x; v[4 * j + 1] = x.y; v[4 * j + 2] = x.z; v[4 * j + 3] = x.w; }
        ln_finish(v, g, bt, (float*)nullptr, outb + (size_t)row * DM, lane);
    }
}
DEVI void ln_rows(bf16* xb, float alpha, const bf16* add, const float* __restrict__ g, const float* __restrict__ bt, int B0, int G) {
    const int gw = B0 * NWAVES + (tidx() >> 6); int lane = tidx() & 63;
    for (int row = gw; row < NTOK; row += G * NWAVES) {
        asm volatile("" : "+v"(lane));
        float v[16];
#pragma unroll
        for (int j = 0; j < 4; ++j) {
            const size_t idx = (size_t)row * DM + lane * 4 + 256 * j;
            const float4 x = ld4bf(xb + idx), a = ld4bf(add + idx);
            v[4 * j] = alpha * x.x + a.x; v[4 * j + 1] = alpha * x.y + a.y; v[4 * j + 2] = alpha * x.z + a.z; v[4 * j + 3] = alpha * x.w + a.w;
        }
        ln_finish(v, g, bt, (float*)nullptr, xb + (size_t)row * DM, lane);
    }
}
DEVI void ln_router_rows(bf16* xb, const bf16* add, const float* __restrict__ g, const float* __restrict__ bt,
                         const float* __restrict__ rw, const float* __restrict__ rb, int* __restrict__ te, float* __restrict__ tw, int* __restrict__ trel,
                         int* __restrict__ cnt, int B0, int G) {
    const int gw = B0 * NWAVES + (tidx() >> 6); int lane = tidx() & 63;
    int mycnt = 0;
    int my_row = -1, my_e0 = 0, my_e1 = 0, my_r0 = 0, my_r1 = 0; int kk_ = 0;
    for (int row = gw; row < NTOK; row += G * NWAVES, ++kk_) {
        asm volatile("" : "+v"(lane));
        float v[16];
#pragma unroll
        for (int j = 0; j < 4; ++j) {
            const size_t idx = (size_t)row * DM + lane * 4 + 256 * j;
            const float4 x = ld4bf(xb + idx), a = ld4bf(add + idx);
            v[4 * j] = ALPHA * x.x + a.x; v[4 * j + 1] = ALPHA * x.y + a.y; v[4 * j + 2] = ALPHA * x.z + a.z; v[4 * j + 3] = ALPHA * x.w + a.w;
        }
        ln_finish(v, g, bt, (float*)nullptr, xb + (size_t)row * DM, lane);
        float lg[16];
#pragma unroll
        for (int e = 0; e < 16; ++e) lg[e] = 0.f;
#pragma unroll
        for (int j = 0; j < 4; ++j)
#pragma unroll
            for (int k = 0; k < 4; ++k) {
                const float xv = v[4 * j + k];
                const float4* wr = (const float4*)(rw + (size_t)(lane * 4 + 256 * j + k) * 16);
                const float4 w0 = wr[0], w1 = wr[1], w2 = wr[2], w3 = wr[3];
                lg[0] = fmaf(xv, w0.x, lg[0]); lg[1] = fmaf(xv, w0.y, lg[1]); lg[2] = fmaf(xv, w0.z, lg[2]); lg[3] = fmaf(xv, w0.w, lg[3]);
                lg[4] = fmaf(xv, w1.x, lg[4]); lg[5] = fmaf(xv, w1.y, lg[5]); lg[6] = fmaf(xv, w1.z, lg[6]); lg[7] = fmaf(xv, w1.w, lg[7]);
                lg[8] = fmaf(xv, w2.x, lg[8]); lg[9] = fmaf(xv, w2.y, lg[9]); lg[10] = fmaf(xv, w2.z, lg[10]); lg[11] = fmaf(xv, w2.w, lg[11]);
                lg[12] = fmaf(xv, w3.x, lg[12]); lg[13] = fmaf(xv, w3.y, lg[13]); lg[14] = fmaf(xv, w3.z, lg[14]); lg[15] = fmaf(xv, w3.w, lg[15]);
            }
#pragma unroll
        for (int e = 0; e < 16; ++e) lg[e] = wsum_all(lg[e]);
        float m = lg[0];
#pragma unroll
        for (int e = 1; e < 16; ++e) m = fmaxf(m, lg[e]);
        float pr[16], sum = 0.f;
#pragma unroll
        for (int e = 0; e < 16; ++e) { pr[e] = expf(lg[e] - m); sum += pr[e]; }
        float sl[16];
#pragma unroll
        for (int e = 0; e < 16; ++e) { pr[e] /= sum; sl[e] = pr[e] + rb[e]; }
        int bg = 0; float bgs = -INFINITY;
#pragma unroll
        for (int gI = 0; gI < 4; ++gI) {
            float m1 = -INFINITY, m2 = -INFINITY;
#pragma unroll
            for (int j = 0; j < 4; ++j) { const float x = sl[gI * 4 + j]; if (x > m1) { m2 = m1; m1 = x; } else if (x > m2) m2 = x; }
            const float sc = m1 + m2;
            if (sc > bgs) { bgs = sc; bg = gI; }
        }
        int e0 = -1, e1 = -1; float s0 = -INFINITY, s1 = -INFINITY, p0 = 0.f, p1 = 0.f;
#pragma unroll
        for (int e = 0; e < 16; ++e) {
            if ((e >> 2) == bg) {
                const float x = sl[e];
                if (x > s0) { s1 = s0; e1 = e0; p1 = p0; s0 = x; e0 = e; p0 = pr[e]; } else if (x > s1) { s1 = x; e1 = e; p1 = pr[e]; }
            }
        }
        if (lane == 0) {
            const float ws = p0 + p1;
            te[row * 2] = e0; te[row * 2 + 1] = e1; tw[row * 2] = p0 / ws; tw[row * 2 + 1] = p1 / ws;
        }
        const int r0 = __shfl(mycnt, e0, 64), r1 = __shfl(mycnt, e1, 64);
        if (lane == e0 || lane == e1) ++mycnt;
        if (lane == kk_) { my_row = row; my_e0 = e0; my_e1 = e1; my_r0 = r0; my_r1 = r1; }
    }
    int base = 0;
    if (lane < 16 && mycnt > 0) base = atomicAdd(&cnt[lane], mycnt);
    const int b0 = __shfl(base, my_e0, 64), b1 = __shfl(base, my_e1, 64);
    if (my_row >= 0) { trel[my_row * 2] = b0 + my_r0; trel[my_row * 2 + 1] = b1 + my_r1; }
}
DEVI void moe_gather2(const bf16* __restrict__ xn, const int* __restrict__ te, const int* __restrict__ trel, const int* __restrict__ cnt, int* __restrict__ slot,
                      int* __restrict__ nrt, int* __restrict__ tile_e, bf16* __restrict__ xg, int B0, int G, LAS int* ofs) {
    __syncthreads();
    if (tidx() == 0) {
        int s = 0;
#pragma unroll 1
        for (int e = 0; e < 16; ++e) { const int c = cnt[e]; ofs[e] = s; ofs[17 + e] = c; s += (c + 255) & ~255; }
        ofs[16] = s;
    }
    __syncthreads();
    const int gw = B0 * NWAVES + (tidx() >> 6), lane = tidx() & 63;
    if (B0 == 0 && tidx() < 16) {
        const int e = tidx();
        for (int r = ofs[e] >> 8; r < (ofs[e + 1] >> 8); ++r) tile_e[r] = e;
        if (e == 0) *nrt = ofs[16] >> 8;
    }
    if (B0 < 16) {
        const int o1 = ofs[B0 + 1];
        for (int r = ofs[B0] + ofs[17 + B0] + (tidx() >> 6); r < o1; r += NWAVES) { v4u* d = (v4u*)(xg + (size_t)r * DM); d[lane] = (v4u){0u, 0u, 0u, 0u}; d[lane + 64] = (v4u){0u, 0u, 0u, 0u}; }
    }
    for (int tok = gw; tok < NTOK; tok += G * NWAVES) {
        const v4u* s = (const v4u*)(xn + (size_t)tok * DM);
        const v4u a = s[lane], b = s[lane + 64];
#pragma unroll
        for (int q = 0; q < 2; ++q) {
            const int pr = ofs[te[tok * 2 + q]] + trel[tok * 2 + q];
            v4u* d = (v4u*)(xg + (size_t)pr * DM); d[lane] = a; d[lane + 64] = b;
            if (lane == 0) slot[tok * 2 + q] = pr;
        }
    }
}
DEVI void moe_combine_rows(bf16* xb, const bf16* __restrict__ Dp, const int* __restrict__ te, const float* __restrict__ tw, const int* __restrict__ slot,
                           const float* __restrict__ g, const float* __restrict__ bt, float* out  , int B0, int G) {
    const int gw = B0 * NWAVES + (tidx() >> 6); int lane = tidx() & 63;
    for (int row = gw; row < NTOK; row += G * NWAVES) {
        asm volatile("" : "+v"(lane));
        int ea = te[row * 2], eb = te[row * 2 + 1];
        float wa = tw[row * 2], wb = tw[row * 2 + 1];
        size_t pa = slot[row * 2], pb = slot[row * 2 + 1];
        if (eb < ea) { const float tf = wa; wa = wb; wb = tf; const size_t tp = pa; pa = pb; pb = tp; }
        float v[16];
#pragma unroll
        for (int j = 0; j < 4; ++j) {
            const int c = lane * 4 + 256 * j;
            const float4 xx = ld4bf(xb + (size_t)row * DM + c);
            const float4 da = ld4bf(Dp + pa * DM + c), db = ld4bf(Dp + pb * DM + c);
            v[4 * j] = ALPHA * xx.x + (wa * da.x + wb * db.x); v[4 * j + 1] = ALPHA * xx.y + (wa * da.y + wb * db.y);
            v[4 * j + 2] = ALPHA * xx.z + (wa * da.z + wb * db.z); v[4 * j + 3] = ALPHA * xx.w + (wa * da.w + wb * db.w);
        }
        ln_finish(v, g, bt, out ? out + (size_t)row * DM : (float*)nullptr, xb + (size_t)row * DM, lane);
    }
}
struct MP {
    const float* in[50];
    float *X, *TW, *R0;
    bf16 *XN, *MIX, *WIN_T, *WOUT_T, *WQK_T, *VWO_T, *W1_T, *W2_T, *LORA_T, *GWS, *VFIRST;
    int *TE, *SLOT, *LIST, *EOFF;
    unsigned* BAR;
    unsigned short nsa_items[248 * 3];
};

DEVI void tr_item(const float* W, int K, int N, int Npad, bf16* WT, LAS float* scr, int item, int lane) {
    const int nblk = Npad / 32, kb = item / nblk, nb = item % nblk, k0 = 64 * kb, n0 = 32 * nb;
    const int n_ = n0 + (lane & 31);
#pragma unroll 8
    for (int i = 0; i < 32; ++i) { const int kk = 2 * i + (lane >> 5); scr[kk * 33 + (lane & 31)] = n_ < N ? W[(size_t)(k0 + kk) * N + n_] : 0.f; }
    LDS_WAIT(); asm volatile("" ::: "memory");
    const int c = lane & 7;
#pragma unroll
    for (int j = 0; j < 4; ++j) { const int n = (lane >> 3) + 8 * j; const LAS float* s = scr + (8 * c) * 33 + n;
        v4u o; o.x = pk2(s[0 * 33], s[1 * 33]); o.y = pk2(s[2 * 33], s[3 * 33]); o.z = pk2(s[4 * 33], s[5 * 33]); o.w = pk2(s[6 * 33], s[7 * 33]);
        *(GAS v4u*)(WT + (size_t)(n0 + n) * K + k0 + 8 * c) = o; }
    LDS_WAIT(); asm volatile("" ::: "memory");
}

DEVI void gemm_all(const GemmArgs& g, int maxM, int Z, int B0, int G, unsigned char* lds) {
    const int total = gemm_tiles(g, maxM, Z);
    for (int t0 = B0 * 2; t0 < total; t0 += G * 2) {
        const int vb = tidx() >> 8; float* sm = (float*)(lds + vb * 32768);
        const bool l0 = gemm_tile_live(g, maxM, t0), l1 = (t0 + 1 < total) && gemm_tile_live(g, maxM, t0 + 1);
        if (!l0 && !l1) continue;
        const int t = (vb && t0 + 1 < total) ? t0 + 1 : t0;
        gemm_tile(g, maxM, t, vb ? l1 : l0, sm);
    }
}

typedef const __attribute__((address_space(4))) MP* kargp_t;
DEVI kargp_t kargs() { kargp_t q = (kargp_t)__builtin_amdgcn_kernarg_segment_ptr(); asm volatile("" : "+s"(q)); return q; }
__global__ void __launch_bounds__(512, 2) mega(MP p_arg) {
#define p (*kargs())
    extern __shared__ __attribute__((aligned(16))) unsigned char lds[];
    cg::grid_group grid = cg::this_grid();
    const int G = gridDim.x, B0 = blockIdx.x;
    {
        LAS unsigned* ctl = (LAS unsigned*)((LAS unsigned char*)lds + LDSCTL_OFF);
        for (int u = threadIdx.x; u < (LDS_BYTES - LDSCTL_OFF) / 4; u += NWAVES * 64) ctl[u] = 0u;
        __syncthreads();
        if ((threadIdx.x & 63) == 0) ctl[__builtin_amdgcn_s_getreg((5 << 11) | 4) & 63u] = threadIdx.x >> 6;
    }
    __syncthreads();
    volatile LAS unsigned* MISC = (volatile LAS unsigned*)((LAS unsigned char*)lds + MISC_OFF);
    XcdBarrier bar = xcd_barrier_post(p.BAR, MISC + 8);
    grid.sync();
#define GSYNC() do { REP(24) xcd_barrier(bar); } while (0)
    float* sm0 = (float*)lds;
    LAS unsigned char* ring = (LAS unsigned char*)lds + RING_OFF;
#define VLOOP(n, body) for (int t0_ = B0 * 2; t0_ < (n); t0_ += G * 2) { const int vb = tidx() >> 8; float* sm = (float*)(lds + vb * 32768); const int t = min(t0_ + vb, (n) - 1); body; }

#define x_in (p.in[0])
#define mem (p.in[1])
#define RB ((unsigned char*)p.R0)
#define SZ_TB ((size_t)NTOK * 256 * 2)
#define rAT ((bf16*)RB)
#define rBT ((bf16*)(RB + 1 * SZ_TB))
#define rKT ((bf16*)(RB + 2 * SZ_TB))
#define rRT ((bf16*)(RB + 3 * SZ_TB))
#define rV ((bf16*)(RB + 4 * SZ_TB))
#define rG ((bf16*)(RB + 5 * SZ_TB))
#define rBON ((bf16*)(RB + 6 * SZ_TB))
#define QNb ((bf16*)(RB + 7 * SZ_TB))
#define QRb ((bf16*)(RB + 8 * SZ_TB))
#define UBb ((bf16*)(RB + 9 * SZ_TB))
#define VBb ((bf16*)(RB + 10 * SZ_TB))
#define KSRb ((bf16*)(RB + 11 * SZ_TB))
#define KWRb (KSRb + (size_t)NTOK * 64)
#define VSTb (KWRb + (size_t)NTOK * 64)
#define VWTb (VSTb + (size_t)NTOK * 64)
#define BLKb (VWTb + (size_t)NTOK * 64)
#define BLVb (BLKb + (size_t)1024 * 2048)
#define rLAM ((float*)(BLVb + (size_t)1024 * 2048))
#define GATESb (rLAM + 1024 * 64)
#define COLSB ((bf16*)(RB + 110100480))
#define rPF ((v4u*)COLSB)
#define rHF (rPF + (size_t)1024 * 512)
#define rSF (rHF + (size_t)1024 * 512)
#define rQT ((float*)(rSF + (size_t)1024 * 512))
#define rOL (rQT + (size_t)1024 * 4096)
#define HIDK (rOL + (size_t)1024 * 4096)
#define HIDV (HIDK + (size_t)1024 * 256)
#define KCMPb ((bf16*)(HIDV + (size_t)1024 * 256))
#define VCMPTb (KCMPb + (size_t)NB * 512 * 64)
#define YBUF ((bf16*)p.R0)
#define PB ((bf16*)(p.R0 + (size_t)17 * 1000 * 1000))
#define XG ((bf16*)p.R0)
#define HB ((bf16*)(p.R0 + (size_t)19 * 1000 * 1000))
#define WGU_T ((bf16*)(p.R0 + (size_t)43 * 1000 * 1000))
#define WD_T ((bf16*)(p.R0 + (size_t)51500000))

    bf16* WQB = (bf16*)p.R0;
    bf16* WKT = WQB + (size_t)2 * DM * DM;
    bf16* WVT = WKT + (size_t)2 * DM * DM;
    bf16* WOT = WVT + (size_t)2 * DM * DM;
    bf16* MEMB = WOT + (size_t)2 * DM * DM;
    bf16* KMEMB = MEMB + (size_t)NB * MEML * DM;
    bf16* VMEMB = KMEMB + (size_t)2 * NB * MEML * DM;
    {
        LAS float* scr = (LAS float*)(ring + (tidx() >> 6) * 16384);
        const int gw = B0 * NWAVES + (tidx() >> 6), NGW = G * NWAVES, lane = tidx() & 63;
        constexpr int I_IN = (DM / 64) * (DINP / 32), I_SQ = (DM / 64) * (DM / 32), I_W1 = (2048 / 64) * (256 / 32);
        for (int it = gw; it < 2 * I_IN + 8 * I_SQ + 4 * I_W1; it += NGW) {
            int r = it;
            if (r < 2 * I_IN) {
                const int l = r / I_IN, item = r % I_IN; const int nblk = DINP / 32, kb = item / nblk, nb = item % nblk, k0 = 64 * kb, n0 = 32 * nb;
                const float* W = p.in[4] + (size_t)l * DM * DIN; const float* VD = p.in[21];
                const int n_ = n0 + (lane & 31);
#pragma unroll 8
                for (int i = 0; i < 32; ++i) { const int kk = 2 * i + (lane >> 5);
                    float v = 0.f;
                    if (n_ < DIN) v = W[(size_t)(k0 + kk) * DIN + n_]; else if (l == 1 && n_ < DIN + 32) v = VD[(size_t)(k0 + kk) * 32 + (n_ - DIN)];
                    scr[kk * 33 + (lane & 31)] = v; }
                LDS_WAIT(); asm volatile("" ::: "memory");
                const int c = lane & 7; bf16* WT = p.WIN_T + (size_t)l * DINP * DM;
#pragma unroll
                for (int j = 0; j < 4; ++j) { const int n = (lane >> 3) + 8 * j; const LAS float* s = scr + (8 * c) * 33 + n;
                    v4u o; o.x = pk2(s[0 * 33], s[1 * 33]); o.y = pk2(s[2 * 33], s[3 * 33]); o.z = pk2(s[4 * 33], s[5 * 33]); o.w = pk2(s[6 * 33], s[7 * 33]);
                    *(GAS v4u*)(WT + (size_t)(n0 + n) * DM + k0 + 8 * c) = o; }
                LDS_WAIT(); asm volatile("" ::: "memory");
                continue;
            }
            r -= 2 * I_IN;
            if (r < 8 * I_SQ) {
                const int which = r / (2 * I_SQ), l = (r / I_SQ) & 1, item = r % I_SQ, kb = item / 32, nb = item % 32;
                const float* W = (which == 0 ? p.in[5] : which == 1 ? p.in[38] : which == 2 ? p.in[39] : p.in[40]) + (size_t)l * DM * DM;
                bf16* WT = (which == 0 ? p.WOUT_T : which == 1 ? WKT : which == 2 ? WVT : WOT) + (size_t)l * DM * DM;
                tr_blk(W, DM, DM, kb * 64, nb * 32, WT, DM, nb * 32, 1.f, scr, lane);
                continue;
            }
            r -= 8 * I_SQ;
            {
                const int which = r / I_W1, item = r % I_W1, kb = item / 8, nb = item % 8, l = which >> 1;
                const float* W = ((which & 1) ? p.in[33] : p.in[30]) + (size_t)l * 2048 * 256;
                tr_blk(W, 256, 256, kb * 64, nb * 32, p.W1_T + (size_t)which * 256 * 2048, 2048, nb * 32, 1.f, scr, lane);
            }
        }
        for (int it = gw; it < 64; it += NGW) {
            if (it < 32) { const int which = it >> 3, nb = it & 7, l = which & 1;
                tr_blk(((which >> 1) ? p.in[14] : p.in[12]) + (size_t)l * 64 * 256, 256, 256, 0, nb * 32, p.LORA_T + (size_t)which * 256 * 64, 64, nb * 32, 1.f, scr, lane); }
            else { const int r2 = it - 32, l = r2 >> 4, kb = (r2 >> 3) & 1, nb = r2 & 7;
                tr_blk(p.in[15] + (size_t)l * 128 * 256, 256, 256, kb * 64, nb * 32, p.LORA_T + (size_t)4 * 256 * 64 + (size_t)l * 256 * 128, 128, nb * 32, 1.f, scr, lane); }
        }
        for (int e = B0 * 512 + tidx(); e < 256 * 32; e += G * 512) { const int n = e >> 5, k = e & 31;
            p.LORA_T[(size_t)4 * 256 * 64 + (size_t)2 * 256 * 128 + e] = (bf16)f2bf(p.in[24][k * 256 + n]); }
        for (int e = B0 * 512 + tidx(); e < 4 * 64 * 256; e += G * 512) { const int which = e >> 14, n = (e >> 8) & 63, k = e & 255;
            p.W2_T[e] = (bf16)f2bf(((which & 1) ? p.in[34] : p.in[31])[(size_t)(which >> 1) * 256 * 64 + k * 64 + n]); }
        for (int e = B0 * 512 + tidx(); e < 2 * 4 * 128 * 128; e += G * 512) { const int t = (e >> 7) & 127, s = e & 127;
            p.GWS[e] = s <= t ? (bf16)f2bf(p.in[27][e]) : (bf16)0; }
        cvt_bf16(p.in[37], WQB, (size_t)2 * DM * DM, 1.f, B0, G);
        cvt_bf16(mem, MEMB, (size_t)NB * MEML * DM, 1.f, B0, G);
    }
    __syncthreads();
    ln_rows_in(x_in, p.in[2], p.in[3], p.XN, B0, G);
    GSYNC();
    {
        const int gi = B0 >> 3, un = B0 & 7;
        pg8::Gemm g{MEMB, ((gi & 1) ? WVT : WKT) + (size_t)(gi >> 1) * DM * DM, NB * MEML, DM, DM};
        pg8::OneUnit S{un >> 2, un & 3, B0 < 32 ? 1 : 0};
        pg8::EpiBf16<0> E{((gi & 1) ? VMEMB : KMEMB) + (size_t)(gi >> 1) * NB * MEML * DM, DM, nullptr, 0, 0, 1.f};
        pg8::gemm_phase<pg8::EpiBf16<0>, pg8::OneUnit, false, true>(ring, g, S, E);
    }
    GSYNC();
    {
        const int l = (B0 >> 6) & 1, kind = (B0 >> 5) & 1, bh = (B0 >> 2) & 7, q4 = B0 & 3, b = bh >> 2, h = bh & 3;
        if (kind == 0) {
            pg8::Gemm g{KMEMB + (size_t)l * NB * MEML * DM + (size_t)b * MEML * DM + h * 256, WQB + (size_t)l * DM * DM + h * 256, 256, DM, 256, DM, DM};
            pg8::OneUnit S{0, q4, B0 < 128 ? 1 : 0};
            pg8::EpiBf16S E{p.WQK_T + (size_t)l * NB * DM * DM + (size_t)b * DM * DM + (size_t)h * 256 * DM, DM, 0.0625f * 1.4426950408889634f};
            pg8::gemm_phase<pg8::EpiBf16S, pg8::OneUnit, false, true>(ring, g, S, E);
        } else {
            pg8::Gemm g{WOT + (size_t)l * DM * DM + h * 256, VMEMB + (size_t)l * NB * MEML * DM + (size_t)b * MEML * DM + h * 256, DM, 256, 256, DM, DM};
            pg8::OneUnit S{q4, 0, B0 < 128 ? 1 : 0};
            pg8::EpiBf16S E{p.VWO_T + (size_t)l * NB * DM * DM + (size_t)b * DM * DM + h * 256, DM, 1.f};
            pg8::gemm_phase<pg8::EpiBf16S, pg8::OneUnit, false, true>(ring, g, S, E);
        }
    }
    GSYNC();
    for (int l = 0; l < 2; ++l) {
REP(1) {
        {
            pg8::Gemm g{p.XN, p.WIN_T + (size_t)l * DINP * DM, NTOK, DINP, DM};
            pg8::StaticOrder S; S.init(NTOK, DINP, G, B0);
            pg8::EpiBf16<0> E{COLSB, DINP, nullptr, 0, 0, 1.f};
            pg8::gemm_phase<pg8::EpiBf16<0>, pg8::StaticOrder, true, true>(ring, g, S, E);
        }
}
        GSYNC();
#define MK_RW() RwP rw; rw.R = nullptr; rw.K = nullptr; rw.V = rV; rw.A = nullptr; rw.B = nullptr; rw.LW = nullptr; rw.G = rG; rw.BON = rBON; \
        rw.AT = rAT; rw.BT = rBT; rw.KT = rKT; rw.RT = rRT; rw.LAM = rLAM; rw.PF = rPF; rw.HF = rHF; rw.QT = rQT; rw.OL = rOL; rw.SF = rSF; \
        rw.gn_g = p.in[19] + l * 256; rw.gn_b = p.in[20] + l * 256; rw.MIX = p.MIX;
        {
            MixP mp;
            mp.COLS = COLSB;
            mp.conv_w = p.in[6] + (size_t)l * 31 * 256; mp.conv_b = p.in[7] + l * 256; mp.conv_gg = p.in[8] + l * 256; mp.conv_gb = p.in[9] + l * 256;
            mp.gl_g = p.in[25] + l * 256; mp.gl_b = p.in[26] + l * 256;
            mp.mu = p.in[10] + l * 1024; mp.w0 = p.in[11] + l * 256; mp.a0 = p.in[13] + l * 256; mp.k_k = p.in[16] + l * 256; mp.k_a = p.in[17] + l * 256; mp.r_k = p.in[18] + l * 256;
            mp.v_mu = p.in[22]; mp.v0 = p.in[23];
            mp.WUP_T = p.LORA_T + (size_t)l * 256 * 64; mp.AUP_T = p.LORA_T + (size_t)(2 + l) * 256 * 64; mp.GUP_T = p.LORA_T + (size_t)4 * 256 * 64 + (size_t)l * 256 * 128;
            mp.VUP_T = p.LORA_T + (size_t)4 * 256 * 64 + (size_t)2 * 256 * 128;
            mp.pe_k = p.in[29] + (size_t)l * 2048; mp.pe_v = p.in[32] + (size_t)l * 2048;
            mp.MIX = p.MIX; mp.UB = UBb; mp.VB = VBb;
            mp.AT = rAT; mp.BT = rBT; mp.KT = rKT; mp.RT = rRT; mp.V = rV; mp.G = rG; mp.BON = rBON; mp.VFIRST = p.VFIRST; mp.LAM = rLAM;
            mp.QN = QNb; mp.QR = QRb; mp.KSR = KSRb; mp.KWR = KWRb; mp.VST = VSTb; mp.VWT = VWTb; mp.GATES = GATESb; mp.BLK = BLKb; mp.BLV = BLVb;
            mp.layer = l; mp.pad = 0;
            if (B0 == 0 && tidx() == 0) p.EOFF[600] = 0;
REP(2) {
            for (int cg = B0; cg < NTOK / 64; cg += G) prep_unit(mp, cg, ring);
}
        }
        GSYNC();
        {
REP(4) {
            {
                const int isv = (B0 >> 2) & 1;
                pg8::Gemm g{isv ? BLVb : BLKb, p.W1_T + (size_t)(l * 2 + isv) * 256 * 2048, 1024, 256, 2048};
                pg8::OneUnit S{B0 & 3, 0, B0 < 8 ? 1 : 0};
                pg8::EpiGeluW2 E{p.W2_T + (size_t)(l * 2 + isv) * 64 * 256, isv ? VCMPTb : KCMPb, isv};
                pg8::gemm_phase<pg8::EpiGeluW2, pg8::OneUnit, false, true>(ring, g, S, E);
            }
}
REP(6) {
            MK_RW()
            for (int u0 = 2 * (G - 1 - B0); u0 < 1024; u0 += 2 * G) rw_r2(rw, u0, ring);
}
REP(5) {
            for (int c = G - 1 - B0; c < NTOK / 128; c += G) gmlp_unit(UBb, VBb, p.GWS + (size_t)l * 4 * 128 * 128, p.in[28] + l * 4 * 128, p.MIX, c, ring);
}
        }
        GSYNC();
        if (B0 >= G - 8) {
REP(8) {
            { MK_RW() const int w_ = tidx() >> 6, bh = G - 1 - B0; if (w_ < 2) rw_r3(rw, bh >> 2, bh & 3, w_, tidx() & 63, ring + w_ * 65536); }
}
        } else {
REP(9) {
            for (int round = 0; round < 3; ++round) {
                const unsigned it = B0 < 248 ? p.nsa_items[B0 * 3 + round] : 0xffffu;
                if (it == 0xffffu) break;
                const int b = it & 1, tile = (it >> 1) & 127, kind = it >> 8;
                NsaP np; np.QN = QNb + (size_t)b * SEQ * 256; np.QR = QRb + (size_t)b * SEQ * 256; np.KSR = KSRb + (size_t)b * SEQ * 64; np.KWR = KWRb + (size_t)b * SEQ * 64;
                np.VST = VSTb + (size_t)b * 64 * SEQ; np.VWT = VWTb + (size_t)b * 64 * SEQ; np.KCMP = KCMPb + (size_t)b * 512 * 64; np.VCMPT = VCMPTb + (size_t)b * 64 * 512;
                np.GATES = GATESb + (size_t)b * SEQ * 12; np.MIX = p.MIX + (size_t)b * SEQ * DM;
                nsa_unit(np, tile, ring, kind, (unsigned*)UBb + (size_t)(b * 64 + (tile & 63)) * (3 * 8 * 18 * 64));
            }
}
            {
                __syncthreads();
                LAS float* scr = (LAS float*)(ring + (tidx() >> 6) * 16384);
                LAS int* grab = (LAS int*)(ring + 131072 - 64);
                const int wv_ = tidx() >> 6, lane = tidx() & 63;
                const float* wg = p.in[45] + (size_t)l * 16 * DM * 512;
                const float* wu = p.in[46] + (size_t)l * 16 * DM * 512;
                const float* wd = p.in[47] + (size_t)l * 16 * 512 * DM;
                constexpr int I_GU = (DM / 64) * (512 / 32), I_D = (512 / 64) * (DM / 32), I_ALL = 16 * (2 * I_GU + I_D);
                for (;;) {
                    if (tidx() == 0) *grab = atomicAdd(p.EOFF + 600, 64);
                    __syncthreads();
                    const int base = *grab;
                    __syncthreads();
                    if (base >= I_ALL) break;
#pragma unroll 1
                    for (int it = base + wv_; it < base + 64 && it < I_ALL; it += NWAVES) {
                        const int e = it / (2 * I_GU + I_D); int r = it % (2 * I_GU + I_D);
                        if (r < 2 * I_GU) {
                            const int isup = r / I_GU; r %= I_GU;
                            const int kb = r / 16, nb = r % 16, n0 = nb * 32;
                            tr_blk((isup ? wu : wg) + (size_t)e * DM * 512, 512, 512, kb * 64, n0, WGU_T + (size_t)e * 1024 * DM, DM, (n0 >> 7) * 256 + (n0 & 127) + isup * 128, 1.f, scr, lane);
                        } else {
                            r -= 2 * I_GU;
                            const int kb = r / 32, nb = r % 32;
                            tr_blk(wd + (size_t)e * 512 * DM, DM, DM, kb * 64, nb * 32, WD_T + (size_t)e * DM * 512, 512, nb * 32, 1.f, scr, lane);
                        }
                    }
                }
            }
        }
        GSYNC();
REP(10) {
        MK_RW()
        for (int i = B0 * NWAVES + (tidx() >> 6); i < 2048; i += G * NWAVES) rw_r4(rw, i >> 1, i & 1, tidx() & 63);
        for (int i = (G - 1 - B0) * NWAVES + (tidx() >> 6); i < 1024; i += G * NWAVES) {
            const int su = i >> 3, b = su >> 6, tile = 64 + (su & 63);
            NsaP np; np.GATES = GATESb + (size_t)b * SEQ * 12; np.MIX = p.MIX + (size_t)b * SEQ * DM;
            nsa_combine(np, tile, i & 7, tidx() & 63, (const unsigned*)UBb + (size_t)su * (3 * 8 * 18 * 64));
        }
}
        GSYNC();
        {
REP(11) {
            pg8::Gemm g{p.MIX, p.WOUT_T + (size_t)l * DM * DM, NTOK, DM, DM};
            pg8::StaticOrder S; S.init(NTOK, DM, G, B0);
            pg8::EpiBf16<0> E{YBUF, DM, nullptr, 0, 0, 1.f};
            pg8::gemm_phase<pg8::EpiBf16<0>, pg8::StaticOrder, true, true>(ring, g, S, E);
}
        }
        GSYNC();
        ln_rows(p.XN, ALPHA, YBUF, p.in[35] + l * DM, p.in[36] + l * DM, B0, G);
        if (B0 == 0 && tidx() < 16) p.EOFF[512 + tidx()] = 0;
        __syncthreads();
        GSYNC();
        {
            bf16* WQK_T = p.WQK_T + (size_t)l * NB * DM * DM;
REP(14) {
            pg8::Gemm g{p.XN, WQK_T, NTOK, DM, DM};
            pg8::XaOrder S{G, B0};
            pg8::EpiSoftmaxP E{PB};
            pg8::gemm_phase<pg8::EpiSoftmaxP, pg8::XaOrder, false, true>(ring, g, S, E);
}
        }
        GSYNC();
        {
REP(15) {
            pg8::Gemm g{PB, p.VWO_T + (size_t)l * NB * DM * DM, NTOK, DM, DM};
            pg8::XaOrder S{G, B0};
            pg8::EpiBf16N4 E{YBUF, DM};
            pg8::gemm_phase<pg8::EpiBf16N4, pg8::XaOrder, true, true>(ring, g, S, E);
}
        }
        GSYNC();
        ln_router_rows(p.XN, YBUF, p.in[41] + l * DM, p.in[42] + l * DM, p.in[43], p.in[44], p.TE, p.TW, p.LIST, p.EOFF + 512, B0, G);
        GSYNC();
REP(21) {
        moe_gather2(p.XN, p.TE, p.LIST, p.EOFF + 512, p.SLOT, p.EOFF + 32, p.EOFF + 64, XG, B0, G, (LAS int*)ring);
}
        GSYNC();
        {
REP(22) {
            pg8::Gemm g{XG, WGU_T, 0, 0, DM};
            pg8::MoeOrder S{p.EOFF + 64, p.EOFF + 32, G, B0};
            pg8::EpiSiluMul E{HB};
            pg8::gemm_phase<pg8::EpiSiluMul, pg8::MoeOrder, true, true>(ring, g, S, E);
}
        }
        GSYNC();
        {
REP(23) {
            pg8::Gemm g{HB, WD_T, 0, 0, 512};
            pg8::MoeOrder S{p.EOFF + 64, p.EOFF + 32, G, B0};
            pg8::EpiBf16N4 E{XG, DM};
            pg8::gemm_phase<pg8::EpiBf16N4, pg8::MoeOrder, true, true>(ring, g, S, E);
}
        }
        GSYNC();
        moe_combine_rows(p.XN, XG, p.TE, p.TW, p.SLOT, p.in[48] + l * DM, p.in[49] + l * DM, l == 1 ? p.X : (float*)nullptr, B0, G);
        GSYNC();
    }
}

#undef RB
#undef SZ_TB
#undef rAT
#undef rBT
#undef rKT
#undef rRT
#undef rV
#undef rG
#undef rBON
#undef QNb
#undef QRb
#undef UBb
#undef VBb
#undef KSRb
#undef KWRb
#undef VSTb
#undef VWTb
#undef BLKb
#undef BLVb
#undef rLAM
#undef GATESb
#undef COLSB
#undef rPF
#undef rHF
#undef rSF
#undef rQT
#undef rOL
#undef HIDK
#undef HIDV
#undef KCMPb
#undef VCMPTb
#undef YBUF
#undef PB
#undef XG
#undef HB
#undef WGU_T
#undef WD_T
#undef x_in
#undef mem
#undef p
extern "C" void kernel_launch(void* const* d_in, const int* in_sizes, int n_in, void* d_out, int out_size, void* d_ws, size_t ws_size,
                              hipStream_t stream) {
    static int grid_blocks = 0;
    if (!grid_blocks) {
        int dev = 0, cus = 0, per_cu = 0;
        (void)hipGetDevice(&dev);
        (void)hipDeviceGetAttribute(&cus, hipDeviceAttributeMultiprocessorCount, dev);
        (void)hipFuncSetAttribute((const void*)mega, hipFuncAttributeMaxDynamicSharedMemorySize, LDS_BYTES);
        (void)hipOccupancyMaxActiveBlocksPerMultiprocessor(&per_cu, (const void*)mega, NWAVES * 64, LDS_BYTES);
        (void)hipGetLastError();
        if (per_cu < 1) { fprintf(stderr, "occupancy query says %d blocks per CU\n", per_cu); per_cu = 1; }
        grid_blocks = cus;
    }
    MP p; memset(&p, 0, sizeof(p));
    for (int i = 0; i < 50; ++i) p.in[i] = (const float*)d_in[i];
    char* ws = (char*)d_ws;
    size_t o = 0;
    auto take = [&](size_t bytes) { char* q = ws + o; o += (bytes + 255) & ~(size_t)255; return q; };
    p.BAR = (unsigned*)take(16384);
    p.X = (float*)d_out;
    p.VFIRST = (bf16*)take((size_t)NTOK * 256 * 2);
    p.LORA_T = (bf16*)take((size_t)(4 * 256 * 64 + 2 * 256 * 128 + 256 * 32) * 2);
    p.GWS = (bf16*)take((size_t)2 * 4 * 128 * 128 * 2);
    p.MIX = (bf16*)take((size_t)NTOK * DM * 2);
    p.XN = (bf16*)take((size_t)NTOK * DM * 2);
    p.WIN_T = (bf16*)take((size_t)2 * DINP * DM * 2);
    p.WOUT_T = (bf16*)take((size_t)2 * DM * DM * 2);
    p.WQK_T = (bf16*)take((size_t)2 * NB * DM * DM * 2);
    p.VWO_T = (bf16*)take((size_t)2 * NB * DM * DM * 2);
    p.W1_T = (bf16*)take((size_t)4 * 256 * 2048 * 2);
    p.W2_T = (bf16*)take((size_t)4 * 64 * 256 * 2);
    p.TE = (int*)take((size_t)NTOK * 2 * 4);
    p.TW = (float*)take((size_t)NTOK * 2 * 4);
    p.SLOT = (int*)take((size_t)NTOK * 2 * 4);
    p.LIST = (int*)take((size_t)36864 * 4);
    p.EOFF = (int*)take(4096);
    p.R0 = (float*)take((size_t)56500000 * 4);
    if (o > ws_size) { fprintf(stderr, "workspace too small: need %zu have %zu\n", o, ws_size); return; }
    {
        struct It { int cost; unsigned short code; } its[384]; int n = 0;
        for (int b = 0; b < 2; ++b)
            for (int t = 0; t < 128; ++t) {
                if (t < 64) { its[n].cost = 26 + t; its[n].code = (unsigned short)(b | (t << 1)); ++n; }
                else { const int js = (t + 10) >> 1;
                    its[n].cost = 26 + (t - js); its[n].code = (unsigned short)(b | (t << 1) | (1 << 8)); ++n;
                    its[n].cost = 16 + js; its[n].code = (unsigned short)(b | (t << 1) | (2 << 8)); ++n; }
            }
        for (int i = 1; i < n; ++i) { It x = its[i]; int j = i - 1; while (j >= 0 && (its[j].cost < x.cost || (its[j].cost == x.cost && its[j].code > x.code))) { its[j + 1] = its[j]; --j; } its[j + 1] = x; }
        int load[248], cnt[248];
        for (int w = 0; w < 248; ++w) { load[w] = 0; cnt[w] = 0; for (int r = 0; r < 3; ++r) p.nsa_items[w * 3 + r] = 0xffff; }
        for (int i = 0; i < n; ++i) {
            int best = -1;
            for (int w = 0; w < 248; ++w) if (cnt[w] < 3 && (best < 0 || load[w] < load[best])) best = w;
            p.nsa_items[best * 3 + cnt[best]] = its[i].code; ++cnt[best]; load[best] += its[i].cost;
        }
    }
    (void)hipMemsetAsync(p.BAR, 0, 16384, stream);
    void* args[] = {&p};
    hipError_t e = hipLaunchCooperativeKernel((const void*)mega, dim3(grid_blocks), dim3(NWAVES * 64), args, LDS_BYTES, stream);
    if (e != hipSuccess) fprintf(stderr, "cooperative launch failed: %s (grid %d)\n", hipGetErrorString(e), grid_blocks);
}
```

```cpp
#include <hip/hip_runtime.h>
#include <hip/hip_cooperative_groups.h>
#include <stdio.h>
#include <stdint.h>
#include <string.h>
#include <math.h>
namespace cg = cooperative_groups;

#define DEVI __device__ __forceinline__
#define GAS __attribute__((address_space(1)))
#define LAS __attribute__((address_space(3)))
typedef unsigned short bf16;
typedef unsigned v4u __attribute__((ext_vector_type(4)));
typedef GAS unsigned gu32;
typedef GAS unsigned long long gu64;
#define RLX_AGENT __ATOMIC_RELAXED, __HIP_MEMORY_SCOPE_AGENT
#define LDS_WAIT() asm volatile("s_waitcnt lgkmcnt(0)" ::: "memory")
#define VM_WAIT() asm volatile("s_waitcnt vmcnt(0)" ::: "memory")
DEVI unsigned f2bf(float f) { unsigned u = __builtin_bit_cast(unsigned, f); return (u + 0x7fffu + ((u >> 16) & 1u)) >> 16; }
DEVI unsigned pk2(float lo, float hi) { return f2bf(lo) | (f2bf(hi) << 16); }
DEVI float bf2f(unsigned short h) { return __builtin_bit_cast(float, (unsigned)h << 16); }

constexpr int NB = 2, SEQ = 8192, DM = 1024, NTOK = NB * SEQ, DIN = 2700, DINP = 2816, MEML = 256;
constexpr int OFF_CV = 0, OFF_CG = 256, OFF_RW = 512, OFF_GU = 1536, OFF_GV = 1792, OFF_Q = 2048, OFF_KC = 2304,
              OFF_VC = 2368, OFF_KS = 2432, OFF_VS = 2496, OFF_KW = 2560, OFF_VW = 2624, OFF_GT = 2688;
constexpr int NCMP = 511;
constexpr float ALPHA = 1.4142135623730951f;
constexpr int NWAVES = 8;
constexpr int RING_OFF = 0, RING_BYTES = 131072;
constexpr int LDSCTL_OFF = RING_BYTES, MISC_OFF = LDSCTL_OFF + 320;
constexpr int LDS_BYTES = 147456;

constexpr int TIDTBL_OFF = LDSCTL_OFF;
DEVI int tidx() {
    const unsigned slot = __builtin_amdgcn_s_getreg((5 << 11) | 4) & 63u;
    int w = *(volatile LAS int*)(unsigned long)(TIDTBL_OFF + slot * 4u);
    w = __builtin_amdgcn_readfirstlane(w);
    int t;
    asm volatile("v_mbcnt_lo_u32_b32 %0, -1, 0\n\tv_mbcnt_hi_u32_b32 %0, -1, %0" : "=v"(t));
    t |= w << 6;
    asm volatile("" : "+v"(t));
    return t;
}

#ifndef PROBE_MASK
#define PROBE_MASK 0ull
#endif
#define PROBE_N 3
#define REP(id) for (int rep_ = 0; rep_ < (((PROBE_MASK >> (id)) & 1ull) ? 1 + PROBE_N : 1); ++rep_)
namespace pg8 {
#define PG8_LAS __attribute__((address_space(3)))
typedef unsigned short bf16_t;
typedef short bf16x8 __attribute__((ext_vector_type(8)));
typedef float f32x4 __attribute__((ext_vector_type(4)));
typedef unsigned u32x4 __attribute__((ext_vector_type(4)));
constexpr int BM = 256, BK = 64, HALF = 128, HTB = HALF * BK * 2  , STAGE_BYTES = 8 * HTB, NXCD = 8, WGM = 8;

__host__ __device__ __forceinline__ int lds_byte(int r, int c) { const int st = (r >> 4) * 2 + (c >> 5), rr = r & 15, cc = c & 31, ob = rr * 64 + cc * 2; return st * 1024 + (ob ^ (((ob >> 9) & 1) << 5)); }
__host__ __device__ __forceinline__ void stage_rc(int b, int& R, int& C) { const int st = b / 1024, sb = b % 1024, swz = sb ^ (((sb >> 9) & 1) << 5); R = (st >> 1) * 16 + swz / 64; C = (st & 1) * 32 + (swz % 64) / 2; }
__host__ __device__ __forceinline__ int perm32(int rho) { const int n = rho >> 4, i = rho & 15; return 8 * (i >> 2) + 4 * n + (i & 3); }

struct Unit { int pm, pn; };
struct Gemm { const bf16_t* A; const bf16_t* Bt; int M, N, K; int lda = 0, ldb = 0; };

struct StaticOrder {
    int nM, nN, nwg, G, c;
    __host__ __device__ void init(int M, int N, int G_, int c_) { nM = M / BM; nN = N / BM; nwg = nM * nN; G = G_; c = c_; }
    __host__ __device__ bool next(int i, Unit& u) const {
        const long L = (long)i * G + c; if (L >= nwg) return false;
        int wgid = (int)L; { const int q = nwg / NXCD, r = nwg % NXCD, xcd = wgid % NXCD, off = wgid / NXCD; wgid = (xcd < r ? xcd * (q + 1) : r * (q + 1) + (xcd - r) * q) + off; }
        const int nig = WGM * nN, gid = wgid / nig, fm = gid * WGM, gsz = (nM - fm) < WGM ? (nM - fm) : WGM;
        u.pm = fm + ((wgid % nig) % gsz); u.pn = (wgid % nig) / gsz; return true;
    }
    __device__ __forceinline__ void a_ready(const Unit&) const {}
    __device__ __forceinline__ void done(const Unit&) const {}
};

__device__ __forceinline__ unsigned cvt_pk_bf16(float lo, float hi) { unsigned r; asm volatile("v_cvt_pk_bf16_f32 %0, %1, %2" : "=v"(r) : "v"(lo), "v"(hi)); return r; }
typedef float f32x2 __attribute__((ext_vector_type(2)));
__device__ __forceinline__ f32x2 gelu_pk(f32x2 v) {
    const f32x2 av = __builtin_elementwise_abs(v), d = av * 0.2316418882f + 1.0f;
    f32x2 t; t.x = __builtin_amdgcn_rcpf(d.x); t.y = __builtin_amdgcn_rcpf(d.y);
    f32x2 q = t * 0.5307027145f + (-0.7265760135f); q = q * t + 0.7107068705f; q = q * t + (-0.142248368f); q = q * t + 0.127414796f; q = q * t;
    const f32x2 s = (v * v) * (-0.72134752044f);
    f32x2 e; e.x = __builtin_amdgcn_exp2f(s.x); e.y = __builtin_amdgcn_exp2f(s.y);
    const f32x2 m = v * (q * e), r = v - m;
    f32x2 o; o.x = v.x < 0.f ? m.x : r.x; o.y = v.y < 0.f ? m.y : r.y; return o;
}

template <int ACT  > struct EpiBf16 {
    static constexpr bool PERM = true, AFTER_DRAIN = false; static_assert(ACT == 0 || ACT == 1, "EpiBf16: ACT is 0 (none) or 1 (gelu_pk)");
    bf16_t* O; int ldc; const float* bias; int split_cols; size_t split_stride; float scale0;
    __device__ __forceinline__ void operator()(const f32x4 (&acc)[2][2][4][2], const Unit& u, int wr, int wc, int fr, int fq) const {
        const int row0 = u.pm * BM + wr * 64 + fr; int colt = u.pn * BM; bf16_t* base = O;
        float sc = 1.f; if (split_cols) { const int t = colt / split_cols; base += (size_t)t * split_stride; colt -= t * split_cols; if (t == 0) sc = scale0; }
        const int col0 = colt + wc * 32 + 8 * fq, bcol0 = u.pn * BM + wc * 32 + 8 * fq;
        f32x4 bv[2][2];
#pragma unroll
        for (int bj = 0; bj < 2; ++bj)
#pragma unroll
            for (int n = 0; n < 2; ++n) bv[bj][n] = bias ? *(const f32x4*)(bias + bcol0 + bj * HALF + 4 * n) : (f32x4){0.f, 0.f, 0.f, 0.f};
#pragma unroll
        for (int ai = 0; ai < 2; ++ai)
#pragma unroll
            for (int m = 0; m < 4; ++m) { bf16_t* rowp = base + (size_t)(row0 + ai * HALF + m * 16) * ldc + col0;
#pragma unroll
                for (int bj = 0; bj < 2; ++bj) { f32x4 v0 = acc[ai][bj][m][0] + bv[bj][0], v1 = acc[ai][bj][m][1] + bv[bj][1];
                    if (ACT == 1) { f32x2 a = gelu_pk((f32x2){v0[0], v0[1]}), b = gelu_pk((f32x2){v0[2], v0[3]}), c = gelu_pk((f32x2){v1[0], v1[1]}), d = gelu_pk((f32x2){v1[2], v1[3]});
                        v0 = (f32x4){a.x, a.y, b.x, b.y}; v1 = (f32x4){c.x, c.y, d.x, d.y}; }
                    v0 = v0 * sc; v1 = v1 * sc; u32x4 w; w.x = cvt_pk_bf16(v0[0], v0[1]); w.y = cvt_pk_bf16(v0[2], v0[3]); w.z = cvt_pk_bf16(v1[0], v1[1]); w.w = cvt_pk_bf16(v1[2], v1[3]);
                    *(u32x4*)(rowp + bj * HALF) = w; } }
    }
};

struct PanelStats {
    unsigned* xbuf;
    unsigned* cnt;
    unsigned* tmo;
    int ntn; float eps;
    unsigned code;
    __device__ __forceinline__ bool run(const f32x4 (&v)[2][2][4][2], const Unit& u, int wr, int wc, int fr, int fq, PG8_LAS unsigned char* lds, int wid, int lane) const {
        typedef float f32x2v __attribute__((ext_vector_type(2)));
        PG8_LAS f32x2v* P = (PG8_LAS f32x2v*)lds;
        PG8_LAS f32x2v* S = (PG8_LAS f32x2v*)(lds + 8192);
        PG8_LAS unsigned* flag = (PG8_LAS unsigned*)(lds + 8192 + 2048);
#pragma unroll
        for (int ai = 0; ai < 2; ++ai)
#pragma unroll
            for (int m = 0; m < 4; ++m) {
                float s = 0.f;
#pragma unroll
                for (int bj = 0; bj < 2; ++bj)
#pragma unroll
                    for (int n = 0; n < 2; ++n) { const f32x4 x = v[ai][bj][m][n]; s += (x[0] + x[1]) + (x[2] + x[3]); }
                s += __shfl_xor(s, 16); s += __shfl_xor(s, 32);
                const float mw = s * (1.0f / 64.0f); float q = 0.f;
#pragma unroll
                for (int bj = 0; bj < 2; ++bj)
#pragma unroll
                    for (int n = 0; n < 2; ++n) { const f32x4 d = v[ai][bj][m][n] - mw; q += (d[0] * d[0] + d[1] * d[1]) + (d[2] * d[2] + d[3] * d[3]); }
                q += __shfl_xor(q, 16); q += __shfl_xor(q, 32);
                if (fq == 0) P[(ai * HALF + wr * 64 + m * 16 + fr) * 4 + wc] = (f32x2v){mw, q};
            }
        asm volatile("s_waitcnt lgkmcnt(0)" ::: "memory"); __builtin_amdgcn_s_barrier(); asm volatile("" ::: "memory");
#if defined(BROKEN_EXCHANGE_NO_WAIT)
#warning BROKEN CONTROL BUILD: the row-statistics exchange does not wait; results are wrong by design
        if (blockIdx.x >= 64) { const long long t0_ = clock64(); while (clock64() - t0_ < 60000) __builtin_amdgcn_s_sleep(8); }
#endif
        const int row = wid * 32 + (lane & 31);
        if (lane < 32) {
            const f32x2v a = P[row * 4 + 0], b = P[row * 4 + 1], c = P[row * 4 + 2], d = P[row * 4 + 3];
            const float mt = (a.x + b.x + c.x + d.x) * 0.25f;
            const float da = a.x - mt, db = b.x - mt, dc = c.x - mt, dd = d.x - mt;
            const float m2 = (a.y + b.y) + (c.y + d.y) + 64.0f * ((da * da + db * db) + (dc * dc + dd * dd));
            unsigned long long* slot = (unsigned long long*)xbuf + ((size_t)(u.pm * BM + row) * 4 + u.pn);
            __hip_atomic_store(slot, ((unsigned long long)__float_as_uint(m2) << 32) | __float_as_uint(mt), __ATOMIC_RELAXED, __HIP_MEMORY_SCOPE_AGENT);
        }
        asm volatile("s_waitcnt vmcnt(0)" ::: "memory");
        if (lane == 0) __hip_atomic_fetch_add(cnt + 64 * u.pm, 1u, __ATOMIC_RELAXED, __HIP_MEMORY_SCOPE_AGENT);
        if (wid == 0) {
            bool dead = false; const unsigned long long t0 = __builtin_amdgcn_s_memrealtime(); const unsigned want = 8u * (unsigned)ntn;
            for (;;) {
#if defined(BROKEN_EXCHANGE_NO_WAIT)
                break;
#endif
                if ((unsigned)__builtin_amdgcn_readfirstlane(__hip_atomic_load(cnt + 64 * u.pm, __ATOMIC_RELAXED, __HIP_MEMORY_SCOPE_AGENT)) >= want) break;
                if (__builtin_amdgcn_s_memrealtime() - t0 > 2000000ull) {
                    if (lane == 0) { unsigned expect = 0u; __hip_atomic_compare_exchange_strong(tmo + 1, &expect, code | (unsigned)(u.pm & 0xff), __ATOMIC_RELAXED, __ATOMIC_RELAXED, __HIP_MEMORY_SCOPE_AGENT);
                                     __hip_atomic_store(tmo, 1u, __ATOMIC_RELAXED, __HIP_MEMORY_SCOPE_AGENT); }
                    dead = true; break; }
                __builtin_amdgcn_s_sleep(2);
            }
            __builtin_amdgcn_fence(__ATOMIC_ACQUIRE, "agent");
            if (lane == 0) flag[0] = dead ? 1u : 0u;
        }
        asm volatile("s_waitcnt vmcnt(0) lgkmcnt(0)" ::: "memory"); __builtin_amdgcn_s_barrier(); asm volatile("" ::: "memory");
        const bool bad = flag[0] != 0u;
        if (lane < 32) {
            const unsigned long long* slot = (const unsigned long long*)xbuf + (size_t)(u.pm * BM + row) * 4; float mt[4], m2[4]; float ms = 0.f;
#pragma unroll
            for (int t = 0; t < 4; ++t) { if (t < ntn) { const unsigned long long w = __hip_atomic_load(slot + t, __ATOMIC_RELAXED, __HIP_MEMORY_SCOPE_AGENT); mt[t] = __uint_as_float((unsigned)w); m2[t] = __uint_as_float((unsigned)(w >> 32)); } else { mt[t] = 0.f; m2[t] = 0.f; } ms += mt[t]; }
            const float mean = ms / (float)ntn; float q = 0.f;
#pragma unroll
            for (int t = 0; t < 4; ++t) if (t < ntn) { const float dm = mt[t] - mean; q += m2[t] + 256.0f * dm * dm; }
            S[row] = (f32x2v){mean, 1.0f / sqrtf(q / (256.0f * (float)ntn) + eps)};
        }
        asm volatile("s_waitcnt lgkmcnt(0)" ::: "memory"); __builtin_amdgcn_s_barrier(); asm volatile("" ::: "memory");
        return bad;
    }
};
struct EpiLnRes {
    static constexpr bool PERM = false, AFTER_DRAIN = true;
    const float* base; float* out; int ldc; const float* bias; PanelStats st; unsigned poison;
    __device__ __forceinline__ void fused(f32x4 (&acc)[2][2][4][2], const Unit& u, int wr, int wc, int fr, int fq, PG8_LAS unsigned char* lds, int wid, int lane) const {
        typedef float f32x2v __attribute__((ext_vector_type(2)));
        const PG8_LAS f32x2v* S = (const PG8_LAS f32x2v*)(lds + 8192);
        const int col0 = u.pn * BM + wc * 32 + 4 * fq;
#pragma unroll
        for (int bj = 0; bj < 2; ++bj)
#pragma unroll
            for (int n = 0; n < 2; ++n) { const f32x4 bv = bias ? *(const f32x4*)(bias + col0 + bj * HALF + n * 16) : (f32x4){0.f, 0.f, 0.f, 0.f};
#pragma unroll
                for (int ai = 0; ai < 2; ++ai)
#pragma unroll
                    for (int m = 0; m < 4; ++m) acc[ai][bj][m][n] += bv; }
        f32x4 pre[4][2][2];
#pragma unroll
        for (int m = 0; m < 4; ++m) { const size_t off = (size_t)(u.pm * BM + wr * 64 + m * 16 + fr) * ldc + col0;
#pragma unroll
            for (int bj = 0; bj < 2; ++bj)
#pragma unroll
                for (int n = 0; n < 2; ++n) pre[m][bj][n] = *(const f32x4*)(base + off + bj * HALF + n * 16); }
        const bool bad = st.run(acc, u, wr, wc, fr, fq, lds, wid, lane) || poison != 0u;
        const float qnan = __builtin_nanf("");
#pragma unroll
        for (int ai = 0; ai < 2; ++ai)
#pragma unroll
            for (int m = 0; m < 4; ++m) { const int r = ai * HALF + wr * 64 + m * 16 + fr; const f32x2v sr = S[r]; const size_t off = (size_t)(u.pm * BM + r) * ldc + col0;
#pragma unroll
                for (int bj = 0; bj < 2; ++bj)
#pragma unroll
                    for (int n = 0; n < 2; ++n) { const f32x4 bs = ai == 0 ? pre[m][bj][n] : *(const f32x4*)(base + off + bj * HALF + n * 16); f32x4 o = bs + (acc[ai][bj][m][n] - sr.x) * sr.y;
                        if (bad) o = (f32x4){qnan, qnan, qnan, qnan}; *(f32x4*)(out + off + bj * HALF + n * 16) = o; }
                if (m & 1) asm volatile("" ::: "memory"); }
    }
};
struct EpiLnResLn {
    static constexpr bool PERM = false, AFTER_DRAIN = true;
    const float* base; float* out; bf16_t* xn; int ldc; const float* bias; PanelStats st1, st2; unsigned poison;
    __device__ __forceinline__ void fused(f32x4 (&acc)[2][2][4][2], const Unit& u, int wr, int wc, int fr, int fq, PG8_LAS unsigned char* lds, int wid, int lane) const {
        typedef float f32x2v __attribute__((ext_vector_type(2))); typedef unsigned u32x2v __attribute__((ext_vector_type(2)));
        const PG8_LAS f32x2v* S = (const PG8_LAS f32x2v*)(lds + 8192);
        const int col0 = u.pn * BM + wc * 32 + 4 * fq;
#pragma unroll
        for (int bj = 0; bj < 2; ++bj)
#pragma unroll
            for (int n = 0; n < 2; ++n) { const f32x4 bv = bias ? *(const f32x4*)(bias + col0 + bj * HALF + n * 16) : (f32x4){0.f, 0.f, 0.f, 0.f};
#pragma unroll
                for (int ai = 0; ai < 2; ++ai)
#pragma unroll
                    for (int m = 0; m < 4; ++m) acc[ai][bj][m][n] += bv; }
        bool bad = st1.run(acc, u, wr, wc, fr, fq, lds, wid, lane) || poison != 0u;
        const float qnan = __builtin_nanf("");
#pragma unroll
        for (int ai = 0; ai < 2; ++ai)
#pragma unroll
            for (int m = 0; m < 4; ++m) { const int r = ai * HALF + wr * 64 + m * 16 + fr; const f32x2v sr = S[r]; const size_t off = (size_t)(u.pm * BM + r) * ldc + col0;
#pragma unroll
                for (int bj = 0; bj < 2; ++bj)
#pragma unroll
                    for (int n = 0; n < 2; ++n) { const f32x4 bs = *(const f32x4*)(base + off + bj * HALF + n * 16); acc[ai][bj][m][n] = bs + (acc[ai][bj][m][n] - sr.x) * sr.y; }
                asm volatile("" : "+v"(acc[ai][0][m][0]), "+v"(acc[ai][0][m][1]), "+v"(acc[ai][1][m][0]), "+v"(acc[ai][1][m][1]));
                if (m & 1) asm volatile("" ::: "memory"); }
        const bool bad1 = bad;
        bad = st2.run(acc, u, wr, wc, fr, fq, lds, wid, lane) || bad;
#pragma unroll
        for (int ai = 0; ai < 2; ++ai)
#pragma unroll
            for (int m = 0; m < 4; ++m) { const int r = ai * HALF + wr * 64 + m * 16 + fr; const f32x2v sr = S[r]; const size_t off = (size_t)(u.pm * BM + r) * ldc + col0;
#pragma unroll
                for (int bj = 0; bj < 2; ++bj)
#pragma unroll
                    for (int n = 0; n < 2; ++n) { const f32x4 x1 = acc[ai][bj][m][n]; *(f32x4*)(out + off + bj * HALF + n * 16) = bad1 ? (f32x4){qnan, qnan, qnan, qnan} : x1;
                        const f32x4 o = (x1 - sr.x) * sr.y; u32x2v w; w.x = cvt_pk_bf16(o[0], o[1]); w.y = cvt_pk_bf16(o[2], o[3]);
                        if (bad) { w.x = 0x7fc07fc0u; w.y = 0x7fc07fc0u; } *(u32x2v*)(xn + off + bj * HALF + n * 16) = w; }
                asm volatile("" ::: "memory"); }
    }
};

template <class Epi, class Sched, bool ALIGN_EPI = false, bool SP2 = false>
__device__ __forceinline__ void gemm_phase(PG8_LAS unsigned char* lds, const Gemm g, const Sched& S, const Epi& E) {
    const int tid = tidx(), wid = __builtin_amdgcn_readfirstlane(tid >> 6), lane = tid & 63, wr = wid >> 2, wc = wid & 3, fr = lane & 15, fq = lane >> 4;
    const int K = g.K, nt = K / BK;
    const int LDA = g.lda ? g.lda : K, LDB = g.ldb ? g.ldb : K;
    unsigned voffA[2], voffB[2];
#pragma unroll
    for (int i = 0; i < 2; ++i) { int R, C; stage_rc(tid * 16 + i * 8192, R, C); const int Rb = Epi::PERM ? ((R & ~31) + perm32(R & 31)) : R;
        voffA[i] = (unsigned)(R * LDA + C) * 2u; voffB[i] = (unsigned)(Rb * LDB + C) * 2u; }
    const size_t kstep = (size_t)(BK * 2);
    const size_t hstepA = (size_t)HALF * LDA * 2, hstepB = (size_t)HALF * LDB * 2;
    const size_t tstepA = 2 * hstepA, tstepB = 2 * hstepB;
    const unsigned ldsw = (unsigned)wid * 1024u;
    const int aoff = lds_byte(wr * 64 + fr, fq * 8), boff = lds_byte(wc * 32 + fr, fq * 8);
#define PG8_SA(b, h) (((b) * 2 + (h)) * HTB)
#define PG8_SB(b, h) ((4 + (b) * 2 + (h)) * HTB)
#define PG8_STAGE(bufoff, gbase, voff) do { _Pragma("unroll") for (int _i = 0; _i < 2; ++_i) \
        __builtin_amdgcn_global_load_lds((const unsigned*)((const char*)(gbase) + (voff)[_i]), (PG8_LAS unsigned*)(lds + (bufoff) + ldsw + _i * 8192), 16, 0, 0); } while (0)
#define PG8_LDA(dst, b, h) do { _Pragma("unroll") for (int m = 0; m < 4; ++m) _Pragma("unroll") for (int k = 0; k < 2; ++k) dst[m][k] = *(const PG8_LAS bf16x8*)(lds + PG8_SA(b, h) + aoff + m * 2048 + k * 1024); } while (0)
#define PG8_LDB(dst, b, h) do { _Pragma("unroll") for (int n = 0; n < 2; ++n) _Pragma("unroll") for (int k = 0; k < 2; ++k) dst[n][k] = *(const PG8_LAS bf16x8*)(lds + PG8_SB(b, h) + boff + n * 2048 + k * 1024); } while (0)
#define PG8_MMA(ai, bj, At, Bt) do { __builtin_amdgcn_s_setprio(1); _Pragma("unroll") for (int m = 0; m < 4; ++m) _Pragma("unroll") for (int n = 0; n < 2; ++n) _Pragma("unroll") for (int k = 0; k < 2; ++k) \
        acc[ai][bj][m][n] = __builtin_amdgcn_mfma_f32_16x16x32_bf16(Bt[n][k], At[m][k], acc[ai][bj][m][n], 0, 0, 0); __builtin_amdgcn_s_setprio(0); } while (0)
#define PG8_WAIT_V(n) asm volatile("s_waitcnt vmcnt(" #n ")" ::: "memory")
#define PG8_WAIT_L(n) asm volatile("s_waitcnt lgkmcnt(" #n ")" ::: "memory")
#define PG8_BAR __builtin_amdgcn_s_barrier()
#define PG8_SCHED __builtin_amdgcn_sched_barrier(0)
    Unit cur, nxt; int ui = 0;
    if (!S.next(0, cur)) return;
    f32x4 acc[2][2][4][2];
#pragma unroll
    for (int a = 0; a < 2; ++a)
#pragma unroll
        for (int b = 0; b < 2; ++b)
#pragma unroll
            for (int m = 0; m < 4; ++m)
#pragma unroll
                for (int n = 0; n < 2; ++n) acc[a][b][m][n] = (f32x4){0.f, 0.f, 0.f, 0.f};
    bf16x8 At[4][2], B0[2][2], B1[2][2];
    const char* cA = (const char*)g.A + (size_t)cur.pm * tstepA; const char* cB = (const char*)g.Bt + (size_t)cur.pn * tstepB;
    S.a_ready(cur);
    if constexpr (SP2) {
        PG8_STAGE(PG8_SB(0, 0), cB, voffB); PG8_STAGE(PG8_SB(0, 1), cB + hstepB, voffB); PG8_STAGE(PG8_SA(0, 0), cA, voffA); PG8_STAGE(PG8_SA(0, 1), cA + hstepA, voffA);
        if (wr == 1) PG8_BAR;
        PG8_WAIT_V(2); PG8_BAR;
        PG8_STAGE(PG8_SB(1, 0), cB + kstep, voffB); PG8_STAGE(PG8_SA(1, 0), cA + kstep, voffA); PG8_STAGE(PG8_SB(1, 1), cB + hstepB + kstep, voffB);
        PG8_WAIT_V(6); PG8_BAR;
    } else {
        PG8_STAGE(PG8_SB(0, 0), cB, voffB); PG8_STAGE(PG8_SA(0, 0), cA, voffA); PG8_STAGE(PG8_SB(0, 1), cB + hstepB, voffB); PG8_STAGE(PG8_SA(0, 1), cA + hstepA, voffA);
        if (wr == 1) PG8_BAR;
        PG8_WAIT_V(4); PG8_BAR;
        PG8_STAGE(PG8_SB(1, 0), cB + kstep, voffB); PG8_STAGE(PG8_SA(1, 0), cA + kstep, voffA); PG8_STAGE(PG8_SB(1, 1), cB + hstepB + kstep, voffB);
        PG8_WAIT_V(6); PG8_BAR;
    }
    for (;;) {
        const bool has_next = S.next(ui + 1, nxt);
        const char* nA = has_next ? (const char*)g.A + (size_t)nxt.pm * tstepA : cA; const char* nB = has_next ? (const char*)g.Bt + (size_t)nxt.pn * tstepB : cB;
        for (int t = 0; t < nt; t += 2) {
            const bool last = (t == nt - 2);
            const char* a1 = cA + (size_t)(t + 1) * kstep;
            const char* a2 = last ? nA : cA + (size_t)(t + 2) * kstep; const char* b2 = last ? nB : cB + (size_t)(t + 2) * kstep;
            const char* a3 = a2 + kstep; const char* b3 = b2 + kstep;
            if (last && has_next) S.a_ready(nxt);
            if constexpr (SP2) {
            PG8_LDB(B0, 0, 0); PG8_LDB(B1, 0, 1); PG8_SCHED; PG8_LDA(At, 0, 0); PG8_STAGE(PG8_SA(1, 1), a1 + hstepA, voffA);
            PG8_WAIT_V(8); PG8_WAIT_L(0); PG8_BAR; PG8_MMA(0, 0, At, B0); PG8_MMA(0, 1, At, B1); PG8_BAR; PG8_SCHED;
            PG8_LDA(At, 0, 1); PG8_STAGE(PG8_SB(0, 0), b2, voffB); PG8_STAGE(PG8_SB(0, 1), b2 + hstepB, voffB); PG8_STAGE(PG8_SA(0, 0), a2, voffA);
            PG8_WAIT_V(8); PG8_WAIT_L(0); PG8_BAR; PG8_MMA(1, 0, At, B0); PG8_MMA(1, 1, At, B1); PG8_BAR; PG8_SCHED;
            PG8_LDB(B0, 1, 0); PG8_LDB(B1, 1, 1); PG8_SCHED; PG8_LDA(At, 1, 0); PG8_STAGE(PG8_SA(0, 1), a2 + hstepA, voffA);
            PG8_WAIT_V(8); PG8_WAIT_L(0); PG8_BAR; PG8_MMA(0, 0, At, B0); PG8_MMA(0, 1, At, B1); PG8_BAR; PG8_SCHED;
            PG8_LDA(At, 1, 1); PG8_STAGE(PG8_SB(1, 0), b3, voffB); PG8_STAGE(PG8_SB(1, 1), b3 + hstepB, voffB); PG8_STAGE(PG8_SA(1, 0), a3, voffA);
            PG8_WAIT_V(8); PG8_WAIT_L(0); PG8_BAR; PG8_MMA(1, 0, At, B0); PG8_MMA(1, 1, At, B1); PG8_BAR; PG8_SCHED;
            } else {
            PG8_LDB(B0, 0, 0); PG8_SCHED; PG8_LDA(At, 0, 0); PG8_STAGE(PG8_SA(1, 1), a1 + hstepA, voffA);
            PG8_WAIT_L(8); PG8_BAR; PG8_WAIT_L(0); PG8_MMA(0, 0, At, B0); PG8_BAR; PG8_SCHED;
            PG8_LDB(B1, 0, 1); PG8_STAGE(PG8_SB(0, 0), b2, voffB);
            PG8_BAR; PG8_WAIT_L(0); PG8_MMA(0, 1, At, B1); PG8_BAR;
            PG8_LDA(At, 0, 1); PG8_STAGE(PG8_SA(0, 0), a2, voffA);
            PG8_BAR; PG8_WAIT_L(0); PG8_MMA(1, 0, At, B0); PG8_BAR; PG8_SCHED;
            PG8_STAGE(PG8_SB(0, 1), b2 + hstepB, voffB);
            PG8_WAIT_V(6); PG8_BAR; PG8_MMA(1, 1, At, B1); PG8_BAR;
            PG8_LDB(B0, 1, 0); PG8_SCHED; PG8_LDA(At, 1, 0); PG8_STAGE(PG8_SA(0, 1), a2 + hstepA, voffA);
            PG8_WAIT_L(8); PG8_BAR; PG8_WAIT_L(0); PG8_MMA(0, 0, At, B0); PG8_BAR; PG8_SCHED;
            PG8_LDB(B1, 1, 1); PG8_STAGE(PG8_SB(1, 0), b3, voffB);
            PG8_BAR; PG8_WAIT_L(0); PG8_MMA(0, 1, At, B1); PG8_BAR;
            PG8_LDA(At, 1, 1); PG8_STAGE(PG8_SA(1, 0), a3, voffA);
            PG8_BAR; PG8_WAIT_L(0); PG8_MMA(1, 0, At, B0); PG8_BAR; PG8_SCHED;
            PG8_STAGE(PG8_SB(1, 1), b3 + hstepB, voffB);
            PG8_WAIT_V(6); PG8_BAR; PG8_MMA(1, 1, At, B1); PG8_BAR;
            }
        }
        if constexpr (ALIGN_EPI) { if (wr == 0) PG8_BAR; }
        if constexpr (!Epi::AFTER_DRAIN) { E(acc, cur, wr, wc, fr, fq); S.done(cur); }
        if (!has_next) break;
#pragma unroll
        for (int a = 0; a < 2; ++a)
#pragma unroll
            for (int b = 0; b < 2; ++b)
#pragma unroll
                for (int m = 0; m < 4; ++m)
#pragma unroll
                    for (int n = 0; n < 2; ++n) acc[a][b][m][n] = (f32x4){0.f, 0.f, 0.f, 0.f};
        cur = nxt; cA = nA; cB = nB; ++ui;
        if constexpr (ALIGN_EPI) { if (wr == 1) PG8_BAR; }
    }
    PG8_WAIT_V(0);
    if constexpr (!ALIGN_EPI) { if (wr == 0) PG8_BAR; }
    PG8_BAR;
    if constexpr (Epi::AFTER_DRAIN) { E.fused(acc, cur, wr, wc, fr, fq, lds, wid, lane); S.done(cur); }
#undef PG8_SA
#undef PG8_SB
#undef PG8_STAGE
#undef PG8_LDA
#undef PG8_LDB
#undef PG8_MMA
#undef PG8_WAIT_V
#undef PG8_WAIT_L
#undef PG8_BAR
#undef PG8_SCHED
}
}
namespace pg8 {
struct EpiF32 {
    static constexpr bool PERM = false, AFTER_DRAIN = false;
    float* C; int ldc; const float* bias;
    __device__ __forceinline__ void operator()(const f32x4 (&acc)[2][2][4][2], const Unit& u, int wr, int wc, int fr, int fq) const {
        const int row0 = u.pm * BM + wr * 64 + fr, col0 = u.pn * BM + wc * 32 + 4 * fq;
        f32x4 bv[2][2];
#pragma unroll
        for (int bj = 0; bj < 2; ++bj)
#pragma unroll
            for (int n = 0; n < 2; ++n) bv[bj][n] = bias ? *(const f32x4*)(bias + col0 + bj * HALF + n * 16) : (f32x4){0.f, 0.f, 0.f, 0.f};
#pragma unroll
        for (int ai = 0; ai < 2; ++ai)
#pragma unroll
            for (int m = 0; m < 4; ++m) { float* rowp = C + (size_t)(row0 + ai * HALF + m * 16) * ldc + col0;
#pragma unroll
                for (int bj = 0; bj < 2; ++bj)
#pragma unroll
                    for (int n = 0; n < 2; ++n) *(f32x4*)(rowp + bj * HALF + n * 16) = acc[ai][bj][m][n] + bv[bj][n]; }
    }
};
}
#define XB_TMO      128
#define XB_XCNT(j)  (256  + 64 * (j))
#define XB_XSUB(j)  (1280 + 64 * (j))
#define XB_XGEN(j)  (2304 + 64 * (j))
#define XB_TOP      3328
#define XB_TOPGEN   3392
#define XCD_BAR_WORDS 3456
#define XB_SPIN_CAP (1u << 18)

__device__ __forceinline__ unsigned xb_ld(unsigned* p)              { return __hip_atomic_load(p, __ATOMIC_RELAXED, __HIP_MEMORY_SCOPE_AGENT); }
__device__ __forceinline__ unsigned xb_add(unsigned* p, unsigned v) { return __hip_atomic_fetch_add(p, v, __ATOMIC_RELAXED, __HIP_MEMORY_SCOPE_AGENT); }
__device__ __forceinline__ unsigned xb_xcc_id() { return (unsigned)__builtin_amdgcn_s_getreg((3 << 11) | 20) & 0xFu; }
#define XB_SPIN(cond, bar) do { unsigned _sp = 0; while (cond) { __builtin_amdgcn_s_sleep(1); \
    if ((++_sp & 255u) == 0u) { if (xb_ld(&(bar)[XB_TMO])) break; if (_sp > XB_SPIN_CAP) { atomicAdd(&(bar)[XB_TMO], 1u); break; } } } } while (0)

struct XcdBarrier {
    unsigned* bar; unsigned x;
    volatile LAS unsigned* st;
};

__device__ __forceinline__ XcdBarrier xcd_barrier_post(unsigned* bar, volatile LAS unsigned* st) {
    XcdBarrier b; b.bar = bar; b.x = xb_xcc_id(); b.st = st;
    if (tidx() == 0) (void)xb_add(&bar[XB_XCNT(b.x)], 1u);
    return b;
}
__device__ __forceinline__ void xcd_barrier_complete(unsigned* bar, unsigned x, unsigned& nloc, unsigned& nx) {
    const unsigned G = gridDim.x * gridDim.y * gridDim.z;
    unsigned sum, cnt, mine, sp = 0u;
    for (;;) {
        sum = 0u; cnt = 0u; mine = 0u;
#pragma unroll
        for (unsigned j = 0; j < 16; ++j) { const unsigned c = xb_ld(&bar[XB_XCNT(j)]); sum += c; cnt += (c > 0u) ? 1u : 0u; mine = (j == x) ? c : mine; }
        if (sum == G) break;
        __builtin_amdgcn_s_sleep(1);
        if ((++sp & 255u) == 0u) { if (xb_ld(&bar[XB_TMO])) break; if (sp > XB_SPIN_CAP) { atomicAdd(&bar[XB_TMO], 1u); break; } }
    }
    nloc = mine > 0u ? mine : 1u; nx = cnt > 0u ? cnt : 1u;
}

__device__ __forceinline__ void xcd_barrier(const XcdBarrier& b) {
    asm volatile("s_waitcnt vmcnt(0)" ::: "memory");
    __syncthreads();
    if (tidx() == 0) {
        unsigned* bar = b.bar;
        __builtin_amdgcn_s_waitcnt(0);
        unsigned nloc = b.st[0], nx = b.st[1];
        if (nloc == 0u) { xcd_barrier_complete(bar, b.x, nloc, nx); b.st[0] = nloc; b.st[1] = nx; }
        const unsigned old = xb_add(&bar[XB_XSUB(b.x)], 1u);
        const unsigned gen = old / nloc;
        if (old + 1u == (gen + 1u) * nloc) {
            __builtin_amdgcn_fence(__ATOMIC_RELEASE, "agent");
            asm volatile("s_waitcnt vmcnt(0)" ::: "memory");
            const unsigned og = xb_add(&bar[XB_TOP], 1u);
            const unsigned tg = og / nx;
            if (og + 1u == (tg + 1u) * nx) xb_add(&bar[XB_TOPGEN], 1u);
            else XB_SPIN(xb_ld(&bar[XB_TOPGEN]) == tg, bar);
            __builtin_amdgcn_fence(__ATOMIC_ACQUIRE, "agent");
            xb_add(&bar[XB_XGEN(b.x)], 1u);
            asm volatile("s_waitcnt vmcnt(0)" ::: "memory");
        } else {
            XB_SPIN(xb_ld(&bar[XB_XGEN(b.x)]) == gen, bar);
            __builtin_amdgcn_fence(__ATOMIC_ACQUIRE, "agent");
            asm volatile("s_waitcnt vmcnt(0)" ::: "memory");
        }
    }
    __syncthreads();
}

#define DPP_ADD(x, ctrl) ((x) + __int_as_float(__builtin_amdgcn_update_dpp(0, __float_as_int(x), (ctrl), 0xF, 0xF, true)))
DEVI float wsum_all(float v) {
    v = DPP_ADD(v, 0xB1);
    v = DPP_ADD(v, 0x4E);
    v = DPP_ADD(v, 0x141);
    v = DPP_ADD(v, 0x140);
    const float r0 = __int_as_float(__builtin_amdgcn_readlane(__float_as_int(v), 0)), r1 = __int_as_float(__builtin_amdgcn_readlane(__float_as_int(v), 16));
    const float r2 = __int_as_float(__builtin_amdgcn_readlane(__float_as_int(v), 32)), r3 = __int_as_float(__builtin_amdgcn_readlane(__float_as_int(v), 48));
    return (r0 + r1) + (r2 + r3);
}
DEVI float wave_sum(float v) { return wsum_all(v); }
DEVI float wave_max(float v) {
#pragma unroll
    for (int o = 32; o > 0; o >>= 1) v = fmaxf(v, __shfl_xor(v, o, 64));
    return v;
}
DEVI float sigm(float x) { return 1.f / (1.f + expf(-x)); }
DEVI float gelu_t(float x) { return 0.5f * x * (1.f + tanhf(0.7978845608028654f * (x + 0.044715f * x * x * x))); }
DEVI float softplus_(float x) { return fmaxf(x, 0.f) + log1pf(expf(-fabsf(x))); }

DEVI float block_sum256(float v, float* red, int tid) {
    v = wave_sum(v);
    __syncthreads();
    if ((tid & 63) == 0) red[tid >> 6] = v;
    __syncthreads();
    return red[0] + red[1] + red[2] + red[3];
}

DEVI void ln_kernel(const float* xres, float alpha, const float* add, const float* __restrict__ g, const float* __restrict__ bt,
                    float* out, bf16* outb, int bid, float* sm) {
    __syncthreads();
    const size_t row = bid;
    const int tid = tidx() & 255;
    float v[4];
#pragma unroll
    for (int i = 0; i < 4; ++i) {
        const size_t idx = row * DM + tid + i * 256;
        v[i] = alpha * xres[idx] + (add ? add[idx] : 0.f);
    }
    const float mean = block_sum256(v[0] + v[1] + v[2] + v[3], sm, tid) * (1.f / DM);
    float q = 0.f;
#pragma unroll
    for (int i = 0; i < 4; ++i) { v[i] -= mean; q += v[i] * v[i]; }
    const float var = block_sum256(q, sm, tid) * (1.f / DM);
    const float rstd = rsqrtf(var + 1e-5f);
#pragma unroll
    for (int i = 0; i < 4; ++i) {
        const int c = tid + i * 256;
        const float o = v[i] * rstd * g[c] + bt[c];
        out[row * DM + c] = o;
        outb[row * DM + c] = (bf16)f2bf(o);
    }
}

struct GemmArgs {
    const float* A; const float* B; float* C; const int* rowidx; const int* zoff;
    long lda, sbk, sbn, ldc, sAz0, sAz1, sBz0, sBz1, sCz0, sCz1;
    int M, N, K, Z1, epi, pad;
};
DEVI void gemm_f32(const GemmArgs& g, int bx, int by, int z, bool live, float* sm) {
    float (*As)[68] = (float (*)[68])sm;
    float (*Bs)[68] = (float (*)[68])(sm + 16 * 68);
    const int z0 = z / g.Z1, z1 = z % g.Z1;
    int mbeg = 0, mend = g.M;
    if (g.zoff) { mbeg = g.zoff[z]; mend = g.zoff[z + 1]; }
    const int m0 = mbeg + by * 64;
    if (!live) mend = 0;
    const int n0 = bx * 64;
    const float* A = g.A + z0 * g.sAz0 + z1 * g.sAz1;
    const float* B = g.B + z0 * g.sBz0 + z1 * g.sBz1;
    float* C = g.C + z0 * g.sCz0 + z1 * g.sCz1;
    const int tid = tidx() & 255, tx = tid & 15, ty = tid >> 4;
    float acc[4][4];
#pragma unroll
    for (int i = 0; i < 4; ++i)
#pragma unroll
        for (int j = 0; j < 4; ++j) acc[i][j] = 0.f;
    long arow[4];
#pragma unroll
    for (int i = 0; i < 4; ++i) {
        const int r = (tid + i * 256) >> 4;
        const int row = m0 + r;
        if (row < mend) arow[i] = (long)(g.rowidx ? g.rowidx[row] : row) * g.lda; else arow[i] = -1;
    }
    __syncthreads();
    for (int k0 = 0; k0 < g.K; k0 += 16) {
#pragma unroll
        for (int i = 0; i < 4; ++i) {
            const int e = tid + i * 256, r = e >> 4, kk = e & 15;
            float v = 0.f;
            if (arow[i] >= 0 && k0 + kk < g.K) v = A[arow[i] + k0 + kk];
            As[kk][r] = v;
        }
#pragma unroll
        for (int i = 0; i < 4; ++i) {
            const int e = tid + i * 256, kk = e >> 6, n = e & 63;
            float v = 0.f;
            if (m0 < mend && n0 + n < g.N && k0 + kk < g.K) v = B[(long)(k0 + kk) * g.sbk + (long)(n0 + n) * g.sbn];
            Bs[kk][n] = v;
        }
        __syncthreads();
#pragma unroll
        for (int kk = 0; kk < 16; ++kk) {
            float a[4], b[4];
#pragma unroll
            for (int i = 0; i < 4; ++i) a[i] = As[kk][ty * 4 + i];
#pragma unroll
            for (int j = 0; j < 4; ++j) b[j] = Bs[kk][tx * 4 + j];
#pragma unroll
            for (int i = 0; i < 4; ++i)
#pragma unroll
                for (int j = 0; j < 4; ++j) acc[i][j] = fmaf(a[i], b[j], acc[i][j]);
        }
        __syncthreads();
    }
#pragma unroll
    for (int i = 0; i < 4; ++i) {
        const int row = m0 + ty * 4 + i;
        if (row >= mend) continue;
#pragma unroll
        for (int j = 0; j < 4; ++j) {
            const int col = n0 + tx * 4 + j;
            if (col >= g.N) continue;
            float* p = C + (long)row * g.ldc + col;
            float v = acc[i][j];
            if (g.epi == 2) { ((bf16*)C)[(long)row * g.ldc + col] = (bf16)f2bf(v); continue; }
            if (g.epi == 3) { ((bf16*)C)[(long)(row >> 9) * 64 * 512 + (long)col * 512 + (row & 511)] = (bf16)f2bf(v); continue; }
            if (g.epi == 1) { v = v * sigm(v) * (*p); }
            *p = v;
        }
    }
}
DEVI GemmArgs mk(const float* A, long lda, const float* B, long sbk, long sbn, float* C, long ldc, int M, int N, int K,
                 int Z1 = 1, long sAz0 = 0, long sAz1 = 0, long sBz0 = 0, long sBz1 = 0, long sCz0 = 0, long sCz1 = 0,
                 const int* rowidx = nullptr, const int* zoff = nullptr, int epi = 0) {
    GemmArgs g;
    g.A = A; g.B = B; g.C = C; g.rowidx = rowidx; g.zoff = zoff;
    g.lda = lda; g.sbk = sbk; g.sbn = sbn; g.ldc = ldc;
    g.sAz0 = sAz0; g.sAz1 = sAz1; g.sBz0 = sBz0; g.sBz1 = sBz1; g.sCz0 = sCz0; g.sCz1 = sCz1;
    g.M = M; g.N = N; g.K = K; g.Z1 = Z1; g.epi = epi; g.pad = 0;
    return g;
}
DEVI int gemm_tiles(const GemmArgs& g, int maxM, int Z) { return ((g.N + 63) / 64) * ((maxM + 63) / 64) * Z; }
DEVI bool gemm_tile_live(const GemmArgs& g, int maxM, int t) {
    const int nbx = (g.N + 63) / 64, nby = (maxM + 63) / 64;
    const int r = t / nbx, by = r % nby, z = r / nby;
    int mbeg = 0, mend = g.M;
    if (g.zoff) { mbeg = g.zoff[z]; mend = g.zoff[z + 1]; }
    return mbeg + by * 64 < mend;
}
DEVI void gemm_tile(const GemmArgs& g, int maxM, int t, bool live, float* sm) {
    const int nbx = (g.N + 63) / 64, nby = (maxM + 63) / 64;
    const int bx = t % nbx, r = t / nbx;
    gemm_f32(g, bx, r % nby, r / nby, live, sm);
}

DEVI void glu_kernel(const bf16* __restrict__ cols, float* __restrict__ h, int bid) {
    const size_t t = bid; const int c = tidx() & 255;
    h[t * 256 + c] = bf2f(cols[t * DINP + OFF_CV + c]) * sigm(bf2f(cols[t * DINP + OFF_CG + c]));
}
DEVI void conv_kernel(const float* __restrict__ h, const float* __restrict__ w, const float* __restrict__ bias,
                      const float* __restrict__ gg, const float* __restrict__ gb, bf16* __restrict__ mix, int bid) {
    const int t = bid, c = tidx() & 255;
    float acc = bias[c];
#pragma unroll 4
    for (int j = 0; j < 31; ++j) {
        const int tt = t - 30 + j;
        if (tt >= 0) acc = fmaf(h[(size_t)tt * 256 + c], w[j * 256 + c], acc);
    }
    const float mean = wave_sum(acc) * (1.f / 64.f);
    const float d = acc - mean;
    const float var = wave_sum(d * d) * (1.f / 64.f);
    const float y = d * rsqrtf(var + 1e-5f) * gg[c] + gb[c];
    mix[(size_t)t * DM + 0 + c] = (bf16)f2bf(y * sigm(y));
}

DEVI void gmlp_pre(const bf16* __restrict__ cols, const float* __restrict__ lg, const float* __restrict__ lb,
                   float* __restrict__ ub, float* __restrict__ vb, int bid, float* sm) {
    __syncthreads();
    const size_t t = bid; const int c = tidx() & 255;
    ub[t * 256 + c] = gelu_t(bf2f(cols[t * DINP + OFF_GU + c]));
    const float v = gelu_t(bf2f(cols[t * DINP + OFF_GV + c]));
    const float mean = block_sum256(v, sm, c) * (1.f / 256.f);
    const float d = v - mean;
    const float var = block_sum256(d * d, sm, c) * (1.f / 256.f);
    vb[t * 256 + c] = d * rsqrtf(var + 1e-5f) * lg[c] + lb[c];
}
DEVI void gmlp_mix(const float* __restrict__ ub, const float* __restrict__ vb, const float* __restrict__ ws,
                   const float* __restrict__ bs, bf16* __restrict__ mix, int bid) {
    const int t = bid, c = tidx() & 255, h = c >> 6, tt = t & 127, base = t - tt;
    float acc = bs[h * 128 + tt];
    const float* wr = ws + ((size_t)h * 128 + tt) * 128;
#pragma unroll 4
    for (int s = 0; s <= tt; ++s) acc = fmaf(wr[s], vb[(size_t)(base + s) * 256 + c], acc);
    mix[(size_t)t * DM + 512 + c] = (bf16)f2bf(ub[(size_t)t * 256 + c] * acc);
}

struct RwkvP {
    const bf16* cols; const float* mu; const float* w0; const float* w_up; const float* a0; const float* a_up; const float* g_up;
    const float* k_k; const float* k_a; const float* r_k; const float* vd; const float* v_mu; const float* v0; const float* v_up;
    float* vfirst; bf16* R; float* LW; bf16* K; bf16* V; bf16* A; bf16* Bv; float* G; float* BON;
    int layer, pad;
};
DEVI void rwkv_prep(const RwkvP& p, int bid, float* sm) {
    __syncthreads();
    float* y = sm;
    float* vds = sm + 1024;
    const int t = bid, c = tidx() & 255;
#pragma unroll
    for (int q = 0; q < 4; ++q) {
        const int j = c + q * 256;
        const float cur = bf2f(p.cols[(size_t)t * DINP + OFF_RW + j]);
        const float prv = t > 0 ? bf2f(p.cols[(size_t)(t - 1) * DINP + OFF_RW + j]) : 0.f;
        y[j] = cur + p.mu[j] * (prv - cur);
    }
    if (p.layer > 0 && c < 32) {
        const float cur = bf2f(p.cols[(size_t)t * DINP + DIN + c]);
        const float prv = t > 0 ? bf2f(p.cols[(size_t)(t - 1) * DINP + DIN + c]) : 0.f;
        vds[c] = cur + p.v_mu[c] * (prv - cur);
    }
    __syncthreads();
    float tw = 0.f, sg = 0.f;
    if (c < 64) tw = tanhf(y[768 + c]);
    if (c >= 128) sg = sigm(y[896 + (c - 128)]);
    __syncthreads();
    if (c < 64) y[768 + c] = tw;
    if (c >= 128) y[896 + (c - 128)] = sg;
    __syncthreads();
    const float r = y[c], k = y[256 + c];
    float v = y[512 + c];
    float wl = p.w0[c], al = p.a0[c], gl = 0.f;
#pragma unroll 4
    for (int j = 0; j < 64; ++j) { wl = fmaf(y[768 + j], p.w_up[j * 256 + c], wl); al = fmaf(y[832 + j], p.a_up[j * 256 + c], al); }
#pragma unroll 4
    for (int j = 0; j < 128; ++j) gl = fmaf(y[896 + j], p.g_up[j * 256 + c], gl);
    const float wlog = -softplus_(-wl) - 0.5f;
    const float a = sigm(al);
    if (p.layer == 0) {
        p.vfirst[(size_t)t * 256 + c] = v;
    } else {
        float vm = p.v0[c];
#pragma unroll 4
        for (int j = 0; j < 32; ++j) vm = fmaf(vds[j], p.v_up[j * 256 + c], vm);
        vm = sigm(vm);
        v = v + (p.vfirst[(size_t)t * 256 + c] - v) * vm;
    }
    float kk = k * p.k_k[c];
    const float nrm = sqrtf(wave_sum(kk * kk));
    kk = kk / fmaxf(nrm, 1e-12f);
    const float k2 = k * (1.f + (a - 1.f) * p.k_a[c]);
    const float bd = wave_sum(r * k2 * p.r_k[c]);
    const size_t o = (size_t)t * 256 + c;
    p.R[o] = (bf16)f2bf(r); p.LW[o] = -expf(wlog); p.K[o] = (bf16)f2bf(k2); p.V[o] = (bf16)f2bf(v); p.A[o] = (bf16)f2bf(-kk); p.Bv[o] = (bf16)f2bf(kk * a); p.G[o] = gl; p.BON[o] = bd * v;
}
DEVI void rwkv_scan(float* R, const float* __restrict__ W, const float* __restrict__ K, const float* __restrict__ V,
                    const float* __restrict__ A, const float* __restrict__ Bv, float* sm0) {
    float (*sr)[256] = (float (*)[256])sm0, (*sw)[256] = sr + 4, (*sk)[256] = sr + 8, (*sa)[256] = sr + 12, (*sb)[256] = sr + 16, (*sv)[256] = sr + 20;
    const int vt = tidx(); const bool act = vt < 256;
    const int tid = vt & 255, h = tid >> 6, lane = tid & 63;
    float st[64];
#pragma unroll
    for (int i = 0; i < 64; ++i) st[i] = 0.f;
    for (int t0 = 0; t0 < SEQ; t0 += 4) {
        __syncthreads();
        if (act) {
#pragma unroll
            for (int s = 0; s < 4; ++s) {
                const size_t idx = (size_t)(t0 + s) * 256 + tid;
                sr[s][tid] = R[idx]; sw[s][tid] = W[idx]; sk[s][tid] = K[idx]; sa[s][tid] = A[idx]; sb[s][tid] = Bv[idx]; sv[s][tid] = V[idx];
            }
        }
        __syncthreads();
        if (act) {
#pragma unroll 1
            for (int s = 0; s < 4; ++s) {
                const float vt_ = sv[s][tid];
                const float* pa = &sa[s][h * 64]; const float* pw = &sw[s][h * 64]; const float* pb = &sb[s][h * 64];
                const float* pk = &sk[s][h * 64]; const float* pr = &sr[s][h * 64];
                float sa_ = 0.f;
#pragma unroll
                for (int k = 0; k < 64; ++k) sa_ = fmaf(st[k], pa[k], sa_);
#pragma unroll
                for (int k = 0; k < 64; ++k) st[k] = fmaf(st[k], pw[k], fmaf(sa_, pb[k], vt_ * pk[k]));
                float o = 0.f;
#pragma unroll
                for (int k = 0; k < 64; ++k) o = fmaf(st[k], pr[k], o);
                R[(size_t)(t0 + s) * 256 + h * 64 + lane] = o;
            }
        }
    }
    __syncthreads();
}
DEVI void rwkv_post(const float* __restrict__ O, const float* __restrict__ BON, const float* __restrict__ G,
                    const float* __restrict__ gg, const float* __restrict__ gb, bf16* __restrict__ mix, int bid) {
    const size_t t = bid; const int c = tidx() & 255;
    const float o = O[t * 256 + c];
    const float mean = wave_sum(o) * (1.f / 64.f);
    const float d = o - mean;
    const float var = wave_sum(d * d) * (1.f / 64.f);
    const float y = d * rsqrtf(var + 64e-5f) * gg[c] + gb[c];
    mix[t * DM + 256 + c] = (bf16)f2bf((y + BON[t * 256 + c]) * G[t * 256 + c]);
}

DEVI void nsa_prep(const bf16* __restrict__ cols, float* __restrict__ qrot, float* __restrict__ ksr,
                   float* __restrict__ kwr, float* __restrict__ gates, int bid) {
    const int t = bid, c = tidx() & 255;
    const int d = c & 63, j = d & 31;
    const float inv = powf(10000.f, -(float)j / 32.f);
    const float ang = (float)t * inv;
    float sn, cs; sincosf(ang, &sn, &cs);
    {
        const bf16* q = cols + (size_t)t * DINP + OFF_Q + (c & ~63);
        const float x1 = bf2f(q[j]), x2 = bf2f(q[j + 32]);
        qrot[(size_t)t * 256 + c] = d < 32 ? x1 * cs - x2 * sn : x2 * cs + x1 * sn;
    }
    if (c < 128) {
        const bf16* kp = cols + (size_t)t * DINP + (c < 64 ? OFF_KS : OFF_KW);
        const float x1 = bf2f(kp[j]), x2 = bf2f(kp[j + 32]);
        const float v = d < 32 ? x1 * cs - x2 * sn : x2 * cs + x1 * sn;
        if (c < 64) ksr[(size_t)t * 64 + d] = v; else kwr[(size_t)t * 64 + d] = v;
    }
    if (c < 12) gates[(size_t)t * 12 + c] = sigm(bf2f(cols[(size_t)t * DINP + OFF_GT + c]));
}
DEVI void cmp_gather(const bf16* __restrict__ cols, const float* __restrict__ pek, const float* __restrict__ pev,
                     bf16* __restrict__ bk, bf16* __restrict__ bv, int bid) {
    const int n = bid, tid = tidx() & 255;
    for (int i = tid; i < 2048; i += 256) {
        const int l = i >> 6, d = i & 63;
        const size_t row = (size_t)(16 * n + l) * DINP;
        bk[(size_t)n * 2048 + i] = n < NCMP ? (bf16)f2bf(bf2f(cols[row + OFF_KC + d]) + pek[i]) : (bf16)0;
        bv[(size_t)n * 2048 + i] = n < NCMP ? (bf16)f2bf(bf2f(cols[row + OFF_VC + d]) + pev[i]) : (bf16)0;
    }
}
DEVI void gelu_inplace(float* p, int n, int bid) {
    const int i = bid * 256 + (tidx() & 255);
    if (i < n) p[i] = gelu_t(p[i]);
}

DEVI void wave_softmax(float* s, int n, int lane) {
    float m = -INFINITY;
    for (int i = lane; i < n; i += 64) m = fmaxf(m, s[i]);
    m = wave_max(m);
    if (m == -INFINITY) { for (int i = lane; i < n; i += 64) s[i] = 0.f; return; }
    float sum = 0.f;
    for (int i = lane; i < n; i += 64) { const float p = expf(s[i] - m); s[i] = p; sum += p; }
    sum = wave_sum(sum);
    const float inv = 1.f / fmaxf(sum, 1e-20f);
    for (int i = lane; i < n; i += 64) s[i] *= inv;
}
DEVI void dot4(const float* q  , const float* __restrict__ krow, float* out4) {
    float a0 = 0.f, a1 = 0.f, a2 = 0.f, a3 = 0.f;
#pragma unroll
    for (int d = 0; d < 64; d += 4) {
        const float4 kv = *(const float4*)(krow + d);
        a0 += q[d] * kv.x + q[d + 1] * kv.y + q[d + 2] * kv.z + q[d + 3] * kv.w;
        a1 += q[64 + d] * kv.x + q[64 + d + 1] * kv.y + q[64 + d + 2] * kv.z + q[64 + d + 3] * kv.w;
        a2 += q[128 + d] * kv.x + q[128 + d + 1] * kv.y + q[128 + d + 2] * kv.z + q[128 + d + 3] * kv.w;
        a3 += q[192 + d] * kv.x + q[192 + d + 1] * kv.y + q[192 + d + 2] * kv.z + q[192 + d + 3] * kv.w;
    }
    out4[0] = a0; out4[1] = a1; out4[2] = a2; out4[3] = a3;
}
DEVI void nsa_attn(const bf16* __restrict__ cols, const float* __restrict__ qrot, const float* __restrict__ ksr,
                   const float* __restrict__ kwr, const float* __restrict__ gates, const float* __restrict__ kcmp,
                   const float* __restrict__ vcmp, bf16* __restrict__ mix, int bid, float* sm) {
    __syncthreads();
    float* q = sm; float* qr = sm + 256;
    float (*sc)[1024] = (float (*)[1024])(sm + 512);
    float* imp = sm + 512 + 4096;
    int* sel = (int*)(sm + 512 + 4096 + 128);
    const int pos = bid, tid = tidx() & 255, h = tid >> 6, lane = tid & 63;
    q[tid] = bf2f(cols[(size_t)pos * DINP + OFF_Q + tid]);
    qr[tid] = qrot[(size_t)pos * 256 + tid];
    __syncthreads();
    int ncv = pos >= 31 ? (pos - 31) / 16 + 1 : 0;
    if (ncv > NCMP) ncv = NCMP;
    for (int n = tid; n < 512; n += 256) {
        if (n < ncv) {
            float d4[4]; dot4(q, kcmp + (size_t)n * 64, d4);
            sc[0][n] = d4[0] * 0.125f; sc[1][n] = d4[1] * 0.125f; sc[2][n] = d4[2] * 0.125f; sc[3][n] = d4[3] * 0.125f;
        } else { sc[0][n] = 0.f; sc[1][n] = 0.f; sc[2][n] = 0.f; sc[3][n] = 0.f; }
    }
    __syncthreads();
    wave_softmax(sc[h], ncv, lane);
    __syncthreads();
    float oc = 0.f;
#pragma unroll 4
    for (int n = 0; n < ncv; ++n) oc = fmaf(sc[h][n], vcmp[(size_t)n * 64 + lane], oc);
    if (tid < 128) {
        const int j = tid;
        auto ps = [&](int n) -> float { return (n >= 0 && n < 512) ? (sc[0][n] + sc[1][n] + sc[2][n] + sc[3][n]) : 0.f; };
        const float v = 0.5f * ps(4 * j - 1) + ps(4 * j) + ps(4 * j + 1) + ps(4 * j + 2) + 0.5f * ps(4 * j + 3);
        const int cur = pos >> 6;
        float key;
        if (j == cur || j == 0) key = INFINITY; else if (j <= cur) key = v; else key = -1.f;
        imp[j] = key;
    }
    __syncthreads();
    if (h == 0) {
        float v0 = imp[lane], v1 = imp[lane + 64];
        for (int r = 0; r < 16; ++r) {
            float bv; int bi;
            if (v1 > v0) { bv = v1; bi = lane + 64; } else { bv = v0; bi = lane; }
#pragma unroll
            for (int o = 32; o > 0; o >>= 1) {
                const float ov = __shfl_xor(bv, o, 64); const int oi = __shfl_xor(bi, o, 64);
                if (ov > bv || (ov == bv && oi < bi)) { bv = ov; bi = oi; }
            }
            if (lane == 0) sel[r] = bi;
            if (bi == lane) v0 = -2.f;
            if (bi == lane + 64) v1 = -2.f;
        }
    }
    __syncthreads();
    for (int i = tid; i < 1024; i += 256) {
        const int kp = sel[i >> 6] * 64 + (i & 63);
        if (kp <= pos) {
            float d4[4]; dot4(qr, ksr + (size_t)kp * 64, d4);
            sc[0][i] = d4[0] * 0.125f; sc[1][i] = d4[1] * 0.125f; sc[2][i] = d4[2] * 0.125f; sc[3][i] = d4[3] * 0.125f;
        } else { sc[0][i] = -INFINITY; sc[1][i] = -INFINITY; sc[2][i] = -INFINITY; sc[3][i] = -INFINITY; }
    }
    __syncthreads();
    wave_softmax(sc[h], 1024, lane);
    __syncthreads();
    float os = 0.f;
#pragma unroll 2
    for (int i = 0; i < 1024; ++i) {
        const float p = sc[h][i];
        if (p != 0.f) { const int kp = sel[i >> 6] * 64 + (i & 63); os = fmaf(p, bf2f(cols[(size_t)kp * DINP + OFF_VS + lane]), os); }
    }
    __syncthreads();
    for (int i = tid; i < 512; i += 256) {
        const int kp = pos - 511 + i;
        if (kp >= 0) {
            float d4[4]; dot4(qr, kwr + (size_t)kp * 64, d4);
            sc[0][i] = d4[0] * 0.125f; sc[1][i] = d4[1] * 0.125f; sc[2][i] = d4[2] * 0.125f; sc[3][i] = d4[3] * 0.125f;
        } else { sc[0][i] = -INFINITY; sc[1][i] = -INFINITY; sc[2][i] = -INFINITY; sc[3][i] = -INFINITY; }
    }
    __syncthreads();
    wave_softmax(sc[h], 512, lane);
    __syncthreads();
    float ow = 0.f;
#pragma unroll 4
    for (int i = 0; i < 512; ++i) {
        const int kp = pos - 511 + i;
        if (kp >= 0) ow = fmaf(sc[h][i], bf2f(cols[(size_t)kp * DINP + OFF_VW + lane]), ow);
    }
    const float* gt = gates + (size_t)pos * 12 + h * 3;
    mix[(size_t)pos * DM + 768 + tid] = (bf16)f2bf(gt[0] * oc + gt[1] * os + gt[2] * ow);
}

DEVI void softmax256(float* s, float scale, int bid, float* sm) {
    __syncthreads();
    const size_t row = bid; const int tid = tidx() & 255;
    const float v = s[row * 256 + tid] * scale;
    float m = wave_max(v);
    if ((tid & 63) == 0) sm[8 + (tid >> 6)] = m;
    __syncthreads();
    m = fmaxf(fmaxf(sm[8], sm[9]), fmaxf(sm[10], sm[11]));
    const float p = expf(v - m);
    const float sum = block_sum256(p, sm, tid);
    s[row * 256 + tid] = p / sum;
}

DEVI void router_kernel(const float* __restrict__ x, const float* __restrict__ rw, const float* __restrict__ rb,
                        int* __restrict__ te, float* __restrict__ tw, int bid, float* sm) {
    __syncthreads();
    float (*part)[16] = (float (*)[16])sm;
    const size_t t = bid; const int tid = tidx() & 255;
    float acc[16];
#pragma unroll
    for (int e = 0; e < 16; ++e) acc[e] = 0.f;
#pragma unroll 1
    for (int i = tid; i < DM; i += 256) {
        const float xv = x[t * DM + i];
#pragma unroll
        for (int e = 0; e < 16; ++e) acc[e] = fmaf(xv, rw[i * 16 + e], acc[e]);
    }
#pragma unroll
    for (int e = 0; e < 16; ++e) acc[e] = wave_sum(acc[e]);
    if ((tid & 63) == 0) {
#pragma unroll
        for (int e = 0; e < 16; ++e) part[tid >> 6][e] = acc[e];
    }
    __syncthreads();
    if (tid == 0) {
        float lg[16], pr[16], sl[16];
        float m = -INFINITY;
#pragma unroll
        for (int e = 0; e < 16; ++e) { lg[e] = part[0][e] + part[1][e] + part[2][e] + part[3][e]; m = fmaxf(m, lg[e]); }
        float sum = 0.f;
#pragma unroll
        for (int e = 0; e < 16; ++e) { pr[e] = expf(lg[e] - m); sum += pr[e]; }
#pragma unroll
        for (int e = 0; e < 16; ++e) { pr[e] /= sum; sl[e] = pr[e] + rb[e]; }
        int bg = 0; float bgs = -INFINITY;
#pragma unroll
        for (int gI = 0; gI < 4; ++gI) {
            float m1 = -INFINITY, m2 = -INFINITY;
#pragma unroll
            for (int j = 0; j < 4; ++j) { const float v = sl[gI * 4 + j]; if (v > m1) { m2 = m1; m1 = v; } else if (v > m2) m2 = v; }
            const float sc = m1 + m2;
            if (sc > bgs) { bgs = sc; bg = gI; }
        }
        int e0 = -1, e1 = -1; float s0 = -INFINITY, s1 = -INFINITY, p0 = 0.f, p1 = 0.f;
#pragma unroll
        for (int e = 0; e < 16; ++e) {
            if ((e >> 2) == bg) {
                const float v = sl[e];
                if (v > s0) { s1 = s0; e1 = e0; p1 = p0; s0 = v; e0 = e; p0 = pr[e]; } else if (v > s1) { s1 = v; e1 = e; p1 = pr[e]; }
            }
        }
        const float wsum = p0 + p1;
        te[t * 2] = e0; te[t * 2 + 1] = e1;
        tw[t * 2] = p0 / wsum; tw[t * 2 + 1] = p1 / wsum;
    }
}
DEVI void moe_lists(const int* __restrict__ te, int* __restrict__ off, int* __restrict__ list, int* __restrict__ slotpos, float* sm0) {
    int* cnt = (int*)sm0;
    int* offs = cnt + 16;
    const int w = tidx() >> 6, lane = tidx() & 63;
    __syncthreads();
    for (int ee = 0; ee < 2; ++ee) {
        const int e = w * 2 + ee;
        int c = 0;
        for (int base = 0; base < NTOK; base += 64) {
            const int tok = base + lane;
            const bool m = (te[tok * 2] == e) || (te[tok * 2 + 1] == e);
            c += __popcll(__ballot(m));
        }
        if (lane == 0) cnt[e] = c;
    }
    __syncthreads();
    if (tidx() == 0) {
        int s = 0;
        for (int i = 0; i < 16; ++i) { offs[i] = s; off[i] = s; s += cnt[i]; }
        offs[16] = s; off[16] = s;
    }
    __syncthreads();
    for (int ee = 0; ee < 2; ++ee) {
        const int e = w * 2 + ee;
        int pos = offs[e];
        for (int base = 0; base < NTOK; base += 64) {
            const int tok = base + lane;
            const int a = te[tok * 2], b = te[tok * 2 + 1];
            const bool m = (a == e) || (b == e);
            const unsigned long long mask = __ballot(m);
            if (m) {
                const int p = pos + __popcll(mask & ((1ull << lane) - 1ull));
                list[p] = tok;
                slotpos[tok * 2 + (a == e ? 0 : 1)] = p;
            }
            pos += __popcll(mask);
        }
    }
    __syncthreads();
}
DEVI void moe_combine_ln(const float* x, const float* __restrict__ Dp, const int* __restrict__ te,
                         const float* __restrict__ tw, const int* __restrict__ slotpos,
                         const float* __restrict__ g, const float* __restrict__ bt, float* out, bf16* outb, int bid, float* sm) {
    __syncthreads();
    const size_t t = bid; const int tid = tidx() & 255;
    int ea = te[t * 2], eb = te[t * 2 + 1];
    float wa = tw[t * 2], wb = tw[t * 2 + 1];
    size_t pa = slotpos[t * 2], pb = slotpos[t * 2 + 1];
    if (eb < ea) { const float tf = wa; wa = wb; wb = tf; const size_t tp = pa; pa = pb; pb = tp; }
    float v[4];
#pragma unroll
    for (int i = 0; i < 4; ++i) {
        const int c = tid + i * 256;
        float y = wa * Dp[pa * DM + c];
        y = y + wb * Dp[pb * DM + c];
        v[i] = ALPHA * x[t * DM + c] + y;
    }
    const float mean = block_sum256(v[0] + v[1] + v[2] + v[3], sm, tid) * (1.f / DM);
    float q = 0.f;
#pragma unroll
    for (int i = 0; i < 4; ++i) { v[i] -= mean; q += v[i] * v[i]; }
    const float var = block_sum256(q, sm, tid) * (1.f / DM);
    const float rstd = rsqrtf(var + 1e-5f);
#pragma unroll
    for (int i = 0; i < 4; ++i) {
        const int c = tid + i * 256;
        const float o = v[i] * rstd * g[c] + bt[c];
        out[t * DM + c] = o;
        outb[t * DM + c] = (bf16)f2bf(o);
    }
}
typedef short bf16x8 __attribute__((ext_vector_type(8)));
typedef short s16x4 __attribute__((ext_vector_type(4)));
typedef float f32x16 __attribute__((ext_vector_type(16)));
typedef float f32x2_t __attribute__((ext_vector_type(2)));
typedef __bf16 bf16x2_t __attribute__((ext_vector_type(2)));
DEVI unsigned cvtpk(float lo, float hi) { f32x2_t v = {lo, hi}; bf16x2_t b = __builtin_convertvector(v, bf16x2_t); return __builtin_bit_cast(unsigned, b); }
constexpr float QSCL = 0.125f * 1.4426950408889634f;

struct NsaP {
    const bf16 *QN, *QR, *KSR, *KWR, *VST, *VWT, *KCMP, *VCMPT;
    const float* GATES;
    bf16* MIX;
};
constexpr int NSA_KT = 0, NSA_VT = 16384, NSA_IA = 32768, NSA_IB = 65536, NSA_SELM = 98304, NSA_UNI = 99328;

DEVI int crow(int r, int hi) { return (r & 3) + 8 * (r >> 2) + 4 * hi; }
DEVI float max3f(float a, float b, float c) { float r; asm("v_max3_f32 %0, %1, %2, %3" : "=v"(r) : "v"(a), "v"(b), "v"(c)); return r; }
DEVI float max2f(float a, float b) { float r; asm("v_max_f32_e32 %0, %1, %2" : "=v"(r) : "v"(a), "v"(b)); return r; }
DEVI float half_max(float x) { auto rr = __builtin_amdgcn_permlane32_swap(__float_as_uint(x), __float_as_uint(x), false, false); return max2f(__uint_as_float(rr[0]), __uint_as_float(rr[1])); }
DEVI float half_sum(float x) { auto rr = __builtin_amdgcn_permlane32_swap(__float_as_uint(x), __float_as_uint(x), false, false); return __uint_as_float(rr[0]) + __uint_as_float(rr[1]); }
DEVI float quad_sum(float x) {
    x += __int_as_float(__builtin_amdgcn_update_dpp(0, __float_as_int(x), 0xB1, 0xF, 0xF, true));
    x += __int_as_float(__builtin_amdgcn_update_dpp(0, __float_as_int(x), 0x4E, 0xF, 0xF, true));
    return x;
}
DEVI float rowmax32(const f32x16& p0, const f32x16& p1) {
    float a = max3f(p0[0], p0[1], p1[0]), b = max3f(p0[2], p0[3], p1[1]); a = max3f(a, p1[2], p1[3]);
#pragma unroll
    for (int r = 4; r < 16; r += 4) { a = max3f(a, p0[r], p0[r + 1]); b = max3f(b, p0[r + 2], p0[r + 3]); a = max3f(a, p1[r], p1[r + 1]); b = max3f(b, p1[r + 2], p1[r + 3]); }
    return half_max(max2f(a, b));
}

DEVI void nsa_ld(v4u& rk, v4u& rv, const bf16* kbase, const bf16* vbase, size_t vstride, int tid) {
    rk = *(const v4u*)((const char*)kbase + tid * 16);
    rv = *(const v4u*)((const char*)(vbase + (size_t)(tid >> 3) * vstride) + (tid & 7) * 16);
}
DEVI void nsa_st(LAS unsigned char* KTb, LAS unsigned char* VTb, const v4u& rk, const v4u& rv, int tid) {
    typedef unsigned u32x2s __attribute__((ext_vector_type(2)));
    const int r = tid >> 3, c = tid & 7, f = (r >> 1) & 7;
    *(LAS v4u*)(KTb + r * 128 + ((c ^ f) << 4)) = rk;
    const int G = c >> 1, o8 = (c & 1) * 8;
    *(LAS u32x2s*)(VTb + r * 128 + (((2 * G) ^ f) << 4) + o8) = (u32x2s){rv.x, rv.y};
    *(LAS u32x2s*)(VTb + r * 128 + (((2 * G + 1) ^ f) << 4) + o8) = (u32x2s){rv.z, rv.w};
}
DEVI void nsa_qk(f32x16& p0, f32x16& p1, const LAS unsigned char* KTb, const bf16x8 (&qf)[4], int q32, int hi) {
#pragma unroll
    for (int r = 0; r < 16; ++r) { p0[r] = 0.f; p1[r] = 0.f; }
    const int f = (q32 >> 1) & 7;
#pragma unroll
    for (int ks = 0; ks < 4; ++ks) {
        const int c = ((2 * ks + hi) ^ f) << 4;
        const bf16x8 a0 = *(const LAS bf16x8*)(KTb + q32 * 128 + c);
        const bf16x8 a1 = *(const LAS bf16x8*)(KTb + (32 + q32) * 128 + c);
        p0 = __builtin_amdgcn_mfma_f32_32x32x16_bf16(a0, qf[ks], p0, 0, 0, 0);
        p1 = __builtin_amdgcn_mfma_f32_32x32x16_bf16(a1, qf[ks], p1, 0, 0, 0);
    }
}
DEVI void nsa_pv(f32x16 (&o)[2], const LAS unsigned char* VTb, const bf16x8 (&pf)[4], int q32, int hi) {
    const int f = (q32 >> 1) & 7;
#pragma unroll
    for (int db = 0; db < 2; ++db) {
        const LAS unsigned char* rowp = VTb + (32 * db + q32) * 128;
#pragma unroll
        for (int s = 0; s < 4; ++s) {
            const bf16x8 a = *(const LAS bf16x8*)(rowp + (((2 * s + hi) ^ f) << 4));
            o[db] = __builtin_amdgcn_mfma_f32_32x32x16_bf16(a, pf[s], o[db], 0, 0, 0);
        }
    }
}
DEVI void nsa_pack(bf16x8 (&pf)[4], const f32x16& p0, const f32x16& p1) {
#pragma unroll
    for (int s = 0; s < 2; ++s) {
        unsigned w0[4], w1[4];
#pragma unroll
        for (int j = 0; j < 4; ++j) { w0[j] = cvtpk(p0[8 * s + 2 * j], p0[8 * s + 2 * j + 1]); w1[j] = cvtpk(p1[8 * s + 2 * j], p1[8 * s + 2 * j + 1]); }
        pf[s] = __builtin_bit_cast(bf16x8, (v4u){w0[0], w0[1], w0[2], w0[3]});
        pf[2 + s] = __builtin_bit_cast(bf16x8, (v4u){w1[0], w1[1], w1[2], w1[3]});
    }
}
DEVI void nsa_softmax(f32x16& p0, f32x16& p1, float& m, float& l, f32x16 (&o)[2], bf16x8 (&pf)[4]) {
    typedef float f2 __attribute__((ext_vector_type(2)));
    const float mx = rowmax32(p0, p1);
    if (__any(mx > m + 8.f)) {
        const float mn = fmaxf(m, mx);
        const float msn = (mn == -INFINITY) ? 0.f : mn;
        const float alpha = __builtin_amdgcn_exp2f(m - msn);
        l *= alpha; m = mn;
#pragma unroll
        for (int r = 0; r < 16; ++r) { o[0][r] *= alpha; o[1][r] *= alpha; }
    }
    const float ms = (m == -INFINITY) ? 0.f : m;
    f2 sum = {0.f, 0.f};
#pragma unroll
    for (int r = 0; r < 16; r += 2) {
        f2 x0 = {p0[r], p0[r + 1]}, x1 = {p1[r], p1[r + 1]};
        x0 = x0 - ms; x1 = x1 - ms;
        x0.x = __builtin_amdgcn_exp2f(x0.x); x0.y = __builtin_amdgcn_exp2f(x0.y); x1.x = __builtin_amdgcn_exp2f(x1.x); x1.y = __builtin_amdgcn_exp2f(x1.y);
        sum = sum + x0 + x1;
        p0[r] = x0.x; p0[r + 1] = x0.y; p1[r] = x1.x; p1[r + 1] = x1.y;
    }
    l += half_sum(sum.x + sum.y);
    nsa_pack(pf, p0, p1);
}
DEVI void nsa_loadq(bf16x8 (&qf)[4], const bf16* Q, int tq, int head, int hi) {
    const bf16* qp = Q + (size_t)tq * 256 + head * 64 + 8 * hi;
#pragma unroll
    for (int ks = 0; ks < 4; ++ks) qf[ks] = *(const bf16x8*)(qp + 16 * ks);
}


#define NSA_PIPE(NT_, KP_, VP_, VSTR_, ...) do { \
    const int nt_ = (NT_); v4u rk0_, rv0_, rk1_, rv1_; \
    if (nt_ > 0) nsa_ld(rk0_, rv0_, KP_(0), VP_(0), VSTR_, tid); \
    if (nt_ > 1) nsa_ld(rk1_, rv1_, KP_(1), VP_(1), VSTR_, tid); \
    __syncthreads(); \
    if (nt_ > 0) nsa_st(KT, VT, rk0_, rv0_, tid); \
    __syncthreads(); \
    if (nt_ > 2) nsa_ld(rk0_, rv0_, KP_(2), VP_(2), VSTR_, tid); \
    for (int it0_ = 0; it0_ < nt_; it0_ += 2) { \
        { const int it_ = it0_; const int bo_ = 0; __VA_ARGS__ } \
        if (it0_ + 1 < nt_) nsa_st(KT + 8192, VT + 8192, rk1_, rv1_, tid); \
        __syncthreads(); \
        if (it0_ + 3 < nt_) nsa_ld(rk1_, rv1_, KP_(it0_ + 3), VP_(it0_ + 3), VSTR_, tid); \
        if (it0_ + 1 >= nt_) break; \
        { const int it_ = it0_ + 1; const int bo_ = 8192; __VA_ARGS__ } \
        if (it0_ + 2 < nt_) nsa_st(KT, VT, rk0_, rv0_, tid); \
        __syncthreads(); \
        if (it0_ + 4 < nt_) nsa_ld(rk0_, rv0_, KP_(it0_ + 4), VP_(it0_ + 4), VSTR_, tid); \
    } } while (0)

DEVI int nsa_split(int cur) { return (cur + 10) >> 1; }
DEVI void nsa_unit(const NsaP& P, int u, LAS unsigned char* lds, int kind, unsigned* part) {
    const int tid = tidx(), w = tid >> 6, lane = tid & 63, q32 = lane & 31, hi = lane >> 5;
    const int t0 = u * 64, cur = u;
    const int tl = 8 * w + (q32 >> 2), head = q32 & 3, tq = t0 + tl;
    LAS unsigned char* KT = lds + NSA_KT; LAS unsigned char* VT = lds + NSA_VT;
    LAS float* IA = (LAS float*)(lds + NSA_IA); LAS float* IB = (LAS float*)(lds + NSA_IB);
    LAS unsigned* SELM = (LAS unsigned*)(lds + NSA_SELM); LAS unsigned* UNI = (LAS unsigned*)(lds + NSA_UNI);
    __syncthreads();
    for (int i = tid; i < 2 * 64 * 128; i += 512) IA[i] = 0.f;
    if (tid < 4) UNI[tid] = 0u;
    LAS float* ACC = (LAS float*)(lds + NSA_IA) + (w * 32) * 64 + lane;
    bf16x8 qf[4], pf[4];
    f32x16 o[2], p0, p1;

    {
        nsa_loadq(qf, P.QN, tq, head, hi);
        const int nlim = tq >= 31 ? (tq - 31) >> 4 : -1;
        const int nmaxu = (t0 + 63 - 31) >> 4;
        const int nct = (nmaxu >> 6) + 1;
        float m = -INFINITY, l = 0.f;
        for (int pass = 0; pass < 2; ++pass) {
#pragma unroll
            for (int r = 0; r < 16; ++r) { o[0][r] = 0.f; o[1][r] = 0.f; }
            const float rl = (pass == 1 && l > 0.f) ? 1.f / l : 0.f;
#define KPC_(i) (P.KCMP + (size_t)(i) * 64 * 64)
#define VPC_(i) (P.VCMPT + (i) * 64)
            NSA_PIPE(nct, KPC_, VPC_, 512, {
                nsa_qk(p0, p1, KT + bo_, qf, q32, hi);
                const int nb = it_ * 64;
                if (__any(nb + 63 > nlim)) {
                    const int lim = nlim - nb - 4 * hi;
_Pragma("unroll")
                    for (int r = 0; r < 16; ++r) { const int c0 = (r & 3) + 8 * (r >> 2); if (c0 > lim) p0[r] = -INFINITY; if (c0 + 32 > lim) p1[r] = -INFINITY; }
                }
                if (pass == 0) {
                    const float mx = rowmax32(p0, p1);
                    const float mn = fmaxf(m, mx), ms = (mn == -INFINITY) ? 0.f : mn;
                    float sum = 0.f;
_Pragma("unroll")
                    for (int r = 0; r < 16; ++r) sum += __builtin_amdgcn_exp2f(p0[r] - ms) + __builtin_amdgcn_exp2f(p1[r] - ms);
                    sum = half_sum(sum);
                    l = l * __builtin_amdgcn_exp2f(m - ms) + sum; m = mn;
                } else {
                    const float ms = (m == -INFINITY) ? 0.f : m;
_Pragma("unroll")
                    for (int r = 0; r < 16; ++r) { p0[r] = __builtin_amdgcn_exp2f(p0[r] - ms) * rl; p1[r] = __builtin_amdgcn_exp2f(p1[r] - ms) * rl; }
_Pragma("unroll")
                    for (int half = 0; half < 2; ++half) {
_Pragma("unroll")
                        for (int g = 0; g < 4; ++g) {
                            const f32x16& pp = half ? p1 : p0;
                            float a = pp[4 * g] + pp[4 * g + 1] + pp[4 * g + 2] + 0.5f * pp[4 * g + 3];
                            float b = 0.5f * pp[4 * g + 3];
                            a = quad_sum(a); b = quad_sum(b);
                            const int j = (nb + 32 * half + 8 * g + 4 * hi) >> 2;
                            if (head == 0 && j < 128) { IA[tl * 128 + j] = a; IB[tl * 128 + j] = b; }
                        }
                    }
                    nsa_pack(pf, p0, p1);
                    nsa_pv(o, VT + bo_, pf, q32, hi);
                }
            });
        }
        { const float g_c = P.GATES[(size_t)tq * 12 + head * 3 + 0];
#pragma unroll
        for (int r = 0; r < 16; ++r) { o[0][r] *= g_c; o[1][r] *= g_c; } }
    }
    REP(26)
    for (int tt = 0; tt < 8; ++tt) {
        const int tok = 8 * w + tt;
        unsigned k0, k1;
        {
            const int j0 = lane, j1 = lane + 64;
            const float i0f = IA[tok * 128 + j0] + (j0 > 0 ? IB[tok * 128 + j0 - 1] : 0.f), i1f = IA[tok * 128 + j1] + IB[tok * 128 + j1 - 1];
            k0 = (j0 == cur || j0 == 0) ? 0x7f800001u : (j0 <= cur ? __float_as_uint(i0f) + 1u : 0u);
            k1 = (j1 == cur) ? 0x7f800001u : (j1 <= cur ? __float_as_uint(i1f) + 1u : 0u);
        }
        unsigned T = 0u;
#pragma unroll 1
        for (int bit = 30; bit >= 0; --bit) {
            const unsigned cand = T | (1u << bit);
            const int cnt = __popcll(__ballot(k0 >= cand)) + __popcll(__ballot(k1 >= cand));
            if (cnt >= 16) T = cand;
        }
        const unsigned long long gt0 = __ballot(k0 > T), gt1 = __ballot(k1 > T), eq0 = __ballot(k0 == T), eq1 = __ballot(k1 == T);
        const int need = 16 - (__popcll(gt0) + __popcll(gt1));
        const unsigned long long lt = (1ull << lane) - 1ull;
        const bool s0_ = (k0 > T) || ((k0 == T) && __popcll(eq0 & lt) < need);
        const bool s1_ = (k1 > T) || ((k1 == T) && (__popcll(eq0) + __popcll(eq1 & lt)) < need);
        const unsigned long long b0 = __ballot(s0_), b1 = __ballot(s1_);
        if (lane == 0) {
            const unsigned m0 = (unsigned)b0, m1 = (unsigned)(b0 >> 32), m2 = (unsigned)b1, m3 = (unsigned)(b1 >> 32);
            SELM[tok * 4 + 0] = m0; SELM[tok * 4 + 1] = m1; SELM[tok * 4 + 2] = m2; SELM[tok * 4 + 3] = m3;
            __hip_atomic_fetch_or(&UNI[0], m0, __ATOMIC_RELAXED, __HIP_MEMORY_SCOPE_WORKGROUP); __hip_atomic_fetch_or(&UNI[1], m1, __ATOMIC_RELAXED, __HIP_MEMORY_SCOPE_WORKGROUP);
            __hip_atomic_fetch_or(&UNI[2], m2, __ATOMIC_RELAXED, __HIP_MEMORY_SCOPE_WORKGROUP); __hip_atomic_fetch_or(&UNI[3], m3, __ATOMIC_RELAXED, __HIP_MEMORY_SCOPE_WORKGROUP);
        }
    }
    __syncthreads();
#pragma unroll
    for (int r = 0; r < 16; ++r) { ACC[r * 64] = o[0][r]; ACC[(16 + r) * 64] = o[1][r]; }
    {
        nsa_loadq(qf, P.QR, tq, head, hi);
        const unsigned s0 = SELM[tl * 4 + 0], s1 = SELM[tl * 4 + 1], s2 = SELM[tl * 4 + 2], s3 = SELM[tl * 4 + 3];
        unsigned u0 = UNI[0], u1 = UNI[1], u2 = UNI[2], u3 = UNI[3];
        if (kind != 0) {
            const int js = nsa_split(cur);
            const unsigned g0 = js >= 32 ? 0u : (0xffffffffu << js), g1 = js >= 64 ? 0u : (js <= 32 ? 0xffffffffu : (0xffffffffu << (js - 32))),
                           g2 = js >= 96 ? 0u : (js <= 64 ? 0xffffffffu : (0xffffffffu << (js - 64))), g3 = js <= 96 ? 0xffffffffu : (0xffffffffu << (js - 96));
            if (kind == 1) { u0 &= g0; u1 &= g1; u2 &= g2; u3 &= g3; } else { u0 &= ~g0; u1 &= ~g1; u2 &= ~g2; u3 &= ~g3; }
        }
        float m = -INFINITY, l = 0.f;
        LAS unsigned char* TL = (LAS unsigned char*)(lds + NSA_UNI + 16);
        int ntl;
        {
            const unsigned lt0 = cur >= 31 ? 0xffffffffu : ((2u << cur) - 1u), lt1 = cur < 32 ? 0u : (cur >= 63 ? 0xffffffffu : ((2u << (cur - 32)) - 1u)),
                           lt2 = cur < 64 ? 0u : (cur >= 95 ? 0xffffffffu : ((2u << (cur - 64)) - 1u)), lt3 = cur < 96 ? 0u : (cur >= 127 ? 0xffffffffu : ((2u << (cur - 96)) - 1u));
            const unsigned v0 = u0 & lt0, v1 = u1 & lt1, v2 = u2 & lt2, v3 = u3 & lt3;
            ntl = __popc(v0) + __popc(v1) + __popc(v2) + __popc(v3);
            if (tid < 128) {
                const int jj = tid, wq = jj >> 5; const unsigned bit = 1u << (jj & 31), below = bit - 1u;
                const unsigned vw = wq == 0 ? v0 : (wq == 1 ? v1 : (wq == 2 ? v2 : v3));
                if (vw & bit) {
                    const int pos = (wq > 0 ? __popc(v0) : 0) + (wq > 1 ? __popc(v1) : 0) + (wq > 2 ? __popc(v2) : 0) + __popc(vw & below);
                    TL[pos] = (unsigned char)jj;
                }
            }
        }
        __syncthreads();
#define KPS_(i) (P.KSR + (size_t)TL[i] * 64 * 64)
#define VPS_(i) (P.VST + (int)TL[i] * 64)
        REP(25) {
        m = -INFINITY; l = 0.f;
#pragma unroll
        for (int r = 0; r < 16; ++r) { o[0][r] = 0.f; o[1][r] = 0.f; }
        NSA_PIPE(ntl, KPS_, VPS_, SEQ, {
            const int j = TL[it_];
            const unsigned wv = j < 32 ? s0 : (j < 64 ? s1 : (j < 96 ? s2 : s3));
            const bool mine = (wv >> (j & 31)) & 1u;
            if (__any(mine)) {
                nsa_qk(p0, p1, KT + bo_, qf, q32, hi);
                if (j == cur || !__all(mine)) {
                    const int klim = (mine ? (j == cur ? (tq & 63) : 63) : -1) - 4 * hi;
_Pragma("unroll")
                    for (int r = 0; r < 16; ++r) { const int c0 = (r & 3) + 8 * (r >> 2); if (c0 > klim) p0[r] = -INFINITY; if (c0 + 32 > klim) p1[r] = -INFINITY; }
                }
                nsa_softmax(p0, p1, m, l, o, pf);
                nsa_pv(o, VT + bo_, pf, q32, hi);
            }
        });
        }
        if (kind == 0) {
            const float g_s = P.GATES[(size_t)tq * 12 + head * 3 + 1];
            const float sc = l > 0.f ? g_s / l : 0.f;
#pragma unroll
            for (int r = 0; r < 16; ++r) { ACC[r * 64] += sc * o[0][r]; ACC[(16 + r) * 64] += sc * o[1][r]; }
        } else {
            unsigned* pp = part + ((size_t)(kind - 1) * 8 + w) * 18 * 64 + lane;
#pragma unroll
            for (int db = 0; db < 2; ++db)
#pragma unroll
                for (int g = 0; g < 8; ++g) pp[(db * 8 + g) * 64] = cvtpk(o[db][2 * g], o[db][2 * g + 1]);
            pp[16 * 64] = __float_as_uint(m); pp[17 * 64] = __float_as_uint(l);
        }
    }
    if (kind == 2) return;
    {
        float m = -INFINITY, l = 0.f;
#pragma unroll
        for (int r = 0; r < 16; ++r) { o[0][r] = 0.f; o[1][r] = 0.f; }
        const int j0 = cur >= 8 ? cur - 8 : 0;
#define KPW_(i) (P.KWR + (size_t)(j0 + (i)) * 64 * 64)
#define VPW_(i) (P.VWT + (j0 + (i)) * 64)
        NSA_PIPE(cur - j0 + 1, KPW_, VPW_, SEQ, {
            const int j = j0 + it_;
            nsa_qk(p0, p1, KT + bo_, qf, q32, hi);
            if (j == cur || j + 8 == cur) {
                const int hiA = tq - j * 64 - 4 * hi, loA = hiA - 512;
_Pragma("unroll")
                for (int r = 0; r < 16; ++r) {
                    const int c0 = (r & 3) + 8 * (r >> 2);
                    if (c0 > hiA || c0 <= loA) p0[r] = -INFINITY;
                    if (c0 + 32 > hiA || c0 + 32 <= loA) p1[r] = -INFINITY;
                }
            }
            nsa_softmax(p0, p1, m, l, o, pf);
            nsa_pv(o, VT + bo_, pf, q32, hi);
        });
        const float g_w = P.GATES[(size_t)tq * 12 + head * 3 + 2];
        const float sc = l > 0.f ? g_w / l : 0.f;
#pragma unroll
        for (int r = 0; r < 16; ++r) { o[0][r] = ACC[r * 64] + sc * o[0][r]; o[1][r] = ACC[(16 + r) * 64] + sc * o[1][r]; }
    }
    if (kind == 1) {
        unsigned* pp = part + ((size_t)2 * 8 + w) * 18 * 64 + lane;
#pragma unroll
        for (int db = 0; db < 2; ++db)
#pragma unroll
            for (int g = 0; g < 8; ++g) pp[(db * 8 + g) * 64] = cvtpk(o[db][2 * g], o[db][2 * g + 1]);
        return;
    }
    {
        bf16* op = P.MIX + (size_t)tq * DM + 768 + head * 64 + 4 * hi;
#pragma unroll
        for (int db = 0; db < 2; ++db)
#pragma unroll
            for (int g = 0; g < 4; ++g) {
                const unsigned lo = cvtpk(o[db][4 * g], o[db][4 * g + 1]), h2 = cvtpk(o[db][4 * g + 2], o[db][4 * g + 3]);
                *(uint2*)(op + 32 * db + 8 * g) = make_uint2(lo, h2);
            }
    }
}

DEVI void nsa_combine(const NsaP& P, int u, int w, int lane, const unsigned* part) {
    const int q32 = lane & 31, hi = lane >> 5, tl = 8 * w + (q32 >> 2), head = q32 & 3, tq = u * 64 + tl;
    const unsigned* pa = part + ((size_t)1 * 8 + w) * 18 * 64 + lane;
    const unsigned* pb = part + ((size_t)0 * 8 + w) * 18 * 64 + lane;
    const unsigned* pc = part + ((size_t)2 * 8 + w) * 18 * 64 + lane;
    const float ma = __uint_as_float(pa[16 * 64]), la = __uint_as_float(pa[17 * 64]), mb = __uint_as_float(pb[16 * 64]), lb = __uint_as_float(pb[17 * 64]);
    const float mm = fmaxf(ma, mb), ms = (mm == -INFINITY) ? 0.f : mm;
    const float wa = __builtin_amdgcn_exp2f(ma - ms), wb = __builtin_amdgcn_exp2f(mb - ms);
    const float l = la * wa + lb * wb;
    const float g_s = P.GATES[(size_t)tq * 12 + head * 3 + 1];
    const float sc = l > 0.f ? g_s / l : 0.f;
    bf16* op = P.MIX + (size_t)tq * DM + 768 + head * 64 + 4 * hi;
#pragma unroll
    for (int db = 0; db < 2; ++db)
#pragma unroll
        for (int g = 0; g < 4; ++g) {
            float v[4];
#pragma unroll
            for (int e = 0; e < 2; ++e) {
                const unsigned xa = pa[(db * 8 + 2 * g + e) * 64], xb = pb[(db * 8 + 2 * g + e) * 64], xc = pc[(db * 8 + 2 * g + e) * 64];
                v[2 * e] = __uint_as_float(xc << 16) + sc * (wa * __uint_as_float(xa << 16) + wb * __uint_as_float(xb << 16));
                v[2 * e + 1] = __uint_as_float(xc & 0xffff0000u) + sc * (wa * __uint_as_float(xa & 0xffff0000u) + wb * __uint_as_float(xb & 0xffff0000u));
            }
            *(uint2*)(op + 32 * db + 8 * g) = make_uint2(cvtpk(v[0], v[1]), cvtpk(v[2], v[3]));
        }
}

DEVI void nsa_prep2(const bf16* __restrict__ cols, bf16* __restrict__ qn, bf16* __restrict__ qr, bf16* __restrict__ ksr, bf16* __restrict__ kwr,
                    bf16* __restrict__ vst, bf16* __restrict__ vwt, float* __restrict__ gates, int bid) {
    const int t = bid, c = tidx() & 255;
    const int d = c & 63, j = d & 31;
    const float inv = powf(10000.f, -(float)j / 32.f);
    const float ang = (float)t * inv;
    float sn, cs; sincosf(ang, &sn, &cs);
    {
        const bf16* q = cols + (size_t)t * DINP + OFF_Q + (c & ~63);
        const float x1 = bf2f(q[j]), x2 = bf2f(q[j + 32]);
        qn[(size_t)t * 256 + c] = (bf16)f2bf(bf2f(q[d]) * QSCL);
        qr[(size_t)t * 256 + c] = (bf16)f2bf((d < 32 ? x1 * cs - x2 * sn : x2 * cs + x1 * sn) * QSCL);
    }
    if (c < 128) {
        const bf16* kp = cols + (size_t)t * DINP + (c < 64 ? OFF_KS : OFF_KW);
        const float x1 = bf2f(kp[j]), x2 = bf2f(kp[j + 32]);
        const float v = d < 32 ? x1 * cs - x2 * sn : x2 * cs + x1 * sn;
        if (c < 64) ksr[(size_t)t * 64 + d] = (bf16)f2bf(v); else kwr[(size_t)t * 64 + d] = (bf16)f2bf(v);
    } else {
        const bf16 v = cols[(size_t)t * DINP + (c < 192 ? OFF_VS : OFF_VW) + d];
        if (c < 192) vst[(size_t)d * SEQ + t] = v; else vwt[(size_t)d * SEQ + t] = v;
    }
    if (c < 12) gates[(size_t)t * 12 + c] = sigm(bf2f(cols[(size_t)t * DINP + OFF_GT + c]));
}
DEVI void nsa_cmp_cvt(const float* __restrict__ kc, const float* __restrict__ vc, bf16* __restrict__ kcb, bf16* __restrict__ vct, int bid) {
    const int i = bid * 256 + (tidx() & 255);
    if (i < 512 * 64) {
        const int n = i >> 6, d = i & 63;
        kcb[i] = n < NCMP ? (bf16)f2bf(kc[i]) : (bf16)0;
        vct[d * 512 + n] = n < NCMP ? (bf16)f2bf(vc[i]) : (bf16)0;
    }
}
DEVI float4 ld4bf(const bf16* p);
constexpr int RW_SLOT = 8192;
typedef unsigned u32x2v __attribute__((ext_vector_type(2)));
DEVI int rw_off(int row, int chunk16) { return row * 128 + ((chunk16 ^ (row & 7)) << 4); }
DEVI void rw_ld(LAS unsigned char* slot, const bf16* g, int gt) {
#pragma unroll
    for (int e = 0; e < 2; ++e) { const int idx = gt + 256 * e, row = idx >> 3, ch = idx & 7;
        *(LAS v4u*)(slot + rw_off(row, ch)) = *(const v4u*)((const char*)g + idx * 16); }
}
DEVI void rw_ldT(LAS unsigned char* slot, const bf16* g, size_t gstride, int gt) {
#pragma unroll
    for (int e = 0; e < 2; ++e) { const int idx = gt + 256 * e, row = idx >> 3, ch = idx & 7;
        const v4u v = *(const v4u*)(g + (size_t)row * gstride + ch * 8);
        const unsigned w[4] = {v.x, v.y, v.z, v.w};
#pragma unroll
        for (int j = 0; j < 8; ++j) { const int col = ch * 8 + j; const unsigned short h = (unsigned short)(w[j >> 1] >> ((j & 1) * 16));
            *(LAS unsigned short*)(slot + rw_off(col, row >> 3) + (row & 7) * 2) = h; }
    }
}
DEVI bf16x8 rw_frag(const LAS unsigned char* slot, int blk, int s, int r32, int hi) {
    return *(const LAS bf16x8*)(slot + rw_off(32 * blk + r32, 2 * s + hi));
}
DEVI void rw_mm(f32x16& acc, const LAS unsigned char* slotA, int rb, const LAS unsigned char* slotBT, int cb, int r32, int hi) {
#pragma unroll
    for (int s = 0; s < 4; ++s) acc = __builtin_amdgcn_mfma_f32_32x32x16_bf16(rw_frag(slotA, rb, s, r32, hi), rw_frag(slotBT, cb, s, r32, hi), acc, 0, 0, 0);
}
DEVI void rw_stT(LAS unsigned char* slot, const f32x16& acc, int rb, int cb, int r32, int hi) {
    const int j = 32 * cb + r32;
#pragma unroll
    for (int g = 0; g < 4; ++g) {
        const u32x2v w = {cvtpk(acc[4 * g], acc[4 * g + 1]), cvtpk(acc[4 * g + 2], acc[4 * g + 3])};
        *(LAS u32x2v*)(slot + rw_off(j, 4 * rb + g) + 8 * hi) = w;
    }
}
DEVI void rw_st(LAS unsigned char* slot, const f32x16& acc, int rb, int cb, int r32, int hi) {
    const int j = 32 * cb + r32;
#pragma unroll
    for (int r = 0; r < 16; ++r) { const int i = 32 * rb + crow(r, hi);
        *(LAS unsigned short*)(slot + rw_off(i, j >> 3) + (j & 7) * 2) = (unsigned short)f2bf(acc[r]); }
}
DEVI void rw_ldaccT(f32x16& acc, const LAS unsigned char* slot, int rb, int cb, int r32, int hi) {
    const int j = 32 * cb + r32;
#pragma unroll
    for (int g = 0; g < 4; ++g) {
        const u32x2v w = *(const LAS u32x2v*)(slot + rw_off(j, 4 * rb + g) + 8 * hi);
        acc[4 * g] = __builtin_bit_cast(float, w.x << 16); acc[4 * g + 1] = __builtin_bit_cast(float, w.x & 0xffff0000u);
        acc[4 * g + 2] = __builtin_bit_cast(float, w.y << 16); acc[4 * g + 3] = __builtin_bit_cast(float, w.y & 0xffff0000u);
    }
}
DEVI void rw_zero(f32x16& a) {
#pragma unroll
    for (int r = 0; r < 16; ++r) a[r] = 0.f;
}
DEVI void rw_frags(v4u& f0, v4u& f1, const f32x16& a) {
    f0 = (v4u){cvtpk(a[0], a[1]), cvtpk(a[2], a[3]), cvtpk(a[4], a[5]), cvtpk(a[6], a[7])};
    f1 = (v4u){cvtpk(a[8], a[9]), cvtpk(a[10], a[11]), cvtpk(a[12], a[13]), cvtpk(a[14], a[15])};
}

struct RwP {
    const bf16 *R, *K, *V, *A, *B;
    const float* LW; const bf16 *G, *BON;
    bf16 *AT, *BT, *KT, *RT;
    float* LAM;
    v4u *PF, *HF;
    float *QT, *OL;
    v4u* SF;
    const float *gn_g, *gn_b;
    bf16* MIX;
};

DEVI void rw_r1b(const RwP& P, int c, LAS unsigned char* lds) {
    LAS float* cum = (LAS float*)lds;
    const int tid = tidx();
    __syncthreads();
    if (tid < 256) {
        float s = 0.f;
#pragma unroll 8
        for (int t = 0; t < 64; ++t) { s += P.LW[(size_t)(c * 64 + t) * 256 + tid]; cum[t * 256 + tid] = s; }
    }
    __syncthreads();
    for (int e = tid; e < 64 * 256; e += 512) {
        const int t = e >> 8, ch = e & 255, h = ch >> 6, k = ch & 63;
        const size_t gi = (size_t)(c * 64 + t) * 256 + ch;
        const float cu = cum[e], lw = P.LW[gi];
        const float ein = __expf(cu), eout = __expf(-cu), eex = __expf(cu - lw);
        const size_t o = ((size_t)(c * 4 + h) * 64 + t) * 64 + k;
        P.AT[o] = (bf16)f2bf(bf2f(P.A[gi]) * eex);
        P.BT[o] = (bf16)f2bf(bf2f(P.B[gi]) * eout);
        P.KT[o] = (bf16)f2bf(bf2f(P.K[gi]) * eout);
        P.RT[o] = (bf16)f2bf(bf2f(P.R[gi]) * ein);
        if (t == 63) P.LAM[(size_t)(c * 4 + h) * 64 + k] = ein;
    }
}

DEVI void rw_r2(const RwP& P, int u0, LAS unsigned char* lds) {
    const int tid = tidx(), grp = tid >> 8, gt = tid & 255, gw = (tid >> 6) & 3, lane = tid & 63, r32 = lane & 31, hi = lane >> 5;
    const int rb = gw >> 1, cb = gw & 1;
    const int u = u0 + grp, c = u >> 2, h = u & 3;
    LAS unsigned char* sl = lds + grp * 65536;
#define SL(i) (sl + (i) * RW_SLOT)
    __syncthreads();
    rw_ldT(SL(0), P.BT + (size_t)u * 4096, 64, gt); rw_ldT(SL(1), P.AT + (size_t)u * 4096, 64, gt);
    rw_ldT(SL(2), P.KT + (size_t)u * 4096, 64, gt); rw_ldT(SL(3), P.RT + (size_t)u * 4096, 64, gt);
    __syncthreads();
    f32x16 aMab, aMak, aNbr, aNkr;
    rw_zero(aMab); rw_zero(aMak); rw_zero(aNbr); rw_zero(aNkr);
    rw_mm(aMab, SL(0), rb, SL(1), cb, r32, hi);
    rw_mm(aMak, SL(2), rb, SL(1), cb, r32, hi);
    rw_mm(aNbr, SL(0), rb, SL(3), cb, r32, hi);
    rw_mm(aNkr, SL(2), rb, SL(3), cb, r32, hi);
    {
        const int t = 32 * cb + r32;
#pragma unroll
        for (int r = 0; r < 16; ++r) { const int i = 32 * rb + crow(r, hi);
            if (!(i < t)) { aMab[r] = 0.f; aMak[r] = 0.f; }
            if (!(i <= t)) { aNbr[r] = 0.f; aNkr[r] = 0.f; } }
    }
    __syncthreads();
    rw_st(SL(4), aMab, rb, cb, r32, hi);
    rw_stT(SL(5), aMab, rb, cb, r32, hi);
    rw_st(SL(6), aMak, rb, cb, r32, hi);
    rw_stT(SL(7), aNbr, rb, cb, r32, hi);
    {
        const int t = 32 * cb + r32;
#pragma unroll
        for (int r = 0; r < 16; ++r) { const int i = 32 * rb + crow(r, hi); if (i == t) aMab[r] += 1.f; }
    }
    rw_st(SL(0), aMab, rb, cb, r32, hi);
    __syncthreads();
    int mA = 4, mT = 5, nA = 1, nT = 2;
#pragma unroll 1
    for (int j = 0; j < 5; ++j) {
        f32x16 a1; rw_zero(a1);
        rw_mm(a1, SL(mT), rb, SL(mA), cb, r32, hi);
        rw_stT(SL(nA), a1, rb, cb, r32, hi);
        rw_st(SL(nT), a1, rb, cb, r32, hi);
        __syncthreads();
        f32x16 a2; rw_ldaccT(a2, SL(0), rb, cb, r32, hi);
        rw_mm(a2, SL(nT), rb, SL(0), cb, r32, hi);
        __syncthreads();
        rw_stT(SL(0), a2, rb, cb, r32, hi);
        __syncthreads();
        const int ta = mA, tb = mT; mA = nA; mT = nT; nA = ta; nT = tb;
    }
    rw_ld(SL(1), P.BT + (size_t)u * 4096, gt); rw_ld(SL(2), P.AT + (size_t)u * 4096, gt);
    rw_ld(SL(4), P.KT + (size_t)u * 4096, gt); rw_ld(SL(5), P.V + (size_t)u * 4096, gt);
    __syncthreads();
    {
        f32x16 aY, aZ; rw_zero(aY); rw_zero(aZ);
        rw_mm(aY, SL(0), rb, SL(1), cb, r32, hi);
        rw_mm(aZ, SL(0), rb, SL(7), cb, r32, hi);
        __syncthreads();
        rw_stT(SL(1), aY, rb, cb, r32, hi);
        rw_stT(SL(7), aZ, rb, cb, r32, hi);
        __syncthreads();
    }
    {
        f32x16 aP; rw_zero(aP);
        rw_mm(aP, SL(2), rb, SL(1), cb, r32, hi);
        const int kp = 32 * cb + r32; const float lam = P.LAM[(size_t)u * 64 + kp];
#pragma unroll
        for (int r = 0; r < 16; ++r) { const int kk = 32 * rb + crow(r, hi); aP[r] = (aP[r] + (kk == kp ? 1.f : 0.f)) * lam; }
        v4u f0, f1; rw_frags(f0, f1, aP);
        v4u* dst = P.PF + ((((size_t)u * 2 + cb) * 2 + rb) * 2) * 64 + lane;
        dst[0] = f0; dst[64] = f1;
    }
    {
        f32x16 aH; rw_ldaccT(aH, SL(3), rb, cb, r32, hi);
        rw_mm(aH, SL(2), rb, SL(7), cb, r32, hi);
        v4u f0, f1; rw_frags(f0, f1, aH);
        v4u* dst = P.HF + ((((size_t)u * 2 + cb) * 2 + rb) * 2) * 64 + lane;
        dst[0] = f0; dst[64] = f1;
    }
    {
        f32x16 aD1; rw_ldaccT(aD1, SL(4), rb, cb, r32, hi);
        rw_mm(aD1, SL(6), rb, SL(1), cb, r32, hi);
        rw_mm(aNkr, SL(6), rb, SL(7), cb, r32, hi);
        __syncthreads();
        rw_stT(SL(0), aD1, rb, cb, r32, hi);
        rw_stT(SL(3), aNkr, rb, cb, r32, hi);
        __syncthreads();
    }
    {
        f32x16 aQ; rw_zero(aQ);
        rw_mm(aQ, SL(0), rb, SL(5), cb, r32, hi);
        float* dst = P.QT + (((size_t)u * 2 + cb) * 2 + rb) * 1024 + lane * 4;
#pragma unroll
        for (int g = 0; g < 4; ++g) {
            const float4 lam = *(const float4*)(P.LAM + (size_t)u * 64 + 32 * rb + 8 * g + 4 * hi);
            *(float4*)(dst + g * 256) = make_float4(aQ[4 * g] * lam.x, aQ[4 * g + 1] * lam.y, aQ[4 * g + 2] * lam.z, aQ[4 * g + 3] * lam.w);
        }
    }
    {
        f32x16 aO; rw_zero(aO);
        rw_mm(aO, SL(5), rb, SL(3), cb, r32, hi);
        float* dst = P.OL + (((size_t)u * 2 + cb) * 2 + rb) * 1024 + lane * 4;
#pragma unroll
        for (int g = 0; g < 4; ++g) *(float4*)(dst + g * 256) = make_float4(aO[4 * g], aO[4 * g + 1], aO[4 * g + 2], aO[4 * g + 3]);
    }
#undef SL
}

DEVI void rw_r3_dma(const RwP& P, size_t u, int vb, int lane, LAS unsigned char* slot) {
#pragma unroll
    for (int kb = 0; kb < 2; ++kb) {
        const float* qp = P.QT + ((u * 2 + vb) * 2 + kb) * 1024 + lane * 4;
#pragma unroll
        for (int g = 0; g < 4; ++g) __builtin_amdgcn_global_load_lds((const unsigned*)(qp + g * 256), (LAS unsigned*)(slot + (kb * 4 + g) * 1024), 16, 0, 0);
        const v4u* pp = P.PF + (((u * 2 + kb) * 2) * 2) * 64 + lane;
#pragma unroll
        for (int i = 0; i < 4; ++i) __builtin_amdgcn_global_load_lds((const unsigned*)(pp + i * 64), (LAS unsigned*)(slot + 8192 + (kb * 4 + i) * 1024), 16, 0, 0);
    }
}
DEVI void rw_r3(const RwP& P, int b, int h, int vb, int lane, LAS unsigned char* ring4  ) {
    typedef float f32x4e __attribute__((ext_vector_type(4)));
    f32x16 st[2]; rw_zero(st[0]); rw_zero(st[1]);
    const size_t ub = (size_t)b * (SEQ / 64) * 4 + h;
    const int NC = SEQ / 64;
    rw_r3_dma(P, ub, vb, lane, ring4);
    rw_r3_dma(P, ub + 4, vb, lane, ring4 + 16384);
    rw_r3_dma(P, ub + 8, vb, lane, ring4 + 32768);
#pragma unroll 1
    for (int c = 0; c < NC; ++c) {
        const size_t u = ub + (size_t)c * 4;
        LAS unsigned char* slot = ring4 + (c & 3) * 16384;
        v4u sf[2][2];
        rw_frags(sf[0][0], sf[0][1], st[0]); rw_frags(sf[1][0], sf[1][1], st[1]);
        asm volatile("s_waitcnt vmcnt(32)" ::: "memory");
        f32x16 q[2]; v4u pf[8];
#pragma unroll
        for (int kb = 0; kb < 2; ++kb) {
#pragma unroll
            for (int g = 0; g < 4; ++g) { const f32x4e v = *(const LAS f32x4e*)(slot + (kb * 4 + g) * 1024 + lane * 16); q[kb][4 * g] = v[0]; q[kb][4 * g + 1] = v[1]; q[kb][4 * g + 2] = v[2]; q[kb][4 * g + 3] = v[3]; }
#pragma unroll
            for (int i = 0; i < 4; ++i) pf[kb * 4 + i] = *(const LAS v4u*)(slot + 8192 + (kb * 4 + i) * 1024 + lane * 16);
        }
        asm volatile("s_waitcnt lgkmcnt(0)" ::: "memory");
        v4u* sdst = P.SF + ((u * 2 + vb) * 4) * 64 + lane;
        sdst[0] = sf[0][0]; sdst[64] = sf[0][1]; sdst[128] = sf[1][0]; sdst[192] = sf[1][1];
        __builtin_amdgcn_sched_barrier(0);
        rw_r3_dma(P, ub + (size_t)(c + 3 < NC ? c + 3 : NC - 1) * 4, vb, lane, ring4 + ((c + 3) & 3) * 16384);
        __builtin_amdgcn_sched_barrier(0);
#pragma unroll
        for (int kb = 0; kb < 2; ++kb)
#pragma unroll
            for (int ki = 0; ki < 2; ++ki)
#pragma unroll
                for (int s = 0; s < 2; ++s)
                    q[kb] = __builtin_amdgcn_mfma_f32_32x32x16_bf16(__builtin_bit_cast(bf16x8, pf[kb * 4 + ki * 2 + s]), __builtin_bit_cast(bf16x8, sf[ki][s]), q[kb], 0, 0, 0);
        st[0] = q[0]; st[1] = q[1];
    }
    asm volatile("s_waitcnt vmcnt(0)" ::: "memory");
}

DEVI void rw_r4(const RwP& P, int u, int tb, int lane) {
    const int c = u >> 2, h = u & 3, r32 = lane & 31, hi = lane >> 5;
    f32x16 o[2];
#pragma unroll
    for (int vb = 0; vb < 2; ++vb) {
        const float* ol = P.OL + (((size_t)u * 2 + tb) * 2 + vb) * 1024 + lane * 4;
#pragma unroll
        for (int g = 0; g < 4; ++g) { const float4 v = *(const float4*)(ol + g * 256); o[vb][4 * g] = v.x; o[vb][4 * g + 1] = v.y; o[vb][4 * g + 2] = v.z; o[vb][4 * g + 3] = v.w; }
        const v4u* sf = P.SF + (((size_t)u * 2 + vb) * 4) * 64 + lane;
        const v4u* hf = P.HF + ((((size_t)u * 2 + tb) * 2) * 2) * 64 + lane;
#pragma unroll
        for (int kb = 0; kb < 2; ++kb)
#pragma unroll
            for (int s = 0; s < 2; ++s)
                o[vb] = __builtin_amdgcn_mfma_f32_32x32x16_bf16(__builtin_bit_cast(bf16x8, sf[(kb * 2 + s) * 64]), __builtin_bit_cast(bf16x8, hf[(kb * 2 + s) * 64]), o[vb], 0, 0, 0);
    }
    float sum = 0.f;
#pragma unroll
    for (int r = 0; r < 16; ++r) sum += o[0][r] + o[1][r];
    sum += __shfl_xor(sum, 32, 64);
    const float mean = sum * (1.f / 64.f);
    float q = 0.f;
#pragma unroll
    for (int r = 0; r < 16; ++r) { const float d0 = o[0][r] - mean, d1 = o[1][r] - mean; q += d0 * d0 + d1 * d1; }
    q += __shfl_xor(q, 32, 64);
    const float rstd = rsqrtf(q * (1.f / 64.f) + 64e-5f);
    const size_t tok = (size_t)c * 64 + 32 * tb + r32;
#pragma unroll
    for (int vb = 0; vb < 2; ++vb)
#pragma unroll
        for (int g = 0; g < 4; ++g) {
            const int ch = h * 64 + 32 * vb + 8 * g + 4 * hi;
            const float4 gg = *(const float4*)(P.gn_g + ch), gb = *(const float4*)(P.gn_b + ch);
            const size_t gb_ = ((size_t)u * 64 + 32 * vb + 8 * g + 4 * hi) * 64 + 32 * tb + r32;
            const float4 bo = make_float4(bf2f(P.BON[gb_]), bf2f(P.BON[gb_ + 64]), bf2f(P.BON[gb_ + 128]), bf2f(P.BON[gb_ + 192]));
            const float4 gt = make_float4(bf2f(P.G[gb_]), bf2f(P.G[gb_ + 64]), bf2f(P.G[gb_ + 128]), bf2f(P.G[gb_ + 192]));
            const float y0 = ((o[vb][4 * g] - mean) * rstd * gg.x + gb.x + bo.x) * gt.x;
            const float y1 = ((o[vb][4 * g + 1] - mean) * rstd * gg.y + gb.y + bo.y) * gt.y;
            const float y2 = ((o[vb][4 * g + 2] - mean) * rstd * gg.z + gb.z + bo.z) * gt.z;
            const float y3 = ((o[vb][4 * g + 3] - mean) * rstd * gg.w + gb.w + bo.w) * gt.w;
            *(uint2*)(P.MIX + tok * DM + 256 + ch) = make_uint2(cvtpk(y0, y1), cvtpk(y2, y3));
        }
}
namespace pg8 {
struct XaOrder {
    int G, c;
    __device__ __forceinline__ bool next(int i, Unit& u) const {
        const int L = i * G + c; if (L >= 256) return false;
        u.pm = L >> 2; u.pn = ((L >> 2) >> 5) * 4 + (L & 3); return true;
    }
    __device__ __forceinline__ void a_ready(const Unit&) const {}
    __device__ __forceinline__ void done(const Unit&) const {}
};
struct MoeOrder {
    const int* tile_e; const int* nrt; int G, c;
    __device__ __forceinline__ bool next(int i, Unit& u) const {
        const int L = i * G + c; if (L >= 4 * (*nrt)) return false;
        u.pm = L >> 2; u.pn = tile_e[L >> 2] * 4 + (L & 3); return true;
    }
    __device__ __forceinline__ void a_ready(const Unit&) const {}
    __device__ __forceinline__ void done(const Unit&) const {}
};
#define PG8_EBAR() do { asm volatile("s_waitcnt lgkmcnt(0)" ::: "memory"); __builtin_amdgcn_s_barrier(); asm volatile("" ::: "memory"); } while (0)
struct EpiSoftmaxP {
    static constexpr bool PERM = true, AFTER_DRAIN = true;
    bf16_t* P;
    __device__ __forceinline__ void fused(f32x4 (&acc)[2][2][4][2], const Unit& u, int wr, int wc, int fr, int fq, PG8_LAS unsigned char* lds, int wid, int lane) const {
        PG8_LAS float* RM = (PG8_LAS float*)lds;
        PG8_LAS float* RS = RM + 1024;
#pragma unroll
        for (int ai = 0; ai < 2; ++ai)
#pragma unroll
            for (int m = 0; m < 4; ++m) {
                float mx = -INFINITY;
#pragma unroll
                for (int bj = 0; bj < 2; ++bj)
#pragma unroll
                    for (int n = 0; n < 2; ++n) { const f32x4 x = acc[ai][bj][m][n]; mx = fmaxf(mx, fmaxf(fmaxf(x[0], x[1]), fmaxf(x[2], x[3]))); }
                mx = fmaxf(mx, __shfl_xor(mx, 16)); mx = fmaxf(mx, __shfl_xor(mx, 32));
                if (fq == 0) RM[(ai * HALF + wr * 64 + m * 16 + fr) * 4 + wc] = mx;
            }
        PG8_EBAR();
#pragma unroll
        for (int ai = 0; ai < 2; ++ai)
#pragma unroll
            for (int m = 0; m < 4; ++m) {
                const int row = ai * HALF + wr * 64 + m * 16 + fr;
                const float gm = fmaxf(fmaxf(RM[row * 4 + 0], RM[row * 4 + 1]), fmaxf(RM[row * 4 + 2], RM[row * 4 + 3]));
                float s = 0.f;
#pragma unroll
                for (int bj = 0; bj < 2; ++bj)
#pragma unroll
                    for (int n = 0; n < 2; ++n) { f32x4 x = acc[ai][bj][m][n];
                        x[0] = __builtin_amdgcn_exp2f(x[0] - gm); x[1] = __builtin_amdgcn_exp2f(x[1] - gm); x[2] = __builtin_amdgcn_exp2f(x[2] - gm); x[3] = __builtin_amdgcn_exp2f(x[3] - gm);
                        s += (x[0] + x[1]) + (x[2] + x[3]); acc[ai][bj][m][n] = x; }
                s += __shfl_xor(s, 16); s += __shfl_xor(s, 32);
                if (fq == 0) RS[row * 4 + wc] = s;
            }
        PG8_EBAR();
        const int colb = (u.pn & 3) * BM + wc * 32 + 8 * fq;
#pragma unroll
        for (int ai = 0; ai < 2; ++ai)
#pragma unroll
            for (int m = 0; m < 4; ++m) {
                const int row = ai * HALF + wr * 64 + m * 16 + fr;
                const float inv = 1.0f / ((RS[row * 4 + 0] + RS[row * 4 + 1]) + (RS[row * 4 + 2] + RS[row * 4 + 3]));
                bf16_t* rowp = P + (size_t)(u.pm * BM + row) * 1024 + colb;
#pragma unroll
                for (int bj = 0; bj < 2; ++bj) { const f32x4 v0 = acc[ai][bj][m][0] * inv, v1 = acc[ai][bj][m][1] * inv;
                    u32x4 w; w.x = cvt_pk_bf16(v0[0], v0[1]); w.y = cvt_pk_bf16(v0[2], v0[3]); w.z = cvt_pk_bf16(v1[0], v1[1]); w.w = cvt_pk_bf16(v1[2], v1[3]);
                    *(u32x4*)(rowp + bj * HALF) = w; }
            }
        PG8_EBAR();
    }
};
struct EpiF32N4 {
    static constexpr bool PERM = false, AFTER_DRAIN = false;
    float* C; int ldc;
    __device__ __forceinline__ void operator()(const f32x4 (&acc)[2][2][4][2], const Unit& u, int wr, int wc, int fr, int fq) const {
        const int row0 = u.pm * BM + wr * 64 + fr, col0 = (u.pn & 3) * BM + wc * 32 + 4 * fq;
#pragma unroll
        for (int ai = 0; ai < 2; ++ai)
#pragma unroll
            for (int m = 0; m < 4; ++m) { float* rowp = C + (size_t)(row0 + ai * HALF + m * 16) * ldc + col0;
#pragma unroll
                for (int bj = 0; bj < 2; ++bj)
#pragma unroll
                    for (int n = 0; n < 2; ++n) *(f32x4*)(rowp + bj * HALF + n * 16) = acc[ai][bj][m][n]; }
    }
};
struct EpiBf16N4 {
    static constexpr bool PERM = true, AFTER_DRAIN = false;
    bf16_t* O; int ldc;
    __device__ __forceinline__ void operator()(const f32x4 (&acc)[2][2][4][2], const Unit& u, int wr, int wc, int fr, int fq) const {
        const int row0 = u.pm * BM + wr * 64 + fr, col0 = (u.pn & 3) * BM + wc * 32 + 8 * fq;
#pragma unroll
        for (int ai = 0; ai < 2; ++ai)
#pragma unroll
            for (int m = 0; m < 4; ++m) { bf16_t* rowp = O + (size_t)(row0 + ai * HALF + m * 16) * ldc + col0;
#pragma unroll
                for (int bj = 0; bj < 2; ++bj) { const f32x4 v0 = acc[ai][bj][m][0], v1 = acc[ai][bj][m][1];
                    u32x4 w; w.x = cvt_pk_bf16(v0[0], v0[1]); w.y = cvt_pk_bf16(v0[2], v0[3]); w.z = cvt_pk_bf16(v1[0], v1[1]); w.w = cvt_pk_bf16(v1[2], v1[3]);
                    *(u32x4*)(rowp + bj * HALF) = w; } }
    }
};
struct EpiSiluMul {
    static constexpr bool PERM = true, AFTER_DRAIN = false;
    bf16_t* H;
    __device__ __forceinline__ void operator()(const f32x4 (&acc)[2][2][4][2], const Unit& u, int wr, int wc, int fr, int fq) const {
        const int row0 = u.pm * BM + wr * 64 + fr, col0 = (u.pn & 3) * HALF + wc * 32 + 8 * fq;
#pragma unroll
        for (int ai = 0; ai < 2; ++ai)
#pragma unroll
            for (int m = 0; m < 4; ++m) {
                float h[8];
#pragma unroll
                for (int n = 0; n < 2; ++n)
#pragma unroll
                    for (int e = 0; e < 4; ++e) { const float g = acc[ai][0][m][n][e], up = acc[ai][1][m][n][e];
                        h[4 * n + e] = g * __builtin_amdgcn_rcpf(1.0f + __expf(-g)) * up; }
                u32x4 w; w.x = cvt_pk_bf16(h[0], h[1]); w.y = cvt_pk_bf16(h[2], h[3]); w.z = cvt_pk_bf16(h[4], h[5]); w.w = cvt_pk_bf16(h[6], h[7]);
                *(u32x4*)(H + (size_t)(row0 + ai * HALF + m * 16) * 512 + col0) = w;
            }
    }
};

struct OneUnit {
    int pm, pn, valid;
    __device__ __forceinline__ bool next(int i, Unit& u) const { if (i != 0 || !valid) return false; u.pm = pm; u.pn = pn; return true; }
    __device__ __forceinline__ void a_ready(const Unit&) const {}
    __device__ __forceinline__ void done(const Unit&) const {}
};
struct EpiBf16S {
    static constexpr bool PERM = true, AFTER_DRAIN = false;
    bf16_t* O; int ldc; float scale;
    __device__ __forceinline__ void operator()(const f32x4 (&acc)[2][2][4][2], const Unit& u, int wr, int wc, int fr, int fq) const {
        const int row0 = u.pm * BM + wr * 64 + fr, col0 = u.pn * BM + wc * 32 + 8 * fq;
#pragma unroll
        for (int ai = 0; ai < 2; ++ai)
#pragma unroll
            for (int m = 0; m < 4; ++m) { bf16_t* rowp = O + (size_t)(row0 + ai * HALF + m * 16) * ldc + col0;
#pragma unroll
                for (int bj = 0; bj < 2; ++bj) { const f32x4 v0 = acc[ai][bj][m][0] * scale, v1 = acc[ai][bj][m][1] * scale;
                    u32x4 w; w.x = cvt_pk_bf16(v0[0], v0[1]); w.y = cvt_pk_bf16(v0[2], v0[3]); w.z = cvt_pk_bf16(v1[0], v1[1]); w.w = cvt_pk_bf16(v1[2], v1[3]);
                    *(u32x4*)(rowp + bj * HALF) = w; } }
    }
};
struct EpiGeluF32 {
    static constexpr bool PERM = false, AFTER_DRAIN = false;
    float* C; int ldc;
    __device__ __forceinline__ void operator()(const f32x4 (&acc)[2][2][4][2], const Unit& u, int wr, int wc, int fr, int fq) const {
        const int row0 = u.pm * BM + wr * 64 + fr, col0 = u.pn * BM + wc * 32 + 4 * fq;
#pragma unroll
        for (int ai = 0; ai < 2; ++ai)
#pragma unroll
            for (int m = 0; m < 4; ++m) { float* rowp = C + (size_t)(row0 + ai * HALF + m * 16) * ldc + col0;
#pragma unroll
                for (int bj = 0; bj < 2; ++bj)
#pragma unroll
                    for (int n = 0; n < 2; ++n) { f32x4 x = acc[ai][bj][m][n];
#pragma unroll
                        for (int e = 0; e < 4; ++e) x[e] = 0.5f * x[e] * (1.f + tanhf(0.7978845608028654f * (x[e] + 0.044715f * x[e] * x[e] * x[e])));
                        *(f32x4*)(rowp + bj * HALF + n * 16) = x; } }
    }
};
struct EpiGeluW2 {
    static constexpr bool PERM = false, AFTER_DRAIN = true;
    const bf16_t* W2T;
    bf16_t* O;
    int isv;
    __device__ __forceinline__ void fused(f32x4 (&acc)[2][2][4][2], const Unit& u, int wr, int wc, int fr, int fq, PG8_LAS unsigned char* lds, int wid, int lane) const {
        typedef unsigned u32x2e __attribute__((ext_vector_type(2)));
        typedef float f32x16e __attribute__((ext_vector_type(16)));
#pragma unroll
        for (int ai = 0; ai < 2; ++ai)
#pragma unroll
            for (int m = 0; m < 4; ++m) { const int row = ai * HALF + wr * 64 + m * 16 + fr;
#pragma unroll
                for (int bj = 0; bj < 2; ++bj)
#pragma unroll
                    for (int n = 0; n < 2; ++n) { f32x4 x = acc[ai][bj][m][n];
#pragma unroll
                        for (int e = 0; e < 4; ++e) x[e] = 0.5f * x[e] * (1.f + tanhf(0.7978845608028654f * (x[e] + 0.044715f * x[e] * x[e] * x[e])));
                        const int col = bj * HALF + wc * 32 + n * 16 + 4 * fq;
                        *(PG8_LAS u32x2e*)(lds + row * 512 + ((((col >> 3) ^ (row & 7))) << 4) + (col & 7) * 2) = (u32x2e){cvt_pk_bf16(x[0], x[1]), cvt_pk_bf16(x[2], x[3])}; } }
        PG8_EBAR();
        const int r32 = lane & 31, hi = lane >> 5, row = wid * 32 + r32;
        f32x16e o[2];
#pragma unroll
        for (int cb = 0; cb < 2; ++cb)
#pragma unroll
            for (int r = 0; r < 16; ++r) o[cb][r] = 0.f;
#pragma unroll 4
        for (int s = 0; s < 16; ++s) {
            const bf16x8 a = *(const PG8_LAS bf16x8*)(lds + row * 512 + (((2 * s + hi) ^ (row & 7)) << 4));
#pragma unroll
            for (int cb = 0; cb < 2; ++cb) {
                const bf16x8 b = *(const bf16x8*)(W2T + (size_t)(32 * cb + r32) * 256 + 16 * s + 8 * hi);
                o[cb] = __builtin_amdgcn_mfma_f32_32x32x16_bf16(a, b, o[cb], 0, 0, 0);
            }
        }
#pragma unroll
        for (int cb = 0; cb < 2; ++cb)
#pragma unroll
            for (int g = 0; g < 4; ++g) {
                const int grow = u.pm * BM + wid * 32 + 8 * g + 4 * hi, col = 32 * cb + r32;
                if (isv) { *(u32x2e*)(O + (size_t)(grow >> 9) * 64 * 512 + (size_t)col * 512 + (grow & 511)) = (u32x2e){cvt_pk_bf16(o[cb][4 * g], o[cb][4 * g + 1]), cvt_pk_bf16(o[cb][4 * g + 2], o[cb][4 * g + 3])}; }
                else {
#pragma unroll
                    for (int e = 0; e < 4; ++e) O[(size_t)(grow + e) * 64 + col] = (bf16_t)(cvt_pk_bf16(o[cb][4 * g + e], 0.f) & 0xffffu);
                }
            }
        PG8_EBAR();
    }
};
}

DEVI void tr_blk(const float* W, size_t ldw, int N, int k0, int n0, bf16* WT, size_t ldt, int drow0, float scale, LAS float* scr, int lane) {
    const int n_ = n0 + (lane & 31);
#pragma unroll 8
    for (int i = 0; i < 32; ++i) { const int kk = 2 * i + (lane >> 5); scr[kk * 33 + (lane & 31)] = n_ < N ? W[(size_t)(k0 + kk) * ldw + n_] * scale : 0.f; }
    LDS_WAIT(); asm volatile("" ::: "memory");
    const int c = lane & 7;
#pragma unroll
    for (int j = 0; j < 4; ++j) { const int n = (lane >> 3) + 8 * j; const LAS float* s = scr + (8 * c) * 33 + n;
        v4u o; o.x = pk2(s[0 * 33], s[1 * 33]); o.y = pk2(s[2 * 33], s[3 * 33]); o.z = pk2(s[4 * 33], s[5 * 33]); o.w = pk2(s[6 * 33], s[7 * 33]);
        *(GAS v4u*)(WT + (size_t)(drow0 + n) * ldt + k0 + 8 * c) = o; }
    LDS_WAIT(); asm volatile("" ::: "memory");
}
DEVI void cvt_bf16(const float* __restrict__ src, bf16* __restrict__ dst, size_t n, float scale, int B0, int G) {
    for (size_t i = ((size_t)B0 * 512 + tidx()) * 4; i < n; i += (size_t)G * 512 * 4) {
        const float4 v = *(const float4*)(src + i);
        *(uint2*)(dst + i) = make_uint2(pk2(v.x * scale, v.y * scale), pk2(v.z * scale, v.w * scale));
    }
}

DEVI void moe_lists2(const int* __restrict__ te, int* __restrict__ off, int* __restrict__ nrt, int* __restrict__ tile_e, int* __restrict__ list,
                     int* __restrict__ slotpos, float* sm0) {
    int* cnt = (int*)sm0;
    int* offs = cnt + 16;
    const int w = tidx() >> 6, lane = tidx() & 63;
    __syncthreads();
    for (int ee = 0; ee < 2; ++ee) {
        const int e = w * 2 + ee;
        int c = 0;
        for (int base = 0; base < NTOK; base += 64) {
            const int tok = base + lane;
            const bool m = (te[tok * 2] == e) || (te[tok * 2 + 1] == e);
            c += __popcll(__ballot(m));
        }
        if (lane == 0) cnt[e] = c;
    }
    __syncthreads();
    if (tidx() == 0) {
        int s = 0;
#pragma unroll 1
        for (int i = 0; i < 16; ++i) { offs[i] = s; off[i] = s; const int pc = (cnt[i] + 255) & ~255;
#pragma unroll 1
            for (int r = s / 256; r < (s + pc) / 256; ++r) tile_e[r] = i;
            s += pc; }
        offs[16] = s; off[16] = s; *nrt = s / 256;
    }
    __syncthreads();
    for (int ee = 0; ee < 2; ++ee) {
        const int e = w * 2 + ee;
        int pos = offs[e];
        for (int base = 0; base < NTOK; base += 64) {
            const int tok = base + lane;
            const int a = te[tok * 2], b = te[tok * 2 + 1];
            const bool m = (a == e) || (b == e);
            const unsigned long long mask = __ballot(m);
            if (m) {
                const int p = pos + __popcll(mask & ((1ull << lane) - 1ull));
                list[p] = tok;
                slotpos[tok * 2 + (a == e ? 0 : 1)] = p;
            }
            pos += __popcll(mask);
        }
        for (int p = pos + lane; p < offs[e + 1]; p += 64) list[p] = -1;
    }
    __syncthreads();
}
DEVI void moe_gather(const bf16* __restrict__ xn, const int* __restrict__ list, const int* __restrict__ off, bf16* __restrict__ xg, int B0, int G) {
    const int total = off[16];
    const int gw = B0 * NWAVES + (tidx() >> 6), lane = tidx() & 63;
    for (int p = gw; p < total; p += G * NWAVES) {
        const int tok = list[p];
        v4u a = (v4u){0u, 0u, 0u, 0u}, b = a;
        if (tok >= 0) { const v4u* s = (const v4u*)(xn + (size_t)tok * DM); a = s[lane]; b = s[lane + 64]; }
        v4u* d = (v4u*)(xg + (size_t)p * DM); d[lane] = a; d[lane + 64] = b;
    }
}
DEVI void moe_combine_ln2(const float* x, const bf16* __restrict__ Dp, const int* __restrict__ te,
                          const float* __restrict__ tw, const int* __restrict__ slotpos,
                          const float* __restrict__ g, const float* __restrict__ bt, float* out, bf16* outb, int bid, float* sm) {
    __syncthreads();
    const size_t t = bid; const int tid = tidx() & 255;
    int ea = te[t * 2], eb = te[t * 2 + 1];
    float wa = tw[t * 2], wb = tw[t * 2 + 1];
    size_t pa = slotpos[t * 2], pb = slotpos[t * 2 + 1];
    if (eb < ea) { const float tf = wa; wa = wb; wb = tf; const size_t tp = pa; pa = pb; pb = tp; }
    float v[4];
#pragma unroll
    for (int i = 0; i < 4; ++i) {
        const int c = tid + i * 256;
        float y = wa * bf2f(Dp[pa * DM + c]);
        y = y + wb * bf2f(Dp[pb * DM + c]);
        v[i] = ALPHA * x[t * DM + c] + y;
    }
    const float mean = block_sum256(v[0] + v[1] + v[2] + v[3], sm, tid) * (1.f / DM);
    float q = 0.f;
#pragma unroll
    for (int i = 0; i < 4; ++i) { v[i] -= mean; q += v[i] * v[i]; }
    const float var = block_sum256(q, sm, tid) * (1.f / DM);
    const float rstd = rsqrtf(var + 1e-5f);
#pragma unroll
    for (int i = 0; i < 4; ++i) {
        const int c = tid + i * 256;
        const float o = v[i] * rstd * g[c] + bt[c];
        out[t * DM + c] = o;
        outb[t * DM + c] = (bf16)f2bf(o);
    }
}
struct MixP {
    const bf16* COLS;
    const float *conv_w, *conv_b, *conv_gg, *conv_gb;
    const float *gl_g, *gl_b;
    const float *mu, *w0, *a0, *k_k, *k_a, *r_k, *v_mu, *v0;
    const bf16 *WUP_T, *AUP_T, *GUP_T, *VUP_T;
    const float *pe_k, *pe_v;
    bf16 *MIX, *UB, *VB;
    bf16 *AT, *BT, *KT, *RT, *V, *G, *BON, *VFIRST;
    float* LAM;
    bf16 *QN, *QR, *KSR, *KWR, *VST, *VWT;
    float* GATES;
    bf16 *BLK, *BLV;
    int layer, pad;
};
DEVI float4 ld4bf(const bf16* p) { const uint2 w = *(const uint2*)p; return make_float4(__builtin_bit_cast(float, w.x << 16), __builtin_bit_cast(float, w.x & 0xffff0000u), __builtin_bit_cast(float, w.y << 16), __builtin_bit_cast(float, w.y & 0xffff0000u)); }
DEVI void st4bf(bf16* p, float a, float b, float c, float d) { *(uint2*)p = make_uint2(cvtpk(a, b), cvtpk(c, d)); }
DEVI float fsig(float x) { return __builtin_amdgcn_rcpf(1.f + __expf(-x)); }
DEVI float ftanh(float x) { const float e = __expf(-2.f * fabsf(x)); const float t = (1.f - e) * __builtin_amdgcn_rcpf(1.f + e); return x < 0.f ? -t : t; }
DEVI float fgelu(float x) { return 0.5f * x * (1.f + ftanh(0.7978845608028654f * (x + 0.044715f * x * x * x))); }

DEVI void prep_unit(const MixP& P, int cg, LAS unsigned char* lds) {
    const int tid = tidx(), w = tid >> 6, lane = tid & 63;
    const int b = cg >> 7, pos0 = (cg & 127) * 64;
    const size_t tok0 = (size_t)cg * 64;
    const bf16* cols = P.COLS + tok0 * DINP;
    REP(27) {
        LAS float* hb = (LAS float*)lds;
        __syncthreads();
        for (int e = tid; e < 94 * 64; e += 512) {
            const int row = e >> 6, c4 = (e & 63) * 4, tt = row - 30;
            float4 h = make_float4(0.f, 0.f, 0.f, 0.f);
            if (pos0 + tt >= 0) {
                const bf16* cr = cols + (long)tt * DINP;
                const float4 v = ld4bf(cr + OFF_CV + c4), g = ld4bf(cr + OFF_CG + c4);
                h = make_float4(v.x * fsig(g.x), v.y * fsig(g.y), v.z * fsig(g.z), v.w * fsig(g.w));
            }
            { typedef float f32x4v __attribute__((ext_vector_type(4))); *(LAS f32x4v*)(hb + row * 256 + c4) = (f32x4v){h.x, h.y, h.z, h.w}; }
        }
        __syncthreads();
        const int c = tid & 255, half = tid >> 8;
        float wj[31];
#pragma unroll
        for (int j = 0; j < 31; ++j) wj[j] = P.conv_w[j * 256 + c];
        const float bias = P.conv_b[c], gg = P.conv_gg[c], gb = P.conv_gb[c];
#pragma unroll 1
        for (int q = 0; q < 4; ++q) {
            float xs[38];
            const int tb = 32 * half + 8 * q;
#pragma unroll
            for (int i = 0; i < 38; ++i) xs[i] = hb[(tb + i) * 256 + c];
#pragma unroll
            for (int t = 0; t < 8; ++t) {
                float acc = bias;
#pragma unroll
                for (int j = 0; j < 31; ++j) acc = fmaf(wj[j], xs[t + j], acc);
                const float mean = wave_sum(acc) * (1.f / 64.f);
                const float d = acc - mean;
                const float var = wave_sum(d * d) * (1.f / 64.f);
                const float y = d * rsqrtf(var + 1e-5f) * gg + gb;
                P.MIX[(tok0 + tb + t) * DM + c] = (bf16)f2bf(y * fsig(y));
            }
        }
    }
    REP(28) {
        const float4 lg = *(const float4*)(P.gl_g + lane * 4), lb = *(const float4*)(P.gl_b + lane * 4);
#pragma unroll 2
        for (int i = 0; i < 8; ++i) {
            const int t = w * 8 + i; const bf16* cr = cols + (size_t)t * DINP;
            const float4 u = ld4bf(cr + OFF_GU + lane * 4);
            st4bf(P.UB + (tok0 + t) * 256 + lane * 4, fgelu(u.x), fgelu(u.y), fgelu(u.z), fgelu(u.w));
            float4 v = ld4bf(cr + OFF_GV + lane * 4);
            v = make_float4(fgelu(v.x), fgelu(v.y), fgelu(v.z), fgelu(v.w));
            const float mean = wave_sum((v.x + v.y) + (v.z + v.w)) * (1.f / 256.f);
            v.x -= mean; v.y -= mean; v.z -= mean; v.w -= mean;
            const float var = wave_sum((v.x * v.x + v.y * v.y) + (v.z * v.z + v.w * v.w)) * (1.f / 256.f);
            const float rs = rsqrtf(var + 1e-5f);
            st4bf(P.VB + (tok0 + t) * 256 + lane * 4, v.x * rs * lg.x + lb.x, v.y * rs * lg.y + lb.y, v.z * rs * lg.z + lb.z, v.w * rs * lg.w + lb.w);
        }
    }
    REP(29) {
        LAS float* cst = (LAS float*)lds;
        LAS unsigned short* vt = (LAS unsigned short*)(lds + 16384);
        __syncthreads();
        for (int e = tid; e < 2048; e += 512) {
            const int t = e >> 5, j = e & 31;
            const float inv = powf(10000.f, -(float)j / 32.f);
            float sn, cs; sincosf((float)(pos0 + t) * inv, &sn, &cs);
            cst[e * 2] = cs; cst[e * 2 + 1] = sn;
        }
        __syncthreads();
#pragma unroll 1
        for (int i = 0; i < 8; ++i) {
            const int t = w * 8 + i; const bf16* cr = cols + (size_t)t * DINP; const size_t tok = tok0 + t;
            {
                const int d4 = (lane & 15) * 4;
                const float4 x = ld4bf(cr + OFF_Q + lane * 4);
                const float4 pr = make_float4(__shfl_xor(x.x, 8, 64), __shfl_xor(x.y, 8, 64), __shfl_xor(x.z, 8, 64), __shfl_xor(x.w, 8, 64));
                const LAS float* cp = cst + (t * 32 + (d4 & 31)) * 2;
                const float sg = d4 < 32 ? -1.f : 1.f;
                st4bf(P.QN + tok * 256 + lane * 4, x.x * QSCL, x.y * QSCL, x.z * QSCL, x.w * QSCL);
                st4bf(P.QR + tok * 256 + lane * 4, (x.x * cp[0] + sg * pr.x * cp[1]) * QSCL, (x.y * cp[2] + sg * pr.y * cp[3]) * QSCL,
                      (x.z * cp[4] + sg * pr.z * cp[5]) * QSCL, (x.w * cp[6] + sg * pr.w * cp[7]) * QSCL);
            }
            {
                const int seg = lane >> 4, d4 = (lane & 15) * 4;
                const float4 x = ld4bf(cr + OFF_KS + seg * 64 + d4);
                const float4 pr = make_float4(__shfl_xor(x.x, 8, 64), __shfl_xor(x.y, 8, 64), __shfl_xor(x.z, 8, 64), __shfl_xor(x.w, 8, 64));
                if ((seg & 1) == 0) {
                    const LAS float* cp = cst + (t * 32 + (d4 & 31)) * 2;
                    const float sg = d4 < 32 ? -1.f : 1.f;
                    bf16* dst = (seg == 0 ? P.KSR : P.KWR) + tok * 64 + d4;
                    st4bf(dst, x.x * cp[0] + sg * pr.x * cp[1], x.y * cp[2] + sg * pr.y * cp[3], x.z * cp[4] + sg * pr.z * cp[5], x.w * cp[6] + sg * pr.w * cp[7]);
                } else {
                    LAS unsigned short* vp = vt + (seg >> 1) * 4096 + d4 * 64 + t;
                    vp[0] = (unsigned short)f2bf(x.x); vp[64] = (unsigned short)f2bf(x.y); vp[128] = (unsigned short)f2bf(x.z); vp[192] = (unsigned short)f2bf(x.w);
                }
            }
            if (lane < 12) P.GATES[tok * 12 + lane] = fsig(bf2f(cr[OFF_GT + lane]));
        }
        __syncthreads();
        for (int e = tid; e < 1024; e += 512) {
            const int which = e >> 9, d = (e >> 3) & 63, ch = e & 7;
            const v4u v = *(const LAS v4u*)((LAS unsigned char*)vt + which * 8192 + d * 128 + ch * 16);
            *(v4u*)((which ? P.VWT : P.VST) + ((size_t)b * 64 + d) * SEQ + pos0 + ch * 8) = v;
        }
        for (int e = tid; e < 4 * 512 * 2; e += 512) {
            const int isv = e >> 11, r = e & 2047, nl = r >> 9, i4 = (r & 511) * 4, l = i4 >> 6, d = i4 & 63;
            const int n = 4 * (cg & 127) + nl;
            bf16* dst = (isv ? P.BLV : P.BLK) + ((size_t)b * 512 + n) * 2048 + i4;
            if (n < NCMP) {
                const float4 x = ld4bf(cols + (size_t)(16 * nl + l) * DINP + (isv ? OFF_VC : OFF_KC) + d);
                const float4 pe = *(const float4*)((isv ? P.pe_v : P.pe_k) + i4);
                st4bf(dst, x.x + pe.x, x.y + pe.y, x.z + pe.z, x.w + pe.w);
            } else *(uint2*)dst = make_uint2(0u, 0u);
        }
    }
    REP(30) {
        LAS unsigned char* TW = lds;
        LAS unsigned char* AD = lds + 8192;
        LAS unsigned char* SG = lds + 16384;
        LAS unsigned char* VD = lds + 32768;
        LAS float* CAR = (LAS float*)(lds + 36864);
        __syncthreads();
        for (int e = tid; e < 64 * 64; e += 512) {
            const int t = e >> 6, j4 = (e & 63) * 4;
            const bf16* cr = cols + (size_t)t * DINP + OFF_RW + 768 + j4;
            const float4 c4 = ld4bf(cr);
            float4 p4 = make_float4(0.f, 0.f, 0.f, 0.f);
            if (pos0 + t > 0) p4 = ld4bf(cr - DINP);
            const float4 m4 = *(const float4*)(P.mu + 768 + j4);
            float y0 = c4.x + m4.x * (p4.x - c4.x), y1 = c4.y + m4.y * (p4.y - c4.y), y2 = c4.z + m4.z * (p4.z - c4.z), y3 = c4.w + m4.w * (p4.w - c4.w);
            if (j4 < 64) { y0 = ftanh(y0); y1 = ftanh(y1); y2 = ftanh(y2); y3 = ftanh(y3);
                *(LAS u32x2v*)(TW + rw_off(t, j4 >> 3) + (j4 & 7) * 2) = (u32x2v){cvtpk(y0, y1), cvtpk(y2, y3)}; }
            else if (j4 < 128) { const int jj = j4 - 64;
                *(LAS u32x2v*)(AD + rw_off(t, jj >> 3) + (jj & 7) * 2) = (u32x2v){cvtpk(y0, y1), cvtpk(y2, y3)}; }
            else { const int jj = j4 - 128; y0 = fsig(y0); y1 = fsig(y1); y2 = fsig(y2); y3 = fsig(y3);
                *(LAS u32x2v*)(SG + t * 256 + (((jj >> 3) ^ (t & 7)) << 4) + (jj & 7) * 2) = (u32x2v){cvtpk(y0, y1), cvtpk(y2, y3)}; }
        }
        if (P.layer > 0) {
            const int t = tid >> 3, j4 = (tid & 7) * 4;
            const bf16* cr = cols + (size_t)t * DINP + DIN + j4;
            const float4 c4 = ld4bf(cr);
            float4 p4 = make_float4(0.f, 0.f, 0.f, 0.f);
            if (pos0 + t > 0) p4 = ld4bf(cr - DINP);
            const float4 m4 = *(const float4*)(P.v_mu + j4);
            *(LAS u32x2v*)(VD + t * 64 + j4 * 2) = (u32x2v){cvtpk(c4.x + m4.x * (p4.x - c4.x), c4.y + m4.y * (p4.y - c4.y)), cvtpk(c4.z + m4.z * (p4.z - c4.z), c4.w + m4.w * (p4.w - c4.w))};
        }
        __syncthreads();
        const int h = w >> 1, tb = w & 1, r32 = lane & 31, hi = lane >> 5;
        const int t = 32 * tb + r32;
        const size_t u = (size_t)cg * 4 + h;
        LAS unsigned char* YS = lds + 40960;
        auto stage = [&](int cb) {
            __syncthreads();
            for (int e = tid; e < 64 * 48; e += 512) {
                const int tt = e / 48, c8 = e % 48, seg = c8 >> 4, hh = (c8 >> 2) & 3, chl = (c8 & 3) * 8;
                const int gcol = seg * 256 + hh * 64 + 32 * cb + chl;
                const bf16* cr = cols + (size_t)tt * DINP + OFF_RW + gcol;
                const v4u cv = *(const v4u*)cr;
                v4u pv = (v4u){0u, 0u, 0u, 0u};
                if (pos0 + tt > 0) pv = *(const v4u*)(cr - DINP);
                const float4 m0 = *(const float4*)(P.mu + gcol), m1 = *(const float4*)(P.mu + gcol + 4);
                const unsigned cw[4] = {cv.x, cv.y, cv.z, cv.w}, pw[4] = {pv.x, pv.y, pv.z, pv.w};
                const float mm[8] = {m0.x, m0.y, m0.z, m0.w, m1.x, m1.y, m1.z, m1.w};
                unsigned ow[4];
#pragma unroll
                for (int q = 0; q < 4; ++q) {
                    const float c0 = __uint_as_float(cw[q] << 16), c1 = __uint_as_float(cw[q] & 0xffff0000u), p0 = __uint_as_float(pw[q] << 16), p1 = __uint_as_float(pw[q] & 0xffff0000u);
                    ow[q] = cvtpk(c0 + mm[2 * q] * (p0 - c0), c1 + mm[2 * q + 1] * (p1 - c1));
                }
                LAS unsigned char* dst = YS + tt * 776 + (seg * 128 + hh * 32 + chl) * 2;
                *(LAS u32x2v*)dst = (u32x2v){ow[0], ow[1]}; *(LAS u32x2v*)(dst + 8) = (u32x2v){ow[2], ow[3]};
            }
            __syncthreads();
        };
        auto ys4 = [&](int seg, int g) -> float4 {
            const u32x2v w2 = *(const LAS u32x2v*)(YS + t * 776 + (seg * 128 + h * 32 + 8 * g + 4 * hi) * 2);
            return make_float4(__uint_as_float(w2.x << 16), __uint_as_float(w2.x & 0xffff0000u), __uint_as_float(w2.y << 16), __uint_as_float(w2.y & 0xffff0000u));
        };
        float n2 = 0.f, bd = 0.f;
#pragma unroll 1
        for (int cb = 0; cb < 2; ++cb) {
            stage(cb);
            f32x16 al; rw_zero(al);
            const bf16* arow = P.AUP_T + (size_t)(h * 64 + 32 * cb + r32) * 64 + 8 * hi;
#pragma unroll
            for (int s = 0; s < 4; ++s) al = __builtin_amdgcn_mfma_f32_32x32x16_bf16(*(const bf16x8*)(arow + 16 * s), rw_frag(AD, tb, s, r32, hi), al, 0, 0, 0);
#pragma unroll
            for (int g = 0; g < 4; ++g) {
                const int ch = h * 64 + 32 * cb + 8 * g + 4 * hi;
                const float4 r4 = ys4(0, g), k4 = ys4(1, g);
                const float4 a0 = *(const float4*)(P.a0 + ch), kk_ = *(const float4*)(P.k_k + ch), ka = *(const float4*)(P.k_a + ch), rk = *(const float4*)(P.r_k + ch);
                const float rr[4] = {r4.x, r4.y, r4.z, r4.w}, kv[4] = {k4.x, k4.y, k4.z, k4.w};
                const float a0v[4] = {a0.x, a0.y, a0.z, a0.w}, kkv[4] = {kk_.x, kk_.y, kk_.z, kk_.w}, kav[4] = {ka.x, ka.y, ka.z, ka.w}, rkv[4] = {rk.x, rk.y, rk.z, rk.w};
#pragma unroll
                for (int e = 0; e < 4; ++e) {
                    const float a = fsig(a0v[e] + al[4 * g + e]);
                    const float kq = kv[e] * kkv[e];
                    n2 = fmaf(kq, kq, n2);
                    bd = fmaf(rr[e] * rkv[e], kv[e] * (1.f + (a - 1.f) * kav[e]), bd);
                }
            }
        }
        n2 += __shfl_xor(n2, 32, 64); bd += __shfl_xor(bd, 32, 64);
        const float rnorm = 1.f / fmaxf(sqrtf(n2), 1e-12f);
#pragma unroll 1
        for (int cb = 0; cb < 2; ++cb) {
            stage(cb);
            f32x16 al, wl, gl, vm; rw_zero(al); rw_zero(wl); rw_zero(gl); rw_zero(vm);
            const int chrow = h * 64 + 32 * cb + r32;
            const bf16* arow = P.AUP_T + (size_t)chrow * 64 + 8 * hi;
            const bf16* wrow = P.WUP_T + (size_t)chrow * 64 + 8 * hi;
            const bf16* grow = P.GUP_T + (size_t)chrow * 128 + 8 * hi;
#pragma unroll
            for (int s = 0; s < 4; ++s) {
                al = __builtin_amdgcn_mfma_f32_32x32x16_bf16(*(const bf16x8*)(arow + 16 * s), rw_frag(AD, tb, s, r32, hi), al, 0, 0, 0);
                wl = __builtin_amdgcn_mfma_f32_32x32x16_bf16(*(const bf16x8*)(wrow + 16 * s), rw_frag(TW, tb, s, r32, hi), wl, 0, 0, 0);
            }
#pragma unroll
            for (int s = 0; s < 8; ++s) {
                const bf16x8 bfr = *(const LAS bf16x8*)(SG + t * 256 + (((2 * s + hi) ^ (t & 7)) << 4));
                gl = __builtin_amdgcn_mfma_f32_32x32x16_bf16(*(const bf16x8*)(grow + 16 * s), bfr, gl, 0, 0, 0);
            }
            if (P.layer > 0) {
                const bf16* vrow = P.VUP_T + (size_t)chrow * 32 + 8 * hi;
#pragma unroll
                for (int s = 0; s < 2; ++s) {
                    const bf16x8 bfr = *(const LAS bf16x8*)(VD + t * 64 + (2 * s + hi) * 16);
                    vm = __builtin_amdgcn_mfma_f32_32x32x16_bf16(*(const bf16x8*)(vrow + 16 * s), bfr, vm, 0, 0, 0);
                }
            }
            f32x16 lw, cum;
#pragma unroll
            for (int g = 0; g < 4; ++g) {
                const float4 w0 = *(const float4*)(P.w0 + h * 64 + 32 * cb + 8 * g + 4 * hi);
                const float w0v[4] = {w0.x, w0.y, w0.z, w0.w};
#pragma unroll
                for (int e = 0; e < 4; ++e) {
                    const float x = -(w0v[e] + wl[4 * g + e]);
                    const float sp = fmaxf(x, 0.f) + __logf(1.f + __expf(-fabsf(x)));
                    lw[4 * g + e] = -__expf(-sp - 0.5f);
                }
            }
#pragma unroll
            for (int r = 0; r < 16; ++r) {
                float s = lw[r];
#pragma unroll
                for (int dl = 1; dl < 32; dl <<= 1) { const float o = __shfl_up(s, dl, 32); if (r32 >= dl) s += o; }
                cum[r] = s;
            }
            if (tb == 0 && r32 == 31) {
#pragma unroll
                for (int r = 0; r < 16; ++r) CAR[h * 64 + 32 * cb + crow(r, hi)] = cum[r];
            }
            __syncthreads();
            if (tb == 1) {
#pragma unroll
                for (int r = 0; r < 16; ++r) cum[r] += CAR[h * 64 + 32 * cb + crow(r, hi)];
            }
#pragma unroll
            for (int g = 0; g < 4; ++g) {
                const int cl = 32 * cb + 8 * g + 4 * hi, ch = h * 64 + cl;
                const float4 r4 = ys4(0, g), k4 = ys4(1, g), v4 = ys4(2, g);
                const float4 a0 = *(const float4*)(P.a0 + ch), kk_ = *(const float4*)(P.k_k + ch), ka = *(const float4*)(P.k_a + ch);
                const float rr[4] = {r4.x, r4.y, r4.z, r4.w}, kv[4] = {k4.x, k4.y, k4.z, k4.w};
                float vv[4] = {v4.x, v4.y, v4.z, v4.w};
                const float a0v[4] = {a0.x, a0.y, a0.z, a0.w}, kkv[4] = {kk_.x, kk_.y, kk_.z, kk_.w}, kav[4] = {ka.x, ka.y, ka.z, ka.w};
                const float4 v0 = *(const float4*)(P.v0 + ch);
                const float v0v[4] = {v0.x, v0.y, v0.z, v0.w};
#pragma unroll
                for (int e = 0; e < 4; ++e) {
                    const size_t bo_ = (u * 64 + cl + e) * 64 + t;
                    if (P.layer == 0) P.VFIRST[bo_] = (bf16)f2bf(vv[e]);
                    else vv[e] = vv[e] + (bf2f(P.VFIRST[bo_]) - vv[e]) * fsig(v0v[e] + vm[4 * g + e]);
                    const float a = fsig(a0v[e] + al[4 * g + e]);
                    const float kkn = kv[e] * kkv[e] * rnorm;
                    const float k2 = kv[e] * (1.f + (a - 1.f) * kav[e]);
                    const float cu = cum[4 * g + e];
                    const float ein = __expf(cu), eout = __expf(-cu), eex = __expf(cu - lw[4 * g + e]);
                    P.AT[bo_] = (bf16)f2bf(-kkn * eex); P.BT[bo_] = (bf16)f2bf(kkn * a * eout); P.KT[bo_] = (bf16)f2bf(k2 * eout); P.RT[bo_] = (bf16)f2bf(rr[e] * ein);
                    P.V[bo_] = (bf16)f2bf(vv[e]); P.G[bo_] = (bf16)f2bf(gl[4 * g + e]); P.BON[bo_] = (bf16)f2bf(bd * vv[e]);
                    if (t == 63) P.LAM[u * 64 + cl + e] = ein;
                }
            }
        }
    }
}

DEVI void gmlp_unit(const bf16* __restrict__ UB, const bf16* __restrict__ VB, const bf16* __restrict__ GWS  , const float* __restrict__ bs,
                    bf16* __restrict__ MIX, int c128, LAS unsigned char* lds) {
    const int tid = tidx(), w = tid >> 6, lane = tid & 63, r32 = lane & 31, hi = lane >> 5;
    const size_t T0 = (size_t)c128 * 128;
    __syncthreads();
    for (int e = tid; e < 128 * 32; e += 512) {
        const int s = e >> 5, c8 = (e & 31) * 8;
        const v4u v = *(const v4u*)(VB + (T0 + s) * 256 + c8);
        const unsigned wv[4] = {v.x, v.y, v.z, v.w};
#pragma unroll
        for (int j = 0; j < 8; ++j) { const int ch = c8 + j;
            *(LAS unsigned short*)(lds + ch * 256 + (((s >> 3) ^ (ch & 7)) << 4) + (s & 7) * 2) = (unsigned short)(wv[j >> 1] >> ((j & 1) * 16)); }
    }
    __syncthreads();
    const int h = w & 3, th = w >> 2;
    f32x16 acc[2][2];
#pragma unroll
    for (int i = 0; i < 2; ++i)
#pragma unroll
        for (int j = 0; j < 2; ++j) rw_zero(acc[i][j]);
    const int nks = 4 * (th + 1);
#pragma unroll 1
    for (int s = 0; s < nks; ++s) {
        bf16x8 bfr[2];
#pragma unroll
        for (int cb = 0; cb < 2; ++cb) { const int ch = h * 64 + 32 * cb + r32; bfr[cb] = *(const LAS bf16x8*)(lds + ch * 256 + (((2 * s + hi) ^ (ch & 7)) << 4)); }
#pragma unroll
        for (int rb = 0; rb < 2; ++rb) {
            const bf16x8 afr = *(const bf16x8*)(GWS + ((size_t)h * 128 + 64 * th + 32 * rb + r32) * 128 + 16 * s + 8 * hi);
#pragma unroll
            for (int cb = 0; cb < 2; ++cb) acc[rb][cb] = __builtin_amdgcn_mfma_f32_32x32x16_bf16(afr, bfr[cb], acc[rb][cb], 0, 0, 0);
        }
    }
#pragma unroll
    for (int rb = 0; rb < 2; ++rb)
#pragma unroll
        for (int cb = 0; cb < 2; ++cb)
#pragma unroll
            for (int r = 0; r < 16; ++r) {
                const int tt = 64 * th + 32 * rb + crow(r, hi), ch = h * 64 + 32 * cb + r32;
                const float uu = bf2f(UB[(T0 + tt) * 256 + ch]);
                MIX[(T0 + tt) * DM + 512 + ch] = (bf16)f2bf(uu * (acc[rb][cb][r] + bs[h * 128 + tt]));
            }
}
DEVI void ln_finish(float (&v)[16], const float* __restrict__ g, const float* __restrict__ bt, float* orow, bf16* obrow, int lane) {
    float s = 0.f;
#pragma unroll
    for (int i = 0; i < 16; ++i) s += v[i];
    const float mean = wsum_all(s) * (1.f / DM);
    float q = 0.f;
#pragma unroll
    for (int i = 0; i < 16; ++i) { v[i] -= mean; q += v[i] * v[i]; }
    const float rstd = rsqrtf(wsum_all(q) * (1.f / DM) + 1e-5f);
#pragma unroll
    for (int j = 0; j < 4; ++j) {
        const int c = lane * 4 + 256 * j;
        const float4 gg = *(const float4*)(g + c), bb = *(const float4*)(bt + c);
        v[4 * j] = v[4 * j] * rstd * gg.x + bb.x; v[4 * j + 1] = v[4 * j + 1] * rstd * gg.y + bb.y;
        v[4 * j + 2] = v[4 * j + 2] * rstd * gg.z + bb.z; v[4 * j + 3] = v[4 * j + 3] * rstd * gg.w + bb.w;
        if (orow) *(float4*)(orow + c) = make_float4(v[4 * j], v[4 * j + 1], v[4 * j + 2], v[4 * j + 3]);
        *(uint2*)(obrow + c) = make_uint2(cvtpk(v[4 * j], v[4 * j + 1]), cvtpk(v[4 * j + 2], v[4 * j + 3]));
    }
}
DEVI void ln_rows_in(const float* __restrict__ xin, const float* __restrict__ g, const float* __restrict__ bt, bf16* outb, int B0, int G) {
    const int gw = B0 * NWAVES + (tidx() >> 6); int lane = tidx() & 63;
    for (int row = gw; row < NTOK; row += G * NWAVES) {
        asm volatile("" : "+v"(lane));
        float v[16];
#pragma unroll
        for (int j = 0; j < 4; ++j) { const float4 x = *(const float4*)(xin + (size_t)row * DM + lane * 4 + 256 * j); v[4 * j] = x.x; v[4 * j + 1] = x.y; v[4 * j + 2] = x.z; v[4 * j + 3] = x.w; }
        ln_finish(v, g, bt, (float*)nullptr, outb + (size_t)row * DM, lane);
    }
}
DEVI void ln_rows(bf16* xb, float alpha, const bf16* add, const float* __restrict__ g, const float* __restrict__ bt, int B0, int G) {
    const int gw = B0 * NWAVES + (tidx() >> 6); int lane = tidx() & 63;
    for (int row = gw; row < NTOK; row += G * NWAVES) {
        asm volatile("" : "+v"(lane));
        float v[16];
#pragma unroll
        for (int j = 0; j < 4; ++j) {
            const size_t idx = (size_t)row * DM + lane * 4 + 256 * j;
            const float4 x = ld4bf(xb + idx), a = ld4bf(add + idx);
            v[4 * j] = alpha * x.x + a.x; v[4 * j + 1] = alpha * x.y + a.y; v[4 * j + 2] = alpha * x.z + a.z; v[4 * j + 3] = alpha * x.w + a.w;
        }
        ln_finish(v, g, bt, (float*)nullptr, xb + (size_t)row * DM, lane);
    }
}
DEVI void ln_router_rows(bf16* xb, const bf16* add, const float* __restrict__ g, const float* __restrict__ bt,
                         const float* __restrict__ rw, const float* __restrict__ rb, int* __restrict__ te, float* __restrict__ tw, int* __restrict__ trel,
                         int* __restrict__ cnt, int B0, int G) {
    const int gw = B0 * NWAVES + (tidx() >> 6); int lane = tidx() & 63;
    int mycnt = 0;
    int my_row = -1, my_e0 = 0, my_e1 = 0, my_r0 = 0, my_r1 = 0; int kk_ = 0;
    for (int row = gw; row < NTOK; row += G * NWAVES, ++kk_) {
        asm volatile("" : "+v"(lane));
        float v[16];
#pragma unroll
        for (int j = 0; j < 4; ++j) {
            const size_t idx = (size_t)row * DM + lane * 4 + 256 * j;
            const float4 x = ld4bf(xb + idx), a = ld4bf(add + idx);
            v[4 * j] = ALPHA * x.x + a.x; v[4 * j + 1] = ALPHA * x.y + a.y; v[4 * j + 2] = ALPHA * x.z + a.z; v[4 * j + 3] = ALPHA * x.w + a.w;
        }
        ln_finish(v, g, bt, (float*)nullptr, xb + (size_t)row * DM, lane);
        float lg[16];
#pragma unroll
        for (int e = 0; e < 16; ++e) lg[e] = 0.f;
#pragma unroll
        for (int j = 0; j < 4; ++j)
#pragma unroll
            for (int k = 0; k < 4; ++k) {
                const float xv = v[4 * j + k];
                const float4* wr = (const float4*)(rw + (size_t)(lane * 4 + 256 * j + k) * 16);
                const float4 w0 = wr[0], w1 = wr[1], w2 = wr[2], w3 = wr[3];
                lg[0] = fmaf(xv, w0.x, lg[0]); lg[1] = fmaf(xv, w0.y, lg[1]); lg[2] = fmaf(xv, w0.z, lg[2]); lg[3] = fmaf(xv, w0.w, lg[3]);
                lg[4] = fmaf(xv, w1.x, lg[4]); lg[5] = fmaf(xv, w1.y, lg[5]); lg[6] = fmaf(xv, w1.z, lg[6]); lg[7] = fmaf(xv, w1.w, lg[7]);
                lg[8] = fmaf(xv, w2.x, lg[8]); lg[9] = fmaf(xv, w2.y, lg[9]); lg[10] = fmaf(xv, w2.z, lg[10]); lg[11] = fmaf(xv, w2.w, lg[11]);
                lg[12] = fmaf(xv, w3.x, lg[12]); lg[13] = fmaf(xv, w3.y, lg[13]); lg[14] = fmaf(xv, w3.z, lg[14]); lg[15] = fmaf(xv, w3.w, lg[15]);
            }
#pragma unroll
        for (int e = 0; e < 16; ++e) lg[e] = wsum_all(lg[e]);
        float m = lg[0];
#pragma unroll
        for (int e = 1; e < 16; ++e) m = fmaxf(m, lg[e]);
        float pr[16], sum = 0.f;
#pragma unroll
        for (int e = 0; e < 16; ++e) { pr[e] = expf(lg[e] - m); sum += pr[e]; }
        float sl[16];
#pragma unroll
        for (int e = 0; e < 16; ++e) { pr[e] /= sum; sl[e] = pr[e] + rb[e]; }
        int bg = 0; float bgs = -INFINITY;
#pragma unroll
        for (int gI = 0; gI < 4; ++gI) {
            float m1 = -INFINITY, m2 = -INFINITY;
#pragma unroll
            for (int j = 0; j < 4; ++j) { const float x = sl[gI * 4 + j]; if (x > m1) { m2 = m1; m1 = x; } else if (x > m2) m2 = x; }
            const float sc = m1 + m2;
            if (sc > bgs) { bgs = sc; bg = gI; }
        }
        int e0 = -1, e1 = -1; float s0 = -INFINITY, s1 = -INFINITY, p0 = 0.f, p1 = 0.f;
#pragma unroll
        for (int e = 0; e < 16; ++e) {
            if ((e >> 2) == bg) {
                const float x = sl[e];
                if (x > s0) { s1 = s0; e1 = e0; p1 = p0; s0 = x; e0 = e; p0 = pr[e]; } else if (x > s1) { s1 = x; e1 = e; p1 = pr[e]; }
            }
        }
        if (lane == 0) {
            const float ws = p0 + p1;
            te[row * 2] = e0; te[row * 2 + 1] = e1; tw[row * 2] = p0 / ws; tw[row * 2 + 1] = p1 / ws;
        }
        const int r0 = __shfl(mycnt, e0, 64), r1 = __shfl(mycnt, e1, 64);
        if (lane == e0 || lane == e1) ++mycnt;
        if (lane == kk_) { my_row = row; my_e0 = e0; my_e1 = e1; my_r0 = r0; my_r1 = r1; }
    }
    int base = 0;
    if (lane < 16 && mycnt > 0) base = atomicAdd(&cnt[lane], mycnt);
    const int b0 = __shfl(base, my_e0, 64), b1 = __shfl(base, my_e1, 64);
    if (my_row >= 0) { trel[my_row * 2] = b0 + my_r0; trel[my_row * 2 + 1] = b1 + my_r1; }
}
DEVI void moe_gather2(const bf16* __restrict__ xn, const int* __restrict__ te, const int* __restrict__ trel, const int* __restrict__ cnt, int* __restrict__ slot,
                      int* __restrict__ nrt, int* __restrict__ tile_e, bf16* __restrict__ xg, int B0, int G, LAS int* ofs) {
    __syncthreads();
    if (tidx() == 0) {
        int s = 0;
#pragma unroll 1
        for (int e = 0; e < 16; ++e) { const int c = cnt[e]; ofs[e] = s; ofs[17 + e] = c; s += (c + 255) & ~255; }
        ofs[16] = s;
    }
    __syncthreads();
    const int gw = B0 * NWAVES + (tidx() >> 6), lane = tidx() & 63;
    if (B0 == 0 && tidx() < 16) {
        const int e = tidx();
        for (int r = ofs[e] >> 8; r < (ofs[e + 1] >> 8); ++r) tile_e[r] = e;
        if (e == 0) *nrt = ofs[16] >> 8;
    }
    if (B0 < 16) {
        const int o1 = ofs[B0 + 1];
        for (int r = ofs[B0] + ofs[17 + B0] + (tidx() >> 6); r < o1; r += NWAVES) { v4u* d = (v4u*)(xg + (size_t)r * DM); d[lane] = (v4u){0u, 0u, 0u, 0u}; d[lane + 64] = (v4u){0u, 0u, 0u, 0u}; }
    }
    for (int tok = gw; tok < NTOK; tok += G * NWAVES) {
        const v4u* s = (const v4u*)(xn + (size_t)tok * DM);
        const v4u a = s[lane], b = s[lane + 64];
#pragma unroll
        for (int q = 0; q < 2; ++q) {
            const int pr = ofs[te[tok * 2 + q]] + trel[tok * 2 + q];
            v4u* d = (v4u*)(xg + (size_t)pr * DM); d[lane] = a; d[lane + 64] = b;
            if (lane == 0) slot[tok * 2 + q] = pr;
        }
    }
}
DEVI void moe_combine_rows(bf16* xb, const bf16* __restrict__ Dp, const int* __restrict__ te, const float* __restrict__ tw, const int* __restrict__ slot,
                           const float* __restrict__ g, const float* __restrict__ bt, float* out  , int B0, int G) {
    const int gw = B0 * NWAVES + (tidx() >> 6); int lane = tidx() & 63;
    for (int row = gw; row < NTOK; row += G * NWAVES) {
        asm volatile("" : "+v"(lane));
        int ea = te[row * 2], eb = te[row * 2 + 1];
        float wa = tw[row * 2], wb = tw[row * 2 + 1];
        size_t pa = slot[row * 2], pb = slot[row * 2 + 1];
        if (eb < ea) { const float tf = wa; wa = wb; wb = tf; const size_t tp = pa; pa = pb; pb = tp; }
        float v[16];
#pragma unroll
        for (int j = 0; j < 4; ++j) {
            const int c = lane * 4 + 256 * j;
            const float4 xx = ld4bf(xb + (size_t)row * DM + c);
            const float4 da = ld4bf(Dp + pa * DM + c), db = ld4bf(Dp + pb * DM + c);
            v[4 * j] = ALPHA * xx.x + (wa * da.x + wb * db.x); v[4 * j + 1] = ALPHA * xx.y + (wa * da.y + wb * db.y);
            v[4 * j + 2] = ALPHA * xx.z + (wa * da.z + wb * db.z); v[4 * j + 3] = ALPHA * xx.w + (wa * da.w + wb * db.w);
        }
        ln_finish(v, g, bt, out ? out + (size_t)row * DM : (float*)nullptr, xb + (size_t)row * DM, lane);
    }
}
struct MP {
    const float* in[50];
    float *X, *TW, *R0;
    bf16 *XN, *MIX, *WIN_T, *WOUT_T, *WQK_T, *VWO_T, *W1_T, *W2_T, *LORA_T, *GWS, *VFIRST;
    int *TE, *SLOT, *LIST, *EOFF;
    unsigned* BAR;
    unsigned short nsa_items[248 * 3];
};

DEVI void tr_item(const float* W, int K, int N, int Npad, bf16* WT, LAS float* scr, int item, int lane) {
    const int nblk = Npad / 32, kb = item / nblk, nb = item % nblk, k0 = 64 * kb, n0 = 32 * nb;
    const int n_ = n0 + (lane & 31);
#pragma unroll 8
    for (int i = 0; i < 32; ++i) { const int kk = 2 * i + (lane >> 5); scr[kk * 33 + (lane & 31)] = n_ < N ? W[(size_t)(k0 + kk) * N + n_] : 0.f; }
    LDS_WAIT(); asm volatile("" ::: "memory");
    const int c = lane & 7;
#pragma unroll
    for (int j = 0; j < 4; ++j) { const int n = (lane >> 3) + 8 * j; const LAS float* s = scr + (8 * c) * 33 + n;
        v4u o; o.x = pk2(s[0 * 33], s[1 * 33]); o.y = pk2(s[2 * 33], s[3 * 33]); o.z = pk2(s[4 * 33], s[5 * 33]); o.w = pk2(s[6 * 33], s[7 * 33]);
        *(GAS v4u*)(WT + (size_t)(n0 + n) * K + k0 + 8 * c) = o; }
    LDS_WAIT(); asm volatile("" ::: "memory");
}

DEVI void gemm_all(const GemmArgs& g, int maxM, int Z, int B0, int G, unsigned char* lds) {
    const int total = gemm_tiles(g, maxM, Z);
    for (int t0 = B0 * 2; t0 < total; t0 += G * 2) {
        const int vb = tidx() >> 8; float* sm = (float*)(lds + vb * 32768);
        const bool l0 = gemm_tile_live(g, maxM, t0), l1 = (t0 + 1 < total) && gemm_tile_live(g, maxM, t0 + 1);
        if (!l0 && !l1) continue;
        const int t = (vb && t0 + 1 < total) ? t0 + 1 : t0;
        gemm_tile(g, maxM, t, vb ? l1 : l0, sm);
    }
}

typedef const __attribute__((address_space(4))) MP* kargp_t;
DEVI kargp_t kargs() { kargp_t q = (kargp_t)__builtin_amdgcn_kernarg_segment_ptr(); asm volatile("" : "+s"(q)); return q; }
__global__ void __launch_bounds__(512, 2) mega(MP p_arg) {
#define p (*kargs())
    extern __shared__ __attribute__((aligned(16))) unsigned char lds[];
    cg::grid_group grid = cg::this_grid();
    const int G = gridDim.x, B0 = blockIdx.x;
    {
        LAS unsigned* ctl = (LAS unsigned*)((LAS unsigned char*)lds + LDSCTL_OFF);
        for (int u = threadIdx.x; u < (LDS_BYTES - LDSCTL_OFF) / 4; u += NWAVES * 64) ctl[u] = 0u;
        __syncthreads();
        if ((threadIdx.x & 63) == 0) ctl[__builtin_amdgcn_s_getreg((5 << 11) | 4) & 63u] = threadIdx.x >> 6;
    }
    __syncthreads();
    volatile LAS unsigned* MISC = (volatile LAS unsigned*)((LAS unsigned char*)lds + MISC_OFF);
    XcdBarrier bar = xcd_barrier_post(p.BAR, MISC + 8);
    grid.sync();
#define GSYNC() do { REP(24) xcd_barrier(bar); } while (0)
    float* sm0 = (float*)lds;
    LAS unsigned char* ring = (LAS unsigned char*)lds + RING_OFF;
#define VLOOP(n, body) for (int t0_ = B0 * 2; t0_ < (n); t0_ += G * 2) { const int vb = tidx() >> 8; float* sm = (float*)(lds + vb * 32768); const int t = min(t0_ + vb, (n) - 1); body; }

#define x_in (p.in[0])
#define mem (p.in[1])
#define RB ((unsigned char*)p.R0)
#define SZ_TB ((size_t)NTOK * 256 * 2)
#define rAT ((bf16*)RB)
#define rBT ((bf16*)(RB + 1 * SZ_TB))
#define rKT ((bf16*)(RB + 2 * SZ_TB))
#define rRT ((bf16*)(RB + 3 * SZ_TB))
#define rV ((bf16*)(RB + 4 * SZ_TB))
#define rG ((bf16*)(RB + 5 * SZ_TB))
#define rBON ((bf16*)(RB + 6 * SZ_TB))
#define QNb ((bf16*)(RB + 7 * SZ_TB))
#define QRb ((bf16*)(RB + 8 * SZ_TB))
#define UBb ((bf16*)(RB + 9 * SZ_TB))
#define VBb ((bf16*)(RB + 10 * SZ_TB))
#define KSRb ((bf16*)(RB + 11 * SZ_TB))
#define KWRb (KSRb + (size_t)NTOK * 64)
#define VSTb (KWRb + (size_t)NTOK * 64)
#define VWTb (VSTb + (size_t)NTOK * 64)
#define BLKb (VWTb + (size_t)NTOK * 64)
#define BLVb (BLKb + (size_t)1024 * 2048)
#define rLAM ((float*)(BLVb + (size_t)1024 * 2048))
#define GATESb (rLAM + 1024 * 64)
#define COLSB ((bf16*)(RB + 110100480))
#define rPF ((v4u*)COLSB)
#define rHF (rPF + (size_t)1024 * 512)
#define rSF (rHF + (size_t)1024 * 512)
#define rQT ((float*)(rSF + (size_t)1024 * 512))
#define rOL (rQT + (size_t)1024 * 4096)
#define HIDK (rOL + (size_t)1024 * 4096)
#define HIDV (HIDK + (size_t)1024 * 256)
#define KCMPb ((bf16*)(HIDV + (size_t)1024 * 256))
#define VCMPTb (KCMPb + (size_t)NB * 512 * 64)
#define YBUF ((bf16*)p.R0)
#define PB ((bf16*)(p.R0 + (size_t)17 * 1000 * 1000))
#define XG ((bf16*)p.R0)
#define HB ((bf16*)(p.R0 + (size_t)19 * 1000 * 1000))
#define WGU_T ((bf16*)(p.R0 + (size_t)43 * 1000 * 1000))
#define WD_T ((bf16*)(p.R0 + (size_t)51500000))

    bf16* WQB = (bf16*)p.R0;
    bf16* WKT = WQB + (size_t)2 * DM * DM;
    bf16* WVT = WKT + (size_t)2 * DM * DM;
    bf16* WOT = WVT + (size_t)2 * DM * DM;
    bf16* MEMB = WOT + (size_t)2 * DM * DM;
    bf16* KMEMB = MEMB + (size_t)NB * MEML * DM;
    bf16* VMEMB = KMEMB + (size_t)2 * NB * MEML * DM;
    {
        LAS float* scr = (LAS float*)(ring + (tidx() >> 6) * 16384);
        const int gw = B0 * NWAVES + (tidx() >> 6), NGW = G * NWAVES, lane = tidx() & 63;
        constexpr int I_IN = (DM / 64) * (DINP / 32), I_SQ = (DM / 64) * (DM / 32), I_W1 = (2048 / 64) * (256 / 32);
        for (int it = gw; it < 2 * I_IN + 8 * I_SQ + 4 * I_W1; it += NGW) {
            int r = it;
            if (r < 2 * I_IN) {
                const int l = r / I_IN, item = r % I_IN; const int nblk = DINP / 32, kb = item / nblk, nb = item % nblk, k0 = 64 * kb, n0 = 32 * nb;
                const float* W = p.in[4] + (size_t)l * DM * DIN; const float* VD = p.in[21];
                const int n_ = n0 + (lane & 31);
#pragma unroll 8
                for (int i = 0; i < 32; ++i) { const int kk = 2 * i + (lane >> 5);
                    float v = 0.f;
                    if (n_ < DIN) v = W[(size_t)(k0 + kk) * DIN + n_]; else if (l == 1 && n_ < DIN + 32) v = VD[(size_t)(k0 + kk) * 32 + (n_ - DIN)];
                    scr[kk * 33 + (lane & 31)] = v; }
                LDS_WAIT(); asm volatile("" ::: "memory");
                const int c = lane & 7; bf16* WT = p.WIN_T + (size_t)l * DINP * DM;
#pragma unroll
                for (int j = 0; j < 4; ++j) { const int n = (lane >> 3) + 8 * j; const LAS float* s = scr + (8 * c) * 33 + n;
                    v4u o; o.x = pk2(s[0 * 33], s[1 * 33]); o.y = pk2(s[2 * 33], s[3 * 33]); o.z = pk2(s[4 * 33], s[5 * 33]); o.w = pk2(s[6 * 33], s[7 * 33]);
                    *(GAS v4u*)(WT + (size_t)(n0 + n) * DM + k0 + 8 * c) = o; }
                LDS_WAIT(); asm volatile("" ::: "memory");
                continue;
            }
            r -= 2 * I_IN;
            if (r < 8 * I_SQ) {
                const int which = r / (2 * I_SQ), l = (r / I_SQ) & 1, item = r % I_SQ, kb = item / 32, nb = item % 32;
                const float* W = (which == 0 ? p.in[5] : which == 1 ? p.in[38] : which == 2 ? p.in[39] : p.in[40]) + (size_t)l * DM * DM;
                bf16* WT = (which == 0 ? p.WOUT_T : which == 1 ? WKT : which == 2 ? WVT : WOT) + (size_t)l * DM * DM;
                tr_blk(W, DM, DM, kb * 64, nb * 32, WT, DM, nb * 32, 1.f, scr, lane);
                continue;
            }
            r -= 8 * I_SQ;
            {
                const int which = r / I_W1, item = r % I_W1, kb = item / 8, nb = item % 8, l = which >> 1;
                const float* W = ((which & 1) ? p.in[33] : p.in[30]) + (size_t)l * 2048 * 256;
                tr_blk(W, 256, 256, kb * 64, nb * 32, p.W1_T + (size_t)which * 256 * 2048, 2048, nb * 32, 1.f, scr, lane);
            }
        }
        for (int it = gw; it < 64; it += NGW) {
            if (it < 32) { const int which = it >> 3, nb = it & 7, l = which & 1;
                tr_blk(((which >> 1) ? p.in[14] : p.in[12]) + (size_t)l * 64 * 256, 256, 256, 0, nb * 32, p.LORA_T + (size_t)which * 256 * 64, 64, nb * 32, 1.f, scr, lane); }
            else { const int r2 = it - 32, l = r2 >> 4, kb = (r2 >> 3) & 1, nb = r2 & 7;
                tr_blk(p.in[15] + (size_t)l * 128 * 256, 256, 256, kb * 64, nb * 32, p.LORA_T + (size_t)4 * 256 * 64 + (size_t)l * 256 * 128, 128, nb * 32, 1.f, scr, lane); }
        }
        for (int e = B0 * 512 + tidx(); e < 256 * 32; e += G * 512) { const int n = e >> 5, k = e & 31;
            p.LORA_T[(size_t)4 * 256 * 64 + (size_t)2 * 256 * 128 + e] = (bf16)f2bf(p.in[24][k * 256 + n]); }
        for (int e = B0 * 512 + tidx(); e < 4 * 64 * 256; e += G * 512) { const int which = e >> 14, n = (e >> 8) & 63, k = e & 255;
            p.W2_T[e] = (bf16)f2bf(((which & 1) ? p.in[34] : p.in[31])[(size_t)(which >> 1) * 256 * 64 + k * 64 + n]); }
        for (int e = B0 * 512 + tidx(); e < 2 * 4 * 128 * 128; e += G * 512) { const int t = (e >> 7) & 127, s = e & 127;
            p.GWS[e] = s <= t ? (bf16)f2bf(p.in[27][e]) : (bf16)0; }
        cvt_bf16(p.in[37], WQB, (size_t)2 * DM * DM, 1.f, B0, G);
        cvt_bf16(mem, MEMB, (size_t)NB * MEML * DM, 1.f, B0, G);
    }
    __syncthreads();
    ln_rows_in(x_in, p.in[2], p.in[3], p.XN, B0, G);
    GSYNC();
    {
        const int gi = B0 >> 3, un = B0 & 7;
        pg8::Gemm g{MEMB, ((gi & 1) ? WVT : WKT) + (size_t)(gi >> 1) * DM * DM, NB * MEML, DM, DM};
        pg8::OneUnit S{un >> 2, un & 3, B0 < 32 ? 1 : 0};
        pg8::EpiBf16<0> E{((gi & 1) ? VMEMB : KMEMB) + (size_t)(gi >> 1) * NB * MEML * DM, DM, nullptr, 0, 0, 1.f};
        pg8::gemm_phase<pg8::EpiBf16<0>, pg8::OneUnit, false, true>(ring, g, S, E);
    }
    GSYNC();
    {
        const int l = (B0 >> 6) & 1, kind = (B0 >> 5) & 1, bh = (B0 >> 2) & 7, q4 = B0 & 3, b = bh >> 2, h = bh & 3;
        if (kind == 0) {
            pg8::Gemm g{KMEMB + (size_t)l * NB * MEML * DM + (size_t)b * MEML * DM + h * 256, WQB + (size_t)l * DM * DM + h * 256, 256, DM, 256, DM, DM};
            pg8::OneUnit S{0, q4, B0 < 128 ? 1 : 0};
            pg8::EpiBf16S E{p.WQK_T + (size_t)l * NB * DM * DM + (size_t)b * DM * DM + (size_t)h * 256 * DM, DM, 0.0625f * 1.4426950408889634f};
            pg8::gemm_phase<pg8::EpiBf16S, pg8::OneUnit, false, true>(ring, g, S, E);
        } else {
            pg8::Gemm g{WOT + (size_t)l * DM * DM + h * 256, VMEMB + (size_t)l * NB * MEML * DM + (size_t)b * MEML * DM + h * 256, DM, 256, 256, DM, DM};
            pg8::OneUnit S{q4, 0, B0 < 128 ? 1 : 0};
            pg8::EpiBf16S E{p.VWO_T + (size_t)l * NB * DM * DM + (size_t)b * DM * DM + h * 256, DM, 1.f};
            pg8::gemm_phase<pg8::EpiBf16S, pg8::OneUnit, false, true>(ring, g, S, E);
        }
    }
    GSYNC();
    for (int l = 0; l < 2; ++l) {
REP(1) {
        {
            pg8::Gemm g{p.XN, p.WIN_T + (size_t)l * DINP * DM, NTOK, DINP, DM};
            pg8::StaticOrder S; S.init(NTOK, DINP, G, B0);
            pg8::EpiBf16<0> E{COLSB, DINP, nullptr, 0, 0, 1.f};
            pg8::gemm_phase<pg8::EpiBf16<0>, pg8::StaticOrder, true, true>(ring, g, S, E);
        }
}
        GSYNC();
#define MK_RW() RwP rw; rw.R = nullptr; rw.K = nullptr; rw.V = rV; rw.A = nullptr; rw.B = nullptr; rw.LW = nullptr; rw.G = rG; rw.BON = rBON; \
        rw.AT = rAT; rw.BT = rBT; rw.KT = rKT; rw.RT = rRT; rw.LAM = rLAM; rw.PF = rPF; rw.HF = rHF; rw.QT = rQT; rw.OL = rOL; rw.SF = rSF; \
        rw.gn_g = p.in[19] + l * 256; rw.gn_b = p.in[20] + l * 256; rw.MIX = p.MIX;
        {
            MixP mp;
            mp.COLS = COLSB;
            mp.conv_w = p.in[6] + (size_t)l * 31 * 256; mp.conv_b = p.in[7] + l * 256; mp.conv_gg = p.in[8] + l * 256; mp.conv_gb = p.in[9] + l * 256;
            mp.gl_g = p.in[25] + l * 256; mp.gl_b = p.in[26] + l * 256;
            mp.mu = p.in[10] + l * 1024; mp.w0 = p.in[11] + l * 256; mp.a0 = p.in[13] + l * 256; mp.k_k = p.in[16] + l * 256; mp.k_a = p.in[17] + l * 256; mp.r_k = p.in[18] + l * 256;
            mp.v_mu = p.in[22]; mp.v0 = p.in[23];
            mp.WUP_T = p.LORA_T + (size_t)l * 256 * 64; mp.AUP_T = p.LORA_T + (size_t)(2 + l) * 256 * 64; mp.GUP_T = p.LORA_T + (size_t)4 * 256 * 64 + (size_t)l * 256 * 128;
            mp.VUP_T = p.LORA_T + (size_t)4 * 256 * 64 + (size_t)2 * 256 * 128;
            mp.pe_k = p.in[29] + (size_t)l * 2048; mp.pe_v = p.in[32] + (size_t)l * 2048;
            mp.MIX = p.MIX; mp.UB = UBb; mp.VB = VBb;
            mp.AT = rAT; mp.BT = rBT; mp.KT = rKT; mp.RT = rRT; mp.V = rV; mp.G = rG; mp.BON = rBON; mp.VFIRST = p.VFIRST; mp.LAM = rLAM;
            mp.QN = QNb; mp.QR = QRb; mp.KSR = KSRb; mp.KWR = KWRb; mp.VST = VSTb; mp.VWT = VWTb; mp.GATES = GATESb; mp.BLK = BLKb; mp.BLV = BLVb;
            mp.layer = l; mp.pad = 0;
            if (B0 == 0 && tidx() == 0) p.EOFF[600] = 0;
REP(2) {
            for (int cg = B0; cg < NTOK / 64; cg += G) prep_unit(mp, cg, ring);
}
        }
        GSYNC();
        {
REP(4) {
            {
                const int isv = (B0 >> 2) & 1;
                pg8::Gemm g{isv ? BLVb : BLKb, p.W1_T + (size_t)(l * 2 + isv) * 256 * 2048, 1024, 256, 2048};
                pg8::OneUnit S{B0 & 3, 0, B0 < 8 ? 1 : 0};
                pg8::EpiGeluW2 E{p.W2_T + (size_t)(l * 2 + isv) * 64 * 256, isv ? VCMPTb : KCMPb, isv};
                pg8::gemm_phase<pg8::EpiGeluW2, pg8::OneUnit, false, true>(ring, g, S, E);
            }
}
REP(6) {
            MK_RW()
            for (int u0 = 2 * (G - 1 - B0); u0 < 1024; u0 += 2 * G) rw_r2(rw, u0, ring);
}
REP(5) {
            for (int c = G - 1 - B0; c < NTOK / 128; c += G) gmlp_unit(UBb, VBb, p.GWS + (size_t)l * 4 * 128 * 128, p.in[28] + l * 4 * 128, p.MIX, c, ring);
}
        }
        GSYNC();
        if (B0 >= G - 8) {
REP(8) {
            { MK_RW() const int w_ = tidx() >> 6, bh = G - 1 - B0; if (w_ < 2) rw_r3(rw, bh >> 2, bh & 3, w_, tidx() & 63, ring + w_ * 65536); }
}
        } else {
REP(9) {
            for (int round = 0; round < 3; ++round) {
                const unsigned it = B0 < 248 ? p.nsa_items[B0 * 3 + round] : 0xffffu;
                if (it == 0xffffu) break;
                const int b = it & 1, tile = (it >> 1) & 127, kind = it >> 8;
                NsaP np; np.QN = QNb + (size_t)b * SEQ * 256; np.QR = QRb + (size_t)b * SEQ * 256; np.KSR = KSRb + (size_t)b * SEQ * 64; np.KWR = KWRb + (size_t)b * SEQ * 64;
                np.VST = VSTb + (size_t)b * 64 * SEQ; np.VWT = VWTb + (size_t)b * 64 * SEQ; np.KCMP = KCMPb + (size_t)b * 512 * 64; np.VCMPT = VCMPTb + (size_t)b * 64 * 512;
                np.GATES = GATESb + (size_t)b * SEQ * 12; np.MIX = p.MIX + (size_t)b * SEQ * DM;
                nsa_unit(np, tile, ring, kind, (unsigned*)UBb + (size_t)(b * 64 + (tile & 63)) * (3 * 8 * 18 * 64));
            }
}
            {
                __syncthreads();
                LAS float* scr = (LAS float*)(ring + (tidx() >> 6) * 16384);
                LAS int* grab = (LAS int*)(ring + 131072 - 64);
                const int wv_ = tidx() >> 6, lane = tidx() & 63;
                const float* wg = p.in[45] + (size_t)l * 16 * DM * 512;
                const float* wu = p.in[46] + (size_t)l * 16 * DM * 512;
                const float* wd = p.in[47] + (size_t)l * 16 * 512 * DM;
                constexpr int I_GU = (DM / 64) * (512 / 32), I_D = (512 / 64) * (DM / 32), I_ALL = 16 * (2 * I_GU + I_D);
                for (;;) {
                    if (tidx() == 0) *grab = atomicAdd(p.EOFF + 600, 64);
                    __syncthreads();
                    const int base = *grab;
                    __syncthreads();
                    if (base >= I_ALL) break;
#pragma unroll 1
                    for (int it = base + wv_; it < base + 64 && it < I_ALL; it += NWAVES) {
                        const int e = it / (2 * I_GU + I_D); int r = it % (2 * I_GU + I_D);
                        if (r < 2 * I_GU) {
                            const int isup = r / I_GU; r %= I_GU;
                            const int kb = r / 16, nb = r % 16, n0 = nb * 32;
                            tr_blk((isup ? wu : wg) + (size_t)e * DM * 512, 512, 512, kb * 64, n0, WGU_T + (size_t)e * 1024 * DM, DM, (n0 >> 7) * 256 + (n0 & 127) + isup * 128, 1.f, scr, lane);
                        } else {
                            r -= 2 * I_GU;
                            const int kb = r / 32, nb = r % 32;
                            tr_blk(wd + (size_t)e * 512 * DM, DM, DM, kb * 64, nb * 32, WD_T + (size_t)e * DM * 512, 512, nb * 32, 1.f, scr, lane);
                        }
                    }
                }
            }
        }
        GSYNC();
REP(10) {
        MK_RW()
        for (int i = B0 * NWAVES + (tidx() >> 6); i < 2048; i += G * NWAVES) rw_r4(rw, i >> 1, i & 1, tidx() & 63);
        for (int i = (G - 1 - B0) * NWAVES + (tidx() >> 6); i < 1024; i += G * NWAVES) {
            const int su = i >> 3, b = su >> 6, tile = 64 + (su & 63);
            NsaP np; np.GATES = GATESb + (size_t)b * SEQ * 12; np.MIX = p.MIX + (size_t)b * SEQ * DM;
            nsa_combine(np, tile, i & 7, tidx() & 63, (const unsigned*)UBb + (size_t)su * (3 * 8 * 18 * 64));
        }
}
        GSYNC();
        {
REP(11) {
            pg8::Gemm g{p.MIX, p.WOUT_T + (size_t)l * DM * DM, NTOK, DM, DM};
            pg8::StaticOrder S; S.init(NTOK, DM, G, B0);
            pg8::EpiBf16<0> E{YBUF, DM, nullptr, 0, 0, 1.f};
            pg8::gemm_phase<pg8::EpiBf16<0>, pg8::StaticOrder, true, true>(ring, g, S, E);
}
        }
        GSYNC();
        ln_rows(p.XN, ALPHA, YBUF, p.in[35] + l * DM, p.in[36] + l * DM, B0, G);
        if (B0 == 0 && tidx() < 16) p.EOFF[512 + tidx()] = 0;
        __syncthreads();
        GSYNC();
        {
            bf16* WQK_T = p.WQK_T + (size_t)l * NB * DM * DM;
REP(14) {
            pg8::Gemm g{p.XN, WQK_T, NTOK, DM, DM};
            pg8::XaOrder S{G, B0};
            pg8::EpiSoftmaxP E{PB};
            pg8::gemm_phase<pg8::EpiSoftmaxP, pg8::XaOrder, false, true>(ring, g, S, E);
}
        }
        GSYNC();
        {
REP(15) {
            pg8::Gemm g{PB, p.VWO_T + (size_t)l * NB * DM * DM, NTOK, DM, DM};
            pg8::XaOrder S{G, B0};
            pg8::EpiBf16N4 E{YBUF, DM};
            pg8::gemm_phase<pg8::EpiBf16N4, pg8::XaOrder, true, true>(ring, g, S, E);
}
        }
        GSYNC();
        ln_router_rows(p.XN, YBUF, p.in[41] + l * DM, p.in[42] + l * DM, p.in[43], p.in[44], p.TE, p.TW, p.LIST, p.EOFF + 512, B0, G);
        GSYNC();
REP(21) {
        moe_gather2(p.XN, p.TE, p.LIST, p.EOFF + 512, p.SLOT, p.EOFF + 32, p.EOFF + 64, XG, B0, G, (LAS int*)ring);
}
        GSYNC();
        {
REP(22) {
            pg8::Gemm g{XG, WGU_T, 0, 0, DM};
            pg8::MoeOrder S{p.EOFF + 64, p.EOFF + 32, G, B0};
            pg8::EpiSiluMul E{HB};
            pg8::gemm_phase<pg8::EpiSiluMul, pg8::MoeOrder, true, true>(ring, g, S, E);
}
        }
        GSYNC();
        {
REP(23) {
            pg8::Gemm g{HB, WD_T, 0, 0, 512};
            pg8::MoeOrder S{p.EOFF + 64, p.EOFF + 32, G, B0};
            pg8::EpiBf16N4 E{XG, DM};
            pg8::gemm_phase<pg8::EpiBf16N4, pg8::MoeOrder, true, true>(ring, g, S, E);
}
        }
        GSYNC();
        moe_combine_rows(p.XN, XG, p.TE, p.TW, p.SLOT, p.in[48] + l * DM, p.in[49] + l * DM, l == 1 ? p.X : (float*)nullptr, B0, G);
        GSYNC();
    }
}

#undef RB
#undef SZ_TB
#undef rAT
#undef rBT
#undef rKT
#undef rRT
#undef rV
#undef rG
#undef rBON
#undef QNb
#undef QRb
#undef UBb
#undef VBb
#undef KSRb
#undef KWRb
#undef VSTb
#undef VWTb
#undef BLKb
#undef BLVb
#undef rLAM
#undef GATESb
#undef COLSB
#undef rPF
#undef rHF
#undef rSF
#undef rQT
#undef rOL
#undef HIDK
#undef HIDV
#undef KCMPb
#undef VCMPTb
#undef YBUF
#undef PB
#undef XG
#undef HB
#undef WGU_T
#undef WD_T
#undef x_in
#undef mem
#undef p
extern "C" void kernel_launch(void* const* d_in, const int* in_sizes, int n_in, void* d_out, int out_size, void* d_ws, size_t ws_size,
                              hipStream_t stream) {
    static int grid_blocks = 0;
    if (!grid_blocks) {
        int dev = 0, cus = 0, per_cu = 0;
        (void)hipGetDevice(&dev);
        (void)hipDeviceGetAttribute(&cus, hipDeviceAttributeMultiprocessorCount, dev);
        (void)hipFuncSetAttribute((const void*)mega, hipFuncAttributeMaxDynamicSharedMemorySize, LDS_BYTES);
        (void)hipOccupancyMaxActiveBlocksPerMultiprocessor(&per_cu, (const void*)mega, NWAVES * 64, LDS_BYTES);
        (void)hipGetLastError();
        if (per_cu < 1) { fprintf(stderr, "occupancy query says %d blocks per CU\n", per_cu); per_cu = 1; }
        grid_blocks = cus;
    }
    MP p; memset(&p, 0, sizeof(p));
    for (int i = 0; i < 50; ++i) p.in[i] = (const float*)d_in[i];
    char* ws = (char*)d_ws;
    size_t o = 0;
    auto take = [&](size_t bytes) { char* q = ws + o; o += (bytes + 255) & ~(size_t)255; return q; };
    p.BAR = (unsigned*)take(16384);
    p.X = (float*)d_out;
    p.VFIRST = (bf16*)take((size_t)NTOK * 256 * 2);
    p.LORA_T = (bf16*)take((size_t)(4 * 256 * 64 + 2 * 256 * 128 + 256 * 32) * 2);
    p.GWS = (bf16*)take((size_t)2 * 4 * 128 * 128 * 2);
    p.MIX = (bf16*)take((size_t)NTOK * DM * 2);
    p.XN = (bf16*)take((size_t)NTOK * DM * 2);
    p.WIN_T = (bf16*)take((size_t)2 * DINP * DM * 2);
    p.WOUT_T = (bf16*)take((size_t)2 * DM * DM * 2);
    p.WQK_T = (bf16*)take((size_t)2 * NB * DM * DM * 2);
    p.VWO_T = (bf16*)take((size_t)2 * NB * DM * DM * 2);
    p.W1_T = (bf16*)take((size_t)4 * 256 * 2048 * 2);
    p.W2_T = (bf16*)take((size_t)4 * 64 * 256 * 2);
    p.TE = (int*)take((size_t)NTOK * 2 * 4);
    p.TW = (float*)take((size_t)NTOK * 2 * 4);
    p.SLOT = (int*)take((size_t)NTOK * 2 * 4);
    p.LIST = (int*)take((size_t)36864 * 4);
    p.EOFF = (int*)take(4096);
    p.R0 = (float*)take((size_t)56500000 * 4);
    if (o > ws_size) { fprintf(stderr, "workspace too small: need %zu have %zu\n", o, ws_size); return; }
    {
        struct It { int cost; unsigned short code; } its[384]; int n = 0;
        for (int b = 0; b < 2; ++b)
            for (int t = 0; t < 128; ++t) {
                if (t < 64) { its[n].cost = 26 + t; its[n].code = (unsigned short)(b | (t << 1)); ++n; }
                else { const int js = (t + 10) >> 1;
                    its[n].cost = 26 + (t - js); its[n].code = (unsigned short)(b | (t << 1) | (1 << 8)); ++n;
                    its[n].cost = 16 + js; its[n].code = (unsigned short)(b | (t << 1) | (2 << 8)); ++n; }
            }
        for (int i = 1; i < n; ++i) { It x = its[i]; int j = i - 1; while (j >= 0 && (its[j].cost < x.cost || (its[j].cost == x.cost && its[j].code > x.code))) { its[j + 1] = its[j]; --j; } its[j + 1] = x; }
        int load[248], cnt[248];
        for (int w = 0; w < 248; ++w) { load[w] = 0; cnt[w] = 0; for (int r = 0; r < 3; ++r) p.nsa_items[w * 3 + r] = 0xffff; }
        for (int i = 0; i < n; ++i) {
            int best = -1;
            for (int w = 0; w < 248; ++w) if (cnt[w] < 3 && (best < 0 || load[w] < load[best])) best = w;
            p.nsa_items[best * 3 + cnt[best]] = its[i].code; ++cnt[best]; load[best] += its[i].cost;
        }
    }
    (void)hipMemsetAsync(p.BAR, 0, 16384, stream);
    void* args[] = {&p};
    hipError_t e = hipLaunchCooperativeKernel((const void*)mega, dim3(grid_blocks), dim3(NWAVES * 64), args, LDS_BYTES, stream);
    if (e != hipSuccess) fprintf(stderr, "cooperative launch failed: %s (grid %d)\n", hipGetErrorString(e), grid_blocks);
}
```
